# Optimizing an MI355X kernel written in HIP

```python
import jax, jax.numpy as jnp
from jax import lax
import numpy as np

D_MODEL = 1024
BATCH = 1
SEQ = 16384
DEPTH = 4
DEC_BATCH = 32
DEC_SEQ = 32
PAST_LEN = 2048

CHUNK = 64
D_FF = 4 * D_MODEL
N_AB_LAYERS = (DEPTH + 1) // 2
N_C_LAYERS = DEPTH // 2
RET_HEADS = 4
RET_DK = D_MODEL // 16
RET_DV = D_MODEL // 8
ROPE_BASE = 10000.0
HG_HEADS = 4
HG_DK = D_MODEL // 8
HG_DV = D_MODEL // 8
AB_IN = 2 * RET_HEADS * RET_DK + 2 * RET_HEADS * RET_DV + 2 * HG_HEADS * HG_DK + 2 * HG_HEADS * HG_DV
AB_OUT = RET_HEADS * RET_DV + HG_HEADS * HG_DV
RW_N = 64
RW_HEADS = D_MODEL // RW_N
RW_DECAY_LORA = 64
RW_AAA_LORA = 64
RW_MV_LORA = 32
RW_GATE_LORA = 160
NORM_EPS = 1e-6
RW_LN_EPS = 64e-5

kernel_name = 'retention_hgrn2_rwkv7_adaln_stream_step'


def _rmsnorm(x, g):
    xf = x.astype(jnp.float32)
    y = xf * lax.rsqrt(jnp.mean(xf * xf, -1, keepdims=True) + NORM_EPS)
    return (y * g.astype(jnp.float32)).astype(x.dtype)


def _head_rms(o):
    return o * lax.rsqrt(jnp.mean(o * o, -1, keepdims=True) + NORM_EPS)


def _rotary(x, pos):
    half = x.shape[-1] // 2
    inv = ROPE_BASE ** (-jnp.arange(half, dtype=jnp.float32) / half)
    ang = pos[:, None] * inv[None, :]
    cos = jnp.cos(ang)[None, :, None, :]
    sin = jnp.sin(ang)[None, :, None, :]
    x1, x2 = x[..., :half], x[..., half:]
    return jnp.concatenate([x1 * cos - x2 * sin, x1 * sin + x2 * cos], -1)


def _chunked_scan(step, s0, *seqs):
    b, t = seqs[0].shape[:2]
    l = min(t, CHUNK)
    n = t // l
    blocks = tuple(jnp.moveaxis(a.reshape((b, n, l) + a.shape[2:]), 1, 0) for a in seqs)
    s, out = lax.scan(lambda s, xs: step(s, *xs), s0, blocks)
    out = jnp.moveaxis(out, 0, 1)
    return out.reshape((b, t) + out.shape[3:]), s


def _retention_step(s, q, k, v):
    l = q.shape[1]
    log_g = jnp.log1p(-jnp.exp2(-5.0 - jnp.arange(RET_HEADS, dtype=jnp.float32)))
    idx = jnp.arange(l, dtype=jnp.float32)
    rel = idx[:, None] - idx[None, :]
    dmat = jnp.exp(jnp.where(rel[None] >= 0, rel[None] * log_g[:, None, None], -jnp.inf))
    scores = jnp.einsum('bihd,bjhd->bhij', q, k) * dmat
    inner = jnp.einsum('bhij,bjhe->bihe', scores, v)
    cross = jnp.einsum('bihd,bhde->bihe', q, s) * jnp.exp((idx[:, None] + 1.0) * log_g[None, :])[None, :, :, None]
    k_dec = k * jnp.exp((l - 1.0 - idx)[:, None] * log_g[None, :])[None, :, :, None]
    s_new = jnp.exp(l * log_g)[None, :, None, None] * s + jnp.einsum('bjhd,bjhe->bhde', k_dec, v)
    return s_new, inner + cross


def _hgrn2_step(s, q, k, v, log_f):
    l = q.shape[1]
    b = jnp.cumsum(log_f, axis=1)
    causal = jnp.tril(jnp.ones((l, l), dtype=bool))
    diff = b[:, :, None] - b[:, None, :]
    decay = jnp.exp(jnp.where(causal[None, :, :, None, None], diff, -jnp.inf))
    attn = jnp.einsum('bihc,bjhc,bijhc->bhij', q, k, decay)
    inner = jnp.einsum('bhij,bjhe->bihe', attn, v)
    cross = jnp.einsum('bihc,bhce->bihe', q * jnp.exp(b), s)
    b_last = b[:, -1:]
    s_new = jnp.exp(b_last[:, 0])[..., None] * s + jnp.einsum('bjhc,bjhe->bhce', k * jnp.exp(b_last - b), v)
    return s_new, inner + cross


def _mix_ab(h, pos, s_ret, s_hg, w_in, lb, hg_g, w_out):
    f32 = jnp.float32
    bsz, t, _ = h.shape
    z = (h @ w_in).astype(f32)
    widths = [RET_HEADS * RET_DK] * 2 + [RET_HEADS * RET_DV] * 2 + [HG_HEADS * HG_DK] * 2 + [HG_HEADS * HG_DV] * 2
    cuts = [int(c) for c in np.cumsum(widths)[:-1]]
    q_a, k_a, v_a, g_a, q_b, f_b, i_b, g_b = jnp.split(z, cuts, axis=-1)
    q = _rotary(q_a.reshape(bsz, t, RET_HEADS, RET_DK), pos) * (RET_DK ** -0.5)
    k = _rotary(k_a.reshape(bsz, t, RET_HEADS, RET_DK), pos)
    v = v_a.reshape(bsz, t, RET_HEADS, RET_DV)
    o_a, s_ret = _chunked_scan(_retention_step, s_ret.astype(f32), q, k, v)
    o_a = _head_rms(o_a).reshape(bsz, t, -1) * jax.nn.silu(g_a)
    lb = lb.reshape(HG_HEADS, HG_DK)
    zf = f_b.reshape(bsz, t, HG_HEADS, HG_DK)
    log_f = jnp.logaddexp(jnp.log(lb), jnp.log1p(-lb) + jax.nn.log_sigmoid(zf))
    k_b = (1.0 - lb) * jax.nn.sigmoid(-zf)
    q_h = jax.nn.silu(q_b).reshape(bsz, t, HG_HEADS, HG_DK)
    v_h = i_b.reshape(bsz, t, HG_HEADS, HG_DV)
    o_b, s_hg = _chunked_scan(_hgrn2_step, s_hg.astype(f32), q_h, k_b, v_h, log_f)
    o_b = (_head_rms(o_b) * hg_g.astype(f32)).reshape(bsz, t, -1) * jax.nn.sigmoid(g_b)
    out = jnp.concatenate([o_a, o_b], -1).astype(h.dtype) @ w_out
    return out, s_ret, s_hg


def _mix_rwkv(h, shift, s_wkv, v_first, vres, mu, w_rkv, w0, w1, w2, a0, a1, a2, g1, g2, k_k, k_a, r_k, ln_g, ln_b, w_out):
    f32 = jnp.float32
    bsz, t, d = h.shape
    prev = jnp.concatenate([shift[:, None].astype(h.dtype), h[:, :-1]], axis=1)
    xx = prev - h
    xr, xw, xk, xv, xa, xg = [h + xx * mu[i] for i in range(6)]
    r = (xr @ w_rkv[0]).astype(f32)
    k = (xk @ w_rkv[1]).astype(f32)
    v = (xv @ w_rkv[2]).astype(f32)
    if vres is None:
        v_first = v
    else:
        v0, v1, v2 = vres
        v = v + (v_first - v) * jax.nn.sigmoid((v0 + (xv @ v1) @ v2).astype(f32))
    w = -jax.nn.softplus(-(w0 + jnp.tanh(xw @ w1) @ w2).astype(f32)) - 0.5
    decay = jnp.exp(-jnp.exp(w))
    a = jax.nn.sigmoid((a0 + (xa @ a1) @ a2).astype(f32))
    g = jax.nn.sigmoid(xg @ g1) @ g2
    heads = lambda u: u.reshape(bsz, t, RW_HEADS, RW_N)
    kk = heads(k * k_k)
    kk = kk / jnp.maximum(jnp.sqrt(jnp.sum(kk * kk, -1, keepdims=True)), 1e-12)
    k_h = heads(k * (1.0 + (a - 1.0) * k_a))
    r_h, v_h, w_h, a_h = heads(r), heads(v), heads(decay), heads(a)

    def step(s, inp):
        r_t, w_t, k_t, v_t, kk_t, a_t = inp
        sa = jnp.einsum('bhij,bhj->bhi', s, -kk_t)
        s = s * w_t[:, :, None, :] + sa[..., None] * (kk_t * a_t)[:, :, None, :] + v_t[..., None] * k_t[:, :, None, :]
        return s, jnp.einsum('bhij,bhj->bhi', s, r_t)

    tm = lambda u: jnp.moveaxis(u, 1, 0)
    s_wkv, y = lax.scan(step, s_wkv.astype(f32), tuple(tm(u) for u in (r_h, w_h, k_h, v_h, kk, a_h)))
    y = tm(y)
    mean = jnp.mean(y, -1, keepdims=True)
    var = jnp.mean(jnp.square(y - mean), -1, keepdims=True)
    y = ((y - mean) * lax.rsqrt(var + RW_LN_EPS)).reshape(bsz, t, d) * ln_g + ln_b
    y = y + (jnp.sum(r_h * k_h * r_k, -1, keepdims=True) * v_h).reshape(bsz, t, d)
    out = (y * g).astype(h.dtype) @ w_out
    return out, s_wkv, h[:, -1], v_first


def _trunk(x, c, pos, s_ret, s_hg, s_wkv, s_shift, W):
    lb_all = jnp.cumsum(jax.nn.softmax(W['hg_lb'].astype(jnp.float32), axis=0), axis=0)
    lb_all = lb_all - lb_all[:1]
    cond = jax.nn.silu(c)
    new_ret, new_hg, new_wkv, new_shift = [], [], [], []
    v_first = None
    for layer in range(DEPTH):
        mod = cond @ W['mod_w'][layer] + W['mod_b'][layer]
        sh1, sc1, gt1, sh2, sc2, gt2 = [u[:, None] for u in jnp.split(mod, 6, axis=-1)]
        hmix = _rmsnorm(x, W['norm_mix_g'][layer]) * (1.0 + sc1) + sh1
        m = layer // 2
        if layer % 2 == 0:
            out, r_s, h_s = _mix_ab(hmix, pos, s_ret[m], s_hg[m], W['ab_w_in'][m], lb_all[m], W['hg_norm_g'][m], W['ab_w_out'][m])
            new_ret.append(r_s)
            new_hg.append(h_s)
        else:
            vres = None if m == 0 else (W['rw_v0'][m - 1], W['rw_v1'][m - 1], W['rw_v2'][m - 1])
            out, w_s, sh_s, v_first = _mix_rwkv(hmix, s_shift[m], s_wkv[m], v_first, vres, W['rw_mu'][m], W['rw_w_rkv'][m], W['rw_w0'][m], W['rw_w1'][m], W['rw_w2'][m], W['rw_a0'][m], W['rw_a1'][m], W['rw_a2'][m], W['rw_g1'][m], W['rw_g2'][m], W['rw_k_k'][m], W['rw_k_a'][m], W['rw_r_k'][m], W['rw_ln_g'][m], W['rw_ln_b'][m], W['rw_w_out'][m])
            new_wkv.append(w_s)
            new_shift.append(sh_s)
        x = x + gt1 * out
        hmlp = _rmsnorm(x, W['norm_mlp_g'][layer]) * (1.0 + sc2) + sh2
        x = x + gt2 * (jnp.square(jax.nn.relu(hmlp @ W['mlp_w1'][layer])) @ W['mlp_w2'][layer])
    y = _rmsnorm(x, W['final_g'])
    return (y, jnp.stack(new_ret).astype(s_ret.dtype), jnp.stack(new_hg).astype(s_hg.dtype),
            jnp.stack(new_wkv).astype(s_wkv.dtype), jnp.stack(new_shift).astype(s_shift.dtype))


def setup_inputs(seed: int = 0) -> dict:
    key = jax.random.key(seed)
    ks = iter(jax.random.split(key, 64))
    f32 = jnp.float32

    def nrm(shape, scale):
        return scale * jax.random.normal(next(ks), shape, f32)

    def uni(shape, lo, hi):
        return jax.random.uniform(next(ks), shape, f32, lo, hi)

    d = D_MODEL
    return {
        'x_prompt': nrm((BATCH, SEQ, d), 1.0),
        'x_sample': nrm((DEC_BATCH, DEC_SEQ, d), 1.0),
        'state_ret': nrm((N_AB_LAYERS, DEC_BATCH, RET_HEADS, RET_DK, RET_DV), 0.5),
        'state_hgrn': nrm((N_AB_LAYERS, DEC_BATCH, HG_HEADS, HG_DK, HG_DV), 0.5),
        'state_wkv': nrm((N_C_LAYERS, DEC_BATCH, RW_HEADS, RW_N, RW_N), 0.3),
        'state_shift': nrm((N_C_LAYERS, DEC_BATCH, d), 1.0),
        'c_prompt': nrm((BATCH, d), 1.0),
        'c_sample': nrm((DEC_BATCH, d), 1.0),
        'mod_w': nrm((DEPTH, d, 6 * d), 0.5 * d ** -0.5),
        'mod_b': nrm((DEPTH, 6 * d), 0.02),
        'norm_mix_g': 1.0 + nrm((DEPTH, d), 0.05),
        'norm_mlp_g': 1.0 + nrm((DEPTH, d), 0.05),
        'final_g': 1.0 + nrm((d,), 0.05),
        'mlp_w1': nrm((DEPTH, d, D_FF), d ** -0.5),
        'mlp_w2': nrm((DEPTH, D_FF, d), D_FF ** -0.5),
        'ab_w_in': nrm((N_AB_LAYERS, d, AB_IN), d ** -0.5),
        'ab_w_out': nrm((N_AB_LAYERS, AB_OUT, d), AB_OUT ** -0.5),
        'hg_lb': nrm((N_AB_LAYERS, HG_HEADS * HG_DK), 1.0),
        'hg_norm_g': 1.0 + nrm((N_AB_LAYERS, HG_DV), 0.05),
        'rw_mu': uni((N_C_LAYERS, 6, d), 0.0, 1.0),
        'rw_w_rkv': nrm((N_C_LAYERS, 3, d, d), d ** -0.5),
        'rw_w0': uni((N_C_LAYERS, d), -4.0, 0.5),
        'rw_w1': nrm((N_C_LAYERS, d, RW_DECAY_LORA), d ** -0.5),
        'rw_w2': nrm((N_C_LAYERS, RW_DECAY_LORA, d), 0.1 * RW_DECAY_LORA ** -0.5),
        'rw_a0': nrm((N_C_LAYERS, d), 0.5),
        'rw_a1': nrm((N_C_LAYERS, d, RW_AAA_LORA), d ** -0.5),
        'rw_a2': nrm((N_C_LAYERS, RW_AAA_LORA, d), 0.1 * RW_AAA_LORA ** -0.5),
        'rw_v0': 1.0 + nrm((N_C_LAYERS - 1, d), 0.1),
        'rw_v1': nrm((N_C_LAYERS - 1, d, RW_MV_LORA), d ** -0.5),
        'rw_v2': nrm((N_C_LAYERS - 1, RW_MV_LORA, d), 0.1 * RW_MV_LORA ** -0.5),
        'rw_g1': nrm((N_C_LAYERS, d, RW_GATE_LORA), d ** -0.5),
        'rw_g2': nrm((N_C_LAYERS, RW_GATE_LORA, d), RW_GATE_LORA ** -0.5),
        'rw_k_k': 0.85 + nrm((N_C_LAYERS, d), 0.05),
        'rw_k_a': 1.0 + nrm((N_C_LAYERS, d), 0.05),
        'rw_r_k': nrm((N_C_LAYERS, RW_HEADS, RW_N), 0.1),
        'rw_ln_g': 1.0 + nrm((N_C_LAYERS, d), 0.05),
        'rw_ln_b': nrm((N_C_LAYERS, d), 0.02),
        'rw_w_out': nrm((N_C_LAYERS, d, d), d ** -0.5),
    }


def reference(x_prompt, x_sample, state_ret, state_hgrn, state_wkv, state_shift, c_prompt, c_sample,
              mod_w, mod_b, norm_mix_g, norm_mlp_g, final_g, mlp_w1, mlp_w2, ab_w_in, ab_w_out, hg_lb, hg_norm_g,
              rw_mu, rw_w_rkv, rw_w0, rw_w1, rw_w2, rw_a0, rw_a1, rw_a2, rw_v0, rw_v1, rw_v2, rw_g1, rw_g2,
              rw_k_k, rw_k_a, rw_r_k, rw_ln_g, rw_ln_b, rw_w_out):
    W = dict(mod_w=mod_w, mod_b=mod_b, norm_mix_g=norm_mix_g, norm_mlp_g=norm_mlp_g, final_g=final_g,
             mlp_w1=mlp_w1, mlp_w2=mlp_w2, ab_w_in=ab_w_in, ab_w_out=ab_w_out, hg_lb=hg_lb, hg_norm_g=hg_norm_g,
             rw_mu=rw_mu, rw_w_rkv=rw_w_rkv, rw_w0=rw_w0, rw_w1=rw_w1, rw_w2=rw_w2, rw_a0=rw_a0, rw_a1=rw_a1,
             rw_a2=rw_a2, rw_v0=rw_v0, rw_v1=rw_v1, rw_v2=rw_v2, rw_g1=rw_g1, rw_g2=rw_g2, rw_k_k=rw_k_k,
             rw_k_a=rw_k_a, rw_r_k=rw_r_k, rw_ln_g=rw_ln_g, rw_ln_b=rw_ln_b, rw_w_out=rw_w_out)
    f32 = jnp.float32
    bp = x_prompt.shape[0]
    dt = x_prompt.dtype
    pos_p = jnp.arange(x_prompt.shape[1], dtype=f32)
    pos_s = PAST_LEN + jnp.arange(x_sample.shape[1], dtype=f32)
    z_ret = jnp.zeros((N_AB_LAYERS, bp, RET_HEADS, RET_DK, RET_DV), dt)
    z_hg = jnp.zeros((N_AB_LAYERS, bp, HG_HEADS, HG_DK, HG_DV), dt)
    z_wkv = jnp.zeros((N_C_LAYERS, bp, RW_HEADS, RW_N, RW_N), dt)
    z_sh = jnp.zeros((N_C_LAYERS, bp, D_MODEL), dt)
    y_p, ret_p, hg_p, wkv_p, sh_p = _trunk(x_prompt, c_prompt, pos_p, z_ret, z_hg, z_wkv, z_sh, W)
    y_s, ret_s, hg_s, wkv_s, sh_s = _trunk(x_sample, c_sample, pos_s, state_ret, state_hgrn, state_wkv, state_shift, W)
    return (y_p, y_s, ret_p, ret_s, hg_p, hg_s, wkv_p, wkv_s, sh_p, sh_s)
```

```cpp
#include <hip/hip_runtime.h>
#include <cstdio>
#include <cstdint>

#define LAS __attribute__((address_space(3)))
#define GAS __attribute__((address_space(1)))
typedef unsigned short bf16_t;
typedef short bf16x8 __attribute__((ext_vector_type(8)));
typedef float f32x4 __attribute__((ext_vector_type(4)));
typedef float f32x2 __attribute__((ext_vector_type(2)));
typedef unsigned u32x4 __attribute__((ext_vector_type(4)));
typedef unsigned u32x2 __attribute__((ext_vector_type(2)));

constexpr int D = 1024, MP = 16384, MS = 1024, M = MP + MS, NSEQ = 33, DFF = 4096, ABIN = 3584;
constexpr int NCHUNK = 288;
constexpr int SLOT_E = 4 * 8192 + 4 * 16384;
constexpr float NORM_EPS = 1e-6f, RW_LN_EPS = 64e-5f;

constexpr size_t MiB = 1u << 20;
constexpr size_t WS_CTL = 0, WS_MOD = 1 * MiB, ZERO_BYTES = 65536;
constexpr size_t WS_ROPE = 5 * MiB;
constexpr size_t WS_ARENA = 10 * MiB;
constexpr size_t AR_W1 = 0, AR_W2 = 8 * MiB, AR_WIN = 16 * MiB, AR_WOUT = 23 * MiB, AR_WC1 = 16 * MiB, AR_WC2 = 32 * MiB, AR_WO = 34 * MiB;
constexpr size_t WS_VFIRST = 46 * MiB;
constexpr size_t WS_XN0 = 80 * MiB, WS_XN = WS_XN0 + 2048;
constexpr size_t WS_PREVS = 115 * MiB;
constexpr size_t WS_R1 = 118 * MiB;
constexpr size_t WS_Z = WS_R1, WS_STATE = WS_R1 + 120 * MiB, WS_DEC = WS_R1 + 174 * MiB;
constexpr size_t WS_H = WS_R1;
constexpr size_t WS_RKV = WS_R1, WS_LO = WS_R1 + 102 * MiB, WS_WLOG = WS_R1 + 136 * MiB, WS_G = WS_R1 + 170 * MiB;
constexpr size_t WS_END = WS_R1 + 204 * MiB;

__device__ const double ROPE_REV[32] = {0.15915494309189535, 0.11934937021124886, 0.089499401608891013, 0.067115083005227255, 0.050329212104487035, 0.037741584717419771, 0.028302195830623399, 0.02122365276477766, 0.015915494309189534, 0.011934937021124886, 0.0089499401608891024, 0.0067115083005227253, 0.0050329212104487037, 0.0037741584717419772, 0.0028302195830623399, 0.0021223652764777662, 0.0015915494309189536, 0.0011934937021124885, 0.00089499401608891024, 0.0006711508300522726, 0.00050329212104487033, 0.00037741584717419774, 0.00028302195830623395, 0.00021223652764777661, 0.00015915494309189535, 0.00011934937021124886, 8.9499401608891018e-05, 6.7115083005227254e-05, 5.0329212104487035e-05, 3.7741584717419777e-05, 2.8302195830623396e-05, 2.1223652764777659e-05};

__device__ __forceinline__ unsigned f2bf(float f) { unsigned u = __builtin_bit_cast(unsigned, f); return (u + 0x7fffu + ((u >> 16) & 1u)) >> 16; }
__device__ __forceinline__ unsigned pk2(float lo, float hi) { return f2bf(lo) | (f2bf(hi) << 16); }
__device__ __forceinline__ float bf2f(unsigned short b) { return __builtin_bit_cast(float, (unsigned)b << 16); }
__device__ __forceinline__ float bflo(unsigned w) { return __builtin_bit_cast(float, w << 16); }
__device__ __forceinline__ float bfhi(unsigned w) { return __builtin_bit_cast(float, w & 0xffff0000u); }
__device__ __forceinline__ float sigmoidf_(float x) { return 1.f / (1.f + __expf(-x)); }
__device__ __forceinline__ float siluf_(float x) { return x / (1.f + __expf(-x)); }
__device__ __forceinline__ float wave_sum(float v) {
#pragma unroll
    for (int o = 1; o < 64; o <<= 1) v += __shfl_xor(v, o);
    return v;
}
__device__ __forceinline__ int otid() { int t = threadIdx.x; asm volatile("" : "+v"(t)); return t; }
__device__ __forceinline__ int seq_of_row(int r) { return r < MP ? 0 : 1 + ((r - MP) >> 5); }
#define LDS_WAIT() asm volatile("s_waitcnt lgkmcnt(0)" ::: "memory")
#define VM_WAIT() asm volatile("s_waitcnt vmcnt(0)" ::: "memory")

namespace pg8 {
constexpr int BM = 256, BK = 64, HALF = 128, HTB = HALF * BK * 2, STAGE_BYTES = 8 * HTB, NXCD = 8, WGM = 8;
__host__ __device__ __forceinline__ int lds_byte(int r, int c) { const int st = (r >> 4) * 2 + (c >> 5), rr = r & 15, cc = c & 31, ob = rr * 64 + cc * 2; return st * 1024 + (ob ^ (((ob >> 9) & 1) << 5)); }
__host__ __device__ __forceinline__ void stage_rc(int b, int& R, int& C) { const int st = b / 1024, sb = b % 1024, swz = sb ^ (((sb >> 9) & 1) << 5); R = (st >> 1) * 16 + swz / 64; C = (st & 1) * 32 + (swz % 64) / 2; }
__host__ __device__ __forceinline__ int perm32(int rho) { const int n = rho >> 4, i = rho & 15; return 8 * (i >> 2) + 4 * n + (i & 3); }

struct Unit { int pm, pn; };
template <int LDA_, int LDB_, int K_, int GSHIFT_, int GSTRIDE_, int KSPLIT_, int DELTAP_> struct Geo {
    static constexpr int LDA = LDA_, LDB = LDB_, K = K_, GSHIFT = GSHIFT_, GSTRIDE = GSTRIDE_, KSPLIT = KSPLIT_, DELTAP = DELTAP_;
};
template <class GC> struct Gemm {
    const bf16_t* A; const bf16_t* Bt; const bf16_t* A2s;
    __device__ __forceinline__ const char* a_base(const Unit& u) const { return (const char*)(A + (size_t)u.pm * BM * GC::LDA + (size_t)(u.pn >> GC::GSHIFT) * GC::GSTRIDE); }
    __device__ __forceinline__ long a_delta(const Unit& u) const {
        if constexpr (GC::KSPLIT >= GC::K / BK) return 0;
        else { if (u.pm < 64) return (long)GC::DELTAP;
            return (long)((const char*)(A2s + (size_t)(u.pm - 64) * BM * GC::LDA) - a_base(u)) - (long)GC::KSPLIT * BK * 2; }
    }
};
struct StaticOrder {
    int nM, nN, nwg, G, c;
    __host__ __device__ void init(int M_, int N_, int G_, int c_) { nM = M_ / BM; nN = N_ / BM; nwg = nM * nN; G = G_; c = c_; }
    __host__ __device__ bool next(int i, Unit& u) const {
        const long L = (long)i * G + c; if (L >= nwg) return false;
        int wgid = (int)L; { const int q = nwg / NXCD, r = nwg % NXCD, xcd = wgid % NXCD, off = wgid / NXCD; wgid = (xcd < r ? xcd * (q + 1) : r * (q + 1) + (xcd - r) * q) + off; }
        const int nig = WGM * nN, gid = wgid / nig, fm = gid * WGM, gsz = (nM - fm) < WGM ? (nM - fm) : WGM;
        u.pm = fm + ((wgid % nig) % gsz); u.pn = (wgid % nig) / gsz; return true;
    }
};
__device__ __forceinline__ unsigned cvt_pk_bf16(float lo, float hi) { unsigned r; asm volatile("v_cvt_pk_bf16_f32 %0, %1, %2" : "=v"(r) : "v"(lo), "v"(hi)); return r; }

template <class Epi, class Sched, class GC, bool ALIGN_EPI = false, bool SP2 = false>
__device__ __forceinline__ void gemm_phase(LAS unsigned char* lds, const Gemm<GC> g, const Sched& S, const Epi& E) {
    const int tid = otid(), wid = __builtin_amdgcn_readfirstlane(tid >> 6), lane = tid & 63, wr = wid >> 2, wc = wid & 3, fr = lane & 15, fq = lane >> 4;
    constexpr int K = GC::K, nt = K / BK, ksplit = GC::KSPLIT;
    unsigned voffA[2], voffB[2];
#pragma unroll
    for (int i = 0; i < 2; ++i) { int R, C; stage_rc(tid * 16 + i * 8192, R, C); const int Rb = Epi::PERM ? ((R & ~31) + perm32(R & 31)) : R;
        voffA[i] = (unsigned)(R * GC::LDA + C) * 2u; voffB[i] = (unsigned)(Rb * GC::LDB + C) * 2u; }
    constexpr size_t kstep = (size_t)(BK * 2);
    constexpr size_t hstepA = (size_t)HALF * GC::LDA * 2, hstepB = (size_t)HALF * GC::LDB * 2;
    constexpr size_t tstepB = 2 * hstepB;
    const unsigned ldsw = (unsigned)wid * 1024u;
    const int aoff = lds_byte(wr * 64 + fr, fq * 8), boff = lds_byte(wc * 32 + fr, fq * 8);
#define PG8_SA(b, h) (((b) * 2 + (h)) * HTB)
#define PG8_SB(b, h) ((4 + (b) * 2 + (h)) * HTB)
#define PG8_STAGE(bufoff, gbase, voff) do { _Pragma("unroll") for (int _i = 0; _i < 2; ++_i) \
        __builtin_amdgcn_global_load_lds((const unsigned*)((const char*)(gbase) + (voff)[_i]), (LAS unsigned*)(lds + (bufoff) + ldsw + _i * 8192), 16, 0, 0); } while (0)
#define PG8_LDA(dst, b, h) do { _Pragma("unroll") for (int m = 0; m < 4; ++m) _Pragma("unroll") for (int k = 0; k < 2; ++k) dst[m][k] = *(const LAS bf16x8*)(lds + PG8_SA(b, h) + aoff + m * 2048 + k * 1024); } while (0)
#define PG8_LDB(dst, b, h) do { _Pragma("unroll") for (int n = 0; n < 2; ++n) _Pragma("unroll") for (int k = 0; k < 2; ++k) dst[n][k] = *(const LAS bf16x8*)(lds + PG8_SB(b, h) + boff + n * 2048 + k * 1024); } while (0)
#define PG8_MMA(ai, bj, At, Bt) do { __builtin_amdgcn_s_setprio(1); _Pragma("unroll") for (int m = 0; m < 4; ++m) _Pragma("unroll") for (int n = 0; n < 2; ++n) _Pragma("unroll") for (int k = 0; k < 2; ++k) \
        acc[ai][bj][m][n] = __builtin_amdgcn_mfma_f32_16x16x32_bf16(Bt[n][k], At[m][k], acc[ai][bj][m][n], 0, 0, 0); __builtin_amdgcn_s_setprio(0); } while (0)
#define PG8_WAIT_V(n) asm volatile("s_waitcnt vmcnt(" #n ")" ::: "memory")
#define PG8_WAIT_L(n) asm volatile("s_waitcnt lgkmcnt(" #n ")" ::: "memory")
#define PG8_BAR __builtin_amdgcn_s_barrier()
#define PG8_SCHED __builtin_amdgcn_sched_barrier(0)
    Unit cur, nxt; int ui = 0;
    if (!S.next(0, cur)) return;
    f32x4 acc[2][2][4][2];
#pragma unroll
    for (int a = 0; a < 2; ++a)
#pragma unroll
        for (int b = 0; b < 2; ++b)
#pragma unroll
            for (int m = 0; m < 4; ++m)
#pragma unroll
                for (int n = 0; n < 2; ++n) acc[a][b][m][n] = (f32x4){0.f, 0.f, 0.f, 0.f};
    bf16x8 At[4][2], B0[2][2], B1[2][2];
    const char* cA = g.a_base(cur); const char* cB = (const char*)g.Bt + (size_t)cur.pn * tstepB; long cD = g.a_delta(cur);
    if constexpr (SP2) {
        PG8_STAGE(PG8_SB(0, 0), cB, voffB); PG8_STAGE(PG8_SB(0, 1), cB + hstepB, voffB); PG8_STAGE(PG8_SA(0, 0), cA, voffA); PG8_STAGE(PG8_SA(0, 1), cA + hstepA, voffA);
        if (wr == 1) PG8_BAR;
        PG8_WAIT_V(2); PG8_BAR;
        PG8_STAGE(PG8_SB(1, 0), cB + kstep, voffB); PG8_STAGE(PG8_SA(1, 0), cA + kstep, voffA); PG8_STAGE(PG8_SB(1, 1), cB + hstepB + kstep, voffB);
        PG8_WAIT_V(6); PG8_BAR;
    } else {
        PG8_STAGE(PG8_SB(0, 0), cB, voffB); PG8_STAGE(PG8_SA(0, 0), cA, voffA); PG8_STAGE(PG8_SB(0, 1), cB + hstepB, voffB); PG8_STAGE(PG8_SA(0, 1), cA + hstepA, voffA);
        if (wr == 1) PG8_BAR;
        PG8_WAIT_V(4); PG8_BAR;
        PG8_STAGE(PG8_SB(1, 0), cB + kstep, voffB); PG8_STAGE(PG8_SA(1, 0), cA + kstep, voffA); PG8_STAGE(PG8_SB(1, 1), cB + hstepB + kstep, voffB);
        PG8_WAIT_V(6); PG8_BAR;
    }
    for (;;) {
        const bool has_next = S.next(ui + 1, nxt);
        const char* nA = has_next ? g.a_base(nxt) : cA; const char* nB = has_next ? (const char*)g.Bt + (size_t)nxt.pn * tstepB : cB;
        const long nD = has_next ? g.a_delta(nxt) : cD;
#pragma unroll 1
        for (int t = 0; t < nt; t += 2) {
            const bool last = (t == nt - 2);
            const char* a1 = cA + (size_t)(t + 1) * kstep + (t >= ksplit ? cD : 0);
            const char* a2 = last ? nA : cA + (size_t)(t + 2) * kstep + (t + 2 >= ksplit ? cD : 0); const char* b2 = last ? nB : cB + (size_t)(t + 2) * kstep;
            const char* a3 = a2 + kstep; const char* b3 = b2 + kstep;
            if constexpr (SP2) {
            PG8_LDB(B0, 0, 0); PG8_LDB(B1, 0, 1); PG8_SCHED; PG8_LDA(At, 0, 0); PG8_STAGE(PG8_SA(1, 1), a1 + hstepA, voffA);
            PG8_WAIT_V(8); PG8_WAIT_L(0); PG8_BAR; PG8_MMA(0, 0, At, B0); PG8_MMA(0, 1, At, B1); PG8_BAR; PG8_SCHED;
            PG8_LDA(At, 0, 1); PG8_STAGE(PG8_SB(0, 0), b2, voffB); PG8_STAGE(PG8_SB(0, 1), b2 + hstepB, voffB); PG8_STAGE(PG8_SA(0, 0), a2, voffA);
            PG8_WAIT_V(8); PG8_WAIT_L(0); PG8_BAR; PG8_MMA(1, 0, At, B0); PG8_MMA(1, 1, At, B1); PG8_BAR; PG8_SCHED;
            PG8_LDB(B0, 1, 0); PG8_LDB(B1, 1, 1); PG8_SCHED; PG8_LDA(At, 1, 0); PG8_STAGE(PG8_SA(0, 1), a2 + hstepA, voffA);
            PG8_WAIT_V(8); PG8_WAIT_L(0); PG8_BAR; PG8_MMA(0, 0, At, B0); PG8_MMA(0, 1, At, B1); PG8_BAR; PG8_SCHED;
            PG8_LDA(At, 1, 1); PG8_STAGE(PG8_SB(1, 0), b3, voffB); PG8_STAGE(PG8_SB(1, 1), b3 + hstepB, voffB); PG8_STAGE(PG8_SA(1, 0), a3, voffA);
            PG8_WAIT_V(8); PG8_WAIT_L(0); PG8_BAR; PG8_MMA(1, 0, At, B0); PG8_MMA(1, 1, At, B1); PG8_BAR; PG8_SCHED;
            } else {
            PG8_LDB(B0, 0, 0); PG8_SCHED; PG8_LDA(At, 0, 0); PG8_STAGE(PG8_SA(1, 1), a1 + hstepA, voffA);
            PG8_WAIT_L(8); PG8_BAR; PG8_WAIT_L(0); PG8_MMA(0, 0, At, B0); PG8_BAR; PG8_SCHED;
            PG8_LDB(B1, 0, 1); PG8_STAGE(PG8_SB(0, 0), b2, voffB);
            PG8_BAR; PG8_WAIT_L(0); PG8_MMA(0, 1, At, B1); PG8_BAR;
            PG8_LDA(At, 0, 1); PG8_STAGE(PG8_SA(0, 0), a2, voffA);
            PG8_BAR; PG8_WAIT_L(0); PG8_MMA(1, 0, At, B0); PG8_BAR; PG8_SCHED;
            PG8_STAGE(PG8_SB(0, 1), b2 + hstepB, voffB);
            PG8_WAIT_V(6); PG8_BAR; PG8_MMA(1, 1, At, B1); PG8_BAR;
            PG8_LDB(B0, 1, 0); PG8_SCHED; PG8_LDA(At, 1, 0); PG8_STAGE(PG8_SA(0, 1), a2 + hstepA, voffA);
            PG8_WAIT_L(8); PG8_BAR; PG8_WAIT_L(0); PG8_MMA(0, 0, At, B0); PG8_BAR; PG8_SCHED;
            PG8_LDB(B1, 1, 1); PG8_STAGE(PG8_SB(1, 0), b3, voffB);
            PG8_BAR; PG8_WAIT_L(0); PG8_MMA(0, 1, At, B1); PG8_BAR;
            PG8_LDA(At, 1, 1); PG8_STAGE(PG8_SA(1, 0), a3, voffA);
            PG8_BAR; PG8_WAIT_L(0); PG8_MMA(1, 0, At, B0); PG8_BAR; PG8_SCHED;
            PG8_STAGE(PG8_SB(1, 1), b3 + hstepB, voffB);
            PG8_WAIT_V(6); PG8_BAR; PG8_MMA(1, 1, At, B1); PG8_BAR;
            }
        }
        if constexpr (ALIGN_EPI) { if (wr == 0) PG8_BAR; }
        E(acc, cur, wr, wc, fr, fq);
        if (!has_next) break;
#pragma unroll
        for (int a = 0; a < 2; ++a)
#pragma unroll
            for (int b = 0; b < 2; ++b)
#pragma unroll
                for (int m = 0; m < 4; ++m)
#pragma unroll
                    for (int n = 0; n < 2; ++n) acc[a][b][m][n] = (f32x4){0.f, 0.f, 0.f, 0.f};
        cur = nxt; cA = nA; cB = nB; cD = nD; ++ui;
        if constexpr (ALIGN_EPI) { if (wr == 1) PG8_BAR; }
    }
    PG8_WAIT_V(0);
    if constexpr (!ALIGN_EPI) { if (wr == 0) PG8_BAR; }
    PG8_BAR;
#undef PG8_SA
#undef PG8_SB
#undef PG8_STAGE
#undef PG8_LDA
#undef PG8_LDB
#undef PG8_MMA
#undef PG8_WAIT_V
#undef PG8_WAIT_L
#undef PG8_BAR
#undef PG8_SCHED
}

__device__ __forceinline__ float act_apply(float v, int act) {
    if (act == 1) { const float r = v > 0.f ? v : 0.f; return r * r; }
    if (act == 2) { const float e = __expf(-2.f * fabsf(v)); const float t = (1.f - e) / (1.f + e); return v < 0.f ? -t : t; }
    if (act == 3) return 1.f / (1.f + __expf(-v));
    return v;
}
template <int ACT> __device__ __forceinline__ void store_tile_bf16(const f32x4 (&acc)[2][2][4][2], bf16_t* base, int ldc, int row0, int col0, bf16_t* base2, int ldc2, int col2) {
#pragma unroll
    for (int ai = 0; ai < 2; ++ai)
#pragma unroll
        for (int m = 0; m < 4; ++m) { const size_t r = (size_t)(row0 + ai * HALF + m * 16);
#pragma unroll
            for (int bj = 0; bj < 2; ++bj) { f32x4 v0 = acc[ai][bj][m][0], v1 = acc[ai][bj][m][1];
#pragma unroll
                for (int q = 0; q < 4; ++q) { v0[q] = act_apply(v0[q], ACT); v1[q] = act_apply(v1[q], ACT); }
                u32x4 w; w.x = cvt_pk_bf16(v0[0], v0[1]); w.y = cvt_pk_bf16(v0[2], v0[3]); w.z = cvt_pk_bf16(v1[0], v1[1]); w.w = cvt_pk_bf16(v1[2], v1[3]);
                *(u32x4*)(base + r * ldc + col0 + bj * HALF) = w;
                if (base2) *(u32x4*)(base2 + r * ldc2 + col2 + bj * HALF) = w; } }
}
template <int ACT> struct EpiBf16 {
    static constexpr bool PERM = true;
    bf16_t* O; int ldc;
    __device__ __forceinline__ void operator()(const f32x4 (&acc)[2][2][4][2], const Unit& u, int wr, int wc, int fr, int fq) const {
        store_tile_bf16<ACT>(acc, O, ldc, u.pm * BM + wr * 64 + fr, u.pn * BM + wc * 32 + 8 * fq, nullptr, 0, 0);
    }
};
struct EpiRkv {
    static constexpr bool PERM = true;
    bf16_t* RKV; bf16_t* LO; bf16_t* vf;
    __device__ __forceinline__ void operator()(const f32x4 (&acc)[2][2][4][2], const Unit& u, int wr, int wc, int fr, int fq) const {
        const int row0 = u.pm * BM + wr * 64 + fr, cin = wc * 32 + 8 * fq;
        if (u.pn < 12) { bf16_t* b2 = (u.pn >= 8) ? vf : nullptr; store_tile_bf16<0>(acc, RKV, 3072, row0, u.pn * BM + cin, b2, 1024, (u.pn - 8) * BM + cin); }
        else if (u.pn == 12) store_tile_bf16<2>(acc, LO, 1024, row0, cin, nullptr, 0, 0);
        else if (u.pn == 15) store_tile_bf16<3>(acc, LO, 1024, row0, 768 + cin, nullptr, 0, 0);
        else store_tile_bf16<0>(acc, LO, 1024, row0, (u.pn - 12) * BM + cin, nullptr, 0, 0);
    }
};
struct EpiRes {
    static constexpr bool PERM = false;
    float* X; const float* modl; int goff;
    __device__ __forceinline__ void operator()(const f32x4 (&acc)[2][2][4][2], const Unit& u, int wr, int wc, int fr, int fq) const {
        const int col0 = u.pn * BM + wc * 32 + 4 * fq;
#pragma unroll
        for (int ai = 0; ai < 2; ++ai)
#pragma unroll
            for (int m = 0; m < 4; ++m) { const int r = u.pm * BM + ai * HALF + wr * 64 + m * 16 + fr; const float* gp = modl + (size_t)seq_of_row(r) * 6144 + goff + col0; float* xp = X + (size_t)r * D + col0;
#pragma unroll
                for (int bj = 0; bj < 2; ++bj)
#pragma unroll
                    for (int n = 0; n < 2; ++n) { const f32x4 gv = *(const f32x4*)(gp + bj * HALF + n * 16); f32x4 xv = *(f32x4*)(xp + bj * HALF + n * 16);
                        xv = xv + gv * acc[ai][bj][m][n]; *(f32x4*)(xp + bj * HALF + n * 16) = xv; }
                asm volatile("" ::: "memory"); }
    }
};
struct EpiLora2 {
    static constexpr bool PERM = false;
    bf16_t* WLOG; bf16_t* Aout; bf16_t* G; bf16_t* RKV; const bf16_t* vf; const float* w0; const float* a0; const float* v0;
    template <int GRP> __device__ __forceinline__ void run(const f32x4 (&acc)[2][2][4][2], const Unit& u, int wr, int wc, int fr, int fq) const {
        const int col0 = (u.pn & 3) * BM + wc * 32 + 4 * fq;
#pragma unroll
        for (int ai = 0; ai < 2; ++ai)
#pragma unroll
            for (int m = 0; m < 4; ++m) { const size_t r = (size_t)(u.pm * BM + ai * HALF + wr * 64 + m * 16 + fr);
#pragma unroll
                for (int bj = 0; bj < 2; ++bj)
#pragma unroll
                    for (int n = 0; n < 2; ++n) { const int c = col0 + bj * HALF + n * 16; const f32x4 a = acc[ai][bj][m][n]; f32x4 o;
                        if constexpr (GRP == 0) { const f32x4 b = *(const f32x4*)(w0 + c);
#pragma unroll
                            for (int q = 0; q < 4; ++q) { const float x = -(b[q] + a[q]); const float sp = fmaxf(x, 0.f) + __logf(1.f + __expf(-fabsf(x))); o[q] = -__expf(-sp - 0.5f); }
                            u32x2 w; w.x = cvt_pk_bf16(o[0], o[1]); w.y = cvt_pk_bf16(o[2], o[3]); *(u32x2*)(WLOG + r * D + c) = w; }
                        else if constexpr (GRP == 1) { const f32x4 b = *(const f32x4*)(a0 + c);
#pragma unroll
                            for (int q = 0; q < 4; ++q) o[q] = 1.f / (1.f + __expf(-(b[q] + a[q])));
                            u32x2 w; w.x = cvt_pk_bf16(o[0], o[1]); w.y = cvt_pk_bf16(o[2], o[3]); *(u32x2*)(Aout + r * D + c) = w; }
                        else if constexpr (GRP == 2) { const f32x4 b = *(const f32x4*)(v0 + c); const u32x2 vv = *(const u32x2*)(RKV + r * 3072 + 2048 + c), ff = *(const u32x2*)(vf + r * D + c);
                            f32x4 v4, f4; v4[0] = bflo(vv.x); v4[1] = bfhi(vv.x); v4[2] = bflo(vv.y); v4[3] = bfhi(vv.y); f4[0] = bflo(ff.x); f4[1] = bfhi(ff.x); f4[2] = bflo(ff.y); f4[3] = bfhi(ff.y);
#pragma unroll
                            for (int q = 0; q < 4; ++q) { const float gte = 1.f / (1.f + __expf(-(b[q] + a[q]))); o[q] = v4[q] + (f4[q] - v4[q]) * gte; }
                            u32x2 w; w.x = cvt_pk_bf16(o[0], o[1]); w.y = cvt_pk_bf16(o[2], o[3]); *(u32x2*)(RKV + r * 3072 + 2048 + c) = w; }
                        else { u32x2 w; w.x = cvt_pk_bf16(a[0], a[1]); w.y = cvt_pk_bf16(a[2], a[3]); *(u32x2*)(G + r * D + c) = w; } }
                asm volatile("" ::: "memory"); }
    }
    __device__ __forceinline__ void operator()(const f32x4 (&acc)[2][2][4][2], const Unit& u, int wr, int wc, int fr, int fq) const {
        const int grp = u.pn >> 2;
        if (grp == 0) run<0>(acc, u, wr, wc, fr, fq);
        else if (grp == 1) run<1>(acc, u, wr, wc, fr, fq);
        else if (grp == 2) { if (vf != nullptr) run<2>(acc, u, wr, wc, fr, fq); }
        else run<3>(acc, u, wr, wc, fr, fq);
    }
};
}

#define RLX_AGENT __ATOMIC_RELAXED, __HIP_MEMORY_SCOPE_AGENT
#define XB_TMO      128
#define XB_XCNT(j)  (256  + 64 * (j))
#define XB_XSUB(j)  (1280 + 64 * (j))
#define XB_XGEN(j)  (2304 + 64 * (j))
#define XB_TOP      3328
#define XB_TOPGEN   3392
#define XCD_BAR_WORDS 3456
#define XB_SPIN_CAP (1u << 24)
__device__ __forceinline__ unsigned xb_ld(unsigned* p)              { return __hip_atomic_load(p, __ATOMIC_RELAXED, __HIP_MEMORY_SCOPE_AGENT); }
__device__ __forceinline__ unsigned xb_add(unsigned* p, unsigned v) { return __hip_atomic_fetch_add(p, v, __ATOMIC_RELAXED, __HIP_MEMORY_SCOPE_AGENT); }
__device__ __forceinline__ unsigned xb_xcc_id() { return (unsigned)__builtin_amdgcn_s_getreg((3 << 11) | 20) & 0xFu; }
#define XB_SPIN(cond, bar) do { unsigned _sp = 0; while (cond) { __builtin_amdgcn_s_sleep(1); \
    if ((++_sp & 255u) == 0u) { if (xb_ld(&(bar)[XB_TMO])) break; if (_sp > XB_SPIN_CAP) { atomicAdd(&(bar)[XB_TMO], 1u); break; } } } } while (0)
struct XcdBarrier { unsigned* bar; unsigned x; volatile LAS unsigned* st; };
__device__ __forceinline__ XcdBarrier xcd_barrier_post(unsigned* bar, volatile LAS unsigned* st) {
    XcdBarrier b; b.bar = bar; b.x = xb_xcc_id(); b.st = st;
    if (threadIdx.x == 0) (void)xb_add(&bar[XB_XCNT(b.x)], 1u);
    return b;
}
__device__ __forceinline__ void xcd_barrier_complete(unsigned* bar, unsigned x, unsigned& nloc, unsigned& nx) {
    const unsigned G = gridDim.x * gridDim.y * gridDim.z;
    unsigned sum, cnt, mine, sp = 0u;
    for (;;) {
        sum = 0u; cnt = 0u; mine = 0u;
#pragma unroll
        for (unsigned j = 0; j < 16; ++j) { const unsigned c = xb_ld(&bar[XB_XCNT(j)]); sum += c; cnt += (c > 0u) ? 1u : 0u; mine = (j == x) ? c : mine; }
        if (sum == G) break;
        __builtin_amdgcn_s_sleep(1);
        if ((++sp & 255u) == 0u) { if (xb_ld(&bar[XB_TMO])) break; if (sp > XB_SPIN_CAP) { atomicAdd(&bar[XB_TMO], 1u); break; } }
    }
    nloc = mine > 0u ? mine : 1u; nx = cnt > 0u ? cnt : 1u;
}
__device__ __forceinline__ void xcd_barrier(const XcdBarrier& b) {
    asm volatile("s_waitcnt vmcnt(0)" ::: "memory");
    __syncthreads();
    if (threadIdx.x == 0) {
        unsigned* bar = b.bar;
        __builtin_amdgcn_s_waitcnt(0);
        unsigned nloc = b.st[0], nx = b.st[1];
        if (nloc == 0u) { xcd_barrier_complete(bar, b.x, nloc, nx); b.st[0] = nloc; b.st[1] = nx; }
        const unsigned old = xb_add(&bar[XB_XSUB(b.x)], 1u);
        const unsigned gen = old / nloc;
        if (old + 1u == (gen + 1u) * nloc) {
            __builtin_amdgcn_fence(__ATOMIC_RELEASE, "agent");
            asm volatile("s_waitcnt vmcnt(0)" ::: "memory");
            const unsigned og = xb_add(&bar[XB_TOP], 1u);
            const unsigned tg = og / nx;
            if (og + 1u == (tg + 1u) * nx) xb_add(&bar[XB_TOPGEN], 1u);
            else XB_SPIN(xb_ld(&bar[XB_TOPGEN]) == tg, bar);
            __builtin_amdgcn_fence(__ATOMIC_ACQUIRE, "agent");
            xb_add(&bar[XB_XGEN(b.x)], 1u);
            asm volatile("s_waitcnt vmcnt(0)" ::: "memory");
        } else {
            XB_SPIN(xb_ld(&bar[XB_XGEN(b.x)]) == gen, bar);
            __builtin_amdgcn_fence(__ATOMIC_ACQUIRE, "agent");
            asm volatile("s_waitcnt vmcnt(0)" ::: "memory");
        }
    }
    __syncthreads();
}

constexpr int NWAVES = 8, NT = NWAVES * 64;
constexpr int RING_BYTES = 131072, LDSCTL_OFF = RING_BYTES, MISC_OFF = LDSCTL_OFF + 320, LDS_BYTES = 147456;
constexpr int CW_BAR = 4096;

struct Args { const float* in[38]; float* out; unsigned char* ws; };
struct Frame {
    LAS unsigned char* lds; volatile LAS unsigned* MISC;
    int wave, vcu, G;
    const float* const* in; float* out; unsigned char* ws;
};
enum { I_XP = 0, I_XS, I_SRET, I_SHG, I_SWKV, I_SSHIFT, I_CP, I_CS, I_MODW, I_MODB, I_NMIXG, I_NMLPG, I_FINALG, I_W1, I_W2, I_ABWIN, I_ABWOUT, I_HGLB, I_HGNG,
       I_MU, I_WRKV, I_RW0, I_RW1, I_RW2, I_RA0, I_RA1, I_RA2, I_RV0, I_RV1, I_RV2, I_RG1, I_RG2, I_RKK, I_RKA, I_RRK, I_RLNG, I_RLNB, I_RWOUT };
constexpr size_t O_Y = 0, O_RETP = 17825792, O_RETS = 17891328, O_HGP = 19988480, O_HGS = 20119552, O_WKVP = 24313856, O_WKVS = 24444928, O_SHP = 28639232, O_SHS = 28641280;

__device__ __forceinline__ void transpose_item(const float* W, int N, bf16_t* WT, int ldt, int row_off, int col_off, const float* mu, int mode, LAS float* scr, int item, int lane) {
    const int nblk = N / 32, kb = item / nblk, nb = item % nblk, k0 = 64 * kb, n0 = 32 * nb;
#pragma unroll 8
    for (int i = 0; i < 32; ++i) { const int kk = 2 * i + (lane >> 5); float s = 1.f; if (mode == 1) s = 1.f - mu[k0 + kk]; else if (mode == 2) s = mu[k0 + kk];
        scr[kk * 33 + (lane & 31)] = W[(size_t)(k0 + kk) * N + n0 + (lane & 31)] * s; }
    LDS_WAIT(); asm volatile("" ::: "memory");
    const int c = lane & 7;
#pragma unroll
    for (int j = 0; j < 4; ++j) { const int n = (lane >> 3) + 8 * j; const LAS float* s = scr + (8 * c) * 33 + n;
        u32x4 o; o.x = pk2(s[0 * 33], s[1 * 33]); o.y = pk2(s[2 * 33], s[3 * 33]); o.z = pk2(s[4 * 33], s[5 * 33]); o.w = pk2(s[6 * 33], s[7 * 33]);
        *(u32x4*)(WT + (size_t)(row_off + n0 + n) * ldt + col_off + k0 + 8 * c) = o; }
    LDS_WAIT(); asm volatile("" ::: "memory");
}
__device__ __forceinline__ void convert_layer_weights(Frame& F, int layer) {
    const int tid = otid(); const int lane = tid & 63; (void)lane;
    LAS float* scr = (LAS float*)(F.lds + F.wave * 16384);
    const int gw = F.vcu * NWAVES + F.wave, NGW = F.G * NWAVES;
    unsigned char* ar = F.ws + WS_ARENA;
    const int m = layer >> 1;
    constexpr int I_1 = (D / 64) * (DFF / 32), I_2 = (DFF / 64) * (D / 32);
    const float* w1 = F.in[I_W1] + (size_t)layer * D * DFF; const float* w2 = F.in[I_W2] + (size_t)layer * DFF * D;
    if ((layer & 1) == 0) {
        constexpr int I_IN = (D / 64) * (ABIN / 32), I_OUT = (D / 64) * (D / 32), NI = I_1 + I_2 + I_IN + I_OUT;
        const float* win = F.in[I_ABWIN] + (size_t)m * D * ABIN; const float* wout = F.in[I_ABWOUT] + (size_t)m * D * D;
        for (int it = gw; it < NI; it += NGW) { int r = it;
            if (r < I_1) { transpose_item(w1, DFF, (bf16_t*)(ar + AR_W1), D, 0, 0, nullptr, 0, scr, r, lane); continue; } r -= I_1;
            if (r < I_2) { transpose_item(w2, D, (bf16_t*)(ar + AR_W2), DFF, 0, 0, nullptr, 0, scr, r, lane); continue; } r -= I_2;
            if (r < I_IN) { transpose_item(win, ABIN, (bf16_t*)(ar + AR_WIN), D, 0, 0, nullptr, 0, scr, r, lane); continue; } r -= I_IN;
            transpose_item(wout, D, (bf16_t*)(ar + AR_WOUT), D, 0, 0, nullptr, 0, scr, r, lane); }
    } else {
        constexpr int I_P = (D / 64) * (D / 32), NI = I_1 + I_2 + 7 * I_P;
        const float* mu = F.in[I_MU] + (size_t)m * 6 * D; const float* wrkv = F.in[I_WRKV] + (size_t)m * 3 * D * D; const float* wo = F.in[I_RWOUT] + (size_t)m * D * D;
        bf16_t* wc1 = (bf16_t*)(ar + AR_WC1);
        for (int it = gw; it < NI; it += NGW) { int r = it;
            if (r < I_1) { transpose_item(w1, DFF, (bf16_t*)(ar + AR_W1), D, 0, 0, nullptr, 0, scr, r, lane); continue; } r -= I_1;
            if (r < I_2) { transpose_item(w2, D, (bf16_t*)(ar + AR_W2), DFF, 0, 0, nullptr, 0, scr, r, lane); continue; } r -= I_2;
            if (r < 6 * I_P) { const int p = r / (2 * I_P), hf = (r / I_P) & 1, mi = (p == 0) ? 0 : (p == 1 ? 2 : 3);
                transpose_item(wrkv + (size_t)p * D * D, D, wc1, 2048, p * D, hf * D, mu + mi * D, 1 + hf, scr, r % I_P, lane); continue; } r -= 6 * I_P;
            transpose_item(wo, D, (bf16_t*)(ar + AR_WO), D, 0, 0, nullptr, 0, scr, r, lane); }
        const int gt = F.vcu * NT + tid, NG = F.G * NT;
        const float* lw1 = F.in[I_RW1] + (size_t)m * D * 64; const float* la1 = F.in[I_RA1] + (size_t)m * D * 64; const float* lv1 = F.in[I_RV1]; const float* lg1 = F.in[I_RG1] + (size_t)m * D * 160;
        for (int idx = gt; idx < 1024 * 2048; idx += NG) { const int n = idx >> 11, k = idx & 2047, kk = k & 1023, s = n >> 8, nn = n & 255;
            const float* src = (s == 0) ? lw1 : (s == 1) ? la1 : (s == 2) ? lv1 : lg1; const int ns = (s == 0 || s == 1) ? 64 : (s == 2 ? 32 : 160); const int mi = (s == 0) ? 1 : (s == 1) ? 4 : (s == 2) ? 3 : 5;
            float v = 0.f; if (nn < ns && !(s == 2 && m == 0)) { const float muv = mu[mi * D + kk]; v = src[(size_t)kk * ns + nn] * (k < 1024 ? 1.f - muv : muv); }
            wc1[(size_t)(3072 + n) * 2048 + k] = (bf16_t)f2bf(v); }
        bf16_t* wc2 = (bf16_t*)(ar + AR_WC2);
        const float* lw2 = F.in[I_RW2] + (size_t)m * 64 * D; const float* la2 = F.in[I_RA2] + (size_t)m * 64 * D; const float* lv2 = F.in[I_RV2]; const float* lg2 = F.in[I_RG2] + (size_t)m * 160 * D;
        for (int idx = gt; idx < 4096 * 256; idx += NG) { const int k = idx >> 12, n = idx & 4095, g = n >> 10, nn = n & 1023;
            const float* src = (g == 0) ? lw2 : (g == 1) ? la2 : (g == 2) ? lv2 : lg2; const int ks = (g == 0 || g == 1) ? 64 : (g == 2 ? 32 : 160);
            float v = 0.f; if (k < ks && !(g == 2 && m == 0)) v = src[(size_t)k * D + nn];
            wc2[(size_t)n * 256 + k] = (bf16_t)f2bf(v); }
    }
}

__device__ __forceinline__ void mod_phase(Frame& F) {
    const int tid = otid(); const int lane = tid & 63;
    const float* __restrict__ SC = (const float*)(F.ws + WS_MOD + 3584 * 1024);
    float* MOD = (float*)(F.ws + WS_MOD);
    LAS float* red = (LAS float*)F.lds;
    for (int task = F.vcu; task < 4 * 96; task += F.G) { const int l = task / 96, n = (task % 96) * 64 + lane, ks = F.wave;
        const float* w = F.in[I_MODW] + ((size_t)l * D + ks * 128) * 6144 + n;
        float acc[NSEQ];
#pragma unroll
        for (int s = 0; s < NSEQ; ++s) acc[s] = 0.f;
        for (int k = 0; k < 128; k += 4) { const float w0 = w[(size_t)k * 6144], w1 = w[(size_t)(k + 1) * 6144], w2 = w[(size_t)(k + 2) * 6144], w3 = w[(size_t)(k + 3) * 6144];
#pragma unroll
            for (int s = 0; s < NSEQ; ++s) { const f32x4 c4 = *(const f32x4*)(SC + s * D + ks * 128 + k); acc[s] += (c4[0] * w0 + c4[1] * w1) + (c4[2] * w2 + c4[3] * w3); } }
        __syncthreads();
#pragma unroll
        for (int s = 0; s < NSEQ; ++s) red[(F.wave * NSEQ + s) * 64 + lane] = acc[s];
        __syncthreads();
        for (int i = tid; i < NSEQ * 64; i += NT) { const int s = i >> 6, c = i & 63; float t = F.in[I_MODB][l * 6144 + (task % 96) * 64 + c];
#pragma unroll
            for (int q = 0; q < 8; ++q) t += red[(q * NSEQ + s) * 64 + c];
            MOD[((size_t)l * NSEQ + s) * 6144 + (task % 96) * 64 + c] = t; }
    }
    __syncthreads();
}

__device__ __forceinline__ void prologue(Frame& F) {
    const int tid = otid(); const int lane = tid & 63; (void)lane;
    const int gt = F.vcu * NT + tid, NG = F.G * NT;
    { const f32x4* xp = (const f32x4*)F.in[I_XP]; const f32x4* xs = (const f32x4*)F.in[I_XS]; f32x4* o = (f32x4*)F.out;
      for (int i = gt; i < M * (D / 4); i += NG) o[i] = (i < MP * (D / 4)) ? xp[i] : xs[i - MP * (D / 4)]; }
    { f32x2* tab = (f32x2*)(F.ws + WS_ROPE);
      for (int i = gt; i < 16384 * 32; i += NG) { const int p = i >> 5, d = i & 31; double rev = (double)p * ROPE_REV[d]; rev -= floor(rev); const float fr = (float)rev;
          tab[i] = (f32x2){__builtin_amdgcn_cosf(fr), __builtin_amdgcn_sinf(fr)}; } }
    { unsigned* z = (unsigned*)(F.ws + WS_XN0); for (int i = gt; i < 512; i += NG) z[i] = 0u; }
    { float* SC = (float*)(F.ws + WS_MOD + 3584 * 1024);
      for (int i = gt; i < NSEQ * D; i += NG) { const int s = i >> 10, k = i & 1023; const float c = (s == 0) ? F.in[I_CP][k] : F.in[I_CS][(size_t)(s - 1) * D + k]; SC[i] = siluf_(c); } }
    convert_layer_weights(F, 0);
}

template <int MODE> __device__ __forceinline__ void norm_pass(Frame& F, int layer) {
    const int tid = otid(); const int lane = tid & 63; (void)lane;
    const int gw = F.vcu * NWAVES + F.wave, NGW = F.G * NWAVES; const int m = layer >> 1;
    const float* MOD = (const float*)(F.ws + WS_MOD) + (size_t)layer * NSEQ * 6144;
    const float* gvec = (MODE == 3) ? F.in[I_FINALG] : (MODE == 2 ? F.in[I_NMLPG] + layer * D : F.in[I_NMIXG] + layer * D);
    const int shoff = (MODE == 2) ? 3072 : 0, scoff = (MODE == 2) ? 4096 : 1024;
    bf16_t* XN = (bf16_t*)(F.ws + WS_XN); bf16_t* PREVS = (bf16_t*)(F.ws + WS_PREVS);
    for (int r = gw; r < M; r += NGW) {
        float* xrow = F.out + (size_t)r * D; const f32x4* xr = (const f32x4*)xrow + lane;
        f32x4 v[4]; float s2 = 0.f;
#pragma unroll
        for (int j = 0; j < 4; ++j) { v[j] = xr[64 * j]; s2 += (v[j].x * v[j].x + v[j].y * v[j].y) + (v[j].z * v[j].z + v[j].w * v[j].w); }
        const float rstd = 1.f / sqrtf(wave_sum(s2) * (1.f / D) + NORM_EPS);
        const int seq = seq_of_row(r); const float* mp = MOD + (size_t)seq * 6144;
#pragma unroll
        for (int j = 0; j < 4; ++j) { const int c = 4 * lane + 256 * j; const f32x4 g4 = *(const f32x4*)(gvec + c); f32x4 o = v[j] * rstd * g4;
            if (MODE == 3) { *((f32x4*)xrow + lane + 64 * j) = o; continue; }
            const f32x4 sc = *(const f32x4*)(mp + scoff + c), sh = *(const f32x4*)(mp + shoff + c);
            o = o * (1.f + sc) + sh;
            const unsigned long long pk = (unsigned long long)pk2(o.x, o.y) | ((unsigned long long)pk2(o.z, o.w) << 32);
            *(unsigned long long*)(XN + (size_t)r * D + c) = pk;
            if (MODE == 1) {
                if (r >= MP) { const int t = (r - MP) & 31; if (t < 31) *(unsigned long long*)(PREVS + (size_t)(r - MP + 1) * D + c) = pk;
                    else *(f32x4*)(F.out + O_SHS + ((size_t)m * 32 + ((r - MP) >> 5)) * D + c) = o;
                    if (t == 0) { const f32x4 ss = *(const f32x4*)(F.in[I_SSHIFT] + ((size_t)m * 32 + ((r - MP) >> 5)) * D + c);
                        *(unsigned long long*)(PREVS + (size_t)(r - MP) * D + c) = (unsigned long long)pk2(ss.x, ss.y) | ((unsigned long long)pk2(ss.z, ss.w) << 32); } }
                else if (r == MP - 1) *(f32x4*)(F.out + O_SHP + (size_t)m * D + c) = o;
            } }
    }
}

template <int MT, int NTT> __device__ __forceinline__ void wave_mm_nt(f32x4 (&acc)[MT][NTT], const LAS bf16_t* X, int ldx, const LAS bf16_t* Y, int ldy, int K, int fr, int fq) {
    for (int k0 = 0; k0 < K; k0 += 32) {
        bf16x8 xa[MT], yb[NTT];
#pragma unroll
        for (int i = 0; i < MT; ++i) xa[i] = *(const LAS bf16x8*)(X + (16 * i + fr) * ldx + k0 + 8 * fq);
#pragma unroll
        for (int j = 0; j < NTT; ++j) yb[j] = *(const LAS bf16x8*)(Y + (16 * j + fr) * ldy + k0 + 8 * fq);
#pragma unroll
        for (int i = 0; i < MT; ++i)
#pragma unroll
            for (int j = 0; j < NTT; ++j) acc[i][j] = __builtin_amdgcn_mfma_f32_16x16x32_bf16(yb[j], xa[i], acc[i][j], 0, 0, 0);
    }
}

constexpr int LQS = 0, LKS = 18432, LQG = 36864, LVT = 55296, LST = 73728, LPS = 108544, LRED = 117760, LBS = 118784;
__device__ __forceinline__ void chunk_geom(int c, int& r0, int& pos0) { if (c < 256) { r0 = 64 * c; pos0 = 64 * c; } else { r0 = MP + 32 * (c - 256); pos0 = 2048; } }

template <int L, bool HG, bool SUMMARY> __device__ __forceinline__ void ab_load(Frame& F, int layer, int c, int h) {
    const int tid = otid(); const int lane = tid & 63; (void)lane;
    const int m = layer >> 1; int r0, pos0; chunk_geom(c, r0, pos0);
    const bf16_t* Z = (const bf16_t*)(F.ws + WS_Z);
    LAS bf16_t* QS = (LAS bf16_t*)(F.lds + LQS); LAS bf16_t* KS = (LAS bf16_t*)(F.lds + LKS); LAS bf16_t* QG = (LAS bf16_t*)(F.lds + LQG); LAS bf16_t* VT = (LAS bf16_t*)(F.lds + LVT);
    constexpr int LDT = L + 8;
    if constexpr (HG) {
        constexpr int TQ = L / 4; LAS float* BS = (LAS float*)(F.lds + LBS);
        const int ch = tid & 127, qtr = tid >> 7;
        float lb = 0.f;
        if (m == 1) { const float a0 = F.in[I_HGLB][h * 128 + ch], a1 = F.in[I_HGLB][512 + h * 128 + ch]; lb = 1.f / (1.f + __expf(a0 - a1)); }
        float zf[TQ], cs[TQ]; float run = 0.f;
#pragma unroll
        for (int jj = 0; jj < TQ; ++jj) { const int j = qtr * TQ + jj; zf[jj] = bf2f(Z[(size_t)(r0 + j) * ABIN + 2048 + h * 128 + ch]);
            float lf; if (lb == 0.f) lf = fminf(zf[jj], 0.f) - log1pf(__expf(-fabsf(zf[jj]))); else lf = __logf(lb + (1.f - lb) * sigmoidf_(zf[jj]));
            run += lf; cs[jj] = run; }
        BS[qtr * 128 + ch] = run;
        __syncthreads();
        const float b0 = BS[ch], b1 = BS[128 + ch], b2 = BS[256 + ch], b3 = BS[384 + ch];
        const float off = (qtr > 0 ? b0 : 0.f) + (qtr > 1 ? b1 : 0.f) + (qtr > 2 ? b2 : 0.f), bL = (b0 + b1) + (b2 + b3), bmid = b0 + b1;
#pragma unroll
        for (int jj = 0; jj < TQ; ++jj) { const int j = qtr * TQ + jj; const size_t zr = (size_t)(r0 + j) * ABIN; const float b = off + cs[jj];
            const float kb = (1.f - lb) * sigmoidf_(-zf[jj]); const float vv = bf2f(Z[zr + 2560 + h * 128 + ch]);
            VT[ch * LDT + j] = (bf16_t)f2bf(vv);
            if constexpr (SUMMARY) { QS[ch * LDT + j] = (bf16_t)f2bf(kb * __expf(bL - b)); }
            else { const float q = siluf_(bf2f(Z[zr + 1536 + h * 128 + ch]));
                QS[j * 136 + ch] = (bf16_t)f2bf(q * __expf(b - bmid)); KS[j * 136 + ch] = (bf16_t)f2bf(kb * __expf(bmid - b)); QG[j * 136 + ch] = (bf16_t)f2bf(q * __expf(b)); } }
        if constexpr (SUMMARY) { if (qtr == 0) ((float*)(F.ws + WS_DEC))[((size_t)c * 4 + h) * 128 + ch] = __expf(bL); }
    } else {
        const float logg = log1pf(-exp2f(-5.f - (float)h));
        const f32x2* rope = (const f32x2*)(F.ws + WS_ROPE);
        for (int it = tid; it < L * 4; it += NT) { const int j = it >> 2, d8 = it & 3; const size_t zr = (size_t)(r0 + j) * ABIN;
            const f32x2* rp = rope + (size_t)(pos0 + j) * 32 + d8 * 8;
            const u32x4 k1 = *(const u32x4*)(Z + zr + 256 + h * 64 + d8 * 8), k2 = *(const u32x4*)(Z + zr + 256 + h * 64 + 32 + d8 * 8);
            const float gk = __expf((float)(L - 1 - j) * logg), gq = __expf((float)(j + 1) * logg);
            u32x4 q1 = (u32x4){0, 0, 0, 0}, q2 = q1; if constexpr (!SUMMARY) { q1 = *(const u32x4*)(Z + zr + h * 64 + d8 * 8); q2 = *(const u32x4*)(Z + zr + h * 64 + 32 + d8 * 8); }
#pragma unroll
            for (int e = 0; e < 8; ++e) { const f32x2 cs_ = rp[e]; const unsigned wk1 = k1[e >> 1], wk2 = k2[e >> 1]; const float x1 = (e & 1) ? bfhi(wk1) : bflo(wk1), x2 = (e & 1) ? bfhi(wk2) : bflo(wk2);
                const float o1 = x1 * cs_.x - x2 * cs_.y, o2 = x1 * cs_.y + x2 * cs_.x; const int d = d8 * 8 + e;
                if constexpr (SUMMARY) { QS[d * LDT + j] = (bf16_t)f2bf(o1 * gk); QS[(d + 32) * LDT + j] = (bf16_t)f2bf(o2 * gk); }
                else { KS[j * 72 + d] = (bf16_t)f2bf(o1); KS[j * 72 + d + 32] = (bf16_t)f2bf(o2);
                    const unsigned wq1 = q1[e >> 1], wq2 = q2[e >> 1]; const float y1 = (e & 1) ? bfhi(wq1) : bflo(wq1), y2 = (e & 1) ? bfhi(wq2) : bflo(wq2);
                    const float p1 = (y1 * cs_.x - y2 * cs_.y) * 0.125f, p2 = (y1 * cs_.y + y2 * cs_.x) * 0.125f;
                    QS[j * 72 + d] = (bf16_t)f2bf(p1); QS[j * 72 + d + 32] = (bf16_t)f2bf(p2); QG[j * 72 + d] = (bf16_t)f2bf(p1 * gq); QG[j * 72 + d + 32] = (bf16_t)f2bf(p2 * gq); } } }
        for (int it = tid; it < L * 16; it += NT) { const int j = it >> 4, e8 = it & 15; const u32x4 vv = *(const u32x4*)(Z + (size_t)(r0 + j) * ABIN + 512 + h * 128 + e8 * 8);
#pragma unroll
            for (int e = 0; e < 8; ++e) { const unsigned w = vv[e >> 1]; VT[(e8 * 8 + e) * LDT + j] = (bf16_t)((e & 1) ? (w >> 16) : (w & 0xffffu)); } }
    }
}

template <int L, bool HG> __device__ __forceinline__ void ab_summary_unit(Frame& F, int layer, int c, int h) {
    const int tid = otid(); const int lane = tid & 63; (void)lane;
    constexpr int DK = HG ? 128 : 64, NCT = DK / 16, LDT = L + 8;
    __syncthreads();
    ab_load<L, HG, true>(F, layer, c, h);
    __syncthreads();
    const int fr = lane & 15, fq = lane >> 4;
    const LAS bf16_t* KDT = (const LAS bf16_t*)(F.lds + LQS); const LAS bf16_t* VT = (const LAS bf16_t*)(F.lds + LVT);
    f32x4 acc[1][NCT];
#pragma unroll
    for (int j = 0; j < NCT; ++j) acc[0][j] = (f32x4){0.f, 0.f, 0.f, 0.f};
    wave_mm_nt<1, NCT>(acc, VT + F.wave * 16 * LDT, LDT, KDT, LDT, L, fr, fq);
    bf16_t* ST = (bf16_t*)(F.ws + WS_STATE) + (size_t)c * SLOT_E + (HG ? 32768 + h * 16384 : h * 8192);
    const int e = F.wave * 16 + fr;
#pragma unroll
    for (int j = 0; j < NCT; ++j) { u32x2 w; w.x = pk2(acc[0][j][0], acc[0][j][1]); w.y = pk2(acc[0][j][2], acc[0][j][3]); *(u32x2*)(ST + (size_t)e * DK + 16 * j + 4 * fq) = w; }
}

template <int L, bool HG> __device__ __forceinline__ void ab_output_unit(Frame& F, int layer, int c, int h) {
    const int tid = otid(); const int lane = tid & 63; (void)lane;
    constexpr int DK = HG ? 128 : 64, LDQ = HG ? 136 : 72, LDT = L + 8, NIT = L / 16, WPI = 8 / NIT, ET = 8 / WPI, TPW = (NIT * NIT >= 8) ? NIT * NIT / 8 : 1;
    const int m = layer >> 1; int r0, pos0; chunk_geom(c, r0, pos0);
    __syncthreads();
    ab_load<L, HG, false>(F, layer, c, h);
    LAS bf16_t* QS = (LAS bf16_t*)(F.lds + LQS); LAS bf16_t* KS = (LAS bf16_t*)(F.lds + LKS); LAS bf16_t* QG = (LAS bf16_t*)(F.lds + LQG); LAS bf16_t* VT = (LAS bf16_t*)(F.lds + LVT);
    LAS bf16_t* STl = (LAS bf16_t*)(F.lds + LST); LAS bf16_t* PS = (LAS bf16_t*)(F.lds + LPS); LAS float* RED = (LAS float*)(F.lds + LRED);
    { const bf16_t* ST = (const bf16_t*)(F.ws + WS_STATE) + (size_t)c * SLOT_E + (HG ? 32768 + h * 16384 : h * 8192);
      for (int it = tid; it < 128 * DK / 8; it += NT) { const int e = it / (DK / 8), c8 = it % (DK / 8); *(LAS u32x4*)(STl + e * LDQ + c8 * 8) = *(const u32x4*)(ST + (size_t)e * DK + c8 * 8); } }
    __syncthreads();
    const int fr = lane & 15, fq = lane >> 4, w = F.wave;
    const float logg = HG ? 0.f : log1pf(-exp2f(-5.f - (float)h));
    if (w * TPW < NIT * NIT) {
        const int it = (w * TPW) / NIT, jt0 = (w * TPW) % NIT;
        f32x4 sc[1][TPW];
#pragma unroll
        for (int q = 0; q < TPW; ++q) sc[0][q] = (f32x4){0.f, 0.f, 0.f, 0.f};
        wave_mm_nt<1, TPW>(sc, QS + it * 16 * LDQ, LDQ, KS + jt0 * 16 * LDQ, LDQ, DK, fr, fq);
        const int i = it * 16 + fr;
#pragma unroll
        for (int q = 0; q < TPW; ++q) { float p[4];
#pragma unroll
            for (int r = 0; r < 4; ++r) { const int j = (jt0 + q) * 16 + 4 * fq + r; float v = sc[0][q][r]; if (!HG) v *= __expf((float)(i - j) * logg); p[r] = (j <= i) ? v : 0.f; }
            u32x2 pw; pw.x = pk2(p[0], p[1]); pw.y = pk2(p[2], p[3]); *(LAS u32x2*)(PS + i * LDT + (jt0 + q) * 16 + 4 * fq) = pw; }
    }
    __syncthreads();
    const int it = w % NIT, eg = w / NIT;
    f32x4 o[1][ET];
#pragma unroll
    for (int q = 0; q < ET; ++q) o[0][q] = (f32x4){0.f, 0.f, 0.f, 0.f};
    wave_mm_nt<1, ET>(o, PS + it * 16 * LDT, LDT, VT + eg * ET * 16 * LDT, LDT, L, fr, fq);
    wave_mm_nt<1, ET>(o, QG + it * 16 * LDQ, LDQ, STl + eg * ET * 16 * LDQ, LDQ, DK, fr, fq);
    float ss = 0.f;
#pragma unroll
    for (int q = 0; q < ET; ++q) ss += (o[0][q][0] * o[0][q][0] + o[0][q][1] * o[0][q][1]) + (o[0][q][2] * o[0][q][2] + o[0][q][3] * o[0][q][3]);
    ss += __shfl_xor(ss, 16); ss += __shfl_xor(ss, 32);
    const int i = it * 16 + fr;
    if (fq == 0) RED[i * 4 + eg] = ss;
    __syncthreads();
    float tot = 0.f;
#pragma unroll
    for (int q = 0; q < WPI; ++q) tot += RED[i * 4 + q];
    const float rstd = 1.f / sqrtf(tot * (1.f / 128.f) + NORM_EPS);
    const bf16_t* Z = (const bf16_t*)(F.ws + WS_Z); bf16_t* O = (bf16_t*)(F.ws + WS_XN);
    const size_t row = (size_t)(r0 + i);
#pragma unroll
    for (int q = 0; q < ET; ++q) { const int e = (eg * ET + q) * 16 + 4 * fq; const u32x2 gw = *(const u32x2*)(Z + row * ABIN + (HG ? 3072 : 1024) + h * 128 + e);
        const float g4[4] = {bflo(gw.x), bfhi(gw.x), bflo(gw.y), bfhi(gw.y)}; float ov[4];
#pragma unroll
        for (int r = 0; r < 4; ++r) { if (HG) ov[r] = o[0][q][r] * rstd * F.in[I_HGNG][m * 128 + e + r] * sigmoidf_(g4[r]); else ov[r] = o[0][q][r] * rstd * siluf_(g4[r]); }
        u32x2 ow; ow.x = pk2(ov[0], ov[1]); ow.y = pk2(ov[2], ov[3]); *(u32x2*)(O + row * D + (HG ? 512 : 0) + h * 128 + e) = ow; }
}

__device__ __forceinline__ void ab_scan(Frame& F, int layer) {
    const int tid = otid(); const int lane = tid & 63; (void)lane;
    const int m = layer >> 1;
    unsigned* ST32 = (unsigned*)(F.ws + WS_STATE); const float* DEC = (const float*)(F.ws + WS_DEC);
    constexpr int NP = SLOT_E / 2;
    const int gt = F.vcu * NT + tid;
    if (gt < NP) {
        const int eo = 2 * gt; const bool hg = eo >= 32768; const int eo2 = hg ? eo - 32768 : eo; const int head = hg ? eo2 >> 14 : eo2 >> 13; const int cch = hg ? (eo2 & 127) : (eo2 & 63); const int e = hg ? ((eo2 & 16383) >> 7) : ((eo2 & 8191) >> 6);
        const float gdec = hg ? 0.f : __expf(64.f * log1pf(-exp2f(-5.f - (float)head)));
        float s0 = 0.f, s1 = 0.f;
        for (int c0 = 0; c0 < 256; c0 += 8) {
            unsigned kv[8]; float d0[8], d1[8];
#pragma unroll
            for (int u = 0; u < 8; ++u) { kv[u] = ST32[(size_t)(c0 + u) * NP + gt]; if (hg) { const f32x2 dd = *(const f32x2*)(DEC + ((size_t)(c0 + u) * 4 + head) * 128 + cch); d0[u] = dd.x; d1[u] = dd.y; } else { d0[u] = gdec; d1[u] = gdec; } }
#pragma unroll
            for (int u = 0; u < 8; ++u) { ST32[(size_t)(c0 + u) * NP + gt] = pk2(s0, s1); s0 = d0[u] * s0 + bflo(kv[u]); s1 = d1[u] * s1 + bfhi(kv[u]); }
        }
        float* outp = hg ? F.out + O_HGP + (size_t)m * 65536 + head * 16384 : F.out + O_RETP + (size_t)m * 32768 + head * 8192;
        outp[(size_t)cch * 128 + e] = s0; outp[(size_t)(cch + 1) * 128 + e] = s1;
    } else {
        const int NG2 = F.G * NT - NP; if (NG2 <= 0) return;
        for (int idx = gt - NP; idx < 32 * NP; idx += NG2) { const int b = idx / NP, pr = idx % NP;
            const int eo = 2 * pr; const bool hg = eo >= 32768; const int eo2 = hg ? eo - 32768 : eo; const int head = hg ? eo2 >> 14 : eo2 >> 13; const int cch = hg ? (eo2 & 127) : (eo2 & 63); const int e = hg ? ((eo2 & 16383) >> 7) : ((eo2 & 8191) >> 6);
            float d0, d1; if (hg) { const f32x2 dd = *(const f32x2*)(DEC + ((size_t)(256 + b) * 4 + head) * 128 + cch); d0 = dd.x; d1 = dd.y; } else { d0 = d1 = __expf(32.f * log1pf(-exp2f(-5.f - (float)head))); }
            const size_t so = hg ? ((size_t)(m * 32 + b) * 4 + head) * 16384 : ((size_t)(m * 32 + b) * 4 + head) * 8192;
            const float* sin_ = (hg ? F.in[I_SHG] : F.in[I_SRET]) + so; float* sout = F.out + (hg ? O_HGS : O_RETS) + so;
            const float i0 = sin_[(size_t)cch * 128 + e], i1 = sin_[(size_t)(cch + 1) * 128 + e];
            const unsigned kv = ST32[(size_t)(256 + b) * NP + pr]; ST32[(size_t)(256 + b) * NP + pr] = pk2(i0, i1);
            sout[(size_t)cch * 128 + e] = d0 * i0 + bflo(kv); sout[(size_t)(cch + 1) * 128 + e] = d1 * i1 + bfhi(kv); }
    }
}

__device__ __forceinline__ void rwkv_seq_unit(Frame& F, int layer, int row0, int T, int h, const float* sin_, float* sout, LAS float* vec) {
    const int tid = otid(); const int lane = tid & 63; (void)lane;
    const int m = layer >> 1, col = h * 64 + lane;
    bf16_t* RKV = (bf16_t*)(F.ws + WS_RKV); const bf16_t* WLOG = (const bf16_t*)(F.ws + WS_WLOG); const bf16_t* AA = (const bf16_t*)(F.ws + WS_XN); const bf16_t* GG = (const bf16_t*)(F.ws + WS_G);
    const float kkw = F.in[I_RKK][m * D + col], kaw = F.in[I_RKA][m * D + col], rkw = F.in[I_RRK][m * D + col], lng = F.in[I_RLNG][m * D + col], lnb = F.in[I_RLNB][m * D + col];
    float s[64];
#pragma unroll
    for (int j = 0; j < 64; ++j) s[j] = sin_ ? sin_[lane * 64 + j] : 0.f;
    unsigned short nr = RKV[(size_t)row0 * 3072 + col], nk = RKV[(size_t)row0 * 3072 + 1024 + col], nv = RKV[(size_t)row0 * 3072 + 2048 + col], nw = WLOG[(size_t)row0 * D + col], na = AA[(size_t)row0 * D + col], ng = GG[(size_t)row0 * D + col];
    for (int t = 0; t < T; ++t) {
        const size_t row = (size_t)(row0 + t);
        const float r = bf2f(nr), k = bf2f(nk), v = bf2f(nv), wl = bf2f(nw), a = bf2f(na), g = bf2f(ng);
        if (t + 1 < T) { const size_t rn = row + 1; nr = RKV[rn * 3072 + col]; nk = RKV[rn * 3072 + 1024 + col]; nv = RKV[rn * 3072 + 2048 + col]; nw = WLOG[rn * D + col]; na = AA[rn * D + col]; ng = GG[rn * D + col]; }
        float kk = k * kkw; const float n2 = wave_sum(kk * kk); kk = kk / fmaxf(sqrtf(n2), 1e-12f);
        const float kh = k * (1.f + (a - 1.f) * kaw), dec = __expf(wl), bb = kk * a;
        asm volatile("" ::: "memory");
        vec[lane] = kk; vec[64 + lane] = dec; vec[128 + lane] = bb; vec[192 + lane] = kh; vec[256 + lane] = r;
        LDS_WAIT(); asm volatile("" ::: "memory");
        float sa = 0.f;
#pragma unroll
        for (int jb = 0; jb < 64; jb += 16) {
#pragma unroll
            for (int j = jb; j < jb + 16; j += 4) { const f32x4 q = *(const LAS f32x4*)(vec + j); sa += (s[j] * q[0] + s[j + 1] * q[1]) + (s[j + 2] * q[2] + s[j + 3] * q[3]); }
            asm volatile("" ::: "memory"); }
        sa = -sa;
        float y = 0.f;
#pragma unroll
        for (int jb = 0; jb < 64; jb += 8) {
#pragma unroll
            for (int j = jb; j < jb + 8; j += 4) { const f32x4 dq = *(const LAS f32x4*)(vec + 64 + j), bq = *(const LAS f32x4*)(vec + 128 + j), kq = *(const LAS f32x4*)(vec + 192 + j), rq = *(const LAS f32x4*)(vec + 256 + j);
#pragma unroll
                for (int q = 0; q < 4; ++q) { s[j + q] = s[j + q] * dq[q] + sa * bq[q] + v * kq[q]; y += s[j + q] * rq[q]; } }
            asm volatile("" ::: "memory"); }
        const float mean = wave_sum(y) * (1.f / 64.f), dd = y - mean, var = wave_sum(dd * dd) * (1.f / 64.f);
        const float yn = dd * (1.f / sqrtf(var + RW_LN_EPS)) * lng + lnb;
        const float bonus = wave_sum(r * kh * rkw);
        RKV[row * 3072 + col] = (bf16_t)f2bf((yn + bonus * v) * g);
        LDS_WAIT(); asm volatile("" ::: "memory");
    }
#pragma unroll
    for (int j = 0; j < 64; ++j) sout[lane * 64 + j] = s[j];
}
__device__ __forceinline__ void rwkv_seq_phase(Frame& F, int layer) {
    const int m = layer >> 1; LAS float* vec = (LAS float*)(F.lds + F.wave * 2048);
    const int b = blockIdx.x;
    int row0 = 0, T = 0, h = 0; const float* sin_ = nullptr; float* sout = nullptr;
    if (b < 16) { if (F.wave == 0) { row0 = 0; T = MP; h = b; sout = F.out + O_WKVP + ((size_t)m * 16 + b) * 4096; } }
    else { const int idx = (b - 16) + (int)(F.G - 16) * F.wave; if (idx < 512) { const int sb = idx >> 4; h = idx & 15; row0 = MP + 32 * sb; T = 32;
            sin_ = F.in[I_SWKV] + (((size_t)m * 32 + sb) * 16 + h) * 4096; sout = F.out + O_WKVS + (((size_t)m * 32 + sb) * 16 + h) * 4096; } }
    if (T > 0) rwkv_seq_unit(F, layer, row0, T, h, sin_, sout, vec);
}

#define GRID_BAR() xcd_barrier(bar)
#ifndef PHASE_MASK
#define PHASE_MASK 0xffffffffu
#endif
#define PH(k) if (PHASE_MASK & (1u << (k)))
template <int layer> __device__ __forceinline__ void layer_body(Frame& F, const XcdBarrier& bar) {
    unsigned char* ws = F.ws; unsigned char* ar = ws + WS_ARENA;
    bf16_t* XN = (bf16_t*)(ws + WS_XN);
    const float* MOD = (const float*)(ws + WS_MOD);
    constexpr int m = layer >> 1; const float* modl = MOD + (size_t)layer * NSEQ * 6144;
    PH(1) if (layer > 0) convert_layer_weights(F, layer);
    if constexpr ((layer & 1) == 0) {
        PH(2) norm_pass<0>(F, layer);
        GRID_BAR();
        PH(3) { using GC = pg8::Geo<D, D, D, 30, 0, 1 << 20, 0>; pg8::Gemm<GC> g{XN, (const bf16_t*)(ar + AR_WIN), nullptr}; pg8::StaticOrder S; S.init(M, ABIN, F.G, (int)blockIdx.x);
          pg8::EpiBf16<0> E{(bf16_t*)(ws + WS_Z), ABIN};
          pg8::gemm_phase<pg8::EpiBf16<0>, pg8::StaticOrder, GC, true, true>(F.lds, g, S, E); }
        GRID_BAR();
        PH(4) for (int u = F.vcu; u < NCHUNK * 8; u += F.G) { const int c = u >> 3, hh = u & 7;
            if (c < 256) { if (hh < 4) ab_summary_unit<64, false>(F, layer, c, hh); else ab_summary_unit<64, true>(F, layer, c, hh - 4); }
            else { if (hh < 4) ab_summary_unit<32, false>(F, layer, c, hh); else ab_summary_unit<32, true>(F, layer, c, hh - 4); } }
        GRID_BAR();
        PH(5) ab_scan(F, layer);
        GRID_BAR();
        PH(6) for (int u = F.vcu; u < NCHUNK * 8; u += F.G) { const int c = u >> 3, hh = u & 7;
            if (c < 256) { if (hh < 4) ab_output_unit<64, false>(F, layer, c, hh); else ab_output_unit<64, true>(F, layer, c, hh - 4); }
            else { if (hh < 4) ab_output_unit<32, false>(F, layer, c, hh); else ab_output_unit<32, true>(F, layer, c, hh - 4); } }
        GRID_BAR();
        PH(7) { using GC = pg8::Geo<D, D, D, 30, 0, 1 << 20, 0>; pg8::Gemm<GC> g{XN, (const bf16_t*)(ar + AR_WOUT), nullptr}; pg8::StaticOrder S; S.init(M, D, F.G, (int)blockIdx.x);
          pg8::EpiRes E{F.out, modl, 2048};
          pg8::gemm_phase<pg8::EpiRes, pg8::StaticOrder, GC, true, true>(F.lds, g, S, E); }
        GRID_BAR();
    } else {
        PH(8) norm_pass<1>(F, layer);
        GRID_BAR();
        PH(9) { using GC = pg8::Geo<D, 2048, 2048, 30, 0, 16, -4096>; pg8::Gemm<GC> g{XN, (const bf16_t*)(ar + AR_WC1), (const bf16_t*)(ws + WS_PREVS)}; pg8::StaticOrder S; S.init(M, 4096, F.G, (int)blockIdx.x);
          pg8::EpiRkv E{(bf16_t*)(ws + WS_RKV), (bf16_t*)(ws + WS_LO), (m == 0) ? (bf16_t*)(ws + WS_VFIRST) : nullptr};
          pg8::gemm_phase<pg8::EpiRkv, pg8::StaticOrder, GC, true, true>(F.lds, g, S, E); }
        GRID_BAR();
        PH(10) { using GC = pg8::Geo<D, 256, 256, 2, 256, 1 << 20, 0>; pg8::Gemm<GC> g{(const bf16_t*)(ws + WS_LO), (const bf16_t*)(ar + AR_WC2), nullptr}; pg8::StaticOrder S; S.init(M, 4096, F.G, (int)blockIdx.x);
          pg8::EpiLora2 E{(bf16_t*)(ws + WS_WLOG), XN, (bf16_t*)(ws + WS_G), (bf16_t*)(ws + WS_RKV), (m == 1) ? (const bf16_t*)(ws + WS_VFIRST) : nullptr,
                          F.in[I_RW0] + m * D, F.in[I_RA0] + m * D, F.in[I_RV0]};
          pg8::gemm_phase<pg8::EpiLora2, pg8::StaticOrder, GC, true, true>(F.lds, g, S, E); }
        GRID_BAR();
        PH(11) rwkv_seq_phase(F, layer);
        GRID_BAR();
        PH(12) { using GC = pg8::Geo<3072, D, D, 30, 0, 1 << 20, 0>; pg8::Gemm<GC> g{(const bf16_t*)(ws + WS_RKV), (const bf16_t*)(ar + AR_WO), nullptr}; pg8::StaticOrder S; S.init(M, D, F.G, (int)blockIdx.x);
          pg8::EpiRes E{F.out, modl, 2048};
          pg8::gemm_phase<pg8::EpiRes, pg8::StaticOrder, GC, true, true>(F.lds, g, S, E); }
        GRID_BAR();
    }
    PH(13) norm_pass<2>(F, layer);
    GRID_BAR();
    PH(14) { using GC = pg8::Geo<D, D, D, 30, 0, 1 << 20, 0>; pg8::Gemm<GC> g{XN, (const bf16_t*)(ar + AR_W1), nullptr}; pg8::StaticOrder S; S.init(M, DFF, F.G, (int)blockIdx.x);
      pg8::EpiBf16<1> E{(bf16_t*)(ws + WS_H), DFF};
      pg8::gemm_phase<pg8::EpiBf16<1>, pg8::StaticOrder, GC, true, true>(F.lds, g, S, E); }
    GRID_BAR();
    PH(15) { using GC = pg8::Geo<DFF, DFF, DFF, 30, 0, 1 << 20, 0>; pg8::Gemm<GC> g{(const bf16_t*)(ws + WS_H), (const bf16_t*)(ar + AR_W2), nullptr}; pg8::StaticOrder S; S.init(M, D, F.G, (int)blockIdx.x);
      pg8::EpiRes E{F.out, modl, 5120};
      pg8::gemm_phase<pg8::EpiRes, pg8::StaticOrder, GC, true, true>(F.lds, g, S, E); }
    GRID_BAR();
}

__global__ void __launch_bounds__(NT, 2) fwd_kernel(Args args) {
    extern __shared__ __attribute__((aligned(16))) unsigned char lds[];
    Frame F;
    F.lds = (LAS unsigned char*)lds; F.MISC = (volatile LAS unsigned*)(F.lds + MISC_OFF);
    F.wave = __builtin_amdgcn_readfirstlane(threadIdx.x >> 6);
    F.G = gridDim.x; { const int bx = blockIdx.x; F.vcu = (F.G % 8 == 0) ? (bx % 8) * (F.G / 8) + bx / 8 : bx; }
    F.in = args.in; F.out = args.out; F.ws = args.ws;
    for (int u = threadIdx.x; u < (LDS_BYTES - LDSCTL_OFF) / 4; u += NT) ((LAS unsigned*)(F.lds + LDSCTL_OFF))[u] = 0u;
    __syncthreads();
    XcdBarrier bar = xcd_barrier_post((unsigned*)(F.ws + WS_CTL) + CW_BAR, F.MISC + 8);
    PH(0) prologue(F);
    GRID_BAR();
    PH(0) mod_phase(F);
    GRID_BAR();
    layer_body<0>(F, bar); layer_body<1>(F, bar); layer_body<2>(F, bar); layer_body<3>(F, bar);
    PH(16) norm_pass<3>(F, 0);
}

extern "C" void kernel_launch(void* const* d_in, const int* in_sizes, int n_in, void* d_out, int out_size, void* d_ws, size_t ws_size, hipStream_t stream) {
    static int grid = 0;
    if (grid == 0) {
        if (n_in != 38 || out_size != 28706816 || ws_size < WS_END) { fprintf(stderr, "kernel_launch: unexpected problem (n_in %d, out %d, ws %zu; need ws >= %zu)\n", n_in, out_size, ws_size, (size_t)WS_END); grid = -1; return; }
        int dev = 0, cus = 0, per_cu = 0;
        if (hipGetDevice(&dev) != hipSuccess || hipDeviceGetAttribute(&cus, hipDeviceAttributeMultiprocessorCount, dev) != hipSuccess) { grid = -1; return; }
        if (hipFuncSetAttribute((const void*)fwd_kernel, hipFuncAttributeMaxDynamicSharedMemorySize, LDS_BYTES) != hipSuccess) { fprintf(stderr, "kernel_launch: hipFuncSetAttribute failed\n"); grid = -1; return; }
        if (hipOccupancyMaxActiveBlocksPerMultiprocessor(&per_cu, (const void*)fwd_kernel, NT, LDS_BYTES) != hipSuccess || per_cu < 1) { fprintf(stderr, "kernel_launch: occupancy query says %d\n", per_cu); per_cu = 1; }
        (void)hipGetLastError();
        grid = cus;
    }
    if (grid < 0) return;
    (void)hipMemsetAsync((char*)d_ws + WS_CTL, 0, ZERO_BYTES, stream);
    Args a{};
    for (int i = 0; i < 38; ++i) a.in[i] = (const float*)d_in[i];
    a.out = (float*)d_out; a.ws = (unsigned char*)d_ws;
    void* kargs[] = {&a};
    hipError_t e = hipLaunchCooperativeKernel((const void*)fwd_kernel, dim3(grid), dim3(NT), kargs, LDS_BYTES, stream);
    if (e != hipSuccess) fprintf(stderr, "kernel_launch: cooperative launch failed: %s (grid %d)\n", hipGetErrorString(e), grid);
}
```

```cpp
#include <hip/hip_runtime.h>
#include <cstdio>
#include <cstdint>

#define LAS __attribute__((address_space(3)))
#define GAS __attribute__((address_space(1)))
typedef unsigned short bf16_t;
typedef short bf16x8 __attribute__((ext_vector_type(8)));
typedef float f32x4 __attribute__((ext_vector_type(4)));
typedef float f32x2 __attribute__((ext_vector_type(2)));
typedef unsigned u32x4 __attribute__((ext_vector_type(4)));
typedef unsigned u32x2 __attribute__((ext_vector_type(2)));

constexpr int D = 1024, MP = 16384, MS = 1024, M = MP + MS, NSEQ = 33, DFF = 4096, ABIN = 3584;
constexpr int NCHUNK = 288;
constexpr int SLOT_E = 4 * 8192 + 4 * 16384;
constexpr float NORM_EPS = 1e-6f, RW_LN_EPS = 64e-5f;

constexpr size_t MiB = 1u << 20;
constexpr size_t WS_CTL = 0, WS_MOD = 1 * MiB, ZERO_BYTES = 65536;
constexpr size_t WS_ROPE = 5 * MiB;
constexpr size_t WS_ARENA = 10 * MiB;
constexpr size_t AR_W1 = 0, AR_W2 = 8 * MiB, AR_WIN = 16 * MiB, AR_WOUT = 23 * MiB, AR_WC1 = 16 * MiB, AR_WC2 = 32 * MiB, AR_WO = 34 * MiB;
constexpr size_t WS_VFIRST = 46 * MiB;
constexpr size_t WS_XN0 = 80 * MiB, WS_XN = WS_XN0 + 2048;
constexpr size_t WS_PREVS = 115 * MiB;
constexpr size_t WS_R1 = 118 * MiB;
constexpr size_t WS_Z = WS_R1, WS_STATE = WS_R1 + 120 * MiB, WS_DEC = WS_R1 + 174 * MiB;
constexpr size_t WS_H = WS_R1;
constexpr size_t WS_RKV = WS_R1, WS_LO = WS_R1 + 102 * MiB, WS_WLOG = WS_R1 + 136 * MiB, WS_G = WS_R1 + 170 * MiB;
constexpr size_t WS_TST = WS_R1 + 102 * MiB;
constexpr size_t WS_PP = WS_R1 + 204 * MiB, WS_QQ = WS_R1 + 236 * MiB, WS_GAM = WS_R1 + 268 * MiB, WS_BON = WS_R1 + 269 * MiB;
constexpr size_t WS_END = WS_R1 + 271 * MiB;

__device__ const double ROPE_REV[32] = {0.15915494309189535, 0.11934937021124886, 0.089499401608891013, 0.067115083005227255, 0.050329212104487035, 0.037741584717419771, 0.028302195830623399, 0.02122365276477766, 0.015915494309189534, 0.011934937021124886, 0.0089499401608891024, 0.0067115083005227253, 0.0050329212104487037, 0.0037741584717419772, 0.0028302195830623399, 0.0021223652764777662, 0.0015915494309189536, 0.0011934937021124885, 0.00089499401608891024, 0.0006711508300522726, 0.00050329212104487033, 0.00037741584717419774, 0.00028302195830623395, 0.00021223652764777661, 0.00015915494309189535, 0.00011934937021124886, 8.9499401608891018e-05, 6.7115083005227254e-05, 5.0329212104487035e-05, 3.7741584717419777e-05, 2.8302195830623396e-05, 2.1223652764777659e-05};

__device__ __forceinline__ unsigned f2bf(float f) { unsigned u = __builtin_bit_cast(unsigned, f); return (u + 0x7fffu + ((u >> 16) & 1u)) >> 16; }
typedef __bf16 bf16x2_t __attribute__((ext_vector_type(2)));
__device__ __forceinline__ unsigned pk2(float lo, float hi) { const f32x2 v = {lo, hi}; const bf16x2_t b = __builtin_convertvector(v, bf16x2_t); return __builtin_bit_cast(unsigned, b); }
__device__ __forceinline__ float bf2f(unsigned short b) { return __builtin_bit_cast(float, (unsigned)b << 16); }
__device__ __forceinline__ float bflo(unsigned w) { return __builtin_bit_cast(float, w << 16); }
__device__ __forceinline__ float bfhi(unsigned w) { return __builtin_bit_cast(float, w & 0xffff0000u); }
__device__ __forceinline__ float sigmoidf_(float x) { return 1.f / (1.f + __expf(-x)); }
__device__ __forceinline__ float siluf_(float x) { return x / (1.f + __expf(-x)); }
__device__ __forceinline__ float wave_sum(float v) {
#pragma unroll
    for (int o = 1; o < 64; o <<= 1) v += __shfl_xor(v, o);
    return v;
}
__device__ __forceinline__ int otid() { int t = threadIdx.x; asm volatile("" : "+v"(t)); return t; }
__device__ __forceinline__ int seq_of_row(int r) { return r < MP ? 0 : 1 + ((r - MP) >> 5); }
#define LDS_WAIT() asm volatile("s_waitcnt lgkmcnt(0)" ::: "memory")
#define VM_WAIT() asm volatile("s_waitcnt vmcnt(0)" ::: "memory")

namespace pg8 {
constexpr int BM = 256, BK = 64, HALF = 128, HTB = HALF * BK * 2, STAGE_BYTES = 8 * HTB, NXCD = 8, WGM = 8;
__host__ __device__ __forceinline__ int lds_byte(int r, int c) { const int st = (r >> 4) * 2 + (c >> 5), rr = r & 15, cc = c & 31, ob = rr * 64 + cc * 2; return st * 1024 + (ob ^ (((ob >> 9) & 1) << 5)); }
__host__ __device__ __forceinline__ void stage_rc(int b, int& R, int& C) { const int st = b / 1024, sb = b % 1024, swz = sb ^ (((sb >> 9) & 1) << 5); R = (st >> 1) * 16 + swz / 64; C = (st & 1) * 32 + (swz % 64) / 2; }
__host__ __device__ __forceinline__ int perm32(int rho) { const int n = rho >> 4, i = rho & 15; return 8 * (i >> 2) + 4 * n + (i & 3); }

struct Unit { int pm, pn; };
template <int LDA_, int LDB_, int K_, int GSHIFT_, int GSTRIDE_, int KSPLIT_, int DELTAP_> struct Geo {
    static constexpr int LDA = LDA_, LDB = LDB_, K = K_, GSHIFT = GSHIFT_, GSTRIDE = GSTRIDE_, KSPLIT = KSPLIT_, DELTAP = DELTAP_;
};
template <class GC> struct Gemm {
    const bf16_t* A; const bf16_t* Bt; const bf16_t* A2s;
    __device__ __forceinline__ const char* a_base(const Unit& u) const { return (const char*)(A + (size_t)u.pm * BM * GC::LDA + (size_t)(u.pn >> GC::GSHIFT) * GC::GSTRIDE); }
    __device__ __forceinline__ long a_delta(const Unit& u) const {
        if constexpr (GC::KSPLIT >= GC::K / BK) return 0;
        else { if (u.pm < 64) return (long)GC::DELTAP;
            return (long)((const char*)(A2s + (size_t)(u.pm - 64) * BM * GC::LDA) - a_base(u)) - (long)GC::KSPLIT * BK * 2; }
    }
};
struct StaticOrder {
    int nM, nN, nwg, G, c;
    __host__ __device__ void init(int M_, int N_, int G_, int c_) { nM = M_ / BM; nN = N_ / BM; nwg = nM * nN; G = G_; c = c_; }
    __host__ __device__ bool next(int i, Unit& u) const {
        const long L = (long)i * G + c; if (L >= nwg) return false;
        int wgid = (int)L; { const int q = nwg / NXCD, r = nwg % NXCD, xcd = wgid % NXCD, off = wgid / NXCD; wgid = (xcd < r ? xcd * (q + 1) : r * (q + 1) + (xcd - r) * q) + off; }
        const int nig = WGM * nN, gid = wgid / nig, fm = gid * WGM, gsz = (nM - fm) < WGM ? (nM - fm) : WGM;
        u.pm = fm + ((wgid % nig) % gsz); u.pn = (wgid % nig) / gsz; return true;
    }
};
__device__ __forceinline__ unsigned cvt_pk_bf16(float lo, float hi) { return pk2(lo, hi); }

template <class Epi, class Sched, class GC, bool ALIGN_EPI = false, bool SP2 = false>
__device__ __forceinline__ void gemm_phase(LAS unsigned char* lds, const Gemm<GC> g, const Sched& S, const Epi& E) {
    const int tid = otid(), wid = __builtin_amdgcn_readfirstlane(tid >> 6), lane = tid & 63, wr = wid >> 2, wc = wid & 3, fr = lane & 15, fq = lane >> 4;
    constexpr int K = GC::K, nt = K / BK, ksplit = GC::KSPLIT;
    unsigned voffA[2], voffB[2];
#pragma unroll
    for (int i = 0; i < 2; ++i) { int R, C; stage_rc(tid * 16 + i * 8192, R, C); const int Rb = Epi::PERM ? ((R & ~31) + perm32(R & 31)) : R;
        voffA[i] = (unsigned)(R * GC::LDA + C) * 2u; voffB[i] = (unsigned)(Rb * GC::LDB + C) * 2u; }
    constexpr size_t kstep = (size_t)(BK * 2);
    constexpr size_t hstepA = (size_t)HALF * GC::LDA * 2, hstepB = (size_t)HALF * GC::LDB * 2;
    constexpr size_t tstepB = 2 * hstepB;
    const unsigned ldsw = (unsigned)wid * 1024u;
    const int aoff = lds_byte(wr * 64 + fr, fq * 8), boff = lds_byte(wc * 32 + fr, fq * 8);
#define PG8_SA(b, h) (((b) * 2 + (h)) * HTB)
#define PG8_SB(b, h) ((4 + (b) * 2 + (h)) * HTB)
#define PG8_STAGE(bufoff, gbase, voff) do { _Pragma("unroll") for (int _i = 0; _i < 2; ++_i) \
        __builtin_amdgcn_global_load_lds((const unsigned*)((const char*)(gbase) + (voff)[_i]), (LAS unsigned*)(lds + (bufoff) + ldsw + _i * 8192), 16, 0, 0); } while (0)
#define PG8_LDA(dst, b, h) do { _Pragma("unroll") for (int m = 0; m < 4; ++m) _Pragma("unroll") for (int k = 0; k < 2; ++k) dst[m][k] = *(const LAS bf16x8*)(lds + PG8_SA(b, h) + aoff + m * 2048 + k * 1024); } while (0)
#define PG8_LDB(dst, b, h) do { _Pragma("unroll") for (int n = 0; n < 2; ++n) _Pragma("unroll") for (int k = 0; k < 2; ++k) dst[n][k] = *(const LAS bf16x8*)(lds + PG8_SB(b, h) + boff + n * 2048 + k * 1024); } while (0)
#define PG8_MMA(ai, bj, At, Bt) do { __builtin_amdgcn_s_setprio(1); _Pragma("unroll") for (int m = 0; m < 4; ++m) _Pragma("unroll") for (int n = 0; n < 2; ++n) _Pragma("unroll") for (int k = 0; k < 2; ++k) \
        acc[ai][bj][m][n] = __builtin_amdgcn_mfma_f32_16x16x32_bf16(Bt[n][k], At[m][k], acc[ai][bj][m][n], 0, 0, 0); __builtin_amdgcn_s_setprio(0); } while (0)
#define PG8_WAIT_V(n) asm volatile("s_waitcnt vmcnt(" #n ")" ::: "memory")
#define PG8_WAIT_L(n) asm volatile("s_waitcnt lgkmcnt(" #n ")" ::: "memory")
#define PG8_BAR __builtin_amdgcn_s_barrier()
#define PG8_SCHED __builtin_amdgcn_sched_barrier(0)
    Unit cur, nxt; int ui = 0;
    if (!S.next(0, cur)) return;
    f32x4 acc[2][2][4][2];
#pragma unroll
    for (int a = 0; a < 2; ++a)
#pragma unroll
        for (int b = 0; b < 2; ++b)
#pragma unroll
            for (int m = 0; m < 4; ++m)
#pragma unroll
                for (int n = 0; n < 2; ++n) acc[a][b][m][n] = (f32x4){0.f, 0.f, 0.f, 0.f};
    bf16x8 At[4][2], B0[2][2], B1[2][2];
    const char* cA = g.a_base(cur); const char* cB = (const char*)g.Bt + (size_t)cur.pn * tstepB; long cD = g.a_delta(cur);
    if constexpr (SP2) {
        PG8_STAGE(PG8_SB(0, 0), cB, voffB); PG8_STAGE(PG8_SB(0, 1), cB + hstepB, voffB); PG8_STAGE(PG8_SA(0, 0), cA, voffA); PG8_STAGE(PG8_SA(0, 1), cA + hstepA, voffA);
        if (wr == 1) PG8_BAR;
        PG8_WAIT_V(2); PG8_BAR;
        PG8_STAGE(PG8_SB(1, 0), cB + kstep, voffB); PG8_STAGE(PG8_SA(1, 0), cA + kstep, voffA); PG8_STAGE(PG8_SB(1, 1), cB + hstepB + kstep, voffB);
        PG8_WAIT_V(6); PG8_BAR;
    } else {
        PG8_STAGE(PG8_SB(0, 0), cB, voffB); PG8_STAGE(PG8_SA(0, 0), cA, voffA); PG8_STAGE(PG8_SB(0, 1), cB + hstepB, voffB); PG8_STAGE(PG8_SA(0, 1), cA + hstepA, voffA);
        if (wr == 1) PG8_BAR;
        PG8_WAIT_V(4); PG8_BAR;
        PG8_STAGE(PG8_SB(1, 0), cB + kstep, voffB); PG8_STAGE(PG8_SA(1, 0), cA + kstep, voffA); PG8_STAGE(PG8_SB(1, 1), cB + hstepB + kstep, voffB);
        PG8_WAIT_V(6); PG8_BAR;
    }
    for (;;) {
        const bool has_next = S.next(ui + 1, nxt);
        const char* nA = has_next ? g.a_base(nxt) : cA; const char* nB = has_next ? (const char*)g.Bt + (size_t)nxt.pn * tstepB : cB;
        const long nD = has_next ? g.a_delta(nxt) : cD;
#pragma unroll 1
        for (int t = 0; t < nt; t += 2) {
            const bool last = (t == nt - 2);
            const char* a1 = cA + (size_t)(t + 1) * kstep + (t >= ksplit ? cD : 0);
            const char* a2 = last ? nA : cA + (size_t)(t + 2) * kstep + (t + 2 >= ksplit ? cD : 0); const char* b2 = last ? nB : cB + (size_t)(t + 2) * kstep;
            const char* a3 = a2 + kstep; const char* b3 = b2 + kstep;
            if constexpr (SP2) {
            PG8_LDB(B0, 0, 0); PG8_LDB(B1, 0, 1); PG8_SCHED; PG8_LDA(At, 0, 0); PG8_STAGE(PG8_SA(1, 1), a1 + hstepA, voffA);
            PG8_WAIT_V(8); PG8_WAIT_L(0); PG8_BAR; PG8_MMA(0, 0, At, B0); PG8_MMA(0, 1, At, B1); PG8_BAR; PG8_SCHED;
            PG8_LDA(At, 0, 1); PG8_STAGE(PG8_SB(0, 0), b2, voffB); PG8_STAGE(PG8_SB(0, 1), b2 + hstepB, voffB); PG8_STAGE(PG8_SA(0, 0), a2, voffA);
            PG8_WAIT_V(8); PG8_WAIT_L(0); PG8_BAR; PG8_MMA(1, 0, At, B0); PG8_MMA(1, 1, At, B1); PG8_BAR; PG8_SCHED;
            PG8_LDB(B0, 1, 0); PG8_LDB(B1, 1, 1); PG8_SCHED; PG8_LDA(At, 1, 0); PG8_STAGE(PG8_SA(0, 1), a2 + hstepA, voffA);
            PG8_WAIT_V(8); PG8_WAIT_L(0); PG8_BAR; PG8_MMA(0, 0, At, B0); PG8_MMA(0, 1, At, B1); PG8_BAR; PG8_SCHED;
            PG8_LDA(At, 1, 1); PG8_STAGE(PG8_SB(1, 0), b3, voffB); PG8_STAGE(PG8_SB(1, 1), b3 + hstepB, voffB); PG8_STAGE(PG8_SA(1, 0), a3, voffA);
            PG8_WAIT_V(8); PG8_WAIT_L(0); PG8_BAR; PG8_MMA(1, 0, At, B0); PG8_MMA(1, 1, At, B1); PG8_BAR; PG8_SCHED;
            } else {
            PG8_LDB(B0, 0, 0); PG8_SCHED; PG8_LDA(At, 0, 0); PG8_STAGE(PG8_SA(1, 1), a1 + hstepA, voffA);
            PG8_WAIT_L(8); PG8_BAR; PG8_WAIT_L(0); PG8_MMA(0, 0, At, B0); PG8_BAR; PG8_SCHED;
            PG8_LDB(B1, 0, 1); PG8_STAGE(PG8_SB(0, 0), b2, voffB);
            PG8_BAR; PG8_WAIT_L(0); PG8_MMA(0, 1, At, B1); PG8_BAR;
            PG8_LDA(At, 0, 1); PG8_STAGE(PG8_SA(0, 0), a2, voffA);
            PG8_BAR; PG8_WAIT_L(0); PG8_MMA(1, 0, At, B0); PG8_BAR; PG8_SCHED;
            PG8_STAGE(PG8_SB(0, 1), b2 + hstepB, voffB);
            PG8_WAIT_V(6); PG8_BAR; PG8_MMA(1, 1, At, B1); PG8_BAR;
            PG8_LDB(B0, 1, 0); PG8_SCHED; PG8_LDA(At, 1, 0); PG8_STAGE(PG8_SA(0, 1), a2 + hstepA, voffA);
            PG8_WAIT_L(8); PG8_BAR; PG8_WAIT_L(0); PG8_MMA(0, 0, At, B0); PG8_BAR; PG8_SCHED;
            PG8_LDB(B1, 1, 1); PG8_STAGE(PG8_SB(1, 0), b3, voffB);
            PG8_BAR; PG8_WAIT_L(0); PG8_MMA(0, 1, At, B1); PG8_BAR;
            PG8_LDA(At, 1, 1); PG8_STAGE(PG8_SA(1, 0), a3, voffA);
            PG8_BAR; PG8_WAIT_L(0); PG8_MMA(1, 0, At, B0); PG8_BAR; PG8_SCHED;
            PG8_STAGE(PG8_SB(1, 1), b3 + hstepB, voffB);
            PG8_WAIT_V(6); PG8_BAR; PG8_MMA(1, 1, At, B1); PG8_BAR;
            }
        }
        if constexpr (ALIGN_EPI) { if (wr == 0) PG8_BAR; }
        E(acc, cur, wr, wc, fr, fq);
        if (!has_next) break;
#pragma unroll
        for (int a = 0; a < 2; ++a)
#pragma unroll
            for (int b = 0; b < 2; ++b)
#pragma unroll
                for (int m = 0; m < 4; ++m)
#pragma unroll
                    for (int n = 0; n < 2; ++n) acc[a][b][m][n] = (f32x4){0.f, 0.f, 0.f, 0.f};
        cur = nxt; cA = nA; cB = nB; cD = nD; ++ui;
        if constexpr (ALIGN_EPI) { if (wr == 1) PG8_BAR; }
    }
    PG8_WAIT_V(0);
    if constexpr (!ALIGN_EPI) { if (wr == 0) PG8_BAR; }
    PG8_BAR;
#undef PG8_SA
#undef PG8_SB
#undef PG8_STAGE
#undef PG8_LDA
#undef PG8_LDB
#undef PG8_MMA
#undef PG8_WAIT_V
#undef PG8_WAIT_L
#undef PG8_BAR
#undef PG8_SCHED
}

__device__ __forceinline__ float act_apply(float v, int act) {
    if (act == 1) { const float r = v > 0.f ? v : 0.f; return r * r; }
    if (act == 2) { const float e = __expf(-2.f * fabsf(v)); const float t = (1.f - e) / (1.f + e); return v < 0.f ? -t : t; }
    if (act == 3) return 1.f / (1.f + __expf(-v));
    return v;
}
template <int ACT> __device__ __forceinline__ void store_tile_bf16(const f32x4 (&acc)[2][2][4][2], bf16_t* base, int ldc, int row0, int col0, bf16_t* base2, int ldc2, int col2) {
#pragma unroll
    for (int ai = 0; ai < 2; ++ai)
#pragma unroll
        for (int m = 0; m < 4; ++m) { const size_t r = (size_t)(row0 + ai * HALF + m * 16);
#pragma unroll
            for (int bj = 0; bj < 2; ++bj) { f32x4 v0 = acc[ai][bj][m][0], v1 = acc[ai][bj][m][1];
#pragma unroll
                for (int q = 0; q < 4; ++q) { v0[q] = act_apply(v0[q], ACT); v1[q] = act_apply(v1[q], ACT); }
                u32x4 w; w.x = cvt_pk_bf16(v0[0], v0[1]); w.y = cvt_pk_bf16(v0[2], v0[3]); w.z = cvt_pk_bf16(v1[0], v1[1]); w.w = cvt_pk_bf16(v1[2], v1[3]);
                *(u32x4*)(base + r * ldc + col0 + bj * HALF) = w;
                if (base2) *(u32x4*)(base2 + r * ldc2 + col2 + bj * HALF) = w; } }
}
template <int ACT> struct EpiBf16 {
    static constexpr bool PERM = true;
    bf16_t* O; int ldc;
    __device__ __forceinline__ void operator()(const f32x4 (&acc)[2][2][4][2], const Unit& u, int wr, int wc, int fr, int fq) const {
        store_tile_bf16<ACT>(acc, O, ldc, u.pm * BM + wr * 64 + fr, u.pn * BM + wc * 32 + 8 * fq, nullptr, 0, 0);
    }
};
struct EpiRkv {
    static constexpr bool PERM = true;
    bf16_t* RKV; bf16_t* LO; bf16_t* vf;
    __device__ __forceinline__ void operator()(const f32x4 (&acc)[2][2][4][2], const Unit& u, int wr, int wc, int fr, int fq) const {
        const int row0 = u.pm * BM + wr * 64 + fr, cin = wc * 32 + 8 * fq;
        if (u.pn < 12) { bf16_t* b2 = (u.pn >= 8) ? vf : nullptr; store_tile_bf16<0>(acc, RKV, 3072, row0, u.pn * BM + cin, b2, 1024, (u.pn - 8) * BM + cin); }
        else if (u.pn == 12) store_tile_bf16<2>(acc, LO, 1024, row0, cin, nullptr, 0, 0);
        else if (u.pn == 15) store_tile_bf16<3>(acc, LO, 1024, row0, 768 + cin, nullptr, 0, 0);
        else store_tile_bf16<0>(acc, LO, 1024, row0, (u.pn - 12) * BM + cin, nullptr, 0, 0);
    }
};
struct EpiRes {
    static constexpr bool PERM = false;
    float* X; const float* modl; int goff;
    __device__ __forceinline__ void operator()(const f32x4 (&acc)[2][2][4][2], const Unit& u, int wr, int wc, int fr, int fq) const {
        const int col0 = u.pn * BM + wc * 32 + 4 * fq;
#pragma unroll
        for (int ai = 0; ai < 2; ++ai)
#pragma unroll
            for (int m = 0; m < 4; ++m) { const int r = u.pm * BM + ai * HALF + wr * 64 + m * 16 + fr; const float* gp = modl + (size_t)seq_of_row(r) * 6144 + goff + col0; float* xp = X + (size_t)r * D + col0;
#pragma unroll
                for (int bj = 0; bj < 2; ++bj)
#pragma unroll
                    for (int n = 0; n < 2; ++n) { const f32x4 gv = *(const f32x4*)(gp + bj * HALF + n * 16); f32x4 xv = *(f32x4*)(xp + bj * HALF + n * 16);
                        xv = xv + gv * acc[ai][bj][m][n]; *(f32x4*)(xp + bj * HALF + n * 16) = xv; }
                asm volatile("" ::: "memory"); }
    }
};
struct EpiLora2 {
    static constexpr bool PERM = false;
    bf16_t* WLOG; bf16_t* Aout; bf16_t* G; bf16_t* RKV; const bf16_t* vf; const float* w0; const float* a0; const float* v0;
    template <int GRP> __device__ __forceinline__ void run(const f32x4 (&acc)[2][2][4][2], const Unit& u, int wr, int wc, int fr, int fq) const {
        const int col0 = (u.pn & 3) * BM + wc * 32 + 4 * fq;
#pragma unroll
        for (int ai = 0; ai < 2; ++ai)
#pragma unroll
            for (int m = 0; m < 4; ++m) { const size_t r = (size_t)(u.pm * BM + ai * HALF + wr * 64 + m * 16 + fr);
#pragma unroll
                for (int bj = 0; bj < 2; ++bj)
#pragma unroll
                    for (int n = 0; n < 2; ++n) { const int c = col0 + bj * HALF + n * 16; const f32x4 a = acc[ai][bj][m][n]; f32x4 o;
                        if constexpr (GRP == 0) { const f32x4 b = *(const f32x4*)(w0 + c);
#pragma unroll
                            for (int q = 0; q < 4; ++q) { const float x = -(b[q] + a[q]); const float sp = fmaxf(x, 0.f) + __logf(1.f + __expf(-fabsf(x))); o[q] = -__expf(-sp - 0.5f); }
                            u32x2 w; w.x = cvt_pk_bf16(o[0], o[1]); w.y = cvt_pk_bf16(o[2], o[3]); *(u32x2*)(WLOG + r * D + c) = w; }
                        else if constexpr (GRP == 1) { const f32x4 b = *(const f32x4*)(a0 + c);
#pragma unroll
                            for (int q = 0; q < 4; ++q) o[q] = 1.f / (1.f + __expf(-(b[q] + a[q])));
                            u32x2 w; w.x = cvt_pk_bf16(o[0], o[1]); w.y = cvt_pk_bf16(o[2], o[3]); *(u32x2*)(Aout + r * D + c) = w; }
                        else if constexpr (GRP == 2) { const f32x4 b = *(const f32x4*)(v0 + c); const u32x2 vv = *(const u32x2*)(RKV + r * 3072 + 2048 + c), ff = *(const u32x2*)(vf + r * D + c);
                            f32x4 v4, f4; v4[0] = bflo(vv.x); v4[1] = bfhi(vv.x); v4[2] = bflo(vv.y); v4[3] = bfhi(vv.y); f4[0] = bflo(ff.x); f4[1] = bfhi(ff.x); f4[2] = bflo(ff.y); f4[3] = bfhi(ff.y);
#pragma unroll
                            for (int q = 0; q < 4; ++q) { const float gte = 1.f / (1.f + __expf(-(b[q] + a[q]))); o[q] = v4[q] + (f4[q] - v4[q]) * gte; }
                            u32x2 w; w.x = cvt_pk_bf16(o[0], o[1]); w.y = cvt_pk_bf16(o[2], o[3]); *(u32x2*)(RKV + r * 3072 + 2048 + c) = w; }
                        else { u32x2 w; w.x = cvt_pk_bf16(a[0], a[1]); w.y = cvt_pk_bf16(a[2], a[3]); *(u32x2*)(G + r * D + c) = w; } }
                asm volatile("" ::: "memory"); }
    }
    __device__ __forceinline__ void operator()(const f32x4 (&acc)[2][2][4][2], const Unit& u, int wr, int wc, int fr, int fq) const {
        const int grp = u.pn >> 2;
        if (grp == 0) run<0>(acc, u, wr, wc, fr, fq);
        else if (grp == 1) run<1>(acc, u, wr, wc, fr, fq);
        else if (grp == 2) { if (vf != nullptr) run<2>(acc, u, wr, wc, fr, fq); }
        else run<3>(acc, u, wr, wc, fr, fq);
    }
};
}

#define RLX_AGENT __ATOMIC_RELAXED, __HIP_MEMORY_SCOPE_AGENT
#define XB_TMO      128
#define XB_XCNT(j)  (256  + 64 * (j))
#define XB_XSUB(j)  (1280 + 64 * (j))
#define XB_XGEN(j)  (2304 + 64 * (j))
#define XB_TOP      3328
#define XB_TOPGEN   3392
#define XCD_BAR_WORDS 3456
#define XB_SPIN_CAP (1u << 24)
__device__ __forceinline__ unsigned xb_ld(unsigned* p)              { return __hip_atomic_load(p, __ATOMIC_RELAXED, __HIP_MEMORY_SCOPE_AGENT); }
__device__ __forceinline__ unsigned xb_add(unsigned* p, unsigned v) { return __hip_atomic_fetch_add(p, v, __ATOMIC_RELAXED, __HIP_MEMORY_SCOPE_AGENT); }
__device__ __forceinline__ unsigned xb_xcc_id() { return (unsigned)__builtin_amdgcn_s_getreg((3 << 11) | 20) & 0xFu; }
#define XB_SPIN(cond, bar) do { unsigned _sp = 0; while (cond) { __builtin_amdgcn_s_sleep(1); \
    if ((++_sp & 255u) == 0u) { if (xb_ld(&(bar)[XB_TMO])) break; if (_sp > XB_SPIN_CAP) { atomicAdd(&(bar)[XB_TMO], 1u); break; } } } } while (0)
struct XcdBarrier { unsigned* bar; unsigned x; volatile LAS unsigned* st; };
__device__ __forceinline__ XcdBarrier xcd_barrier_post(unsigned* bar, volatile LAS unsigned* st) {
    XcdBarrier b; b.bar = bar; b.x = xb_xcc_id(); b.st = st;
    if (threadIdx.x == 0) (void)xb_add(&bar[XB_XCNT(b.x)], 1u);
    return b;
}
__device__ __forceinline__ void xcd_barrier_complete(unsigned* bar, unsigned x, unsigned& nloc, unsigned& nx) {
    const unsigned G = gridDim.x * gridDim.y * gridDim.z;
    unsigned sum, cnt, mine, sp = 0u;
    for (;;) {
        sum = 0u; cnt = 0u; mine = 0u;
#pragma unroll
        for (unsigned j = 0; j < 16; ++j) { const unsigned c = xb_ld(&bar[XB_XCNT(j)]); sum += c; cnt += (c > 0u) ? 1u : 0u; mine = (j == x) ? c : mine; }
        if (sum == G) break;
        __builtin_amdgcn_s_sleep(1);
        if ((++sp & 255u) == 0u) { if (xb_ld(&bar[XB_TMO])) break; if (sp > XB_SPIN_CAP) { atomicAdd(&bar[XB_TMO], 1u); break; } }
    }
    nloc = mine > 0u ? mine : 1u; nx = cnt > 0u ? cnt : 1u;
}
__device__ __forceinline__ void xcd_barrier(const XcdBarrier& b) {
    asm volatile("s_waitcnt vmcnt(0)" ::: "memory");
    __syncthreads();
    if (threadIdx.x == 0) {
        unsigned* bar = b.bar;
        __builtin_amdgcn_s_waitcnt(0);
        unsigned nloc = b.st[0], nx = b.st[1];
        if (nloc == 0u) { xcd_barrier_complete(bar, b.x, nloc, nx); b.st[0] = nloc; b.st[1] = nx; }
        const unsigned old = xb_add(&bar[XB_XSUB(b.x)], 1u);
        const unsigned gen = old / nloc;
        if (old + 1u == (gen + 1u) * nloc) {
            __builtin_amdgcn_fence(__ATOMIC_RELEASE, "agent");
            asm volatile("s_waitcnt vmcnt(0)" ::: "memory");
            const unsigned og = xb_add(&bar[XB_TOP], 1u);
            const unsigned tg = og / nx;
            if (og + 1u == (tg + 1u) * nx) xb_add(&bar[XB_TOPGEN], 1u);
            else XB_SPIN(xb_ld(&bar[XB_TOPGEN]) == tg, bar);
            __builtin_amdgcn_fence(__ATOMIC_ACQUIRE, "agent");
            xb_add(&bar[XB_XGEN(b.x)], 1u);
            asm volatile("s_waitcnt vmcnt(0)" ::: "memory");
        } else {
            XB_SPIN(xb_ld(&bar[XB_XGEN(b.x)]) == gen, bar);
            __builtin_amdgcn_fence(__ATOMIC_ACQUIRE, "agent");
            asm volatile("s_waitcnt vmcnt(0)" ::: "memory");
        }
    }
    __syncthreads();
}

constexpr int NWAVES = 8, NT = NWAVES * 64;
constexpr int RING_BYTES = 131072, LDSCTL_OFF = RING_BYTES, MISC_OFF = LDSCTL_OFF + 320, LDS_BYTES = 147456;
constexpr int CW_BAR = 4096;

struct Args { const float* in[38]; float* out; unsigned char* ws; };
struct Frame {
    LAS unsigned char* lds; volatile LAS unsigned* MISC;
    int wave, vcu, G;
    const float* const* in; float* out; unsigned char* ws;
};
enum { I_XP = 0, I_XS, I_SRET, I_SHG, I_SWKV, I_SSHIFT, I_CP, I_CS, I_MODW, I_MODB, I_NMIXG, I_NMLPG, I_FINALG, I_W1, I_W2, I_ABWIN, I_ABWOUT, I_HGLB, I_HGNG,
       I_MU, I_WRKV, I_RW0, I_RW1, I_RW2, I_RA0, I_RA1, I_RA2, I_RV0, I_RV1, I_RV2, I_RG1, I_RG2, I_RKK, I_RKA, I_RRK, I_RLNG, I_RLNB, I_RWOUT };
constexpr size_t O_Y = 0, O_RETP = 17825792, O_RETS = 17891328, O_HGP = 19988480, O_HGS = 20119552, O_WKVP = 24313856, O_WKVS = 24444928, O_SHP = 28639232, O_SHS = 28641280;

__device__ __forceinline__ void transpose_item(const float* W, int N, bf16_t* WT, int ldt, int row_off, int col_off, const float* mu, int mode, LAS float* scr, int item, int lane) {
    const int nblk = N / 32, kb = item / nblk, nb = item % nblk, k0 = 64 * kb, n0 = 32 * nb;
#pragma unroll 8
    for (int i = 0; i < 32; ++i) { const int kk = 2 * i + (lane >> 5); float s = 1.f; if (mode == 1) s = 1.f - mu[k0 + kk]; else if (mode == 2) s = mu[k0 + kk];
        scr[kk * 33 + (lane & 31)] = W[(size_t)(k0 + kk) * N + n0 + (lane & 31)] * s; }
    LDS_WAIT(); asm volatile("" ::: "memory");
    const int c = lane & 7;
#pragma unroll
    for (int j = 0; j < 4; ++j) { const int n = (lane >> 3) + 8 * j; const LAS float* s = scr + (8 * c) * 33 + n;
        u32x4 o; o.x = pk2(s[0 * 33], s[1 * 33]); o.y = pk2(s[2 * 33], s[3 * 33]); o.z = pk2(s[4 * 33], s[5 * 33]); o.w = pk2(s[6 * 33], s[7 * 33]);
        *(u32x4*)(WT + (size_t)(row_off + n0 + n) * ldt + col_off + k0 + 8 * c) = o; }
    LDS_WAIT(); asm volatile("" ::: "memory");
}
__device__ __forceinline__ void convert_layer_weights(Frame& F, int layer) {
    const int tid = otid(); const int lane = tid & 63; (void)lane;
    LAS float* scr = (LAS float*)(F.lds + F.wave * 16384);
    const int gw = F.vcu * NWAVES + F.wave, NGW = F.G * NWAVES;
    unsigned char* ar = F.ws + WS_ARENA;
    const int m = layer >> 1;
    constexpr int I_1 = (D / 64) * (DFF / 32), I_2 = (DFF / 64) * (D / 32);
    const float* w1 = F.in[I_W1] + (size_t)layer * D * DFF; const float* w2 = F.in[I_W2] + (size_t)layer * DFF * D;
    if ((layer & 1) == 0) {
        constexpr int I_IN = (D / 64) * (ABIN / 32), I_OUT = (D / 64) * (D / 32), NI = I_1 + I_2 + I_IN + I_OUT;
        const float* win = F.in[I_ABWIN] + (size_t)m * D * ABIN; const float* wout = F.in[I_ABWOUT] + (size_t)m * D * D;
        for (int it = gw; it < NI; it += NGW) { int r = it;
            if (r < I_1) { transpose_item(w1, DFF, (bf16_t*)(ar + AR_W1), D, 0, 0, nullptr, 0, scr, r, lane); continue; } r -= I_1;
            if (r < I_2) { transpose_item(w2, D, (bf16_t*)(ar + AR_W2), DFF, 0, 0, nullptr, 0, scr, r, lane); continue; } r -= I_2;
            if (r < I_IN) { transpose_item(win, ABIN, (bf16_t*)(ar + AR_WIN), D, 0, 0, nullptr, 0, scr, r, lane); continue; } r -= I_IN;
            transpose_item(wout, D, (bf16_t*)(ar + AR_WOUT), D, 0, 0, nullptr, 0, scr, r, lane); }
    } else {
        constexpr int I_P = (D / 64) * (D / 32), NI = I_1 + I_2 + 7 * I_P;
        const float* mu = F.in[I_MU] + (size_t)m * 6 * D; const float* wrkv = F.in[I_WRKV] + (size_t)m * 3 * D * D; const float* wo = F.in[I_RWOUT] + (size_t)m * D * D;
        bf16_t* wc1 = (bf16_t*)(ar + AR_WC1);
        for (int it = gw; it < NI; it += NGW) { int r = it;
            if (r < I_1) { transpose_item(w1, DFF, (bf16_t*)(ar + AR_W1), D, 0, 0, nullptr, 0, scr, r, lane); continue; } r -= I_1;
            if (r < I_2) { transpose_item(w2, D, (bf16_t*)(ar + AR_W2), DFF, 0, 0, nullptr, 0, scr, r, lane); continue; } r -= I_2;
            if (r < 6 * I_P) { const int p = r / (2 * I_P), hf = (r / I_P) & 1, mi = (p == 0) ? 0 : (p == 1 ? 2 : 3);
                transpose_item(wrkv + (size_t)p * D * D, D, wc1, 2048, p * D, hf * D, mu + mi * D, 1 + hf, scr, r % I_P, lane); continue; } r -= 6 * I_P;
            transpose_item(wo, D, (bf16_t*)(ar + AR_WO), D, 0, 0, nullptr, 0, scr, r, lane); }
        const int gt = F.vcu * NT + tid, NG = F.G * NT;
        const float* lw1 = F.in[I_RW1] + (size_t)m * D * 64; const float* la1 = F.in[I_RA1] + (size_t)m * D * 64; const float* lv1 = F.in[I_RV1]; const float* lg1 = F.in[I_RG1] + (size_t)m * D * 160;
        for (int idx = gt; idx < 1024 * 2048; idx += NG) { const int n = idx >> 11, k = idx & 2047, kk = k & 1023, s = n >> 8, nn = n & 255;
            const float* src = (s == 0) ? lw1 : (s == 1) ? la1 : (s == 2) ? lv1 : lg1; const int ns = (s == 0 || s == 1) ? 64 : (s == 2 ? 32 : 160); const int mi = (s == 0) ? 1 : (s == 1) ? 4 : (s == 2) ? 3 : 5;
            float v = 0.f; if (nn < ns && !(s == 2 && m == 0)) { const float muv = mu[mi * D + kk]; v = src[(size_t)kk * ns + nn] * (k < 1024 ? 1.f - muv : muv); }
            wc1[(size_t)(3072 + n) * 2048 + k] = (bf16_t)f2bf(v); }
        bf16_t* wc2 = (bf16_t*)(ar + AR_WC2);
        const float* lw2 = F.in[I_RW2] + (size_t)m * 64 * D; const float* la2 = F.in[I_RA2] + (size_t)m * 64 * D; const float* lv2 = F.in[I_RV2]; const float* lg2 = F.in[I_RG2] + (size_t)m * 160 * D;
        for (int idx = gt; idx < 4096 * 256; idx += NG) { const int k = idx >> 12, n = idx & 4095, g = n >> 10, nn = n & 1023;
            const float* src = (g == 0) ? lw2 : (g == 1) ? la2 : (g == 2) ? lv2 : lg2; const int ks = (g == 0 || g == 1) ? 64 : (g == 2 ? 32 : 160);
            float v = 0.f; if (k < ks && !(g == 2 && m == 0)) v = src[(size_t)k * D + nn];
            wc2[(size_t)n * 256 + k] = (bf16_t)f2bf(v); }
    }
}

__device__ __forceinline__ void mod_phase(Frame& F) {
    const int tid = otid(); const int lane = tid & 63;
    const float* __restrict__ SC = (const float*)(F.ws + WS_MOD + 3584 * 1024);
    float* MOD = (float*)(F.ws + WS_MOD);
    LAS float* red = (LAS float*)F.lds;
    for (int task = F.vcu; task < 4 * 96; task += F.G) { const int l = task / 96, n = (task % 96) * 64 + lane, ks = F.wave;
        const float* w = F.in[I_MODW] + ((size_t)l * D + ks * 128) * 6144 + n;
        float acc[NSEQ];
#pragma unroll
        for (int s = 0; s < NSEQ; ++s) acc[s] = 0.f;
        for (int k = 0; k < 128; k += 4) { const float w0 = w[(size_t)k * 6144], w1 = w[(size_t)(k + 1) * 6144], w2 = w[(size_t)(k + 2) * 6144], w3 = w[(size_t)(k + 3) * 6144];
#pragma unroll
            for (int s = 0; s < NSEQ; ++s) { const f32x4 c4 = *(const f32x4*)(SC + s * D + ks * 128 + k); acc[s] += (c4[0] * w0 + c4[1] * w1) + (c4[2] * w2 + c4[3] * w3); } }
        __syncthreads();
#pragma unroll
        for (int s = 0; s < NSEQ; ++s) red[(F.wave * NSEQ + s) * 64 + lane] = acc[s];
        __syncthreads();
        for (int i = tid; i < NSEQ * 64; i += NT) { const int s = i >> 6, c = i & 63; float t = F.in[I_MODB][l * 6144 + (task % 96) * 64 + c];
#pragma unroll
            for (int q = 0; q < 8; ++q) t += red[(q * NSEQ + s) * 64 + c];
            MOD[((size_t)l * NSEQ + s) * 6144 + (task % 96) * 64 + c] = t; }
    }
    __syncthreads();
}

__device__ __forceinline__ void prologue(Frame& F) {
    const int tid = otid(); const int lane = tid & 63; (void)lane;
    const int gt = F.vcu * NT + tid, NG = F.G * NT;
    { const f32x4* xp = (const f32x4*)F.in[I_XP]; const f32x4* xs = (const f32x4*)F.in[I_XS]; f32x4* o = (f32x4*)F.out;
      for (int i = gt; i < M * (D / 4); i += NG) o[i] = (i < MP * (D / 4)) ? xp[i] : xs[i - MP * (D / 4)]; }
    { f32x2* tab = (f32x2*)(F.ws + WS_ROPE);
      for (int i = gt; i < 16384 * 32; i += NG) { const int p = i >> 5, d = i & 31; double rev = (double)p * ROPE_REV[d]; rev -= floor(rev); const float fr = (float)rev;
          tab[i] = (f32x2){__builtin_amdgcn_cosf(fr), __builtin_amdgcn_sinf(fr)}; } }
    { unsigned* z = (unsigned*)(F.ws + WS_XN0); for (int i = gt; i < 512; i += NG) z[i] = 0u; }
    { float* SC = (float*)(F.ws + WS_MOD + 3584 * 1024);
      for (int i = gt; i < NSEQ * D; i += NG) { const int s = i >> 10, k = i & 1023; const float c = (s == 0) ? F.in[I_CP][k] : F.in[I_CS][(size_t)(s - 1) * D + k]; SC[i] = siluf_(c); } }
    convert_layer_weights(F, 0);
}

template <int MODE> __device__ __forceinline__ void norm_pass(Frame& F, int layer) {
    const int tid = otid(); const int lane = tid & 63; (void)lane;
    const int gw = F.vcu * NWAVES + F.wave, NGW = F.G * NWAVES; const int m = layer >> 1;
    const float* MOD = (const float*)(F.ws + WS_MOD) + (size_t)layer * NSEQ * 6144;
    const float* gvec = (MODE == 3) ? F.in[I_FINALG] : (MODE == 2 ? F.in[I_NMLPG] + layer * D : F.in[I_NMIXG] + layer * D);
    const int shoff = (MODE == 2) ? 3072 : 0, scoff = (MODE == 2) ? 4096 : 1024;
    bf16_t* XN = (bf16_t*)(F.ws + WS_XN); bf16_t* PREVS = (bf16_t*)(F.ws + WS_PREVS);
    for (int r = gw; r < M; r += NGW) {
        float* xrow = F.out + (size_t)r * D; const f32x4* xr = (const f32x4*)xrow + lane;
        f32x4 v[4]; float s2 = 0.f;
#pragma unroll
        for (int j = 0; j < 4; ++j) { v[j] = xr[64 * j]; s2 += (v[j].x * v[j].x + v[j].y * v[j].y) + (v[j].z * v[j].z + v[j].w * v[j].w); }
        const float rstd = 1.f / sqrtf(wave_sum(s2) * (1.f / D) + NORM_EPS);
        const int seq = seq_of_row(r); const float* mp = MOD + (size_t)seq * 6144;
#pragma unroll
        for (int j = 0; j < 4; ++j) { const int c = 4 * lane + 256 * j; const f32x4 g4 = *(const f32x4*)(gvec + c); f32x4 o = v[j] * rstd * g4;
            if (MODE == 3) { *((f32x4*)xrow + lane + 64 * j) = o; continue; }
            const f32x4 sc = *(const f32x4*)(mp + scoff + c), sh = *(const f32x4*)(mp + shoff + c);
            o = o * (1.f + sc) + sh;
            const unsigned long long pk = (unsigned long long)pk2(o.x, o.y) | ((unsigned long long)pk2(o.z, o.w) << 32);
            *(unsigned long long*)(XN + (size_t)r * D + c) = pk;
            if (MODE == 1) {
                if (r >= MP) { const int t = (r - MP) & 31; if (t < 31) *(unsigned long long*)(PREVS + (size_t)(r - MP + 1) * D + c) = pk;
                    else *(f32x4*)(F.out + O_SHS + ((size_t)m * 32 + ((r - MP) >> 5)) * D + c) = o;
                    if (t == 0) { const f32x4 ss = *(const f32x4*)(F.in[I_SSHIFT] + ((size_t)m * 32 + ((r - MP) >> 5)) * D + c);
                        *(unsigned long long*)(PREVS + (size_t)(r - MP) * D + c) = (unsigned long long)pk2(ss.x, ss.y) | ((unsigned long long)pk2(ss.z, ss.w) << 32); } }
                else if (r == MP - 1) *(f32x4*)(F.out + O_SHP + (size_t)m * D + c) = o;
            } }
    }
}

template <int MT, int NTT> __device__ __forceinline__ void wave_mm_nt(f32x4 (&acc)[MT][NTT], const LAS bf16_t* X, int ldx, const LAS bf16_t* Y, int ldy, int K, int fr, int fq) {
    for (int k0 = 0; k0 < K; k0 += 32) {
        bf16x8 xa[MT], yb[NTT];
#pragma unroll
        for (int i = 0; i < MT; ++i) xa[i] = *(const LAS bf16x8*)(X + (16 * i + fr) * ldx + k0 + 8 * fq);
#pragma unroll
        for (int j = 0; j < NTT; ++j) yb[j] = *(const LAS bf16x8*)(Y + (16 * j + fr) * ldy + k0 + 8 * fq);
#pragma unroll
        for (int i = 0; i < MT; ++i)
#pragma unroll
            for (int j = 0; j < NTT; ++j) acc[i][j] = __builtin_amdgcn_mfma_f32_16x16x32_bf16(yb[j], xa[i], acc[i][j], 0, 0, 0);
    }
}

constexpr int LQS = 0, LKS = 18432, LQG = 36864, LVT = 55296, LST = 73728, LPS = 108544, LRED = 117760, LBS = 118784;
__device__ __forceinline__ void chunk_geom(int c, int& r0, int& pos0) { if (c < 256) { r0 = 64 * c; pos0 = 64 * c; } else { r0 = MP + 32 * (c - 256); pos0 = 2048; } }

template <int L, bool HG, bool SUMMARY> __device__ __forceinline__ void ab_load(Frame& F, int layer, int c, int h) {
    const int tid = otid(); const int lane = tid & 63; (void)lane;
    const int m = layer >> 1; int r0, pos0; chunk_geom(c, r0, pos0);
    const bf16_t* Z = (const bf16_t*)(F.ws + WS_Z);
    LAS bf16_t* QS = (LAS bf16_t*)(F.lds + LQS); LAS bf16_t* KS = (LAS bf16_t*)(F.lds + LKS); LAS bf16_t* QG = (LAS bf16_t*)(F.lds + LQG); LAS bf16_t* VT = (LAS bf16_t*)(F.lds + LVT);
    constexpr int LDT = L + 8;
    if constexpr (HG) {
        constexpr int TQ = L / 4; LAS float* BS = (LAS float*)(F.lds + LBS);
        const int ch = tid & 127, qtr = tid >> 7;
        float lb = 0.f;
        if (m == 1) { const float a0 = F.in[I_HGLB][h * 128 + ch], a1 = F.in[I_HGLB][512 + h * 128 + ch]; lb = 1.f / (1.f + __expf(a0 - a1)); }
        float zf[TQ], cs[TQ]; float run = 0.f;
#pragma unroll
        for (int jj = 0; jj < TQ; ++jj) { const int j = qtr * TQ + jj; zf[jj] = bf2f(Z[(size_t)(r0 + j) * ABIN + 2048 + h * 128 + ch]);
            float lf; if (lb == 0.f) lf = fminf(zf[jj], 0.f) - log1pf(__expf(-fabsf(zf[jj]))); else lf = __logf(lb + (1.f - lb) * sigmoidf_(zf[jj]));
            run += lf; cs[jj] = run; }
        BS[qtr * 128 + ch] = run;
        __syncthreads();
        const float b0 = BS[ch], b1 = BS[128 + ch], b2 = BS[256 + ch], b3 = BS[384 + ch];
        const float off = (qtr > 0 ? b0 : 0.f) + (qtr > 1 ? b1 : 0.f) + (qtr > 2 ? b2 : 0.f), bL = (b0 + b1) + (b2 + b3), bmid = b0 + b1;
#pragma unroll
        for (int jj = 0; jj < TQ; ++jj) { const int j = qtr * TQ + jj; const size_t zr = (size_t)(r0 + j) * ABIN; const float b = off + cs[jj];
            const float kb = (1.f - lb) * sigmoidf_(-zf[jj]); const float vv = bf2f(Z[zr + 2560 + h * 128 + ch]);
            VT[ch * LDT + j] = (bf16_t)f2bf(vv);
            if constexpr (SUMMARY) { QS[ch * LDT + j] = (bf16_t)f2bf(kb * __expf(bL - b)); }
            else { const float q = siluf_(bf2f(Z[zr + 1536 + h * 128 + ch]));
                QS[j * 136 + ch] = (bf16_t)f2bf(q * __expf(b - bmid)); KS[j * 136 + ch] = (bf16_t)f2bf(kb * __expf(bmid - b)); QG[j * 136 + ch] = (bf16_t)f2bf(q * __expf(b)); } }
        if constexpr (SUMMARY) { if (qtr == 0) ((float*)(F.ws + WS_DEC))[((size_t)c * 4 + h) * 128 + ch] = __expf(bL); }
    } else {
        const float logg = log1pf(-exp2f(-5.f - (float)h));
        const f32x2* rope = (const f32x2*)(F.ws + WS_ROPE);
        for (int it = tid; it < L * 4; it += NT) { const int j = it >> 2, d8 = it & 3; const size_t zr = (size_t)(r0 + j) * ABIN;
            const f32x2* rp = rope + (size_t)(pos0 + j) * 32 + d8 * 8;
            const u32x4 k1 = *(const u32x4*)(Z + zr + 256 + h * 64 + d8 * 8), k2 = *(const u32x4*)(Z + zr + 256 + h * 64 + 32 + d8 * 8);
            const float gk = __expf((float)(L - 1 - j) * logg), gq = __expf((float)(j + 1) * logg);
            u32x4 q1 = (u32x4){0, 0, 0, 0}, q2 = q1; if constexpr (!SUMMARY) { q1 = *(const u32x4*)(Z + zr + h * 64 + d8 * 8); q2 = *(const u32x4*)(Z + zr + h * 64 + 32 + d8 * 8); }
#pragma unroll
            for (int e = 0; e < 8; ++e) { const f32x2 cs_ = rp[e]; const unsigned wk1 = k1[e >> 1], wk2 = k2[e >> 1]; const float x1 = (e & 1) ? bfhi(wk1) : bflo(wk1), x2 = (e & 1) ? bfhi(wk2) : bflo(wk2);
                const float o1 = x1 * cs_.x - x2 * cs_.y, o2 = x1 * cs_.y + x2 * cs_.x; const int d = d8 * 8 + e;
                if constexpr (SUMMARY) { QS[d * LDT + j] = (bf16_t)f2bf(o1 * gk); QS[(d + 32) * LDT + j] = (bf16_t)f2bf(o2 * gk); }
                else { KS[j * 72 + d] = (bf16_t)f2bf(o1); KS[j * 72 + d + 32] = (bf16_t)f2bf(o2);
                    const unsigned wq1 = q1[e >> 1], wq2 = q2[e >> 1]; const float y1 = (e & 1) ? bfhi(wq1) : bflo(wq1), y2 = (e & 1) ? bfhi(wq2) : bflo(wq2);
                    const float p1 = (y1 * cs_.x - y2 * cs_.y) * 0.125f, p2 = (y1 * cs_.y + y2 * cs_.x) * 0.125f;
                    QS[j * 72 + d] = (bf16_t)f2bf(p1); QS[j * 72 + d + 32] = (bf16_t)f2bf(p2); QG[j * 72 + d] = (bf16_t)f2bf(p1 * gq); QG[j * 72 + d + 32] = (bf16_t)f2bf(p2 * gq); } } }
        for (int it = tid; it < L * 16; it += NT) { const int j = it >> 4, e8 = it & 15; const u32x4 vv = *(const u32x4*)(Z + (size_t)(r0 + j) * ABIN + 512 + h * 128 + e8 * 8);
#pragma unroll
            for (int e = 0; e < 8; ++e) { const unsigned w = vv[e >> 1]; VT[(e8 * 8 + e) * LDT + j] = (bf16_t)((e & 1) ? (w >> 16) : (w & 0xffffu)); } }
    }
}

template <int L, bool HG> __device__ __forceinline__ void ab_summary_unit(Frame& F, int layer, int c, int h) {
    const int tid = otid(); const int lane = tid & 63; (void)lane;
    constexpr int DK = HG ? 128 : 64, NCT = DK / 16, LDT = L + 8;
    __syncthreads();
    ab_load<L, HG, true>(F, layer, c, h);
    __syncthreads();
    const int fr = lane & 15, fq = lane >> 4;
    const LAS bf16_t* KDT = (const LAS bf16_t*)(F.lds + LQS); const LAS bf16_t* VT = (const LAS bf16_t*)(F.lds + LVT);
    f32x4 acc[1][NCT];
#pragma unroll
    for (int j = 0; j < NCT; ++j) acc[0][j] = (f32x4){0.f, 0.f, 0.f, 0.f};
    wave_mm_nt<1, NCT>(acc, VT + F.wave * 16 * LDT, LDT, KDT, LDT, L, fr, fq);
    bf16_t* ST = (bf16_t*)(F.ws + WS_STATE) + (size_t)c * SLOT_E + (HG ? 32768 + h * 16384 : h * 8192);
    const int e = F.wave * 16 + fr;
#pragma unroll
    for (int j = 0; j < NCT; ++j) { u32x2 w; w.x = pk2(acc[0][j][0], acc[0][j][1]); w.y = pk2(acc[0][j][2], acc[0][j][3]); *(u32x2*)(ST + (size_t)e * DK + 16 * j + 4 * fq) = w; }
}

template <int L, bool HG> __device__ __forceinline__ void ab_output_unit(Frame& F, int layer, int c, int h) {
    const int tid = otid(); const int lane = tid & 63; (void)lane;
    constexpr int DK = HG ? 128 : 64, LDQ = HG ? 136 : 72, LDT = L + 8, NIT = L / 16, WPI = 8 / NIT, ET = 8 / WPI, TPW = (NIT * NIT >= 8) ? NIT * NIT / 8 : 1;
    const int m = layer >> 1; int r0, pos0; chunk_geom(c, r0, pos0);
    __syncthreads();
    ab_load<L, HG, false>(F, layer, c, h);
    LAS bf16_t* QS = (LAS bf16_t*)(F.lds + LQS); LAS bf16_t* KS = (LAS bf16_t*)(F.lds + LKS); LAS bf16_t* QG = (LAS bf16_t*)(F.lds + LQG); LAS bf16_t* VT = (LAS bf16_t*)(F.lds + LVT);
    LAS bf16_t* STl = (LAS bf16_t*)(F.lds + LST); LAS bf16_t* PS = (LAS bf16_t*)(F.lds + LPS); LAS float* RED = (LAS float*)(F.lds + LRED);
    { const bf16_t* ST = (const bf16_t*)(F.ws + WS_STATE) + (size_t)c * SLOT_E + (HG ? 32768 + h * 16384 : h * 8192);
      for (int it = tid; it < 128 * DK / 8; it += NT) { const int e = it / (DK / 8), c8 = it % (DK / 8); *(LAS u32x4*)(STl + e * LDQ + c8 * 8) = *(const u32x4*)(ST + (size_t)e * DK + c8 * 8); } }
    __syncthreads();
    const int fr = lane & 15, fq = lane >> 4, w = F.wave;
    const float logg = HG ? 0.f : log1pf(-exp2f(-5.f - (float)h));
    if (w * TPW < NIT * NIT) {
        const int it = (w * TPW) / NIT, jt0 = (w * TPW) % NIT;
        f32x4 sc[1][TPW];
#pragma unroll
        for (int q = 0; q < TPW; ++q) sc[0][q] = (f32x4){0.f, 0.f, 0.f, 0.f};
        wave_mm_nt<1, TPW>(sc, QS + it * 16 * LDQ, LDQ, KS + jt0 * 16 * LDQ, LDQ, DK, fr, fq);
        const int i = it * 16 + fr;
#pragma unroll
        for (int q = 0; q < TPW; ++q) { float p[4];
#pragma unroll
            for (int r = 0; r < 4; ++r) { const int j = (jt0 + q) * 16 + 4 * fq + r; float v = sc[0][q][r]; if (!HG) v *= __expf((float)(i - j) * logg); p[r] = (j <= i) ? v : 0.f; }
            u32x2 pw; pw.x = pk2(p[0], p[1]); pw.y = pk2(p[2], p[3]); *(LAS u32x2*)(PS + i * LDT + (jt0 + q) * 16 + 4 * fq) = pw; }
    }
    __syncthreads();
    const int it = w % NIT, eg = w / NIT;
    f32x4 o[1][ET];
#pragma unroll
    for (int q = 0; q < ET; ++q) o[0][q] = (f32x4){0.f, 0.f, 0.f, 0.f};
    wave_mm_nt<1, ET>(o, PS + it * 16 * LDT, LDT, VT + eg * ET * 16 * LDT, LDT, L, fr, fq);
    wave_mm_nt<1, ET>(o, QG + it * 16 * LDQ, LDQ, STl + eg * ET * 16 * LDQ, LDQ, DK, fr, fq);
    float ss = 0.f;
#pragma unroll
    for (int q = 0; q < ET; ++q) ss += (o[0][q][0] * o[0][q][0] + o[0][q][1] * o[0][q][1]) + (o[0][q][2] * o[0][q][2] + o[0][q][3] * o[0][q][3]);
    ss += __shfl_xor(ss, 16); ss += __shfl_xor(ss, 32);
    const int i = it * 16 + fr;
    if (fq == 0) RED[i * 4 + eg] = ss;
    __syncthreads();
    float tot = 0.f;
#pragma unroll
    for (int q = 0; q < WPI; ++q) tot += RED[i * 4 + q];
    const float rstd = 1.f / sqrtf(tot * (1.f / 128.f) + NORM_EPS);
    const bf16_t* Z = (const bf16_t*)(F.ws + WS_Z); bf16_t* O = (bf16_t*)(F.ws + WS_XN);
    const size_t row = (size_t)(r0 + i);
#pragma unroll
    for (int q = 0; q < ET; ++q) { const int e = (eg * ET + q) * 16 + 4 * fq; const u32x2 gw = *(const u32x2*)(Z + row * ABIN + (HG ? 3072 : 1024) + h * 128 + e);
        const float g4[4] = {bflo(gw.x), bfhi(gw.x), bflo(gw.y), bfhi(gw.y)}; float ov[4];
#pragma unroll
        for (int r = 0; r < 4; ++r) { if (HG) ov[r] = o[0][q][r] * rstd * F.in[I_HGNG][m * 128 + e + r] * sigmoidf_(g4[r]); else ov[r] = o[0][q][r] * rstd * siluf_(g4[r]); }
        u32x2 ow; ow.x = pk2(ov[0], ov[1]); ow.y = pk2(ov[2], ov[3]); *(u32x2*)(O + row * D + (HG ? 512 : 0) + h * 128 + e) = ow; }
}

__device__ __forceinline__ void ab_scan(Frame& F, int layer) {
    const int tid = otid(); const int lane = tid & 63; (void)lane;
    const int m = layer >> 1;
    unsigned* ST32 = (unsigned*)(F.ws + WS_STATE); const float* DEC = (const float*)(F.ws + WS_DEC);
    constexpr int NP = SLOT_E / 2;
    const int gt = F.vcu * NT + tid;
    if (gt < NP) {
        const int eo = 2 * gt; const bool hg = eo >= 32768; const int eo2 = hg ? eo - 32768 : eo; const int head = hg ? eo2 >> 14 : eo2 >> 13; const int cch = hg ? (eo2 & 127) : (eo2 & 63); const int e = hg ? ((eo2 & 16383) >> 7) : ((eo2 & 8191) >> 6);
        const float gdec = hg ? 0.f : __expf(64.f * log1pf(-exp2f(-5.f - (float)head)));
        float s0 = 0.f, s1 = 0.f;
        for (int c0 = 0; c0 < 256; c0 += 8) {
            unsigned kv[8]; float d0[8], d1[8];
#pragma unroll
            for (int u = 0; u < 8; ++u) { kv[u] = ST32[(size_t)(c0 + u) * NP + gt]; if (hg) { const f32x2 dd = *(const f32x2*)(DEC + ((size_t)(c0 + u) * 4 + head) * 128 + cch); d0[u] = dd.x; d1[u] = dd.y; } else { d0[u] = gdec; d1[u] = gdec; } }
#pragma unroll
            for (int u = 0; u < 8; ++u) { ST32[(size_t)(c0 + u) * NP + gt] = pk2(s0, s1); s0 = d0[u] * s0 + bflo(kv[u]); s1 = d1[u] * s1 + bfhi(kv[u]); }
        }
        float* outp = hg ? F.out + O_HGP + (size_t)m * 65536 + head * 16384 : F.out + O_RETP + (size_t)m * 32768 + head * 8192;
        outp[(size_t)cch * 128 + e] = s0; outp[(size_t)(cch + 1) * 128 + e] = s1;
    } else {
        const int NG2 = F.G * NT - NP; if (NG2 <= 0) return;
        for (int idx = gt - NP; idx < 32 * NP; idx += NG2) { const int b = idx / NP, pr = idx % NP;
            const int eo = 2 * pr; const bool hg = eo >= 32768; const int eo2 = hg ? eo - 32768 : eo; const int head = hg ? eo2 >> 14 : eo2 >> 13; const int cch = hg ? (eo2 & 127) : (eo2 & 63); const int e = hg ? ((eo2 & 16383) >> 7) : ((eo2 & 8191) >> 6);
            float d0, d1; if (hg) { const f32x2 dd = *(const f32x2*)(DEC + ((size_t)(256 + b) * 4 + head) * 128 + cch); d0 = dd.x; d1 = dd.y; } else { d0 = d1 = __expf(32.f * log1pf(-exp2f(-5.f - (float)head))); }
            const size_t so = hg ? ((size_t)(m * 32 + b) * 4 + head) * 16384 : ((size_t)(m * 32 + b) * 4 + head) * 8192;
            const float* sin_ = (hg ? F.in[I_SHG] : F.in[I_SRET]) + so; float* sout = F.out + (hg ? O_HGS : O_RETS) + so;
            const float i0 = sin_[(size_t)cch * 128 + e], i1 = sin_[(size_t)(cch + 1) * 128 + e];
            const unsigned kv = ST32[(size_t)(256 + b) * NP + pr]; ST32[(size_t)(256 + b) * NP + pr] = pk2(i0, i1);
            sout[(size_t)cch * 128 + e] = d0 * i0 + bflo(kv); sout[(size_t)(cch + 1) * 128 + e] = d1 * i1 + bfhi(kv); }
    }
}

constexpr int RL_AT = 0, RL_RT = 9216, RL_BT = 18432, RL_KT = 27648, RL_BHT = 36864, RL_KHT = 46080, RL_VT = 55296, RL_AAB = 64512, RL_AAK = 81920, RL_ARB = 91136, RL_ARK = 100352,
              RL_U0T = 109568, RL_VEC = 118784, RL_PSUM = 119808;
constexpr int RL_G = RL_AAB, RL_WW = RL_BT, RL_APT = RL_AAK;
constexpr int RL_PL = RL_AT, RL_RL = RL_BT, RL_Y0L = RL_BT + 4608, RL_QTL = RL_AAB, RL_S = RL_BHT;
__device__ __forceinline__ int pperm(int k) { return 32 * (k >> 5) + 8 * ((k >> 2) & 3) + 4 * ((k >> 4) & 1) + (k & 3); }

__device__ __forceinline__ void rwkv_out_epilogue(Frame& F, int m, const f32x4 (&y)[4], size_t row, int h, int fq) {
    bf16_t* RKV = (bf16_t*)(F.ws + WS_RKV); const bf16_t* GG = (const bf16_t*)(F.ws + WS_G); const float* BON = (const float*)(F.ws + WS_BON);
    float s1 = 0.f;
#pragma unroll
    for (int nt = 0; nt < 4; ++nt) s1 += (y[nt][0] + y[nt][1]) + (y[nt][2] + y[nt][3]);
    s1 += __shfl_xor(s1, 16); s1 += __shfl_xor(s1, 32);
    const float mean = s1 * (1.f / 64.f); float s2 = 0.f;
#pragma unroll
    for (int nt = 0; nt < 4; ++nt)
#pragma unroll
        for (int r = 0; r < 4; ++r) { const float d = y[nt][r] - mean; s2 += d * d; }
    s2 += __shfl_xor(s2, 16); s2 += __shfl_xor(s2, 32);
    const float rstd = 1.f / sqrtf(s2 * (1.f / 64.f) + RW_LN_EPS), bon = BON[row * 16 + h];
#pragma unroll
    for (int nt = 0; nt < 4; ++nt) { const int i = h * 64 + 16 * nt + 4 * fq;
        const f32x4 lg = *(const f32x4*)(F.in[I_RLNG] + m * D + i), lb = *(const f32x4*)(F.in[I_RLNB] + m * D + i);
        const u32x2 vv = *(const u32x2*)(RKV + row * 3072 + 2048 + i), gg = *(const u32x2*)(GG + row * D + i);
        const float v4[4] = {bflo(vv.x), bfhi(vv.x), bflo(vv.y), bfhi(vv.y)}, g4[4] = {bflo(gg.x), bfhi(gg.x), bflo(gg.y), bfhi(gg.y)}; float o[4];
#pragma unroll
        for (int r = 0; r < 4; ++r) o[r] = ((y[nt][r] - mean) * rstd * lg[r] + lb[r] + bon * v4[r]) * g4[r];
        u32x2 w; w.x = pk2(o[0], o[1]); w.y = pk2(o[2], o[3]); *(u32x2*)(RKV + row * 3072 + i) = w; }
}

template <int SX, int L> struct SubstCol {
    static __device__ __forceinline__ void run(float (&x)[L], const LAS float* aabt) {
        if constexpr (SX < L - 1) {
            const float xs = x[SX];
#pragma unroll
            for (int t4 = (SX + 1) / 4; t4 < L / 4; ++t4) { const f32x4 q = *(const LAS f32x4*)(aabt + SX * 68 + 4 * t4);
                if (4 * t4 > SX) x[4 * t4] += q[0] * xs; if (4 * t4 + 1 > SX) x[4 * t4 + 1] += q[1] * xs; if (4 * t4 + 2 > SX) x[4 * t4 + 2] += q[2] * xs; if (4 * t4 + 3 > SX) x[4 * t4 + 3] += q[3] * xs;
                asm volatile("" : "+v"(x[4 * t4]), "+v"(x[4 * t4 + 1]), "+v"(x[4 * t4 + 2]), "+v"(x[4 * t4 + 3])); }
            asm volatile("" ::: "memory");
            SubstCol<SX + 1, L>::run(x, aabt);
        }
    }
};
template <int L> __device__ __forceinline__ void rwkv_local_unit(Frame& F, int layer, int c, int h) {
    const int tid = otid(); const int lane = tid & 63, fr = lane & 15, fq = lane >> 4, w = F.wave;
    constexpr int NIT = L / 16; constexpr bool SAMPLE = (L == 32);
    const int m = layer >> 1; int r0, pos0; chunk_geom(c, r0, pos0);
    bf16_t* RKV = (bf16_t*)(F.ws + WS_RKV); const bf16_t* WLOG = (const bf16_t*)(F.ws + WS_WLOG); const bf16_t* AA = (const bf16_t*)(F.ws + WS_XN);
    LAS bf16_t* AT = (LAS bf16_t*)(F.lds + RL_AT); LAS bf16_t* RT = (LAS bf16_t*)(F.lds + RL_RT); LAS bf16_t* BT = (LAS bf16_t*)(F.lds + RL_BT); LAS bf16_t* KT = (LAS bf16_t*)(F.lds + RL_KT);
    LAS bf16_t* BHT = (LAS bf16_t*)(F.lds + RL_BHT); LAS bf16_t* KHT = (LAS bf16_t*)(F.lds + RL_KHT); LAS bf16_t* VT = (LAS bf16_t*)(F.lds + RL_VT);
    LAS float* AAB = (LAS float*)(F.lds + RL_AAB); LAS bf16_t* AAK = (LAS bf16_t*)(F.lds + RL_AAK); LAS bf16_t* ARB = (LAS bf16_t*)(F.lds + RL_ARB); LAS bf16_t* ARK = (LAS bf16_t*)(F.lds + RL_ARK);
    LAS bf16_t* U0T = (LAS bf16_t*)(F.lds + RL_U0T); LAS float* GMID = (LAS float*)(F.lds + RL_VEC); LAS float* GLV = GMID + 64; LAS float* EGM = GMID + 128; LAS float* PSUM = (LAS float*)(F.lds + RL_PSUM);
    LAS float* G = (LAS float*)(F.lds + RL_G); LAS float* WW = (LAS float*)(F.lds + RL_WW); LAS bf16_t* APT = (LAS bf16_t*)(F.lds + RL_APT);
    __syncthreads();
    const int t = tid >> 3, c8 = tid & 7; const bool act = t < L;
    float rr[8], kkv[8], bb[8], kh[8], vv[8];
    if (act) { const size_t row = (size_t)(r0 + t); const int col = h * 64 + 8 * c8;
        const u32x4 r4 = *(const u32x4*)(RKV + row * 3072 + col), k4 = *(const u32x4*)(RKV + row * 3072 + 1024 + col), v4 = *(const u32x4*)(RKV + row * 3072 + 2048 + col);
        const u32x4 w4 = *(const u32x4*)(WLOG + row * D + col), a4 = *(const u32x4*)(AA + row * D + col);
        const float* kkp = F.in[I_RKK] + m * D + col; const float* kap = F.in[I_RKA] + m * D + col; const float* rkp = F.in[I_RRK] + m * D + col;
        float ss = 0.f, bon = 0.f;
#pragma unroll
        for (int e = 0; e < 8; ++e) { const float kx = (e & 1) ? bfhi(k4[e >> 1]) : bflo(k4[e >> 1]), al = (e & 1) ? bfhi(a4[e >> 1]) : bflo(a4[e >> 1]);
            rr[e] = (e & 1) ? bfhi(r4[e >> 1]) : bflo(r4[e >> 1]); vv[e] = (e & 1) ? bfhi(v4[e >> 1]) : bflo(v4[e >> 1]);
            kkv[e] = kx * kkp[e]; ss += kkv[e] * kkv[e]; kh[e] = kx * (1.f + (al - 1.f) * kap[e]); bb[e] = al; bon += rr[e] * kh[e] * rkp[e];
            G[t * 64 + 8 * c8 + e] = (e & 1) ? bfhi(w4[e >> 1]) : bflo(w4[e >> 1]); }
        ss += __shfl_xor(ss, 1); ss += __shfl_xor(ss, 2); ss += __shfl_xor(ss, 4); bon += __shfl_xor(bon, 1); bon += __shfl_xor(bon, 2); bon += __shfl_xor(bon, 4);
        const float inv = 1.f / fmaxf(sqrtf(ss), 1e-12f);
#pragma unroll
        for (int e = 0; e < 8; ++e) { kkv[e] *= inv; bb[e] *= kkv[e]; }
        if (c8 == 0) ((float*)(F.ws + WS_BON))[row * 16 + h] = bon; }
    __syncthreads();
    { constexpr int TE = L / 8; const int j = tid & 63, e8 = tid >> 6; float cs[TE]; float run = 0.f;
#pragma unroll
      for (int q = 0; q < TE; ++q) { run += G[(e8 * TE + q) * 64 + j]; cs[q] = run; }
      PSUM[e8 * 64 + j] = run;
      __syncthreads();
      float off = 0.f, gm = 0.f, gl = 0.f;
#pragma unroll
      for (int q = 0; q < 8; ++q) { const float p = PSUM[q * 64 + j]; if (q < e8) off += p; if (q < 4) gm += p; gl += p; }
#pragma unroll
      for (int q = 0; q < TE; ++q) G[(e8 * TE + q) * 64 + j] = off + cs[q];
      if (e8 == 0) { GMID[j] = gm; GLV[j] = gl; EGM[j] = __expf(gm); if (!SAMPLE) ((float*)(F.ws + WS_GAM))[((size_t)c * 16 + h) * 64 + j] = __expf(gl); } }
    __syncthreads();
    if (act) { float fa[8], fr_[8], fb[8], fk[8];
#pragma unroll
        for (int e = 0; e < 8; ++e) { const int j = 8 * c8 + e; const float g = G[t * 64 + j], gp = (t > 0) ? G[(t - 1) * 64 + j] : 0.f, gm = GMID[j], gl = GLV[j];
            const float ed = __expf(gm - g), eu = __expf(g - gm), el = __expf(gl - g);
            fa[e] = -kkv[e] * __expf(gp - gm); fr_[e] = rr[e] * eu; fb[e] = bb[e] * ed; fk[e] = kh[e] * ed;
            BHT[j * 72 + t] = (bf16_t)f2bf(bb[e] * el); KHT[j * 72 + t] = (bf16_t)f2bf(kh[e] * el); VT[j * 72 + t] = (bf16_t)f2bf(vv[e]); }
        u32x4 p;
        p.x = pk2(fa[0], fa[1]); p.y = pk2(fa[2], fa[3]); p.z = pk2(fa[4], fa[5]); p.w = pk2(fa[6], fa[7]); *(LAS u32x4*)(AT + t * 72 + 8 * c8) = p;
        p.x = pk2(fr_[0], fr_[1]); p.y = pk2(fr_[2], fr_[3]); p.z = pk2(fr_[4], fr_[5]); p.w = pk2(fr_[6], fr_[7]); *(LAS u32x4*)(RT + t * 72 + 8 * c8) = p;
        p.x = pk2(fb[0], fb[1]); p.y = pk2(fb[2], fb[3]); p.z = pk2(fb[4], fb[5]); p.w = pk2(fb[6], fb[7]); *(LAS u32x4*)(BT + t * 72 + 8 * c8) = p;
        p.x = pk2(fk[0], fk[1]); p.y = pk2(fk[2], fk[3]); p.z = pk2(fk[4], fk[5]); p.w = pk2(fk[6], fk[7]); *(LAS u32x4*)(KT + t * 72 + 8 * c8) = p; }
    __syncthreads();
    { constexpr int TPW = (NIT * NIT >= 8) ? NIT * NIT / 8 : 1;
      if (w * TPW < NIT * NIT) { const int it = (w * TPW) / NIT, jt0 = (w * TPW) % NIT;
          f32x4 ab[1][TPW], ak[1][TPW], rb[1][TPW], rk[1][TPW];
#pragma unroll
          for (int q = 0; q < TPW; ++q) { ab[0][q] = (f32x4){0.f, 0.f, 0.f, 0.f}; ak[0][q] = ab[0][q]; rb[0][q] = ab[0][q]; rk[0][q] = ab[0][q]; }
          wave_mm_nt<1, TPW>(ab, AT + it * 16 * 72, 72, BT + jt0 * 16 * 72, 72, 64, fr, fq); wave_mm_nt<1, TPW>(ak, AT + it * 16 * 72, 72, KT + jt0 * 16 * 72, 72, 64, fr, fq);
          wave_mm_nt<1, TPW>(rb, RT + it * 16 * 72, 72, BT + jt0 * 16 * 72, 72, 64, fr, fq); wave_mm_nt<1, TPW>(rk, RT + it * 16 * 72, 72, KT + jt0 * 16 * 72, 72, 64, fr, fq);
          const int tt = it * 16 + fr;
#pragma unroll
          for (int q = 0; q < TPW; ++q) { const int s0 = (jt0 + q) * 16 + 4 * fq; f32x4 fab; float fak[4], frb[4], frk[4];
#pragma unroll
              for (int r = 0; r < 4; ++r) { const int sx = s0 + r; fab[r] = (sx < tt) ? ab[0][q][r] : 0.f; fak[r] = (sx < tt) ? ak[0][q][r] : 0.f; frb[r] = (sx <= tt) ? rb[0][q][r] : 0.f; frk[r] = (sx <= tt) ? rk[0][q][r] : 0.f; }
#pragma unroll
              for (int r = 0; r < 4; ++r) AAB[(s0 + r) * 68 + tt] = fab[r];
              u32x2 p; p.x = pk2(fak[0], fak[1]); p.y = pk2(fak[2], fak[3]); *(LAS u32x2*)(AAK + tt * 72 + s0) = p;
              p.x = pk2(frb[0], frb[1]); p.y = pk2(frb[2], frb[3]); *(LAS u32x2*)(ARB + tt * 72 + s0) = p;
              p.x = pk2(frk[0], frk[1]); p.y = pk2(frk[2], frk[3]); *(LAS u32x2*)(ARK + tt * 72 + s0) = p; } } }
    __syncthreads();
    { constexpr int TP3 = NIT / 2; const int it = (w * TP3) / 4, nt0 = (w * TP3) % 4;
      f32x4 ww[1][TP3];
#pragma unroll
      for (int q = 0; q < TP3; ++q) ww[0][q] = (f32x4){0.f, 0.f, 0.f, 0.f};
      wave_mm_nt<1, TP3>(ww, AAK + it * 16 * 72, 72, VT + nt0 * 16 * 72, 72, L, fr, fq);
#pragma unroll
      for (int q = 0; q < TP3; ++q) *(LAS f32x4*)(WW + (it * 16 + fr) * 68 + (nt0 + q) * 16 + 4 * fq) = ww[0][q]; }
    __syncthreads();
    if (tid < 128) { const int cidx = tid & 63; const bool isA = tid < 64; float x[L]; const float eg = EGM[cidx];
        int vz = 0; asm volatile("" : "+v"(vz));
#pragma unroll
        for (int tt = 0; tt < L; ++tt) x[tt] = isA ? bf2f(AT[tt * 72 + cidx]) * eg : WW[tt * 68 + cidx];
        SubstCol<0, L>::run(x, AAB + vz);
        LAS bf16_t* dst = (isA ? APT : U0T) + cidx * 72;
#pragma unroll
        for (int t8 = 0; t8 < L; t8 += 8) { u32x4 p; p.x = pk2(x[t8], x[t8 + 1]); p.y = pk2(x[t8 + 2], x[t8 + 3]); p.z = pk2(x[t8 + 4], x[t8 + 5]); p.w = pk2(x[t8 + 6], x[t8 + 7]); *(LAS u32x4*)(dst + t8) = p; } }
    __syncthreads();
    { const int mt = w >> 1, nt0 = (w & 1) * 2;
      f32x4 pp[1][2], qt[1][2];
#pragma unroll
      for (int q = 0; q < 2; ++q) { pp[0][q] = (f32x4){0.f, 0.f, 0.f, 0.f}; qt[0][q] = pp[0][q]; }
      wave_mm_nt<1, 2>(pp, BHT + mt * 16 * 72, 72, APT + nt0 * 16 * 72, 72, L, fr, fq);
      wave_mm_nt<1, 2>(qt, U0T + mt * 16 * 72, 72, BHT + nt0 * 16 * 72, 72, L, fr, fq); wave_mm_nt<1, 2>(qt, VT + mt * 16 * 72, 72, KHT + nt0 * 16 * 72, 72, L, fr, fq);
      constexpr int TP5 = NIT / 2; const int it = (w * TP5) / 4, rn0 = (w * TP5) % 4;
      f32x4 rp[1][TP5], y0[1][TP5];
#pragma unroll
      for (int q = 0; q < TP5; ++q) { const int j = (rn0 + q) * 16 + 4 * fq; const u32x2 rw = *(const LAS u32x2*)(RT + (it * 16 + fr) * 72 + j); const f32x4 e4 = *(const LAS f32x4*)(EGM + j);
          rp[0][q] = (f32x4){bflo(rw.x) * e4[0], bfhi(rw.x) * e4[1], bflo(rw.y) * e4[2], bfhi(rw.y) * e4[3]}; y0[0][q] = (f32x4){0.f, 0.f, 0.f, 0.f}; }
      wave_mm_nt<1, TP5>(rp, ARB + it * 16 * 72, 72, APT + rn0 * 16 * 72, 72, L, fr, fq);
      wave_mm_nt<1, TP5>(y0, ARB + it * 16 * 72, 72, U0T + rn0 * 16 * 72, 72, L, fr, fq); wave_mm_nt<1, TP5>(y0, ARK + it * 16 * 72, 72, VT + rn0 * 16 * 72, 72, L, fr, fq);
      if constexpr (!SAMPLE) {
          bf16_t* PP = (bf16_t*)(F.ws + WS_PP) + ((size_t)c * 16 + h) * 4096; bf16_t* QQ = (bf16_t*)(F.ws + WS_QQ) + ((size_t)c * 16 + h) * 4096;
#pragma unroll
          for (int q = 0; q < 2; ++q) { const int n0 = (nt0 + q) * 16 + 4 * fq; u32x2 p; p.x = pk2(pp[0][q][0], pp[0][q][1]); p.y = pk2(pp[0][q][2], pp[0][q][3]);
              *(u32x2*)(PP + (mt * 16 + fr) * 64 + pperm(n0)) = p;
              p.x = pk2(qt[0][q][0], qt[0][q][1]); p.y = pk2(qt[0][q][2], qt[0][q][3]); *(u32x2*)(QQ + (mt * 16 + fr) * 64 + n0) = p; }
#pragma unroll
          for (int q = 0; q < TP5; ++q) { const size_t row = (size_t)(r0 + it * 16 + fr); const int n0 = (rn0 + q) * 16 + 4 * fq; u32x2 p;
              p.x = pk2(rp[0][q][0], rp[0][q][1]); p.y = pk2(rp[0][q][2], rp[0][q][3]); *(u32x2*)(RKV + row * 3072 + 1024 + h * 64 + n0) = p;
              p.x = pk2(y0[0][q][0], y0[0][q][1]); p.y = pk2(y0[0][q][2], y0[0][q][3]); *(u32x2*)(RKV + row * 3072 + h * 64 + n0) = p; }
      } else {
          __syncthreads();
          LAS bf16_t* PL = (LAS bf16_t*)(F.lds + RL_PL); LAS bf16_t* RLs = (LAS bf16_t*)(F.lds + RL_RL); LAS float* Y0L = (LAS float*)(F.lds + RL_Y0L); LAS float* QTL = (LAS float*)(F.lds + RL_QTL); LAS bf16_t* Sl = (LAS bf16_t*)(F.lds + RL_S);
#pragma unroll
          for (int q = 0; q < 2; ++q) { const int n0 = (nt0 + q) * 16 + 4 * fq; u32x2 p; p.x = pk2(pp[0][q][0], pp[0][q][1]); p.y = pk2(pp[0][q][2], pp[0][q][3]);
              *(LAS u32x2*)(PL + (mt * 16 + fr) * 72 + n0) = p; *(LAS f32x4*)(QTL + (mt * 16 + fr) * 68 + n0) = qt[0][q]; }
#pragma unroll
          for (int q = 0; q < TP5; ++q) { const int n0 = (rn0 + q) * 16 + 4 * fq; u32x2 p; p.x = pk2(rp[0][q][0], rp[0][q][1]); p.y = pk2(rp[0][q][2], rp[0][q][3]);
              *(LAS u32x2*)(RLs + (it * 16 + fr) * 72 + n0) = p; *(LAS f32x4*)(Y0L + (it * 16 + fr) * 68 + n0) = y0[0][q]; }
          const int sb = c - 256; const float* sin_ = F.in[I_SWKV] + (((size_t)m * 32 + sb) * 16 + h) * 4096; float* sout = F.out + O_WKVS + (((size_t)m * 32 + sb) * 16 + h) * 4096;
          for (int it2 = tid; it2 < 64 * 16; it2 += NT) { const int i = it2 >> 4, j4 = (it2 & 15) * 4; const f32x4 sv = *(const f32x4*)(sin_ + i * 64 + j4); u32x2 p; p.x = pk2(sv[0], sv[1]); p.y = pk2(sv[2], sv[3]); *(LAS u32x2*)(Sl + i * 72 + j4) = p; }
          __syncthreads();
          if (w < 2) { f32x4 y[1][4];
#pragma unroll
              for (int q = 0; q < 4; ++q) y[0][q] = *(const LAS f32x4*)(Y0L + (w * 16 + fr) * 68 + q * 16 + 4 * fq);
              wave_mm_nt<1, 4>(y, RLs + w * 16 * 72, 72, Sl, 72, 64, fr, fq);
              rwkv_out_epilogue(F, m, y[0], (size_t)(r0 + w * 16 + fr), h, fq); }
          else if (w < 6) { const int mi = w - 2; f32x4 tl[1][4];
#pragma unroll
              for (int q = 0; q < 4; ++q) { const int j = q * 16 + 4 * fq; const f32x4 sv = *(const f32x4*)(sin_ + (mi * 16 + fr) * 64 + j), gl4 = *(const LAS f32x4*)(GLV + j), qv = *(const LAS f32x4*)(QTL + (mi * 16 + fr) * 68 + j);
                  tl[0][q] = (f32x4){__expf(gl4[0]) * sv[0] + qv[0], __expf(gl4[1]) * sv[1] + qv[1], __expf(gl4[2]) * sv[2] + qv[2], __expf(gl4[3]) * sv[3] + qv[3]}; }
              wave_mm_nt<1, 4>(tl, Sl + mi * 16 * 72, 72, PL, 72, 64, fr, fq);
#pragma unroll
              for (int q = 0; q < 4; ++q) *(f32x4*)(sout + (mi * 16 + fr) * 64 + q * 16 + 4 * fq) = tl[0][q]; }
      }
    }
}

constexpr int SC_GRP = 4, SC_CH = 8192 + 2048 + 256, SC_BUF = SC_GRP * SC_CH;
__device__ __forceinline__ void rwkv_scan_phase(Frame& F, int layer) {
    const int tid = otid(); const int lane = tid & 63, m = layer >> 1; const int b = blockIdx.x;
    if (b >= 64) return;
    const int h = b >> 2, sl = b & 3;
    const unsigned char* PP = F.ws + WS_PP; const unsigned char* QQ = F.ws + WS_QQ; const unsigned char* GAM = F.ws + WS_GAM;
    constexpr int NV = SC_BUF / 16;
    constexpr int NPT = (NV + NT - 1) / NT;
    u32x4 st[NPT];
    auto issue = [&](int g) {
#pragma unroll
        for (int q = 0; q < NPT; ++q) { const int v = tid + q * NT; if (v < NV) { const int cc = v / (SC_CH / 16), o = (v % (SC_CH / 16)) * 16; const size_t ch = (size_t)(g * SC_GRP + cc) * 16 + h;
                const unsigned char* src = (o < 8192) ? PP + ch * 8192 + o : (o < 10240) ? QQ + ch * 8192 + (size_t)sl * 2048 + (o - 8192) : GAM + ch * 256 + (o - 10240);
                st[q] = *(const u32x4*)src; } } };
    auto commit = [&](int buf) {
#pragma unroll
        for (int q = 0; q < NPT; ++q) { const int v = tid + q * NT; if (v < NV) *(LAS u32x4*)(F.lds + buf * SC_BUF + v * 16) = st[q]; } };
    const int ci = lane & 15, q4 = lane >> 4, i = 16 * sl + ci;
    f32x4 T[4];
#pragma unroll
    for (int mm = 0; mm < 4; ++mm) T[mm] = (f32x4){0.f, 0.f, 0.f, 0.f};
    bf16_t* TST = (bf16_t*)(F.ws + WS_TST);
    issue(0); commit(0);
    constexpr int NG = 256 / SC_GRP;
    for (int g = 0; g < NG; ++g) {
        if (g + 1 < NG) issue(g + 1);
        __syncthreads();
        if (F.wave == 0) {
            const LAS unsigned char* base = F.lds + (g & 1) * SC_BUF;
#pragma unroll 1
            for (int cc = 0; cc < SC_GRP; ++cc) { const int c = g * SC_GRP + cc; const LAS unsigned char* cb = base + cc * SC_CH;
                bf16_t* tdst = TST + (((size_t)c * 16 + h) * 64 + i) * 64;
                bf16x8 Tf[2];
#pragma unroll
                for (int mm = 0; mm < 4; ++mm) { u32x2 p; p.x = pk2(T[mm][0], T[mm][1]); p.y = pk2(T[mm][2], T[mm][3]); *(u32x2*)(tdst + 16 * mm + 4 * q4) = p;
                    Tf[mm >> 1][(mm & 1) * 4 + 0] = (short)(p.x & 0xffffu); Tf[mm >> 1][(mm & 1) * 4 + 1] = (short)(p.x >> 16); Tf[mm >> 1][(mm & 1) * 4 + 2] = (short)(p.y & 0xffffu); Tf[mm >> 1][(mm & 1) * 4 + 3] = (short)(p.y >> 16); }
#pragma unroll
                for (int mm = 0; mm < 4; ++mm) { const int j = 16 * mm + 4 * q4; const f32x4 gv = *(const LAS f32x4*)(cb + 10240 + j * 4); const u32x2 qv = *(const LAS u32x2*)(cb + 8192 + (ci * 64 + j) * 2);
                    f32x4 acc = (f32x4){gv[0] * T[mm][0] + bflo(qv.x), gv[1] * T[mm][1] + bfhi(qv.x), gv[2] * T[mm][2] + bflo(qv.y), gv[3] * T[mm][3] + bfhi(qv.y)};
#pragma unroll
                    for (int s = 0; s < 2; ++s) { const bf16x8 pf = *(const LAS bf16x8*)(cb + ((16 * mm + ci) * 64 + 32 * s + 8 * q4) * 2); acc = __builtin_amdgcn_mfma_f32_16x16x32_bf16(pf, Tf[s], acc, 0, 0, 0); }
                    T[mm] = acc; } }
        }
        __syncthreads();
        if (g + 1 < NG) commit((g + 1) & 1);
    }
    if (F.wave == 0) { float* outp = F.out + O_WKVP + ((size_t)m * 16 + h) * 4096 + (size_t)i * 64;
#pragma unroll
        for (int mm = 0; mm < 4; ++mm) *(f32x4*)(outp + 16 * mm + 4 * q4) = T[mm]; }
}

__device__ __forceinline__ void rwkv_output_phase(Frame& F, int layer) {
    const int tid = otid(); const int lane = tid & 63, fr = lane & 15, fq = lane >> 4, m = layer >> 1;
    const bf16_t* RKV = (const bf16_t*)(F.ws + WS_RKV); const bf16_t* TST = (const bf16_t*)(F.ws + WS_TST);
    const int gw = F.vcu * NWAVES + F.wave, NGW = F.G * NWAVES;
    for (int u = gw; u < 256 * 16 * 4; u += NGW) { const int it = u & 3, h = (u >> 2) & 15, c = u >> 6;
        const size_t row = (size_t)(64 * c + 16 * it + fr); const bf16_t* ts = TST + ((size_t)c * 16 + h) * 4096;
        f32x4 y[4];
#pragma unroll
        for (int nt = 0; nt < 4; ++nt) { const u32x2 yv = *(const u32x2*)(RKV + row * 3072 + h * 64 + 16 * nt + 4 * fq); y[nt] = (f32x4){bflo(yv.x), bfhi(yv.x), bflo(yv.y), bfhi(yv.y)}; }
#pragma unroll
        for (int s = 0; s < 2; ++s) { const bf16x8 xa = *(const bf16x8*)(RKV + row * 3072 + 1024 + h * 64 + 32 * s + 8 * fq);
#pragma unroll
            for (int nt = 0; nt < 4; ++nt) { const bf16x8 yb = *(const bf16x8*)(ts + (16 * nt + fr) * 64 + 32 * s + 8 * fq); y[nt] = __builtin_amdgcn_mfma_f32_16x16x32_bf16(yb, xa, y[nt], 0, 0, 0); } }
        rwkv_out_epilogue(F, m, y, row, h, fq);
    }
}

#define GRID_BAR() xcd_barrier(bar)
#ifndef PHASE_MASK
#define PHASE_MASK 0xffffffffu
#endif
#define PH(k) if (PHASE_MASK & (1u << (k)))
template <int layer> __device__ __forceinline__ void layer_body(Frame& F, const XcdBarrier& bar) {
    unsigned char* ws = F.ws; unsigned char* ar = ws + WS_ARENA;
    bf16_t* XN = (bf16_t*)(ws + WS_XN);
    const float* MOD = (const float*)(ws + WS_MOD);
    constexpr int m = layer >> 1; const float* modl = MOD + (size_t)layer * NSEQ * 6144;
    PH(1) if (layer > 0) convert_layer_weights(F, layer);
    if constexpr ((layer & 1) == 0) {
        PH(2) norm_pass<0>(F, layer);
        GRID_BAR();
        PH(3) { using GC = pg8::Geo<D, D, D, 30, 0, 1 << 20, 0>; pg8::Gemm<GC> g{XN, (const bf16_t*)(ar + AR_WIN), nullptr}; pg8::StaticOrder S; S.init(M, ABIN, F.G, (int)blockIdx.x);
          pg8::EpiBf16<0> E{(bf16_t*)(ws + WS_Z), ABIN};
          pg8::gemm_phase<pg8::EpiBf16<0>, pg8::StaticOrder, GC, true, true>(F.lds, g, S, E); }
        GRID_BAR();
        PH(4) for (int u = F.vcu; u < NCHUNK * 8; u += F.G) { const int c = u >> 3, hh = u & 7;
            if (c < 256) { if (hh < 4) ab_summary_unit<64, false>(F, layer, c, hh); else ab_summary_unit<64, true>(F, layer, c, hh - 4); }
            else { if (hh < 4) ab_summary_unit<32, false>(F, layer, c, hh); else ab_summary_unit<32, true>(F, layer, c, hh - 4); } }
        GRID_BAR();
        PH(5) ab_scan(F, layer);
        GRID_BAR();
        PH(6) for (int u = F.vcu; u < NCHUNK * 8; u += F.G) { const int c = u >> 3, hh = u & 7;
            if (c < 256) { if (hh < 4) ab_output_unit<64, false>(F, layer, c, hh); else ab_output_unit<64, true>(F, layer, c, hh - 4); }
            else { if (hh < 4) ab_output_unit<32, false>(F, layer, c, hh); else ab_output_unit<32, true>(F, layer, c, hh - 4); } }
        GRID_BAR();
        PH(7) { using GC = pg8::Geo<D, D, D, 30, 0, 1 << 20, 0>; pg8::Gemm<GC> g{XN, (const bf16_t*)(ar + AR_WOUT), nullptr}; pg8::StaticOrder S; S.init(M, D, F.G, (int)blockIdx.x);
          pg8::EpiRes E{F.out, modl, 2048};
          pg8::gemm_phase<pg8::EpiRes, pg8::StaticOrder, GC, true, true>(F.lds, g, S, E); }
        GRID_BAR();
    } else {
        PH(8) norm_pass<1>(F, layer);
        GRID_BAR();
        PH(9) { using GC = pg8::Geo<D, 2048, 2048, 30, 0, 16, -4096>; pg8::Gemm<GC> g{XN, (const bf16_t*)(ar + AR_WC1), (const bf16_t*)(ws + WS_PREVS)}; pg8::StaticOrder S; S.init(M, 4096, F.G, (int)blockIdx.x);
          pg8::EpiRkv E{(bf16_t*)(ws + WS_RKV), (bf16_t*)(ws + WS_LO), (m == 0) ? (bf16_t*)(ws + WS_VFIRST) : nullptr};
          pg8::gemm_phase<pg8::EpiRkv, pg8::StaticOrder, GC, true, true>(F.lds, g, S, E); }
        GRID_BAR();
        PH(10) { using GC = pg8::Geo<D, 256, 256, 2, 256, 1 << 20, 0>; pg8::Gemm<GC> g{(const bf16_t*)(ws + WS_LO), (const bf16_t*)(ar + AR_WC2), nullptr}; pg8::StaticOrder S; S.init(M, 4096, F.G, (int)blockIdx.x);
          pg8::EpiLora2 E{(bf16_t*)(ws + WS_WLOG), XN, (bf16_t*)(ws + WS_G), (bf16_t*)(ws + WS_RKV), (m == 1) ? (const bf16_t*)(ws + WS_VFIRST) : nullptr,
                          F.in[I_RW0] + m * D, F.in[I_RA0] + m * D, F.in[I_RV0]};
          pg8::gemm_phase<pg8::EpiLora2, pg8::StaticOrder, GC, true, true>(F.lds, g, S, E); }
        GRID_BAR();
        PH(11) for (int u = F.vcu; u < NCHUNK * 16; u += F.G) { const int c = u >> 4, hh = u & 15; if (c < 256) rwkv_local_unit<64>(F, layer, c, hh); else rwkv_local_unit<32>(F, layer, c, hh); }
        GRID_BAR();
        PH(17) rwkv_scan_phase(F, layer);
        GRID_BAR();
        PH(18) rwkv_output_phase(F, layer);
        GRID_BAR();
        PH(12) { using GC = pg8::Geo<3072, D, D, 30, 0, 1 << 20, 0>; pg8::Gemm<GC> g{(const bf16_t*)(ws + WS_RKV), (const bf16_t*)(ar + AR_WO), nullptr}; pg8::StaticOrder S; S.init(M, D, F.G, (int)blockIdx.x);
          pg8::EpiRes E{F.out, modl, 2048};
          pg8::gemm_phase<pg8::EpiRes, pg8::StaticOrder, GC, true, true>(F.lds, g, S, E); }
        GRID_BAR();
    }
    PH(13) norm_pass<2>(F, layer);
    GRID_BAR();
    PH(14) { using GC = pg8::Geo<D, D, D, 30, 0, 1 << 20, 0>; pg8::Gemm<GC> g{XN, (const bf16_t*)(ar + AR_W1), nullptr}; pg8::StaticOrder S; S.init(M, DFF, F.G, (int)blockIdx.x);
      pg8::EpiBf16<1> E{(bf16_t*)(ws + WS_H), DFF};
      pg8::gemm_phase<pg8::EpiBf16<1>, pg8::StaticOrder, GC, true, true>(F.lds, g, S, E); }
    GRID_BAR();
    PH(15) { using GC = pg8::Geo<DFF, DFF, DFF, 30, 0, 1 << 20, 0>; pg8::Gemm<GC> g{(const bf16_t*)(ws + WS_H), (const bf16_t*)(ar + AR_W2), nullptr}; pg8::StaticOrder S; S.init(M, D, F.G, (int)blockIdx.x);
      pg8::EpiRes E{F.out, modl, 5120};
      pg8::gemm_phase<pg8::EpiRes, pg8::StaticOrder, GC, true, true>(F.lds, g, S, E); }
    GRID_BAR();
}

__global__ void __launch_bounds__(NT, 2) fwd_kernel(Args args) {
    extern __shared__ __attribute__((aligned(16))) unsigned char lds[];
    Frame F;
    F.lds = (LAS unsigned char*)lds; F.MISC = (volatile LAS unsigned*)(F.lds + MISC_OFF);
    F.wave = __builtin_amdgcn_readfirstlane(threadIdx.x >> 6);
    F.G = gridDim.x; { const int bx = blockIdx.x; F.vcu = (F.G % 8 == 0) ? (bx % 8) * (F.G / 8) + bx / 8 : bx; }
    F.in = args.in; F.out = args.out; F.ws = args.ws;
    for (int u = threadIdx.x; u < (LDS_BYTES - LDSCTL_OFF) / 4; u += NT) ((LAS unsigned*)(F.lds + LDSCTL_OFF))[u] = 0u;
    __syncthreads();
    XcdBarrier bar = xcd_barrier_post((unsigned*)(F.ws + WS_CTL) + CW_BAR, F.MISC + 8);
    PH(0) prologue(F);
    GRID_BAR();
    PH(0) mod_phase(F);
    GRID_BAR();
    layer_body<0>(F, bar); layer_body<1>(F, bar); layer_body<2>(F, bar); layer_body<3>(F, bar);
    PH(16) norm_pass<3>(F, 0);
}

extern "C" void kernel_launch(void* const* d_in, const int* in_sizes, int n_in, void* d_out, int out_size, void* d_ws, size_t ws_size, hipStream_t stream) {
    static int grid = 0;
    if (grid == 0) {
        if (n_in != 38 || out_size != 28706816 || ws_size < WS_END) { fprintf(stderr, "kernel_launch: unexpected problem (n_in %d, out %d, ws %zu; need ws >= %zu)\n", n_in, out_size, ws_size, (size_t)WS_END); grid = -1; return; }
        int dev = 0, cus = 0, per_cu = 0;
        if (hipGetDevice(&dev) != hipSuccess || hipDeviceGetAttribute(&cus, hipDeviceAttributeMultiprocessorCount, dev) != hipSuccess) { grid = -1; return; }
        if (hipFuncSetAttribute((const void*)fwd_kernel, hipFuncAttributeMaxDynamicSharedMemorySize, LDS_BYTES) != hipSuccess) { fprintf(stderr, "kernel_launch: hipFuncSetAttribute failed\n"); grid = -1; return; }
        if (hipOccupancyMaxActiveBlocksPerMultiprocessor(&per_cu, (const void*)fwd_kernel, NT, LDS_BYTES) != hipSuccess || per_cu < 1) { fprintf(stderr, "kernel_launch: occupancy query says %d\n", per_cu); per_cu = 1; }
        (void)hipGetLastError();
        grid = cus;
    }
    if (grid < 0) return;
    (void)hipMemsetAsync((char*)d_ws + WS_CTL, 0, ZERO_BYTES, stream);
    Args a{};
    for (int i = 0; i < 38; ++i) a.in[i] = (const float*)d_in[i];
    a.out = (float*)d_out; a.ws = (unsigned char*)d_ws;
    void* kargs[] = {&a};
    hipError_t e = hipLaunchCooperativeKernel((const void*)fwd_kernel, dim3(grid), dim3(NT), kargs, LDS_BYTES, stream);
    if (e != hipSuccess) fprintf(stderr, "kernel_launch: cooperative launch failed: %s (grid %d)\n", hipGetErrorString(e), grid);
}
```

```cpp
#include <hip/hip_runtime.h>
#include <cstdio>
#include <cstdint>

#define LAS __attribute__((address_space(3)))
#define GAS __attribute__((address_space(1)))
typedef unsigned short bf16_t;
typedef short bf16x8 __attribute__((ext_vector_type(8)));
typedef float f32x4 __attribute__((ext_vector_type(4)));
typedef float f32x2 __attribute__((ext_vector_type(2)));
typedef unsigned u32x4 __attribute__((ext_vector_type(4)));
typedef unsigned u32x2 __attribute__((ext_vector_type(2)));

#ifndef LOCAL_SKIP
#define LOCAL_SKIP 0
#endif
constexpr int D = 1024, MP = 16384, MS = 1024, M = MP + MS, NSEQ = 33, DFF = 4096, ABIN = 3584;
constexpr int NCHUNK = 288;
constexpr int SLOT_E = 4 * 8192 + 4 * 16384;
constexpr float NORM_EPS = 1e-6f, RW_LN_EPS = 64e-5f;

constexpr size_t MiB = 1u << 20;
constexpr size_t WS_CTL = 0, WS_MOD = 1 * MiB, ZERO_BYTES = 65536;
constexpr size_t WS_ROPE = 5 * MiB;
constexpr size_t WS_ARENA = 10 * MiB;
constexpr size_t AR_W1 = 0, AR_W2 = 8 * MiB, AR_WIN = 16 * MiB, AR_WOUT = 23 * MiB, AR_WC1 = 16 * MiB, AR_WC2 = 32 * MiB, AR_WO = 34 * MiB;
constexpr size_t WS_VFIRST = 46 * MiB;
constexpr size_t WS_XN0 = 80 * MiB, WS_XN = WS_XN0 + 2048;
constexpr size_t WS_PREVS = 115 * MiB;
constexpr size_t WS_R1 = 118 * MiB;
constexpr size_t WS_Z = WS_R1, WS_STATE = WS_R1 + 120 * MiB, WS_DEC = WS_R1 + 174 * MiB;
constexpr size_t WS_H = WS_R1;
constexpr size_t WS_RKV = WS_R1, WS_LO = WS_R1 + 102 * MiB, WS_WLOG = WS_R1 + 136 * MiB, WS_G = WS_R1 + 170 * MiB;
constexpr size_t WS_TST = WS_R1 + 102 * MiB;
constexpr size_t WS_REC = WS_R1 + 204 * MiB, WS_BON = WS_R1 + 269 * MiB;
constexpr int REC_B = 16640;
constexpr size_t WS_END = WS_R1 + 271 * MiB;

__device__ const double ROPE_REV[32] = {0.15915494309189535, 0.11934937021124886, 0.089499401608891013, 0.067115083005227255, 0.050329212104487035, 0.037741584717419771, 0.028302195830623399, 0.02122365276477766, 0.015915494309189534, 0.011934937021124886, 0.0089499401608891024, 0.0067115083005227253, 0.0050329212104487037, 0.0037741584717419772, 0.0028302195830623399, 0.0021223652764777662, 0.0015915494309189536, 0.0011934937021124885, 0.00089499401608891024, 0.0006711508300522726, 0.00050329212104487033, 0.00037741584717419774, 0.00028302195830623395, 0.00021223652764777661, 0.00015915494309189535, 0.00011934937021124886, 8.9499401608891018e-05, 6.7115083005227254e-05, 5.0329212104487035e-05, 3.7741584717419777e-05, 2.8302195830623396e-05, 2.1223652764777659e-05};

__device__ __forceinline__ unsigned f2bf(float f) { unsigned u = __builtin_bit_cast(unsigned, f); return (u + 0x7fffu + ((u >> 16) & 1u)) >> 16; }
typedef __bf16 bf16x2_t __attribute__((ext_vector_type(2)));
__device__ __forceinline__ unsigned pk2(float lo, float hi) { const f32x2 v = {lo, hi}; const bf16x2_t b = __builtin_convertvector(v, bf16x2_t); return __builtin_bit_cast(unsigned, b); }
__device__ __forceinline__ float bf2f(unsigned short b) { return __builtin_bit_cast(float, (unsigned)b << 16); }
__device__ __forceinline__ float bflo(unsigned w) { return __builtin_bit_cast(float, w << 16); }
__device__ __forceinline__ float bfhi(unsigned w) { return __builtin_bit_cast(float, w & 0xffff0000u); }
__device__ __forceinline__ float sigmoidf_(float x) { return 1.f / (1.f + __expf(-x)); }
__device__ __forceinline__ float siluf_(float x) { return x / (1.f + __expf(-x)); }
__device__ __forceinline__ float wave_sum(float v) {
#pragma unroll
    for (int o = 1; o < 64; o <<= 1) v += __shfl_xor(v, o);
    return v;
}
__device__ __forceinline__ int otid() { int t = threadIdx.x; asm volatile("" : "+v"(t)); return t; }
__device__ __forceinline__ int seq_of_row(int r) { return r < MP ? 0 : 1 + ((r - MP) >> 5); }
#define LDS_WAIT() asm volatile("s_waitcnt lgkmcnt(0)" ::: "memory")
#define VM_WAIT() asm volatile("s_waitcnt vmcnt(0)" ::: "memory")

namespace pg8 {
constexpr int BM = 256, BK = 64, HALF = 128, HTB = HALF * BK * 2, STAGE_BYTES = 8 * HTB, NXCD = 8, WGM = 8;
__host__ __device__ __forceinline__ int lds_byte(int r, int c) { const int st = (r >> 4) * 2 + (c >> 5), rr = r & 15, cc = c & 31, ob = rr * 64 + cc * 2; return st * 1024 + (ob ^ (((ob >> 9) & 1) << 5)); }
__host__ __device__ __forceinline__ void stage_rc(int b, int& R, int& C) { const int st = b / 1024, sb = b % 1024, swz = sb ^ (((sb >> 9) & 1) << 5); R = (st >> 1) * 16 + swz / 64; C = (st & 1) * 32 + (swz % 64) / 2; }
__host__ __device__ __forceinline__ int perm32(int rho) { const int n = rho >> 4, i = rho & 15; return 8 * (i >> 2) + 4 * n + (i & 3); }

struct Unit { int pm, pn; };
template <int LDA_, int LDB_, int K_, int GSHIFT_, int GSTRIDE_, int KSPLIT_, int DELTAP_> struct Geo {
    static constexpr int LDA = LDA_, LDB = LDB_, K = K_, GSHIFT = GSHIFT_, GSTRIDE = GSTRIDE_, KSPLIT = KSPLIT_, DELTAP = DELTAP_;
};
template <class GC> struct Gemm {
    const bf16_t* A; const bf16_t* Bt; const bf16_t* A2s;
    __device__ __forceinline__ const char* a_base(const Unit& u) const { return (const char*)(A + (size_t)u.pm * BM * GC::LDA + (size_t)(u.pn >> GC::GSHIFT) * GC::GSTRIDE); }
    __device__ __forceinline__ long a_delta(const Unit& u) const {
        if constexpr (GC::KSPLIT >= GC::K / BK) return 0;
        else { if (u.pm < 64) return (long)GC::DELTAP;
            return (long)((const char*)(A2s + (size_t)(u.pm - 64) * BM * GC::LDA) - a_base(u)) - (long)GC::KSPLIT * BK * 2; }
    }
};
struct StaticOrder {
    int nM, nN, nwg, G, c;
    __host__ __device__ void init(int M_, int N_, int G_, int c_) { nM = M_ / BM; nN = N_ / BM; nwg = nM * nN; G = G_; c = c_; }
    __host__ __device__ bool next(int i, Unit& u) const {
        const long L = (long)i * G + c; if (L >= nwg) return false;
        int wgid = (int)L; { const int q = nwg / NXCD, r = nwg % NXCD, xcd = wgid % NXCD, off = wgid / NXCD; wgid = (xcd < r ? xcd * (q + 1) : r * (q + 1) + (xcd - r) * q) + off; }
        const int nig = WGM * nN, gid = wgid / nig, fm = gid * WGM, gsz = (nM - fm) < WGM ? (nM - fm) : WGM;
        u.pm = fm + ((wgid % nig) % gsz); u.pn = (wgid % nig) / gsz; return true;
    }
};
__device__ __forceinline__ unsigned cvt_pk_bf16(float lo, float hi) { return pk2(lo, hi); }

template <class Epi, class Sched, class GC, bool ALIGN_EPI = false, bool SP2 = false>
__device__ __forceinline__ void gemm_phase(LAS unsigned char* lds, const Gemm<GC> g, const Sched& S, const Epi& E) {
    const int tid = otid(), wid = __builtin_amdgcn_readfirstlane(tid >> 6), lane = tid & 63, wr = wid >> 2, wc = wid & 3, fr = lane & 15, fq = lane >> 4;
    constexpr int K = GC::K, nt = K / BK, ksplit = GC::KSPLIT;
    unsigned voffA[2], voffB[2];
#pragma unroll
    for (int i = 0; i < 2; ++i) { int R, C; stage_rc(tid * 16 + i * 8192, R, C); const int Rb = Epi::PERM ? ((R & ~31) + perm32(R & 31)) : R;
        voffA[i] = (unsigned)(R * GC::LDA + C) * 2u; voffB[i] = (unsigned)(Rb * GC::LDB + C) * 2u; }
    constexpr size_t kstep = (size_t)(BK * 2);
    constexpr size_t hstepA = (size_t)HALF * GC::LDA * 2, hstepB = (size_t)HALF * GC::LDB * 2;
    constexpr size_t tstepB = 2 * hstepB;
    const unsigned ldsw = (unsigned)wid * 1024u;
    const int aoff = lds_byte(wr * 64 + fr, fq * 8), boff = lds_byte(wc * 32 + fr, fq * 8);
#define PG8_SA(b, h) (((b) * 2 + (h)) * HTB)
#define PG8_SB(b, h) ((4 + (b) * 2 + (h)) * HTB)
#define PG8_STAGE(bufoff, gbase, voff) do { _Pragma("unroll") for (int _i = 0; _i < 2; ++_i) \
        __builtin_amdgcn_global_load_lds((const unsigned*)((const char*)(gbase) + (voff)[_i]), (LAS unsigned*)(lds + (bufoff) + ldsw + _i * 8192), 16, 0, 0); } while (0)
#define PG8_LDA(dst, b, h) do { _Pragma("unroll") for (int m = 0; m < 4; ++m) _Pragma("unroll") for (int k = 0; k < 2; ++k) dst[m][k] = *(const LAS bf16x8*)(lds + PG8_SA(b, h) + aoff + m * 2048 + k * 1024); } while (0)
#define PG8_LDB(dst, b, h) do { _Pragma("unroll") for (int n = 0; n < 2; ++n) _Pragma("unroll") for (int k = 0; k < 2; ++k) dst[n][k] = *(const LAS bf16x8*)(lds + PG8_SB(b, h) + boff + n * 2048 + k * 1024); } while (0)
#define PG8_MMA(ai, bj, At, Bt) do { __builtin_amdgcn_s_setprio(1); _Pragma("unroll") for (int m = 0; m < 4; ++m) _Pragma("unroll") for (int n = 0; n < 2; ++n) _Pragma("unroll") for (int k = 0; k < 2; ++k) \
        acc[ai][bj][m][n] = __builtin_amdgcn_mfma_f32_16x16x32_bf16(Bt[n][k], At[m][k], acc[ai][bj][m][n], 0, 0, 0); __builtin_amdgcn_s_setprio(0); } while (0)
#define PG8_WAIT_V(n) asm volatile("s_waitcnt vmcnt(" #n ")" ::: "memory")
#define PG8_WAIT_L(n) asm volatile("s_waitcnt lgkmcnt(" #n ")" ::: "memory")
#define PG8_BAR __builtin_amdgcn_s_barrier()
#define PG8_SCHED __builtin_amdgcn_sched_barrier(0)
    Unit cur, nxt; int ui = 0;
    if (!S.next(0, cur)) return;
    f32x4 acc[2][2][4][2];
#pragma unroll
    for (int a = 0; a < 2; ++a)
#pragma unroll
        for (int b = 0; b < 2; ++b)
#pragma unroll
            for (int m = 0; m < 4; ++m)
#pragma unroll
                for (int n = 0; n < 2; ++n) acc[a][b][m][n] = (f32x4){0.f, 0.f, 0.f, 0.f};
    bf16x8 At[4][2], B0[2][2], B1[2][2];
    const char* cA = g.a_base(cur); const char* cB = (const char*)g.Bt + (size_t)cur.pn * tstepB; long cD = g.a_delta(cur);
    if constexpr (SP2) {
        PG8_STAGE(PG8_SB(0, 0), cB, voffB); PG8_STAGE(PG8_SB(0, 1), cB + hstepB, voffB); PG8_STAGE(PG8_SA(0, 0), cA, voffA); PG8_STAGE(PG8_SA(0, 1), cA + hstepA, voffA);
        if (wr == 1) PG8_BAR;
        PG8_WAIT_V(2); PG8_BAR;
        PG8_STAGE(PG8_SB(1, 0), cB + kstep, voffB); PG8_STAGE(PG8_SA(1, 0), cA + kstep, voffA); PG8_STAGE(PG8_SB(1, 1), cB + hstepB + kstep, voffB);
        PG8_WAIT_V(6); PG8_BAR;
    } else {
        PG8_STAGE(PG8_SB(0, 0), cB, voffB); PG8_STAGE(PG8_SA(0, 0), cA, voffA); PG8_STAGE(PG8_SB(0, 1), cB + hstepB, voffB); PG8_STAGE(PG8_SA(0, 1), cA + hstepA, voffA);
        if (wr == 1) PG8_BAR;
        PG8_WAIT_V(4); PG8_BAR;
        PG8_STAGE(PG8_SB(1, 0), cB + kstep, voffB); PG8_STAGE(PG8_SA(1, 0), cA + kstep, voffA); PG8_STAGE(PG8_SB(1, 1), cB + hstepB + kstep, voffB);
        PG8_WAIT_V(6); PG8_BAR;
    }
    for (;;) {
        const bool has_next = S.next(ui + 1, nxt);
        const char* nA = has_next ? g.a_base(nxt) : cA; const char* nB = has_next ? (const char*)g.Bt + (size_t)nxt.pn * tstepB : cB;
        const long nD = has_next ? g.a_delta(nxt) : cD;
#pragma unroll 1
        for (int t = 0; t < nt; t += 2) {
            const bool last = (t == nt - 2);
            const char* a1 = cA + (size_t)(t + 1) * kstep + (t >= ksplit ? cD : 0);
            const char* a2 = last ? nA : cA + (size_t)(t + 2) * kstep + (t + 2 >= ksplit ? cD : 0); const char* b2 = last ? nB : cB + (size_t)(t + 2) * kstep;
            const char* a3 = a2 + kstep; const char* b3 = b2 + kstep;
            if constexpr (SP2) {
            PG8_LDB(B0, 0, 0); PG8_LDB(B1, 0, 1); PG8_SCHED; PG8_LDA(At, 0, 0); PG8_STAGE(PG8_SA(1, 1), a1 + hstepA, voffA);
            PG8_WAIT_V(8); PG8_WAIT_L(0); PG8_BAR; PG8_MMA(0, 0, At, B0); PG8_MMA(0, 1, At, B1); PG8_BAR; PG8_SCHED;
            PG8_LDA(At, 0, 1); PG8_STAGE(PG8_SB(0, 0), b2, voffB); PG8_STAGE(PG8_SB(0, 1), b2 + hstepB, voffB); PG8_STAGE(PG8_SA(0, 0), a2, voffA);
            PG8_WAIT_V(8); PG8_WAIT_L(0); PG8_BAR; PG8_MMA(1, 0, At, B0); PG8_MMA(1, 1, At, B1); PG8_BAR; PG8_SCHED;
            PG8_LDB(B0, 1, 0); PG8_LDB(B1, 1, 1); PG8_SCHED; PG8_LDA(At, 1, 0); PG8_STAGE(PG8_SA(0, 1), a2 + hstepA, voffA);
            PG8_WAIT_V(8); PG8_WAIT_L(0); PG8_BAR; PG8_MMA(0, 0, At, B0); PG8_MMA(0, 1, At, B1); PG8_BAR; PG8_SCHED;
            PG8_LDA(At, 1, 1); PG8_STAGE(PG8_SB(1, 0), b3, voffB); PG8_STAGE(PG8_SB(1, 1), b3 + hstepB, voffB); PG8_STAGE(PG8_SA(1, 0), a3, voffA);
            PG8_WAIT_V(8); PG8_WAIT_L(0); PG8_BAR; PG8_MMA(1, 0, At, B0); PG8_MMA(1, 1, At, B1); PG8_BAR; PG8_SCHED;
            } else {
            PG8_LDB(B0, 0, 0); PG8_SCHED; PG8_LDA(At, 0, 0); PG8_STAGE(PG8_SA(1, 1), a1 + hstepA, voffA);
            PG8_WAIT_L(8); PG8_BAR; PG8_WAIT_L(0); PG8_MMA(0, 0, At, B0); PG8_BAR; PG8_SCHED;
            PG8_LDB(B1, 0, 1); PG8_STAGE(PG8_SB(0, 0), b2, voffB);
            PG8_BAR; PG8_WAIT_L(0); PG8_MMA(0, 1, At, B1); PG8_BAR;
            PG8_LDA(At, 0, 1); PG8_STAGE(PG8_SA(0, 0), a2, voffA);
            PG8_BAR; PG8_WAIT_L(0); PG8_MMA(1, 0, At, B0); PG8_BAR; PG8_SCHED;
            PG8_STAGE(PG8_SB(0, 1), b2 + hstepB, voffB);
            PG8_WAIT_V(6); PG8_BAR; PG8_MMA(1, 1, At, B1); PG8_BAR;
            PG8_LDB(B0, 1, 0); PG8_SCHED; PG8_LDA(At, 1, 0); PG8_STAGE(PG8_SA(0, 1), a2 + hstepA, voffA);
            PG8_WAIT_L(8); PG8_BAR; PG8_WAIT_L(0); PG8_MMA(0, 0, At, B0); PG8_BAR; PG8_SCHED;
            PG8_LDB(B1, 1, 1); PG8_STAGE(PG8_SB(1, 0), b3, voffB);
            PG8_BAR; PG8_WAIT_L(0); PG8_MMA(0, 1, At, B1); PG8_BAR;
            PG8_LDA(At, 1, 1); PG8_STAGE(PG8_SA(1, 0), a3, voffA);
            PG8_BAR; PG8_WAIT_L(0); PG8_MMA(1, 0, At, B0); PG8_BAR; PG8_SCHED;
            PG8_STAGE(PG8_SB(1, 1), b3 + hstepB, voffB);
            PG8_WAIT_V(6); PG8_BAR; PG8_MMA(1, 1, At, B1); PG8_BAR;
            }
        }
        if constexpr (ALIGN_EPI) { if (wr == 0) PG8_BAR; }
        E(acc, cur, wr, wc, fr, fq);
        if (!has_next) break;
#pragma unroll
        for (int a = 0; a < 2; ++a)
#pragma unroll
            for (int b = 0; b < 2; ++b)
#pragma unroll
                for (int m = 0; m < 4; ++m)
#pragma unroll
                    for (int n = 0; n < 2; ++n) acc[a][b][m][n] = (f32x4){0.f, 0.f, 0.f, 0.f};
        cur = nxt; cA = nA; cB = nB; cD = nD; ++ui;
        if constexpr (ALIGN_EPI) { if (wr == 1) PG8_BAR; }
    }
    PG8_WAIT_V(0);
    if constexpr (!ALIGN_EPI) { if (wr == 0) PG8_BAR; }
    PG8_BAR;
#undef PG8_SA
#undef PG8_SB
#undef PG8_STAGE
#undef PG8_LDA
#undef PG8_LDB
#undef PG8_MMA
#undef PG8_WAIT_V
#undef PG8_WAIT_L
#undef PG8_BAR
#undef PG8_SCHED
}

__device__ __forceinline__ float act_apply(float v, int act) {
    if (act == 1) { const float r = v > 0.f ? v : 0.f; return r * r; }
    if (act == 2) { const float e = __expf(-2.f * fabsf(v)); const float t = (1.f - e) / (1.f + e); return v < 0.f ? -t : t; }
    if (act == 3) return 1.f / (1.f + __expf(-v));
    return v;
}
template <int ACT> __device__ __forceinline__ void store_tile_bf16(const f32x4 (&acc)[2][2][4][2], bf16_t* base, int ldc, int row0, int col0, bf16_t* base2, int ldc2, int col2) {
#pragma unroll
    for (int ai = 0; ai < 2; ++ai)
#pragma unroll
        for (int m = 0; m < 4; ++m) { const size_t r = (size_t)(row0 + ai * HALF + m * 16);
#pragma unroll
            for (int bj = 0; bj < 2; ++bj) { f32x4 v0 = acc[ai][bj][m][0], v1 = acc[ai][bj][m][1];
#pragma unroll
                for (int q = 0; q < 4; ++q) { v0[q] = act_apply(v0[q], ACT); v1[q] = act_apply(v1[q], ACT); }
                u32x4 w; w.x = cvt_pk_bf16(v0[0], v0[1]); w.y = cvt_pk_bf16(v0[2], v0[3]); w.z = cvt_pk_bf16(v1[0], v1[1]); w.w = cvt_pk_bf16(v1[2], v1[3]);
                *(u32x4*)(base + r * ldc + col0 + bj * HALF) = w;
                if (base2) *(u32x4*)(base2 + r * ldc2 + col2 + bj * HALF) = w; } }
}
template <int ACT> struct EpiBf16 {
    static constexpr bool PERM = true;
    bf16_t* O; int ldc;
    __device__ __forceinline__ void operator()(const f32x4 (&acc)[2][2][4][2], const Unit& u, int wr, int wc, int fr, int fq) const {
        store_tile_bf16<ACT>(acc, O, ldc, u.pm * BM + wr * 64 + fr, u.pn * BM + wc * 32 + 8 * fq, nullptr, 0, 0);
    }
};
struct EpiRkv {
    static constexpr bool PERM = true;
    bf16_t* RKV; bf16_t* LO; bf16_t* vf;
    __device__ __forceinline__ void operator()(const f32x4 (&acc)[2][2][4][2], const Unit& u, int wr, int wc, int fr, int fq) const {
        const int row0 = u.pm * BM + wr * 64 + fr, cin = wc * 32 + 8 * fq;
        if (u.pn < 12) { bf16_t* b2 = (u.pn >= 8) ? vf : nullptr; store_tile_bf16<0>(acc, RKV, 3072, row0, u.pn * BM + cin, b2, 1024, (u.pn - 8) * BM + cin); }
        else if (u.pn == 12) store_tile_bf16<2>(acc, LO, 1024, row0, cin, nullptr, 0, 0);
        else if (u.pn == 15) store_tile_bf16<3>(acc, LO, 1024, row0, 768 + cin, nullptr, 0, 0);
        else store_tile_bf16<0>(acc, LO, 1024, row0, (u.pn - 12) * BM + cin, nullptr, 0, 0);
    }
};
struct EpiRes {
    static constexpr bool PERM = false;
    float* X; const float* modl; int goff;
    __device__ __forceinline__ void operator()(const f32x4 (&acc)[2][2][4][2], const Unit& u, int wr, int wc, int fr, int fq) const {
        const int col0 = u.pn * BM + wc * 32 + 4 * fq;
#pragma unroll
        for (int ai = 0; ai < 2; ++ai)
#pragma unroll
            for (int m = 0; m < 4; ++m) { const int r = u.pm * BM + ai * HALF + wr * 64 + m * 16 + fr; const float* gp = modl + (size_t)seq_of_row(r) * 6144 + goff + col0; float* xp = X + (size_t)r * D + col0;
#pragma unroll
                for (int bj = 0; bj < 2; ++bj)
#pragma unroll
                    for (int n = 0; n < 2; ++n) { const f32x4 gv = *(const f32x4*)(gp + bj * HALF + n * 16); f32x4 xv = *(f32x4*)(xp + bj * HALF + n * 16);
                        xv = xv + gv * acc[ai][bj][m][n]; *(f32x4*)(xp + bj * HALF + n * 16) = xv; }
                asm volatile("" ::: "memory"); }
    }
};
struct EpiLora2 {
    static constexpr bool PERM = false;
    bf16_t* WLOG; bf16_t* Aout; bf16_t* G; bf16_t* RKV; const bf16_t* vf; const float* w0; const float* a0; const float* v0;
    template <int GRP> __device__ __forceinline__ void run(const f32x4 (&acc)[2][2][4][2], const Unit& u, int wr, int wc, int fr, int fq) const {
        const int col0 = (u.pn & 3) * BM + wc * 32 + 4 * fq;
#pragma unroll
        for (int ai = 0; ai < 2; ++ai)
#pragma unroll
            for (int m = 0; m < 4; ++m) { const size_t r = (size_t)(u.pm * BM + ai * HALF + wr * 64 + m * 16 + fr);
#pragma unroll
                for (int bj = 0; bj < 2; ++bj)
#pragma unroll
                    for (int n = 0; n < 2; ++n) { const int c = col0 + bj * HALF + n * 16; const f32x4 a = acc[ai][bj][m][n]; f32x4 o;
                        if constexpr (GRP == 0) { const f32x4 b = *(const f32x4*)(w0 + c);
#pragma unroll
                            for (int q = 0; q < 4; ++q) { const float x = -(b[q] + a[q]); const float sp = fmaxf(x, 0.f) + __logf(1.f + __expf(-fabsf(x))); o[q] = -__expf(-sp - 0.5f); }
                            u32x2 w; w.x = cvt_pk_bf16(o[0], o[1]); w.y = cvt_pk_bf16(o[2], o[3]); *(u32x2*)(WLOG + r * D + c) = w; }
                        else if constexpr (GRP == 1) { const f32x4 b = *(const f32x4*)(a0 + c);
#pragma unroll
                            for (int q = 0; q < 4; ++q) o[q] = 1.f / (1.f + __expf(-(b[q] + a[q])));
                            u32x2 w; w.x = cvt_pk_bf16(o[0], o[1]); w.y = cvt_pk_bf16(o[2], o[3]); *(u32x2*)(Aout + r * D + c) = w; }
                        else if constexpr (GRP == 2) { const f32x4 b = *(const f32x4*)(v0 + c); const u32x2 vv = *(const u32x2*)(RKV + r * 3072 + 2048 + c), ff = *(const u32x2*)(vf + r * D + c);
                            f32x4 v4, f4; v4[0] = bflo(vv.x); v4[1] = bfhi(vv.x); v4[2] = bflo(vv.y); v4[3] = bfhi(vv.y); f4[0] = bflo(ff.x); f4[1] = bfhi(ff.x); f4[2] = bflo(ff.y); f4[3] = bfhi(ff.y);
#pragma unroll
                            for (int q = 0; q < 4; ++q) { const float gte = 1.f / (1.f + __expf(-(b[q] + a[q]))); o[q] = v4[q] + (f4[q] - v4[q]) * gte; }
                            u32x2 w; w.x = cvt_pk_bf16(o[0], o[1]); w.y = cvt_pk_bf16(o[2], o[3]); *(u32x2*)(RKV + r * 3072 + 2048 + c) = w; }
                        else { u32x2 w; w.x = cvt_pk_bf16(a[0], a[1]); w.y = cvt_pk_bf16(a[2], a[3]); *(u32x2*)(G + r * D + c) = w; } }
                asm volatile("" ::: "memory"); }
    }
    __device__ __forceinline__ void operator()(const f32x4 (&acc)[2][2][4][2], const Unit& u, int wr, int wc, int fr, int fq) const {
        const int grp = u.pn >> 2;
        if (grp == 0) run<0>(acc, u, wr, wc, fr, fq);
        else if (grp == 1) run<1>(acc, u, wr, wc, fr, fq);
        else if (grp == 2) { if (vf != nullptr) run<2>(acc, u, wr, wc, fr, fq); }
        else run<3>(acc, u, wr, wc, fr, fq);
    }
};
template <bool PERM_> struct EpiNull {
    static constexpr bool PERM = PERM_;
    __device__ __forceinline__ void operator()(const f32x4 (&acc)[2][2][4][2], const Unit&, int, int, int, int) const {
#pragma unroll
        for (int a = 0; a < 2; ++a)
#pragma unroll
            for (int b = 0; b < 2; ++b)
#pragma unroll
                for (int m = 0; m < 4; ++m)
#pragma unroll
                    for (int n = 0; n < 2; ++n) asm volatile("" :: "v"(acc[a][b][m][n]));
    }
};
}

#define RLX_AGENT __ATOMIC_RELAXED, __HIP_MEMORY_SCOPE_AGENT
#define XB_TMO      128
#define XB_XCNT(j)  (256  + 64 * (j))
#define XB_XSUB(j)  (1280 + 64 * (j))
#define XB_XGEN(j)  (2304 + 64 * (j))
#define XB_TOP      3328
#define XB_TOPGEN   3392
#define XCD_BAR_WORDS 3456
#define XB_SPIN_CAP (1u << 24)
__device__ __forceinline__ unsigned xb_ld(unsigned* p)              { return __hip_atomic_load(p, __ATOMIC_RELAXED, __HIP_MEMORY_SCOPE_AGENT); }
__device__ __forceinline__ unsigned xb_add(unsigned* p, unsigned v) { return __hip_atomic_fetch_add(p, v, __ATOMIC_RELAXED, __HIP_MEMORY_SCOPE_AGENT); }
__device__ __forceinline__ unsigned xb_xcc_id() { return (unsigned)__builtin_amdgcn_s_getreg((3 << 11) | 20) & 0xFu; }
#define XB_SPIN(cond, bar) do { unsigned _sp = 0; while (cond) { __builtin_amdgcn_s_sleep(4); \
    if ((++_sp & 255u) == 0u) { if (xb_ld(&(bar)[XB_TMO])) break; if (_sp > XB_SPIN_CAP) { atomicAdd(&(bar)[XB_TMO], 1u); break; } } } } while (0)
struct XcdBarrier { unsigned* bar; unsigned x; volatile LAS unsigned* st; };
__device__ __forceinline__ XcdBarrier xcd_barrier_post(unsigned* bar, volatile LAS unsigned* st) {
    XcdBarrier b; b.bar = bar; b.x = xb_xcc_id(); b.st = st;
    if (threadIdx.x == 0) (void)xb_add(&bar[XB_XCNT(b.x)], 1u);
    return b;
}
__device__ __forceinline__ void xcd_barrier_complete(unsigned* bar, unsigned x, unsigned& nloc, unsigned& nx) {
    const unsigned G = gridDim.x * gridDim.y * gridDim.z;
    unsigned sum, cnt, mine, sp = 0u;
    for (;;) {
        sum = 0u; cnt = 0u; mine = 0u;
#pragma unroll
        for (unsigned j = 0; j < 16; ++j) { const unsigned c = xb_ld(&bar[XB_XCNT(j)]); sum += c; cnt += (c > 0u) ? 1u : 0u; mine = (j == x) ? c : mine; }
        if (sum == G) break;
        __builtin_amdgcn_s_sleep(1);
        if ((++sp & 255u) == 0u) { if (xb_ld(&bar[XB_TMO])) break; if (sp > XB_SPIN_CAP) { atomicAdd(&bar[XB_TMO], 1u); break; } }
    }
    nloc = mine > 0u ? mine : 1u; nx = cnt > 0u ? cnt : 1u;
}
__device__ __forceinline__ void xcd_barrier(const XcdBarrier& b) {
    asm volatile("s_waitcnt vmcnt(0)" ::: "memory");
    __syncthreads();
    if (threadIdx.x == 0) {
        unsigned* bar = b.bar;
        __builtin_amdgcn_s_waitcnt(0);
        unsigned nloc = b.st[0], nx = b.st[1];
        if (nloc == 0u) { xcd_barrier_complete(bar, b.x, nloc, nx); b.st[0] = nloc; b.st[1] = nx; }
        const unsigned old = xb_add(&bar[XB_XSUB(b.x)], 1u);
        const unsigned gen = old / nloc;
        if (old + 1u == (gen + 1u) * nloc) {
            __builtin_amdgcn_fence(__ATOMIC_RELEASE, "agent");
            asm volatile("s_waitcnt vmcnt(0)" ::: "memory");
            const unsigned og = xb_add(&bar[XB_TOP], 1u);
            const unsigned tg = og / nx;
            if (og + 1u == (tg + 1u) * nx) xb_add(&bar[XB_TOPGEN], 1u);
            else XB_SPIN(xb_ld(&bar[XB_TOPGEN]) == tg, bar);
            __builtin_amdgcn_fence(__ATOMIC_ACQUIRE, "agent");
            xb_add(&bar[XB_XGEN(b.x)], 1u);
            asm volatile("s_waitcnt vmcnt(0)" ::: "memory");
        } else {
            XB_SPIN(xb_ld(&bar[XB_XGEN(b.x)]) == gen, bar);
            __builtin_amdgcn_fence(__ATOMIC_ACQUIRE, "agent");
            asm volatile("s_waitcnt vmcnt(0)" ::: "memory");
        }
    }
    __syncthreads();
}

constexpr int NWAVES = 8, NT = NWAVES * 64;
constexpr int RING_BYTES = 131072, LDSCTL_OFF = RING_BYTES, MISC_OFF = LDSCTL_OFF + 320, LDS_BYTES = 147456;
constexpr int CW_BAR = 4096;

struct Args { const float* in[38]; float* out; unsigned char* ws; };
struct Frame {
    LAS unsigned char* lds; volatile LAS unsigned* MISC;
    int wave, vcu, G;
    const float* const* in; float* out; unsigned char* ws;
};
enum { I_XP = 0, I_XS, I_SRET, I_SHG, I_SWKV, I_SSHIFT, I_CP, I_CS, I_MODW, I_MODB, I_NMIXG, I_NMLPG, I_FINALG, I_W1, I_W2, I_ABWIN, I_ABWOUT, I_HGLB, I_HGNG,
       I_MU, I_WRKV, I_RW0, I_RW1, I_RW2, I_RA0, I_RA1, I_RA2, I_RV0, I_RV1, I_RV2, I_RG1, I_RG2, I_RKK, I_RKA, I_RRK, I_RLNG, I_RLNB, I_RWOUT };
constexpr size_t O_Y = 0, O_RETP = 17825792, O_RETS = 17891328, O_HGP = 19988480, O_HGS = 20119552, O_WKVP = 24313856, O_WKVS = 24444928, O_SHP = 28639232, O_SHS = 28641280;

__device__ __forceinline__ void transpose_item(const float* W, int N, bf16_t* WT, int ldt, int row_off, int col_off, const float* mu, int mode, LAS float* scr, int item, int lane) {
    const int nblk = N / 32, kb = item / nblk, nb = item % nblk, k0 = 64 * kb, n0 = 32 * nb;
#pragma unroll 8
    for (int i = 0; i < 32; ++i) { const int kk = 2 * i + (lane >> 5); float s = 1.f; if (mode == 1) s = 1.f - mu[k0 + kk]; else if (mode == 2) s = mu[k0 + kk];
        scr[kk * 33 + (lane & 31)] = W[(size_t)(k0 + kk) * N + n0 + (lane & 31)] * s; }
    LDS_WAIT(); asm volatile("" ::: "memory");
    const int c = lane & 7;
#pragma unroll
    for (int j = 0; j < 4; ++j) { const int n = (lane >> 3) + 8 * j; const LAS float* s = scr + (8 * c) * 33 + n;
        u32x4 o; o.x = pk2(s[0 * 33], s[1 * 33]); o.y = pk2(s[2 * 33], s[3 * 33]); o.z = pk2(s[4 * 33], s[5 * 33]); o.w = pk2(s[6 * 33], s[7 * 33]);
        *(u32x4*)(WT + (size_t)(row_off + n0 + n) * ldt + col_off + k0 + 8 * c) = o; }
    LDS_WAIT(); asm volatile("" ::: "memory");
}
__device__ __forceinline__ void convert_layer_weights(Frame& F, int layer) {
    const int tid = otid(); const int lane = tid & 63; (void)lane;
    LAS float* scr = (LAS float*)(F.lds + F.wave * 16384);
    const int gw = F.vcu * NWAVES + F.wave, NGW = F.G * NWAVES;
    unsigned char* ar = F.ws + WS_ARENA;
    const int m = layer >> 1;
    constexpr int I_1 = (D / 64) * (DFF / 32), I_2 = (DFF / 64) * (D / 32);
    const float* w1 = F.in[I_W1] + (size_t)layer * D * DFF; const float* w2 = F.in[I_W2] + (size_t)layer * DFF * D;
    if ((layer & 1) == 0) {
        constexpr int I_IN = (D / 64) * (ABIN / 32), I_OUT = (D / 64) * (D / 32), NI = I_1 + I_2 + I_IN + I_OUT;
        const float* win = F.in[I_ABWIN] + (size_t)m * D * ABIN; const float* wout = F.in[I_ABWOUT] + (size_t)m * D * D;
        for (int it = gw; it < NI; it += NGW) { int r = it;
            if (r < I_1) { transpose_item(w1, DFF, (bf16_t*)(ar + AR_W1), D, 0, 0, nullptr, 0, scr, r, lane); continue; } r -= I_1;
            if (r < I_2) { transpose_item(w2, D, (bf16_t*)(ar + AR_W2), DFF, 0, 0, nullptr, 0, scr, r, lane); continue; } r -= I_2;
            if (r < I_IN) { transpose_item(win, ABIN, (bf16_t*)(ar + AR_WIN), D, 0, 0, nullptr, 0, scr, r, lane); continue; } r -= I_IN;
            transpose_item(wout, D, (bf16_t*)(ar + AR_WOUT), D, 0, 0, nullptr, 0, scr, r, lane); }
    } else {
        constexpr int I_P = (D / 64) * (D / 32), NI = I_1 + I_2 + 7 * I_P;
        const float* mu = F.in[I_MU] + (size_t)m * 6 * D; const float* wrkv = F.in[I_WRKV] + (size_t)m * 3 * D * D; const float* wo = F.in[I_RWOUT] + (size_t)m * D * D;
        bf16_t* wc1 = (bf16_t*)(ar + AR_WC1);
        for (int it = gw; it < NI; it += NGW) { int r = it;
            if (r < I_1) { transpose_item(w1, DFF, (bf16_t*)(ar + AR_W1), D, 0, 0, nullptr, 0, scr, r, lane); continue; } r -= I_1;
            if (r < I_2) { transpose_item(w2, D, (bf16_t*)(ar + AR_W2), DFF, 0, 0, nullptr, 0, scr, r, lane); continue; } r -= I_2;
            if (r < 6 * I_P) { const int p = r / (2 * I_P), hf = (r / I_P) & 1, mi = (p == 0) ? 0 : (p == 1 ? 2 : 3);
                transpose_item(wrkv + (size_t)p * D * D, D, wc1, 2048, p * D, hf * D, mu + mi * D, 1 + hf, scr, r % I_P, lane); continue; } r -= 6 * I_P;
            transpose_item(wo, D, (bf16_t*)(ar + AR_WO), D, 0, 0, nullptr, 0, scr, r, lane); }
        const int gt = F.vcu * NT + tid, NG = F.G * NT;
        const float* lw1 = F.in[I_RW1] + (size_t)m * D * 64; const float* la1 = F.in[I_RA1] + (size_t)m * D * 64; const float* lv1 = F.in[I_RV1]; const float* lg1 = F.in[I_RG1] + (size_t)m * D * 160;
        for (int idx = gt; idx < 1024 * 2048; idx += NG) { const int n = idx >> 11, k = idx & 2047, kk = k & 1023, s = n >> 8, nn = n & 255;
            const float* src = (s == 0) ? lw1 : (s == 1) ? la1 : (s == 2) ? lv1 : lg1; const int ns = (s == 0 || s == 1) ? 64 : (s == 2 ? 32 : 160); const int mi = (s == 0) ? 1 : (s == 1) ? 4 : (s == 2) ? 3 : 5;
            float v = 0.f; if (nn < ns && !(s == 2 && m == 0)) { const float muv = mu[mi * D + kk]; v = src[(size_t)kk * ns + nn] * (k < 1024 ? 1.f - muv : muv); }
            wc1[(size_t)(3072 + n) * 2048 + k] = (bf16_t)f2bf(v); }
        bf16_t* wc2 = (bf16_t*)(ar + AR_WC2);
        const float* lw2 = F.in[I_RW2] + (size_t)m * 64 * D; const float* la2 = F.in[I_RA2] + (size_t)m * 64 * D; const float* lv2 = F.in[I_RV2]; const float* lg2 = F.in[I_RG2] + (size_t)m * 160 * D;
        for (int idx = gt; idx < 4096 * 256; idx += NG) { const int k = idx >> 12, n = idx & 4095, g = n >> 10, nn = n & 1023;
            const float* src = (g == 0) ? lw2 : (g == 1) ? la2 : (g == 2) ? lv2 : lg2; const int ks = (g == 0 || g == 1) ? 64 : (g == 2 ? 32 : 160);
            float v = 0.f; if (k < ks && !(g == 2 && m == 0)) v = src[(size_t)k * D + nn];
            wc2[(size_t)n * 256 + k] = (bf16_t)f2bf(v); }
    }
}

__device__ __forceinline__ void mod_phase(Frame& F) {
    const int tid = otid(); const int lane = tid & 63;
    const float* __restrict__ SC = (const float*)(F.ws + WS_MOD + 3584 * 1024);
    float* MOD = (float*)(F.ws + WS_MOD);
    LAS float* red = (LAS float*)F.lds;
    for (int task = F.vcu; task < 4 * 96; task += F.G) { const int l = task / 96, n = (task % 96) * 64 + lane, ks = F.wave;
        const float* w = F.in[I_MODW] + ((size_t)l * D + ks * 128) * 6144 + n;
        float acc[NSEQ];
#pragma unroll
        for (int s = 0; s < NSEQ; ++s) acc[s] = 0.f;
        for (int k = 0; k < 128; k += 4) { const float w0 = w[(size_t)k * 6144], w1 = w[(size_t)(k + 1) * 6144], w2 = w[(size_t)(k + 2) * 6144], w3 = w[(size_t)(k + 3) * 6144];
#pragma unroll
            for (int s = 0; s < NSEQ; ++s) { const f32x4 c4 = *(const f32x4*)(SC + s * D + ks * 128 + k); acc[s] += (c4[0] * w0 + c4[1] * w1) + (c4[2] * w2 + c4[3] * w3); } }
        __syncthreads();
#pragma unroll
        for (int s = 0; s < NSEQ; ++s) red[(F.wave * NSEQ + s) * 64 + lane] = acc[s];
        __syncthreads();
        for (int i = tid; i < NSEQ * 64; i += NT) { const int s = i >> 6, c = i & 63; float t = F.in[I_MODB][l * 6144 + (task % 96) * 64 + c];
#pragma unroll
            for (int q = 0; q < 8; ++q) t += red[(q * NSEQ + s) * 64 + c];
            MOD[((size_t)l * NSEQ + s) * 6144 + (task % 96) * 64 + c] = t; }
    }
    __syncthreads();
}

__device__ __forceinline__ void prologue(Frame& F) {
    const int tid = otid(); const int lane = tid & 63; (void)lane;
    const int gt = F.vcu * NT + tid, NG = F.G * NT;
    { const f32x4* xp = (const f32x4*)F.in[I_XP]; const f32x4* xs = (const f32x4*)F.in[I_XS]; f32x4* o = (f32x4*)F.out;
      for (int i = gt; i < M * (D / 4); i += NG) o[i] = (i < MP * (D / 4)) ? xp[i] : xs[i - MP * (D / 4)]; }
    { f32x2* tab = (f32x2*)(F.ws + WS_ROPE);
      for (int i = gt; i < 16384 * 32; i += NG) { const int p = i >> 5, d = i & 31; double rev = (double)p * ROPE_REV[d]; rev -= floor(rev); const float fr = (float)rev;
          tab[i] = (f32x2){__builtin_amdgcn_cosf(fr), __builtin_amdgcn_sinf(fr)}; } }
    { unsigned* z = (unsigned*)(F.ws + WS_XN0); for (int i = gt; i < 512; i += NG) z[i] = 0u; }
    { float* SC = (float*)(F.ws + WS_MOD + 3584 * 1024);
      for (int i = gt; i < NSEQ * D; i += NG) { const int s = i >> 10, k = i & 1023; const float c = (s == 0) ? F.in[I_CP][k] : F.in[I_CS][(size_t)(s - 1) * D + k]; SC[i] = siluf_(c); } }
    convert_layer_weights(F, 0);
}

template <int MODE> __device__ __forceinline__ void norm_pass(Frame& F, int layer) {
    const int tid = otid(); const int lane = tid & 63; (void)lane;
    const int gw = F.vcu * NWAVES + F.wave, NGW = F.G * NWAVES; const int m = layer >> 1;
    const float* MOD = (const float*)(F.ws + WS_MOD) + (size_t)layer * NSEQ * 6144;
    const float* gvec = (MODE == 3) ? F.in[I_FINALG] : (MODE == 2 ? F.in[I_NMLPG] + layer * D : F.in[I_NMIXG] + layer * D);
    const int shoff = (MODE == 2) ? 3072 : 0, scoff = (MODE == 2) ? 4096 : 1024;
    bf16_t* XN = (bf16_t*)(F.ws + WS_XN); bf16_t* PREVS = (bf16_t*)(F.ws + WS_PREVS);
    for (int r = gw; r < M; r += NGW) {
        float* xrow = F.out + (size_t)r * D; const f32x4* xr = (const f32x4*)xrow + lane;
        f32x4 v[4]; float s2 = 0.f;
#pragma unroll
        for (int j = 0; j < 4; ++j) { v[j] = xr[64 * j]; s2 += (v[j].x * v[j].x + v[j].y * v[j].y) + (v[j].z * v[j].z + v[j].w * v[j].w); }
        const float rstd = 1.f / sqrtf(wave_sum(s2) * (1.f / D) + NORM_EPS);
        const int seq = seq_of_row(r); const float* mp = MOD + (size_t)seq * 6144;
#pragma unroll
        for (int j = 0; j < 4; ++j) { const int c = 4 * lane + 256 * j; const f32x4 g4 = *(const f32x4*)(gvec + c); f32x4 o = v[j] * rstd * g4;
            if (MODE == 3) { *((f32x4*)xrow + lane + 64 * j) = o; continue; }
            const f32x4 sc = *(const f32x4*)(mp + scoff + c), sh = *(const f32x4*)(mp + shoff + c);
            o = o * (1.f + sc) + sh;
            const unsigned long long pk = (unsigned long long)pk2(o.x, o.y) | ((unsigned long long)pk2(o.z, o.w) << 32);
            *(unsigned long long*)(XN + (size_t)r * D + c) = pk;
            if (MODE == 1) {
                if (r >= MP) { const int t = (r - MP) & 31; if (t < 31) *(unsigned long long*)(PREVS + (size_t)(r - MP + 1) * D + c) = pk;
                    else *(f32x4*)(F.out + O_SHS + ((size_t)m * 32 + ((r - MP) >> 5)) * D + c) = o;
                    if (t == 0) { const f32x4 ss = *(const f32x4*)(F.in[I_SSHIFT] + ((size_t)m * 32 + ((r - MP) >> 5)) * D + c);
                        *(unsigned long long*)(PREVS + (size_t)(r - MP) * D + c) = (unsigned long long)pk2(ss.x, ss.y) | ((unsigned long long)pk2(ss.z, ss.w) << 32); } }
                else if (r == MP - 1) *(f32x4*)(F.out + O_SHP + (size_t)m * D + c) = o;
            } }
    }
}

template <int MT, int NTT> __device__ __forceinline__ void wave_mm_nt(f32x4 (&acc)[MT][NTT], const LAS bf16_t* X, int ldx, const LAS bf16_t* Y, int ldy, int K, int fr, int fq) {
    for (int k0 = 0; k0 < K; k0 += 32) {
        bf16x8 xa[MT], yb[NTT];
#pragma unroll
        for (int i = 0; i < MT; ++i) xa[i] = *(const LAS bf16x8*)(X + (16 * i + fr) * ldx + k0 + 8 * fq);
#pragma unroll
        for (int j = 0; j < NTT; ++j) yb[j] = *(const LAS bf16x8*)(Y + (16 * j + fr) * ldy + k0 + 8 * fq);
#pragma unroll
        for (int i = 0; i < MT; ++i)
#pragma unroll
            for (int j = 0; j < NTT; ++j) acc[i][j] = __builtin_amdgcn_mfma_f32_16x16x32_bf16(yb[j], xa[i], acc[i][j], 0, 0, 0);
    }
}

constexpr int LQS = 0, LKS = 18432, LQG = 36864, LVT = 55296, LST = 73728, LPS = 108544, LRED = 117760, LBS = 118784;
__device__ __forceinline__ void chunk_geom(int c, int& r0, int& pos0) { if (c < 256) { r0 = 64 * c; pos0 = 64 * c; } else { r0 = MP + 32 * (c - 256); pos0 = 2048; } }

template <int L, bool HG, bool SUMMARY> __device__ __forceinline__ void ab_load(Frame& F, int layer, int c, int h) {
    const int tid = otid(); const int lane = tid & 63; (void)lane;
    const int m = layer >> 1; int r0, pos0; chunk_geom(c, r0, pos0);
    const bf16_t* Z = (const bf16_t*)(F.ws + WS_Z);
    LAS bf16_t* QS = (LAS bf16_t*)(F.lds + LQS); LAS bf16_t* KS = (LAS bf16_t*)(F.lds + LKS); LAS bf16_t* QG = (LAS bf16_t*)(F.lds + LQG); LAS bf16_t* VT = (LAS bf16_t*)(F.lds + LVT);
    constexpr int LDT = L + 8;
    if constexpr (HG) {
        constexpr int TQ = L / 4; LAS float* BS = (LAS float*)(F.lds + LBS);
        const int ch = tid & 127, qtr = tid >> 7;
        float lb = 0.f;
        if (m == 1) { const float a0 = F.in[I_HGLB][h * 128 + ch], a1 = F.in[I_HGLB][512 + h * 128 + ch]; lb = 1.f / (1.f + __expf(a0 - a1)); }
        { constexpr int NP = L * 16;
#pragma unroll
          for (int q = 0; q < (NP + NT - 1) / NT; ++q) { const int v = tid + q * NT; if (NP % NT == 0 || v < NP) { const int j = v >> 4, c8 = v & 15; const size_t zr = (size_t)(r0 + j) * ABIN + h * 128 + c8 * 8;
                  const u32x4 zf4 = *(const u32x4*)(Z + zr + 2048), v4 = *(const u32x4*)(Z + zr + 2560);
                  *(LAS u32x4*)(QG + j * 136 + c8 * 8) = zf4; *(LAS u32x4*)(KS + j * 136 + c8 * 8) = v4;
                  if constexpr (!SUMMARY) { const u32x4 q4 = *(const u32x4*)(Z + zr + 1536); *(LAS u32x4*)(QS + j * 136 + c8 * 8) = q4; } } } }
        __syncthreads();
        float zf[TQ], cs[TQ]; float run = 0.f;
#pragma unroll
        for (int jj = 0; jj < TQ; ++jj) { const int j = qtr * TQ + jj; zf[jj] = bf2f(QG[j * 136 + ch]);
            float lf; if (lb == 0.f) lf = fminf(zf[jj], 0.f) - __logf(1.f + __expf(-fabsf(zf[jj]))); else lf = __logf(lb + (1.f - lb) * sigmoidf_(zf[jj]));
            run += lf; cs[jj] = run; }
        BS[qtr * 128 + ch] = run;
        __syncthreads();
        const float b0 = BS[ch], b1 = BS[128 + ch], b2 = BS[256 + ch], b3 = BS[384 + ch];
        const float off = (qtr > 0 ? b0 : 0.f) + (qtr > 1 ? b1 : 0.f) + (qtr > 2 ? b2 : 0.f), bL = (b0 + b1) + (b2 + b3), bmid = b0 + b1;
        if constexpr (SUMMARY) {
#pragma unroll
            for (int jj = 0; jj < TQ; ++jj) { const int j = qtr * TQ + jj; const float b = off + cs[jj]; const float kb = (1.f - lb) * sigmoidf_(-zf[jj]);
                VT[ch * LDT + j] = KS[j * 136 + ch]; QS[ch * LDT + j] = (bf16_t)f2bf(kb * __expf(bL - b)); }
            if (qtr == 0) ((float*)(F.ws + WS_DEC))[((size_t)c * 4 + h) * 128 + ch] = __expf(bL);
        } else {
#pragma unroll
            for (int jj = 0; jj < TQ; ++jj) { const int j = qtr * TQ + jj; const float b = off + cs[jj]; const float kb = (1.f - lb) * sigmoidf_(-zf[jj]);
                const float q = siluf_(bf2f(QS[j * 136 + ch]));
                VT[ch * LDT + j] = KS[j * 136 + ch];
                QS[j * 136 + ch] = (bf16_t)f2bf(q * __expf(b - bmid)); KS[j * 136 + ch] = (bf16_t)f2bf(kb * __expf(bmid - b)); QG[j * 136 + ch] = (bf16_t)f2bf(q * __expf(b)); }
        }
    } else {
        const float logg = log1pf(-exp2f(-5.f - (float)h));
        const f32x2* rope = (const f32x2*)(F.ws + WS_ROPE);
        for (int it = tid; it < L * 4; it += NT) { const int j = it >> 2, d8 = it & 3; const size_t zr = (size_t)(r0 + j) * ABIN;
            const f32x2* rp = rope + (size_t)(pos0 + j) * 32 + d8 * 8;
            const u32x4 k1 = *(const u32x4*)(Z + zr + 256 + h * 64 + d8 * 8), k2 = *(const u32x4*)(Z + zr + 256 + h * 64 + 32 + d8 * 8);
            const float gk = __expf((float)(L - 1 - j) * logg), gq = __expf((float)(j + 1) * logg);
            u32x4 q1 = (u32x4){0, 0, 0, 0}, q2 = q1; if constexpr (!SUMMARY) { q1 = *(const u32x4*)(Z + zr + h * 64 + d8 * 8); q2 = *(const u32x4*)(Z + zr + h * 64 + 32 + d8 * 8); }
#pragma unroll
            for (int e = 0; e < 8; ++e) { const f32x2 cs_ = rp[e]; const unsigned wk1 = k1[e >> 1], wk2 = k2[e >> 1]; const float x1 = (e & 1) ? bfhi(wk1) : bflo(wk1), x2 = (e & 1) ? bfhi(wk2) : bflo(wk2);
                const float o1 = x1 * cs_.x - x2 * cs_.y, o2 = x1 * cs_.y + x2 * cs_.x; const int d = d8 * 8 + e;
                if constexpr (SUMMARY) { QS[d * LDT + j] = (bf16_t)f2bf(o1 * gk); QS[(d + 32) * LDT + j] = (bf16_t)f2bf(o2 * gk); }
                else { KS[j * 72 + d] = (bf16_t)f2bf(o1); KS[j * 72 + d + 32] = (bf16_t)f2bf(o2);
                    const unsigned wq1 = q1[e >> 1], wq2 = q2[e >> 1]; const float y1 = (e & 1) ? bfhi(wq1) : bflo(wq1), y2 = (e & 1) ? bfhi(wq2) : bflo(wq2);
                    const float p1 = (y1 * cs_.x - y2 * cs_.y) * 0.125f, p2 = (y1 * cs_.y + y2 * cs_.x) * 0.125f;
                    QS[j * 72 + d] = (bf16_t)f2bf(p1); QS[j * 72 + d + 32] = (bf16_t)f2bf(p2); QG[j * 72 + d] = (bf16_t)f2bf(p1 * gq); QG[j * 72 + d + 32] = (bf16_t)f2bf(p2 * gq); } } }
        for (int it = tid; it < L * 16; it += NT) { const int j = it >> 4, e8 = it & 15; const u32x4 vv = *(const u32x4*)(Z + (size_t)(r0 + j) * ABIN + 512 + h * 128 + e8 * 8);
#pragma unroll
            for (int e = 0; e < 8; ++e) { const unsigned w = vv[e >> 1]; VT[(e8 * 8 + e) * LDT + j] = (bf16_t)((e & 1) ? (w >> 16) : (w & 0xffffu)); } }
    }
}

template <int L, bool HG> __device__ __forceinline__ void ab_summary_unit(Frame& F, int layer, int c, int h) {
    const int tid = otid(); const int lane = tid & 63; (void)lane;
    constexpr int DK = HG ? 128 : 64, NCT = DK / 16, LDT = L + 8;
    __syncthreads();
    ab_load<L, HG, true>(F, layer, c, h);
    __syncthreads();
    const int fr = lane & 15, fq = lane >> 4;
    const LAS bf16_t* KDT = (const LAS bf16_t*)(F.lds + LQS); const LAS bf16_t* VT = (const LAS bf16_t*)(F.lds + LVT);
    f32x4 acc[1][NCT];
#pragma unroll
    for (int j = 0; j < NCT; ++j) acc[0][j] = (f32x4){0.f, 0.f, 0.f, 0.f};
    wave_mm_nt<1, NCT>(acc, VT + F.wave * 16 * LDT, LDT, KDT, LDT, L, fr, fq);
    bf16_t* ST = (bf16_t*)(F.ws + WS_STATE) + (size_t)c * SLOT_E + (HG ? 32768 + h * 16384 : h * 8192);
    const int e = F.wave * 16 + fr;
#pragma unroll
    for (int j = 0; j < NCT; ++j) { u32x2 w; w.x = pk2(acc[0][j][0], acc[0][j][1]); w.y = pk2(acc[0][j][2], acc[0][j][3]); *(u32x2*)(ST + (size_t)e * DK + 16 * j + 4 * fq) = w; }
}

template <int L, bool HG> __device__ __forceinline__ void ab_output_unit(Frame& F, int layer, int c, int h) {
    const int tid = otid(); const int lane = tid & 63; (void)lane;
    constexpr int DK = HG ? 128 : 64, LDQ = HG ? 136 : 72, LDT = L + 8, NIT = L / 16, WPI = 8 / NIT, ET = 8 / WPI, TPW = (NIT * NIT >= 8) ? NIT * NIT / 8 : 1;
    const int m = layer >> 1; int r0, pos0; chunk_geom(c, r0, pos0);
    __syncthreads();
    ab_load<L, HG, false>(F, layer, c, h);
    LAS bf16_t* QS = (LAS bf16_t*)(F.lds + LQS); LAS bf16_t* KS = (LAS bf16_t*)(F.lds + LKS); LAS bf16_t* QG = (LAS bf16_t*)(F.lds + LQG); LAS bf16_t* VT = (LAS bf16_t*)(F.lds + LVT);
    LAS bf16_t* STl = (LAS bf16_t*)(F.lds + LST); LAS bf16_t* PS = (LAS bf16_t*)(F.lds + LPS); LAS float* RED = (LAS float*)(F.lds + LRED);
    { const bf16_t* ST = (const bf16_t*)(F.ws + WS_STATE) + (size_t)c * SLOT_E + (HG ? 32768 + h * 16384 : h * 8192);
      for (int it = tid; it < 128 * DK / 8; it += NT) { const int e = it / (DK / 8), c8 = it % (DK / 8); *(LAS u32x4*)(STl + e * LDQ + c8 * 8) = *(const u32x4*)(ST + (size_t)e * DK + c8 * 8); } }
    __syncthreads();
    const int fr = lane & 15, fq = lane >> 4, w = F.wave;
    const float logg = HG ? 0.f : log1pf(-exp2f(-5.f - (float)h));
    if (w * TPW < NIT * NIT) {
        const int it = (w * TPW) / NIT, jt0 = (w * TPW) % NIT;
        f32x4 sc[1][TPW];
#pragma unroll
        for (int q = 0; q < TPW; ++q) sc[0][q] = (f32x4){0.f, 0.f, 0.f, 0.f};
        wave_mm_nt<1, TPW>(sc, QS + it * 16 * LDQ, LDQ, KS + jt0 * 16 * LDQ, LDQ, DK, fr, fq);
        const int i = it * 16 + fr;
#pragma unroll
        for (int q = 0; q < TPW; ++q) { float p[4];
#pragma unroll
            for (int r = 0; r < 4; ++r) { const int j = (jt0 + q) * 16 + 4 * fq + r; float v = sc[0][q][r]; if (!HG) v *= __expf((float)(i - j) * logg); p[r] = (j <= i) ? v : 0.f; }
            u32x2 pw; pw.x = pk2(p[0], p[1]); pw.y = pk2(p[2], p[3]); *(LAS u32x2*)(PS + i * LDT + (jt0 + q) * 16 + 4 * fq) = pw; }
    }
    __syncthreads();
    const int it = w % NIT, eg = w / NIT;
    f32x4 o[1][ET];
#pragma unroll
    for (int q = 0; q < ET; ++q) o[0][q] = (f32x4){0.f, 0.f, 0.f, 0.f};
    wave_mm_nt<1, ET>(o, PS + it * 16 * LDT, LDT, VT + eg * ET * 16 * LDT, LDT, L, fr, fq);
    wave_mm_nt<1, ET>(o, QG + it * 16 * LDQ, LDQ, STl + eg * ET * 16 * LDQ, LDQ, DK, fr, fq);
    float ss = 0.f;
#pragma unroll
    for (int q = 0; q < ET; ++q) ss += (o[0][q][0] * o[0][q][0] + o[0][q][1] * o[0][q][1]) + (o[0][q][2] * o[0][q][2] + o[0][q][3] * o[0][q][3]);
    ss += __shfl_xor(ss, 16); ss += __shfl_xor(ss, 32);
    const int i = it * 16 + fr;
    if (fq == 0) RED[i * 4 + eg] = ss;
    __syncthreads();
    float tot = 0.f;
#pragma unroll
    for (int q = 0; q < WPI; ++q) tot += RED[i * 4 + q];
    const float rstd = 1.f / sqrtf(tot * (1.f / 128.f) + NORM_EPS);
    const bf16_t* Z = (const bf16_t*)(F.ws + WS_Z); bf16_t* O = (bf16_t*)(F.ws + WS_XN);
    const size_t row = (size_t)(r0 + i);
#pragma unroll
    for (int q = 0; q < ET; ++q) { const int e = (eg * ET + q) * 16 + 4 * fq; const u32x2 gw = *(const u32x2*)(Z + row * ABIN + (HG ? 3072 : 1024) + h * 128 + e);
        const float g4[4] = {bflo(gw.x), bfhi(gw.x), bflo(gw.y), bfhi(gw.y)}; float ov[4];
#pragma unroll
        for (int r = 0; r < 4; ++r) { if (HG) ov[r] = o[0][q][r] * rstd * F.in[I_HGNG][m * 128 + e + r] * sigmoidf_(g4[r]); else ov[r] = o[0][q][r] * rstd * siluf_(g4[r]); }
        u32x2 ow; ow.x = pk2(ov[0], ov[1]); ow.y = pk2(ov[2], ov[3]); *(u32x2*)(O + row * D + (HG ? 512 : 0) + h * 128 + e) = ow; }
}

template <bool DRY = false> __device__ __forceinline__ void ab_scan(Frame& F, int layer) {
    const int tid = otid(); const int lane = tid & 63; (void)lane;
    const int m = layer >> 1;
    unsigned* ST32 = (unsigned*)(F.ws + WS_STATE); const float* DEC = (const float*)(F.ws + WS_DEC);
    constexpr int NP = SLOT_E / 2;
    const int gt = F.vcu * NT + tid;
    if (gt < NP) {
        const int eo = 2 * gt; const bool hg = eo >= 32768; const int eo2 = hg ? eo - 32768 : eo; const int head = hg ? eo2 >> 14 : eo2 >> 13; const int cch = hg ? (eo2 & 127) : (eo2 & 63); const int e = hg ? ((eo2 & 16383) >> 7) : ((eo2 & 8191) >> 6);
        const float gdec = hg ? 0.f : __expf(64.f * log1pf(-exp2f(-5.f - (float)head)));
        float s0 = 0.f, s1 = 0.f;
        for (int c0 = 0; c0 < 256; c0 += 8) {
            unsigned kv[8]; float d0[8], d1[8];
#pragma unroll
            for (int u = 0; u < 8; ++u) { kv[u] = ST32[(size_t)(c0 + u) * NP + gt]; if (hg) { const f32x2 dd = *(const f32x2*)(DEC + ((size_t)(c0 + u) * 4 + head) * 128 + cch); d0[u] = dd.x; d1[u] = dd.y; } else { d0[u] = gdec; d1[u] = gdec; } }
#pragma unroll
            for (int u = 0; u < 8; ++u) { const unsigned pw = pk2(s0, s1); if constexpr (DRY) asm volatile("" :: "v"(pw)); else ST32[(size_t)(c0 + u) * NP + gt] = pw; s0 = d0[u] * s0 + bflo(kv[u]); s1 = d1[u] * s1 + bfhi(kv[u]); }
        }
        float* outp = hg ? F.out + O_HGP + (size_t)m * 65536 + head * 16384 : F.out + O_RETP + (size_t)m * 32768 + head * 8192;
        outp[(size_t)cch * 128 + e] = s0; outp[(size_t)(cch + 1) * 128 + e] = s1;
    } else {
        const int NG2 = F.G * NT - NP; if (NG2 <= 0) return;
        for (int idx = gt - NP; idx < 32 * NP; idx += NG2) { const int b = idx / NP, pr = idx % NP;
            const int eo = 2 * pr; const bool hg = eo >= 32768; const int eo2 = hg ? eo - 32768 : eo; const int head = hg ? eo2 >> 14 : eo2 >> 13; const int cch = hg ? (eo2 & 127) : (eo2 & 63); const int e = hg ? ((eo2 & 16383) >> 7) : ((eo2 & 8191) >> 6);
            float d0, d1; if (hg) { const f32x2 dd = *(const f32x2*)(DEC + ((size_t)(256 + b) * 4 + head) * 128 + cch); d0 = dd.x; d1 = dd.y; } else { d0 = d1 = __expf(32.f * log1pf(-exp2f(-5.f - (float)head))); }
            const size_t so = hg ? ((size_t)(m * 32 + b) * 4 + head) * 16384 : ((size_t)(m * 32 + b) * 4 + head) * 8192;
            const float* sin_ = (hg ? F.in[I_SHG] : F.in[I_SRET]) + so; float* sout = F.out + (hg ? O_HGS : O_RETS) + so;
            const float i0 = sin_[(size_t)cch * 128 + e], i1 = sin_[(size_t)(cch + 1) * 128 + e];
            const unsigned kv = ST32[(size_t)(256 + b) * NP + pr]; if constexpr (!DRY) ST32[(size_t)(256 + b) * NP + pr] = pk2(i0, i1);
            sout[(size_t)cch * 128 + e] = d0 * i0 + bflo(kv); sout[(size_t)(cch + 1) * 128 + e] = d1 * i1 + bfhi(kv); }
    }
}

constexpr int RL_AT = 0, RL_RT = 9216, RL_BT = 18432, RL_KT = 27648, RL_BHT = 36864, RL_KHT = 46080, RL_VT = 55296, RL_AAB = 64512, RL_AAK = 81920, RL_ARB = 91136, RL_ARK = 100352,
              RL_U0T = 109568, RL_VEC = 118784, RL_PSUM = 119808;
constexpr int RL_G = RL_AAB, RL_WW = RL_BT, RL_APT = RL_AAK;
constexpr int RL_PL = RL_AT, RL_RL = RL_BT, RL_Y0L = RL_BT + 4608, RL_QTL = RL_AAB, RL_S = RL_BHT;
__device__ __forceinline__ int pperm(int k) { return 32 * (k >> 5) + 8 * ((k >> 2) & 3) + 4 * ((k >> 4) & 1) + (k & 3); }

template <bool DRY = false> __device__ __forceinline__ void rwkv_out_epilogue(Frame& F, int m, const f32x4 (&y)[4], size_t row, int h, int fq) {
    bf16_t* RKV = (bf16_t*)(F.ws + WS_RKV); const bf16_t* GG = (const bf16_t*)(F.ws + WS_G); const float* BON = (const float*)(F.ws + WS_BON);
    float s1 = 0.f;
#pragma unroll
    for (int nt = 0; nt < 4; ++nt) s1 += (y[nt][0] + y[nt][1]) + (y[nt][2] + y[nt][3]);
    s1 += __shfl_xor(s1, 16); s1 += __shfl_xor(s1, 32);
    const float mean = s1 * (1.f / 64.f); float s2 = 0.f;
#pragma unroll
    for (int nt = 0; nt < 4; ++nt)
#pragma unroll
        for (int r = 0; r < 4; ++r) { const float d = y[nt][r] - mean; s2 += d * d; }
    s2 += __shfl_xor(s2, 16); s2 += __shfl_xor(s2, 32);
    const float rstd = 1.f / sqrtf(s2 * (1.f / 64.f) + RW_LN_EPS), bon = BON[row * 16 + h];
#pragma unroll
    for (int nt = 0; nt < 4; ++nt) { const int i = h * 64 + 16 * nt + 4 * fq;
        const f32x4 lg = *(const f32x4*)(F.in[I_RLNG] + m * D + i), lb = *(const f32x4*)(F.in[I_RLNB] + m * D + i);
        const u32x2 vv = *(const u32x2*)(RKV + row * 3072 + 2048 + i), gg = *(const u32x2*)(GG + row * D + i);
        const float v4[4] = {bflo(vv.x), bfhi(vv.x), bflo(vv.y), bfhi(vv.y)}, g4[4] = {bflo(gg.x), bfhi(gg.x), bflo(gg.y), bfhi(gg.y)}; float o[4];
#pragma unroll
        for (int r = 0; r < 4; ++r) o[r] = ((y[nt][r] - mean) * rstd * lg[r] + lb[r] + bon * v4[r]) * g4[r];
        u32x2 w; w.x = pk2(o[0], o[1]); w.y = pk2(o[2], o[3]); if constexpr (DRY) asm volatile("" :: "v"(w.x), "v"(w.y)); else *(u32x2*)(RKV + row * 3072 + i) = w; }
}

template <int S, int L> struct SubstQ {
    static constexpr int RQ = L / 4, NV4 = RQ / 4;
    static __device__ __forceinline__ void run(float (&x)[RQ], f32x4 (&aq)[3][NV4], const LAS float* ap) {
        if constexpr (S < L - 1) {
            if constexpr (S + 2 < L - 1) {
#pragma unroll
                for (int k = 0; k < NV4; ++k) aq[(S + 2) % 3][k] = *(const LAS f32x4*)(ap + (S + 2) * 68 + 4 * k);
            }
            constexpr int own = S / RQ, ctrl = own * 0x55;
            const float xs = __builtin_bit_cast(float, __builtin_amdgcn_update_dpp(0, __builtin_bit_cast(int, x[S % RQ]), ctrl, 0xf, 0xf, false));
#pragma unroll
            for (int k = 0; k < NV4; ++k) { x[4 * k] += aq[S % 3][k][0] * xs; x[4 * k + 1] += aq[S % 3][k][1] * xs; x[4 * k + 2] += aq[S % 3][k][2] * xs; x[4 * k + 3] += aq[S % 3][k][3] * xs;
                asm volatile("" : "+v"(x[4 * k]), "+v"(x[4 * k + 1]), "+v"(x[4 * k + 2]), "+v"(x[4 * k + 3])); }
            asm volatile("" ::: "memory");
            SubstQ<S + 1, L>::run(x, aq, ap);
        }
    }
};
template <int L, bool DRY = false> __device__ __forceinline__ void rwkv_local_unit(Frame& F, int layer, int c, int h) {
    const int tid = otid(); const int lane = tid & 63, fr = lane & 15, fq = lane >> 4, w = F.wave;
    constexpr int NIT = L / 16; constexpr bool SAMPLE = (L == 32);
    const int m = layer >> 1; int r0, pos0; chunk_geom(c, r0, pos0);
    bf16_t* RKV = (bf16_t*)(F.ws + WS_RKV); const bf16_t* WLOG = (const bf16_t*)(F.ws + WS_WLOG); const bf16_t* AA = (const bf16_t*)(F.ws + WS_XN);
    LAS bf16_t* AT = (LAS bf16_t*)(F.lds + RL_AT); LAS bf16_t* RT = (LAS bf16_t*)(F.lds + RL_RT); LAS bf16_t* BT = (LAS bf16_t*)(F.lds + RL_BT); LAS bf16_t* KT = (LAS bf16_t*)(F.lds + RL_KT);
    LAS bf16_t* BHT = (LAS bf16_t*)(F.lds + RL_BHT); LAS bf16_t* KHT = (LAS bf16_t*)(F.lds + RL_KHT); LAS bf16_t* VT = (LAS bf16_t*)(F.lds + RL_VT);
    LAS float* AAB = (LAS float*)(F.lds + RL_AAB); LAS bf16_t* AAK = (LAS bf16_t*)(F.lds + RL_AAK); LAS bf16_t* ARB = (LAS bf16_t*)(F.lds + RL_ARB); LAS bf16_t* ARK = (LAS bf16_t*)(F.lds + RL_ARK);
    LAS bf16_t* U0T = (LAS bf16_t*)(F.lds + RL_U0T); LAS float* GMID = (LAS float*)(F.lds + RL_VEC); LAS float* GLV = GMID + 64; LAS float* EGM = GMID + 128; LAS float* PSUM = (LAS float*)(F.lds + RL_PSUM);
    LAS float* G = (LAS float*)(F.lds + RL_G); LAS float* WW = (LAS float*)(F.lds + RL_WW); LAS bf16_t* APT = (LAS bf16_t*)(F.lds + RL_APT);
    __syncthreads();
    const int t = tid >> 3, c8 = tid & 7; const bool act = t < L;
    float rr[8], kkv[8], bb[8], kh[8], vv[8];
    if (act) { const size_t row = (size_t)(r0 + t); const int col = h * 64 + 8 * c8;
        const u32x4 r4 = *(const u32x4*)(RKV + row * 3072 + col), k4 = *(const u32x4*)(RKV + row * 3072 + 1024 + col), v4 = *(const u32x4*)(RKV + row * 3072 + 2048 + col);
        const u32x4 w4 = *(const u32x4*)(WLOG + row * D + col), a4 = *(const u32x4*)(AA + row * D + col);
        const float* kkp = F.in[I_RKK] + m * D + col; const float* kap = F.in[I_RKA] + m * D + col; const float* rkp = F.in[I_RRK] + m * D + col;
        float ss = 0.f, bon = 0.f;
#pragma unroll
        for (int e = 0; e < 8; ++e) { const float kx = (e & 1) ? bfhi(k4[e >> 1]) : bflo(k4[e >> 1]), al = (e & 1) ? bfhi(a4[e >> 1]) : bflo(a4[e >> 1]);
            rr[e] = (e & 1) ? bfhi(r4[e >> 1]) : bflo(r4[e >> 1]); vv[e] = (e & 1) ? bfhi(v4[e >> 1]) : bflo(v4[e >> 1]);
            kkv[e] = kx * kkp[e]; ss += kkv[e] * kkv[e]; kh[e] = kx * (1.f + (al - 1.f) * kap[e]); bb[e] = al; bon += rr[e] * kh[e] * rkp[e];
            G[t * 64 + 8 * c8 + e] = (e & 1) ? bfhi(w4[e >> 1]) : bflo(w4[e >> 1]); }
        ss += __shfl_xor(ss, 1); ss += __shfl_xor(ss, 2); ss += __shfl_xor(ss, 4); bon += __shfl_xor(bon, 1); bon += __shfl_xor(bon, 2); bon += __shfl_xor(bon, 4);
        const float inv = 1.f / fmaxf(sqrtf(ss), 1e-12f);
#pragma unroll
        for (int e = 0; e < 8; ++e) { kkv[e] *= inv; bb[e] *= kkv[e]; }
        if (c8 == 0) ((float*)(F.ws + WS_BON))[row * 16 + h] = bon; }
    __syncthreads();
    { constexpr int TE = L / 8; const int j = tid & 63, e8 = tid >> 6; float cs[TE]; float run = 0.f;
#pragma unroll
      for (int q = 0; q < TE; ++q) { run += G[(e8 * TE + q) * 64 + j]; cs[q] = run; }
      PSUM[e8 * 64 + j] = run;
      __syncthreads();
      float off = 0.f, gm = 0.f, gl = 0.f;
#pragma unroll
      for (int q = 0; q < 8; ++q) { const float p = PSUM[q * 64 + j]; if (q < e8) off += p; if (q < 4) gm += p; gl += p; }
#pragma unroll
      for (int q = 0; q < TE; ++q) G[(e8 * TE + q) * 64 + j] = off + cs[q];
      if (e8 == 0) { GMID[j] = gm; GLV[j] = gl; EGM[j] = __expf(gm); if (!SAMPLE) ((float*)(F.ws + WS_REC + ((size_t)c * 16 + h) * REC_B + 16384))[j] = __expf(gl); } }
    __syncthreads();
    if (act) { float fa[8], fr_[8], fb[8], fk[8];
#pragma unroll
        for (int e = 0; e < 8; ++e) { const int j = 8 * c8 + e; const float g = G[t * 64 + j], gp = (t > 0) ? G[(t - 1) * 64 + j] : 0.f, gm = GMID[j], gl = GLV[j];
            const float ed = __expf(gm - g), eu = __expf(g - gm), el = __expf(gl - g);
            fa[e] = -kkv[e] * __expf(gp - gm); fr_[e] = rr[e] * eu; fb[e] = bb[e] * ed; fk[e] = kh[e] * ed;
            if constexpr (!(DRY && (LOCAL_SKIP & 4))) { BHT[j * 72 + t] = (bf16_t)f2bf(bb[e] * el); KHT[j * 72 + t] = (bf16_t)f2bf(kh[e] * el); VT[j * 72 + t] = (bf16_t)f2bf(vv[e]); } }
        u32x4 p;
        p.x = pk2(fa[0], fa[1]); p.y = pk2(fa[2], fa[3]); p.z = pk2(fa[4], fa[5]); p.w = pk2(fa[6], fa[7]); *(LAS u32x4*)(AT + t * 72 + 8 * c8) = p;
        p.x = pk2(fr_[0], fr_[1]); p.y = pk2(fr_[2], fr_[3]); p.z = pk2(fr_[4], fr_[5]); p.w = pk2(fr_[6], fr_[7]); *(LAS u32x4*)(RT + t * 72 + 8 * c8) = p;
        p.x = pk2(fb[0], fb[1]); p.y = pk2(fb[2], fb[3]); p.z = pk2(fb[4], fb[5]); p.w = pk2(fb[6], fb[7]); *(LAS u32x4*)(BT + t * 72 + 8 * c8) = p;
        p.x = pk2(fk[0], fk[1]); p.y = pk2(fk[2], fk[3]); p.z = pk2(fk[4], fk[5]); p.w = pk2(fk[6], fk[7]); *(LAS u32x4*)(KT + t * 72 + 8 * c8) = p; }
    __syncthreads();
    if constexpr (DRY && (LOCAL_SKIP & 2)) return;
    { constexpr int TPW = (NIT * NIT >= 8) ? NIT * NIT / 8 : 1;
      if (w * TPW < NIT * NIT) { const int it = (w * TPW) / NIT, jt0 = (w * TPW) % NIT;
          f32x4 ab[1][TPW], ak[1][TPW], rb[1][TPW], rk[1][TPW];
#pragma unroll
          for (int q = 0; q < TPW; ++q) { ab[0][q] = (f32x4){0.f, 0.f, 0.f, 0.f}; ak[0][q] = ab[0][q]; rb[0][q] = ab[0][q]; rk[0][q] = ab[0][q]; }
          wave_mm_nt<1, TPW>(ab, AT + it * 16 * 72, 72, BT + jt0 * 16 * 72, 72, 64, fr, fq); wave_mm_nt<1, TPW>(ak, AT + it * 16 * 72, 72, KT + jt0 * 16 * 72, 72, 64, fr, fq);
          wave_mm_nt<1, TPW>(rb, RT + it * 16 * 72, 72, BT + jt0 * 16 * 72, 72, 64, fr, fq); wave_mm_nt<1, TPW>(rk, RT + it * 16 * 72, 72, KT + jt0 * 16 * 72, 72, 64, fr, fq);
          const int tt = it * 16 + fr;
#pragma unroll
          for (int q = 0; q < TPW; ++q) { const int s0 = (jt0 + q) * 16 + 4 * fq; f32x4 fab; float fak[4], frb[4], frk[4];
#pragma unroll
              for (int r = 0; r < 4; ++r) { const int sx = s0 + r; fab[r] = (sx < tt) ? ab[0][q][r] : 0.f; fak[r] = (sx < tt) ? ak[0][q][r] : 0.f; frb[r] = (sx <= tt) ? rb[0][q][r] : 0.f; frk[r] = (sx <= tt) ? rk[0][q][r] : 0.f; }
#pragma unroll
              for (int r = 0; r < 4; ++r) AAB[(s0 + r) * 68 + tt] = fab[r];
              u32x2 p; p.x = pk2(fak[0], fak[1]); p.y = pk2(fak[2], fak[3]); *(LAS u32x2*)(AAK + tt * 72 + s0) = p;
              p.x = pk2(frb[0], frb[1]); p.y = pk2(frb[2], frb[3]); *(LAS u32x2*)(ARB + tt * 72 + s0) = p;
              p.x = pk2(frk[0], frk[1]); p.y = pk2(frk[2], frk[3]); *(LAS u32x2*)(ARK + tt * 72 + s0) = p; } } }
    __syncthreads();
    { constexpr int TP3 = NIT / 2; const int it = (w * TP3) / 4, nt0 = (w * TP3) % 4;
      f32x4 ww[1][TP3];
#pragma unroll
      for (int q = 0; q < TP3; ++q) ww[0][q] = (f32x4){0.f, 0.f, 0.f, 0.f};
      wave_mm_nt<1, TP3>(ww, AAK + it * 16 * 72, 72, VT + nt0 * 16 * 72, 72, L, fr, fq);
#pragma unroll
      for (int q = 0; q < TP3; ++q) *(LAS f32x4*)(WW + (it * 16 + fr) * 68 + (nt0 + q) * 16 + 4 * fq) = ww[0][q]; }
    __syncthreads();
    { constexpr int RQ = L / 4, NV4 = RQ / 4; const int col = tid >> 2, qd = tid & 3, cidx = col & 63; const bool isA = col < 64; const float eg = EGM[cidx];
      float x[RQ]; f32x4 aq[3][NV4];
#pragma unroll
      for (int i = 0; i < RQ; ++i) { const int tt = qd * RQ + i; x[i] = isA ? bf2f(AT[tt * 72 + cidx]) * eg : WW[tt * 68 + cidx]; }
      const LAS float* ap = AAB + qd * RQ;
#pragma unroll
      for (int k = 0; k < NV4; ++k) { aq[0][k] = *(const LAS f32x4*)(ap + 4 * k); aq[1][k] = *(const LAS f32x4*)(ap + 68 + 4 * k); }
      if constexpr (!(DRY && (LOCAL_SKIP & 1))) SubstQ<0, L>::run(x, aq, ap);
      LAS bf16_t* dst = (isA ? APT : U0T) + cidx * 72 + qd * RQ;
#pragma unroll
      for (int t8 = 0; t8 < RQ; t8 += 8) { u32x4 p; p.x = pk2(x[t8], x[t8 + 1]); p.y = pk2(x[t8 + 2], x[t8 + 3]); p.z = pk2(x[t8 + 4], x[t8 + 5]); p.w = pk2(x[t8 + 6], x[t8 + 7]); *(LAS u32x4*)(dst + t8) = p; } }
    __syncthreads();
    { const int mt = w >> 1, nt0 = (w & 1) * 2;
      f32x4 pp[1][2], qt[1][2];
#pragma unroll
      for (int q = 0; q < 2; ++q) { pp[0][q] = (f32x4){0.f, 0.f, 0.f, 0.f}; qt[0][q] = pp[0][q]; }
      wave_mm_nt<1, 2>(pp, BHT + mt * 16 * 72, 72, APT + nt0 * 16 * 72, 72, L, fr, fq);
      wave_mm_nt<1, 2>(qt, U0T + mt * 16 * 72, 72, BHT + nt0 * 16 * 72, 72, L, fr, fq); wave_mm_nt<1, 2>(qt, VT + mt * 16 * 72, 72, KHT + nt0 * 16 * 72, 72, L, fr, fq);
      constexpr int TP5 = NIT / 2; const int it = (w * TP5) / 4, rn0 = (w * TP5) % 4;
      f32x4 rp[1][TP5], y0[1][TP5];
#pragma unroll
      for (int q = 0; q < TP5; ++q) { const int j = (rn0 + q) * 16 + 4 * fq; const u32x2 rw = *(const LAS u32x2*)(RT + (it * 16 + fr) * 72 + j); const f32x4 e4 = *(const LAS f32x4*)(EGM + j);
          rp[0][q] = (f32x4){bflo(rw.x) * e4[0], bfhi(rw.x) * e4[1], bflo(rw.y) * e4[2], bfhi(rw.y) * e4[3]}; y0[0][q] = (f32x4){0.f, 0.f, 0.f, 0.f}; }
      wave_mm_nt<1, TP5>(rp, ARB + it * 16 * 72, 72, APT + rn0 * 16 * 72, 72, L, fr, fq);
      wave_mm_nt<1, TP5>(y0, ARB + it * 16 * 72, 72, U0T + rn0 * 16 * 72, 72, L, fr, fq); wave_mm_nt<1, TP5>(y0, ARK + it * 16 * 72, 72, VT + rn0 * 16 * 72, 72, L, fr, fq);
      if constexpr (!SAMPLE) {
          bf16_t* PP = (bf16_t*)(F.ws + WS_REC + ((size_t)c * 16 + h) * REC_B); bf16_t* QQ = PP + 4096;
#pragma unroll
          for (int q = 0; q < 2; ++q) { const int n0 = (nt0 + q) * 16 + 4 * fq; u32x2 p; p.x = pk2(pp[0][q][0], pp[0][q][1]); p.y = pk2(pp[0][q][2], pp[0][q][3]);
              *(u32x2*)(PP + (mt * 16 + fr) * 64 + pperm(n0)) = p;
              p.x = pk2(qt[0][q][0], qt[0][q][1]); p.y = pk2(qt[0][q][2], qt[0][q][3]); *(u32x2*)(QQ + (mt * 16 + fr) * 64 + n0) = p; }
#pragma unroll
          for (int q = 0; q < TP5; ++q) { const size_t row = (size_t)(r0 + it * 16 + fr); const int n0 = (rn0 + q) * 16 + 4 * fq; u32x2 p;
              p.x = pk2(rp[0][q][0], rp[0][q][1]); p.y = pk2(rp[0][q][2], rp[0][q][3]); if constexpr (DRY) asm volatile("" :: "v"(p.x), "v"(p.y)); else *(u32x2*)(RKV + row * 3072 + 1024 + h * 64 + n0) = p;
              p.x = pk2(y0[0][q][0], y0[0][q][1]); p.y = pk2(y0[0][q][2], y0[0][q][3]); if constexpr (DRY) asm volatile("" :: "v"(p.x), "v"(p.y)); else *(u32x2*)(RKV + row * 3072 + h * 64 + n0) = p; }
      } else {
          __syncthreads();
          LAS bf16_t* PL = (LAS bf16_t*)(F.lds + RL_PL); LAS bf16_t* RLs = (LAS bf16_t*)(F.lds + RL_RL); LAS float* Y0L = (LAS float*)(F.lds + RL_Y0L); LAS float* QTL = (LAS float*)(F.lds + RL_QTL); LAS bf16_t* Sl = (LAS bf16_t*)(F.lds + RL_S);
#pragma unroll
          for (int q = 0; q < 2; ++q) { const int n0 = (nt0 + q) * 16 + 4 * fq; u32x2 p; p.x = pk2(pp[0][q][0], pp[0][q][1]); p.y = pk2(pp[0][q][2], pp[0][q][3]);
              *(LAS u32x2*)(PL + (mt * 16 + fr) * 72 + n0) = p; *(LAS f32x4*)(QTL + (mt * 16 + fr) * 68 + n0) = qt[0][q]; }
#pragma unroll
          for (int q = 0; q < TP5; ++q) { const int n0 = (rn0 + q) * 16 + 4 * fq; u32x2 p; p.x = pk2(rp[0][q][0], rp[0][q][1]); p.y = pk2(rp[0][q][2], rp[0][q][3]);
              *(LAS u32x2*)(RLs + (it * 16 + fr) * 72 + n0) = p; *(LAS f32x4*)(Y0L + (it * 16 + fr) * 68 + n0) = y0[0][q]; }
          const int sb = c - 256; const float* sin_ = F.in[I_SWKV] + (((size_t)m * 32 + sb) * 16 + h) * 4096; float* sout = F.out + O_WKVS + (((size_t)m * 32 + sb) * 16 + h) * 4096;
          for (int it2 = tid; it2 < 64 * 16; it2 += NT) { const int i = it2 >> 4, j4 = (it2 & 15) * 4; const f32x4 sv = *(const f32x4*)(sin_ + i * 64 + j4); u32x2 p; p.x = pk2(sv[0], sv[1]); p.y = pk2(sv[2], sv[3]); *(LAS u32x2*)(Sl + i * 72 + j4) = p; }
          __syncthreads();
          if (w < 2) { f32x4 y[1][4];
#pragma unroll
              for (int q = 0; q < 4; ++q) y[0][q] = *(const LAS f32x4*)(Y0L + (w * 16 + fr) * 68 + q * 16 + 4 * fq);
              wave_mm_nt<1, 4>(y, RLs + w * 16 * 72, 72, Sl, 72, 64, fr, fq);
              rwkv_out_epilogue<DRY>(F, m, y[0], (size_t)(r0 + w * 16 + fr), h, fq); }
          else if (w < 6) { const int mi = w - 2; f32x4 tl[1][4];
#pragma unroll
              for (int q = 0; q < 4; ++q) { const int j = q * 16 + 4 * fq; const f32x4 sv = *(const f32x4*)(sin_ + (mi * 16 + fr) * 64 + j), gl4 = *(const LAS f32x4*)(GLV + j), qv = *(const LAS f32x4*)(QTL + (mi * 16 + fr) * 68 + j);
                  tl[0][q] = (f32x4){__expf(gl4[0]) * sv[0] + qv[0], __expf(gl4[1]) * sv[1] + qv[1], __expf(gl4[2]) * sv[2] + qv[2], __expf(gl4[3]) * sv[3] + qv[3]}; }
              wave_mm_nt<1, 4>(tl, Sl + mi * 16 * 72, 72, PL, 72, 64, fr, fq);
#pragma unroll
              for (int q = 0; q < 4; ++q) *(f32x4*)(sout + (mi * 16 + fr) * 64 + q * 16 + 4 * fq) = tl[0][q]; }
      }
    }
}

constexpr int SC_GRP = 4, SC_CH = 8192 + 2048 + 256, SC_BUF = SC_GRP * SC_CH;
__device__ __forceinline__ void rwkv_scan_phase(Frame& F, int layer) {
    const int tid = otid(); const int lane = tid & 63, m = layer >> 1; const int b = blockIdx.x;
    if (b >= 64) return;
    const int h = b >> 2, sl = b & 3;
    const unsigned char* REC = F.ws + WS_REC;
    constexpr int NV = SC_BUF / 16;
    constexpr int NPT = (NV + NT - 1) / NT;
    constexpr int DEPTH = 4;
    struct RegSet { u32x4 v[NPT]; };
    RegSet sets[DEPTH];
    unsigned poff[NPT], pdst[NPT];
#pragma unroll
    for (int q = 0; q < NPT; ++q) { int v = tid + q * NT; v = v < NV ? v : NV - 1; const int cc = v / (SC_CH / 16), o = (v % (SC_CH / 16)) * 16;
        poff[q] = (unsigned)(cc * 16 * REC_B + o + (o >= 10240 ? 6144 : (o >= 8192 ? sl * 2048 : 0))); pdst[q] = (unsigned)(v * 16); }
    auto issue = [&](int g, RegSet& st) { const unsigned char* gb = REC + ((size_t)(g * SC_GRP) * 16 + h) * REC_B;
#pragma unroll
        for (int q = 0; q < NPT; ++q) st.v[q] = *(const u32x4*)(gb + poff[q]); };
    auto commit = [&](int buf, const RegSet& st) {
#pragma unroll
        for (int q = 0; q < NPT; ++q) *(LAS u32x4*)(F.lds + buf * SC_BUF + pdst[q]) = st.v[q]; };
    const int ci = lane & 15, q4 = lane >> 4, i = 16 * sl + ci;
    f32x4 T[4];
#pragma unroll
    for (int mm = 0; mm < 4; ++mm) T[mm] = (f32x4){0.f, 0.f, 0.f, 0.f};
    bf16_t* TST = (bf16_t*)(F.ws + WS_TST);
    constexpr int NG = 256 / SC_GRP;
    static_assert(NG % DEPTH == 0, "scan groups vs prefetch depth");
    issue(0, sets[0]);
#pragma unroll
    for (int d = 1; d < DEPTH; ++d) issue(d, sets[d]);
    commit(0, sets[0]);
    for (int g0 = 0; g0 < NG; g0 += DEPTH) {
#pragma unroll
        for (int dd = 0; dd < DEPTH; ++dd) { const int g = g0 + dd;
        if (g + DEPTH < NG) issue(g + DEPTH, sets[dd]);
        __syncthreads();
        if (F.wave == 0) {
            const LAS unsigned char* base = F.lds + (g & 1) * SC_BUF;
#pragma unroll 1
            for (int cc = 0; cc < SC_GRP; ++cc) { const int c = g * SC_GRP + cc; const LAS unsigned char* cb = base + cc * SC_CH;
                bf16_t* tdst = TST + (((size_t)c * 16 + h) * 64 + i) * 64;
                bf16x8 Tf[2];
#pragma unroll
                for (int mm = 0; mm < 4; ++mm) { u32x2 p; p.x = pk2(T[mm][0], T[mm][1]); p.y = pk2(T[mm][2], T[mm][3]); *(u32x2*)(tdst + 16 * mm + 4 * q4) = p;
                    Tf[mm >> 1][(mm & 1) * 4 + 0] = (short)(p.x & 0xffffu); Tf[mm >> 1][(mm & 1) * 4 + 1] = (short)(p.x >> 16); Tf[mm >> 1][(mm & 1) * 4 + 2] = (short)(p.y & 0xffffu); Tf[mm >> 1][(mm & 1) * 4 + 3] = (short)(p.y >> 16); }
#pragma unroll
                for (int mm = 0; mm < 4; ++mm) { const int j = 16 * mm + 4 * q4; const f32x4 gv = *(const LAS f32x4*)(cb + 10240 + j * 4); const u32x2 qv = *(const LAS u32x2*)(cb + 8192 + (ci * 64 + j) * 2);
                    f32x4 acc = (f32x4){gv[0] * T[mm][0] + bflo(qv.x), gv[1] * T[mm][1] + bfhi(qv.x), gv[2] * T[mm][2] + bflo(qv.y), gv[3] * T[mm][3] + bfhi(qv.y)};
#pragma unroll
                    for (int s = 0; s < 2; ++s) { const bf16x8 pf = *(const LAS bf16x8*)(cb + ((16 * mm + ci) * 64 + 32 * s + 8 * q4) * 2); acc = __builtin_amdgcn_mfma_f32_16x16x32_bf16(pf, Tf[s], acc, 0, 0, 0); }
                    T[mm] = acc; } }
        }
        __syncthreads();
        if (g + 1 < NG) commit((g + 1) & 1, sets[(dd + 1) % DEPTH]);
        }
    }
    if (F.wave == 0) { float* outp = F.out + O_WKVP + ((size_t)m * 16 + h) * 4096 + (size_t)i * 64;
#pragma unroll
        for (int mm = 0; mm < 4; ++mm) *(f32x4*)(outp + 16 * mm + 4 * q4) = T[mm]; }
}

template <bool DRY = false> __device__ __forceinline__ void rwkv_output_phase(Frame& F, int layer) {
    const int tid = otid(); const int lane = tid & 63, fr = lane & 15, fq = lane >> 4, m = layer >> 1;
    const bf16_t* RKV = (const bf16_t*)(F.ws + WS_RKV); const bf16_t* TST = (const bf16_t*)(F.ws + WS_TST);
    const int gw = F.vcu * NWAVES + F.wave, NGW = F.G * NWAVES;
    for (int u = gw; u < 256 * 16 * 4; u += NGW) { const int it = u & 3, h = (u >> 2) & 15, c = u >> 6;
        const size_t row = (size_t)(64 * c + 16 * it + fr); const bf16_t* ts = TST + ((size_t)c * 16 + h) * 4096;
        f32x4 y[4];
#pragma unroll
        for (int nt = 0; nt < 4; ++nt) { const u32x2 yv = *(const u32x2*)(RKV + row * 3072 + h * 64 + 16 * nt + 4 * fq); y[nt] = (f32x4){bflo(yv.x), bfhi(yv.x), bflo(yv.y), bfhi(yv.y)}; }
#pragma unroll
        for (int s = 0; s < 2; ++s) { const bf16x8 xa = *(const bf16x8*)(RKV + row * 3072 + 1024 + h * 64 + 32 * s + 8 * fq);
#pragma unroll
            for (int nt = 0; nt < 4; ++nt) { const bf16x8 yb = *(const bf16x8*)(ts + (16 * nt + fr) * 64 + 32 * s + 8 * fq); y[nt] = __builtin_amdgcn_mfma_f32_16x16x32_bf16(yb, xa, y[nt], 0, 0, 0); } }
        rwkv_out_epilogue<DRY>(F, m, y, row, h, fq);
    }
}

#define GRID_BAR() xcd_barrier(bar)
#ifndef PHASE_MASK
#define PHASE_MASK 0xffffffffu
#endif
#define PH(k) if (PHASE_MASK & (1u << (k)))
#ifndef REP_MASK
#define REP_MASK 0u
#endif
#define REP(k) (((REP_MASK) >> (k)) & 1u)
#ifndef LOCAL_SKIP
#define LOCAL_SKIP 0
#endif
#ifndef EXTRA_BARS
#define EXTRA_BARS 0
#endif
template <int layer> __device__ __forceinline__ void layer_body(Frame& F, const XcdBarrier& bar) {
    unsigned char* ws = F.ws; unsigned char* ar = ws + WS_ARENA;
    bf16_t* XN = (bf16_t*)(ws + WS_XN);
    const float* MOD = (const float*)(ws + WS_MOD);
    constexpr int m = layer >> 1; const float* modl = MOD + (size_t)layer * NSEQ * 6144;
    PH(1) for (int rep = 0; rep <= (int)REP(1); ++rep) if (layer > 0) convert_layer_weights(F, layer);
    if constexpr ((layer & 1) == 0) {
        PH(2) for (int rep = 0; rep <= (int)REP(2); ++rep) norm_pass<0>(F, layer);
        GRID_BAR();
        PH(3) { using GC = pg8::Geo<D, D, D, 30, 0, 1 << 20, 0>; pg8::Gemm<GC> g{XN, (const bf16_t*)(ar + AR_WIN), nullptr}; pg8::StaticOrder S; S.init(M, ABIN, F.G, (int)blockIdx.x);
          pg8::EpiBf16<0> E{(bf16_t*)(ws + WS_Z), ABIN};
          pg8::gemm_phase<pg8::EpiBf16<0>, pg8::StaticOrder, GC, true, true>(F.lds, g, S, E);
          if (REP(3)) { pg8::EpiNull<true> EN; pg8::gemm_phase<pg8::EpiNull<true>, pg8::StaticOrder, GC, true, true>(F.lds, g, S, EN); } }
        GRID_BAR();
        PH(4) for (int rep = 0; rep <= (int)REP(4); ++rep) for (int u = F.vcu; u < NCHUNK * 8; u += F.G) { const int c = u >> 3, hh = u & 7;
            if (c < 256) { if (hh < 4) ab_summary_unit<64, false>(F, layer, c, hh); else ab_summary_unit<64, true>(F, layer, c, hh - 4); }
            else { if (hh < 4) ab_summary_unit<32, false>(F, layer, c, hh); else ab_summary_unit<32, true>(F, layer, c, hh - 4); } }
        GRID_BAR();
        PH(5) { if (REP(5)) ab_scan<true>(F, layer); ab_scan<false>(F, layer); }
        GRID_BAR();
        PH(6) for (int rep = 0; rep <= (int)REP(6); ++rep) for (int u = F.vcu; u < NCHUNK * 8; u += F.G) { const int c = u >> 3, hh = u & 7;
            if (c < 256) { if (hh < 4) ab_output_unit<64, false>(F, layer, c, hh); else ab_output_unit<64, true>(F, layer, c, hh - 4); }
            else { if (hh < 4) ab_output_unit<32, false>(F, layer, c, hh); else ab_output_unit<32, true>(F, layer, c, hh - 4); } }
        GRID_BAR();
        PH(7) { using GC = pg8::Geo<D, D, D, 30, 0, 1 << 20, 0>; pg8::Gemm<GC> g{XN, (const bf16_t*)(ar + AR_WOUT), nullptr}; pg8::StaticOrder S; S.init(M, D, F.G, (int)blockIdx.x);
          pg8::EpiRes E{F.out, modl, 2048};
          pg8::gemm_phase<pg8::EpiRes, pg8::StaticOrder, GC, true, true>(F.lds, g, S, E);
          if (REP(7)) { pg8::EpiNull<false> EN; pg8::gemm_phase<pg8::EpiNull<false>, pg8::StaticOrder, GC, true, true>(F.lds, g, S, EN); } }
        GRID_BAR();
    } else {
        PH(8) for (int rep = 0; rep <= (int)REP(8); ++rep) norm_pass<1>(F, layer);
        GRID_BAR();
        PH(9) { using GC = pg8::Geo<D, 2048, 2048, 30, 0, 16, -4096>; pg8::Gemm<GC> g{XN, (const bf16_t*)(ar + AR_WC1), (const bf16_t*)(ws + WS_PREVS)}; pg8::StaticOrder S; S.init(M, 4096, F.G, (int)blockIdx.x);
          pg8::EpiRkv E{(bf16_t*)(ws + WS_RKV), (bf16_t*)(ws + WS_LO), (m == 0) ? (bf16_t*)(ws + WS_VFIRST) : nullptr};
          pg8::gemm_phase<pg8::EpiRkv, pg8::StaticOrder, GC, true, true>(F.lds, g, S, E);
          if (REP(9)) { pg8::EpiNull<true> EN; pg8::gemm_phase<pg8::EpiNull<true>, pg8::StaticOrder, GC, true, true>(F.lds, g, S, EN); } }
        GRID_BAR();
        PH(10) { using GC = pg8::Geo<D, 256, 256, 2, 256, 1 << 20, 0>; pg8::Gemm<GC> g{(const bf16_t*)(ws + WS_LO), (const bf16_t*)(ar + AR_WC2), nullptr}; pg8::StaticOrder S; S.init(M, 4096, F.G, (int)blockIdx.x);
          pg8::EpiLora2 E{(bf16_t*)(ws + WS_WLOG), XN, (bf16_t*)(ws + WS_G), (bf16_t*)(ws + WS_RKV), (m == 1) ? (const bf16_t*)(ws + WS_VFIRST) : nullptr,
                          F.in[I_RW0] + m * D, F.in[I_RA0] + m * D, F.in[I_RV0]};
          pg8::gemm_phase<pg8::EpiLora2, pg8::StaticOrder, GC, true, true>(F.lds, g, S, E);
          if (REP(10)) { pg8::EpiNull<false> EN; pg8::gemm_phase<pg8::EpiNull<false>, pg8::StaticOrder, GC, true, true>(F.lds, g, S, EN); } }
        GRID_BAR();
        PH(11) { if (REP(11)) for (int u = F.vcu; u < NCHUNK * 16; u += F.G) { const int c = u >> 4, hh = u & 15; if (c < 256) rwkv_local_unit<64, true>(F, layer, c, hh); else rwkv_local_unit<32, true>(F, layer, c, hh); }
          for (int u = F.vcu; u < NCHUNK * 16; u += F.G) { const int c = u >> 4, hh = u & 15; if (c < 256) rwkv_local_unit<64>(F, layer, c, hh); else rwkv_local_unit<32>(F, layer, c, hh); } }
        GRID_BAR();
        PH(17) for (int rep = 0; rep <= (int)REP(17); ++rep) rwkv_scan_phase(F, layer);
        GRID_BAR();
        PH(18) { if (REP(18)) rwkv_output_phase<true>(F, layer); rwkv_output_phase<false>(F, layer); }
        GRID_BAR();
        PH(12) { using GC = pg8::Geo<3072, D, D, 30, 0, 1 << 20, 0>; pg8::Gemm<GC> g{(const bf16_t*)(ws + WS_RKV), (const bf16_t*)(ar + AR_WO), nullptr}; pg8::StaticOrder S; S.init(M, D, F.G, (int)blockIdx.x);
          pg8::EpiRes E{F.out, modl, 2048};
          pg8::gemm_phase<pg8::EpiRes, pg8::StaticOrder, GC, true, true>(F.lds, g, S, E);
          if (REP(12)) { pg8::EpiNull<false> EN; pg8::gemm_phase<pg8::EpiNull<false>, pg8::StaticOrder, GC, true, true>(F.lds, g, S, EN); } }
        GRID_BAR();
    }
    PH(13) for (int rep = 0; rep <= (int)REP(13); ++rep) norm_pass<2>(F, layer);
    GRID_BAR();
    PH(14) { using GC = pg8::Geo<D, D, D, 30, 0, 1 << 20, 0>; pg8::Gemm<GC> g{XN, (const bf16_t*)(ar + AR_W1), nullptr}; pg8::StaticOrder S; S.init(M, DFF, F.G, (int)blockIdx.x);
      pg8::EpiBf16<1> E{(bf16_t*)(ws + WS_H), DFF};
      pg8::gemm_phase<pg8::EpiBf16<1>, pg8::StaticOrder, GC, true, true>(F.lds, g, S, E);
          if (REP(14)) { pg8::EpiNull<true> EN; pg8::gemm_phase<pg8::EpiNull<true>, pg8::StaticOrder, GC, true, true>(F.lds, g, S, EN); } }
    GRID_BAR();
    PH(15) { using GC = pg8::Geo<DFF, DFF, DFF, 30, 0, 1 << 20, 0>; pg8::Gemm<GC> g{(const bf16_t*)(ws + WS_H), (const bf16_t*)(ar + AR_W2), nullptr}; pg8::StaticOrder S; S.init(M, D, F.G, (int)blockIdx.x);
      pg8::EpiRes E{F.out, modl, 5120};
      for (int xb = 0; xb < EXTRA_BARS; ++xb) GRID_BAR();
      pg8::gemm_phase<pg8::EpiRes, pg8::StaticOrder, GC, true, true>(F.lds, g, S, E);
          if (REP(15)) { pg8::EpiNull<false> EN; pg8::gemm_phase<pg8::EpiNull<false>, pg8::StaticOrder, GC, true, true>(F.lds, g, S, EN); } }
    GRID_BAR();
}

__global__ void __launch_bounds__(NT, 2) fwd_kernel(Args args) {
    extern __shared__ __attribute__((aligned(16))) unsigned char lds[];
    Frame F;
    F.lds = (LAS unsigned char*)lds; F.MISC = (volatile LAS unsigned*)(F.lds + MISC_OFF);
    F.wave = __builtin_amdgcn_readfirstlane(threadIdx.x >> 6);
    F.G = gridDim.x; { const int bx = blockIdx.x; F.vcu = (F.G % 8 == 0) ? (bx % 8) * (F.G / 8) + bx / 8 : bx; }
    F.in = args.in; F.out = args.out; F.ws = args.ws;
    for (int u = threadIdx.x; u < (LDS_BYTES - LDSCTL_OFF) / 4; u += NT) ((LAS unsigned*)(F.lds + LDSCTL_OFF))[u] = 0u;
    __syncthreads();
    XcdBarrier bar = xcd_barrier_post((unsigned*)(F.ws + WS_CTL) + CW_BAR, F.MISC + 8);
    PH(0) prologue(F);
    GRID_BAR();
    PH(0) mod_phase(F);
    GRID_BAR();
    layer_body<0>(F, bar); layer_body<1>(F, bar); layer_body<2>(F, bar); layer_body<3>(F, bar);
    PH(16) norm_pass<3>(F, 0);
}

extern "C" void kernel_launch(void* const* d_in, const int* in_sizes, int n_in, void* d_out, int out_size, void* d_ws, size_t ws_size, hipStream_t stream) {
    static int grid = 0;
    if (grid == 0) {
        if (n_in != 38 || out_size != 28706816 || ws_size < WS_END) { fprintf(stderr, "kernel_launch: unexpected problem (n_in %d, out %d, ws %zu; need ws >= %zu)\n", n_in, out_size, ws_size, (size_t)WS_END); grid = -1; return; }
        int dev = 0, cus = 0, per_cu = 0;
        if (hipGetDevice(&dev) != hipSuccess || hipDeviceGetAttribute(&cus, hipDeviceAttributeMultiprocessorCount, dev) != hipSuccess) { grid = -1; return; }
        if (hipFuncSetAttribute((const void*)fwd_kernel, hipFuncAttributeMaxDynamicSharedMemorySize, LDS_BYTES) != hipSuccess) { fprintf(stderr, "kernel_launch: hipFuncSetAttribute failed\n"); grid = -1; return; }
        if (hipOccupancyMaxActiveBlocksPerMultiprocessor(&per_cu, (const void*)fwd_kernel, NT, LDS_BYTES) != hipSuccess || per_cu < 1) { fprintf(stderr, "kernel_launch: occupancy query says %d\n", per_cu); per_cu = 1; }
        (void)hipGetLastError();
        grid = cus;
    }
    if (grid < 0) return;
    (void)hipMemsetAsync((char*)d_ws + WS_CTL, 0, ZERO_BYTES, stream);
    Args a{};
    for (int i = 0; i < 38; ++i) a.in[i] = (const float*)d_in[i];
    a.out = (float*)d_out; a.ws = (unsigned char*)d_ws;
    void* kargs[] = {&a};
    hipError_t e = hipLaunchCooperativeKernel((const void*)fwd_kernel, dim3(grid), dim3(NT), kargs, LDS_BYTES, stream);
    if (e != hipSuccess) fprintf(stderr, "kernel_launch: cooperative launch failed: %s (grid %d)\n", hipGetErrorString(e), grid);
}
```

```cpp
#include <hip/hip_runtime.h>
#include <cstdio>
#include <cstdint>

#define LAS __attribute__((address_space(3)))
#define GAS __attribute__((address_space(1)))
typedef unsigned short bf16_t;
typedef short bf16x8 __attribute__((ext_vector_type(8)));
typedef float f32x4 __attribute__((ext_vector_type(4)));
typedef float f32x2 __attribute__((ext_vector_type(2)));
typedef unsigned u32x4 __attribute__((ext_vector_type(4)));
typedef unsigned u32x2 __attribute__((ext_vector_type(2)));

#ifndef LOCAL_SKIP
#define LOCAL_SKIP 0
#endif
constexpr int D = 1024, MP = 16384, MS = 1024, M = MP + MS, NSEQ = 33, DFF = 4096, ABIN = 3584;
constexpr int NCHUNK = 288;
constexpr int SLOT_E = 4 * 8192 + 4 * 16384;
constexpr float NORM_EPS = 1e-6f, RW_LN_EPS = 64e-5f;

constexpr size_t MiB = 1u << 20;
constexpr size_t WS_CTL = 0, WS_MOD = 1 * MiB, ZERO_BYTES = 65536;
constexpr size_t WS_ROPE = 5 * MiB;
constexpr size_t WS_ARENA = 10 * MiB;
constexpr size_t AR_W1 = 0, AR_W2 = 8 * MiB, AR_WIN = 16 * MiB, AR_WOUT = 23 * MiB, AR_WC1 = 16 * MiB, AR_WC2 = 32 * MiB, AR_WO = 34 * MiB;
constexpr size_t WS_VFIRST = 46 * MiB;
constexpr size_t WS_XN0 = 80 * MiB, WS_XN = WS_XN0 + 2048;
constexpr size_t WS_PREVS = 115 * MiB;
constexpr size_t WS_R1 = 118 * MiB;
constexpr size_t WS_Z = WS_R1, WS_STATE = WS_R1 + 120 * MiB, WS_DEC = WS_R1 + 174 * MiB;
constexpr size_t WS_H = WS_R1;
constexpr size_t WS_RKV = WS_R1, WS_LO = WS_R1 + 102 * MiB, WS_WLOG = WS_R1 + 136 * MiB, WS_G = WS_R1 + 170 * MiB;
constexpr size_t WS_TST = WS_R1 + 102 * MiB;
constexpr size_t WS_REC = WS_R1 + 204 * MiB, WS_BON = WS_R1 + 269 * MiB;
constexpr int REC_B = 16640;
constexpr size_t WS_PART = WS_R1 + 136 * MiB;
constexpr size_t WS_END = WS_R1 + 271 * MiB;

__device__ const double ROPE_REV[32] = {0.15915494309189535, 0.11934937021124886, 0.089499401608891013, 0.067115083005227255, 0.050329212104487035, 0.037741584717419771, 0.028302195830623399, 0.02122365276477766, 0.015915494309189534, 0.011934937021124886, 0.0089499401608891024, 0.0067115083005227253, 0.0050329212104487037, 0.0037741584717419772, 0.0028302195830623399, 0.0021223652764777662, 0.0015915494309189536, 0.0011934937021124885, 0.00089499401608891024, 0.0006711508300522726, 0.00050329212104487033, 0.00037741584717419774, 0.00028302195830623395, 0.00021223652764777661, 0.00015915494309189535, 0.00011934937021124886, 8.9499401608891018e-05, 6.7115083005227254e-05, 5.0329212104487035e-05, 3.7741584717419777e-05, 2.8302195830623396e-05, 2.1223652764777659e-05};

__device__ __forceinline__ unsigned f2bf(float f) { unsigned u = __builtin_bit_cast(unsigned, f); return (u + 0x7fffu + ((u >> 16) & 1u)) >> 16; }
typedef __bf16 bf16x2_t __attribute__((ext_vector_type(2)));
__device__ __forceinline__ unsigned pk2(float lo, float hi) { const f32x2 v = {lo, hi}; const bf16x2_t b = __builtin_convertvector(v, bf16x2_t); return __builtin_bit_cast(unsigned, b); }
__device__ __forceinline__ float bf2f(unsigned short b) { return __builtin_bit_cast(float, (unsigned)b << 16); }
__device__ __forceinline__ float bflo(unsigned w) { return __builtin_bit_cast(float, w << 16); }
__device__ __forceinline__ float bfhi(unsigned w) { return __builtin_bit_cast(float, w & 0xffff0000u); }
__device__ __forceinline__ float sigmoidf_(float x) { return 1.f / (1.f + __expf(-x)); }
__device__ __forceinline__ float siluf_(float x) { return x / (1.f + __expf(-x)); }
__device__ __forceinline__ float wave_sum(float v) {
#pragma unroll
    for (int o = 1; o < 64; o <<= 1) v += __shfl_xor(v, o);
    return v;
}
__device__ __forceinline__ int otid() { int t = threadIdx.x; asm volatile("" : "+v"(t)); return t; }
__device__ __forceinline__ int seq_of_row(int r) { return r < MP ? 0 : 1 + ((r - MP) >> 5); }
#define LDS_WAIT() asm volatile("s_waitcnt lgkmcnt(0)" ::: "memory")
#define VM_WAIT() asm volatile("s_waitcnt vmcnt(0)" ::: "memory")

namespace pg8 {
constexpr int BM = 256, BK = 64, HALF = 128, HTB = HALF * BK * 2, STAGE_BYTES = 8 * HTB, NXCD = 8, WGM = 8;
__host__ __device__ __forceinline__ int lds_byte(int r, int c) { const int st = (r >> 4) * 2 + (c >> 5), rr = r & 15, cc = c & 31, ob = rr * 64 + cc * 2; return st * 1024 + (ob ^ (((ob >> 9) & 1) << 5)); }
__host__ __device__ __forceinline__ void stage_rc(int b, int& R, int& C) { const int st = b / 1024, sb = b % 1024, swz = sb ^ (((sb >> 9) & 1) << 5); R = (st >> 1) * 16 + swz / 64; C = (st & 1) * 32 + (swz % 64) / 2; }
__host__ __device__ __forceinline__ int perm32(int rho) { const int n = rho >> 4, i = rho & 15; return 8 * (i >> 2) + 4 * n + (i & 3); }

struct Unit { int pm, pn, ks; };
template <int LDA_, int LDB_, int K_, int GSHIFT_, int GSTRIDE_, int KSPLIT_, int DELTAP_, bool SPLIT_ = false> struct Geo {
    static constexpr int LDA = LDA_, LDB = LDB_, K = K_, GSHIFT = GSHIFT_, GSTRIDE = GSTRIDE_, KSPLIT = KSPLIT_, DELTAP = DELTAP_; static constexpr bool SPLIT = SPLIT_;
};
template <class GC> struct Gemm {
    const bf16_t* A; const bf16_t* Bt; const bf16_t* A2s;
    __device__ __forceinline__ const char* a_base(const Unit& u) const { return (const char*)(A + (size_t)u.pm * BM * GC::LDA + (size_t)(u.pn >> GC::GSHIFT) * GC::GSTRIDE + (GC::SPLIT ? (size_t)u.ks * GC::K : 0)); }
    __device__ __forceinline__ const char* b_base(const Unit& u) const { return (const char*)(Bt + (size_t)u.pn * BM * GC::LDB + (GC::SPLIT ? (size_t)u.ks * GC::K : 0)); }
    __device__ __forceinline__ long a_delta(const Unit& u) const {
        if constexpr (GC::KSPLIT >= GC::K / BK) return 0;
        else { if (u.pm < 64) return (long)GC::DELTAP;
            return (long)((const char*)(A2s + (size_t)(u.pm - 64) * BM * GC::LDA) - a_base(u)) - (long)GC::KSPLIT * BK * 2; }
    }
};
struct StaticOrder {
    int nM, nN, nwg, G, c;
    __host__ __device__ void init(int M_, int N_, int G_, int c_) { nM = M_ / BM; nN = N_ / BM; nwg = nM * nN; G = G_; c = c_; }
    __host__ __device__ bool next(int i, Unit& u) const {
        const long L = (long)i * G + c; if (L >= nwg) return false;
        int wgid = (int)L; { const int q = nwg / NXCD, r = nwg % NXCD, xcd = wgid % NXCD, off = wgid / NXCD; wgid = (xcd < r ? xcd * (q + 1) : r * (q + 1) + (xcd - r) * q) + off; }
        const int nig = WGM * nN, gid = wgid / nig, fm = gid * WGM, gsz = (nM - fm) < WGM ? (nM - fm) : WGM;
        u.pm = fm + ((wgid % nig) % gsz); u.pn = (wgid % nig) / gsz; u.ks = 0; return true;
    }
};
__device__ __forceinline__ unsigned cvt_pk_bf16(float lo, float hi) { return pk2(lo, hi); }

template <class Epi, class Sched, class GC, bool ALIGN_EPI = false, bool SP2 = false>
__device__ __forceinline__ void gemm_phase(LAS unsigned char* lds, const Gemm<GC> g, const Sched& S, const Epi& E) {
    const int tid = otid(), wid = __builtin_amdgcn_readfirstlane(tid >> 6), lane = tid & 63, wr = wid >> 2, wc = wid & 3, fr = lane & 15, fq = lane >> 4;
    constexpr int K = GC::K, nt = K / BK, ksplit = GC::KSPLIT;
    unsigned voffA[2], voffB[2];
#pragma unroll
    for (int i = 0; i < 2; ++i) { int R, C; stage_rc(tid * 16 + i * 8192, R, C); const int Rb = Epi::PERM ? ((R & ~31) + perm32(R & 31)) : R;
        voffA[i] = (unsigned)(R * GC::LDA + C) * 2u; voffB[i] = (unsigned)(Rb * GC::LDB + C) * 2u; }
    constexpr size_t kstep = (size_t)(BK * 2);
    constexpr size_t hstepA = (size_t)HALF * GC::LDA * 2, hstepB = (size_t)HALF * GC::LDB * 2;
    const unsigned ldsw = (unsigned)wid * 1024u;
    const int aoff = lds_byte(wr * 64 + fr, fq * 8), boff = lds_byte(wc * 32 + fr, fq * 8);
#define PG8_SA(b, h) (((b) * 2 + (h)) * HTB)
#define PG8_SB(b, h) ((4 + (b) * 2 + (h)) * HTB)
#define PG8_STAGE(bufoff, gbase, voff) do { _Pragma("unroll") for (int _i = 0; _i < 2; ++_i) \
        __builtin_amdgcn_global_load_lds((const unsigned*)((const char*)(gbase) + (voff)[_i]), (LAS unsigned*)(lds + (bufoff) + ldsw + _i * 8192), 16, 0, 0); } while (0)
#define PG8_LDA(dst, b, h) do { _Pragma("unroll") for (int m = 0; m < 4; ++m) _Pragma("unroll") for (int k = 0; k < 2; ++k) dst[m][k] = *(const LAS bf16x8*)(lds + PG8_SA(b, h) + aoff + m * 2048 + k * 1024); } while (0)
#define PG8_LDB(dst, b, h) do { _Pragma("unroll") for (int n = 0; n < 2; ++n) _Pragma("unroll") for (int k = 0; k < 2; ++k) dst[n][k] = *(const LAS bf16x8*)(lds + PG8_SB(b, h) + boff + n * 2048 + k * 1024); } while (0)
#define PG8_MMA(ai, bj, At, Bt) do { __builtin_amdgcn_s_setprio(1); _Pragma("unroll") for (int m = 0; m < 4; ++m) _Pragma("unroll") for (int n = 0; n < 2; ++n) _Pragma("unroll") for (int k = 0; k < 2; ++k) \
        acc[ai][bj][m][n] = __builtin_amdgcn_mfma_f32_16x16x32_bf16(Bt[n][k], At[m][k], acc[ai][bj][m][n], 0, 0, 0); __builtin_amdgcn_s_setprio(0); } while (0)
#define PG8_WAIT_V(n) asm volatile("s_waitcnt vmcnt(" #n ")" ::: "memory")
#define PG8_WAIT_L(n) asm volatile("s_waitcnt lgkmcnt(" #n ")" ::: "memory")
#define PG8_BAR __builtin_amdgcn_s_barrier()
#define PG8_SCHED __builtin_amdgcn_sched_barrier(0)
    Unit cur, nxt; int ui = 0;
    if (!S.next(0, cur)) return;
    f32x4 acc[2][2][4][2];
#pragma unroll
    for (int a = 0; a < 2; ++a)
#pragma unroll
        for (int b = 0; b < 2; ++b)
#pragma unroll
            for (int m = 0; m < 4; ++m)
#pragma unroll
                for (int n = 0; n < 2; ++n) acc[a][b][m][n] = (f32x4){0.f, 0.f, 0.f, 0.f};
    bf16x8 At[4][2], B0[2][2], B1[2][2];
    const char* cA = g.a_base(cur); const char* cB = g.b_base(cur); long cD = g.a_delta(cur);
    if constexpr (SP2) {
        PG8_STAGE(PG8_SB(0, 0), cB, voffB); PG8_STAGE(PG8_SB(0, 1), cB + hstepB, voffB); PG8_STAGE(PG8_SA(0, 0), cA, voffA); PG8_STAGE(PG8_SA(0, 1), cA + hstepA, voffA);
        if (wr == 1) PG8_BAR;
        PG8_WAIT_V(2); PG8_BAR;
        PG8_STAGE(PG8_SB(1, 0), cB + kstep, voffB); PG8_STAGE(PG8_SA(1, 0), cA + kstep, voffA); PG8_STAGE(PG8_SB(1, 1), cB + hstepB + kstep, voffB);
        PG8_WAIT_V(6); PG8_BAR;
    } else {
        PG8_STAGE(PG8_SB(0, 0), cB, voffB); PG8_STAGE(PG8_SA(0, 0), cA, voffA); PG8_STAGE(PG8_SB(0, 1), cB + hstepB, voffB); PG8_STAGE(PG8_SA(0, 1), cA + hstepA, voffA);
        if (wr == 1) PG8_BAR;
        PG8_WAIT_V(4); PG8_BAR;
        PG8_STAGE(PG8_SB(1, 0), cB + kstep, voffB); PG8_STAGE(PG8_SA(1, 0), cA + kstep, voffA); PG8_STAGE(PG8_SB(1, 1), cB + hstepB + kstep, voffB);
        PG8_WAIT_V(6); PG8_BAR;
    }
    for (;;) {
        const bool has_next = S.next(ui + 1, nxt);
        const char* nA = has_next ? g.a_base(nxt) : cA; const char* nB = has_next ? g.b_base(nxt) : cB;
        const long nD = has_next ? g.a_delta(nxt) : cD;
#pragma unroll 1
        for (int t = 0; t < nt; t += 2) {
            const bool last = (t == nt - 2);
            const char* a1 = cA + (size_t)(t + 1) * kstep + (t >= ksplit ? cD : 0);
            const char* a2 = last ? nA : cA + (size_t)(t + 2) * kstep + (t + 2 >= ksplit ? cD : 0); const char* b2 = last ? nB : cB + (size_t)(t + 2) * kstep;
            const char* a3 = a2 + kstep; const char* b3 = b2 + kstep;
            if constexpr (SP2) {
            PG8_LDB(B0, 0, 0); PG8_LDB(B1, 0, 1); PG8_SCHED; PG8_LDA(At, 0, 0); PG8_STAGE(PG8_SA(1, 1), a1 + hstepA, voffA);
            PG8_WAIT_V(8); PG8_WAIT_L(0); PG8_BAR; PG8_MMA(0, 0, At, B0); PG8_MMA(0, 1, At, B1); PG8_BAR; PG8_SCHED;
            PG8_LDA(At, 0, 1); PG8_STAGE(PG8_SB(0, 0), b2, voffB); PG8_STAGE(PG8_SB(0, 1), b2 + hstepB, voffB); PG8_STAGE(PG8_SA(0, 0), a2, voffA);
            PG8_WAIT_V(8); PG8_WAIT_L(0); PG8_BAR; PG8_MMA(1, 0, At, B0); PG8_MMA(1, 1, At, B1); PG8_BAR; PG8_SCHED;
            PG8_LDB(B0, 1, 0); PG8_LDB(B1, 1, 1); PG8_SCHED; PG8_LDA(At, 1, 0); PG8_STAGE(PG8_SA(0, 1), a2 + hstepA, voffA);
            PG8_WAIT_V(8); PG8_WAIT_L(0); PG8_BAR; PG8_MMA(0, 0, At, B0); PG8_MMA(0, 1, At, B1); PG8_BAR; PG8_SCHED;
            PG8_LDA(At, 1, 1); PG8_STAGE(PG8_SB(1, 0), b3, voffB); PG8_STAGE(PG8_SB(1, 1), b3 + hstepB, voffB); PG8_STAGE(PG8_SA(1, 0), a3, voffA);
            PG8_WAIT_V(8); PG8_WAIT_L(0); PG8_BAR; PG8_MMA(1, 0, At, B0); PG8_MMA(1, 1, At, B1); PG8_BAR; PG8_SCHED;
            } else {
            PG8_LDB(B0, 0, 0); PG8_SCHED; PG8_LDA(At, 0, 0); PG8_STAGE(PG8_SA(1, 1), a1 + hstepA, voffA);
            PG8_WAIT_L(8); PG8_BAR; PG8_WAIT_L(0); PG8_MMA(0, 0, At, B0); PG8_BAR; PG8_SCHED;
            PG8_LDB(B1, 0, 1); PG8_STAGE(PG8_SB(0, 0), b2, voffB);
            PG8_BAR; PG8_WAIT_L(0); PG8_MMA(0, 1, At, B1); PG8_BAR;
            PG8_LDA(At, 0, 1); PG8_STAGE(PG8_SA(0, 0), a2, voffA);
            PG8_BAR; PG8_WAIT_L(0); PG8_MMA(1, 0, At, B0); PG8_BAR; PG8_SCHED;
            PG8_STAGE(PG8_SB(0, 1), b2 + hstepB, voffB);
            PG8_WAIT_V(6); PG8_BAR; PG8_MMA(1, 1, At, B1); PG8_BAR;
            PG8_LDB(B0, 1, 0); PG8_SCHED; PG8_LDA(At, 1, 0); PG8_STAGE(PG8_SA(0, 1), a2 + hstepA, voffA);
            PG8_WAIT_L(8); PG8_BAR; PG8_WAIT_L(0); PG8_MMA(0, 0, At, B0); PG8_BAR; PG8_SCHED;
            PG8_LDB(B1, 1, 1); PG8_STAGE(PG8_SB(1, 0), b3, voffB);
            PG8_BAR; PG8_WAIT_L(0); PG8_MMA(0, 1, At, B1); PG8_BAR;
            PG8_LDA(At, 1, 1); PG8_STAGE(PG8_SA(1, 0), a3, voffA);
            PG8_BAR; PG8_WAIT_L(0); PG8_MMA(1, 0, At, B0); PG8_BAR; PG8_SCHED;
            PG8_STAGE(PG8_SB(1, 1), b3 + hstepB, voffB);
            PG8_WAIT_V(6); PG8_BAR; PG8_MMA(1, 1, At, B1); PG8_BAR;
            }
        }
        if constexpr (ALIGN_EPI) { if (wr == 0) PG8_BAR; }
        E(acc, cur, wr, wc, fr, fq);
        if (!has_next) break;
#pragma unroll
        for (int a = 0; a < 2; ++a)
#pragma unroll
            for (int b = 0; b < 2; ++b)
#pragma unroll
                for (int m = 0; m < 4; ++m)
#pragma unroll
                    for (int n = 0; n < 2; ++n) acc[a][b][m][n] = (f32x4){0.f, 0.f, 0.f, 0.f};
        cur = nxt; cA = nA; cB = nB; cD = nD; ++ui;
        if constexpr (ALIGN_EPI) { if (wr == 1) PG8_BAR; }
    }
    PG8_WAIT_V(0);
    if constexpr (!ALIGN_EPI) { if (wr == 0) PG8_BAR; }
    PG8_BAR;
#undef PG8_SA
#undef PG8_SB
#undef PG8_STAGE
#undef PG8_LDA
#undef PG8_LDB
#undef PG8_MMA
#undef PG8_WAIT_V
#undef PG8_WAIT_L
#undef PG8_BAR
#undef PG8_SCHED
}

__device__ __forceinline__ float act_apply(float v, int act) {
    if (act == 1) { const float r = v > 0.f ? v : 0.f; return r * r; }
    if (act == 2) { const float e = __expf(-2.f * fabsf(v)); const float t = (1.f - e) / (1.f + e); return v < 0.f ? -t : t; }
    if (act == 3) return 1.f / (1.f + __expf(-v));
    return v;
}
template <int ACT> __device__ __forceinline__ void store_tile_bf16(const f32x4 (&acc)[2][2][4][2], bf16_t* base, int ldc, int row0, int col0, bf16_t* base2, int ldc2, int col2) {
#pragma unroll
    for (int ai = 0; ai < 2; ++ai)
#pragma unroll
        for (int m = 0; m < 4; ++m) { const size_t r = (size_t)(row0 + ai * HALF + m * 16);
#pragma unroll
            for (int bj = 0; bj < 2; ++bj) { f32x4 v0 = acc[ai][bj][m][0], v1 = acc[ai][bj][m][1];
#pragma unroll
                for (int q = 0; q < 4; ++q) { v0[q] = act_apply(v0[q], ACT); v1[q] = act_apply(v1[q], ACT); }
                u32x4 w; w.x = cvt_pk_bf16(v0[0], v0[1]); w.y = cvt_pk_bf16(v0[2], v0[3]); w.z = cvt_pk_bf16(v1[0], v1[1]); w.w = cvt_pk_bf16(v1[2], v1[3]);
                *(u32x4*)(base + r * ldc + col0 + bj * HALF) = w;
                if (base2) *(u32x4*)(base2 + r * ldc2 + col2 + bj * HALF) = w; } }
}
template <int ACT> struct EpiBf16 {
    static constexpr bool PERM = true;
    bf16_t* O; int ldc;
    __device__ __forceinline__ void operator()(const f32x4 (&acc)[2][2][4][2], const Unit& u, int wr, int wc, int fr, int fq) const {
        store_tile_bf16<ACT>(acc, O, ldc, u.pm * BM + wr * 64 + fr, u.pn * BM + wc * 32 + 8 * fq, nullptr, 0, 0);
    }
};
struct EpiRkv {
    static constexpr bool PERM = true;
    bf16_t* RKV; bf16_t* LO; bf16_t* vf;
    __device__ __forceinline__ void operator()(const f32x4 (&acc)[2][2][4][2], const Unit& u, int wr, int wc, int fr, int fq) const {
        const int row0 = u.pm * BM + wr * 64 + fr, cin = wc * 32 + 8 * fq;
        if (u.pn < 12) { bf16_t* b2 = (u.pn >= 8) ? vf : nullptr; store_tile_bf16<0>(acc, RKV, 3072, row0, u.pn * BM + cin, b2, 1024, (u.pn - 8) * BM + cin); }
        else {
#pragma unroll
            for (int bj = 0; bj < 2; ++bj) { const int c = cin + bj * HALF; int dst = -1, act = 0;
                if (u.pn == 12) { if (c < 64) { dst = c; act = 2; } else if (c < 128) dst = 256 + (c - 64); else if (c < 160) dst = 512 + (c - 128); }
                else if (c < 160) { dst = 768 + c; act = 3; }
                if (dst >= 0) {
#pragma unroll
                    for (int ai = 0; ai < 2; ++ai)
#pragma unroll
                        for (int m = 0; m < 4; ++m) { const size_t r = (size_t)(row0 + ai * HALF + m * 16); f32x4 v0 = acc[ai][bj][m][0], v1 = acc[ai][bj][m][1];
#pragma unroll
                            for (int q = 0; q < 4; ++q) { v0[q] = act_apply(v0[q], act); v1[q] = act_apply(v1[q], act); }
                            u32x4 w; w.x = cvt_pk_bf16(v0[0], v0[1]); w.y = cvt_pk_bf16(v0[2], v0[3]); w.z = cvt_pk_bf16(v1[0], v1[1]); w.w = cvt_pk_bf16(v1[2], v1[3]);
                            *(u32x4*)(LO + r * 1024 + dst) = w; } } }
        }
    }
};
struct EpiRes {
    static constexpr bool PERM = false;
    float* X; const float* modl; int goff;
    __device__ __forceinline__ void operator()(const f32x4 (&acc)[2][2][4][2], const Unit& u, int wr, int wc, int fr, int fq) const {
        const int col0 = u.pn * BM + wc * 32 + 4 * fq;
#pragma unroll
        for (int ai = 0; ai < 2; ++ai)
#pragma unroll
            for (int m = 0; m < 4; ++m) { const int r = u.pm * BM + ai * HALF + wr * 64 + m * 16 + fr; const float* gp = modl + (size_t)seq_of_row(r) * 6144 + goff + col0; float* xp = X + (size_t)r * D + col0;
#pragma unroll
                for (int bj = 0; bj < 2; ++bj)
#pragma unroll
                    for (int n = 0; n < 2; ++n) { const f32x4 gv = *(const f32x4*)(gp + bj * HALF + n * 16); f32x4 xv = *(f32x4*)(xp + bj * HALF + n * 16);
                        xv = xv + gv * acc[ai][bj][m][n]; *(f32x4*)(xp + bj * HALF + n * 16) = xv; }
                asm volatile("" ::: "memory"); }
    }
};
struct EpiLora2 {
    static constexpr bool PERM = false;
    bf16_t* WLOG; bf16_t* Aout; bf16_t* G; bf16_t* RKV; const bf16_t* vf; const float* w0; const float* a0; const float* v0;
    template <int GRP> __device__ __forceinline__ void run(const f32x4 (&acc)[2][2][4][2], const Unit& u, int wr, int wc, int fr, int fq) const {
        const int col0 = (u.pn & 3) * BM + wc * 32 + 4 * fq;
#pragma unroll
        for (int ai = 0; ai < 2; ++ai)
#pragma unroll
            for (int m = 0; m < 4; ++m) { const size_t r = (size_t)(u.pm * BM + ai * HALF + wr * 64 + m * 16 + fr);
#pragma unroll
                for (int bj = 0; bj < 2; ++bj)
#pragma unroll
                    for (int n = 0; n < 2; ++n) { const int c = col0 + bj * HALF + n * 16; const f32x4 a = acc[ai][bj][m][n]; f32x4 o;
                        if constexpr (GRP == 0) { const f32x4 b = *(const f32x4*)(w0 + c);
#pragma unroll
                            for (int q = 0; q < 4; ++q) { const float x = -(b[q] + a[q]); const float sp = fmaxf(x, 0.f) + __logf(1.f + __expf(-fabsf(x))); o[q] = -__expf(-sp - 0.5f); }
                            u32x2 w; w.x = cvt_pk_bf16(o[0], o[1]); w.y = cvt_pk_bf16(o[2], o[3]); *(u32x2*)(WLOG + r * D + c) = w; }
                        else if constexpr (GRP == 1) { const f32x4 b = *(const f32x4*)(a0 + c);
#pragma unroll
                            for (int q = 0; q < 4; ++q) o[q] = 1.f / (1.f + __expf(-(b[q] + a[q])));
                            u32x2 w; w.x = cvt_pk_bf16(o[0], o[1]); w.y = cvt_pk_bf16(o[2], o[3]); *(u32x2*)(Aout + r * D + c) = w; }
                        else if constexpr (GRP == 2) { const f32x4 b = *(const f32x4*)(v0 + c); const u32x2 vv = *(const u32x2*)(RKV + r * 3072 + 2048 + c), ff = *(const u32x2*)(vf + r * D + c);
                            f32x4 v4, f4; v4[0] = bflo(vv.x); v4[1] = bfhi(vv.x); v4[2] = bflo(vv.y); v4[3] = bfhi(vv.y); f4[0] = bflo(ff.x); f4[1] = bfhi(ff.x); f4[2] = bflo(ff.y); f4[3] = bfhi(ff.y);
#pragma unroll
                            for (int q = 0; q < 4; ++q) { const float gte = 1.f / (1.f + __expf(-(b[q] + a[q]))); o[q] = v4[q] + (f4[q] - v4[q]) * gte; }
                            u32x2 w; w.x = cvt_pk_bf16(o[0], o[1]); w.y = cvt_pk_bf16(o[2], o[3]); *(u32x2*)(RKV + r * 3072 + 2048 + c) = w; }
                        else { u32x2 w; w.x = cvt_pk_bf16(a[0], a[1]); w.y = cvt_pk_bf16(a[2], a[3]); *(u32x2*)(G + r * D + c) = w; } }
                asm volatile("" ::: "memory"); }
    }
    __device__ __forceinline__ void operator()(const f32x4 (&acc)[2][2][4][2], const Unit& u, int wr, int wc, int fr, int fq) const {
        const int grp = u.pn >> 2;
        if (grp == 0) run<0>(acc, u, wr, wc, fr, fq);
        else if (grp == 1) run<1>(acc, u, wr, wc, fr, fq);
        else if (grp == 2) { if (vf != nullptr) run<2>(acc, u, wr, wc, fr, fq); }
        else run<3>(acc, u, wr, wc, fr, fq);
    }
};
struct SplitOrder {
    int c, splitk;
    __device__ bool next(int i, Unit& u) const { if (i != 0 || c >= 16 * splitk) return false; const int t = c / splitk; u.pm = 64 + (t >> 2); u.pn = t & 3; u.ks = c % splitk; return true; }
};
struct EpiPartial {
    static constexpr bool PERM = false;
    float* PART; int splitk;
    __device__ __forceinline__ void operator()(const f32x4 (&acc)[2][2][4][2], const Unit& u, int wr, int wc, int fr, int fq) const {
        float* base = PART + ((size_t)(((u.pm - 64) * 4 + u.pn) * splitk + u.ks) << 16) + wc * 32 + 4 * fq;
#pragma unroll
        for (int ai = 0; ai < 2; ++ai)
#pragma unroll
            for (int m = 0; m < 4; ++m) { float* rp = base + (ai * HALF + wr * 64 + m * 16 + fr) * 256;
#pragma unroll
                for (int bj = 0; bj < 2; ++bj)
#pragma unroll
                    for (int n = 0; n < 2; ++n) *(f32x4*)(rp + bj * HALF + n * 16) = acc[ai][bj][m][n]; }
    }
};
template <bool PERM_> struct EpiNull {
    static constexpr bool PERM = PERM_;
    __device__ __forceinline__ void operator()(const f32x4 (&acc)[2][2][4][2], const Unit&, int, int, int, int) const {
#pragma unroll
        for (int a = 0; a < 2; ++a)
#pragma unroll
            for (int b = 0; b < 2; ++b)
#pragma unroll
                for (int m = 0; m < 4; ++m)
#pragma unroll
                    for (int n = 0; n < 2; ++n) asm volatile("" :: "v"(acc[a][b][m][n]));
    }
};
}

#define RLX_AGENT __ATOMIC_RELAXED, __HIP_MEMORY_SCOPE_AGENT
#define XB_TMO      128
#define XB_XCNT(j)  (256  + 64 * (j))
#define XB_XSUB(j)  (1280 + 64 * (j))
#define XB_XGEN(j)  (2304 + 64 * (j))
#define XB_TOP      3328
#define XB_TOPGEN   3392
#define XCD_BAR_WORDS 3456
#define XB_SPIN_CAP (1u << 24)
__device__ __forceinline__ unsigned xb_ld(unsigned* p)              { return __hip_atomic_load(p, __ATOMIC_RELAXED, __HIP_MEMORY_SCOPE_AGENT); }
__device__ __forceinline__ unsigned xb_add(unsigned* p, unsigned v) { return __hip_atomic_fetch_add(p, v, __ATOMIC_RELAXED, __HIP_MEMORY_SCOPE_AGENT); }
__device__ __forceinline__ unsigned xb_xcc_id() { return (unsigned)__builtin_amdgcn_s_getreg((3 << 11) | 20) & 0xFu; }
#define XB_SPIN(cond, bar) do { unsigned _sp = 0; while (cond) { __builtin_amdgcn_s_sleep(4); \
    if ((++_sp & 255u) == 0u) { if (xb_ld(&(bar)[XB_TMO])) break; if (_sp > XB_SPIN_CAP) { atomicAdd(&(bar)[XB_TMO], 1u); break; } } } } while (0)
struct XcdBarrier { unsigned* bar; unsigned x; volatile LAS unsigned* st; };
__device__ __forceinline__ XcdBarrier xcd_barrier_post(unsigned* bar, volatile LAS unsigned* st) {
    XcdBarrier b; b.bar = bar; b.x = xb_xcc_id(); b.st = st;
    if (threadIdx.x == 0) (void)xb_add(&bar[XB_XCNT(b.x)], 1u);
    return b;
}
__device__ __forceinline__ void xcd_barrier_complete(unsigned* bar, unsigned x, unsigned& nloc, unsigned& nx) {
    const unsigned G = gridDim.x * gridDim.y * gridDim.z;
    unsigned sum, cnt, mine, sp = 0u;
    for (;;) {
        sum = 0u; cnt = 0u; mine = 0u;
#pragma unroll
        for (unsigned j = 0; j < 16; ++j) { const unsigned c = xb_ld(&bar[XB_XCNT(j)]); sum += c; cnt += (c > 0u) ? 1u : 0u; mine = (j == x) ? c : mine; }
        if (sum == G) break;
        __builtin_amdgcn_s_sleep(1);
        if ((++sp & 255u) == 0u) { if (xb_ld(&bar[XB_TMO])) break; if (sp > XB_SPIN_CAP) { atomicAdd(&bar[XB_TMO], 1u); break; } }
    }
    nloc = mine > 0u ? mine : 1u; nx = cnt > 0u ? cnt : 1u;
}
__device__ __forceinline__ void xcd_barrier(const XcdBarrier& b) {
    asm volatile("s_waitcnt vmcnt(0)" ::: "memory");
    __syncthreads();
    if (threadIdx.x == 0) {
        unsigned* bar = b.bar;
        __builtin_amdgcn_s_waitcnt(0);
        unsigned nloc = b.st[0], nx = b.st[1];
        if (nloc == 0u) { xcd_barrier_complete(bar, b.x, nloc, nx); b.st[0] = nloc; b.st[1] = nx; }
        const unsigned old = xb_add(&bar[XB_XSUB(b.x)], 1u);
        const unsigned gen = old / nloc;
        if (old + 1u == (gen + 1u) * nloc) {
            __builtin_amdgcn_fence(__ATOMIC_RELEASE, "agent");
            asm volatile("s_waitcnt vmcnt(0)" ::: "memory");
            const unsigned og = xb_add(&bar[XB_TOP], 1u);
            const unsigned tg = og / nx;
            if (og + 1u == (tg + 1u) * nx) xb_add(&bar[XB_TOPGEN], 1u);
            else XB_SPIN(xb_ld(&bar[XB_TOPGEN]) == tg, bar);
            __builtin_amdgcn_fence(__ATOMIC_ACQUIRE, "agent");
            xb_add(&bar[XB_XGEN(b.x)], 1u);
            asm volatile("s_waitcnt vmcnt(0)" ::: "memory");
        } else {
            XB_SPIN(xb_ld(&bar[XB_XGEN(b.x)]) == gen, bar);
            __builtin_amdgcn_fence(__ATOMIC_ACQUIRE, "agent");
            asm volatile("s_waitcnt vmcnt(0)" ::: "memory");
        }
    }
    __syncthreads();
}

constexpr int NWAVES = 8, NT = NWAVES * 64;
constexpr int RING_BYTES = 131072, LDSCTL_OFF = RING_BYTES, MISC_OFF = LDSCTL_OFF + 320, LDS_BYTES = 147456;
constexpr int CW_BAR = 4096;

struct Args { const float* in[38]; float* out; unsigned char* ws; };
struct Frame {
    LAS unsigned char* lds; volatile LAS unsigned* MISC;
    int wave, vcu, G;
    const float* const* in; float* out; unsigned char* ws;
};
enum { I_XP = 0, I_XS, I_SRET, I_SHG, I_SWKV, I_SSHIFT, I_CP, I_CS, I_MODW, I_MODB, I_NMIXG, I_NMLPG, I_FINALG, I_W1, I_W2, I_ABWIN, I_ABWOUT, I_HGLB, I_HGNG,
       I_MU, I_WRKV, I_RW0, I_RW1, I_RW2, I_RA0, I_RA1, I_RA2, I_RV0, I_RV1, I_RV2, I_RG1, I_RG2, I_RKK, I_RKA, I_RRK, I_RLNG, I_RLNB, I_RWOUT };
constexpr size_t O_Y = 0, O_RETP = 17825792, O_RETS = 17891328, O_HGP = 19988480, O_HGS = 20119552, O_WKVP = 24313856, O_WKVS = 24444928, O_SHP = 28639232, O_SHS = 28641280;

__device__ __forceinline__ void transpose_item(const float* W, int N, bf16_t* WT, int ldt, int row_off, int col_off, const float* mu, int mode, LAS float* scr, int item, int lane) {
    const int nblk = N / 32, kb = item / nblk, nb = item % nblk, k0 = 64 * kb, n0 = 32 * nb;
#pragma unroll 8
    for (int i = 0; i < 32; ++i) { const int kk = 2 * i + (lane >> 5); float s = 1.f; if (mode == 1) s = 1.f - mu[k0 + kk]; else if (mode == 2) s = mu[k0 + kk];
        scr[kk * 33 + (lane & 31)] = W[(size_t)(k0 + kk) * N + n0 + (lane & 31)] * s; }
    LDS_WAIT(); asm volatile("" ::: "memory");
    const int c = lane & 7;
#pragma unroll
    for (int j = 0; j < 4; ++j) { const int n = (lane >> 3) + 8 * j; const LAS float* s = scr + (8 * c) * 33 + n;
        u32x4 o; o.x = pk2(s[0 * 33], s[1 * 33]); o.y = pk2(s[2 * 33], s[3 * 33]); o.z = pk2(s[4 * 33], s[5 * 33]); o.w = pk2(s[6 * 33], s[7 * 33]);
        *(u32x4*)(WT + (size_t)(row_off + n0 + n) * ldt + col_off + k0 + 8 * c) = o; }
    LDS_WAIT(); asm volatile("" ::: "memory");
}
__device__ __forceinline__ void convert_layer_weights(Frame& F, int layer) {
    const int tid = otid(); const int lane = tid & 63; (void)lane;
    LAS float* scr = (LAS float*)(F.lds + F.wave * 16384);
    const int gw = F.vcu * NWAVES + F.wave, NGW = F.G * NWAVES;
    unsigned char* ar = F.ws + WS_ARENA;
    const int m = layer >> 1;
    constexpr int I_1 = (D / 64) * (DFF / 32), I_2 = (DFF / 64) * (D / 32);
    const float* w1 = F.in[I_W1] + (size_t)layer * D * DFF; const float* w2 = F.in[I_W2] + (size_t)layer * DFF * D;
    if ((layer & 1) == 0) {
        constexpr int I_IN = (D / 64) * (ABIN / 32), I_OUT = (D / 64) * (D / 32), NI = I_1 + I_2 + I_IN + I_OUT;
        const float* win = F.in[I_ABWIN] + (size_t)m * D * ABIN; const float* wout = F.in[I_ABWOUT] + (size_t)m * D * D;
        for (int it = gw; it < NI; it += NGW) { int r = it;
            if (r < I_1) { transpose_item(w1, DFF, (bf16_t*)(ar + AR_W1), D, 0, 0, nullptr, 0, scr, r, lane); continue; } r -= I_1;
            if (r < I_2) { transpose_item(w2, D, (bf16_t*)(ar + AR_W2), DFF, 0, 0, nullptr, 0, scr, r, lane); continue; } r -= I_2;
            if (r < I_IN) { transpose_item(win, ABIN, (bf16_t*)(ar + AR_WIN), D, 0, 0, nullptr, 0, scr, r, lane); continue; } r -= I_IN;
            transpose_item(wout, D, (bf16_t*)(ar + AR_WOUT), D, 0, 0, nullptr, 0, scr, r, lane); }
    } else {
        constexpr int I_P = (D / 64) * (D / 32), NI = I_1 + I_2 + 7 * I_P;
        const float* mu = F.in[I_MU] + (size_t)m * 6 * D; const float* wrkv = F.in[I_WRKV] + (size_t)m * 3 * D * D; const float* wo = F.in[I_RWOUT] + (size_t)m * D * D;
        bf16_t* wc1 = (bf16_t*)(ar + AR_WC1);
        for (int it = gw; it < NI; it += NGW) { int r = it;
            if (r < I_1) { transpose_item(w1, DFF, (bf16_t*)(ar + AR_W1), D, 0, 0, nullptr, 0, scr, r, lane); continue; } r -= I_1;
            if (r < I_2) { transpose_item(w2, D, (bf16_t*)(ar + AR_W2), DFF, 0, 0, nullptr, 0, scr, r, lane); continue; } r -= I_2;
            if (r < 6 * I_P) { const int p = r / (2 * I_P), hf = (r / I_P) & 1, mi = (p == 0) ? 0 : (p == 1 ? 2 : 3);
                transpose_item(wrkv + (size_t)p * D * D, D, wc1, 2048, p * D, hf * D, mu + mi * D, 1 + hf, scr, r % I_P, lane); continue; } r -= 6 * I_P;
            transpose_item(wo, D, (bf16_t*)(ar + AR_WO), D, 0, 0, nullptr, 0, scr, r, lane); }
        const int gt = F.vcu * NT + tid, NG = F.G * NT;
        const float* lw1 = F.in[I_RW1] + (size_t)m * D * 64; const float* la1 = F.in[I_RA1] + (size_t)m * D * 64; const float* lv1 = F.in[I_RV1]; const float* lg1 = F.in[I_RG1] + (size_t)m * D * 160;
        for (int idx = gt; idx < 512 * 2048; idx += NG) { const int n = idx >> 11, k = idx & 2047, kk = k & 1023, nn = n & 255;
            const float* src = nullptr; int ns = 0, mi = 0, nc = 0;
            if (n < 256) { if (nn < 64) { src = lw1; ns = 64; mi = 1; nc = nn; } else if (nn < 128) { src = la1; ns = 64; mi = 4; nc = nn - 64; } else if (nn < 160 && m == 1) { src = lv1; ns = 32; mi = 3; nc = nn - 128; } }
            else if (nn < 160) { src = lg1; ns = 160; mi = 5; nc = nn; }
            float v = 0.f; if (src) { const float muv = mu[mi * D + kk]; v = src[(size_t)kk * ns + nc] * (k < 1024 ? 1.f - muv : muv); }
            wc1[(size_t)(3072 + n) * 2048 + k] = (bf16_t)f2bf(v); }
        bf16_t* wc2 = (bf16_t*)(ar + AR_WC2);
        const float* lw2 = F.in[I_RW2] + (size_t)m * 64 * D; const float* la2 = F.in[I_RA2] + (size_t)m * 64 * D; const float* lv2 = F.in[I_RV2]; const float* lg2 = F.in[I_RG2] + (size_t)m * 160 * D;
        for (int idx = gt; idx < 4096 * 256; idx += NG) { const int k = idx >> 12, n = idx & 4095, g = n >> 10, nn = n & 1023;
            const float* src = (g == 0) ? lw2 : (g == 1) ? la2 : (g == 2) ? lv2 : lg2; const int ks = (g == 0 || g == 1) ? 64 : (g == 2 ? 32 : 160);
            float v = 0.f; if (k < ks && !(g == 2 && m == 0)) v = src[(size_t)k * D + nn];
            wc2[(size_t)n * 256 + k] = (bf16_t)f2bf(v); }
    }
}

__device__ __forceinline__ void mod_phase(Frame& F) {
    const int tid = otid(); const int lane = tid & 63;
    const float* __restrict__ SC = (const float*)(F.ws + WS_MOD + 3584 * 1024);
    float* MOD = (float*)(F.ws + WS_MOD);
    LAS float* red = (LAS float*)F.lds;
    for (int task = F.vcu; task < 4 * 96; task += F.G) { const int l = task / 96, n = (task % 96) * 64 + lane, ks = F.wave;
        const float* w = F.in[I_MODW] + ((size_t)l * D + ks * 128) * 6144 + n;
        float acc[NSEQ];
#pragma unroll
        for (int s = 0; s < NSEQ; ++s) acc[s] = 0.f;
        for (int k = 0; k < 128; k += 4) { const float w0 = w[(size_t)k * 6144], w1 = w[(size_t)(k + 1) * 6144], w2 = w[(size_t)(k + 2) * 6144], w3 = w[(size_t)(k + 3) * 6144];
#pragma unroll
            for (int s = 0; s < NSEQ; ++s) { const f32x4 c4 = *(const f32x4*)(SC + s * D + ks * 128 + k); acc[s] += (c4[0] * w0 + c4[1] * w1) + (c4[2] * w2 + c4[3] * w3); } }
        __syncthreads();
#pragma unroll
        for (int s = 0; s < NSEQ; ++s) red[(F.wave * NSEQ + s) * 64 + lane] = acc[s];
        __syncthreads();
        for (int i = tid; i < NSEQ * 64; i += NT) { const int s = i >> 6, c = i & 63; float t = F.in[I_MODB][l * 6144 + (task % 96) * 64 + c];
#pragma unroll
            for (int q = 0; q < 8; ++q) t += red[(q * NSEQ + s) * 64 + c];
            MOD[((size_t)l * NSEQ + s) * 6144 + (task % 96) * 64 + c] = t; }
    }
    __syncthreads();
}

__device__ __forceinline__ void prologue(Frame& F) {
    const int tid = otid(); const int lane = tid & 63; (void)lane;
    const int gt = F.vcu * NT + tid, NG = F.G * NT;
    { const f32x4* xp = (const f32x4*)F.in[I_XP]; const f32x4* xs = (const f32x4*)F.in[I_XS]; f32x4* o = (f32x4*)F.out;
      for (int i = gt; i < M * (D / 4); i += NG) o[i] = (i < MP * (D / 4)) ? xp[i] : xs[i - MP * (D / 4)]; }
    { f32x2* tab = (f32x2*)(F.ws + WS_ROPE);
      for (int i = gt; i < 16384 * 32; i += NG) { const int p = i >> 5, d = i & 31; double rev = (double)p * ROPE_REV[d]; rev -= floor(rev); const float fr = (float)rev;
          tab[i] = (f32x2){__builtin_amdgcn_cosf(fr), __builtin_amdgcn_sinf(fr)}; } }
    { unsigned* z = (unsigned*)(F.ws + WS_XN0); for (int i = gt; i < 512; i += NG) z[i] = 0u; }
    { float* SC = (float*)(F.ws + WS_MOD + 3584 * 1024);
      for (int i = gt; i < NSEQ * D; i += NG) { const int s = i >> 10, k = i & 1023; const float c = (s == 0) ? F.in[I_CP][k] : F.in[I_CS][(size_t)(s - 1) * D + k]; SC[i] = siluf_(c); } }
    convert_layer_weights(F, 0);
}

template <int MODE> __device__ __forceinline__ void norm_row(Frame& F, int layer, int r, f32x4 (&v)[4], const float* MOD, const float* gvec, int lane) {
    const int m = layer >> 1; const int shoff = (MODE == 2) ? 3072 : 0, scoff = (MODE == 2) ? 4096 : 1024;
    bf16_t* XN = (bf16_t*)(F.ws + WS_XN); bf16_t* PREVS = (bf16_t*)(F.ws + WS_PREVS);
    float* xrow = F.out + (size_t)r * D; float s2 = 0.f;
#pragma unroll
    for (int j = 0; j < 4; ++j) s2 += (v[j].x * v[j].x + v[j].y * v[j].y) + (v[j].z * v[j].z + v[j].w * v[j].w);
    const float rstd = 1.f / sqrtf(wave_sum(s2) * (1.f / D) + NORM_EPS);
    const int seq = seq_of_row(r); const float* mp = MOD + (size_t)seq * 6144;
#pragma unroll
    for (int j = 0; j < 4; ++j) { const int c = 4 * lane + 256 * j; const f32x4 g4 = *(const f32x4*)(gvec + c); f32x4 o = v[j] * rstd * g4;
        if (MODE == 3) { *((f32x4*)xrow + lane + 64 * j) = o; continue; }
        const f32x4 sc = *(const f32x4*)(mp + scoff + c), sh = *(const f32x4*)(mp + shoff + c);
        o = o * (1.f + sc) + sh;
        const unsigned long long pk = (unsigned long long)pk2(o.x, o.y) | ((unsigned long long)pk2(o.z, o.w) << 32);
        *(unsigned long long*)(XN + (size_t)r * D + c) = pk;
        if (MODE == 1) {
            if (r >= MP) { const int t = (r - MP) & 31; if (t < 31) *(unsigned long long*)(PREVS + (size_t)(r - MP + 1) * D + c) = pk;
                else *(f32x4*)(F.out + O_SHS + ((size_t)m * 32 + ((r - MP) >> 5)) * D + c) = o;
                if (t == 0) { const f32x4 ss = *(const f32x4*)(F.in[I_SSHIFT] + ((size_t)m * 32 + ((r - MP) >> 5)) * D + c);
                    *(unsigned long long*)(PREVS + (size_t)(r - MP) * D + c) = (unsigned long long)pk2(ss.x, ss.y) | ((unsigned long long)pk2(ss.z, ss.w) << 32); } }
            else if (r == MP - 1) *(f32x4*)(F.out + O_SHP + (size_t)m * D + c) = o;
        } }
}
template <int MODE, int PEND = 0> __device__ __forceinline__ void norm_pass(Frame& F, int layer, int player = 0, int pgoff = 0) {
    const int tid = otid(); const int lane = tid & 63;
    const int gw = F.vcu * NWAVES + F.wave, NGW = F.G * NWAVES;
    const float* MOD = (const float*)(F.ws + WS_MOD) + (size_t)layer * NSEQ * 6144;
    const float* gvec = (MODE == 3) ? F.in[I_FINALG] : (MODE == 2 ? F.in[I_NMLPG] + layer * D : F.in[I_NMIXG] + layer * D);
    LAS float* xs = (LAS float*)F.lds;
    if constexpr (PEND > 0) {
        __syncthreads();
        const float* gmod = (const float*)(F.ws + WS_MOD) + (size_t)player * NSEQ * 6144 + pgoff;
#pragma unroll
        for (int q = 0; q < 2; ++q) { const int idx = tid + q * NT, rr = idx >> 8, c4 = (idx & 255) * 4; const int r = MP + 4 * F.vcu + rr; if (4 * F.vcu + rr < MS) {
                const int pn = c4 >> 8; const float* pb = (const float*)(F.ws + WS_PART) + ((size_t)((((r >> 8) - 64) * 4 + pn) * PEND) << 16) + (r & 255) * 256 + (c4 & 255);
                f32x4 acc = (f32x4){0.f, 0.f, 0.f, 0.f};
#pragma unroll
                for (int ks = 0; ks < PEND; ++ks) acc += *(const f32x4*)(pb + ((size_t)ks << 16));
                const f32x4 g4 = *(const f32x4*)(gmod + (size_t)seq_of_row(r) * 6144 + c4); f32x4 x4 = *(const f32x4*)(F.out + (size_t)r * D + c4);
                x4 = x4 + g4 * acc; *(f32x4*)(F.out + (size_t)r * D + c4) = x4; *(LAS f32x4*)(xs + rr * 1024 + c4) = x4; } }
        __syncthreads();
    }
    for (int r = gw; r < MP; r += NGW) {
        const f32x4* xr = (const f32x4*)(F.out + (size_t)r * D) + lane; f32x4 v[4];
#pragma unroll
        for (int j = 0; j < 4; ++j) v[j] = xr[64 * j];
        norm_row<MODE>(F, layer, r, v, MOD, gvec, lane);
    }
    if (F.wave < 4 && 4 * F.vcu + F.wave < MS) { const int r = MP + 4 * F.vcu + F.wave; f32x4 v[4];
#pragma unroll
        for (int j = 0; j < 4; ++j) { if constexpr (PEND > 0) v[j] = *(const LAS f32x4*)(xs + F.wave * 1024 + 4 * lane + 256 * j); else v[j] = *((const f32x4*)(F.out + (size_t)r * D) + lane + 64 * j); }
        norm_row<MODE>(F, layer, r, v, MOD, gvec, lane); }
}

template <int MT, int NTT> __device__ __forceinline__ void wave_mm_nt(f32x4 (&acc)[MT][NTT], const LAS bf16_t* X, int ldx, const LAS bf16_t* Y, int ldy, int K, int fr, int fq) {
    for (int k0 = 0; k0 < K; k0 += 32) {
        bf16x8 xa[MT], yb[NTT];
#pragma unroll
        for (int i = 0; i < MT; ++i) xa[i] = *(const LAS bf16x8*)(X + (16 * i + fr) * ldx + k0 + 8 * fq);
#pragma unroll
        for (int j = 0; j < NTT; ++j) yb[j] = *(const LAS bf16x8*)(Y + (16 * j + fr) * ldy + k0 + 8 * fq);
#pragma unroll
        for (int i = 0; i < MT; ++i)
#pragma unroll
            for (int j = 0; j < NTT; ++j) acc[i][j] = __builtin_amdgcn_mfma_f32_16x16x32_bf16(yb[j], xa[i], acc[i][j], 0, 0, 0);
    }
}

constexpr int LQS = 0, LKS = 18432, LQG = 36864, LVT = 55296, LST = 73728, LPS = 108544, LRED = 117760, LBS = 118784;
__device__ __forceinline__ void chunk_geom(int c, int& r0, int& pos0) { if (c < 256) { r0 = 64 * c; pos0 = 64 * c; } else { r0 = MP + 32 * (c - 256); pos0 = 2048; } }

template <int L, bool HG, bool SUMMARY> __device__ __forceinline__ void ab_load(Frame& F, int layer, int c, int h) {
    const int tid = otid(); const int lane = tid & 63; (void)lane;
    const int m = layer >> 1; int r0, pos0; chunk_geom(c, r0, pos0);
    const bf16_t* Z = (const bf16_t*)(F.ws + WS_Z);
    LAS bf16_t* QS = (LAS bf16_t*)(F.lds + LQS); LAS bf16_t* KS = (LAS bf16_t*)(F.lds + LKS); LAS bf16_t* QG = (LAS bf16_t*)(F.lds + LQG); LAS bf16_t* VT = (LAS bf16_t*)(F.lds + LVT);
    constexpr int LDT = L + 8;
    if constexpr (HG) {
        constexpr int TQ = L / 4; LAS float* BS = (LAS float*)(F.lds + LBS);
        const int ch = tid & 127, qtr = tid >> 7;
        float lb = 0.f;
        if (m == 1) { const float a0 = F.in[I_HGLB][h * 128 + ch], a1 = F.in[I_HGLB][512 + h * 128 + ch]; lb = 1.f / (1.f + __expf(a0 - a1)); }
        { constexpr int NP = L * 16;
#pragma unroll
          for (int q = 0; q < (NP + NT - 1) / NT; ++q) { const int v = tid + q * NT; if (NP % NT == 0 || v < NP) { const int j = v >> 4, c8 = v & 15; const size_t zr = (size_t)(r0 + j) * ABIN + h * 128 + c8 * 8;
                  const u32x4 zf4 = *(const u32x4*)(Z + zr + 2048), v4 = *(const u32x4*)(Z + zr + 2560);
                  *(LAS u32x4*)(QG + j * 136 + c8 * 8) = zf4; *(LAS u32x4*)(KS + j * 136 + c8 * 8) = v4;
                  if constexpr (!SUMMARY) { const u32x4 q4 = *(const u32x4*)(Z + zr + 1536); *(LAS u32x4*)(QS + j * 136 + c8 * 8) = q4; } } } }
        __syncthreads();
        float zf[TQ], cs[TQ]; float run = 0.f;
#pragma unroll
        for (int jj = 0; jj < TQ; ++jj) { const int j = qtr * TQ + jj; zf[jj] = bf2f(QG[j * 136 + ch]);
            float lf; if (lb == 0.f) lf = fminf(zf[jj], 0.f) - __logf(1.f + __expf(-fabsf(zf[jj]))); else lf = __logf(lb + (1.f - lb) * sigmoidf_(zf[jj]));
            run += lf; cs[jj] = run; }
        BS[qtr * 128 + ch] = run;
        __syncthreads();
        const float b0 = BS[ch], b1 = BS[128 + ch], b2 = BS[256 + ch], b3 = BS[384 + ch];
        const float off = (qtr > 0 ? b0 : 0.f) + (qtr > 1 ? b1 : 0.f) + (qtr > 2 ? b2 : 0.f), bL = (b0 + b1) + (b2 + b3), bmid = b0 + b1;
        if constexpr (SUMMARY) {
#pragma unroll
            for (int jj = 0; jj < TQ; ++jj) { const int j = qtr * TQ + jj; const float b = off + cs[jj]; const float kb = (1.f - lb) * sigmoidf_(-zf[jj]);
                VT[ch * LDT + j] = KS[j * 136 + ch]; QS[ch * LDT + j] = (bf16_t)f2bf(kb * __expf(bL - b)); }
            if (qtr == 0) ((float*)(F.ws + WS_DEC))[((size_t)c * 4 + h) * 128 + ch] = __expf(bL);
        } else {
#pragma unroll
            for (int jj = 0; jj < TQ; ++jj) { const int j = qtr * TQ + jj; const float b = off + cs[jj]; const float kb = (1.f - lb) * sigmoidf_(-zf[jj]);
                const float q = siluf_(bf2f(QS[j * 136 + ch]));
                VT[ch * LDT + j] = KS[j * 136 + ch];
                QS[j * 136 + ch] = (bf16_t)f2bf(q * __expf(b - bmid)); KS[j * 136 + ch] = (bf16_t)f2bf(kb * __expf(bmid - b)); QG[j * 136 + ch] = (bf16_t)f2bf(q * __expf(b)); }
        }
    } else {
        const float logg = log1pf(-exp2f(-5.f - (float)h));
        const f32x2* rope = (const f32x2*)(F.ws + WS_ROPE);
        for (int it = tid; it < L * 4; it += NT) { const int j = it >> 2, d8 = it & 3; const size_t zr = (size_t)(r0 + j) * ABIN;
            const f32x2* rp = rope + (size_t)(pos0 + j) * 32 + d8 * 8;
            const u32x4 k1 = *(const u32x4*)(Z + zr + 256 + h * 64 + d8 * 8), k2 = *(const u32x4*)(Z + zr + 256 + h * 64 + 32 + d8 * 8);
            const float gk = __expf((float)(L - 1 - j) * logg), gq = __expf((float)(j + 1) * logg);
            u32x4 q1 = (u32x4){0, 0, 0, 0}, q2 = q1; if constexpr (!SUMMARY) { q1 = *(const u32x4*)(Z + zr + h * 64 + d8 * 8); q2 = *(const u32x4*)(Z + zr + h * 64 + 32 + d8 * 8); }
#pragma unroll
            for (int e = 0; e < 8; ++e) { const f32x2 cs_ = rp[e]; const unsigned wk1 = k1[e >> 1], wk2 = k2[e >> 1]; const float x1 = (e & 1) ? bfhi(wk1) : bflo(wk1), x2 = (e & 1) ? bfhi(wk2) : bflo(wk2);
                const float o1 = x1 * cs_.x - x2 * cs_.y, o2 = x1 * cs_.y + x2 * cs_.x; const int d = d8 * 8 + e;
                if constexpr (SUMMARY) { QS[d * LDT + j] = (bf16_t)f2bf(o1 * gk); QS[(d + 32) * LDT + j] = (bf16_t)f2bf(o2 * gk); }
                else { KS[j * 72 + d] = (bf16_t)f2bf(o1); KS[j * 72 + d + 32] = (bf16_t)f2bf(o2);
                    const unsigned wq1 = q1[e >> 1], wq2 = q2[e >> 1]; const float y1 = (e & 1) ? bfhi(wq1) : bflo(wq1), y2 = (e & 1) ? bfhi(wq2) : bflo(wq2);
                    const float p1 = (y1 * cs_.x - y2 * cs_.y) * 0.125f, p2 = (y1 * cs_.y + y2 * cs_.x) * 0.125f;
                    QS[j * 72 + d] = (bf16_t)f2bf(p1); QS[j * 72 + d + 32] = (bf16_t)f2bf(p2); QG[j * 72 + d] = (bf16_t)f2bf(p1 * gq); QG[j * 72 + d + 32] = (bf16_t)f2bf(p2 * gq); } } }
        for (int it = tid; it < L * 16; it += NT) { const int j = it >> 4, e8 = it & 15; const u32x4 vv = *(const u32x4*)(Z + (size_t)(r0 + j) * ABIN + 512 + h * 128 + e8 * 8);
#pragma unroll
            for (int e = 0; e < 8; ++e) { const unsigned w = vv[e >> 1]; VT[(e8 * 8 + e) * LDT + j] = (bf16_t)((e & 1) ? (w >> 16) : (w & 0xffffu)); } }
    }
}

template <int L, bool HG> __device__ __forceinline__ void ab_summary_unit(Frame& F, int layer, int c, int h) {
    const int tid = otid(); const int lane = tid & 63; (void)lane;
    constexpr int DK = HG ? 128 : 64, NCT = DK / 16, LDT = L + 8;
    __syncthreads();
    ab_load<L, HG, true>(F, layer, c, h);
    __syncthreads();
    const int fr = lane & 15, fq = lane >> 4;
    const LAS bf16_t* KDT = (const LAS bf16_t*)(F.lds + LQS); const LAS bf16_t* VT = (const LAS bf16_t*)(F.lds + LVT);
    f32x4 acc[1][NCT];
#pragma unroll
    for (int j = 0; j < NCT; ++j) acc[0][j] = (f32x4){0.f, 0.f, 0.f, 0.f};
    wave_mm_nt<1, NCT>(acc, VT + F.wave * 16 * LDT, LDT, KDT, LDT, L, fr, fq);
    bf16_t* ST = (bf16_t*)(F.ws + WS_STATE) + (size_t)c * SLOT_E + (HG ? 32768 + h * 16384 : h * 8192);
    const int e = F.wave * 16 + fr;
#pragma unroll
    for (int j = 0; j < NCT; ++j) { u32x2 w; w.x = pk2(acc[0][j][0], acc[0][j][1]); w.y = pk2(acc[0][j][2], acc[0][j][3]); *(u32x2*)(ST + (size_t)e * DK + 16 * j + 4 * fq) = w; }
}

template <int L, bool HG> __device__ __forceinline__ void ab_output_unit(Frame& F, int layer, int c, int h) {
    const int tid = otid(); const int lane = tid & 63; (void)lane;
    constexpr int DK = HG ? 128 : 64, LDQ = HG ? 136 : 72, LDT = L + 8, NIT = L / 16, WPI = 8 / NIT, ET = 8 / WPI, TPW = (NIT * NIT >= 8) ? NIT * NIT / 8 : 1;
    const int m = layer >> 1; int r0, pos0; chunk_geom(c, r0, pos0);
    __syncthreads();
    ab_load<L, HG, false>(F, layer, c, h);
    LAS bf16_t* QS = (LAS bf16_t*)(F.lds + LQS); LAS bf16_t* KS = (LAS bf16_t*)(F.lds + LKS); LAS bf16_t* QG = (LAS bf16_t*)(F.lds + LQG); LAS bf16_t* VT = (LAS bf16_t*)(F.lds + LVT);
    LAS bf16_t* STl = (LAS bf16_t*)(F.lds + LST); LAS bf16_t* PS = (LAS bf16_t*)(F.lds + LPS); LAS float* RED = (LAS float*)(F.lds + LRED);
    { const bf16_t* ST = (const bf16_t*)(F.ws + WS_STATE) + (size_t)c * SLOT_E + (HG ? 32768 + h * 16384 : h * 8192);
      for (int it = tid; it < 128 * DK / 8; it += NT) { const int e = it / (DK / 8), c8 = it % (DK / 8); *(LAS u32x4*)(STl + e * LDQ + c8 * 8) = *(const u32x4*)(ST + (size_t)e * DK + c8 * 8); } }
    __syncthreads();
    const int fr = lane & 15, fq = lane >> 4, w = F.wave;
    const float logg = HG ? 0.f : log1pf(-exp2f(-5.f - (float)h));
    if (w * TPW < NIT * NIT) {
        const int it = (w * TPW) / NIT, jt0 = (w * TPW) % NIT;
        f32x4 sc[1][TPW];
#pragma unroll
        for (int q = 0; q < TPW; ++q) sc[0][q] = (f32x4){0.f, 0.f, 0.f, 0.f};
        wave_mm_nt<1, TPW>(sc, QS + it * 16 * LDQ, LDQ, KS + jt0 * 16 * LDQ, LDQ, DK, fr, fq);
        const int i = it * 16 + fr;
#pragma unroll
        for (int q = 0; q < TPW; ++q) { float p[4];
#pragma unroll
            for (int r = 0; r < 4; ++r) { const int j = (jt0 + q) * 16 + 4 * fq + r; float v = sc[0][q][r]; if (!HG) v *= __expf((float)(i - j) * logg); p[r] = (j <= i) ? v : 0.f; }
            u32x2 pw; pw.x = pk2(p[0], p[1]); pw.y = pk2(p[2], p[3]); *(LAS u32x2*)(PS + i * LDT + (jt0 + q) * 16 + 4 * fq) = pw; }
    }
    __syncthreads();
    const int it = w % NIT, eg = w / NIT;
    f32x4 o[1][ET];
#pragma unroll
    for (int q = 0; q < ET; ++q) o[0][q] = (f32x4){0.f, 0.f, 0.f, 0.f};
    wave_mm_nt<1, ET>(o, PS + it * 16 * LDT, LDT, VT + eg * ET * 16 * LDT, LDT, L, fr, fq);
    wave_mm_nt<1, ET>(o, QG + it * 16 * LDQ, LDQ, STl + eg * ET * 16 * LDQ, LDQ, DK, fr, fq);
    float ss = 0.f;
#pragma unroll
    for (int q = 0; q < ET; ++q) ss += (o[0][q][0] * o[0][q][0] + o[0][q][1] * o[0][q][1]) + (o[0][q][2] * o[0][q][2] + o[0][q][3] * o[0][q][3]);
    ss += __shfl_xor(ss, 16); ss += __shfl_xor(ss, 32);
    const int i = it * 16 + fr;
    if (fq == 0) RED[i * 4 + eg] = ss;
    __syncthreads();
    float tot = 0.f;
#pragma unroll
    for (int q = 0; q < WPI; ++q) tot += RED[i * 4 + q];
    const float rstd = 1.f / sqrtf(tot * (1.f / 128.f) + NORM_EPS);
    const bf16_t* Z = (const bf16_t*)(F.ws + WS_Z); bf16_t* O = (bf16_t*)(F.ws + WS_XN);
    const size_t row = (size_t)(r0 + i);
#pragma unroll
    for (int q = 0; q < ET; ++q) { const int e = (eg * ET + q) * 16 + 4 * fq; const u32x2 gw = *(const u32x2*)(Z + row * ABIN + (HG ? 3072 : 1024) + h * 128 + e);
        const float g4[4] = {bflo(gw.x), bfhi(gw.x), bflo(gw.y), bfhi(gw.y)}; float ov[4];
#pragma unroll
        for (int r = 0; r < 4; ++r) { if (HG) ov[r] = o[0][q][r] * rstd * F.in[I_HGNG][m * 128 + e + r] * sigmoidf_(g4[r]); else ov[r] = o[0][q][r] * rstd * siluf_(g4[r]); }
        u32x2 ow; ow.x = pk2(ov[0], ov[1]); ow.y = pk2(ov[2], ov[3]); *(u32x2*)(O + row * D + (HG ? 512 : 0) + h * 128 + e) = ow; }
}

template <bool DRY = false> __device__ __forceinline__ void ab_scan(Frame& F, int layer) {
    const int tid = otid(); const int lane = tid & 63; (void)lane;
    const int m = layer >> 1;
    unsigned* ST32 = (unsigned*)(F.ws + WS_STATE); const float* DEC = (const float*)(F.ws + WS_DEC);
    constexpr int NP = SLOT_E / 2;
    const int gt = F.vcu * NT + tid;
    if (gt < NP) {
        const int eo = 2 * gt; const bool hg = eo >= 32768; const int eo2 = hg ? eo - 32768 : eo; const int head = hg ? eo2 >> 14 : eo2 >> 13; const int cch = hg ? (eo2 & 127) : (eo2 & 63); const int e = hg ? ((eo2 & 16383) >> 7) : ((eo2 & 8191) >> 6);
        const float gdec = hg ? 0.f : __expf(64.f * log1pf(-exp2f(-5.f - (float)head)));
        float s0 = 0.f, s1 = 0.f;
        for (int c0 = 0; c0 < 256; c0 += 8) {
            unsigned kv[8]; float d0[8], d1[8];
#pragma unroll
            for (int u = 0; u < 8; ++u) { kv[u] = ST32[(size_t)(c0 + u) * NP + gt]; if (hg) { const f32x2 dd = *(const f32x2*)(DEC + ((size_t)(c0 + u) * 4 + head) * 128 + cch); d0[u] = dd.x; d1[u] = dd.y; } else { d0[u] = gdec; d1[u] = gdec; } }
#pragma unroll
            for (int u = 0; u < 8; ++u) { const unsigned pw = pk2(s0, s1); if constexpr (DRY) asm volatile("" :: "v"(pw)); else ST32[(size_t)(c0 + u) * NP + gt] = pw; s0 = d0[u] * s0 + bflo(kv[u]); s1 = d1[u] * s1 + bfhi(kv[u]); }
        }
        float* outp = hg ? F.out + O_HGP + (size_t)m * 65536 + head * 16384 : F.out + O_RETP + (size_t)m * 32768 + head * 8192;
        outp[(size_t)cch * 128 + e] = s0; outp[(size_t)(cch + 1) * 128 + e] = s1;
    } else {
        const int NG2 = F.G * NT - NP; if (NG2 <= 0) return;
        for (int idx = gt - NP; idx < 32 * NP; idx += NG2) { const int b = idx / NP, pr = idx % NP;
            const int eo = 2 * pr; const bool hg = eo >= 32768; const int eo2 = hg ? eo - 32768 : eo; const int head = hg ? eo2 >> 14 : eo2 >> 13; const int cch = hg ? (eo2 & 127) : (eo2 & 63); const int e = hg ? ((eo2 & 16383) >> 7) : ((eo2 & 8191) >> 6);
            float d0, d1; if (hg) { const f32x2 dd = *(const f32x2*)(DEC + ((size_t)(256 + b) * 4 + head) * 128 + cch); d0 = dd.x; d1 = dd.y; } else { d0 = d1 = __expf(32.f * log1pf(-exp2f(-5.f - (float)head))); }
            const size_t so = hg ? ((size_t)(m * 32 + b) * 4 + head) * 16384 : ((size_t)(m * 32 + b) * 4 + head) * 8192;
            const float* sin_ = (hg ? F.in[I_SHG] : F.in[I_SRET]) + so; float* sout = F.out + (hg ? O_HGS : O_RETS) + so;
            const float i0 = sin_[(size_t)cch * 128 + e], i1 = sin_[(size_t)(cch + 1) * 128 + e];
            const unsigned kv = ST32[(size_t)(256 + b) * NP + pr]; if constexpr (!DRY) ST32[(size_t)(256 + b) * NP + pr] = pk2(i0, i1);
            sout[(size_t)cch * 128 + e] = d0 * i0 + bflo(kv); sout[(size_t)(cch + 1) * 128 + e] = d1 * i1 + bfhi(kv); }
    }
}

constexpr int RL_AT = 0, RL_RT = 9216, RL_BT = 18432, RL_KT = 27648, RL_BHT = 36864, RL_KHT = 46080, RL_VT = 55296, RL_AAB = 64512, RL_AAK = 81920, RL_ARB = 91136, RL_ARK = 100352,
              RL_U0T = 109568, RL_VEC = 118784, RL_PSUM = 119808;
constexpr int RL_G = RL_AAB, RL_WW = RL_BT, RL_APT = RL_AAK;
constexpr int RL_PL = RL_AT, RL_RL = RL_BT, RL_Y0L = RL_BT + 4608, RL_QTL = RL_AAB, RL_S = RL_BHT;
__device__ __forceinline__ int pperm(int k) { return 32 * (k >> 5) + 8 * ((k >> 2) & 3) + 4 * ((k >> 4) & 1) + (k & 3); }

template <bool DRY = false> __device__ __forceinline__ void rwkv_out_epilogue(Frame& F, int m, const f32x4 (&y)[4], size_t row, int h, int fq) {
    bf16_t* RKV = (bf16_t*)(F.ws + WS_RKV); const bf16_t* GG = (const bf16_t*)(F.ws + WS_G); const float* BON = (const float*)(F.ws + WS_BON);
    float s1 = 0.f;
#pragma unroll
    for (int nt = 0; nt < 4; ++nt) s1 += (y[nt][0] + y[nt][1]) + (y[nt][2] + y[nt][3]);
    s1 += __shfl_xor(s1, 16); s1 += __shfl_xor(s1, 32);
    const float mean = s1 * (1.f / 64.f); float s2 = 0.f;
#pragma unroll
    for (int nt = 0; nt < 4; ++nt)
#pragma unroll
        for (int r = 0; r < 4; ++r) { const float d = y[nt][r] - mean; s2 += d * d; }
    s2 += __shfl_xor(s2, 16); s2 += __shfl_xor(s2, 32);
    const float rstd = 1.f / sqrtf(s2 * (1.f / 64.f) + RW_LN_EPS), bon = BON[row * 16 + h];
#pragma unroll
    for (int nt = 0; nt < 4; ++nt) { const int i = h * 64 + 16 * nt + 4 * fq;
        const f32x4 lg = *(const f32x4*)(F.in[I_RLNG] + m * D + i), lb = *(const f32x4*)(F.in[I_RLNB] + m * D + i);
        const u32x2 vv = *(const u32x2*)(RKV + row * 3072 + 2048 + i), gg = *(const u32x2*)(GG + row * D + i);
        const float v4[4] = {bflo(vv.x), bfhi(vv.x), bflo(vv.y), bfhi(vv.y)}, g4[4] = {bflo(gg.x), bfhi(gg.x), bflo(gg.y), bfhi(gg.y)}; float o[4];
#pragma unroll
        for (int r = 0; r < 4; ++r) o[r] = ((y[nt][r] - mean) * rstd * lg[r] + lb[r] + bon * v4[r]) * g4[r];
        u32x2 w; w.x = pk2(o[0], o[1]); w.y = pk2(o[2], o[3]); if constexpr (DRY) asm volatile("" :: "v"(w.x), "v"(w.y)); else *(u32x2*)(RKV + row * 3072 + i) = w; }
}

template <int S, int L> struct SubstQ {
    static constexpr int RQ = L / 4, NV4 = RQ / 4;
    static __device__ __forceinline__ void run(float (&x)[RQ], f32x4 (&aq)[3][NV4], const LAS float* ap) {
        if constexpr (S < L - 1) {
            if constexpr (S + 2 < L - 1) {
#pragma unroll
                for (int k = 0; k < NV4; ++k) aq[(S + 2) % 3][k] = *(const LAS f32x4*)(ap + (S + 2) * 68 + 4 * k);
            }
            constexpr int own = S / RQ, ctrl = own * 0x55;
            const float xs = __builtin_bit_cast(float, __builtin_amdgcn_update_dpp(0, __builtin_bit_cast(int, x[S % RQ]), ctrl, 0xf, 0xf, false));
#pragma unroll
            for (int k = 0; k < NV4; ++k) { x[4 * k] += aq[S % 3][k][0] * xs; x[4 * k + 1] += aq[S % 3][k][1] * xs; x[4 * k + 2] += aq[S % 3][k][2] * xs; x[4 * k + 3] += aq[S % 3][k][3] * xs;
                asm volatile("" : "+v"(x[4 * k]), "+v"(x[4 * k + 1]), "+v"(x[4 * k + 2]), "+v"(x[4 * k + 3])); }
            asm volatile("" ::: "memory");
            SubstQ<S + 1, L>::run(x, aq, ap);
        }
    }
};
struct RawRegs { u32x4 r, k, v, w, a; };
__device__ __forceinline__ void rwkv_load_raw(Frame& F, int u, int tid, RawRegs& raw) {
    const int c = u >> 4, h = u & 15; int r0, pos0; chunk_geom(c, r0, pos0); const int L = c < 256 ? 64 : 32; int t = tid >> 3; t = t < L ? t : 0;
    const bf16_t* RKV = (const bf16_t*)(F.ws + WS_RKV); const bf16_t* WLOG = (const bf16_t*)(F.ws + WS_WLOG); const bf16_t* AA = (const bf16_t*)(F.ws + WS_XN);
    const size_t row = (size_t)(r0 + t); const int col = h * 64 + 8 * (tid & 7);
    raw.r = *(const u32x4*)(RKV + row * 3072 + col); raw.k = *(const u32x4*)(RKV + row * 3072 + 1024 + col); raw.v = *(const u32x4*)(RKV + row * 3072 + 2048 + col);
    raw.w = *(const u32x4*)(WLOG + row * D + col); raw.a = *(const u32x4*)(AA + row * D + col);
}
template <int L, bool DRY = false> __device__ __forceinline__ void rwkv_local_unit(Frame& F, int layer, int c, int h, RawRegs& raw, int unext) {
    const int tid = otid(); const int lane = tid & 63, fr = lane & 15, fq = lane >> 4, w = F.wave;
    constexpr int NIT = L / 16; constexpr bool SAMPLE = (L == 32);
    const int m = layer >> 1; int r0, pos0; chunk_geom(c, r0, pos0);
    bf16_t* RKV = (bf16_t*)(F.ws + WS_RKV); const bf16_t* WLOG = (const bf16_t*)(F.ws + WS_WLOG); const bf16_t* AA = (const bf16_t*)(F.ws + WS_XN);
    LAS bf16_t* AT = (LAS bf16_t*)(F.lds + RL_AT); LAS bf16_t* RT = (LAS bf16_t*)(F.lds + RL_RT); LAS bf16_t* BT = (LAS bf16_t*)(F.lds + RL_BT); LAS bf16_t* KT = (LAS bf16_t*)(F.lds + RL_KT);
    LAS bf16_t* BHT = (LAS bf16_t*)(F.lds + RL_BHT); LAS bf16_t* KHT = (LAS bf16_t*)(F.lds + RL_KHT); LAS bf16_t* VT = (LAS bf16_t*)(F.lds + RL_VT);
    LAS float* AAB = (LAS float*)(F.lds + RL_AAB); LAS bf16_t* AAK = (LAS bf16_t*)(F.lds + RL_AAK); LAS bf16_t* ARB = (LAS bf16_t*)(F.lds + RL_ARB); LAS bf16_t* ARK = (LAS bf16_t*)(F.lds + RL_ARK);
    LAS bf16_t* U0T = (LAS bf16_t*)(F.lds + RL_U0T); LAS float* GMID = (LAS float*)(F.lds + RL_VEC); LAS float* GLV = GMID + 64; LAS float* EGM = GMID + 128; LAS float* PSUM = (LAS float*)(F.lds + RL_PSUM);
    LAS float* G = (LAS float*)(F.lds + RL_G); LAS float* WW = (LAS float*)(F.lds + RL_WW); LAS bf16_t* APT = (LAS bf16_t*)(F.lds + RL_APT);
    __syncthreads();
    const int t = tid >> 3, c8 = tid & 7; const bool act = t < L;
    float rr[8], kkv[8], bb[8], kh[8], vv[8];
    if (act) { const size_t row = (size_t)(r0 + t); const int col = h * 64 + 8 * c8;
        const u32x4 r4 = raw.r, k4 = raw.k, v4 = raw.v, w4 = raw.w, a4 = raw.a;
        const float* kkp = F.in[I_RKK] + m * D + col; const float* kap = F.in[I_RKA] + m * D + col; const float* rkp = F.in[I_RRK] + m * D + col;
        float ss = 0.f, bon = 0.f;
#pragma unroll
        for (int e = 0; e < 8; ++e) { const float kx = (e & 1) ? bfhi(k4[e >> 1]) : bflo(k4[e >> 1]), al = (e & 1) ? bfhi(a4[e >> 1]) : bflo(a4[e >> 1]);
            rr[e] = (e & 1) ? bfhi(r4[e >> 1]) : bflo(r4[e >> 1]); vv[e] = (e & 1) ? bfhi(v4[e >> 1]) : bflo(v4[e >> 1]);
            kkv[e] = kx * kkp[e]; ss += kkv[e] * kkv[e]; kh[e] = kx * (1.f + (al - 1.f) * kap[e]); bb[e] = al; bon += rr[e] * kh[e] * rkp[e];
            G[t * 64 + 8 * c8 + e] = (e & 1) ? bfhi(w4[e >> 1]) : bflo(w4[e >> 1]); }
        ss += __shfl_xor(ss, 1); ss += __shfl_xor(ss, 2); ss += __shfl_xor(ss, 4); bon += __shfl_xor(bon, 1); bon += __shfl_xor(bon, 2); bon += __shfl_xor(bon, 4);
        const float inv = 1.f / fmaxf(sqrtf(ss), 1e-12f);
#pragma unroll
        for (int e = 0; e < 8; ++e) { kkv[e] *= inv; bb[e] *= kkv[e]; }
        if (c8 == 0) ((float*)(F.ws + WS_BON))[row * 16 + h] = bon; }
    if (unext >= 0) rwkv_load_raw(F, unext, tid, raw);
    __syncthreads();
    { constexpr int TE = L / 8; const int j = tid & 63, e8 = tid >> 6; float cs[TE]; float run = 0.f;
#pragma unroll
      for (int q = 0; q < TE; ++q) { run += G[(e8 * TE + q) * 64 + j]; cs[q] = run; }
      PSUM[e8 * 64 + j] = run;
      __syncthreads();
      float off = 0.f, gm = 0.f, gl = 0.f;
#pragma unroll
      for (int q = 0; q < 8; ++q) { const float p = PSUM[q * 64 + j]; if (q < e8) off += p; if (q < 4) gm += p; gl += p; }
#pragma unroll
      for (int q = 0; q < TE; ++q) G[(e8 * TE + q) * 64 + j] = off + cs[q];
      if (e8 == 0) { GMID[j] = gm; GLV[j] = gl; EGM[j] = __expf(gm); if (!SAMPLE) ((float*)(F.ws + WS_REC + ((size_t)h * 256 + c) * REC_B + 16384))[j] = __expf(gl); } }
    __syncthreads();
    if (act) { float fa[8], fr_[8], fb[8], fk[8];
#pragma unroll
        for (int e = 0; e < 8; ++e) { const int j = 8 * c8 + e; const float g = G[t * 64 + j], gp = (t > 0) ? G[(t - 1) * 64 + j] : 0.f, gm = GMID[j], gl = GLV[j];
            const float ed = __expf(gm - g), eu = __expf(g - gm), el = __expf(gl - g);
            fa[e] = -kkv[e] * __expf(gp - gm); fr_[e] = rr[e] * eu; fb[e] = bb[e] * ed; fk[e] = kh[e] * ed;
            if constexpr (!(DRY && (LOCAL_SKIP & 4))) { BHT[j * 72 + t] = (bf16_t)f2bf(bb[e] * el); KHT[j * 72 + t] = (bf16_t)f2bf(kh[e] * el); VT[j * 72 + t] = (bf16_t)f2bf(vv[e]); } }
        u32x4 p;
        p.x = pk2(fa[0], fa[1]); p.y = pk2(fa[2], fa[3]); p.z = pk2(fa[4], fa[5]); p.w = pk2(fa[6], fa[7]); *(LAS u32x4*)(AT + t * 72 + 8 * c8) = p;
        p.x = pk2(fr_[0], fr_[1]); p.y = pk2(fr_[2], fr_[3]); p.z = pk2(fr_[4], fr_[5]); p.w = pk2(fr_[6], fr_[7]); *(LAS u32x4*)(RT + t * 72 + 8 * c8) = p;
        p.x = pk2(fb[0], fb[1]); p.y = pk2(fb[2], fb[3]); p.z = pk2(fb[4], fb[5]); p.w = pk2(fb[6], fb[7]); *(LAS u32x4*)(BT + t * 72 + 8 * c8) = p;
        p.x = pk2(fk[0], fk[1]); p.y = pk2(fk[2], fk[3]); p.z = pk2(fk[4], fk[5]); p.w = pk2(fk[6], fk[7]); *(LAS u32x4*)(KT + t * 72 + 8 * c8) = p; }
    __syncthreads();
    if constexpr (DRY && (LOCAL_SKIP & 2)) return;
    { constexpr int TPW = (NIT * NIT >= 8) ? NIT * NIT / 8 : 1;
      if (w * TPW < NIT * NIT) { const int it = (w * TPW) / NIT, jt0 = (w * TPW) % NIT;
          f32x4 ab[1][TPW], ak[1][TPW], rb[1][TPW], rk[1][TPW];
#pragma unroll
          for (int q = 0; q < TPW; ++q) { ab[0][q] = (f32x4){0.f, 0.f, 0.f, 0.f}; ak[0][q] = ab[0][q]; rb[0][q] = ab[0][q]; rk[0][q] = ab[0][q]; }
          wave_mm_nt<1, TPW>(ab, AT + it * 16 * 72, 72, BT + jt0 * 16 * 72, 72, 64, fr, fq); wave_mm_nt<1, TPW>(ak, AT + it * 16 * 72, 72, KT + jt0 * 16 * 72, 72, 64, fr, fq);
          wave_mm_nt<1, TPW>(rb, RT + it * 16 * 72, 72, BT + jt0 * 16 * 72, 72, 64, fr, fq); wave_mm_nt<1, TPW>(rk, RT + it * 16 * 72, 72, KT + jt0 * 16 * 72, 72, 64, fr, fq);
          const int tt = it * 16 + fr;
#pragma unroll
          for (int q = 0; q < TPW; ++q) { const int s0 = (jt0 + q) * 16 + 4 * fq; f32x4 fab; float fak[4], frb[4], frk[4];
#pragma unroll
              for (int r = 0; r < 4; ++r) { const int sx = s0 + r; fab[r] = (sx < tt) ? ab[0][q][r] : 0.f; fak[r] = (sx < tt) ? ak[0][q][r] : 0.f; frb[r] = (sx <= tt) ? rb[0][q][r] : 0.f; frk[r] = (sx <= tt) ? rk[0][q][r] : 0.f; }
#pragma unroll
              for (int r = 0; r < 4; ++r) AAB[(s0 + r) * 68 + tt] = fab[r];
              u32x2 p; p.x = pk2(fak[0], fak[1]); p.y = pk2(fak[2], fak[3]); *(LAS u32x2*)(AAK + tt * 72 + s0) = p;
              p.x = pk2(frb[0], frb[1]); p.y = pk2(frb[2], frb[3]); *(LAS u32x2*)(ARB + tt * 72 + s0) = p;
              p.x = pk2(frk[0], frk[1]); p.y = pk2(frk[2], frk[3]); *(LAS u32x2*)(ARK + tt * 72 + s0) = p; } } }
    __syncthreads();
    { constexpr int TP3 = NIT / 2; const int it = (w * TP3) / 4, nt0 = (w * TP3) % 4;
      f32x4 ww[1][TP3];
#pragma unroll
      for (int q = 0; q < TP3; ++q) ww[0][q] = (f32x4){0.f, 0.f, 0.f, 0.f};
      wave_mm_nt<1, TP3>(ww, AAK + it * 16 * 72, 72, VT + nt0 * 16 * 72, 72, L, fr, fq);
#pragma unroll
      for (int q = 0; q < TP3; ++q) *(LAS f32x4*)(WW + (it * 16 + fr) * 68 + (nt0 + q) * 16 + 4 * fq) = ww[0][q]; }
    __syncthreads();
    { constexpr int RQ = L / 4, NV4 = RQ / 4; const int col = tid >> 2, qd = tid & 3, cidx = col & 63; const bool isA = col < 64; const float eg = EGM[cidx];
      float x[RQ]; f32x4 aq[3][NV4];
#pragma unroll
      for (int i = 0; i < RQ; ++i) { const int tt = qd * RQ + i; x[i] = isA ? bf2f(AT[tt * 72 + cidx]) * eg : WW[tt * 68 + cidx]; }
      const LAS float* ap = AAB + qd * RQ;
#pragma unroll
      for (int k = 0; k < NV4; ++k) { aq[0][k] = *(const LAS f32x4*)(ap + 4 * k); aq[1][k] = *(const LAS f32x4*)(ap + 68 + 4 * k); }
      if constexpr (!(DRY && (LOCAL_SKIP & 1))) SubstQ<0, L>::run(x, aq, ap);
      LAS bf16_t* dst = (isA ? APT : U0T) + cidx * 72 + qd * RQ;
#pragma unroll
      for (int t8 = 0; t8 < RQ; t8 += 8) { u32x4 p; p.x = pk2(x[t8], x[t8 + 1]); p.y = pk2(x[t8 + 2], x[t8 + 3]); p.z = pk2(x[t8 + 4], x[t8 + 5]); p.w = pk2(x[t8 + 6], x[t8 + 7]); *(LAS u32x4*)(dst + t8) = p; } }
    __syncthreads();
    { const int mt = w >> 1, nt0 = (w & 1) * 2;
      f32x4 pp[1][2], qt[1][2];
#pragma unroll
      for (int q = 0; q < 2; ++q) { pp[0][q] = (f32x4){0.f, 0.f, 0.f, 0.f}; qt[0][q] = pp[0][q]; }
      wave_mm_nt<1, 2>(pp, BHT + mt * 16 * 72, 72, APT + nt0 * 16 * 72, 72, L, fr, fq);
      wave_mm_nt<1, 2>(qt, U0T + mt * 16 * 72, 72, BHT + nt0 * 16 * 72, 72, L, fr, fq); wave_mm_nt<1, 2>(qt, VT + mt * 16 * 72, 72, KHT + nt0 * 16 * 72, 72, L, fr, fq);
      constexpr int TP5 = NIT / 2; const int it = (w * TP5) / 4, rn0 = (w * TP5) % 4;
      f32x4 rp[1][TP5], y0[1][TP5];
#pragma unroll
      for (int q = 0; q < TP5; ++q) { const int j = (rn0 + q) * 16 + 4 * fq; const u32x2 rw = *(const LAS u32x2*)(RT + (it * 16 + fr) * 72 + j); const f32x4 e4 = *(const LAS f32x4*)(EGM + j);
          rp[0][q] = (f32x4){bflo(rw.x) * e4[0], bfhi(rw.x) * e4[1], bflo(rw.y) * e4[2], bfhi(rw.y) * e4[3]}; y0[0][q] = (f32x4){0.f, 0.f, 0.f, 0.f}; }
      wave_mm_nt<1, TP5>(rp, ARB + it * 16 * 72, 72, APT + rn0 * 16 * 72, 72, L, fr, fq);
      wave_mm_nt<1, TP5>(y0, ARB + it * 16 * 72, 72, U0T + rn0 * 16 * 72, 72, L, fr, fq); wave_mm_nt<1, TP5>(y0, ARK + it * 16 * 72, 72, VT + rn0 * 16 * 72, 72, L, fr, fq);
      if constexpr (!SAMPLE) {
          bf16_t* PP = (bf16_t*)(F.ws + WS_REC + ((size_t)h * 256 + c) * REC_B); bf16_t* QQ = PP + 4096;
#pragma unroll
          for (int q = 0; q < 2; ++q) { const int n0 = (nt0 + q) * 16 + 4 * fq; u32x2 p; p.x = pk2(pp[0][q][0], pp[0][q][1]); p.y = pk2(pp[0][q][2], pp[0][q][3]);
              *(u32x2*)(PP + (mt * 16 + fr) * 64 + pperm(n0)) = p;
              p.x = pk2(qt[0][q][0], qt[0][q][1]); p.y = pk2(qt[0][q][2], qt[0][q][3]); *(u32x2*)(QQ + (mt * 16 + fr) * 64 + n0) = p; }
#pragma unroll
          for (int q = 0; q < TP5; ++q) { const size_t row = (size_t)(r0 + it * 16 + fr); const int n0 = (rn0 + q) * 16 + 4 * fq; u32x2 p;
              p.x = pk2(rp[0][q][0], rp[0][q][1]); p.y = pk2(rp[0][q][2], rp[0][q][3]); if constexpr (DRY) asm volatile("" :: "v"(p.x), "v"(p.y)); else *(u32x2*)(RKV + row * 3072 + 1024 + h * 64 + n0) = p;
              p.x = pk2(y0[0][q][0], y0[0][q][1]); p.y = pk2(y0[0][q][2], y0[0][q][3]); if constexpr (DRY) asm volatile("" :: "v"(p.x), "v"(p.y)); else *(u32x2*)(RKV + row * 3072 + h * 64 + n0) = p; }
      } else {
          __syncthreads();
          LAS bf16_t* PL = (LAS bf16_t*)(F.lds + RL_PL); LAS bf16_t* RLs = (LAS bf16_t*)(F.lds + RL_RL); LAS float* Y0L = (LAS float*)(F.lds + RL_Y0L); LAS float* QTL = (LAS float*)(F.lds + RL_QTL); LAS bf16_t* Sl = (LAS bf16_t*)(F.lds + RL_S);
#pragma unroll
          for (int q = 0; q < 2; ++q) { const int n0 = (nt0 + q) * 16 + 4 * fq; u32x2 p; p.x = pk2(pp[0][q][0], pp[0][q][1]); p.y = pk2(pp[0][q][2], pp[0][q][3]);
              *(LAS u32x2*)(PL + (mt * 16 + fr) * 72 + n0) = p; *(LAS f32x4*)(QTL + (mt * 16 + fr) * 68 + n0) = qt[0][q]; }
#pragma unroll
          for (int q = 0; q < TP5; ++q) { const int n0 = (rn0 + q) * 16 + 4 * fq; u32x2 p; p.x = pk2(rp[0][q][0], rp[0][q][1]); p.y = pk2(rp[0][q][2], rp[0][q][3]);
              *(LAS u32x2*)(RLs + (it * 16 + fr) * 72 + n0) = p; *(LAS f32x4*)(Y0L + (it * 16 + fr) * 68 + n0) = y0[0][q]; }
          const int sb = c - 256; const float* sin_ = F.in[I_SWKV] + (((size_t)m * 32 + sb) * 16 + h) * 4096; float* sout = F.out + O_WKVS + (((size_t)m * 32 + sb) * 16 + h) * 4096;
          for (int it2 = tid; it2 < 64 * 16; it2 += NT) { const int i = it2 >> 4, j4 = (it2 & 15) * 4; const f32x4 sv = *(const f32x4*)(sin_ + i * 64 + j4); u32x2 p; p.x = pk2(sv[0], sv[1]); p.y = pk2(sv[2], sv[3]); *(LAS u32x2*)(Sl + i * 72 + j4) = p; }
          __syncthreads();
          if (w < 2) { f32x4 y[1][4];
#pragma unroll
              for (int q = 0; q < 4; ++q) y[0][q] = *(const LAS f32x4*)(Y0L + (w * 16 + fr) * 68 + q * 16 + 4 * fq);
              wave_mm_nt<1, 4>(y, RLs + w * 16 * 72, 72, Sl, 72, 64, fr, fq);
              rwkv_out_epilogue<DRY>(F, m, y[0], (size_t)(r0 + w * 16 + fr), h, fq); }
          else if (w < 6) { const int mi = w - 2; f32x4 tl[1][4];
#pragma unroll
              for (int q = 0; q < 4; ++q) { const int j = q * 16 + 4 * fq; const f32x4 sv = *(const f32x4*)(sin_ + (mi * 16 + fr) * 64 + j), gl4 = *(const LAS f32x4*)(GLV + j), qv = *(const LAS f32x4*)(QTL + (mi * 16 + fr) * 68 + j);
                  tl[0][q] = (f32x4){__expf(gl4[0]) * sv[0] + qv[0], __expf(gl4[1]) * sv[1] + qv[1], __expf(gl4[2]) * sv[2] + qv[2], __expf(gl4[3]) * sv[3] + qv[3]}; }
              wave_mm_nt<1, 4>(tl, Sl + mi * 16 * 72, 72, PL, 72, 64, fr, fq);
#pragma unroll
              for (int q = 0; q < 4; ++q) *(f32x4*)(sout + (mi * 16 + fr) * 64 + q * 16 + 4 * fq) = tl[0][q]; }
      }
    }
}

constexpr int SC_GRP = 4, SC_CH = 8192 + 2048 + 256, SC_BUF = SC_GRP * SC_CH;
__device__ __forceinline__ void rwkv_scan_phase(Frame& F, int layer) {
    const int tid = otid(); const int lane = tid & 63, m = layer >> 1; const int b = blockIdx.x;
    if (b >= 64) return;
    const int h = b >> 2, sl = b & 3;
    const unsigned char* REC = F.ws + WS_REC;
    constexpr int NV = SC_BUF / 16;
    constexpr int NPT = (NV + NT - 1) / NT;
    constexpr int DEPTH = 4;
    struct RegSet { u32x4 v[NPT]; };
    RegSet sets[DEPTH];
    unsigned poff[NPT], pdst[NPT];
#pragma unroll
    for (int q = 0; q < NPT; ++q) { int v = tid + q * NT; v = v < NV ? v : NV - 1; const int cc = v / (SC_CH / 16), o = (v % (SC_CH / 16)) * 16;
        poff[q] = (unsigned)(cc * REC_B + o + (o >= 10240 ? 6144 : (o >= 8192 ? sl * 2048 : 0))); pdst[q] = (unsigned)(v * 16); }
    auto issue = [&](int g, RegSet& st) { const unsigned char* gb = REC + ((size_t)h * 256 + g * SC_GRP) * REC_B;
#pragma unroll
        for (int q = 0; q < NPT; ++q) st.v[q] = *(const u32x4*)(gb + poff[q]); };
    auto commit = [&](int buf, const RegSet& st) {
#pragma unroll
        for (int q = 0; q < NPT; ++q) *(LAS u32x4*)(F.lds + buf * SC_BUF + pdst[q]) = st.v[q]; };
    const int ci = lane & 15, q4 = lane >> 4, i = 16 * sl + ci;
    f32x4 T[4];
#pragma unroll
    for (int mm = 0; mm < 4; ++mm) T[mm] = (f32x4){0.f, 0.f, 0.f, 0.f};
    bf16_t* TST = (bf16_t*)(F.ws + WS_TST);
    constexpr int NG = 256 / SC_GRP;
    static_assert(NG % DEPTH == 0, "scan groups vs prefetch depth");
    issue(0, sets[0]);
#pragma unroll
    for (int d = 1; d < DEPTH; ++d) issue(d, sets[d]);
    commit(0, sets[0]);
    for (int g0 = 0; g0 < NG; g0 += DEPTH) {
#pragma unroll
        for (int dd = 0; dd < DEPTH; ++dd) { const int g = g0 + dd;
        if (g + DEPTH < NG) issue(g + DEPTH, sets[dd]);
        __syncthreads();
        if (F.wave == 0) {
            const LAS unsigned char* base = F.lds + (g & 1) * SC_BUF;
#pragma unroll 1
            for (int cc = 0; cc < SC_GRP; ++cc) { const int c = g * SC_GRP + cc; const LAS unsigned char* cb = base + cc * SC_CH;
                bf16_t* tdst = TST + (((size_t)h * 256 + c) * 64 + i) * 64;
                bf16x8 Tf[2];
#pragma unroll
                for (int mm = 0; mm < 4; ++mm) { u32x2 p; p.x = pk2(T[mm][0], T[mm][1]); p.y = pk2(T[mm][2], T[mm][3]); *(u32x2*)(tdst + 16 * mm + 4 * q4) = p;
                    Tf[mm >> 1][(mm & 1) * 4 + 0] = (short)(p.x & 0xffffu); Tf[mm >> 1][(mm & 1) * 4 + 1] = (short)(p.x >> 16); Tf[mm >> 1][(mm & 1) * 4 + 2] = (short)(p.y & 0xffffu); Tf[mm >> 1][(mm & 1) * 4 + 3] = (short)(p.y >> 16); }
#pragma unroll
                for (int mm = 0; mm < 4; ++mm) { const int j = 16 * mm + 4 * q4; const f32x4 gv = *(const LAS f32x4*)(cb + 10240 + j * 4); const u32x2 qv = *(const LAS u32x2*)(cb + 8192 + (ci * 64 + j) * 2);
                    f32x4 acc = (f32x4){gv[0] * T[mm][0] + bflo(qv.x), gv[1] * T[mm][1] + bfhi(qv.x), gv[2] * T[mm][2] + bflo(qv.y), gv[3] * T[mm][3] + bfhi(qv.y)};
#pragma unroll
                    for (int s = 0; s < 2; ++s) { const bf16x8 pf = *(const LAS bf16x8*)(cb + ((16 * mm + ci) * 64 + 32 * s + 8 * q4) * 2); acc = __builtin_amdgcn_mfma_f32_16x16x32_bf16(pf, Tf[s], acc, 0, 0, 0); }
                    T[mm] = acc; } }
        }
        __syncthreads();
        if (g + 1 < NG) commit((g + 1) & 1, sets[(dd + 1) % DEPTH]);
        }
    }
    if (F.wave == 0) { float* outp = F.out + O_WKVP + ((size_t)m * 16 + h) * 4096 + (size_t)i * 64;
#pragma unroll
        for (int mm = 0; mm < 4; ++mm) *(f32x4*)(outp + 16 * mm + 4 * q4) = T[mm]; }
}

template <bool DRY = false> __device__ __forceinline__ void rwkv_output_phase(Frame& F, int layer) {
    const int tid = otid(); const int lane = tid & 63, fr = lane & 15, fq = lane >> 4, m = layer >> 1;
    const bf16_t* RKV = (const bf16_t*)(F.ws + WS_RKV); const bf16_t* TST = (const bf16_t*)(F.ws + WS_TST);
    const int gw = F.vcu * NWAVES + F.wave, NGW = F.G * NWAVES;
    for (int u = gw; u < 256 * 16 * 4; u += NGW) { const int it = u & 3, h = (u >> 2) & 15, c = u >> 6;
        const size_t row = (size_t)(64 * c + 16 * it + fr); const bf16_t* ts = TST + ((size_t)h * 256 + c) * 4096;
        f32x4 y[4];
#pragma unroll
        for (int nt = 0; nt < 4; ++nt) { const u32x2 yv = *(const u32x2*)(RKV + row * 3072 + h * 64 + 16 * nt + 4 * fq); y[nt] = (f32x4){bflo(yv.x), bfhi(yv.x), bflo(yv.y), bfhi(yv.y)}; }
#pragma unroll
        for (int s = 0; s < 2; ++s) { const bf16x8 xa = *(const bf16x8*)(RKV + row * 3072 + 1024 + h * 64 + 32 * s + 8 * fq);
#pragma unroll
            for (int nt = 0; nt < 4; ++nt) { const bf16x8 yb = *(const bf16x8*)(ts + (16 * nt + fr) * 64 + 32 * s + 8 * fq); y[nt] = __builtin_amdgcn_mfma_f32_16x16x32_bf16(yb, xa, y[nt], 0, 0, 0); } }
        rwkv_out_epilogue<DRY>(F, m, y, row, h, fq);
    }
}

#define GRID_BAR() xcd_barrier(bar)
#ifndef PHASE_MASK
#define PHASE_MASK 0xffffffffu
#endif
#define PH(k) if (PHASE_MASK & (1u << (k)))
#ifndef REP_MASK
#define REP_MASK 0u
#endif
#define REP(k) (((REP_MASK) >> (k)) & 1u)
#ifndef LOCAL_SKIP
#define LOCAL_SKIP 0
#endif
#ifndef EXTRA_BARS
#define EXTRA_BARS 0
#endif
template <int layer> __device__ __forceinline__ void layer_body(Frame& F, const XcdBarrier& bar) {
    unsigned char* ws = F.ws; unsigned char* ar = ws + WS_ARENA;
    bf16_t* XN = (bf16_t*)(ws + WS_XN);
    const float* MOD = (const float*)(ws + WS_MOD);
    constexpr int m = layer >> 1; const float* modl = MOD + (size_t)layer * NSEQ * 6144;
    PH(1) for (int rep = 0; rep <= (int)REP(1); ++rep) if (layer > 0) convert_layer_weights(F, layer);
    if constexpr ((layer & 1) == 0) {
        PH(2) for (int rep = 0; rep <= (int)REP(2); ++rep) { if constexpr (layer == 0) norm_pass<0>(F, layer); else norm_pass<0, 16>(F, layer, layer - 1, 5120); }
        GRID_BAR();
        PH(3) { using GC = pg8::Geo<D, D, D, 30, 0, 1 << 20, 0>; pg8::Gemm<GC> g{XN, (const bf16_t*)(ar + AR_WIN), nullptr}; pg8::StaticOrder S; S.init(M, ABIN, F.G, (int)blockIdx.x);
          pg8::EpiBf16<0> E{(bf16_t*)(ws + WS_Z), ABIN};
          pg8::gemm_phase<pg8::EpiBf16<0>, pg8::StaticOrder, GC, true, true>(F.lds, g, S, E);
          if (REP(3)) { pg8::EpiNull<true> EN; pg8::gemm_phase<pg8::EpiNull<true>, pg8::StaticOrder, GC, true, true>(F.lds, g, S, EN); } }
        GRID_BAR();
        PH(4) for (int rep = 0; rep <= (int)REP(4); ++rep) for (int u = F.vcu; u < NCHUNK * 8; u += F.G) { const int c = u >> 3, hh = u & 7;
            if (c < 256) { if (hh < 4) ab_summary_unit<64, false>(F, layer, c, hh); else ab_summary_unit<64, true>(F, layer, c, hh - 4); }
            else { if (hh < 4) ab_summary_unit<32, false>(F, layer, c, hh); else ab_summary_unit<32, true>(F, layer, c, hh - 4); } }
        GRID_BAR();
        PH(5) { if (REP(5)) ab_scan<true>(F, layer); ab_scan<false>(F, layer); }
        GRID_BAR();
        PH(6) for (int rep = 0; rep <= (int)REP(6); ++rep) for (int u = F.vcu; u < NCHUNK * 8; u += F.G) { const int c = u >> 3, hh = u & 7;
            if (c < 256) { if (hh < 4) ab_output_unit<64, false>(F, layer, c, hh); else ab_output_unit<64, true>(F, layer, c, hh - 4); }
            else { if (hh < 4) ab_output_unit<32, false>(F, layer, c, hh); else ab_output_unit<32, true>(F, layer, c, hh - 4); } }
        GRID_BAR();
        PH(7) { using GC = pg8::Geo<D, D, D, 30, 0, 1 << 20, 0>; pg8::Gemm<GC> g{XN, (const bf16_t*)(ar + AR_WOUT), nullptr}; pg8::StaticOrder S; S.init(MP, D, F.G, (int)blockIdx.x);
          pg8::EpiRes E{F.out, modl, 2048};
          pg8::gemm_phase<pg8::EpiRes, pg8::StaticOrder, GC, true, true>(F.lds, g, S, E);
          if (REP(7)) { pg8::EpiNull<false> EN; pg8::gemm_phase<pg8::EpiNull<false>, pg8::StaticOrder, GC, true, true>(F.lds, g, S, EN); }
          using GC2 = pg8::Geo<D, D, 256, 30, 0, 1 << 20, 0, true>; pg8::Gemm<GC2> g2{XN, (const bf16_t*)(ar + AR_WOUT), nullptr}; pg8::SplitOrder S2{F.vcu, 4};
          pg8::EpiPartial E2{(float*)(ws + WS_PART), 4};
          pg8::gemm_phase<pg8::EpiPartial, pg8::SplitOrder, GC2, true, true>(F.lds, g2, S2, E2); }
        GRID_BAR();
    } else {
        PH(8) for (int rep = 0; rep <= (int)REP(8); ++rep) norm_pass<1, 16>(F, layer, layer - 1, 5120);
        GRID_BAR();
        PH(9) { using GC = pg8::Geo<D, 2048, 2048, 30, 0, 16, -4096>; pg8::Gemm<GC> g{XN, (const bf16_t*)(ar + AR_WC1), (const bf16_t*)(ws + WS_PREVS)}; pg8::StaticOrder S; S.init(M, 3584, F.G, (int)blockIdx.x);
          pg8::EpiRkv E{(bf16_t*)(ws + WS_RKV), (bf16_t*)(ws + WS_LO), (m == 0) ? (bf16_t*)(ws + WS_VFIRST) : nullptr};
          pg8::gemm_phase<pg8::EpiRkv, pg8::StaticOrder, GC, true, true>(F.lds, g, S, E);
          if (REP(9)) { pg8::EpiNull<true> EN; pg8::gemm_phase<pg8::EpiNull<true>, pg8::StaticOrder, GC, true, true>(F.lds, g, S, EN); } }
        GRID_BAR();
        PH(10) { using GC = pg8::Geo<D, 256, 256, 2, 256, 1 << 20, 0>; pg8::Gemm<GC> g{(const bf16_t*)(ws + WS_LO), (const bf16_t*)(ar + AR_WC2), nullptr}; pg8::StaticOrder S; S.init(M, 4096, F.G, (int)blockIdx.x);
          pg8::EpiLora2 E{(bf16_t*)(ws + WS_WLOG), XN, (bf16_t*)(ws + WS_G), (bf16_t*)(ws + WS_RKV), (m == 1) ? (const bf16_t*)(ws + WS_VFIRST) : nullptr,
                          F.in[I_RW0] + m * D, F.in[I_RA0] + m * D, F.in[I_RV0]};
          pg8::gemm_phase<pg8::EpiLora2, pg8::StaticOrder, GC, true, true>(F.lds, g, S, E);
          if (REP(10)) { pg8::EpiNull<false> EN; pg8::gemm_phase<pg8::EpiNull<false>, pg8::StaticOrder, GC, true, true>(F.lds, g, S, EN); } }
        GRID_BAR();
        PH(11) { RawRegs raw; const int tid0 = otid(); int u = F.vcu; if (u < NCHUNK * 16) rwkv_load_raw(F, u, tid0, raw);
          for (; u < NCHUNK * 16; u += F.G) { const int c = u >> 4, hh = u & 15, un = (u + F.G < NCHUNK * 16) ? u + F.G : -1;
              if (c < 256) rwkv_local_unit<64>(F, layer, c, hh, raw, un); else rwkv_local_unit<32>(F, layer, c, hh, raw, un); } }
        GRID_BAR();
        PH(17) for (int rep = 0; rep <= (int)REP(17); ++rep) rwkv_scan_phase(F, layer);
        GRID_BAR();
        PH(18) { if (REP(18)) rwkv_output_phase<true>(F, layer); rwkv_output_phase<false>(F, layer); }
        GRID_BAR();
        PH(12) { using GC = pg8::Geo<3072, D, D, 30, 0, 1 << 20, 0>; pg8::Gemm<GC> g{(const bf16_t*)(ws + WS_RKV), (const bf16_t*)(ar + AR_WO), nullptr}; pg8::StaticOrder S; S.init(MP, D, F.G, (int)blockIdx.x);
          pg8::EpiRes E{F.out, modl, 2048};
          pg8::gemm_phase<pg8::EpiRes, pg8::StaticOrder, GC, true, true>(F.lds, g, S, E);
          if (REP(12)) { pg8::EpiNull<false> EN; pg8::gemm_phase<pg8::EpiNull<false>, pg8::StaticOrder, GC, true, true>(F.lds, g, S, EN); }
          using GC2 = pg8::Geo<3072, D, 256, 30, 0, 1 << 20, 0, true>; pg8::Gemm<GC2> g2{(const bf16_t*)(ws + WS_RKV), (const bf16_t*)(ar + AR_WO), nullptr}; pg8::SplitOrder S2{F.vcu, 4};
          pg8::EpiPartial E2{(float*)(ws + WS_PART), 4};
          pg8::gemm_phase<pg8::EpiPartial, pg8::SplitOrder, GC2, true, true>(F.lds, g2, S2, E2); }
        GRID_BAR();
    }
    PH(13) for (int rep = 0; rep <= (int)REP(13); ++rep) norm_pass<2, 4>(F, layer, layer, 2048);
    GRID_BAR();
    PH(14) { using GC = pg8::Geo<D, D, D, 30, 0, 1 << 20, 0>; pg8::Gemm<GC> g{XN, (const bf16_t*)(ar + AR_W1), nullptr}; pg8::StaticOrder S; S.init(M, DFF, F.G, (int)blockIdx.x);
      pg8::EpiBf16<1> E{(bf16_t*)(ws + WS_H), DFF};
      pg8::gemm_phase<pg8::EpiBf16<1>, pg8::StaticOrder, GC, true, true>(F.lds, g, S, E);
          if (REP(14)) { pg8::EpiNull<true> EN; pg8::gemm_phase<pg8::EpiNull<true>, pg8::StaticOrder, GC, true, true>(F.lds, g, S, EN); } }
    GRID_BAR();
    PH(15) { using GC = pg8::Geo<DFF, DFF, DFF, 30, 0, 1 << 20, 0>; pg8::Gemm<GC> g{(const bf16_t*)(ws + WS_H), (const bf16_t*)(ar + AR_W2), nullptr}; pg8::StaticOrder S; S.init(MP, D, F.G, (int)blockIdx.x);
      pg8::EpiRes E{F.out, modl, 5120};
      for (int xb = 0; xb < EXTRA_BARS; ++xb) GRID_BAR();
      pg8::gemm_phase<pg8::EpiRes, pg8::StaticOrder, GC, true, true>(F.lds, g, S, E);
      if (REP(15)) { pg8::EpiNull<false> EN; pg8::gemm_phase<pg8::EpiNull<false>, pg8::StaticOrder, GC, true, true>(F.lds, g, S, EN); }
      using GC2 = pg8::Geo<DFF, DFF, 256, 30, 0, 1 << 20, 0, true>; pg8::Gemm<GC2> g2{(const bf16_t*)(ws + WS_H), (const bf16_t*)(ar + AR_W2), nullptr}; pg8::SplitOrder S2{F.vcu, 16};
      pg8::EpiPartial E2{(float*)(ws + WS_PART), 16};
      pg8::gemm_phase<pg8::EpiPartial, pg8::SplitOrder, GC2, true, true>(F.lds, g2, S2, E2); }
    GRID_BAR();
}

__global__ void __launch_bounds__(NT, 2) fwd_kernel(Args args) {
    extern __shared__ __attribute__((aligned(16))) unsigned char lds[];
    Frame F;
    F.lds = (LAS unsigned char*)lds; F.MISC = (volatile LAS unsigned*)(F.lds + MISC_OFF);
    F.wave = __builtin_amdgcn_readfirstlane(threadIdx.x >> 6);
    F.G = gridDim.x; { const int bx = blockIdx.x; F.vcu = (F.G % 8 == 0) ? (bx % 8) * (F.G / 8) + bx / 8 : bx; }
    F.in = args.in; F.out = args.out; F.ws = args.ws;
    for (int u = threadIdx.x; u < (LDS_BYTES - LDSCTL_OFF) / 4; u += NT) ((LAS unsigned*)(F.lds + LDSCTL_OFF))[u] = 0u;
    __syncthreads();
    XcdBarrier bar = xcd_barrier_post((unsigned*)(F.ws + WS_CTL) + CW_BAR, F.MISC + 8);
    PH(0) prologue(F);
    GRID_BAR();
    PH(0) mod_phase(F);
    GRID_BAR();
    layer_body<0>(F, bar); layer_body<1>(F, bar); layer_body<2>(F, bar); layer_body<3>(F, bar);
    PH(16) norm_pass<3, 16>(F, 0, 3, 5120);
}

extern "C" void kernel_launch(void* const* d_in, const int* in_sizes, int n_in, void* d_out, int out_size, void* d_ws, size_t ws_size, hipStream_t stream) {
    static int grid = 0;
    if (grid == 0) {
        if (n_in != 38 || out_size != 28706816 || ws_size < WS_END) { fprintf(stderr, "kernel_launch: unexpected problem (n_in %d, out %d, ws %zu; need ws >= %zu)\n", n_in, out_size, ws_size, (size_t)WS_END); grid = -1; return; }
        int dev = 0, cus = 0, per_cu = 0;
        if (hipGetDevice(&dev) != hipSuccess || hipDeviceGetAttribute(&cus, hipDeviceAttributeMultiprocessorCount, dev) != hipSuccess) { grid = -1; return; }
        if (hipFuncSetAttribute((const void*)fwd_kernel, hipFuncAttributeMaxDynamicSharedMemorySize, LDS_BYTES) != hipSuccess) { fprintf(stderr, "kernel_launch: hipFuncSetAttribute failed\n"); grid = -1; return; }
        if (hipOccupancyMaxActiveBlocksPerMultiprocessor(&per_cu, (const void*)fwd_kernel, NT, LDS_BYTES) != hipSuccess || per_cu < 1) { fprintf(stderr, "kernel_launch: occupancy query says %d\n", per_cu); per_cu = 1; }
        (void)hipGetLastError();
        grid = cus;
    }
    if (grid < 0) return;
    (void)hipMemsetAsync((char*)d_ws + WS_CTL, 0, ZERO_BYTES, stream);
    Args a{};
    for (int i = 0; i < 38; ++i) a.in[i] = (const float*)d_in[i];
    a.out = (float*)d_out; a.ws = (unsigned char*)d_ws;
    void* kargs[] = {&a};
    hipError_t e = hipLaunchCooperativeKernel((const void*)fwd_kernel, dim3(grid), dim3(NT), kargs, LDS_BYTES, stream);
    if (e != hipSuccess) fprintf(stderr, "kernel_launch: cooperative launch failed: %s (grid %d)\n", hipGetErrorString(e), grid);
}
```

```cpp
#include <hip/hip_runtime.h>
#include <cstdio>
#include <cstdint>

#define LAS __attribute__((address_space(3)))
#define GAS __attribute__((address_space(1)))
typedef unsigned short bf16_t;
typedef short bf16x8 __attribute__((ext_vector_type(8)));
typedef float f32x4 __attribute__((ext_vector_type(4)));
typedef float f32x2 __attribute__((ext_vector_type(2)));
typedef unsigned u32x4 __attribute__((ext_vector_type(4)));
typedef unsigned u32x2 __attribute__((ext_vector_type(2)));

#ifndef LOCAL_SKIP
#define LOCAL_SKIP 0
#endif
constexpr int D = 1024, MP = 16384, MS = 1024, M = MP + MS, NSEQ = 33, DFF = 4096, ABIN = 3584;
constexpr int NCHUNK = 288;
constexpr int SLOT_E = 4 * 8192 + 4 * 16384;
constexpr float NORM_EPS = 1e-6f, RW_LN_EPS = 64e-5f;

constexpr size_t MiB = 1u << 20;
constexpr size_t WS_CTL = 0, WS_MOD = 1 * MiB, ZERO_BYTES = 65536;
constexpr size_t WS_ROPE = 5 * MiB;
constexpr size_t WS_ARENA = 10 * MiB;
constexpr size_t AR_W1 = 0, AR_W2 = 8 * MiB, AR_WIN = 16 * MiB, AR_WOUT = 23 * MiB, AR_WC1 = 16 * MiB, AR_WC2 = 32 * MiB, AR_WO = 34 * MiB;
constexpr size_t WS_VFIRST = 46 * MiB;
constexpr size_t WS_XN0 = 80 * MiB, WS_XN = WS_XN0 + 2048;
constexpr size_t WS_PREVS = 115 * MiB;
constexpr size_t WS_R1 = 118 * MiB;
constexpr size_t WS_Z = WS_R1, WS_STATE = WS_R1 + 120 * MiB, WS_DEC = WS_R1 + 174 * MiB;
constexpr size_t WS_H = WS_R1;
constexpr size_t WS_RKV = WS_R1, WS_LO = WS_R1 + 102 * MiB, WS_WLOG = WS_R1 + 136 * MiB, WS_G = WS_R1 + 170 * MiB;
constexpr size_t WS_TST = WS_R1 + 102 * MiB;
constexpr size_t WS_REC = WS_R1 + 204 * MiB, WS_BON = WS_R1 + 269 * MiB;
constexpr int REC_B = 16640;
constexpr size_t WS_PART = WS_R1 + 136 * MiB;
constexpr size_t WS_END = WS_R1 + 271 * MiB;

__device__ const double ROPE_REV[32] = {0.15915494309189535, 0.11934937021124886, 0.089499401608891013, 0.067115083005227255, 0.050329212104487035, 0.037741584717419771, 0.028302195830623399, 0.02122365276477766, 0.015915494309189534, 0.011934937021124886, 0.0089499401608891024, 0.0067115083005227253, 0.0050329212104487037, 0.0037741584717419772, 0.0028302195830623399, 0.0021223652764777662, 0.0015915494309189536, 0.0011934937021124885, 0.00089499401608891024, 0.0006711508300522726, 0.00050329212104487033, 0.00037741584717419774, 0.00028302195830623395, 0.00021223652764777661, 0.00015915494309189535, 0.00011934937021124886, 8.9499401608891018e-05, 6.7115083005227254e-05, 5.0329212104487035e-05, 3.7741584717419777e-05, 2.8302195830623396e-05, 2.1223652764777659e-05};

__device__ __forceinline__ unsigned f2bf(float f) { unsigned u = __builtin_bit_cast(unsigned, f); return (u + 0x7fffu + ((u >> 16) & 1u)) >> 16; }
typedef __bf16 bf16x2_t __attribute__((ext_vector_type(2)));
__device__ __forceinline__ unsigned pk2(float lo, float hi) { const f32x2 v = {lo, hi}; const bf16x2_t b = __builtin_convertvector(v, bf16x2_t); return __builtin_bit_cast(unsigned, b); }
__device__ __forceinline__ float bf2f(unsigned short b) { return __builtin_bit_cast(float, (unsigned)b << 16); }
__device__ __forceinline__ float bflo(unsigned w) { return __builtin_bit_cast(float, w << 16); }
__device__ __forceinline__ float bfhi(unsigned w) { return __builtin_bit_cast(float, w & 0xffff0000u); }
__device__ __forceinline__ float sigmoidf_(float x) { return 1.f / (1.f + __expf(-x)); }
__device__ __forceinline__ float siluf_(float x) { return x / (1.f + __expf(-x)); }
__device__ __forceinline__ float wave_sum(float v) {
#pragma unroll
    for (int o = 1; o < 64; o <<= 1) v += __shfl_xor(v, o);
    return v;
}
__device__ __forceinline__ int otid() { int t = threadIdx.x; asm volatile("" : "+v"(t)); return t; }
__device__ __forceinline__ int seq_of_row(int r) { return r < MP ? 0 : 1 + ((r - MP) >> 5); }
#define LDS_WAIT() asm volatile("s_waitcnt lgkmcnt(0)" ::: "memory")
#define VM_WAIT() asm volatile("s_waitcnt vmcnt(0)" ::: "memory")

namespace pg8 {
constexpr int BM = 256, BK = 64, HALF = 128, HTB = HALF * BK * 2, STAGE_BYTES = 8 * HTB, NXCD = 8, WGM = 8;
__host__ __device__ __forceinline__ int lds_byte(int r, int c) { const int st = (r >> 4) * 2 + (c >> 5), rr = r & 15, cc = c & 31, ob = rr * 64 + cc * 2; return st * 1024 + (ob ^ (((ob >> 9) & 1) << 5)); }
__host__ __device__ __forceinline__ void stage_rc(int b, int& R, int& C) { const int st = b / 1024, sb = b % 1024, swz = sb ^ (((sb >> 9) & 1) << 5); R = (st >> 1) * 16 + swz / 64; C = (st & 1) * 32 + (swz % 64) / 2; }
__host__ __device__ __forceinline__ int perm32(int rho) { const int n = rho >> 4, i = rho & 15; return 8 * (i >> 2) + 4 * n + (i & 3); }

struct Unit { int pm, pn, ks; };
template <int LDA_, int LDB_, int K_, int GSHIFT_, int GSTRIDE_, int KSPLIT_, int DELTAP_, bool SPLIT_ = false> struct Geo {
    static constexpr int LDA = LDA_, LDB = LDB_, K = K_, GSHIFT = GSHIFT_, GSTRIDE = GSTRIDE_, KSPLIT = KSPLIT_, DELTAP = DELTAP_; static constexpr bool SPLIT = SPLIT_;
};
template <class GC> struct Gemm {
    const bf16_t* A; const bf16_t* Bt; const bf16_t* A2s;
    __device__ __forceinline__ const char* a_base(const Unit& u) const { return (const char*)(A + (size_t)u.pm * BM * GC::LDA + (size_t)(u.pn >> GC::GSHIFT) * GC::GSTRIDE + (GC::SPLIT ? (size_t)u.ks * GC::K : 0)); }
    __device__ __forceinline__ const char* b_base(const Unit& u) const { return (const char*)(Bt + (size_t)u.pn * BM * GC::LDB + (GC::SPLIT ? (size_t)u.ks * GC::K : 0)); }
    __device__ __forceinline__ long a_delta(const Unit& u) const {
        if constexpr (GC::KSPLIT >= GC::K / BK) return 0;
        else { if (u.pm < 64) return (long)GC::DELTAP;
            return (long)((const char*)(A2s + (size_t)(u.pm - 64) * BM * GC::LDA) - a_base(u)) - (long)GC::KSPLIT * BK * 2; }
    }
};
struct StaticOrder {
    int nM, nN, nwg, G, c;
    __host__ __device__ void init(int M_, int N_, int G_, int c_) { nM = M_ / BM; nN = N_ / BM; nwg = nM * nN; G = G_; c = c_; }
    __host__ __device__ bool next(int i, Unit& u) const {
        const long L = (long)i * G + c; if (L >= nwg) return false;
        int wgid = (int)L; { const int q = nwg / NXCD, r = nwg % NXCD, xcd = wgid % NXCD, off = wgid / NXCD; wgid = (xcd < r ? xcd * (q + 1) : r * (q + 1) + (xcd - r) * q) + off; }
        const int nig = WGM * nN, gid = wgid / nig, fm = gid * WGM, gsz = (nM - fm) < WGM ? (nM - fm) : WGM;
        u.pm = fm + ((wgid % nig) % gsz); u.pn = (wgid % nig) / gsz; u.ks = 0; return true;
    }
};
__device__ __forceinline__ unsigned cvt_pk_bf16(float lo, float hi) { return pk2(lo, hi); }

template <class Epi, class Sched, class GC, bool ALIGN_EPI = false, bool SP2 = false>
__device__ __forceinline__ void gemm_phase(LAS unsigned char* lds, const Gemm<GC> g, const Sched& S, const Epi& E) {
    const int tid = otid(), wid = __builtin_amdgcn_readfirstlane(tid >> 6), lane = tid & 63, wr = wid >> 2, wc = wid & 3, fr = lane & 15, fq = lane >> 4;
    constexpr int K = GC::K, nt = K / BK, ksplit = GC::KSPLIT;
    unsigned voffA[2], voffB[2];
#pragma unroll
    for (int i = 0; i < 2; ++i) { int R, C; stage_rc(tid * 16 + i * 8192, R, C); const int Rb = Epi::PERM ? ((R & ~31) + perm32(R & 31)) : R;
        voffA[i] = (unsigned)(R * GC::LDA + C) * 2u; voffB[i] = (unsigned)(Rb * GC::LDB + C) * 2u; }
    constexpr size_t kstep = (size_t)(BK * 2);
    constexpr size_t hstepA = (size_t)HALF * GC::LDA * 2, hstepB = (size_t)HALF * GC::LDB * 2;
    const unsigned ldsw = (unsigned)wid * 1024u;
    const int aoff = lds_byte(wr * 64 + fr, fq * 8), boff = lds_byte(wc * 32 + fr, fq * 8);
#define PG8_SA(b, h) (((b) * 2 + (h)) * HTB)
#define PG8_SB(b, h) ((4 + (b) * 2 + (h)) * HTB)
#define PG8_STAGE(bufoff, gbase, voff) do { _Pragma("unroll") for (int _i = 0; _i < 2; ++_i) \
        __builtin_amdgcn_global_load_lds((const unsigned*)((const char*)(gbase) + (voff)[_i]), (LAS unsigned*)(lds + (bufoff) + ldsw + _i * 8192), 16, 0, 0); } while (0)
#define PG8_LDA(dst, b, h) do { _Pragma("unroll") for (int m = 0; m < 4; ++m) _Pragma("unroll") for (int k = 0; k < 2; ++k) dst[m][k] = *(const LAS bf16x8*)(lds + PG8_SA(b, h) + aoff + m * 2048 + k * 1024); } while (0)
#define PG8_LDB(dst, b, h) do { _Pragma("unroll") for (int n = 0; n < 2; ++n) _Pragma("unroll") for (int k = 0; k < 2; ++k) dst[n][k] = *(const LAS bf16x8*)(lds + PG8_SB(b, h) + boff + n * 2048 + k * 1024); } while (0)
#define PG8_MMA(ai, bj, At, Bt) do { __builtin_amdgcn_s_setprio(1); _Pragma("unroll") for (int m = 0; m < 4; ++m) _Pragma("unroll") for (int n = 0; n < 2; ++n) _Pragma("unroll") for (int k = 0; k < 2; ++k) \
        acc[ai][bj][m][n] = __builtin_amdgcn_mfma_f32_16x16x32_bf16(Bt[n][k], At[m][k], acc[ai][bj][m][n], 0, 0, 0); __builtin_amdgcn_s_setprio(0); } while (0)
#define PG8_WAIT_V(n) asm volatile("s_waitcnt vmcnt(" #n ")" ::: "memory")
#define PG8_WAIT_L(n) asm volatile("s_waitcnt lgkmcnt(" #n ")" ::: "memory")
#define PG8_BAR __builtin_amdgcn_s_barrier()
#define PG8_SCHED __builtin_amdgcn_sched_barrier(0)
    Unit cur, nxt; int ui = 0;
    if (!S.next(0, cur)) return;
    f32x4 acc[2][2][4][2];
#pragma unroll
    for (int a = 0; a < 2; ++a)
#pragma unroll
        for (int b = 0; b < 2; ++b)
#pragma unroll
            for (int m = 0; m < 4; ++m)
#pragma unroll
                for (int n = 0; n < 2; ++n) acc[a][b][m][n] = (f32x4){0.f, 0.f, 0.f, 0.f};
    bf16x8 At[4][2], B0[2][2], B1[2][2];
    const char* cA = g.a_base(cur); const char* cB = g.b_base(cur); long cD = g.a_delta(cur);
    if constexpr (SP2) {
        PG8_STAGE(PG8_SB(0, 0), cB, voffB); PG8_STAGE(PG8_SB(0, 1), cB + hstepB, voffB); PG8_STAGE(PG8_SA(0, 0), cA, voffA); PG8_STAGE(PG8_SA(0, 1), cA + hstepA, voffA);
        if (wr == 1) PG8_BAR;
        PG8_WAIT_V(2); PG8_BAR;
        PG8_STAGE(PG8_SB(1, 0), cB + kstep, voffB); PG8_STAGE(PG8_SA(1, 0), cA + kstep, voffA); PG8_STAGE(PG8_SB(1, 1), cB + hstepB + kstep, voffB);
        PG8_WAIT_V(6); PG8_BAR;
    } else {
        PG8_STAGE(PG8_SB(0, 0), cB, voffB); PG8_STAGE(PG8_SA(0, 0), cA, voffA); PG8_STAGE(PG8_SB(0, 1), cB + hstepB, voffB); PG8_STAGE(PG8_SA(0, 1), cA + hstepA, voffA);
        if (wr == 1) PG8_BAR;
        PG8_WAIT_V(4); PG8_BAR;
        PG8_STAGE(PG8_SB(1, 0), cB + kstep, voffB); PG8_STAGE(PG8_SA(1, 0), cA + kstep, voffA); PG8_STAGE(PG8_SB(1, 1), cB + hstepB + kstep, voffB);
        PG8_WAIT_V(6); PG8_BAR;
    }
    for (;;) {
        const bool has_next = S.next(ui + 1, nxt);
        const char* nA = has_next ? g.a_base(nxt) : cA; const char* nB = has_next ? g.b_base(nxt) : cB;
        const long nD = has_next ? g.a_delta(nxt) : cD;
#pragma unroll 1
        for (int t = 0; t < nt; t += 2) {
            const bool last = (t == nt - 2);
            const char* a1 = cA + (size_t)(t + 1) * kstep + (t >= ksplit ? cD : 0);
            const char* a2 = last ? nA : cA + (size_t)(t + 2) * kstep + (t + 2 >= ksplit ? cD : 0); const char* b2 = last ? nB : cB + (size_t)(t + 2) * kstep;
            const char* a3 = a2 + kstep; const char* b3 = b2 + kstep;
            if constexpr (SP2) {
            PG8_LDB(B0, 0, 0); PG8_LDB(B1, 0, 1); PG8_SCHED; PG8_LDA(At, 0, 0); PG8_STAGE(PG8_SA(1, 1), a1 + hstepA, voffA);
            PG8_WAIT_V(8); PG8_WAIT_L(0); PG8_BAR; PG8_MMA(0, 0, At, B0); PG8_MMA(0, 1, At, B1); PG8_BAR; PG8_SCHED;
            PG8_LDA(At, 0, 1); PG8_STAGE(PG8_SB(0, 0), b2, voffB); PG8_STAGE(PG8_SB(0, 1), b2 + hstepB, voffB); PG8_STAGE(PG8_SA(0, 0), a2, voffA);
            PG8_WAIT_V(8); PG8_WAIT_L(0); PG8_BAR; PG8_MMA(1, 0, At, B0); PG8_MMA(1, 1, At, B1); PG8_BAR; PG8_SCHED;
            PG8_LDB(B0, 1, 0); PG8_LDB(B1, 1, 1); PG8_SCHED; PG8_LDA(At, 1, 0); PG8_STAGE(PG8_SA(0, 1), a2 + hstepA, voffA);
            PG8_WAIT_V(8); PG8_WAIT_L(0); PG8_BAR; PG8_MMA(0, 0, At, B0); PG8_MMA(0, 1, At, B1); PG8_BAR; PG8_SCHED;
            PG8_LDA(At, 1, 1); PG8_STAGE(PG8_SB(1, 0), b3, voffB); PG8_STAGE(PG8_SB(1, 1), b3 + hstepB, voffB); PG8_STAGE(PG8_SA(1, 0), a3, voffA);
            PG8_WAIT_V(8); PG8_WAIT_L(0); PG8_BAR; PG8_MMA(1, 0, At, B0); PG8_MMA(1, 1, At, B1); PG8_BAR; PG8_SCHED;
            } else {
            PG8_LDB(B0, 0, 0); PG8_SCHED; PG8_LDA(At, 0, 0); PG8_STAGE(PG8_SA(1, 1), a1 + hstepA, voffA);
            PG8_WAIT_L(8); PG8_BAR; PG8_WAIT_L(0); PG8_MMA(0, 0, At, B0); PG8_BAR; PG8_SCHED;
            PG8_LDB(B1, 0, 1); PG8_STAGE(PG8_SB(0, 0), b2, voffB);
            PG8_BAR; PG8_WAIT_L(0); PG8_MMA(0, 1, At, B1); PG8_BAR;
            PG8_LDA(At, 0, 1); PG8_STAGE(PG8_SA(0, 0), a2, voffA);
            PG8_BAR; PG8_WAIT_L(0); PG8_MMA(1, 0, At, B0); PG8_BAR; PG8_SCHED;
            PG8_STAGE(PG8_SB(0, 1), b2 + hstepB, voffB);
            PG8_WAIT_V(6); PG8_BAR; PG8_MMA(1, 1, At, B1); PG8_BAR;
            PG8_LDB(B0, 1, 0); PG8_SCHED; PG8_LDA(At, 1, 0); PG8_STAGE(PG8_SA(0, 1), a2 + hstepA, voffA);
            PG8_WAIT_L(8); PG8_BAR; PG8_WAIT_L(0); PG8_MMA(0, 0, At, B0); PG8_BAR; PG8_SCHED;
            PG8_LDB(B1, 1, 1); PG8_STAGE(PG8_SB(1, 0), b3, voffB);
            PG8_BAR; PG8_WAIT_L(0); PG8_MMA(0, 1, At, B1); PG8_BAR;
            PG8_LDA(At, 1, 1); PG8_STAGE(PG8_SA(1, 0), a3, voffA);
            PG8_BAR; PG8_WAIT_L(0); PG8_MMA(1, 0, At, B0); PG8_BAR; PG8_SCHED;
            PG8_STAGE(PG8_SB(1, 1), b3 + hstepB, voffB);
            PG8_WAIT_V(6); PG8_BAR; PG8_MMA(1, 1, At, B1); PG8_BAR;
            }
        }
        if constexpr (ALIGN_EPI) { if (wr == 0) PG8_BAR; }
        E(acc, cur, wr, wc, fr, fq);
        if (!has_next) break;
#pragma unroll
        for (int a = 0; a < 2; ++a)
#pragma unroll
            for (int b = 0; b < 2; ++b)
#pragma unroll
                for (int m = 0; m < 4; ++m)
#pragma unroll
                    for (int n = 0; n < 2; ++n) acc[a][b][m][n] = (f32x4){0.f, 0.f, 0.f, 0.f};
        cur = nxt; cA = nA; cB = nB; cD = nD; ++ui;
        if constexpr (ALIGN_EPI) { if (wr == 1) PG8_BAR; }
    }
    PG8_WAIT_V(0);
    if constexpr (!ALIGN_EPI) { if (wr == 0) PG8_BAR; }
    PG8_BAR;
#undef PG8_SA
#undef PG8_SB
#undef PG8_STAGE
#undef PG8_LDA
#undef PG8_LDB
#undef PG8_MMA
#undef PG8_WAIT_V
#undef PG8_WAIT_L
#undef PG8_BAR
#undef PG8_SCHED
}

__device__ __forceinline__ float act_apply(float v, int act) {
    if (act == 1) { const float r = v > 0.f ? v : 0.f; return r * r; }
    if (act == 2) { const float e = __expf(-2.f * fabsf(v)); const float t = (1.f - e) / (1.f + e); return v < 0.f ? -t : t; }
    if (act == 3) return 1.f / (1.f + __expf(-v));
    return v;
}
template <int ACT> __device__ __forceinline__ void store_tile_bf16(const f32x4 (&acc)[2][2][4][2], bf16_t* base, int ldc, int row0, int col0, bf16_t* base2, int ldc2, int col2) {
#pragma unroll
    for (int ai = 0; ai < 2; ++ai)
#pragma unroll
        for (int m = 0; m < 4; ++m) { const size_t r = (size_t)(row0 + ai * HALF + m * 16);
#pragma unroll
            for (int bj = 0; bj < 2; ++bj) { f32x4 v0 = acc[ai][bj][m][0], v1 = acc[ai][bj][m][1];
#pragma unroll
                for (int q = 0; q < 4; ++q) { v0[q] = act_apply(v0[q], ACT); v1[q] = act_apply(v1[q], ACT); }
                u32x4 w; w.x = cvt_pk_bf16(v0[0], v0[1]); w.y = cvt_pk_bf16(v0[2], v0[3]); w.z = cvt_pk_bf16(v1[0], v1[1]); w.w = cvt_pk_bf16(v1[2], v1[3]);
                *(u32x4*)(base + r * ldc + col0 + bj * HALF) = w;
                if (base2) *(u32x4*)(base2 + r * ldc2 + col2 + bj * HALF) = w; } }
}
template <int ACT> struct EpiBf16 {
    static constexpr bool PERM = true;
    bf16_t* O; int ldc;
    __device__ __forceinline__ void operator()(const f32x4 (&acc)[2][2][4][2], const Unit& u, int wr, int wc, int fr, int fq) const {
        store_tile_bf16<ACT>(acc, O, ldc, u.pm * BM + wr * 64 + fr, u.pn * BM + wc * 32 + 8 * fq, nullptr, 0, 0);
    }
};
struct EpiRkv {
    static constexpr bool PERM = true;
    bf16_t* RKV; bf16_t* LO; bf16_t* vf;
    __device__ __forceinline__ void operator()(const f32x4 (&acc)[2][2][4][2], const Unit& u, int wr, int wc, int fr, int fq) const {
        const int row0 = u.pm * BM + wr * 64 + fr, cin = wc * 32 + 8 * fq;
        if (u.pn < 12) { bf16_t* b2 = (u.pn >= 8) ? vf : nullptr; store_tile_bf16<0>(acc, RKV, 3072, row0, u.pn * BM + cin, b2, 1024, (u.pn - 8) * BM + cin); }
        else {
#pragma unroll
            for (int bj = 0; bj < 2; ++bj) { const int c = cin + bj * HALF; int dst = -1, act = 0;
                if (u.pn == 12) { if (c < 64) { dst = c; act = 2; } else if (c < 128) dst = 256 + (c - 64); else if (c < 160) dst = 512 + (c - 128); }
                else if (c < 160) { dst = 768 + c; act = 3; }
                if (dst >= 0) {
#pragma unroll
                    for (int ai = 0; ai < 2; ++ai)
#pragma unroll
                        for (int m = 0; m < 4; ++m) { const size_t r = (size_t)(row0 + ai * HALF + m * 16); f32x4 v0 = acc[ai][bj][m][0], v1 = acc[ai][bj][m][1];
#pragma unroll
                            for (int q = 0; q < 4; ++q) { v0[q] = act_apply(v0[q], act); v1[q] = act_apply(v1[q], act); }
                            u32x4 w; w.x = cvt_pk_bf16(v0[0], v0[1]); w.y = cvt_pk_bf16(v0[2], v0[3]); w.z = cvt_pk_bf16(v1[0], v1[1]); w.w = cvt_pk_bf16(v1[2], v1[3]);
                            *(u32x4*)(LO + r * 1024 + dst) = w; } } }
        }
    }
};
struct EpiRes {
    static constexpr bool PERM = false;
    float* X; const float* modl; int goff; const float* Xin;
    __device__ __forceinline__ void operator()(const f32x4 (&acc)[2][2][4][2], const Unit& u, int wr, int wc, int fr, int fq) const {
        const int col0 = u.pn * BM + wc * 32 + 4 * fq;
#pragma unroll
        for (int ai = 0; ai < 2; ++ai)
#pragma unroll
            for (int m = 0; m < 4; ++m) { const int r = u.pm * BM + ai * HALF + wr * 64 + m * 16 + fr; const float* gp = modl + (size_t)seq_of_row(r) * 6144 + goff + col0; float* xp = X + (size_t)r * D + col0; const float* xi = Xin + (size_t)r * D + col0;
#pragma unroll
                for (int bj = 0; bj < 2; ++bj)
#pragma unroll
                    for (int n = 0; n < 2; ++n) { const f32x4 gv = *(const f32x4*)(gp + bj * HALF + n * 16); f32x4 xv = *(const f32x4*)(xi + bj * HALF + n * 16);
                        xv = xv + gv * acc[ai][bj][m][n]; *(f32x4*)(xp + bj * HALF + n * 16) = xv; }
                asm volatile("" ::: "memory"); }
    }
};
struct EpiLora2 {
    static constexpr bool PERM = false;
    bf16_t* WLOG; bf16_t* Aout; bf16_t* G; bf16_t* RKV; const bf16_t* vf; const float* w0; const float* a0; const float* v0;
    template <int GRP> __device__ __forceinline__ void run(const f32x4 (&acc)[2][2][4][2], const Unit& u, int wr, int wc, int fr, int fq) const {
        const int col0 = (u.pn & 3) * BM + wc * 32 + 4 * fq;
#pragma unroll
        for (int ai = 0; ai < 2; ++ai)
#pragma unroll
            for (int m = 0; m < 4; ++m) { const size_t r = (size_t)(u.pm * BM + ai * HALF + wr * 64 + m * 16 + fr);
#pragma unroll
                for (int bj = 0; bj < 2; ++bj)
#pragma unroll
                    for (int n = 0; n < 2; ++n) { const int c = col0 + bj * HALF + n * 16; const f32x4 a = acc[ai][bj][m][n]; f32x4 o;
                        if constexpr (GRP == 0) { const f32x4 b = *(const f32x4*)(w0 + c);
#pragma unroll
                            for (int q = 0; q < 4; ++q) { const float x = -(b[q] + a[q]); const float sp = fmaxf(x, 0.f) + __logf(1.f + __expf(-fabsf(x))); o[q] = -__expf(-sp - 0.5f); }
                            u32x2 w; w.x = cvt_pk_bf16(o[0], o[1]); w.y = cvt_pk_bf16(o[2], o[3]); *(u32x2*)(WLOG + r * D + c) = w; }
                        else if constexpr (GRP == 1) { const f32x4 b = *(const f32x4*)(a0 + c);
#pragma unroll
                            for (int q = 0; q < 4; ++q) o[q] = 1.f / (1.f + __expf(-(b[q] + a[q])));
                            u32x2 w; w.x = cvt_pk_bf16(o[0], o[1]); w.y = cvt_pk_bf16(o[2], o[3]); *(u32x2*)(Aout + r * D + c) = w; }
                        else if constexpr (GRP == 2) { const f32x4 b = *(const f32x4*)(v0 + c); const u32x2 vv = *(const u32x2*)(RKV + r * 3072 + 2048 + c), ff = *(const u32x2*)(vf + r * D + c);
                            f32x4 v4, f4; v4[0] = bflo(vv.x); v4[1] = bfhi(vv.x); v4[2] = bflo(vv.y); v4[3] = bfhi(vv.y); f4[0] = bflo(ff.x); f4[1] = bfhi(ff.x); f4[2] = bflo(ff.y); f4[3] = bfhi(ff.y);
#pragma unroll
                            for (int q = 0; q < 4; ++q) { const float gte = 1.f / (1.f + __expf(-(b[q] + a[q]))); o[q] = v4[q] + (f4[q] - v4[q]) * gte; }
                            u32x2 w; w.x = cvt_pk_bf16(o[0], o[1]); w.y = cvt_pk_bf16(o[2], o[3]); *(u32x2*)(RKV + r * 3072 + 2048 + c) = w; }
                        else { u32x2 w; w.x = cvt_pk_bf16(a[0], a[1]); w.y = cvt_pk_bf16(a[2], a[3]); *(u32x2*)(G + r * D + c) = w; } }
                asm volatile("" ::: "memory"); }
    }
    __device__ __forceinline__ void operator()(const f32x4 (&acc)[2][2][4][2], const Unit& u, int wr, int wc, int fr, int fq) const {
        const int grp = u.pn >> 2;
        if (grp == 0) run<0>(acc, u, wr, wc, fr, fq);
        else if (grp == 1) run<1>(acc, u, wr, wc, fr, fq);
        else if (grp == 2) { if (vf != nullptr) run<2>(acc, u, wr, wc, fr, fq); }
        else run<3>(acc, u, wr, wc, fr, fq);
    }
};
struct SplitOrder {
    int c, splitk;
    __device__ bool next(int i, Unit& u) const { if (i != 0 || c >= 16 * splitk) return false; const int t = c / splitk; u.pm = 64 + (t >> 2); u.pn = t & 3; u.ks = c % splitk; return true; }
};
struct EpiPartial {
    static constexpr bool PERM = false;
    float* PART; int splitk;
    __device__ __forceinline__ void operator()(const f32x4 (&acc)[2][2][4][2], const Unit& u, int wr, int wc, int fr, int fq) const {
        float* base = PART + ((size_t)(((u.pm - 64) * 4 + u.pn) * splitk + u.ks) << 16) + wc * 32 + 4 * fq;
#pragma unroll
        for (int ai = 0; ai < 2; ++ai)
#pragma unroll
            for (int m = 0; m < 4; ++m) { float* rp = base + (ai * HALF + wr * 64 + m * 16 + fr) * 256;
#pragma unroll
                for (int bj = 0; bj < 2; ++bj)
#pragma unroll
                    for (int n = 0; n < 2; ++n) *(f32x4*)(rp + bj * HALF + n * 16) = acc[ai][bj][m][n]; }
    }
};
template <bool PERM_> struct EpiNull {
    static constexpr bool PERM = PERM_;
    __device__ __forceinline__ void operator()(const f32x4 (&acc)[2][2][4][2], const Unit&, int, int, int, int) const {
#pragma unroll
        for (int a = 0; a < 2; ++a)
#pragma unroll
            for (int b = 0; b < 2; ++b)
#pragma unroll
                for (int m = 0; m < 4; ++m)
#pragma unroll
                    for (int n = 0; n < 2; ++n) asm volatile("" :: "v"(acc[a][b][m][n]));
    }
};
}

#define RLX_AGENT __ATOMIC_RELAXED, __HIP_MEMORY_SCOPE_AGENT
#define XB_TMO      128
#define XB_XCNT(j)  (256  + 64 * (j))
#define XB_XSUB(j)  (1280 + 64 * (j))
#define XB_XGEN(j)  (2304 + 64 * (j))
#define XB_TOP      3328
#define XB_TOPGEN   3392
#define XCD_BAR_WORDS 3456
#define XB_SPIN_CAP (1u << 24)
__device__ __forceinline__ unsigned xb_ld(unsigned* p)              { return __hip_atomic_load(p, __ATOMIC_RELAXED, __HIP_MEMORY_SCOPE_AGENT); }
__device__ __forceinline__ unsigned xb_add(unsigned* p, unsigned v) { return __hip_atomic_fetch_add(p, v, __ATOMIC_RELAXED, __HIP_MEMORY_SCOPE_AGENT); }
__device__ __forceinline__ unsigned xb_xcc_id() { return (unsigned)__builtin_amdgcn_s_getreg((3 << 11) | 20) & 0xFu; }
#define XB_SPIN(cond, bar) do { unsigned _sp = 0; while (cond) { __builtin_amdgcn_s_sleep(4); \
    if ((++_sp & 255u) == 0u) { if (xb_ld(&(bar)[XB_TMO])) break; if (_sp > XB_SPIN_CAP) { atomicAdd(&(bar)[XB_TMO], 1u); break; } } } } while (0)
struct XcdBarrier { unsigned* bar; unsigned x; volatile LAS unsigned* st; };
__device__ __forceinline__ XcdBarrier xcd_barrier_post(unsigned* bar, volatile LAS unsigned* st) {
    XcdBarrier b; b.bar = bar; b.x = xb_xcc_id(); b.st = st;
    if (threadIdx.x == 0) (void)xb_add(&bar[XB_XCNT(b.x)], 1u);
    return b;
}
__device__ __forceinline__ void xcd_barrier_complete(unsigned* bar, unsigned x, unsigned& nloc, unsigned& nx) {
    const unsigned G = gridDim.x * gridDim.y * gridDim.z;
    unsigned sum, cnt, mine, sp = 0u;
    for (;;) {
        sum = 0u; cnt = 0u; mine = 0u;
#pragma unroll
        for (unsigned j = 0; j < 16; ++j) { const unsigned c = xb_ld(&bar[XB_XCNT(j)]); sum += c; cnt += (c > 0u) ? 1u : 0u; mine = (j == x) ? c : mine; }
        if (sum == G) break;
        __builtin_amdgcn_s_sleep(1);
        if ((++sp & 255u) == 0u) { if (xb_ld(&bar[XB_TMO])) break; if (sp > XB_SPIN_CAP) { atomicAdd(&bar[XB_TMO], 1u); break; } }
    }
    nloc = mine > 0u ? mine : 1u; nx = cnt > 0u ? cnt : 1u;
}
__device__ __forceinline__ void xcd_barrier(const XcdBarrier& b) {
    asm volatile("s_waitcnt vmcnt(0)" ::: "memory");
    __syncthreads();
    if (threadIdx.x == 0) {
        unsigned* bar = b.bar;
        __builtin_amdgcn_s_waitcnt(0);
        unsigned nloc = b.st[0], nx = b.st[1];
        if (nloc == 0u) { xcd_barrier_complete(bar, b.x, nloc, nx); b.st[0] = nloc; b.st[1] = nx; }
        const unsigned old = xb_add(&bar[XB_XSUB(b.x)], 1u);
        const unsigned gen = old / nloc;
        if (old + 1u == (gen + 1u) * nloc) {
            __builtin_amdgcn_fence(__ATOMIC_RELEASE, "agent");
            asm volatile("s_waitcnt vmcnt(0)" ::: "memory");
            const unsigned og = xb_add(&bar[XB_TOP], 1u);
            const unsigned tg = og / nx;
            if (og + 1u == (tg + 1u) * nx) xb_add(&bar[XB_TOPGEN], 1u);
            else XB_SPIN(xb_ld(&bar[XB_TOPGEN]) == tg, bar);
            __builtin_amdgcn_fence(__ATOMIC_ACQUIRE, "agent");
            xb_add(&bar[XB_XGEN(b.x)], 1u);
            asm volatile("s_waitcnt vmcnt(0)" ::: "memory");
        } else {
            XB_SPIN(xb_ld(&bar[XB_XGEN(b.x)]) == gen, bar);
            __builtin_amdgcn_fence(__ATOMIC_ACQUIRE, "agent");
            asm volatile("s_waitcnt vmcnt(0)" ::: "memory");
        }
    }
    __syncthreads();
}

constexpr int NWAVES = 8, NT = NWAVES * 64;
constexpr int RING_BYTES = 131072, LDSCTL_OFF = RING_BYTES, MISC_OFF = LDSCTL_OFF + 320, LDS_BYTES = 147456;
constexpr int CW_BAR = 4096;

struct Args { const float* in[38]; float* out; unsigned char* ws; };
struct Frame {
    LAS unsigned char* lds; volatile LAS unsigned* MISC;
    int wave, vcu, G;
    const float* const* in; float* out; unsigned char* ws;
};
enum { I_XP = 0, I_XS, I_SRET, I_SHG, I_SWKV, I_SSHIFT, I_CP, I_CS, I_MODW, I_MODB, I_NMIXG, I_NMLPG, I_FINALG, I_W1, I_W2, I_ABWIN, I_ABWOUT, I_HGLB, I_HGNG,
       I_MU, I_WRKV, I_RW0, I_RW1, I_RW2, I_RA0, I_RA1, I_RA2, I_RV0, I_RV1, I_RV2, I_RG1, I_RG2, I_RKK, I_RKA, I_RRK, I_RLNG, I_RLNB, I_RWOUT };
constexpr size_t O_Y = 0, O_RETP = 17825792, O_RETS = 17891328, O_HGP = 19988480, O_HGS = 20119552, O_WKVP = 24313856, O_WKVS = 24444928, O_SHP = 28639232, O_SHS = 28641280;

__device__ __forceinline__ void transpose_item(const float* W, int N, bf16_t* WT, int ldt, int row_off, int col_off, const float* mu, int mode, LAS float* scr, int item, int lane) {
    const int nblk = N / 32, kb = item / nblk, nb = item % nblk, k0 = 64 * kb, n0 = 32 * nb;
#pragma unroll 8
    for (int i = 0; i < 32; ++i) { const int kk = 2 * i + (lane >> 5); float s = 1.f; if (mode == 1) s = 1.f - mu[k0 + kk]; else if (mode == 2) s = mu[k0 + kk];
        scr[kk * 33 + (lane & 31)] = W[(size_t)(k0 + kk) * N + n0 + (lane & 31)] * s; }
    LDS_WAIT(); asm volatile("" ::: "memory");
    const int c = lane & 7;
#pragma unroll
    for (int j = 0; j < 4; ++j) { const int n = (lane >> 3) + 8 * j; const LAS float* s = scr + (8 * c) * 33 + n;
        u32x4 o; o.x = pk2(s[0 * 33], s[1 * 33]); o.y = pk2(s[2 * 33], s[3 * 33]); o.z = pk2(s[4 * 33], s[5 * 33]); o.w = pk2(s[6 * 33], s[7 * 33]);
        *(u32x4*)(WT + (size_t)(row_off + n0 + n) * ldt + col_off + k0 + 8 * c) = o; }
    LDS_WAIT(); asm volatile("" ::: "memory");
}
__device__ __forceinline__ void convert_layer_weights(Frame& F, int layer) {
    const int tid = otid(); const int lane = tid & 63; (void)lane;
    LAS float* scr = (LAS float*)(F.lds + F.wave * 16384);
    const int gw = F.vcu * NWAVES + F.wave, NGW = F.G * NWAVES;
    unsigned char* ar = F.ws + WS_ARENA;
    const int m = layer >> 1;
    constexpr int I_1 = (D / 64) * (DFF / 32), I_2 = (DFF / 64) * (D / 32);
    const float* w1 = F.in[I_W1] + (size_t)layer * D * DFF; const float* w2 = F.in[I_W2] + (size_t)layer * DFF * D;
    if ((layer & 1) == 0) {
        constexpr int I_IN = (D / 64) * (ABIN / 32), I_OUT = (D / 64) * (D / 32), NI = I_1 + I_2 + I_IN + I_OUT;
        const float* win = F.in[I_ABWIN] + (size_t)m * D * ABIN; const float* wout = F.in[I_ABWOUT] + (size_t)m * D * D;
        for (int it = gw; it < NI; it += NGW) { int r = it;
            if (r < I_1) { transpose_item(w1, DFF, (bf16_t*)(ar + AR_W1), D, 0, 0, nullptr, 0, scr, r, lane); continue; } r -= I_1;
            if (r < I_2) { transpose_item(w2, D, (bf16_t*)(ar + AR_W2), DFF, 0, 0, nullptr, 0, scr, r, lane); continue; } r -= I_2;
            if (r < I_IN) { transpose_item(win, ABIN, (bf16_t*)(ar + AR_WIN), D, 0, 0, nullptr, 0, scr, r, lane); continue; } r -= I_IN;
            transpose_item(wout, D, (bf16_t*)(ar + AR_WOUT), D, 0, 0, nullptr, 0, scr, r, lane); }
    } else {
        constexpr int I_P = (D / 64) * (D / 32), NI = I_1 + I_2 + 7 * I_P;
        const float* mu = F.in[I_MU] + (size_t)m * 6 * D; const float* wrkv = F.in[I_WRKV] + (size_t)m * 3 * D * D; const float* wo = F.in[I_RWOUT] + (size_t)m * D * D;
        bf16_t* wc1 = (bf16_t*)(ar + AR_WC1);
        for (int it = gw; it < NI; it += NGW) { int r = it;
            if (r < I_1) { transpose_item(w1, DFF, (bf16_t*)(ar + AR_W1), D, 0, 0, nullptr, 0, scr, r, lane); continue; } r -= I_1;
            if (r < I_2) { transpose_item(w2, D, (bf16_t*)(ar + AR_W2), DFF, 0, 0, nullptr, 0, scr, r, lane); continue; } r -= I_2;
            if (r < 6 * I_P) { const int p = r / (2 * I_P), hf = (r / I_P) & 1, mi = (p == 0) ? 0 : (p == 1 ? 2 : 3);
                transpose_item(wrkv + (size_t)p * D * D, D, wc1, 2048, p * D, hf * D, mu + mi * D, 1 + hf, scr, r % I_P, lane); continue; } r -= 6 * I_P;
            transpose_item(wo, D, (bf16_t*)(ar + AR_WO), D, 0, 0, nullptr, 0, scr, r, lane); }
        const int gt = F.vcu * NT + tid, NG = F.G * NT;
        const float* lw1 = F.in[I_RW1] + (size_t)m * D * 64; const float* la1 = F.in[I_RA1] + (size_t)m * D * 64; const float* lv1 = F.in[I_RV1]; const float* lg1 = F.in[I_RG1] + (size_t)m * D * 160;
        for (int idx = gt; idx < 512 * 2048; idx += NG) { const int n = idx >> 11, k = idx & 2047, kk = k & 1023, nn = n & 255;
            const float* src = nullptr; int ns = 0, mi = 0, nc = 0;
            if (n < 256) { if (nn < 64) { src = lw1; ns = 64; mi = 1; nc = nn; } else if (nn < 128) { src = la1; ns = 64; mi = 4; nc = nn - 64; } else if (nn < 160 && m == 1) { src = lv1; ns = 32; mi = 3; nc = nn - 128; } }
            else if (nn < 160) { src = lg1; ns = 160; mi = 5; nc = nn; }
            float v = 0.f; if (src) { const float muv = mu[mi * D + kk]; v = src[(size_t)kk * ns + nc] * (k < 1024 ? 1.f - muv : muv); }
            wc1[(size_t)(3072 + n) * 2048 + k] = (bf16_t)f2bf(v); }
        bf16_t* wc2 = (bf16_t*)(ar + AR_WC2);
        const float* lw2 = F.in[I_RW2] + (size_t)m * 64 * D; const float* la2 = F.in[I_RA2] + (size_t)m * 64 * D; const float* lv2 = F.in[I_RV2]; const float* lg2 = F.in[I_RG2] + (size_t)m * 160 * D;
        for (int idx = gt; idx < 4096 * 256; idx += NG) { const int k = idx >> 12, n = idx & 4095, g = n >> 10, nn = n & 1023;
            const float* src = (g == 0) ? lw2 : (g == 1) ? la2 : (g == 2) ? lv2 : lg2; const int ks = (g == 0 || g == 1) ? 64 : (g == 2 ? 32 : 160);
            float v = 0.f; if (k < ks && !(g == 2 && m == 0)) v = src[(size_t)k * D + nn];
            wc2[(size_t)n * 256 + k] = (bf16_t)f2bf(v); }
    }
}

__device__ __forceinline__ void mod_phase(Frame& F) {
    const int tid = otid(); const int lane = tid & 63;
    const float* __restrict__ SC = (const float*)(F.ws + WS_MOD + 3584 * 1024);
    float* MOD = (float*)(F.ws + WS_MOD);
    LAS float* red = (LAS float*)F.lds;
    for (int task = F.vcu; task < 4 * 96; task += F.G) { const int l = task / 96, n = (task % 96) * 64 + lane, ks = F.wave;
        const float* w = F.in[I_MODW] + ((size_t)l * D + ks * 128) * 6144 + n;
        float acc[NSEQ];
#pragma unroll
        for (int s = 0; s < NSEQ; ++s) acc[s] = 0.f;
        for (int k = 0; k < 128; k += 4) { const float w0 = w[(size_t)k * 6144], w1 = w[(size_t)(k + 1) * 6144], w2 = w[(size_t)(k + 2) * 6144], w3 = w[(size_t)(k + 3) * 6144];
#pragma unroll
            for (int s = 0; s < NSEQ; ++s) { const f32x4 c4 = *(const f32x4*)(SC + s * D + ks * 128 + k); acc[s] += (c4[0] * w0 + c4[1] * w1) + (c4[2] * w2 + c4[3] * w3); } }
        __syncthreads();
#pragma unroll
        for (int s = 0; s < NSEQ; ++s) red[(F.wave * NSEQ + s) * 64 + lane] = acc[s];
        __syncthreads();
        for (int i = tid; i < NSEQ * 64; i += NT) { const int s = i >> 6, c = i & 63; float t = F.in[I_MODB][l * 6144 + (task % 96) * 64 + c];
#pragma unroll
            for (int q = 0; q < 8; ++q) t += red[(q * NSEQ + s) * 64 + c];
            MOD[((size_t)l * NSEQ + s) * 6144 + (task % 96) * 64 + c] = t; }
    }
    __syncthreads();
}

__device__ __forceinline__ void prologue(Frame& F) {
    const int tid = otid(); const int lane = tid & 63; (void)lane;
    const int gt = F.vcu * NT + tid, NG = F.G * NT;
    { f32x2* tab = (f32x2*)(F.ws + WS_ROPE);
      for (int i = gt; i < 16384 * 32; i += NG) { const int p = i >> 5, d = i & 31; double rev = (double)p * ROPE_REV[d]; rev -= floor(rev); const float fr = (float)rev;
          tab[i] = (f32x2){__builtin_amdgcn_cosf(fr), __builtin_amdgcn_sinf(fr)}; } }
    { unsigned* z = (unsigned*)(F.ws + WS_XN0); for (int i = gt; i < 512; i += NG) z[i] = 0u; }
    { float* SC = (float*)(F.ws + WS_MOD + 3584 * 1024);
      for (int i = gt; i < NSEQ * D; i += NG) { const int s = i >> 10, k = i & 1023; const float c = (s == 0) ? F.in[I_CP][k] : F.in[I_CS][(size_t)(s - 1) * D + k]; SC[i] = siluf_(c); } }
    convert_layer_weights(F, 0);
}

template <int MODE> __device__ __forceinline__ void norm_row(Frame& F, int layer, int r, f32x4 (&v)[4], const float* MOD, const float* gvec, int lane) {
    const int m = layer >> 1; const int shoff = (MODE == 2) ? 3072 : 0, scoff = (MODE == 2) ? 4096 : 1024;
    bf16_t* XN = (bf16_t*)(F.ws + WS_XN); bf16_t* PREVS = (bf16_t*)(F.ws + WS_PREVS);
    float* xrow = F.out + (size_t)r * D; float s2 = 0.f;
#pragma unroll
    for (int j = 0; j < 4; ++j) s2 += (v[j].x * v[j].x + v[j].y * v[j].y) + (v[j].z * v[j].z + v[j].w * v[j].w);
    const float rstd = 1.f / sqrtf(wave_sum(s2) * (1.f / D) + NORM_EPS);
    const int seq = seq_of_row(r); const float* mp = MOD + (size_t)seq * 6144;
#pragma unroll
    for (int j = 0; j < 4; ++j) { const int c = 4 * lane + 256 * j; const f32x4 g4 = *(const f32x4*)(gvec + c); f32x4 o = v[j] * rstd * g4;
        if (MODE == 3) { *((f32x4*)xrow + lane + 64 * j) = o; continue; }
        const f32x4 sc = *(const f32x4*)(mp + scoff + c), sh = *(const f32x4*)(mp + shoff + c);
        o = o * (1.f + sc) + sh;
        const unsigned long long pk = (unsigned long long)pk2(o.x, o.y) | ((unsigned long long)pk2(o.z, o.w) << 32);
        *(unsigned long long*)(XN + (size_t)r * D + c) = pk;
        if (MODE == 1) {
            if (r >= MP) { const int t = (r - MP) & 31; if (t < 31) *(unsigned long long*)(PREVS + (size_t)(r - MP + 1) * D + c) = pk;
                else *(f32x4*)(F.out + O_SHS + ((size_t)m * 32 + ((r - MP) >> 5)) * D + c) = o;
                if (t == 0) { const f32x4 ss = *(const f32x4*)(F.in[I_SSHIFT] + ((size_t)m * 32 + ((r - MP) >> 5)) * D + c);
                    *(unsigned long long*)(PREVS + (size_t)(r - MP) * D + c) = (unsigned long long)pk2(ss.x, ss.y) | ((unsigned long long)pk2(ss.z, ss.w) << 32); } }
            else if (r == MP - 1) *(f32x4*)(F.out + O_SHP + (size_t)m * D + c) = o;
        } }
}
template <int MODE, int PEND = 0, bool FIRSTP = false, bool FIRSTS = false> __device__ __forceinline__ void norm_pass(Frame& F, int layer, int player = 0, int pgoff = 0) {
    const int tid = otid(); const int lane = tid & 63;
    const int gw = F.vcu * NWAVES + F.wave, NGW = F.G * NWAVES;
    const float* MOD = (const float*)(F.ws + WS_MOD) + (size_t)layer * NSEQ * 6144;
    const float* gvec = (MODE == 3) ? F.in[I_FINALG] : (MODE == 2 ? F.in[I_NMLPG] + layer * D : F.in[I_NMIXG] + layer * D);
    LAS float* xs = (LAS float*)F.lds;
    if constexpr (PEND > 0) {
        __syncthreads();
        const float* gmod = (const float*)(F.ws + WS_MOD) + (size_t)player * NSEQ * 6144 + pgoff;
#pragma unroll
        for (int q = 0; q < 2; ++q) { const int idx = tid + q * NT, rr = idx >> 8, c4 = (idx & 255) * 4; const int r = MP + 4 * F.vcu + rr; if (4 * F.vcu + rr < MS) {
                const int pn = c4 >> 8; const float* pb = (const float*)(F.ws + WS_PART) + ((size_t)((((r >> 8) - 64) * 4 + pn) * PEND) << 16) + (r & 255) * 256 + (c4 & 255);
                f32x4 acc = (f32x4){0.f, 0.f, 0.f, 0.f};
#pragma unroll
                for (int ks = 0; ks < PEND; ++ks) acc += *(const f32x4*)(pb + ((size_t)ks << 16));
                const f32x4 g4 = *(const f32x4*)(gmod + (size_t)seq_of_row(r) * 6144 + c4); f32x4 x4 = FIRSTS ? *(const f32x4*)(F.in[I_XS] + (size_t)(r - MP) * D + c4) : *(const f32x4*)(F.out + (size_t)r * D + c4);
                x4 = x4 + g4 * acc; *(f32x4*)(F.out + (size_t)r * D + c4) = x4; *(LAS f32x4*)(xs + rr * 1024 + c4) = x4; } }
        __syncthreads();
    }
    for (int r = gw; r < MP; r += NGW) {
        const f32x4* xr = (const f32x4*)((FIRSTP ? F.in[I_XP] : F.out) + (size_t)r * D) + lane; f32x4 v[4];
#pragma unroll
        for (int j = 0; j < 4; ++j) v[j] = xr[64 * j];
        norm_row<MODE>(F, layer, r, v, MOD, gvec, lane);
    }
    if (F.wave < 4 && 4 * F.vcu + F.wave < MS) { const int r = MP + 4 * F.vcu + F.wave; f32x4 v[4];
#pragma unroll
        for (int j = 0; j < 4; ++j) { if constexpr (PEND > 0) v[j] = *(const LAS f32x4*)(xs + F.wave * 1024 + 4 * lane + 256 * j); else v[j] = *((const f32x4*)(FIRSTS ? F.in[I_XS] + (size_t)(r - MP) * D : F.out + (size_t)r * D) + lane + 64 * j); }
        norm_row<MODE>(F, layer, r, v, MOD, gvec, lane); }
}

template <int MT, int NTT> __device__ __forceinline__ void wave_mm_nt(f32x4 (&acc)[MT][NTT], const LAS bf16_t* X, int ldx, const LAS bf16_t* Y, int ldy, int K, int fr, int fq) {
    for (int k0 = 0; k0 < K; k0 += 32) {
        bf16x8 xa[MT], yb[NTT];
#pragma unroll
        for (int i = 0; i < MT; ++i) xa[i] = *(const LAS bf16x8*)(X + (16 * i + fr) * ldx + k0 + 8 * fq);
#pragma unroll
        for (int j = 0; j < NTT; ++j) yb[j] = *(const LAS bf16x8*)(Y + (16 * j + fr) * ldy + k0 + 8 * fq);
#pragma unroll
        for (int i = 0; i < MT; ++i)
#pragma unroll
            for (int j = 0; j < NTT; ++j) acc[i][j] = __builtin_amdgcn_mfma_f32_16x16x32_bf16(yb[j], xa[i], acc[i][j], 0, 0, 0);
    }
}

constexpr int LQS = 0, LKS = 18432, LQG = 36864, LVT = 55296, LST = 73728, LPS = 108544, LRED = 117760, LBS = 118784;
__device__ __forceinline__ void chunk_geom(int c, int& r0, int& pos0) { if (c < 256) { r0 = 64 * c; pos0 = 64 * c; } else { r0 = MP + 32 * (c - 256); pos0 = 2048; } }

template <int L, bool HG, bool SUMMARY> __device__ __forceinline__ void ab_load(Frame& F, int layer, int c, int h) {
    const int tid = otid(); const int lane = tid & 63; (void)lane;
    const int m = layer >> 1; int r0, pos0; chunk_geom(c, r0, pos0);
    const bf16_t* Z = (const bf16_t*)(F.ws + WS_Z);
    LAS bf16_t* QS = (LAS bf16_t*)(F.lds + LQS); LAS bf16_t* KS = (LAS bf16_t*)(F.lds + LKS); LAS bf16_t* QG = (LAS bf16_t*)(F.lds + LQG); LAS bf16_t* VT = (LAS bf16_t*)(F.lds + LVT);
    constexpr int LDT = L + 8;
    if constexpr (HG) {
        constexpr int TQ = L / 4; LAS float* BS = (LAS float*)(F.lds + LBS);
        const int ch = tid & 127, qtr = tid >> 7;
        float lb = 0.f;
        if (m == 1) { const float a0 = F.in[I_HGLB][h * 128 + ch], a1 = F.in[I_HGLB][512 + h * 128 + ch]; lb = 1.f / (1.f + __expf(a0 - a1)); }
        { constexpr int NP = L * 16;
#pragma unroll
          for (int q = 0; q < (NP + NT - 1) / NT; ++q) { const int v = tid + q * NT; if (NP % NT == 0 || v < NP) { const int j = v >> 4, c8 = v & 15; const size_t zr = (size_t)(r0 + j) * ABIN + h * 128 + c8 * 8;
                  const u32x4 zf4 = *(const u32x4*)(Z + zr + 2048), v4 = *(const u32x4*)(Z + zr + 2560);
                  *(LAS u32x4*)(QG + j * 136 + c8 * 8) = zf4; *(LAS u32x4*)(KS + j * 136 + c8 * 8) = v4;
                  if constexpr (!SUMMARY) { const u32x4 q4 = *(const u32x4*)(Z + zr + 1536); *(LAS u32x4*)(QS + j * 136 + c8 * 8) = q4; } } } }
        __syncthreads();
        float zf[TQ], cs[TQ]; float run = 0.f;
#pragma unroll
        for (int jj = 0; jj < TQ; ++jj) { const int j = qtr * TQ + jj; zf[jj] = bf2f(QG[j * 136 + ch]);
            float lf; if (lb == 0.f) lf = fminf(zf[jj], 0.f) - __logf(1.f + __expf(-fabsf(zf[jj]))); else lf = __logf(lb + (1.f - lb) * sigmoidf_(zf[jj]));
            run += lf; cs[jj] = run; }
        BS[qtr * 128 + ch] = run;
        __syncthreads();
        const float b0 = BS[ch], b1 = BS[128 + ch], b2 = BS[256 + ch], b3 = BS[384 + ch];
        const float off = (qtr > 0 ? b0 : 0.f) + (qtr > 1 ? b1 : 0.f) + (qtr > 2 ? b2 : 0.f), bL = (b0 + b1) + (b2 + b3), bmid = b0 + b1;
        if constexpr (SUMMARY) {
#pragma unroll
            for (int jj = 0; jj < TQ; ++jj) { const int j = qtr * TQ + jj; const float b = off + cs[jj]; const float kb = (1.f - lb) * sigmoidf_(-zf[jj]);
                VT[ch * LDT + j] = KS[j * 136 + ch]; QS[ch * LDT + j] = (bf16_t)f2bf(kb * __expf(bL - b)); }
            if (qtr == 0) ((float*)(F.ws + WS_DEC))[((size_t)c * 4 + h) * 128 + ch] = __expf(bL);
        } else {
#pragma unroll
            for (int jj = 0; jj < TQ; ++jj) { const int j = qtr * TQ + jj; const float b = off + cs[jj]; const float kb = (1.f - lb) * sigmoidf_(-zf[jj]);
                const float q = siluf_(bf2f(QS[j * 136 + ch]));
                VT[ch * LDT + j] = KS[j * 136 + ch];
                QS[j * 136 + ch] = (bf16_t)f2bf(q * __expf(b - bmid)); KS[j * 136 + ch] = (bf16_t)f2bf(kb * __expf(bmid - b)); QG[j * 136 + ch] = (bf16_t)f2bf(q * __expf(b)); }
        }
    } else {
        const float logg = log1pf(-exp2f(-5.f - (float)h));
        const f32x2* rope = (const f32x2*)(F.ws + WS_ROPE);
        for (int it = tid; it < L * 4; it += NT) { const int j = it >> 2, d8 = it & 3; const size_t zr = (size_t)(r0 + j) * ABIN;
            const f32x2* rp = rope + (size_t)(pos0 + j) * 32 + d8 * 8;
            const u32x4 k1 = *(const u32x4*)(Z + zr + 256 + h * 64 + d8 * 8), k2 = *(const u32x4*)(Z + zr + 256 + h * 64 + 32 + d8 * 8);
            const float gk = __expf((float)(L - 1 - j) * logg), gq = __expf((float)(j + 1) * logg);
            u32x4 q1 = (u32x4){0, 0, 0, 0}, q2 = q1; if constexpr (!SUMMARY) { q1 = *(const u32x4*)(Z + zr + h * 64 + d8 * 8); q2 = *(const u32x4*)(Z + zr + h * 64 + 32 + d8 * 8); }
#pragma unroll
            for (int e = 0; e < 8; ++e) { const f32x2 cs_ = rp[e]; const unsigned wk1 = k1[e >> 1], wk2 = k2[e >> 1]; const float x1 = (e & 1) ? bfhi(wk1) : bflo(wk1), x2 = (e & 1) ? bfhi(wk2) : bflo(wk2);
                const float o1 = x1 * cs_.x - x2 * cs_.y, o2 = x1 * cs_.y + x2 * cs_.x; const int d = d8 * 8 + e;
                if constexpr (SUMMARY) { QS[d * LDT + j] = (bf16_t)f2bf(o1 * gk); QS[(d + 32) * LDT + j] = (bf16_t)f2bf(o2 * gk); }
                else { KS[j * 72 + d] = (bf16_t)f2bf(o1); KS[j * 72 + d + 32] = (bf16_t)f2bf(o2);
                    const unsigned wq1 = q1[e >> 1], wq2 = q2[e >> 1]; const float y1 = (e & 1) ? bfhi(wq1) : bflo(wq1), y2 = (e & 1) ? bfhi(wq2) : bflo(wq2);
                    const float p1 = (y1 * cs_.x - y2 * cs_.y) * 0.125f, p2 = (y1 * cs_.y + y2 * cs_.x) * 0.125f;
                    QS[j * 72 + d] = (bf16_t)f2bf(p1); QS[j * 72 + d + 32] = (bf16_t)f2bf(p2); QG[j * 72 + d] = (bf16_t)f2bf(p1 * gq); QG[j * 72 + d + 32] = (bf16_t)f2bf(p2 * gq); } } }
        for (int it = tid; it < L * 16; it += NT) { const int j = it >> 4, e8 = it & 15; const u32x4 vv = *(const u32x4*)(Z + (size_t)(r0 + j) * ABIN + 512 + h * 128 + e8 * 8);
#pragma unroll
            for (int e = 0; e < 8; ++e) { const unsigned w = vv[e >> 1]; VT[(e8 * 8 + e) * LDT + j] = (bf16_t)((e & 1) ? (w >> 16) : (w & 0xffffu)); } }
    }
}

template <int L, bool HG> __device__ __forceinline__ void ab_summary_unit(Frame& F, int layer, int c, int h) {
    const int tid = otid(); const int lane = tid & 63; (void)lane;
    constexpr int DK = HG ? 128 : 64, NCT = DK / 16, LDT = L + 8;
    __syncthreads();
    ab_load<L, HG, true>(F, layer, c, h);
    __syncthreads();
    const int fr = lane & 15, fq = lane >> 4;
    const LAS bf16_t* KDT = (const LAS bf16_t*)(F.lds + LQS); const LAS bf16_t* VT = (const LAS bf16_t*)(F.lds + LVT);
    f32x4 acc[1][NCT];
#pragma unroll
    for (int j = 0; j < NCT; ++j) acc[0][j] = (f32x4){0.f, 0.f, 0.f, 0.f};
    wave_mm_nt<1, NCT>(acc, VT + F.wave * 16 * LDT, LDT, KDT, LDT, L, fr, fq);
    bf16_t* ST = (bf16_t*)(F.ws + WS_STATE) + (size_t)c * SLOT_E + (HG ? 32768 + h * 16384 : h * 8192);
    const int e = F.wave * 16 + fr;
#pragma unroll
    for (int j = 0; j < NCT; ++j) { u32x2 w; w.x = pk2(acc[0][j][0], acc[0][j][1]); w.y = pk2(acc[0][j][2], acc[0][j][3]); *(u32x2*)(ST + (size_t)e * DK + 16 * j + 4 * fq) = w; }
}

template <int L, bool HG> __device__ __forceinline__ void ab_output_unit(Frame& F, int layer, int c, int h) {
    const int tid = otid(); const int lane = tid & 63; (void)lane;
    constexpr int DK = HG ? 128 : 64, LDQ = HG ? 136 : 72, LDT = L + 8, NIT = L / 16, WPI = 8 / NIT, ET = 8 / WPI, TPW = (NIT * NIT >= 8) ? NIT * NIT / 8 : 1;
    const int m = layer >> 1; int r0, pos0; chunk_geom(c, r0, pos0);
    __syncthreads();
    ab_load<L, HG, false>(F, layer, c, h);
    LAS bf16_t* QS = (LAS bf16_t*)(F.lds + LQS); LAS bf16_t* KS = (LAS bf16_t*)(F.lds + LKS); LAS bf16_t* QG = (LAS bf16_t*)(F.lds + LQG); LAS bf16_t* VT = (LAS bf16_t*)(F.lds + LVT);
    LAS bf16_t* STl = (LAS bf16_t*)(F.lds + LST); LAS bf16_t* PS = (LAS bf16_t*)(F.lds + LPS); LAS float* RED = (LAS float*)(F.lds + LRED);
    { const bf16_t* ST = (const bf16_t*)(F.ws + WS_STATE) + (size_t)c * SLOT_E + (HG ? 32768 + h * 16384 : h * 8192);
      for (int it = tid; it < 128 * DK / 8; it += NT) { const int e = it / (DK / 8), c8 = it % (DK / 8); *(LAS u32x4*)(STl + e * LDQ + c8 * 8) = *(const u32x4*)(ST + (size_t)e * DK + c8 * 8); } }
    __syncthreads();
    const int fr = lane & 15, fq = lane >> 4, w = F.wave;
    const float logg = HG ? 0.f : log1pf(-exp2f(-5.f - (float)h));
    if (w * TPW < NIT * NIT) {
        const int it = (w * TPW) / NIT, jt0 = (w * TPW) % NIT;
        f32x4 sc[1][TPW];
#pragma unroll
        for (int q = 0; q < TPW; ++q) sc[0][q] = (f32x4){0.f, 0.f, 0.f, 0.f};
        wave_mm_nt<1, TPW>(sc, QS + it * 16 * LDQ, LDQ, KS + jt0 * 16 * LDQ, LDQ, DK, fr, fq);
        const int i = it * 16 + fr;
#pragma unroll
        for (int q = 0; q < TPW; ++q) { float p[4];
#pragma unroll
            for (int r = 0; r < 4; ++r) { const int j = (jt0 + q) * 16 + 4 * fq + r; float v = sc[0][q][r]; if (!HG) v *= __expf((float)(i - j) * logg); p[r] = (j <= i) ? v : 0.f; }
            u32x2 pw; pw.x = pk2(p[0], p[1]); pw.y = pk2(p[2], p[3]); *(LAS u32x2*)(PS + i * LDT + (jt0 + q) * 16 + 4 * fq) = pw; }
    }
    __syncthreads();
    const int it = w % NIT, eg = w / NIT;
    f32x4 o[1][ET];
#pragma unroll
    for (int q = 0; q < ET; ++q) o[0][q] = (f32x4){0.f, 0.f, 0.f, 0.f};
    wave_mm_nt<1, ET>(o, PS + it * 16 * LDT, LDT, VT + eg * ET * 16 * LDT, LDT, L, fr, fq);
    wave_mm_nt<1, ET>(o, QG + it * 16 * LDQ, LDQ, STl + eg * ET * 16 * LDQ, LDQ, DK, fr, fq);
    float ss = 0.f;
#pragma unroll
    for (int q = 0; q < ET; ++q) ss += (o[0][q][0] * o[0][q][0] + o[0][q][1] * o[0][q][1]) + (o[0][q][2] * o[0][q][2] + o[0][q][3] * o[0][q][3]);
    ss += __shfl_xor(ss, 16); ss += __shfl_xor(ss, 32);
    const int i = it * 16 + fr;
    if (fq == 0) RED[i * 4 + eg] = ss;
    __syncthreads();
    float tot = 0.f;
#pragma unroll
    for (int q = 0; q < WPI; ++q) tot += RED[i * 4 + q];
    const float rstd = 1.f / sqrtf(tot * (1.f / 128.f) + NORM_EPS);
    const bf16_t* Z = (const bf16_t*)(F.ws + WS_Z); bf16_t* O = (bf16_t*)(F.ws + WS_XN);
    const size_t row = (size_t)(r0 + i);
#pragma unroll
    for (int q = 0; q < ET; ++q) { const int e = (eg * ET + q) * 16 + 4 * fq; const u32x2 gw = *(const u32x2*)(Z + row * ABIN + (HG ? 3072 : 1024) + h * 128 + e);
        const float g4[4] = {bflo(gw.x), bfhi(gw.x), bflo(gw.y), bfhi(gw.y)}; float ov[4];
#pragma unroll
        for (int r = 0; r < 4; ++r) { if (HG) ov[r] = o[0][q][r] * rstd * F.in[I_HGNG][m * 128 + e + r] * sigmoidf_(g4[r]); else ov[r] = o[0][q][r] * rstd * siluf_(g4[r]); }
        u32x2 ow; ow.x = pk2(ov[0], ov[1]); ow.y = pk2(ov[2], ov[3]); *(u32x2*)(O + row * D + (HG ? 512 : 0) + h * 128 + e) = ow; }
}

template <bool DRY = false> __device__ __forceinline__ void ab_scan(Frame& F, int layer) {
    const int tid = otid(); const int lane = tid & 63; (void)lane;
    const int m = layer >> 1;
    unsigned* ST32 = (unsigned*)(F.ws + WS_STATE); const float* DEC = (const float*)(F.ws + WS_DEC);
    constexpr int NP = SLOT_E / 2;
    const int gt = F.vcu * NT + tid;
    if (gt < NP) {
        const int eo = 2 * gt; const bool hg = eo >= 32768; const int eo2 = hg ? eo - 32768 : eo; const int head = hg ? eo2 >> 14 : eo2 >> 13; const int cch = hg ? (eo2 & 127) : (eo2 & 63); const int e = hg ? ((eo2 & 16383) >> 7) : ((eo2 & 8191) >> 6);
        const float gdec = hg ? 0.f : __expf(64.f * log1pf(-exp2f(-5.f - (float)head)));
        float s0 = 0.f, s1 = 0.f;
        for (int c0 = 0; c0 < 256; c0 += 8) {
            unsigned kv[8]; float d0[8], d1[8];
#pragma unroll
            for (int u = 0; u < 8; ++u) { kv[u] = ST32[(size_t)(c0 + u) * NP + gt]; if (hg) { const f32x2 dd = *(const f32x2*)(DEC + ((size_t)(c0 + u) * 4 + head) * 128 + cch); d0[u] = dd.x; d1[u] = dd.y; } else { d0[u] = gdec; d1[u] = gdec; } }
#pragma unroll
            for (int u = 0; u < 8; ++u) { const unsigned pw = pk2(s0, s1); if constexpr (DRY) asm volatile("" :: "v"(pw)); else ST32[(size_t)(c0 + u) * NP + gt] = pw; s0 = d0[u] * s0 + bflo(kv[u]); s1 = d1[u] * s1 + bfhi(kv[u]); }
        }
        float* outp = hg ? F.out + O_HGP + (size_t)m * 65536 + head * 16384 : F.out + O_RETP + (size_t)m * 32768 + head * 8192;
        outp[(size_t)cch * 128 + e] = s0; outp[(size_t)(cch + 1) * 128 + e] = s1;
    } else {
        const int NG2 = F.G * NT - NP; if (NG2 <= 0) return;
        for (int idx = gt - NP; idx < 32 * NP; idx += NG2) { const int b = idx / NP, pr = idx % NP;
            const int eo = 2 * pr; const bool hg = eo >= 32768; const int eo2 = hg ? eo - 32768 : eo; const int head = hg ? eo2 >> 14 : eo2 >> 13; const int cch = hg ? (eo2 & 127) : (eo2 & 63); const int e = hg ? ((eo2 & 16383) >> 7) : ((eo2 & 8191) >> 6);
            float d0, d1; if (hg) { const f32x2 dd = *(const f32x2*)(DEC + ((size_t)(256 + b) * 4 + head) * 128 + cch); d0 = dd.x; d1 = dd.y; } else { d0 = d1 = __expf(32.f * log1pf(-exp2f(-5.f - (float)head))); }
            const size_t so = hg ? ((size_t)(m * 32 + b) * 4 + head) * 16384 : ((size_t)(m * 32 + b) * 4 + head) * 8192;
            const float* sin_ = (hg ? F.in[I_SHG] : F.in[I_SRET]) + so; float* sout = F.out + (hg ? O_HGS : O_RETS) + so;
            const float i0 = sin_[(size_t)cch * 128 + e], i1 = sin_[(size_t)(cch + 1) * 128 + e];
            const unsigned kv = ST32[(size_t)(256 + b) * NP + pr]; if constexpr (!DRY) ST32[(size_t)(256 + b) * NP + pr] = pk2(i0, i1);
            sout[(size_t)cch * 128 + e] = d0 * i0 + bflo(kv); sout[(size_t)(cch + 1) * 128 + e] = d1 * i1 + bfhi(kv); }
    }
}

constexpr int RL_AT = 0, RL_RT = 9216, RL_BT = 18432, RL_KT = 27648, RL_BHT = 36864, RL_KHT = 46080, RL_VT = 55296, RL_AAB = 64512, RL_AAK = 81920, RL_ARB = 91136, RL_ARK = 100352,
              RL_U0T = 109568, RL_VEC = 118784, RL_PSUM = 119808;
constexpr int RL_G = RL_AAB, RL_WW = RL_BT, RL_APT = RL_AAK;
constexpr int RL_PL = RL_AT, RL_RL = RL_BT, RL_Y0L = RL_BT + 4608, RL_QTL = RL_AAB, RL_S = RL_BHT;
__device__ __forceinline__ int pperm(int k) { return 32 * (k >> 5) + 8 * ((k >> 2) & 3) + 4 * ((k >> 4) & 1) + (k & 3); }

template <bool DRY = false> __device__ __forceinline__ void rwkv_out_epilogue(Frame& F, int m, const f32x4 (&y)[4], size_t row, int h, int fq) {
    bf16_t* RKV = (bf16_t*)(F.ws + WS_RKV); const bf16_t* GG = (const bf16_t*)(F.ws + WS_G); const float* BON = (const float*)(F.ws + WS_BON);
    float s1 = 0.f;
#pragma unroll
    for (int nt = 0; nt < 4; ++nt) s1 += (y[nt][0] + y[nt][1]) + (y[nt][2] + y[nt][3]);
    s1 += __shfl_xor(s1, 16); s1 += __shfl_xor(s1, 32);
    const float mean = s1 * (1.f / 64.f); float s2 = 0.f;
#pragma unroll
    for (int nt = 0; nt < 4; ++nt)
#pragma unroll
        for (int r = 0; r < 4; ++r) { const float d = y[nt][r] - mean; s2 += d * d; }
    s2 += __shfl_xor(s2, 16); s2 += __shfl_xor(s2, 32);
    const float rstd = 1.f / sqrtf(s2 * (1.f / 64.f) + RW_LN_EPS), bon = BON[row * 16 + h];
#pragma unroll
    for (int nt = 0; nt < 4; ++nt) { const int i = h * 64 + 16 * nt + 4 * fq;
        const f32x4 lg = *(const f32x4*)(F.in[I_RLNG] + m * D + i), lb = *(const f32x4*)(F.in[I_RLNB] + m * D + i);
        const u32x2 vv = *(const u32x2*)(RKV + row * 3072 + 2048 + i), gg = *(const u32x2*)(GG + row * D + i);
        const float v4[4] = {bflo(vv.x), bfhi(vv.x), bflo(vv.y), bfhi(vv.y)}, g4[4] = {bflo(gg.x), bfhi(gg.x), bflo(gg.y), bfhi(gg.y)}; float o[4];
#pragma unroll
        for (int r = 0; r < 4; ++r) o[r] = ((y[nt][r] - mean) * rstd * lg[r] + lb[r] + bon * v4[r]) * g4[r];
        u32x2 w; w.x = pk2(o[0], o[1]); w.y = pk2(o[2], o[3]); if constexpr (DRY) asm volatile("" :: "v"(w.x), "v"(w.y)); else *(u32x2*)(RKV + row * 3072 + i) = w; }
}

template <int S, int L> struct SubstQ {
    static constexpr int RQ = L / 4, NV4 = RQ / 4;
    static __device__ __forceinline__ void run(float (&x)[RQ], f32x4 (&aq)[3][NV4], const LAS float* ap) {
        if constexpr (S < L - 1) {
            if constexpr (S + 2 < L - 1) {
#pragma unroll
                for (int k = 0; k < NV4; ++k) aq[(S + 2) % 3][k] = *(const LAS f32x4*)(ap + (S + 2) * 68 + 4 * k);
            }
            constexpr int own = S / RQ, ctrl = own * 0x55;
            const float xs = __builtin_bit_cast(float, __builtin_amdgcn_update_dpp(0, __builtin_bit_cast(int, x[S % RQ]), ctrl, 0xf, 0xf, false));
#pragma unroll
            for (int k = 0; k < NV4; ++k) { x[4 * k] += aq[S % 3][k][0] * xs; x[4 * k + 1] += aq[S % 3][k][1] * xs; x[4 * k + 2] += aq[S % 3][k][2] * xs; x[4 * k + 3] += aq[S % 3][k][3] * xs;
                asm volatile("" : "+v"(x[4 * k]), "+v"(x[4 * k + 1]), "+v"(x[4 * k + 2]), "+v"(x[4 * k + 3])); }
            asm volatile("" ::: "memory");
            SubstQ<S + 1, L>::run(x, aq, ap);
        }
    }
};
struct RawRegs { u32x4 r, k, v, w, a; };
__device__ __forceinline__ void rwkv_load_raw(Frame& F, int u, int tid, RawRegs& raw) {
    const int c = u >> 4, h = u & 15; int r0, pos0; chunk_geom(c, r0, pos0); const int L = c < 256 ? 64 : 32; int t = tid >> 3; t = t < L ? t : 0;
    const bf16_t* RKV = (const bf16_t*)(F.ws + WS_RKV); const bf16_t* WLOG = (const bf16_t*)(F.ws + WS_WLOG); const bf16_t* AA = (const bf16_t*)(F.ws + WS_XN);
    const size_t row = (size_t)(r0 + t); const int col = h * 64 + 8 * (tid & 7);
    raw.r = *(const u32x4*)(RKV + row * 3072 + col); raw.k = *(const u32x4*)(RKV + row * 3072 + 1024 + col); raw.v = *(const u32x4*)(RKV + row * 3072 + 2048 + col);
    raw.w = *(const u32x4*)(WLOG + row * D + col); raw.a = *(const u32x4*)(AA + row * D + col);
}
template <int L, bool DRY = false> __device__ __forceinline__ void rwkv_local_unit(Frame& F, int layer, int c, int h, RawRegs& raw, int unext) {
    const int tid = otid(); const int lane = tid & 63, fr = lane & 15, fq = lane >> 4, w = F.wave;
    constexpr int NIT = L / 16; constexpr bool SAMPLE = (L == 32);
    const int m = layer >> 1; int r0, pos0; chunk_geom(c, r0, pos0);
    bf16_t* RKV = (bf16_t*)(F.ws + WS_RKV); const bf16_t* WLOG = (const bf16_t*)(F.ws + WS_WLOG); const bf16_t* AA = (const bf16_t*)(F.ws + WS_XN);
    LAS bf16_t* AT = (LAS bf16_t*)(F.lds + RL_AT); LAS bf16_t* RT = (LAS bf16_t*)(F.lds + RL_RT); LAS bf16_t* BT = (LAS bf16_t*)(F.lds + RL_BT); LAS bf16_t* KT = (LAS bf16_t*)(F.lds + RL_KT);
    LAS bf16_t* BHT = (LAS bf16_t*)(F.lds + RL_BHT); LAS bf16_t* KHT = (LAS bf16_t*)(F.lds + RL_KHT); LAS bf16_t* VT = (LAS bf16_t*)(F.lds + RL_VT);
    LAS float* AAB = (LAS float*)(F.lds + RL_AAB); LAS bf16_t* AAK = (LAS bf16_t*)(F.lds + RL_AAK); LAS bf16_t* ARB = (LAS bf16_t*)(F.lds + RL_ARB); LAS bf16_t* ARK = (LAS bf16_t*)(F.lds + RL_ARK);
    LAS bf16_t* U0T = (LAS bf16_t*)(F.lds + RL_U0T); LAS float* GMID = (LAS float*)(F.lds + RL_VEC); LAS float* GLV = GMID + 64; LAS float* EGM = GMID + 128; LAS float* PSUM = (LAS float*)(F.lds + RL_PSUM);
    LAS float* G = (LAS float*)(F.lds + RL_G); LAS float* WW = (LAS float*)(F.lds + RL_WW); LAS bf16_t* APT = (LAS bf16_t*)(F.lds + RL_APT);
    __syncthreads();
    const int t = tid >> 3, c8 = tid & 7; const bool act = t < L;
    float rr[8], kkv[8], bb[8], kh[8], vv[8];
    if (act) { const size_t row = (size_t)(r0 + t); const int col = h * 64 + 8 * c8;
        const u32x4 r4 = raw.r, k4 = raw.k, v4 = raw.v, w4 = raw.w, a4 = raw.a;
        const float* kkp = F.in[I_RKK] + m * D + col; const float* kap = F.in[I_RKA] + m * D + col; const float* rkp = F.in[I_RRK] + m * D + col;
        float ss = 0.f, bon = 0.f;
#pragma unroll
        for (int e = 0; e < 8; ++e) { const float kx = (e & 1) ? bfhi(k4[e >> 1]) : bflo(k4[e >> 1]), al = (e & 1) ? bfhi(a4[e >> 1]) : bflo(a4[e >> 1]);
            rr[e] = (e & 1) ? bfhi(r4[e >> 1]) : bflo(r4[e >> 1]); vv[e] = (e & 1) ? bfhi(v4[e >> 1]) : bflo(v4[e >> 1]);
            kkv[e] = kx * kkp[e]; ss += kkv[e] * kkv[e]; kh[e] = kx * (1.f + (al - 1.f) * kap[e]); bb[e] = al; bon += rr[e] * kh[e] * rkp[e];
            G[t * 64 + 8 * c8 + e] = (e & 1) ? bfhi(w4[e >> 1]) : bflo(w4[e >> 1]); }
        ss += __shfl_xor(ss, 1); ss += __shfl_xor(ss, 2); ss += __shfl_xor(ss, 4); bon += __shfl_xor(bon, 1); bon += __shfl_xor(bon, 2); bon += __shfl_xor(bon, 4);
        const float inv = 1.f / fmaxf(sqrtf(ss), 1e-12f);
#pragma unroll
        for (int e = 0; e < 8; ++e) { kkv[e] *= inv; bb[e] *= kkv[e]; }
        if (c8 == 0) ((float*)(F.ws + WS_BON))[row * 16 + h] = bon; }
    if (unext >= 0) rwkv_load_raw(F, unext, tid, raw);
    __syncthreads();
    { constexpr int TE = L / 8; const int j = tid & 63, e8 = tid >> 6; float cs[TE]; float run = 0.f;
#pragma unroll
      for (int q = 0; q < TE; ++q) { run += G[(e8 * TE + q) * 64 + j]; cs[q] = run; }
      PSUM[e8 * 64 + j] = run;
      __syncthreads();
      float off = 0.f, gm = 0.f, gl = 0.f;
#pragma unroll
      for (int q = 0; q < 8; ++q) { const float p = PSUM[q * 64 + j]; if (q < e8) off += p; if (q < 4) gm += p; gl += p; }
#pragma unroll
      for (int q = 0; q < TE; ++q) G[(e8 * TE + q) * 64 + j] = off + cs[q];
      if (e8 == 0) { GMID[j] = gm; GLV[j] = gl; EGM[j] = __expf(gm); if (!SAMPLE) ((float*)(F.ws + WS_REC + ((size_t)h * 256 + c) * REC_B + 16384))[j] = __expf(gl); } }
    __syncthreads();
    if (act) { float fa[8], fr_[8], fb[8], fk[8];
#pragma unroll
        for (int e = 0; e < 8; ++e) { const int j = 8 * c8 + e; const float g = G[t * 64 + j], gp = (t > 0) ? G[(t - 1) * 64 + j] : 0.f, gm = GMID[j], gl = GLV[j];
            const float ed = __expf(gm - g), eu = __expf(g - gm), el = __expf(gl - g);
            fa[e] = -kkv[e] * __expf(gp - gm); fr_[e] = rr[e] * eu; fb[e] = bb[e] * ed; fk[e] = kh[e] * ed;
            if constexpr (!(DRY && (LOCAL_SKIP & 4))) { BHT[j * 72 + t] = (bf16_t)f2bf(bb[e] * el); KHT[j * 72 + t] = (bf16_t)f2bf(kh[e] * el); VT[j * 72 + t] = (bf16_t)f2bf(vv[e]); } }
        u32x4 p;
        p.x = pk2(fa[0], fa[1]); p.y = pk2(fa[2], fa[3]); p.z = pk2(fa[4], fa[5]); p.w = pk2(fa[6], fa[7]); *(LAS u32x4*)(AT + t * 72 + 8 * c8) = p;
        p.x = pk2(fr_[0], fr_[1]); p.y = pk2(fr_[2], fr_[3]); p.z = pk2(fr_[4], fr_[5]); p.w = pk2(fr_[6], fr_[7]); *(LAS u32x4*)(RT + t * 72 + 8 * c8) = p;
        p.x = pk2(fb[0], fb[1]); p.y = pk2(fb[2], fb[3]); p.z = pk2(fb[4], fb[5]); p.w = pk2(fb[6], fb[7]); *(LAS u32x4*)(BT + t * 72 + 8 * c8) = p;
        p.x = pk2(fk[0], fk[1]); p.y = pk2(fk[2], fk[3]); p.z = pk2(fk[4], fk[5]); p.w = pk2(fk[6], fk[7]); *(LAS u32x4*)(KT + t * 72 + 8 * c8) = p; }
    __syncthreads();
    if constexpr (DRY && (LOCAL_SKIP & 2)) return;
    { constexpr int TPW = (NIT * NIT >= 8) ? NIT * NIT / 8 : 1;
      if (w * TPW < NIT * NIT) { const int it = (w * TPW) / NIT, jt0 = (w * TPW) % NIT;
          f32x4 ab[1][TPW], ak[1][TPW], rb[1][TPW], rk[1][TPW];
#pragma unroll
          for (int q = 0; q < TPW; ++q) { ab[0][q] = (f32x4){0.f, 0.f, 0.f, 0.f}; ak[0][q] = ab[0][q]; rb[0][q] = ab[0][q]; rk[0][q] = ab[0][q]; }
          wave_mm_nt<1, TPW>(ab, AT + it * 16 * 72, 72, BT + jt0 * 16 * 72, 72, 64, fr, fq); wave_mm_nt<1, TPW>(ak, AT + it * 16 * 72, 72, KT + jt0 * 16 * 72, 72, 64, fr, fq);
          wave_mm_nt<1, TPW>(rb, RT + it * 16 * 72, 72, BT + jt0 * 16 * 72, 72, 64, fr, fq); wave_mm_nt<1, TPW>(rk, RT + it * 16 * 72, 72, KT + jt0 * 16 * 72, 72, 64, fr, fq);
          const int tt = it * 16 + fr;
#pragma unroll
          for (int q = 0; q < TPW; ++q) { const int s0 = (jt0 + q) * 16 + 4 * fq; f32x4 fab; float fak[4], frb[4], frk[4];
#pragma unroll
              for (int r = 0; r < 4; ++r) { const int sx = s0 + r; fab[r] = (sx < tt) ? ab[0][q][r] : 0.f; fak[r] = (sx < tt) ? ak[0][q][r] : 0.f; frb[r] = (sx <= tt) ? rb[0][q][r] : 0.f; frk[r] = (sx <= tt) ? rk[0][q][r] : 0.f; }
#pragma unroll
              for (int r = 0; r < 4; ++r) AAB[(s0 + r) * 68 + tt] = fab[r];
              u32x2 p; p.x = pk2(fak[0], fak[1]); p.y = pk2(fak[2], fak[3]); *(LAS u32x2*)(AAK + tt * 72 + s0) = p;
              p.x = pk2(frb[0], frb[1]); p.y = pk2(frb[2], frb[3]); *(LAS u32x2*)(ARB + tt * 72 + s0) = p;
              p.x = pk2(frk[0], frk[1]); p.y = pk2(frk[2], frk[3]); *(LAS u32x2*)(ARK + tt * 72 + s0) = p; } } }
    __syncthreads();
    { constexpr int TP3 = NIT / 2; const int it = (w * TP3) / 4, nt0 = (w * TP3) % 4;
      f32x4 ww[1][TP3];
#pragma unroll
      for (int q = 0; q < TP3; ++q) ww[0][q] = (f32x4){0.f, 0.f, 0.f, 0.f};
      wave_mm_nt<1, TP3>(ww, AAK + it * 16 * 72, 72, VT + nt0 * 16 * 72, 72, L, fr, fq);
#pragma unroll
      for (int q = 0; q < TP3; ++q) *(LAS f32x4*)(WW + (it * 16 + fr) * 68 + (nt0 + q) * 16 + 4 * fq) = ww[0][q]; }
    __syncthreads();
    { constexpr int RQ = L / 4, NV4 = RQ / 4; const int col = tid >> 2, qd = tid & 3, cidx = col & 63; const bool isA = col < 64; const float eg = EGM[cidx];
      float x[RQ]; f32x4 aq[3][NV4];
#pragma unroll
      for (int i = 0; i < RQ; ++i) { const int tt = qd * RQ + i; x[i] = isA ? bf2f(AT[tt * 72 + cidx]) * eg : WW[tt * 68 + cidx]; }
      const LAS float* ap = AAB + qd * RQ;
#pragma unroll
      for (int k = 0; k < NV4; ++k) { aq[0][k] = *(const LAS f32x4*)(ap + 4 * k); aq[1][k] = *(const LAS f32x4*)(ap + 68 + 4 * k); }
      if constexpr (!(DRY && (LOCAL_SKIP & 1))) SubstQ<0, L>::run(x, aq, ap);
      LAS bf16_t* dst = (isA ? APT : U0T) + cidx * 72 + qd * RQ;
#pragma unroll
      for (int t8 = 0; t8 < RQ; t8 += 8) { u32x4 p; p.x = pk2(x[t8], x[t8 + 1]); p.y = pk2(x[t8 + 2], x[t8 + 3]); p.z = pk2(x[t8 + 4], x[t8 + 5]); p.w = pk2(x[t8 + 6], x[t8 + 7]); *(LAS u32x4*)(dst + t8) = p; } }
    __syncthreads();
    { const int mt = w >> 1, nt0 = (w & 1) * 2;
      f32x4 pp[1][2], qt[1][2];
#pragma unroll
      for (int q = 0; q < 2; ++q) { pp[0][q] = (f32x4){0.f, 0.f, 0.f, 0.f}; qt[0][q] = pp[0][q]; }
      wave_mm_nt<1, 2>(pp, BHT + mt * 16 * 72, 72, APT + nt0 * 16 * 72, 72, L, fr, fq);
      wave_mm_nt<1, 2>(qt, U0T + mt * 16 * 72, 72, BHT + nt0 * 16 * 72, 72, L, fr, fq); wave_mm_nt<1, 2>(qt, VT + mt * 16 * 72, 72, KHT + nt0 * 16 * 72, 72, L, fr, fq);
      constexpr int TP5 = NIT / 2; const int it = (w * TP5) / 4, rn0 = (w * TP5) % 4;
      f32x4 rp[1][TP5], y0[1][TP5];
#pragma unroll
      for (int q = 0; q < TP5; ++q) { const int j = (rn0 + q) * 16 + 4 * fq; const u32x2 rw = *(const LAS u32x2*)(RT + (it * 16 + fr) * 72 + j); const f32x4 e4 = *(const LAS f32x4*)(EGM + j);
          rp[0][q] = (f32x4){bflo(rw.x) * e4[0], bfhi(rw.x) * e4[1], bflo(rw.y) * e4[2], bfhi(rw.y) * e4[3]}; y0[0][q] = (f32x4){0.f, 0.f, 0.f, 0.f}; }
      wave_mm_nt<1, TP5>(rp, ARB + it * 16 * 72, 72, APT + rn0 * 16 * 72, 72, L, fr, fq);
      wave_mm_nt<1, TP5>(y0, ARB + it * 16 * 72, 72, U0T + rn0 * 16 * 72, 72, L, fr, fq); wave_mm_nt<1, TP5>(y0, ARK + it * 16 * 72, 72, VT + rn0 * 16 * 72, 72, L, fr, fq);
      if constexpr (!SAMPLE) {
          bf16_t* PP = (bf16_t*)(F.ws + WS_REC + ((size_t)h * 256 + c) * REC_B); bf16_t* QQ = PP + 4096;
#pragma unroll
          for (int q = 0; q < 2; ++q) { const int n0 = (nt0 + q) * 16 + 4 * fq; u32x2 p; p.x = pk2(pp[0][q][0], pp[0][q][1]); p.y = pk2(pp[0][q][2], pp[0][q][3]);
              *(u32x2*)(PP + (mt * 16 + fr) * 64 + pperm(n0)) = p;
              p.x = pk2(qt[0][q][0], qt[0][q][1]); p.y = pk2(qt[0][q][2], qt[0][q][3]); *(u32x2*)(QQ + (mt * 16 + fr) * 64 + n0) = p; }
#pragma unroll
          for (int q = 0; q < TP5; ++q) { const size_t row = (size_t)(r0 + it * 16 + fr); const int n0 = (rn0 + q) * 16 + 4 * fq; u32x2 p;
              p.x = pk2(rp[0][q][0], rp[0][q][1]); p.y = pk2(rp[0][q][2], rp[0][q][3]); if constexpr (DRY) asm volatile("" :: "v"(p.x), "v"(p.y)); else *(u32x2*)(RKV + row * 3072 + 1024 + h * 64 + n0) = p;
              p.x = pk2(y0[0][q][0], y0[0][q][1]); p.y = pk2(y0[0][q][2], y0[0][q][3]); if constexpr (DRY) asm volatile("" :: "v"(p.x), "v"(p.y)); else *(u32x2*)(RKV + row * 3072 + h * 64 + n0) = p; }
      } else {
          __syncthreads();
          LAS bf16_t* PL = (LAS bf16_t*)(F.lds + RL_PL); LAS bf16_t* RLs = (LAS bf16_t*)(F.lds + RL_RL); LAS float* Y0L = (LAS float*)(F.lds + RL_Y0L); LAS float* QTL = (LAS float*)(F.lds + RL_QTL); LAS bf16_t* Sl = (LAS bf16_t*)(F.lds + RL_S);
#pragma unroll
          for (int q = 0; q < 2; ++q) { const int n0 = (nt0 + q) * 16 + 4 * fq; u32x2 p; p.x = pk2(pp[0][q][0], pp[0][q][1]); p.y = pk2(pp[0][q][2], pp[0][q][3]);
              *(LAS u32x2*)(PL + (mt * 16 + fr) * 72 + n0) = p; *(LAS f32x4*)(QTL + (mt * 16 + fr) * 68 + n0) = qt[0][q]; }
#pragma unroll
          for (int q = 0; q < TP5; ++q) { const int n0 = (rn0 + q) * 16 + 4 * fq; u32x2 p; p.x = pk2(rp[0][q][0], rp[0][q][1]); p.y = pk2(rp[0][q][2], rp[0][q][3]);
              *(LAS u32x2*)(RLs + (it * 16 + fr) * 72 + n0) = p; *(LAS f32x4*)(Y0L + (it * 16 + fr) * 68 + n0) = y0[0][q]; }
          const int sb = c - 256; const float* sin_ = F.in[I_SWKV] + (((size_t)m * 32 + sb) * 16 + h) * 4096; float* sout = F.out + O_WKVS + (((size_t)m * 32 + sb) * 16 + h) * 4096;
          for (int it2 = tid; it2 < 64 * 16; it2 += NT) { const int i = it2 >> 4, j4 = (it2 & 15) * 4; const f32x4 sv = *(const f32x4*)(sin_ + i * 64 + j4); u32x2 p; p.x = pk2(sv[0], sv[1]); p.y = pk2(sv[2], sv[3]); *(LAS u32x2*)(Sl + i * 72 + j4) = p; }
          __syncthreads();
          if (w < 2) { f32x4 y[1][4];
#pragma unroll
              for (int q = 0; q < 4; ++q) y[0][q] = *(const LAS f32x4*)(Y0L + (w * 16 + fr) * 68 + q * 16 + 4 * fq);
              wave_mm_nt<1, 4>(y, RLs + w * 16 * 72, 72, Sl, 72, 64, fr, fq);
              rwkv_out_epilogue<DRY>(F, m, y[0], (size_t)(r0 + w * 16 + fr), h, fq); }
          else if (w < 6) { const int mi = w - 2; f32x4 tl[1][4];
#pragma unroll
              for (int q = 0; q < 4; ++q) { const int j = q * 16 + 4 * fq; const f32x4 sv = *(const f32x4*)(sin_ + (mi * 16 + fr) * 64 + j), gl4 = *(const LAS f32x4*)(GLV + j), qv = *(const LAS f32x4*)(QTL + (mi * 16 + fr) * 68 + j);
                  tl[0][q] = (f32x4){__expf(gl4[0]) * sv[0] + qv[0], __expf(gl4[1]) * sv[1] + qv[1], __expf(gl4[2]) * sv[2] + qv[2], __expf(gl4[3]) * sv[3] + qv[3]}; }
              wave_mm_nt<1, 4>(tl, Sl + mi * 16 * 72, 72, PL, 72, 64, fr, fq);
#pragma unroll
              for (int q = 0; q < 4; ++q) *(f32x4*)(sout + (mi * 16 + fr) * 64 + q * 16 + 4 * fq) = tl[0][q]; }
      }
    }
}

constexpr int SC_GRP = 4, SC_CH = 8192 + 2048 + 256, SC_LCH = 9216 + 2304 + 256, SC_LBUF = SC_GRP * SC_LCH;
template <int SKIP = 0> __device__ __forceinline__ void rwkv_scan_phase(Frame& F, int layer) {
    const int tid = otid(); const int lane = tid & 63, m = layer >> 1; const int b = blockIdx.x;
    if (b >= 64) return;
    const int h = 2 * (b & 7) + (b >> 5), sl = (b >> 3) & 3;
    const unsigned char* REC = F.ws + WS_REC;
    constexpr int NG = 256 / SC_GRP, DEPTH = 4;
    static_assert(NG % DEPTH == 0, "scan groups vs prefetch depth");
    if (F.wave != 0) {
        constexpr int NV = SC_GRP * SC_CH / 16, NLT = NT - 64, NPT = (NV + NLT - 1) / NLT;
        struct RegSet { u32x4 v[NPT]; };
        RegSet sets[DEPTH];
        unsigned poff[NPT], pdst[NPT];
#pragma unroll
        for (int q = 0; q < NPT; ++q) { int v = (tid - 64) + q * NLT; v = v < NV ? v : NV - 1; const int cc = v / (SC_CH / 16), o = (v % (SC_CH / 16)) * 16;
            poff[q] = (unsigned)(cc * REC_B + o + (o >= 10240 ? 6144 : (o >= 8192 ? sl * 2048 : 0)));
            const int lo = (o < 8192) ? (o >> 7) * 144 + (o & 127) : (o < 10240) ? 9216 + ((o - 8192) >> 7) * 144 + ((o - 8192) & 127) : 9216 + 2304 + (o - 10240);
            pdst[q] = (unsigned)(cc * SC_LCH + lo); }
        auto issue = [&](int g, RegSet& st) { const unsigned char* gb = REC + ((size_t)h * 256 + g * SC_GRP) * REC_B;
#pragma unroll
            for (int q = 0; q < NPT; ++q) st.v[q] = *(const u32x4*)(gb + poff[q]); };
        auto commit = [&](int buf, const RegSet& st) {
#pragma unroll
            for (int q = 0; q < NPT; ++q) *(LAS u32x4*)(F.lds + buf * SC_LBUF + pdst[q]) = st.v[q]; };
        if (!(SKIP & 2)) {
#pragma unroll
            for (int d = 0; d < DEPTH; ++d) issue(d, sets[d]);
            commit(0, sets[0]); }
        for (int g0 = 0; g0 < NG; g0 += DEPTH) {
#pragma unroll
            for (int dd = 0; dd < DEPTH; ++dd) { const int g = g0 + dd;
                if (!(SKIP & 2)) { if (g > 0 && g + DEPTH - 1 < NG) issue(g + DEPTH - 1, sets[(dd + DEPTH - 1) % DEPTH]); }
                __syncthreads();
                __syncthreads();
                if (!(SKIP & 2)) { if (g + 1 < NG) commit((g + 1) & 1, sets[(dd + 1) % DEPTH]); } }
        }
    } else {
        const int ci = lane & 15, q4 = lane >> 4, i = 16 * sl + ci;
        f32x4 T[4];
#pragma unroll
        for (int mm = 0; mm < 4; ++mm) T[mm] = (f32x4){0.f, 0.f, 0.f, 0.f};
        bf16_t* TST = (bf16_t*)(F.ws + WS_TST);
        const unsigned pfo = (unsigned)(ci * 144 + q4 * 16);
        for (int g = 0; g < NG; ++g) {
            __syncthreads();
            if (!(SKIP & 1)) {
                const LAS unsigned char* base = F.lds + (g & 1) * SC_LBUF;
                bf16x8 pf[4][2];
#pragma unroll
                for (int mm = 0; mm < 4; ++mm)
#pragma unroll
                    for (int s = 0; s < 2; ++s) pf[mm][s] = *(const LAS bf16x8*)(base + pfo + mm * 2304 + s * 64);
#pragma unroll
                for (int cc = 0; cc < SC_GRP; ++cc) { const int c = g * SC_GRP + cc; const LAS unsigned char* cb = base + cc * SC_LCH;
                    bf16_t* tdst = TST + (((size_t)h * 256 + c) * 64 + i) * 64;
                    f32x4 gv[4]; u32x2 qv[4];
#pragma unroll
                    for (int mm = 0; mm < 4; ++mm) { const int j = 16 * mm + 4 * q4; gv[mm] = *(const LAS f32x4*)(cb + 9216 + 2304 + j * 4); qv[mm] = *(const LAS u32x2*)(cb + 9216 + ci * 144 + j * 2); }
                    bf16x8 pn[4][2];
                    if (cc + 1 < SC_GRP) {
#pragma unroll
                        for (int mm = 0; mm < 4; ++mm)
#pragma unroll
                            for (int s = 0; s < 2; ++s) pn[mm][s] = *(const LAS bf16x8*)(cb + SC_LCH + pfo + mm * 2304 + s * 64); }
                    bf16x8 Tf[2];
#pragma unroll
                    for (int mm = 0; mm < 4; ++mm) { u32x2 p; p.x = pk2(T[mm][0], T[mm][1]); p.y = pk2(T[mm][2], T[mm][3]); *(u32x2*)(tdst + 16 * mm + 4 * q4) = p;
                        Tf[mm >> 1][(mm & 1) * 4 + 0] = (short)(p.x & 0xffffu); Tf[mm >> 1][(mm & 1) * 4 + 1] = (short)(p.x >> 16); Tf[mm >> 1][(mm & 1) * 4 + 2] = (short)(p.y & 0xffffu); Tf[mm >> 1][(mm & 1) * 4 + 3] = (short)(p.y >> 16); }
#pragma unroll
                    for (int mm = 0; mm < 4; ++mm) {
                        f32x4 acc = (f32x4){gv[mm][0] * T[mm][0] + bflo(qv[mm].x), gv[mm][1] * T[mm][1] + bfhi(qv[mm].x), gv[mm][2] * T[mm][2] + bflo(qv[mm].y), gv[mm][3] * T[mm][3] + bfhi(qv[mm].y)};
                        acc = __builtin_amdgcn_mfma_f32_16x16x32_bf16(pf[mm][0], Tf[0], acc, 0, 0, 0); acc = __builtin_amdgcn_mfma_f32_16x16x32_bf16(pf[mm][1], Tf[1], acc, 0, 0, 0);
                        T[mm] = acc; }
                    if (cc + 1 < SC_GRP) {
#pragma unroll
                        for (int mm = 0; mm < 4; ++mm) { pf[mm][0] = pn[mm][0]; pf[mm][1] = pn[mm][1]; } }
                }
            }
            __syncthreads();
        }
        float* outp = F.out + O_WKVP + ((size_t)m * 16 + h) * 4096 + (size_t)i * 64;
#pragma unroll
        for (int mm = 0; mm < 4; ++mm) *(f32x4*)(outp + 16 * mm + 4 * q4) = T[mm];
    }
}

template <bool DRY = false> __device__ __forceinline__ void rwkv_output_phase(Frame& F, int layer) {
    const int tid = otid(); const int lane = tid & 63, fr = lane & 15, fq = lane >> 4, m = layer >> 1;
    const bf16_t* RKV = (const bf16_t*)(F.ws + WS_RKV); const bf16_t* TST = (const bf16_t*)(F.ws + WS_TST);
    const int gw = F.vcu * NWAVES + F.wave, NGW = F.G * NWAVES;
    for (int u = gw; u < 256 * 16 * 4; u += NGW) { const int it = u & 3, h = (u >> 2) & 15, c = u >> 6;
        const size_t row = (size_t)(64 * c + 16 * it + fr); const bf16_t* ts = TST + ((size_t)h * 256 + c) * 4096;
        f32x4 y[4];
#pragma unroll
        for (int nt = 0; nt < 4; ++nt) { const u32x2 yv = *(const u32x2*)(RKV + row * 3072 + h * 64 + 16 * nt + 4 * fq); y[nt] = (f32x4){bflo(yv.x), bfhi(yv.x), bflo(yv.y), bfhi(yv.y)}; }
#pragma unroll
        for (int s = 0; s < 2; ++s) { const bf16x8 xa = *(const bf16x8*)(RKV + row * 3072 + 1024 + h * 64 + 32 * s + 8 * fq);
#pragma unroll
            for (int nt = 0; nt < 4; ++nt) { const bf16x8 yb = *(const bf16x8*)(ts + (16 * nt + fr) * 64 + 32 * s + 8 * fq); y[nt] = __builtin_amdgcn_mfma_f32_16x16x32_bf16(yb, xa, y[nt], 0, 0, 0); } }
        rwkv_out_epilogue<DRY>(F, m, y, row, h, fq);
    }
}

#define GRID_BAR() xcd_barrier(bar)
#ifndef PHASE_MASK
#define PHASE_MASK 0xffffffffu
#endif
#define PH(k) if (PHASE_MASK & (1u << (k)))
#ifndef REP_MASK
#define REP_MASK 0u
#endif
#define REP(k) (((REP_MASK) >> (k)) & 1u)
#ifndef LOCAL_SKIP
#define LOCAL_SKIP 0
#endif
#ifndef EXTRA_BARS
#define EXTRA_BARS 0
#endif
template <int layer> __device__ __forceinline__ void layer_body(Frame& F, const XcdBarrier& bar) {
    unsigned char* ws = F.ws; unsigned char* ar = ws + WS_ARENA;
    bf16_t* XN = (bf16_t*)(ws + WS_XN);
    const float* MOD = (const float*)(ws + WS_MOD);
    constexpr int m = layer >> 1; const float* modl = MOD + (size_t)layer * NSEQ * 6144;
    PH(1) for (int rep = 0; rep <= (int)REP(1); ++rep) if (layer > 0) convert_layer_weights(F, layer);
    if constexpr ((layer & 1) == 0) {
        PH(2) for (int rep = 0; rep <= (int)REP(2); ++rep) { if constexpr (layer == 0) norm_pass<0, 0, true, true>(F, layer); else norm_pass<0, 16>(F, layer, layer - 1, 5120); }
        GRID_BAR();
        PH(3) { using GC = pg8::Geo<D, D, D, 30, 0, 1 << 20, 0>; pg8::Gemm<GC> g{XN, (const bf16_t*)(ar + AR_WIN), nullptr}; pg8::StaticOrder S; S.init(M, ABIN, F.G, (int)blockIdx.x);
          pg8::EpiBf16<0> E{(bf16_t*)(ws + WS_Z), ABIN};
          pg8::gemm_phase<pg8::EpiBf16<0>, pg8::StaticOrder, GC, true, true>(F.lds, g, S, E);
          if (REP(3)) { pg8::EpiNull<true> EN; pg8::gemm_phase<pg8::EpiNull<true>, pg8::StaticOrder, GC, true, true>(F.lds, g, S, EN); } }
        GRID_BAR();
        PH(4) for (int rep = 0; rep <= (int)REP(4); ++rep) for (int u = F.vcu; u < NCHUNK * 8; u += F.G) { const int c = u >> 3, hh = u & 7;
            if (c < 256) { if (hh < 4) ab_summary_unit<64, false>(F, layer, c, hh); else ab_summary_unit<64, true>(F, layer, c, hh - 4); }
            else { if (hh < 4) ab_summary_unit<32, false>(F, layer, c, hh); else ab_summary_unit<32, true>(F, layer, c, hh - 4); } }
        GRID_BAR();
        PH(5) { if (REP(5)) ab_scan<true>(F, layer); ab_scan<false>(F, layer); }
        GRID_BAR();
        PH(6) for (int rep = 0; rep <= (int)REP(6); ++rep) for (int u = F.vcu; u < NCHUNK * 8; u += F.G) { const int c = u >> 3, hh = u & 7;
            if (c < 256) { if (hh < 4) ab_output_unit<64, false>(F, layer, c, hh); else ab_output_unit<64, true>(F, layer, c, hh - 4); }
            else { if (hh < 4) ab_output_unit<32, false>(F, layer, c, hh); else ab_output_unit<32, true>(F, layer, c, hh - 4); } }
        GRID_BAR();
        PH(7) { using GC = pg8::Geo<D, D, D, 30, 0, 1 << 20, 0>; pg8::Gemm<GC> g{XN, (const bf16_t*)(ar + AR_WOUT), nullptr}; pg8::StaticOrder S; S.init(MP, D, F.G, (int)blockIdx.x);
          pg8::EpiRes E{F.out, modl, 2048, (layer == 0) ? F.in[I_XP] : F.out};
          pg8::gemm_phase<pg8::EpiRes, pg8::StaticOrder, GC, true, true>(F.lds, g, S, E);
          if (REP(7)) { pg8::EpiNull<false> EN; pg8::gemm_phase<pg8::EpiNull<false>, pg8::StaticOrder, GC, true, true>(F.lds, g, S, EN); }
          using GC2 = pg8::Geo<D, D, 256, 30, 0, 1 << 20, 0, true>; pg8::Gemm<GC2> g2{XN, (const bf16_t*)(ar + AR_WOUT), nullptr}; pg8::SplitOrder S2{F.vcu, 4};
          pg8::EpiPartial E2{(float*)(ws + WS_PART), 4};
          pg8::gemm_phase<pg8::EpiPartial, pg8::SplitOrder, GC2, true, true>(F.lds, g2, S2, E2); }
        GRID_BAR();
    } else {
        PH(8) for (int rep = 0; rep <= (int)REP(8); ++rep) norm_pass<1, 16>(F, layer, layer - 1, 5120);
        GRID_BAR();
        PH(9) { using GC = pg8::Geo<D, 2048, 2048, 30, 0, 16, -4096>; pg8::Gemm<GC> g{XN, (const bf16_t*)(ar + AR_WC1), (const bf16_t*)(ws + WS_PREVS)}; pg8::StaticOrder S; S.init(M, 3584, F.G, (int)blockIdx.x);
          pg8::EpiRkv E{(bf16_t*)(ws + WS_RKV), (bf16_t*)(ws + WS_LO), (m == 0) ? (bf16_t*)(ws + WS_VFIRST) : nullptr};
          pg8::gemm_phase<pg8::EpiRkv, pg8::StaticOrder, GC, true, true>(F.lds, g, S, E);
          if (REP(9)) { pg8::EpiNull<true> EN; pg8::gemm_phase<pg8::EpiNull<true>, pg8::StaticOrder, GC, true, true>(F.lds, g, S, EN); } }
        GRID_BAR();
        PH(10) { using GC = pg8::Geo<D, 256, 256, 2, 256, 1 << 20, 0>; pg8::Gemm<GC> g{(const bf16_t*)(ws + WS_LO), (const bf16_t*)(ar + AR_WC2), nullptr}; pg8::StaticOrder S; S.init(M, 4096, F.G, (int)blockIdx.x);
          pg8::EpiLora2 E{(bf16_t*)(ws + WS_WLOG), XN, (bf16_t*)(ws + WS_G), (bf16_t*)(ws + WS_RKV), (m == 1) ? (const bf16_t*)(ws + WS_VFIRST) : nullptr,
                          F.in[I_RW0] + m * D, F.in[I_RA0] + m * D, F.in[I_RV0]};
          pg8::gemm_phase<pg8::EpiLora2, pg8::StaticOrder, GC, true, true>(F.lds, g, S, E);
          if (REP(10)) { pg8::EpiNull<false> EN; pg8::gemm_phase<pg8::EpiNull<false>, pg8::StaticOrder, GC, true, true>(F.lds, g, S, EN); } }
        GRID_BAR();
        PH(11) { RawRegs raw; const int tid0 = otid(); int u = F.vcu; if (u < NCHUNK * 16) rwkv_load_raw(F, u, tid0, raw);
          for (; u < NCHUNK * 16; u += F.G) { const int c = u >> 4, hh = u & 15, un = (u + F.G < NCHUNK * 16) ? u + F.G : -1;
              if (c < 256) rwkv_local_unit<64>(F, layer, c, hh, raw, un); else rwkv_local_unit<32>(F, layer, c, hh, raw, un); } }
        GRID_BAR();
        PH(17) { if (REP(17)) rwkv_scan_phase<LOCAL_SKIP>(F, layer); rwkv_scan_phase<0>(F, layer); }
        GRID_BAR();
        PH(18) { if (REP(18)) rwkv_output_phase<true>(F, layer); rwkv_output_phase<false>(F, layer); }
        GRID_BAR();
        PH(12) { using GC = pg8::Geo<3072, D, D, 30, 0, 1 << 20, 0>; pg8::Gemm<GC> g{(const bf16_t*)(ws + WS_RKV), (const bf16_t*)(ar + AR_WO), nullptr}; pg8::StaticOrder S; S.init(MP, D, F.G, (int)blockIdx.x);
          pg8::EpiRes E{F.out, modl, 2048, F.out};
          pg8::gemm_phase<pg8::EpiRes, pg8::StaticOrder, GC, true, true>(F.lds, g, S, E);
          if (REP(12)) { pg8::EpiNull<false> EN; pg8::gemm_phase<pg8::EpiNull<false>, pg8::StaticOrder, GC, true, true>(F.lds, g, S, EN); }
          using GC2 = pg8::Geo<3072, D, 256, 30, 0, 1 << 20, 0, true>; pg8::Gemm<GC2> g2{(const bf16_t*)(ws + WS_RKV), (const bf16_t*)(ar + AR_WO), nullptr}; pg8::SplitOrder S2{F.vcu, 4};
          pg8::EpiPartial E2{(float*)(ws + WS_PART), 4};
          pg8::gemm_phase<pg8::EpiPartial, pg8::SplitOrder, GC2, true, true>(F.lds, g2, S2, E2); }
        GRID_BAR();
    }
    PH(13) for (int rep = 0; rep <= (int)REP(13); ++rep) norm_pass<2, 4, false, (layer == 0)>(F, layer, layer, 2048);
    GRID_BAR();
    PH(14) { using GC = pg8::Geo<D, D, D, 30, 0, 1 << 20, 0>; pg8::Gemm<GC> g{XN, (const bf16_t*)(ar + AR_W1), nullptr}; pg8::StaticOrder S; S.init(M, DFF, F.G, (int)blockIdx.x);
      pg8::EpiBf16<1> E{(bf16_t*)(ws + WS_H), DFF};
      pg8::gemm_phase<pg8::EpiBf16<1>, pg8::StaticOrder, GC, true, true>(F.lds, g, S, E);
          if (REP(14)) { pg8::EpiNull<true> EN; pg8::gemm_phase<pg8::EpiNull<true>, pg8::StaticOrder, GC, true, true>(F.lds, g, S, EN); } }
    GRID_BAR();
    PH(15) { using GC = pg8::Geo<DFF, DFF, DFF, 30, 0, 1 << 20, 0>; pg8::Gemm<GC> g{(const bf16_t*)(ws + WS_H), (const bf16_t*)(ar + AR_W2), nullptr}; pg8::StaticOrder S; S.init(MP, D, F.G, (int)blockIdx.x);
      pg8::EpiRes E{F.out, modl, 5120, F.out};
      for (int xb = 0; xb < EXTRA_BARS; ++xb) GRID_BAR();
      pg8::gemm_phase<pg8::EpiRes, pg8::StaticOrder, GC, true, true>(F.lds, g, S, E);
      if (REP(15)) { pg8::EpiNull<false> EN; pg8::gemm_phase<pg8::EpiNull<false>, pg8::StaticOrder, GC, true, true>(F.lds, g, S, EN); }
      using GC2 = pg8::Geo<DFF, DFF, 256, 30, 0, 1 << 20, 0, true>; pg8::Gemm<GC2> g2{(const bf16_t*)(ws + WS_H), (const bf16_t*)(ar + AR_W2), nullptr}; pg8::SplitOrder S2{F.vcu, 16};
      pg8::EpiPartial E2{(float*)(ws + WS_PART), 16};
      pg8::gemm_phase<pg8::EpiPartial, pg8::SplitOrder, GC2, true, true>(F.lds, g2, S2, E2); }
    GRID_BAR();
}

__global__ void __launch_bounds__(NT, 2) fwd_kernel(Args args) {
    extern __shared__ __attribute__((aligned(16))) unsigned char lds[];
    Frame F;
    F.lds = (LAS unsigned char*)lds; F.MISC = (volatile LAS unsigned*)(F.lds + MISC_OFF);
    F.wave = __builtin_amdgcn_readfirstlane(threadIdx.x >> 6);
    F.G = gridDim.x; { const int bx = blockIdx.x; F.vcu = (F.G % 8 == 0) ? (bx % 8) * (F.G / 8) + bx / 8 : bx; }
    F.in = args.in; F.out = args.out; F.ws = args.ws;
    for (int u = threadIdx.x; u < (LDS_BYTES - LDSCTL_OFF) / 4; u += NT) ((LAS unsigned*)(F.lds + LDSCTL_OFF))[u] = 0u;
    __syncthreads();
    XcdBarrier bar = xcd_barrier_post((unsigned*)(F.ws + WS_CTL) + CW_BAR, F.MISC + 8);
    PH(0) prologue(F);
    GRID_BAR();
    PH(0) mod_phase(F);
    GRID_BAR();
    layer_body<0>(F, bar); layer_body<1>(F, bar); layer_body<2>(F, bar); layer_body<3>(F, bar);
    PH(16) norm_pass<3, 16>(F, 0, 3, 5120);
}

extern "C" void kernel_launch(void* const* d_in, const int* in_sizes, int n_in, void* d_out, int out_size, void* d_ws, size_t ws_size, hipStream_t stream) {
    static int grid = 0;
    if (grid == 0) {
        if (n_in != 38 || out_size != 28706816 || ws_size < WS_END) { fprintf(stderr, "kernel_launch: unexpected problem (n_in %d, out %d, ws %zu; need ws >= %zu)\n", n_in, out_size, ws_size, (size_t)WS_END); grid = -1; return; }
        int dev = 0, cus = 0, per_cu = 0;
        if (hipGetDevice(&dev) != hipSuccess || hipDeviceGetAttribute(&cus, hipDeviceAttributeMultiprocessorCount, dev) != hipSuccess) { grid = -1; return; }
        if (hipFuncSetAttribute((const void*)fwd_kernel, hipFuncAttributeMaxDynamicSharedMemorySize, LDS_BYTES) != hipSuccess) { fprintf(stderr, "kernel_launch: hipFuncSetAttribute failed\n"); grid = -1; return; }
        if (hipOccupancyMaxActiveBlocksPerMultiprocessor(&per_cu, (const void*)fwd_kernel, NT, LDS_BYTES) != hipSuccess || per_cu < 1) { fprintf(stderr, "kernel_launch: occupancy query says %d\n", per_cu); per_cu = 1; }
        (void)hipGetLastError();
        grid = cus;
    }
    if (grid < 0) return;
    (void)hipMemsetAsync((char*)d_ws + WS_CTL, 0, ZERO_BYTES, stream);
    Args a{};
    for (int i = 0; i < 38; ++i) a.in[i] = (const float*)d_in[i];
    a.out = (float*)d_out; a.ws = (unsigned char*)d_ws;
    void* kargs[] = {&a};
    hipError_t e = hipLaunchCooperativeKernel((const void*)fwd_kernel, dim3(grid), dim3(NT), kargs, LDS_BYTES, stream);
    if (e != hipSuccess) fprintf(stderr, "kernel_launch: cooperative launch failed: %s (grid %d)\n", hipGetErrorString(e), grid);
}
```

```cpp
#include <hip/hip_runtime.h>
#include <cstdio>
#include <cstdint>

#define LAS __attribute__((address_space(3)))
#define GAS __attribute__((address_space(1)))
typedef unsigned short bf16_t;
typedef short bf16x8 __attribute__((ext_vector_type(8)));
typedef float f32x4 __attribute__((ext_vector_type(4)));
typedef float f32x2 __attribute__((ext_vector_type(2)));
typedef unsigned u32x4 __attribute__((ext_vector_type(4)));
typedef unsigned u32x2 __attribute__((ext_vector_type(2)));

#ifndef LOCAL_SKIP
#define LOCAL_SKIP 0
#endif
constexpr int D = 1024, MP = 16384, MS = 1024, M = MP + MS, NSEQ = 33, DFF = 4096, ABIN = 3584;
constexpr int NCHUNK = 288;
constexpr int SLOT_E = 4 * 8192 + 4 * 16384;
constexpr float NORM_EPS = 1e-6f, RW_LN_EPS = 64e-5f;

constexpr size_t MiB = 1u << 20;
constexpr size_t WS_CTL = 0, WS_MOD = 1 * MiB, ZERO_BYTES = 65536;
constexpr size_t WS_ROPE = 5 * MiB;
constexpr size_t WS_ARENA = 10 * MiB;
constexpr size_t AR_W1 = 0, AR_W2 = 8 * MiB, AR_WIN = 16 * MiB, AR_WOUT = 23 * MiB, AR_WC1 = 16 * MiB, AR_WC2 = 32 * MiB, AR_WO = 34 * MiB;
constexpr size_t WS_VFIRST = 46 * MiB;
constexpr size_t WS_XN0 = 80 * MiB, WS_XN = WS_XN0 + 2048;
constexpr size_t WS_PREVS = 115 * MiB;
constexpr size_t WS_R1 = 118 * MiB;
constexpr size_t WS_Z = WS_R1, WS_STATE = WS_R1 + 120 * MiB, WS_DEC = WS_R1 + 174 * MiB;
constexpr size_t WS_H = WS_R1;
constexpr size_t WS_RKV = WS_R1, WS_LO = WS_R1 + 102 * MiB, WS_WLOG = WS_R1 + 136 * MiB, WS_G = WS_R1 + 170 * MiB;
constexpr size_t WS_TST = WS_R1 + 102 * MiB;
constexpr size_t WS_REC = WS_R1 + 204 * MiB, WS_BON = WS_R1 + 269 * MiB;
constexpr int REC_B = 16640;
constexpr size_t WS_PART = WS_R1 + 136 * MiB;
constexpr size_t WS_END = WS_R1 + 271 * MiB;

__device__ const double ROPE_REV[32] = {0.15915494309189535, 0.11934937021124886, 0.089499401608891013, 0.067115083005227255, 0.050329212104487035, 0.037741584717419771, 0.028302195830623399, 0.02122365276477766, 0.015915494309189534, 0.011934937021124886, 0.0089499401608891024, 0.0067115083005227253, 0.0050329212104487037, 0.0037741584717419772, 0.0028302195830623399, 0.0021223652764777662, 0.0015915494309189536, 0.0011934937021124885, 0.00089499401608891024, 0.0006711508300522726, 0.00050329212104487033, 0.00037741584717419774, 0.00028302195830623395, 0.00021223652764777661, 0.00015915494309189535, 0.00011934937021124886, 8.9499401608891018e-05, 6.7115083005227254e-05, 5.0329212104487035e-05, 3.7741584717419777e-05, 2.8302195830623396e-05, 2.1223652764777659e-05};

__device__ __forceinline__ unsigned f2bf(float f) { unsigned u = __builtin_bit_cast(unsigned, f); return (u + 0x7fffu + ((u >> 16) & 1u)) >> 16; }
typedef __bf16 bf16x2_t __attribute__((ext_vector_type(2)));
__device__ __forceinline__ unsigned pk2(float lo, float hi) { const f32x2 v = {lo, hi}; const bf16x2_t b = __builtin_convertvector(v, bf16x2_t); return __builtin_bit_cast(unsigned, b); }
__device__ __forceinline__ float bf2f(unsigned short b) { return __builtin_bit_cast(float, (unsigned)b << 16); }
__device__ __forceinline__ float bflo(unsigned w) { return __builtin_bit_cast(float, w << 16); }
__device__ __forceinline__ float bfhi(unsigned w) { return __builtin_bit_cast(float, w & 0xffff0000u); }
__device__ __forceinline__ float sigmoidf_(float x) { return 1.f / (1.f + __expf(-x)); }
__device__ __forceinline__ float siluf_(float x) { return x / (1.f + __expf(-x)); }
__device__ __forceinline__ float wave_sum(float v) {
#pragma unroll
    for (int o = 1; o < 64; o <<= 1) v += __shfl_xor(v, o);
    return v;
}
__device__ __forceinline__ int otid() { int t = threadIdx.x; asm volatile("" : "+v"(t)); return t; }
__device__ __forceinline__ int seq_of_row(int r) { return r < MP ? 0 : 1 + ((r - MP) >> 5); }
#define LDS_WAIT() asm volatile("s_waitcnt lgkmcnt(0)" ::: "memory")
#define VM_WAIT() asm volatile("s_waitcnt vmcnt(0)" ::: "memory")

namespace pg8 {
constexpr int BM = 256, BK = 64, HALF = 128, HTB = HALF * BK * 2, STAGE_BYTES = 8 * HTB, NXCD = 8, WGM = 8;
__host__ __device__ __forceinline__ int lds_byte(int r, int c) { const int st = (r >> 4) * 2 + (c >> 5), rr = r & 15, cc = c & 31, ob = rr * 64 + cc * 2; return st * 1024 + (ob ^ (((ob >> 9) & 1) << 5)); }
__host__ __device__ __forceinline__ void stage_rc(int b, int& R, int& C) { const int st = b / 1024, sb = b % 1024, swz = sb ^ (((sb >> 9) & 1) << 5); R = (st >> 1) * 16 + swz / 64; C = (st & 1) * 32 + (swz % 64) / 2; }
__host__ __device__ __forceinline__ int perm32(int rho) { const int n = rho >> 4, i = rho & 15; return 8 * (i >> 2) + 4 * n + (i & 3); }

struct Unit { int pm, pn, ks; };
template <int LDA_, int LDB_, int K_, int GSHIFT_, int GSTRIDE_, int KSPLIT_, int DELTAP_, bool SPLIT_ = false> struct Geo {
    static constexpr int LDA = LDA_, LDB = LDB_, K = K_, GSHIFT = GSHIFT_, GSTRIDE = GSTRIDE_, KSPLIT = KSPLIT_, DELTAP = DELTAP_; static constexpr bool SPLIT = SPLIT_;
};
template <class GC> struct Gemm {
    const bf16_t* A; const bf16_t* Bt; const bf16_t* A2s;
    __device__ __forceinline__ const char* a_base(const Unit& u) const { return (const char*)(A + (size_t)u.pm * BM * GC::LDA + (size_t)(u.pn >> GC::GSHIFT) * GC::GSTRIDE + (GC::SPLIT ? (size_t)u.ks * GC::K : 0)); }
    __device__ __forceinline__ const char* b_base(const Unit& u) const { return (const char*)(Bt + (size_t)u.pn * BM * GC::LDB + (GC::SPLIT ? (size_t)u.ks * GC::K : 0)); }
    __device__ __forceinline__ long a_delta(const Unit& u) const {
        if constexpr (GC::KSPLIT >= GC::K / BK) return 0;
        else { if (u.pm < 64) return (long)GC::DELTAP;
            return (long)((const char*)(A2s + (size_t)(u.pm - 64) * BM * GC::LDA) - a_base(u)) - (long)GC::KSPLIT * BK * 2; }
    }
};
struct StaticOrder {
    int nM, nN, nwg, G, c;
    __host__ __device__ void init(int M_, int N_, int G_, int c_) { nM = M_ / BM; nN = N_ / BM; nwg = nM * nN; G = G_; c = c_; }
    __host__ __device__ bool next(int i, Unit& u) const {
        const long L = (long)i * G + c; if (L >= nwg) return false;
        int wgid = (int)L; { const int q = nwg / NXCD, r = nwg % NXCD, xcd = wgid % NXCD, off = wgid / NXCD; wgid = (xcd < r ? xcd * (q + 1) : r * (q + 1) + (xcd - r) * q) + off; }
        const int nig = WGM * nN, gid = wgid / nig, fm = gid * WGM, gsz = (nM - fm) < WGM ? (nM - fm) : WGM;
        u.pm = fm + ((wgid % nig) % gsz); u.pn = (wgid % nig) / gsz; u.ks = 0; return true;
    }
};
__device__ __forceinline__ unsigned cvt_pk_bf16(float lo, float hi) { return pk2(lo, hi); }

template <class Epi, class Sched, class GC, bool ALIGN_EPI = false, bool SP2 = false>
__device__ __forceinline__ void gemm_phase(LAS unsigned char* lds, const Gemm<GC> g, const Sched& S, const Epi& E) {
    const int tid = otid(), wid = __builtin_amdgcn_readfirstlane(tid >> 6), lane = tid & 63, wr = wid >> 2, wc = wid & 3, fr = lane & 15, fq = lane >> 4;
    constexpr int K = GC::K, nt = K / BK, ksplit = GC::KSPLIT;
    unsigned voffA[2], voffB[2];
#pragma unroll
    for (int i = 0; i < 2; ++i) { int R, C; stage_rc(tid * 16 + i * 8192, R, C); const int Rb = Epi::PERM ? ((R & ~31) + perm32(R & 31)) : R;
        voffA[i] = (unsigned)(R * GC::LDA + C) * 2u; voffB[i] = (unsigned)(Rb * GC::LDB + C) * 2u; }
    constexpr size_t kstep = (size_t)(BK * 2);
    constexpr size_t hstepA = (size_t)HALF * GC::LDA * 2, hstepB = (size_t)HALF * GC::LDB * 2;
    const unsigned ldsw = (unsigned)wid * 1024u;
    const int aoff = lds_byte(wr * 64 + fr, fq * 8), boff = lds_byte(wc * 32 + fr, fq * 8);
#define PG8_SA(b, h) (((b) * 2 + (h)) * HTB)
#define PG8_SB(b, h) ((4 + (b) * 2 + (h)) * HTB)
#define PG8_STAGE(bufoff, gbase, voff) do { _Pragma("unroll") for (int _i = 0; _i < 2; ++_i) \
        __builtin_amdgcn_global_load_lds((const unsigned*)((const char*)(gbase) + (voff)[_i]), (LAS unsigned*)(lds + (bufoff) + ldsw + _i * 8192), 16, 0, 0); } while (0)
#define PG8_LDA(dst, b, h) do { _Pragma("unroll") for (int m = 0; m < 4; ++m) _Pragma("unroll") for (int k = 0; k < 2; ++k) dst[m][k] = *(const LAS bf16x8*)(lds + PG8_SA(b, h) + aoff + m * 2048 + k * 1024); } while (0)
#define PG8_LDB(dst, b, h) do { _Pragma("unroll") for (int n = 0; n < 2; ++n) _Pragma("unroll") for (int k = 0; k < 2; ++k) dst[n][k] = *(const LAS bf16x8*)(lds + PG8_SB(b, h) + boff + n * 2048 + k * 1024); } while (0)
#define PG8_MMA(ai, bj, At, Bt) do { __builtin_amdgcn_s_setprio(1); _Pragma("unroll") for (int m = 0; m < 4; ++m) _Pragma("unroll") for (int n = 0; n < 2; ++n) _Pragma("unroll") for (int k = 0; k < 2; ++k) \
        acc[ai][bj][m][n] = __builtin_amdgcn_mfma_f32_16x16x32_bf16(Bt[n][k], At[m][k], acc[ai][bj][m][n], 0, 0, 0); __builtin_amdgcn_s_setprio(0); } while (0)
#define PG8_WAIT_V(n) asm volatile("s_waitcnt vmcnt(" #n ")" ::: "memory")
#define PG8_WAIT_L(n) asm volatile("s_waitcnt lgkmcnt(" #n ")" ::: "memory")
#define PG8_BAR __builtin_amdgcn_s_barrier()
#define PG8_SCHED __builtin_amdgcn_sched_barrier(0)
    Unit cur, nxt; int ui = 0;
    if (!S.next(0, cur)) return;
    f32x4 acc[2][2][4][2];
#pragma unroll
    for (int a = 0; a < 2; ++a)
#pragma unroll
        for (int b = 0; b < 2; ++b)
#pragma unroll
            for (int m = 0; m < 4; ++m)
#pragma unroll
                for (int n = 0; n < 2; ++n) acc[a][b][m][n] = (f32x4){0.f, 0.f, 0.f, 0.f};
    bf16x8 At[4][2], B0[2][2], B1[2][2];
    const char* cA = g.a_base(cur); const char* cB = g.b_base(cur); long cD = g.a_delta(cur);
    if constexpr (SP2) {
        PG8_STAGE(PG8_SB(0, 0), cB, voffB); PG8_STAGE(PG8_SB(0, 1), cB + hstepB, voffB); PG8_STAGE(PG8_SA(0, 0), cA, voffA); PG8_STAGE(PG8_SA(0, 1), cA + hstepA, voffA);
        if (wr == 1) PG8_BAR;
        PG8_WAIT_V(2); PG8_BAR;
        PG8_STAGE(PG8_SB(1, 0), cB + kstep, voffB); PG8_STAGE(PG8_SA(1, 0), cA + kstep, voffA); PG8_STAGE(PG8_SB(1, 1), cB + hstepB + kstep, voffB);
        PG8_WAIT_V(6); PG8_BAR;
    } else {
        PG8_STAGE(PG8_SB(0, 0), cB, voffB); PG8_STAGE(PG8_SA(0, 0), cA, voffA); PG8_STAGE(PG8_SB(0, 1), cB + hstepB, voffB); PG8_STAGE(PG8_SA(0, 1), cA + hstepA, voffA);
        if (wr == 1) PG8_BAR;
        PG8_WAIT_V(4); PG8_BAR;
        PG8_STAGE(PG8_SB(1, 0), cB + kstep, voffB); PG8_STAGE(PG8_SA(1, 0), cA + kstep, voffA); PG8_STAGE(PG8_SB(1, 1), cB + hstepB + kstep, voffB);
        PG8_WAIT_V(6); PG8_BAR;
    }
    for (;;) {
        const bool has_next = S.next(ui + 1, nxt);
        const char* nA = has_next ? g.a_base(nxt) : cA; const char* nB = has_next ? g.b_base(nxt) : cB;
        const long nD = has_next ? g.a_delta(nxt) : cD;
#pragma unroll 1
        for (int t = 0; t < nt; t += 2) {
            const bool last = (t == nt - 2);
            const char* a1 = cA + (size_t)(t + 1) * kstep + (t >= ksplit ? cD : 0);
            const char* a2 = last ? nA : cA + (size_t)(t + 2) * kstep + (t + 2 >= ksplit ? cD : 0); const char* b2 = last ? nB : cB + (size_t)(t + 2) * kstep;
            const char* a3 = a2 + kstep; const char* b3 = b2 + kstep;
            if constexpr (SP2) {
            PG8_LDB(B0, 0, 0); PG8_LDB(B1, 0, 1); PG8_SCHED; PG8_LDA(At, 0, 0); PG8_STAGE(PG8_SA(1, 1), a1 + hstepA, voffA);
            PG8_WAIT_V(8); PG8_WAIT_L(0); PG8_BAR; PG8_MMA(0, 0, At, B0); PG8_MMA(0, 1, At, B1); PG8_BAR; PG8_SCHED;
            PG8_LDA(At, 0, 1); PG8_STAGE(PG8_SB(0, 0), b2, voffB); PG8_STAGE(PG8_SB(0, 1), b2 + hstepB, voffB); PG8_STAGE(PG8_SA(0, 0), a2, voffA);
            PG8_WAIT_V(8); PG8_WAIT_L(0); PG8_BAR; PG8_MMA(1, 0, At, B0); PG8_MMA(1, 1, At, B1); PG8_BAR; PG8_SCHED;
            PG8_LDB(B0, 1, 0); PG8_LDB(B1, 1, 1); PG8_SCHED; PG8_LDA(At, 1, 0); PG8_STAGE(PG8_SA(0, 1), a2 + hstepA, voffA);
            PG8_WAIT_V(8); PG8_WAIT_L(0); PG8_BAR; PG8_MMA(0, 0, At, B0); PG8_MMA(0, 1, At, B1); PG8_BAR; PG8_SCHED;
            PG8_LDA(At, 1, 1); PG8_STAGE(PG8_SB(1, 0), b3, voffB); PG8_STAGE(PG8_SB(1, 1), b3 + hstepB, voffB); PG8_STAGE(PG8_SA(1, 0), a3, voffA);
            PG8_WAIT_V(8); PG8_WAIT_L(0); PG8_BAR; PG8_MMA(1, 0, At, B0); PG8_MMA(1, 1, At, B1); PG8_BAR; PG8_SCHED;
            } else {
            PG8_LDB(B0, 0, 0); PG8_SCHED; PG8_LDA(At, 0, 0); PG8_STAGE(PG8_SA(1, 1), a1 + hstepA, voffA);
            PG8_WAIT_L(8); PG8_BAR; PG8_WAIT_L(0); PG8_MMA(0, 0, At, B0); PG8_BAR; PG8_SCHED;
            PG8_LDB(B1, 0, 1); PG8_STAGE(PG8_SB(0, 0), b2, voffB);
            PG8_BAR; PG8_WAIT_L(0); PG8_MMA(0, 1, At, B1); PG8_BAR;
            PG8_LDA(At, 0, 1); PG8_STAGE(PG8_SA(0, 0), a2, voffA);
            PG8_BAR; PG8_WAIT_L(0); PG8_MMA(1, 0, At, B0); PG8_BAR; PG8_SCHED;
            PG8_STAGE(PG8_SB(0, 1), b2 + hstepB, voffB);
            PG8_WAIT_V(6); PG8_BAR; PG8_MMA(1, 1, At, B1); PG8_BAR;
            PG8_LDB(B0, 1, 0); PG8_SCHED; PG8_LDA(At, 1, 0); PG8_STAGE(PG8_SA(0, 1), a2 + hstepA, voffA);
            PG8_WAIT_L(8); PG8_BAR; PG8_WAIT_L(0); PG8_MMA(0, 0, At, B0); PG8_BAR; PG8_SCHED;
            PG8_LDB(B1, 1, 1); PG8_STAGE(PG8_SB(1, 0), b3, voffB);
            PG8_BAR; PG8_WAIT_L(0); PG8_MMA(0, 1, At, B1); PG8_BAR;
            PG8_LDA(At, 1, 1); PG8_STAGE(PG8_SA(1, 0), a3, voffA);
            PG8_BAR; PG8_WAIT_L(0); PG8_MMA(1, 0, At, B0); PG8_BAR; PG8_SCHED;
            PG8_STAGE(PG8_SB(1, 1), b3 + hstepB, voffB);
            PG8_WAIT_V(6); PG8_BAR; PG8_MMA(1, 1, At, B1); PG8_BAR;
            }
        }
        if constexpr (ALIGN_EPI) { if (wr == 0) PG8_BAR; }
        E(acc, cur, wr, wc, fr, fq);
        if (!has_next) break;
#pragma unroll
        for (int a = 0; a < 2; ++a)
#pragma unroll
            for (int b = 0; b < 2; ++b)
#pragma unroll
                for (int m = 0; m < 4; ++m)
#pragma unroll
                    for (int n = 0; n < 2; ++n) acc[a][b][m][n] = (f32x4){0.f, 0.f, 0.f, 0.f};
        cur = nxt; cA = nA; cB = nB; cD = nD; ++ui;
        if constexpr (ALIGN_EPI) { if (wr == 1) PG8_BAR; }
    }
    PG8_WAIT_V(0);
    if constexpr (!ALIGN_EPI) { if (wr == 0) PG8_BAR; }
    PG8_BAR;
#undef PG8_SA
#undef PG8_SB
#undef PG8_STAGE
#undef PG8_LDA
#undef PG8_LDB
#undef PG8_MMA
#undef PG8_WAIT_V
#undef PG8_WAIT_L
#undef PG8_BAR
#undef PG8_SCHED
}

__device__ __forceinline__ float act_apply(float v, int act) {
    if (act == 1) { const float r = v > 0.f ? v : 0.f; return r * r; }
    if (act == 2) { const float e = __expf(-2.f * fabsf(v)); const float t = (1.f - e) / (1.f + e); return v < 0.f ? -t : t; }
    if (act == 3) return 1.f / (1.f + __expf(-v));
    return v;
}
template <int ACT> __device__ __forceinline__ void store_tile_bf16(const f32x4 (&acc)[2][2][4][2], bf16_t* base, int ldc, int row0, int col0, bf16_t* base2, int ldc2, int col2) {
#pragma unroll
    for (int ai = 0; ai < 2; ++ai)
#pragma unroll
        for (int m = 0; m < 4; ++m) { const size_t r = (size_t)(row0 + ai * HALF + m * 16);
#pragma unroll
            for (int bj = 0; bj < 2; ++bj) { f32x4 v0 = acc[ai][bj][m][0], v1 = acc[ai][bj][m][1];
#pragma unroll
                for (int q = 0; q < 4; ++q) { v0[q] = act_apply(v0[q], ACT); v1[q] = act_apply(v1[q], ACT); }
                u32x4 w; w.x = cvt_pk_bf16(v0[0], v0[1]); w.y = cvt_pk_bf16(v0[2], v0[3]); w.z = cvt_pk_bf16(v1[0], v1[1]); w.w = cvt_pk_bf16(v1[2], v1[3]);
                *(u32x4*)(base + r * ldc + col0 + bj * HALF) = w;
                if (base2) *(u32x4*)(base2 + r * ldc2 + col2 + bj * HALF) = w; } }
}
template <int ACT> struct EpiBf16 {
    static constexpr bool PERM = true;
    bf16_t* O; int ldc;
    __device__ __forceinline__ void operator()(const f32x4 (&acc)[2][2][4][2], const Unit& u, int wr, int wc, int fr, int fq) const {
        store_tile_bf16<ACT>(acc, O, ldc, u.pm * BM + wr * 64 + fr, u.pn * BM + wc * 32 + 8 * fq, nullptr, 0, 0);
    }
};
struct EpiRkv {
    static constexpr bool PERM = true;
    bf16_t* RKV; bf16_t* LO; bf16_t* vf;
    __device__ __forceinline__ void operator()(const f32x4 (&acc)[2][2][4][2], const Unit& u, int wr, int wc, int fr, int fq) const {
        const int row0 = u.pm * BM + wr * 64 + fr, cin = wc * 32 + 8 * fq;
        if (u.pn < 12) { bf16_t* b2 = (u.pn >= 8) ? vf : nullptr; store_tile_bf16<0>(acc, RKV, 3072, row0, u.pn * BM + cin, b2, 1024, (u.pn - 8) * BM + cin); }
        else {
#pragma unroll
            for (int bj = 0; bj < 2; ++bj) { const int c = cin + bj * HALF; int dst = -1, act = 0;
                if (u.pn == 12) { if (c < 64) { dst = c; act = 2; } else if (c < 128) dst = 256 + (c - 64); else if (c < 160) dst = 512 + (c - 128); }
                else if (c < 160) { dst = 768 + c; act = 3; }
                if (dst >= 0) {
#pragma unroll
                    for (int ai = 0; ai < 2; ++ai)
#pragma unroll
                        for (int m = 0; m < 4; ++m) { const size_t r = (size_t)(row0 + ai * HALF + m * 16); f32x4 v0 = acc[ai][bj][m][0], v1 = acc[ai][bj][m][1];
#pragma unroll
                            for (int q = 0; q < 4; ++q) { v0[q] = act_apply(v0[q], act); v1[q] = act_apply(v1[q], act); }
                            u32x4 w; w.x = cvt_pk_bf16(v0[0], v0[1]); w.y = cvt_pk_bf16(v0[2], v0[3]); w.z = cvt_pk_bf16(v1[0], v1[1]); w.w = cvt_pk_bf16(v1[2], v1[3]);
                            *(u32x4*)(LO + r * 1024 + dst) = w; } } }
        }
    }
};
struct EpiRes {
    static constexpr bool PERM = false;
    float* X; const float* modl; int goff; const float* Xin;
    __device__ __forceinline__ void operator()(const f32x4 (&acc)[2][2][4][2], const Unit& u, int wr, int wc, int fr, int fq) const {
        const int col0 = u.pn * BM + wc * 32 + 4 * fq;
#pragma unroll
        for (int ai = 0; ai < 2; ++ai)
#pragma unroll
            for (int m = 0; m < 4; ++m) { const int r = u.pm * BM + ai * HALF + wr * 64 + m * 16 + fr; const float* gp = modl + (size_t)seq_of_row(r) * 6144 + goff + col0; float* xp = X + (size_t)r * D + col0; const float* xi = Xin + (size_t)r * D + col0;
#pragma unroll
                for (int bj = 0; bj < 2; ++bj)
#pragma unroll
                    for (int n = 0; n < 2; ++n) { const f32x4 gv = *(const f32x4*)(gp + bj * HALF + n * 16); f32x4 xv = *(const f32x4*)(xi + bj * HALF + n * 16);
                        xv = xv + gv * acc[ai][bj][m][n]; *(f32x4*)(xp + bj * HALF + n * 16) = xv; }
                asm volatile("" ::: "memory"); }
    }
};
struct EpiLora2 {
    static constexpr bool PERM = false;
    bf16_t* WLOG; bf16_t* Aout; bf16_t* G; bf16_t* RKV; const bf16_t* vf; const float* w0; const float* a0; const float* v0;
    template <int GRP> __device__ __forceinline__ void run(const f32x4 (&acc)[2][2][4][2], const Unit& u, int wr, int wc, int fr, int fq) const {
        const int col0 = (u.pn & 3) * BM + wc * 32 + 4 * fq;
#pragma unroll
        for (int ai = 0; ai < 2; ++ai)
#pragma unroll
            for (int m = 0; m < 4; ++m) { const size_t r = (size_t)(u.pm * BM + ai * HALF + wr * 64 + m * 16 + fr);
#pragma unroll
                for (int bj = 0; bj < 2; ++bj)
#pragma unroll
                    for (int n = 0; n < 2; ++n) { const int c = col0 + bj * HALF + n * 16; const f32x4 a = acc[ai][bj][m][n]; f32x4 o;
                        if constexpr (GRP == 0) { const f32x4 b = *(const f32x4*)(w0 + c);
#pragma unroll
                            for (int q = 0; q < 4; ++q) { const float x = -(b[q] + a[q]); const float sp = fmaxf(x, 0.f) + __logf(1.f + __expf(-fabsf(x))); o[q] = -__expf(-sp - 0.5f); }
                            u32x2 w; w.x = cvt_pk_bf16(o[0], o[1]); w.y = cvt_pk_bf16(o[2], o[3]); *(u32x2*)(WLOG + r * D + c) = w; }
                        else if constexpr (GRP == 1) { const f32x4 b = *(const f32x4*)(a0 + c);
#pragma unroll
                            for (int q = 0; q < 4; ++q) o[q] = 1.f / (1.f + __expf(-(b[q] + a[q])));
                            u32x2 w; w.x = cvt_pk_bf16(o[0], o[1]); w.y = cvt_pk_bf16(o[2], o[3]); *(u32x2*)(Aout + r * D + c) = w; }
                        else if constexpr (GRP == 2) { const f32x4 b = *(const f32x4*)(v0 + c); const u32x2 vv = *(const u32x2*)(RKV + r * 3072 + 2048 + c), ff = *(const u32x2*)(vf + r * D + c);
                            f32x4 v4, f4; v4[0] = bflo(vv.x); v4[1] = bfhi(vv.x); v4[2] = bflo(vv.y); v4[3] = bfhi(vv.y); f4[0] = bflo(ff.x); f4[1] = bfhi(ff.x); f4[2] = bflo(ff.y); f4[3] = bfhi(ff.y);
#pragma unroll
                            for (int q = 0; q < 4; ++q) { const float gte = 1.f / (1.f + __expf(-(b[q] + a[q]))); o[q] = v4[q] + (f4[q] - v4[q]) * gte; }
                            u32x2 w; w.x = cvt_pk_bf16(o[0], o[1]); w.y = cvt_pk_bf16(o[2], o[3]); *(u32x2*)(RKV + r * 3072 + 2048 + c) = w; }
                        else { u32x2 w; w.x = cvt_pk_bf16(a[0], a[1]); w.y = cvt_pk_bf16(a[2], a[3]); *(u32x2*)(G + r * D + c) = w; } }
                asm volatile("" ::: "memory"); }
    }
    __device__ __forceinline__ void operator()(const f32x4 (&acc)[2][2][4][2], const Unit& u, int wr, int wc, int fr, int fq) const {
        const int grp = u.pn >> 2;
        if (grp == 0) run<0>(acc, u, wr, wc, fr, fq);
        else if (grp == 1) run<1>(acc, u, wr, wc, fr, fq);
        else if (grp == 2) { if (vf != nullptr) run<2>(acc, u, wr, wc, fr, fq); }
        else run<3>(acc, u, wr, wc, fr, fq);
    }
};
struct SplitOrder {
    int c, splitk;
    __device__ bool next(int i, Unit& u) const { if (i != 0 || c >= 16 * splitk) return false; const int t = c / splitk; u.pm = 64 + (t >> 2); u.pn = t & 3; u.ks = c % splitk; return true; }
};
struct EpiPartial {
    static constexpr bool PERM = false;
    float* PART; int splitk;
    __device__ __forceinline__ void operator()(const f32x4 (&acc)[2][2][4][2], const Unit& u, int wr, int wc, int fr, int fq) const {
        float* base = PART + ((size_t)(((u.pm - 64) * 4 + u.pn) * splitk + u.ks) << 16) + wc * 32 + 4 * fq;
#pragma unroll
        for (int ai = 0; ai < 2; ++ai)
#pragma unroll
            for (int m = 0; m < 4; ++m) { float* rp = base + (ai * HALF + wr * 64 + m * 16 + fr) * 256;
#pragma unroll
                for (int bj = 0; bj < 2; ++bj)
#pragma unroll
                    for (int n = 0; n < 2; ++n) *(f32x4*)(rp + bj * HALF + n * 16) = acc[ai][bj][m][n]; }
    }
};
template <bool PERM_> struct EpiNull {
    static constexpr bool PERM = PERM_;
    __device__ __forceinline__ void operator()(const f32x4 (&acc)[2][2][4][2], const Unit&, int, int, int, int) const {
#pragma unroll
        for (int a = 0; a < 2; ++a)
#pragma unroll
            for (int b = 0; b < 2; ++b)
#pragma unroll
                for (int m = 0; m < 4; ++m)
#pragma unroll
                    for (int n = 0; n < 2; ++n) asm volatile("" :: "v"(acc[a][b][m][n]));
    }
};
}

#define RLX_AGENT __ATOMIC_RELAXED, __HIP_MEMORY_SCOPE_AGENT
#define XB_TMO      128
#define XB_XCNT(j)  (256  + 64 * (j))
#define XB_XSUB(j)  (1280 + 64 * (j))
#define XB_XGEN(j)  (2304 + 64 * (j))
#define XB_TOP      3328
#define XB_TOPGEN   3392
#define XCD_BAR_WORDS 3456
#define XB_SPIN_CAP (1u << 24)
__device__ __forceinline__ unsigned xb_ld(unsigned* p)              { return __hip_atomic_load(p, __ATOMIC_RELAXED, __HIP_MEMORY_SCOPE_AGENT); }
__device__ __forceinline__ unsigned xb_add(unsigned* p, unsigned v) { return __hip_atomic_fetch_add(p, v, __ATOMIC_RELAXED, __HIP_MEMORY_SCOPE_AGENT); }
__device__ __forceinline__ unsigned xb_xcc_id() { return (unsigned)__builtin_amdgcn_s_getreg((3 << 11) | 20) & 0xFu; }
#define XB_SPIN(cond, bar) do { unsigned _sp = 0; while (cond) { __builtin_amdgcn_s_sleep(4); \
    if ((++_sp & 255u) == 0u) { if (xb_ld(&(bar)[XB_TMO])) break; if (_sp > XB_SPIN_CAP) { atomicAdd(&(bar)[XB_TMO], 1u); break; } } } } while (0)
struct XcdBarrier { unsigned* bar; unsigned x; volatile LAS unsigned* st; };
__device__ __forceinline__ XcdBarrier xcd_barrier_post(unsigned* bar, volatile LAS unsigned* st) {
    XcdBarrier b; b.bar = bar; b.x = xb_xcc_id(); b.st = st;
    if (threadIdx.x == 0) (void)xb_add(&bar[XB_XCNT(b.x)], 1u);
    return b;
}
__device__ __forceinline__ void xcd_barrier_complete(unsigned* bar, unsigned x, unsigned& nloc, unsigned& nx) {
    const unsigned G = gridDim.x * gridDim.y * gridDim.z;
    unsigned sum, cnt, mine, sp = 0u;
    for (;;) {
        sum = 0u; cnt = 0u; mine = 0u;
#pragma unroll
        for (unsigned j = 0; j < 16; ++j) { const unsigned c = xb_ld(&bar[XB_XCNT(j)]); sum += c; cnt += (c > 0u) ? 1u : 0u; mine = (j == x) ? c : mine; }
        if (sum == G) break;
        __builtin_amdgcn_s_sleep(1);
        if ((++sp & 255u) == 0u) { if (xb_ld(&bar[XB_TMO])) break; if (sp > XB_SPIN_CAP) { atomicAdd(&bar[XB_TMO], 1u); break; } }
    }
    nloc = mine > 0u ? mine : 1u; nx = cnt > 0u ? cnt : 1u;
}
__device__ __forceinline__ void xcd_barrier(const XcdBarrier& b) {
    asm volatile("s_waitcnt vmcnt(0)" ::: "memory");
    __syncthreads();
    if (threadIdx.x == 0) {
        unsigned* bar = b.bar;
        __builtin_amdgcn_s_waitcnt(0);
        unsigned nloc = b.st[0], nx = b.st[1];
        if (nloc == 0u) { xcd_barrier_complete(bar, b.x, nloc, nx); b.st[0] = nloc; b.st[1] = nx; }
        const unsigned gen = b.st[2];
        const unsigned old = xb_add(&bar[XB_XSUB(b.x)], 1u);
        if (old + 1u == (gen + 1u) * nloc) {
            __builtin_amdgcn_fence(__ATOMIC_RELEASE, "agent");
            asm volatile("s_waitcnt vmcnt(0)" ::: "memory");
            const unsigned og = xb_add(&bar[XB_TOP], 1u);
            if (og + 1u == (gen + 1u) * nx) xb_add(&bar[XB_TOPGEN], 1u);
            else XB_SPIN(xb_ld(&bar[XB_TOPGEN]) == gen, bar);
        } else {
            XB_SPIN(xb_ld(&bar[XB_TOPGEN]) == gen, bar);
        }
        __builtin_amdgcn_fence(__ATOMIC_ACQUIRE, "agent");
        asm volatile("s_waitcnt vmcnt(0)" ::: "memory");
        b.st[2] = gen + 1u;
    }
    __syncthreads();
}

constexpr int NWAVES = 8, NT = NWAVES * 64;
constexpr int RING_BYTES = 131072, LDSCTL_OFF = RING_BYTES, MISC_OFF = LDSCTL_OFF + 320, LDS_BYTES = 147456;
constexpr int CW_BAR = 4096;

struct Args { const float* in[38]; float* out; unsigned char* ws; };
struct Frame {
    LAS unsigned char* lds; volatile LAS unsigned* MISC;
    int wave, vcu, G;
    const float* const* in; float* out; unsigned char* ws;
};
enum { I_XP = 0, I_XS, I_SRET, I_SHG, I_SWKV, I_SSHIFT, I_CP, I_CS, I_MODW, I_MODB, I_NMIXG, I_NMLPG, I_FINALG, I_W1, I_W2, I_ABWIN, I_ABWOUT, I_HGLB, I_HGNG,
       I_MU, I_WRKV, I_RW0, I_RW1, I_RW2, I_RA0, I_RA1, I_RA2, I_RV0, I_RV1, I_RV2, I_RG1, I_RG2, I_RKK, I_RKA, I_RRK, I_RLNG, I_RLNB, I_RWOUT };
constexpr size_t O_Y = 0, O_RETP = 17825792, O_RETS = 17891328, O_HGP = 19988480, O_HGS = 20119552, O_WKVP = 24313856, O_WKVS = 24444928, O_SHP = 28639232, O_SHS = 28641280;

__device__ __forceinline__ void transpose_item(const float* W, int N, bf16_t* WT, int ldt, int row_off, int col_off, const float* mu, int mode, LAS float* scr, int item, int lane) {
    const int nblk = N / 32, kb = item / nblk, nb = item % nblk, k0 = 64 * kb, n0 = 32 * nb;
#pragma unroll 8
    for (int i = 0; i < 32; ++i) { const int kk = 2 * i + (lane >> 5); float s = 1.f; if (mode == 1) s = 1.f - mu[k0 + kk]; else if (mode == 2) s = mu[k0 + kk];
        scr[kk * 33 + (lane & 31)] = W[(size_t)(k0 + kk) * N + n0 + (lane & 31)] * s; }
    LDS_WAIT(); asm volatile("" ::: "memory");
    const int c = lane & 7;
#pragma unroll
    for (int j = 0; j < 4; ++j) { const int n = (lane >> 3) + 8 * j; const LAS float* s = scr + (8 * c) * 33 + n;
        u32x4 o; o.x = pk2(s[0 * 33], s[1 * 33]); o.y = pk2(s[2 * 33], s[3 * 33]); o.z = pk2(s[4 * 33], s[5 * 33]); o.w = pk2(s[6 * 33], s[7 * 33]);
        *(u32x4*)(WT + (size_t)(row_off + n0 + n) * ldt + col_off + k0 + 8 * c) = o; }
    LDS_WAIT(); asm volatile("" ::: "memory");
}
__device__ __forceinline__ void convert_layer_weights(Frame& F, int layer) {
    const int tid = otid(); const int lane = tid & 63; (void)lane;
    LAS float* scr = (LAS float*)(F.lds + F.wave * 16384);
    const int gw = F.vcu * NWAVES + F.wave, NGW = F.G * NWAVES;
    unsigned char* ar = F.ws + WS_ARENA;
    const int m = layer >> 1;
    constexpr int I_1 = (D / 64) * (DFF / 32), I_2 = (DFF / 64) * (D / 32);
    const float* w1 = F.in[I_W1] + (size_t)layer * D * DFF; const float* w2 = F.in[I_W2] + (size_t)layer * DFF * D;
    if ((layer & 1) == 0) {
        constexpr int I_IN = (D / 64) * (ABIN / 32), I_OUT = (D / 64) * (D / 32), NI = I_1 + I_2 + I_IN + I_OUT;
        const float* win = F.in[I_ABWIN] + (size_t)m * D * ABIN; const float* wout = F.in[I_ABWOUT] + (size_t)m * D * D;
        for (int it = gw; it < NI; it += NGW) { int r = it;
            if (r < I_1) { transpose_item(w1, DFF, (bf16_t*)(ar + AR_W1), D, 0, 0, nullptr, 0, scr, r, lane); continue; } r -= I_1;
            if (r < I_2) { transpose_item(w2, D, (bf16_t*)(ar + AR_W2), DFF, 0, 0, nullptr, 0, scr, r, lane); continue; } r -= I_2;
            if (r < I_IN) { transpose_item(win, ABIN, (bf16_t*)(ar + AR_WIN), D, 0, 0, nullptr, 0, scr, r, lane); continue; } r -= I_IN;
            transpose_item(wout, D, (bf16_t*)(ar + AR_WOUT), D, 0, 0, nullptr, 0, scr, r, lane); }
    } else {
        constexpr int I_P = (D / 64) * (D / 32), NI = I_1 + I_2 + 7 * I_P;
        const float* mu = F.in[I_MU] + (size_t)m * 6 * D; const float* wrkv = F.in[I_WRKV] + (size_t)m * 3 * D * D; const float* wo = F.in[I_RWOUT] + (size_t)m * D * D;
        bf16_t* wc1 = (bf16_t*)(ar + AR_WC1);
        for (int it = gw; it < NI; it += NGW) { int r = it;
            if (r < I_1) { transpose_item(w1, DFF, (bf16_t*)(ar + AR_W1), D, 0, 0, nullptr, 0, scr, r, lane); continue; } r -= I_1;
            if (r < I_2) { transpose_item(w2, D, (bf16_t*)(ar + AR_W2), DFF, 0, 0, nullptr, 0, scr, r, lane); continue; } r -= I_2;
            if (r < 6 * I_P) { const int p = r / (2 * I_P), hf = (r / I_P) & 1, mi = (p == 0) ? 0 : (p == 1 ? 2 : 3);
                transpose_item(wrkv + (size_t)p * D * D, D, wc1, 2048, p * D, hf * D, mu + mi * D, 1 + hf, scr, r % I_P, lane); continue; } r -= 6 * I_P;
            transpose_item(wo, D, (bf16_t*)(ar + AR_WO), D, 0, 0, nullptr, 0, scr, r, lane); }
        const int gt = F.vcu * NT + tid, NG = F.G * NT;
        const float* lw1 = F.in[I_RW1] + (size_t)m * D * 64; const float* la1 = F.in[I_RA1] + (size_t)m * D * 64; const float* lv1 = F.in[I_RV1]; const float* lg1 = F.in[I_RG1] + (size_t)m * D * 160;
        for (int idx = gt; idx < 512 * 2048; idx += NG) { const int n = idx >> 11, k = idx & 2047, kk = k & 1023, nn = n & 255;
            const float* src = nullptr; int ns = 0, mi = 0, nc = 0;
            if (n < 256) { if (nn < 64) { src = lw1; ns = 64; mi = 1; nc = nn; } else if (nn < 128) { src = la1; ns = 64; mi = 4; nc = nn - 64; } else if (nn < 160 && m == 1) { src = lv1; ns = 32; mi = 3; nc = nn - 128; } }
            else if (nn < 160) { src = lg1; ns = 160; mi = 5; nc = nn; }
            float v = 0.f; if (src) { const float muv = mu[mi * D + kk]; v = src[(size_t)kk * ns + nc] * (k < 1024 ? 1.f - muv : muv); }
            wc1[(size_t)(3072 + n) * 2048 + k] = (bf16_t)f2bf(v); }
        bf16_t* wc2 = (bf16_t*)(ar + AR_WC2);
        const float* lw2 = F.in[I_RW2] + (size_t)m * 64 * D; const float* la2 = F.in[I_RA2] + (size_t)m * 64 * D; const float* lv2 = F.in[I_RV2]; const float* lg2 = F.in[I_RG2] + (size_t)m * 160 * D;
        for (int idx = gt; idx < 4096 * 256; idx += NG) { const int k = idx >> 12, n = idx & 4095, g = n >> 10, nn = n & 1023;
            const float* src = (g == 0) ? lw2 : (g == 1) ? la2 : (g == 2) ? lv2 : lg2; const int ks = (g == 0 || g == 1) ? 64 : (g == 2 ? 32 : 160);
            float v = 0.f; if (k < ks && !(g == 2 && m == 0)) v = src[(size_t)k * D + nn];
            wc2[(size_t)n * 256 + k] = (bf16_t)f2bf(v); }
    }
}

__device__ __forceinline__ void mod_phase(Frame& F) {
    const int tid = otid(); const int lane = tid & 63;
    const float* __restrict__ SC = (const float*)(F.ws + WS_MOD + 3584 * 1024);
    float* MOD = (float*)(F.ws + WS_MOD);
    LAS float* red = (LAS float*)F.lds;
    for (int task = F.vcu; task < 4 * 96; task += F.G) { const int l = task / 96, n = (task % 96) * 64 + lane, ks = F.wave;
        const float* w = F.in[I_MODW] + ((size_t)l * D + ks * 128) * 6144 + n;
        float acc[NSEQ];
#pragma unroll
        for (int s = 0; s < NSEQ; ++s) acc[s] = 0.f;
        for (int k = 0; k < 128; k += 4) { const float w0 = w[(size_t)k * 6144], w1 = w[(size_t)(k + 1) * 6144], w2 = w[(size_t)(k + 2) * 6144], w3 = w[(size_t)(k + 3) * 6144];
#pragma unroll
            for (int s = 0; s < NSEQ; ++s) { const f32x4 c4 = *(const f32x4*)(SC + s * D + ks * 128 + k); acc[s] += (c4[0] * w0 + c4[1] * w1) + (c4[2] * w2 + c4[3] * w3); } }
        __syncthreads();
#pragma unroll
        for (int s = 0; s < NSEQ; ++s) red[(F.wave * NSEQ + s) * 64 + lane] = acc[s];
        __syncthreads();
        for (int i = tid; i < NSEQ * 64; i += NT) { const int s = i >> 6, c = i & 63; float t = F.in[I_MODB][l * 6144 + (task % 96) * 64 + c];
#pragma unroll
            for (int q = 0; q < 8; ++q) t += red[(q * NSEQ + s) * 64 + c];
            MOD[((size_t)l * NSEQ + s) * 6144 + (task % 96) * 64 + c] = t; }
    }
    __syncthreads();
}

__device__ __forceinline__ void prologue(Frame& F) {
    const int tid = otid(); const int lane = tid & 63; (void)lane;
    const int gt = F.vcu * NT + tid, NG = F.G * NT;
    { f32x2* tab = (f32x2*)(F.ws + WS_ROPE);
      for (int i = gt; i < 16384 * 32; i += NG) { const int p = i >> 5, d = i & 31; double rev = (double)p * ROPE_REV[d]; rev -= floor(rev); const float fr = (float)rev;
          tab[i] = (f32x2){__builtin_amdgcn_cosf(fr), __builtin_amdgcn_sinf(fr)}; } }
    { unsigned* z = (unsigned*)(F.ws + WS_XN0); for (int i = gt; i < 512; i += NG) z[i] = 0u; }
    { float* SC = (float*)(F.ws + WS_MOD + 3584 * 1024);
      for (int i = gt; i < NSEQ * D; i += NG) { const int s = i >> 10, k = i & 1023; const float c = (s == 0) ? F.in[I_CP][k] : F.in[I_CS][(size_t)(s - 1) * D + k]; SC[i] = siluf_(c); } }
    convert_layer_weights(F, 0);
}

template <int MODE> __device__ __forceinline__ void norm_row(Frame& F, int layer, int r, f32x4 (&v)[4], const float* MOD, const float* gvec, int lane) {
    const int m = layer >> 1; const int shoff = (MODE == 2) ? 3072 : 0, scoff = (MODE == 2) ? 4096 : 1024;
    bf16_t* XN = (bf16_t*)(F.ws + WS_XN); bf16_t* PREVS = (bf16_t*)(F.ws + WS_PREVS);
    float* xrow = F.out + (size_t)r * D; float s2 = 0.f;
#pragma unroll
    for (int j = 0; j < 4; ++j) s2 += (v[j].x * v[j].x + v[j].y * v[j].y) + (v[j].z * v[j].z + v[j].w * v[j].w);
    const float rstd = 1.f / sqrtf(wave_sum(s2) * (1.f / D) + NORM_EPS);
    const int seq = seq_of_row(r); const float* mp = MOD + (size_t)seq * 6144;
#pragma unroll
    for (int j = 0; j < 4; ++j) { const int c = 4 * lane + 256 * j; const f32x4 g4 = *(const f32x4*)(gvec + c); f32x4 o = v[j] * rstd * g4;
        if (MODE == 3) { *((f32x4*)xrow + lane + 64 * j) = o; continue; }
        const f32x4 sc = *(const f32x4*)(mp + scoff + c), sh = *(const f32x4*)(mp + shoff + c);
        o = o * (1.f + sc) + sh;
        const unsigned long long pk = (unsigned long long)pk2(o.x, o.y) | ((unsigned long long)pk2(o.z, o.w) << 32);
        *(unsigned long long*)(XN + (size_t)r * D + c) = pk;
        if (MODE == 1) {
            if (r >= MP) { const int t = (r - MP) & 31; if (t < 31) *(unsigned long long*)(PREVS + (size_t)(r - MP + 1) * D + c) = pk;
                else *(f32x4*)(F.out + O_SHS + ((size_t)m * 32 + ((r - MP) >> 5)) * D + c) = o;
                if (t == 0) { const f32x4 ss = *(const f32x4*)(F.in[I_SSHIFT] + ((size_t)m * 32 + ((r - MP) >> 5)) * D + c);
                    *(unsigned long long*)(PREVS + (size_t)(r - MP) * D + c) = (unsigned long long)pk2(ss.x, ss.y) | ((unsigned long long)pk2(ss.z, ss.w) << 32); } }
            else if (r == MP - 1) *(f32x4*)(F.out + O_SHP + (size_t)m * D + c) = o;
        } }
}
template <int MODE, int PEND = 0, bool FIRSTP = false, bool FIRSTS = false> __device__ __forceinline__ void norm_pass(Frame& F, int layer, int player = 0, int pgoff = 0) {
    const int tid = otid(); const int lane = tid & 63;
    const int gw = F.vcu * NWAVES + F.wave, NGW = F.G * NWAVES;
    const float* MOD = (const float*)(F.ws + WS_MOD) + (size_t)layer * NSEQ * 6144;
    const float* gvec = (MODE == 3) ? F.in[I_FINALG] : (MODE == 2 ? F.in[I_NMLPG] + layer * D : F.in[I_NMIXG] + layer * D);
    LAS float* xs = (LAS float*)F.lds;
    if constexpr (PEND > 0) {
        __syncthreads();
        const float* gmod = (const float*)(F.ws + WS_MOD) + (size_t)player * NSEQ * 6144 + pgoff;
#pragma unroll
        for (int q = 0; q < 2; ++q) { const int idx = tid + q * NT, rr = idx >> 8, c4 = (idx & 255) * 4; const int r = MP + 4 * F.vcu + rr; if (4 * F.vcu + rr < MS) {
                const int pn = c4 >> 8; const float* pb = (const float*)(F.ws + WS_PART) + ((size_t)((((r >> 8) - 64) * 4 + pn) * PEND) << 16) + (r & 255) * 256 + (c4 & 255);
                f32x4 acc = (f32x4){0.f, 0.f, 0.f, 0.f};
#pragma unroll
                for (int ks = 0; ks < PEND; ++ks) acc += *(const f32x4*)(pb + ((size_t)ks << 16));
                const f32x4 g4 = *(const f32x4*)(gmod + (size_t)seq_of_row(r) * 6144 + c4); f32x4 x4 = FIRSTS ? *(const f32x4*)(F.in[I_XS] + (size_t)(r - MP) * D + c4) : *(const f32x4*)(F.out + (size_t)r * D + c4);
                x4 = x4 + g4 * acc; *(f32x4*)(F.out + (size_t)r * D + c4) = x4; *(LAS f32x4*)(xs + rr * 1024 + c4) = x4; } }
        __syncthreads();
    }
    for (int r = gw; r < MP; r += NGW) {
        const f32x4* xr = (const f32x4*)((FIRSTP ? F.in[I_XP] : F.out) + (size_t)r * D) + lane; f32x4 v[4];
#pragma unroll
        for (int j = 0; j < 4; ++j) v[j] = xr[64 * j];
        norm_row<MODE>(F, layer, r, v, MOD, gvec, lane);
    }
    if (F.wave < 4 && 4 * F.vcu + F.wave < MS) { const int r = MP + 4 * F.vcu + F.wave; f32x4 v[4];
#pragma unroll
        for (int j = 0; j < 4; ++j) { if constexpr (PEND > 0) v[j] = *(const LAS f32x4*)(xs + F.wave * 1024 + 4 * lane + 256 * j); else v[j] = *((const f32x4*)(FIRSTS ? F.in[I_XS] + (size_t)(r - MP) * D : F.out + (size_t)r * D) + lane + 64 * j); }
        norm_row<MODE>(F, layer, r, v, MOD, gvec, lane); }
}

template <int MT, int NTT> __device__ __forceinline__ void wave_mm_nt(f32x4 (&acc)[MT][NTT], const LAS bf16_t* X, int ldx, const LAS bf16_t* Y, int ldy, int K, int fr, int fq) {
    for (int k0 = 0; k0 < K; k0 += 32) {
        bf16x8 xa[MT], yb[NTT];
#pragma unroll
        for (int i = 0; i < MT; ++i) xa[i] = *(const LAS bf16x8*)(X + (16 * i + fr) * ldx + k0 + 8 * fq);
#pragma unroll
        for (int j = 0; j < NTT; ++j) yb[j] = *(const LAS bf16x8*)(Y + (16 * j + fr) * ldy + k0 + 8 * fq);
#pragma unroll
        for (int i = 0; i < MT; ++i)
#pragma unroll
            for (int j = 0; j < NTT; ++j) acc[i][j] = __builtin_amdgcn_mfma_f32_16x16x32_bf16(yb[j], xa[i], acc[i][j], 0, 0, 0);
    }
}

constexpr int LQS = 0, LKS = 18432, LQG = 36864, LVT = 55296, LST = 73728, LPS = 108544, LRED = 117760, LBS = 118784;
__device__ __forceinline__ void chunk_geom(int c, int& r0, int& pos0) { if (c < 256) { r0 = 64 * c; pos0 = 64 * c; } else { r0 = MP + 32 * (c - 256); pos0 = 2048; } }

template <int L, bool HG, bool SUMMARY> __device__ __forceinline__ void ab_load(Frame& F, int layer, int c, int h) {
    const int tid = otid(); const int lane = tid & 63; (void)lane;
    const int m = layer >> 1; int r0, pos0; chunk_geom(c, r0, pos0);
    const bf16_t* Z = (const bf16_t*)(F.ws + WS_Z);
    LAS bf16_t* QS = (LAS bf16_t*)(F.lds + LQS); LAS bf16_t* KS = (LAS bf16_t*)(F.lds + LKS); LAS bf16_t* QG = (LAS bf16_t*)(F.lds + LQG); LAS bf16_t* VT = (LAS bf16_t*)(F.lds + LVT);
    constexpr int LDT = L + 8;
    if constexpr (HG) {
        constexpr int TQ = L / 4; LAS float* BS = (LAS float*)(F.lds + LBS);
        const int ch = tid & 127, qtr = tid >> 7;
        float lb = 0.f;
        if (m == 1) { const float a0 = F.in[I_HGLB][h * 128 + ch], a1 = F.in[I_HGLB][512 + h * 128 + ch]; lb = 1.f / (1.f + __expf(a0 - a1)); }
        { constexpr int NP = L * 16;
#pragma unroll
          for (int q = 0; q < (NP + NT - 1) / NT; ++q) { const int v = tid + q * NT; if (NP % NT == 0 || v < NP) { const int j = v >> 4, c8 = v & 15; const size_t zr = (size_t)(r0 + j) * ABIN + h * 128 + c8 * 8;
                  const u32x4 zf4 = *(const u32x4*)(Z + zr + 2048), v4 = *(const u32x4*)(Z + zr + 2560);
                  *(LAS u32x4*)(QG + j * 136 + c8 * 8) = zf4; *(LAS u32x4*)(KS + j * 136 + c8 * 8) = v4;
                  if constexpr (!SUMMARY) { const u32x4 q4 = *(const u32x4*)(Z + zr + 1536); *(LAS u32x4*)(QS + j * 136 + c8 * 8) = q4; } } } }
        __syncthreads();
        float zf[TQ], cs[TQ]; float run = 0.f;
#pragma unroll
        for (int jj = 0; jj < TQ; ++jj) { const int j = qtr * TQ + jj; zf[jj] = bf2f(QG[j * 136 + ch]);
            float lf; if (lb == 0.f) lf = fminf(zf[jj], 0.f) - __logf(1.f + __expf(-fabsf(zf[jj]))); else lf = __logf(lb + (1.f - lb) * sigmoidf_(zf[jj]));
            run += lf; cs[jj] = run; }
        BS[qtr * 128 + ch] = run;
        __syncthreads();
        const float b0 = BS[ch], b1 = BS[128 + ch], b2 = BS[256 + ch], b3 = BS[384 + ch];
        const float off = (qtr > 0 ? b0 : 0.f) + (qtr > 1 ? b1 : 0.f) + (qtr > 2 ? b2 : 0.f), bL = (b0 + b1) + (b2 + b3), bmid = b0 + b1;
        if constexpr (SUMMARY) {
#pragma unroll
            for (int j8 = 0; j8 < TQ; j8 += 8) { unsigned vv[8]; float kd[8];
#pragma unroll
                for (int q = 0; q < 8; ++q) { const int jj = j8 + q, j = qtr * TQ + jj; const float b = off + cs[jj]; const float kb = (1.f - lb) * sigmoidf_(-zf[jj]); vv[q] = KS[j * 136 + ch]; kd[q] = kb * __expf(bL - b); }
                u32x4 pv, pk; pv.x = vv[0] | (vv[1] << 16); pv.y = vv[2] | (vv[3] << 16); pv.z = vv[4] | (vv[5] << 16); pv.w = vv[6] | (vv[7] << 16);
                pk.x = pk2(kd[0], kd[1]); pk.y = pk2(kd[2], kd[3]); pk.z = pk2(kd[4], kd[5]); pk.w = pk2(kd[6], kd[7]);
                *(LAS u32x4*)(VT + ch * LDT + qtr * TQ + j8) = pv; *(LAS u32x4*)(QS + ch * LDT + qtr * TQ + j8) = pk; }
            if (qtr == 0) ((float*)(F.ws + WS_DEC))[((size_t)c * 4 + h) * 128 + ch] = __expf(bL);
        } else {
#pragma unroll
            for (int j8 = 0; j8 < TQ; j8 += 8) { unsigned vv[8];
#pragma unroll
                for (int q8 = 0; q8 < 8; ++q8) { const int jj = j8 + q8, j = qtr * TQ + jj; const float b = off + cs[jj]; const float kb = (1.f - lb) * sigmoidf_(-zf[jj]);
                    const float q = siluf_(bf2f(QS[j * 136 + ch])); vv[q8] = KS[j * 136 + ch];
                    QS[j * 136 + ch] = (bf16_t)f2bf(q * __expf(b - bmid)); KS[j * 136 + ch] = (bf16_t)f2bf(kb * __expf(bmid - b)); QG[j * 136 + ch] = (bf16_t)f2bf(q * __expf(b)); }
                u32x4 pv; pv.x = vv[0] | (vv[1] << 16); pv.y = vv[2] | (vv[3] << 16); pv.z = vv[4] | (vv[5] << 16); pv.w = vv[6] | (vv[7] << 16);
                *(LAS u32x4*)(VT + ch * LDT + qtr * TQ + j8) = pv; }
        }
    } else {
        const float logg = log1pf(-exp2f(-5.f - (float)h));
        const f32x2* rope = (const f32x2*)(F.ws + WS_ROPE);
        for (int it = tid; it < L * 4; it += NT) { const int j = it >> 2, d8 = it & 3; const size_t zr = (size_t)(r0 + j) * ABIN;
            const f32x2* rp = rope + (size_t)(pos0 + j) * 32 + d8 * 8;
            const u32x4 k1 = *(const u32x4*)(Z + zr + 256 + h * 64 + d8 * 8), k2 = *(const u32x4*)(Z + zr + 256 + h * 64 + 32 + d8 * 8);
            const float gk = __expf((float)(L - 1 - j) * logg), gq = __expf((float)(j + 1) * logg);
            u32x4 q1 = (u32x4){0, 0, 0, 0}, q2 = q1; if constexpr (!SUMMARY) { q1 = *(const u32x4*)(Z + zr + h * 64 + d8 * 8); q2 = *(const u32x4*)(Z + zr + h * 64 + 32 + d8 * 8); }
#pragma unroll
            for (int e = 0; e < 8; ++e) { const f32x2 cs_ = rp[e]; const unsigned wk1 = k1[e >> 1], wk2 = k2[e >> 1]; const float x1 = (e & 1) ? bfhi(wk1) : bflo(wk1), x2 = (e & 1) ? bfhi(wk2) : bflo(wk2);
                const float o1 = x1 * cs_.x - x2 * cs_.y, o2 = x1 * cs_.y + x2 * cs_.x; const int d = d8 * 8 + e;
                if constexpr (SUMMARY) { QS[d * LDT + j] = (bf16_t)f2bf(o1 * gk); QS[(d + 32) * LDT + j] = (bf16_t)f2bf(o2 * gk); }
                else { KS[j * 72 + d] = (bf16_t)f2bf(o1); KS[j * 72 + d + 32] = (bf16_t)f2bf(o2);
                    const unsigned wq1 = q1[e >> 1], wq2 = q2[e >> 1]; const float y1 = (e & 1) ? bfhi(wq1) : bflo(wq1), y2 = (e & 1) ? bfhi(wq2) : bflo(wq2);
                    const float p1 = (y1 * cs_.x - y2 * cs_.y) * 0.125f, p2 = (y1 * cs_.y + y2 * cs_.x) * 0.125f;
                    QS[j * 72 + d] = (bf16_t)f2bf(p1); QS[j * 72 + d + 32] = (bf16_t)f2bf(p2); QG[j * 72 + d] = (bf16_t)f2bf(p1 * gq); QG[j * 72 + d + 32] = (bf16_t)f2bf(p2 * gq); } } }
        for (int it = tid; it < L * 16; it += NT) { const int j = it >> 4, e8 = it & 15; const u32x4 vv = *(const u32x4*)(Z + (size_t)(r0 + j) * ABIN + 512 + h * 128 + e8 * 8);
#pragma unroll
            for (int e = 0; e < 8; ++e) { const unsigned w = vv[e >> 1]; VT[(e8 * 8 + e) * LDT + j] = (bf16_t)((e & 1) ? (w >> 16) : (w & 0xffffu)); } }
    }
}

template <int L, bool HG> __device__ __forceinline__ void ab_summary_unit(Frame& F, int layer, int c, int h) {
    const int tid = otid(); const int lane = tid & 63; (void)lane;
    constexpr int DK = HG ? 128 : 64, NCT = DK / 16, LDT = L + 8;
    __syncthreads();
    ab_load<L, HG, true>(F, layer, c, h);
    __syncthreads();
    const int fr = lane & 15, fq = lane >> 4;
    const LAS bf16_t* KDT = (const LAS bf16_t*)(F.lds + LQS); const LAS bf16_t* VT = (const LAS bf16_t*)(F.lds + LVT);
    f32x4 acc[1][NCT];
#pragma unroll
    for (int j = 0; j < NCT; ++j) acc[0][j] = (f32x4){0.f, 0.f, 0.f, 0.f};
    wave_mm_nt<1, NCT>(acc, VT + F.wave * 16 * LDT, LDT, KDT, LDT, L, fr, fq);
    bf16_t* ST = (bf16_t*)(F.ws + WS_STATE) + (size_t)c * SLOT_E + (HG ? 32768 + h * 16384 : h * 8192);
    const int e = F.wave * 16 + fr;
#pragma unroll
    for (int j = 0; j < NCT; ++j) { u32x2 w; w.x = pk2(acc[0][j][0], acc[0][j][1]); w.y = pk2(acc[0][j][2], acc[0][j][3]); *(u32x2*)(ST + (size_t)e * DK + 16 * j + 4 * fq) = w; }
}

template <int L, bool HG> __device__ __forceinline__ void ab_output_unit(Frame& F, int layer, int c, int h) {
    const int tid = otid(); const int lane = tid & 63; (void)lane;
    constexpr int DK = HG ? 128 : 64, LDQ = HG ? 136 : 72, LDT = L + 8, NIT = L / 16, WPI = 8 / NIT, ET = 8 / WPI, TPW = (NIT * NIT >= 8) ? NIT * NIT / 8 : 1;
    const int m = layer >> 1; int r0, pos0; chunk_geom(c, r0, pos0);
    __syncthreads();
    ab_load<L, HG, false>(F, layer, c, h);
    LAS bf16_t* QS = (LAS bf16_t*)(F.lds + LQS); LAS bf16_t* KS = (LAS bf16_t*)(F.lds + LKS); LAS bf16_t* QG = (LAS bf16_t*)(F.lds + LQG); LAS bf16_t* VT = (LAS bf16_t*)(F.lds + LVT);
    LAS bf16_t* STl = (LAS bf16_t*)(F.lds + LST); LAS bf16_t* PS = (LAS bf16_t*)(F.lds + LPS); LAS float* RED = (LAS float*)(F.lds + LRED);
    { const bf16_t* ST = (const bf16_t*)(F.ws + WS_STATE) + (size_t)c * SLOT_E + (HG ? 32768 + h * 16384 : h * 8192);
      for (int it = tid; it < 128 * DK / 8; it += NT) { const int e = it / (DK / 8), c8 = it % (DK / 8); *(LAS u32x4*)(STl + e * LDQ + c8 * 8) = *(const u32x4*)(ST + (size_t)e * DK + c8 * 8); } }
    __syncthreads();
    const int fr = lane & 15, fq = lane >> 4, w = F.wave;
    const float logg = HG ? 0.f : log1pf(-exp2f(-5.f - (float)h));
    if (w * TPW < NIT * NIT) {
        const int it = (w * TPW) / NIT, jt0 = (w * TPW) % NIT;
        f32x4 sc[1][TPW];
#pragma unroll
        for (int q = 0; q < TPW; ++q) sc[0][q] = (f32x4){0.f, 0.f, 0.f, 0.f};
        wave_mm_nt<1, TPW>(sc, QS + it * 16 * LDQ, LDQ, KS + jt0 * 16 * LDQ, LDQ, DK, fr, fq);
        const int i = it * 16 + fr;
#pragma unroll
        for (int q = 0; q < TPW; ++q) { float p[4];
#pragma unroll
            for (int r = 0; r < 4; ++r) { const int j = (jt0 + q) * 16 + 4 * fq + r; float v = sc[0][q][r]; if (!HG) v *= __expf((float)(i - j) * logg); p[r] = (j <= i) ? v : 0.f; }
            u32x2 pw; pw.x = pk2(p[0], p[1]); pw.y = pk2(p[2], p[3]); *(LAS u32x2*)(PS + i * LDT + (jt0 + q) * 16 + 4 * fq) = pw; }
    }
    __syncthreads();
    const int it = w % NIT, eg = w / NIT;
    f32x4 o[1][ET];
#pragma unroll
    for (int q = 0; q < ET; ++q) o[0][q] = (f32x4){0.f, 0.f, 0.f, 0.f};
    wave_mm_nt<1, ET>(o, PS + it * 16 * LDT, LDT, VT + eg * ET * 16 * LDT, LDT, L, fr, fq);
    wave_mm_nt<1, ET>(o, QG + it * 16 * LDQ, LDQ, STl + eg * ET * 16 * LDQ, LDQ, DK, fr, fq);
    float ss = 0.f;
#pragma unroll
    for (int q = 0; q < ET; ++q) ss += (o[0][q][0] * o[0][q][0] + o[0][q][1] * o[0][q][1]) + (o[0][q][2] * o[0][q][2] + o[0][q][3] * o[0][q][3]);
    ss += __shfl_xor(ss, 16); ss += __shfl_xor(ss, 32);
    const int i = it * 16 + fr;
    if (fq == 0) RED[i * 4 + eg] = ss;
    __syncthreads();
    float tot = 0.f;
#pragma unroll
    for (int q = 0; q < WPI; ++q) tot += RED[i * 4 + q];
    const float rstd = 1.f / sqrtf(tot * (1.f / 128.f) + NORM_EPS);
    const bf16_t* Z = (const bf16_t*)(F.ws + WS_Z); bf16_t* O = (bf16_t*)(F.ws + WS_XN);
    const size_t row = (size_t)(r0 + i);
#pragma unroll
    for (int q = 0; q < ET; ++q) { const int e = (eg * ET + q) * 16 + 4 * fq; const u32x2 gw = *(const u32x2*)(Z + row * ABIN + (HG ? 3072 : 1024) + h * 128 + e);
        const float g4[4] = {bflo(gw.x), bfhi(gw.x), bflo(gw.y), bfhi(gw.y)}; float ov[4];
#pragma unroll
        for (int r = 0; r < 4; ++r) { if (HG) ov[r] = o[0][q][r] * rstd * F.in[I_HGNG][m * 128 + e + r] * sigmoidf_(g4[r]); else ov[r] = o[0][q][r] * rstd * siluf_(g4[r]); }
        u32x2 ow; ow.x = pk2(ov[0], ov[1]); ow.y = pk2(ov[2], ov[3]); *(u32x2*)(O + row * D + (HG ? 512 : 0) + h * 128 + e) = ow; }
}

template <bool DRY = false> __device__ __forceinline__ void ab_scan(Frame& F, int layer) {
    const int tid = otid(); const int lane = tid & 63; (void)lane;
    const int m = layer >> 1;
    unsigned* ST32 = (unsigned*)(F.ws + WS_STATE); const float* DEC = (const float*)(F.ws + WS_DEC);
    constexpr int NP = SLOT_E / 2;
    const int gt = F.vcu * NT + tid;
    if (gt < NP) {
        const int eo = 2 * gt; const bool hg = eo >= 32768; const int eo2 = hg ? eo - 32768 : eo; const int head = hg ? eo2 >> 14 : eo2 >> 13; const int cch = hg ? (eo2 & 127) : (eo2 & 63); const int e = hg ? ((eo2 & 16383) >> 7) : ((eo2 & 8191) >> 6);
        const float gdec = hg ? 0.f : __expf(64.f * log1pf(-exp2f(-5.f - (float)head)));
        float s0 = 0.f, s1 = 0.f;
        for (int c0 = 0; c0 < 256; c0 += 8) {
            unsigned kv[8]; float d0[8], d1[8];
#pragma unroll
            for (int u = 0; u < 8; ++u) { kv[u] = ST32[(size_t)(c0 + u) * NP + gt]; if (hg) { const f32x2 dd = *(const f32x2*)(DEC + ((size_t)(c0 + u) * 4 + head) * 128 + cch); d0[u] = dd.x; d1[u] = dd.y; } else { d0[u] = gdec; d1[u] = gdec; } }
#pragma unroll
            for (int u = 0; u < 8; ++u) { const unsigned pw = pk2(s0, s1); if constexpr (DRY) asm volatile("" :: "v"(pw)); else ST32[(size_t)(c0 + u) * NP + gt] = pw; s0 = d0[u] * s0 + bflo(kv[u]); s1 = d1[u] * s1 + bfhi(kv[u]); }
        }
        float* outp = hg ? F.out + O_HGP + (size_t)m * 65536 + head * 16384 : F.out + O_RETP + (size_t)m * 32768 + head * 8192;
        outp[(size_t)cch * 128 + e] = s0; outp[(size_t)(cch + 1) * 128 + e] = s1;
    } else {
        const int NG2 = F.G * NT - NP; if (NG2 <= 0) return;
        for (int idx = gt - NP; idx < 32 * NP; idx += NG2) { const int b = idx / NP, pr = idx % NP;
            const int eo = 2 * pr; const bool hg = eo >= 32768; const int eo2 = hg ? eo - 32768 : eo; const int head = hg ? eo2 >> 14 : eo2 >> 13; const int cch = hg ? (eo2 & 127) : (eo2 & 63); const int e = hg ? ((eo2 & 16383) >> 7) : ((eo2 & 8191) >> 6);
            float d0, d1; if (hg) { const f32x2 dd = *(const f32x2*)(DEC + ((size_t)(256 + b) * 4 + head) * 128 + cch); d0 = dd.x; d1 = dd.y; } else { d0 = d1 = __expf(32.f * log1pf(-exp2f(-5.f - (float)head))); }
            const size_t so = hg ? ((size_t)(m * 32 + b) * 4 + head) * 16384 : ((size_t)(m * 32 + b) * 4 + head) * 8192;
            const float* sin_ = (hg ? F.in[I_SHG] : F.in[I_SRET]) + so; float* sout = F.out + (hg ? O_HGS : O_RETS) + so;
            const float i0 = sin_[(size_t)cch * 128 + e], i1 = sin_[(size_t)(cch + 1) * 128 + e];
            const unsigned kv = ST32[(size_t)(256 + b) * NP + pr]; if constexpr (!DRY) ST32[(size_t)(256 + b) * NP + pr] = pk2(i0, i1);
            sout[(size_t)cch * 128 + e] = d0 * i0 + bflo(kv); sout[(size_t)(cch + 1) * 128 + e] = d1 * i1 + bfhi(kv); }
    }
}

constexpr int RL_AT = 0, RL_RT = 9216, RL_BT = 18432, RL_KT = 27648, RL_BHT = 36864, RL_KHT = 46080, RL_VT = 55296, RL_AAB = 64512, RL_AAK = 81920, RL_ARB = 91136, RL_ARK = 100352,
              RL_U0T = 109568, RL_VEC = 118784, RL_PSUM = 119808;
constexpr int RL_G = RL_AAB, RL_WW = RL_BT, RL_APT = RL_AAK;
constexpr int RL_PL = RL_AT, RL_RL = RL_BT, RL_Y0L = RL_BT + 4608, RL_QTL = RL_AAB, RL_S = RL_BHT;
__device__ __forceinline__ int pperm(int k) { return 32 * (k >> 5) + 8 * ((k >> 2) & 3) + 4 * ((k >> 4) & 1) + (k & 3); }

template <bool DRY = false> __device__ __forceinline__ void rwkv_out_epilogue(Frame& F, int m, const f32x4 (&y)[4], size_t row, int h, int fq) {
    bf16_t* RKV = (bf16_t*)(F.ws + WS_RKV); const bf16_t* GG = (const bf16_t*)(F.ws + WS_G); const float* BON = (const float*)(F.ws + WS_BON);
    float s1 = 0.f;
#pragma unroll
    for (int nt = 0; nt < 4; ++nt) s1 += (y[nt][0] + y[nt][1]) + (y[nt][2] + y[nt][3]);
    s1 += __shfl_xor(s1, 16); s1 += __shfl_xor(s1, 32);
    const float mean = s1 * (1.f / 64.f); float s2 = 0.f;
#pragma unroll
    for (int nt = 0; nt < 4; ++nt)
#pragma unroll
        for (int r = 0; r < 4; ++r) { const float d = y[nt][r] - mean; s2 += d * d; }
    s2 += __shfl_xor(s2, 16); s2 += __shfl_xor(s2, 32);
    const float rstd = 1.f / sqrtf(s2 * (1.f / 64.f) + RW_LN_EPS), bon = BON[row * 16 + h];
#pragma unroll
    for (int nt = 0; nt < 4; ++nt) { const int i = h * 64 + 16 * nt + 4 * fq;
        const f32x4 lg = *(const f32x4*)(F.in[I_RLNG] + m * D + i), lb = *(const f32x4*)(F.in[I_RLNB] + m * D + i);
        const u32x2 vv = *(const u32x2*)(RKV + row * 3072 + 2048 + i), gg = *(const u32x2*)(GG + row * D + i);
        const float v4[4] = {bflo(vv.x), bfhi(vv.x), bflo(vv.y), bfhi(vv.y)}, g4[4] = {bflo(gg.x), bfhi(gg.x), bflo(gg.y), bfhi(gg.y)}; float o[4];
#pragma unroll
        for (int r = 0; r < 4; ++r) o[r] = ((y[nt][r] - mean) * rstd * lg[r] + lb[r] + bon * v4[r]) * g4[r];
        u32x2 w; w.x = pk2(o[0], o[1]); w.y = pk2(o[2], o[3]); if constexpr (DRY) asm volatile("" :: "v"(w.x), "v"(w.y)); else *(u32x2*)(RKV + row * 3072 + i) = w; }
}

template <int S, int L> struct SubstQ {
    static constexpr int RQ = L / 4, NV4 = RQ / 4;
    static __device__ __forceinline__ void run(float (&x)[RQ], f32x4 (&aq)[3][NV4], const LAS float* ap) {
        if constexpr (S < L - 1) {
            if constexpr (S + 2 < L - 1) {
#pragma unroll
                for (int k = 0; k < NV4; ++k) aq[(S + 2) % 3][k] = *(const LAS f32x4*)(ap + (S + 2) * 68 + 4 * k);
            }
            constexpr int own = S / RQ, ctrl = own * 0x55;
            const float xs = __builtin_bit_cast(float, __builtin_amdgcn_update_dpp(0, __builtin_bit_cast(int, x[S % RQ]), ctrl, 0xf, 0xf, false));
#pragma unroll
            for (int k = 0; k < NV4; ++k) { x[4 * k] += aq[S % 3][k][0] * xs; x[4 * k + 1] += aq[S % 3][k][1] * xs; x[4 * k + 2] += aq[S % 3][k][2] * xs; x[4 * k + 3] += aq[S % 3][k][3] * xs;
                asm volatile("" : "+v"(x[4 * k]), "+v"(x[4 * k + 1]), "+v"(x[4 * k + 2]), "+v"(x[4 * k + 3])); }
            asm volatile("" ::: "memory");
            SubstQ<S + 1, L>::run(x, aq, ap);
        }
    }
};
struct RawRegs { u32x4 r, k, v, w, a; };
__device__ __forceinline__ void rwkv_load_raw(Frame& F, int u, int tid, RawRegs& raw) {
    const int c = u >> 4, h = u & 15; int r0, pos0; chunk_geom(c, r0, pos0); const int L = c < 256 ? 64 : 32; int t = tid >> 3; t = t < L ? t : 0;
    const bf16_t* RKV = (const bf16_t*)(F.ws + WS_RKV); const bf16_t* WLOG = (const bf16_t*)(F.ws + WS_WLOG); const bf16_t* AA = (const bf16_t*)(F.ws + WS_XN);
    const size_t row = (size_t)(r0 + t); const int col = h * 64 + 8 * (tid & 7);
    raw.r = *(const u32x4*)(RKV + row * 3072 + col); raw.k = *(const u32x4*)(RKV + row * 3072 + 1024 + col); raw.v = *(const u32x4*)(RKV + row * 3072 + 2048 + col);
    raw.w = *(const u32x4*)(WLOG + row * D + col); raw.a = *(const u32x4*)(AA + row * D + col);
}
template <int L, bool DRY = false> __device__ __forceinline__ void rwkv_local_unit(Frame& F, int layer, int c, int h, RawRegs& raw, int unext) {
    const int tid = otid(); const int lane = tid & 63, fr = lane & 15, fq = lane >> 4, w = F.wave;
    constexpr int NIT = L / 16; constexpr bool SAMPLE = (L == 32);
    const int m = layer >> 1; int r0, pos0; chunk_geom(c, r0, pos0);
    bf16_t* RKV = (bf16_t*)(F.ws + WS_RKV); const bf16_t* WLOG = (const bf16_t*)(F.ws + WS_WLOG); const bf16_t* AA = (const bf16_t*)(F.ws + WS_XN);
    LAS bf16_t* AT = (LAS bf16_t*)(F.lds + RL_AT); LAS bf16_t* RT = (LAS bf16_t*)(F.lds + RL_RT); LAS bf16_t* BT = (LAS bf16_t*)(F.lds + RL_BT); LAS bf16_t* KT = (LAS bf16_t*)(F.lds + RL_KT);
    LAS bf16_t* BHT = (LAS bf16_t*)(F.lds + RL_BHT); LAS bf16_t* KHT = (LAS bf16_t*)(F.lds + RL_KHT); LAS bf16_t* VT = (LAS bf16_t*)(F.lds + RL_VT);
    LAS float* AAB = (LAS float*)(F.lds + RL_AAB); LAS bf16_t* AAK = (LAS bf16_t*)(F.lds + RL_AAK); LAS bf16_t* ARB = (LAS bf16_t*)(F.lds + RL_ARB); LAS bf16_t* ARK = (LAS bf16_t*)(F.lds + RL_ARK);
    LAS bf16_t* U0T = (LAS bf16_t*)(F.lds + RL_U0T); LAS float* GMID = (LAS float*)(F.lds + RL_VEC); LAS float* GLV = GMID + 64; LAS float* EGM = GMID + 128; LAS float* PSUM = (LAS float*)(F.lds + RL_PSUM);
    LAS float* G = (LAS float*)(F.lds + RL_G); LAS float* WW = (LAS float*)(F.lds + RL_WW); LAS bf16_t* APT = (LAS bf16_t*)(F.lds + RL_APT);
    __syncthreads();
    const int t = tid >> 3, c8 = tid & 7; const bool act = t < L;
    float rr[8], kkv[8], bb[8], kh[8], vv[8];
    if (act) { const size_t row = (size_t)(r0 + t); const int col = h * 64 + 8 * c8;
        const u32x4 r4 = raw.r, k4 = raw.k, v4 = raw.v, w4 = raw.w, a4 = raw.a;
        const float* kkp = F.in[I_RKK] + m * D + col; const float* kap = F.in[I_RKA] + m * D + col; const float* rkp = F.in[I_RRK] + m * D + col;
        float ss = 0.f, bon = 0.f;
#pragma unroll
        for (int e = 0; e < 8; ++e) { const float kx = (e & 1) ? bfhi(k4[e >> 1]) : bflo(k4[e >> 1]), al = (e & 1) ? bfhi(a4[e >> 1]) : bflo(a4[e >> 1]);
            rr[e] = (e & 1) ? bfhi(r4[e >> 1]) : bflo(r4[e >> 1]); vv[e] = (e & 1) ? bfhi(v4[e >> 1]) : bflo(v4[e >> 1]);
            kkv[e] = kx * kkp[e]; ss += kkv[e] * kkv[e]; kh[e] = kx * (1.f + (al - 1.f) * kap[e]); bb[e] = al; bon += rr[e] * kh[e] * rkp[e];
            G[t * 64 + 8 * c8 + e] = (e & 1) ? bfhi(w4[e >> 1]) : bflo(w4[e >> 1]); }
        ss += __shfl_xor(ss, 1); ss += __shfl_xor(ss, 2); ss += __shfl_xor(ss, 4); bon += __shfl_xor(bon, 1); bon += __shfl_xor(bon, 2); bon += __shfl_xor(bon, 4);
        const float inv = 1.f / fmaxf(sqrtf(ss), 1e-12f);
#pragma unroll
        for (int e = 0; e < 8; ++e) { kkv[e] *= inv; bb[e] *= kkv[e]; }
        if (c8 == 0) ((float*)(F.ws + WS_BON))[row * 16 + h] = bon; }
    if (unext >= 0) rwkv_load_raw(F, unext, tid, raw);
    __syncthreads();
    { constexpr int TE = L / 8; const int j = tid & 63, e8 = tid >> 6; float cs[TE]; float run = 0.f;
#pragma unroll
      for (int q = 0; q < TE; ++q) { run += G[(e8 * TE + q) * 64 + j]; cs[q] = run; }
      PSUM[e8 * 64 + j] = run;
      __syncthreads();
      float off = 0.f, gm = 0.f, gl = 0.f;
#pragma unroll
      for (int q = 0; q < 8; ++q) { const float p = PSUM[q * 64 + j]; if (q < e8) off += p; if (q < 4) gm += p; gl += p; }
#pragma unroll
      for (int q = 0; q < TE; ++q) G[(e8 * TE + q) * 64 + j] = off + cs[q];
      if (e8 == 0) { GMID[j] = gm; GLV[j] = gl; EGM[j] = __expf(gm); if (!SAMPLE) ((float*)(F.ws + WS_REC + ((size_t)h * 256 + c) * REC_B + 16384))[j] = __expf(gl); } }
    __syncthreads();
    if (act) { float fa[8], fr_[8], fb[8], fk[8];
#pragma unroll
        for (int e = 0; e < 8; ++e) { const int j = 8 * c8 + e; const float g = G[t * 64 + j], gp = (t > 0) ? G[(t - 1) * 64 + j] : 0.f, gm = GMID[j], gl = GLV[j];
            const float ed = __expf(gm - g), eu = __expf(g - gm), el = __expf(gl - g);
            fa[e] = -kkv[e] * __expf(gp - gm); fr_[e] = rr[e] * eu; fb[e] = bb[e] * ed; fk[e] = kh[e] * ed;
            if constexpr (!(DRY && (LOCAL_SKIP & 4))) { BHT[j * 72 + t] = (bf16_t)f2bf(bb[e] * el); KHT[j * 72 + t] = (bf16_t)f2bf(kh[e] * el); VT[j * 72 + t] = (bf16_t)f2bf(vv[e]); } }
        u32x4 p;
        p.x = pk2(fa[0], fa[1]); p.y = pk2(fa[2], fa[3]); p.z = pk2(fa[4], fa[5]); p.w = pk2(fa[6], fa[7]); *(LAS u32x4*)(AT + t * 72 + 8 * c8) = p;
        p.x = pk2(fr_[0], fr_[1]); p.y = pk2(fr_[2], fr_[3]); p.z = pk2(fr_[4], fr_[5]); p.w = pk2(fr_[6], fr_[7]); *(LAS u32x4*)(RT + t * 72 + 8 * c8) = p;
        p.x = pk2(fb[0], fb[1]); p.y = pk2(fb[2], fb[3]); p.z = pk2(fb[4], fb[5]); p.w = pk2(fb[6], fb[7]); *(LAS u32x4*)(BT + t * 72 + 8 * c8) = p;
        p.x = pk2(fk[0], fk[1]); p.y = pk2(fk[2], fk[3]); p.z = pk2(fk[4], fk[5]); p.w = pk2(fk[6], fk[7]); *(LAS u32x4*)(KT + t * 72 + 8 * c8) = p; }
    __syncthreads();
    if constexpr (DRY && (LOCAL_SKIP & 2)) return;
    { constexpr int TPW = (NIT * NIT >= 8) ? NIT * NIT / 8 : 1;
      if (w * TPW < NIT * NIT) { const int it = (w * TPW) / NIT, jt0 = (w * TPW) % NIT;
          f32x4 ab[1][TPW], ak[1][TPW], rb[1][TPW], rk[1][TPW];
#pragma unroll
          for (int q = 0; q < TPW; ++q) { ab[0][q] = (f32x4){0.f, 0.f, 0.f, 0.f}; ak[0][q] = ab[0][q]; rb[0][q] = ab[0][q]; rk[0][q] = ab[0][q]; }
          wave_mm_nt<1, TPW>(ab, AT + it * 16 * 72, 72, BT + jt0 * 16 * 72, 72, 64, fr, fq); wave_mm_nt<1, TPW>(ak, AT + it * 16 * 72, 72, KT + jt0 * 16 * 72, 72, 64, fr, fq);
          wave_mm_nt<1, TPW>(rb, RT + it * 16 * 72, 72, BT + jt0 * 16 * 72, 72, 64, fr, fq); wave_mm_nt<1, TPW>(rk, RT + it * 16 * 72, 72, KT + jt0 * 16 * 72, 72, 64, fr, fq);
          const int tt = it * 16 + fr;
#pragma unroll
          for (int q = 0; q < TPW; ++q) { const int s0 = (jt0 + q) * 16 + 4 * fq; f32x4 fab; float fak[4], frb[4], frk[4];
#pragma unroll
              for (int r = 0; r < 4; ++r) { const int sx = s0 + r; fab[r] = (sx < tt) ? ab[0][q][r] : 0.f; fak[r] = (sx < tt) ? ak[0][q][r] : 0.f; frb[r] = (sx <= tt) ? rb[0][q][r] : 0.f; frk[r] = (sx <= tt) ? rk[0][q][r] : 0.f; }
#pragma unroll
              for (int r = 0; r < 4; ++r) AAB[(s0 + r) * 68 + tt] = fab[r];
              u32x2 p; p.x = pk2(fak[0], fak[1]); p.y = pk2(fak[2], fak[3]); *(LAS u32x2*)(AAK + tt * 72 + s0) = p;
              p.x = pk2(frb[0], frb[1]); p.y = pk2(frb[2], frb[3]); *(LAS u32x2*)(ARB + tt * 72 + s0) = p;
              p.x = pk2(frk[0], frk[1]); p.y = pk2(frk[2], frk[3]); *(LAS u32x2*)(ARK + tt * 72 + s0) = p; } } }
    __syncthreads();
    { constexpr int TP3 = NIT / 2; const int it = (w * TP3) / 4, nt0 = (w * TP3) % 4;
      f32x4 ww[1][TP3];
#pragma unroll
      for (int q = 0; q < TP3; ++q) ww[0][q] = (f32x4){0.f, 0.f, 0.f, 0.f};
      wave_mm_nt<1, TP3>(ww, AAK + it * 16 * 72, 72, VT + nt0 * 16 * 72, 72, L, fr, fq);
#pragma unroll
      for (int q = 0; q < TP3; ++q) *(LAS f32x4*)(WW + (it * 16 + fr) * 68 + (nt0 + q) * 16 + 4 * fq) = ww[0][q]; }
    __syncthreads();
    { constexpr int RQ = L / 4, NV4 = RQ / 4; const int col = tid >> 2, qd = tid & 3, cidx = col & 63; const bool isA = col < 64; const float eg = EGM[cidx];
      float x[RQ]; f32x4 aq[3][NV4];
#pragma unroll
      for (int i = 0; i < RQ; ++i) { const int tt = qd * RQ + i; x[i] = isA ? bf2f(AT[tt * 72 + cidx]) * eg : WW[tt * 68 + cidx]; }
      const LAS float* ap = AAB + qd * RQ;
#pragma unroll
      for (int k = 0; k < NV4; ++k) { aq[0][k] = *(const LAS f32x4*)(ap + 4 * k); aq[1][k] = *(const LAS f32x4*)(ap + 68 + 4 * k); }
      if constexpr (!(DRY && (LOCAL_SKIP & 1))) SubstQ<0, L>::run(x, aq, ap);
      LAS bf16_t* dst = (isA ? APT : U0T) + cidx * 72 + qd * RQ;
#pragma unroll
      for (int t8 = 0; t8 < RQ; t8 += 8) { u32x4 p; p.x = pk2(x[t8], x[t8 + 1]); p.y = pk2(x[t8 + 2], x[t8 + 3]); p.z = pk2(x[t8 + 4], x[t8 + 5]); p.w = pk2(x[t8 + 6], x[t8 + 7]); *(LAS u32x4*)(dst + t8) = p; } }
    __syncthreads();
    { const int mt = w >> 1, nt0 = (w & 1) * 2;
      f32x4 pp[1][2], qt[1][2];
#pragma unroll
      for (int q = 0; q < 2; ++q) { pp[0][q] = (f32x4){0.f, 0.f, 0.f, 0.f}; qt[0][q] = pp[0][q]; }
      wave_mm_nt<1, 2>(pp, BHT + mt * 16 * 72, 72, APT + nt0 * 16 * 72, 72, L, fr, fq);
      wave_mm_nt<1, 2>(qt, U0T + mt * 16 * 72, 72, BHT + nt0 * 16 * 72, 72, L, fr, fq); wave_mm_nt<1, 2>(qt, VT + mt * 16 * 72, 72, KHT + nt0 * 16 * 72, 72, L, fr, fq);
      constexpr int TP5 = NIT / 2; const int it = (w * TP5) / 4, rn0 = (w * TP5) % 4;
      f32x4 rp[1][TP5], y0[1][TP5];
#pragma unroll
      for (int q = 0; q < TP5; ++q) { const int j = (rn0 + q) * 16 + 4 * fq; const u32x2 rw = *(const LAS u32x2*)(RT + (it * 16 + fr) * 72 + j); const f32x4 e4 = *(const LAS f32x4*)(EGM + j);
          rp[0][q] = (f32x4){bflo(rw.x) * e4[0], bfhi(rw.x) * e4[1], bflo(rw.y) * e4[2], bfhi(rw.y) * e4[3]}; y0[0][q] = (f32x4){0.f, 0.f, 0.f, 0.f}; }
      wave_mm_nt<1, TP5>(rp, ARB + it * 16 * 72, 72, APT + rn0 * 16 * 72, 72, L, fr, fq);
      wave_mm_nt<1, TP5>(y0, ARB + it * 16 * 72, 72, U0T + rn0 * 16 * 72, 72, L, fr, fq); wave_mm_nt<1, TP5>(y0, ARK + it * 16 * 72, 72, VT + rn0 * 16 * 72, 72, L, fr, fq);
      if constexpr (!SAMPLE) {
          bf16_t* PP = (bf16_t*)(F.ws + WS_REC + ((size_t)h * 256 + c) * REC_B); bf16_t* QQ = PP + 4096;
#pragma unroll
          for (int q = 0; q < 2; ++q) { const int n0 = (nt0 + q) * 16 + 4 * fq; u32x2 p; p.x = pk2(pp[0][q][0], pp[0][q][1]); p.y = pk2(pp[0][q][2], pp[0][q][3]);
              *(u32x2*)(PP + (mt * 16 + fr) * 64 + pperm(n0)) = p;
              p.x = pk2(qt[0][q][0], qt[0][q][1]); p.y = pk2(qt[0][q][2], qt[0][q][3]); *(u32x2*)(QQ + (mt * 16 + fr) * 64 + n0) = p; }
#pragma unroll
          for (int q = 0; q < TP5; ++q) { const size_t row = (size_t)(r0 + it * 16 + fr); const int n0 = (rn0 + q) * 16 + 4 * fq; u32x2 p;
              p.x = pk2(rp[0][q][0], rp[0][q][1]); p.y = pk2(rp[0][q][2], rp[0][q][3]); if constexpr (DRY) asm volatile("" :: "v"(p.x), "v"(p.y)); else *(u32x2*)(RKV + row * 3072 + 1024 + h * 64 + n0) = p;
              p.x = pk2(y0[0][q][0], y0[0][q][1]); p.y = pk2(y0[0][q][2], y0[0][q][3]); if constexpr (DRY) asm volatile("" :: "v"(p.x), "v"(p.y)); else *(u32x2*)(RKV + row * 3072 + h * 64 + n0) = p; }
      } else {
          __syncthreads();
          LAS bf16_t* PL = (LAS bf16_t*)(F.lds + RL_PL); LAS bf16_t* RLs = (LAS bf16_t*)(F.lds + RL_RL); LAS float* Y0L = (LAS float*)(F.lds + RL_Y0L); LAS float* QTL = (LAS float*)(F.lds + RL_QTL); LAS bf16_t* Sl = (LAS bf16_t*)(F.lds + RL_S);
#pragma unroll
          for (int q = 0; q < 2; ++q) { const int n0 = (nt0 + q) * 16 + 4 * fq; u32x2 p; p.x = pk2(pp[0][q][0], pp[0][q][1]); p.y = pk2(pp[0][q][2], pp[0][q][3]);
              *(LAS u32x2*)(PL + (mt * 16 + fr) * 72 + n0) = p; *(LAS f32x4*)(QTL + (mt * 16 + fr) * 68 + n0) = qt[0][q]; }
#pragma unroll
          for (int q = 0; q < TP5; ++q) { const int n0 = (rn0 + q) * 16 + 4 * fq; u32x2 p; p.x = pk2(rp[0][q][0], rp[0][q][1]); p.y = pk2(rp[0][q][2], rp[0][q][3]);
              *(LAS u32x2*)(RLs + (it * 16 + fr) * 72 + n0) = p; *(LAS f32x4*)(Y0L + (it * 16 + fr) * 68 + n0) = y0[0][q]; }
          const int sb = c - 256; const float* sin_ = F.in[I_SWKV] + (((size_t)m * 32 + sb) * 16 + h) * 4096; float* sout = F.out + O_WKVS + (((size_t)m * 32 + sb) * 16 + h) * 4096;
          for (int it2 = tid; it2 < 64 * 16; it2 += NT) { const int i = it2 >> 4, j4 = (it2 & 15) * 4; const f32x4 sv = *(const f32x4*)(sin_ + i * 64 + j4); u32x2 p; p.x = pk2(sv[0], sv[1]); p.y = pk2(sv[2], sv[3]); *(LAS u32x2*)(Sl + i * 72 + j4) = p; }
          __syncthreads();
          if (w < 2) { f32x4 y[1][4];
#pragma unroll
              for (int q = 0; q < 4; ++q) y[0][q] = *(const LAS f32x4*)(Y0L + (w * 16 + fr) * 68 + q * 16 + 4 * fq);
              wave_mm_nt<1, 4>(y, RLs + w * 16 * 72, 72, Sl, 72, 64, fr, fq);
              rwkv_out_epilogue<DRY>(F, m, y[0], (size_t)(r0 + w * 16 + fr), h, fq); }
          else if (w < 6) { const int mi = w - 2; f32x4 tl[1][4];
#pragma unroll
              for (int q = 0; q < 4; ++q) { const int j = q * 16 + 4 * fq; const f32x4 sv = *(const f32x4*)(sin_ + (mi * 16 + fr) * 64 + j), gl4 = *(const LAS f32x4*)(GLV + j), qv = *(const LAS f32x4*)(QTL + (mi * 16 + fr) * 68 + j);
                  tl[0][q] = (f32x4){__expf(gl4[0]) * sv[0] + qv[0], __expf(gl4[1]) * sv[1] + qv[1], __expf(gl4[2]) * sv[2] + qv[2], __expf(gl4[3]) * sv[3] + qv[3]}; }
              wave_mm_nt<1, 4>(tl, Sl + mi * 16 * 72, 72, PL, 72, 64, fr, fq);
#pragma unroll
              for (int q = 0; q < 4; ++q) *(f32x4*)(sout + (mi * 16 + fr) * 64 + q * 16 + 4 * fq) = tl[0][q]; }
      }
    }
}

constexpr int SC_GRP = 4, SC_CH = 8192 + 2048 + 256, SC_LCH = 9216 + 2304 + 256, SC_LBUF = SC_GRP * SC_LCH;
template <int SKIP = 0> __device__ __forceinline__ void rwkv_scan_phase(Frame& F, int layer) {
    const int tid = otid(); const int lane = tid & 63, m = layer >> 1; const int b = blockIdx.x;
    if (b >= 64) return;
    const int h = 2 * (b & 7) + (b >> 5), sl = (b >> 3) & 3;
    const unsigned char* REC = F.ws + WS_REC;
    constexpr int NG = 256 / SC_GRP, DEPTH = 4;
    static_assert(NG % DEPTH == 0, "scan groups vs prefetch depth");
    if (F.wave != 0) {
        constexpr int NV = SC_GRP * SC_CH / 16, NLT = NT - 64, NPT = (NV + NLT - 1) / NLT;
        struct RegSet { u32x4 v[NPT]; };
        RegSet sets[DEPTH];
        unsigned poff[NPT], pdst[NPT];
#pragma unroll
        for (int q = 0; q < NPT; ++q) { int v = (tid - 64) + q * NLT; v = v < NV ? v : NV - 1; const int cc = v / (SC_CH / 16), o = (v % (SC_CH / 16)) * 16;
            poff[q] = (unsigned)(cc * REC_B + o + (o >= 10240 ? 6144 : (o >= 8192 ? sl * 2048 : 0)));
            const int lo = (o < 8192) ? (o >> 7) * 144 + (o & 127) : (o < 10240) ? 9216 + ((o - 8192) >> 7) * 144 + ((o - 8192) & 127) : 9216 + 2304 + (o - 10240);
            pdst[q] = (unsigned)(cc * SC_LCH + lo); }
        auto issue = [&](int g, RegSet& st) { const unsigned char* gb = REC + ((size_t)h * 256 + g * SC_GRP) * REC_B;
#pragma unroll
            for (int q = 0; q < NPT; ++q) st.v[q] = *(const u32x4*)(gb + poff[q]); };
        auto commit = [&](int buf, const RegSet& st) {
#pragma unroll
            for (int q = 0; q < NPT; ++q) *(LAS u32x4*)(F.lds + buf * SC_LBUF + pdst[q]) = st.v[q]; };
        if (!(SKIP & 2)) {
#pragma unroll
            for (int d = 0; d < DEPTH; ++d) issue(d, sets[d]);
            commit(0, sets[0]); }
        for (int g0 = 0; g0 < NG; g0 += DEPTH) {
#pragma unroll
            for (int dd = 0; dd < DEPTH; ++dd) { const int g = g0 + dd;
                if (!(SKIP & 2)) { if (g > 0 && g + DEPTH - 1 < NG) issue(g + DEPTH - 1, sets[(dd + DEPTH - 1) % DEPTH]); }
                __syncthreads();
                __syncthreads();
                if (!(SKIP & 2)) { if (g + 1 < NG) commit((g + 1) & 1, sets[(dd + 1) % DEPTH]); } }
        }
    } else {
        const int ci = lane & 15, q4 = lane >> 4, i = 16 * sl + ci;
        f32x4 T[4];
#pragma unroll
        for (int mm = 0; mm < 4; ++mm) T[mm] = (f32x4){0.f, 0.f, 0.f, 0.f};
        bf16_t* TST = (bf16_t*)(F.ws + WS_TST);
        const unsigned pfo = (unsigned)(ci * 144 + q4 * 16);
        for (int g = 0; g < NG; ++g) {
            __syncthreads();
            if (!(SKIP & 1)) {
                const LAS unsigned char* base = F.lds + (g & 1) * SC_LBUF;
                bf16x8 pf[4][2];
#pragma unroll
                for (int mm = 0; mm < 4; ++mm)
#pragma unroll
                    for (int s = 0; s < 2; ++s) pf[mm][s] = *(const LAS bf16x8*)(base + pfo + mm * 2304 + s * 64);
#pragma unroll
                for (int cc = 0; cc < SC_GRP; ++cc) { const int c = g * SC_GRP + cc; const LAS unsigned char* cb = base + cc * SC_LCH;
                    bf16_t* tdst = TST + (((size_t)h * 256 + c) * 64 + i) * 64;
                    f32x4 gv[4]; u32x2 qv[4];
#pragma unroll
                    for (int mm = 0; mm < 4; ++mm) { const int j = 16 * mm + 4 * q4; gv[mm] = *(const LAS f32x4*)(cb + 9216 + 2304 + j * 4); qv[mm] = *(const LAS u32x2*)(cb + 9216 + ci * 144 + j * 2); }
                    bf16x8 pn[4][2];
                    if (cc + 1 < SC_GRP) {
#pragma unroll
                        for (int mm = 0; mm < 4; ++mm)
#pragma unroll
                            for (int s = 0; s < 2; ++s) pn[mm][s] = *(const LAS bf16x8*)(cb + SC_LCH + pfo + mm * 2304 + s * 64); }
                    bf16x8 Tf[2];
#pragma unroll
                    for (int mm = 0; mm < 4; ++mm) { u32x2 p; p.x = pk2(T[mm][0], T[mm][1]); p.y = pk2(T[mm][2], T[mm][3]); *(u32x2*)(tdst + 16 * mm + 4 * q4) = p;
                        Tf[mm >> 1][(mm & 1) * 4 + 0] = (short)(p.x & 0xffffu); Tf[mm >> 1][(mm & 1) * 4 + 1] = (short)(p.x >> 16); Tf[mm >> 1][(mm & 1) * 4 + 2] = (short)(p.y & 0xffffu); Tf[mm >> 1][(mm & 1) * 4 + 3] = (short)(p.y >> 16); }
#pragma unroll
                    for (int mm = 0; mm < 4; ++mm) {
                        f32x4 acc = (f32x4){gv[mm][0] * T[mm][0] + bflo(qv[mm].x), gv[mm][1] * T[mm][1] + bfhi(qv[mm].x), gv[mm][2] * T[mm][2] + bflo(qv[mm].y), gv[mm][3] * T[mm][3] + bfhi(qv[mm].y)};
                        acc = __builtin_amdgcn_mfma_f32_16x16x32_bf16(pf[mm][0], Tf[0], acc, 0, 0, 0); acc = __builtin_amdgcn_mfma_f32_16x16x32_bf16(pf[mm][1], Tf[1], acc, 0, 0, 0);
                        T[mm] = acc; }
                    if (cc + 1 < SC_GRP) {
#pragma unroll
                        for (int mm = 0; mm < 4; ++mm) { pf[mm][0] = pn[mm][0]; pf[mm][1] = pn[mm][1]; } }
                }
            }
            __syncthreads();
        }
        float* outp = F.out + O_WKVP + ((size_t)m * 16 + h) * 4096 + (size_t)i * 64;
#pragma unroll
        for (int mm = 0; mm < 4; ++mm) *(f32x4*)(outp + 16 * mm + 4 * q4) = T[mm];
    }
}

template <bool DRY = false> __device__ __forceinline__ void rwkv_output_phase(Frame& F, int layer) {
    const int tid = otid(); const int lane = tid & 63, fr = lane & 15, fq = lane >> 4, m = layer >> 1;
    const bf16_t* RKV = (const bf16_t*)(F.ws + WS_RKV); const bf16_t* TST = (const bf16_t*)(F.ws + WS_TST);
    const int gw = F.vcu * NWAVES + F.wave, NGW = F.G * NWAVES;
    for (int u = gw; u < 256 * 16 * 4; u += NGW) { const int it = u & 3, h = (u >> 2) & 15, c = u >> 6;
        const size_t row = (size_t)(64 * c + 16 * it + fr); const bf16_t* ts = TST + ((size_t)h * 256 + c) * 4096;
        f32x4 y[4];
#pragma unroll
        for (int nt = 0; nt < 4; ++nt) { const u32x2 yv = *(const u32x2*)(RKV + row * 3072 + h * 64 + 16 * nt + 4 * fq); y[nt] = (f32x4){bflo(yv.x), bfhi(yv.x), bflo(yv.y), bfhi(yv.y)}; }
#pragma unroll
        for (int s = 0; s < 2; ++s) { const bf16x8 xa = *(const bf16x8*)(RKV + row * 3072 + 1024 + h * 64 + 32 * s + 8 * fq);
#pragma unroll
            for (int nt = 0; nt < 4; ++nt) { const bf16x8 yb = *(const bf16x8*)(ts + (16 * nt + fr) * 64 + 32 * s + 8 * fq); y[nt] = __builtin_amdgcn_mfma_f32_16x16x32_bf16(yb, xa, y[nt], 0, 0, 0); } }
        rwkv_out_epilogue<DRY>(F, m, y, row, h, fq);
    }
}

#define GRID_BAR() xcd_barrier(bar)
#ifndef PHASE_MASK
#define PHASE_MASK 0xffffffffu
#endif
#define PH(k) if (PHASE_MASK & (1u << (k)))
#ifndef REP_MASK
#define REP_MASK 0u
#endif
#define REP(k) (((REP_MASK) >> (k)) & 1u)
#ifndef LOCAL_SKIP
#define LOCAL_SKIP 0
#endif
#ifndef EXTRA_BARS
#define EXTRA_BARS 0
#endif
template <int layer> __device__ __forceinline__ void layer_body(Frame& F, const XcdBarrier& bar) {
    unsigned char* ws = F.ws; unsigned char* ar = ws + WS_ARENA;
    bf16_t* XN = (bf16_t*)(ws + WS_XN);
    const float* MOD = (const float*)(ws + WS_MOD);
    constexpr int m = layer >> 1; const float* modl = MOD + (size_t)layer * NSEQ * 6144;
    PH(1) for (int rep = 0; rep <= (int)REP(1); ++rep) if (layer > 0) convert_layer_weights(F, layer);
    if constexpr ((layer & 1) == 0) {
        PH(2) for (int rep = 0; rep <= (int)REP(2); ++rep) { if constexpr (layer == 0) norm_pass<0, 0, true, true>(F, layer); else norm_pass<0, 16>(F, layer, layer - 1, 5120); }
        GRID_BAR();
        PH(3) { using GC = pg8::Geo<D, D, D, 30, 0, 1 << 20, 0>; pg8::Gemm<GC> g{XN, (const bf16_t*)(ar + AR_WIN), nullptr}; pg8::StaticOrder S; S.init(M, ABIN, F.G, (int)blockIdx.x);
          pg8::EpiBf16<0> E{(bf16_t*)(ws + WS_Z), ABIN};
          pg8::gemm_phase<pg8::EpiBf16<0>, pg8::StaticOrder, GC, true, true>(F.lds, g, S, E);
          if (REP(3)) { pg8::EpiNull<true> EN; pg8::gemm_phase<pg8::EpiNull<true>, pg8::StaticOrder, GC, true, true>(F.lds, g, S, EN); } }
        GRID_BAR();
        PH(4) for (int rep = 0; rep <= (int)REP(4); ++rep) for (int u = F.vcu; u < NCHUNK * 8; u += F.G) { const int c = u >> 3, hh = u & 7;
            if (c < 256) { if (hh < 4) ab_summary_unit<64, false>(F, layer, c, hh); else ab_summary_unit<64, true>(F, layer, c, hh - 4); }
            else { if (hh < 4) ab_summary_unit<32, false>(F, layer, c, hh); else ab_summary_unit<32, true>(F, layer, c, hh - 4); } }
        GRID_BAR();
        PH(5) { if (REP(5)) ab_scan<true>(F, layer); ab_scan<false>(F, layer); }
        GRID_BAR();
        PH(6) for (int rep = 0; rep <= (int)REP(6); ++rep) for (int u = F.vcu; u < NCHUNK * 8; u += F.G) { const int c = u >> 3, hh = u & 7;
            if (c < 256) { if (hh < 4) ab_output_unit<64, false>(F, layer, c, hh); else ab_output_unit<64, true>(F, layer, c, hh - 4); }
            else { if (hh < 4) ab_output_unit<32, false>(F, layer, c, hh); else ab_output_unit<32, true>(F, layer, c, hh - 4); } }
        GRID_BAR();
        PH(7) { using GC = pg8::Geo<D, D, D, 30, 0, 1 << 20, 0>; pg8::Gemm<GC> g{XN, (const bf16_t*)(ar + AR_WOUT), nullptr}; pg8::StaticOrder S; S.init(MP, D, F.G, (int)blockIdx.x);
          pg8::EpiRes E{F.out, modl, 2048, (layer == 0) ? F.in[I_XP] : F.out};
          pg8::gemm_phase<pg8::EpiRes, pg8::StaticOrder, GC, true, true>(F.lds, g, S, E);
          if (REP(7)) { pg8::EpiNull<false> EN; pg8::gemm_phase<pg8::EpiNull<false>, pg8::StaticOrder, GC, true, true>(F.lds, g, S, EN); }
          using GC2 = pg8::Geo<D, D, 256, 30, 0, 1 << 20, 0, true>; pg8::Gemm<GC2> g2{XN, (const bf16_t*)(ar + AR_WOUT), nullptr}; pg8::SplitOrder S2{F.vcu, 4};
          pg8::EpiPartial E2{(float*)(ws + WS_PART), 4};
          pg8::gemm_phase<pg8::EpiPartial, pg8::SplitOrder, GC2, true, true>(F.lds, g2, S2, E2); }
        GRID_BAR();
    } else {
        PH(8) for (int rep = 0; rep <= (int)REP(8); ++rep) norm_pass<1, 16>(F, layer, layer - 1, 5120);
        GRID_BAR();
        PH(9) { using GC = pg8::Geo<D, 2048, 2048, 30, 0, 16, -4096>; pg8::Gemm<GC> g{XN, (const bf16_t*)(ar + AR_WC1), (const bf16_t*)(ws + WS_PREVS)}; pg8::StaticOrder S; S.init(M, 3584, F.G, (int)blockIdx.x);
          pg8::EpiRkv E{(bf16_t*)(ws + WS_RKV), (bf16_t*)(ws + WS_LO), (m == 0) ? (bf16_t*)(ws + WS_VFIRST) : nullptr};
          pg8::gemm_phase<pg8::EpiRkv, pg8::StaticOrder, GC, true, true>(F.lds, g, S, E);
          if (REP(9)) { pg8::EpiNull<true> EN; pg8::gemm_phase<pg8::EpiNull<true>, pg8::StaticOrder, GC, true, true>(F.lds, g, S, EN); } }
        GRID_BAR();
        PH(10) { using GC = pg8::Geo<D, 256, 256, 2, 256, 1 << 20, 0>; pg8::Gemm<GC> g{(const bf16_t*)(ws + WS_LO), (const bf16_t*)(ar + AR_WC2), nullptr}; pg8::StaticOrder S; S.init(M, 4096, F.G, (int)blockIdx.x);
          pg8::EpiLora2 E{(bf16_t*)(ws + WS_WLOG), XN, (bf16_t*)(ws + WS_G), (bf16_t*)(ws + WS_RKV), (m == 1) ? (const bf16_t*)(ws + WS_VFIRST) : nullptr,
                          F.in[I_RW0] + m * D, F.in[I_RA0] + m * D, F.in[I_RV0]};
          pg8::gemm_phase<pg8::EpiLora2, pg8::StaticOrder, GC, true, true>(F.lds, g, S, E);
          if (REP(10)) { pg8::EpiNull<false> EN; pg8::gemm_phase<pg8::EpiNull<false>, pg8::StaticOrder, GC, true, true>(F.lds, g, S, EN); } }
        GRID_BAR();
        PH(11) { RawRegs raw; const int tid0 = otid(); int u = F.vcu; if (u < NCHUNK * 16) rwkv_load_raw(F, u, tid0, raw);
          for (; u < NCHUNK * 16; u += F.G) { const int c = u >> 4, hh = u & 15, un = (u + F.G < NCHUNK * 16) ? u + F.G : -1;
              if (c < 256) rwkv_local_unit<64>(F, layer, c, hh, raw, un); else rwkv_local_unit<32>(F, layer, c, hh, raw, un); } }
        GRID_BAR();
        PH(17) { if (REP(17)) rwkv_scan_phase<LOCAL_SKIP>(F, layer); rwkv_scan_phase<0>(F, layer); }
        GRID_BAR();
        PH(18) { if (REP(18)) rwkv_output_phase<true>(F, layer); rwkv_output_phase<false>(F, layer); }
        GRID_BAR();
        PH(12) { using GC = pg8::Geo<3072, D, D, 30, 0, 1 << 20, 0>; pg8::Gemm<GC> g{(const bf16_t*)(ws + WS_RKV), (const bf16_t*)(ar + AR_WO), nullptr}; pg8::StaticOrder S; S.init(MP, D, F.G, (int)blockIdx.x);
          pg8::EpiRes E{F.out, modl, 2048, F.out};
          pg8::gemm_phase<pg8::EpiRes, pg8::StaticOrder, GC, true, true>(F.lds, g, S, E);
          if (REP(12)) { pg8::EpiNull<false> EN; pg8::gemm_phase<pg8::EpiNull<false>, pg8::StaticOrder, GC, true, true>(F.lds, g, S, EN); }
          using GC2 = pg8::Geo<3072, D, 256, 30, 0, 1 << 20, 0, true>; pg8::Gemm<GC2> g2{(const bf16_t*)(ws + WS_RKV), (const bf16_t*)(ar + AR_WO), nullptr}; pg8::SplitOrder S2{F.vcu, 4};
          pg8::EpiPartial E2{(float*)(ws + WS_PART), 4};
          pg8::gemm_phase<pg8::EpiPartial, pg8::SplitOrder, GC2, true, true>(F.lds, g2, S2, E2); }
        GRID_BAR();
    }
    PH(13) for (int rep = 0; rep <= (int)REP(13); ++rep) norm_pass<2, 4, false, (layer == 0)>(F, layer, layer, 2048);
    GRID_BAR();
    PH(14) { using GC = pg8::Geo<D, D, D, 30, 0, 1 << 20, 0>; pg8::Gemm<GC> g{XN, (const bf16_t*)(ar + AR_W1), nullptr}; pg8::StaticOrder S; S.init(M, DFF, F.G, (int)blockIdx.x);
      pg8::EpiBf16<1> E{(bf16_t*)(ws + WS_H), DFF};
      pg8::gemm_phase<pg8::EpiBf16<1>, pg8::StaticOrder, GC, true, true>(F.lds, g, S, E);
          if (REP(14)) { pg8::EpiNull<true> EN; pg8::gemm_phase<pg8::EpiNull<true>, pg8::StaticOrder, GC, true, true>(F.lds, g, S, EN); } }
    GRID_BAR();
    PH(15) { using GC = pg8::Geo<DFF, DFF, DFF, 30, 0, 1 << 20, 0>; pg8::Gemm<GC> g{(const bf16_t*)(ws + WS_H), (const bf16_t*)(ar + AR_W2), nullptr}; pg8::StaticOrder S; S.init(MP, D, F.G, (int)blockIdx.x);
      pg8::EpiRes E{F.out, modl, 5120, F.out};
      for (int xb = 0; xb < EXTRA_BARS; ++xb) GRID_BAR();
      pg8::gemm_phase<pg8::EpiRes, pg8::StaticOrder, GC, true, true>(F.lds, g, S, E);
      if (REP(15)) { pg8::EpiNull<false> EN; pg8::gemm_phase<pg8::EpiNull<false>, pg8::StaticOrder, GC, true, true>(F.lds, g, S, EN); }
      using GC2 = pg8::Geo<DFF, DFF, 256, 30, 0, 1 << 20, 0, true>; pg8::Gemm<GC2> g2{(const bf16_t*)(ws + WS_H), (const bf16_t*)(ar + AR_W2), nullptr}; pg8::SplitOrder S2{F.vcu, 16};
      pg8::EpiPartial E2{(float*)(ws + WS_PART), 16};
      pg8::gemm_phase<pg8::EpiPartial, pg8::SplitOrder, GC2, true, true>(F.lds, g2, S2, E2); }
    GRID_BAR();
}

__global__ void __launch_bounds__(NT, 2) fwd_kernel(Args args) {
    extern __shared__ __attribute__((aligned(16))) unsigned char lds[];
    Frame F;
    F.lds = (LAS unsigned char*)lds; F.MISC = (volatile LAS unsigned*)(F.lds + MISC_OFF);
    F.wave = __builtin_amdgcn_readfirstlane(threadIdx.x >> 6);
    F.G = gridDim.x; { const int bx = blockIdx.x; F.vcu = (F.G % 8 == 0) ? (bx % 8) * (F.G / 8) + bx / 8 : bx; }
    F.in = args.in; F.out = args.out; F.ws = args.ws;
    for (int u = threadIdx.x; u < (LDS_BYTES - LDSCTL_OFF) / 4; u += NT) ((LAS unsigned*)(F.lds + LDSCTL_OFF))[u] = 0u;
    __syncthreads();
    XcdBarrier bar = xcd_barrier_post((unsigned*)(F.ws + WS_CTL) + CW_BAR, F.MISC + 8);
    PH(0) prologue(F);
    GRID_BAR();
    PH(0) mod_phase(F);
    GRID_BAR();
    layer_body<0>(F, bar); layer_body<1>(F, bar); layer_body<2>(F, bar); layer_body<3>(F, bar);
    PH(16) norm_pass<3, 16>(F, 0, 3, 5120);
}

extern "C" void kernel_launch(void* const* d_in, const int* in_sizes, int n_in, void* d_out, int out_size, void* d_ws, size_t ws_size, hipStream_t stream) {
    static int grid = 0;
    if (grid == 0) {
        if (n_in != 38 || out_size != 28706816 || ws_size < WS_END) { fprintf(stderr, "kernel_launch: unexpected problem (n_in %d, out %d, ws %zu; need ws >= %zu)\n", n_in, out_size, ws_size, (size_t)WS_END); grid = -1; return; }
        int dev = 0, cus = 0, per_cu = 0;
        if (hipGetDevice(&dev) != hipSuccess || hipDeviceGetAttribute(&cus, hipDeviceAttributeMultiprocessorCount, dev) != hipSuccess) { grid = -1; return; }
        if (hipFuncSetAttribute((const void*)fwd_kernel, hipFuncAttributeMaxDynamicSharedMemorySize, LDS_BYTES) != hipSuccess) { fprintf(stderr, "kernel_launch: hipFuncSetAttribute failed\n"); grid = -1; return; }
        if (hipOccupancyMaxActiveBlocksPerMultiprocessor(&per_cu, (const void*)fwd_kernel, NT, LDS_BYTES) != hipSuccess || per_cu < 1) { fprintf(stderr, "kernel_launch: occupancy query says %d\n", per_cu); per_cu = 1; }
        (void)hipGetLastError();
        grid = cus;
    }
    if (grid < 0) return;
    (void)hipMemsetAsync((char*)d_ws + WS_CTL, 0, ZERO_BYTES, stream);
    Args a{};
    for (int i = 0; i < 38; ++i) a.in[i] = (const float*)d_in[i];
    a.out = (float*)d_out; a.ws = (unsigned char*)d_ws;
    void* kargs[] = {&a};
    hipError_t e = hipLaunchCooperativeKernel((const void*)fwd_kernel, dim3(grid), dim3(NT), kargs, LDS_BYTES, stream);
    if (e != hipSuccess) fprintf(stderr, "kernel_launch: cooperative launch failed: %s (grid %d)\n", hipGetErrorString(e), grid);
}
```

```cpp
#include <hip/hip_runtime.h>
#include <cstdio>
#include <cstdint>

#define LAS __attribute__((address_space(3)))
#define GAS __attribute__((address_space(1)))
typedef unsigned short bf16_t;
typedef short bf16x8 __attribute__((ext_vector_type(8)));
typedef float f32x4 __attribute__((ext_vector_type(4)));
typedef float f32x2 __attribute__((ext_vector_type(2)));
typedef unsigned u32x4 __attribute__((ext_vector_type(4)));
typedef unsigned u32x2 __attribute__((ext_vector_type(2)));

#ifndef LOCAL_SKIP
#define LOCAL_SKIP 0
#endif
constexpr int D = 1024, MP = 16384, MS = 1024, M = MP + MS, NSEQ = 33, DFF = 4096, ABIN = 3584;
constexpr int NCHUNK = 288;
constexpr int SLOT_E = 4 * 8192 + 4 * 16384;
constexpr float NORM_EPS = 1e-6f, RW_LN_EPS = 64e-5f;

constexpr size_t MiB = 1u << 20;
constexpr size_t WS_CTL = 0, WS_MOD = 1 * MiB, ZERO_BYTES = 65536;
constexpr size_t WS_ROPE = 5 * MiB;
constexpr size_t WS_ARENA = 10 * MiB;
constexpr size_t AR_W1 = 0, AR_W2 = 8 * MiB, AR_WIN = 16 * MiB, AR_WOUT = 23 * MiB, AR_WC1 = 16 * MiB, AR_WC2 = 32 * MiB, AR_WO = 34 * MiB;
constexpr size_t WS_VFIRST = 46 * MiB;
constexpr size_t WS_XN0 = 80 * MiB, WS_XN = WS_XN0 + 2048;
constexpr size_t WS_PREVS = 115 * MiB;
constexpr size_t WS_R1 = 118 * MiB;
constexpr size_t WS_Z = WS_R1, WS_STATE = WS_R1 + 120 * MiB, WS_DEC = WS_R1 + 174 * MiB;
constexpr size_t WS_H = WS_R1;
constexpr size_t WS_RKV = WS_R1, WS_LO = WS_R1 + 102 * MiB, WS_WLOG = WS_R1 + 136 * MiB, WS_G = WS_R1 + 170 * MiB;
constexpr size_t WS_TST = WS_R1 + 102 * MiB;
constexpr size_t WS_REC = WS_R1 + 204 * MiB, WS_BON = WS_R1 + 269 * MiB;
constexpr int REC_B = 16640;
constexpr size_t WS_XMIX = WS_R1 + 168 * MiB;
constexpr size_t WS_PART = WS_R1 + 136 * MiB;
constexpr size_t WS_END = WS_R1 + 271 * MiB;

__device__ const double ROPE_REV[32] = {0.15915494309189535, 0.11934937021124886, 0.089499401608891013, 0.067115083005227255, 0.050329212104487035, 0.037741584717419771, 0.028302195830623399, 0.02122365276477766, 0.015915494309189534, 0.011934937021124886, 0.0089499401608891024, 0.0067115083005227253, 0.0050329212104487037, 0.0037741584717419772, 0.0028302195830623399, 0.0021223652764777662, 0.0015915494309189536, 0.0011934937021124885, 0.00089499401608891024, 0.0006711508300522726, 0.00050329212104487033, 0.00037741584717419774, 0.00028302195830623395, 0.00021223652764777661, 0.00015915494309189535, 0.00011934937021124886, 8.9499401608891018e-05, 6.7115083005227254e-05, 5.0329212104487035e-05, 3.7741584717419777e-05, 2.8302195830623396e-05, 2.1223652764777659e-05};

__device__ __forceinline__ unsigned f2bf(float f) { unsigned u = __builtin_bit_cast(unsigned, f); return (u + 0x7fffu + ((u >> 16) & 1u)) >> 16; }
typedef __bf16 bf16x2_t __attribute__((ext_vector_type(2)));
__device__ __forceinline__ unsigned pk2(float lo, float hi) { const f32x2 v = {lo, hi}; const bf16x2_t b = __builtin_convertvector(v, bf16x2_t); return __builtin_bit_cast(unsigned, b); }
__device__ __forceinline__ float bf2f(unsigned short b) { return __builtin_bit_cast(float, (unsigned)b << 16); }
__device__ __forceinline__ float bflo(unsigned w) { return __builtin_bit_cast(float, w << 16); }
__device__ __forceinline__ float bfhi(unsigned w) { return __builtin_bit_cast(float, w & 0xffff0000u); }
__device__ __forceinline__ float sigmoidf_(float x) { return 1.f / (1.f + __expf(-x)); }
__device__ __forceinline__ float siluf_(float x) { return x / (1.f + __expf(-x)); }
__device__ __forceinline__ float wave_sum(float v) {
#pragma unroll
    for (int o = 1; o < 64; o <<= 1) v += __shfl_xor(v, o);
    return v;
}
__device__ __forceinline__ int otid() { int t = threadIdx.x; asm volatile("" : "+v"(t)); return t; }
__device__ __forceinline__ int seq_of_row(int r) { return r < MP ? 0 : 1 + ((r - MP) >> 5); }
#define LDS_WAIT() asm volatile("s_waitcnt lgkmcnt(0)" ::: "memory")
#define VM_WAIT() asm volatile("s_waitcnt vmcnt(0)" ::: "memory")

namespace pg8 {
constexpr int BM = 256, BK = 64, HALF = 128, HTB = HALF * BK * 2, STAGE_BYTES = 8 * HTB, NXCD = 8, WGM = 8;
__host__ __device__ __forceinline__ int lds_byte(int r, int c) { const int st = (r >> 4) * 2 + (c >> 5), rr = r & 15, cc = c & 31, ob = rr * 64 + cc * 2; return st * 1024 + (ob ^ (((ob >> 9) & 1) << 5)); }
__host__ __device__ __forceinline__ void stage_rc(int b, int& R, int& C) { const int st = b / 1024, sb = b % 1024, swz = sb ^ (((sb >> 9) & 1) << 5); R = (st >> 1) * 16 + swz / 64; C = (st & 1) * 32 + (swz % 64) / 2; }
__host__ __device__ __forceinline__ int perm32(int rho) { const int n = rho >> 4, i = rho & 15; return 8 * (i >> 2) + 4 * n + (i & 3); }

struct Unit { int pm, pn, ks; };
template <int LDA_, int LDB_, int K_, int GSHIFT_, int GSTRIDE_, int KSPLIT_, int DELTAP_, bool SPLIT_ = false> struct Geo {
    static constexpr int LDA = LDA_, LDB = LDB_, K = K_, GSHIFT = GSHIFT_, GSTRIDE = GSTRIDE_, KSPLIT = KSPLIT_, DELTAP = DELTAP_; static constexpr bool SPLIT = SPLIT_;
};
template <class GC> struct Gemm {
    const bf16_t* A; const bf16_t* Bt; const bf16_t* A2s;
    __device__ __forceinline__ const char* a_base(const Unit& u) const { return (const char*)(A + (size_t)u.pm * BM * GC::LDA + (size_t)(u.pn >> GC::GSHIFT) * GC::GSTRIDE + (GC::SPLIT ? (size_t)u.ks * GC::K : 0)); }
    __device__ __forceinline__ const char* b_base(const Unit& u) const { return (const char*)(Bt + (size_t)u.pn * BM * GC::LDB + (GC::SPLIT ? (size_t)u.ks * GC::K : 0)); }
    __device__ __forceinline__ long a_delta(const Unit& u) const {
        if constexpr (GC::KSPLIT >= GC::K / BK) return 0;
        else { if (u.pm < 64) return (long)GC::DELTAP;
            return (long)((const char*)(A2s + (size_t)(u.pm - 64) * BM * GC::LDA) - a_base(u)) - (long)GC::KSPLIT * BK * 2; }
    }
};
struct StaticOrder {
    int nM, nN, nwg, G, c;
    __host__ __device__ void init(int M_, int N_, int G_, int c_) { nM = M_ / BM; nN = N_ / BM; nwg = nM * nN; G = G_; c = c_; }
    __host__ __device__ bool next(int i, Unit& u) const {
        const long L = (long)i * G + c; if (L >= nwg) return false;
        int wgid = (int)L; { const int q = nwg / NXCD, r = nwg % NXCD, xcd = wgid % NXCD, off = wgid / NXCD; wgid = (xcd < r ? xcd * (q + 1) : r * (q + 1) + (xcd - r) * q) + off; }
        const int nig = WGM * nN, gid = wgid / nig, fm = gid * WGM, gsz = (nM - fm) < WGM ? (nM - fm) : WGM;
        u.pm = fm + ((wgid % nig) % gsz); u.pn = (wgid % nig) / gsz; u.ks = 0; return true;
    }
};
__device__ __forceinline__ unsigned cvt_pk_bf16(float lo, float hi) { return pk2(lo, hi); }

template <class Epi, class Sched, class GC, bool ALIGN_EPI = false, bool SP2 = false>
__device__ __forceinline__ void gemm_phase(LAS unsigned char* lds, const Gemm<GC> g, const Sched& S, const Epi& E) {
    const int tid = otid(), wid = __builtin_amdgcn_readfirstlane(tid >> 6), lane = tid & 63, wr = wid >> 2, wc = wid & 3, fr = lane & 15, fq = lane >> 4;
    constexpr int K = GC::K, nt = K / BK, ksplit = GC::KSPLIT;
    unsigned voffA[2], voffB[2];
#pragma unroll
    for (int i = 0; i < 2; ++i) { int R, C; stage_rc(tid * 16 + i * 8192, R, C); const int Rb = Epi::PERM ? ((R & ~31) + perm32(R & 31)) : R;
        voffA[i] = (unsigned)(R * GC::LDA + C) * 2u; voffB[i] = (unsigned)(Rb * GC::LDB + C) * 2u; }
    constexpr size_t kstep = (size_t)(BK * 2);
    constexpr size_t hstepA = (size_t)HALF * GC::LDA * 2, hstepB = (size_t)HALF * GC::LDB * 2;
    const unsigned ldsw = (unsigned)wid * 1024u;
    const int aoff = lds_byte(wr * 64 + fr, fq * 8), boff = lds_byte(wc * 32 + fr, fq * 8);
#define PG8_SA(b, h) (((b) * 2 + (h)) * HTB)
#define PG8_SB(b, h) ((4 + (b) * 2 + (h)) * HTB)
#define PG8_STAGE(bufoff, gbase, voff) do { _Pragma("unroll") for (int _i = 0; _i < 2; ++_i) \
        __builtin_amdgcn_global_load_lds((const unsigned*)((const char*)(gbase) + (voff)[_i]), (LAS unsigned*)(lds + (bufoff) + ldsw + _i * 8192), 16, 0, 0); } while (0)
#define PG8_LDA(dst, b, h) do { _Pragma("unroll") for (int m = 0; m < 4; ++m) _Pragma("unroll") for (int k = 0; k < 2; ++k) dst[m][k] = *(const LAS bf16x8*)(lds + PG8_SA(b, h) + aoff + m * 2048 + k * 1024); } while (0)
#define PG8_LDB(dst, b, h) do { _Pragma("unroll") for (int n = 0; n < 2; ++n) _Pragma("unroll") for (int k = 0; k < 2; ++k) dst[n][k] = *(const LAS bf16x8*)(lds + PG8_SB(b, h) + boff + n * 2048 + k * 1024); } while (0)
#define PG8_MMA(ai, bj, At, Bt) do { __builtin_amdgcn_s_setprio(1); _Pragma("unroll") for (int m = 0; m < 4; ++m) _Pragma("unroll") for (int n = 0; n < 2; ++n) _Pragma("unroll") for (int k = 0; k < 2; ++k) \
        acc[ai][bj][m][n] = __builtin_amdgcn_mfma_f32_16x16x32_bf16(Bt[n][k], At[m][k], acc[ai][bj][m][n], 0, 0, 0); __builtin_amdgcn_s_setprio(0); } while (0)
#define PG8_WAIT_V(n) asm volatile("s_waitcnt vmcnt(" #n ")" ::: "memory")
#define PG8_WAIT_L(n) asm volatile("s_waitcnt lgkmcnt(" #n ")" ::: "memory")
#define PG8_BAR __builtin_amdgcn_s_barrier()
#define PG8_SCHED __builtin_amdgcn_sched_barrier(0)
    Unit cur, nxt; int ui = 0;
    if (!S.next(0, cur)) return;
    f32x4 acc[2][2][4][2];
#pragma unroll
    for (int a = 0; a < 2; ++a)
#pragma unroll
        for (int b = 0; b < 2; ++b)
#pragma unroll
            for (int m = 0; m < 4; ++m)
#pragma unroll
                for (int n = 0; n < 2; ++n) acc[a][b][m][n] = (f32x4){0.f, 0.f, 0.f, 0.f};
    bf16x8 At[4][2], B0[2][2], B1[2][2];
    const char* cA = g.a_base(cur); const char* cB = g.b_base(cur); long cD = g.a_delta(cur);
    if constexpr (SP2) {
        PG8_STAGE(PG8_SB(0, 0), cB, voffB); PG8_STAGE(PG8_SB(0, 1), cB + hstepB, voffB); PG8_STAGE(PG8_SA(0, 0), cA, voffA); PG8_STAGE(PG8_SA(0, 1), cA + hstepA, voffA);
        if (wr == 1) PG8_BAR;
        PG8_WAIT_V(2); PG8_BAR;
        PG8_STAGE(PG8_SB(1, 0), cB + kstep, voffB); PG8_STAGE(PG8_SA(1, 0), cA + kstep, voffA); PG8_STAGE(PG8_SB(1, 1), cB + hstepB + kstep, voffB);
        PG8_WAIT_V(6); PG8_BAR;
    } else {
        PG8_STAGE(PG8_SB(0, 0), cB, voffB); PG8_STAGE(PG8_SA(0, 0), cA, voffA); PG8_STAGE(PG8_SB(0, 1), cB + hstepB, voffB); PG8_STAGE(PG8_SA(0, 1), cA + hstepA, voffA);
        if (wr == 1) PG8_BAR;
        PG8_WAIT_V(4); PG8_BAR;
        PG8_STAGE(PG8_SB(1, 0), cB + kstep, voffB); PG8_STAGE(PG8_SA(1, 0), cA + kstep, voffA); PG8_STAGE(PG8_SB(1, 1), cB + hstepB + kstep, voffB);
        PG8_WAIT_V(6); PG8_BAR;
    }
    for (;;) {
        const bool has_next = S.next(ui + 1, nxt);
        const char* nA = has_next ? g.a_base(nxt) : cA; const char* nB = has_next ? g.b_base(nxt) : cB;
        const long nD = has_next ? g.a_delta(nxt) : cD;
#pragma unroll 1
        for (int t = 0; t < nt; t += 2) {
            const bool last = (t == nt - 2);
            const char* a1 = cA + (size_t)(t + 1) * kstep + (t >= ksplit ? cD : 0);
            const char* a2 = last ? nA : cA + (size_t)(t + 2) * kstep + (t + 2 >= ksplit ? cD : 0); const char* b2 = last ? nB : cB + (size_t)(t + 2) * kstep;
            const char* a3 = a2 + kstep; const char* b3 = b2 + kstep;
            if constexpr (SP2) {
            PG8_LDB(B0, 0, 0); PG8_LDB(B1, 0, 1); PG8_SCHED; PG8_LDA(At, 0, 0); PG8_STAGE(PG8_SA(1, 1), a1 + hstepA, voffA);
            PG8_WAIT_V(8); PG8_WAIT_L(0); PG8_BAR; PG8_MMA(0, 0, At, B0); PG8_MMA(0, 1, At, B1); PG8_BAR; PG8_SCHED;
            PG8_LDA(At, 0, 1); PG8_STAGE(PG8_SB(0, 0), b2, voffB); PG8_STAGE(PG8_SB(0, 1), b2 + hstepB, voffB); PG8_STAGE(PG8_SA(0, 0), a2, voffA);
            PG8_WAIT_V(8); PG8_WAIT_L(0); PG8_BAR; PG8_MMA(1, 0, At, B0); PG8_MMA(1, 1, At, B1); PG8_BAR; PG8_SCHED;
            PG8_LDB(B0, 1, 0); PG8_LDB(B1, 1, 1); PG8_SCHED; PG8_LDA(At, 1, 0); PG8_STAGE(PG8_SA(0, 1), a2 + hstepA, voffA);
            PG8_WAIT_V(8); PG8_WAIT_L(0); PG8_BAR; PG8_MMA(0, 0, At, B0); PG8_MMA(0, 1, At, B1); PG8_BAR; PG8_SCHED;
            PG8_LDA(At, 1, 1); PG8_STAGE(PG8_SB(1, 0), b3, voffB); PG8_STAGE(PG8_SB(1, 1), b3 + hstepB, voffB); PG8_STAGE(PG8_SA(1, 0), a3, voffA);
            PG8_WAIT_V(8); PG8_WAIT_L(0); PG8_BAR; PG8_MMA(1, 0, At, B0); PG8_MMA(1, 1, At, B1); PG8_BAR; PG8_SCHED;
            } else {
            PG8_LDB(B0, 0, 0); PG8_SCHED; PG8_LDA(At, 0, 0); PG8_STAGE(PG8_SA(1, 1), a1 + hstepA, voffA);
            PG8_WAIT_L(8); PG8_BAR; PG8_WAIT_L(0); PG8_MMA(0, 0, At, B0); PG8_BAR; PG8_SCHED;
            PG8_LDB(B1, 0, 1); PG8_STAGE(PG8_SB(0, 0), b2, voffB);
            PG8_BAR; PG8_WAIT_L(0); PG8_MMA(0, 1, At, B1); PG8_BAR;
            PG8_LDA(At, 0, 1); PG8_STAGE(PG8_SA(0, 0), a2, voffA);
            PG8_BAR; PG8_WAIT_L(0); PG8_MMA(1, 0, At, B0); PG8_BAR; PG8_SCHED;
            PG8_STAGE(PG8_SB(0, 1), b2 + hstepB, voffB);
            PG8_WAIT_V(6); PG8_BAR; PG8_MMA(1, 1, At, B1); PG8_BAR;
            PG8_LDB(B0, 1, 0); PG8_SCHED; PG8_LDA(At, 1, 0); PG8_STAGE(PG8_SA(0, 1), a2 + hstepA, voffA);
            PG8_WAIT_L(8); PG8_BAR; PG8_WAIT_L(0); PG8_MMA(0, 0, At, B0); PG8_BAR; PG8_SCHED;
            PG8_LDB(B1, 1, 1); PG8_STAGE(PG8_SB(1, 0), b3, voffB);
            PG8_BAR; PG8_WAIT_L(0); PG8_MMA(0, 1, At, B1); PG8_BAR;
            PG8_LDA(At, 1, 1); PG8_STAGE(PG8_SA(1, 0), a3, voffA);
            PG8_BAR; PG8_WAIT_L(0); PG8_MMA(1, 0, At, B0); PG8_BAR; PG8_SCHED;
            PG8_STAGE(PG8_SB(1, 1), b3 + hstepB, voffB);
            PG8_WAIT_V(6); PG8_BAR; PG8_MMA(1, 1, At, B1); PG8_BAR;
            }
        }
        if constexpr (ALIGN_EPI) { if (wr == 0) PG8_BAR; }
        E(acc, cur, wr, wc, fr, fq);
        if (!has_next) break;
#pragma unroll
        for (int a = 0; a < 2; ++a)
#pragma unroll
            for (int b = 0; b < 2; ++b)
#pragma unroll
                for (int m = 0; m < 4; ++m)
#pragma unroll
                    for (int n = 0; n < 2; ++n) acc[a][b][m][n] = (f32x4){0.f, 0.f, 0.f, 0.f};
        cur = nxt; cA = nA; cB = nB; cD = nD; ++ui;
        if constexpr (ALIGN_EPI) { if (wr == 1) PG8_BAR; }
    }
    PG8_WAIT_V(0);
    if constexpr (!ALIGN_EPI) { if (wr == 0) PG8_BAR; }
    PG8_BAR;
#undef PG8_SA
#undef PG8_SB
#undef PG8_STAGE
#undef PG8_LDA
#undef PG8_LDB
#undef PG8_MMA
#undef PG8_WAIT_V
#undef PG8_WAIT_L
#undef PG8_BAR
#undef PG8_SCHED
}

__device__ __forceinline__ float act_apply(float v, int act) {
    if (act == 1) { const float r = v > 0.f ? v : 0.f; return r * r; }
    if (act == 2) { const float e = __expf(-2.f * fabsf(v)); const float t = (1.f - e) / (1.f + e); return v < 0.f ? -t : t; }
    if (act == 3) return 1.f / (1.f + __expf(-v));
    return v;
}
template <int ACT> __device__ __forceinline__ void store_tile_bf16(const f32x4 (&acc)[2][2][4][2], bf16_t* base, int ldc, int row0, int col0, bf16_t* base2, int ldc2, int col2) {
#pragma unroll
    for (int ai = 0; ai < 2; ++ai)
#pragma unroll
        for (int m = 0; m < 4; ++m) { const size_t r = (size_t)(row0 + ai * HALF + m * 16);
#pragma unroll
            for (int bj = 0; bj < 2; ++bj) { f32x4 v0 = acc[ai][bj][m][0], v1 = acc[ai][bj][m][1];
#pragma unroll
                for (int q = 0; q < 4; ++q) { v0[q] = act_apply(v0[q], ACT); v1[q] = act_apply(v1[q], ACT); }
                u32x4 w; w.x = cvt_pk_bf16(v0[0], v0[1]); w.y = cvt_pk_bf16(v0[2], v0[3]); w.z = cvt_pk_bf16(v1[0], v1[1]); w.w = cvt_pk_bf16(v1[2], v1[3]);
                *(u32x4*)(base + r * ldc + col0 + bj * HALF) = w;
                if (base2) *(u32x4*)(base2 + r * ldc2 + col2 + bj * HALF) = w; } }
}
template <int ACT> struct EpiBf16 {
    static constexpr bool PERM = true;
    bf16_t* O; int ldc;
    __device__ __forceinline__ void operator()(const f32x4 (&acc)[2][2][4][2], const Unit& u, int wr, int wc, int fr, int fq) const {
        store_tile_bf16<ACT>(acc, O, ldc, u.pm * BM + wr * 64 + fr, u.pn * BM + wc * 32 + 8 * fq, nullptr, 0, 0);
    }
};
struct EpiRkv {
    static constexpr bool PERM = true;
    bf16_t* RKV; bf16_t* LO; bf16_t* vf;
    __device__ __forceinline__ void operator()(const f32x4 (&acc)[2][2][4][2], const Unit& u, int wr, int wc, int fr, int fq) const {
        const int row0 = u.pm * BM + wr * 64 + fr, cin = wc * 32 + 8 * fq;
        if (u.pn < 12) { bf16_t* b2 = (u.pn >= 8) ? vf : nullptr; store_tile_bf16<0>(acc, RKV, 3072, row0, u.pn * BM + cin, b2, 1024, (u.pn - 8) * BM + cin); }
        else {
#pragma unroll
            for (int bj = 0; bj < 2; ++bj) { const int c = cin + bj * HALF; int dst = -1, act = 0;
                if (u.pn == 12) { if (c < 64) { dst = c; act = 2; } else if (c < 128) dst = 256 + (c - 64); else if (c < 160) dst = 512 + (c - 128); }
                else if (c < 160) { dst = 768 + c; act = 3; }
                if (dst >= 0) {
#pragma unroll
                    for (int ai = 0; ai < 2; ++ai)
#pragma unroll
                        for (int m = 0; m < 4; ++m) { const size_t r = (size_t)(row0 + ai * HALF + m * 16); f32x4 v0 = acc[ai][bj][m][0], v1 = acc[ai][bj][m][1];
#pragma unroll
                            for (int q = 0; q < 4; ++q) { v0[q] = act_apply(v0[q], act); v1[q] = act_apply(v1[q], act); }
                            u32x4 w; w.x = cvt_pk_bf16(v0[0], v0[1]); w.y = cvt_pk_bf16(v0[2], v0[3]); w.z = cvt_pk_bf16(v1[0], v1[1]); w.w = cvt_pk_bf16(v1[2], v1[3]);
                            *(u32x4*)(LO + r * 1024 + dst) = w; } } }
        }
    }
};
struct EpiRes {
    static constexpr bool PERM = false;
    float* X; const float* modl; int goff; const float* Xin;
    __device__ __forceinline__ void operator()(const f32x4 (&acc)[2][2][4][2], const Unit& u, int wr, int wc, int fr, int fq) const {
        const int col0 = u.pn * BM + wc * 32 + 4 * fq;
#pragma unroll
        for (int ai = 0; ai < 2; ++ai)
#pragma unroll
            for (int m = 0; m < 4; ++m) { const int r = u.pm * BM + ai * HALF + wr * 64 + m * 16 + fr; const float* gp = modl + (size_t)seq_of_row(r) * 6144 + goff + col0; float* xp = X + (size_t)r * D + col0; const float* xi = Xin + (size_t)r * D + col0;
#pragma unroll
                for (int bj = 0; bj < 2; ++bj)
#pragma unroll
                    for (int n = 0; n < 2; ++n) { const f32x4 gv = *(const f32x4*)(gp + bj * HALF + n * 16); f32x4 xv = *(const f32x4*)(xi + bj * HALF + n * 16);
                        xv = xv + gv * acc[ai][bj][m][n]; *(f32x4*)(xp + bj * HALF + n * 16) = xv; }
                asm volatile("" ::: "memory"); }
    }
};
struct EpiLora2 {
    static constexpr bool PERM = false;
    bf16_t* WLOG; bf16_t* Aout; bf16_t* G; bf16_t* RKV; const bf16_t* vf; const float* w0; const float* a0; const float* v0;
    template <int GRP> __device__ __forceinline__ void run(const f32x4 (&acc)[2][2][4][2], const Unit& u, int wr, int wc, int fr, int fq) const {
        const int col0 = (u.pn & 3) * BM + wc * 32 + 4 * fq;
#pragma unroll
        for (int ai = 0; ai < 2; ++ai)
#pragma unroll
            for (int m = 0; m < 4; ++m) { const size_t r = (size_t)(u.pm * BM + ai * HALF + wr * 64 + m * 16 + fr);
#pragma unroll
                for (int bj = 0; bj < 2; ++bj)
#pragma unroll
                    for (int n = 0; n < 2; ++n) { const int c = col0 + bj * HALF + n * 16; const f32x4 a = acc[ai][bj][m][n]; f32x4 o;
                        if constexpr (GRP == 0) { const f32x4 b = *(const f32x4*)(w0 + c);
#pragma unroll
                            for (int q = 0; q < 4; ++q) { const float x = -(b[q] + a[q]); const float sp = fmaxf(x, 0.f) + __logf(1.f + __expf(-fabsf(x))); o[q] = -__expf(-sp - 0.5f); }
                            u32x2 w; w.x = cvt_pk_bf16(o[0], o[1]); w.y = cvt_pk_bf16(o[2], o[3]); *(u32x2*)(WLOG + r * D + c) = w; }
                        else if constexpr (GRP == 1) { const f32x4 b = *(const f32x4*)(a0 + c);
#pragma unroll
                            for (int q = 0; q < 4; ++q) o[q] = 1.f / (1.f + __expf(-(b[q] + a[q])));
                            u32x2 w; w.x = cvt_pk_bf16(o[0], o[1]); w.y = cvt_pk_bf16(o[2], o[3]); *(u32x2*)(Aout + r * D + c) = w; }
                        else if constexpr (GRP == 2) { const f32x4 b = *(const f32x4*)(v0 + c); const u32x2 vv = *(const u32x2*)(RKV + r * 3072 + 2048 + c), ff = *(const u32x2*)(vf + r * D + c);
                            f32x4 v4, f4; v4[0] = bflo(vv.x); v4[1] = bfhi(vv.x); v4[2] = bflo(vv.y); v4[3] = bfhi(vv.y); f4[0] = bflo(ff.x); f4[1] = bfhi(ff.x); f4[2] = bflo(ff.y); f4[3] = bfhi(ff.y);
#pragma unroll
                            for (int q = 0; q < 4; ++q) { const float gte = 1.f / (1.f + __expf(-(b[q] + a[q]))); o[q] = v4[q] + (f4[q] - v4[q]) * gte; }
                            u32x2 w; w.x = cvt_pk_bf16(o[0], o[1]); w.y = cvt_pk_bf16(o[2], o[3]); *(u32x2*)(RKV + r * 3072 + 2048 + c) = w; }
                        else { u32x2 w; w.x = cvt_pk_bf16(a[0], a[1]); w.y = cvt_pk_bf16(a[2], a[3]); *(u32x2*)(G + r * D + c) = w; } }
                asm volatile("" ::: "memory"); }
    }
    __device__ __forceinline__ void operator()(const f32x4 (&acc)[2][2][4][2], const Unit& u, int wr, int wc, int fr, int fq) const {
        const int grp = u.pn >> 2;
        if (grp == 0) run<0>(acc, u, wr, wc, fr, fq);
        else if (grp == 1) run<1>(acc, u, wr, wc, fr, fq);
        else if (grp == 2) { if (vf != nullptr) run<2>(acc, u, wr, wc, fr, fq); }
        else run<3>(acc, u, wr, wc, fr, fq);
    }
};
struct SplitOrder {
    int c, splitk;
    __device__ bool next(int i, Unit& u) const { if (i != 0 || c >= 16 * splitk) return false; const int t = c / splitk; u.pm = 64 + (t >> 2); u.pn = t & 3; u.ks = c % splitk; return true; }
};
struct LoraOrder {
    int c;
    __device__ bool next(int i, Unit& u) const { const int idx = c - 48; if (i != 0 || idx < 0 || idx >= 136) return false; u.pm = idx >> 1; u.pn = 12 + (idx & 1); u.ks = 0; return true; }
};
struct EpiPartial {
    static constexpr bool PERM = false;
    float* PART; int splitk;
    __device__ __forceinline__ void operator()(const f32x4 (&acc)[2][2][4][2], const Unit& u, int wr, int wc, int fr, int fq) const {
        float* base = PART + ((size_t)(((u.pm - 64) * 4 + u.pn) * splitk + u.ks) << 16) + wc * 32 + 4 * fq;
#pragma unroll
        for (int ai = 0; ai < 2; ++ai)
#pragma unroll
            for (int m = 0; m < 4; ++m) { float* rp = base + (ai * HALF + wr * 64 + m * 16 + fr) * 256;
#pragma unroll
                for (int bj = 0; bj < 2; ++bj)
#pragma unroll
                    for (int n = 0; n < 2; ++n) *(f32x4*)(rp + bj * HALF + n * 16) = acc[ai][bj][m][n]; }
    }
};
template <bool PERM_> struct EpiNull {
    static constexpr bool PERM = PERM_;
    __device__ __forceinline__ void operator()(const f32x4 (&acc)[2][2][4][2], const Unit&, int, int, int, int) const {
#pragma unroll
        for (int a = 0; a < 2; ++a)
#pragma unroll
            for (int b = 0; b < 2; ++b)
#pragma unroll
                for (int m = 0; m < 4; ++m)
#pragma unroll
                    for (int n = 0; n < 2; ++n) asm volatile("" :: "v"(acc[a][b][m][n]));
    }
};
}

#define RLX_AGENT __ATOMIC_RELAXED, __HIP_MEMORY_SCOPE_AGENT
#define XB_TMO      128
#define XB_XCNT(j)  (256  + 64 * (j))
#define XB_XSUB(j)  (1280 + 64 * (j))
#define XB_XGEN(j)  (2304 + 64 * (j))
#define XB_TOP      3328
#define XB_TOPGEN   3392
#define XCD_BAR_WORDS 3456
#define XB_SPIN_CAP (1u << 24)
__device__ __forceinline__ unsigned xb_ld(unsigned* p)              { return __hip_atomic_load(p, __ATOMIC_RELAXED, __HIP_MEMORY_SCOPE_AGENT); }
__device__ __forceinline__ unsigned xb_add(unsigned* p, unsigned v) { return __hip_atomic_fetch_add(p, v, __ATOMIC_RELAXED, __HIP_MEMORY_SCOPE_AGENT); }
__device__ __forceinline__ unsigned xb_xcc_id() { return (unsigned)__builtin_amdgcn_s_getreg((3 << 11) | 20) & 0xFu; }
#define XB_SPIN(cond, bar) do { unsigned _sp = 0; while (cond) { __builtin_amdgcn_s_sleep(4); \
    if ((++_sp & 255u) == 0u) { if (xb_ld(&(bar)[XB_TMO])) break; if (_sp > XB_SPIN_CAP) { atomicAdd(&(bar)[XB_TMO], 1u); break; } } } } while (0)
struct XcdBarrier { unsigned* bar; unsigned x; volatile LAS unsigned* st; };
__device__ __forceinline__ XcdBarrier xcd_barrier_post(unsigned* bar, volatile LAS unsigned* st) {
    XcdBarrier b; b.bar = bar; b.x = xb_xcc_id(); b.st = st;
    if (threadIdx.x == 0) (void)xb_add(&bar[XB_XCNT(b.x)], 1u);
    return b;
}
__device__ __forceinline__ void xcd_barrier_complete(unsigned* bar, unsigned x, unsigned& nloc, unsigned& nx) {
    const unsigned G = gridDim.x * gridDim.y * gridDim.z;
    unsigned sum, cnt, mine, sp = 0u;
    for (;;) {
        sum = 0u; cnt = 0u; mine = 0u;
#pragma unroll
        for (unsigned j = 0; j < 16; ++j) { const unsigned c = xb_ld(&bar[XB_XCNT(j)]); sum += c; cnt += (c > 0u) ? 1u : 0u; mine = (j == x) ? c : mine; }
        if (sum == G) break;
        __builtin_amdgcn_s_sleep(1);
        if ((++sp & 255u) == 0u) { if (xb_ld(&bar[XB_TMO])) break; if (sp > XB_SPIN_CAP) { atomicAdd(&bar[XB_TMO], 1u); break; } }
    }
    nloc = mine > 0u ? mine : 1u; nx = cnt > 0u ? cnt : 1u;
}
__device__ __forceinline__ void xcd_barrier(const XcdBarrier& b) {
    asm volatile("s_waitcnt vmcnt(0)" ::: "memory");
    __syncthreads();
    if (threadIdx.x == 0) {
        unsigned* bar = b.bar;
        __builtin_amdgcn_s_waitcnt(0);
        unsigned nloc = b.st[0], nx = b.st[1];
        if (nloc == 0u) { xcd_barrier_complete(bar, b.x, nloc, nx); b.st[0] = nloc; b.st[1] = nx; }
        const unsigned gen = b.st[2];
        const unsigned old = xb_add(&bar[XB_XSUB(b.x)], 1u);
        if (old + 1u == (gen + 1u) * nloc) {
            __builtin_amdgcn_fence(__ATOMIC_RELEASE, "agent");
            asm volatile("s_waitcnt vmcnt(0)" ::: "memory");
            const unsigned og = xb_add(&bar[XB_TOP], 1u);
            if (og + 1u == (gen + 1u) * nx) xb_add(&bar[XB_TOPGEN], 1u);
            else XB_SPIN(xb_ld(&bar[XB_TOPGEN]) == gen, bar);
        } else {
            XB_SPIN(xb_ld(&bar[XB_TOPGEN]) == gen, bar);
        }
        __builtin_amdgcn_fence(__ATOMIC_ACQUIRE, "agent");
        asm volatile("s_waitcnt vmcnt(0)" ::: "memory");
        b.st[2] = gen + 1u;
    }
    __syncthreads();
}

constexpr int NWAVES = 8, NT = NWAVES * 64;
constexpr int RING_BYTES = 131072, LDSCTL_OFF = RING_BYTES, MISC_OFF = LDSCTL_OFF + 320, LDS_BYTES = 147456;
constexpr int CW_BAR = 4096;

struct Args { const float* in[38]; float* out; unsigned char* ws; };
struct Frame {
    LAS unsigned char* lds; volatile LAS unsigned* MISC;
    int wave, vcu, G;
    const float* const* in; float* out; unsigned char* ws;
};
enum { I_XP = 0, I_XS, I_SRET, I_SHG, I_SWKV, I_SSHIFT, I_CP, I_CS, I_MODW, I_MODB, I_NMIXG, I_NMLPG, I_FINALG, I_W1, I_W2, I_ABWIN, I_ABWOUT, I_HGLB, I_HGNG,
       I_MU, I_WRKV, I_RW0, I_RW1, I_RW2, I_RA0, I_RA1, I_RA2, I_RV0, I_RV1, I_RV2, I_RG1, I_RG2, I_RKK, I_RKA, I_RRK, I_RLNG, I_RLNB, I_RWOUT };
constexpr size_t O_Y = 0, O_RETP = 17825792, O_RETS = 17891328, O_HGP = 19988480, O_HGS = 20119552, O_WKVP = 24313856, O_WKVS = 24444928, O_SHP = 28639232, O_SHS = 28641280;

__device__ __forceinline__ void transpose_item(const float* W, int N, bf16_t* WT, int ldt, int row_off, int col_off, const float* mu, int mode, LAS float* scr, int item, int lane) {
    const int nblk = N / 32, kb = item / nblk, nb = item % nblk, k0 = 64 * kb, n0 = 32 * nb;
#pragma unroll 8
    for (int i = 0; i < 32; ++i) { const int kk = 2 * i + (lane >> 5); float s = 1.f; if (mode == 1) s = 1.f - mu[k0 + kk]; else if (mode == 2) s = mu[k0 + kk];
        scr[kk * 33 + (lane & 31)] = W[(size_t)(k0 + kk) * N + n0 + (lane & 31)] * s; }
    LDS_WAIT(); asm volatile("" ::: "memory");
    const int c = lane & 7;
#pragma unroll
    for (int j = 0; j < 4; ++j) { const int n = (lane >> 3) + 8 * j; const LAS float* s = scr + (8 * c) * 33 + n;
        u32x4 o; o.x = pk2(s[0 * 33], s[1 * 33]); o.y = pk2(s[2 * 33], s[3 * 33]); o.z = pk2(s[4 * 33], s[5 * 33]); o.w = pk2(s[6 * 33], s[7 * 33]);
        *(u32x4*)(WT + (size_t)(row_off + n0 + n) * ldt + col_off + k0 + 8 * c) = o; }
    LDS_WAIT(); asm volatile("" ::: "memory");
}
__device__ __forceinline__ void convert_layer_weights(Frame& F, int layer) {
    const int tid = otid(); const int lane = tid & 63; (void)lane;
    LAS float* scr = (LAS float*)(F.lds + F.wave * 16384);
    const int gw = F.vcu * NWAVES + F.wave, NGW = F.G * NWAVES;
    unsigned char* ar = F.ws + WS_ARENA;
    const int m = layer >> 1;
    constexpr int I_1 = (D / 64) * (DFF / 32), I_2 = (DFF / 64) * (D / 32);
    const float* w1 = F.in[I_W1] + (size_t)layer * D * DFF; const float* w2 = F.in[I_W2] + (size_t)layer * DFF * D;
    if ((layer & 1) == 0) {
        constexpr int I_IN = (D / 64) * (ABIN / 32), I_OUT = (D / 64) * (D / 32), NI = I_1 + I_2 + I_IN + I_OUT;
        const float* win = F.in[I_ABWIN] + (size_t)m * D * ABIN; const float* wout = F.in[I_ABWOUT] + (size_t)m * D * D;
        for (int it = gw; it < NI; it += NGW) { int r = it;
            if (r < I_1) { transpose_item(w1, DFF, (bf16_t*)(ar + AR_W1), D, 0, 0, nullptr, 0, scr, r, lane); continue; } r -= I_1;
            if (r < I_2) { transpose_item(w2, D, (bf16_t*)(ar + AR_W2), DFF, 0, 0, nullptr, 0, scr, r, lane); continue; } r -= I_2;
            if (r < I_IN) { transpose_item(win, ABIN, (bf16_t*)(ar + AR_WIN), D, 0, 0, nullptr, 0, scr, r, lane); continue; } r -= I_IN;
            transpose_item(wout, D, (bf16_t*)(ar + AR_WOUT), D, 0, 0, nullptr, 0, scr, r, lane); }
    } else {
        constexpr int I_P = (D / 64) * (D / 32), NI = I_1 + I_2 + 4 * I_P;
        const float* mu = F.in[I_MU] + (size_t)m * 6 * D; const float* wrkv = F.in[I_WRKV] + (size_t)m * 3 * D * D; const float* wo = F.in[I_RWOUT] + (size_t)m * D * D;
        bf16_t* wc1 = (bf16_t*)(ar + AR_WC1);
        for (int it = gw; it < NI; it += NGW) { int r = it;
            if (r < I_1) { transpose_item(w1, DFF, (bf16_t*)(ar + AR_W1), D, 0, 0, nullptr, 0, scr, r, lane); continue; } r -= I_1;
            if (r < I_2) { transpose_item(w2, D, (bf16_t*)(ar + AR_W2), DFF, 0, 0, nullptr, 0, scr, r, lane); continue; } r -= I_2;
            if (r < 3 * I_P) { const int p = r / I_P;
                transpose_item(wrkv + (size_t)p * D * D, D, wc1, 2048, p * D, 0, nullptr, 0, scr, r % I_P, lane); continue; } r -= 3 * I_P;
            transpose_item(wo, D, (bf16_t*)(ar + AR_WO), D, 0, 0, nullptr, 0, scr, r, lane); }
        const int gt = F.vcu * NT + tid, NG = F.G * NT;
        const float* lw1 = F.in[I_RW1] + (size_t)m * D * 64; const float* la1 = F.in[I_RA1] + (size_t)m * D * 64; const float* lv1 = F.in[I_RV1]; const float* lg1 = F.in[I_RG1] + (size_t)m * D * 160;
        for (int idx = gt; idx < 512 * 2048; idx += NG) { const int n = idx >> 11, k = idx & 2047, kk = k & 1023, nn = n & 255;
            const float* src = nullptr; int ns = 0, mi = 0, nc = 0;
            if (n < 256) { if (nn < 64) { src = lw1; ns = 64; mi = 1; nc = nn; } else if (nn < 128) { src = la1; ns = 64; mi = 4; nc = nn - 64; } else if (nn < 160 && m == 1) { src = lv1; ns = 32; mi = 3; nc = nn - 128; } }
            else if (nn < 160) { src = lg1; ns = 160; mi = 5; nc = nn; }
            float v = 0.f; if (src) { const float muv = mu[mi * D + kk]; v = src[(size_t)kk * ns + nc] * (k < 1024 ? 1.f - muv : muv); }
            wc1[(size_t)(3072 + n) * 2048 + k] = (bf16_t)f2bf(v); }
        bf16_t* wc2 = (bf16_t*)(ar + AR_WC2);
        const float* lw2 = F.in[I_RW2] + (size_t)m * 64 * D; const float* la2 = F.in[I_RA2] + (size_t)m * 64 * D; const float* lv2 = F.in[I_RV2]; const float* lg2 = F.in[I_RG2] + (size_t)m * 160 * D;
        for (int idx = gt; idx < 4096 * 256; idx += NG) { const int k = idx >> 12, n = idx & 4095, g = n >> 10, nn = n & 1023;
            const float* src = (g == 0) ? lw2 : (g == 1) ? la2 : (g == 2) ? lv2 : lg2; const int ks = (g == 0 || g == 1) ? 64 : (g == 2 ? 32 : 160);
            float v = 0.f; if (k < ks && !(g == 2 && m == 0)) v = src[(size_t)k * D + nn];
            wc2[(size_t)n * 256 + k] = (bf16_t)f2bf(v); }
    }
}

__device__ __forceinline__ void mod_phase(Frame& F) {
    const int tid = otid(); const int lane = tid & 63;
    const float* __restrict__ SC = (const float*)(F.ws + WS_MOD + 3584 * 1024);
    float* MOD = (float*)(F.ws + WS_MOD);
    LAS float* red = (LAS float*)F.lds;
    for (int task = F.vcu; task < 4 * 96; task += F.G) { const int l = task / 96, n = (task % 96) * 64 + lane, ks = F.wave;
        const float* w = F.in[I_MODW] + ((size_t)l * D + ks * 128) * 6144 + n;
        float acc[NSEQ];
#pragma unroll
        for (int s = 0; s < NSEQ; ++s) acc[s] = 0.f;
        for (int k = 0; k < 128; k += 4) { const float w0 = w[(size_t)k * 6144], w1 = w[(size_t)(k + 1) * 6144], w2 = w[(size_t)(k + 2) * 6144], w3 = w[(size_t)(k + 3) * 6144];
#pragma unroll
            for (int s = 0; s < NSEQ; ++s) { const f32x4 c4 = *(const f32x4*)(SC + s * D + ks * 128 + k); acc[s] += (c4[0] * w0 + c4[1] * w1) + (c4[2] * w2 + c4[3] * w3); } }
        __syncthreads();
#pragma unroll
        for (int s = 0; s < NSEQ; ++s) red[(F.wave * NSEQ + s) * 64 + lane] = acc[s];
        __syncthreads();
        for (int i = tid; i < NSEQ * 64; i += NT) { const int s = i >> 6, c = i & 63; float t = F.in[I_MODB][l * 6144 + (task % 96) * 64 + c];
#pragma unroll
            for (int q = 0; q < 8; ++q) t += red[(q * NSEQ + s) * 64 + c];
            MOD[((size_t)l * NSEQ + s) * 6144 + (task % 96) * 64 + c] = t; }
    }
    __syncthreads();
}

__device__ __forceinline__ void prologue(Frame& F) {
    const int tid = otid(); const int lane = tid & 63; (void)lane;
    const int gt = F.vcu * NT + tid, NG = F.G * NT;
    { f32x2* tab = (f32x2*)(F.ws + WS_ROPE);
      for (int i = gt; i < 16384 * 32; i += NG) { const int p = i >> 5, d = i & 31; double rev = (double)p * ROPE_REV[d]; rev -= floor(rev); const float fr = (float)rev;
          tab[i] = (f32x2){__builtin_amdgcn_cosf(fr), __builtin_amdgcn_sinf(fr)}; } }
    { unsigned* z = (unsigned*)(F.ws + WS_XN0); for (int i = gt; i < 512; i += NG) z[i] = 0u; }
    { float* SC = (float*)(F.ws + WS_MOD + 3584 * 1024);
      for (int i = gt; i < NSEQ * D; i += NG) { const int s = i >> 10, k = i & 1023; const float c = (s == 0) ? F.in[I_CP][k] : F.in[I_CS][(size_t)(s - 1) * D + k]; SC[i] = siluf_(c); } }
    convert_layer_weights(F, 0);
}

template <int MODE> __device__ __forceinline__ void norm_row(Frame& F, int layer, int r, f32x4 (&v)[4], const float* MOD, const float* gvec, int lane, f32x4 (&ho)[4]) {
    const int m = layer >> 1; const int shoff = (MODE == 2) ? 3072 : 0, scoff = (MODE == 2) ? 4096 : 1024;
    bf16_t* XN = (bf16_t*)(F.ws + WS_XN); bf16_t* PREVS = (bf16_t*)(F.ws + WS_PREVS);
    float* xrow = F.out + (size_t)r * D; float s2 = 0.f;
#pragma unroll
    for (int j = 0; j < 4; ++j) s2 += (v[j].x * v[j].x + v[j].y * v[j].y) + (v[j].z * v[j].z + v[j].w * v[j].w);
    const float rstd = 1.f / sqrtf(wave_sum(s2) * (1.f / D) + NORM_EPS);
    const int seq = seq_of_row(r); const float* mp = MOD + (size_t)seq * 6144;
#pragma unroll
    for (int j = 0; j < 4; ++j) { const int c = 4 * lane + 256 * j; const f32x4 g4 = *(const f32x4*)(gvec + c); f32x4 o = v[j] * rstd * g4;
        if (MODE == 3) { *((f32x4*)xrow + lane + 64 * j) = o; continue; }
        const f32x4 sc = *(const f32x4*)(mp + scoff + c), sh = *(const f32x4*)(mp + shoff + c);
        o = o * (1.f + sc) + sh; ho[j] = o;
        const unsigned long long pk = (unsigned long long)pk2(o.x, o.y) | ((unsigned long long)pk2(o.z, o.w) << 32);
        *(unsigned long long*)(XN + (size_t)r * D + c) = pk;
        if (MODE == 1) {
            if (r >= MP) { const int t = (r - MP) & 31; if (t < 31) *(unsigned long long*)(PREVS + (size_t)(r - MP + 1) * D + c) = pk;
                else *(f32x4*)(F.out + O_SHS + ((size_t)m * 32 + ((r - MP) >> 5)) * D + c) = o;
                if (t == 0) { const f32x4 ss = *(const f32x4*)(F.in[I_SSHIFT] + ((size_t)m * 32 + ((r - MP) >> 5)) * D + c);
                    *(unsigned long long*)(PREVS + (size_t)(r - MP) * D + c) = (unsigned long long)pk2(ss.x, ss.y) | ((unsigned long long)pk2(ss.z, ss.w) << 32); } }
            else if (r == MP - 1) *(f32x4*)(F.out + O_SHP + (size_t)m * D + c) = o;
        } }
}
__device__ __forceinline__ void hmix_calc(const float* mp, const float* gvec, const f32x4 (&v)[4], int lane, f32x4 (&h)[4]) {
    float s2 = 0.f;
#pragma unroll
    for (int j = 0; j < 4; ++j) s2 += (v[j].x * v[j].x + v[j].y * v[j].y) + (v[j].z * v[j].z + v[j].w * v[j].w);
    const float rstd = 1.f / sqrtf(wave_sum(s2) * (1.f / D) + NORM_EPS);
#pragma unroll
    for (int j = 0; j < 4; ++j) { const int c = 4 * lane + 256 * j; const f32x4 g4 = *(const f32x4*)(gvec + c), sc = *(const f32x4*)(mp + 1024 + c), sh = *(const f32x4*)(mp + c); h[j] = v[j] * rstd * g4 * (1.f + sc) + sh; }
}
__device__ __forceinline__ void write_mixes(Frame& F, int m, int r, const f32x4 (&h)[4], const f32x4 (&p)[4], int lane) {
    bf16_t* XM = (bf16_t*)(F.ws + WS_XMIX); const float* mu = F.in[I_MU] + (size_t)m * 6 * D;
#pragma unroll
    for (int j = 0; j < 4; ++j) { const int c = 4 * lane + 256 * j; const f32x4 d = p[j] - h[j];
#pragma unroll
        for (int q = 0; q < 3; ++q) { const f32x4 mv = *(const f32x4*)(mu + (q == 0 ? 0 : (q == 1 ? 2 : 3)) * D + c); const f32x4 x = h[j] + d * mv;
            *(unsigned long long*)(XM + ((size_t)q * M + r) * D + c) = (unsigned long long)pk2(x.x, x.y) | ((unsigned long long)pk2(x.z, x.w) << 32); } }
}
template <int MODE, int PEND = 0, bool FIRSTP = false, bool FIRSTS = false> __device__ __forceinline__ void norm_pass(Frame& F, int layer, int player = 0, int pgoff = 0) {
    const int tid = otid(); const int lane = tid & 63;
    const int gw = F.vcu * NWAVES + F.wave, NGW = F.G * NWAVES;
    const float* MOD = (const float*)(F.ws + WS_MOD) + (size_t)layer * NSEQ * 6144;
    const float* gvec = (MODE == 3) ? F.in[I_FINALG] : (MODE == 2 ? F.in[I_NMLPG] + layer * D : F.in[I_NMIXG] + layer * D);
    LAS float* xs = (LAS float*)F.lds;
    const int m = layer >> 1; const int r0s = MP + 4 * F.vcu;
    const float* gmod = (const float*)(F.ws + WS_MOD) + (size_t)player * NSEQ * 6144 + pgoff;
    if constexpr (MODE == 1) {
        static_assert(PEND > 0, "the RWKV mix norm always follows an MLP-down GEMM");
        if (F.vcu < 32) { const int sq = F.vcu, rbase = MP + 32 * sq; const float* mp = MOD + (size_t)(1 + sq) * 6144;
            __syncthreads();
#pragma unroll 2
            for (int q = 0; q < 16; ++q) { const int idx = tid + q * NT, rr = idx >> 8, c4 = (idx & 255) * 4; const int r = rbase + rr;
                const int pn = c4 >> 8; const float* pb = (const float*)(F.ws + WS_PART) + ((size_t)((((r >> 8) - 64) * 4 + pn) * PEND) << 16) + (r & 255) * 256 + (c4 & 255);
                f32x4 acc = (f32x4){0.f, 0.f, 0.f, 0.f};
#pragma unroll
                for (int ks = 0; ks < PEND; ++ks) acc += *(const f32x4*)(pb + ((size_t)ks << 16));
                const f32x4 g4 = *(const f32x4*)(gmod + (size_t)(1 + sq) * 6144 + c4); f32x4 x4 = *(const f32x4*)(F.out + (size_t)r * D + c4);
                x4 = x4 + g4 * acc; *(f32x4*)(F.out + (size_t)r * D + c4) = x4; *(LAS f32x4*)(xs + rr * 1024 + c4) = x4; }
            __syncthreads();
            for (int rr = F.wave; rr < 32; rr += NWAVES) { const int r = rbase + rr; f32x4 v[4], ho[4], hp[4];
#pragma unroll
                for (int j = 0; j < 4; ++j) v[j] = *(const LAS f32x4*)(xs + rr * 1024 + 4 * lane + 256 * j);
                norm_row<MODE>(F, layer, r, v, MOD, gvec, lane, ho);
                if (rr == 0) {
#pragma unroll
                    for (int j = 0; j < 4; ++j) hp[j] = *((const f32x4*)(F.in[I_SSHIFT] + ((size_t)m * 32 + sq) * D) + lane + 64 * j);
                } else { f32x4 pv[4];
#pragma unroll
                    for (int j = 0; j < 4; ++j) pv[j] = *(const LAS f32x4*)(xs + (rr - 1) * 1024 + 4 * lane + 256 * j);
                    hmix_calc(mp, gvec, pv, lane, hp); }
                write_mixes(F, m, r, ho, hp, lane); }
            __syncthreads(); }
    } else if constexpr (PEND > 0) {
        __syncthreads();
#pragma unroll
        for (int q = 0; q < 2; ++q) { const int idx = tid + q * NT, rr = idx >> 8, c4 = (idx & 255) * 4; const int r = r0s + rr; if (4 * F.vcu + rr < MS) {
                const int pn = c4 >> 8; const float* pb = (const float*)(F.ws + WS_PART) + ((size_t)((((r >> 8) - 64) * 4 + pn) * PEND) << 16) + (r & 255) * 256 + (c4 & 255);
                f32x4 acc = (f32x4){0.f, 0.f, 0.f, 0.f};
#pragma unroll
                for (int ks = 0; ks < PEND; ++ks) acc += *(const f32x4*)(pb + ((size_t)ks << 16));
                const f32x4 g4 = *(const f32x4*)(gmod + (size_t)seq_of_row(r) * 6144 + c4); f32x4 x4 = FIRSTS ? *(const f32x4*)(F.in[I_XS] + (size_t)(r - MP) * D + c4) : *(const f32x4*)(F.out + (size_t)r * D + c4);
                x4 = x4 + g4 * acc; *(f32x4*)(F.out + (size_t)r * D + c4) = x4; *(LAS f32x4*)(xs + rr * 1024 + c4) = x4; } }
        __syncthreads();
    }
    for (int r = gw; r < MP; r += NGW) {
        const f32x4* xr = (const f32x4*)((FIRSTP ? F.in[I_XP] : F.out) + (size_t)r * D) + lane; f32x4 v[4], ho[4];
#pragma unroll
        for (int j = 0; j < 4; ++j) v[j] = xr[64 * j];
        if constexpr (MODE == 1) { f32x4 pv[4], hp[4];
#pragma unroll
            for (int j = 0; j < 4; ++j) pv[j] = (r > 0) ? *((const f32x4*)(F.out + (size_t)(r - 1) * D) + lane + 64 * j) : (f32x4){0.f, 0.f, 0.f, 0.f};
            norm_row<MODE>(F, layer, r, v, MOD, gvec, lane, ho);
            if (r > 0) hmix_calc(MOD, gvec, pv, lane, hp); else {
#pragma unroll
                for (int j = 0; j < 4; ++j) hp[j] = (f32x4){0.f, 0.f, 0.f, 0.f}; }
            write_mixes(F, m, r, ho, hp, lane);
        } else norm_row<MODE>(F, layer, r, v, MOD, gvec, lane, ho);
    }
    if constexpr (MODE != 1) {
        if (F.wave < 4 && 4 * F.vcu + F.wave < MS) { const int r = r0s + F.wave; f32x4 v[4], ho[4];
#pragma unroll
            for (int j = 0; j < 4; ++j) { if constexpr (PEND > 0) v[j] = *(const LAS f32x4*)(xs + F.wave * 1024 + 4 * lane + 256 * j); else v[j] = *((const f32x4*)(FIRSTS ? F.in[I_XS] + (size_t)(r - MP) * D : F.out + (size_t)r * D) + lane + 64 * j); }
            norm_row<MODE>(F, layer, r, v, MOD, gvec, lane, ho); } }
}

template <int MT, int NTT> __device__ __forceinline__ void wave_mm_nt(f32x4 (&acc)[MT][NTT], const LAS bf16_t* X, int ldx, const LAS bf16_t* Y, int ldy, int K, int fr, int fq) {
    for (int k0 = 0; k0 < K; k0 += 32) {
        bf16x8 xa[MT], yb[NTT];
#pragma unroll
        for (int i = 0; i < MT; ++i) xa[i] = *(const LAS bf16x8*)(X + (16 * i + fr) * ldx + k0 + 8 * fq);
#pragma unroll
        for (int j = 0; j < NTT; ++j) yb[j] = *(const LAS bf16x8*)(Y + (16 * j + fr) * ldy + k0 + 8 * fq);
#pragma unroll
        for (int i = 0; i < MT; ++i)
#pragma unroll
            for (int j = 0; j < NTT; ++j) acc[i][j] = __builtin_amdgcn_mfma_f32_16x16x32_bf16(yb[j], xa[i], acc[i][j], 0, 0, 0);
    }
}

constexpr int LQS = 0, LKS = 18432, LQG = 36864, LVT = 55296, LST = 73728, LPS = 108544, LRED = 117760, LBS = 118784;
__device__ __forceinline__ void chunk_geom(int c, int& r0, int& pos0) { if (c < 256) { r0 = 64 * c; pos0 = 64 * c; } else { r0 = MP + 32 * (c - 256); pos0 = 2048; } }

template <int L, bool HG, bool SUMMARY> __device__ __forceinline__ void ab_load(Frame& F, int layer, int c, int h) {
    const int tid = otid(); const int lane = tid & 63; (void)lane;
    const int m = layer >> 1; int r0, pos0; chunk_geom(c, r0, pos0);
    const bf16_t* Z = (const bf16_t*)(F.ws + WS_Z);
    LAS bf16_t* QS = (LAS bf16_t*)(F.lds + LQS); LAS bf16_t* KS = (LAS bf16_t*)(F.lds + LKS); LAS bf16_t* QG = (LAS bf16_t*)(F.lds + LQG); LAS bf16_t* VT = (LAS bf16_t*)(F.lds + LVT);
    constexpr int LDT = L + 8;
    if constexpr (HG) {
        constexpr int TQ = L / 4; LAS float* BS = (LAS float*)(F.lds + LBS);
        const int ch = tid & 127, qtr = tid >> 7;
        float lb = 0.f;
        if (m == 1) { const float a0 = F.in[I_HGLB][h * 128 + ch], a1 = F.in[I_HGLB][512 + h * 128 + ch]; lb = 1.f / (1.f + __expf(a0 - a1)); }
        { constexpr int NP = L * 16;
#pragma unroll
          for (int q = 0; q < (NP + NT - 1) / NT; ++q) { const int v = tid + q * NT; if (NP % NT == 0 || v < NP) { const int j = v >> 4, c8 = v & 15; const size_t zr = (size_t)(r0 + j) * ABIN + h * 128 + c8 * 8;
                  const u32x4 zf4 = *(const u32x4*)(Z + zr + 2048), v4 = *(const u32x4*)(Z + zr + 2560);
                  *(LAS u32x4*)(QG + j * 136 + c8 * 8) = zf4; *(LAS u32x4*)(KS + j * 136 + c8 * 8) = v4;
                  if constexpr (!SUMMARY) { const u32x4 q4 = *(const u32x4*)(Z + zr + 1536); *(LAS u32x4*)(QS + j * 136 + c8 * 8) = q4; } } } }
        __syncthreads();
        float zf[TQ], cs[TQ]; float run = 0.f;
#pragma unroll
        for (int jj = 0; jj < TQ; ++jj) { const int j = qtr * TQ + jj; zf[jj] = bf2f(QG[j * 136 + ch]);
            float lf; if (lb == 0.f) lf = fminf(zf[jj], 0.f) - __logf(1.f + __expf(-fabsf(zf[jj]))); else lf = __logf(lb + (1.f - lb) * sigmoidf_(zf[jj]));
            run += lf; cs[jj] = run; }
        BS[qtr * 128 + ch] = run;
        __syncthreads();
        const float b0 = BS[ch], b1 = BS[128 + ch], b2 = BS[256 + ch], b3 = BS[384 + ch];
        const float off = (qtr > 0 ? b0 : 0.f) + (qtr > 1 ? b1 : 0.f) + (qtr > 2 ? b2 : 0.f), bL = (b0 + b1) + (b2 + b3), bmid = b0 + b1;
        if constexpr (SUMMARY) {
#pragma unroll
            for (int j8 = 0; j8 < TQ; j8 += 8) { unsigned vv[8]; float kd[8];
#pragma unroll
                for (int q = 0; q < 8; ++q) { const int jj = j8 + q, j = qtr * TQ + jj; const float b = off + cs[jj]; const float kb = (1.f - lb) * sigmoidf_(-zf[jj]); vv[q] = KS[j * 136 + ch]; kd[q] = kb * __expf(bL - b); }
                u32x4 pv, pk; pv.x = vv[0] | (vv[1] << 16); pv.y = vv[2] | (vv[3] << 16); pv.z = vv[4] | (vv[5] << 16); pv.w = vv[6] | (vv[7] << 16);
                pk.x = pk2(kd[0], kd[1]); pk.y = pk2(kd[2], kd[3]); pk.z = pk2(kd[4], kd[5]); pk.w = pk2(kd[6], kd[7]);
                *(LAS u32x4*)(VT + ch * LDT + qtr * TQ + j8) = pv; *(LAS u32x4*)(QS + ch * LDT + qtr * TQ + j8) = pk; }
            if (qtr == 0) ((float*)(F.ws + WS_DEC))[((size_t)c * 4 + h) * 128 + ch] = __expf(bL);
        } else {
#pragma unroll
            for (int j8 = 0; j8 < TQ; j8 += 8) { unsigned vv[8];
#pragma unroll
                for (int q8 = 0; q8 < 8; ++q8) { const int jj = j8 + q8, j = qtr * TQ + jj; const float b = off + cs[jj]; const float kb = (1.f - lb) * sigmoidf_(-zf[jj]);
                    const float q = siluf_(bf2f(QS[j * 136 + ch])); vv[q8] = KS[j * 136 + ch];
                    QS[j * 136 + ch] = (bf16_t)f2bf(q * __expf(b - bmid)); KS[j * 136 + ch] = (bf16_t)f2bf(kb * __expf(bmid - b)); QG[j * 136 + ch] = (bf16_t)f2bf(q * __expf(b)); }
                u32x4 pv; pv.x = vv[0] | (vv[1] << 16); pv.y = vv[2] | (vv[3] << 16); pv.z = vv[4] | (vv[5] << 16); pv.w = vv[6] | (vv[7] << 16);
                *(LAS u32x4*)(VT + ch * LDT + qtr * TQ + j8) = pv; }
        }
    } else {
        const float logg = log1pf(-exp2f(-5.f - (float)h));
        const f32x2* rope = (const f32x2*)(F.ws + WS_ROPE);
        for (int it = tid; it < L * 4; it += NT) { const int j = it >> 2, d8 = it & 3; const size_t zr = (size_t)(r0 + j) * ABIN;
            const f32x2* rp = rope + (size_t)(pos0 + j) * 32 + d8 * 8;
            const u32x4 k1 = *(const u32x4*)(Z + zr + 256 + h * 64 + d8 * 8), k2 = *(const u32x4*)(Z + zr + 256 + h * 64 + 32 + d8 * 8);
            const float gk = __expf((float)(L - 1 - j) * logg), gq = __expf((float)(j + 1) * logg);
            u32x4 q1 = (u32x4){0, 0, 0, 0}, q2 = q1; if constexpr (!SUMMARY) { q1 = *(const u32x4*)(Z + zr + h * 64 + d8 * 8); q2 = *(const u32x4*)(Z + zr + h * 64 + 32 + d8 * 8); }
#pragma unroll
            for (int e = 0; e < 8; ++e) { const f32x2 cs_ = rp[e]; const unsigned wk1 = k1[e >> 1], wk2 = k2[e >> 1]; const float x1 = (e & 1) ? bfhi(wk1) : bflo(wk1), x2 = (e & 1) ? bfhi(wk2) : bflo(wk2);
                const float o1 = x1 * cs_.x - x2 * cs_.y, o2 = x1 * cs_.y + x2 * cs_.x; const int d = d8 * 8 + e;
                if constexpr (SUMMARY) { QS[d * LDT + j] = (bf16_t)f2bf(o1 * gk); QS[(d + 32) * LDT + j] = (bf16_t)f2bf(o2 * gk); }
                else { KS[j * 72 + d] = (bf16_t)f2bf(o1); KS[j * 72 + d + 32] = (bf16_t)f2bf(o2);
                    const unsigned wq1 = q1[e >> 1], wq2 = q2[e >> 1]; const float y1 = (e & 1) ? bfhi(wq1) : bflo(wq1), y2 = (e & 1) ? bfhi(wq2) : bflo(wq2);
                    const float p1 = (y1 * cs_.x - y2 * cs_.y) * 0.125f, p2 = (y1 * cs_.y + y2 * cs_.x) * 0.125f;
                    QS[j * 72 + d] = (bf16_t)f2bf(p1); QS[j * 72 + d + 32] = (bf16_t)f2bf(p2); QG[j * 72 + d] = (bf16_t)f2bf(p1 * gq); QG[j * 72 + d + 32] = (bf16_t)f2bf(p2 * gq); } } }
        for (int it = tid; it < L * 16; it += NT) { const int j = it >> 4, e8 = it & 15; const u32x4 vv = *(const u32x4*)(Z + (size_t)(r0 + j) * ABIN + 512 + h * 128 + e8 * 8);
#pragma unroll
            for (int e = 0; e < 8; ++e) { const unsigned w = vv[e >> 1]; VT[(e8 * 8 + e) * LDT + j] = (bf16_t)((e & 1) ? (w >> 16) : (w & 0xffffu)); } }
    }
}

template <int L, bool HG> __device__ __forceinline__ void ab_summary_unit(Frame& F, int layer, int c, int h) {
    const int tid = otid(); const int lane = tid & 63; (void)lane;
    constexpr int DK = HG ? 128 : 64, NCT = DK / 16, LDT = L + 8;
    __syncthreads();
    ab_load<L, HG, true>(F, layer, c, h);
    __syncthreads();
    const int fr = lane & 15, fq = lane >> 4;
    const LAS bf16_t* KDT = (const LAS bf16_t*)(F.lds + LQS); const LAS bf16_t* VT = (const LAS bf16_t*)(F.lds + LVT);
    f32x4 acc[1][NCT];
#pragma unroll
    for (int j = 0; j < NCT; ++j) acc[0][j] = (f32x4){0.f, 0.f, 0.f, 0.f};
    wave_mm_nt<1, NCT>(acc, VT + F.wave * 16 * LDT, LDT, KDT, LDT, L, fr, fq);
    bf16_t* ST = (bf16_t*)(F.ws + WS_STATE) + (size_t)c * SLOT_E + (HG ? 32768 + h * 16384 : h * 8192);
    const int e = F.wave * 16 + fr;
#pragma unroll
    for (int j = 0; j < NCT; ++j) { u32x2 w; w.x = pk2(acc[0][j][0], acc[0][j][1]); w.y = pk2(acc[0][j][2], acc[0][j][3]); *(u32x2*)(ST + (size_t)e * DK + 16 * j + 4 * fq) = w; }
}

template <int L, bool HG> __device__ __forceinline__ void ab_output_unit(Frame& F, int layer, int c, int h) {
    const int tid = otid(); const int lane = tid & 63; (void)lane;
    constexpr int DK = HG ? 128 : 64, LDQ = HG ? 136 : 72, LDT = L + 8, NIT = L / 16, WPI = 8 / NIT, ET = 8 / WPI, TPW = (NIT * NIT >= 8) ? NIT * NIT / 8 : 1;
    const int m = layer >> 1; int r0, pos0; chunk_geom(c, r0, pos0);
    __syncthreads();
    ab_load<L, HG, false>(F, layer, c, h);
    LAS bf16_t* QS = (LAS bf16_t*)(F.lds + LQS); LAS bf16_t* KS = (LAS bf16_t*)(F.lds + LKS); LAS bf16_t* QG = (LAS bf16_t*)(F.lds + LQG); LAS bf16_t* VT = (LAS bf16_t*)(F.lds + LVT);
    LAS bf16_t* STl = (LAS bf16_t*)(F.lds + LST); LAS bf16_t* PS = (LAS bf16_t*)(F.lds + LPS); LAS float* RED = (LAS float*)(F.lds + LRED);
    { const bf16_t* ST = (const bf16_t*)(F.ws + WS_STATE) + (size_t)c * SLOT_E + (HG ? 32768 + h * 16384 : h * 8192);
      for (int it = tid; it < 128 * DK / 8; it += NT) { const int e = it / (DK / 8), c8 = it % (DK / 8); *(LAS u32x4*)(STl + e * LDQ + c8 * 8) = *(const u32x4*)(ST + (size_t)e * DK + c8 * 8); } }
    __syncthreads();
    const int fr = lane & 15, fq = lane >> 4, w = F.wave;
    const float logg = HG ? 0.f : log1pf(-exp2f(-5.f - (float)h));
    if (w * TPW < NIT * NIT) {
        const int it = (w * TPW) / NIT, jt0 = (w * TPW) % NIT;
        f32x4 sc[1][TPW];
#pragma unroll
        for (int q = 0; q < TPW; ++q) sc[0][q] = (f32x4){0.f, 0.f, 0.f, 0.f};
        wave_mm_nt<1, TPW>(sc, QS + it * 16 * LDQ, LDQ, KS + jt0 * 16 * LDQ, LDQ, DK, fr, fq);
        const int i = it * 16 + fr;
#pragma unroll
        for (int q = 0; q < TPW; ++q) { float p[4];
#pragma unroll
            for (int r = 0; r < 4; ++r) { const int j = (jt0 + q) * 16 + 4 * fq + r; float v = sc[0][q][r]; if (!HG) v *= __expf((float)(i - j) * logg); p[r] = (j <= i) ? v : 0.f; }
            u32x2 pw; pw.x = pk2(p[0], p[1]); pw.y = pk2(p[2], p[3]); *(LAS u32x2*)(PS + i * LDT + (jt0 + q) * 16 + 4 * fq) = pw; }
    }
    __syncthreads();
    const int it = w % NIT, eg = w / NIT;
    f32x4 o[1][ET];
#pragma unroll
    for (int q = 0; q < ET; ++q) o[0][q] = (f32x4){0.f, 0.f, 0.f, 0.f};
    wave_mm_nt<1, ET>(o, PS + it * 16 * LDT, LDT, VT + eg * ET * 16 * LDT, LDT, L, fr, fq);
    wave_mm_nt<1, ET>(o, QG + it * 16 * LDQ, LDQ, STl + eg * ET * 16 * LDQ, LDQ, DK, fr, fq);
    float ss = 0.f;
#pragma unroll
    for (int q = 0; q < ET; ++q) ss += (o[0][q][0] * o[0][q][0] + o[0][q][1] * o[0][q][1]) + (o[0][q][2] * o[0][q][2] + o[0][q][3] * o[0][q][3]);
    ss += __shfl_xor(ss, 16); ss += __shfl_xor(ss, 32);
    const int i = it * 16 + fr;
    if (fq == 0) RED[i * 4 + eg] = ss;
    __syncthreads();
    float tot = 0.f;
#pragma unroll
    for (int q = 0; q < WPI; ++q) tot += RED[i * 4 + q];
    const float rstd = 1.f / sqrtf(tot * (1.f / 128.f) + NORM_EPS);
    const bf16_t* Z = (const bf16_t*)(F.ws + WS_Z); bf16_t* O = (bf16_t*)(F.ws + WS_XN);
    const size_t row = (size_t)(r0 + i);
#pragma unroll
    for (int q = 0; q < ET; ++q) { const int e = (eg * ET + q) * 16 + 4 * fq; const u32x2 gw = *(const u32x2*)(Z + row * ABIN + (HG ? 3072 : 1024) + h * 128 + e);
        const float g4[4] = {bflo(gw.x), bfhi(gw.x), bflo(gw.y), bfhi(gw.y)}; float ov[4];
#pragma unroll
        for (int r = 0; r < 4; ++r) { if (HG) ov[r] = o[0][q][r] * rstd * F.in[I_HGNG][m * 128 + e + r] * sigmoidf_(g4[r]); else ov[r] = o[0][q][r] * rstd * siluf_(g4[r]); }
        u32x2 ow; ow.x = pk2(ov[0], ov[1]); ow.y = pk2(ov[2], ov[3]); *(u32x2*)(O + row * D + (HG ? 512 : 0) + h * 128 + e) = ow; }
}

template <bool DRY = false> __device__ __forceinline__ void ab_scan(Frame& F, int layer) {
    const int tid = otid(); const int lane = tid & 63; (void)lane;
    const int m = layer >> 1;
    unsigned* ST32 = (unsigned*)(F.ws + WS_STATE); const float* DEC = (const float*)(F.ws + WS_DEC);
    constexpr int NP = SLOT_E / 2;
    const int gt = F.vcu * NT + tid;
    if (gt < NP) {
        const int eo = 2 * gt; const bool hg = eo >= 32768; const int eo2 = hg ? eo - 32768 : eo; const int head = hg ? eo2 >> 14 : eo2 >> 13; const int cch = hg ? (eo2 & 127) : (eo2 & 63); const int e = hg ? ((eo2 & 16383) >> 7) : ((eo2 & 8191) >> 6);
        const float gdec = hg ? 0.f : __expf(64.f * log1pf(-exp2f(-5.f - (float)head)));
        float s0 = 0.f, s1 = 0.f;
        for (int c0 = 0; c0 < 256; c0 += 8) {
            unsigned kv[8]; float d0[8], d1[8];
#pragma unroll
            for (int u = 0; u < 8; ++u) { kv[u] = ST32[(size_t)(c0 + u) * NP + gt]; if (hg) { const f32x2 dd = *(const f32x2*)(DEC + ((size_t)(c0 + u) * 4 + head) * 128 + cch); d0[u] = dd.x; d1[u] = dd.y; } else { d0[u] = gdec; d1[u] = gdec; } }
#pragma unroll
            for (int u = 0; u < 8; ++u) { const unsigned pw = pk2(s0, s1); if constexpr (DRY) asm volatile("" :: "v"(pw)); else ST32[(size_t)(c0 + u) * NP + gt] = pw; s0 = d0[u] * s0 + bflo(kv[u]); s1 = d1[u] * s1 + bfhi(kv[u]); }
        }
        float* outp = hg ? F.out + O_HGP + (size_t)m * 65536 + head * 16384 : F.out + O_RETP + (size_t)m * 32768 + head * 8192;
        outp[(size_t)cch * 128 + e] = s0; outp[(size_t)(cch + 1) * 128 + e] = s1;
    } else {
        const int NG2 = F.G * NT - NP; if (NG2 <= 0) return;
        for (int idx = gt - NP; idx < 32 * NP; idx += NG2) { const int b = idx / NP, pr = idx % NP;
            const int eo = 2 * pr; const bool hg = eo >= 32768; const int eo2 = hg ? eo - 32768 : eo; const int head = hg ? eo2 >> 14 : eo2 >> 13; const int cch = hg ? (eo2 & 127) : (eo2 & 63); const int e = hg ? ((eo2 & 16383) >> 7) : ((eo2 & 8191) >> 6);
            float d0, d1; if (hg) { const f32x2 dd = *(const f32x2*)(DEC + ((size_t)(256 + b) * 4 + head) * 128 + cch); d0 = dd.x; d1 = dd.y; } else { d0 = d1 = __expf(32.f * log1pf(-exp2f(-5.f - (float)head))); }
            const size_t so = hg ? ((size_t)(m * 32 + b) * 4 + head) * 16384 : ((size_t)(m * 32 + b) * 4 + head) * 8192;
            const float* sin_ = (hg ? F.in[I_SHG] : F.in[I_SRET]) + so; float* sout = F.out + (hg ? O_HGS : O_RETS) + so;
            const float i0 = sin_[(size_t)cch * 128 + e], i1 = sin_[(size_t)(cch + 1) * 128 + e];
            const unsigned kv = ST32[(size_t)(256 + b) * NP + pr]; if constexpr (!DRY) ST32[(size_t)(256 + b) * NP + pr] = pk2(i0, i1);
            sout[(size_t)cch * 128 + e] = d0 * i0 + bflo(kv); sout[(size_t)(cch + 1) * 128 + e] = d1 * i1 + bfhi(kv); }
    }
}

constexpr int RL_AT = 0, RL_RT = 9216, RL_BT = 18432, RL_KT = 27648, RL_BHT = 36864, RL_KHT = 46080, RL_VT = 55296, RL_AAB = 64512, RL_AAK = 81920, RL_ARB = 91136, RL_ARK = 100352,
              RL_U0T = 109568, RL_VEC = 118784, RL_PSUM = 119808;
constexpr int RL_G = RL_AAB, RL_WW = RL_BT, RL_APT = RL_AAK;
constexpr int RL_PL = RL_AT, RL_RL = RL_BT, RL_Y0L = RL_BT + 4608, RL_QTL = RL_AAB, RL_S = RL_BHT;
__device__ __forceinline__ int pperm(int k) { return 32 * (k >> 5) + 8 * ((k >> 2) & 3) + 4 * ((k >> 4) & 1) + (k & 3); }

template <bool DRY = false> __device__ __forceinline__ void rwkv_out_epilogue(Frame& F, int m, const f32x4 (&y)[4], size_t row, int h, int fq) {
    bf16_t* RKV = (bf16_t*)(F.ws + WS_RKV); const bf16_t* GG = (const bf16_t*)(F.ws + WS_G); const float* BON = (const float*)(F.ws + WS_BON);
    float s1 = 0.f;
#pragma unroll
    for (int nt = 0; nt < 4; ++nt) s1 += (y[nt][0] + y[nt][1]) + (y[nt][2] + y[nt][3]);
    s1 += __shfl_xor(s1, 16); s1 += __shfl_xor(s1, 32);
    const float mean = s1 * (1.f / 64.f); float s2 = 0.f;
#pragma unroll
    for (int nt = 0; nt < 4; ++nt)
#pragma unroll
        for (int r = 0; r < 4; ++r) { const float d = y[nt][r] - mean; s2 += d * d; }
    s2 += __shfl_xor(s2, 16); s2 += __shfl_xor(s2, 32);
    const float rstd = 1.f / sqrtf(s2 * (1.f / 64.f) + RW_LN_EPS), bon = BON[row * 16 + h];
#pragma unroll
    for (int nt = 0; nt < 4; ++nt) { const int i = h * 64 + 16 * nt + 4 * fq;
        const f32x4 lg = *(const f32x4*)(F.in[I_RLNG] + m * D + i), lb = *(const f32x4*)(F.in[I_RLNB] + m * D + i);
        const u32x2 vv = *(const u32x2*)(RKV + row * 3072 + 2048 + i), gg = *(const u32x2*)(GG + row * D + i);
        const float v4[4] = {bflo(vv.x), bfhi(vv.x), bflo(vv.y), bfhi(vv.y)}, g4[4] = {bflo(gg.x), bfhi(gg.x), bflo(gg.y), bfhi(gg.y)}; float o[4];
#pragma unroll
        for (int r = 0; r < 4; ++r) o[r] = ((y[nt][r] - mean) * rstd * lg[r] + lb[r] + bon * v4[r]) * g4[r];
        u32x2 w; w.x = pk2(o[0], o[1]); w.y = pk2(o[2], o[3]); if constexpr (DRY) asm volatile("" :: "v"(w.x), "v"(w.y)); else *(u32x2*)(RKV + row * 3072 + i) = w; }
}

template <int S, int L> struct SubstQ {
    static constexpr int RQ = L / 4, NV4 = RQ / 4;
    static __device__ __forceinline__ void run(float (&x)[RQ], f32x4 (&aq)[3][NV4], const LAS float* ap) {
        if constexpr (S < L - 1) {
            if constexpr (S + 2 < L - 1) {
#pragma unroll
                for (int k = 0; k < NV4; ++k) aq[(S + 2) % 3][k] = *(const LAS f32x4*)(ap + (S + 2) * 68 + 4 * k);
            }
            constexpr int own = S / RQ, ctrl = own * 0x55;
            const float xs = __builtin_bit_cast(float, __builtin_amdgcn_update_dpp(0, __builtin_bit_cast(int, x[S % RQ]), ctrl, 0xf, 0xf, false));
#pragma unroll
            for (int k = 0; k < NV4; ++k) { x[4 * k] += aq[S % 3][k][0] * xs; x[4 * k + 1] += aq[S % 3][k][1] * xs; x[4 * k + 2] += aq[S % 3][k][2] * xs; x[4 * k + 3] += aq[S % 3][k][3] * xs;
                asm volatile("" : "+v"(x[4 * k]), "+v"(x[4 * k + 1]), "+v"(x[4 * k + 2]), "+v"(x[4 * k + 3])); }
            asm volatile("" ::: "memory");
            SubstQ<S + 1, L>::run(x, aq, ap);
        }
    }
};
struct RawRegs { u32x4 r, k, v, w, a; };
__device__ __forceinline__ void rwkv_load_raw(Frame& F, int u, int tid, RawRegs& raw) {
    const int c = u >> 4, h = u & 15; int r0, pos0; chunk_geom(c, r0, pos0); const int L = c < 256 ? 64 : 32; int t = tid >> 3; t = t < L ? t : 0;
    const bf16_t* RKV = (const bf16_t*)(F.ws + WS_RKV); const bf16_t* WLOG = (const bf16_t*)(F.ws + WS_WLOG); const bf16_t* AA = (const bf16_t*)(F.ws + WS_XN);
    const size_t row = (size_t)(r0 + t); const int col = h * 64 + 8 * (tid & 7);
    raw.r = *(const u32x4*)(RKV + row * 3072 + col); raw.k = *(const u32x4*)(RKV + row * 3072 + 1024 + col); raw.v = *(const u32x4*)(RKV + row * 3072 + 2048 + col);
    raw.w = *(const u32x4*)(WLOG + row * D + col); raw.a = *(const u32x4*)(AA + row * D + col);
}
template <int L, bool DRY = false> __device__ __forceinline__ void rwkv_local_unit(Frame& F, int layer, int c, int h, RawRegs& raw, int unext) {
    const int tid = otid(); const int lane = tid & 63, fr = lane & 15, fq = lane >> 4, w = F.wave;
    constexpr int NIT = L / 16; constexpr bool SAMPLE = (L == 32);
    const int m = layer >> 1; int r0, pos0; chunk_geom(c, r0, pos0);
    bf16_t* RKV = (bf16_t*)(F.ws + WS_RKV); const bf16_t* WLOG = (const bf16_t*)(F.ws + WS_WLOG); const bf16_t* AA = (const bf16_t*)(F.ws + WS_XN);
    LAS bf16_t* AT = (LAS bf16_t*)(F.lds + RL_AT); LAS bf16_t* RT = (LAS bf16_t*)(F.lds + RL_RT); LAS bf16_t* BT = (LAS bf16_t*)(F.lds + RL_BT); LAS bf16_t* KT = (LAS bf16_t*)(F.lds + RL_KT);
    LAS bf16_t* BHT = (LAS bf16_t*)(F.lds + RL_BHT); LAS bf16_t* KHT = (LAS bf16_t*)(F.lds + RL_KHT); LAS bf16_t* VT = (LAS bf16_t*)(F.lds + RL_VT);
    LAS float* AAB = (LAS float*)(F.lds + RL_AAB); LAS bf16_t* AAK = (LAS bf16_t*)(F.lds + RL_AAK); LAS bf16_t* ARB = (LAS bf16_t*)(F.lds + RL_ARB); LAS bf16_t* ARK = (LAS bf16_t*)(F.lds + RL_ARK);
    LAS bf16_t* U0T = (LAS bf16_t*)(F.lds + RL_U0T); LAS float* GMID = (LAS float*)(F.lds + RL_VEC); LAS float* GLV = GMID + 64; LAS float* EGM = GMID + 128; LAS float* PSUM = (LAS float*)(F.lds + RL_PSUM);
    LAS float* G = (LAS float*)(F.lds + RL_G); LAS float* WW = (LAS float*)(F.lds + RL_WW); LAS bf16_t* APT = (LAS bf16_t*)(F.lds + RL_APT);
    __syncthreads();
    const int t = tid >> 3, c8 = tid & 7; const bool act = t < L;
    float rr[8], kkv[8], bb[8], kh[8], vv[8];
    if (act) { const size_t row = (size_t)(r0 + t); const int col = h * 64 + 8 * c8;
        const u32x4 r4 = raw.r, k4 = raw.k, v4 = raw.v, w4 = raw.w, a4 = raw.a;
        const float* kkp = F.in[I_RKK] + m * D + col; const float* kap = F.in[I_RKA] + m * D + col; const float* rkp = F.in[I_RRK] + m * D + col;
        float ss = 0.f, bon = 0.f;
#pragma unroll
        for (int e = 0; e < 8; ++e) { const float kx = (e & 1) ? bfhi(k4[e >> 1]) : bflo(k4[e >> 1]), al = (e & 1) ? bfhi(a4[e >> 1]) : bflo(a4[e >> 1]);
            rr[e] = (e & 1) ? bfhi(r4[e >> 1]) : bflo(r4[e >> 1]); vv[e] = (e & 1) ? bfhi(v4[e >> 1]) : bflo(v4[e >> 1]);
            kkv[e] = kx * kkp[e]; ss += kkv[e] * kkv[e]; kh[e] = kx * (1.f + (al - 1.f) * kap[e]); bb[e] = al; bon += rr[e] * kh[e] * rkp[e];
            G[t * 64 + 8 * c8 + e] = (e & 1) ? bfhi(w4[e >> 1]) : bflo(w4[e >> 1]); }
        ss += __shfl_xor(ss, 1); ss += __shfl_xor(ss, 2); ss += __shfl_xor(ss, 4); bon += __shfl_xor(bon, 1); bon += __shfl_xor(bon, 2); bon += __shfl_xor(bon, 4);
        const float inv = 1.f / fmaxf(sqrtf(ss), 1e-12f);
#pragma unroll
        for (int e = 0; e < 8; ++e) { kkv[e] *= inv; bb[e] *= kkv[e]; }
        if (c8 == 0) ((float*)(F.ws + WS_BON))[row * 16 + h] = bon; }
    if (unext >= 0) rwkv_load_raw(F, unext, tid, raw);
    __syncthreads();
    { constexpr int TE = L / 8; const int j = tid & 63, e8 = tid >> 6; float cs[TE]; float run = 0.f;
#pragma unroll
      for (int q = 0; q < TE; ++q) { run += G[(e8 * TE + q) * 64 + j]; cs[q] = run; }
      PSUM[e8 * 64 + j] = run;
      __syncthreads();
      float off = 0.f, gm = 0.f, gl = 0.f;
#pragma unroll
      for (int q = 0; q < 8; ++q) { const float p = PSUM[q * 64 + j]; if (q < e8) off += p; if (q < 4) gm += p; gl += p; }
#pragma unroll
      for (int q = 0; q < TE; ++q) G[(e8 * TE + q) * 64 + j] = off + cs[q];
      if (e8 == 0) { GMID[j] = gm; GLV[j] = gl; EGM[j] = __expf(gm); if (!SAMPLE) ((float*)(F.ws + WS_REC + ((size_t)h * 256 + c) * REC_B + 16384))[j] = __expf(gl); } }
    __syncthreads();
    if (act) { float fa[8], fr_[8], fb[8], fk[8];
#pragma unroll
        for (int e = 0; e < 8; ++e) { const int j = 8 * c8 + e; const float g = G[t * 64 + j], gp = (t > 0) ? G[(t - 1) * 64 + j] : 0.f, gm = GMID[j], gl = GLV[j];
            const float ed = __expf(gm - g), eu = __expf(g - gm), el = __expf(gl - g);
            fa[e] = -kkv[e] * __expf(gp - gm); fr_[e] = rr[e] * eu; fb[e] = bb[e] * ed; fk[e] = kh[e] * ed;
            if constexpr (!(DRY && (LOCAL_SKIP & 4))) { BHT[j * 72 + t] = (bf16_t)f2bf(bb[e] * el); KHT[j * 72 + t] = (bf16_t)f2bf(kh[e] * el); VT[j * 72 + t] = (bf16_t)f2bf(vv[e]); } }
        u32x4 p;
        p.x = pk2(fa[0], fa[1]); p.y = pk2(fa[2], fa[3]); p.z = pk2(fa[4], fa[5]); p.w = pk2(fa[6], fa[7]); *(LAS u32x4*)(AT + t * 72 + 8 * c8) = p;
        p.x = pk2(fr_[0], fr_[1]); p.y = pk2(fr_[2], fr_[3]); p.z = pk2(fr_[4], fr_[5]); p.w = pk2(fr_[6], fr_[7]); *(LAS u32x4*)(RT + t * 72 + 8 * c8) = p;
        p.x = pk2(fb[0], fb[1]); p.y = pk2(fb[2], fb[3]); p.z = pk2(fb[4], fb[5]); p.w = pk2(fb[6], fb[7]); *(LAS u32x4*)(BT + t * 72 + 8 * c8) = p;
        p.x = pk2(fk[0], fk[1]); p.y = pk2(fk[2], fk[3]); p.z = pk2(fk[4], fk[5]); p.w = pk2(fk[6], fk[7]); *(LAS u32x4*)(KT + t * 72 + 8 * c8) = p; }
    __syncthreads();
    if constexpr (DRY && (LOCAL_SKIP & 2)) return;
    { constexpr int TPW = (NIT * NIT >= 8) ? NIT * NIT / 8 : 1;
      if (w * TPW < NIT * NIT) { const int it = (w * TPW) / NIT, jt0 = (w * TPW) % NIT;
          f32x4 ab[1][TPW], ak[1][TPW], rb[1][TPW], rk[1][TPW];
#pragma unroll
          for (int q = 0; q < TPW; ++q) { ab[0][q] = (f32x4){0.f, 0.f, 0.f, 0.f}; ak[0][q] = ab[0][q]; rb[0][q] = ab[0][q]; rk[0][q] = ab[0][q]; }
          wave_mm_nt<1, TPW>(ab, AT + it * 16 * 72, 72, BT + jt0 * 16 * 72, 72, 64, fr, fq); wave_mm_nt<1, TPW>(ak, AT + it * 16 * 72, 72, KT + jt0 * 16 * 72, 72, 64, fr, fq);
          wave_mm_nt<1, TPW>(rb, RT + it * 16 * 72, 72, BT + jt0 * 16 * 72, 72, 64, fr, fq); wave_mm_nt<1, TPW>(rk, RT + it * 16 * 72, 72, KT + jt0 * 16 * 72, 72, 64, fr, fq);
          const int tt = it * 16 + fr;
#pragma unroll
          for (int q = 0; q < TPW; ++q) { const int s0 = (jt0 + q) * 16 + 4 * fq; f32x4 fab; float fak[4], frb[4], frk[4];
#pragma unroll
              for (int r = 0; r < 4; ++r) { const int sx = s0 + r; fab[r] = (sx < tt) ? ab[0][q][r] : 0.f; fak[r] = (sx < tt) ? ak[0][q][r] : 0.f; frb[r] = (sx <= tt) ? rb[0][q][r] : 0.f; frk[r] = (sx <= tt) ? rk[0][q][r] : 0.f; }
#pragma unroll
              for (int r = 0; r < 4; ++r) AAB[(s0 + r) * 68 + tt] = fab[r];
              u32x2 p; p.x = pk2(fak[0], fak[1]); p.y = pk2(fak[2], fak[3]); *(LAS u32x2*)(AAK + tt * 72 + s0) = p;
              p.x = pk2(frb[0], frb[1]); p.y = pk2(frb[2], frb[3]); *(LAS u32x2*)(ARB + tt * 72 + s0) = p;
              p.x = pk2(frk[0], frk[1]); p.y = pk2(frk[2], frk[3]); *(LAS u32x2*)(ARK + tt * 72 + s0) = p; } } }
    __syncthreads();
    { constexpr int TP3 = NIT / 2; const int it = (w * TP3) / 4, nt0 = (w * TP3) % 4;
      f32x4 ww[1][TP3];
#pragma unroll
      for (int q = 0; q < TP3; ++q) ww[0][q] = (f32x4){0.f, 0.f, 0.f, 0.f};
      wave_mm_nt<1, TP3>(ww, AAK + it * 16 * 72, 72, VT + nt0 * 16 * 72, 72, L, fr, fq);
#pragma unroll
      for (int q = 0; q < TP3; ++q) *(LAS f32x4*)(WW + (it * 16 + fr) * 68 + (nt0 + q) * 16 + 4 * fq) = ww[0][q]; }
    __syncthreads();
    { constexpr int RQ = L / 4, NV4 = RQ / 4; const int col = tid >> 2, qd = tid & 3, cidx = col & 63; const bool isA = col < 64; const float eg = EGM[cidx];
      float x[RQ]; f32x4 aq[3][NV4];
#pragma unroll
      for (int i = 0; i < RQ; ++i) { const int tt = qd * RQ + i; x[i] = isA ? bf2f(AT[tt * 72 + cidx]) * eg : WW[tt * 68 + cidx]; }
      const LAS float* ap = AAB + qd * RQ;
#pragma unroll
      for (int k = 0; k < NV4; ++k) { aq[0][k] = *(const LAS f32x4*)(ap + 4 * k); aq[1][k] = *(const LAS f32x4*)(ap + 68 + 4 * k); }
      if constexpr (!(DRY && (LOCAL_SKIP & 1))) SubstQ<0, L>::run(x, aq, ap);
      LAS bf16_t* dst = (isA ? APT : U0T) + cidx * 72 + qd * RQ;
#pragma unroll
      for (int t8 = 0; t8 < RQ; t8 += 8) { u32x4 p; p.x = pk2(x[t8], x[t8 + 1]); p.y = pk2(x[t8 + 2], x[t8 + 3]); p.z = pk2(x[t8 + 4], x[t8 + 5]); p.w = pk2(x[t8 + 6], x[t8 + 7]); *(LAS u32x4*)(dst + t8) = p; } }
    __syncthreads();
    { const int mt = w >> 1, nt0 = (w & 1) * 2;
      f32x4 pp[1][2], qt[1][2];
#pragma unroll
      for (int q = 0; q < 2; ++q) { pp[0][q] = (f32x4){0.f, 0.f, 0.f, 0.f}; qt[0][q] = pp[0][q]; }
      wave_mm_nt<1, 2>(pp, BHT + mt * 16 * 72, 72, APT + nt0 * 16 * 72, 72, L, fr, fq);
      wave_mm_nt<1, 2>(qt, U0T + mt * 16 * 72, 72, BHT + nt0 * 16 * 72, 72, L, fr, fq); wave_mm_nt<1, 2>(qt, VT + mt * 16 * 72, 72, KHT + nt0 * 16 * 72, 72, L, fr, fq);
      constexpr int TP5 = NIT / 2; const int it = (w * TP5) / 4, rn0 = (w * TP5) % 4;
      f32x4 rp[1][TP5], y0[1][TP5];
#pragma unroll
      for (int q = 0; q < TP5; ++q) { const int j = (rn0 + q) * 16 + 4 * fq; const u32x2 rw = *(const LAS u32x2*)(RT + (it * 16 + fr) * 72 + j); const f32x4 e4 = *(const LAS f32x4*)(EGM + j);
          rp[0][q] = (f32x4){bflo(rw.x) * e4[0], bfhi(rw.x) * e4[1], bflo(rw.y) * e4[2], bfhi(rw.y) * e4[3]}; y0[0][q] = (f32x4){0.f, 0.f, 0.f, 0.f}; }
      wave_mm_nt<1, TP5>(rp, ARB + it * 16 * 72, 72, APT + rn0 * 16 * 72, 72, L, fr, fq);
      wave_mm_nt<1, TP5>(y0, ARB + it * 16 * 72, 72, U0T + rn0 * 16 * 72, 72, L, fr, fq); wave_mm_nt<1, TP5>(y0, ARK + it * 16 * 72, 72, VT + rn0 * 16 * 72, 72, L, fr, fq);
      if constexpr (!SAMPLE) {
          bf16_t* PP = (bf16_t*)(F.ws + WS_REC + ((size_t)h * 256 + c) * REC_B); bf16_t* QQ = PP + 4096;
#pragma unroll
          for (int q = 0; q < 2; ++q) { const int n0 = (nt0 + q) * 16 + 4 * fq; u32x2 p; p.x = pk2(pp[0][q][0], pp[0][q][1]); p.y = pk2(pp[0][q][2], pp[0][q][3]);
              *(u32x2*)(PP + (mt * 16 + fr) * 64 + pperm(n0)) = p;
              p.x = pk2(qt[0][q][0], qt[0][q][1]); p.y = pk2(qt[0][q][2], qt[0][q][3]); *(u32x2*)(QQ + (mt * 16 + fr) * 64 + n0) = p; }
#pragma unroll
          for (int q = 0; q < TP5; ++q) { const size_t row = (size_t)(r0 + it * 16 + fr); const int n0 = (rn0 + q) * 16 + 4 * fq; u32x2 p;
              p.x = pk2(rp[0][q][0], rp[0][q][1]); p.y = pk2(rp[0][q][2], rp[0][q][3]); if constexpr (DRY) asm volatile("" :: "v"(p.x), "v"(p.y)); else *(u32x2*)(RKV + row * 3072 + 1024 + h * 64 + n0) = p;
              p.x = pk2(y0[0][q][0], y0[0][q][1]); p.y = pk2(y0[0][q][2], y0[0][q][3]); if constexpr (DRY) asm volatile("" :: "v"(p.x), "v"(p.y)); else *(u32x2*)(RKV + row * 3072 + h * 64 + n0) = p; }
      } else {
          __syncthreads();
          LAS bf16_t* PL = (LAS bf16_t*)(F.lds + RL_PL); LAS bf16_t* RLs = (LAS bf16_t*)(F.lds + RL_RL); LAS float* Y0L = (LAS float*)(F.lds + RL_Y0L); LAS float* QTL = (LAS float*)(F.lds + RL_QTL); LAS bf16_t* Sl = (LAS bf16_t*)(F.lds + RL_S);
#pragma unroll
          for (int q = 0; q < 2; ++q) { const int n0 = (nt0 + q) * 16 + 4 * fq; u32x2 p; p.x = pk2(pp[0][q][0], pp[0][q][1]); p.y = pk2(pp[0][q][2], pp[0][q][3]);
              *(LAS u32x2*)(PL + (mt * 16 + fr) * 72 + n0) = p; *(LAS f32x4*)(QTL + (mt * 16 + fr) * 68 + n0) = qt[0][q]; }
#pragma unroll
          for (int q = 0; q < TP5; ++q) { const int n0 = (rn0 + q) * 16 + 4 * fq; u32x2 p; p.x = pk2(rp[0][q][0], rp[0][q][1]); p.y = pk2(rp[0][q][2], rp[0][q][3]);
              *(LAS u32x2*)(RLs + (it * 16 + fr) * 72 + n0) = p; *(LAS f32x4*)(Y0L + (it * 16 + fr) * 68 + n0) = y0[0][q]; }
          const int sb = c - 256; const float* sin_ = F.in[I_SWKV] + (((size_t)m * 32 + sb) * 16 + h) * 4096; float* sout = F.out + O_WKVS + (((size_t)m * 32 + sb) * 16 + h) * 4096;
          for (int it2 = tid; it2 < 64 * 16; it2 += NT) { const int i = it2 >> 4, j4 = (it2 & 15) * 4; const f32x4 sv = *(const f32x4*)(sin_ + i * 64 + j4); u32x2 p; p.x = pk2(sv[0], sv[1]); p.y = pk2(sv[2], sv[3]); *(LAS u32x2*)(Sl + i * 72 + j4) = p; }
          __syncthreads();
          if (w < 2) { f32x4 y[1][4];
#pragma unroll
              for (int q = 0; q < 4; ++q) y[0][q] = *(const LAS f32x4*)(Y0L + (w * 16 + fr) * 68 + q * 16 + 4 * fq);
              wave_mm_nt<1, 4>(y, RLs + w * 16 * 72, 72, Sl, 72, 64, fr, fq);
              rwkv_out_epilogue<DRY>(F, m, y[0], (size_t)(r0 + w * 16 + fr), h, fq); }
          else if (w < 6) { const int mi = w - 2; f32x4 tl[1][4];
#pragma unroll
              for (int q = 0; q < 4; ++q) { const int j = q * 16 + 4 * fq; const f32x4 sv = *(const f32x4*)(sin_ + (mi * 16 + fr) * 64 + j), gl4 = *(const LAS f32x4*)(GLV + j), qv = *(const LAS f32x4*)(QTL + (mi * 16 + fr) * 68 + j);
                  tl[0][q] = (f32x4){__expf(gl4[0]) * sv[0] + qv[0], __expf(gl4[1]) * sv[1] + qv[1], __expf(gl4[2]) * sv[2] + qv[2], __expf(gl4[3]) * sv[3] + qv[3]}; }
              wave_mm_nt<1, 4>(tl, Sl + mi * 16 * 72, 72, PL, 72, 64, fr, fq);
#pragma unroll
              for (int q = 0; q < 4; ++q) *(f32x4*)(sout + (mi * 16 + fr) * 64 + q * 16 + 4 * fq) = tl[0][q]; }
      }
    }
}

constexpr int SC_GRP = 4, SC_CH = 8192 + 2048 + 256, SC_LCH = 9216 + 2304 + 256, SC_LBUF = SC_GRP * SC_LCH;
template <int SKIP = 0> __device__ __forceinline__ void rwkv_scan_phase(Frame& F, int layer) {
    const int tid = otid(); const int lane = tid & 63, m = layer >> 1; const int b = blockIdx.x;
    if (b >= 64) return;
    const int h = 2 * (b & 7) + (b >> 5), sl = (b >> 3) & 3;
    const unsigned char* REC = F.ws + WS_REC;
    constexpr int NG = 256 / SC_GRP, DEPTH = 4;
    static_assert(NG % DEPTH == 0, "scan groups vs prefetch depth");
    if (F.wave != 0) {
        constexpr int NV = SC_GRP * SC_CH / 16, NLT = NT - 64, NPT = (NV + NLT - 1) / NLT;
        struct RegSet { u32x4 v[NPT]; };
        RegSet sets[DEPTH];
        unsigned poff[NPT], pdst[NPT];
#pragma unroll
        for (int q = 0; q < NPT; ++q) { int v = (tid - 64) + q * NLT; v = v < NV ? v : NV - 1; const int cc = v / (SC_CH / 16), o = (v % (SC_CH / 16)) * 16;
            poff[q] = (unsigned)(cc * REC_B + o + (o >= 10240 ? 6144 : (o >= 8192 ? sl * 2048 : 0)));
            const int lo = (o < 8192) ? (o >> 7) * 144 + (o & 127) : (o < 10240) ? 9216 + ((o - 8192) >> 7) * 144 + ((o - 8192) & 127) : 9216 + 2304 + (o - 10240);
            pdst[q] = (unsigned)(cc * SC_LCH + lo); }
        auto issue = [&](int g, RegSet& st) { const unsigned char* gb = REC + ((size_t)h * 256 + g * SC_GRP) * REC_B;
#pragma unroll
            for (int q = 0; q < NPT; ++q) st.v[q] = *(const u32x4*)(gb + poff[q]); };
        auto commit = [&](int buf, const RegSet& st) {
#pragma unroll
            for (int q = 0; q < NPT; ++q) *(LAS u32x4*)(F.lds + buf * SC_LBUF + pdst[q]) = st.v[q]; };
        if (!(SKIP & 2)) {
#pragma unroll
            for (int d = 0; d < DEPTH; ++d) issue(d, sets[d]);
            commit(0, sets[0]); }
        for (int g0 = 0; g0 < NG; g0 += DEPTH) {
#pragma unroll
            for (int dd = 0; dd < DEPTH; ++dd) { const int g = g0 + dd;
                if (!(SKIP & 2)) { if (g > 0 && g + DEPTH - 1 < NG) issue(g + DEPTH - 1, sets[(dd + DEPTH - 1) % DEPTH]); }
                __syncthreads();
                __syncthreads();
                if (!(SKIP & 2)) { if (g + 1 < NG) commit((g + 1) & 1, sets[(dd + 1) % DEPTH]); } }
        }
    } else {
        const int ci = lane & 15, q4 = lane >> 4, i = 16 * sl + ci;
        f32x4 T[4];
#pragma unroll
        for (int mm = 0; mm < 4; ++mm) T[mm] = (f32x4){0.f, 0.f, 0.f, 0.f};
        bf16_t* TST = (bf16_t*)(F.ws + WS_TST);
        const unsigned pfo = (unsigned)(ci * 144 + q4 * 16);
        for (int g = 0; g < NG; ++g) {
            __syncthreads();
            if (!(SKIP & 1)) {
                const LAS unsigned char* base = F.lds + (g & 1) * SC_LBUF;
                bf16x8 pf[4][2];
#pragma unroll
                for (int mm = 0; mm < 4; ++mm)
#pragma unroll
                    for (int s = 0; s < 2; ++s) pf[mm][s] = *(const LAS bf16x8*)(base + pfo + mm * 2304 + s * 64);
#pragma unroll
                for (int cc = 0; cc < SC_GRP; ++cc) { const int c = g * SC_GRP + cc; const LAS unsigned char* cb = base + cc * SC_LCH;
                    bf16_t* tdst = TST + (((size_t)h * 256 + c) * 64 + i) * 64;
                    f32x4 gv[4]; u32x2 qv[4];
#pragma unroll
                    for (int mm = 0; mm < 4; ++mm) { const int j = 16 * mm + 4 * q4; gv[mm] = *(const LAS f32x4*)(cb + 9216 + 2304 + j * 4); qv[mm] = *(const LAS u32x2*)(cb + 9216 + ci * 144 + j * 2); }
                    bf16x8 pn[4][2];
                    if (cc + 1 < SC_GRP) {
#pragma unroll
                        for (int mm = 0; mm < 4; ++mm)
#pragma unroll
                            for (int s = 0; s < 2; ++s) pn[mm][s] = *(const LAS bf16x8*)(cb + SC_LCH + pfo + mm * 2304 + s * 64); }
                    bf16x8 Tf[2];
#pragma unroll
                    for (int mm = 0; mm < 4; ++mm) { u32x2 p; p.x = pk2(T[mm][0], T[mm][1]); p.y = pk2(T[mm][2], T[mm][3]); *(u32x2*)(tdst + 16 * mm + 4 * q4) = p;
                        Tf[mm >> 1][(mm & 1) * 4 + 0] = (short)(p.x & 0xffffu); Tf[mm >> 1][(mm & 1) * 4 + 1] = (short)(p.x >> 16); Tf[mm >> 1][(mm & 1) * 4 + 2] = (short)(p.y & 0xffffu); Tf[mm >> 1][(mm & 1) * 4 + 3] = (short)(p.y >> 16); }
#pragma unroll
                    for (int mm = 0; mm < 4; ++mm) {
                        f32x4 acc = (f32x4){gv[mm][0] * T[mm][0] + bflo(qv[mm].x), gv[mm][1] * T[mm][1] + bfhi(qv[mm].x), gv[mm][2] * T[mm][2] + bflo(qv[mm].y), gv[mm][3] * T[mm][3] + bfhi(qv[mm].y)};
                        acc = __builtin_amdgcn_mfma_f32_16x16x32_bf16(pf[mm][0], Tf[0], acc, 0, 0, 0); acc = __builtin_amdgcn_mfma_f32_16x16x32_bf16(pf[mm][1], Tf[1], acc, 0, 0, 0);
                        T[mm] = acc; }
                    if (cc + 1 < SC_GRP) {
#pragma unroll
                        for (int mm = 0; mm < 4; ++mm) { pf[mm][0] = pn[mm][0]; pf[mm][1] = pn[mm][1]; } }
                }
            }
            __syncthreads();
        }
        float* outp = F.out + O_WKVP + ((size_t)m * 16 + h) * 4096 + (size_t)i * 64;
#pragma unroll
        for (int mm = 0; mm < 4; ++mm) *(f32x4*)(outp + 16 * mm + 4 * q4) = T[mm];
    }
}

template <bool DRY = false> __device__ __forceinline__ void rwkv_output_phase(Frame& F, int layer) {
    const int tid = otid(); const int lane = tid & 63, fr = lane & 15, fq = lane >> 4, m = layer >> 1;
    const bf16_t* RKV = (const bf16_t*)(F.ws + WS_RKV); const bf16_t* TST = (const bf16_t*)(F.ws + WS_TST);
    const int gw = F.vcu * NWAVES + F.wave, NGW = F.G * NWAVES;
    for (int u = gw; u < 256 * 16 * 4; u += NGW) { const int it = u & 3, h = (u >> 2) & 15, c = u >> 6;
        const size_t row = (size_t)(64 * c + 16 * it + fr); const bf16_t* ts = TST + ((size_t)h * 256 + c) * 4096;
        f32x4 y[4];
#pragma unroll
        for (int nt = 0; nt < 4; ++nt) { const u32x2 yv = *(const u32x2*)(RKV + row * 3072 + h * 64 + 16 * nt + 4 * fq); y[nt] = (f32x4){bflo(yv.x), bfhi(yv.x), bflo(yv.y), bfhi(yv.y)}; }
#pragma unroll
        for (int s = 0; s < 2; ++s) { const bf16x8 xa = *(const bf16x8*)(RKV + row * 3072 + 1024 + h * 64 + 32 * s + 8 * fq);
#pragma unroll
            for (int nt = 0; nt < 4; ++nt) { const bf16x8 yb = *(const bf16x8*)(ts + (16 * nt + fr) * 64 + 32 * s + 8 * fq); y[nt] = __builtin_amdgcn_mfma_f32_16x16x32_bf16(yb, xa, y[nt], 0, 0, 0); } }
        rwkv_out_epilogue<DRY>(F, m, y, row, h, fq);
    }
}

#define GRID_BAR() xcd_barrier(bar)
#ifndef PHASE_MASK
#define PHASE_MASK 0xffffffffu
#endif
#define PH(k) if (PHASE_MASK & (1u << (k)))
#ifndef REP_MASK
#define REP_MASK 0u
#endif
#define REP(k) (((REP_MASK) >> (k)) & 1u)
#ifndef LOCAL_SKIP
#define LOCAL_SKIP 0
#endif
#ifndef EXTRA_BARS
#define EXTRA_BARS 0
#endif
template <int layer> __device__ __forceinline__ void layer_body(Frame& F, const XcdBarrier& bar) {
    unsigned char* ws = F.ws; unsigned char* ar = ws + WS_ARENA;
    bf16_t* XN = (bf16_t*)(ws + WS_XN);
    const float* MOD = (const float*)(ws + WS_MOD);
    constexpr int m = layer >> 1; const float* modl = MOD + (size_t)layer * NSEQ * 6144;
    PH(1) for (int rep = 0; rep <= (int)REP(1); ++rep) if (layer > 0) convert_layer_weights(F, layer);
    if constexpr ((layer & 1) == 0) {
        PH(2) for (int rep = 0; rep <= (int)REP(2); ++rep) { if constexpr (layer == 0) norm_pass<0, 0, true, true>(F, layer); else norm_pass<0, 8>(F, layer, layer - 1, 5120); }
        GRID_BAR();
        PH(3) { using GC = pg8::Geo<D, D, D, 30, 0, 1 << 20, 0>; pg8::Gemm<GC> g{XN, (const bf16_t*)(ar + AR_WIN), nullptr}; pg8::StaticOrder S; S.init(M, ABIN, F.G, (int)blockIdx.x);
          pg8::EpiBf16<0> E{(bf16_t*)(ws + WS_Z), ABIN};
          pg8::gemm_phase<pg8::EpiBf16<0>, pg8::StaticOrder, GC, true, true>(F.lds, g, S, E);
          if (REP(3)) { pg8::EpiNull<true> EN; pg8::gemm_phase<pg8::EpiNull<true>, pg8::StaticOrder, GC, true, true>(F.lds, g, S, EN); } }
        GRID_BAR();
        PH(4) for (int rep = 0; rep <= (int)REP(4); ++rep) for (int u = F.vcu; u < NCHUNK * 8; u += F.G) { const int c = u >> 3, hh = u & 7;
            if (c < 256) { if (hh < 4) ab_summary_unit<64, false>(F, layer, c, hh); else ab_summary_unit<64, true>(F, layer, c, hh - 4); }
            else { if (hh < 4) ab_summary_unit<32, false>(F, layer, c, hh); else ab_summary_unit<32, true>(F, layer, c, hh - 4); } }
        GRID_BAR();
        PH(5) { if (REP(5)) ab_scan<true>(F, layer); ab_scan<false>(F, layer); }
        GRID_BAR();
        PH(6) for (int rep = 0; rep <= (int)REP(6); ++rep) for (int u = F.vcu; u < NCHUNK * 8; u += F.G) { const int c = u >> 3, hh = u & 7;
            if (c < 256) { if (hh < 4) ab_output_unit<64, false>(F, layer, c, hh); else ab_output_unit<64, true>(F, layer, c, hh - 4); }
            else { if (hh < 4) ab_output_unit<32, false>(F, layer, c, hh); else ab_output_unit<32, true>(F, layer, c, hh - 4); } }
        GRID_BAR();
        PH(7) { using GC = pg8::Geo<D, D, D, 30, 0, 1 << 20, 0>; pg8::Gemm<GC> g{XN, (const bf16_t*)(ar + AR_WOUT), nullptr}; pg8::StaticOrder S; S.init(MP, D, F.G, (int)blockIdx.x);
          pg8::EpiRes E{F.out, modl, 2048, (layer == 0) ? F.in[I_XP] : F.out};
          pg8::gemm_phase<pg8::EpiRes, pg8::StaticOrder, GC, true, true>(F.lds, g, S, E);
          if (REP(7)) { pg8::EpiNull<false> EN; pg8::gemm_phase<pg8::EpiNull<false>, pg8::StaticOrder, GC, true, true>(F.lds, g, S, EN); }
          using GC2 = pg8::Geo<D, D, 256, 30, 0, 1 << 20, 0, true>; pg8::Gemm<GC2> g2{XN, (const bf16_t*)(ar + AR_WOUT), nullptr}; pg8::SplitOrder S2{F.vcu, 4};
          pg8::EpiPartial E2{(float*)(ws + WS_PART), 4};
          pg8::gemm_phase<pg8::EpiPartial, pg8::SplitOrder, GC2, true, true>(F.lds, g2, S2, E2); }
        GRID_BAR();
    } else {
        PH(8) for (int rep = 0; rep <= (int)REP(8); ++rep) norm_pass<1, 8>(F, layer, layer - 1, 5120);
        GRID_BAR();
        PH(9) { using GCr = pg8::Geo<D, 2048, D, 2, M * D, 1 << 20, 0>; pg8::Gemm<GCr> gr{(const bf16_t*)(ws + WS_XMIX), (const bf16_t*)(ar + AR_WC1), nullptr}; pg8::StaticOrder Sr; Sr.init(M, 3072, F.G, (int)blockIdx.x);
          pg8::EpiRkv E{(bf16_t*)(ws + WS_RKV), (bf16_t*)(ws + WS_LO), (m == 0) ? (bf16_t*)(ws + WS_VFIRST) : nullptr};
          pg8::gemm_phase<pg8::EpiRkv, pg8::StaticOrder, GCr, true, true>(F.lds, gr, Sr, E);
          if (REP(9)) { pg8::EpiNull<true> EN; pg8::gemm_phase<pg8::EpiNull<true>, pg8::StaticOrder, GCr, true, true>(F.lds, gr, Sr, EN); }
          using GC = pg8::Geo<D, 2048, 2048, 30, 0, 16, -4096>; pg8::Gemm<GC> g{XN, (const bf16_t*)(ar + AR_WC1), (const bf16_t*)(ws + WS_PREVS)}; pg8::LoraOrder Sl{(int)blockIdx.x};
          pg8::gemm_phase<pg8::EpiRkv, pg8::LoraOrder, GC, true, true>(F.lds, g, Sl, E); }
        GRID_BAR();
        PH(10) { using GC = pg8::Geo<D, 256, 256, 2, 256, 1 << 20, 0>; pg8::Gemm<GC> g{(const bf16_t*)(ws + WS_LO), (const bf16_t*)(ar + AR_WC2), nullptr}; pg8::StaticOrder S; S.init(M, 4096, F.G, (int)blockIdx.x);
          pg8::EpiLora2 E{(bf16_t*)(ws + WS_WLOG), XN, (bf16_t*)(ws + WS_G), (bf16_t*)(ws + WS_RKV), (m == 1) ? (const bf16_t*)(ws + WS_VFIRST) : nullptr,
                          F.in[I_RW0] + m * D, F.in[I_RA0] + m * D, F.in[I_RV0]};
          pg8::gemm_phase<pg8::EpiLora2, pg8::StaticOrder, GC, true, true>(F.lds, g, S, E);
          if (REP(10)) { pg8::EpiNull<false> EN; pg8::gemm_phase<pg8::EpiNull<false>, pg8::StaticOrder, GC, true, true>(F.lds, g, S, EN); } }
        GRID_BAR();
        PH(11) { RawRegs raw; const int tid0 = otid(); int u = F.vcu; if (u < NCHUNK * 16) rwkv_load_raw(F, u, tid0, raw);
          for (; u < NCHUNK * 16; u += F.G) { const int c = u >> 4, hh = u & 15, un = (u + F.G < NCHUNK * 16) ? u + F.G : -1;
              if (c < 256) rwkv_local_unit<64>(F, layer, c, hh, raw, un); else rwkv_local_unit<32>(F, layer, c, hh, raw, un); } }
        GRID_BAR();
        PH(17) { if (REP(17)) rwkv_scan_phase<LOCAL_SKIP>(F, layer); rwkv_scan_phase<0>(F, layer); }
        GRID_BAR();
        PH(18) { if (REP(18)) rwkv_output_phase<true>(F, layer); rwkv_output_phase<false>(F, layer); }
        GRID_BAR();
        PH(12) { using GC = pg8::Geo<3072, D, D, 30, 0, 1 << 20, 0>; pg8::Gemm<GC> g{(const bf16_t*)(ws + WS_RKV), (const bf16_t*)(ar + AR_WO), nullptr}; pg8::StaticOrder S; S.init(MP, D, F.G, (int)blockIdx.x);
          pg8::EpiRes E{F.out, modl, 2048, F.out};
          pg8::gemm_phase<pg8::EpiRes, pg8::StaticOrder, GC, true, true>(F.lds, g, S, E);
          if (REP(12)) { pg8::EpiNull<false> EN; pg8::gemm_phase<pg8::EpiNull<false>, pg8::StaticOrder, GC, true, true>(F.lds, g, S, EN); }
          using GC2 = pg8::Geo<3072, D, 256, 30, 0, 1 << 20, 0, true>; pg8::Gemm<GC2> g2{(const bf16_t*)(ws + WS_RKV), (const bf16_t*)(ar + AR_WO), nullptr}; pg8::SplitOrder S2{F.vcu, 4};
          pg8::EpiPartial E2{(float*)(ws + WS_PART), 4};
          pg8::gemm_phase<pg8::EpiPartial, pg8::SplitOrder, GC2, true, true>(F.lds, g2, S2, E2); }
        GRID_BAR();
    }
    PH(13) for (int rep = 0; rep <= (int)REP(13); ++rep) norm_pass<2, 4, false, (layer == 0)>(F, layer, layer, 2048);
    GRID_BAR();
    PH(14) { using GC = pg8::Geo<D, D, D, 30, 0, 1 << 20, 0>; pg8::Gemm<GC> g{XN, (const bf16_t*)(ar + AR_W1), nullptr}; pg8::StaticOrder S; S.init(M, DFF, F.G, (int)blockIdx.x);
      pg8::EpiBf16<1> E{(bf16_t*)(ws + WS_H), DFF};
      pg8::gemm_phase<pg8::EpiBf16<1>, pg8::StaticOrder, GC, true, true>(F.lds, g, S, E);
          if (REP(14)) { pg8::EpiNull<true> EN; pg8::gemm_phase<pg8::EpiNull<true>, pg8::StaticOrder, GC, true, true>(F.lds, g, S, EN); } }
    GRID_BAR();
    PH(15) { using GC = pg8::Geo<DFF, DFF, DFF, 30, 0, 1 << 20, 0>; pg8::Gemm<GC> g{(const bf16_t*)(ws + WS_H), (const bf16_t*)(ar + AR_W2), nullptr}; pg8::StaticOrder S; S.init(MP, D, F.G, (int)blockIdx.x);
      pg8::EpiRes E{F.out, modl, 5120, F.out};
      for (int xb = 0; xb < EXTRA_BARS; ++xb) GRID_BAR();
      pg8::gemm_phase<pg8::EpiRes, pg8::StaticOrder, GC, true, true>(F.lds, g, S, E);
      if (REP(15)) { pg8::EpiNull<false> EN; pg8::gemm_phase<pg8::EpiNull<false>, pg8::StaticOrder, GC, true, true>(F.lds, g, S, EN); }
      using GC2 = pg8::Geo<DFF, DFF, 512, 30, 0, 1 << 20, 0, true>; pg8::Gemm<GC2> g2{(const bf16_t*)(ws + WS_H), (const bf16_t*)(ar + AR_W2), nullptr}; pg8::SplitOrder S2{F.vcu, 8};
      pg8::EpiPartial E2{(float*)(ws + WS_PART), 8};
      pg8::gemm_phase<pg8::EpiPartial, pg8::SplitOrder, GC2, true, true>(F.lds, g2, S2, E2); }
    GRID_BAR();
}

__global__ void __launch_bounds__(NT, 2) fwd_kernel(Args args) {
    extern __shared__ __attribute__((aligned(16))) unsigned char lds[];
    Frame F;
    F.lds = (LAS unsigned char*)lds; F.MISC = (volatile LAS unsigned*)(F.lds + MISC_OFF);
    F.wave = __builtin_amdgcn_readfirstlane(threadIdx.x >> 6);
    F.G = gridDim.x; { const int bx = blockIdx.x; F.vcu = (F.G % 8 == 0) ? (bx % 8) * (F.G / 8) + bx / 8 : bx; }
    F.in = args.in; F.out = args.out; F.ws = args.ws;
    for (int u = threadIdx.x; u < (LDS_BYTES - LDSCTL_OFF) / 4; u += NT) ((LAS unsigned*)(F.lds + LDSCTL_OFF))[u] = 0u;
    __syncthreads();
    XcdBarrier bar = xcd_barrier_post((unsigned*)(F.ws + WS_CTL) + CW_BAR, F.MISC + 8);
    PH(0) prologue(F);
    GRID_BAR();
    PH(0) mod_phase(F);
    GRID_BAR();
    layer_body<0>(F, bar); layer_body<1>(F, bar); layer_body<2>(F, bar); layer_body<3>(F, bar);
    PH(16) norm_pass<3, 8>(F, 0, 3, 5120);
}

extern "C" void kernel_launch(void* const* d_in, const int* in_sizes, int n_in, void* d_out, int out_size, void* d_ws, size_t ws_size, hipStream_t stream) {
    static int grid = 0;
    if (grid == 0) {
        if (n_in != 38 || out_size != 28706816 || ws_size < WS_END) { fprintf(stderr, "kernel_launch: unexpected problem (n_in %d, out %d, ws %zu; need ws >= %zu)\n", n_in, out_size, ws_size, (size_t)WS_END); grid = -1; return; }
        int dev = 0, cus = 0, per_cu = 0;
        if (hipGetDevice(&dev) != hipSuccess || hipDeviceGetAttribute(&cus, hipDeviceAttributeMultiprocessorCount, dev) != hipSuccess) { grid = -1; return; }
        if (hipFuncSetAttribute((const void*)fwd_kernel, hipFuncAttributeMaxDynamicSharedMemorySize, LDS_BYTES) != hipSuccess) { fprintf(stderr, "kernel_launch: hipFuncSetAttribute failed\n"); grid = -1; return; }
        if (hipOccupancyMaxActiveBlocksPerMultiprocessor(&per_cu, (const void*)fwd_kernel, NT, LDS_BYTES) != hipSuccess || per_cu < 1) { fprintf(stderr, "kernel_launch: occupancy query says %d\n", per_cu); per_cu = 1; }
        (void)hipGetLastError();
        grid = cus;
    }
    if (grid < 0) return;
    (void)hipMemsetAsync((char*)d_ws + WS_CTL, 0, ZERO_BYTES, stream);
    Args a{};
    for (int i = 0; i < 38; ++i) a.in[i] = (const float*)d_in[i];
    a.out = (float*)d_out; a.ws = (unsigned char*)d_ws;
    void* kargs[] = {&a};
    hipError_t e = hipLaunchCooperativeKernel((const void*)fwd_kernel, dim3(grid), dim3(NT), kargs, LDS_BYTES, stream);
    if (e != hipSuccess) fprintf(stderr, "kernel_launch: cooperative launch failed: %s (grid %d)\n", hipGetErrorString(e), grid);
}
```

```cpp
#include <hip/hip_runtime.h>
#include <cstdio>
#include <cstdint>

#define LAS __attribute__((address_space(3)))
#define GAS __attribute__((address_space(1)))
typedef unsigned short bf16_t;
typedef short bf16x8 __attribute__((ext_vector_type(8)));
typedef float f32x4 __attribute__((ext_vector_type(4)));
typedef float f32x2 __attribute__((ext_vector_type(2)));
typedef unsigned u32x4 __attribute__((ext_vector_type(4)));
typedef unsigned u32x2 __attribute__((ext_vector_type(2)));

#ifndef LOCAL_SKIP
#define LOCAL_SKIP 0
#endif
constexpr int D = 1024, MP = 16384, MS = 1024, M = MP + MS, NSEQ = 33, DFF = 4096, ABIN = 3584;
constexpr int NCHUNK = 288;
constexpr int SLOT_E = 4 * 8192 + 4 * 16384;
constexpr float NORM_EPS = 1e-6f, RW_LN_EPS = 64e-5f;

constexpr size_t MiB = 1u << 20;
constexpr size_t WS_CTL = 0, WS_MOD = 1 * MiB, ZERO_BYTES = 65536;
constexpr size_t WS_ROPE = 5 * MiB;
constexpr size_t WS_ARENA = 10 * MiB;
constexpr size_t AR_W1 = 0, AR_W2 = 8 * MiB, AR_WIN = 16 * MiB, AR_WOUT = 23 * MiB, AR_WC1 = 16 * MiB, AR_WC2 = 32 * MiB, AR_WO = 34 * MiB;
constexpr size_t WS_VFIRST = 46 * MiB;
constexpr size_t WS_XN0 = 80 * MiB, WS_XN = WS_XN0 + 2048;
constexpr size_t WS_PREVS = 115 * MiB;
constexpr size_t WS_R1 = 118 * MiB;
constexpr size_t WS_Z = WS_R1, WS_STATE = WS_R1 + 120 * MiB, WS_DEC = WS_R1 + 174 * MiB;
constexpr size_t WS_H = WS_R1;
constexpr size_t WS_RKV = WS_R1, WS_LO = WS_R1 + 102 * MiB, WS_WLOG = WS_R1 + 136 * MiB, WS_G = WS_R1 + 170 * MiB;
constexpr size_t WS_TST = WS_R1 + 102 * MiB;
constexpr size_t WS_REC = WS_R1 + 204 * MiB, WS_BON = WS_R1 + 269 * MiB;
constexpr int REC_B = 16640;
constexpr size_t WS_XMIX = WS_R1 + 168 * MiB;
constexpr size_t WS_PART = WS_R1 + 136 * MiB;
constexpr size_t WS_END = WS_R1 + 271 * MiB;

__device__ const double ROPE_REV[32] = {0.15915494309189535, 0.11934937021124886, 0.089499401608891013, 0.067115083005227255, 0.050329212104487035, 0.037741584717419771, 0.028302195830623399, 0.02122365276477766, 0.015915494309189534, 0.011934937021124886, 0.0089499401608891024, 0.0067115083005227253, 0.0050329212104487037, 0.0037741584717419772, 0.0028302195830623399, 0.0021223652764777662, 0.0015915494309189536, 0.0011934937021124885, 0.00089499401608891024, 0.0006711508300522726, 0.00050329212104487033, 0.00037741584717419774, 0.00028302195830623395, 0.00021223652764777661, 0.00015915494309189535, 0.00011934937021124886, 8.9499401608891018e-05, 6.7115083005227254e-05, 5.0329212104487035e-05, 3.7741584717419777e-05, 2.8302195830623396e-05, 2.1223652764777659e-05};

__device__ __forceinline__ unsigned f2bf(float f) { unsigned u = __builtin_bit_cast(unsigned, f); return (u + 0x7fffu + ((u >> 16) & 1u)) >> 16; }
typedef __bf16 bf16x2_t __attribute__((ext_vector_type(2)));
__device__ __forceinline__ unsigned pk2(float lo, float hi) { const f32x2 v = {lo, hi}; const bf16x2_t b = __builtin_convertvector(v, bf16x2_t); return __builtin_bit_cast(unsigned, b); }
__device__ __forceinline__ float bf2f(unsigned short b) { return __builtin_bit_cast(float, (unsigned)b << 16); }
__device__ __forceinline__ float bflo(unsigned w) { return __builtin_bit_cast(float, w << 16); }
__device__ __forceinline__ float bfhi(unsigned w) { return __builtin_bit_cast(float, w & 0xffff0000u); }
__device__ __forceinline__ float sigmoidf_(float x) { return 1.f / (1.f + __expf(-x)); }
__device__ __forceinline__ float siluf_(float x) { return x / (1.f + __expf(-x)); }
__device__ __forceinline__ float wave_sum(float v) {
#pragma unroll
    for (int o = 1; o < 64; o <<= 1) v += __shfl_xor(v, o);
    return v;
}
__device__ __forceinline__ int otid() { int t = threadIdx.x; asm volatile("" : "+v"(t)); return t; }
__device__ __forceinline__ int seq_of_row(int r) { return r < MP ? 0 : 1 + ((r - MP) >> 5); }
#define LDS_WAIT() asm volatile("s_waitcnt lgkmcnt(0)" ::: "memory")
#define VM_WAIT() asm volatile("s_waitcnt vmcnt(0)" ::: "memory")

namespace pg8 {
constexpr int BM = 256, BK = 64, HALF = 128, HTB = HALF * BK * 2, STAGE_BYTES = 8 * HTB, NXCD = 8, WGM = 8;
__host__ __device__ __forceinline__ int lds_byte(int r, int c) { const int st = (r >> 4) * 2 + (c >> 5), rr = r & 15, cc = c & 31, ob = rr * 64 + cc * 2; return st * 1024 + (ob ^ (((ob >> 9) & 1) << 5)); }
__host__ __device__ __forceinline__ void stage_rc(int b, int& R, int& C) { const int st = b / 1024, sb = b % 1024, swz = sb ^ (((sb >> 9) & 1) << 5); R = (st >> 1) * 16 + swz / 64; C = (st & 1) * 32 + (swz % 64) / 2; }
__host__ __device__ __forceinline__ int perm32(int rho) { const int n = rho >> 4, i = rho & 15; return 8 * (i >> 2) + 4 * n + (i & 3); }

struct Unit { int pm, pn, ks; };
template <int LDA_, int LDB_, int K_, int GSHIFT_, int GSTRIDE_, int KSPLIT_, int DELTAP_, bool SPLIT_ = false> struct Geo {
    static constexpr int LDA = LDA_, LDB = LDB_, K = K_, GSHIFT = GSHIFT_, GSTRIDE = GSTRIDE_, KSPLIT = KSPLIT_, DELTAP = DELTAP_; static constexpr bool SPLIT = SPLIT_;
};
template <class GC> struct Gemm {
    const bf16_t* A; const bf16_t* Bt; const bf16_t* A2s;
    __device__ __forceinline__ const char* a_base(const Unit& u) const { return (const char*)(A + (size_t)u.pm * BM * GC::LDA + (size_t)(u.pn >> GC::GSHIFT) * GC::GSTRIDE + (GC::SPLIT ? (size_t)u.ks * GC::K : 0)); }
    __device__ __forceinline__ const char* b_base(const Unit& u) const { return (const char*)(Bt + (size_t)u.pn * BM * GC::LDB + (GC::SPLIT ? (size_t)u.ks * GC::K : 0)); }
    __device__ __forceinline__ long a_delta(const Unit& u) const {
        if constexpr (GC::KSPLIT >= GC::K / BK) return 0;
        else { if (u.pm < 64) return (long)GC::DELTAP;
            return (long)((const char*)(A2s + (size_t)(u.pm - 64) * BM * GC::LDA) - a_base(u)) - (long)GC::KSPLIT * BK * 2; }
    }
};
struct StaticOrder {
    int nM, nN, nwg, G, c;
    __host__ __device__ void init(int M_, int N_, int G_, int c_) { nM = M_ / BM; nN = N_ / BM; nwg = nM * nN; G = G_; c = c_; }
    __host__ __device__ bool next(int i, Unit& u) const {
        const long L = (long)i * G + c; if (L >= nwg) return false;
        int wgid = (int)L; { const int q = nwg / NXCD, r = nwg % NXCD, xcd = wgid % NXCD, off = wgid / NXCD; wgid = (xcd < r ? xcd * (q + 1) : r * (q + 1) + (xcd - r) * q) + off; }
        const int nig = WGM * nN, gid = wgid / nig, fm = gid * WGM, gsz = (nM - fm) < WGM ? (nM - fm) : WGM;
        u.pm = fm + ((wgid % nig) % gsz); u.pn = (wgid % nig) / gsz; u.ks = 0; return true;
    }
};
__device__ __forceinline__ unsigned cvt_pk_bf16(float lo, float hi) { return pk2(lo, hi); }

template <class Epi, class Sched, class GC, bool ALIGN_EPI = false, bool SP2 = false>
__device__ __forceinline__ void gemm_phase(LAS unsigned char* lds, const Gemm<GC> g, const Sched& S, const Epi& E) {
    const int tid = otid(), wid = __builtin_amdgcn_readfirstlane(tid >> 6), lane = tid & 63, wr = wid >> 2, wc = wid & 3, fr = lane & 15, fq = lane >> 4;
    constexpr int K = GC::K, nt = K / BK, ksplit = GC::KSPLIT;
    unsigned voffA[2], voffB[2];
#pragma unroll
    for (int i = 0; i < 2; ++i) { int R, C; stage_rc(tid * 16 + i * 8192, R, C); const int Rb = Epi::PERM ? ((R & ~31) + perm32(R & 31)) : R;
        voffA[i] = (unsigned)(R * GC::LDA + C) * 2u; voffB[i] = (unsigned)(Rb * GC::LDB + C) * 2u; }
    constexpr size_t kstep = (size_t)(BK * 2);
    constexpr size_t hstepA = (size_t)HALF * GC::LDA * 2, hstepB = (size_t)HALF * GC::LDB * 2;
    const unsigned ldsw = (unsigned)wid * 1024u;
    const int aoff = lds_byte(wr * 64 + fr, fq * 8), boff = lds_byte(wc * 32 + fr, fq * 8);
#define PG8_SA(b, h) (((b) * 2 + (h)) * HTB)
#define PG8_SB(b, h) ((4 + (b) * 2 + (h)) * HTB)
#define PG8_STAGE(bufoff, gbase, voff) do { _Pragma("unroll") for (int _i = 0; _i < 2; ++_i) \
        __builtin_amdgcn_global_load_lds((const unsigned*)((const char*)(gbase) + (voff)[_i]), (LAS unsigned*)(lds + (bufoff) + ldsw + _i * 8192), 16, 0, 0); } while (0)
#define PG8_LDA(dst, b, h) do { _Pragma("unroll") for (int m = 0; m < 4; ++m) _Pragma("unroll") for (int k = 0; k < 2; ++k) dst[m][k] = *(const LAS bf16x8*)(lds + PG8_SA(b, h) + aoff + m * 2048 + k * 1024); } while (0)
#define PG8_LDB(dst, b, h) do { _Pragma("unroll") for (int n = 0; n < 2; ++n) _Pragma("unroll") for (int k = 0; k < 2; ++k) dst[n][k] = *(const LAS bf16x8*)(lds + PG8_SB(b, h) + boff + n * 2048 + k * 1024); } while (0)
#define PG8_MMA(ai, bj, At, Bt) do { __builtin_amdgcn_s_setprio(1); _Pragma("unroll") for (int m = 0; m < 4; ++m) _Pragma("unroll") for (int n = 0; n < 2; ++n) _Pragma("unroll") for (int k = 0; k < 2; ++k) \
        acc[ai][bj][m][n] = __builtin_amdgcn_mfma_f32_16x16x32_bf16(Bt[n][k], At[m][k], acc[ai][bj][m][n], 0, 0, 0); __builtin_amdgcn_s_setprio(0); } while (0)
#define PG8_WAIT_V(n) asm volatile("s_waitcnt vmcnt(" #n ")" ::: "memory")
#define PG8_WAIT_L(n) asm volatile("s_waitcnt lgkmcnt(" #n ")" ::: "memory")
#define PG8_BAR __builtin_amdgcn_s_barrier()
#define PG8_SCHED __builtin_amdgcn_sched_barrier(0)
    Unit cur, nxt; int ui = 0;
    if (!S.next(0, cur)) return;
    f32x4 acc[2][2][4][2];
#pragma unroll
    for (int a = 0; a < 2; ++a)
#pragma unroll
        for (int b = 0; b < 2; ++b)
#pragma unroll
            for (int m = 0; m < 4; ++m)
#pragma unroll
                for (int n = 0; n < 2; ++n) acc[a][b][m][n] = (f32x4){0.f, 0.f, 0.f, 0.f};
    bf16x8 At[4][2], B0[2][2], B1[2][2];
    const char* cA = g.a_base(cur); const char* cB = g.b_base(cur); long cD = g.a_delta(cur);
    if constexpr (SP2) {
        PG8_STAGE(PG8_SB(0, 0), cB, voffB); PG8_STAGE(PG8_SB(0, 1), cB + hstepB, voffB); PG8_STAGE(PG8_SA(0, 0), cA, voffA); PG8_STAGE(PG8_SA(0, 1), cA + hstepA, voffA);
        if (wr == 1) PG8_BAR;
        PG8_WAIT_V(2); PG8_BAR;
        PG8_STAGE(PG8_SB(1, 0), cB + kstep, voffB); PG8_STAGE(PG8_SA(1, 0), cA + kstep, voffA); PG8_STAGE(PG8_SB(1, 1), cB + hstepB + kstep, voffB);
        PG8_WAIT_V(6); PG8_BAR;
    } else {
        PG8_STAGE(PG8_SB(0, 0), cB, voffB); PG8_STAGE(PG8_SA(0, 0), cA, voffA); PG8_STAGE(PG8_SB(0, 1), cB + hstepB, voffB); PG8_STAGE(PG8_SA(0, 1), cA + hstepA, voffA);
        if (wr == 1) PG8_BAR;
        PG8_WAIT_V(4); PG8_BAR;
        PG8_STAGE(PG8_SB(1, 0), cB + kstep, voffB); PG8_STAGE(PG8_SA(1, 0), cA + kstep, voffA); PG8_STAGE(PG8_SB(1, 1), cB + hstepB + kstep, voffB);
        PG8_WAIT_V(6); PG8_BAR;
    }
    for (;;) {
        const bool has_next = S.next(ui + 1, nxt);
        const char* nA = has_next ? g.a_base(nxt) : cA; const char* nB = has_next ? g.b_base(nxt) : cB;
        const long nD = has_next ? g.a_delta(nxt) : cD;
#pragma unroll 1
        for (int t = 0; t < nt; t += 2) {
            const bool last = (t == nt - 2);
            const char* a1 = cA + (size_t)(t + 1) * kstep + (t >= ksplit ? cD : 0);
            const char* a2 = last ? nA : cA + (size_t)(t + 2) * kstep + (t + 2 >= ksplit ? cD : 0); const char* b2 = last ? nB : cB + (size_t)(t + 2) * kstep;
            const char* a3 = a2 + kstep; const char* b3 = b2 + kstep;
            if constexpr (SP2) {
            PG8_LDB(B0, 0, 0); PG8_LDB(B1, 0, 1); PG8_SCHED; PG8_LDA(At, 0, 0); PG8_STAGE(PG8_SA(1, 1), a1 + hstepA, voffA);
            PG8_WAIT_V(8); PG8_WAIT_L(0); PG8_BAR; PG8_MMA(0, 0, At, B0); PG8_MMA(0, 1, At, B1); PG8_BAR; PG8_SCHED;
            PG8_LDA(At, 0, 1); PG8_STAGE(PG8_SB(0, 0), b2, voffB); PG8_STAGE(PG8_SB(0, 1), b2 + hstepB, voffB); PG8_STAGE(PG8_SA(0, 0), a2, voffA);
            PG8_WAIT_V(8); PG8_WAIT_L(0); PG8_BAR; PG8_MMA(1, 0, At, B0); PG8_MMA(1, 1, At, B1); PG8_BAR; PG8_SCHED;
            PG8_LDB(B0, 1, 0); PG8_LDB(B1, 1, 1); PG8_SCHED; PG8_LDA(At, 1, 0); PG8_STAGE(PG8_SA(0, 1), a2 + hstepA, voffA);
            PG8_WAIT_V(8); PG8_WAIT_L(0); PG8_BAR; PG8_MMA(0, 0, At, B0); PG8_MMA(0, 1, At, B1); PG8_BAR; PG8_SCHED;
            PG8_LDA(At, 1, 1); PG8_STAGE(PG8_SB(1, 0), b3, voffB); PG8_STAGE(PG8_SB(1, 1), b3 + hstepB, voffB); PG8_STAGE(PG8_SA(1, 0), a3, voffA);
            PG8_WAIT_V(8); PG8_WAIT_L(0); PG8_BAR; PG8_MMA(1, 0, At, B0); PG8_MMA(1, 1, At, B1); PG8_BAR; PG8_SCHED;
            } else {
            PG8_LDB(B0, 0, 0); PG8_SCHED; PG8_LDA(At, 0, 0); PG8_STAGE(PG8_SA(1, 1), a1 + hstepA, voffA);
            PG8_WAIT_L(8); PG8_BAR; PG8_WAIT_L(0); PG8_MMA(0, 0, At, B0); PG8_BAR; PG8_SCHED;
            PG8_LDB(B1, 0, 1); PG8_STAGE(PG8_SB(0, 0), b2, voffB);
            PG8_BAR; PG8_WAIT_L(0); PG8_MMA(0, 1, At, B1); PG8_BAR;
            PG8_LDA(At, 0, 1); PG8_STAGE(PG8_SA(0, 0), a2, voffA);
            PG8_BAR; PG8_WAIT_L(0); PG8_MMA(1, 0, At, B0); PG8_BAR; PG8_SCHED;
            PG8_STAGE(PG8_SB(0, 1), b2 + hstepB, voffB);
            PG8_WAIT_V(6); PG8_BAR; PG8_MMA(1, 1, At, B1); PG8_BAR;
            PG8_LDB(B0, 1, 0); PG8_SCHED; PG8_LDA(At, 1, 0); PG8_STAGE(PG8_SA(0, 1), a2 + hstepA, voffA);
            PG8_WAIT_L(8); PG8_BAR; PG8_WAIT_L(0); PG8_MMA(0, 0, At, B0); PG8_BAR; PG8_SCHED;
            PG8_LDB(B1, 1, 1); PG8_STAGE(PG8_SB(1, 0), b3, voffB);
            PG8_BAR; PG8_WAIT_L(0); PG8_MMA(0, 1, At, B1); PG8_BAR;
            PG8_LDA(At, 1, 1); PG8_STAGE(PG8_SA(1, 0), a3, voffA);
            PG8_BAR; PG8_WAIT_L(0); PG8_MMA(1, 0, At, B0); PG8_BAR; PG8_SCHED;
            PG8_STAGE(PG8_SB(1, 1), b3 + hstepB, voffB);
            PG8_WAIT_V(6); PG8_BAR; PG8_MMA(1, 1, At, B1); PG8_BAR;
            }
        }
        if constexpr (ALIGN_EPI) { if (wr == 0) PG8_BAR; }
        E(acc, cur, wr, wc, fr, fq);
        if (!has_next) break;
#pragma unroll
        for (int a = 0; a < 2; ++a)
#pragma unroll
            for (int b = 0; b < 2; ++b)
#pragma unroll
                for (int m = 0; m < 4; ++m)
#pragma unroll
                    for (int n = 0; n < 2; ++n) acc[a][b][m][n] = (f32x4){0.f, 0.f, 0.f, 0.f};
        cur = nxt; cA = nA; cB = nB; cD = nD; ++ui;
        if constexpr (ALIGN_EPI) { if (wr == 1) PG8_BAR; }
    }
    PG8_WAIT_V(0);
    if constexpr (!ALIGN_EPI) { if (wr == 0) PG8_BAR; }
    PG8_BAR;
#undef PG8_SA
#undef PG8_SB
#undef PG8_STAGE
#undef PG8_LDA
#undef PG8_LDB
#undef PG8_MMA
#undef PG8_WAIT_V
#undef PG8_WAIT_L
#undef PG8_BAR
#undef PG8_SCHED
}

__device__ __forceinline__ float act_apply(float v, int act) {
    if (act == 1) { const float r = v > 0.f ? v : 0.f; return r * r; }
    if (act == 2) { const float e = __expf(-2.f * fabsf(v)); const float t = (1.f - e) / (1.f + e); return v < 0.f ? -t : t; }
    if (act == 3) return 1.f / (1.f + __expf(-v));
    return v;
}
template <int ACT> __device__ __forceinline__ void store_tile_bf16(const f32x4 (&acc)[2][2][4][2], bf16_t* base, int ldc, int row0, int col0, bf16_t* base2, int ldc2, int col2) {
#pragma unroll
    for (int ai = 0; ai < 2; ++ai)
#pragma unroll
        for (int m = 0; m < 4; ++m) { const size_t r = (size_t)(row0 + ai * HALF + m * 16);
#pragma unroll
            for (int bj = 0; bj < 2; ++bj) { f32x4 v0 = acc[ai][bj][m][0], v1 = acc[ai][bj][m][1];
#pragma unroll
                for (int q = 0; q < 4; ++q) { v0[q] = act_apply(v0[q], ACT); v1[q] = act_apply(v1[q], ACT); }
                u32x4 w; w.x = cvt_pk_bf16(v0[0], v0[1]); w.y = cvt_pk_bf16(v0[2], v0[3]); w.z = cvt_pk_bf16(v1[0], v1[1]); w.w = cvt_pk_bf16(v1[2], v1[3]);
                *(u32x4*)(base + r * ldc + col0 + bj * HALF) = w;
                if (base2) *(u32x4*)(base2 + r * ldc2 + col2 + bj * HALF) = w; } }
}
template <int ACT> struct EpiBf16 {
    static constexpr bool PERM = true;
    bf16_t* O; int ldc;
    __device__ __forceinline__ void operator()(const f32x4 (&acc)[2][2][4][2], const Unit& u, int wr, int wc, int fr, int fq) const {
        store_tile_bf16<ACT>(acc, O, ldc, u.pm * BM + wr * 64 + fr, u.pn * BM + wc * 32 + 8 * fq, nullptr, 0, 0);
    }
};
struct EpiRkv {
    static constexpr bool PERM = true;
    bf16_t* RKV; bf16_t* LO; bf16_t* vf;
    __device__ __forceinline__ void operator()(const f32x4 (&acc)[2][2][4][2], const Unit& u, int wr, int wc, int fr, int fq) const {
        const int row0 = u.pm * BM + wr * 64 + fr, cin = wc * 32 + 8 * fq;
        if (u.pn < 12) { bf16_t* b2 = (u.pn >= 8) ? vf : nullptr; store_tile_bf16<0>(acc, RKV, 3072, row0, u.pn * BM + cin, b2, 1024, (u.pn - 8) * BM + cin); }
        else {
#pragma unroll
            for (int bj = 0; bj < 2; ++bj) { const int c = cin + bj * HALF; int dst = -1, act = 0;
                if (u.pn == 12) { if (c < 64) { dst = c; act = 2; } else if (c < 128) dst = 256 + (c - 64); else if (c < 160) dst = 512 + (c - 128); }
                else if (c < 160) { dst = 768 + c; act = 3; }
                if (dst >= 0) {
#pragma unroll
                    for (int ai = 0; ai < 2; ++ai)
#pragma unroll
                        for (int m = 0; m < 4; ++m) { const size_t r = (size_t)(row0 + ai * HALF + m * 16); f32x4 v0 = acc[ai][bj][m][0], v1 = acc[ai][bj][m][1];
#pragma unroll
                            for (int q = 0; q < 4; ++q) { v0[q] = act_apply(v0[q], act); v1[q] = act_apply(v1[q], act); }
                            u32x4 w; w.x = cvt_pk_bf16(v0[0], v0[1]); w.y = cvt_pk_bf16(v0[2], v0[3]); w.z = cvt_pk_bf16(v1[0], v1[1]); w.w = cvt_pk_bf16(v1[2], v1[3]);
                            *(u32x4*)(LO + r * 1024 + dst) = w; } } }
        }
    }
};
struct EpiRes {
    static constexpr bool PERM = false;
    float* X; const float* modl; int goff; const float* Xin;
    __device__ __forceinline__ void operator()(const f32x4 (&acc)[2][2][4][2], const Unit& u, int wr, int wc, int fr, int fq) const {
        const int col0 = u.pn * BM + wc * 32 + 4 * fq;
#pragma unroll
        for (int ai = 0; ai < 2; ++ai)
#pragma unroll
            for (int m = 0; m < 4; ++m) { const int r = u.pm * BM + ai * HALF + wr * 64 + m * 16 + fr; const float* gp = modl + (size_t)seq_of_row(r) * 6144 + goff + col0; float* xp = X + (size_t)r * D + col0; const float* xi = Xin + (size_t)r * D + col0;
#pragma unroll
                for (int bj = 0; bj < 2; ++bj)
#pragma unroll
                    for (int n = 0; n < 2; ++n) { const f32x4 gv = *(const f32x4*)(gp + bj * HALF + n * 16); f32x4 xv = *(const f32x4*)(xi + bj * HALF + n * 16);
                        xv = xv + gv * acc[ai][bj][m][n]; *(f32x4*)(xp + bj * HALF + n * 16) = xv; }
                asm volatile("" ::: "memory"); }
    }
};
struct EpiLora2 {
    static constexpr bool PERM = false;
    bf16_t* WLOG; bf16_t* Aout; bf16_t* G; bf16_t* RKV; const bf16_t* vf; const float* w0; const float* a0; const float* v0;
    template <int GRP> __device__ __forceinline__ void run(const f32x4 (&acc)[2][2][4][2], const Unit& u, int wr, int wc, int fr, int fq) const {
        const int col0 = (u.pn & 3) * BM + wc * 32 + 4 * fq;
#pragma unroll
        for (int ai = 0; ai < 2; ++ai)
#pragma unroll
            for (int m = 0; m < 4; ++m) { const size_t r = (size_t)(u.pm * BM + ai * HALF + wr * 64 + m * 16 + fr);
#pragma unroll
                for (int bj = 0; bj < 2; ++bj)
#pragma unroll
                    for (int n = 0; n < 2; ++n) { const int c = col0 + bj * HALF + n * 16; const f32x4 a = acc[ai][bj][m][n]; f32x4 o;
                        if constexpr (GRP == 0) { const f32x4 b = *(const f32x4*)(w0 + c);
#pragma unroll
                            for (int q = 0; q < 4; ++q) { const float x = -(b[q] + a[q]); const float sp = fmaxf(x, 0.f) + __logf(1.f + __expf(-fabsf(x))); o[q] = -__expf(-sp - 0.5f); }
                            u32x2 w; w.x = cvt_pk_bf16(o[0], o[1]); w.y = cvt_pk_bf16(o[2], o[3]); *(u32x2*)(WLOG + r * D + c) = w; }
                        else if constexpr (GRP == 1) { const f32x4 b = *(const f32x4*)(a0 + c);
#pragma unroll
                            for (int q = 0; q < 4; ++q) o[q] = 1.f / (1.f + __expf(-(b[q] + a[q])));
                            u32x2 w; w.x = cvt_pk_bf16(o[0], o[1]); w.y = cvt_pk_bf16(o[2], o[3]); *(u32x2*)(Aout + r * D + c) = w; }
                        else if constexpr (GRP == 2) { const f32x4 b = *(const f32x4*)(v0 + c); const u32x2 vv = *(const u32x2*)(RKV + r * 3072 + 2048 + c), ff = *(const u32x2*)(vf + r * D + c);
                            f32x4 v4, f4; v4[0] = bflo(vv.x); v4[1] = bfhi(vv.x); v4[2] = bflo(vv.y); v4[3] = bfhi(vv.y); f4[0] = bflo(ff.x); f4[1] = bfhi(ff.x); f4[2] = bflo(ff.y); f4[3] = bfhi(ff.y);
#pragma unroll
                            for (int q = 0; q < 4; ++q) { const float gte = 1.f / (1.f + __expf(-(b[q] + a[q]))); o[q] = v4[q] + (f4[q] - v4[q]) * gte; }
                            u32x2 w; w.x = cvt_pk_bf16(o[0], o[1]); w.y = cvt_pk_bf16(o[2], o[3]); *(u32x2*)(RKV + r * 3072 + 2048 + c) = w; }
                        else { u32x2 w; w.x = cvt_pk_bf16(a[0], a[1]); w.y = cvt_pk_bf16(a[2], a[3]); *(u32x2*)(G + r * D + c) = w; } }
                asm volatile("" ::: "memory"); }
    }
    __device__ __forceinline__ void operator()(const f32x4 (&acc)[2][2][4][2], const Unit& u, int wr, int wc, int fr, int fq) const {
        const int grp = u.pn >> 2;
        if (grp == 0) run<0>(acc, u, wr, wc, fr, fq);
        else if (grp == 1) run<1>(acc, u, wr, wc, fr, fq);
        else if (grp == 2) { if (vf != nullptr) run<2>(acc, u, wr, wc, fr, fq); }
        else run<3>(acc, u, wr, wc, fr, fq);
    }
};
struct SplitOrder {
    int c, splitk;
    __device__ bool next(int i, Unit& u) const { if (i != 0 || c >= 16 * splitk) return false; const int t = c / splitk; u.pm = 64 + (t >> 2); u.pn = t & 3; u.ks = c % splitk; return true; }
};
struct LoraOrder {
    int c;
    __device__ bool next(int i, Unit& u) const { const int idx = c - 48; if (i != 0 || idx < 0 || idx >= 136) return false; u.pm = idx >> 1; u.pn = 12 + (idx & 1); u.ks = 0; return true; }
};
struct EpiPartial {
    static constexpr bool PERM = false;
    float* PART; int splitk;
    __device__ __forceinline__ void operator()(const f32x4 (&acc)[2][2][4][2], const Unit& u, int wr, int wc, int fr, int fq) const {
        float* base = PART + ((size_t)(((u.pm - 64) * 4 + u.pn) * splitk + u.ks) << 16) + wc * 32 + 4 * fq;
#pragma unroll
        for (int ai = 0; ai < 2; ++ai)
#pragma unroll
            for (int m = 0; m < 4; ++m) { float* rp = base + (ai * HALF + wr * 64 + m * 16 + fr) * 256;
#pragma unroll
                for (int bj = 0; bj < 2; ++bj)
#pragma unroll
                    for (int n = 0; n < 2; ++n) *(f32x4*)(rp + bj * HALF + n * 16) = acc[ai][bj][m][n]; }
    }
};
template <bool PERM_> struct EpiNull {
    static constexpr bool PERM = PERM_;
    __device__ __forceinline__ void operator()(const f32x4 (&acc)[2][2][4][2], const Unit&, int, int, int, int) const {
#pragma unroll
        for (int a = 0; a < 2; ++a)
#pragma unroll
            for (int b = 0; b < 2; ++b)
#pragma unroll
                for (int m = 0; m < 4; ++m)
#pragma unroll
                    for (int n = 0; n < 2; ++n) asm volatile("" :: "v"(acc[a][b][m][n]));
    }
};
}

#define RLX_AGENT __ATOMIC_RELAXED, __HIP_MEMORY_SCOPE_AGENT
#define XB_TMO      128
#define XB_XCNT(j)  (256  + 64 * (j))
#define XB_XSUB(j)  (1280 + 64 * (j))
#define XB_XGEN(j)  (2304 + 64 * (j))
#define XB_TOP      3328
#define XB_TOPGEN   3392
#define XCD_BAR_WORDS 3456
#define XB_SPIN_CAP (1u << 24)
__device__ __forceinline__ unsigned xb_ld(unsigned* p)              { return __hip_atomic_load(p, __ATOMIC_RELAXED, __HIP_MEMORY_SCOPE_AGENT); }
__device__ __forceinline__ unsigned xb_add(unsigned* p, unsigned v) { return __hip_atomic_fetch_add(p, v, __ATOMIC_RELAXED, __HIP_MEMORY_SCOPE_AGENT); }
__device__ __forceinline__ unsigned xb_xcc_id() { return (unsigned)__builtin_amdgcn_s_getreg((3 << 11) | 20) & 0xFu; }
#define XB_SPIN(cond, bar) do { unsigned _sp = 0; while (cond) { __builtin_amdgcn_s_sleep(4); \
    if ((++_sp & 255u) == 0u) { if (xb_ld(&(bar)[XB_TMO])) break; if (_sp > XB_SPIN_CAP) { atomicAdd(&(bar)[XB_TMO], 1u); break; } } } } while (0)
struct XcdBarrier { unsigned* bar; unsigned x; volatile LAS unsigned* st; };
__device__ __forceinline__ XcdBarrier xcd_barrier_post(unsigned* bar, volatile LAS unsigned* st) {
    XcdBarrier b; b.bar = bar; b.x = xb_xcc_id(); b.st = st;
    if (threadIdx.x == 0) (void)xb_add(&bar[XB_XCNT(b.x)], 1u);
    return b;
}
__device__ __forceinline__ void xcd_barrier_complete(unsigned* bar, unsigned x, unsigned& nloc, unsigned& nx) {
    const unsigned G = gridDim.x * gridDim.y * gridDim.z;
    unsigned sum, cnt, mine, sp = 0u;
    for (;;) {
        sum = 0u; cnt = 0u; mine = 0u;
#pragma unroll
        for (unsigned j = 0; j < 16; ++j) { const unsigned c = xb_ld(&bar[XB_XCNT(j)]); sum += c; cnt += (c > 0u) ? 1u : 0u; mine = (j == x) ? c : mine; }
        if (sum == G) break;
        __builtin_amdgcn_s_sleep(1);
        if ((++sp & 255u) == 0u) { if (xb_ld(&bar[XB_TMO])) break; if (sp > XB_SPIN_CAP) { atomicAdd(&bar[XB_TMO], 1u); break; } }
    }
    nloc = mine > 0u ? mine : 1u; nx = cnt > 0u ? cnt : 1u;
}
__device__ __forceinline__ void xcd_barrier(const XcdBarrier& b) {
    asm volatile("s_waitcnt vmcnt(0)" ::: "memory");
    __syncthreads();
    if (threadIdx.x == 0) {
        unsigned* bar = b.bar;
        __builtin_amdgcn_s_waitcnt(0);
        unsigned nloc = b.st[0], nx = b.st[1];
        if (nloc == 0u) { xcd_barrier_complete(bar, b.x, nloc, nx); b.st[0] = nloc; b.st[1] = nx; }
        const unsigned gen = b.st[2];
        const unsigned old = xb_add(&bar[XB_XSUB(b.x)], 1u);
        if (old + 1u == (gen + 1u) * nloc) {
            __builtin_amdgcn_fence(__ATOMIC_RELEASE, "agent");
            asm volatile("s_waitcnt vmcnt(0)" ::: "memory");
            const unsigned og = xb_add(&bar[XB_TOP], 1u);
            if (og + 1u == (gen + 1u) * nx) xb_add(&bar[XB_TOPGEN], 1u);
            else XB_SPIN(xb_ld(&bar[XB_TOPGEN]) == gen, bar);
        } else {
            XB_SPIN(xb_ld(&bar[XB_TOPGEN]) == gen, bar);
        }
        __builtin_amdgcn_fence(__ATOMIC_ACQUIRE, "agent");
        asm volatile("s_waitcnt vmcnt(0)" ::: "memory");
        b.st[2] = gen + 1u;
    }
    __syncthreads();
}

constexpr int NWAVES = 8, NT = NWAVES * 64;
constexpr int RING_BYTES = 131072, LDSCTL_OFF = RING_BYTES, MISC_OFF = LDSCTL_OFF + 320, LDS_BYTES = 147456;
constexpr int CW_BAR = 4096;

struct Args { const float* in[38]; float* out; unsigned char* ws; };
struct Frame {
    LAS unsigned char* lds; volatile LAS unsigned* MISC;
    int wave, vcu, G;
    const float* const* in; float* out; unsigned char* ws;
};
enum { I_XP = 0, I_XS, I_SRET, I_SHG, I_SWKV, I_SSHIFT, I_CP, I_CS, I_MODW, I_MODB, I_NMIXG, I_NMLPG, I_FINALG, I_W1, I_W2, I_ABWIN, I_ABWOUT, I_HGLB, I_HGNG,
       I_MU, I_WRKV, I_RW0, I_RW1, I_RW2, I_RA0, I_RA1, I_RA2, I_RV0, I_RV1, I_RV2, I_RG1, I_RG2, I_RKK, I_RKA, I_RRK, I_RLNG, I_RLNB, I_RWOUT };
constexpr size_t O_Y = 0, O_RETP = 17825792, O_RETS = 17891328, O_HGP = 19988480, O_HGS = 20119552, O_WKVP = 24313856, O_WKVS = 24444928, O_SHP = 28639232, O_SHS = 28641280;

__device__ __forceinline__ void transpose_item(const float* W, int N, bf16_t* WT, int ldt, int row_off, int col_off, const float* mu, int mode, LAS float* scr, int item, int lane) {
    const int nblk = N / 32, kb = item / nblk, nb = item % nblk, k0 = 64 * kb, n0 = 32 * nb;
#pragma unroll 8
    for (int i = 0; i < 32; ++i) { const int kk = 2 * i + (lane >> 5); float s = 1.f; if (mode == 1) s = 1.f - mu[k0 + kk]; else if (mode == 2) s = mu[k0 + kk];
        scr[kk * 33 + (lane & 31)] = W[(size_t)(k0 + kk) * N + n0 + (lane & 31)] * s; }
    LDS_WAIT(); asm volatile("" ::: "memory");
    const int c = lane & 7;
#pragma unroll
    for (int j = 0; j < 4; ++j) { const int n = (lane >> 3) + 8 * j; const LAS float* s = scr + (8 * c) * 33 + n;
        u32x4 o; o.x = pk2(s[0 * 33], s[1 * 33]); o.y = pk2(s[2 * 33], s[3 * 33]); o.z = pk2(s[4 * 33], s[5 * 33]); o.w = pk2(s[6 * 33], s[7 * 33]);
        *(u32x4*)(WT + (size_t)(row_off + n0 + n) * ldt + col_off + k0 + 8 * c) = o; }
    LDS_WAIT(); asm volatile("" ::: "memory");
}
__device__ __forceinline__ void convert_layer_weights(Frame& F, int layer) {
    const int tid = otid(); const int lane = tid & 63; (void)lane;
    LAS float* scr = (LAS float*)(F.lds + F.wave * 16384);
    const int gw = F.vcu * NWAVES + F.wave, NGW = F.G * NWAVES;
    unsigned char* ar = F.ws + WS_ARENA;
    const int m = layer >> 1;
    constexpr int I_1 = (D / 64) * (DFF / 32), I_2 = (DFF / 64) * (D / 32);
    const float* w1 = F.in[I_W1] + (size_t)layer * D * DFF; const float* w2 = F.in[I_W2] + (size_t)layer * DFF * D;
    if ((layer & 1) == 0) {
        constexpr int I_IN = (D / 64) * (ABIN / 32), I_OUT = (D / 64) * (D / 32), NI = I_1 + I_2 + I_IN + I_OUT;
        const float* win = F.in[I_ABWIN] + (size_t)m * D * ABIN; const float* wout = F.in[I_ABWOUT] + (size_t)m * D * D;
        for (int it = gw; it < NI; it += NGW) { int r = it;
            if (r < I_1) { transpose_item(w1, DFF, (bf16_t*)(ar + AR_W1), D, 0, 0, nullptr, 0, scr, r, lane); continue; } r -= I_1;
            if (r < I_2) { transpose_item(w2, D, (bf16_t*)(ar + AR_W2), DFF, 0, 0, nullptr, 0, scr, r, lane); continue; } r -= I_2;
            if (r < I_IN) { transpose_item(win, ABIN, (bf16_t*)(ar + AR_WIN), D, 0, 0, nullptr, 0, scr, r, lane); continue; } r -= I_IN;
            transpose_item(wout, D, (bf16_t*)(ar + AR_WOUT), D, 0, 0, nullptr, 0, scr, r, lane); }
    } else {
        constexpr int I_P = (D / 64) * (D / 32), NI = I_1 + I_2 + 4 * I_P;
        const float* mu = F.in[I_MU] + (size_t)m * 6 * D; const float* wrkv = F.in[I_WRKV] + (size_t)m * 3 * D * D; const float* wo = F.in[I_RWOUT] + (size_t)m * D * D;
        bf16_t* wc1 = (bf16_t*)(ar + AR_WC1);
        for (int it = gw; it < NI; it += NGW) { int r = it;
            if (r < I_1) { transpose_item(w1, DFF, (bf16_t*)(ar + AR_W1), D, 0, 0, nullptr, 0, scr, r, lane); continue; } r -= I_1;
            if (r < I_2) { transpose_item(w2, D, (bf16_t*)(ar + AR_W2), DFF, 0, 0, nullptr, 0, scr, r, lane); continue; } r -= I_2;
            if (r < 3 * I_P) { const int p = r / I_P;
                transpose_item(wrkv + (size_t)p * D * D, D, wc1, 2048, p * D, 0, nullptr, 0, scr, r % I_P, lane); continue; } r -= 3 * I_P;
            transpose_item(wo, D, (bf16_t*)(ar + AR_WO), D, 0, 0, nullptr, 0, scr, r, lane); }
        const int gt = F.vcu * NT + tid, NG = F.G * NT;
        const float* lw1 = F.in[I_RW1] + (size_t)m * D * 64; const float* la1 = F.in[I_RA1] + (size_t)m * D * 64; const float* lv1 = F.in[I_RV1]; const float* lg1 = F.in[I_RG1] + (size_t)m * D * 160;
        for (int idx = gt; idx < 512 * 2048; idx += NG) { const int n = idx >> 11, k = idx & 2047, kk = k & 1023, nn = n & 255;
            const float* src = nullptr; int ns = 0, mi = 0, nc = 0;
            if (n < 256) { if (nn < 64) { src = lw1; ns = 64; mi = 1; nc = nn; } else if (nn < 128) { src = la1; ns = 64; mi = 4; nc = nn - 64; } else if (nn < 160 && m == 1) { src = lv1; ns = 32; mi = 3; nc = nn - 128; } }
            else if (nn < 160) { src = lg1; ns = 160; mi = 5; nc = nn; }
            float v = 0.f; if (src) { const float muv = mu[mi * D + kk]; v = src[(size_t)kk * ns + nc] * (k < 1024 ? 1.f - muv : muv); }
            wc1[(size_t)(3072 + n) * 2048 + k] = (bf16_t)f2bf(v); }
        bf16_t* wc2 = (bf16_t*)(ar + AR_WC2);
        const float* lw2 = F.in[I_RW2] + (size_t)m * 64 * D; const float* la2 = F.in[I_RA2] + (size_t)m * 64 * D; const float* lv2 = F.in[I_RV2]; const float* lg2 = F.in[I_RG2] + (size_t)m * 160 * D;
        for (int idx = gt; idx < 4096 * 256; idx += NG) { const int k = idx >> 12, n = idx & 4095, g = n >> 10, nn = n & 1023;
            const float* src = (g == 0) ? lw2 : (g == 1) ? la2 : (g == 2) ? lv2 : lg2; const int ks = (g == 0 || g == 1) ? 64 : (g == 2 ? 32 : 160);
            float v = 0.f; if (k < ks && !(g == 2 && m == 0)) v = src[(size_t)k * D + nn];
            wc2[(size_t)n * 256 + k] = (bf16_t)f2bf(v); }
    }
}

__device__ __forceinline__ void mod_phase(Frame& F) {
    const int tid = otid(); const int lane = tid & 63;
    const float* __restrict__ SC = (const float*)(F.ws + WS_MOD + 3584 * 1024);
    float* MOD = (float*)(F.ws + WS_MOD);
    LAS float* red = (LAS float*)F.lds;
    for (int task = F.vcu; task < 4 * 96; task += F.G) { const int l = task / 96, n = (task % 96) * 64 + lane, ks = F.wave;
        const float* w = F.in[I_MODW] + ((size_t)l * D + ks * 128) * 6144 + n;
        float acc[NSEQ];
#pragma unroll
        for (int s = 0; s < NSEQ; ++s) acc[s] = 0.f;
        for (int k = 0; k < 128; k += 4) { const float w0 = w[(size_t)k * 6144], w1 = w[(size_t)(k + 1) * 6144], w2 = w[(size_t)(k + 2) * 6144], w3 = w[(size_t)(k + 3) * 6144];
#pragma unroll
            for (int s = 0; s < NSEQ; ++s) { const f32x4 c4 = *(const f32x4*)(SC + s * D + ks * 128 + k); acc[s] += (c4[0] * w0 + c4[1] * w1) + (c4[2] * w2 + c4[3] * w3); } }
        __syncthreads();
#pragma unroll
        for (int s = 0; s < NSEQ; ++s) red[(F.wave * NSEQ + s) * 64 + lane] = acc[s];
        __syncthreads();
        for (int i = tid; i < NSEQ * 64; i += NT) { const int s = i >> 6, c = i & 63; float t = F.in[I_MODB][l * 6144 + (task % 96) * 64 + c];
#pragma unroll
            for (int q = 0; q < 8; ++q) t += red[(q * NSEQ + s) * 64 + c];
            MOD[((size_t)l * NSEQ + s) * 6144 + (task % 96) * 64 + c] = t; }
    }
    __syncthreads();
}

__device__ __forceinline__ void prologue(Frame& F) {
    const int tid = otid(); const int lane = tid & 63; (void)lane;
    const int gt = F.vcu * NT + tid, NG = F.G * NT;
    { f32x2* tab = (f32x2*)(F.ws + WS_ROPE);
      for (int i = gt; i < 16384 * 32; i += NG) { const int p = i >> 5, d = i & 31; double rev = (double)p * ROPE_REV[d]; rev -= floor(rev); const float fr = (float)rev;
          tab[i] = (f32x2){__builtin_amdgcn_cosf(fr), __builtin_amdgcn_sinf(fr)}; } }
    { unsigned* z = (unsigned*)(F.ws + WS_XN0); for (int i = gt; i < 512; i += NG) z[i] = 0u; }
    { float* SC = (float*)(F.ws + WS_MOD + 3584 * 1024);
      for (int i = gt; i < NSEQ * D; i += NG) { const int s = i >> 10, k = i & 1023; const float c = (s == 0) ? F.in[I_CP][k] : F.in[I_CS][(size_t)(s - 1) * D + k]; SC[i] = siluf_(c); } }
    convert_layer_weights(F, 0);
}

template <int MODE> __device__ __forceinline__ void norm_row(Frame& F, int layer, int r, f32x4 (&v)[4], const float* MOD, const float* gvec, int lane, f32x4 (&ho)[4]) {
    const int m = layer >> 1; const int shoff = (MODE == 2) ? 3072 : 0, scoff = (MODE == 2) ? 4096 : 1024;
    bf16_t* XN = (bf16_t*)(F.ws + WS_XN); bf16_t* PREVS = (bf16_t*)(F.ws + WS_PREVS);
    float* xrow = F.out + (size_t)r * D; float s2 = 0.f;
#pragma unroll
    for (int j = 0; j < 4; ++j) s2 += (v[j].x * v[j].x + v[j].y * v[j].y) + (v[j].z * v[j].z + v[j].w * v[j].w);
    const float rstd = 1.f / sqrtf(wave_sum(s2) * (1.f / D) + NORM_EPS);
    const int seq = seq_of_row(r); const float* mp = MOD + (size_t)seq * 6144;
#pragma unroll
    for (int j = 0; j < 4; ++j) { const int c = 4 * lane + 256 * j; const f32x4 g4 = *(const f32x4*)(gvec + c); f32x4 o = v[j] * rstd * g4;
        if (MODE == 3) { *((f32x4*)xrow + lane + 64 * j) = o; continue; }
        const f32x4 sc = *(const f32x4*)(mp + scoff + c), sh = *(const f32x4*)(mp + shoff + c);
        o = o * (1.f + sc) + sh; ho[j] = o;
        const unsigned long long pk = (unsigned long long)pk2(o.x, o.y) | ((unsigned long long)pk2(o.z, o.w) << 32);
        *(unsigned long long*)(XN + (size_t)r * D + c) = pk;
        if (MODE == 1) {
            if (r >= MP) { const int t = (r - MP) & 31; if (t < 31) *(unsigned long long*)(PREVS + (size_t)(r - MP + 1) * D + c) = pk;
                else *(f32x4*)(F.out + O_SHS + ((size_t)m * 32 + ((r - MP) >> 5)) * D + c) = o;
                if (t == 0) { const f32x4 ss = *(const f32x4*)(F.in[I_SSHIFT] + ((size_t)m * 32 + ((r - MP) >> 5)) * D + c);
                    *(unsigned long long*)(PREVS + (size_t)(r - MP) * D + c) = (unsigned long long)pk2(ss.x, ss.y) | ((unsigned long long)pk2(ss.z, ss.w) << 32); } }
            else if (r == MP - 1) *(f32x4*)(F.out + O_SHP + (size_t)m * D + c) = o;
        } }
}
__device__ __forceinline__ void hmix_calc(const float* mp, const float* gvec, const f32x4 (&v)[4], int lane, f32x4 (&h)[4]) {
    float s2 = 0.f;
#pragma unroll
    for (int j = 0; j < 4; ++j) s2 += (v[j].x * v[j].x + v[j].y * v[j].y) + (v[j].z * v[j].z + v[j].w * v[j].w);
    const float rstd = 1.f / sqrtf(wave_sum(s2) * (1.f / D) + NORM_EPS);
#pragma unroll
    for (int j = 0; j < 4; ++j) { const int c = 4 * lane + 256 * j; const f32x4 g4 = *(const f32x4*)(gvec + c), sc = *(const f32x4*)(mp + 1024 + c), sh = *(const f32x4*)(mp + c); h[j] = v[j] * rstd * g4 * (1.f + sc) + sh; }
}
__device__ __forceinline__ void write_mixes(Frame& F, int m, int r, const f32x4 (&h)[4], const f32x4 (&p)[4], int lane) {
    bf16_t* XM = (bf16_t*)(F.ws + WS_XMIX); const float* mu = F.in[I_MU] + (size_t)m * 6 * D;
#pragma unroll
    for (int j = 0; j < 4; ++j) { const int c = 4 * lane + 256 * j; const f32x4 d = p[j] - h[j];
#pragma unroll
        for (int q = 0; q < 3; ++q) { const f32x4 mv = *(const f32x4*)(mu + (q == 0 ? 0 : (q == 1 ? 2 : 3)) * D + c); const f32x4 x = h[j] + d * mv;
            *(unsigned long long*)(XM + ((size_t)q * M + r) * D + c) = (unsigned long long)pk2(x.x, x.y) | ((unsigned long long)pk2(x.z, x.w) << 32); } }
}
template <int MODE, int PEND = 0, bool FIRSTP = false, bool FIRSTS = false> __device__ __forceinline__ void norm_pass(Frame& F, int layer, int player = 0, int pgoff = 0) {
    const int tid = otid(); const int lane = tid & 63;
    const int gw = F.vcu * NWAVES + F.wave, NGW = F.G * NWAVES;
    const float* MOD = (const float*)(F.ws + WS_MOD) + (size_t)layer * NSEQ * 6144;
    const float* gvec = (MODE == 3) ? F.in[I_FINALG] : (MODE == 2 ? F.in[I_NMLPG] + layer * D : F.in[I_NMIXG] + layer * D);
    LAS float* xs = (LAS float*)F.lds;
    const int m = layer >> 1; const int r0s = MP + 4 * F.vcu;
    const float* gmod = (const float*)(F.ws + WS_MOD) + (size_t)player * NSEQ * 6144 + pgoff;
    if constexpr (MODE == 1) {
        static_assert(PEND > 0, "the RWKV mix norm always follows an MLP-down GEMM");
        if (F.vcu < 32) { const int sq = F.vcu, rbase = MP + 32 * sq; const float* mp = MOD + (size_t)(1 + sq) * 6144;
            __syncthreads();
#pragma unroll 2
            for (int q = 0; q < 16; ++q) { const int idx = tid + q * NT, rr = idx >> 8, c4 = (idx & 255) * 4; const int r = rbase + rr;
                const int pn = c4 >> 8; const float* pb = (const float*)(F.ws + WS_PART) + ((size_t)((((r >> 8) - 64) * 4 + pn) * PEND) << 16) + (r & 255) * 256 + (c4 & 255);
                f32x4 acc = (f32x4){0.f, 0.f, 0.f, 0.f};
#pragma unroll
                for (int ks = 0; ks < PEND; ++ks) acc += *(const f32x4*)(pb + ((size_t)ks << 16));
                const f32x4 g4 = *(const f32x4*)(gmod + (size_t)(1 + sq) * 6144 + c4); f32x4 x4 = *(const f32x4*)(F.out + (size_t)r * D + c4);
                x4 = x4 + g4 * acc; *(f32x4*)(F.out + (size_t)r * D + c4) = x4; *(LAS f32x4*)(xs + rr * 1024 + c4) = x4; }
            __syncthreads();
            for (int rr = F.wave; rr < 32; rr += NWAVES) { const int r = rbase + rr; f32x4 v[4], ho[4], hp[4];
#pragma unroll
                for (int j = 0; j < 4; ++j) v[j] = *(const LAS f32x4*)(xs + rr * 1024 + 4 * lane + 256 * j);
                norm_row<MODE>(F, layer, r, v, MOD, gvec, lane, ho);
                if (rr == 0) {
#pragma unroll
                    for (int j = 0; j < 4; ++j) hp[j] = *((const f32x4*)(F.in[I_SSHIFT] + ((size_t)m * 32 + sq) * D) + lane + 64 * j);
                } else { f32x4 pv[4];
#pragma unroll
                    for (int j = 0; j < 4; ++j) pv[j] = *(const LAS f32x4*)(xs + (rr - 1) * 1024 + 4 * lane + 256 * j);
                    hmix_calc(mp, gvec, pv, lane, hp); }
                write_mixes(F, m, r, ho, hp, lane); }
            __syncthreads(); }
    } else if constexpr (PEND > 0) {
        __syncthreads();
#pragma unroll
        for (int q = 0; q < 2; ++q) { const int idx = tid + q * NT, rr = idx >> 8, c4 = (idx & 255) * 4; const int r = r0s + rr; if (4 * F.vcu + rr < MS) {
                const int pn = c4 >> 8; const float* pb = (const float*)(F.ws + WS_PART) + ((size_t)((((r >> 8) - 64) * 4 + pn) * PEND) << 16) + (r & 255) * 256 + (c4 & 255);
                f32x4 acc = (f32x4){0.f, 0.f, 0.f, 0.f};
#pragma unroll
                for (int ks = 0; ks < PEND; ++ks) acc += *(const f32x4*)(pb + ((size_t)ks << 16));
                const f32x4 g4 = *(const f32x4*)(gmod + (size_t)seq_of_row(r) * 6144 + c4); f32x4 x4 = FIRSTS ? *(const f32x4*)(F.in[I_XS] + (size_t)(r - MP) * D + c4) : *(const f32x4*)(F.out + (size_t)r * D + c4);
                x4 = x4 + g4 * acc; *(f32x4*)(F.out + (size_t)r * D + c4) = x4; *(LAS f32x4*)(xs + rr * 1024 + c4) = x4; } }
        __syncthreads();
    }
    for (int r = gw; r < MP; r += NGW) {
        const f32x4* xr = (const f32x4*)((FIRSTP ? F.in[I_XP] : F.out) + (size_t)r * D) + lane; f32x4 v[4], ho[4];
#pragma unroll
        for (int j = 0; j < 4; ++j) v[j] = xr[64 * j];
        if constexpr (MODE == 1) { f32x4 pv[4], hp[4];
#pragma unroll
            for (int j = 0; j < 4; ++j) pv[j] = (r > 0) ? *((const f32x4*)(F.out + (size_t)(r - 1) * D) + lane + 64 * j) : (f32x4){0.f, 0.f, 0.f, 0.f};
            norm_row<MODE>(F, layer, r, v, MOD, gvec, lane, ho);
            if (r > 0) hmix_calc(MOD, gvec, pv, lane, hp); else {
#pragma unroll
                for (int j = 0; j < 4; ++j) hp[j] = (f32x4){0.f, 0.f, 0.f, 0.f}; }
            write_mixes(F, m, r, ho, hp, lane);
        } else norm_row<MODE>(F, layer, r, v, MOD, gvec, lane, ho);
    }
    if constexpr (MODE != 1) {
        if (F.wave < 4 && 4 * F.vcu + F.wave < MS) { const int r = r0s + F.wave; f32x4 v[4], ho[4];
#pragma unroll
            for (int j = 0; j < 4; ++j) { if constexpr (PEND > 0) v[j] = *(const LAS f32x4*)(xs + F.wave * 1024 + 4 * lane + 256 * j); else v[j] = *((const f32x4*)(FIRSTS ? F.in[I_XS] + (size_t)(r - MP) * D : F.out + (size_t)r * D) + lane + 64 * j); }
            norm_row<MODE>(F, layer, r, v, MOD, gvec, lane, ho); } }
}

template <int MT, int NTT> __device__ __forceinline__ void wave_mm_nt(f32x4 (&acc)[MT][NTT], const LAS bf16_t* X, int ldx, const LAS bf16_t* Y, int ldy, int K, int fr, int fq) {
    for (int k0 = 0; k0 < K; k0 += 32) {
        bf16x8 xa[MT], yb[NTT];
#pragma unroll
        for (int i = 0; i < MT; ++i) xa[i] = *(const LAS bf16x8*)(X + (16 * i + fr) * ldx + k0 + 8 * fq);
#pragma unroll
        for (int j = 0; j < NTT; ++j) yb[j] = *(const LAS bf16x8*)(Y + (16 * j + fr) * ldy + k0 + 8 * fq);
#pragma unroll
        for (int i = 0; i < MT; ++i)
#pragma unroll
            for (int j = 0; j < NTT; ++j) acc[i][j] = __builtin_amdgcn_mfma_f32_16x16x32_bf16(yb[j], xa[i], acc[i][j], 0, 0, 0);
    }
}

constexpr int LQS = 0, LKS = 18432, LQG = 36864, LVT = 55296, LST = 73728, LPS = 108544, LRED = 117760, LBS = 118784;
__device__ __forceinline__ void chunk_geom(int c, int& r0, int& pos0) { if (c < 256) { r0 = 64 * c; pos0 = 64 * c; } else { r0 = MP + 32 * (c - 256); pos0 = 2048; } }

template <int L, bool HG, bool SUMMARY> __device__ __forceinline__ void ab_load(Frame& F, int layer, int c, int h) {
    const int tid = otid(); const int lane = tid & 63; (void)lane;
    const int m = layer >> 1; int r0, pos0; chunk_geom(c, r0, pos0);
    const bf16_t* Z = (const bf16_t*)(F.ws + WS_Z);
    LAS bf16_t* QS = (LAS bf16_t*)(F.lds + LQS); LAS bf16_t* KS = (LAS bf16_t*)(F.lds + LKS); LAS bf16_t* QG = (LAS bf16_t*)(F.lds + LQG); LAS bf16_t* VT = (LAS bf16_t*)(F.lds + LVT);
    constexpr int LDT = L + 8;
    if constexpr (HG) {
        constexpr int TQ = L / 4; LAS float* BS = (LAS float*)(F.lds + LBS);
        const int ch = tid & 127, qtr = tid >> 7;
        float lb = 0.f;
        if (m == 1) { const float a0 = F.in[I_HGLB][h * 128 + ch], a1 = F.in[I_HGLB][512 + h * 128 + ch]; lb = 1.f / (1.f + __expf(a0 - a1)); }
        { constexpr int NP = L * 16;
#pragma unroll
          for (int q = 0; q < (NP + NT - 1) / NT; ++q) { const int v = tid + q * NT; if (NP % NT == 0 || v < NP) { const int j = v >> 4, c8 = v & 15; const size_t zr = (size_t)(r0 + j) * ABIN + h * 128 + c8 * 8;
                  const u32x4 zf4 = *(const u32x4*)(Z + zr + 2048), v4 = *(const u32x4*)(Z + zr + 2560);
                  *(LAS u32x4*)(QG + j * 136 + c8 * 8) = zf4; *(LAS u32x4*)(KS + j * 136 + c8 * 8) = v4;
                  if constexpr (!SUMMARY) { const u32x4 q4 = *(const u32x4*)(Z + zr + 1536); *(LAS u32x4*)(QS + j * 136 + c8 * 8) = q4; } } } }
        __syncthreads();
        float zf[TQ], cs[TQ]; float run = 0.f;
#pragma unroll
        for (int jj = 0; jj < TQ; ++jj) { const int j = qtr * TQ + jj; zf[jj] = bf2f(QG[j * 136 + ch]);
            float lf; if (lb == 0.f) lf = fminf(zf[jj], 0.f) - __logf(1.f + __expf(-fabsf(zf[jj]))); else lf = __logf(lb + (1.f - lb) * sigmoidf_(zf[jj]));
            run += lf; cs[jj] = run; }
        BS[qtr * 128 + ch] = run;
        __syncthreads();
        const float b0 = BS[ch], b1 = BS[128 + ch], b2 = BS[256 + ch], b3 = BS[384 + ch];
        const float off = (qtr > 0 ? b0 : 0.f) + (qtr > 1 ? b1 : 0.f) + (qtr > 2 ? b2 : 0.f), bL = (b0 + b1) + (b2 + b3), bmid = b0 + b1;
        if constexpr (SUMMARY) {
#pragma unroll
            for (int j8 = 0; j8 < TQ; j8 += 8) { unsigned vv[8]; float kd[8];
#pragma unroll
                for (int q = 0; q < 8; ++q) { const int jj = j8 + q, j = qtr * TQ + jj; const float b = off + cs[jj]; const float kb = (1.f - lb) * sigmoidf_(-zf[jj]); vv[q] = KS[j * 136 + ch]; kd[q] = kb * __expf(bL - b); }
                u32x4 pv, pk; pv.x = vv[0] | (vv[1] << 16); pv.y = vv[2] | (vv[3] << 16); pv.z = vv[4] | (vv[5] << 16); pv.w = vv[6] | (vv[7] << 16);
                pk.x = pk2(kd[0], kd[1]); pk.y = pk2(kd[2], kd[3]); pk.z = pk2(kd[4], kd[5]); pk.w = pk2(kd[6], kd[7]);
                *(LAS u32x4*)(VT + ch * LDT + qtr * TQ + j8) = pv; *(LAS u32x4*)(QS + ch * LDT + qtr * TQ + j8) = pk; }
            if (qtr == 0) ((float*)(F.ws + WS_DEC))[((size_t)c * 4 + h) * 128 + ch] = __expf(bL);
        } else {
#pragma unroll
            for (int j8 = 0; j8 < TQ; j8 += 8) { unsigned vv[8];
#pragma unroll
                for (int q8 = 0; q8 < 8; ++q8) { const int jj = j8 + q8, j = qtr * TQ + jj; const float b = off + cs[jj]; const float kb = (1.f - lb) * sigmoidf_(-zf[jj]);
                    const float q = siluf_(bf2f(QS[j * 136 + ch])); vv[q8] = KS[j * 136 + ch];
                    QS[j * 136 + ch] = (bf16_t)f2bf(q * __expf(b - bmid)); KS[j * 136 + ch] = (bf16_t)f2bf(kb * __expf(bmid - b)); QG[j * 136 + ch] = (bf16_t)f2bf(q * __expf(b)); }
                u32x4 pv; pv.x = vv[0] | (vv[1] << 16); pv.y = vv[2] | (vv[3] << 16); pv.z = vv[4] | (vv[5] << 16); pv.w = vv[6] | (vv[7] << 16);
                *(LAS u32x4*)(VT + ch * LDT + qtr * TQ + j8) = pv; }
        }
    } else {
        const float logg = log1pf(-exp2f(-5.f - (float)h));
        const f32x2* rope = (const f32x2*)(F.ws + WS_ROPE);
        for (int it = tid; it < L * 4; it += NT) { const int j = it >> 2, d8 = it & 3; const size_t zr = (size_t)(r0 + j) * ABIN;
            const f32x2* rp = rope + (size_t)(pos0 + j) * 32 + d8 * 8;
            const u32x4 k1 = *(const u32x4*)(Z + zr + 256 + h * 64 + d8 * 8), k2 = *(const u32x4*)(Z + zr + 256 + h * 64 + 32 + d8 * 8);
            const float gk = __expf((float)(L - 1 - j) * logg), gq = __expf((float)(j + 1) * logg);
            u32x4 q1 = (u32x4){0, 0, 0, 0}, q2 = q1; if constexpr (!SUMMARY) { q1 = *(const u32x4*)(Z + zr + h * 64 + d8 * 8); q2 = *(const u32x4*)(Z + zr + h * 64 + 32 + d8 * 8); }
#pragma unroll
            for (int e = 0; e < 8; ++e) { const f32x2 cs_ = rp[e]; const unsigned wk1 = k1[e >> 1], wk2 = k2[e >> 1]; const float x1 = (e & 1) ? bfhi(wk1) : bflo(wk1), x2 = (e & 1) ? bfhi(wk2) : bflo(wk2);
                const float o1 = x1 * cs_.x - x2 * cs_.y, o2 = x1 * cs_.y + x2 * cs_.x; const int d = d8 * 8 + e;
                if constexpr (SUMMARY) { QS[d * LDT + j] = (bf16_t)f2bf(o1 * gk); QS[(d + 32) * LDT + j] = (bf16_t)f2bf(o2 * gk); }
                else { KS[j * 72 + d] = (bf16_t)f2bf(o1); KS[j * 72 + d + 32] = (bf16_t)f2bf(o2);
                    const unsigned wq1 = q1[e >> 1], wq2 = q2[e >> 1]; const float y1 = (e & 1) ? bfhi(wq1) : bflo(wq1), y2 = (e & 1) ? bfhi(wq2) : bflo(wq2);
                    const float p1 = (y1 * cs_.x - y2 * cs_.y) * 0.125f, p2 = (y1 * cs_.y + y2 * cs_.x) * 0.125f;
                    QS[j * 72 + d] = (bf16_t)f2bf(p1); QS[j * 72 + d + 32] = (bf16_t)f2bf(p2); QG[j * 72 + d] = (bf16_t)f2bf(p1 * gq); QG[j * 72 + d + 32] = (bf16_t)f2bf(p2 * gq); } } }
        for (int it = tid; it < L * 16; it += NT) { const int j = it >> 4, e8 = it & 15; const u32x4 vv = *(const u32x4*)(Z + (size_t)(r0 + j) * ABIN + 512 + h * 128 + e8 * 8);
#pragma unroll
            for (int e = 0; e < 8; ++e) { const unsigned w = vv[e >> 1]; VT[(e8 * 8 + e) * LDT + j] = (bf16_t)((e & 1) ? (w >> 16) : (w & 0xffffu)); } }
    }
}

template <int L, bool HG> __device__ __forceinline__ void ab_summary_unit(Frame& F, int layer, int c, int h) {
    const int tid = otid(); const int lane = tid & 63; (void)lane;
    constexpr int DK = HG ? 128 : 64, NCT = DK / 16, LDT = L + 8;
    __syncthreads();
    ab_load<L, HG, true>(F, layer, c, h);
    __syncthreads();
    const int fr = lane & 15, fq = lane >> 4;
    const LAS bf16_t* KDT = (const LAS bf16_t*)(F.lds + LQS); const LAS bf16_t* VT = (const LAS bf16_t*)(F.lds + LVT);
    f32x4 acc[1][NCT];
#pragma unroll
    for (int j = 0; j < NCT; ++j) acc[0][j] = (f32x4){0.f, 0.f, 0.f, 0.f};
    wave_mm_nt<1, NCT>(acc, VT + F.wave * 16 * LDT, LDT, KDT, LDT, L, fr, fq);
    bf16_t* ST = (bf16_t*)(F.ws + WS_STATE) + (size_t)c * SLOT_E + (HG ? 32768 + h * 16384 : h * 8192);
    const int e = F.wave * 16 + fr;
#pragma unroll
    for (int j = 0; j < NCT; ++j) { u32x2 w; w.x = pk2(acc[0][j][0], acc[0][j][1]); w.y = pk2(acc[0][j][2], acc[0][j][3]); *(u32x2*)(ST + (size_t)e * DK + 16 * j + 4 * fq) = w; }
}

template <int L, bool HG> __device__ __forceinline__ void ab_output_unit(Frame& F, int layer, int c, int h) {
    const int tid = otid(); const int lane = tid & 63; (void)lane;
    constexpr int DK = HG ? 128 : 64, LDQ = HG ? 136 : 72, LDT = L + 8, NIT = L / 16, WPI = 8 / NIT, ET = 8 / WPI, TPW = (NIT * NIT >= 8) ? NIT * NIT / 8 : 1;
    const int m = layer >> 1; int r0, pos0; chunk_geom(c, r0, pos0);
    __syncthreads();
    ab_load<L, HG, false>(F, layer, c, h);
    LAS bf16_t* QS = (LAS bf16_t*)(F.lds + LQS); LAS bf16_t* KS = (LAS bf16_t*)(F.lds + LKS); LAS bf16_t* QG = (LAS bf16_t*)(F.lds + LQG); LAS bf16_t* VT = (LAS bf16_t*)(F.lds + LVT);
    LAS bf16_t* STl = (LAS bf16_t*)(F.lds + LST); LAS bf16_t* PS = (LAS bf16_t*)(F.lds + LPS); LAS float* RED = (LAS float*)(F.lds + LRED);
    { const bf16_t* ST = (const bf16_t*)(F.ws + WS_STATE) + (size_t)c * SLOT_E + (HG ? 32768 + h * 16384 : h * 8192);
      for (int it = tid; it < 128 * DK / 8; it += NT) { const int e = it / (DK / 8), c8 = it % (DK / 8); *(LAS u32x4*)(STl + e * LDQ + c8 * 8) = *(const u32x4*)(ST + (size_t)e * DK + c8 * 8); } }
    __syncthreads();
    const int fr = lane & 15, fq = lane >> 4, w = F.wave;
    const float logg = HG ? 0.f : log1pf(-exp2f(-5.f - (float)h));
    if (w * TPW < NIT * NIT) {
        const int it = (w * TPW) / NIT, jt0 = (w * TPW) % NIT;
        f32x4 sc[1][TPW];
#pragma unroll
        for (int q = 0; q < TPW; ++q) sc[0][q] = (f32x4){0.f, 0.f, 0.f, 0.f};
        wave_mm_nt<1, TPW>(sc, QS + it * 16 * LDQ, LDQ, KS + jt0 * 16 * LDQ, LDQ, DK, fr, fq);
        const int i = it * 16 + fr;
#pragma unroll
        for (int q = 0; q < TPW; ++q) { float p[4];
#pragma unroll
            for (int r = 0; r < 4; ++r) { const int j = (jt0 + q) * 16 + 4 * fq + r; float v = sc[0][q][r]; if (!HG) v *= __expf((float)(i - j) * logg); p[r] = (j <= i) ? v : 0.f; }
            u32x2 pw; pw.x = pk2(p[0], p[1]); pw.y = pk2(p[2], p[3]); *(LAS u32x2*)(PS + i * LDT + (jt0 + q) * 16 + 4 * fq) = pw; }
    }
    __syncthreads();
    const int it = w % NIT, eg = w / NIT;
    f32x4 o[1][ET];
#pragma unroll
    for (int q = 0; q < ET; ++q) o[0][q] = (f32x4){0.f, 0.f, 0.f, 0.f};
    wave_mm_nt<1, ET>(o, PS + it * 16 * LDT, LDT, VT + eg * ET * 16 * LDT, LDT, L, fr, fq);
    wave_mm_nt<1, ET>(o, QG + it * 16 * LDQ, LDQ, STl + eg * ET * 16 * LDQ, LDQ, DK, fr, fq);
    float ss = 0.f;
#pragma unroll
    for (int q = 0; q < ET; ++q) ss += (o[0][q][0] * o[0][q][0] + o[0][q][1] * o[0][q][1]) + (o[0][q][2] * o[0][q][2] + o[0][q][3] * o[0][q][3]);
    ss += __shfl_xor(ss, 16); ss += __shfl_xor(ss, 32);
    const int i = it * 16 + fr;
    if (fq == 0) RED[i * 4 + eg] = ss;
    __syncthreads();
    float tot = 0.f;
#pragma unroll
    for (int q = 0; q < WPI; ++q) tot += RED[i * 4 + q];
    const float rstd = 1.f / sqrtf(tot * (1.f / 128.f) + NORM_EPS);
    const bf16_t* Z = (const bf16_t*)(F.ws + WS_Z); bf16_t* O = (bf16_t*)(F.ws + WS_XN);
    const size_t row = (size_t)(r0 + i);
#pragma unroll
    for (int q = 0; q < ET; ++q) { const int e = (eg * ET + q) * 16 + 4 * fq; const u32x2 gw = *(const u32x2*)(Z + row * ABIN + (HG ? 3072 : 1024) + h * 128 + e);
        const float g4[4] = {bflo(gw.x), bfhi(gw.x), bflo(gw.y), bfhi(gw.y)}; float ov[4];
#pragma unroll
        for (int r = 0; r < 4; ++r) { if (HG) ov[r] = o[0][q][r] * rstd * F.in[I_HGNG][m * 128 + e + r] * sigmoidf_(g4[r]); else ov[r] = o[0][q][r] * rstd * siluf_(g4[r]); }
        u32x2 ow; ow.x = pk2(ov[0], ov[1]); ow.y = pk2(ov[2], ov[3]); *(u32x2*)(O + row * D + (HG ? 512 : 0) + h * 128 + e) = ow; }
}

template <bool DRY = false> __device__ __forceinline__ void ab_scan(Frame& F, int layer) {
    const int tid = otid(); const int lane = tid & 63; (void)lane;
    const int m = layer >> 1;
    unsigned* ST32 = (unsigned*)(F.ws + WS_STATE); const float* DEC = (const float*)(F.ws + WS_DEC);
    constexpr int NP = SLOT_E / 2;
    const int gt = F.vcu * NT + tid;
    if (gt < NP) {
        const int eo = 2 * gt; const bool hg = eo >= 32768; const int eo2 = hg ? eo - 32768 : eo; const int head = hg ? eo2 >> 14 : eo2 >> 13; const int cch = hg ? (eo2 & 127) : (eo2 & 63); const int e = hg ? ((eo2 & 16383) >> 7) : ((eo2 & 8191) >> 6);
        const float gdec = hg ? 0.f : __expf(64.f * log1pf(-exp2f(-5.f - (float)head)));
        float s0 = 0.f, s1 = 0.f;
        for (int c0 = 0; c0 < 256; c0 += 8) {
            unsigned kv[8]; float d0[8], d1[8];
#pragma unroll
            for (int u = 0; u < 8; ++u) { kv[u] = ST32[(size_t)(c0 + u) * NP + gt]; if (hg) { const f32x2 dd = *(const f32x2*)(DEC + ((size_t)(c0 + u) * 4 + head) * 128 + cch); d0[u] = dd.x; d1[u] = dd.y; } else { d0[u] = gdec; d1[u] = gdec; } }
#pragma unroll
            for (int u = 0; u < 8; ++u) { const unsigned pw = pk2(s0, s1); if constexpr (DRY) asm volatile("" :: "v"(pw)); else ST32[(size_t)(c0 + u) * NP + gt] = pw; s0 = d0[u] * s0 + bflo(kv[u]); s1 = d1[u] * s1 + bfhi(kv[u]); }
        }
        float* outp = hg ? F.out + O_HGP + (size_t)m * 65536 + head * 16384 : F.out + O_RETP + (size_t)m * 32768 + head * 8192;
        outp[(size_t)cch * 128 + e] = s0; outp[(size_t)(cch + 1) * 128 + e] = s1;
    } else {
        const int NG2 = F.G * NT - NP; if (NG2 <= 0) return;
        for (int idx = gt - NP; idx < 32 * NP; idx += NG2) { const int b = idx / NP, pr = idx % NP;
            const int eo = 2 * pr; const bool hg = eo >= 32768; const int eo2 = hg ? eo - 32768 : eo; const int head = hg ? eo2 >> 14 : eo2 >> 13; const int cch = hg ? (eo2 & 127) : (eo2 & 63); const int e = hg ? ((eo2 & 16383) >> 7) : ((eo2 & 8191) >> 6);
            float d0, d1; if (hg) { const f32x2 dd = *(const f32x2*)(DEC + ((size_t)(256 + b) * 4 + head) * 128 + cch); d0 = dd.x; d1 = dd.y; } else { d0 = d1 = __expf(32.f * log1pf(-exp2f(-5.f - (float)head))); }
            const size_t so = hg ? ((size_t)(m * 32 + b) * 4 + head) * 16384 : ((size_t)(m * 32 + b) * 4 + head) * 8192;
            const float* sin_ = (hg ? F.in[I_SHG] : F.in[I_SRET]) + so; float* sout = F.out + (hg ? O_HGS : O_RETS) + so;
            const float i0 = sin_[(size_t)cch * 128 + e], i1 = sin_[(size_t)(cch + 1) * 128 + e];
            const unsigned kv = ST32[(size_t)(256 + b) * NP + pr]; if constexpr (!DRY) ST32[(size_t)(256 + b) * NP + pr] = pk2(i0, i1);
            sout[(size_t)cch * 128 + e] = d0 * i0 + bflo(kv); sout[(size_t)(cch + 1) * 128 + e] = d1 * i1 + bfhi(kv); }
    }
}

constexpr int RL_AT = 0, RL_RT = 9216, RL_BT = 18432, RL_KT = 27648, RL_BHT = 36864, RL_KHT = 46080, RL_VT = 55296, RL_AAB = 64512, RL_AAK = 81920, RL_ARB = 91136, RL_ARK = 100352,
              RL_U0T = 109568, RL_VEC = 118784, RL_PSUM = 119808;
constexpr int RL_G = RL_AAB, RL_WW = RL_BT, RL_APT = RL_AAK;
constexpr int RL_PL = RL_AT, RL_RL = RL_BT, RL_Y0L = RL_BT + 4608, RL_QTL = RL_AAB, RL_S = RL_BHT;
__device__ __forceinline__ int pperm(int k) { return 32 * (k >> 5) + 8 * ((k >> 2) & 3) + 4 * ((k >> 4) & 1) + (k & 3); }

template <bool DRY = false> __device__ __forceinline__ void rwkv_out_epilogue(Frame& F, int m, const f32x4 (&y)[4], size_t row, int h, int fq) {
    bf16_t* RKV = (bf16_t*)(F.ws + WS_RKV); const bf16_t* GG = (const bf16_t*)(F.ws + WS_G); const float* BON = (const float*)(F.ws + WS_BON);
    float s1 = 0.f;
#pragma unroll
    for (int nt = 0; nt < 4; ++nt) s1 += (y[nt][0] + y[nt][1]) + (y[nt][2] + y[nt][3]);
    s1 += __shfl_xor(s1, 16); s1 += __shfl_xor(s1, 32);
    const float mean = s1 * (1.f / 64.f); float s2 = 0.f;
#pragma unroll
    for (int nt = 0; nt < 4; ++nt)
#pragma unroll
        for (int r = 0; r < 4; ++r) { const float d = y[nt][r] - mean; s2 += d * d; }
    s2 += __shfl_xor(s2, 16); s2 += __shfl_xor(s2, 32);
    const float rstd = 1.f / sqrtf(s2 * (1.f / 64.f) + RW_LN_EPS), bon = BON[row * 16 + h];
#pragma unroll
    for (int nt = 0; nt < 4; ++nt) { const int i = h * 64 + 16 * nt + 4 * fq;
        const f32x4 lg = *(const f32x4*)(F.in[I_RLNG] + m * D + i), lb = *(const f32x4*)(F.in[I_RLNB] + m * D + i);
        const u32x2 vv = *(const u32x2*)(RKV + row * 3072 + 2048 + i), gg = *(const u32x2*)(GG + row * D + i);
        const float v4[4] = {bflo(vv.x), bfhi(vv.x), bflo(vv.y), bfhi(vv.y)}, g4[4] = {bflo(gg.x), bfhi(gg.x), bflo(gg.y), bfhi(gg.y)}; float o[4];
#pragma unroll
        for (int r = 0; r < 4; ++r) o[r] = ((y[nt][r] - mean) * rstd * lg[r] + lb[r] + bon * v4[r]) * g4[r];
        u32x2 w; w.x = pk2(o[0], o[1]); w.y = pk2(o[2], o[3]); if constexpr (DRY) asm volatile("" :: "v"(w.x), "v"(w.y)); else *(u32x2*)(RKV + row * 3072 + i) = w; }
}

template <int S, int L> struct SubstQ {
    static constexpr int RQ = L / 4, NV4 = RQ / 4;
    static __device__ __forceinline__ void run(float (&x)[RQ], f32x4 (&aq)[3][NV4], const LAS float* ap) {
        if constexpr (S < L - 1) {
            if constexpr (S + 2 < L - 1) {
#pragma unroll
                for (int k = 0; k < NV4; ++k) aq[(S + 2) % 3][k] = *(const LAS f32x4*)(ap + (S + 2) * 68 + 4 * k);
            }
            constexpr int own = S / RQ, ctrl = own * 0x55;
            const float xs = __builtin_bit_cast(float, __builtin_amdgcn_update_dpp(0, __builtin_bit_cast(int, x[S % RQ]), ctrl, 0xf, 0xf, false));
#pragma unroll
            for (int k = 0; k < NV4; ++k) { x[4 * k] += aq[S % 3][k][0] * xs; x[4 * k + 1] += aq[S % 3][k][1] * xs; x[4 * k + 2] += aq[S % 3][k][2] * xs; x[4 * k + 3] += aq[S % 3][k][3] * xs;
                asm volatile("" : "+v"(x[4 * k]), "+v"(x[4 * k + 1]), "+v"(x[4 * k + 2]), "+v"(x[4 * k + 3])); }
            asm volatile("" ::: "memory");
            SubstQ<S + 1, L>::run(x, aq, ap);
        }
    }
};
struct RawRegs { u32x4 r, k, v, w, a; };
__device__ __forceinline__ void rwkv_load_raw(Frame& F, int u, int tid, RawRegs& raw) {
    const int c = u >> 4, h = u & 15; int r0, pos0; chunk_geom(c, r0, pos0); const int L = c < 256 ? 64 : 32; int t = tid >> 3; t = t < L ? t : 0;
    const bf16_t* RKV = (const bf16_t*)(F.ws + WS_RKV); const bf16_t* WLOG = (const bf16_t*)(F.ws + WS_WLOG); const bf16_t* AA = (const bf16_t*)(F.ws + WS_XN);
    const size_t row = (size_t)(r0 + t); const int col = h * 64 + 8 * (tid & 7);
    raw.r = *(const u32x4*)(RKV + row * 3072 + col); raw.k = *(const u32x4*)(RKV + row * 3072 + 1024 + col); raw.v = *(const u32x4*)(RKV + row * 3072 + 2048 + col);
    raw.w = *(const u32x4*)(WLOG + row * D + col); raw.a = *(const u32x4*)(AA + row * D + col);
}
template <int L, bool DRY = false> __device__ __forceinline__ void rwkv_local_unit(Frame& F, int layer, int c, int h, RawRegs& raw, int unext) {
    const int tid = otid(); const int lane = tid & 63, fr = lane & 15, fq = lane >> 4, w = F.wave;
    constexpr int NIT = L / 16; constexpr bool SAMPLE = (L == 32);
    const int m = layer >> 1; int r0, pos0; chunk_geom(c, r0, pos0);
    bf16_t* RKV = (bf16_t*)(F.ws + WS_RKV); const bf16_t* WLOG = (const bf16_t*)(F.ws + WS_WLOG); const bf16_t* AA = (const bf16_t*)(F.ws + WS_XN);
    LAS bf16_t* AT = (LAS bf16_t*)(F.lds + RL_AT); LAS bf16_t* RT = (LAS bf16_t*)(F.lds + RL_RT); LAS bf16_t* BT = (LAS bf16_t*)(F.lds + RL_BT); LAS bf16_t* KT = (LAS bf16_t*)(F.lds + RL_KT);
    LAS bf16_t* BHT = (LAS bf16_t*)(F.lds + RL_BHT); LAS bf16_t* KHT = (LAS bf16_t*)(F.lds + RL_KHT); LAS bf16_t* VT = (LAS bf16_t*)(F.lds + RL_VT);
    LAS float* AAB = (LAS float*)(F.lds + RL_AAB); LAS bf16_t* AAK = (LAS bf16_t*)(F.lds + RL_AAK); LAS bf16_t* ARB = (LAS bf16_t*)(F.lds + RL_ARB); LAS bf16_t* ARK = (LAS bf16_t*)(F.lds + RL_ARK);
    LAS bf16_t* U0T = (LAS bf16_t*)(F.lds + RL_U0T); LAS float* GMID = (LAS float*)(F.lds + RL_VEC); LAS float* GLV = GMID + 64; LAS float* EGM = GMID + 128; LAS float* PSUM = (LAS float*)(F.lds + RL_PSUM);
    LAS float* G = (LAS float*)(F.lds + RL_G); LAS float* WW = (LAS float*)(F.lds + RL_WW); LAS bf16_t* APT = (LAS bf16_t*)(F.lds + RL_APT);
    __syncthreads();
    const int t = tid >> 3, c8 = tid & 7; const bool act = t < L;
    float rr[8], kkv[8], bb[8], kh[8], vv[8];
    if (act) { const size_t row = (size_t)(r0 + t); const int col = h * 64 + 8 * c8;
        const u32x4 r4 = raw.r, k4 = raw.k, v4 = raw.v, w4 = raw.w, a4 = raw.a;
        const float* kkp = F.in[I_RKK] + m * D + col; const float* kap = F.in[I_RKA] + m * D + col; const float* rkp = F.in[I_RRK] + m * D + col;
        float ss = 0.f, bon = 0.f;
#pragma unroll
        for (int e = 0; e < 8; ++e) { const float kx = (e & 1) ? bfhi(k4[e >> 1]) : bflo(k4[e >> 1]), al = (e & 1) ? bfhi(a4[e >> 1]) : bflo(a4[e >> 1]);
            rr[e] = (e & 1) ? bfhi(r4[e >> 1]) : bflo(r4[e >> 1]); vv[e] = (e & 1) ? bfhi(v4[e >> 1]) : bflo(v4[e >> 1]);
            kkv[e] = kx * kkp[e]; ss += kkv[e] * kkv[e]; kh[e] = kx * (1.f + (al - 1.f) * kap[e]); bb[e] = al; bon += rr[e] * kh[e] * rkp[e];
            G[t * 64 + 8 * c8 + e] = (e & 1) ? bfhi(w4[e >> 1]) : bflo(w4[e >> 1]); }
        ss += __shfl_xor(ss, 1); ss += __shfl_xor(ss, 2); ss += __shfl_xor(ss, 4); bon += __shfl_xor(bon, 1); bon += __shfl_xor(bon, 2); bon += __shfl_xor(bon, 4);
        const float inv = 1.f / fmaxf(sqrtf(ss), 1e-12f);
#pragma unroll
        for (int e = 0; e < 8; ++e) { kkv[e] *= inv; bb[e] *= kkv[e]; }
        if (c8 == 0) ((float*)(F.ws + WS_BON))[row * 16 + h] = bon; }
    if (unext >= 0) rwkv_load_raw(F, unext, tid, raw);
    __syncthreads();
    { constexpr int TE = L / 8; const int j = tid & 63, e8 = tid >> 6; float cs[TE]; float run = 0.f;
#pragma unroll
      for (int q = 0; q < TE; ++q) { run += G[(e8 * TE + q) * 64 + j]; cs[q] = run; }
      PSUM[e8 * 64 + j] = run;
      __syncthreads();
      float off = 0.f, gm = 0.f, gl = 0.f;
#pragma unroll
      for (int q = 0; q < 8; ++q) { const float p = PSUM[q * 64 + j]; if (q < e8) off += p; if (q < 4) gm += p; gl += p; }
#pragma unroll
      for (int q = 0; q < TE; ++q) G[(e8 * TE + q) * 64 + j] = off + cs[q];
      if (e8 == 0) { GMID[j] = gm; GLV[j] = gl; EGM[j] = __expf(gm); if (!SAMPLE) ((float*)(F.ws + WS_REC + ((size_t)h * 256 + c) * REC_B + 16384))[j] = __expf(gl); } }
    __syncthreads();
    if (act) { float fa[8], fr_[8], fb[8], fk[8];
#pragma unroll
        for (int e = 0; e < 8; ++e) { const int j = 8 * c8 + e; const float g = G[t * 64 + j], gp = (t > 0) ? G[(t - 1) * 64 + j] : 0.f, gm = GMID[j], gl = GLV[j];
            const float ed = __expf(gm - g), eu = __expf(g - gm), el = __expf(gl - g);
            fa[e] = -kkv[e] * __expf(gp - gm); fr_[e] = rr[e] * eu; fb[e] = bb[e] * ed; fk[e] = kh[e] * ed;
            if constexpr (!(DRY && (LOCAL_SKIP & 4))) { BHT[j * 72 + t] = (bf16_t)f2bf(bb[e] * el); KHT[j * 72 + t] = (bf16_t)f2bf(kh[e] * el); VT[j * 72 + t] = (bf16_t)f2bf(vv[e]); } }
        u32x4 p;
        p.x = pk2(fa[0], fa[1]); p.y = pk2(fa[2], fa[3]); p.z = pk2(fa[4], fa[5]); p.w = pk2(fa[6], fa[7]); *(LAS u32x4*)(AT + t * 72 + 8 * c8) = p;
        p.x = pk2(fr_[0], fr_[1]); p.y = pk2(fr_[2], fr_[3]); p.z = pk2(fr_[4], fr_[5]); p.w = pk2(fr_[6], fr_[7]); *(LAS u32x4*)(RT + t * 72 + 8 * c8) = p;
        p.x = pk2(fb[0], fb[1]); p.y = pk2(fb[2], fb[3]); p.z = pk2(fb[4], fb[5]); p.w = pk2(fb[6], fb[7]); *(LAS u32x4*)(BT + t * 72 + 8 * c8) = p;
        p.x = pk2(fk[0], fk[1]); p.y = pk2(fk[2], fk[3]); p.z = pk2(fk[4], fk[5]); p.w = pk2(fk[6], fk[7]); *(LAS u32x4*)(KT + t * 72 + 8 * c8) = p; }
    __syncthreads();
    if constexpr (DRY && (LOCAL_SKIP & 2)) return;
    { constexpr int TPW = (NIT * NIT >= 8) ? NIT * NIT / 8 : 1;
      if (w * TPW < NIT * NIT) { const int it = (w * TPW) / NIT, jt0 = (w * TPW) % NIT;
          f32x4 ab[1][TPW], ak[1][TPW], rb[1][TPW], rk[1][TPW];
#pragma unroll
          for (int q = 0; q < TPW; ++q) { ab[0][q] = (f32x4){0.f, 0.f, 0.f, 0.f}; ak[0][q] = ab[0][q]; rb[0][q] = ab[0][q]; rk[0][q] = ab[0][q]; }
          wave_mm_nt<1, TPW>(ab, AT + it * 16 * 72, 72, BT + jt0 * 16 * 72, 72, 64, fr, fq); wave_mm_nt<1, TPW>(ak, AT + it * 16 * 72, 72, KT + jt0 * 16 * 72, 72, 64, fr, fq);
          wave_mm_nt<1, TPW>(rb, RT + it * 16 * 72, 72, BT + jt0 * 16 * 72, 72, 64, fr, fq); wave_mm_nt<1, TPW>(rk, RT + it * 16 * 72, 72, KT + jt0 * 16 * 72, 72, 64, fr, fq);
          const int tt = it * 16 + fr;
#pragma unroll
          for (int q = 0; q < TPW; ++q) { const int s0 = (jt0 + q) * 16 + 4 * fq; f32x4 fab; float fak[4], frb[4], frk[4];
#pragma unroll
              for (int r = 0; r < 4; ++r) { const int sx = s0 + r; fab[r] = (sx < tt) ? ab[0][q][r] : 0.f; fak[r] = (sx < tt) ? ak[0][q][r] : 0.f; frb[r] = (sx <= tt) ? rb[0][q][r] : 0.f; frk[r] = (sx <= tt) ? rk[0][q][r] : 0.f; }
#pragma unroll
              for (int r = 0; r < 4; ++r) AAB[(s0 + r) * 68 + tt] = fab[r];
              u32x2 p; p.x = pk2(fak[0], fak[1]); p.y = pk2(fak[2], fak[3]); *(LAS u32x2*)(AAK + tt * 72 + s0) = p;
              p.x = pk2(frb[0], frb[1]); p.y = pk2(frb[2], frb[3]); *(LAS u32x2*)(ARB + tt * 72 + s0) = p;
              p.x = pk2(frk[0], frk[1]); p.y = pk2(frk[2], frk[3]); *(LAS u32x2*)(ARK + tt * 72 + s0) = p; } } }
    __syncthreads();
    { constexpr int TP3 = NIT / 2; const int it = (w * TP3) / 4, nt0 = (w * TP3) % 4;
      f32x4 ww[1][TP3];
#pragma unroll
      for (int q = 0; q < TP3; ++q) ww[0][q] = (f32x4){0.f, 0.f, 0.f, 0.f};
      wave_mm_nt<1, TP3>(ww, AAK + it * 16 * 72, 72, VT + nt0 * 16 * 72, 72, L, fr, fq);
#pragma unroll
      for (int q = 0; q < TP3; ++q) *(LAS f32x4*)(WW + (it * 16 + fr) * 68 + (nt0 + q) * 16 + 4 * fq) = ww[0][q]; }
    __syncthreads();
    { constexpr int RQ = L / 4, NV4 = RQ / 4; const int col = tid >> 2, qd = tid & 3, cidx = col & 63; const bool isA = col < 64; const float eg = EGM[cidx];
      float x[RQ]; f32x4 aq[3][NV4];
#pragma unroll
      for (int i = 0; i < RQ; ++i) { const int tt = qd * RQ + i; x[i] = isA ? bf2f(AT[tt * 72 + cidx]) * eg : WW[tt * 68 + cidx]; }
      const LAS float* ap = AAB + qd * RQ;
#pragma unroll
      for (int k = 0; k < NV4; ++k) { aq[0][k] = *(const LAS f32x4*)(ap + 4 * k); aq[1][k] = *(const LAS f32x4*)(ap + 68 + 4 * k); }
      if constexpr (!(DRY && (LOCAL_SKIP & 1))) SubstQ<0, L>::run(x, aq, ap);
      LAS bf16_t* dst = (isA ? APT : U0T) + cidx * 72 + qd * RQ;
#pragma unroll
      for (int t8 = 0; t8 < RQ; t8 += 8) { u32x4 p; p.x = pk2(x[t8], x[t8 + 1]); p.y = pk2(x[t8 + 2], x[t8 + 3]); p.z = pk2(x[t8 + 4], x[t8 + 5]); p.w = pk2(x[t8 + 6], x[t8 + 7]); *(LAS u32x4*)(dst + t8) = p; } }
    __syncthreads();
    { const int mt = w >> 1, nt0 = (w & 1) * 2;
      f32x4 pp[1][2], qt[1][2];
#pragma unroll
      for (int q = 0; q < 2; ++q) { pp[0][q] = (f32x4){0.f, 0.f, 0.f, 0.f}; qt[0][q] = pp[0][q]; }
      wave_mm_nt<1, 2>(pp, BHT + mt * 16 * 72, 72, APT + nt0 * 16 * 72, 72, L, fr, fq);
      wave_mm_nt<1, 2>(qt, U0T + mt * 16 * 72, 72, BHT + nt0 * 16 * 72, 72, L, fr, fq); wave_mm_nt<1, 2>(qt, VT + mt * 16 * 72, 72, KHT + nt0 * 16 * 72, 72, L, fr, fq);
      constexpr int TP5 = NIT / 2; const int it = (w * TP5) / 4, rn0 = (w * TP5) % 4;
      f32x4 rp[1][TP5], y0[1][TP5];
#pragma unroll
      for (int q = 0; q < TP5; ++q) { const int j = (rn0 + q) * 16 + 4 * fq; const u32x2 rw = *(const LAS u32x2*)(RT + (it * 16 + fr) * 72 + j); const f32x4 e4 = *(const LAS f32x4*)(EGM + j);
          rp[0][q] = (f32x4){bflo(rw.x) * e4[0], bfhi(rw.x) * e4[1], bflo(rw.y) * e4[2], bfhi(rw.y) * e4[3]}; y0[0][q] = (f32x4){0.f, 0.f, 0.f, 0.f}; }
      wave_mm_nt<1, TP5>(rp, ARB + it * 16 * 72, 72, APT + rn0 * 16 * 72, 72, L, fr, fq);
      wave_mm_nt<1, TP5>(y0, ARB + it * 16 * 72, 72, U0T + rn0 * 16 * 72, 72, L, fr, fq); wave_mm_nt<1, TP5>(y0, ARK + it * 16 * 72, 72, VT + rn0 * 16 * 72, 72, L, fr, fq);
      if constexpr (!SAMPLE) {
          bf16_t* PP = (bf16_t*)(F.ws + WS_REC + ((size_t)h * 256 + c) * REC_B); bf16_t* QQ = PP + 4096;
#pragma unroll
          for (int q = 0; q < 2; ++q) { const int n0 = (nt0 + q) * 16 + 4 * fq; u32x2 p; p.x = pk2(pp[0][q][0], pp[0][q][1]); p.y = pk2(pp[0][q][2], pp[0][q][3]);
              *(u32x2*)(PP + (mt * 16 + fr) * 64 + pperm(n0)) = p;
              p.x = pk2(qt[0][q][0], qt[0][q][1]); p.y = pk2(qt[0][q][2], qt[0][q][3]); *(u32x2*)(QQ + (mt * 16 + fr) * 64 + n0) = p; }
#pragma unroll
          for (int q = 0; q < TP5; ++q) { const size_t row = (size_t)(r0 + it * 16 + fr); const int n0 = (rn0 + q) * 16 + 4 * fq; u32x2 p;
              p.x = pk2(rp[0][q][0], rp[0][q][1]); p.y = pk2(rp[0][q][2], rp[0][q][3]); if constexpr (DRY) asm volatile("" :: "v"(p.x), "v"(p.y)); else *(u32x2*)(RKV + row * 3072 + 1024 + h * 64 + n0) = p;
              p.x = pk2(y0[0][q][0], y0[0][q][1]); p.y = pk2(y0[0][q][2], y0[0][q][3]); if constexpr (DRY) asm volatile("" :: "v"(p.x), "v"(p.y)); else *(u32x2*)(RKV + row * 3072 + h * 64 + n0) = p; }
      } else {
          __syncthreads();
          LAS bf16_t* PL = (LAS bf16_t*)(F.lds + RL_PL); LAS bf16_t* RLs = (LAS bf16_t*)(F.lds + RL_RL); LAS float* Y0L = (LAS float*)(F.lds + RL_Y0L); LAS float* QTL = (LAS float*)(F.lds + RL_QTL); LAS bf16_t* Sl = (LAS bf16_t*)(F.lds + RL_S);
#pragma unroll
          for (int q = 0; q < 2; ++q) { const int n0 = (nt0 + q) * 16 + 4 * fq; u32x2 p; p.x = pk2(pp[0][q][0], pp[0][q][1]); p.y = pk2(pp[0][q][2], pp[0][q][3]);
              *(LAS u32x2*)(PL + (mt * 16 + fr) * 72 + n0) = p; *(LAS f32x4*)(QTL + (mt * 16 + fr) * 68 + n0) = qt[0][q]; }
#pragma unroll
          for (int q = 0; q < TP5; ++q) { const int n0 = (rn0 + q) * 16 + 4 * fq; u32x2 p; p.x = pk2(rp[0][q][0], rp[0][q][1]); p.y = pk2(rp[0][q][2], rp[0][q][3]);
              *(LAS u32x2*)(RLs + (it * 16 + fr) * 72 + n0) = p; *(LAS f32x4*)(Y0L + (it * 16 + fr) * 68 + n0) = y0[0][q]; }
          const int sb = c - 256; const float* sin_ = F.in[I_SWKV] + (((size_t)m * 32 + sb) * 16 + h) * 4096; float* sout = F.out + O_WKVS + (((size_t)m * 32 + sb) * 16 + h) * 4096;
          for (int it2 = tid; it2 < 64 * 16; it2 += NT) { const int i = it2 >> 4, j4 = (it2 & 15) * 4; const f32x4 sv = *(const f32x4*)(sin_ + i * 64 + j4); u32x2 p; p.x = pk2(sv[0], sv[1]); p.y = pk2(sv[2], sv[3]); *(LAS u32x2*)(Sl + i * 72 + j4) = p; }
          __syncthreads();
          if (w < 2) { f32x4 y[1][4];
#pragma unroll
              for (int q = 0; q < 4; ++q) y[0][q] = *(const LAS f32x4*)(Y0L + (w * 16 + fr) * 68 + q * 16 + 4 * fq);
              wave_mm_nt<1, 4>(y, RLs + w * 16 * 72, 72, Sl, 72, 64, fr, fq);
              rwkv_out_epilogue<DRY>(F, m, y[0], (size_t)(r0 + w * 16 + fr), h, fq); }
          else if (w < 6) { const int mi = w - 2; f32x4 tl[1][4];
#pragma unroll
              for (int q = 0; q < 4; ++q) { const int j = q * 16 + 4 * fq; const f32x4 sv = *(const f32x4*)(sin_ + (mi * 16 + fr) * 64 + j), gl4 = *(const LAS f32x4*)(GLV + j), qv = *(const LAS f32x4*)(QTL + (mi * 16 + fr) * 68 + j);
                  tl[0][q] = (f32x4){__expf(gl4[0]) * sv[0] + qv[0], __expf(gl4[1]) * sv[1] + qv[1], __expf(gl4[2]) * sv[2] + qv[2], __expf(gl4[3]) * sv[3] + qv[3]}; }
              wave_mm_nt<1, 4>(tl, Sl + mi * 16 * 72, 72, PL, 72, 64, fr, fq);
#pragma unroll
              for (int q = 0; q < 4; ++q) *(f32x4*)(sout + (mi * 16 + fr) * 64 + q * 16 + 4 * fq) = tl[0][q]; }
      }
    }
}

constexpr int SC_GRP = 4, SC_CH = 8192 + 2048 + 256, SC_LCH = 9216 + 2304 + 256, SC_LBUF = SC_GRP * SC_LCH;
template <int SKIP = 0> __device__ __forceinline__ void rwkv_scan_phase(Frame& F, int layer) {
    const int tid = otid(); const int lane = tid & 63, m = layer >> 1; const int b = blockIdx.x;
    if (b >= 64) return;
    const int h = 2 * (b & 7) + (b >> 5), sl = (b >> 3) & 3;
    const unsigned char* REC = F.ws + WS_REC;
    constexpr int NG = 256 / SC_GRP, DEPTH = 4;
    static_assert(NG % DEPTH == 0, "scan groups vs prefetch depth");
    if (F.wave != 0) {
        constexpr int NV = SC_GRP * SC_CH / 16, NLT = NT - 64, NPT = (NV + NLT - 1) / NLT;
        struct RegSet { u32x4 v[NPT]; };
        RegSet sets[DEPTH];
        unsigned poff[NPT], pdst[NPT];
#pragma unroll
        for (int q = 0; q < NPT; ++q) { int v = (tid - 64) + q * NLT; v = v < NV ? v : NV - 1; const int cc = v / (SC_CH / 16), o = (v % (SC_CH / 16)) * 16;
            poff[q] = (unsigned)(cc * REC_B + o + (o >= 10240 ? 6144 : (o >= 8192 ? sl * 2048 : 0)));
            const int lo = (o < 8192) ? (o >> 7) * 144 + (o & 127) : (o < 10240) ? 9216 + ((o - 8192) >> 7) * 144 + ((o - 8192) & 127) : 9216 + 2304 + (o - 10240);
            pdst[q] = (unsigned)(cc * SC_LCH + lo); }
        auto issue = [&](int g, RegSet& st) { const unsigned char* gb = REC + ((size_t)h * 256 + g * SC_GRP) * REC_B;
#pragma unroll
            for (int q = 0; q < NPT; ++q) st.v[q] = *(const u32x4*)(gb + poff[q]); };
        auto commit = [&](int buf, const RegSet& st) {
#pragma unroll
            for (int q = 0; q < NPT; ++q) *(LAS u32x4*)(F.lds + buf * SC_LBUF + pdst[q]) = st.v[q]; };
        if (!(SKIP & 2)) {
#pragma unroll
            for (int d = 0; d < DEPTH; ++d) issue(d, sets[d]);
            commit(0, sets[0]); }
        for (int g0 = 0; g0 < NG; g0 += DEPTH) {
#pragma unroll
            for (int dd = 0; dd < DEPTH; ++dd) { const int g = g0 + dd;
                if (!(SKIP & 2)) { if (g > 0 && g + DEPTH - 1 < NG) issue(g + DEPTH - 1, sets[(dd + DEPTH - 1) % DEPTH]); }
                __syncthreads();
                __syncthreads();
                if (!(SKIP & 2)) { if (g + 1 < NG) commit((g + 1) & 1, sets[(dd + 1) % DEPTH]); } }
        }
    } else {
        const int ci = lane & 15, q4 = lane >> 4, i = 16 * sl + ci;
        f32x4 T[4];
#pragma unroll
        for (int mm = 0; mm < 4; ++mm) T[mm] = (f32x4){0.f, 0.f, 0.f, 0.f};
        bf16_t* TST = (bf16_t*)(F.ws + WS_TST);
        const unsigned pfo = (unsigned)(ci * 144 + q4 * 16);
        for (int g = 0; g < NG; ++g) {
            __syncthreads();
            if (!(SKIP & 1)) {
                const LAS unsigned char* base = F.lds + (g & 1) * SC_LBUF;
                bf16x8 pf[4][2];
#pragma unroll
                for (int mm = 0; mm < 4; ++mm)
#pragma unroll
                    for (int s = 0; s < 2; ++s) pf[mm][s] = *(const LAS bf16x8*)(base + pfo + mm * 2304 + s * 64);
#pragma unroll
                for (int cc = 0; cc < SC_GRP; ++cc) { const int c = g * SC_GRP + cc; const LAS unsigned char* cb = base + cc * SC_LCH;
                    bf16_t* tdst = TST + (((size_t)h * 256 + c) * 64 + i) * 64;
                    f32x4 gv[4]; u32x2 qv[4];
#pragma unroll
                    for (int mm = 0; mm < 4; ++mm) { const int j = 16 * mm + 4 * q4; gv[mm] = *(const LAS f32x4*)(cb + 9216 + 2304 + j * 4); qv[mm] = *(const LAS u32x2*)(cb + 9216 + ci * 144 + j * 2); }
                    bf16x8 pn[4][2];
                    if (cc + 1 < SC_GRP) {
#pragma unroll
                        for (int mm = 0; mm < 4; ++mm)
#pragma unroll
                            for (int s = 0; s < 2; ++s) pn[mm][s] = *(const LAS bf16x8*)(cb + SC_LCH + pfo + mm * 2304 + s * 64); }
                    bf16x8 Tf[2];
#pragma unroll
                    for (int mm = 0; mm < 4; ++mm) { u32x2 p; p.x = pk2(T[mm][0], T[mm][1]); p.y = pk2(T[mm][2], T[mm][3]); *(u32x2*)(tdst + 16 * mm + 4 * q4) = p;
                        Tf[mm >> 1][(mm & 1) * 4 + 0] = (short)(p.x & 0xffffu); Tf[mm >> 1][(mm & 1) * 4 + 1] = (short)(p.x >> 16); Tf[mm >> 1][(mm & 1) * 4 + 2] = (short)(p.y & 0xffffu); Tf[mm >> 1][(mm & 1) * 4 + 3] = (short)(p.y >> 16); }
#pragma unroll
                    for (int mm = 0; mm < 4; ++mm) {
                        f32x4 acc = (f32x4){gv[mm][0] * T[mm][0] + bflo(qv[mm].x), gv[mm][1] * T[mm][1] + bfhi(qv[mm].x), gv[mm][2] * T[mm][2] + bflo(qv[mm].y), gv[mm][3] * T[mm][3] + bfhi(qv[mm].y)};
                        acc = __builtin_amdgcn_mfma_f32_16x16x32_bf16(pf[mm][0], Tf[0], acc, 0, 0, 0); acc = __builtin_amdgcn_mfma_f32_16x16x32_bf16(pf[mm][1], Tf[1], acc, 0, 0, 0);
                        T[mm] = acc; }
                    if (cc + 1 < SC_GRP) {
#pragma unroll
                        for (int mm = 0; mm < 4; ++mm) { pf[mm][0] = pn[mm][0]; pf[mm][1] = pn[mm][1]; } }
                }
            }
            __syncthreads();
        }
        float* outp = F.out + O_WKVP + ((size_t)m * 16 + h) * 4096 + (size_t)i * 64;
#pragma unroll
        for (int mm = 0; mm < 4; ++mm) *(f32x4*)(outp + 16 * mm + 4 * q4) = T[mm];
    }
}

template <bool DRY = false> __device__ __forceinline__ void rwkv_output_phase(Frame& F, int layer) {
    const int tid = otid(); const int lane = tid & 63, fr = lane & 15, fq = lane >> 4, m = layer >> 1;
    const bf16_t* RKV = (const bf16_t*)(F.ws + WS_RKV); const bf16_t* TST = (const bf16_t*)(F.ws + WS_TST);
    const int gw = F.vcu * NWAVES + F.wave, NGW = F.G * NWAVES;
    for (int u = gw; u < 256 * 16 * 4; u += NGW) { const int it = u & 3, h = (u >> 2) & 15, c = u >> 6;
        const size_t row = (size_t)(64 * c + 16 * it + fr); const bf16_t* ts = TST + ((size_t)h * 256 + c) * 4096;
        f32x4 y[4];
#pragma unroll
        for (int nt = 0; nt < 4; ++nt) { const u32x2 yv = *(const u32x2*)(RKV + row * 3072 + h * 64 + 16 * nt + 4 * fq); y[nt] = (f32x4){bflo(yv.x), bfhi(yv.x), bflo(yv.y), bfhi(yv.y)}; }
#pragma unroll
        for (int s = 0; s < 2; ++s) { const bf16x8 xa = *(const bf16x8*)(RKV + row * 3072 + 1024 + h * 64 + 32 * s + 8 * fq);
#pragma unroll
            for (int nt = 0; nt < 4; ++nt) { const bf16x8 yb = *(const bf16x8*)(ts + (16 * nt + fr) * 64 + 32 * s + 8 * fq); y[nt] = __builtin_amdgcn_mfma_f32_16x16x32_bf16(yb, xa, y[nt], 0, 0, 0); } }
        rwkv_out_epilogue<DRY>(F, m, y, row, h, fq);
    }
}

#define GRID_BAR() xcd_barrier(bar)
#ifndef PHASE_MASK
#define PHASE_MASK 0xffffffffu
#endif
#define PH(k) if (PHASE_MASK & (1u << (k)))
#ifndef REP_MASK
#define REP_MASK 0u
#endif
#define REP(k) (((REP_MASK) >> (k)) & 1u)
#ifndef LOCAL_SKIP
#define LOCAL_SKIP 0
#endif
#ifndef EXTRA_BARS
#define EXTRA_BARS 0
#endif
template <int layer> __device__ __forceinline__ void layer_body(Frame& F, const XcdBarrier& bar) {
    unsigned char* ws = F.ws; unsigned char* ar = ws + WS_ARENA;
    bf16_t* XN = (bf16_t*)(ws + WS_XN);
    const float* MOD = (const float*)(ws + WS_MOD);
    constexpr int m = layer >> 1; const float* modl = MOD + (size_t)layer * NSEQ * 6144;
    PH(1) for (int rep = 0; rep <= (int)REP(1); ++rep) if (layer > 0) convert_layer_weights(F, layer);
    if constexpr ((layer & 1) == 0) {
        PH(2) for (int rep = 0; rep <= (int)REP(2); ++rep) { if constexpr (layer == 0) norm_pass<0, 0, true, true>(F, layer); else norm_pass<0, 8>(F, layer, layer - 1, 5120); }
        GRID_BAR();
        PH(3) { using GC = pg8::Geo<D, D, D, 30, 0, 1 << 20, 0>; pg8::Gemm<GC> g{XN, (const bf16_t*)(ar + AR_WIN), nullptr}; pg8::StaticOrder S; S.init(M, ABIN, F.G, (int)blockIdx.x);
          pg8::EpiBf16<0> E{(bf16_t*)(ws + WS_Z), ABIN};
          pg8::gemm_phase<pg8::EpiBf16<0>, pg8::StaticOrder, GC, true, true>(F.lds, g, S, E);
          if (REP(3)) { pg8::EpiNull<true> EN; pg8::gemm_phase<pg8::EpiNull<true>, pg8::StaticOrder, GC, true, true>(F.lds, g, S, EN); } }
        GRID_BAR();
        PH(4) for (int rep = 0; rep <= (int)REP(4); ++rep) for (int u = F.vcu; u < NCHUNK * 8; u += F.G) { const int c = u >> 3, hh = (u + u / F.G) & 7;
            if (c < 256) { if (hh < 4) ab_summary_unit<64, false>(F, layer, c, hh); else ab_summary_unit<64, true>(F, layer, c, hh - 4); }
            else { if (hh < 4) ab_summary_unit<32, false>(F, layer, c, hh); else ab_summary_unit<32, true>(F, layer, c, hh - 4); } }
        GRID_BAR();
        PH(5) { if (REP(5)) ab_scan<true>(F, layer); ab_scan<false>(F, layer); }
        GRID_BAR();
        PH(6) for (int rep = 0; rep <= (int)REP(6); ++rep) for (int u = F.vcu; u < NCHUNK * 8; u += F.G) { const int c = u >> 3, hh = (u + u / F.G) & 7;
            if (c < 256) { if (hh < 4) ab_output_unit<64, false>(F, layer, c, hh); else ab_output_unit<64, true>(F, layer, c, hh - 4); }
            else { if (hh < 4) ab_output_unit<32, false>(F, layer, c, hh); else ab_output_unit<32, true>(F, layer, c, hh - 4); } }
        GRID_BAR();
        PH(7) { using GC = pg8::Geo<D, D, D, 30, 0, 1 << 20, 0>; pg8::Gemm<GC> g{XN, (const bf16_t*)(ar + AR_WOUT), nullptr}; pg8::StaticOrder S; S.init(MP, D, F.G, (int)blockIdx.x);
          pg8::EpiRes E{F.out, modl, 2048, (layer == 0) ? F.in[I_XP] : F.out};
          pg8::gemm_phase<pg8::EpiRes, pg8::StaticOrder, GC, true, true>(F.lds, g, S, E);
          if (REP(7)) { pg8::EpiNull<false> EN; pg8::gemm_phase<pg8::EpiNull<false>, pg8::StaticOrder, GC, true, true>(F.lds, g, S, EN); }
          using GC2 = pg8::Geo<D, D, 256, 30, 0, 1 << 20, 0, true>; pg8::Gemm<GC2> g2{XN, (const bf16_t*)(ar + AR_WOUT), nullptr}; pg8::SplitOrder S2{F.vcu, 4};
          pg8::EpiPartial E2{(float*)(ws + WS_PART), 4};
          pg8::gemm_phase<pg8::EpiPartial, pg8::SplitOrder, GC2, true, true>(F.lds, g2, S2, E2); }
        GRID_BAR();
    } else {
        PH(8) for (int rep = 0; rep <= (int)REP(8); ++rep) norm_pass<1, 8>(F, layer, layer - 1, 5120);
        GRID_BAR();
        PH(9) { using GCr = pg8::Geo<D, 2048, D, 2, M * D, 1 << 20, 0>; pg8::Gemm<GCr> gr{(const bf16_t*)(ws + WS_XMIX), (const bf16_t*)(ar + AR_WC1), nullptr}; pg8::StaticOrder Sr; Sr.init(M, 3072, F.G, (int)blockIdx.x);
          pg8::EpiRkv E{(bf16_t*)(ws + WS_RKV), (bf16_t*)(ws + WS_LO), (m == 0) ? (bf16_t*)(ws + WS_VFIRST) : nullptr};
          pg8::gemm_phase<pg8::EpiRkv, pg8::StaticOrder, GCr, true, true>(F.lds, gr, Sr, E);
          if (REP(9)) { pg8::EpiNull<true> EN; pg8::gemm_phase<pg8::EpiNull<true>, pg8::StaticOrder, GCr, true, true>(F.lds, gr, Sr, EN); }
          using GC = pg8::Geo<D, 2048, 2048, 30, 0, 16, -4096>; pg8::Gemm<GC> g{XN, (const bf16_t*)(ar + AR_WC1), (const bf16_t*)(ws + WS_PREVS)}; pg8::LoraOrder Sl{(int)blockIdx.x};
          pg8::gemm_phase<pg8::EpiRkv, pg8::LoraOrder, GC, true, true>(F.lds, g, Sl, E); }
        GRID_BAR();
        PH(10) { using GC = pg8::Geo<D, 256, 256, 2, 256, 1 << 20, 0>; pg8::Gemm<GC> g{(const bf16_t*)(ws + WS_LO), (const bf16_t*)(ar + AR_WC2), nullptr}; pg8::StaticOrder S; S.init(M, 4096, F.G, (int)blockIdx.x);
          pg8::EpiLora2 E{(bf16_t*)(ws + WS_WLOG), XN, (bf16_t*)(ws + WS_G), (bf16_t*)(ws + WS_RKV), (m == 1) ? (const bf16_t*)(ws + WS_VFIRST) : nullptr,
                          F.in[I_RW0] + m * D, F.in[I_RA0] + m * D, F.in[I_RV0]};
          pg8::gemm_phase<pg8::EpiLora2, pg8::StaticOrder, GC, true, true>(F.lds, g, S, E);
          if (REP(10)) { pg8::EpiNull<false> EN; pg8::gemm_phase<pg8::EpiNull<false>, pg8::StaticOrder, GC, true, true>(F.lds, g, S, EN); } }
        GRID_BAR();
        PH(11) { RawRegs raw; const int tid0 = otid(); int u = F.vcu; if (u < NCHUNK * 16) rwkv_load_raw(F, u, tid0, raw);
          for (; u < NCHUNK * 16; u += F.G) { const int c = u >> 4, hh = u & 15, un = (u + F.G < NCHUNK * 16) ? u + F.G : -1;
              if (c < 256) rwkv_local_unit<64>(F, layer, c, hh, raw, un); else rwkv_local_unit<32>(F, layer, c, hh, raw, un); } }
        GRID_BAR();
        PH(17) { if (REP(17)) rwkv_scan_phase<LOCAL_SKIP>(F, layer); rwkv_scan_phase<0>(F, layer); }
        GRID_BAR();
        PH(18) { if (REP(18)) rwkv_output_phase<true>(F, layer); rwkv_output_phase<false>(F, layer); }
        GRID_BAR();
        PH(12) { using GC = pg8::Geo<3072, D, D, 30, 0, 1 << 20, 0>; pg8::Gemm<GC> g{(const bf16_t*)(ws + WS_RKV), (const bf16_t*)(ar + AR_WO), nullptr}; pg8::StaticOrder S; S.init(MP, D, F.G, (int)blockIdx.x);
          pg8::EpiRes E{F.out, modl, 2048, F.out};
          pg8::gemm_phase<pg8::EpiRes, pg8::StaticOrder, GC, true, true>(F.lds, g, S, E);
          if (REP(12)) { pg8::EpiNull<false> EN; pg8::gemm_phase<pg8::EpiNull<false>, pg8::StaticOrder, GC, true, true>(F.lds, g, S, EN); }
          using GC2 = pg8::Geo<3072, D, 256, 30, 0, 1 << 20, 0, true>; pg8::Gemm<GC2> g2{(const bf16_t*)(ws + WS_RKV), (const bf16_t*)(ar + AR_WO), nullptr}; pg8::SplitOrder S2{F.vcu, 4};
          pg8::EpiPartial E2{(float*)(ws + WS_PART), 4};
          pg8::gemm_phase<pg8::EpiPartial, pg8::SplitOrder, GC2, true, true>(F.lds, g2, S2, E2); }
        GRID_BAR();
    }
    PH(13) for (int rep = 0; rep <= (int)REP(13); ++rep) norm_pass<2, 4, false, (layer == 0)>(F, layer, layer, 2048);
    GRID_BAR();
    PH(14) { using GC = pg8::Geo<D, D, D, 30, 0, 1 << 20, 0>; pg8::Gemm<GC> g{XN, (const bf16_t*)(ar + AR_W1), nullptr}; pg8::StaticOrder S; S.init(M, DFF, F.G, (int)blockIdx.x);
      pg8::EpiBf16<1> E{(bf16_t*)(ws + WS_H), DFF};
      pg8::gemm_phase<pg8::EpiBf16<1>, pg8::StaticOrder, GC, true, true>(F.lds, g, S, E);
          if (REP(14)) { pg8::EpiNull<true> EN; pg8::gemm_phase<pg8::EpiNull<true>, pg8::StaticOrder, GC, true, true>(F.lds, g, S, EN); } }
    GRID_BAR();
    PH(15) { using GC = pg8::Geo<DFF, DFF, DFF, 30, 0, 1 << 20, 0>; pg8::Gemm<GC> g{(const bf16_t*)(ws + WS_H), (const bf16_t*)(ar + AR_W2), nullptr}; pg8::StaticOrder S; S.init(MP, D, F.G, (int)blockIdx.x);
      pg8::EpiRes E{F.out, modl, 5120, F.out};
      for (int xb = 0; xb < EXTRA_BARS; ++xb) GRID_BAR();
      pg8::gemm_phase<pg8::EpiRes, pg8::StaticOrder, GC, true, true>(F.lds, g, S, E);
      if (REP(15)) { pg8::EpiNull<false> EN; pg8::gemm_phase<pg8::EpiNull<false>, pg8::StaticOrder, GC, true, true>(F.lds, g, S, EN); }
      using GC2 = pg8::Geo<DFF, DFF, 512, 30, 0, 1 << 20, 0, true>; pg8::Gemm<GC2> g2{(const bf16_t*)(ws + WS_H), (const bf16_t*)(ar + AR_W2), nullptr}; pg8::SplitOrder S2{F.vcu, 8};
      pg8::EpiPartial E2{(float*)(ws + WS_PART), 8};
      pg8::gemm_phase<pg8::EpiPartial, pg8::SplitOrder, GC2, true, true>(F.lds, g2, S2, E2); }
    GRID_BAR();
}

__global__ void __launch_bounds__(NT, 2) fwd_kernel(Args args) {
    extern __shared__ __attribute__((aligned(16))) unsigned char lds[];
    Frame F;
    F.lds = (LAS unsigned char*)lds; F.MISC = (volatile LAS unsigned*)(F.lds + MISC_OFF);
    F.wave = __builtin_amdgcn_readfirstlane(threadIdx.x >> 6);
    F.G = gridDim.x; { const int bx = blockIdx.x; F.vcu = (F.G % 8 == 0) ? (bx % 8) * (F.G / 8) + bx / 8 : bx; }
    F.in = args.in; F.out = args.out; F.ws = args.ws;
    for (int u = threadIdx.x; u < (LDS_BYTES - LDSCTL_OFF) / 4; u += NT) ((LAS unsigned*)(F.lds + LDSCTL_OFF))[u] = 0u;
    __syncthreads();
    XcdBarrier bar = xcd_barrier_post((unsigned*)(F.ws + WS_CTL) + CW_BAR, F.MISC + 8);
    PH(0) prologue(F);
    GRID_BAR();
    PH(0) mod_phase(F);
    GRID_BAR();
    layer_body<0>(F, bar); layer_body<1>(F, bar); layer_body<2>(F, bar); layer_body<3>(F, bar);
    PH(16) norm_pass<3, 8>(F, 0, 3, 5120);
}

extern "C" void kernel_launch(void* const* d_in, const int* in_sizes, int n_in, void* d_out, int out_size, void* d_ws, size_t ws_size, hipStream_t stream) {
    static int grid = 0;
    if (grid == 0) {
        if (n_in != 38 || out_size != 28706816 || ws_size < WS_END) { fprintf(stderr, "kernel_launch: unexpected problem (n_in %d, out %d, ws %zu; need ws >= %zu)\n", n_in, out_size, ws_size, (size_t)WS_END); grid = -1; return; }
        int dev = 0, cus = 0, per_cu = 0;
        if (hipGetDevice(&dev) != hipSuccess || hipDeviceGetAttribute(&cus, hipDeviceAttributeMultiprocessorCount, dev) != hipSuccess) { grid = -1; return; }
        if (hipFuncSetAttribute((const void*)fwd_kernel, hipFuncAttributeMaxDynamicSharedMemorySize, LDS_BYTES) != hipSuccess) { fprintf(stderr, "kernel_launch: hipFuncSetAttribute failed\n"); grid = -1; return; }
        if (hipOccupancyMaxActiveBlocksPerMultiprocessor(&per_cu, (const void*)fwd_kernel, NT, LDS_BYTES) != hipSuccess || per_cu < 1) { fprintf(stderr, "kernel_launch: occupancy query says %d\n", per_cu); per_cu = 1; }
        (void)hipGetLastError();
        grid = cus;
    }
    if (grid < 0) return;
    (void)hipMemsetAsync((char*)d_ws + WS_CTL, 0, ZERO_BYTES, stream);
    Args a{};
    for (int i = 0; i < 38; ++i) a.in[i] = (const float*)d_in[i];
    a.out = (float*)d_out; a.ws = (unsigned char*)d_ws;
    void* kargs[] = {&a};
    hipError_t e = hipLaunchCooperativeKernel((const void*)fwd_kernel, dim3(grid), dim3(NT), kargs, LDS_BYTES, stream);
    if (e != hipSuccess) fprintf(stderr, "kernel_launch: cooperative launch failed: %s (grid %d)\n", hipGetErrorString(e), grid);
}
```

```cpp
#include <hip/hip_runtime.h>
#include <cstdio>
#include <cstdint>

#define LAS __attribute__((address_space(3)))
#define GAS __attribute__((address_space(1)))
typedef unsigned short bf16_t;
typedef short bf16x8 __attribute__((ext_vector_type(8)));
typedef float f32x4 __attribute__((ext_vector_type(4)));
typedef float f32x2 __attribute__((ext_vector_type(2)));
typedef unsigned u32x4 __attribute__((ext_vector_type(4)));
typedef unsigned u32x2 __attribute__((ext_vector_type(2)));

#ifndef LOCAL_SKIP
#define LOCAL_SKIP 0
#endif
constexpr int D = 1024, MP = 16384, MS = 1024, M = MP + MS, NSEQ = 33, DFF = 4096, ABIN = 3584;
constexpr int NCHUNK = 288;
constexpr int SLOT_E = 4 * 8192 + 4 * 16384;
constexpr float NORM_EPS = 1e-6f, RW_LN_EPS = 64e-5f;

constexpr size_t MiB = 1u << 20;
constexpr size_t WS_CTL = 0, WS_MOD = 1 * MiB, ZERO_BYTES = 65536;
constexpr size_t WS_ROPE = 5 * MiB;
constexpr size_t WS_ARENA = 10 * MiB;
constexpr size_t AR_W1 = 0, AR_W2 = 8 * MiB, AR_WIN = 16 * MiB, AR_WOUT = 23 * MiB, AR_WC1 = 16 * MiB, AR_WC2 = 32 * MiB, AR_WO = 34 * MiB;
constexpr size_t WS_VFIRST = 46 * MiB;
constexpr size_t WS_XN0 = 80 * MiB, WS_XN = WS_XN0 + 2048;
constexpr size_t WS_PREVS = 115 * MiB;
constexpr size_t WS_R1 = 118 * MiB;
constexpr size_t WS_Z = WS_R1, WS_STATE = WS_R1 + 120 * MiB, WS_DEC = WS_R1 + 174 * MiB;
constexpr size_t WS_H = WS_R1;
constexpr size_t WS_RKV = WS_R1, WS_LO = WS_R1 + 102 * MiB, WS_WLOG = WS_R1 + 136 * MiB, WS_G = WS_R1 + 170 * MiB;
constexpr size_t WS_TST = WS_R1 + 102 * MiB;
constexpr size_t WS_REC = WS_R1 + 204 * MiB, WS_BON = WS_R1 + 269 * MiB;
constexpr int REC_B = 16640;
constexpr size_t WS_XMIX = WS_R1 + 168 * MiB;
constexpr size_t WS_PART = WS_R1 + 136 * MiB;
constexpr size_t WS_END = WS_R1 + 271 * MiB;

__device__ const double ROPE_REV[32] = {0.15915494309189535, 0.11934937021124886, 0.089499401608891013, 0.067115083005227255, 0.050329212104487035, 0.037741584717419771, 0.028302195830623399, 0.02122365276477766, 0.015915494309189534, 0.011934937021124886, 0.0089499401608891024, 0.0067115083005227253, 0.0050329212104487037, 0.0037741584717419772, 0.0028302195830623399, 0.0021223652764777662, 0.0015915494309189536, 0.0011934937021124885, 0.00089499401608891024, 0.0006711508300522726, 0.00050329212104487033, 0.00037741584717419774, 0.00028302195830623395, 0.00021223652764777661, 0.00015915494309189535, 0.00011934937021124886, 8.9499401608891018e-05, 6.7115083005227254e-05, 5.0329212104487035e-05, 3.7741584717419777e-05, 2.8302195830623396e-05, 2.1223652764777659e-05};

__device__ __forceinline__ unsigned f2bf(float f) { unsigned u = __builtin_bit_cast(unsigned, f); return (u + 0x7fffu + ((u >> 16) & 1u)) >> 16; }
typedef __bf16 bf16x2_t __attribute__((ext_vector_type(2)));
__device__ __forceinline__ unsigned pk2(float lo, float hi) { const f32x2 v = {lo, hi}; const bf16x2_t b = __builtin_convertvector(v, bf16x2_t); return __builtin_bit_cast(unsigned, b); }
__device__ __forceinline__ float bf2f(unsigned short b) { return __builtin_bit_cast(float, (unsigned)b << 16); }
__device__ __forceinline__ float bflo(unsigned w) { return __builtin_bit_cast(float, w << 16); }
__device__ __forceinline__ float bfhi(unsigned w) { return __builtin_bit_cast(float, w & 0xffff0000u); }
__device__ __forceinline__ float sigmoidf_(float x) { return 1.f / (1.f + __expf(-x)); }
__device__ __forceinline__ float siluf_(float x) { return x / (1.f + __expf(-x)); }
__device__ __forceinline__ float wave_sum(float v) {
#pragma unroll
    for (int o = 1; o < 64; o <<= 1) v += __shfl_xor(v, o);
    return v;
}
__device__ __forceinline__ int otid() { int t = threadIdx.x; asm volatile("" : "+v"(t)); return t; }
__device__ __forceinline__ int seq_of_row(int r) { return r < MP ? 0 : 1 + ((r - MP) >> 5); }
#define LDS_WAIT() asm volatile("s_waitcnt lgkmcnt(0)" ::: "memory")
#define VM_WAIT() asm volatile("s_waitcnt vmcnt(0)" ::: "memory")

namespace pg8 {
constexpr int BM = 256, BK = 64, HALF = 128, HTB = HALF * BK * 2, STAGE_BYTES = 8 * HTB, NXCD = 8, WGM = 8;
__host__ __device__ __forceinline__ int lds_byte(int r, int c) { const int st = (r >> 4) * 2 + (c >> 5), rr = r & 15, cc = c & 31, ob = rr * 64 + cc * 2; return st * 1024 + (ob ^ (((ob >> 9) & 1) << 5)); }
__host__ __device__ __forceinline__ void stage_rc(int b, int& R, int& C) { const int st = b / 1024, sb = b % 1024, swz = sb ^ (((sb >> 9) & 1) << 5); R = (st >> 1) * 16 + swz / 64; C = (st & 1) * 32 + (swz % 64) / 2; }
__host__ __device__ __forceinline__ int perm32(int rho) { const int n = rho >> 4, i = rho & 15; return 8 * (i >> 2) + 4 * n + (i & 3); }

struct Unit { int pm, pn, ks; };
template <int LDA_, int LDB_, int K_, int GSHIFT_, int GSTRIDE_, int KSPLIT_, int DELTAP_, bool SPLIT_ = false> struct Geo {
    static constexpr int LDA = LDA_, LDB = LDB_, K = K_, GSHIFT = GSHIFT_, GSTRIDE = GSTRIDE_, KSPLIT = KSPLIT_, DELTAP = DELTAP_; static constexpr bool SPLIT = SPLIT_;
};
template <class GC> struct Gemm {
    const bf16_t* A; const bf16_t* Bt; const bf16_t* A2s;
    __device__ __forceinline__ const char* a_base(const Unit& u) const { return (const char*)(A + (size_t)u.pm * BM * GC::LDA + (size_t)(u.pn >> GC::GSHIFT) * GC::GSTRIDE + (GC::SPLIT ? (size_t)u.ks * GC::K : 0)); }
    __device__ __forceinline__ const char* b_base(const Unit& u) const { return (const char*)(Bt + (size_t)u.pn * BM * GC::LDB + (GC::SPLIT ? (size_t)u.ks * GC::K : 0)); }
    __device__ __forceinline__ long a_delta(const Unit& u) const {
        if constexpr (GC::KSPLIT >= GC::K / BK) return 0;
        else { if (u.pm < 64) return (long)GC::DELTAP;
            return (long)((const char*)(A2s + (size_t)(u.pm - 64) * BM * GC::LDA) - a_base(u)) - (long)GC::KSPLIT * BK * 2; }
    }
};
struct StaticOrder {
    int nM, nN, nwg, G, c;
    __host__ __device__ void init(int M_, int N_, int G_, int c_) { nM = M_ / BM; nN = N_ / BM; nwg = nM * nN; G = G_; c = c_; }
    __host__ __device__ bool next(int i, Unit& u) const {
        const long L = (long)i * G + c; if (L >= nwg) return false;
        int wgid = (int)L; { const int q = nwg / NXCD, r = nwg % NXCD, xcd = wgid % NXCD, off = wgid / NXCD; wgid = (xcd < r ? xcd * (q + 1) : r * (q + 1) + (xcd - r) * q) + off; }
        const int nig = WGM * nN, gid = wgid / nig, fm = gid * WGM, gsz = (nM - fm) < WGM ? (nM - fm) : WGM;
        u.pm = fm + ((wgid % nig) % gsz); u.pn = (wgid % nig) / gsz; u.ks = 0; return true;
    }
};
__device__ __forceinline__ unsigned cvt_pk_bf16(float lo, float hi) { return pk2(lo, hi); }

template <class Epi, class Sched, class GC, bool ALIGN_EPI = false, bool SP2 = false>
__device__ __forceinline__ void gemm_phase(LAS unsigned char* lds, const Gemm<GC> g, const Sched& S, const Epi& E) {
    const int tid = otid(), wid = __builtin_amdgcn_readfirstlane(tid >> 6), lane = tid & 63, wr = wid >> 2, wc = wid & 3, fr = lane & 15, fq = lane >> 4;
    constexpr int K = GC::K, nt = K / BK, ksplit = GC::KSPLIT;
    unsigned voffA[2], voffB[2];
#pragma unroll
    for (int i = 0; i < 2; ++i) { int R, C; stage_rc(tid * 16 + i * 8192, R, C); const int Rb = Epi::PERM ? ((R & ~31) + perm32(R & 31)) : R;
        voffA[i] = (unsigned)(R * GC::LDA + C) * 2u; voffB[i] = (unsigned)(Rb * GC::LDB + C) * 2u; }
    constexpr size_t kstep = (size_t)(BK * 2);
    constexpr size_t hstepA = (size_t)HALF * GC::LDA * 2, hstepB = (size_t)HALF * GC::LDB * 2;
    const unsigned ldsw = (unsigned)wid * 1024u;
    const int aoff = lds_byte(wr * 64 + fr, fq * 8), boff = lds_byte(wc * 32 + fr, fq * 8);
#define PG8_SA(b, h) (((b) * 2 + (h)) * HTB)
#define PG8_SB(b, h) ((4 + (b) * 2 + (h)) * HTB)
#define PG8_STAGE(bufoff, gbase, voff) do { _Pragma("unroll") for (int _i = 0; _i < 2; ++_i) \
        __builtin_amdgcn_global_load_lds((const unsigned*)((const char*)(gbase) + (voff)[_i]), (LAS unsigned*)(lds + (bufoff) + ldsw + _i * 8192), 16, 0, 0); } while (0)
#define PG8_LDA(dst, b, h) do { _Pragma("unroll") for (int m = 0; m < 4; ++m) _Pragma("unroll") for (int k = 0; k < 2; ++k) dst[m][k] = *(const LAS bf16x8*)(lds + PG8_SA(b, h) + aoff + m * 2048 + k * 1024); } while (0)
#define PG8_LDB(dst, b, h) do { _Pragma("unroll") for (int n = 0; n < 2; ++n) _Pragma("unroll") for (int k = 0; k < 2; ++k) dst[n][k] = *(const LAS bf16x8*)(lds + PG8_SB(b, h) + boff + n * 2048 + k * 1024); } while (0)
#define PG8_MMA(ai, bj, At, Bt) do { __builtin_amdgcn_s_setprio(1); _Pragma("unroll") for (int m = 0; m < 4; ++m) _Pragma("unroll") for (int n = 0; n < 2; ++n) _Pragma("unroll") for (int k = 0; k < 2; ++k) \
        acc[ai][bj][m][n] = __builtin_amdgcn_mfma_f32_16x16x32_bf16(Bt[n][k], At[m][k], acc[ai][bj][m][n], 0, 0, 0); __builtin_amdgcn_s_setprio(0); } while (0)
#define PG8_WAIT_V(n) asm volatile("s_waitcnt vmcnt(" #n ")" ::: "memory")
#define PG8_WAIT_L(n) asm volatile("s_waitcnt lgkmcnt(" #n ")" ::: "memory")
#define PG8_BAR __builtin_amdgcn_s_barrier()
#define PG8_SCHED __builtin_amdgcn_sched_barrier(0)
    Unit cur, nxt; int ui = 0;
    if (!S.next(0, cur)) return;
    f32x4 acc[2][2][4][2];
#pragma unroll
    for (int a = 0; a < 2; ++a)
#pragma unroll
        for (int b = 0; b < 2; ++b)
#pragma unroll
            for (int m = 0; m < 4; ++m)
#pragma unroll
                for (int n = 0; n < 2; ++n) acc[a][b][m][n] = (f32x4){0.f, 0.f, 0.f, 0.f};
    bf16x8 At[4][2], B0[2][2], B1[2][2];
    const char* cA = g.a_base(cur); const char* cB = g.b_base(cur); long cD = g.a_delta(cur);
    if constexpr (SP2) {
        PG8_STAGE(PG8_SB(0, 0), cB, voffB); PG8_STAGE(PG8_SB(0, 1), cB + hstepB, voffB); PG8_STAGE(PG8_SA(0, 0), cA, voffA); PG8_STAGE(PG8_SA(0, 1), cA + hstepA, voffA);
        if (wr == 1) PG8_BAR;
        PG8_WAIT_V(2); PG8_BAR;
        PG8_STAGE(PG8_SB(1, 0), cB + kstep, voffB); PG8_STAGE(PG8_SA(1, 0), cA + kstep, voffA); PG8_STAGE(PG8_SB(1, 1), cB + hstepB + kstep, voffB);
        PG8_WAIT_V(6); PG8_BAR;
    } else {
        PG8_STAGE(PG8_SB(0, 0), cB, voffB); PG8_STAGE(PG8_SA(0, 0), cA, voffA); PG8_STAGE(PG8_SB(0, 1), cB + hstepB, voffB); PG8_STAGE(PG8_SA(0, 1), cA + hstepA, voffA);
        if (wr == 1) PG8_BAR;
        PG8_WAIT_V(4); PG8_BAR;
        PG8_STAGE(PG8_SB(1, 0), cB + kstep, voffB); PG8_STAGE(PG8_SA(1, 0), cA + kstep, voffA); PG8_STAGE(PG8_SB(1, 1), cB + hstepB + kstep, voffB);
        PG8_WAIT_V(6); PG8_BAR;
    }
    for (;;) {
        const bool has_next = S.next(ui + 1, nxt);
        const char* nA = has_next ? g.a_base(nxt) : cA; const char* nB = has_next ? g.b_base(nxt) : cB;
        const long nD = has_next ? g.a_delta(nxt) : cD;
#pragma unroll 1
        for (int t = 0; t < nt; t += 2) {
            const bool last = (t == nt - 2);
            const char* a1 = cA + (size_t)(t + 1) * kstep + (t >= ksplit ? cD : 0);
            const char* a2 = last ? nA : cA + (size_t)(t + 2) * kstep + (t + 2 >= ksplit ? cD : 0); const char* b2 = last ? nB : cB + (size_t)(t + 2) * kstep;
            const char* a3 = a2 + kstep; const char* b3 = b2 + kstep;
            if constexpr (SP2) {
            PG8_LDB(B0, 0, 0); PG8_LDB(B1, 0, 1); PG8_SCHED; PG8_LDA(At, 0, 0); PG8_STAGE(PG8_SA(1, 1), a1 + hstepA, voffA);
            PG8_WAIT_V(8); PG8_WAIT_L(0); PG8_BAR; PG8_MMA(0, 0, At, B0); PG8_MMA(0, 1, At, B1); PG8_BAR; PG8_SCHED;
            PG8_LDA(At, 0, 1); PG8_STAGE(PG8_SB(0, 0), b2, voffB); PG8_STAGE(PG8_SB(0, 1), b2 + hstepB, voffB); PG8_STAGE(PG8_SA(0, 0), a2, voffA);
            PG8_WAIT_V(8); PG8_WAIT_L(0); PG8_BAR; PG8_MMA(1, 0, At, B0); PG8_MMA(1, 1, At, B1); PG8_BAR; PG8_SCHED;
            PG8_LDB(B0, 1, 0); PG8_LDB(B1, 1, 1); PG8_SCHED; PG8_LDA(At, 1, 0); PG8_STAGE(PG8_SA(0, 1), a2 + hstepA, voffA);
            PG8_WAIT_V(8); PG8_WAIT_L(0); PG8_BAR; PG8_MMA(0, 0, At, B0); PG8_MMA(0, 1, At, B1); PG8_BAR; PG8_SCHED;
            PG8_LDA(At, 1, 1); PG8_STAGE(PG8_SB(1, 0), b3, voffB); PG8_STAGE(PG8_SB(1, 1), b3 + hstepB, voffB); PG8_STAGE(PG8_SA(1, 0), a3, voffA);
            PG8_WAIT_V(8); PG8_WAIT_L(0); PG8_BAR; PG8_MMA(1, 0, At, B0); PG8_MMA(1, 1, At, B1); PG8_BAR; PG8_SCHED;
            } else {
            PG8_LDB(B0, 0, 0); PG8_SCHED; PG8_LDA(At, 0, 0); PG8_STAGE(PG8_SA(1, 1), a1 + hstepA, voffA);
            PG8_WAIT_L(8); PG8_BAR; PG8_WAIT_L(0); PG8_MMA(0, 0, At, B0); PG8_BAR; PG8_SCHED;
            PG8_LDB(B1, 0, 1); PG8_STAGE(PG8_SB(0, 0), b2, voffB);
            PG8_BAR; PG8_WAIT_L(0); PG8_MMA(0, 1, At, B1); PG8_BAR;
            PG8_LDA(At, 0, 1); PG8_STAGE(PG8_SA(0, 0), a2, voffA);
            PG8_BAR; PG8_WAIT_L(0); PG8_MMA(1, 0, At, B0); PG8_BAR; PG8_SCHED;
            PG8_STAGE(PG8_SB(0, 1), b2 + hstepB, voffB);
            PG8_WAIT_V(6); PG8_BAR; PG8_MMA(1, 1, At, B1); PG8_BAR;
            PG8_LDB(B0, 1, 0); PG8_SCHED; PG8_LDA(At, 1, 0); PG8_STAGE(PG8_SA(0, 1), a2 + hstepA, voffA);
            PG8_WAIT_L(8); PG8_BAR; PG8_WAIT_L(0); PG8_MMA(0, 0, At, B0); PG8_BAR; PG8_SCHED;
            PG8_LDB(B1, 1, 1); PG8_STAGE(PG8_SB(1, 0), b3, voffB);
            PG8_BAR; PG8_WAIT_L(0); PG8_MMA(0, 1, At, B1); PG8_BAR;
            PG8_LDA(At, 1, 1); PG8_STAGE(PG8_SA(1, 0), a3, voffA);
            PG8_BAR; PG8_WAIT_L(0); PG8_MMA(1, 0, At, B0); PG8_BAR; PG8_SCHED;
            PG8_STAGE(PG8_SB(1, 1), b3 + hstepB, voffB);
            PG8_WAIT_V(6); PG8_BAR; PG8_MMA(1, 1, At, B1); PG8_BAR;
            }
        }
        if constexpr (ALIGN_EPI) { if (wr == 0) PG8_BAR; }
        E(acc, cur, wr, wc, fr, fq);
        if (!has_next) break;
#pragma unroll
        for (int a = 0; a < 2; ++a)
#pragma unroll
            for (int b = 0; b < 2; ++b)
#pragma unroll
                for (int m = 0; m < 4; ++m)
#pragma unroll
                    for (int n = 0; n < 2; ++n) acc[a][b][m][n] = (f32x4){0.f, 0.f, 0.f, 0.f};
        cur = nxt; cA = nA; cB = nB; cD = nD; ++ui;
        if constexpr (ALIGN_EPI) { if (wr == 1) PG8_BAR; }
    }
    PG8_WAIT_V(0);
    if constexpr (!ALIGN_EPI) { if (wr == 0) PG8_BAR; }
    PG8_BAR;
#undef PG8_SA
#undef PG8_SB
#undef PG8_STAGE
#undef PG8_LDA
#undef PG8_LDB
#undef PG8_MMA
#undef PG8_WAIT_V
#undef PG8_WAIT_L
#undef PG8_BAR
#undef PG8_SCHED
}

__device__ __forceinline__ float act_apply(float v, int act) {
    if (act == 1) { const float r = v > 0.f ? v : 0.f; return r * r; }
    if (act == 2) { const float e = __expf(-2.f * fabsf(v)); const float t = (1.f - e) / (1.f + e); return v < 0.f ? -t : t; }
    if (act == 3) return 1.f / (1.f + __expf(-v));
    return v;
}
template <int ACT> __device__ __forceinline__ void store_tile_bf16(const f32x4 (&acc)[2][2][4][2], bf16_t* base, int ldc, int row0, int col0, bf16_t* base2, int ldc2, int col2) {
#pragma unroll
    for (int ai = 0; ai < 2; ++ai)
#pragma unroll
        for (int m = 0; m < 4; ++m) { const size_t r = (size_t)(row0 + ai * HALF + m * 16);
#pragma unroll
            for (int bj = 0; bj < 2; ++bj) { f32x4 v0 = acc[ai][bj][m][0], v1 = acc[ai][bj][m][1];
#pragma unroll
                for (int q = 0; q < 4; ++q) { v0[q] = act_apply(v0[q], ACT); v1[q] = act_apply(v1[q], ACT); }
                u32x4 w; w.x = cvt_pk_bf16(v0[0], v0[1]); w.y = cvt_pk_bf16(v0[2], v0[3]); w.z = cvt_pk_bf16(v1[0], v1[1]); w.w = cvt_pk_bf16(v1[2], v1[3]);
                *(u32x4*)(base + r * ldc + col0 + bj * HALF) = w;
                if (base2) *(u32x4*)(base2 + r * ldc2 + col2 + bj * HALF) = w; } }
}
template <int ACT> struct EpiBf16 {
    static constexpr bool PERM = true;
    bf16_t* O; int ldc;
    __device__ __forceinline__ void operator()(const f32x4 (&acc)[2][2][4][2], const Unit& u, int wr, int wc, int fr, int fq) const {
        store_tile_bf16<ACT>(acc, O, ldc, u.pm * BM + wr * 64 + fr, u.pn * BM + wc * 32 + 8 * fq, nullptr, 0, 0);
    }
};
struct EpiRkv {
    static constexpr bool PERM = true;
    bf16_t* RKV; bf16_t* LO; bf16_t* vf;
    __device__ __forceinline__ void operator()(const f32x4 (&acc)[2][2][4][2], const Unit& u, int wr, int wc, int fr, int fq) const {
        const int row0 = u.pm * BM + wr * 64 + fr, cin = wc * 32 + 8 * fq;
        if (u.pn < 12) { bf16_t* b2 = (u.pn >= 8) ? vf : nullptr; store_tile_bf16<0>(acc, RKV, 3072, row0, u.pn * BM + cin, b2, 1024, (u.pn - 8) * BM + cin); }
        else {
#pragma unroll
            for (int bj = 0; bj < 2; ++bj) { const int c = cin + bj * HALF; int dst = -1, act = 0;
                if (u.pn == 12) { if (c < 64) { dst = c; act = 2; } else if (c < 128) dst = 256 + (c - 64); else if (c < 160) dst = 512 + (c - 128); }
                else if (c < 160) { dst = 768 + c; act = 3; }
                if (dst >= 0) {
#pragma unroll
                    for (int ai = 0; ai < 2; ++ai)
#pragma unroll
                        for (int m = 0; m < 4; ++m) { const size_t r = (size_t)(row0 + ai * HALF + m * 16); f32x4 v0 = acc[ai][bj][m][0], v1 = acc[ai][bj][m][1];
#pragma unroll
                            for (int q = 0; q < 4; ++q) { v0[q] = act_apply(v0[q], act); v1[q] = act_apply(v1[q], act); }
                            u32x4 w; w.x = cvt_pk_bf16(v0[0], v0[1]); w.y = cvt_pk_bf16(v0[2], v0[3]); w.z = cvt_pk_bf16(v1[0], v1[1]); w.w = cvt_pk_bf16(v1[2], v1[3]);
                            *(u32x4*)(LO + r * 1024 + dst) = w; } } }
        }
    }
};
struct EpiRes {
    static constexpr bool PERM = false;
    float* X; const float* modl; int goff; const float* Xin;
    __device__ __forceinline__ void operator()(const f32x4 (&acc)[2][2][4][2], const Unit& u, int wr, int wc, int fr, int fq) const {
        const int col0 = u.pn * BM + wc * 32 + 4 * fq;
#pragma unroll
        for (int ai = 0; ai < 2; ++ai)
#pragma unroll
            for (int m = 0; m < 4; ++m) { const int r = u.pm * BM + ai * HALF + wr * 64 + m * 16 + fr; const float* gp = modl + (size_t)seq_of_row(r) * 6144 + goff + col0; float* xp = X + (size_t)r * D + col0; const float* xi = Xin + (size_t)r * D + col0;
#pragma unroll
                for (int bj = 0; bj < 2; ++bj)
#pragma unroll
                    for (int n = 0; n < 2; ++n) { const f32x4 gv = *(const f32x4*)(gp + bj * HALF + n * 16); f32x4 xv = *(const f32x4*)(xi + bj * HALF + n * 16);
                        xv = xv + gv * acc[ai][bj][m][n]; *(f32x4*)(xp + bj * HALF + n * 16) = xv; }
                asm volatile("" ::: "memory"); }
    }
};
struct EpiLora2 {
    static constexpr bool PERM = false;
    bf16_t* WLOG; bf16_t* Aout; bf16_t* G; bf16_t* RKV; const bf16_t* vf; const float* w0; const float* a0; const float* v0;
    template <int GRP> __device__ __forceinline__ void run(const f32x4 (&acc)[2][2][4][2], const Unit& u, int wr, int wc, int fr, int fq) const {
        const int col0 = (u.pn & 3) * BM + wc * 32 + 4 * fq;
#pragma unroll
        for (int ai = 0; ai < 2; ++ai)
#pragma unroll
            for (int m = 0; m < 4; ++m) { const size_t r = (size_t)(u.pm * BM + ai * HALF + wr * 64 + m * 16 + fr);
#pragma unroll
                for (int bj = 0; bj < 2; ++bj)
#pragma unroll
                    for (int n = 0; n < 2; ++n) { const int c = col0 + bj * HALF + n * 16; const f32x4 a = acc[ai][bj][m][n]; f32x4 o;
                        if constexpr (GRP == 0) { const f32x4 b = *(const f32x4*)(w0 + c);
#pragma unroll
                            for (int q = 0; q < 4; ++q) { const float x = -(b[q] + a[q]); const float sp = fmaxf(x, 0.f) + __logf(1.f + __expf(-fabsf(x))); o[q] = -__expf(-sp - 0.5f); }
                            u32x2 w; w.x = cvt_pk_bf16(o[0], o[1]); w.y = cvt_pk_bf16(o[2], o[3]); *(u32x2*)(WLOG + r * D + c) = w; }
                        else if constexpr (GRP == 1) { const f32x4 b = *(const f32x4*)(a0 + c);
#pragma unroll
                            for (int q = 0; q < 4; ++q) o[q] = 1.f / (1.f + __expf(-(b[q] + a[q])));
                            u32x2 w; w.x = cvt_pk_bf16(o[0], o[1]); w.y = cvt_pk_bf16(o[2], o[3]); *(u32x2*)(Aout + r * D + c) = w; }
                        else if constexpr (GRP == 2) { const f32x4 b = *(const f32x4*)(v0 + c); const u32x2 vv = *(const u32x2*)(RKV + r * 3072 + 2048 + c), ff = *(const u32x2*)(vf + r * D + c);
                            f32x4 v4, f4; v4[0] = bflo(vv.x); v4[1] = bfhi(vv.x); v4[2] = bflo(vv.y); v4[3] = bfhi(vv.y); f4[0] = bflo(ff.x); f4[1] = bfhi(ff.x); f4[2] = bflo(ff.y); f4[3] = bfhi(ff.y);
#pragma unroll
                            for (int q = 0; q < 4; ++q) { const float gte = 1.f / (1.f + __expf(-(b[q] + a[q]))); o[q] = v4[q] + (f4[q] - v4[q]) * gte; }
                            u32x2 w; w.x = cvt_pk_bf16(o[0], o[1]); w.y = cvt_pk_bf16(o[2], o[3]); *(u32x2*)(RKV + r * 3072 + 2048 + c) = w; }
                        else { u32x2 w; w.x = cvt_pk_bf16(a[0], a[1]); w.y = cvt_pk_bf16(a[2], a[3]); *(u32x2*)(G + r * D + c) = w; } }
                asm volatile("" ::: "memory"); }
    }
    __device__ __forceinline__ void operator()(const f32x4 (&acc)[2][2][4][2], const Unit& u, int wr, int wc, int fr, int fq) const {
        const int grp = u.pn >> 2;
        if (grp == 0) run<0>(acc, u, wr, wc, fr, fq);
        else if (grp == 1) run<1>(acc, u, wr, wc, fr, fq);
        else if (grp == 2) { if (vf != nullptr) run<2>(acc, u, wr, wc, fr, fq); }
        else run<3>(acc, u, wr, wc, fr, fq);
    }
};
struct SplitOrder {
    int c, splitk;
    __device__ bool next(int i, Unit& u) const { if (i != 0 || c >= 16 * splitk) return false; const int t = c / splitk; u.pm = 64 + (t >> 2); u.pn = t & 3; u.ks = c % splitk; return true; }
};
struct LoraOrder {
    int c;
    __device__ bool next(int i, Unit& u) const { const int idx = c - 48; if (i != 0 || idx < 0 || idx >= 136) return false; u.pm = idx >> 1; u.pn = 12 + (idx & 1); u.ks = 0; return true; }
};
struct EpiPartial {
    static constexpr bool PERM = false;
    float* PART; int splitk;
    __device__ __forceinline__ void operator()(const f32x4 (&acc)[2][2][4][2], const Unit& u, int wr, int wc, int fr, int fq) const {
        float* base = PART + ((size_t)(((u.pm - 64) * 4 + u.pn) * splitk + u.ks) << 16) + wc * 32 + 4 * fq;
#pragma unroll
        for (int ai = 0; ai < 2; ++ai)
#pragma unroll
            for (int m = 0; m < 4; ++m) { float* rp = base + (ai * HALF + wr * 64 + m * 16 + fr) * 256;
#pragma unroll
                for (int bj = 0; bj < 2; ++bj)
#pragma unroll
                    for (int n = 0; n < 2; ++n) *(f32x4*)(rp + bj * HALF + n * 16) = acc[ai][bj][m][n]; }
    }
};
template <bool PERM_> struct EpiNull {
    static constexpr bool PERM = PERM_;
    __device__ __forceinline__ void operator()(const f32x4 (&acc)[2][2][4][2], const Unit&, int, int, int, int) const {
#pragma unroll
        for (int a = 0; a < 2; ++a)
#pragma unroll
            for (int b = 0; b < 2; ++b)
#pragma unroll
                for (int m = 0; m < 4; ++m)
#pragma unroll
                    for (int n = 0; n < 2; ++n) asm volatile("" :: "v"(acc[a][b][m][n]));
    }
};
}

#define RLX_AGENT __ATOMIC_RELAXED, __HIP_MEMORY_SCOPE_AGENT
#define XB_TMO      128
#define XB_XCNT(j)  (256  + 64 * (j))
#define XB_XSUB(j)  (1280 + 64 * (j))
#define XB_XGEN(j)  (2304 + 64 * (j))
#define XB_TOP      3328
#define XB_TOPGEN   3392
#define XCD_BAR_WORDS 3456
#define XB_SPIN_CAP (1u << 24)
__device__ __forceinline__ unsigned xb_ld(unsigned* p)              { return __hip_atomic_load(p, __ATOMIC_RELAXED, __HIP_MEMORY_SCOPE_AGENT); }
__device__ __forceinline__ unsigned xb_add(unsigned* p, unsigned v) { return __hip_atomic_fetch_add(p, v, __ATOMIC_RELAXED, __HIP_MEMORY_SCOPE_AGENT); }
__device__ __forceinline__ unsigned xb_xcc_id() { return (unsigned)__builtin_amdgcn_s_getreg((3 << 11) | 20) & 0xFu; }
#define XB_SPIN(cond, bar) do { unsigned _sp = 0; while (cond) { __builtin_amdgcn_s_sleep(4); \
    if ((++_sp & 255u) == 0u) { if (xb_ld(&(bar)[XB_TMO])) break; if (_sp > XB_SPIN_CAP) { atomicAdd(&(bar)[XB_TMO], 1u); break; } } } } while (0)
struct XcdBarrier { unsigned* bar; unsigned x; volatile LAS unsigned* st; };
__device__ __forceinline__ XcdBarrier xcd_barrier_post(unsigned* bar, volatile LAS unsigned* st) {
    XcdBarrier b; b.bar = bar; b.x = xb_xcc_id(); b.st = st;
    if (threadIdx.x == 0) (void)xb_add(&bar[XB_XCNT(b.x)], 1u);
    return b;
}
__device__ __forceinline__ void xcd_barrier_complete(unsigned* bar, unsigned x, unsigned& nloc, unsigned& nx) {
    const unsigned G = gridDim.x * gridDim.y * gridDim.z;
    unsigned sum, cnt, mine, sp = 0u;
    for (;;) {
        sum = 0u; cnt = 0u; mine = 0u;
#pragma unroll
        for (unsigned j = 0; j < 16; ++j) { const unsigned c = xb_ld(&bar[XB_XCNT(j)]); sum += c; cnt += (c > 0u) ? 1u : 0u; mine = (j == x) ? c : mine; }
        if (sum == G) break;
        __builtin_amdgcn_s_sleep(1);
        if ((++sp & 255u) == 0u) { if (xb_ld(&bar[XB_TMO])) break; if (sp > XB_SPIN_CAP) { atomicAdd(&bar[XB_TMO], 1u); break; } }
    }
    nloc = mine > 0u ? mine : 1u; nx = cnt > 0u ? cnt : 1u;
}
__device__ __forceinline__ void xcd_barrier(const XcdBarrier& b) {
    asm volatile("s_waitcnt vmcnt(0)" ::: "memory");
    __syncthreads();
    if (threadIdx.x == 0) {
        unsigned* bar = b.bar;
        __builtin_amdgcn_s_waitcnt(0);
        unsigned nloc = b.st[0], nx = b.st[1];
        if (nloc == 0u) { xcd_barrier_complete(bar, b.x, nloc, nx); b.st[0] = nloc; b.st[1] = nx; }
        const unsigned gen = b.st[2];
        const unsigned old = xb_add(&bar[XB_XSUB(b.x)], 1u);
        if (old + 1u == (gen + 1u) * nloc) {
            __builtin_amdgcn_fence(__ATOMIC_RELEASE, "agent");
            asm volatile("s_waitcnt vmcnt(0)" ::: "memory");
            const unsigned og = xb_add(&bar[XB_TOP], 1u);
            if (og + 1u == (gen + 1u) * nx) xb_add(&bar[XB_TOPGEN], 1u);
            else XB_SPIN(xb_ld(&bar[XB_TOPGEN]) == gen, bar);
        } else {
            XB_SPIN(xb_ld(&bar[XB_TOPGEN]) == gen, bar);
        }
        __builtin_amdgcn_fence(__ATOMIC_ACQUIRE, "agent");
        asm volatile("s_waitcnt vmcnt(0)" ::: "memory");
        b.st[2] = gen + 1u;
    }
    __syncthreads();
}

constexpr int NWAVES = 8, NT = NWAVES * 64;
constexpr int RING_BYTES = 131072, LDSCTL_OFF = RING_BYTES, MISC_OFF = LDSCTL_OFF + 320, LDS_BYTES = 147456;
constexpr int CW_BAR = 4096;

struct Args { const float* in[38]; float* out; unsigned char* ws; };
struct Frame {
    LAS unsigned char* lds; volatile LAS unsigned* MISC;
    int wave, vcu, G;
    const float* const* in; float* out; unsigned char* ws;
};
enum { I_XP = 0, I_XS, I_SRET, I_SHG, I_SWKV, I_SSHIFT, I_CP, I_CS, I_MODW, I_MODB, I_NMIXG, I_NMLPG, I_FINALG, I_W1, I_W2, I_ABWIN, I_ABWOUT, I_HGLB, I_HGNG,
       I_MU, I_WRKV, I_RW0, I_RW1, I_RW2, I_RA0, I_RA1, I_RA2, I_RV0, I_RV1, I_RV2, I_RG1, I_RG2, I_RKK, I_RKA, I_RRK, I_RLNG, I_RLNB, I_RWOUT };
constexpr size_t O_Y = 0, O_RETP = 17825792, O_RETS = 17891328, O_HGP = 19988480, O_HGS = 20119552, O_WKVP = 24313856, O_WKVS = 24444928, O_SHP = 28639232, O_SHS = 28641280;

__device__ __forceinline__ void transpose_item(const float* W, int N, bf16_t* WT, int ldt, int row_off, int col_off, const float* mu, int mode, LAS float* scr, int item, int lane) {
    const int nblk = N / 32, kb = item / nblk, nb = item % nblk, k0 = 64 * kb, n0 = 32 * nb;
#pragma unroll 8
    for (int i = 0; i < 32; ++i) { const int kk = 2 * i + (lane >> 5); float s = 1.f; if (mode == 1) s = 1.f - mu[k0 + kk]; else if (mode == 2) s = mu[k0 + kk];
        scr[kk * 33 + (lane & 31)] = W[(size_t)(k0 + kk) * N + n0 + (lane & 31)] * s; }
    LDS_WAIT(); asm volatile("" ::: "memory");
    const int c = lane & 7;
#pragma unroll
    for (int j = 0; j < 4; ++j) { const int n = (lane >> 3) + 8 * j; const LAS float* s = scr + (8 * c) * 33 + n;
        u32x4 o; o.x = pk2(s[0 * 33], s[1 * 33]); o.y = pk2(s[2 * 33], s[3 * 33]); o.z = pk2(s[4 * 33], s[5 * 33]); o.w = pk2(s[6 * 33], s[7 * 33]);
        *(u32x4*)(WT + (size_t)(row_off + n0 + n) * ldt + col_off + k0 + 8 * c) = o; }
    LDS_WAIT(); asm volatile("" ::: "memory");
}
__device__ __forceinline__ void convert_layer_weights(Frame& F, int layer) {
    const int tid = otid(); const int lane = tid & 63; (void)lane;
    LAS float* scr = (LAS float*)(F.lds + F.wave * 16384);
    const int gw = F.vcu * NWAVES + F.wave, NGW = F.G * NWAVES;
    unsigned char* ar = F.ws + WS_ARENA;
    const int m = layer >> 1;
    constexpr int I_1 = (D / 64) * (DFF / 32), I_2 = (DFF / 64) * (D / 32);
    const float* w1 = F.in[I_W1] + (size_t)layer * D * DFF; const float* w2 = F.in[I_W2] + (size_t)layer * DFF * D;
    if ((layer & 1) == 0) {
        constexpr int I_IN = (D / 64) * (ABIN / 32), I_OUT = (D / 64) * (D / 32), NI = I_1 + I_2 + I_IN + I_OUT;
        const float* win = F.in[I_ABWIN] + (size_t)m * D * ABIN; const float* wout = F.in[I_ABWOUT] + (size_t)m * D * D;
        for (int it = gw; it < NI; it += NGW) { int r = it;
            if (r < I_1) { transpose_item(w1, DFF, (bf16_t*)(ar + AR_W1), D, 0, 0, nullptr, 0, scr, r, lane); continue; } r -= I_1;
            if (r < I_2) { transpose_item(w2, D, (bf16_t*)(ar + AR_W2), DFF, 0, 0, nullptr, 0, scr, r, lane); continue; } r -= I_2;
            if (r < I_IN) { transpose_item(win, ABIN, (bf16_t*)(ar + AR_WIN), D, 0, 0, nullptr, 0, scr, r, lane); continue; } r -= I_IN;
            transpose_item(wout, D, (bf16_t*)(ar + AR_WOUT), D, 0, 0, nullptr, 0, scr, r, lane); }
    } else {
        constexpr int I_P = (D / 64) * (D / 32), NI = I_1 + I_2 + 4 * I_P;
        const float* mu = F.in[I_MU] + (size_t)m * 6 * D; const float* wrkv = F.in[I_WRKV] + (size_t)m * 3 * D * D; const float* wo = F.in[I_RWOUT] + (size_t)m * D * D;
        bf16_t* wc1 = (bf16_t*)(ar + AR_WC1);
        for (int it = gw; it < NI; it += NGW) { int r = it;
            if (r < I_1) { transpose_item(w1, DFF, (bf16_t*)(ar + AR_W1), D, 0, 0, nullptr, 0, scr, r, lane); continue; } r -= I_1;
            if (r < I_2) { transpose_item(w2, D, (bf16_t*)(ar + AR_W2), DFF, 0, 0, nullptr, 0, scr, r, lane); continue; } r -= I_2;
            if (r < 3 * I_P) { const int p = r / I_P;
                transpose_item(wrkv + (size_t)p * D * D, D, wc1, 2048, p * D, 0, nullptr, 0, scr, r % I_P, lane); continue; } r -= 3 * I_P;
            transpose_item(wo, D, (bf16_t*)(ar + AR_WO), D, 0, 0, nullptr, 0, scr, r, lane); }
        const int gt = F.vcu * NT + tid, NG = F.G * NT;
        const float* lw1 = F.in[I_RW1] + (size_t)m * D * 64; const float* la1 = F.in[I_RA1] + (size_t)m * D * 64; const float* lv1 = F.in[I_RV1]; const float* lg1 = F.in[I_RG1] + (size_t)m * D * 160;
        for (int idx = gt; idx < 512 * 2048; idx += NG) { const int n = idx >> 11, k = idx & 2047, kk = k & 1023, nn = n & 255;
            const float* src = nullptr; int ns = 0, mi = 0, nc = 0;
            if (n < 256) { if (nn < 64) { src = lw1; ns = 64; mi = 1; nc = nn; } else if (nn < 128) { src = la1; ns = 64; mi = 4; nc = nn - 64; } else if (nn < 160 && m == 1) { src = lv1; ns = 32; mi = 3; nc = nn - 128; } }
            else if (nn < 160) { src = lg1; ns = 160; mi = 5; nc = nn; }
            float v = 0.f; if (src) { const float muv = mu[mi * D + kk]; v = src[(size_t)kk * ns + nc] * (k < 1024 ? 1.f - muv : muv); }
            wc1[(size_t)(3072 + n) * 2048 + k] = (bf16_t)f2bf(v); }
        bf16_t* wc2 = (bf16_t*)(ar + AR_WC2);
        const float* lw2 = F.in[I_RW2] + (size_t)m * 64 * D; const float* la2 = F.in[I_RA2] + (size_t)m * 64 * D; const float* lv2 = F.in[I_RV2]; const float* lg2 = F.in[I_RG2] + (size_t)m * 160 * D;
        for (int idx = gt; idx < 4096 * 256; idx += NG) { const int k = idx >> 12, n = idx & 4095, g = n >> 10, nn = n & 1023;
            const float* src = (g == 0) ? lw2 : (g == 1) ? la2 : (g == 2) ? lv2 : lg2; const int ks = (g == 0 || g == 1) ? 64 : (g == 2 ? 32 : 160);
            float v = 0.f; if (k < ks && !(g == 2 && m == 0)) v = src[(size_t)k * D + nn];
            wc2[(size_t)n * 256 + k] = (bf16_t)f2bf(v); }
    }
}

__device__ __forceinline__ void mod_phase(Frame& F, int l_lo, int l_hi, int wb, int nb) {
    const int tid = otid(); const int lane = tid & 63;
    const float* __restrict__ SC = (const float*)(F.ws + WS_MOD + 3584 * 1024);
    float* MOD = (float*)(F.ws + WS_MOD);
    LAS float* red = (LAS float*)F.lds;
    for (int task = l_lo * 96 + wb; task < l_hi * 96; task += nb) { const int l = task / 96, n = (task % 96) * 64 + lane, ks = F.wave;
        const float* w = F.in[I_MODW] + ((size_t)l * D + ks * 128) * 6144 + n;
        float acc[NSEQ];
#pragma unroll
        for (int s = 0; s < NSEQ; ++s) acc[s] = 0.f;
        for (int k = 0; k < 128; k += 4) { const float w0 = w[(size_t)k * 6144], w1 = w[(size_t)(k + 1) * 6144], w2 = w[(size_t)(k + 2) * 6144], w3 = w[(size_t)(k + 3) * 6144];
#pragma unroll
            for (int s = 0; s < NSEQ; ++s) { const f32x4 c4 = *(const f32x4*)(SC + s * D + ks * 128 + k); acc[s] += (c4[0] * w0 + c4[1] * w1) + (c4[2] * w2 + c4[3] * w3); } }
        __syncthreads();
#pragma unroll
        for (int s = 0; s < NSEQ; ++s) red[(F.wave * NSEQ + s) * 64 + lane] = acc[s];
        __syncthreads();
        for (int i = tid; i < NSEQ * 64; i += NT) { const int s = i >> 6, c = i & 63; float t = F.in[I_MODB][l * 6144 + (task % 96) * 64 + c];
#pragma unroll
            for (int q = 0; q < 8; ++q) t += red[(q * NSEQ + s) * 64 + c];
            MOD[((size_t)l * NSEQ + s) * 6144 + (task % 96) * 64 + c] = t; }
    }
    __syncthreads();
}

__device__ __forceinline__ void prologue(Frame& F) {
    const int tid = otid(); const int lane = tid & 63; (void)lane;
    const int gt = F.vcu * NT + tid, NG = F.G * NT;
    { f32x2* tab = (f32x2*)(F.ws + WS_ROPE);
      for (int i = gt; i < 16384 * 32; i += NG) { const int p = i >> 5, d = i & 31; double rev = (double)p * ROPE_REV[d]; rev -= floor(rev); const float fr = (float)rev;
          tab[i] = (f32x2){__builtin_amdgcn_cosf(fr), __builtin_amdgcn_sinf(fr)}; } }
    { unsigned* z = (unsigned*)(F.ws + WS_XN0); for (int i = gt; i < 512; i += NG) z[i] = 0u; }
    { float* SC = (float*)(F.ws + WS_MOD + 3584 * 1024);
      for (int i = gt; i < NSEQ * D; i += NG) { const int s = i >> 10, k = i & 1023; const float c = (s == 0) ? F.in[I_CP][k] : F.in[I_CS][(size_t)(s - 1) * D + k]; SC[i] = siluf_(c); } }
    convert_layer_weights(F, 0);
}

template <int MODE> __device__ __forceinline__ void norm_row(Frame& F, int layer, int r, f32x4 (&v)[4], const float* MOD, const float* gvec, int lane, f32x4 (&ho)[4]) {
    const int m = layer >> 1; const int shoff = (MODE == 2) ? 3072 : 0, scoff = (MODE == 2) ? 4096 : 1024;
    bf16_t* XN = (bf16_t*)(F.ws + WS_XN); bf16_t* PREVS = (bf16_t*)(F.ws + WS_PREVS);
    float* xrow = F.out + (size_t)r * D; float s2 = 0.f;
#pragma unroll
    for (int j = 0; j < 4; ++j) s2 += (v[j].x * v[j].x + v[j].y * v[j].y) + (v[j].z * v[j].z + v[j].w * v[j].w);
    const float rstd = 1.f / sqrtf(wave_sum(s2) * (1.f / D) + NORM_EPS);
    const int seq = seq_of_row(r); const float* mp = MOD + (size_t)seq * 6144;
#pragma unroll
    for (int j = 0; j < 4; ++j) { const int c = 4 * lane + 256 * j; const f32x4 g4 = *(const f32x4*)(gvec + c); f32x4 o = v[j] * rstd * g4;
        if (MODE == 3) { *((f32x4*)xrow + lane + 64 * j) = o; continue; }
        const f32x4 sc = *(const f32x4*)(mp + scoff + c), sh = *(const f32x4*)(mp + shoff + c);
        o = o * (1.f + sc) + sh; ho[j] = o;
        const unsigned long long pk = (unsigned long long)pk2(o.x, o.y) | ((unsigned long long)pk2(o.z, o.w) << 32);
        *(unsigned long long*)(XN + (size_t)r * D + c) = pk;
        if (MODE == 1) {
            if (r >= MP) { const int t = (r - MP) & 31; if (t < 31) *(unsigned long long*)(PREVS + (size_t)(r - MP + 1) * D + c) = pk;
                else *(f32x4*)(F.out + O_SHS + ((size_t)m * 32 + ((r - MP) >> 5)) * D + c) = o;
                if (t == 0) { const f32x4 ss = *(const f32x4*)(F.in[I_SSHIFT] + ((size_t)m * 32 + ((r - MP) >> 5)) * D + c);
                    *(unsigned long long*)(PREVS + (size_t)(r - MP) * D + c) = (unsigned long long)pk2(ss.x, ss.y) | ((unsigned long long)pk2(ss.z, ss.w) << 32); } }
            else if (r == MP - 1) *(f32x4*)(F.out + O_SHP + (size_t)m * D + c) = o;
        } }
}
__device__ __forceinline__ void hmix_calc(const float* mp, const float* gvec, const f32x4 (&v)[4], int lane, f32x4 (&h)[4]) {
    float s2 = 0.f;
#pragma unroll
    for (int j = 0; j < 4; ++j) s2 += (v[j].x * v[j].x + v[j].y * v[j].y) + (v[j].z * v[j].z + v[j].w * v[j].w);
    const float rstd = 1.f / sqrtf(wave_sum(s2) * (1.f / D) + NORM_EPS);
#pragma unroll
    for (int j = 0; j < 4; ++j) { const int c = 4 * lane + 256 * j; const f32x4 g4 = *(const f32x4*)(gvec + c), sc = *(const f32x4*)(mp + 1024 + c), sh = *(const f32x4*)(mp + c); h[j] = v[j] * rstd * g4 * (1.f + sc) + sh; }
}
__device__ __forceinline__ void write_mixes(Frame& F, int m, int r, const f32x4 (&h)[4], const f32x4 (&p)[4], int lane) {
    bf16_t* XM = (bf16_t*)(F.ws + WS_XMIX); const float* mu = F.in[I_MU] + (size_t)m * 6 * D;
#pragma unroll
    for (int j = 0; j < 4; ++j) { const int c = 4 * lane + 256 * j; const f32x4 d = p[j] - h[j];
#pragma unroll
        for (int q = 0; q < 3; ++q) { const f32x4 mv = *(const f32x4*)(mu + (q == 0 ? 0 : (q == 1 ? 2 : 3)) * D + c); const f32x4 x = h[j] + d * mv;
            *(unsigned long long*)(XM + ((size_t)q * M + r) * D + c) = (unsigned long long)pk2(x.x, x.y) | ((unsigned long long)pk2(x.z, x.w) << 32); } }
}
template <int MODE, int PEND = 0, bool FIRSTP = false, bool FIRSTS = false> __device__ __forceinline__ void norm_pass(Frame& F, int layer, int player = 0, int pgoff = 0) {
    const int tid = otid(); const int lane = tid & 63;
    const int gw = F.vcu * NWAVES + F.wave, NGW = F.G * NWAVES;
    const float* MOD = (const float*)(F.ws + WS_MOD) + (size_t)layer * NSEQ * 6144;
    const float* gvec = (MODE == 3) ? F.in[I_FINALG] : (MODE == 2 ? F.in[I_NMLPG] + layer * D : F.in[I_NMIXG] + layer * D);
    LAS float* xs = (LAS float*)F.lds;
    const int m = layer >> 1; const int r0s = MP + 4 * F.vcu;
    const float* gmod = (const float*)(F.ws + WS_MOD) + (size_t)player * NSEQ * 6144 + pgoff;
    if constexpr (MODE == 1) {
        static_assert(PEND > 0, "the RWKV mix norm always follows an MLP-down GEMM");
        if (F.vcu < 32) { const int sq = F.vcu, rbase = MP + 32 * sq; const float* mp = MOD + (size_t)(1 + sq) * 6144;
            __syncthreads();
#pragma unroll 2
            for (int q = 0; q < 16; ++q) { const int idx = tid + q * NT, rr = idx >> 8, c4 = (idx & 255) * 4; const int r = rbase + rr;
                const int pn = c4 >> 8; const float* pb = (const float*)(F.ws + WS_PART) + ((size_t)((((r >> 8) - 64) * 4 + pn) * PEND) << 16) + (r & 255) * 256 + (c4 & 255);
                f32x4 acc = (f32x4){0.f, 0.f, 0.f, 0.f};
#pragma unroll
                for (int ks = 0; ks < PEND; ++ks) acc += *(const f32x4*)(pb + ((size_t)ks << 16));
                const f32x4 g4 = *(const f32x4*)(gmod + (size_t)(1 + sq) * 6144 + c4); f32x4 x4 = *(const f32x4*)(F.out + (size_t)r * D + c4);
                x4 = x4 + g4 * acc; *(f32x4*)(F.out + (size_t)r * D + c4) = x4; *(LAS f32x4*)(xs + rr * 1024 + c4) = x4; }
            __syncthreads();
            for (int rr = F.wave; rr < 32; rr += NWAVES) { const int r = rbase + rr; f32x4 v[4], ho[4], hp[4];
#pragma unroll
                for (int j = 0; j < 4; ++j) v[j] = *(const LAS f32x4*)(xs + rr * 1024 + 4 * lane + 256 * j);
                norm_row<MODE>(F, layer, r, v, MOD, gvec, lane, ho);
                if (rr == 0) {
#pragma unroll
                    for (int j = 0; j < 4; ++j) hp[j] = *((const f32x4*)(F.in[I_SSHIFT] + ((size_t)m * 32 + sq) * D) + lane + 64 * j);
                } else { f32x4 pv[4];
#pragma unroll
                    for (int j = 0; j < 4; ++j) pv[j] = *(const LAS f32x4*)(xs + (rr - 1) * 1024 + 4 * lane + 256 * j);
                    hmix_calc(mp, gvec, pv, lane, hp); }
                write_mixes(F, m, r, ho, hp, lane); }
            __syncthreads(); }
    } else if constexpr (PEND > 0) {
        __syncthreads();
#pragma unroll
        for (int q = 0; q < 2; ++q) { const int idx = tid + q * NT, rr = idx >> 8, c4 = (idx & 255) * 4; const int r = r0s + rr; if (4 * F.vcu + rr < MS) {
                const int pn = c4 >> 8; const float* pb = (const float*)(F.ws + WS_PART) + ((size_t)((((r >> 8) - 64) * 4 + pn) * PEND) << 16) + (r & 255) * 256 + (c4 & 255);
                f32x4 acc = (f32x4){0.f, 0.f, 0.f, 0.f};
#pragma unroll
                for (int ks = 0; ks < PEND; ++ks) acc += *(const f32x4*)(pb + ((size_t)ks << 16));
                const f32x4 g4 = *(const f32x4*)(gmod + (size_t)seq_of_row(r) * 6144 + c4); f32x4 x4 = FIRSTS ? *(const f32x4*)(F.in[I_XS] + (size_t)(r - MP) * D + c4) : *(const f32x4*)(F.out + (size_t)r * D + c4);
                x4 = x4 + g4 * acc; *(f32x4*)(F.out + (size_t)r * D + c4) = x4; *(LAS f32x4*)(xs + rr * 1024 + c4) = x4; } }
        __syncthreads();
    }
    const int pgw = (MODE == 1) ? (F.vcu - 32) * NWAVES + F.wave : gw, PNGW = (MODE == 1) ? (F.G - 32) * NWAVES : NGW;
    for (int r = pgw; r < MP && pgw >= 0; r += PNGW) {
        const f32x4* xr = (const f32x4*)((FIRSTP ? F.in[I_XP] : F.out) + (size_t)r * D) + lane; f32x4 v[4], ho[4];
#pragma unroll
        for (int j = 0; j < 4; ++j) v[j] = xr[64 * j];
        if constexpr (MODE == 1) { f32x4 pv[4], hp[4];
#pragma unroll
            for (int j = 0; j < 4; ++j) pv[j] = (r > 0) ? *((const f32x4*)(F.out + (size_t)(r - 1) * D) + lane + 64 * j) : (f32x4){0.f, 0.f, 0.f, 0.f};
            norm_row<MODE>(F, layer, r, v, MOD, gvec, lane, ho);
            if (r > 0) hmix_calc(MOD, gvec, pv, lane, hp); else {
#pragma unroll
                for (int j = 0; j < 4; ++j) hp[j] = (f32x4){0.f, 0.f, 0.f, 0.f}; }
            write_mixes(F, m, r, ho, hp, lane);
        } else norm_row<MODE>(F, layer, r, v, MOD, gvec, lane, ho);
    }
    if constexpr (MODE != 1) {
        if (F.wave < 4 && 4 * F.vcu + F.wave < MS) { const int r = r0s + F.wave; f32x4 v[4], ho[4];
#pragma unroll
            for (int j = 0; j < 4; ++j) { if constexpr (PEND > 0) v[j] = *(const LAS f32x4*)(xs + F.wave * 1024 + 4 * lane + 256 * j); else v[j] = *((const f32x4*)(FIRSTS ? F.in[I_XS] + (size_t)(r - MP) * D : F.out + (size_t)r * D) + lane + 64 * j); }
            norm_row<MODE>(F, layer, r, v, MOD, gvec, lane, ho); } }
}

template <int MT, int NTT> __device__ __forceinline__ void wave_mm_nt(f32x4 (&acc)[MT][NTT], const LAS bf16_t* X, int ldx, const LAS bf16_t* Y, int ldy, int K, int fr, int fq) {
    for (int k0 = 0; k0 < K; k0 += 32) {
        bf16x8 xa[MT], yb[NTT];
#pragma unroll
        for (int i = 0; i < MT; ++i) xa[i] = *(const LAS bf16x8*)(X + (16 * i + fr) * ldx + k0 + 8 * fq);
#pragma unroll
        for (int j = 0; j < NTT; ++j) yb[j] = *(const LAS bf16x8*)(Y + (16 * j + fr) * ldy + k0 + 8 * fq);
#pragma unroll
        for (int i = 0; i < MT; ++i)
#pragma unroll
            for (int j = 0; j < NTT; ++j) acc[i][j] = __builtin_amdgcn_mfma_f32_16x16x32_bf16(yb[j], xa[i], acc[i][j], 0, 0, 0);
    }
}

constexpr int LQS = 0, LKS = 18432, LQG = 36864, LVT = 55296, LST = 73728, LPS = 108544, LRED = 117760, LBS = 118784;
__device__ __forceinline__ void chunk_geom(int c, int& r0, int& pos0) { if (c < 256) { r0 = 64 * c; pos0 = 64 * c; } else { r0 = MP + 32 * (c - 256); pos0 = 2048; } }

template <int L, bool HG, bool SUMMARY> __device__ __forceinline__ void ab_load(Frame& F, int layer, int c, int h) {
    const int tid = otid(); const int lane = tid & 63; (void)lane;
    const int m = layer >> 1; int r0, pos0; chunk_geom(c, r0, pos0);
    const bf16_t* Z = (const bf16_t*)(F.ws + WS_Z);
    LAS bf16_t* QS = (LAS bf16_t*)(F.lds + LQS); LAS bf16_t* KS = (LAS bf16_t*)(F.lds + LKS); LAS bf16_t* QG = (LAS bf16_t*)(F.lds + LQG); LAS bf16_t* VT = (LAS bf16_t*)(F.lds + LVT);
    constexpr int LDT = L + 8;
    if constexpr (HG) {
        constexpr int TQ = L / 4; LAS float* BS = (LAS float*)(F.lds + LBS);
        const int ch = tid & 127, qtr = tid >> 7;
        float lb = 0.f;
        if (m == 1) { const float a0 = F.in[I_HGLB][h * 128 + ch], a1 = F.in[I_HGLB][512 + h * 128 + ch]; lb = 1.f / (1.f + __expf(a0 - a1)); }
        { constexpr int NP = L * 16;
#pragma unroll
          for (int q = 0; q < (NP + NT - 1) / NT; ++q) { const int v = tid + q * NT; if (NP % NT == 0 || v < NP) { const int j = v >> 4, c8 = v & 15; const size_t zr = (size_t)(r0 + j) * ABIN + h * 128 + c8 * 8;
                  const u32x4 zf4 = *(const u32x4*)(Z + zr + 2048), v4 = *(const u32x4*)(Z + zr + 2560);
                  *(LAS u32x4*)(QG + j * 136 + c8 * 8) = zf4; *(LAS u32x4*)(KS + j * 136 + c8 * 8) = v4;
                  if constexpr (!SUMMARY) { const u32x4 q4 = *(const u32x4*)(Z + zr + 1536); *(LAS u32x4*)(QS + j * 136 + c8 * 8) = q4; } } } }
        __syncthreads();
        float zf[TQ], cs[TQ]; float run = 0.f;
#pragma unroll
        for (int jj = 0; jj < TQ; ++jj) { const int j = qtr * TQ + jj; zf[jj] = bf2f(QG[j * 136 + ch]);
            float lf; if (lb == 0.f) lf = fminf(zf[jj], 0.f) - __logf(1.f + __expf(-fabsf(zf[jj]))); else lf = __logf(lb + (1.f - lb) * sigmoidf_(zf[jj]));
            run += lf; cs[jj] = run; }
        BS[qtr * 128 + ch] = run;
        __syncthreads();
        const float b0 = BS[ch], b1 = BS[128 + ch], b2 = BS[256 + ch], b3 = BS[384 + ch];
        const float off = (qtr > 0 ? b0 : 0.f) + (qtr > 1 ? b1 : 0.f) + (qtr > 2 ? b2 : 0.f), bL = (b0 + b1) + (b2 + b3), bmid = b0 + b1;
        if constexpr (SUMMARY) {
#pragma unroll
            for (int j8 = 0; j8 < TQ; j8 += 8) { unsigned vv[8]; float kd[8];
#pragma unroll
                for (int q = 0; q < 8; ++q) { const int jj = j8 + q, j = qtr * TQ + jj; const float b = off + cs[jj]; const float kb = (1.f - lb) * sigmoidf_(-zf[jj]); vv[q] = KS[j * 136 + ch]; kd[q] = kb * __expf(bL - b); }
                u32x4 pv, pk; pv.x = vv[0] | (vv[1] << 16); pv.y = vv[2] | (vv[3] << 16); pv.z = vv[4] | (vv[5] << 16); pv.w = vv[6] | (vv[7] << 16);
                pk.x = pk2(kd[0], kd[1]); pk.y = pk2(kd[2], kd[3]); pk.z = pk2(kd[4], kd[5]); pk.w = pk2(kd[6], kd[7]);
                *(LAS u32x4*)(VT + ch * LDT + qtr * TQ + j8) = pv; *(LAS u32x4*)(QS + ch * LDT + qtr * TQ + j8) = pk; }
            if (qtr == 0) ((float*)(F.ws + WS_DEC))[((size_t)c * 4 + h) * 128 + ch] = __expf(bL);
        } else {
#pragma unroll
            for (int j8 = 0; j8 < TQ; j8 += 8) { unsigned vv[8];
#pragma unroll
                for (int q8 = 0; q8 < 8; ++q8) { const int jj = j8 + q8, j = qtr * TQ + jj; const float b = off + cs[jj]; const float kb = (1.f - lb) * sigmoidf_(-zf[jj]);
                    const float q = siluf_(bf2f(QS[j * 136 + ch])); vv[q8] = KS[j * 136 + ch];
                    QS[j * 136 + ch] = (bf16_t)f2bf(q * __expf(b - bmid)); KS[j * 136 + ch] = (bf16_t)f2bf(kb * __expf(bmid - b)); QG[j * 136 + ch] = (bf16_t)f2bf(q * __expf(b)); }
                u32x4 pv; pv.x = vv[0] | (vv[1] << 16); pv.y = vv[2] | (vv[3] << 16); pv.z = vv[4] | (vv[5] << 16); pv.w = vv[6] | (vv[7] << 16);
                *(LAS u32x4*)(VT + ch * LDT + qtr * TQ + j8) = pv; }
        }
    } else {
        const float logg = log1pf(-exp2f(-5.f - (float)h));
        const f32x2* rope = (const f32x2*)(F.ws + WS_ROPE);
        for (int it = tid; it < L * 4; it += NT) { const int j = it >> 2, d8 = it & 3; const size_t zr = (size_t)(r0 + j) * ABIN;
            const f32x2* rp = rope + (size_t)(pos0 + j) * 32 + d8 * 8;
            const u32x4 k1 = *(const u32x4*)(Z + zr + 256 + h * 64 + d8 * 8), k2 = *(const u32x4*)(Z + zr + 256 + h * 64 + 32 + d8 * 8);
            const float gk = __expf((float)(L - 1 - j) * logg), gq = __expf((float)(j + 1) * logg);
            u32x4 q1 = (u32x4){0, 0, 0, 0}, q2 = q1; if constexpr (!SUMMARY) { q1 = *(const u32x4*)(Z + zr + h * 64 + d8 * 8); q2 = *(const u32x4*)(Z + zr + h * 64 + 32 + d8 * 8); }
#pragma unroll
            for (int e = 0; e < 8; ++e) { const f32x2 cs_ = rp[e]; const unsigned wk1 = k1[e >> 1], wk2 = k2[e >> 1]; const float x1 = (e & 1) ? bfhi(wk1) : bflo(wk1), x2 = (e & 1) ? bfhi(wk2) : bflo(wk2);
                const float o1 = x1 * cs_.x - x2 * cs_.y, o2 = x1 * cs_.y + x2 * cs_.x; const int d = d8 * 8 + e;
                if constexpr (SUMMARY) { QS[d * LDT + j] = (bf16_t)f2bf(o1 * gk); QS[(d + 32) * LDT + j] = (bf16_t)f2bf(o2 * gk); }
                else { KS[j * 72 + d] = (bf16_t)f2bf(o1); KS[j * 72 + d + 32] = (bf16_t)f2bf(o2);
                    const unsigned wq1 = q1[e >> 1], wq2 = q2[e >> 1]; const float y1 = (e & 1) ? bfhi(wq1) : bflo(wq1), y2 = (e & 1) ? bfhi(wq2) : bflo(wq2);
                    const float p1 = (y1 * cs_.x - y2 * cs_.y) * 0.125f, p2 = (y1 * cs_.y + y2 * cs_.x) * 0.125f;
                    QS[j * 72 + d] = (bf16_t)f2bf(p1); QS[j * 72 + d + 32] = (bf16_t)f2bf(p2); QG[j * 72 + d] = (bf16_t)f2bf(p1 * gq); QG[j * 72 + d + 32] = (bf16_t)f2bf(p2 * gq); } } }
        for (int it = tid; it < L * 16; it += NT) { const int j = it >> 4, e8 = it & 15; const u32x4 vv = *(const u32x4*)(Z + (size_t)(r0 + j) * ABIN + 512 + h * 128 + e8 * 8);
#pragma unroll
            for (int e = 0; e < 8; ++e) { const unsigned w = vv[e >> 1]; VT[(e8 * 8 + e) * LDT + j] = (bf16_t)((e & 1) ? (w >> 16) : (w & 0xffffu)); } }
    }
}

template <int L, bool HG> __device__ __forceinline__ void ab_summary_unit(Frame& F, int layer, int c, int h) {
    const int tid = otid(); const int lane = tid & 63; (void)lane;
    constexpr int DK = HG ? 128 : 64, NCT = DK / 16, LDT = L + 8;
    __syncthreads();
    ab_load<L, HG, true>(F, layer, c, h);
    __syncthreads();
    const int fr = lane & 15, fq = lane >> 4;
    const LAS bf16_t* KDT = (const LAS bf16_t*)(F.lds + LQS); const LAS bf16_t* VT = (const LAS bf16_t*)(F.lds + LVT);
    f32x4 acc[1][NCT];
#pragma unroll
    for (int j = 0; j < NCT; ++j) acc[0][j] = (f32x4){0.f, 0.f, 0.f, 0.f};
    wave_mm_nt<1, NCT>(acc, VT + F.wave * 16 * LDT, LDT, KDT, LDT, L, fr, fq);
    bf16_t* ST = (bf16_t*)(F.ws + WS_STATE) + (size_t)c * SLOT_E + (HG ? 32768 + h * 16384 : h * 8192);
    const int e = F.wave * 16 + fr;
#pragma unroll
    for (int j = 0; j < NCT; ++j) { u32x2 w; w.x = pk2(acc[0][j][0], acc[0][j][1]); w.y = pk2(acc[0][j][2], acc[0][j][3]); *(u32x2*)(ST + (size_t)e * DK + 16 * j + 4 * fq) = w; }
}

template <int L, bool HG> __device__ __forceinline__ void ab_output_unit(Frame& F, int layer, int c, int h) {
    const int tid = otid(); const int lane = tid & 63; (void)lane;
    constexpr int DK = HG ? 128 : 64, LDQ = HG ? 136 : 72, LDT = L + 8, NIT = L / 16, WPI = 8 / NIT, ET = 8 / WPI, TPW = (NIT * NIT >= 8) ? NIT * NIT / 8 : 1;
    const int m = layer >> 1; int r0, pos0; chunk_geom(c, r0, pos0);
    __syncthreads();
    ab_load<L, HG, false>(F, layer, c, h);
    LAS bf16_t* QS = (LAS bf16_t*)(F.lds + LQS); LAS bf16_t* KS = (LAS bf16_t*)(F.lds + LKS); LAS bf16_t* QG = (LAS bf16_t*)(F.lds + LQG); LAS bf16_t* VT = (LAS bf16_t*)(F.lds + LVT);
    LAS bf16_t* STl = (LAS bf16_t*)(F.lds + LST); LAS bf16_t* PS = (LAS bf16_t*)(F.lds + LPS); LAS float* RED = (LAS float*)(F.lds + LRED);
    { const bf16_t* ST = (const bf16_t*)(F.ws + WS_STATE) + (size_t)c * SLOT_E + (HG ? 32768 + h * 16384 : h * 8192);
      for (int it = tid; it < 128 * DK / 8; it += NT) { const int e = it / (DK / 8), c8 = it % (DK / 8); *(LAS u32x4*)(STl + e * LDQ + c8 * 8) = *(const u32x4*)(ST + (size_t)e * DK + c8 * 8); } }
    __syncthreads();
    const int fr = lane & 15, fq = lane >> 4, w = F.wave;
    const float logg = HG ? 0.f : log1pf(-exp2f(-5.f - (float)h));
    if (w * TPW < NIT * NIT) {
        const int it = (w * TPW) / NIT, jt0 = (w * TPW) % NIT;
        f32x4 sc[1][TPW];
#pragma unroll
        for (int q = 0; q < TPW; ++q) sc[0][q] = (f32x4){0.f, 0.f, 0.f, 0.f};
        wave_mm_nt<1, TPW>(sc, QS + it * 16 * LDQ, LDQ, KS + jt0 * 16 * LDQ, LDQ, DK, fr, fq);
        const int i = it * 16 + fr;
#pragma unroll
        for (int q = 0; q < TPW; ++q) { float p[4];
#pragma unroll
            for (int r = 0; r < 4; ++r) { const int j = (jt0 + q) * 16 + 4 * fq + r; float v = sc[0][q][r]; if (!HG) v *= __expf((float)(i - j) * logg); p[r] = (j <= i) ? v : 0.f; }
            u32x2 pw; pw.x = pk2(p[0], p[1]); pw.y = pk2(p[2], p[3]); *(LAS u32x2*)(PS + i * LDT + (jt0 + q) * 16 + 4 * fq) = pw; }
    }
    __syncthreads();
    const int it = w % NIT, eg = w / NIT;
    f32x4 o[1][ET];
#pragma unroll
    for (int q = 0; q < ET; ++q) o[0][q] = (f32x4){0.f, 0.f, 0.f, 0.f};
    wave_mm_nt<1, ET>(o, PS + it * 16 * LDT, LDT, VT + eg * ET * 16 * LDT, LDT, L, fr, fq);
    wave_mm_nt<1, ET>(o, QG + it * 16 * LDQ, LDQ, STl + eg * ET * 16 * LDQ, LDQ, DK, fr, fq);
    float ss = 0.f;
#pragma unroll
    for (int q = 0; q < ET; ++q) ss += (o[0][q][0] * o[0][q][0] + o[0][q][1] * o[0][q][1]) + (o[0][q][2] * o[0][q][2] + o[0][q][3] * o[0][q][3]);
    ss += __shfl_xor(ss, 16); ss += __shfl_xor(ss, 32);
    const int i = it * 16 + fr;
    if (fq == 0) RED[i * 4 + eg] = ss;
    __syncthreads();
    float tot = 0.f;
#pragma unroll
    for (int q = 0; q < WPI; ++q) tot += RED[i * 4 + q];
    const float rstd = 1.f / sqrtf(tot * (1.f / 128.f) + NORM_EPS);
    const bf16_t* Z = (const bf16_t*)(F.ws + WS_Z); bf16_t* O = (bf16_t*)(F.ws + WS_XN);
    const size_t row = (size_t)(r0 + i);
#pragma unroll
    for (int q = 0; q < ET; ++q) { const int e = (eg * ET + q) * 16 + 4 * fq; const u32x2 gw = *(const u32x2*)(Z + row * ABIN + (HG ? 3072 : 1024) + h * 128 + e);
        const float g4[4] = {bflo(gw.x), bfhi(gw.x), bflo(gw.y), bfhi(gw.y)}; float ov[4];
#pragma unroll
        for (int r = 0; r < 4; ++r) { if (HG) ov[r] = o[0][q][r] * rstd * F.in[I_HGNG][m * 128 + e + r] * sigmoidf_(g4[r]); else ov[r] = o[0][q][r] * rstd * siluf_(g4[r]); }
        u32x2 ow; ow.x = pk2(ov[0], ov[1]); ow.y = pk2(ov[2], ov[3]); *(u32x2*)(O + row * D + (HG ? 512 : 0) + h * 128 + e) = ow; }
}

template <bool DRY = false> __device__ __forceinline__ void ab_scan(Frame& F, int layer) {
    const int tid = otid(); const int lane = tid & 63; (void)lane;
    const int m = layer >> 1;
    unsigned* ST32 = (unsigned*)(F.ws + WS_STATE); const float* DEC = (const float*)(F.ws + WS_DEC);
    constexpr int NP = SLOT_E / 2;
    const int gt = F.vcu * NT + tid;
    if (gt < NP) {
        const int eo = 2 * gt; const bool hg = eo >= 32768; const int eo2 = hg ? eo - 32768 : eo; const int head = hg ? eo2 >> 14 : eo2 >> 13; const int cch = hg ? (eo2 & 127) : (eo2 & 63); const int e = hg ? ((eo2 & 16383) >> 7) : ((eo2 & 8191) >> 6);
        const float gdec = hg ? 0.f : __expf(64.f * log1pf(-exp2f(-5.f - (float)head)));
        float s0 = 0.f, s1 = 0.f;
        for (int c0 = 0; c0 < 256; c0 += 8) {
            unsigned kv[8]; float d0[8], d1[8];
#pragma unroll
            for (int u = 0; u < 8; ++u) { kv[u] = ST32[(size_t)(c0 + u) * NP + gt]; if (hg) { const f32x2 dd = *(const f32x2*)(DEC + ((size_t)(c0 + u) * 4 + head) * 128 + cch); d0[u] = dd.x; d1[u] = dd.y; } else { d0[u] = gdec; d1[u] = gdec; } }
#pragma unroll
            for (int u = 0; u < 8; ++u) { const unsigned pw = pk2(s0, s1); if constexpr (DRY) asm volatile("" :: "v"(pw)); else ST32[(size_t)(c0 + u) * NP + gt] = pw; s0 = d0[u] * s0 + bflo(kv[u]); s1 = d1[u] * s1 + bfhi(kv[u]); }
        }
        float* outp = hg ? F.out + O_HGP + (size_t)m * 65536 + head * 16384 : F.out + O_RETP + (size_t)m * 32768 + head * 8192;
        outp[(size_t)cch * 128 + e] = s0; outp[(size_t)(cch + 1) * 128 + e] = s1;
    } else {
        const int NG2 = F.G * NT - NP; if (NG2 <= 0) return;
        for (int idx = gt - NP; idx < 32 * NP; idx += NG2) { const int b = idx / NP, pr = idx % NP;
            const int eo = 2 * pr; const bool hg = eo >= 32768; const int eo2 = hg ? eo - 32768 : eo; const int head = hg ? eo2 >> 14 : eo2 >> 13; const int cch = hg ? (eo2 & 127) : (eo2 & 63); const int e = hg ? ((eo2 & 16383) >> 7) : ((eo2 & 8191) >> 6);
            float d0, d1; if (hg) { const f32x2 dd = *(const f32x2*)(DEC + ((size_t)(256 + b) * 4 + head) * 128 + cch); d0 = dd.x; d1 = dd.y; } else { d0 = d1 = __expf(32.f * log1pf(-exp2f(-5.f - (float)head))); }
            const size_t so = hg ? ((size_t)(m * 32 + b) * 4 + head) * 16384 : ((size_t)(m * 32 + b) * 4 + head) * 8192;
            const float* sin_ = (hg ? F.in[I_SHG] : F.in[I_SRET]) + so; float* sout = F.out + (hg ? O_HGS : O_RETS) + so;
            const float i0 = sin_[(size_t)cch * 128 + e], i1 = sin_[(size_t)(cch + 1) * 128 + e];
            const unsigned kv = ST32[(size_t)(256 + b) * NP + pr]; if constexpr (!DRY) ST32[(size_t)(256 + b) * NP + pr] = pk2(i0, i1);
            sout[(size_t)cch * 128 + e] = d0 * i0 + bflo(kv); sout[(size_t)(cch + 1) * 128 + e] = d1 * i1 + bfhi(kv); }
    }
}

constexpr int RL_AT = 0, RL_RT = 9216, RL_BT = 18432, RL_KT = 27648, RL_BHT = 36864, RL_KHT = 46080, RL_VT = 55296, RL_AAB = 64512, RL_AAK = 81920, RL_ARB = 91136, RL_ARK = 100352,
              RL_U0T = 109568, RL_VEC = 118784, RL_PSUM = 119808;
constexpr int RL_G = RL_AAB, RL_WW = RL_BT, RL_APT = RL_AAK;
constexpr int RL_PL = RL_AT, RL_RL = RL_BT, RL_Y0L = RL_BT + 4608, RL_QTL = RL_AAB, RL_S = RL_BHT;
__device__ __forceinline__ int pperm(int k) { return 32 * (k >> 5) + 8 * ((k >> 2) & 3) + 4 * ((k >> 4) & 1) + (k & 3); }

struct OutSide { u32x2 vv[4], gg[4]; f32x4 lg[4], lb[4]; float bon; };
__device__ __forceinline__ void rwkv_out_side(Frame& F, int m, size_t row, int h, int fq, OutSide& o) {
    const bf16_t* RKV = (const bf16_t*)(F.ws + WS_RKV); const bf16_t* GG = (const bf16_t*)(F.ws + WS_G); const float* BON = (const float*)(F.ws + WS_BON);
    o.bon = BON[row * 16 + h];
#pragma unroll
    for (int nt = 0; nt < 4; ++nt) { const int i = h * 64 + 16 * nt + 4 * fq;
        o.lg[nt] = *(const f32x4*)(F.in[I_RLNG] + m * D + i); o.lb[nt] = *(const f32x4*)(F.in[I_RLNB] + m * D + i);
        o.vv[nt] = *(const u32x2*)(RKV + row * 3072 + 2048 + i); o.gg[nt] = *(const u32x2*)(GG + row * D + i); }
}
template <bool DRY = false> __device__ __forceinline__ void rwkv_out_core(Frame& F, const f32x4 (&y)[4], size_t row, int h, int fq, const OutSide& sd) {
    bf16_t* RKV = (bf16_t*)(F.ws + WS_RKV);
    float s1 = 0.f;
#pragma unroll
    for (int nt = 0; nt < 4; ++nt) s1 += (y[nt][0] + y[nt][1]) + (y[nt][2] + y[nt][3]);
    s1 += __shfl_xor(s1, 16); s1 += __shfl_xor(s1, 32);
    const float mean = s1 * (1.f / 64.f); float s2 = 0.f;
#pragma unroll
    for (int nt = 0; nt < 4; ++nt)
#pragma unroll
        for (int r = 0; r < 4; ++r) { const float d = y[nt][r] - mean; s2 += d * d; }
    s2 += __shfl_xor(s2, 16); s2 += __shfl_xor(s2, 32);
    const float rstd = 1.f / sqrtf(s2 * (1.f / 64.f) + RW_LN_EPS), bon = sd.bon;
#pragma unroll
    for (int nt = 0; nt < 4; ++nt) { const int i = h * 64 + 16 * nt + 4 * fq; const f32x4 lg = sd.lg[nt], lb = sd.lb[nt]; const u32x2 vv = sd.vv[nt], gg = sd.gg[nt];
        const float v4[4] = {bflo(vv.x), bfhi(vv.x), bflo(vv.y), bfhi(vv.y)}, g4[4] = {bflo(gg.x), bfhi(gg.x), bflo(gg.y), bfhi(gg.y)}; float o[4];
#pragma unroll
        for (int r = 0; r < 4; ++r) o[r] = ((y[nt][r] - mean) * rstd * lg[r] + lb[r] + bon * v4[r]) * g4[r];
        u32x2 w; w.x = pk2(o[0], o[1]); w.y = pk2(o[2], o[3]); if constexpr (DRY) asm volatile("" :: "v"(w.x), "v"(w.y)); else *(u32x2*)(RKV + row * 3072 + i) = w; }
}
template <bool DRY = false> __device__ __forceinline__ void rwkv_out_epilogue(Frame& F, int m, const f32x4 (&y)[4], size_t row, int h, int fq) {
    OutSide sd; rwkv_out_side(F, m, row, h, fq, sd); rwkv_out_core<DRY>(F, y, row, h, fq, sd);
}

template <int S, int L> struct SubstQ {
    static constexpr int RQ = L / 4, NV4 = RQ / 4;
    static __device__ __forceinline__ void run(float (&x)[RQ], f32x4 (&aq)[3][NV4], const LAS float* ap) {
        if constexpr (S < L - 1) {
            if constexpr (S + 2 < L - 1) {
#pragma unroll
                for (int k = 0; k < NV4; ++k) aq[(S + 2) % 3][k] = *(const LAS f32x4*)(ap + (S + 2) * 68 + 4 * k);
            }
            constexpr int own = S / RQ, ctrl = own * 0x55;
            const float xs = __builtin_bit_cast(float, __builtin_amdgcn_update_dpp(0, __builtin_bit_cast(int, x[S % RQ]), ctrl, 0xf, 0xf, false));
#pragma unroll
            for (int k = 0; k < NV4; ++k) { x[4 * k] += aq[S % 3][k][0] * xs; x[4 * k + 1] += aq[S % 3][k][1] * xs; x[4 * k + 2] += aq[S % 3][k][2] * xs; x[4 * k + 3] += aq[S % 3][k][3] * xs;
                asm volatile("" : "+v"(x[4 * k]), "+v"(x[4 * k + 1]), "+v"(x[4 * k + 2]), "+v"(x[4 * k + 3])); }
            asm volatile("" ::: "memory");
            SubstQ<S + 1, L>::run(x, aq, ap);
        }
    }
};
struct RawRegs { u32x4 r, k, v, w, a; };
__device__ __forceinline__ void rwkv_load_raw(Frame& F, int u, int tid, RawRegs& raw) {
    const int c = u >> 4, h = u & 15; int r0, pos0; chunk_geom(c, r0, pos0); const int L = c < 256 ? 64 : 32; int t = tid >> 3; t = t < L ? t : 0;
    const bf16_t* RKV = (const bf16_t*)(F.ws + WS_RKV); const bf16_t* WLOG = (const bf16_t*)(F.ws + WS_WLOG); const bf16_t* AA = (const bf16_t*)(F.ws + WS_XN);
    const size_t row = (size_t)(r0 + t); const int col = h * 64 + 8 * (tid & 7);
    raw.r = *(const u32x4*)(RKV + row * 3072 + col); raw.k = *(const u32x4*)(RKV + row * 3072 + 1024 + col); raw.v = *(const u32x4*)(RKV + row * 3072 + 2048 + col);
    raw.w = *(const u32x4*)(WLOG + row * D + col); raw.a = *(const u32x4*)(AA + row * D + col);
}
template <int L, bool DRY = false> __device__ __forceinline__ void rwkv_local_unit(Frame& F, int layer, int c, int h, RawRegs& raw, int unext) {
    const int tid = otid(); const int lane = tid & 63, fr = lane & 15, fq = lane >> 4, w = F.wave;
    constexpr int NIT = L / 16; constexpr bool SAMPLE = (L == 32);
    const int m = layer >> 1; int r0, pos0; chunk_geom(c, r0, pos0);
    bf16_t* RKV = (bf16_t*)(F.ws + WS_RKV); const bf16_t* WLOG = (const bf16_t*)(F.ws + WS_WLOG); const bf16_t* AA = (const bf16_t*)(F.ws + WS_XN);
    LAS bf16_t* AT = (LAS bf16_t*)(F.lds + RL_AT); LAS bf16_t* RT = (LAS bf16_t*)(F.lds + RL_RT); LAS bf16_t* BT = (LAS bf16_t*)(F.lds + RL_BT); LAS bf16_t* KT = (LAS bf16_t*)(F.lds + RL_KT);
    LAS bf16_t* BHT = (LAS bf16_t*)(F.lds + RL_BHT); LAS bf16_t* KHT = (LAS bf16_t*)(F.lds + RL_KHT); LAS bf16_t* VT = (LAS bf16_t*)(F.lds + RL_VT);
    LAS float* AAB = (LAS float*)(F.lds + RL_AAB); LAS bf16_t* AAK = (LAS bf16_t*)(F.lds + RL_AAK); LAS bf16_t* ARB = (LAS bf16_t*)(F.lds + RL_ARB); LAS bf16_t* ARK = (LAS bf16_t*)(F.lds + RL_ARK);
    LAS bf16_t* U0T = (LAS bf16_t*)(F.lds + RL_U0T); LAS float* GMID = (LAS float*)(F.lds + RL_VEC); LAS float* GLV = GMID + 64; LAS float* EGM = GMID + 128; LAS float* PSUM = (LAS float*)(F.lds + RL_PSUM);
    LAS float* G = (LAS float*)(F.lds + RL_G); LAS float* WW = (LAS float*)(F.lds + RL_WW); LAS bf16_t* APT = (LAS bf16_t*)(F.lds + RL_APT);
    __syncthreads();
    const int t = tid >> 3, c8 = tid & 7; const bool act = t < L;
    float rr[8], kkv[8], bb[8], kh[8], vv[8];
    if (act) { const size_t row = (size_t)(r0 + t); const int col = h * 64 + 8 * c8;
        const u32x4 r4 = raw.r, k4 = raw.k, v4 = raw.v, w4 = raw.w, a4 = raw.a;
        const float* kkp = F.in[I_RKK] + m * D + col; const float* kap = F.in[I_RKA] + m * D + col; const float* rkp = F.in[I_RRK] + m * D + col;
        float ss = 0.f, bon = 0.f;
#pragma unroll
        for (int e = 0; e < 8; ++e) { const float kx = (e & 1) ? bfhi(k4[e >> 1]) : bflo(k4[e >> 1]), al = (e & 1) ? bfhi(a4[e >> 1]) : bflo(a4[e >> 1]);
            rr[e] = (e & 1) ? bfhi(r4[e >> 1]) : bflo(r4[e >> 1]); vv[e] = (e & 1) ? bfhi(v4[e >> 1]) : bflo(v4[e >> 1]);
            kkv[e] = kx * kkp[e]; ss += kkv[e] * kkv[e]; kh[e] = kx * (1.f + (al - 1.f) * kap[e]); bb[e] = al; bon += rr[e] * kh[e] * rkp[e];
            G[t * 64 + 8 * c8 + e] = (e & 1) ? bfhi(w4[e >> 1]) : bflo(w4[e >> 1]); }
        ss += __shfl_xor(ss, 1); ss += __shfl_xor(ss, 2); ss += __shfl_xor(ss, 4); bon += __shfl_xor(bon, 1); bon += __shfl_xor(bon, 2); bon += __shfl_xor(bon, 4);
        const float inv = 1.f / fmaxf(sqrtf(ss), 1e-12f);
#pragma unroll
        for (int e = 0; e < 8; ++e) { kkv[e] *= inv; bb[e] *= kkv[e]; }
        if (c8 == 0) ((float*)(F.ws + WS_BON))[row * 16 + h] = bon; }
    if (unext >= 0) rwkv_load_raw(F, unext, tid, raw);
    __syncthreads();
    { constexpr int TE = L / 8; const int j = tid & 63, e8 = tid >> 6; float cs[TE]; float run = 0.f;
#pragma unroll
      for (int q = 0; q < TE; ++q) { run += G[(e8 * TE + q) * 64 + j]; cs[q] = run; }
      PSUM[e8 * 64 + j] = run;
      __syncthreads();
      float off = 0.f, gm = 0.f, gl = 0.f;
#pragma unroll
      for (int q = 0; q < 8; ++q) { const float p = PSUM[q * 64 + j]; if (q < e8) off += p; if (q < 4) gm += p; gl += p; }
#pragma unroll
      for (int q = 0; q < TE; ++q) G[(e8 * TE + q) * 64 + j] = off + cs[q];
      if (e8 == 0) { GMID[j] = gm; GLV[j] = gl; EGM[j] = __expf(gm); if (!SAMPLE) ((float*)(F.ws + WS_REC + ((size_t)h * 256 + c) * REC_B + 16384))[j] = __expf(gl); } }
    __syncthreads();
    if (act) { float fa[8], fr_[8], fb[8], fk[8];
#pragma unroll
        for (int e = 0; e < 8; ++e) { const int j = 8 * c8 + e; const float g = G[t * 64 + j], gp = (t > 0) ? G[(t - 1) * 64 + j] : 0.f, gm = GMID[j], gl = GLV[j];
            const float ed = __expf(gm - g), eu = __expf(g - gm), el = __expf(gl - g);
            fa[e] = -kkv[e] * __expf(gp - gm); fr_[e] = rr[e] * eu; fb[e] = bb[e] * ed; fk[e] = kh[e] * ed;
            if constexpr (!(DRY && (LOCAL_SKIP & 4))) { BHT[j * 72 + t] = (bf16_t)f2bf(bb[e] * el); KHT[j * 72 + t] = (bf16_t)f2bf(kh[e] * el); VT[j * 72 + t] = (bf16_t)f2bf(vv[e]); } }
        u32x4 p;
        p.x = pk2(fa[0], fa[1]); p.y = pk2(fa[2], fa[3]); p.z = pk2(fa[4], fa[5]); p.w = pk2(fa[6], fa[7]); *(LAS u32x4*)(AT + t * 72 + 8 * c8) = p;
        p.x = pk2(fr_[0], fr_[1]); p.y = pk2(fr_[2], fr_[3]); p.z = pk2(fr_[4], fr_[5]); p.w = pk2(fr_[6], fr_[7]); *(LAS u32x4*)(RT + t * 72 + 8 * c8) = p;
        p.x = pk2(fb[0], fb[1]); p.y = pk2(fb[2], fb[3]); p.z = pk2(fb[4], fb[5]); p.w = pk2(fb[6], fb[7]); *(LAS u32x4*)(BT + t * 72 + 8 * c8) = p;
        p.x = pk2(fk[0], fk[1]); p.y = pk2(fk[2], fk[3]); p.z = pk2(fk[4], fk[5]); p.w = pk2(fk[6], fk[7]); *(LAS u32x4*)(KT + t * 72 + 8 * c8) = p; }
    __syncthreads();
    if constexpr (DRY && (LOCAL_SKIP & 2)) return;
    { constexpr int TPW = (NIT * NIT >= 8) ? NIT * NIT / 8 : 1;
      if (w * TPW < NIT * NIT) { const int it = (w * TPW) / NIT, jt0 = (w * TPW) % NIT;
          f32x4 ab[1][TPW], ak[1][TPW], rb[1][TPW], rk[1][TPW];
#pragma unroll
          for (int q = 0; q < TPW; ++q) { ab[0][q] = (f32x4){0.f, 0.f, 0.f, 0.f}; ak[0][q] = ab[0][q]; rb[0][q] = ab[0][q]; rk[0][q] = ab[0][q]; }
          wave_mm_nt<1, TPW>(ab, AT + it * 16 * 72, 72, BT + jt0 * 16 * 72, 72, 64, fr, fq); wave_mm_nt<1, TPW>(ak, AT + it * 16 * 72, 72, KT + jt0 * 16 * 72, 72, 64, fr, fq);
          wave_mm_nt<1, TPW>(rb, RT + it * 16 * 72, 72, BT + jt0 * 16 * 72, 72, 64, fr, fq); wave_mm_nt<1, TPW>(rk, RT + it * 16 * 72, 72, KT + jt0 * 16 * 72, 72, 64, fr, fq);
          const int tt = it * 16 + fr;
#pragma unroll
          for (int q = 0; q < TPW; ++q) { const int s0 = (jt0 + q) * 16 + 4 * fq; f32x4 fab; float fak[4], frb[4], frk[4];
#pragma unroll
              for (int r = 0; r < 4; ++r) { const int sx = s0 + r; fab[r] = (sx < tt) ? ab[0][q][r] : 0.f; fak[r] = (sx < tt) ? ak[0][q][r] : 0.f; frb[r] = (sx <= tt) ? rb[0][q][r] : 0.f; frk[r] = (sx <= tt) ? rk[0][q][r] : 0.f; }
#pragma unroll
              for (int r = 0; r < 4; ++r) AAB[(s0 + r) * 68 + tt] = fab[r];
              u32x2 p; p.x = pk2(fak[0], fak[1]); p.y = pk2(fak[2], fak[3]); *(LAS u32x2*)(AAK + tt * 72 + s0) = p;
              p.x = pk2(frb[0], frb[1]); p.y = pk2(frb[2], frb[3]); *(LAS u32x2*)(ARB + tt * 72 + s0) = p;
              p.x = pk2(frk[0], frk[1]); p.y = pk2(frk[2], frk[3]); *(LAS u32x2*)(ARK + tt * 72 + s0) = p; } } }
    __syncthreads();
    { constexpr int TP3 = NIT / 2; const int it = (w * TP3) / 4, nt0 = (w * TP3) % 4;
      f32x4 ww[1][TP3];
#pragma unroll
      for (int q = 0; q < TP3; ++q) ww[0][q] = (f32x4){0.f, 0.f, 0.f, 0.f};
      wave_mm_nt<1, TP3>(ww, AAK + it * 16 * 72, 72, VT + nt0 * 16 * 72, 72, L, fr, fq);
#pragma unroll
      for (int q = 0; q < TP3; ++q) *(LAS f32x4*)(WW + (it * 16 + fr) * 68 + (nt0 + q) * 16 + 4 * fq) = ww[0][q]; }
    __syncthreads();
    { constexpr int RQ = L / 4, NV4 = RQ / 4; const int col = tid >> 2, qd = tid & 3, cidx = col & 63; const bool isA = col < 64; const float eg = EGM[cidx];
      float x[RQ]; f32x4 aq[3][NV4];
#pragma unroll
      for (int i = 0; i < RQ; ++i) { const int tt = qd * RQ + i; x[i] = isA ? bf2f(AT[tt * 72 + cidx]) * eg : WW[tt * 68 + cidx]; }
      const LAS float* ap = AAB + qd * RQ;
#pragma unroll
      for (int k = 0; k < NV4; ++k) { aq[0][k] = *(const LAS f32x4*)(ap + 4 * k); aq[1][k] = *(const LAS f32x4*)(ap + 68 + 4 * k); }
      if constexpr (!(DRY && (LOCAL_SKIP & 1))) SubstQ<0, L>::run(x, aq, ap);
      LAS bf16_t* dst = (isA ? APT : U0T) + cidx * 72 + qd * RQ;
#pragma unroll
      for (int t8 = 0; t8 < RQ; t8 += 8) { u32x4 p; p.x = pk2(x[t8], x[t8 + 1]); p.y = pk2(x[t8 + 2], x[t8 + 3]); p.z = pk2(x[t8 + 4], x[t8 + 5]); p.w = pk2(x[t8 + 6], x[t8 + 7]); *(LAS u32x4*)(dst + t8) = p; } }
    __syncthreads();
    { const int mt = w >> 1, nt0 = (w & 1) * 2;
      f32x4 pp[1][2], qt[1][2];
#pragma unroll
      for (int q = 0; q < 2; ++q) { pp[0][q] = (f32x4){0.f, 0.f, 0.f, 0.f}; qt[0][q] = pp[0][q]; }
      wave_mm_nt<1, 2>(pp, BHT + mt * 16 * 72, 72, APT + nt0 * 16 * 72, 72, L, fr, fq);
      wave_mm_nt<1, 2>(qt, U0T + mt * 16 * 72, 72, BHT + nt0 * 16 * 72, 72, L, fr, fq); wave_mm_nt<1, 2>(qt, VT + mt * 16 * 72, 72, KHT + nt0 * 16 * 72, 72, L, fr, fq);
      constexpr int TP5 = NIT / 2; const int it = (w * TP5) / 4, rn0 = (w * TP5) % 4;
      f32x4 rp[1][TP5], y0[1][TP5];
#pragma unroll
      for (int q = 0; q < TP5; ++q) { const int j = (rn0 + q) * 16 + 4 * fq; const u32x2 rw = *(const LAS u32x2*)(RT + (it * 16 + fr) * 72 + j); const f32x4 e4 = *(const LAS f32x4*)(EGM + j);
          rp[0][q] = (f32x4){bflo(rw.x) * e4[0], bfhi(rw.x) * e4[1], bflo(rw.y) * e4[2], bfhi(rw.y) * e4[3]}; y0[0][q] = (f32x4){0.f, 0.f, 0.f, 0.f}; }
      wave_mm_nt<1, TP5>(rp, ARB + it * 16 * 72, 72, APT + rn0 * 16 * 72, 72, L, fr, fq);
      wave_mm_nt<1, TP5>(y0, ARB + it * 16 * 72, 72, U0T + rn0 * 16 * 72, 72, L, fr, fq); wave_mm_nt<1, TP5>(y0, ARK + it * 16 * 72, 72, VT + rn0 * 16 * 72, 72, L, fr, fq);
      if constexpr (!SAMPLE) {
          bf16_t* PP = (bf16_t*)(F.ws + WS_REC + ((size_t)h * 256 + c) * REC_B); bf16_t* QQ = PP + 4096;
#pragma unroll
          for (int q = 0; q < 2; ++q) { const int n0 = (nt0 + q) * 16 + 4 * fq; u32x2 p; p.x = pk2(pp[0][q][0], pp[0][q][1]); p.y = pk2(pp[0][q][2], pp[0][q][3]);
              *(u32x2*)(PP + (mt * 16 + fr) * 64 + pperm(n0)) = p;
              p.x = pk2(qt[0][q][0], qt[0][q][1]); p.y = pk2(qt[0][q][2], qt[0][q][3]); *(u32x2*)(QQ + (mt * 16 + fr) * 64 + n0) = p; }
#pragma unroll
          for (int q = 0; q < TP5; ++q) { const size_t row = (size_t)(r0 + it * 16 + fr); const int n0 = (rn0 + q) * 16 + 4 * fq; u32x2 p;
              p.x = pk2(rp[0][q][0], rp[0][q][1]); p.y = pk2(rp[0][q][2], rp[0][q][3]); if constexpr (DRY) asm volatile("" :: "v"(p.x), "v"(p.y)); else *(u32x2*)(RKV + row * 3072 + 1024 + h * 64 + n0) = p;
              p.x = pk2(y0[0][q][0], y0[0][q][1]); p.y = pk2(y0[0][q][2], y0[0][q][3]); if constexpr (DRY) asm volatile("" :: "v"(p.x), "v"(p.y)); else *(u32x2*)(RKV + row * 3072 + h * 64 + n0) = p; }
      } else {
          __syncthreads();
          LAS bf16_t* PL = (LAS bf16_t*)(F.lds + RL_PL); LAS bf16_t* RLs = (LAS bf16_t*)(F.lds + RL_RL); LAS float* Y0L = (LAS float*)(F.lds + RL_Y0L); LAS float* QTL = (LAS float*)(F.lds + RL_QTL); LAS bf16_t* Sl = (LAS bf16_t*)(F.lds + RL_S);
#pragma unroll
          for (int q = 0; q < 2; ++q) { const int n0 = (nt0 + q) * 16 + 4 * fq; u32x2 p; p.x = pk2(pp[0][q][0], pp[0][q][1]); p.y = pk2(pp[0][q][2], pp[0][q][3]);
              *(LAS u32x2*)(PL + (mt * 16 + fr) * 72 + n0) = p; *(LAS f32x4*)(QTL + (mt * 16 + fr) * 68 + n0) = qt[0][q]; }
#pragma unroll
          for (int q = 0; q < TP5; ++q) { const int n0 = (rn0 + q) * 16 + 4 * fq; u32x2 p; p.x = pk2(rp[0][q][0], rp[0][q][1]); p.y = pk2(rp[0][q][2], rp[0][q][3]);
              *(LAS u32x2*)(RLs + (it * 16 + fr) * 72 + n0) = p; *(LAS f32x4*)(Y0L + (it * 16 + fr) * 68 + n0) = y0[0][q]; }
          const int sb = c - 256; const float* sin_ = F.in[I_SWKV] + (((size_t)m * 32 + sb) * 16 + h) * 4096; float* sout = F.out + O_WKVS + (((size_t)m * 32 + sb) * 16 + h) * 4096;
          for (int it2 = tid; it2 < 64 * 16; it2 += NT) { const int i = it2 >> 4, j4 = (it2 & 15) * 4; const f32x4 sv = *(const f32x4*)(sin_ + i * 64 + j4); u32x2 p; p.x = pk2(sv[0], sv[1]); p.y = pk2(sv[2], sv[3]); *(LAS u32x2*)(Sl + i * 72 + j4) = p; }
          __syncthreads();
          if (w < 2) { f32x4 y[1][4];
#pragma unroll
              for (int q = 0; q < 4; ++q) y[0][q] = *(const LAS f32x4*)(Y0L + (w * 16 + fr) * 68 + q * 16 + 4 * fq);
              wave_mm_nt<1, 4>(y, RLs + w * 16 * 72, 72, Sl, 72, 64, fr, fq);
              rwkv_out_epilogue<DRY>(F, m, y[0], (size_t)(r0 + w * 16 + fr), h, fq); }
          else if (w < 6) { const int mi = w - 2; f32x4 tl[1][4];
#pragma unroll
              for (int q = 0; q < 4; ++q) { const int j = q * 16 + 4 * fq; const f32x4 sv = *(const f32x4*)(sin_ + (mi * 16 + fr) * 64 + j), gl4 = *(const LAS f32x4*)(GLV + j), qv = *(const LAS f32x4*)(QTL + (mi * 16 + fr) * 68 + j);
                  tl[0][q] = (f32x4){__expf(gl4[0]) * sv[0] + qv[0], __expf(gl4[1]) * sv[1] + qv[1], __expf(gl4[2]) * sv[2] + qv[2], __expf(gl4[3]) * sv[3] + qv[3]}; }
              wave_mm_nt<1, 4>(tl, Sl + mi * 16 * 72, 72, PL, 72, 64, fr, fq);
#pragma unroll
              for (int q = 0; q < 4; ++q) *(f32x4*)(sout + (mi * 16 + fr) * 64 + q * 16 + 4 * fq) = tl[0][q]; }
      }
    }
}

constexpr int SC_GRP = 4, SC_CH = 8192 + 2048 + 256, SC_LCH = 9216 + 2304 + 256, SC_LBUF = SC_GRP * SC_LCH;
template <int SKIP = 0> __device__ __forceinline__ void rwkv_scan_phase(Frame& F, int layer) {
    const int tid = otid(); const int lane = tid & 63, m = layer >> 1; const int b = blockIdx.x;
    if (b >= 64) {
        if constexpr (SKIP == 0) { const int nb = (int)F.G - 64; RawRegs raw; int u = 256 * 16 + (b - 64); if (u < NCHUNK * 16) rwkv_load_raw(F, u, tid, raw);
            for (; u < NCHUNK * 16; u += nb) { const int un = (u + nb < NCHUNK * 16) ? u + nb : -1; rwkv_local_unit<32>(F, layer, u >> 4, u & 15, raw, un); } }
        return; }
    const int h = 2 * (b & 7) + (b >> 5), sl = (b >> 3) & 3;
    const unsigned char* REC = F.ws + WS_REC;
    constexpr int NG = 256 / SC_GRP, DEPTH = 4;
    static_assert(NG % DEPTH == 0, "scan groups vs prefetch depth");
    if (F.wave != 0) {
        constexpr int NV = SC_GRP * SC_CH / 16, NLT = NT - 64, NPT = (NV + NLT - 1) / NLT;
        struct RegSet { u32x4 v[NPT]; };
        RegSet sets[DEPTH];
        unsigned poff[NPT], pdst[NPT];
#pragma unroll
        for (int q = 0; q < NPT; ++q) { int v = (tid - 64) + q * NLT; v = v < NV ? v : NV - 1; const int cc = v / (SC_CH / 16), o = (v % (SC_CH / 16)) * 16;
            poff[q] = (unsigned)(cc * REC_B + o + (o >= 10240 ? 6144 : (o >= 8192 ? sl * 2048 : 0)));
            const int lo = (o < 8192) ? (o >> 7) * 144 + (o & 127) : (o < 10240) ? 9216 + ((o - 8192) >> 7) * 144 + ((o - 8192) & 127) : 9216 + 2304 + (o - 10240);
            pdst[q] = (unsigned)(cc * SC_LCH + lo); }
        auto issue = [&](int g, RegSet& st) { const unsigned char* gb = REC + ((size_t)h * 256 + g * SC_GRP) * REC_B;
#pragma unroll
            for (int q = 0; q < NPT; ++q) st.v[q] = *(const u32x4*)(gb + poff[q]); };
        auto commit = [&](int buf, const RegSet& st) {
#pragma unroll
            for (int q = 0; q < NPT; ++q) *(LAS u32x4*)(F.lds + buf * SC_LBUF + pdst[q]) = st.v[q]; };
        if (!(SKIP & 2)) {
#pragma unroll
            for (int d = 0; d < DEPTH; ++d) issue(d, sets[d]);
            commit(0, sets[0]); }
        for (int g0 = 0; g0 < NG; g0 += DEPTH) {
#pragma unroll
            for (int dd = 0; dd < DEPTH; ++dd) { const int g = g0 + dd;
                if (!(SKIP & 2)) { if (g > 0 && g + DEPTH - 1 < NG) issue(g + DEPTH - 1, sets[(dd + DEPTH - 1) % DEPTH]); }
                __syncthreads();
                __syncthreads();
                if (!(SKIP & 2)) { if (g + 1 < NG) commit((g + 1) & 1, sets[(dd + 1) % DEPTH]); } }
        }
    } else {
        const int ci = lane & 15, q4 = lane >> 4, i = 16 * sl + ci;
        f32x4 T[4];
#pragma unroll
        for (int mm = 0; mm < 4; ++mm) T[mm] = (f32x4){0.f, 0.f, 0.f, 0.f};
        bf16_t* TST = (bf16_t*)(F.ws + WS_TST);
        const unsigned pfo = (unsigned)(ci * 144 + q4 * 16);
        for (int g = 0; g < NG; ++g) {
            __syncthreads();
            if (!(SKIP & 1)) {
                const LAS unsigned char* base = F.lds + (g & 1) * SC_LBUF;
                bf16x8 pf[4][2];
#pragma unroll
                for (int mm = 0; mm < 4; ++mm)
#pragma unroll
                    for (int s = 0; s < 2; ++s) pf[mm][s] = *(const LAS bf16x8*)(base + pfo + mm * 2304 + s * 64);
#pragma unroll
                for (int cc = 0; cc < SC_GRP; ++cc) { const int c = g * SC_GRP + cc; const LAS unsigned char* cb = base + cc * SC_LCH;
                    bf16_t* tdst = TST + (((size_t)h * 256 + c) * 64 + i) * 64;
                    f32x4 gv[4]; u32x2 qv[4];
#pragma unroll
                    for (int mm = 0; mm < 4; ++mm) { const int j = 16 * mm + 4 * q4; gv[mm] = *(const LAS f32x4*)(cb + 9216 + 2304 + j * 4); qv[mm] = *(const LAS u32x2*)(cb + 9216 + ci * 144 + j * 2); }
                    bf16x8 pn[4][2];
                    if (cc + 1 < SC_GRP) {
#pragma unroll
                        for (int mm = 0; mm < 4; ++mm)
#pragma unroll
                            for (int s = 0; s < 2; ++s) pn[mm][s] = *(const LAS bf16x8*)(cb + SC_LCH + pfo + mm * 2304 + s * 64); }
                    bf16x8 Tf[2];
#pragma unroll
                    for (int mm = 0; mm < 4; ++mm) { u32x2 p; p.x = pk2(T[mm][0], T[mm][1]); p.y = pk2(T[mm][2], T[mm][3]); *(u32x2*)(tdst + 16 * mm + 4 * q4) = p;
                        Tf[mm >> 1][(mm & 1) * 4 + 0] = (short)(p.x & 0xffffu); Tf[mm >> 1][(mm & 1) * 4 + 1] = (short)(p.x >> 16); Tf[mm >> 1][(mm & 1) * 4 + 2] = (short)(p.y & 0xffffu); Tf[mm >> 1][(mm & 1) * 4 + 3] = (short)(p.y >> 16); }
#pragma unroll
                    for (int mm = 0; mm < 4; ++mm) {
                        f32x4 acc = (f32x4){gv[mm][0] * T[mm][0] + bflo(qv[mm].x), gv[mm][1] * T[mm][1] + bfhi(qv[mm].x), gv[mm][2] * T[mm][2] + bflo(qv[mm].y), gv[mm][3] * T[mm][3] + bfhi(qv[mm].y)};
                        acc = __builtin_amdgcn_mfma_f32_16x16x32_bf16(pf[mm][0], Tf[0], acc, 0, 0, 0); acc = __builtin_amdgcn_mfma_f32_16x16x32_bf16(pf[mm][1], Tf[1], acc, 0, 0, 0);
                        T[mm] = acc; }
                    if (cc + 1 < SC_GRP) {
#pragma unroll
                        for (int mm = 0; mm < 4; ++mm) { pf[mm][0] = pn[mm][0]; pf[mm][1] = pn[mm][1]; } }
                }
            }
            __syncthreads();
        }
        float* outp = F.out + O_WKVP + ((size_t)m * 16 + h) * 4096 + (size_t)i * 64;
#pragma unroll
        for (int mm = 0; mm < 4; ++mm) *(f32x4*)(outp + 16 * mm + 4 * q4) = T[mm];
    }
}

struct OutMain { u32x2 y0[4]; bf16x8 xa[2]; bf16x8 yb[2][4]; };
template <bool DRY = false> __device__ __forceinline__ void rwkv_output_phase(Frame& F, int layer) {
    const int tid = otid(); const int lane = tid & 63, fr = lane & 15, fq = lane >> 4, m = layer >> 1;
    const bf16_t* RKV = (const bf16_t*)(F.ws + WS_RKV); const bf16_t* TST = (const bf16_t*)(F.ws + WS_TST);
    const int gw = F.vcu * NWAVES + F.wave, NGW = F.G * NWAVES;
    auto issue = [&](int u, OutMain& mn, OutSide& sd) { const int it = u & 3, h = (u >> 2) & 15, c = u >> 6;
        const size_t row = (size_t)(64 * c + 16 * it + fr); const bf16_t* ts = TST + ((size_t)h * 256 + c) * 4096;
#pragma unroll
        for (int nt = 0; nt < 4; ++nt) mn.y0[nt] = *(const u32x2*)(RKV + row * 3072 + h * 64 + 16 * nt + 4 * fq);
#pragma unroll
        for (int s = 0; s < 2; ++s) { mn.xa[s] = *(const bf16x8*)(RKV + row * 3072 + 1024 + h * 64 + 32 * s + 8 * fq);
#pragma unroll
            for (int nt = 0; nt < 4; ++nt) mn.yb[s][nt] = *(const bf16x8*)(ts + (16 * nt + fr) * 64 + 32 * s + 8 * fq); }
        rwkv_out_side(F, m, row, h, fq, sd); };
    constexpr int NU = 256 * 16 * 4;
    OutMain mA, mB; OutSide sA, sB;
    int u = gw; if (u < NU) issue(u, mA, sA);
    for (; u < NU; u += 2 * NGW) {
        { int un = u + NGW; un = un < NU ? un : NU - 1; issue(un, mB, sB);
          const int it = u & 3, h = (u >> 2) & 15, c = u >> 6; const size_t row = (size_t)(64 * c + 16 * it + fr); f32x4 y[4];
#pragma unroll
          for (int nt = 0; nt < 4; ++nt) y[nt] = (f32x4){bflo(mA.y0[nt].x), bfhi(mA.y0[nt].x), bflo(mA.y0[nt].y), bfhi(mA.y0[nt].y)};
#pragma unroll
          for (int s = 0; s < 2; ++s)
#pragma unroll
              for (int nt = 0; nt < 4; ++nt) y[nt] = __builtin_amdgcn_mfma_f32_16x16x32_bf16(mA.yb[s][nt], mA.xa[s], y[nt], 0, 0, 0);
          rwkv_out_core<DRY>(F, y, row, h, fq, sA); }
        { const int u1 = u + NGW; if (u1 < NU) { int un = u1 + NGW; un = un < NU ? un : NU - 1; issue(un, mA, sA);
          const int it = u1 & 3, h = (u1 >> 2) & 15, c = u1 >> 6; const size_t row = (size_t)(64 * c + 16 * it + fr); f32x4 y[4];
#pragma unroll
          for (int nt = 0; nt < 4; ++nt) y[nt] = (f32x4){bflo(mB.y0[nt].x), bfhi(mB.y0[nt].x), bflo(mB.y0[nt].y), bfhi(mB.y0[nt].y)};
#pragma unroll
          for (int s = 0; s < 2; ++s)
#pragma unroll
              for (int nt = 0; nt < 4; ++nt) y[nt] = __builtin_amdgcn_mfma_f32_16x16x32_bf16(mB.yb[s][nt], mB.xa[s], y[nt], 0, 0, 0);
          rwkv_out_core<DRY>(F, y, row, h, fq, sB); } }
    }
}

#define GRID_BAR() xcd_barrier(bar)
#ifndef PHASE_MASK
#define PHASE_MASK 0xffffffffu
#endif
#define PH(k) if (PHASE_MASK & (1u << (k)))
#ifndef REP_MASK
#define REP_MASK 0u
#endif
#define REP(k) (((REP_MASK) >> (k)) & 1u)
#ifndef LOCAL_SKIP
#define LOCAL_SKIP 0
#endif
#ifndef EXTRA_BARS
#define EXTRA_BARS 0
#endif
template <int layer> __device__ __forceinline__ void layer_body(Frame& F, const XcdBarrier& bar) {
    unsigned char* ws = F.ws; unsigned char* ar = ws + WS_ARENA;
    bf16_t* XN = (bf16_t*)(ws + WS_XN);
    const float* MOD = (const float*)(ws + WS_MOD);
    constexpr int m = layer >> 1; const float* modl = MOD + (size_t)layer * NSEQ * 6144;
    PH(1) for (int rep = 0; rep <= (int)REP(1); ++rep) if (layer > 0) convert_layer_weights(F, layer);
    if constexpr ((layer & 1) == 0) {
        PH(2) for (int rep = 0; rep <= (int)REP(2); ++rep) { if constexpr (layer == 0) norm_pass<0, 0, true, true>(F, layer); else norm_pass<0, 8>(F, layer, layer - 1, 5120); }
        GRID_BAR();
        PH(3) { using GC = pg8::Geo<D, D, D, 30, 0, 1 << 20, 0>; pg8::Gemm<GC> g{XN, (const bf16_t*)(ar + AR_WIN), nullptr}; pg8::StaticOrder S; S.init(M, ABIN, F.G, (int)blockIdx.x);
          pg8::EpiBf16<0> E{(bf16_t*)(ws + WS_Z), ABIN};
          pg8::gemm_phase<pg8::EpiBf16<0>, pg8::StaticOrder, GC, true, true>(F.lds, g, S, E);
          if (REP(3)) { pg8::EpiNull<true> EN; pg8::gemm_phase<pg8::EpiNull<true>, pg8::StaticOrder, GC, true, true>(F.lds, g, S, EN); } }
        GRID_BAR();
        PH(4) for (int rep = 0; rep <= (int)REP(4); ++rep) for (int u = F.vcu; u < NCHUNK * 8; u += F.G) { const int c = u >> 3, hh = (u + u / F.G) & 7;
            if (c < 256) { if (hh < 4) ab_summary_unit<64, false>(F, layer, c, hh); else ab_summary_unit<64, true>(F, layer, c, hh - 4); }
            else { if (hh < 4) ab_summary_unit<32, false>(F, layer, c, hh); else ab_summary_unit<32, true>(F, layer, c, hh - 4); } }
        GRID_BAR();
        PH(5) { if (REP(5)) ab_scan<true>(F, layer); ab_scan<false>(F, layer); if (layer == 0 && F.vcu >= 96) mod_phase(F, 1, 4, F.vcu - 96, F.G - 96); }
        GRID_BAR();
        PH(6) for (int rep = 0; rep <= (int)REP(6); ++rep) for (int u = F.vcu; u < NCHUNK * 8; u += F.G) { const int c = u >> 3, hh = (u + u / F.G) & 7;
            if (c < 256) { if (hh < 4) ab_output_unit<64, false>(F, layer, c, hh); else ab_output_unit<64, true>(F, layer, c, hh - 4); }
            else { if (hh < 4) ab_output_unit<32, false>(F, layer, c, hh); else ab_output_unit<32, true>(F, layer, c, hh - 4); } }
        GRID_BAR();
        PH(7) { using GC = pg8::Geo<D, D, D, 30, 0, 1 << 20, 0>; pg8::Gemm<GC> g{XN, (const bf16_t*)(ar + AR_WOUT), nullptr}; pg8::StaticOrder S; S.init(MP, D, F.G, (int)blockIdx.x);
          pg8::EpiRes E{F.out, modl, 2048, (layer == 0) ? F.in[I_XP] : F.out};
          pg8::gemm_phase<pg8::EpiRes, pg8::StaticOrder, GC, true, true>(F.lds, g, S, E);
          if (REP(7)) { pg8::EpiNull<false> EN; pg8::gemm_phase<pg8::EpiNull<false>, pg8::StaticOrder, GC, true, true>(F.lds, g, S, EN); }
          using GC2 = pg8::Geo<D, D, 256, 30, 0, 1 << 20, 0, true>; pg8::Gemm<GC2> g2{XN, (const bf16_t*)(ar + AR_WOUT), nullptr}; pg8::SplitOrder S2{F.vcu, 4};
          pg8::EpiPartial E2{(float*)(ws + WS_PART), 4};
          pg8::gemm_phase<pg8::EpiPartial, pg8::SplitOrder, GC2, true, true>(F.lds, g2, S2, E2); }
        GRID_BAR();
    } else {
        PH(8) for (int rep = 0; rep <= (int)REP(8); ++rep) norm_pass<1, 8>(F, layer, layer - 1, 5120);
        GRID_BAR();
        PH(9) { using GCr = pg8::Geo<D, 2048, D, 2, M * D, 1 << 20, 0>; pg8::Gemm<GCr> gr{(const bf16_t*)(ws + WS_XMIX), (const bf16_t*)(ar + AR_WC1), nullptr}; pg8::StaticOrder Sr; Sr.init(M, 3072, F.G, (int)blockIdx.x);
          pg8::EpiRkv E{(bf16_t*)(ws + WS_RKV), (bf16_t*)(ws + WS_LO), (m == 0) ? (bf16_t*)(ws + WS_VFIRST) : nullptr};
          pg8::gemm_phase<pg8::EpiRkv, pg8::StaticOrder, GCr, true, true>(F.lds, gr, Sr, E);
          if (REP(9)) { pg8::EpiNull<true> EN; pg8::gemm_phase<pg8::EpiNull<true>, pg8::StaticOrder, GCr, true, true>(F.lds, gr, Sr, EN); }
          using GC = pg8::Geo<D, 2048, 2048, 30, 0, 16, -4096>; pg8::Gemm<GC> g{XN, (const bf16_t*)(ar + AR_WC1), (const bf16_t*)(ws + WS_PREVS)}; pg8::LoraOrder Sl{(int)blockIdx.x};
          pg8::gemm_phase<pg8::EpiRkv, pg8::LoraOrder, GC, true, true>(F.lds, g, Sl, E); }
        GRID_BAR();
        PH(10) { using GC = pg8::Geo<D, 256, 256, 2, 256, 1 << 20, 0>; pg8::Gemm<GC> g{(const bf16_t*)(ws + WS_LO), (const bf16_t*)(ar + AR_WC2), nullptr}; pg8::StaticOrder S; S.init(M, 4096, F.G, (int)blockIdx.x);
          pg8::EpiLora2 E{(bf16_t*)(ws + WS_WLOG), XN, (bf16_t*)(ws + WS_G), (bf16_t*)(ws + WS_RKV), (m == 1) ? (const bf16_t*)(ws + WS_VFIRST) : nullptr,
                          F.in[I_RW0] + m * D, F.in[I_RA0] + m * D, F.in[I_RV0]};
          pg8::gemm_phase<pg8::EpiLora2, pg8::StaticOrder, GC, true, true>(F.lds, g, S, E);
          if (REP(10)) { pg8::EpiNull<false> EN; pg8::gemm_phase<pg8::EpiNull<false>, pg8::StaticOrder, GC, true, true>(F.lds, g, S, EN); } }
        GRID_BAR();
        PH(11) { RawRegs raw; const int tid0 = otid(); int u = F.vcu; if (u < 256 * 16) rwkv_load_raw(F, u, tid0, raw);
          for (; u < 256 * 16; u += F.G) { const int c = u >> 4, hh = u & 15, un = (u + F.G < 256 * 16) ? u + F.G : -1;
              rwkv_local_unit<64>(F, layer, c, hh, raw, un); } }
        GRID_BAR();
        PH(17) { if (REP(17)) rwkv_scan_phase<LOCAL_SKIP>(F, layer); rwkv_scan_phase<0>(F, layer); }
        GRID_BAR();
        PH(18) { if (REP(18)) rwkv_output_phase<true>(F, layer); rwkv_output_phase<false>(F, layer); }
        GRID_BAR();
        PH(12) { using GC = pg8::Geo<3072, D, D, 30, 0, 1 << 20, 0>; pg8::Gemm<GC> g{(const bf16_t*)(ws + WS_RKV), (const bf16_t*)(ar + AR_WO), nullptr}; pg8::StaticOrder S; S.init(MP, D, F.G, (int)blockIdx.x);
          pg8::EpiRes E{F.out, modl, 2048, F.out};
          pg8::gemm_phase<pg8::EpiRes, pg8::StaticOrder, GC, true, true>(F.lds, g, S, E);
          if (REP(12)) { pg8::EpiNull<false> EN; pg8::gemm_phase<pg8::EpiNull<false>, pg8::StaticOrder, GC, true, true>(F.lds, g, S, EN); }
          using GC2 = pg8::Geo<3072, D, 256, 30, 0, 1 << 20, 0, true>; pg8::Gemm<GC2> g2{(const bf16_t*)(ws + WS_RKV), (const bf16_t*)(ar + AR_WO), nullptr}; pg8::SplitOrder S2{F.vcu, 4};
          pg8::EpiPartial E2{(float*)(ws + WS_PART), 4};
          pg8::gemm_phase<pg8::EpiPartial, pg8::SplitOrder, GC2, true, true>(F.lds, g2, S2, E2); }
        GRID_BAR();
    }
    PH(13) for (int rep = 0; rep <= (int)REP(13); ++rep) norm_pass<2, 4, false, (layer == 0)>(F, layer, layer, 2048);
    GRID_BAR();
    PH(14) { using GC = pg8::Geo<D, D, D, 30, 0, 1 << 20, 0>; pg8::Gemm<GC> g{XN, (const bf16_t*)(ar + AR_W1), nullptr}; pg8::StaticOrder S; S.init(M, DFF, F.G, (int)blockIdx.x);
      pg8::EpiBf16<1> E{(bf16_t*)(ws + WS_H), DFF};
      pg8::gemm_phase<pg8::EpiBf16<1>, pg8::StaticOrder, GC, true, true>(F.lds, g, S, E);
          if (REP(14)) { pg8::EpiNull<true> EN; pg8::gemm_phase<pg8::EpiNull<true>, pg8::StaticOrder, GC, true, true>(F.lds, g, S, EN); } }
    GRID_BAR();
    PH(15) { using GC = pg8::Geo<DFF, DFF, DFF, 30, 0, 1 << 20, 0>; pg8::Gemm<GC> g{(const bf16_t*)(ws + WS_H), (const bf16_t*)(ar + AR_W2), nullptr}; pg8::StaticOrder S; S.init(MP, D, F.G, (int)blockIdx.x);
      pg8::EpiRes E{F.out, modl, 5120, F.out};
      for (int xb = 0; xb < EXTRA_BARS; ++xb) GRID_BAR();
      pg8::gemm_phase<pg8::EpiRes, pg8::StaticOrder, GC, true, true>(F.lds, g, S, E);
      if (REP(15)) { pg8::EpiNull<false> EN; pg8::gemm_phase<pg8::EpiNull<false>, pg8::StaticOrder, GC, true, true>(F.lds, g, S, EN); }
      using GC2 = pg8::Geo<DFF, DFF, 512, 30, 0, 1 << 20, 0, true>; pg8::Gemm<GC2> g2{(const bf16_t*)(ws + WS_H), (const bf16_t*)(ar + AR_W2), nullptr}; pg8::SplitOrder S2{F.vcu, 8};
      pg8::EpiPartial E2{(float*)(ws + WS_PART), 8};
      pg8::gemm_phase<pg8::EpiPartial, pg8::SplitOrder, GC2, true, true>(F.lds, g2, S2, E2); }
    GRID_BAR();
}

__global__ void __launch_bounds__(NT, 2) fwd_kernel(Args args) {
    extern __shared__ __attribute__((aligned(16))) unsigned char lds[];
    Frame F;
    F.lds = (LAS unsigned char*)lds; F.MISC = (volatile LAS unsigned*)(F.lds + MISC_OFF);
    F.wave = __builtin_amdgcn_readfirstlane(threadIdx.x >> 6);
    F.G = gridDim.x; { const int bx = blockIdx.x; F.vcu = (F.G % 8 == 0) ? (bx % 8) * (F.G / 8) + bx / 8 : bx; }
    F.in = args.in; F.out = args.out; F.ws = args.ws;
    for (int u = threadIdx.x; u < (LDS_BYTES - LDSCTL_OFF) / 4; u += NT) ((LAS unsigned*)(F.lds + LDSCTL_OFF))[u] = 0u;
    __syncthreads();
    XcdBarrier bar = xcd_barrier_post((unsigned*)(F.ws + WS_CTL) + CW_BAR, F.MISC + 8);
    PH(0) prologue(F);
    GRID_BAR();
    PH(0) mod_phase(F, 0, 1, F.vcu, F.G);
    GRID_BAR();
    layer_body<0>(F, bar); layer_body<1>(F, bar); layer_body<2>(F, bar); layer_body<3>(F, bar);
    PH(16) norm_pass<3, 8>(F, 0, 3, 5120);
}

extern "C" void kernel_launch(void* const* d_in, const int* in_sizes, int n_in, void* d_out, int out_size, void* d_ws, size_t ws_size, hipStream_t stream) {
    static int grid = 0;
    if (grid == 0) {
        if (n_in != 38 || out_size != 28706816 || ws_size < WS_END) { fprintf(stderr, "kernel_launch: unexpected problem (n_in %d, out %d, ws %zu; need ws >= %zu)\n", n_in, out_size, ws_size, (size_t)WS_END); grid = -1; return; }
        int dev = 0, cus = 0, per_cu = 0;
        if (hipGetDevice(&dev) != hipSuccess || hipDeviceGetAttribute(&cus, hipDeviceAttributeMultiprocessorCount, dev) != hipSuccess) { grid = -1; return; }
        if (hipFuncSetAttribute((const void*)fwd_kernel, hipFuncAttributeMaxDynamicSharedMemorySize, LDS_BYTES) != hipSuccess) { fprintf(stderr, "kernel_launch: hipFuncSetAttribute failed\n"); grid = -1; return; }
        if (hipOccupancyMaxActiveBlocksPerMultiprocessor(&per_cu, (const void*)fwd_kernel, NT, LDS_BYTES) != hipSuccess || per_cu < 1) { fprintf(stderr, "kernel_launch: occupancy query says %d\n", per_cu); per_cu = 1; }
        (void)hipGetLastError();
        grid = cus;
    }
    if (grid < 0) return;
    (void)hipMemsetAsync((char*)d_ws + WS_CTL, 0, ZERO_BYTES, stream);
    Args a{};
    for (int i = 0; i < 38; ++i) a.in[i] = (const float*)d_in[i];
    a.out = (float*)d_out; a.ws = (unsigned char*)d_ws;
    void* kargs[] = {&a};
    hipError_t e = hipLaunchCooperativeKernel((const void*)fwd_kernel, dim3(grid), dim3(NT), kargs, LDS_BYTES, stream);
    if (e != hipSuccess) fprintf(stderr, "kernel_launch: cooperative launch failed: %s (grid %d)\n", hipGetErrorString(e), grid);
}
```

```cpp
#include <hip/hip_runtime.h>
#include <cstdio>
#include <cstdint>

#define LAS __attribute__((address_space(3)))
#define GAS __attribute__((address_space(1)))
typedef unsigned short bf16_t;
typedef short bf16x8 __attribute__((ext_vector_type(8)));
typedef float f32x4 __attribute__((ext_vector_type(4)));
typedef float f32x2 __attribute__((ext_vector_type(2)));
typedef unsigned u32x4 __attribute__((ext_vector_type(4)));
typedef unsigned u32x2 __attribute__((ext_vector_type(2)));

#ifndef LOCAL_SKIP
#define LOCAL_SKIP 0
#endif
constexpr int D = 1024, MP = 16384, MS = 1024, M = MP + MS, NSEQ = 33, DFF = 4096, ABIN = 3584;
constexpr int NCHUNK = 288;
constexpr int SLOT_E = 4 * 8192 + 4 * 16384;
constexpr float NORM_EPS = 1e-6f, RW_LN_EPS = 64e-5f;

constexpr size_t MiB = 1u << 20;
constexpr size_t WS_CTL = 0, WS_MOD = 1 * MiB, ZERO_BYTES = 65536;
constexpr size_t WS_ROPE = 5 * MiB;
constexpr size_t WS_ARENA = 10 * MiB;
constexpr size_t AR_W1 = 0, AR_W2 = 8 * MiB, AR_WIN = 16 * MiB, AR_WOUT = 23 * MiB, AR_WC1 = 16 * MiB, AR_WC2 = 32 * MiB, AR_WO = 34 * MiB;
constexpr size_t WS_VFIRST = 46 * MiB;
constexpr size_t WS_XN0 = 80 * MiB, WS_XN = WS_XN0 + 2048;
constexpr size_t WS_PREVS = 115 * MiB;
constexpr size_t WS_R1 = 118 * MiB;
constexpr size_t WS_Z = WS_R1, WS_STATE = WS_R1 + 120 * MiB, WS_DEC = WS_R1 + 174 * MiB;
constexpr size_t WS_H = WS_R1;
constexpr size_t WS_RKV = WS_R1, WS_LO = WS_R1 + 102 * MiB, WS_WLOG = WS_R1 + 136 * MiB, WS_G = WS_R1 + 170 * MiB;
constexpr size_t WS_TST = WS_R1 + 102 * MiB;
constexpr size_t WS_REC = WS_R1 + 204 * MiB, WS_BON = WS_R1 + 269 * MiB;
constexpr int REC_B = 16640;
constexpr size_t WS_XMIX = WS_R1 + 168 * MiB;
constexpr size_t WS_PART = WS_R1 + 136 * MiB;
constexpr size_t WS_SXB = WS_R1 + 271 * MiB;
constexpr size_t WS_END = WS_R1 + 275 * MiB;

__device__ const double ROPE_REV[32] = {0.15915494309189535, 0.11934937021124886, 0.089499401608891013, 0.067115083005227255, 0.050329212104487035, 0.037741584717419771, 0.028302195830623399, 0.02122365276477766, 0.015915494309189534, 0.011934937021124886, 0.0089499401608891024, 0.0067115083005227253, 0.0050329212104487037, 0.0037741584717419772, 0.0028302195830623399, 0.0021223652764777662, 0.0015915494309189536, 0.0011934937021124885, 0.00089499401608891024, 0.0006711508300522726, 0.00050329212104487033, 0.00037741584717419774, 0.00028302195830623395, 0.00021223652764777661, 0.00015915494309189535, 0.00011934937021124886, 8.9499401608891018e-05, 6.7115083005227254e-05, 5.0329212104487035e-05, 3.7741584717419777e-05, 2.8302195830623396e-05, 2.1223652764777659e-05};

__device__ __forceinline__ unsigned f2bf(float f) { unsigned u = __builtin_bit_cast(unsigned, f); return (u + 0x7fffu + ((u >> 16) & 1u)) >> 16; }
typedef __bf16 bf16x2_t __attribute__((ext_vector_type(2)));
__device__ __forceinline__ unsigned pk2(float lo, float hi) { const f32x2 v = {lo, hi}; const bf16x2_t b = __builtin_convertvector(v, bf16x2_t); return __builtin_bit_cast(unsigned, b); }
__device__ __forceinline__ float bf2f(unsigned short b) { return __builtin_bit_cast(float, (unsigned)b << 16); }
__device__ __forceinline__ float bflo(unsigned w) { return __builtin_bit_cast(float, w << 16); }
__device__ __forceinline__ float bfhi(unsigned w) { return __builtin_bit_cast(float, w & 0xffff0000u); }
__device__ __forceinline__ float sigmoidf_(float x) { return 1.f / (1.f + __expf(-x)); }
__device__ __forceinline__ float siluf_(float x) { return x / (1.f + __expf(-x)); }
__device__ __forceinline__ float wave_sum(float v) {
#pragma unroll
    for (int o = 1; o < 64; o <<= 1) v += __shfl_xor(v, o);
    return v;
}
__device__ __forceinline__ int otid() { int t = threadIdx.x; asm volatile("" : "+v"(t)); return t; }
__device__ __forceinline__ int seq_of_row(int r) { return r < MP ? 0 : 1 + ((r - MP) >> 5); }
#define LDS_WAIT() asm volatile("s_waitcnt lgkmcnt(0)" ::: "memory")
#define VM_WAIT() asm volatile("s_waitcnt vmcnt(0)" ::: "memory")

namespace pg8 {
constexpr int BM = 256, BK = 64, HALF = 128, HTB = HALF * BK * 2, STAGE_BYTES = 8 * HTB, NXCD = 8, WGM = 8;
__host__ __device__ __forceinline__ int lds_byte(int r, int c) { const int st = (r >> 4) * 2 + (c >> 5), rr = r & 15, cc = c & 31, ob = rr * 64 + cc * 2; return st * 1024 + (ob ^ (((ob >> 9) & 1) << 5)); }
__host__ __device__ __forceinline__ void stage_rc(int b, int& R, int& C) { const int st = b / 1024, sb = b % 1024, swz = sb ^ (((sb >> 9) & 1) << 5); R = (st >> 1) * 16 + swz / 64; C = (st & 1) * 32 + (swz % 64) / 2; }
__host__ __device__ __forceinline__ int perm32(int rho) { const int n = rho >> 4, i = rho & 15; return 8 * (i >> 2) + 4 * n + (i & 3); }

struct Unit { int pm, pn, ks; };
template <int LDA_, int LDB_, int K_, int GSHIFT_, int GSTRIDE_, int KSPLIT_, int DELTAP_, bool SPLIT_ = false> struct Geo {
    static constexpr int LDA = LDA_, LDB = LDB_, K = K_, GSHIFT = GSHIFT_, GSTRIDE = GSTRIDE_, KSPLIT = KSPLIT_, DELTAP = DELTAP_; static constexpr bool SPLIT = SPLIT_;
};
template <class GC> struct Gemm {
    const bf16_t* A; const bf16_t* Bt; const bf16_t* A2s;
    __device__ __forceinline__ const char* a_base(const Unit& u) const { return (const char*)(A + (size_t)u.pm * BM * GC::LDA + (size_t)(u.pn >> GC::GSHIFT) * GC::GSTRIDE + (GC::SPLIT ? (size_t)u.ks * GC::K : 0)); }
    __device__ __forceinline__ const char* b_base(const Unit& u) const { return (const char*)(Bt + (size_t)u.pn * BM * GC::LDB + (GC::SPLIT ? (size_t)u.ks * GC::K : 0)); }
    __device__ __forceinline__ long a_delta(const Unit& u) const {
        if constexpr (GC::KSPLIT >= GC::K / BK) return 0;
        else { if (u.pm < 64) return (long)GC::DELTAP;
            return (long)((const char*)(A2s + (size_t)(u.pm - 64) * BM * GC::LDA) - a_base(u)) - (long)GC::KSPLIT * BK * 2; }
    }
};
struct StaticOrder {
    int nM, nN, nwg, G, c;
    __host__ __device__ void init(int M_, int N_, int G_, int c_) { nM = M_ / BM; nN = N_ / BM; nwg = nM * nN; G = G_; c = c_; }
    __host__ __device__ bool next(int i, Unit& u) const {
        const long L = (long)i * G + c; if (L >= nwg) return false;
        int wgid = (int)L; { const int q = nwg / NXCD, r = nwg % NXCD, xcd = wgid % NXCD, off = wgid / NXCD; wgid = (xcd < r ? xcd * (q + 1) : r * (q + 1) + (xcd - r) * q) + off; }
        const int nig = WGM * nN, gid = wgid / nig, fm = gid * WGM, gsz = (nM - fm) < WGM ? (nM - fm) : WGM;
        u.pm = fm + ((wgid % nig) % gsz); u.pn = (wgid % nig) / gsz; u.ks = 0; return true;
    }
};
__device__ __forceinline__ unsigned cvt_pk_bf16(float lo, float hi) { return pk2(lo, hi); }

template <class Epi, class Sched, class GC, bool ALIGN_EPI = false, bool SP2 = false>
__device__ __forceinline__ void gemm_phase(LAS unsigned char* lds, const Gemm<GC> g, const Sched& S, const Epi& E) {
    const int tid = otid(), wid = __builtin_amdgcn_readfirstlane(tid >> 6), lane = tid & 63, wr = wid >> 2, wc = wid & 3, fr = lane & 15, fq = lane >> 4;
    constexpr int K = GC::K, nt = K / BK, ksplit = GC::KSPLIT;
    unsigned voffA[2], voffB[2];
#pragma unroll
    for (int i = 0; i < 2; ++i) { int R, C; stage_rc(tid * 16 + i * 8192, R, C); const int Rb = Epi::PERM ? ((R & ~31) + perm32(R & 31)) : R;
        voffA[i] = (unsigned)(R * GC::LDA + C) * 2u; voffB[i] = (unsigned)(Rb * GC::LDB + C) * 2u; }
    constexpr size_t kstep = (size_t)(BK * 2);
    constexpr size_t hstepA = (size_t)HALF * GC::LDA * 2, hstepB = (size_t)HALF * GC::LDB * 2;
    const unsigned ldsw = (unsigned)wid * 1024u;
    const int aoff = lds_byte(wr * 64 + fr, fq * 8), boff = lds_byte(wc * 32 + fr, fq * 8);
#define PG8_SA(b, h) (((b) * 2 + (h)) * HTB)
#define PG8_SB(b, h) ((4 + (b) * 2 + (h)) * HTB)
#define PG8_STAGE(bufoff, gbase, voff) do { _Pragma("unroll") for (int _i = 0; _i < 2; ++_i) \
        __builtin_amdgcn_global_load_lds((const unsigned*)((const char*)(gbase) + (voff)[_i]), (LAS unsigned*)(lds + (bufoff) + ldsw + _i * 8192), 16, 0, 0); } while (0)
#define PG8_LDA(dst, b, h) do { _Pragma("unroll") for (int m = 0; m < 4; ++m) _Pragma("unroll") for (int k = 0; k < 2; ++k) dst[m][k] = *(const LAS bf16x8*)(lds + PG8_SA(b, h) + aoff + m * 2048 + k * 1024); } while (0)
#define PG8_LDB(dst, b, h) do { _Pragma("unroll") for (int n = 0; n < 2; ++n) _Pragma("unroll") for (int k = 0; k < 2; ++k) dst[n][k] = *(const LAS bf16x8*)(lds + PG8_SB(b, h) + boff + n * 2048 + k * 1024); } while (0)
#define PG8_MMA(ai, bj, At, Bt) do { __builtin_amdgcn_s_setprio(1); _Pragma("unroll") for (int m = 0; m < 4; ++m) _Pragma("unroll") for (int n = 0; n < 2; ++n) _Pragma("unroll") for (int k = 0; k < 2; ++k) \
        acc[ai][bj][m][n] = __builtin_amdgcn_mfma_f32_16x16x32_bf16(Bt[n][k], At[m][k], acc[ai][bj][m][n], 0, 0, 0); __builtin_amdgcn_s_setprio(0); } while (0)
#define PG8_WAIT_V(n) asm volatile("s_waitcnt vmcnt(" #n ")" ::: "memory")
#define PG8_WAIT_L(n) asm volatile("s_waitcnt lgkmcnt(" #n ")" ::: "memory")
#define PG8_BAR __builtin_amdgcn_s_barrier()
#define PG8_SCHED __builtin_amdgcn_sched_barrier(0)
    Unit cur, nxt; int ui = 0;
    if (!S.next(0, cur)) return;
    f32x4 acc[2][2][4][2];
#pragma unroll
    for (int a = 0; a < 2; ++a)
#pragma unroll
        for (int b = 0; b < 2; ++b)
#pragma unroll
            for (int m = 0; m < 4; ++m)
#pragma unroll
                for (int n = 0; n < 2; ++n) acc[a][b][m][n] = (f32x4){0.f, 0.f, 0.f, 0.f};
    bf16x8 At[4][2], B0[2][2], B1[2][2];
    const char* cA = g.a_base(cur); const char* cB = g.b_base(cur); long cD = g.a_delta(cur);
    if constexpr (SP2) {
        PG8_STAGE(PG8_SB(0, 0), cB, voffB); PG8_STAGE(PG8_SB(0, 1), cB + hstepB, voffB); PG8_STAGE(PG8_SA(0, 0), cA, voffA); PG8_STAGE(PG8_SA(0, 1), cA + hstepA, voffA);
        if (wr == 1) PG8_BAR;
        PG8_WAIT_V(2); PG8_BAR;
        PG8_STAGE(PG8_SB(1, 0), cB + kstep, voffB); PG8_STAGE(PG8_SA(1, 0), cA + kstep, voffA); PG8_STAGE(PG8_SB(1, 1), cB + hstepB + kstep, voffB);
        PG8_WAIT_V(6); PG8_BAR;
    } else {
        PG8_STAGE(PG8_SB(0, 0), cB, voffB); PG8_STAGE(PG8_SA(0, 0), cA, voffA); PG8_STAGE(PG8_SB(0, 1), cB + hstepB, voffB); PG8_STAGE(PG8_SA(0, 1), cA + hstepA, voffA);
        if (wr == 1) PG8_BAR;
        PG8_WAIT_V(4); PG8_BAR;
        PG8_STAGE(PG8_SB(1, 0), cB + kstep, voffB); PG8_STAGE(PG8_SA(1, 0), cA + kstep, voffA); PG8_STAGE(PG8_SB(1, 1), cB + hstepB + kstep, voffB);
        PG8_WAIT_V(6); PG8_BAR;
    }
    for (;;) {
        const bool has_next = S.next(ui + 1, nxt);
        const char* nA = has_next ? g.a_base(nxt) : cA; const char* nB = has_next ? g.b_base(nxt) : cB;
        const long nD = has_next ? g.a_delta(nxt) : cD;
#pragma unroll 1
        for (int t = 0; t < nt; t += 2) {
            const bool last = (t == nt - 2);
            const char* a1 = cA + (size_t)(t + 1) * kstep + (t >= ksplit ? cD : 0);
            const char* a2 = last ? nA : cA + (size_t)(t + 2) * kstep + (t + 2 >= ksplit ? cD : 0); const char* b2 = last ? nB : cB + (size_t)(t + 2) * kstep;
            const char* a3 = a2 + kstep; const char* b3 = b2 + kstep;
            if constexpr (SP2) {
            PG8_LDB(B0, 0, 0); PG8_LDB(B1, 0, 1); PG8_SCHED; PG8_LDA(At, 0, 0); PG8_STAGE(PG8_SA(1, 1), a1 + hstepA, voffA);
            PG8_WAIT_V(8); PG8_WAIT_L(0); PG8_BAR; PG8_MMA(0, 0, At, B0); PG8_MMA(0, 1, At, B1); PG8_BAR; PG8_SCHED;
            PG8_LDA(At, 0, 1); PG8_STAGE(PG8_SB(0, 0), b2, voffB); PG8_STAGE(PG8_SB(0, 1), b2 + hstepB, voffB); PG8_STAGE(PG8_SA(0, 0), a2, voffA);
            PG8_WAIT_V(8); PG8_WAIT_L(0); PG8_BAR; PG8_MMA(1, 0, At, B0); PG8_MMA(1, 1, At, B1); PG8_BAR; PG8_SCHED;
            PG8_LDB(B0, 1, 0); PG8_LDB(B1, 1, 1); PG8_SCHED; PG8_LDA(At, 1, 0); PG8_STAGE(PG8_SA(0, 1), a2 + hstepA, voffA);
            PG8_WAIT_V(8); PG8_WAIT_L(0); PG8_BAR; PG8_MMA(0, 0, At, B0); PG8_MMA(0, 1, At, B1); PG8_BAR; PG8_SCHED;
            PG8_LDA(At, 1, 1); PG8_STAGE(PG8_SB(1, 0), b3, voffB); PG8_STAGE(PG8_SB(1, 1), b3 + hstepB, voffB); PG8_STAGE(PG8_SA(1, 0), a3, voffA);
            PG8_WAIT_V(8); PG8_WAIT_L(0); PG8_BAR; PG8_MMA(1, 0, At, B0); PG8_MMA(1, 1, At, B1); PG8_BAR; PG8_SCHED;
            } else {
            PG8_LDB(B0, 0, 0); PG8_SCHED; PG8_LDA(At, 0, 0); PG8_STAGE(PG8_SA(1, 1), a1 + hstepA, voffA);
            PG8_WAIT_L(8); PG8_BAR; PG8_WAIT_L(0); PG8_MMA(0, 0, At, B0); PG8_BAR; PG8_SCHED;
            PG8_LDB(B1, 0, 1); PG8_STAGE(PG8_SB(0, 0), b2, voffB);
            PG8_BAR; PG8_WAIT_L(0); PG8_MMA(0, 1, At, B1); PG8_BAR;
            PG8_LDA(At, 0, 1); PG8_STAGE(PG8_SA(0, 0), a2, voffA);
            PG8_BAR; PG8_WAIT_L(0); PG8_MMA(1, 0, At, B0); PG8_BAR; PG8_SCHED;
            PG8_STAGE(PG8_SB(0, 1), b2 + hstepB, voffB);
            PG8_WAIT_V(6); PG8_BAR; PG8_MMA(1, 1, At, B1); PG8_BAR;
            PG8_LDB(B0, 1, 0); PG8_SCHED; PG8_LDA(At, 1, 0); PG8_STAGE(PG8_SA(0, 1), a2 + hstepA, voffA);
            PG8_WAIT_L(8); PG8_BAR; PG8_WAIT_L(0); PG8_MMA(0, 0, At, B0); PG8_BAR; PG8_SCHED;
            PG8_LDB(B1, 1, 1); PG8_STAGE(PG8_SB(1, 0), b3, voffB);
            PG8_BAR; PG8_WAIT_L(0); PG8_MMA(0, 1, At, B1); PG8_BAR;
            PG8_LDA(At, 1, 1); PG8_STAGE(PG8_SA(1, 0), a3, voffA);
            PG8_BAR; PG8_WAIT_L(0); PG8_MMA(1, 0, At, B0); PG8_BAR; PG8_SCHED;
            PG8_STAGE(PG8_SB(1, 1), b3 + hstepB, voffB);
            PG8_WAIT_V(6); PG8_BAR; PG8_MMA(1, 1, At, B1); PG8_BAR;
            }
        }
        if constexpr (ALIGN_EPI) { if (wr == 0) PG8_BAR; }
        E(acc, cur, wr, wc, fr, fq);
        if (!has_next) break;
#pragma unroll
        for (int a = 0; a < 2; ++a)
#pragma unroll
            for (int b = 0; b < 2; ++b)
#pragma unroll
                for (int m = 0; m < 4; ++m)
#pragma unroll
                    for (int n = 0; n < 2; ++n) acc[a][b][m][n] = (f32x4){0.f, 0.f, 0.f, 0.f};
        cur = nxt; cA = nA; cB = nB; cD = nD; ++ui;
        if constexpr (ALIGN_EPI) { if (wr == 1) PG8_BAR; }
    }
    PG8_WAIT_V(0);
    if constexpr (!ALIGN_EPI) { if (wr == 0) PG8_BAR; }
    PG8_BAR;
#undef PG8_SA
#undef PG8_SB
#undef PG8_STAGE
#undef PG8_LDA
#undef PG8_LDB
#undef PG8_MMA
#undef PG8_WAIT_V
#undef PG8_WAIT_L
#undef PG8_BAR
#undef PG8_SCHED
}

__device__ __forceinline__ float act_apply(float v, int act) {
    if (act == 1) { const float r = v > 0.f ? v : 0.f; return r * r; }
    if (act == 2) { const float e = __expf(-2.f * fabsf(v)); const float t = (1.f - e) / (1.f + e); return v < 0.f ? -t : t; }
    if (act == 3) return 1.f / (1.f + __expf(-v));
    return v;
}
template <int ACT> __device__ __forceinline__ void store_tile_bf16(const f32x4 (&acc)[2][2][4][2], bf16_t* base, int ldc, int row0, int col0, bf16_t* base2, int ldc2, int col2) {
#pragma unroll
    for (int ai = 0; ai < 2; ++ai)
#pragma unroll
        for (int m = 0; m < 4; ++m) { const size_t r = (size_t)(row0 + ai * HALF + m * 16);
#pragma unroll
            for (int bj = 0; bj < 2; ++bj) { f32x4 v0 = acc[ai][bj][m][0], v1 = acc[ai][bj][m][1];
#pragma unroll
                for (int q = 0; q < 4; ++q) { v0[q] = act_apply(v0[q], ACT); v1[q] = act_apply(v1[q], ACT); }
                u32x4 w; w.x = cvt_pk_bf16(v0[0], v0[1]); w.y = cvt_pk_bf16(v0[2], v0[3]); w.z = cvt_pk_bf16(v1[0], v1[1]); w.w = cvt_pk_bf16(v1[2], v1[3]);
                *(u32x4*)(base + r * ldc + col0 + bj * HALF) = w;
                if (base2) *(u32x4*)(base2 + r * ldc2 + col2 + bj * HALF) = w; } }
}
template <int ACT> struct EpiBf16 {
    static constexpr bool PERM = true;
    bf16_t* O; int ldc;
    __device__ __forceinline__ void operator()(const f32x4 (&acc)[2][2][4][2], const Unit& u, int wr, int wc, int fr, int fq) const {
        store_tile_bf16<ACT>(acc, O, ldc, u.pm * BM + wr * 64 + fr, u.pn * BM + wc * 32 + 8 * fq, nullptr, 0, 0);
    }
};
struct EpiRkv {
    static constexpr bool PERM = true;
    bf16_t* RKV; bf16_t* LO; bf16_t* vf;
    __device__ __forceinline__ void operator()(const f32x4 (&acc)[2][2][4][2], const Unit& u, int wr, int wc, int fr, int fq) const {
        const int row0 = u.pm * BM + wr * 64 + fr, cin = wc * 32 + 8 * fq;
        if (u.pn < 12) { bf16_t* b2 = (u.pn >= 8) ? vf : nullptr; store_tile_bf16<0>(acc, RKV, 3072, row0, u.pn * BM + cin, b2, 1024, (u.pn - 8) * BM + cin); }
        else {
#pragma unroll
            for (int bj = 0; bj < 2; ++bj) { const int c = cin + bj * HALF; int dst = -1, act = 0;
                if (u.pn == 12) { if (c < 64) { dst = c; act = 2; } else if (c < 128) dst = 256 + (c - 64); else if (c < 160) dst = 512 + (c - 128); }
                else if (c < 160) { dst = 768 + c; act = 3; }
                if (dst >= 0) {
#pragma unroll
                    for (int ai = 0; ai < 2; ++ai)
#pragma unroll
                        for (int m = 0; m < 4; ++m) { const size_t r = (size_t)(row0 + ai * HALF + m * 16); f32x4 v0 = acc[ai][bj][m][0], v1 = acc[ai][bj][m][1];
#pragma unroll
                            for (int q = 0; q < 4; ++q) { v0[q] = act_apply(v0[q], act); v1[q] = act_apply(v1[q], act); }
                            u32x4 w; w.x = cvt_pk_bf16(v0[0], v0[1]); w.y = cvt_pk_bf16(v0[2], v0[3]); w.z = cvt_pk_bf16(v1[0], v1[1]); w.w = cvt_pk_bf16(v1[2], v1[3]);
                            *(u32x4*)(LO + r * 1024 + dst) = w; } } }
        }
    }
};
struct EpiRes {
    static constexpr bool PERM = false;
    float* X; const float* modl; int goff; const float* Xin;
    __device__ __forceinline__ void operator()(const f32x4 (&acc)[2][2][4][2], const Unit& u, int wr, int wc, int fr, int fq) const {
        const int col0 = u.pn * BM + wc * 32 + 4 * fq;
#pragma unroll
        for (int ai = 0; ai < 2; ++ai)
#pragma unroll
            for (int m = 0; m < 4; ++m) { const int r = u.pm * BM + ai * HALF + wr * 64 + m * 16 + fr; const float* gp = modl + (size_t)seq_of_row(r) * 6144 + goff + col0; float* xp = X + (size_t)r * D + col0; const float* xi = Xin + (size_t)r * D + col0;
#pragma unroll
                for (int bj = 0; bj < 2; ++bj)
#pragma unroll
                    for (int n = 0; n < 2; ++n) { const f32x4 gv = *(const f32x4*)(gp + bj * HALF + n * 16); f32x4 xv = *(const f32x4*)(xi + bj * HALF + n * 16);
                        xv = xv + gv * acc[ai][bj][m][n]; *(f32x4*)(xp + bj * HALF + n * 16) = xv; }
                asm volatile("" ::: "memory"); }
    }
};
struct EpiLora2 {
    static constexpr bool PERM = false;
    bf16_t* WLOG; bf16_t* Aout; bf16_t* G; bf16_t* RKV; const bf16_t* vf; const float* w0; const float* a0; const float* v0;
    template <int GRP> __device__ __forceinline__ void run(const f32x4 (&acc)[2][2][4][2], const Unit& u, int wr, int wc, int fr, int fq) const {
        const int col0 = (u.pn & 3) * BM + wc * 32 + 4 * fq;
#pragma unroll
        for (int ai = 0; ai < 2; ++ai)
#pragma unroll
            for (int m = 0; m < 4; ++m) { const size_t r = (size_t)(u.pm * BM + ai * HALF + wr * 64 + m * 16 + fr);
#pragma unroll
                for (int bj = 0; bj < 2; ++bj)
#pragma unroll
                    for (int n = 0; n < 2; ++n) { const int c = col0 + bj * HALF + n * 16; const f32x4 a = acc[ai][bj][m][n]; f32x4 o;
                        if constexpr (GRP == 0) { const f32x4 b = *(const f32x4*)(w0 + c);
#pragma unroll
                            for (int q = 0; q < 4; ++q) { const float x = -(b[q] + a[q]); const float sp = fmaxf(x, 0.f) + __logf(1.f + __expf(-fabsf(x))); o[q] = -__expf(-sp - 0.5f); }
                            u32x2 w; w.x = cvt_pk_bf16(o[0], o[1]); w.y = cvt_pk_bf16(o[2], o[3]); *(u32x2*)(WLOG + r * D + c) = w; }
                        else if constexpr (GRP == 1) { const f32x4 b = *(const f32x4*)(a0 + c);
#pragma unroll
                            for (int q = 0; q < 4; ++q) o[q] = 1.f / (1.f + __expf(-(b[q] + a[q])));
                            u32x2 w; w.x = cvt_pk_bf16(o[0], o[1]); w.y = cvt_pk_bf16(o[2], o[3]); *(u32x2*)(Aout + r * D + c) = w; }
                        else if constexpr (GRP == 2) { const f32x4 b = *(const f32x4*)(v0 + c); const u32x2 vv = *(const u32x2*)(RKV + r * 3072 + 2048 + c), ff = *(const u32x2*)(vf + r * D + c);
                            f32x4 v4, f4; v4[0] = bflo(vv.x); v4[1] = bfhi(vv.x); v4[2] = bflo(vv.y); v4[3] = bfhi(vv.y); f4[0] = bflo(ff.x); f4[1] = bfhi(ff.x); f4[2] = bflo(ff.y); f4[3] = bfhi(ff.y);
#pragma unroll
                            for (int q = 0; q < 4; ++q) { const float gte = 1.f / (1.f + __expf(-(b[q] + a[q]))); o[q] = v4[q] + (f4[q] - v4[q]) * gte; }
                            u32x2 w; w.x = cvt_pk_bf16(o[0], o[1]); w.y = cvt_pk_bf16(o[2], o[3]); *(u32x2*)(RKV + r * 3072 + 2048 + c) = w; }
                        else { u32x2 w; w.x = cvt_pk_bf16(a[0], a[1]); w.y = cvt_pk_bf16(a[2], a[3]); *(u32x2*)(G + r * D + c) = w; } }
                asm volatile("" ::: "memory"); }
    }
    __device__ __forceinline__ void operator()(const f32x4 (&acc)[2][2][4][2], const Unit& u, int wr, int wc, int fr, int fq) const {
        const int grp = u.pn >> 2;
        if (grp == 0) run<0>(acc, u, wr, wc, fr, fq);
        else if (grp == 1) run<1>(acc, u, wr, wc, fr, fq);
        else if (grp == 2) { if (vf != nullptr) run<2>(acc, u, wr, wc, fr, fq); }
        else run<3>(acc, u, wr, wc, fr, fq);
    }
};
struct SplitOrder {
    int c, splitk;
    __device__ bool next(int i, Unit& u) const { if (i != 0 || c >= 16 * splitk) return false; const int t = c / splitk; u.pm = 64 + (t >> 2); u.pn = t & 3; u.ks = c % splitk; return true; }
};
struct LoraOrder {
    int c;
    __device__ bool next(int i, Unit& u) const { const int idx = c - 48; if (i != 0 || idx < 0 || idx >= 136) return false; u.pm = idx >> 1; u.pn = 12 + (idx & 1); u.ks = 0; return true; }
};
struct EpiPartial {
    static constexpr bool PERM = false;
    float* PART; int splitk;
    __device__ __forceinline__ void operator()(const f32x4 (&acc)[2][2][4][2], const Unit& u, int wr, int wc, int fr, int fq) const {
        float* base = PART + ((size_t)(((u.pm - 64) * 4 + u.pn) * splitk + u.ks) << 16) + wc * 32 + 4 * fq;
#pragma unroll
        for (int ai = 0; ai < 2; ++ai)
#pragma unroll
            for (int m = 0; m < 4; ++m) { float* rp = base + (ai * HALF + wr * 64 + m * 16 + fr) * 256;
#pragma unroll
                for (int bj = 0; bj < 2; ++bj)
#pragma unroll
                    for (int n = 0; n < 2; ++n) *(f32x4*)(rp + bj * HALF + n * 16) = acc[ai][bj][m][n]; }
    }
};
template <bool PERM_> struct EpiNull {
    static constexpr bool PERM = PERM_;
    __device__ __forceinline__ void operator()(const f32x4 (&acc)[2][2][4][2], const Unit&, int, int, int, int) const {
#pragma unroll
        for (int a = 0; a < 2; ++a)
#pragma unroll
            for (int b = 0; b < 2; ++b)
#pragma unroll
                for (int m = 0; m < 4; ++m)
#pragma unroll
                    for (int n = 0; n < 2; ++n) asm volatile("" :: "v"(acc[a][b][m][n]));
    }
};
}

#define RLX_AGENT __ATOMIC_RELAXED, __HIP_MEMORY_SCOPE_AGENT
#define XB_TMO      128
#define XB_XCNT(j)  (256  + 64 * (j))
#define XB_XSUB(j)  (1280 + 64 * (j))
#define XB_XGEN(j)  (2304 + 64 * (j))
#define XB_TOP      3328
#define XB_TOPGEN   3392
#define XCD_BAR_WORDS 3456
#define XB_SPIN_CAP (1u << 24)
__device__ __forceinline__ unsigned xb_ld(unsigned* p)              { return __hip_atomic_load(p, __ATOMIC_RELAXED, __HIP_MEMORY_SCOPE_AGENT); }
__device__ __forceinline__ unsigned xb_add(unsigned* p, unsigned v) { return __hip_atomic_fetch_add(p, v, __ATOMIC_RELAXED, __HIP_MEMORY_SCOPE_AGENT); }
__device__ __forceinline__ unsigned xb_xcc_id() { return (unsigned)__builtin_amdgcn_s_getreg((3 << 11) | 20) & 0xFu; }
#define XB_SPIN(cond, bar) do { unsigned _sp = 0; while (cond) { __builtin_amdgcn_s_sleep(4); \
    if ((++_sp & 255u) == 0u) { if (xb_ld(&(bar)[XB_TMO])) break; if (_sp > XB_SPIN_CAP) { atomicAdd(&(bar)[XB_TMO], 1u); break; } } } } while (0)
struct XcdBarrier { unsigned* bar; unsigned x; volatile LAS unsigned* st; };
__device__ __forceinline__ XcdBarrier xcd_barrier_post(unsigned* bar, volatile LAS unsigned* st) {
    XcdBarrier b; b.bar = bar; b.x = xb_xcc_id(); b.st = st;
    if (threadIdx.x == 0) (void)xb_add(&bar[XB_XCNT(b.x)], 1u);
    return b;
}
__device__ __forceinline__ void xcd_barrier_complete(unsigned* bar, unsigned x, unsigned& nloc, unsigned& nx) {
    const unsigned G = gridDim.x * gridDim.y * gridDim.z;
    unsigned sum, cnt, mine, sp = 0u;
    for (;;) {
        sum = 0u; cnt = 0u; mine = 0u;
#pragma unroll
        for (unsigned j = 0; j < 16; ++j) { const unsigned c = xb_ld(&bar[XB_XCNT(j)]); sum += c; cnt += (c > 0u) ? 1u : 0u; mine = (j == x) ? c : mine; }
        if (sum == G) break;
        __builtin_amdgcn_s_sleep(1);
        if ((++sp & 255u) == 0u) { if (xb_ld(&bar[XB_TMO])) break; if (sp > XB_SPIN_CAP) { atomicAdd(&bar[XB_TMO], 1u); break; } }
    }
    nloc = mine > 0u ? mine : 1u; nx = cnt > 0u ? cnt : 1u;
}
__device__ __forceinline__ void xcd_barrier(const XcdBarrier& b) {
    asm volatile("s_waitcnt vmcnt(0)" ::: "memory");
    __syncthreads();
    if (threadIdx.x == 0) {
        unsigned* bar = b.bar;
        __builtin_amdgcn_s_waitcnt(0);
        unsigned nloc = b.st[0], nx = b.st[1];
        if (nloc == 0u) { xcd_barrier_complete(bar, b.x, nloc, nx); b.st[0] = nloc; b.st[1] = nx; }
        const unsigned gen = b.st[2];
        const unsigned old = xb_add(&bar[XB_XSUB(b.x)], 1u);
        if (old + 1u == (gen + 1u) * nloc) {
            __builtin_amdgcn_fence(__ATOMIC_RELEASE, "agent");
            asm volatile("s_waitcnt vmcnt(0)" ::: "memory");
            const unsigned og = xb_add(&bar[XB_TOP], 1u);
            if (og + 1u == (gen + 1u) * nx) xb_add(&bar[XB_TOPGEN], 1u);
            else XB_SPIN(xb_ld(&bar[XB_TOPGEN]) == gen, bar);
        } else {
            XB_SPIN(xb_ld(&bar[XB_TOPGEN]) == gen, bar);
        }
        __builtin_amdgcn_fence(__ATOMIC_ACQUIRE, "agent");
        asm volatile("s_waitcnt vmcnt(0)" ::: "memory");
        b.st[2] = gen + 1u;
    }
    __syncthreads();
}

constexpr int NWAVES = 8, NT = NWAVES * 64;
constexpr int RING_BYTES = 131072, LDSCTL_OFF = RING_BYTES, MISC_OFF = LDSCTL_OFF + 320, LDS_BYTES = 147456;
constexpr int CW_BAR = 4096;

struct Args { const float* in[38]; float* out; unsigned char* ws; };
struct Frame {
    LAS unsigned char* lds; volatile LAS unsigned* MISC;
    int wave, vcu, G;
    const float* const* in; float* out; unsigned char* ws;
};
enum { I_XP = 0, I_XS, I_SRET, I_SHG, I_SWKV, I_SSHIFT, I_CP, I_CS, I_MODW, I_MODB, I_NMIXG, I_NMLPG, I_FINALG, I_W1, I_W2, I_ABWIN, I_ABWOUT, I_HGLB, I_HGNG,
       I_MU, I_WRKV, I_RW0, I_RW1, I_RW2, I_RA0, I_RA1, I_RA2, I_RV0, I_RV1, I_RV2, I_RG1, I_RG2, I_RKK, I_RKA, I_RRK, I_RLNG, I_RLNB, I_RWOUT };
constexpr size_t O_Y = 0, O_RETP = 17825792, O_RETS = 17891328, O_HGP = 19988480, O_HGS = 20119552, O_WKVP = 24313856, O_WKVS = 24444928, O_SHP = 28639232, O_SHS = 28641280;

__device__ __forceinline__ void transpose_item(const float* W, int N, bf16_t* WT, int ldt, int row_off, int col_off, const float* mu, int mode, LAS float* scr, int item, int lane) {
    const int nblk = N / 32, kb = item / nblk, nb = item % nblk, k0 = 64 * kb, n0 = 32 * nb;
#pragma unroll 8
    for (int i = 0; i < 32; ++i) { const int kk = 2 * i + (lane >> 5); float s = 1.f; if (mode == 1) s = 1.f - mu[k0 + kk]; else if (mode == 2) s = mu[k0 + kk];
        scr[kk * 33 + (lane & 31)] = W[(size_t)(k0 + kk) * N + n0 + (lane & 31)] * s; }
    LDS_WAIT(); asm volatile("" ::: "memory");
    const int c = lane & 7;
#pragma unroll
    for (int j = 0; j < 4; ++j) { const int n = (lane >> 3) + 8 * j; const LAS float* s = scr + (8 * c) * 33 + n;
        u32x4 o; o.x = pk2(s[0 * 33], s[1 * 33]); o.y = pk2(s[2 * 33], s[3 * 33]); o.z = pk2(s[4 * 33], s[5 * 33]); o.w = pk2(s[6 * 33], s[7 * 33]);
        *(u32x4*)(WT + (size_t)(row_off + n0 + n) * ldt + col_off + k0 + 8 * c) = o; }
    LDS_WAIT(); asm volatile("" ::: "memory");
}
__device__ __forceinline__ void convert_layer_weights(Frame& F, int layer) {
    const int tid = otid(); const int lane = tid & 63; (void)lane;
    LAS float* scr = (LAS float*)(F.lds + F.wave * 16384);
    const int gw = F.vcu * NWAVES + F.wave, NGW = F.G * NWAVES;
    unsigned char* ar = F.ws + WS_ARENA;
    const int m = layer >> 1;
    constexpr int I_1 = (D / 64) * (DFF / 32), I_2 = (DFF / 64) * (D / 32);
    const float* w1 = F.in[I_W1] + (size_t)layer * D * DFF; const float* w2 = F.in[I_W2] + (size_t)layer * DFF * D;
    if ((layer & 1) == 0) {
        constexpr int I_IN = (D / 64) * (ABIN / 32), I_OUT = (D / 64) * (D / 32), NI = I_1 + I_2 + I_IN + I_OUT;
        const float* win = F.in[I_ABWIN] + (size_t)m * D * ABIN; const float* wout = F.in[I_ABWOUT] + (size_t)m * D * D;
        for (int it = gw; it < NI; it += NGW) { int r = it;
            if (r < I_1) { transpose_item(w1, DFF, (bf16_t*)(ar + AR_W1), D, 0, 0, nullptr, 0, scr, r, lane); continue; } r -= I_1;
            if (r < I_2) { transpose_item(w2, D, (bf16_t*)(ar + AR_W2), DFF, 0, 0, nullptr, 0, scr, r, lane); continue; } r -= I_2;
            if (r < I_IN) { transpose_item(win, ABIN, (bf16_t*)(ar + AR_WIN), D, 0, 0, nullptr, 0, scr, r, lane); continue; } r -= I_IN;
            transpose_item(wout, D, (bf16_t*)(ar + AR_WOUT), D, 0, 0, nullptr, 0, scr, r, lane); }
    } else {
        constexpr int I_P = (D / 64) * (D / 32), NI = I_1 + I_2 + 4 * I_P;
        const float* mu = F.in[I_MU] + (size_t)m * 6 * D; const float* wrkv = F.in[I_WRKV] + (size_t)m * 3 * D * D; const float* wo = F.in[I_RWOUT] + (size_t)m * D * D;
        bf16_t* wc1 = (bf16_t*)(ar + AR_WC1);
        for (int it = gw; it < NI; it += NGW) { int r = it;
            if (r < I_1) { transpose_item(w1, DFF, (bf16_t*)(ar + AR_W1), D, 0, 0, nullptr, 0, scr, r, lane); continue; } r -= I_1;
            if (r < I_2) { transpose_item(w2, D, (bf16_t*)(ar + AR_W2), DFF, 0, 0, nullptr, 0, scr, r, lane); continue; } r -= I_2;
            if (r < 3 * I_P) { const int p = r / I_P;
                transpose_item(wrkv + (size_t)p * D * D, D, wc1, 2048, p * D, 0, nullptr, 0, scr, r % I_P, lane); continue; } r -= 3 * I_P;
            transpose_item(wo, D, (bf16_t*)(ar + AR_WO), D, 0, 0, nullptr, 0, scr, r, lane); }
        const int gt = F.vcu * NT + tid, NG = F.G * NT;
        const float* lw1 = F.in[I_RW1] + (size_t)m * D * 64; const float* la1 = F.in[I_RA1] + (size_t)m * D * 64; const float* lv1 = F.in[I_RV1]; const float* lg1 = F.in[I_RG1] + (size_t)m * D * 160;
        for (int idx = gt; idx < 512 * 2048; idx += NG) { const int n = idx >> 11, k = idx & 2047, kk = k & 1023, nn = n & 255;
            const float* src = nullptr; int ns = 0, mi = 0, nc = 0;
            if (n < 256) { if (nn < 64) { src = lw1; ns = 64; mi = 1; nc = nn; } else if (nn < 128) { src = la1; ns = 64; mi = 4; nc = nn - 64; } else if (nn < 160 && m == 1) { src = lv1; ns = 32; mi = 3; nc = nn - 128; } }
            else if (nn < 160) { src = lg1; ns = 160; mi = 5; nc = nn; }
            float v = 0.f; if (src) { const float muv = mu[mi * D + kk]; v = src[(size_t)kk * ns + nc] * (k < 1024 ? 1.f - muv : muv); }
            wc1[(size_t)(3072 + n) * 2048 + k] = (bf16_t)f2bf(v); }
        bf16_t* wc2 = (bf16_t*)(ar + AR_WC2);
        const float* lw2 = F.in[I_RW2] + (size_t)m * 64 * D; const float* la2 = F.in[I_RA2] + (size_t)m * 64 * D; const float* lv2 = F.in[I_RV2]; const float* lg2 = F.in[I_RG2] + (size_t)m * 160 * D;
        for (int idx = gt; idx < 4096 * 256; idx += NG) { const int k = idx >> 12, n = idx & 4095, g = n >> 10, nn = n & 1023;
            const float* src = (g == 0) ? lw2 : (g == 1) ? la2 : (g == 2) ? lv2 : lg2; const int ks = (g == 0 || g == 1) ? 64 : (g == 2 ? 32 : 160);
            float v = 0.f; if (k < ks && !(g == 2 && m == 0)) v = src[(size_t)k * D + nn];
            wc2[(size_t)n * 256 + k] = (bf16_t)f2bf(v); }
    }
}

__device__ __forceinline__ void mod_phase(Frame& F, int l_lo, int l_hi, int wb, int nb) {
    const int tid = otid(); const int lane = tid & 63;
    const float* __restrict__ SC = (const float*)(F.ws + WS_MOD + 3584 * 1024);
    float* MOD = (float*)(F.ws + WS_MOD);
    LAS float* red = (LAS float*)F.lds;
    for (int task = l_lo * 96 + wb; task < l_hi * 96; task += nb) { const int l = task / 96, n = (task % 96) * 64 + lane, ks = F.wave;
        const float* w = F.in[I_MODW] + ((size_t)l * D + ks * 128) * 6144 + n;
        float acc[NSEQ];
#pragma unroll
        for (int s = 0; s < NSEQ; ++s) acc[s] = 0.f;
        for (int k = 0; k < 128; k += 4) { const float w0 = w[(size_t)k * 6144], w1 = w[(size_t)(k + 1) * 6144], w2 = w[(size_t)(k + 2) * 6144], w3 = w[(size_t)(k + 3) * 6144];
#pragma unroll
            for (int s = 0; s < NSEQ; ++s) { const f32x4 c4 = *(const f32x4*)(SC + s * D + ks * 128 + k); acc[s] += (c4[0] * w0 + c4[1] * w1) + (c4[2] * w2 + c4[3] * w3); } }
        __syncthreads();
#pragma unroll
        for (int s = 0; s < NSEQ; ++s) red[(F.wave * NSEQ + s) * 64 + lane] = acc[s];
        __syncthreads();
        for (int i = tid; i < NSEQ * 64; i += NT) { const int s = i >> 6, c = i & 63; float t = F.in[I_MODB][l * 6144 + (task % 96) * 64 + c];
#pragma unroll
            for (int q = 0; q < 8; ++q) t += red[(q * NSEQ + s) * 64 + c];
            MOD[((size_t)l * NSEQ + s) * 6144 + (task % 96) * 64 + c] = t; }
    }
    __syncthreads();
}

__device__ __forceinline__ void prologue(Frame& F) {
    const int tid = otid(); const int lane = tid & 63; (void)lane;
    const int gt = F.vcu * NT + tid, NG = F.G * NT;
    { f32x2* tab = (f32x2*)(F.ws + WS_ROPE);
      for (int i = gt; i < 16384 * 32; i += NG) { const int p = i >> 5, d = i & 31; double rev = (double)p * ROPE_REV[d]; rev -= floor(rev); const float fr = (float)rev;
          tab[i] = (f32x2){__builtin_amdgcn_cosf(fr), __builtin_amdgcn_sinf(fr)}; } }
    { unsigned* z = (unsigned*)(F.ws + WS_XN0); for (int i = gt; i < 512; i += NG) z[i] = 0u; }
    { float* SC = (float*)(F.ws + WS_MOD + 3584 * 1024);
      for (int i = gt; i < NSEQ * D; i += NG) { const int s = i >> 10, k = i & 1023; const float c = (s == 0) ? F.in[I_CP][k] : F.in[I_CS][(size_t)(s - 1) * D + k]; SC[i] = siluf_(c); } }
    convert_layer_weights(F, 0);
}

template <int MODE> __device__ __forceinline__ void norm_row(Frame& F, int layer, int r, f32x4 (&v)[4], const float* MOD, const float* gvec, int lane, f32x4 (&ho)[4]) {
    const int m = layer >> 1; const int shoff = (MODE == 2) ? 3072 : 0, scoff = (MODE == 2) ? 4096 : 1024;
    bf16_t* XN = (bf16_t*)(F.ws + WS_XN); bf16_t* PREVS = (bf16_t*)(F.ws + WS_PREVS);
    float* xrow = F.out + (size_t)r * D; float s2 = 0.f;
#pragma unroll
    for (int j = 0; j < 4; ++j) s2 += (v[j].x * v[j].x + v[j].y * v[j].y) + (v[j].z * v[j].z + v[j].w * v[j].w);
    const float rstd = 1.f / sqrtf(wave_sum(s2) * (1.f / D) + NORM_EPS);
    const int seq = seq_of_row(r); const float* mp = MOD + (size_t)seq * 6144;
#pragma unroll
    for (int j = 0; j < 4; ++j) { const int c = 4 * lane + 256 * j; const f32x4 g4 = *(const f32x4*)(gvec + c); f32x4 o = v[j] * rstd * g4;
        if (MODE == 3) { *((f32x4*)xrow + lane + 64 * j) = o; continue; }
        const f32x4 sc = *(const f32x4*)(mp + scoff + c), sh = *(const f32x4*)(mp + shoff + c);
        o = o * (1.f + sc) + sh; ho[j] = o;
        const unsigned long long pk = (unsigned long long)pk2(o.x, o.y) | ((unsigned long long)pk2(o.z, o.w) << 32);
        *(unsigned long long*)(XN + (size_t)r * D + c) = pk;
        if (MODE == 1) {
            if (r >= MP) { const int t = (r - MP) & 31; if (t < 31) *(unsigned long long*)(PREVS + (size_t)(r - MP + 1) * D + c) = pk;
                else *(f32x4*)(F.out + O_SHS + ((size_t)m * 32 + ((r - MP) >> 5)) * D + c) = o;
                if (t == 0) { const f32x4 ss = *(const f32x4*)(F.in[I_SSHIFT] + ((size_t)m * 32 + ((r - MP) >> 5)) * D + c);
                    *(unsigned long long*)(PREVS + (size_t)(r - MP) * D + c) = (unsigned long long)pk2(ss.x, ss.y) | ((unsigned long long)pk2(ss.z, ss.w) << 32); } }
            else if (r == MP - 1) *(f32x4*)(F.out + O_SHP + (size_t)m * D + c) = o;
        } }
}
__device__ __forceinline__ void hmix_calc(const float* mp, const float* gvec, const f32x4 (&v)[4], int lane, f32x4 (&h)[4]) {
    float s2 = 0.f;
#pragma unroll
    for (int j = 0; j < 4; ++j) s2 += (v[j].x * v[j].x + v[j].y * v[j].y) + (v[j].z * v[j].z + v[j].w * v[j].w);
    const float rstd = 1.f / sqrtf(wave_sum(s2) * (1.f / D) + NORM_EPS);
#pragma unroll
    for (int j = 0; j < 4; ++j) { const int c = 4 * lane + 256 * j; const f32x4 g4 = *(const f32x4*)(gvec + c), sc = *(const f32x4*)(mp + 1024 + c), sh = *(const f32x4*)(mp + c); h[j] = v[j] * rstd * g4 * (1.f + sc) + sh; }
}
__device__ __forceinline__ void write_mixes(Frame& F, int m, int r, const f32x4 (&h)[4], const f32x4 (&p)[4], int lane) {
    bf16_t* XM = (bf16_t*)(F.ws + WS_XMIX); const float* mu = F.in[I_MU] + (size_t)m * 6 * D;
#pragma unroll
    for (int j = 0; j < 4; ++j) { const int c = 4 * lane + 256 * j; const f32x4 d = p[j] - h[j];
#pragma unroll
        for (int q = 0; q < 3; ++q) { const f32x4 mv = *(const f32x4*)(mu + (q == 0 ? 0 : (q == 1 ? 2 : 3)) * D + c); const f32x4 x = h[j] + d * mv;
            *(unsigned long long*)(XM + ((size_t)q * M + r) * D + c) = (unsigned long long)pk2(x.x, x.y) | ((unsigned long long)pk2(x.z, x.w) << 32); } }
}
template <int MODE, int PEND = 0, bool FIRSTP = false> __device__ __forceinline__ void norm_pass(Frame& F, int layer, int player, int pgoff, const float* sx_in, float* sx_out) {
    const int tid = otid(); const int lane = tid & 63;
    const int gw = F.vcu * NWAVES + F.wave, NGW = F.G * NWAVES;
    const float* MOD = (const float*)(F.ws + WS_MOD) + (size_t)layer * NSEQ * 6144;
    const float* gvec = (MODE == 3) ? F.in[I_FINALG] : (MODE == 2 ? F.in[I_NMLPG] + layer * D : F.in[I_NMIXG] + layer * D);
    constexpr int HALO = (MODE == 1) ? 1 : 0;
    LAS float* xs = (LAS float*)F.lds;
    const int m = layer >> 1; const int r0s = MP + 4 * F.vcu;
    const float* gmod = (const float*)(F.ws + WS_MOD) + (size_t)player * NSEQ * 6144 + pgoff;
    if constexpr (PEND > 0) {
        __syncthreads();
#pragma unroll
        for (int q = 0; q < (4 + HALO + 1) / 2; ++q) { const int idx = tid + q * NT, rr = idx >> 8, c4 = (idx & 255) * 4; const int r = r0s - HALO + rr;
            if (rr < 4 + HALO && !(HALO && rr == 0 && ((r0s - MP) & 31) == 0)) {
                const int pn = c4 >> 8; const float* pb = (const float*)(F.ws + WS_PART) + ((size_t)((((r >> 8) - 64) * 4 + pn) * PEND) << 16) + (r & 255) * 256 + (c4 & 255);
                f32x4 acc = (f32x4){0.f, 0.f, 0.f, 0.f};
#pragma unroll
                for (int ks = 0; ks < PEND; ++ks) acc += *(const f32x4*)(pb + ((size_t)ks << 16));
                const f32x4 g4 = *(const f32x4*)(gmod + (size_t)seq_of_row(r) * 6144 + c4); f32x4 x4 = *(const f32x4*)(sx_in + (size_t)(r - MP) * D + c4);
                x4 = x4 + g4 * acc; if (sx_out != nullptr && !(HALO && rr == 0)) *(f32x4*)(sx_out + (size_t)(r - MP) * D + c4) = x4; *(LAS f32x4*)(xs + rr * 1024 + c4) = x4; } }
        __syncthreads();
    }
    for (int r = gw; r < MP; r += NGW) {
        const f32x4* xr = (const f32x4*)((FIRSTP ? F.in[I_XP] : F.out) + (size_t)r * D) + lane; f32x4 v[4], ho[4];
#pragma unroll
        for (int j = 0; j < 4; ++j) v[j] = xr[64 * j];
        if constexpr (MODE == 1) { f32x4 pv[4], hp[4];
#pragma unroll
            for (int j = 0; j < 4; ++j) pv[j] = (r > 0) ? *((const f32x4*)(F.out + (size_t)(r - 1) * D) + lane + 64 * j) : (f32x4){0.f, 0.f, 0.f, 0.f};
            norm_row<MODE>(F, layer, r, v, MOD, gvec, lane, ho);
            if (r > 0) hmix_calc(MOD, gvec, pv, lane, hp); else {
#pragma unroll
                for (int j = 0; j < 4; ++j) hp[j] = (f32x4){0.f, 0.f, 0.f, 0.f}; }
            write_mixes(F, m, r, ho, hp, lane);
        } else norm_row<MODE>(F, layer, r, v, MOD, gvec, lane, ho);
    }
    if (F.wave < 4 && 4 * F.vcu + F.wave < MS) { const int r = r0s + F.wave; f32x4 v[4], ho[4];
#pragma unroll
        for (int j = 0; j < 4; ++j) { if constexpr (PEND > 0) v[j] = *(const LAS f32x4*)(xs + (F.wave + HALO) * 1024 + 4 * lane + 256 * j); else v[j] = *((const f32x4*)(sx_in + (size_t)(r - MP) * D) + lane + 64 * j); }
        norm_row<MODE>(F, layer, r, v, MOD, gvec, lane, ho);
        if constexpr (MODE == 1) { f32x4 hp[4]; const int t = (r - MP) & 31, sq = (r - MP) >> 5;
            if (t == 0) {
#pragma unroll
                for (int j = 0; j < 4; ++j) hp[j] = *((const f32x4*)(F.in[I_SSHIFT] + ((size_t)m * 32 + sq) * D) + lane + 64 * j);
            } else { f32x4 pv[4];
#pragma unroll
                for (int j = 0; j < 4; ++j) pv[j] = *(const LAS f32x4*)(xs + (F.wave + HALO - 1) * 1024 + 4 * lane + 256 * j);
                hmix_calc(MOD + (size_t)(1 + sq) * 6144, gvec, pv, lane, hp); }
            write_mixes(F, m, r, ho, hp, lane); } }
}

template <int MT, int NTT> __device__ __forceinline__ void wave_mm_nt(f32x4 (&acc)[MT][NTT], const LAS bf16_t* X, int ldx, const LAS bf16_t* Y, int ldy, int K, int fr, int fq) {
    for (int k0 = 0; k0 < K; k0 += 32) {
        bf16x8 xa[MT], yb[NTT];
#pragma unroll
        for (int i = 0; i < MT; ++i) xa[i] = *(const LAS bf16x8*)(X + (16 * i + fr) * ldx + k0 + 8 * fq);
#pragma unroll
        for (int j = 0; j < NTT; ++j) yb[j] = *(const LAS bf16x8*)(Y + (16 * j + fr) * ldy + k0 + 8 * fq);
#pragma unroll
        for (int i = 0; i < MT; ++i)
#pragma unroll
            for (int j = 0; j < NTT; ++j) acc[i][j] = __builtin_amdgcn_mfma_f32_16x16x32_bf16(yb[j], xa[i], acc[i][j], 0, 0, 0);
    }
}

constexpr int LQS = 0, LKS = 18432, LQG = 36864, LVT = 55296, LST = 73728, LPS = 108544, LRED = 117760, LBS = 118784;
__device__ __forceinline__ void chunk_geom(int c, int& r0, int& pos0) { if (c < 256) { r0 = 64 * c; pos0 = 64 * c; } else { r0 = MP + 32 * (c - 256); pos0 = 2048; } }

template <int L, bool HG, bool SUMMARY> __device__ __forceinline__ void ab_load(Frame& F, int layer, int c, int h) {
    const int tid = otid(); const int lane = tid & 63; (void)lane;
    const int m = layer >> 1; int r0, pos0; chunk_geom(c, r0, pos0);
    const bf16_t* Z = (const bf16_t*)(F.ws + WS_Z);
    LAS bf16_t* QS = (LAS bf16_t*)(F.lds + LQS); LAS bf16_t* KS = (LAS bf16_t*)(F.lds + LKS); LAS bf16_t* QG = (LAS bf16_t*)(F.lds + LQG); LAS bf16_t* VT = (LAS bf16_t*)(F.lds + LVT);
    constexpr int LDT = L + 8;
    if constexpr (HG) {
        constexpr int TQ = L / 4; LAS float* BS = (LAS float*)(F.lds + LBS);
        const int ch = tid & 127, qtr = tid >> 7;
        float lb = 0.f;
        if (m == 1) { const float a0 = F.in[I_HGLB][h * 128 + ch], a1 = F.in[I_HGLB][512 + h * 128 + ch]; lb = 1.f / (1.f + __expf(a0 - a1)); }
        { constexpr int NP = L * 16;
#pragma unroll
          for (int q = 0; q < (NP + NT - 1) / NT; ++q) { const int v = tid + q * NT; if (NP % NT == 0 || v < NP) { const int j = v >> 4, c8 = v & 15; const size_t zr = (size_t)(r0 + j) * ABIN + h * 128 + c8 * 8;
                  const u32x4 zf4 = *(const u32x4*)(Z + zr + 2048), v4 = *(const u32x4*)(Z + zr + 2560);
                  *(LAS u32x4*)(QG + j * 136 + c8 * 8) = zf4; *(LAS u32x4*)(KS + j * 136 + c8 * 8) = v4;
                  if constexpr (!SUMMARY) { const u32x4 q4 = *(const u32x4*)(Z + zr + 1536); *(LAS u32x4*)(QS + j * 136 + c8 * 8) = q4; } } } }
        __syncthreads();
        float zf[TQ], cs[TQ]; float run = 0.f;
#pragma unroll
        for (int jj = 0; jj < TQ; ++jj) { const int j = qtr * TQ + jj; zf[jj] = bf2f(QG[j * 136 + ch]);
            float lf; if (lb == 0.f) lf = fminf(zf[jj], 0.f) - __logf(1.f + __expf(-fabsf(zf[jj]))); else lf = __logf(lb + (1.f - lb) * sigmoidf_(zf[jj]));
            run += lf; cs[jj] = run; }
        BS[qtr * 128 + ch] = run;
        __syncthreads();
        const float b0 = BS[ch], b1 = BS[128 + ch], b2 = BS[256 + ch], b3 = BS[384 + ch];
        const float off = (qtr > 0 ? b0 : 0.f) + (qtr > 1 ? b1 : 0.f) + (qtr > 2 ? b2 : 0.f), bL = (b0 + b1) + (b2 + b3), bmid = b0 + b1;
        if constexpr (SUMMARY) {
#pragma unroll
            for (int j8 = 0; j8 < TQ; j8 += 8) { unsigned vv[8]; float kd[8];
#pragma unroll
                for (int q = 0; q < 8; ++q) { const int jj = j8 + q, j = qtr * TQ + jj; const float b = off + cs[jj]; const float kb = (1.f - lb) * sigmoidf_(-zf[jj]); vv[q] = KS[j * 136 + ch]; kd[q] = kb * __expf(bL - b); }
                u32x4 pv, pk; pv.x = vv[0] | (vv[1] << 16); pv.y = vv[2] | (vv[3] << 16); pv.z = vv[4] | (vv[5] << 16); pv.w = vv[6] | (vv[7] << 16);
                pk.x = pk2(kd[0], kd[1]); pk.y = pk2(kd[2], kd[3]); pk.z = pk2(kd[4], kd[5]); pk.w = pk2(kd[6], kd[7]);
                *(LAS u32x4*)(VT + ch * LDT + qtr * TQ + j8) = pv; *(LAS u32x4*)(QS + ch * LDT + qtr * TQ + j8) = pk; }
            if (qtr == 0) ((float*)(F.ws + WS_DEC))[((size_t)c * 4 + h) * 128 + ch] = __expf(bL);
        } else {
#pragma unroll
            for (int j8 = 0; j8 < TQ; j8 += 8) { unsigned vv[8];
#pragma unroll
                for (int q8 = 0; q8 < 8; ++q8) { const int jj = j8 + q8, j = qtr * TQ + jj; const float b = off + cs[jj]; const float kb = (1.f - lb) * sigmoidf_(-zf[jj]);
                    const float q = siluf_(bf2f(QS[j * 136 + ch])); vv[q8] = KS[j * 136 + ch];
                    QS[j * 136 + ch] = (bf16_t)f2bf(q * __expf(b - bmid)); KS[j * 136 + ch] = (bf16_t)f2bf(kb * __expf(bmid - b)); QG[j * 136 + ch] = (bf16_t)f2bf(q * __expf(b)); }
                u32x4 pv; pv.x = vv[0] | (vv[1] << 16); pv.y = vv[2] | (vv[3] << 16); pv.z = vv[4] | (vv[5] << 16); pv.w = vv[6] | (vv[7] << 16);
                *(LAS u32x4*)(VT + ch * LDT + qtr * TQ + j8) = pv; }
        }
    } else {
        const float logg = log1pf(-exp2f(-5.f - (float)h));
        const f32x2* rope = (const f32x2*)(F.ws + WS_ROPE);
        for (int it = tid; it < L * 4; it += NT) { const int j = it >> 2, d8 = it & 3; const size_t zr = (size_t)(r0 + j) * ABIN;
            const f32x2* rp = rope + (size_t)(pos0 + j) * 32 + d8 * 8;
            const u32x4 k1 = *(const u32x4*)(Z + zr + 256 + h * 64 + d8 * 8), k2 = *(const u32x4*)(Z + zr + 256 + h * 64 + 32 + d8 * 8);
            const float gk = __expf((float)(L - 1 - j) * logg), gq = __expf((float)(j + 1) * logg);
            u32x4 q1 = (u32x4){0, 0, 0, 0}, q2 = q1; if constexpr (!SUMMARY) { q1 = *(const u32x4*)(Z + zr + h * 64 + d8 * 8); q2 = *(const u32x4*)(Z + zr + h * 64 + 32 + d8 * 8); }
#pragma unroll
            for (int e = 0; e < 8; ++e) { const f32x2 cs_ = rp[e]; const unsigned wk1 = k1[e >> 1], wk2 = k2[e >> 1]; const float x1 = (e & 1) ? bfhi(wk1) : bflo(wk1), x2 = (e & 1) ? bfhi(wk2) : bflo(wk2);
                const float o1 = x1 * cs_.x - x2 * cs_.y, o2 = x1 * cs_.y + x2 * cs_.x; const int d = d8 * 8 + e;
                if constexpr (SUMMARY) { QS[d * LDT + j] = (bf16_t)f2bf(o1 * gk); QS[(d + 32) * LDT + j] = (bf16_t)f2bf(o2 * gk); }
                else { KS[j * 72 + d] = (bf16_t)f2bf(o1); KS[j * 72 + d + 32] = (bf16_t)f2bf(o2);
                    const unsigned wq1 = q1[e >> 1], wq2 = q2[e >> 1]; const float y1 = (e & 1) ? bfhi(wq1) : bflo(wq1), y2 = (e & 1) ? bfhi(wq2) : bflo(wq2);
                    const float p1 = (y1 * cs_.x - y2 * cs_.y) * 0.125f, p2 = (y1 * cs_.y + y2 * cs_.x) * 0.125f;
                    QS[j * 72 + d] = (bf16_t)f2bf(p1); QS[j * 72 + d + 32] = (bf16_t)f2bf(p2); QG[j * 72 + d] = (bf16_t)f2bf(p1 * gq); QG[j * 72 + d + 32] = (bf16_t)f2bf(p2 * gq); } } }
        for (int it = tid; it < L * 16; it += NT) { const int j = it >> 4, e8 = it & 15; const u32x4 vv = *(const u32x4*)(Z + (size_t)(r0 + j) * ABIN + 512 + h * 128 + e8 * 8);
#pragma unroll
            for (int e = 0; e < 8; ++e) { const unsigned w = vv[e >> 1]; VT[(e8 * 8 + e) * LDT + j] = (bf16_t)((e & 1) ? (w >> 16) : (w & 0xffffu)); } }
    }
}

template <int L, bool HG> __device__ __forceinline__ void ab_summary_unit(Frame& F, int layer, int c, int h) {
    const int tid = otid(); const int lane = tid & 63; (void)lane;
    constexpr int DK = HG ? 128 : 64, NCT = DK / 16, LDT = L + 8;
    __syncthreads();
    ab_load<L, HG, true>(F, layer, c, h);
    __syncthreads();
    const int fr = lane & 15, fq = lane >> 4;
    const LAS bf16_t* KDT = (const LAS bf16_t*)(F.lds + LQS); const LAS bf16_t* VT = (const LAS bf16_t*)(F.lds + LVT);
    f32x4 acc[1][NCT];
#pragma unroll
    for (int j = 0; j < NCT; ++j) acc[0][j] = (f32x4){0.f, 0.f, 0.f, 0.f};
    wave_mm_nt<1, NCT>(acc, VT + F.wave * 16 * LDT, LDT, KDT, LDT, L, fr, fq);
    bf16_t* ST = (bf16_t*)(F.ws + WS_STATE) + (size_t)c * SLOT_E + (HG ? 32768 + h * 16384 : h * 8192);
    const int e = F.wave * 16 + fr;
#pragma unroll
    for (int j = 0; j < NCT; ++j) { u32x2 w; w.x = pk2(acc[0][j][0], acc[0][j][1]); w.y = pk2(acc[0][j][2], acc[0][j][3]); *(u32x2*)(ST + (size_t)e * DK + 16 * j + 4 * fq) = w; }
}

template <int L, bool HG> __device__ __forceinline__ void ab_output_unit(Frame& F, int layer, int c, int h) {
    const int tid = otid(); const int lane = tid & 63; (void)lane;
    constexpr int DK = HG ? 128 : 64, LDQ = HG ? 136 : 72, LDT = L + 8, NIT = L / 16, WPI = 8 / NIT, ET = 8 / WPI, TPW = (NIT * NIT >= 8) ? NIT * NIT / 8 : 1;
    const int m = layer >> 1; int r0, pos0; chunk_geom(c, r0, pos0);
    __syncthreads();
    ab_load<L, HG, false>(F, layer, c, h);
    LAS bf16_t* QS = (LAS bf16_t*)(F.lds + LQS); LAS bf16_t* KS = (LAS bf16_t*)(F.lds + LKS); LAS bf16_t* QG = (LAS bf16_t*)(F.lds + LQG); LAS bf16_t* VT = (LAS bf16_t*)(F.lds + LVT);
    LAS bf16_t* STl = (LAS bf16_t*)(F.lds + LST); LAS bf16_t* PS = (LAS bf16_t*)(F.lds + LPS); LAS float* RED = (LAS float*)(F.lds + LRED);
    { const bf16_t* ST = (const bf16_t*)(F.ws + WS_STATE) + (size_t)c * SLOT_E + (HG ? 32768 + h * 16384 : h * 8192);
      for (int it = tid; it < 128 * DK / 8; it += NT) { const int e = it / (DK / 8), c8 = it % (DK / 8); *(LAS u32x4*)(STl + e * LDQ + c8 * 8) = *(const u32x4*)(ST + (size_t)e * DK + c8 * 8); } }
    __syncthreads();
    const int fr = lane & 15, fq = lane >> 4, w = F.wave;
    const float logg = HG ? 0.f : log1pf(-exp2f(-5.f - (float)h));
    if (w * TPW < NIT * NIT) {
        const int it = (w * TPW) / NIT, jt0 = (w * TPW) % NIT;
        f32x4 sc[1][TPW];
#pragma unroll
        for (int q = 0; q < TPW; ++q) sc[0][q] = (f32x4){0.f, 0.f, 0.f, 0.f};
        wave_mm_nt<1, TPW>(sc, QS + it * 16 * LDQ, LDQ, KS + jt0 * 16 * LDQ, LDQ, DK, fr, fq);
        const int i = it * 16 + fr;
#pragma unroll
        for (int q = 0; q < TPW; ++q) { float p[4];
#pragma unroll
            for (int r = 0; r < 4; ++r) { const int j = (jt0 + q) * 16 + 4 * fq + r; float v = sc[0][q][r]; if (!HG) v *= __expf((float)(i - j) * logg); p[r] = (j <= i) ? v : 0.f; }
            u32x2 pw; pw.x = pk2(p[0], p[1]); pw.y = pk2(p[2], p[3]); *(LAS u32x2*)(PS + i * LDT + (jt0 + q) * 16 + 4 * fq) = pw; }
    }
    __syncthreads();
    const int it = w % NIT, eg = w / NIT;
    f32x4 o[1][ET];
#pragma unroll
    for (int q = 0; q < ET; ++q) o[0][q] = (f32x4){0.f, 0.f, 0.f, 0.f};
    wave_mm_nt<1, ET>(o, PS + it * 16 * LDT, LDT, VT + eg * ET * 16 * LDT, LDT, L, fr, fq);
    wave_mm_nt<1, ET>(o, QG + it * 16 * LDQ, LDQ, STl + eg * ET * 16 * LDQ, LDQ, DK, fr, fq);
    float ss = 0.f;
#pragma unroll
    for (int q = 0; q < ET; ++q) ss += (o[0][q][0] * o[0][q][0] + o[0][q][1] * o[0][q][1]) + (o[0][q][2] * o[0][q][2] + o[0][q][3] * o[0][q][3]);
    ss += __shfl_xor(ss, 16); ss += __shfl_xor(ss, 32);
    const int i = it * 16 + fr;
    if (fq == 0) RED[i * 4 + eg] = ss;
    __syncthreads();
    float tot = 0.f;
#pragma unroll
    for (int q = 0; q < WPI; ++q) tot += RED[i * 4 + q];
    const float rstd = 1.f / sqrtf(tot * (1.f / 128.f) + NORM_EPS);
    const bf16_t* Z = (const bf16_t*)(F.ws + WS_Z); bf16_t* O = (bf16_t*)(F.ws + WS_XN);
    const size_t row = (size_t)(r0 + i);
#pragma unroll
    for (int q = 0; q < ET; ++q) { const int e = (eg * ET + q) * 16 + 4 * fq; const u32x2 gw = *(const u32x2*)(Z + row * ABIN + (HG ? 3072 : 1024) + h * 128 + e);
        const float g4[4] = {bflo(gw.x), bfhi(gw.x), bflo(gw.y), bfhi(gw.y)}; float ov[4];
#pragma unroll
        for (int r = 0; r < 4; ++r) { if (HG) ov[r] = o[0][q][r] * rstd * F.in[I_HGNG][m * 128 + e + r] * sigmoidf_(g4[r]); else ov[r] = o[0][q][r] * rstd * siluf_(g4[r]); }
        u32x2 ow; ow.x = pk2(ov[0], ov[1]); ow.y = pk2(ov[2], ov[3]); *(u32x2*)(O + row * D + (HG ? 512 : 0) + h * 128 + e) = ow; }
}

template <bool DRY = false> __device__ __forceinline__ void ab_scan(Frame& F, int layer) {
    const int tid = otid(); const int lane = tid & 63; (void)lane;
    const int m = layer >> 1;
    unsigned* ST32 = (unsigned*)(F.ws + WS_STATE); const float* DEC = (const float*)(F.ws + WS_DEC);
    constexpr int NP = SLOT_E / 2;
    const int gt = F.vcu * NT + tid;
    if (gt < NP) {
        const int eo = 2 * gt; const bool hg = eo >= 32768; const int eo2 = hg ? eo - 32768 : eo; const int head = hg ? eo2 >> 14 : eo2 >> 13; const int cch = hg ? (eo2 & 127) : (eo2 & 63); const int e = hg ? ((eo2 & 16383) >> 7) : ((eo2 & 8191) >> 6);
        const float gdec = hg ? 0.f : __expf(64.f * log1pf(-exp2f(-5.f - (float)head)));
        float s0 = 0.f, s1 = 0.f;
        for (int c0 = 0; c0 < 256; c0 += 8) {
            unsigned kv[8]; float d0[8], d1[8];
#pragma unroll
            for (int u = 0; u < 8; ++u) { kv[u] = ST32[(size_t)(c0 + u) * NP + gt]; if (hg) { const f32x2 dd = *(const f32x2*)(DEC + ((size_t)(c0 + u) * 4 + head) * 128 + cch); d0[u] = dd.x; d1[u] = dd.y; } else { d0[u] = gdec; d1[u] = gdec; } }
#pragma unroll
            for (int u = 0; u < 8; ++u) { const unsigned pw = pk2(s0, s1); if constexpr (DRY) asm volatile("" :: "v"(pw)); else ST32[(size_t)(c0 + u) * NP + gt] = pw; s0 = d0[u] * s0 + bflo(kv[u]); s1 = d1[u] * s1 + bfhi(kv[u]); }
        }
        float* outp = hg ? F.out + O_HGP + (size_t)m * 65536 + head * 16384 : F.out + O_RETP + (size_t)m * 32768 + head * 8192;
        outp[(size_t)cch * 128 + e] = s0; outp[(size_t)(cch + 1) * 128 + e] = s1;
    } else {
        const int NG2 = F.G * NT - NP; if (NG2 <= 0) return;
        for (int idx = gt - NP; idx < 32 * NP; idx += NG2) { const int b = idx / NP, pr = idx % NP;
            const int eo = 2 * pr; const bool hg = eo >= 32768; const int eo2 = hg ? eo - 32768 : eo; const int head = hg ? eo2 >> 14 : eo2 >> 13; const int cch = hg ? (eo2 & 127) : (eo2 & 63); const int e = hg ? ((eo2 & 16383) >> 7) : ((eo2 & 8191) >> 6);
            float d0, d1; if (hg) { const f32x2 dd = *(const f32x2*)(DEC + ((size_t)(256 + b) * 4 + head) * 128 + cch); d0 = dd.x; d1 = dd.y; } else { d0 = d1 = __expf(32.f * log1pf(-exp2f(-5.f - (float)head))); }
            const size_t so = hg ? ((size_t)(m * 32 + b) * 4 + head) * 16384 : ((size_t)(m * 32 + b) * 4 + head) * 8192;
            const float* sin_ = (hg ? F.in[I_SHG] : F.in[I_SRET]) + so; float* sout = F.out + (hg ? O_HGS : O_RETS) + so;
            const float i0 = sin_[(size_t)cch * 128 + e], i1 = sin_[(size_t)(cch + 1) * 128 + e];
            const unsigned kv = ST32[(size_t)(256 + b) * NP + pr]; if constexpr (!DRY) ST32[(size_t)(256 + b) * NP + pr] = pk2(i0, i1);
            sout[(size_t)cch * 128 + e] = d0 * i0 + bflo(kv); sout[(size_t)(cch + 1) * 128 + e] = d1 * i1 + bfhi(kv); }
    }
}

constexpr int RL_AT = 0, RL_RT = 9216, RL_BT = 18432, RL_KT = 27648, RL_BHT = 36864, RL_KHT = 46080, RL_VT = 55296, RL_AAB = 64512, RL_AAK = 81920, RL_ARB = 91136, RL_ARK = 100352,
              RL_U0T = 109568, RL_VEC = 118784, RL_PSUM = 119808;
constexpr int RL_G = RL_AAB, RL_WW = RL_BT, RL_APT = RL_AAK;
constexpr int RL_PL = RL_AT, RL_RL = RL_BT, RL_Y0L = RL_BT + 4608, RL_QTL = RL_AAB, RL_S = RL_BHT;
__device__ __forceinline__ int pperm(int k) { return 32 * (k >> 5) + 8 * ((k >> 2) & 3) + 4 * ((k >> 4) & 1) + (k & 3); }

struct OutSide { u32x2 vv[4], gg[4]; f32x4 lg[4], lb[4]; float bon; };
__device__ __forceinline__ void rwkv_out_side(Frame& F, int m, size_t row, int h, int fq, OutSide& o) {
    const bf16_t* RKV = (const bf16_t*)(F.ws + WS_RKV); const bf16_t* GG = (const bf16_t*)(F.ws + WS_G); const float* BON = (const float*)(F.ws + WS_BON);
    o.bon = BON[row * 16 + h];
#pragma unroll
    for (int nt = 0; nt < 4; ++nt) { const int i = h * 64 + 16 * nt + 4 * fq;
        o.lg[nt] = *(const f32x4*)(F.in[I_RLNG] + m * D + i); o.lb[nt] = *(const f32x4*)(F.in[I_RLNB] + m * D + i);
        o.vv[nt] = *(const u32x2*)(RKV + row * 3072 + 2048 + i); o.gg[nt] = *(const u32x2*)(GG + row * D + i); }
}
template <bool DRY = false> __device__ __forceinline__ void rwkv_out_core(Frame& F, const f32x4 (&y)[4], size_t row, int h, int fq, const OutSide& sd) {
    bf16_t* RKV = (bf16_t*)(F.ws + WS_RKV);
    float s1 = 0.f;
#pragma unroll
    for (int nt = 0; nt < 4; ++nt) s1 += (y[nt][0] + y[nt][1]) + (y[nt][2] + y[nt][3]);
    s1 += __shfl_xor(s1, 16); s1 += __shfl_xor(s1, 32);
    const float mean = s1 * (1.f / 64.f); float s2 = 0.f;
#pragma unroll
    for (int nt = 0; nt < 4; ++nt)
#pragma unroll
        for (int r = 0; r < 4; ++r) { const float d = y[nt][r] - mean; s2 += d * d; }
    s2 += __shfl_xor(s2, 16); s2 += __shfl_xor(s2, 32);
    const float rstd = 1.f / sqrtf(s2 * (1.f / 64.f) + RW_LN_EPS), bon = sd.bon;
#pragma unroll
    for (int nt = 0; nt < 4; ++nt) { const int i = h * 64 + 16 * nt + 4 * fq; const f32x4 lg = sd.lg[nt], lb = sd.lb[nt]; const u32x2 vv = sd.vv[nt], gg = sd.gg[nt];
        const float v4[4] = {bflo(vv.x), bfhi(vv.x), bflo(vv.y), bfhi(vv.y)}, g4[4] = {bflo(gg.x), bfhi(gg.x), bflo(gg.y), bfhi(gg.y)}; float o[4];
#pragma unroll
        for (int r = 0; r < 4; ++r) o[r] = ((y[nt][r] - mean) * rstd * lg[r] + lb[r] + bon * v4[r]) * g4[r];
        u32x2 w; w.x = pk2(o[0], o[1]); w.y = pk2(o[2], o[3]); if constexpr (DRY) asm volatile("" :: "v"(w.x), "v"(w.y)); else *(u32x2*)(RKV + row * 3072 + i) = w; }
}
template <bool DRY = false> __device__ __forceinline__ void rwkv_out_epilogue(Frame& F, int m, const f32x4 (&y)[4], size_t row, int h, int fq) {
    OutSide sd; rwkv_out_side(F, m, row, h, fq, sd); rwkv_out_core<DRY>(F, y, row, h, fq, sd);
}

template <int S, int L> struct SubstQ {
    static constexpr int RQ = L / 4, NV4 = RQ / 4;
    static __device__ __forceinline__ void run(float (&x)[RQ], f32x4 (&aq)[3][NV4], const LAS float* ap) {
        if constexpr (S < L - 1) {
            if constexpr (S + 2 < L - 1) {
#pragma unroll
                for (int k = 0; k < NV4; ++k) aq[(S + 2) % 3][k] = *(const LAS f32x4*)(ap + (S + 2) * 68 + 4 * k);
            }
            constexpr int own = S / RQ, ctrl = own * 0x55;
            const float xs = __builtin_bit_cast(float, __builtin_amdgcn_update_dpp(0, __builtin_bit_cast(int, x[S % RQ]), ctrl, 0xf, 0xf, false));
#pragma unroll
            for (int k = 0; k < NV4; ++k) { x[4 * k] += aq[S % 3][k][0] * xs; x[4 * k + 1] += aq[S % 3][k][1] * xs; x[4 * k + 2] += aq[S % 3][k][2] * xs; x[4 * k + 3] += aq[S % 3][k][3] * xs;
                asm volatile("" : "+v"(x[4 * k]), "+v"(x[4 * k + 1]), "+v"(x[4 * k + 2]), "+v"(x[4 * k + 3])); }
            asm volatile("" ::: "memory");
            SubstQ<S + 1, L>::run(x, aq, ap);
        }
    }
};
struct RawRegs { u32x4 r, k, v, w, a; };
__device__ __forceinline__ void rwkv_load_raw(Frame& F, int u, int tid, RawRegs& raw) {
    const int c = u >> 4, h = u & 15; int r0, pos0; chunk_geom(c, r0, pos0); const int L = c < 256 ? 64 : 32; int t = tid >> 3; t = t < L ? t : 0;
    const bf16_t* RKV = (const bf16_t*)(F.ws + WS_RKV); const bf16_t* WLOG = (const bf16_t*)(F.ws + WS_WLOG); const bf16_t* AA = (const bf16_t*)(F.ws + WS_XN);
    const size_t row = (size_t)(r0 + t); const int col = h * 64 + 8 * (tid & 7);
    raw.r = *(const u32x4*)(RKV + row * 3072 + col); raw.k = *(const u32x4*)(RKV + row * 3072 + 1024 + col); raw.v = *(const u32x4*)(RKV + row * 3072 + 2048 + col);
    raw.w = *(const u32x4*)(WLOG + row * D + col); raw.a = *(const u32x4*)(AA + row * D + col);
}
template <int L, bool DRY = false> __device__ __forceinline__ void rwkv_local_unit(Frame& F, int layer, int c, int h, RawRegs& raw, int unext) {
    const int tid = otid(); const int lane = tid & 63, fr = lane & 15, fq = lane >> 4, w = F.wave;
    constexpr int NIT = L / 16; constexpr bool SAMPLE = (L == 32);
    const int m = layer >> 1; int r0, pos0; chunk_geom(c, r0, pos0);
    bf16_t* RKV = (bf16_t*)(F.ws + WS_RKV); const bf16_t* WLOG = (const bf16_t*)(F.ws + WS_WLOG); const bf16_t* AA = (const bf16_t*)(F.ws + WS_XN);
    LAS bf16_t* AT = (LAS bf16_t*)(F.lds + RL_AT); LAS bf16_t* RT = (LAS bf16_t*)(F.lds + RL_RT); LAS bf16_t* BT = (LAS bf16_t*)(F.lds + RL_BT); LAS bf16_t* KT = (LAS bf16_t*)(F.lds + RL_KT);
    LAS bf16_t* BHT = (LAS bf16_t*)(F.lds + RL_BHT); LAS bf16_t* KHT = (LAS bf16_t*)(F.lds + RL_KHT); LAS bf16_t* VT = (LAS bf16_t*)(F.lds + RL_VT);
    LAS float* AAB = (LAS float*)(F.lds + RL_AAB); LAS bf16_t* AAK = (LAS bf16_t*)(F.lds + RL_AAK); LAS bf16_t* ARB = (LAS bf16_t*)(F.lds + RL_ARB); LAS bf16_t* ARK = (LAS bf16_t*)(F.lds + RL_ARK);
    LAS bf16_t* U0T = (LAS bf16_t*)(F.lds + RL_U0T); LAS float* GMID = (LAS float*)(F.lds + RL_VEC); LAS float* GLV = GMID + 64; LAS float* EGM = GMID + 128; LAS float* PSUM = (LAS float*)(F.lds + RL_PSUM);
    LAS float* G = (LAS float*)(F.lds + RL_G); LAS float* WW = (LAS float*)(F.lds + RL_WW); LAS bf16_t* APT = (LAS bf16_t*)(F.lds + RL_APT);
    __syncthreads();
    const int t = tid >> 3, c8 = tid & 7; const bool act = t < L;
    float rr[8], kkv[8], bb[8], kh[8], vv[8];
    if (act) { const size_t row = (size_t)(r0 + t); const int col = h * 64 + 8 * c8;
        const u32x4 r4 = raw.r, k4 = raw.k, v4 = raw.v, w4 = raw.w, a4 = raw.a;
        const float* kkp = F.in[I_RKK] + m * D + col; const float* kap = F.in[I_RKA] + m * D + col; const float* rkp = F.in[I_RRK] + m * D + col;
        float ss = 0.f, bon = 0.f;
#pragma unroll
        for (int e = 0; e < 8; ++e) { const float kx = (e & 1) ? bfhi(k4[e >> 1]) : bflo(k4[e >> 1]), al = (e & 1) ? bfhi(a4[e >> 1]) : bflo(a4[e >> 1]);
            rr[e] = (e & 1) ? bfhi(r4[e >> 1]) : bflo(r4[e >> 1]); vv[e] = (e & 1) ? bfhi(v4[e >> 1]) : bflo(v4[e >> 1]);
            kkv[e] = kx * kkp[e]; ss += kkv[e] * kkv[e]; kh[e] = kx * (1.f + (al - 1.f) * kap[e]); bb[e] = al; bon += rr[e] * kh[e] * rkp[e];
            G[t * 64 + 8 * c8 + e] = (e & 1) ? bfhi(w4[e >> 1]) : bflo(w4[e >> 1]); }
        ss += __shfl_xor(ss, 1); ss += __shfl_xor(ss, 2); ss += __shfl_xor(ss, 4); bon += __shfl_xor(bon, 1); bon += __shfl_xor(bon, 2); bon += __shfl_xor(bon, 4);
        const float inv = 1.f / fmaxf(sqrtf(ss), 1e-12f);
#pragma unroll
        for (int e = 0; e < 8; ++e) { kkv[e] *= inv; bb[e] *= kkv[e]; }
        if (c8 == 0) ((float*)(F.ws + WS_BON))[row * 16 + h] = bon; }
    if (unext >= 0) rwkv_load_raw(F, unext, tid, raw);
    __syncthreads();
    { constexpr int TE = L / 8; const int j = tid & 63, e8 = tid >> 6; float cs[TE]; float run = 0.f;
#pragma unroll
      for (int q = 0; q < TE; ++q) { run += G[(e8 * TE + q) * 64 + j]; cs[q] = run; }
      PSUM[e8 * 64 + j] = run;
      __syncthreads();
      float off = 0.f, gm = 0.f, gl = 0.f;
#pragma unroll
      for (int q = 0; q < 8; ++q) { const float p = PSUM[q * 64 + j]; if (q < e8) off += p; if (q < 4) gm += p; gl += p; }
#pragma unroll
      for (int q = 0; q < TE; ++q) G[(e8 * TE + q) * 64 + j] = off + cs[q];
      if (e8 == 0) { GMID[j] = gm; GLV[j] = gl; EGM[j] = __expf(gm); if (!SAMPLE) ((float*)(F.ws + WS_REC + ((size_t)h * 256 + c) * REC_B + 16384))[j] = __expf(gl); } }
    __syncthreads();
    if (act) { float fa[8], fr_[8], fb[8], fk[8];
#pragma unroll
        for (int e = 0; e < 8; ++e) { const int j = 8 * c8 + e; const float g = G[t * 64 + j], gp = (t > 0) ? G[(t - 1) * 64 + j] : 0.f, gm = GMID[j], gl = GLV[j];
            const float ed = __expf(gm - g), eu = __expf(g - gm), el = __expf(gl - g);
            fa[e] = -kkv[e] * __expf(gp - gm); fr_[e] = rr[e] * eu; fb[e] = bb[e] * ed; fk[e] = kh[e] * ed;
            if constexpr (!(DRY && (LOCAL_SKIP & 4))) { BHT[j * 72 + t] = (bf16_t)f2bf(bb[e] * el); KHT[j * 72 + t] = (bf16_t)f2bf(kh[e] * el); VT[j * 72 + t] = (bf16_t)f2bf(vv[e]); } }
        u32x4 p;
        p.x = pk2(fa[0], fa[1]); p.y = pk2(fa[2], fa[3]); p.z = pk2(fa[4], fa[5]); p.w = pk2(fa[6], fa[7]); *(LAS u32x4*)(AT + t * 72 + 8 * c8) = p;
        p.x = pk2(fr_[0], fr_[1]); p.y = pk2(fr_[2], fr_[3]); p.z = pk2(fr_[4], fr_[5]); p.w = pk2(fr_[6], fr_[7]); *(LAS u32x4*)(RT + t * 72 + 8 * c8) = p;
        p.x = pk2(fb[0], fb[1]); p.y = pk2(fb[2], fb[3]); p.z = pk2(fb[4], fb[5]); p.w = pk2(fb[6], fb[7]); *(LAS u32x4*)(BT + t * 72 + 8 * c8) = p;
        p.x = pk2(fk[0], fk[1]); p.y = pk2(fk[2], fk[3]); p.z = pk2(fk[4], fk[5]); p.w = pk2(fk[6], fk[7]); *(LAS u32x4*)(KT + t * 72 + 8 * c8) = p; }
    __syncthreads();
    if constexpr (DRY && (LOCAL_SKIP & 2)) return;
    { constexpr int TPW = (NIT * NIT >= 8) ? NIT * NIT / 8 : 1;
      if (w * TPW < NIT * NIT) { const int it = (w * TPW) / NIT, jt0 = (w * TPW) % NIT;
          f32x4 ab[1][TPW], ak[1][TPW], rb[1][TPW], rk[1][TPW];
#pragma unroll
          for (int q = 0; q < TPW; ++q) { ab[0][q] = (f32x4){0.f, 0.f, 0.f, 0.f}; ak[0][q] = ab[0][q]; rb[0][q] = ab[0][q]; rk[0][q] = ab[0][q]; }
          wave_mm_nt<1, TPW>(ab, AT + it * 16 * 72, 72, BT + jt0 * 16 * 72, 72, 64, fr, fq); wave_mm_nt<1, TPW>(ak, AT + it * 16 * 72, 72, KT + jt0 * 16 * 72, 72, 64, fr, fq);
          wave_mm_nt<1, TPW>(rb, RT + it * 16 * 72, 72, BT + jt0 * 16 * 72, 72, 64, fr, fq); wave_mm_nt<1, TPW>(rk, RT + it * 16 * 72, 72, KT + jt0 * 16 * 72, 72, 64, fr, fq);
          const int tt = it * 16 + fr;
#pragma unroll
          for (int q = 0; q < TPW; ++q) { const int s0 = (jt0 + q) * 16 + 4 * fq; f32x4 fab; float fak[4], frb[4], frk[4];
#pragma unroll
              for (int r = 0; r < 4; ++r) { const int sx = s0 + r; fab[r] = (sx < tt) ? ab[0][q][r] : 0.f; fak[r] = (sx < tt) ? ak[0][q][r] : 0.f; frb[r] = (sx <= tt) ? rb[0][q][r] : 0.f; frk[r] = (sx <= tt) ? rk[0][q][r] : 0.f; }
#pragma unroll
              for (int r = 0; r < 4; ++r) AAB[(s0 + r) * 68 + tt] = fab[r];
              u32x2 p; p.x = pk2(fak[0], fak[1]); p.y = pk2(fak[2], fak[3]); *(LAS u32x2*)(AAK + tt * 72 + s0) = p;
              p.x = pk2(frb[0], frb[1]); p.y = pk2(frb[2], frb[3]); *(LAS u32x2*)(ARB + tt * 72 + s0) = p;
              p.x = pk2(frk[0], frk[1]); p.y = pk2(frk[2], frk[3]); *(LAS u32x2*)(ARK + tt * 72 + s0) = p; } } }
    __syncthreads();
    { constexpr int TP3 = NIT / 2; const int it = (w * TP3) / 4, nt0 = (w * TP3) % 4;
      f32x4 ww[1][TP3];
#pragma unroll
      for (int q = 0; q < TP3; ++q) ww[0][q] = (f32x4){0.f, 0.f, 0.f, 0.f};
      wave_mm_nt<1, TP3>(ww, AAK + it * 16 * 72, 72, VT + nt0 * 16 * 72, 72, L, fr, fq);
#pragma unroll
      for (int q = 0; q < TP3; ++q) *(LAS f32x4*)(WW + (it * 16 + fr) * 68 + (nt0 + q) * 16 + 4 * fq) = ww[0][q]; }
    __syncthreads();
    { constexpr int RQ = L / 4, NV4 = RQ / 4; const int col = tid >> 2, qd = tid & 3, cidx = col & 63; const bool isA = col < 64; const float eg = EGM[cidx];
      float x[RQ]; f32x4 aq[3][NV4];
#pragma unroll
      for (int i = 0; i < RQ; ++i) { const int tt = qd * RQ + i; x[i] = isA ? bf2f(AT[tt * 72 + cidx]) * eg : WW[tt * 68 + cidx]; }
      const LAS float* ap = AAB + qd * RQ;
#pragma unroll
      for (int k = 0; k < NV4; ++k) { aq[0][k] = *(const LAS f32x4*)(ap + 4 * k); aq[1][k] = *(const LAS f32x4*)(ap + 68 + 4 * k); }
      if constexpr (!(DRY && (LOCAL_SKIP & 1))) SubstQ<0, L>::run(x, aq, ap);
      LAS bf16_t* dst = (isA ? APT : U0T) + cidx * 72 + qd * RQ;
#pragma unroll
      for (int t8 = 0; t8 < RQ; t8 += 8) { u32x4 p; p.x = pk2(x[t8], x[t8 + 1]); p.y = pk2(x[t8 + 2], x[t8 + 3]); p.z = pk2(x[t8 + 4], x[t8 + 5]); p.w = pk2(x[t8 + 6], x[t8 + 7]); *(LAS u32x4*)(dst + t8) = p; } }
    __syncthreads();
    { const int mt = w >> 1, nt0 = (w & 1) * 2;
      f32x4 pp[1][2], qt[1][2];
#pragma unroll
      for (int q = 0; q < 2; ++q) { pp[0][q] = (f32x4){0.f, 0.f, 0.f, 0.f}; qt[0][q] = pp[0][q]; }
      wave_mm_nt<1, 2>(pp, BHT + mt * 16 * 72, 72, APT + nt0 * 16 * 72, 72, L, fr, fq);
      wave_mm_nt<1, 2>(qt, U0T + mt * 16 * 72, 72, BHT + nt0 * 16 * 72, 72, L, fr, fq); wave_mm_nt<1, 2>(qt, VT + mt * 16 * 72, 72, KHT + nt0 * 16 * 72, 72, L, fr, fq);
      constexpr int TP5 = NIT / 2; const int it = (w * TP5) / 4, rn0 = (w * TP5) % 4;
      f32x4 rp[1][TP5], y0[1][TP5];
#pragma unroll
      for (int q = 0; q < TP5; ++q) { const int j = (rn0 + q) * 16 + 4 * fq; const u32x2 rw = *(const LAS u32x2*)(RT + (it * 16 + fr) * 72 + j); const f32x4 e4 = *(const LAS f32x4*)(EGM + j);
          rp[0][q] = (f32x4){bflo(rw.x) * e4[0], bfhi(rw.x) * e4[1], bflo(rw.y) * e4[2], bfhi(rw.y) * e4[3]}; y0[0][q] = (f32x4){0.f, 0.f, 0.f, 0.f}; }
      wave_mm_nt<1, TP5>(rp, ARB + it * 16 * 72, 72, APT + rn0 * 16 * 72, 72, L, fr, fq);
      wave_mm_nt<1, TP5>(y0, ARB + it * 16 * 72, 72, U0T + rn0 * 16 * 72, 72, L, fr, fq); wave_mm_nt<1, TP5>(y0, ARK + it * 16 * 72, 72, VT + rn0 * 16 * 72, 72, L, fr, fq);
      if constexpr (!SAMPLE) {
          bf16_t* PP = (bf16_t*)(F.ws + WS_REC + ((size_t)h * 256 + c) * REC_B); bf16_t* QQ = PP + 4096;
#pragma unroll
          for (int q = 0; q < 2; ++q) { const int n0 = (nt0 + q) * 16 + 4 * fq; u32x2 p; p.x = pk2(pp[0][q][0], pp[0][q][1]); p.y = pk2(pp[0][q][2], pp[0][q][3]);
              *(u32x2*)(PP + (mt * 16 + fr) * 64 + pperm(n0)) = p;
              p.x = pk2(qt[0][q][0], qt[0][q][1]); p.y = pk2(qt[0][q][2], qt[0][q][3]); *(u32x2*)(QQ + (mt * 16 + fr) * 64 + n0) = p; }
#pragma unroll
          for (int q = 0; q < TP5; ++q) { const size_t row = (size_t)(r0 + it * 16 + fr); const int n0 = (rn0 + q) * 16 + 4 * fq; u32x2 p;
              p.x = pk2(rp[0][q][0], rp[0][q][1]); p.y = pk2(rp[0][q][2], rp[0][q][3]); if constexpr (DRY) asm volatile("" :: "v"(p.x), "v"(p.y)); else *(u32x2*)(RKV + row * 3072 + 1024 + h * 64 + n0) = p;
              p.x = pk2(y0[0][q][0], y0[0][q][1]); p.y = pk2(y0[0][q][2], y0[0][q][3]); if constexpr (DRY) asm volatile("" :: "v"(p.x), "v"(p.y)); else *(u32x2*)(RKV + row * 3072 + h * 64 + n0) = p; }
      } else {
          __syncthreads();
          LAS bf16_t* PL = (LAS bf16_t*)(F.lds + RL_PL); LAS bf16_t* RLs = (LAS bf16_t*)(F.lds + RL_RL); LAS float* Y0L = (LAS float*)(F.lds + RL_Y0L); LAS float* QTL = (LAS float*)(F.lds + RL_QTL); LAS bf16_t* Sl = (LAS bf16_t*)(F.lds + RL_S);
#pragma unroll
          for (int q = 0; q < 2; ++q) { const int n0 = (nt0 + q) * 16 + 4 * fq; u32x2 p; p.x = pk2(pp[0][q][0], pp[0][q][1]); p.y = pk2(pp[0][q][2], pp[0][q][3]);
              *(LAS u32x2*)(PL + (mt * 16 + fr) * 72 + n0) = p; *(LAS f32x4*)(QTL + (mt * 16 + fr) * 68 + n0) = qt[0][q]; }
#pragma unroll
          for (int q = 0; q < TP5; ++q) { const int n0 = (rn0 + q) * 16 + 4 * fq; u32x2 p; p.x = pk2(rp[0][q][0], rp[0][q][1]); p.y = pk2(rp[0][q][2], rp[0][q][3]);
              *(LAS u32x2*)(RLs + (it * 16 + fr) * 72 + n0) = p; *(LAS f32x4*)(Y0L + (it * 16 + fr) * 68 + n0) = y0[0][q]; }
          const int sb = c - 256; const float* sin_ = F.in[I_SWKV] + (((size_t)m * 32 + sb) * 16 + h) * 4096; float* sout = F.out + O_WKVS + (((size_t)m * 32 + sb) * 16 + h) * 4096;
          for (int it2 = tid; it2 < 64 * 16; it2 += NT) { const int i = it2 >> 4, j4 = (it2 & 15) * 4; const f32x4 sv = *(const f32x4*)(sin_ + i * 64 + j4); u32x2 p; p.x = pk2(sv[0], sv[1]); p.y = pk2(sv[2], sv[3]); *(LAS u32x2*)(Sl + i * 72 + j4) = p; }
          __syncthreads();
          if (w < 2) { f32x4 y[1][4];
#pragma unroll
              for (int q = 0; q < 4; ++q) y[0][q] = *(const LAS f32x4*)(Y0L + (w * 16 + fr) * 68 + q * 16 + 4 * fq);
              wave_mm_nt<1, 4>(y, RLs + w * 16 * 72, 72, Sl, 72, 64, fr, fq);
              rwkv_out_epilogue<DRY>(F, m, y[0], (size_t)(r0 + w * 16 + fr), h, fq); }
          else if (w < 6) { const int mi = w - 2; f32x4 tl[1][4];
#pragma unroll
              for (int q = 0; q < 4; ++q) { const int j = q * 16 + 4 * fq; const f32x4 sv = *(const f32x4*)(sin_ + (mi * 16 + fr) * 64 + j), gl4 = *(const LAS f32x4*)(GLV + j), qv = *(const LAS f32x4*)(QTL + (mi * 16 + fr) * 68 + j);
                  tl[0][q] = (f32x4){__expf(gl4[0]) * sv[0] + qv[0], __expf(gl4[1]) * sv[1] + qv[1], __expf(gl4[2]) * sv[2] + qv[2], __expf(gl4[3]) * sv[3] + qv[3]}; }
              wave_mm_nt<1, 4>(tl, Sl + mi * 16 * 72, 72, PL, 72, 64, fr, fq);
#pragma unroll
              for (int q = 0; q < 4; ++q) *(f32x4*)(sout + (mi * 16 + fr) * 64 + q * 16 + 4 * fq) = tl[0][q]; }
      }
    }
}

constexpr int SC_GRP = 4, SC_CH = 8192 + 2048 + 256, SC_LCH = 9216 + 2304 + 256, SC_LBUF = SC_GRP * SC_LCH;
template <int SKIP = 0> __device__ __forceinline__ void rwkv_scan_phase(Frame& F, int layer) {
    const int tid = otid(); const int lane = tid & 63, m = layer >> 1; const int b = blockIdx.x;
    if (b >= 64) {
        if constexpr (SKIP == 0) { const int nb = (int)F.G - 64; RawRegs raw; int u = 256 * 16 + (b - 64); if (u < NCHUNK * 16) rwkv_load_raw(F, u, tid, raw);
            for (; u < NCHUNK * 16; u += nb) { const int un = (u + nb < NCHUNK * 16) ? u + nb : -1; rwkv_local_unit<32>(F, layer, u >> 4, u & 15, raw, un); }
            if (layer == 1) { __syncthreads(); mod_phase(F, 2, 4, b - 64, nb); } }
        return; }
    const int h = 2 * (b & 7) + (b >> 5), sl = (b >> 3) & 3;
    const unsigned char* REC = F.ws + WS_REC;
    constexpr int NG = 256 / SC_GRP, DEPTH = 4;
    static_assert(NG % DEPTH == 0, "scan groups vs prefetch depth");
    if (F.wave != 0) {
        constexpr int NV = SC_GRP * SC_CH / 16, NLT = NT - 64, NPT = (NV + NLT - 1) / NLT;
        struct RegSet { u32x4 v[NPT]; };
        RegSet sets[DEPTH];
        unsigned poff[NPT], pdst[NPT];
#pragma unroll
        for (int q = 0; q < NPT; ++q) { int v = (tid - 64) + q * NLT; v = v < NV ? v : NV - 1; const int cc = v / (SC_CH / 16), o = (v % (SC_CH / 16)) * 16;
            poff[q] = (unsigned)(cc * REC_B + o + (o >= 10240 ? 6144 : (o >= 8192 ? sl * 2048 : 0)));
            const int lo = (o < 8192) ? (o >> 7) * 144 + (o & 127) : (o < 10240) ? 9216 + ((o - 8192) >> 7) * 144 + ((o - 8192) & 127) : 9216 + 2304 + (o - 10240);
            pdst[q] = (unsigned)(cc * SC_LCH + lo); }
        auto issue = [&](int g, RegSet& st) { const unsigned char* gb = REC + ((size_t)h * 256 + g * SC_GRP) * REC_B;
#pragma unroll
            for (int q = 0; q < NPT; ++q) st.v[q] = *(const u32x4*)(gb + poff[q]); };
        auto commit = [&](int buf, const RegSet& st) {
#pragma unroll
            for (int q = 0; q < NPT; ++q) *(LAS u32x4*)(F.lds + buf * SC_LBUF + pdst[q]) = st.v[q]; };
        if (!(SKIP & 2)) {
#pragma unroll
            for (int d = 0; d < DEPTH; ++d) issue(d, sets[d]);
            commit(0, sets[0]); }
        for (int g0 = 0; g0 < NG; g0 += DEPTH) {
#pragma unroll
            for (int dd = 0; dd < DEPTH; ++dd) { const int g = g0 + dd;
                if (!(SKIP & 2)) { if (g > 0 && g + DEPTH - 1 < NG) issue(g + DEPTH - 1, sets[(dd + DEPTH - 1) % DEPTH]); }
                __syncthreads();
                __syncthreads();
                if (!(SKIP & 2)) { if (g + 1 < NG) commit((g + 1) & 1, sets[(dd + 1) % DEPTH]); } }
        }
    } else {
        const int ci = lane & 15, q4 = lane >> 4, i = 16 * sl + ci;
        f32x4 T[4];
#pragma unroll
        for (int mm = 0; mm < 4; ++mm) T[mm] = (f32x4){0.f, 0.f, 0.f, 0.f};
        bf16_t* TST = (bf16_t*)(F.ws + WS_TST);
        const unsigned pfo = (unsigned)(ci * 144 + q4 * 16);
        for (int g = 0; g < NG; ++g) {
            __syncthreads();
            if (!(SKIP & 1)) {
                const LAS unsigned char* base = F.lds + (g & 1) * SC_LBUF;
                bf16x8 pf[4][2];
#pragma unroll
                for (int mm = 0; mm < 4; ++mm)
#pragma unroll
                    for (int s = 0; s < 2; ++s) pf[mm][s] = *(const LAS bf16x8*)(base + pfo + mm * 2304 + s * 64);
#pragma unroll
                for (int cc = 0; cc < SC_GRP; ++cc) { const int c = g * SC_GRP + cc; const LAS unsigned char* cb = base + cc * SC_LCH;
                    bf16_t* tdst = TST + (((size_t)h * 256 + c) * 64 + i) * 64;
                    f32x4 gv[4]; u32x2 qv[4];
#pragma unroll
                    for (int mm = 0; mm < 4; ++mm) { const int j = 16 * mm + 4 * q4; gv[mm] = *(const LAS f32x4*)(cb + 9216 + 2304 + j * 4); qv[mm] = *(const LAS u32x2*)(cb + 9216 + ci * 144 + j * 2); }
                    bf16x8 pn[4][2];
                    if (cc + 1 < SC_GRP) {
#pragma unroll
                        for (int mm = 0; mm < 4; ++mm)
#pragma unroll
                            for (int s = 0; s < 2; ++s) pn[mm][s] = *(const LAS bf16x8*)(cb + SC_LCH + pfo + mm * 2304 + s * 64); }
                    bf16x8 Tf[2];
#pragma unroll
                    for (int mm = 0; mm < 4; ++mm) { u32x2 p; p.x = pk2(T[mm][0], T[mm][1]); p.y = pk2(T[mm][2], T[mm][3]); *(u32x2*)(tdst + 16 * mm + 4 * q4) = p;
                        Tf[mm >> 1][(mm & 1) * 4 + 0] = (short)(p.x & 0xffffu); Tf[mm >> 1][(mm & 1) * 4 + 1] = (short)(p.x >> 16); Tf[mm >> 1][(mm & 1) * 4 + 2] = (short)(p.y & 0xffffu); Tf[mm >> 1][(mm & 1) * 4 + 3] = (short)(p.y >> 16); }
#pragma unroll
                    for (int mm = 0; mm < 4; ++mm) {
                        f32x4 acc = (f32x4){gv[mm][0] * T[mm][0] + bflo(qv[mm].x), gv[mm][1] * T[mm][1] + bfhi(qv[mm].x), gv[mm][2] * T[mm][2] + bflo(qv[mm].y), gv[mm][3] * T[mm][3] + bfhi(qv[mm].y)};
                        acc = __builtin_amdgcn_mfma_f32_16x16x32_bf16(pf[mm][0], Tf[0], acc, 0, 0, 0); acc = __builtin_amdgcn_mfma_f32_16x16x32_bf16(pf[mm][1], Tf[1], acc, 0, 0, 0);
                        T[mm] = acc; }
                    if (cc + 1 < SC_GRP) {
#pragma unroll
                        for (int mm = 0; mm < 4; ++mm) { pf[mm][0] = pn[mm][0]; pf[mm][1] = pn[mm][1]; } }
                }
            }
            __syncthreads();
        }
        float* outp = F.out + O_WKVP + ((size_t)m * 16 + h) * 4096 + (size_t)i * 64;
#pragma unroll
        for (int mm = 0; mm < 4; ++mm) *(f32x4*)(outp + 16 * mm + 4 * q4) = T[mm];
    }
}

struct OutMain { u32x2 y0[4]; bf16x8 xa[2]; bf16x8 yb[2][4]; };
template <bool DRY = false> __device__ __forceinline__ void rwkv_output_phase(Frame& F, int layer) {
    const int tid = otid(); const int lane = tid & 63, fr = lane & 15, fq = lane >> 4, m = layer >> 1;
    const bf16_t* RKV = (const bf16_t*)(F.ws + WS_RKV); const bf16_t* TST = (const bf16_t*)(F.ws + WS_TST);
    const int gw = F.vcu * NWAVES + F.wave, NGW = F.G * NWAVES;
    auto issue = [&](int u, OutMain& mn, OutSide& sd) { const int it = u & 3, h = (u >> 2) & 15, c = u >> 6;
        const size_t row = (size_t)(64 * c + 16 * it + fr); const bf16_t* ts = TST + ((size_t)h * 256 + c) * 4096;
#pragma unroll
        for (int nt = 0; nt < 4; ++nt) mn.y0[nt] = *(const u32x2*)(RKV + row * 3072 + h * 64 + 16 * nt + 4 * fq);
#pragma unroll
        for (int s = 0; s < 2; ++s) { mn.xa[s] = *(const bf16x8*)(RKV + row * 3072 + 1024 + h * 64 + 32 * s + 8 * fq);
#pragma unroll
            for (int nt = 0; nt < 4; ++nt) mn.yb[s][nt] = *(const bf16x8*)(ts + (16 * nt + fr) * 64 + 32 * s + 8 * fq); }
        rwkv_out_side(F, m, row, h, fq, sd); };
    constexpr int NU = 256 * 16 * 4;
    OutMain mA, mB; OutSide sA, sB;
    int u = gw; if (u < NU) issue(u, mA, sA);
    for (; u < NU; u += 2 * NGW) {
        { int un = u + NGW; un = un < NU ? un : NU - 1; issue(un, mB, sB);
          const int it = u & 3, h = (u >> 2) & 15, c = u >> 6; const size_t row = (size_t)(64 * c + 16 * it + fr); f32x4 y[4];
#pragma unroll
          for (int nt = 0; nt < 4; ++nt) y[nt] = (f32x4){bflo(mA.y0[nt].x), bfhi(mA.y0[nt].x), bflo(mA.y0[nt].y), bfhi(mA.y0[nt].y)};
#pragma unroll
          for (int s = 0; s < 2; ++s)
#pragma unroll
              for (int nt = 0; nt < 4; ++nt) y[nt] = __builtin_amdgcn_mfma_f32_16x16x32_bf16(mA.yb[s][nt], mA.xa[s], y[nt], 0, 0, 0);
          rwkv_out_core<DRY>(F, y, row, h, fq, sA); }
        { const int u1 = u + NGW; if (u1 < NU) { int un = u1 + NGW; un = un < NU ? un : NU - 1; issue(un, mA, sA);
          const int it = u1 & 3, h = (u1 >> 2) & 15, c = u1 >> 6; const size_t row = (size_t)(64 * c + 16 * it + fr); f32x4 y[4];
#pragma unroll
          for (int nt = 0; nt < 4; ++nt) y[nt] = (f32x4){bflo(mB.y0[nt].x), bfhi(mB.y0[nt].x), bflo(mB.y0[nt].y), bfhi(mB.y0[nt].y)};
#pragma unroll
          for (int s = 0; s < 2; ++s)
#pragma unroll
              for (int nt = 0; nt < 4; ++nt) y[nt] = __builtin_amdgcn_mfma_f32_16x16x32_bf16(mB.yb[s][nt], mB.xa[s], y[nt], 0, 0, 0);
          rwkv_out_core<DRY>(F, y, row, h, fq, sB); } }
    }
}

#define GRID_BAR() xcd_barrier(bar)
#ifndef PHASE_MASK
#define PHASE_MASK 0xffffffffu
#endif
#ifndef STRETCH_MASK
#define STRETCH_MASK 0u
#endif
struct StretchGuard { unsigned long long t0; bool on; __device__ __forceinline__ StretchGuard(bool o) : t0(o ? __builtin_amdgcn_s_memrealtime() : 0ull), on(o) {}
    __device__ __forceinline__ ~StretchGuard() { if (on) { __syncthreads(); const unsigned long long t1 = __builtin_amdgcn_s_memrealtime(); while (__builtin_amdgcn_s_memrealtime() < t1 + (t1 - t0)) __builtin_amdgcn_s_sleep(2); } } };
#define PH(k) if (StretchGuard sg_(((STRETCH_MASK) >> (k)) & 1u); PHASE_MASK & (1u << (k)))
#ifndef REP_MASK
#define REP_MASK 0u
#endif
#define REP(k) (((REP_MASK) >> (k)) & 1u)
#ifndef LOCAL_SKIP
#define LOCAL_SKIP 0
#endif
#ifndef EXTRA_BARS
#define EXTRA_BARS 0
#endif
template <int layer> __device__ __forceinline__ void layer_body(Frame& F, const XcdBarrier& bar) {
    unsigned char* ws = F.ws; unsigned char* ar = ws + WS_ARENA;
    bf16_t* XN = (bf16_t*)(ws + WS_XN);
    const float* MOD = (const float*)(ws + WS_MOD);
    constexpr int m = layer >> 1; const float* modl = MOD + (size_t)layer * NSEQ * 6144;
    PH(1) for (int rep = 0; rep <= (int)REP(1); ++rep) if (layer > 0) convert_layer_weights(F, layer);
    if constexpr ((layer & 1) == 0) {
        PH(2) for (int rep = 0; rep <= (int)REP(2); ++rep) { if constexpr (layer == 0) norm_pass<0, 0, true>(F, layer, 0, 0, F.in[I_XS], nullptr); else norm_pass<0, 8>(F, layer, layer - 1, 5120, F.out + (size_t)MP * D, (float*)(ws + WS_SXB)); }
        GRID_BAR();
        PH(3) { using GC = pg8::Geo<D, D, D, 30, 0, 1 << 20, 0>; pg8::Gemm<GC> g{XN, (const bf16_t*)(ar + AR_WIN), nullptr}; pg8::StaticOrder S; S.init(M, ABIN, F.G, (int)blockIdx.x);
          pg8::EpiBf16<0> E{(bf16_t*)(ws + WS_Z), ABIN};
          pg8::gemm_phase<pg8::EpiBf16<0>, pg8::StaticOrder, GC, true, true>(F.lds, g, S, E);
          if (REP(3)) { pg8::EpiNull<true> EN; pg8::gemm_phase<pg8::EpiNull<true>, pg8::StaticOrder, GC, true, true>(F.lds, g, S, EN); } }
        GRID_BAR();
        PH(4) for (int rep = 0; rep <= (int)REP(4); ++rep) for (int u = F.vcu; u < NCHUNK * 8; u += F.G) { const int c = u >> 3, hh = (u + u / F.G) & 7;
            if (c < 256) { if (hh < 4) ab_summary_unit<64, false>(F, layer, c, hh); else ab_summary_unit<64, true>(F, layer, c, hh - 4); }
            else { if (hh < 4) ab_summary_unit<32, false>(F, layer, c, hh); else ab_summary_unit<32, true>(F, layer, c, hh - 4); } }
        GRID_BAR();
        PH(5) { if (REP(5)) ab_scan<true>(F, layer); ab_scan<false>(F, layer); }
        GRID_BAR();
        PH(6) for (int rep = 0; rep <= (int)REP(6); ++rep) for (int u = F.vcu; u < NCHUNK * 8; u += F.G) { const int c = u >> 3, hh = (u + u / F.G) & 7;
            if (c < 256) { if (hh < 4) ab_output_unit<64, false>(F, layer, c, hh); else ab_output_unit<64, true>(F, layer, c, hh - 4); }
            else { if (hh < 4) ab_output_unit<32, false>(F, layer, c, hh); else ab_output_unit<32, true>(F, layer, c, hh - 4); } }
        GRID_BAR();
        PH(7) { using GC = pg8::Geo<D, D, D, 30, 0, 1 << 20, 0>; pg8::Gemm<GC> g{XN, (const bf16_t*)(ar + AR_WOUT), nullptr}; pg8::StaticOrder S; S.init(MP, D, F.G, (int)blockIdx.x);
          pg8::EpiRes E{F.out, modl, 2048, (layer == 0) ? F.in[I_XP] : F.out};
          pg8::gemm_phase<pg8::EpiRes, pg8::StaticOrder, GC, true, true>(F.lds, g, S, E);
          if (REP(7)) { pg8::EpiNull<false> EN; pg8::gemm_phase<pg8::EpiNull<false>, pg8::StaticOrder, GC, true, true>(F.lds, g, S, EN); }
          using GC2 = pg8::Geo<D, D, 256, 30, 0, 1 << 20, 0, true>; pg8::Gemm<GC2> g2{XN, (const bf16_t*)(ar + AR_WOUT), nullptr}; pg8::SplitOrder S2{F.vcu, 4};
          pg8::EpiPartial E2{(float*)(ws + WS_PART), 4};
          pg8::gemm_phase<pg8::EpiPartial, pg8::SplitOrder, GC2, true, true>(F.lds, g2, S2, E2); }
        GRID_BAR();
    } else {
        PH(8) for (int rep = 0; rep <= (int)REP(8); ++rep) norm_pass<1, 8>(F, layer, layer - 1, 5120, F.out + (size_t)MP * D, (float*)(ws + WS_SXB));
        GRID_BAR();
        PH(9) { using GCr = pg8::Geo<D, 2048, D, 2, M * D, 1 << 20, 0>; pg8::Gemm<GCr> gr{(const bf16_t*)(ws + WS_XMIX), (const bf16_t*)(ar + AR_WC1), nullptr}; pg8::StaticOrder Sr; Sr.init(M, 3072, F.G, (int)blockIdx.x);
          pg8::EpiRkv E{(bf16_t*)(ws + WS_RKV), (bf16_t*)(ws + WS_LO), (m == 0) ? (bf16_t*)(ws + WS_VFIRST) : nullptr};
          pg8::gemm_phase<pg8::EpiRkv, pg8::StaticOrder, GCr, true, true>(F.lds, gr, Sr, E);
          if (REP(9)) { pg8::EpiNull<true> EN; pg8::gemm_phase<pg8::EpiNull<true>, pg8::StaticOrder, GCr, true, true>(F.lds, gr, Sr, EN); }
          using GC = pg8::Geo<D, 2048, 2048, 30, 0, 16, -4096>; pg8::Gemm<GC> g{XN, (const bf16_t*)(ar + AR_WC1), (const bf16_t*)(ws + WS_PREVS)}; pg8::LoraOrder Sl{(int)blockIdx.x};
          pg8::gemm_phase<pg8::EpiRkv, pg8::LoraOrder, GC, true, true>(F.lds, g, Sl, E); }
        GRID_BAR();
        PH(10) { using GC = pg8::Geo<D, 256, 256, 2, 256, 1 << 20, 0>; pg8::Gemm<GC> g{(const bf16_t*)(ws + WS_LO), (const bf16_t*)(ar + AR_WC2), nullptr}; pg8::StaticOrder S; S.init(M, 4096, F.G, (int)blockIdx.x);
          pg8::EpiLora2 E{(bf16_t*)(ws + WS_WLOG), XN, (bf16_t*)(ws + WS_G), (bf16_t*)(ws + WS_RKV), (m == 1) ? (const bf16_t*)(ws + WS_VFIRST) : nullptr,
                          F.in[I_RW0] + m * D, F.in[I_RA0] + m * D, F.in[I_RV0]};
          pg8::gemm_phase<pg8::EpiLora2, pg8::StaticOrder, GC, true, true>(F.lds, g, S, E);
          if (REP(10)) { pg8::EpiNull<false> EN; pg8::gemm_phase<pg8::EpiNull<false>, pg8::StaticOrder, GC, true, true>(F.lds, g, S, EN); } }
        GRID_BAR();
        PH(11) { RawRegs raw; const int tid0 = otid(); int u = F.vcu; if (u < 256 * 16) rwkv_load_raw(F, u, tid0, raw);
          for (; u < 256 * 16; u += F.G) { const int c = u >> 4, hh = u & 15, un = (u + F.G < 256 * 16) ? u + F.G : -1;
              rwkv_local_unit<64>(F, layer, c, hh, raw, un); } }
        GRID_BAR();
        PH(17) { if (REP(17)) rwkv_scan_phase<LOCAL_SKIP>(F, layer); rwkv_scan_phase<0>(F, layer); }
        GRID_BAR();
        PH(18) { if (REP(18)) rwkv_output_phase<true>(F, layer); rwkv_output_phase<false>(F, layer); }
        GRID_BAR();
        PH(12) { using GC = pg8::Geo<3072, D, D, 30, 0, 1 << 20, 0>; pg8::Gemm<GC> g{(const bf16_t*)(ws + WS_RKV), (const bf16_t*)(ar + AR_WO), nullptr}; pg8::StaticOrder S; S.init(MP, D, F.G, (int)blockIdx.x);
          pg8::EpiRes E{F.out, modl, 2048, F.out};
          pg8::gemm_phase<pg8::EpiRes, pg8::StaticOrder, GC, true, true>(F.lds, g, S, E);
          if (REP(12)) { pg8::EpiNull<false> EN; pg8::gemm_phase<pg8::EpiNull<false>, pg8::StaticOrder, GC, true, true>(F.lds, g, S, EN); }
          using GC2 = pg8::Geo<3072, D, 256, 30, 0, 1 << 20, 0, true>; pg8::Gemm<GC2> g2{(const bf16_t*)(ws + WS_RKV), (const bf16_t*)(ar + AR_WO), nullptr}; pg8::SplitOrder S2{F.vcu, 4};
          pg8::EpiPartial E2{(float*)(ws + WS_PART), 4};
          pg8::gemm_phase<pg8::EpiPartial, pg8::SplitOrder, GC2, true, true>(F.lds, g2, S2, E2); }
        GRID_BAR();
    }
    PH(13) for (int rep = 0; rep <= (int)REP(13); ++rep) norm_pass<2, 4>(F, layer, layer, 2048, (layer == 0) ? F.in[I_XS] : (const float*)(ws + WS_SXB), F.out + (size_t)MP * D);
    GRID_BAR();
    PH(14) { using GC = pg8::Geo<D, D, D, 30, 0, 1 << 20, 0>; pg8::Gemm<GC> g{XN, (const bf16_t*)(ar + AR_W1), nullptr}; pg8::StaticOrder S; S.init(M, DFF, F.G, (int)blockIdx.x);
      pg8::EpiBf16<1> E{(bf16_t*)(ws + WS_H), DFF};
      pg8::gemm_phase<pg8::EpiBf16<1>, pg8::StaticOrder, GC, true, true>(F.lds, g, S, E);
          if (REP(14)) { pg8::EpiNull<true> EN; pg8::gemm_phase<pg8::EpiNull<true>, pg8::StaticOrder, GC, true, true>(F.lds, g, S, EN); } }
    GRID_BAR();
    PH(15) { using GC = pg8::Geo<DFF, DFF, DFF, 30, 0, 1 << 20, 0>; pg8::Gemm<GC> g{(const bf16_t*)(ws + WS_H), (const bf16_t*)(ar + AR_W2), nullptr}; pg8::StaticOrder S; S.init(MP, D, F.G, (int)blockIdx.x);
      pg8::EpiRes E{F.out, modl, 5120, F.out};
      for (int xb = 0; xb < EXTRA_BARS; ++xb) GRID_BAR();
      pg8::gemm_phase<pg8::EpiRes, pg8::StaticOrder, GC, true, true>(F.lds, g, S, E);
      if (REP(15)) { pg8::EpiNull<false> EN; pg8::gemm_phase<pg8::EpiNull<false>, pg8::StaticOrder, GC, true, true>(F.lds, g, S, EN); }
      using GC2 = pg8::Geo<DFF, DFF, 512, 30, 0, 1 << 20, 0, true>; pg8::Gemm<GC2> g2{(const bf16_t*)(ws + WS_H), (const bf16_t*)(ar + AR_W2), nullptr}; pg8::SplitOrder S2{F.vcu, 8};
      pg8::EpiPartial E2{(float*)(ws + WS_PART), 8};
      pg8::gemm_phase<pg8::EpiPartial, pg8::SplitOrder, GC2, true, true>(F.lds, g2, S2, E2); }
    GRID_BAR();
}

__global__ void __launch_bounds__(NT, 2) fwd_kernel(Args args) {
    extern __shared__ __attribute__((aligned(16))) unsigned char lds[];
    Frame F;
    F.lds = (LAS unsigned char*)lds; F.MISC = (volatile LAS unsigned*)(F.lds + MISC_OFF);
    F.wave = __builtin_amdgcn_readfirstlane(threadIdx.x >> 6);
    F.G = gridDim.x; { const int bx = blockIdx.x; F.vcu = (F.G % 8 == 0) ? (bx % 8) * (F.G / 8) + bx / 8 : bx; }
    F.in = args.in; F.out = args.out; F.ws = args.ws;
    for (int u = threadIdx.x; u < (LDS_BYTES - LDSCTL_OFF) / 4; u += NT) ((LAS unsigned*)(F.lds + LDSCTL_OFF))[u] = 0u;
    __syncthreads();
    XcdBarrier bar = xcd_barrier_post((unsigned*)(F.ws + WS_CTL) + CW_BAR, F.MISC + 8);
    PH(0) prologue(F);
    GRID_BAR();
    PH(0) mod_phase(F, 0, 2, F.vcu, F.G);
    GRID_BAR();
    layer_body<0>(F, bar); layer_body<1>(F, bar); layer_body<2>(F, bar); layer_body<3>(F, bar);
    PH(16) norm_pass<3, 8>(F, 0, 3, 5120, F.out + (size_t)MP * D, nullptr);
}

extern "C" void kernel_launch(void* const* d_in, const int* in_sizes, int n_in, void* d_out, int out_size, void* d_ws, size_t ws_size, hipStream_t stream) {
    static int grid = 0;
    if (grid == 0) {
        if (n_in != 38 || out_size != 28706816 || ws_size < WS_END) { fprintf(stderr, "kernel_launch: unexpected problem (n_in %d, out %d, ws %zu; need ws >= %zu)\n", n_in, out_size, ws_size, (size_t)WS_END); grid = -1; return; }
        int dev = 0, cus = 0, per_cu = 0;
        if (hipGetDevice(&dev) != hipSuccess || hipDeviceGetAttribute(&cus, hipDeviceAttributeMultiprocessorCount, dev) != hipSuccess) { grid = -1; return; }
        if (hipFuncSetAttribute((const void*)fwd_kernel, hipFuncAttributeMaxDynamicSharedMemorySize, LDS_BYTES) != hipSuccess) { fprintf(stderr, "kernel_launch: hipFuncSetAttribute failed\n"); grid = -1; return; }
        if (hipOccupancyMaxActiveBlocksPerMultiprocessor(&per_cu, (const void*)fwd_kernel, NT, LDS_BYTES) != hipSuccess || per_cu < 1) { fprintf(stderr, "kernel_launch: occupancy query says %d\n", per_cu); per_cu = 1; }
        (void)hipGetLastError();
        grid = cus;
    }
    if (grid < 0) return;
    (void)hipMemsetAsync((char*)d_ws + WS_CTL, 0, ZERO_BYTES, stream);
    Args a{};
    for (int i = 0; i < 38; ++i) a.in[i] = (const float*)d_in[i];
    a.out = (float*)d_out; a.ws = (unsigned char*)d_ws;
    void* kargs[] = {&a};
    hipError_t e = hipLaunchCooperativeKernel((const void*)fwd_kernel, dim3(grid), dim3(NT), kargs, LDS_BYTES, stream);
    if (e != hipSuccess) fprintf(stderr, "kernel_launch: cooperative launch failed: %s (grid %d)\n", hipGetErrorString(e), grid);
}
```

```cpp
#include <hip/hip_runtime.h>
#include <cstdio>
#include <cstdint>

#define LAS __attribute__((address_space(3)))
#define GAS __attribute__((address_space(1)))
typedef unsigned short bf16_t;
typedef short bf16x8 __attribute__((ext_vector_type(8)));
typedef float f32x4 __attribute__((ext_vector_type(4)));
typedef float f32x2 __attribute__((ext_vector_type(2)));
typedef unsigned u32x4 __attribute__((ext_vector_type(4)));
typedef unsigned u32x2 __attribute__((ext_vector_type(2)));

#ifndef LOCAL_SKIP
#define LOCAL_SKIP 0
#endif
constexpr int D = 1024, MP = 16384, MS = 1024, M = MP + MS, NSEQ = 33, DFF = 4096, ABIN = 3584;
constexpr int NCHUNK = 288;
constexpr int SLOT_E = 4 * 8192 + 4 * 16384;
constexpr float NORM_EPS = 1e-6f, RW_LN_EPS = 64e-5f;

constexpr size_t MiB = 1u << 20;
constexpr size_t WS_CTL = 0, WS_MOD = 1 * MiB, ZERO_BYTES = 65536;
constexpr size_t WS_ROPE = 5 * MiB;
constexpr size_t WS_ARENA = 10 * MiB;
constexpr size_t AR_W1 = 0, AR_W2 = 8 * MiB, AR_WIN = 16 * MiB, AR_WOUT = 23 * MiB, AR_WC1 = 16 * MiB, AR_WC2 = 32 * MiB, AR_WO = 34 * MiB;
constexpr size_t WS_VFIRST = 46 * MiB;
constexpr size_t WS_XN0 = 80 * MiB, WS_XN = WS_XN0 + 2048;
constexpr size_t WS_PREVS = 115 * MiB;
constexpr size_t WS_R1 = 118 * MiB;
constexpr size_t WS_Z = WS_R1, WS_STATE = WS_R1 + 120 * MiB, WS_DEC = WS_R1 + 174 * MiB;
constexpr size_t WS_H = WS_R1;
constexpr size_t WS_RKV = WS_R1, WS_LO = WS_R1 + 102 * MiB, WS_WLOG = WS_R1 + 136 * MiB, WS_G = WS_R1 + 170 * MiB;
constexpr size_t WS_TST = WS_R1 + 102 * MiB;
constexpr size_t WS_REC = WS_R1 + 204 * MiB, WS_BON = WS_R1 + 269 * MiB;
constexpr int REC_B = 16640;
constexpr size_t WS_XMIX = WS_R1 + 168 * MiB;
constexpr size_t WS_PART = WS_R1 + 136 * MiB;
constexpr size_t WS_SXB = WS_R1 + 271 * MiB;
constexpr size_t WS_END = WS_R1 + 275 * MiB;

__device__ const double ROPE_REV[32] = {0.15915494309189535, 0.11934937021124886, 0.089499401608891013, 0.067115083005227255, 0.050329212104487035, 0.037741584717419771, 0.028302195830623399, 0.02122365276477766, 0.015915494309189534, 0.011934937021124886, 0.0089499401608891024, 0.0067115083005227253, 0.0050329212104487037, 0.0037741584717419772, 0.0028302195830623399, 0.0021223652764777662, 0.0015915494309189536, 0.0011934937021124885, 0.00089499401608891024, 0.0006711508300522726, 0.00050329212104487033, 0.00037741584717419774, 0.00028302195830623395, 0.00021223652764777661, 0.00015915494309189535, 0.00011934937021124886, 8.9499401608891018e-05, 6.7115083005227254e-05, 5.0329212104487035e-05, 3.7741584717419777e-05, 2.8302195830623396e-05, 2.1223652764777659e-05};

__device__ __forceinline__ unsigned f2bf(float f) { unsigned u = __builtin_bit_cast(unsigned, f); return (u + 0x7fffu + ((u >> 16) & 1u)) >> 16; }
typedef __bf16 bf16x2_t __attribute__((ext_vector_type(2)));
__device__ __forceinline__ unsigned pk2(float lo, float hi) { const f32x2 v = {lo, hi}; const bf16x2_t b = __builtin_convertvector(v, bf16x2_t); return __builtin_bit_cast(unsigned, b); }
__device__ __forceinline__ float bf2f(unsigned short b) { return __builtin_bit_cast(float, (unsigned)b << 16); }
__device__ __forceinline__ float bflo(unsigned w) { return __builtin_bit_cast(float, w << 16); }
__device__ __forceinline__ float bfhi(unsigned w) { return __builtin_bit_cast(float, w & 0xffff0000u); }
__device__ __forceinline__ float sigmoidf_(float x) { return 1.f / (1.f + __expf(-x)); }
__device__ __forceinline__ float siluf_(float x) { return x / (1.f + __expf(-x)); }
__device__ __forceinline__ float wave_sum(float v) {
#pragma unroll
    for (int o = 1; o < 64; o <<= 1) v += __shfl_xor(v, o);
    return v;
}
__device__ __forceinline__ int otid() { int t = threadIdx.x; asm volatile("" : "+v"(t)); return t; }
__device__ __forceinline__ int seq_of_row(int r) { return r < MP ? 0 : 1 + ((r - MP) >> 5); }
#define LDS_WAIT() asm volatile("s_waitcnt lgkmcnt(0)" ::: "memory")
#define VM_WAIT() asm volatile("s_waitcnt vmcnt(0)" ::: "memory")

namespace pg8 {
constexpr int BM = 256, BK = 64, HALF = 128, HTB = HALF * BK * 2, STAGE_BYTES = 8 * HTB, NXCD = 8, WGM = 8;
__host__ __device__ __forceinline__ int lds_byte(int r, int c) { const int st = (r >> 4) * 2 + (c >> 5), rr = r & 15, cc = c & 31, ob = rr * 64 + cc * 2; return st * 1024 + (ob ^ (((ob >> 9) & 1) << 5)); }
__host__ __device__ __forceinline__ void stage_rc(int b, int& R, int& C) { const int st = b / 1024, sb = b % 1024, swz = sb ^ (((sb >> 9) & 1) << 5); R = (st >> 1) * 16 + swz / 64; C = (st & 1) * 32 + (swz % 64) / 2; }
__host__ __device__ __forceinline__ int perm32(int rho) { const int n = rho >> 4, i = rho & 15; return 8 * (i >> 2) + 4 * n + (i & 3); }

struct Unit { int pm, pn, ks; };
template <int LDA_, int LDB_, int K_, int GSHIFT_, int GSTRIDE_, int KSPLIT_, int DELTAP_, bool SPLIT_ = false> struct Geo {
    static constexpr int LDA = LDA_, LDB = LDB_, K = K_, GSHIFT = GSHIFT_, GSTRIDE = GSTRIDE_, KSPLIT = KSPLIT_, DELTAP = DELTAP_; static constexpr bool SPLIT = SPLIT_;
};
template <class GC> struct Gemm {
    const bf16_t* A; const bf16_t* Bt; const bf16_t* A2s;
    __device__ __forceinline__ const char* a_base(const Unit& u) const { return (const char*)(A + (size_t)u.pm * BM * GC::LDA + (size_t)(u.pn >> GC::GSHIFT) * GC::GSTRIDE + (GC::SPLIT ? (size_t)u.ks * GC::K : 0)); }
    __device__ __forceinline__ const char* b_base(const Unit& u) const { return (const char*)(Bt + (size_t)u.pn * BM * GC::LDB + (GC::SPLIT ? (size_t)u.ks * GC::K : 0)); }
    __device__ __forceinline__ long a_delta(const Unit& u) const {
        if constexpr (GC::KSPLIT >= GC::K / BK) return 0;
        else { if (u.pm < 64) return (long)GC::DELTAP;
            return (long)((const char*)(A2s + (size_t)(u.pm - 64) * BM * GC::LDA) - a_base(u)) - (long)GC::KSPLIT * BK * 2; }
    }
};
struct StaticOrder {
    int nM, nN, nwg, G, c;
    __host__ __device__ void init(int M_, int N_, int G_, int c_) { nM = M_ / BM; nN = N_ / BM; nwg = nM * nN; G = G_; c = c_; }
    __host__ __device__ bool next(int i, Unit& u) const {
        const long L = (long)i * G + c; if (L >= nwg) return false;
        int wgid = (int)L; { const int q = nwg / NXCD, r = nwg % NXCD, xcd = wgid % NXCD, off = wgid / NXCD; wgid = (xcd < r ? xcd * (q + 1) : r * (q + 1) + (xcd - r) * q) + off; }
        const int nig = WGM * nN, gid = wgid / nig, fm = gid * WGM, gsz = (nM - fm) < WGM ? (nM - fm) : WGM;
        u.pm = fm + ((wgid % nig) % gsz); u.pn = (wgid % nig) / gsz; u.ks = 0; return true;
    }
};
__device__ __forceinline__ unsigned cvt_pk_bf16(float lo, float hi) { return pk2(lo, hi); }

template <class Epi, class Sched, class GC, bool ALIGN_EPI = false, bool SP2 = false>
__device__ __forceinline__ void gemm_phase(LAS unsigned char* lds, const Gemm<GC> g, const Sched& S, const Epi& E) {
    const int tid = otid(), wid = __builtin_amdgcn_readfirstlane(tid >> 6), lane = tid & 63, wr = wid >> 2, wc = wid & 3, fr = lane & 15, fq = lane >> 4;
    constexpr int K = GC::K, nt = K / BK, ksplit = GC::KSPLIT;
    unsigned voffA[2], voffB[2];
#pragma unroll
    for (int i = 0; i < 2; ++i) { int R, C; stage_rc(tid * 16 + i * 8192, R, C); const int Rb = Epi::PERM ? ((R & ~31) + perm32(R & 31)) : R;
        voffA[i] = (unsigned)(R * GC::LDA + C) * 2u; voffB[i] = (unsigned)(Rb * GC::LDB + C) * 2u; }
    constexpr size_t kstep = (size_t)(BK * 2);
    constexpr size_t hstepA = (size_t)HALF * GC::LDA * 2, hstepB = (size_t)HALF * GC::LDB * 2;
    const unsigned ldsw = (unsigned)wid * 1024u;
    const int aoff = lds_byte(wr * 64 + fr, fq * 8), boff = lds_byte(wc * 32 + fr, fq * 8);
#define PG8_SA(b, h) (((b) * 2 + (h)) * HTB)
#define PG8_SB(b, h) ((4 + (b) * 2 + (h)) * HTB)
#define PG8_STAGE(bufoff, gbase, voff) do { _Pragma("unroll") for (int _i = 0; _i < 2; ++_i) \
        __builtin_amdgcn_global_load_lds((const unsigned*)((const char*)(gbase) + (voff)[_i]), (LAS unsigned*)(lds + (bufoff) + ldsw + _i * 8192), 16, 0, 0); } while (0)
#define PG8_LDA(dst, b, h) do { _Pragma("unroll") for (int m = 0; m < 4; ++m) _Pragma("unroll") for (int k = 0; k < 2; ++k) dst[m][k] = *(const LAS bf16x8*)(lds + PG8_SA(b, h) + aoff + m * 2048 + k * 1024); } while (0)
#define PG8_LDB(dst, b, h) do { _Pragma("unroll") for (int n = 0; n < 2; ++n) _Pragma("unroll") for (int k = 0; k < 2; ++k) dst[n][k] = *(const LAS bf16x8*)(lds + PG8_SB(b, h) + boff + n * 2048 + k * 1024); } while (0)
#define PG8_MMA(ai, bj, At, Bt) do { __builtin_amdgcn_s_setprio(1); _Pragma("unroll") for (int m = 0; m < 4; ++m) _Pragma("unroll") for (int n = 0; n < 2; ++n) _Pragma("unroll") for (int k = 0; k < 2; ++k) \
        acc[ai][bj][m][n] = __builtin_amdgcn_mfma_f32_16x16x32_bf16(Bt[n][k], At[m][k], acc[ai][bj][m][n], 0, 0, 0); __builtin_amdgcn_s_setprio(0); } while (0)
#define PG8_WAIT_V(n) asm volatile("s_waitcnt vmcnt(" #n ")" ::: "memory")
#define PG8_WAIT_L(n) asm volatile("s_waitcnt lgkmcnt(" #n ")" ::: "memory")
#define PG8_BAR __builtin_amdgcn_s_barrier()
#define PG8_SCHED __builtin_amdgcn_sched_barrier(0)
    Unit cur, nxt; int ui = 0;
    if (!S.next(0, cur)) return;
    f32x4 acc[2][2][4][2];
#pragma unroll
    for (int a = 0; a < 2; ++a)
#pragma unroll
        for (int b = 0; b < 2; ++b)
#pragma unroll
            for (int m = 0; m < 4; ++m)
#pragma unroll
                for (int n = 0; n < 2; ++n) acc[a][b][m][n] = (f32x4){0.f, 0.f, 0.f, 0.f};
    bf16x8 At[4][2], B0[2][2], B1[2][2];
    const char* cA = g.a_base(cur); const char* cB = g.b_base(cur); long cD = g.a_delta(cur);
    if constexpr (SP2) {
        PG8_STAGE(PG8_SB(0, 0), cB, voffB); PG8_STAGE(PG8_SB(0, 1), cB + hstepB, voffB); PG8_STAGE(PG8_SA(0, 0), cA, voffA); PG8_STAGE(PG8_SA(0, 1), cA + hstepA, voffA);
        if (wr == 1) PG8_BAR;
        PG8_WAIT_V(2); PG8_BAR;
        PG8_STAGE(PG8_SB(1, 0), cB + kstep, voffB); PG8_STAGE(PG8_SA(1, 0), cA + kstep, voffA); PG8_STAGE(PG8_SB(1, 1), cB + hstepB + kstep, voffB);
        PG8_WAIT_V(6); PG8_BAR;
    } else {
        PG8_STAGE(PG8_SB(0, 0), cB, voffB); PG8_STAGE(PG8_SA(0, 0), cA, voffA); PG8_STAGE(PG8_SB(0, 1), cB + hstepB, voffB); PG8_STAGE(PG8_SA(0, 1), cA + hstepA, voffA);
        if (wr == 1) PG8_BAR;
        PG8_WAIT_V(4); PG8_BAR;
        PG8_STAGE(PG8_SB(1, 0), cB + kstep, voffB); PG8_STAGE(PG8_SA(1, 0), cA + kstep, voffA); PG8_STAGE(PG8_SB(1, 1), cB + hstepB + kstep, voffB);
        PG8_WAIT_V(6); PG8_BAR;
    }
    for (;;) {
        const bool has_next = S.next(ui + 1, nxt);
        const char* nA = has_next ? g.a_base(nxt) : cA; const char* nB = has_next ? g.b_base(nxt) : cB;
        const long nD = has_next ? g.a_delta(nxt) : cD;
#pragma unroll 1
        for (int t = 0; t < nt; t += 2) {
            const bool last = (t == nt - 2);
            const char* a1 = cA + (size_t)(t + 1) * kstep + (t >= ksplit ? cD : 0);
            const char* a2 = last ? nA : cA + (size_t)(t + 2) * kstep + (t + 2 >= ksplit ? cD : 0); const char* b2 = last ? nB : cB + (size_t)(t + 2) * kstep;
            const char* a3 = a2 + kstep; const char* b3 = b2 + kstep;
            if constexpr (SP2) {
            PG8_LDB(B0, 0, 0); PG8_LDB(B1, 0, 1); PG8_SCHED; PG8_LDA(At, 0, 0); PG8_STAGE(PG8_SA(1, 1), a1 + hstepA, voffA);
            PG8_WAIT_V(8); PG8_WAIT_L(0); PG8_BAR; PG8_MMA(0, 0, At, B0); PG8_MMA(0, 1, At, B1); PG8_BAR; PG8_SCHED;
            PG8_LDA(At, 0, 1); PG8_STAGE(PG8_SB(0, 0), b2, voffB); PG8_STAGE(PG8_SB(0, 1), b2 + hstepB, voffB); PG8_STAGE(PG8_SA(0, 0), a2, voffA);
            PG8_WAIT_V(8); PG8_WAIT_L(0); PG8_BAR; PG8_MMA(1, 0, At, B0); PG8_MMA(1, 1, At, B1); PG8_BAR; PG8_SCHED;
            PG8_LDB(B0, 1, 0); PG8_LDB(B1, 1, 1); PG8_SCHED; PG8_LDA(At, 1, 0); PG8_STAGE(PG8_SA(0, 1), a2 + hstepA, voffA);
            PG8_WAIT_V(8); PG8_WAIT_L(0); PG8_BAR; PG8_MMA(0, 0, At, B0); PG8_MMA(0, 1, At, B1); PG8_BAR; PG8_SCHED;
            PG8_LDA(At, 1, 1); PG8_STAGE(PG8_SB(1, 0), b3, voffB); PG8_STAGE(PG8_SB(1, 1), b3 + hstepB, voffB); PG8_STAGE(PG8_SA(1, 0), a3, voffA);
            PG8_WAIT_V(8); PG8_WAIT_L(0); PG8_BAR; PG8_MMA(1, 0, At, B0); PG8_MMA(1, 1, At, B1); PG8_BAR; PG8_SCHED;
            } else {
            PG8_LDB(B0, 0, 0); PG8_SCHED; PG8_LDA(At, 0, 0); PG8_STAGE(PG8_SA(1, 1), a1 + hstepA, voffA);
            PG8_WAIT_L(8); PG8_BAR; PG8_WAIT_L(0); PG8_MMA(0, 0, At, B0); PG8_BAR; PG8_SCHED;
            PG8_LDB(B1, 0, 1); PG8_STAGE(PG8_SB(0, 0), b2, voffB);
            PG8_BAR; PG8_WAIT_L(0); PG8_MMA(0, 1, At, B1); PG8_BAR;
            PG8_LDA(At, 0, 1); PG8_STAGE(PG8_SA(0, 0), a2, voffA);
            PG8_BAR; PG8_WAIT_L(0); PG8_MMA(1, 0, At, B0); PG8_BAR; PG8_SCHED;
            PG8_STAGE(PG8_SB(0, 1), b2 + hstepB, voffB);
            PG8_WAIT_V(6); PG8_BAR; PG8_MMA(1, 1, At, B1); PG8_BAR;
            PG8_LDB(B0, 1, 0); PG8_SCHED; PG8_LDA(At, 1, 0); PG8_STAGE(PG8_SA(0, 1), a2 + hstepA, voffA);
            PG8_WAIT_L(8); PG8_BAR; PG8_WAIT_L(0); PG8_MMA(0, 0, At, B0); PG8_BAR; PG8_SCHED;
            PG8_LDB(B1, 1, 1); PG8_STAGE(PG8_SB(1, 0), b3, voffB);
            PG8_BAR; PG8_WAIT_L(0); PG8_MMA(0, 1, At, B1); PG8_BAR;
            PG8_LDA(At, 1, 1); PG8_STAGE(PG8_SA(1, 0), a3, voffA);
            PG8_BAR; PG8_WAIT_L(0); PG8_MMA(1, 0, At, B0); PG8_BAR; PG8_SCHED;
            PG8_STAGE(PG8_SB(1, 1), b3 + hstepB, voffB);
            PG8_WAIT_V(6); PG8_BAR; PG8_MMA(1, 1, At, B1); PG8_BAR;
            }
        }
        if constexpr (ALIGN_EPI) { if (wr == 0) PG8_BAR; }
        E(acc, cur, wr, wc, fr, fq);
        if (!has_next) break;
#pragma unroll
        for (int a = 0; a < 2; ++a)
#pragma unroll
            for (int b = 0; b < 2; ++b)
#pragma unroll
                for (int m = 0; m < 4; ++m)
#pragma unroll
                    for (int n = 0; n < 2; ++n) acc[a][b][m][n] = (f32x4){0.f, 0.f, 0.f, 0.f};
        cur = nxt; cA = nA; cB = nB; cD = nD; ++ui;
        if constexpr (ALIGN_EPI) { if (wr == 1) PG8_BAR; }
    }
    PG8_WAIT_V(0);
    if constexpr (!ALIGN_EPI) { if (wr == 0) PG8_BAR; }
    PG8_BAR;
#undef PG8_SA
#undef PG8_SB
#undef PG8_STAGE
#undef PG8_LDA
#undef PG8_LDB
#undef PG8_MMA
#undef PG8_WAIT_V
#undef PG8_WAIT_L
#undef PG8_BAR
#undef PG8_SCHED
}

__device__ __forceinline__ float act_apply(float v, int act) {
    if (act == 1) { const float r = v > 0.f ? v : 0.f; return r * r; }
    if (act == 2) { const float e = __expf(-2.f * fabsf(v)); const float t = (1.f - e) / (1.f + e); return v < 0.f ? -t : t; }
    if (act == 3) return 1.f / (1.f + __expf(-v));
    return v;
}
template <int ACT> __device__ __forceinline__ void store_tile_bf16(const f32x4 (&acc)[2][2][4][2], bf16_t* base, int ldc, int row0, int col0, bf16_t* base2, int ldc2, int col2) {
#pragma unroll
    for (int ai = 0; ai < 2; ++ai)
#pragma unroll
        for (int m = 0; m < 4; ++m) { const size_t r = (size_t)(row0 + ai * HALF + m * 16);
#pragma unroll
            for (int bj = 0; bj < 2; ++bj) { f32x4 v0 = acc[ai][bj][m][0], v1 = acc[ai][bj][m][1];
#pragma unroll
                for (int q = 0; q < 4; ++q) { v0[q] = act_apply(v0[q], ACT); v1[q] = act_apply(v1[q], ACT); }
                u32x4 w; w.x = cvt_pk_bf16(v0[0], v0[1]); w.y = cvt_pk_bf16(v0[2], v0[3]); w.z = cvt_pk_bf16(v1[0], v1[1]); w.w = cvt_pk_bf16(v1[2], v1[3]);
                *(u32x4*)(base + r * ldc + col0 + bj * HALF) = w;
                if (base2) *(u32x4*)(base2 + r * ldc2 + col2 + bj * HALF) = w; } }
}
template <int ACT> struct EpiBf16 {
    static constexpr bool PERM = true;
    bf16_t* O; int ldc;
    __device__ __forceinline__ void operator()(const f32x4 (&acc)[2][2][4][2], const Unit& u, int wr, int wc, int fr, int fq) const {
        store_tile_bf16<ACT>(acc, O, ldc, u.pm * BM + wr * 64 + fr, u.pn * BM + wc * 32 + 8 * fq, nullptr, 0, 0);
    }
};
struct EpiRkv {
    static constexpr bool PERM = true;
    bf16_t* RKV; bf16_t* LO; bf16_t* vf;
    __device__ __forceinline__ void operator()(const f32x4 (&acc)[2][2][4][2], const Unit& u, int wr, int wc, int fr, int fq) const {
        const int row0 = u.pm * BM + wr * 64 + fr, cin = wc * 32 + 8 * fq;
        if (u.pn < 12) { bf16_t* b2 = (u.pn >= 8) ? vf : nullptr; store_tile_bf16<0>(acc, RKV, 3072, row0, u.pn * BM + cin, b2, 1024, (u.pn - 8) * BM + cin); }
        else {
#pragma unroll
            for (int bj = 0; bj < 2; ++bj) { const int c = cin + bj * HALF; int dst = -1, act = 0;
                if (u.pn == 12) { if (c < 64) { dst = c; act = 2; } else if (c < 128) dst = 256 + (c - 64); else if (c < 160) dst = 512 + (c - 128); }
                else if (c < 160) { dst = 768 + c; act = 3; }
                if (dst >= 0) {
#pragma unroll
                    for (int ai = 0; ai < 2; ++ai)
#pragma unroll
                        for (int m = 0; m < 4; ++m) { const size_t r = (size_t)(row0 + ai * HALF + m * 16); f32x4 v0 = acc[ai][bj][m][0], v1 = acc[ai][bj][m][1];
#pragma unroll
                            for (int q = 0; q < 4; ++q) { v0[q] = act_apply(v0[q], act); v1[q] = act_apply(v1[q], act); }
                            u32x4 w; w.x = cvt_pk_bf16(v0[0], v0[1]); w.y = cvt_pk_bf16(v0[2], v0[3]); w.z = cvt_pk_bf16(v1[0], v1[1]); w.w = cvt_pk_bf16(v1[2], v1[3]);
                            *(u32x4*)(LO + r * 1024 + dst) = w; } } }
        }
    }
};
struct EpiRes {
    static constexpr bool PERM = false;
    float* X; const float* modl; int goff; const float* Xin;
    __device__ __forceinline__ void operator()(const f32x4 (&acc)[2][2][4][2], const Unit& u, int wr, int wc, int fr, int fq) const {
        const int col0 = u.pn * BM + wc * 32 + 4 * fq;
#pragma unroll
        for (int ai = 0; ai < 2; ++ai)
#pragma unroll
            for (int m = 0; m < 4; ++m) { const int r = u.pm * BM + ai * HALF + wr * 64 + m * 16 + fr; const float* gp = modl + (size_t)seq_of_row(r) * 6144 + goff + col0; float* xp = X + (size_t)r * D + col0; const float* xi = Xin + (size_t)r * D + col0;
#pragma unroll
                for (int bj = 0; bj < 2; ++bj)
#pragma unroll
                    for (int n = 0; n < 2; ++n) { const f32x4 gv = *(const f32x4*)(gp + bj * HALF + n * 16); f32x4 xv = *(const f32x4*)(xi + bj * HALF + n * 16);
                        xv = xv + gv * acc[ai][bj][m][n]; *(f32x4*)(xp + bj * HALF + n * 16) = xv; }
                asm volatile("" ::: "memory"); }
    }
};
struct EpiLora2 {
    static constexpr bool PERM = false;
    bf16_t* WLOG; bf16_t* Aout; bf16_t* G; bf16_t* RKV; const bf16_t* vf; const float* w0; const float* a0; const float* v0;
    template <int GRP> __device__ __forceinline__ void run(const f32x4 (&acc)[2][2][4][2], const Unit& u, int wr, int wc, int fr, int fq) const {
        const int col0 = (u.pn & 3) * BM + wc * 32 + 4 * fq;
#pragma unroll
        for (int ai = 0; ai < 2; ++ai)
#pragma unroll
            for (int m = 0; m < 4; ++m) { const size_t r = (size_t)(u.pm * BM + ai * HALF + wr * 64 + m * 16 + fr);
#pragma unroll
                for (int bj = 0; bj < 2; ++bj)
#pragma unroll
                    for (int n = 0; n < 2; ++n) { const int c = col0 + bj * HALF + n * 16; const f32x4 a = acc[ai][bj][m][n]; f32x4 o;
                        if constexpr (GRP == 0) { const f32x4 b = *(const f32x4*)(w0 + c);
#pragma unroll
                            for (int q = 0; q < 4; ++q) { const float x = -(b[q] + a[q]); const float sp = fmaxf(x, 0.f) + __logf(1.f + __expf(-fabsf(x))); o[q] = -__expf(-sp - 0.5f); }
                            u32x2 w; w.x = cvt_pk_bf16(o[0], o[1]); w.y = cvt_pk_bf16(o[2], o[3]); *(u32x2*)(WLOG + r * D + c) = w; }
                        else if constexpr (GRP == 1) { const f32x4 b = *(const f32x4*)(a0 + c);
#pragma unroll
                            for (int q = 0; q < 4; ++q) o[q] = 1.f / (1.f + __expf(-(b[q] + a[q])));
                            u32x2 w; w.x = cvt_pk_bf16(o[0], o[1]); w.y = cvt_pk_bf16(o[2], o[3]); *(u32x2*)(Aout + r * D + c) = w; }
                        else if constexpr (GRP == 2) { const f32x4 b = *(const f32x4*)(v0 + c); const u32x2 vv = *(const u32x2*)(RKV + r * 3072 + 2048 + c), ff = *(const u32x2*)(vf + r * D + c);
                            f32x4 v4, f4; v4[0] = bflo(vv.x); v4[1] = bfhi(vv.x); v4[2] = bflo(vv.y); v4[3] = bfhi(vv.y); f4[0] = bflo(ff.x); f4[1] = bfhi(ff.x); f4[2] = bflo(ff.y); f4[3] = bfhi(ff.y);
#pragma unroll
                            for (int q = 0; q < 4; ++q) { const float gte = 1.f / (1.f + __expf(-(b[q] + a[q]))); o[q] = v4[q] + (f4[q] - v4[q]) * gte; }
                            u32x2 w; w.x = cvt_pk_bf16(o[0], o[1]); w.y = cvt_pk_bf16(o[2], o[3]); *(u32x2*)(RKV + r * 3072 + 2048 + c) = w; }
                        else { u32x2 w; w.x = cvt_pk_bf16(a[0], a[1]); w.y = cvt_pk_bf16(a[2], a[3]); *(u32x2*)(G + r * D + c) = w; } }
                asm volatile("" ::: "memory"); }
    }
    __device__ __forceinline__ void operator()(const f32x4 (&acc)[2][2][4][2], const Unit& u, int wr, int wc, int fr, int fq) const {
        const int grp = u.pn >> 2;
        if (grp == 0) run<0>(acc, u, wr, wc, fr, fq);
        else if (grp == 1) run<1>(acc, u, wr, wc, fr, fq);
        else if (grp == 2) { if (vf != nullptr) run<2>(acc, u, wr, wc, fr, fq); }
        else run<3>(acc, u, wr, wc, fr, fq);
    }
};
struct SplitOrder {
    int c, splitk;
    __device__ bool next(int i, Unit& u) const { if (i != 0 || c >= 16 * splitk) return false; const int t = c / splitk; u.pm = 64 + (t >> 2); u.pn = t & 3; u.ks = c % splitk; return true; }
};
struct SkipVOrder {
    StaticOrder S; bool skip;
    __device__ bool next(int i, Unit& u) const { if (!S.next(i, u)) return false; if (skip && u.pn >= 8) u.pn += 4; return true; }
};
struct LoraOrder {
    int c;
    __device__ bool next(int i, Unit& u) const { const int idx = c - 48; if (i != 0 || idx < 0 || idx >= 136) return false; u.pm = idx >> 1; u.pn = 12 + (idx & 1); u.ks = 0; return true; }
};
struct EpiPartial {
    static constexpr bool PERM = false;
    float* PART; int splitk;
    __device__ __forceinline__ void operator()(const f32x4 (&acc)[2][2][4][2], const Unit& u, int wr, int wc, int fr, int fq) const {
        float* base = PART + ((size_t)(((u.pm - 64) * 4 + u.pn) * splitk + u.ks) << 16) + wc * 32 + 4 * fq;
#pragma unroll
        for (int ai = 0; ai < 2; ++ai)
#pragma unroll
            for (int m = 0; m < 4; ++m) { float* rp = base + (ai * HALF + wr * 64 + m * 16 + fr) * 256;
#pragma unroll
                for (int bj = 0; bj < 2; ++bj)
#pragma unroll
                    for (int n = 0; n < 2; ++n) *(f32x4*)(rp + bj * HALF + n * 16) = acc[ai][bj][m][n]; }
    }
};
template <bool PERM_> struct EpiNull {
    static constexpr bool PERM = PERM_;
    __device__ __forceinline__ void operator()(const f32x4 (&acc)[2][2][4][2], const Unit&, int, int, int, int) const {
#pragma unroll
        for (int a = 0; a < 2; ++a)
#pragma unroll
            for (int b = 0; b < 2; ++b)
#pragma unroll
                for (int m = 0; m < 4; ++m)
#pragma unroll
                    for (int n = 0; n < 2; ++n) asm volatile("" :: "v"(acc[a][b][m][n]));
    }
};
}

#define RLX_AGENT __ATOMIC_RELAXED, __HIP_MEMORY_SCOPE_AGENT
#define XB_TMO      128
#define XB_XCNT(j)  (256  + 64 * (j))
#define XB_XSUB(j)  (1280 + 64 * (j))
#define XB_XGEN(j)  (2304 + 64 * (j))
#define XB_TOP      3328
#define XB_TOPGEN   3392
#define XCD_BAR_WORDS 3456
#define XB_SPIN_CAP (1u << 24)
__device__ __forceinline__ unsigned xb_ld(unsigned* p)              { return __hip_atomic_load(p, __ATOMIC_RELAXED, __HIP_MEMORY_SCOPE_AGENT); }
__device__ __forceinline__ unsigned xb_add(unsigned* p, unsigned v) { return __hip_atomic_fetch_add(p, v, __ATOMIC_RELAXED, __HIP_MEMORY_SCOPE_AGENT); }
__device__ __forceinline__ unsigned xb_xcc_id() { return (unsigned)__builtin_amdgcn_s_getreg((3 << 11) | 20) & 0xFu; }
#define XB_SPIN(cond, bar) do { unsigned _sp = 0; while (cond) { __builtin_amdgcn_s_sleep(4); \
    if ((++_sp & 255u) == 0u) { if (xb_ld(&(bar)[XB_TMO])) break; if (_sp > XB_SPIN_CAP) { atomicAdd(&(bar)[XB_TMO], 1u); break; } } } } while (0)
struct XcdBarrier { unsigned* bar; unsigned x; volatile LAS unsigned* st; };
__device__ __forceinline__ XcdBarrier xcd_barrier_post(unsigned* bar, volatile LAS unsigned* st) {
    XcdBarrier b; b.bar = bar; b.x = xb_xcc_id(); b.st = st;
    if (threadIdx.x == 0) (void)xb_add(&bar[XB_XCNT(b.x)], 1u);
    return b;
}
__device__ __forceinline__ void xcd_barrier_complete(unsigned* bar, unsigned x, unsigned& nloc, unsigned& nx) {
    const unsigned G = gridDim.x * gridDim.y * gridDim.z;
    unsigned sum, cnt, mine, sp = 0u;
    for (;;) {
        sum = 0u; cnt = 0u; mine = 0u;
#pragma unroll
        for (unsigned j = 0; j < 16; ++j) { const unsigned c = xb_ld(&bar[XB_XCNT(j)]); sum += c; cnt += (c > 0u) ? 1u : 0u; mine = (j == x) ? c : mine; }
        if (sum == G) break;
        __builtin_amdgcn_s_sleep(1);
        if ((++sp & 255u) == 0u) { if (xb_ld(&bar[XB_TMO])) break; if (sp > XB_SPIN_CAP) { atomicAdd(&bar[XB_TMO], 1u); break; } }
    }
    nloc = mine > 0u ? mine : 1u; nx = cnt > 0u ? cnt : 1u;
}
__device__ __forceinline__ void xcd_barrier(const XcdBarrier& b) {
    asm volatile("s_waitcnt vmcnt(0)" ::: "memory");
    __syncthreads();
    if (threadIdx.x == 0) {
        unsigned* bar = b.bar;
        __builtin_amdgcn_s_waitcnt(0);
        unsigned nloc = b.st[0], nx = b.st[1];
        if (nloc == 0u) { xcd_barrier_complete(bar, b.x, nloc, nx); b.st[0] = nloc; b.st[1] = nx; }
        const unsigned gen = b.st[2];
        const unsigned old = xb_add(&bar[XB_XSUB(b.x)], 1u);
        if (old + 1u == (gen + 1u) * nloc) {
            __builtin_amdgcn_fence(__ATOMIC_RELEASE, "agent");
            asm volatile("s_waitcnt vmcnt(0)" ::: "memory");
            const unsigned og = xb_add(&bar[XB_TOP], 1u);
            if (og + 1u == (gen + 1u) * nx) xb_add(&bar[XB_TOPGEN], 1u);
            else XB_SPIN(xb_ld(&bar[XB_TOPGEN]) == gen, bar);
        } else {
            XB_SPIN(xb_ld(&bar[XB_TOPGEN]) == gen, bar);
        }
        __builtin_amdgcn_fence(__ATOMIC_ACQUIRE, "agent");
        asm volatile("s_waitcnt vmcnt(0)" ::: "memory");
        b.st[2] = gen + 1u;
    }
    __syncthreads();
}

constexpr int NWAVES = 8, NT = NWAVES * 64;
constexpr int RING_BYTES = 131072, LDSCTL_OFF = RING_BYTES, MISC_OFF = LDSCTL_OFF + 320, LDS_BYTES = 147456;
constexpr int CW_BAR = 4096;

struct Args { const float* in[38]; float* out; unsigned char* ws; };
struct Frame {
    LAS unsigned char* lds; volatile LAS unsigned* MISC;
    int wave, vcu, G;
    const float* const* in; float* out; unsigned char* ws;
};
enum { I_XP = 0, I_XS, I_SRET, I_SHG, I_SWKV, I_SSHIFT, I_CP, I_CS, I_MODW, I_MODB, I_NMIXG, I_NMLPG, I_FINALG, I_W1, I_W2, I_ABWIN, I_ABWOUT, I_HGLB, I_HGNG,
       I_MU, I_WRKV, I_RW0, I_RW1, I_RW2, I_RA0, I_RA1, I_RA2, I_RV0, I_RV1, I_RV2, I_RG1, I_RG2, I_RKK, I_RKA, I_RRK, I_RLNG, I_RLNB, I_RWOUT };
constexpr size_t O_Y = 0, O_RETP = 17825792, O_RETS = 17891328, O_HGP = 19988480, O_HGS = 20119552, O_WKVP = 24313856, O_WKVS = 24444928, O_SHP = 28639232, O_SHS = 28641280;

__device__ __forceinline__ void transpose_item(const float* W, int N, bf16_t* WT, int ldt, int row_off, int col_off, const float* mu, int mode, LAS float* scr, int item, int lane) {
    const int nblk = N / 32, kb = item / nblk, nb = item % nblk, k0 = 64 * kb, n0 = 32 * nb;
#pragma unroll 8
    for (int i = 0; i < 32; ++i) { const int kk = 2 * i + (lane >> 5); float s = 1.f; if (mode == 1) s = 1.f - mu[k0 + kk]; else if (mode == 2) s = mu[k0 + kk];
        scr[kk * 33 + (lane & 31)] = W[(size_t)(k0 + kk) * N + n0 + (lane & 31)] * s; }
    LDS_WAIT(); asm volatile("" ::: "memory");
    const int c = lane & 7;
#pragma unroll
    for (int j = 0; j < 4; ++j) { const int n = (lane >> 3) + 8 * j; const LAS float* s = scr + (8 * c) * 33 + n;
        u32x4 o; o.x = pk2(s[0 * 33], s[1 * 33]); o.y = pk2(s[2 * 33], s[3 * 33]); o.z = pk2(s[4 * 33], s[5 * 33]); o.w = pk2(s[6 * 33], s[7 * 33]);
        *(u32x4*)(WT + (size_t)(row_off + n0 + n) * ldt + col_off + k0 + 8 * c) = o; }
    LDS_WAIT(); asm volatile("" ::: "memory");
}
__device__ __forceinline__ void convert_layer_weights(Frame& F, int layer) {
    const int tid = otid(); const int lane = tid & 63; (void)lane;
    LAS float* scr = (LAS float*)(F.lds + F.wave * 16384);
    const int gw = F.vcu * NWAVES + F.wave, NGW = F.G * NWAVES;
    unsigned char* ar = F.ws + WS_ARENA;
    const int m = layer >> 1;
    constexpr int I_1 = (D / 64) * (DFF / 32), I_2 = (DFF / 64) * (D / 32);
    const float* w1 = F.in[I_W1] + (size_t)layer * D * DFF; const float* w2 = F.in[I_W2] + (size_t)layer * DFF * D;
    if ((layer & 1) == 0) {
        constexpr int I_IN = (D / 64) * (ABIN / 32), I_OUT = (D / 64) * (D / 32), NI = I_1 + I_2 + I_IN + I_OUT;
        const float* win = F.in[I_ABWIN] + (size_t)m * D * ABIN; const float* wout = F.in[I_ABWOUT] + (size_t)m * D * D;
        for (int it = gw; it < NI; it += NGW) { int r = it;
            if (r < I_1) { transpose_item(w1, DFF, (bf16_t*)(ar + AR_W1), D, 0, 0, nullptr, 0, scr, r, lane); continue; } r -= I_1;
            if (r < I_2) { transpose_item(w2, D, (bf16_t*)(ar + AR_W2), DFF, 0, 0, nullptr, 0, scr, r, lane); continue; } r -= I_2;
            if (r < I_IN) { transpose_item(win, ABIN, (bf16_t*)(ar + AR_WIN), D, 0, 0, nullptr, 0, scr, r, lane); continue; } r -= I_IN;
            transpose_item(wout, D, (bf16_t*)(ar + AR_WOUT), D, 0, 0, nullptr, 0, scr, r, lane); }
    } else {
        constexpr int I_P = (D / 64) * (D / 32), NI = I_1 + I_2 + 4 * I_P;
        const float* mu = F.in[I_MU] + (size_t)m * 6 * D; const float* wrkv = F.in[I_WRKV] + (size_t)m * 3 * D * D; const float* wo = F.in[I_RWOUT] + (size_t)m * D * D;
        bf16_t* wc1 = (bf16_t*)(ar + AR_WC1);
        for (int it = gw; it < NI; it += NGW) { int r = it;
            if (r < I_1) { transpose_item(w1, DFF, (bf16_t*)(ar + AR_W1), D, 0, 0, nullptr, 0, scr, r, lane); continue; } r -= I_1;
            if (r < I_2) { transpose_item(w2, D, (bf16_t*)(ar + AR_W2), DFF, 0, 0, nullptr, 0, scr, r, lane); continue; } r -= I_2;
            if (r < 3 * I_P) { const int p = r / I_P;
                transpose_item(wrkv + (size_t)p * D * D, D, wc1, 2048, p * D, 0, nullptr, 0, scr, r % I_P, lane); continue; } r -= 3 * I_P;
            transpose_item(wo, D, (bf16_t*)(ar + AR_WO), D, 0, 0, nullptr, 0, scr, r, lane); }
        const int gt = F.vcu * NT + tid, NG = F.G * NT;
        const float* lw1 = F.in[I_RW1] + (size_t)m * D * 64; const float* la1 = F.in[I_RA1] + (size_t)m * D * 64; const float* lv1 = F.in[I_RV1]; const float* lg1 = F.in[I_RG1] + (size_t)m * D * 160;
        for (int idx = gt; idx < 512 * 2048; idx += NG) { const int n = idx >> 11, k = idx & 2047, kk = k & 1023, nn = n & 255;
            const float* src = nullptr; int ns = 0, mi = 0, nc = 0;
            if (n < 256) { if (nn < 64) { src = lw1; ns = 64; mi = 1; nc = nn; } else if (nn < 128) { src = la1; ns = 64; mi = 4; nc = nn - 64; } else if (nn < 160 && m == 1) { src = lv1; ns = 32; mi = 3; nc = nn - 128; } }
            else if (nn < 160) { src = lg1; ns = 160; mi = 5; nc = nn; }
            float v = 0.f; if (src) { const float muv = mu[mi * D + kk]; v = src[(size_t)kk * ns + nc] * (k < 1024 ? 1.f - muv : muv); }
            wc1[(size_t)(3072 + n) * 2048 + k] = (bf16_t)f2bf(v); }
        bf16_t* wc2 = (bf16_t*)(ar + AR_WC2);
        const float* lw2 = F.in[I_RW2] + (size_t)m * 64 * D; const float* la2 = F.in[I_RA2] + (size_t)m * 64 * D; const float* lv2 = F.in[I_RV2]; const float* lg2 = F.in[I_RG2] + (size_t)m * 160 * D;
        for (int idx = gt; idx < 4096 * 256; idx += NG) { const int k = idx >> 12, n = idx & 4095, g = n >> 10, nn = n & 1023;
            const float* src = (g == 0) ? lw2 : (g == 1) ? la2 : (g == 2) ? lv2 : lg2; const int ks = (g == 0 || g == 1) ? 64 : (g == 2 ? 32 : 160);
            float v = 0.f; if (k < ks && !(g == 2 && m == 0)) v = src[(size_t)k * D + nn];
            wc2[(size_t)n * 256 + k] = (bf16_t)f2bf(v); }
    }
}

__device__ __forceinline__ void mod_phase(Frame& F, int l_lo, int l_hi, int wb, int nb) {
    const int tid = otid(); const int lane = tid & 63;
    const float* __restrict__ SC = (const float*)(F.ws + WS_MOD + 3584 * 1024);
    float* MOD = (float*)(F.ws + WS_MOD);
    LAS float* red = (LAS float*)F.lds;
    for (int task = l_lo * 96 + wb; task < l_hi * 96; task += nb) { const int l = task / 96, n = (task % 96) * 64 + lane, ks = F.wave;
        const float* w = F.in[I_MODW] + ((size_t)l * D + ks * 128) * 6144 + n;
        float acc[NSEQ];
#pragma unroll
        for (int s = 0; s < NSEQ; ++s) acc[s] = 0.f;
        for (int k = 0; k < 128; k += 4) { const float w0 = w[(size_t)k * 6144], w1 = w[(size_t)(k + 1) * 6144], w2 = w[(size_t)(k + 2) * 6144], w3 = w[(size_t)(k + 3) * 6144];
#pragma unroll
            for (int s = 0; s < NSEQ; ++s) { const f32x4 c4 = *(const f32x4*)(SC + s * D + ks * 128 + k); acc[s] += (c4[0] * w0 + c4[1] * w1) + (c4[2] * w2 + c4[3] * w3); } }
        __syncthreads();
#pragma unroll
        for (int s = 0; s < NSEQ; ++s) red[(F.wave * NSEQ + s) * 64 + lane] = acc[s];
        __syncthreads();
        for (int i = tid; i < NSEQ * 64; i += NT) { const int s = i >> 6, c = i & 63; float t = F.in[I_MODB][l * 6144 + (task % 96) * 64 + c];
#pragma unroll
            for (int q = 0; q < 8; ++q) t += red[(q * NSEQ + s) * 64 + c];
            MOD[((size_t)l * NSEQ + s) * 6144 + (task % 96) * 64 + c] = t; }
    }
    __syncthreads();
}

__device__ __forceinline__ void prologue(Frame& F) {
    const int tid = otid(); const int lane = tid & 63; (void)lane;
    const int gt = F.vcu * NT + tid, NG = F.G * NT;
    { f32x2* tab = (f32x2*)(F.ws + WS_ROPE);
      for (int i = gt; i < 16384 * 32; i += NG) { const int p = i >> 5, d = i & 31; double rev = (double)p * ROPE_REV[d]; rev -= floor(rev); const float fr = (float)rev;
          tab[i] = (f32x2){__builtin_amdgcn_cosf(fr), __builtin_amdgcn_sinf(fr)}; } }
    { unsigned* z = (unsigned*)(F.ws + WS_XN0); for (int i = gt; i < 512; i += NG) z[i] = 0u; }
    { float* SC = (float*)(F.ws + WS_MOD + 3584 * 1024);
      for (int i = gt; i < NSEQ * D; i += NG) { const int s = i >> 10, k = i & 1023; const float c = (s == 0) ? F.in[I_CP][k] : F.in[I_CS][(size_t)(s - 1) * D + k]; SC[i] = siluf_(c); } }
    convert_layer_weights(F, 0);
}

template <int MODE> __device__ __forceinline__ void norm_row(Frame& F, int layer, int r, f32x4 (&v)[4], const float* MOD, const float* gvec, int lane, f32x4 (&ho)[4]) {
    const int m = layer >> 1; const int shoff = (MODE == 2) ? 3072 : 0, scoff = (MODE == 2) ? 4096 : 1024;
    bf16_t* XN = (bf16_t*)(F.ws + WS_XN); bf16_t* PREVS = (bf16_t*)(F.ws + WS_PREVS);
    float* xrow = F.out + (size_t)r * D; float s2 = 0.f;
#pragma unroll
    for (int j = 0; j < 4; ++j) s2 += (v[j].x * v[j].x + v[j].y * v[j].y) + (v[j].z * v[j].z + v[j].w * v[j].w);
    const float rstd = 1.f / sqrtf(wave_sum(s2) * (1.f / D) + NORM_EPS);
    const int seq = seq_of_row(r); const float* mp = MOD + (size_t)seq * 6144;
#pragma unroll
    for (int j = 0; j < 4; ++j) { const int c = 4 * lane + 256 * j; const f32x4 g4 = *(const f32x4*)(gvec + c); f32x4 o = v[j] * rstd * g4;
        if (MODE == 3) { *((f32x4*)xrow + lane + 64 * j) = o; continue; }
        const f32x4 sc = *(const f32x4*)(mp + scoff + c), sh = *(const f32x4*)(mp + shoff + c);
        o = o * (1.f + sc) + sh; ho[j] = o;
        const unsigned long long pk = (unsigned long long)pk2(o.x, o.y) | ((unsigned long long)pk2(o.z, o.w) << 32);
        *(unsigned long long*)(XN + (size_t)r * D + c) = pk;
        if (MODE == 1) {
            if (r >= MP) { const int t = (r - MP) & 31; if (t < 31) *(unsigned long long*)(PREVS + (size_t)(r - MP + 1) * D + c) = pk;
                else *(f32x4*)(F.out + O_SHS + ((size_t)m * 32 + ((r - MP) >> 5)) * D + c) = o;
                if (t == 0) { const f32x4 ss = *(const f32x4*)(F.in[I_SSHIFT] + ((size_t)m * 32 + ((r - MP) >> 5)) * D + c);
                    *(unsigned long long*)(PREVS + (size_t)(r - MP) * D + c) = (unsigned long long)pk2(ss.x, ss.y) | ((unsigned long long)pk2(ss.z, ss.w) << 32); } }
            else if (r == MP - 1) *(f32x4*)(F.out + O_SHP + (size_t)m * D + c) = o;
        } }
}
__device__ __forceinline__ void hmix_calc(const float* mp, const float* gvec, const f32x4 (&v)[4], int lane, f32x4 (&h)[4]) {
    float s2 = 0.f;
#pragma unroll
    for (int j = 0; j < 4; ++j) s2 += (v[j].x * v[j].x + v[j].y * v[j].y) + (v[j].z * v[j].z + v[j].w * v[j].w);
    const float rstd = 1.f / sqrtf(wave_sum(s2) * (1.f / D) + NORM_EPS);
#pragma unroll
    for (int j = 0; j < 4; ++j) { const int c = 4 * lane + 256 * j; const f32x4 g4 = *(const f32x4*)(gvec + c), sc = *(const f32x4*)(mp + 1024 + c), sh = *(const f32x4*)(mp + c); h[j] = v[j] * rstd * g4 * (1.f + sc) + sh; }
}
__device__ __forceinline__ void write_mixes(Frame& F, int m, int r, const f32x4 (&h)[4], const f32x4 (&p)[4], int lane) {
    bf16_t* XM = (bf16_t*)(F.ws + WS_XMIX); const float* mu = F.in[I_MU] + (size_t)m * 6 * D;
#pragma unroll
    for (int j = 0; j < 4; ++j) { const int c = 4 * lane + 256 * j; const f32x4 d = p[j] - h[j];
#pragma unroll
        for (int q = 0; q < 3; ++q) { const f32x4 mv = *(const f32x4*)(mu + (q == 0 ? 0 : (q == 1 ? 2 : 3)) * D + c); const f32x4 x = h[j] + d * mv;
            *(unsigned long long*)(XM + ((size_t)q * M + r) * D + c) = (unsigned long long)pk2(x.x, x.y) | ((unsigned long long)pk2(x.z, x.w) << 32); } }
}
template <int MODE, int PEND = 0, bool FIRSTP = false> __device__ __forceinline__ void norm_pass(Frame& F, int layer, int player, int pgoff, const float* sx_in, float* sx_out) {
    const int tid = otid(); const int lane = tid & 63;
    const int gw = F.vcu * NWAVES + F.wave, NGW = F.G * NWAVES;
    const float* MOD = (const float*)(F.ws + WS_MOD) + (size_t)layer * NSEQ * 6144;
    const float* gvec = (MODE == 3) ? F.in[I_FINALG] : (MODE == 2 ? F.in[I_NMLPG] + layer * D : F.in[I_NMIXG] + layer * D);
    constexpr int HALO = (MODE == 1) ? 1 : 0;
    LAS float* xs = (LAS float*)F.lds;
    const int m = layer >> 1; const int r0s = MP + 4 * F.vcu;
    const float* gmod = (const float*)(F.ws + WS_MOD) + (size_t)player * NSEQ * 6144 + pgoff;
    if constexpr (PEND > 0) {
        __syncthreads();
#pragma unroll
        for (int q = 0; q < (4 + HALO + 1) / 2; ++q) { const int idx = tid + q * NT, rr = idx >> 8, c4 = (idx & 255) * 4; const int r = r0s - HALO + rr;
            if (rr < 4 + HALO && !(HALO && rr == 0 && ((r0s - MP) & 31) == 0)) {
                const int pn = c4 >> 8; const float* pb = (const float*)(F.ws + WS_PART) + ((size_t)((((r >> 8) - 64) * 4 + pn) * PEND) << 16) + (r & 255) * 256 + (c4 & 255);
                f32x4 acc = (f32x4){0.f, 0.f, 0.f, 0.f};
#pragma unroll
                for (int ks = 0; ks < PEND; ++ks) acc += *(const f32x4*)(pb + ((size_t)ks << 16));
                const f32x4 g4 = *(const f32x4*)(gmod + (size_t)seq_of_row(r) * 6144 + c4); f32x4 x4 = *(const f32x4*)(sx_in + (size_t)(r - MP) * D + c4);
                x4 = x4 + g4 * acc; if (sx_out != nullptr && !(HALO && rr == 0)) *(f32x4*)(sx_out + (size_t)(r - MP) * D + c4) = x4; *(LAS f32x4*)(xs + rr * 1024 + c4) = x4; } }
        __syncthreads();
    }
    for (int r = gw; r < MP; r += NGW) {
        const f32x4* xr = (const f32x4*)((FIRSTP ? F.in[I_XP] : F.out) + (size_t)r * D) + lane; f32x4 v[4], ho[4];
#pragma unroll
        for (int j = 0; j < 4; ++j) v[j] = xr[64 * j];
        if constexpr (MODE == 1) { f32x4 pv[4], hp[4];
#pragma unroll
            for (int j = 0; j < 4; ++j) pv[j] = (r > 0) ? *((const f32x4*)(F.out + (size_t)(r - 1) * D) + lane + 64 * j) : (f32x4){0.f, 0.f, 0.f, 0.f};
            norm_row<MODE>(F, layer, r, v, MOD, gvec, lane, ho);
            if (r > 0) hmix_calc(MOD, gvec, pv, lane, hp); else {
#pragma unroll
                for (int j = 0; j < 4; ++j) hp[j] = (f32x4){0.f, 0.f, 0.f, 0.f}; }
            write_mixes(F, m, r, ho, hp, lane);
        } else norm_row<MODE>(F, layer, r, v, MOD, gvec, lane, ho);
    }
    if (F.wave < 4 && 4 * F.vcu + F.wave < MS) { const int r = r0s + F.wave; f32x4 v[4], ho[4];
#pragma unroll
        for (int j = 0; j < 4; ++j) { if constexpr (PEND > 0) v[j] = *(const LAS f32x4*)(xs + (F.wave + HALO) * 1024 + 4 * lane + 256 * j); else v[j] = *((const f32x4*)(sx_in + (size_t)(r - MP) * D) + lane + 64 * j); }
        norm_row<MODE>(F, layer, r, v, MOD, gvec, lane, ho);
        if constexpr (MODE == 1) { f32x4 hp[4]; const int t = (r - MP) & 31, sq = (r - MP) >> 5;
            if (t == 0) {
#pragma unroll
                for (int j = 0; j < 4; ++j) hp[j] = *((const f32x4*)(F.in[I_SSHIFT] + ((size_t)m * 32 + sq) * D) + lane + 64 * j);
            } else { f32x4 pv[4];
#pragma unroll
                for (int j = 0; j < 4; ++j) pv[j] = *(const LAS f32x4*)(xs + (F.wave + HALO - 1) * 1024 + 4 * lane + 256 * j);
                hmix_calc(MOD + (size_t)(1 + sq) * 6144, gvec, pv, lane, hp); }
            write_mixes(F, m, r, ho, hp, lane); } }
}

template <int MT, int NTT> __device__ __forceinline__ void wave_mm_nt(f32x4 (&acc)[MT][NTT], const LAS bf16_t* X, int ldx, const LAS bf16_t* Y, int ldy, int K, int fr, int fq) {
    for (int k0 = 0; k0 < K; k0 += 32) {
        bf16x8 xa[MT], yb[NTT];
#pragma unroll
        for (int i = 0; i < MT; ++i) xa[i] = *(const LAS bf16x8*)(X + (16 * i + fr) * ldx + k0 + 8 * fq);
#pragma unroll
        for (int j = 0; j < NTT; ++j) yb[j] = *(const LAS bf16x8*)(Y + (16 * j + fr) * ldy + k0 + 8 * fq);
#pragma unroll
        for (int i = 0; i < MT; ++i)
#pragma unroll
            for (int j = 0; j < NTT; ++j) acc[i][j] = __builtin_amdgcn_mfma_f32_16x16x32_bf16(yb[j], xa[i], acc[i][j], 0, 0, 0);
    }
}

constexpr int LQS = 0, LKS = 18432, LQG = 36864, LVT = 55296, LST = 73728, LPS = 108544, LRED = 117760, LBS = 118784;
__device__ __forceinline__ void chunk_geom(int c, int& r0, int& pos0) { if (c < 256) { r0 = 64 * c; pos0 = 64 * c; } else { r0 = MP + 32 * (c - 256); pos0 = 2048; } }

template <int L, bool HG, bool SUMMARY> __device__ __forceinline__ void ab_load(Frame& F, int layer, int c, int h) {
    const int tid = otid(); const int lane = tid & 63; (void)lane;
    const int m = layer >> 1; int r0, pos0; chunk_geom(c, r0, pos0);
    const bf16_t* Z = (const bf16_t*)(F.ws + WS_Z);
    LAS bf16_t* QS = (LAS bf16_t*)(F.lds + LQS); LAS bf16_t* KS = (LAS bf16_t*)(F.lds + LKS); LAS bf16_t* QG = (LAS bf16_t*)(F.lds + LQG); LAS bf16_t* VT = (LAS bf16_t*)(F.lds + LVT);
    constexpr int LDT = L + 8;
    if constexpr (HG) {
        constexpr int TQ = L / 4; LAS float* BS = (LAS float*)(F.lds + LBS);
        const int ch = tid & 127, qtr = tid >> 7;
        float lb = 0.f;
        if (m == 1) { const float a0 = F.in[I_HGLB][h * 128 + ch], a1 = F.in[I_HGLB][512 + h * 128 + ch]; lb = 1.f / (1.f + __expf(a0 - a1)); }
        { constexpr int NP = L * 16;
#pragma unroll
          for (int q = 0; q < (NP + NT - 1) / NT; ++q) { const int v = tid + q * NT; if (NP % NT == 0 || v < NP) { const int j = v >> 4, c8 = v & 15; const size_t zr = (size_t)(r0 + j) * ABIN + h * 128 + c8 * 8;
                  const u32x4 zf4 = *(const u32x4*)(Z + zr + 2048), v4 = *(const u32x4*)(Z + zr + 2560);
                  *(LAS u32x4*)(QG + j * 136 + c8 * 8) = zf4; *(LAS u32x4*)(KS + j * 136 + c8 * 8) = v4;
                  if constexpr (!SUMMARY) { const u32x4 q4 = *(const u32x4*)(Z + zr + 1536); *(LAS u32x4*)(QS + j * 136 + c8 * 8) = q4; } } } }
        __syncthreads();
        float zf[TQ], cs[TQ]; float run = 0.f;
#pragma unroll
        for (int jj = 0; jj < TQ; ++jj) { const int j = qtr * TQ + jj; zf[jj] = bf2f(QG[j * 136 + ch]);
            float lf; if (lb == 0.f) lf = fminf(zf[jj], 0.f) - __logf(1.f + __expf(-fabsf(zf[jj]))); else lf = __logf(lb + (1.f - lb) * sigmoidf_(zf[jj]));
            run += lf; cs[jj] = run; }
        BS[qtr * 128 + ch] = run;
        __syncthreads();
        const float b0 = BS[ch], b1 = BS[128 + ch], b2 = BS[256 + ch], b3 = BS[384 + ch];
        const float off = (qtr > 0 ? b0 : 0.f) + (qtr > 1 ? b1 : 0.f) + (qtr > 2 ? b2 : 0.f), bL = (b0 + b1) + (b2 + b3), bmid = b0 + b1;
        if constexpr (SUMMARY) {
#pragma unroll
            for (int j8 = 0; j8 < TQ; j8 += 8) { unsigned vv[8]; float kd[8];
#pragma unroll
                for (int q = 0; q < 8; ++q) { const int jj = j8 + q, j = qtr * TQ + jj; const float b = off + cs[jj]; const float kb = (1.f - lb) * sigmoidf_(-zf[jj]); vv[q] = KS[j * 136 + ch]; kd[q] = kb * __expf(bL - b); }
                u32x4 pv, pk; pv.x = vv[0] | (vv[1] << 16); pv.y = vv[2] | (vv[3] << 16); pv.z = vv[4] | (vv[5] << 16); pv.w = vv[6] | (vv[7] << 16);
                pk.x = pk2(kd[0], kd[1]); pk.y = pk2(kd[2], kd[3]); pk.z = pk2(kd[4], kd[5]); pk.w = pk2(kd[6], kd[7]);
                *(LAS u32x4*)(VT + ch * LDT + qtr * TQ + j8) = pv; *(LAS u32x4*)(QS + ch * LDT + qtr * TQ + j8) = pk; }
            if (qtr == 0) ((float*)(F.ws + WS_DEC))[((size_t)c * 4 + h) * 128 + ch] = __expf(bL);
        } else {
#pragma unroll
            for (int j8 = 0; j8 < TQ; j8 += 8) { unsigned vv[8];
#pragma unroll
                for (int q8 = 0; q8 < 8; ++q8) { const int jj = j8 + q8, j = qtr * TQ + jj; const float b = off + cs[jj]; const float kb = (1.f - lb) * sigmoidf_(-zf[jj]);
                    const float q = siluf_(bf2f(QS[j * 136 + ch])); vv[q8] = KS[j * 136 + ch];
                    QS[j * 136 + ch] = (bf16_t)f2bf(q * __expf(b - bmid)); KS[j * 136 + ch] = (bf16_t)f2bf(kb * __expf(bmid - b)); QG[j * 136 + ch] = (bf16_t)f2bf(q * __expf(b)); }
                u32x4 pv; pv.x = vv[0] | (vv[1] << 16); pv.y = vv[2] | (vv[3] << 16); pv.z = vv[4] | (vv[5] << 16); pv.w = vv[6] | (vv[7] << 16);
                *(LAS u32x4*)(VT + ch * LDT + qtr * TQ + j8) = pv; }
        }
    } else {
        const float logg = log1pf(-exp2f(-5.f - (float)h));
        const f32x2* rope = (const f32x2*)(F.ws + WS_ROPE);
        for (int it = tid; it < L * 4; it += NT) { const int j = it >> 2, d8 = it & 3; const size_t zr = (size_t)(r0 + j) * ABIN;
            const f32x2* rp = rope + (size_t)(pos0 + j) * 32 + d8 * 8;
            const u32x4 k1 = *(const u32x4*)(Z + zr + 256 + h * 64 + d8 * 8), k2 = *(const u32x4*)(Z + zr + 256 + h * 64 + 32 + d8 * 8);
            const float gk = __expf((float)(L - 1 - j) * logg), gq = __expf((float)(j + 1) * logg);
            u32x4 q1 = (u32x4){0, 0, 0, 0}, q2 = q1; if constexpr (!SUMMARY) { q1 = *(const u32x4*)(Z + zr + h * 64 + d8 * 8); q2 = *(const u32x4*)(Z + zr + h * 64 + 32 + d8 * 8); }
#pragma unroll
            for (int e = 0; e < 8; ++e) { const f32x2 cs_ = rp[e]; const unsigned wk1 = k1[e >> 1], wk2 = k2[e >> 1]; const float x1 = (e & 1) ? bfhi(wk1) : bflo(wk1), x2 = (e & 1) ? bfhi(wk2) : bflo(wk2);
                const float o1 = x1 * cs_.x - x2 * cs_.y, o2 = x1 * cs_.y + x2 * cs_.x; const int d = d8 * 8 + e;
                if constexpr (SUMMARY) { QS[d * LDT + j] = (bf16_t)f2bf(o1 * gk); QS[(d + 32) * LDT + j] = (bf16_t)f2bf(o2 * gk); }
                else { KS[j * 72 + d] = (bf16_t)f2bf(o1); KS[j * 72 + d + 32] = (bf16_t)f2bf(o2);
                    const unsigned wq1 = q1[e >> 1], wq2 = q2[e >> 1]; const float y1 = (e & 1) ? bfhi(wq1) : bflo(wq1), y2 = (e & 1) ? bfhi(wq2) : bflo(wq2);
                    const float p1 = (y1 * cs_.x - y2 * cs_.y) * 0.125f, p2 = (y1 * cs_.y + y2 * cs_.x) * 0.125f;
                    QS[j * 72 + d] = (bf16_t)f2bf(p1); QS[j * 72 + d + 32] = (bf16_t)f2bf(p2); QG[j * 72 + d] = (bf16_t)f2bf(p1 * gq); QG[j * 72 + d + 32] = (bf16_t)f2bf(p2 * gq); } } }
        for (int it = tid; it < L * 16; it += NT) { const int j = it >> 4, e8 = it & 15; const u32x4 vv = *(const u32x4*)(Z + (size_t)(r0 + j) * ABIN + 512 + h * 128 + e8 * 8);
#pragma unroll
            for (int e = 0; e < 8; ++e) { const unsigned w = vv[e >> 1]; VT[(e8 * 8 + e) * LDT + j] = (bf16_t)((e & 1) ? (w >> 16) : (w & 0xffffu)); } }
    }
}

template <int L, bool HG> __device__ __forceinline__ void ab_summary_unit(Frame& F, int layer, int c, int h) {
    const int tid = otid(); const int lane = tid & 63; (void)lane;
    constexpr int DK = HG ? 128 : 64, NCT = DK / 16, LDT = L + 8;
    __syncthreads();
    ab_load<L, HG, true>(F, layer, c, h);
    __syncthreads();
    const int fr = lane & 15, fq = lane >> 4;
    const LAS bf16_t* KDT = (const LAS bf16_t*)(F.lds + LQS); const LAS bf16_t* VT = (const LAS bf16_t*)(F.lds + LVT);
    f32x4 acc[1][NCT];
#pragma unroll
    for (int j = 0; j < NCT; ++j) acc[0][j] = (f32x4){0.f, 0.f, 0.f, 0.f};
    wave_mm_nt<1, NCT>(acc, VT + F.wave * 16 * LDT, LDT, KDT, LDT, L, fr, fq);
    bf16_t* ST = (bf16_t*)(F.ws + WS_STATE) + (size_t)c * SLOT_E + (HG ? 32768 + h * 16384 : h * 8192);
    const int e = F.wave * 16 + fr;
#pragma unroll
    for (int j = 0; j < NCT; ++j) { u32x2 w; w.x = pk2(acc[0][j][0], acc[0][j][1]); w.y = pk2(acc[0][j][2], acc[0][j][3]); *(u32x2*)(ST + (size_t)e * DK + 16 * j + 4 * fq) = w; }
}

template <int L, bool HG> __device__ __forceinline__ void ab_output_unit(Frame& F, int layer, int c, int h) {
    const int tid = otid(); const int lane = tid & 63; (void)lane;
    constexpr int DK = HG ? 128 : 64, LDQ = HG ? 136 : 72, LDT = L + 8, NIT = L / 16, WPI = 8 / NIT, ET = 8 / WPI, TPW = (NIT * NIT >= 8) ? NIT * NIT / 8 : 1;
    const int m = layer >> 1; int r0, pos0; chunk_geom(c, r0, pos0);
    __syncthreads();
    ab_load<L, HG, false>(F, layer, c, h);
    LAS bf16_t* QS = (LAS bf16_t*)(F.lds + LQS); LAS bf16_t* KS = (LAS bf16_t*)(F.lds + LKS); LAS bf16_t* QG = (LAS bf16_t*)(F.lds + LQG); LAS bf16_t* VT = (LAS bf16_t*)(F.lds + LVT);
    LAS bf16_t* STl = (LAS bf16_t*)(F.lds + LST); LAS bf16_t* PS = (LAS bf16_t*)(F.lds + LPS); LAS float* RED = (LAS float*)(F.lds + LRED);
    { const bf16_t* ST = (const bf16_t*)(F.ws + WS_STATE) + (size_t)c * SLOT_E + (HG ? 32768 + h * 16384 : h * 8192);
      for (int it = tid; it < 128 * DK / 8; it += NT) { const int e = it / (DK / 8), c8 = it % (DK / 8); *(LAS u32x4*)(STl + e * LDQ + c8 * 8) = *(const u32x4*)(ST + (size_t)e * DK + c8 * 8); } }
    __syncthreads();
    const int fr = lane & 15, fq = lane >> 4, w = F.wave;
    const float logg = HG ? 0.f : log1pf(-exp2f(-5.f - (float)h));
    if (w * TPW < NIT * NIT) {
        const int it = (w * TPW) / NIT, jt0 = (w * TPW) % NIT;
        f32x4 sc[1][TPW];
#pragma unroll
        for (int q = 0; q < TPW; ++q) sc[0][q] = (f32x4){0.f, 0.f, 0.f, 0.f};
        wave_mm_nt<1, TPW>(sc, QS + it * 16 * LDQ, LDQ, KS + jt0 * 16 * LDQ, LDQ, DK, fr, fq);
        const int i = it * 16 + fr;
#pragma unroll
        for (int q = 0; q < TPW; ++q) { float p[4];
#pragma unroll
            for (int r = 0; r < 4; ++r) { const int j = (jt0 + q) * 16 + 4 * fq + r; float v = sc[0][q][r]; if (!HG) v *= __expf((float)(i - j) * logg); p[r] = (j <= i) ? v : 0.f; }
            u32x2 pw; pw.x = pk2(p[0], p[1]); pw.y = pk2(p[2], p[3]); *(LAS u32x2*)(PS + i * LDT + (jt0 + q) * 16 + 4 * fq) = pw; }
    }
    __syncthreads();
    const int it = w % NIT, eg = w / NIT;
    f32x4 o[1][ET];
#pragma unroll
    for (int q = 0; q < ET; ++q) o[0][q] = (f32x4){0.f, 0.f, 0.f, 0.f};
    wave_mm_nt<1, ET>(o, PS + it * 16 * LDT, LDT, VT + eg * ET * 16 * LDT, LDT, L, fr, fq);
    wave_mm_nt<1, ET>(o, QG + it * 16 * LDQ, LDQ, STl + eg * ET * 16 * LDQ, LDQ, DK, fr, fq);
    float ss = 0.f;
#pragma unroll
    for (int q = 0; q < ET; ++q) ss += (o[0][q][0] * o[0][q][0] + o[0][q][1] * o[0][q][1]) + (o[0][q][2] * o[0][q][2] + o[0][q][3] * o[0][q][3]);
    ss += __shfl_xor(ss, 16); ss += __shfl_xor(ss, 32);
    const int i = it * 16 + fr;
    if (fq == 0) RED[i * 4 + eg] = ss;
    __syncthreads();
    float tot = 0.f;
#pragma unroll
    for (int q = 0; q < WPI; ++q) tot += RED[i * 4 + q];
    const float rstd = 1.f / sqrtf(tot * (1.f / 128.f) + NORM_EPS);
    const bf16_t* Z = (const bf16_t*)(F.ws + WS_Z); bf16_t* O = (bf16_t*)(F.ws + WS_XN);
    const size_t row = (size_t)(r0 + i);
#pragma unroll
    for (int q = 0; q < ET; ++q) { const int e = (eg * ET + q) * 16 + 4 * fq; const u32x2 gw = *(const u32x2*)(Z + row * ABIN + (HG ? 3072 : 1024) + h * 128 + e);
        const float g4[4] = {bflo(gw.x), bfhi(gw.x), bflo(gw.y), bfhi(gw.y)}; float ov[4];
#pragma unroll
        for (int r = 0; r < 4; ++r) { if (HG) ov[r] = o[0][q][r] * rstd * F.in[I_HGNG][m * 128 + e + r] * sigmoidf_(g4[r]); else ov[r] = o[0][q][r] * rstd * siluf_(g4[r]); }
        u32x2 ow; ow.x = pk2(ov[0], ov[1]); ow.y = pk2(ov[2], ov[3]); *(u32x2*)(O + row * D + (HG ? 512 : 0) + h * 128 + e) = ow; }
}

template <bool DRY = false> __device__ __forceinline__ void ab_scan(Frame& F, int layer) {
    const int tid = otid(); const int lane = tid & 63; (void)lane;
    const int m = layer >> 1;
    unsigned* ST32 = (unsigned*)(F.ws + WS_STATE); const float* DEC = (const float*)(F.ws + WS_DEC);
    constexpr int NP = SLOT_E / 2;
    const int gt = F.vcu * NT + tid;
    if (gt < NP) {
        const int eo = 2 * gt; const bool hg = eo >= 32768; const int eo2 = hg ? eo - 32768 : eo; const int head = hg ? eo2 >> 14 : eo2 >> 13; const int cch = hg ? (eo2 & 127) : (eo2 & 63); const int e = hg ? ((eo2 & 16383) >> 7) : ((eo2 & 8191) >> 6);
        const float gdec = hg ? 0.f : __expf(64.f * log1pf(-exp2f(-5.f - (float)head)));
        float s0 = 0.f, s1 = 0.f;
        for (int c0 = 0; c0 < 256; c0 += 32) {
            unsigned kv[32]; float d0[32], d1[32];
#pragma unroll
            for (int u = 0; u < 32; ++u) { kv[u] = ST32[(size_t)(c0 + u) * NP + gt]; if (hg) { const f32x2 dd = *(const f32x2*)(DEC + ((size_t)(c0 + u) * 4 + head) * 128 + cch); d0[u] = dd.x; d1[u] = dd.y; } else { d0[u] = gdec; d1[u] = gdec; } }
#pragma unroll
            for (int u = 0; u < 32; ++u) { const unsigned pw = pk2(s0, s1); if constexpr (DRY) asm volatile("" :: "v"(pw)); else ST32[(size_t)(c0 + u) * NP + gt] = pw; s0 = d0[u] * s0 + bflo(kv[u]); s1 = d1[u] * s1 + bfhi(kv[u]); }
        }
        float* outp = hg ? F.out + O_HGP + (size_t)m * 65536 + head * 16384 : F.out + O_RETP + (size_t)m * 32768 + head * 8192;
        outp[(size_t)cch * 128 + e] = s0; outp[(size_t)(cch + 1) * 128 + e] = s1;
    } else {
        const int NG2 = F.G * NT - NP; if (NG2 <= 0) return;
        for (int idx = gt - NP; idx < 32 * NP; idx += NG2) { const int b = idx / NP, pr = idx % NP;
            const int eo = 2 * pr; const bool hg = eo >= 32768; const int eo2 = hg ? eo - 32768 : eo; const int head = hg ? eo2 >> 14 : eo2 >> 13; const int cch = hg ? (eo2 & 127) : (eo2 & 63); const int e = hg ? ((eo2 & 16383) >> 7) : ((eo2 & 8191) >> 6);
            float d0, d1; if (hg) { const f32x2 dd = *(const f32x2*)(DEC + ((size_t)(256 + b) * 4 + head) * 128 + cch); d0 = dd.x; d1 = dd.y; } else { d0 = d1 = __expf(32.f * log1pf(-exp2f(-5.f - (float)head))); }
            const size_t so = hg ? ((size_t)(m * 32 + b) * 4 + head) * 16384 : ((size_t)(m * 32 + b) * 4 + head) * 8192;
            const float* sin_ = (hg ? F.in[I_SHG] : F.in[I_SRET]) + so; float* sout = F.out + (hg ? O_HGS : O_RETS) + so;
            const float i0 = sin_[(size_t)cch * 128 + e], i1 = sin_[(size_t)(cch + 1) * 128 + e];
            const unsigned kv = ST32[(size_t)(256 + b) * NP + pr]; if constexpr (!DRY) ST32[(size_t)(256 + b) * NP + pr] = pk2(i0, i1);
            sout[(size_t)cch * 128 + e] = d0 * i0 + bflo(kv); sout[(size_t)(cch + 1) * 128 + e] = d1 * i1 + bfhi(kv); }
    }
}

constexpr int RL_AT = 0, RL_RT = 9216, RL_BT = 18432, RL_KT = 27648, RL_BHT = 36864, RL_KHT = 46080, RL_VT = 55296, RL_AAB = 64512, RL_AAK = 81920, RL_ARB = 91136, RL_ARK = 100352,
              RL_U0T = 109568, RL_VEC = 118784, RL_PSUM = 119808;
constexpr int RL_G = RL_AAB, RL_WW = RL_BT, RL_APT = RL_AAK;
constexpr int RL_PL = RL_AT, RL_RL = RL_BT, RL_Y0L = RL_BT + 4608, RL_QTL = RL_AAB, RL_S = RL_BHT;
__device__ __forceinline__ int pperm(int k) { return 32 * (k >> 5) + 8 * ((k >> 2) & 3) + 4 * ((k >> 4) & 1) + (k & 3); }

struct OutSide { u32x2 vv[4], gg[4]; f32x4 lg[4], lb[4]; float bon; };
__device__ __forceinline__ void rwkv_out_side(Frame& F, int m, size_t row, int h, int fq, OutSide& o) {
    const bf16_t* RKV = (const bf16_t*)(F.ws + WS_RKV); const bf16_t* GG = (const bf16_t*)(F.ws + WS_G); const float* BON = (const float*)(F.ws + WS_BON);
    o.bon = BON[row * 16 + h];
#pragma unroll
    for (int nt = 0; nt < 4; ++nt) { const int i = h * 64 + 16 * nt + 4 * fq;
        o.lg[nt] = *(const f32x4*)(F.in[I_RLNG] + m * D + i); o.lb[nt] = *(const f32x4*)(F.in[I_RLNB] + m * D + i);
        o.vv[nt] = *(const u32x2*)(RKV + row * 3072 + 2048 + i); o.gg[nt] = *(const u32x2*)(GG + row * D + i); }
}
template <bool DRY = false> __device__ __forceinline__ void rwkv_out_core(Frame& F, const f32x4 (&y)[4], size_t row, int h, int fq, const OutSide& sd) {
    bf16_t* RKV = (bf16_t*)(F.ws + WS_RKV);
    float s1 = 0.f;
#pragma unroll
    for (int nt = 0; nt < 4; ++nt) s1 += (y[nt][0] + y[nt][1]) + (y[nt][2] + y[nt][3]);
    s1 += __shfl_xor(s1, 16); s1 += __shfl_xor(s1, 32);
    const float mean = s1 * (1.f / 64.f); float s2 = 0.f;
#pragma unroll
    for (int nt = 0; nt < 4; ++nt)
#pragma unroll
        for (int r = 0; r < 4; ++r) { const float d = y[nt][r] - mean; s2 += d * d; }
    s2 += __shfl_xor(s2, 16); s2 += __shfl_xor(s2, 32);
    const float rstd = 1.f / sqrtf(s2 * (1.f / 64.f) + RW_LN_EPS), bon = sd.bon;
#pragma unroll
    for (int nt = 0; nt < 4; ++nt) { const int i = h * 64 + 16 * nt + 4 * fq; const f32x4 lg = sd.lg[nt], lb = sd.lb[nt]; const u32x2 vv = sd.vv[nt], gg = sd.gg[nt];
        const float v4[4] = {bflo(vv.x), bfhi(vv.x), bflo(vv.y), bfhi(vv.y)}, g4[4] = {bflo(gg.x), bfhi(gg.x), bflo(gg.y), bfhi(gg.y)}; float o[4];
#pragma unroll
        for (int r = 0; r < 4; ++r) o[r] = ((y[nt][r] - mean) * rstd * lg[r] + lb[r] + bon * v4[r]) * g4[r];
        u32x2 w; w.x = pk2(o[0], o[1]); w.y = pk2(o[2], o[3]); if constexpr (DRY) asm volatile("" :: "v"(w.x), "v"(w.y)); else *(u32x2*)(RKV + row * 3072 + i) = w; }
}
template <bool DRY = false> __device__ __forceinline__ void rwkv_out_epilogue(Frame& F, int m, const f32x4 (&y)[4], size_t row, int h, int fq) {
    OutSide sd; rwkv_out_side(F, m, row, h, fq, sd); rwkv_out_core<DRY>(F, y, row, h, fq, sd);
}

template <int S, int L> struct SubstQ {
    static constexpr int RQ = L / 4, NV4 = RQ / 4;
    static __device__ __forceinline__ void run(float (&x)[RQ], f32x4 (&aq)[3][NV4], const LAS float* ap) {
        if constexpr (S < L - 1) {
            if constexpr (S + 2 < L - 1) {
#pragma unroll
                for (int k = 0; k < NV4; ++k) aq[(S + 2) % 3][k] = *(const LAS f32x4*)(ap + (S + 2) * 68 + 4 * k);
            }
            constexpr int own = S / RQ, ctrl = own * 0x55;
            const float xs = __builtin_bit_cast(float, __builtin_amdgcn_update_dpp(0, __builtin_bit_cast(int, x[S % RQ]), ctrl, 0xf, 0xf, false));
#pragma unroll
            for (int k = 0; k < NV4; ++k) { x[4 * k] += aq[S % 3][k][0] * xs; x[4 * k + 1] += aq[S % 3][k][1] * xs; x[4 * k + 2] += aq[S % 3][k][2] * xs; x[4 * k + 3] += aq[S % 3][k][3] * xs;
                asm volatile("" : "+v"(x[4 * k]), "+v"(x[4 * k + 1]), "+v"(x[4 * k + 2]), "+v"(x[4 * k + 3])); }
            asm volatile("" ::: "memory");
            SubstQ<S + 1, L>::run(x, aq, ap);
        }
    }
};
struct RawRegs { u32x4 r, k, v, w, a; };
__device__ __forceinline__ void rwkv_load_raw(Frame& F, int u, int tid, RawRegs& raw) {
    const int c = u >> 4, h = u & 15; int r0, pos0; chunk_geom(c, r0, pos0); const int L = c < 256 ? 64 : 32; int t = tid >> 3; t = t < L ? t : 0;
    const bf16_t* RKV = (const bf16_t*)(F.ws + WS_RKV); const bf16_t* WLOG = (const bf16_t*)(F.ws + WS_WLOG); const bf16_t* AA = (const bf16_t*)(F.ws + WS_XN);
    const size_t row = (size_t)(r0 + t); const int col = h * 64 + 8 * (tid & 7);
    raw.r = *(const u32x4*)(RKV + row * 3072 + col); raw.k = *(const u32x4*)(RKV + row * 3072 + 1024 + col); raw.v = *(const u32x4*)(RKV + row * 3072 + 2048 + col);
    raw.w = *(const u32x4*)(WLOG + row * D + col); raw.a = *(const u32x4*)(AA + row * D + col);
}
template <int L, bool DRY = false> __device__ __forceinline__ void rwkv_local_unit(Frame& F, int layer, int c, int h, RawRegs& raw, int unext) {
    const int tid = otid(); const int lane = tid & 63, fr = lane & 15, fq = lane >> 4, w = F.wave;
    constexpr int NIT = L / 16; constexpr bool SAMPLE = (L == 32);
    const int m = layer >> 1; int r0, pos0; chunk_geom(c, r0, pos0);
    bf16_t* RKV = (bf16_t*)(F.ws + WS_RKV); const bf16_t* WLOG = (const bf16_t*)(F.ws + WS_WLOG); const bf16_t* AA = (const bf16_t*)(F.ws + WS_XN);
    LAS bf16_t* AT = (LAS bf16_t*)(F.lds + RL_AT); LAS bf16_t* RT = (LAS bf16_t*)(F.lds + RL_RT); LAS bf16_t* BT = (LAS bf16_t*)(F.lds + RL_BT); LAS bf16_t* KT = (LAS bf16_t*)(F.lds + RL_KT);
    LAS bf16_t* BHT = (LAS bf16_t*)(F.lds + RL_BHT); LAS bf16_t* KHT = (LAS bf16_t*)(F.lds + RL_KHT); LAS bf16_t* VT = (LAS bf16_t*)(F.lds + RL_VT);
    LAS float* AAB = (LAS float*)(F.lds + RL_AAB); LAS bf16_t* AAK = (LAS bf16_t*)(F.lds + RL_AAK); LAS bf16_t* ARB = (LAS bf16_t*)(F.lds + RL_ARB); LAS bf16_t* ARK = (LAS bf16_t*)(F.lds + RL_ARK);
    LAS bf16_t* U0T = (LAS bf16_t*)(F.lds + RL_U0T); LAS float* GMID = (LAS float*)(F.lds + RL_VEC); LAS float* GLV = GMID + 64; LAS float* EGM = GMID + 128; LAS float* PSUM = (LAS float*)(F.lds + RL_PSUM);
    LAS float* G = (LAS float*)(F.lds + RL_G); LAS float* WW = (LAS float*)(F.lds + RL_WW); LAS bf16_t* APT = (LAS bf16_t*)(F.lds + RL_APT);
    __syncthreads();
    const int t = tid >> 3, c8 = tid & 7; const bool act = t < L;
    float rr[8], kkv[8], bb[8], kh[8], vv[8];
    if (act) { const size_t row = (size_t)(r0 + t); const int col = h * 64 + 8 * c8;
        const u32x4 r4 = raw.r, k4 = raw.k, v4 = raw.v, w4 = raw.w, a4 = raw.a;
        const float* kkp = F.in[I_RKK] + m * D + col; const float* kap = F.in[I_RKA] + m * D + col; const float* rkp = F.in[I_RRK] + m * D + col;
        float ss = 0.f, bon = 0.f;
#pragma unroll
        for (int e = 0; e < 8; ++e) { const float kx = (e & 1) ? bfhi(k4[e >> 1]) : bflo(k4[e >> 1]), al = (e & 1) ? bfhi(a4[e >> 1]) : bflo(a4[e >> 1]);
            rr[e] = (e & 1) ? bfhi(r4[e >> 1]) : bflo(r4[e >> 1]); vv[e] = (e & 1) ? bfhi(v4[e >> 1]) : bflo(v4[e >> 1]);
            kkv[e] = kx * kkp[e]; ss += kkv[e] * kkv[e]; kh[e] = kx * (1.f + (al - 1.f) * kap[e]); bb[e] = al; bon += rr[e] * kh[e] * rkp[e];
            G[t * 64 + 8 * c8 + e] = (e & 1) ? bfhi(w4[e >> 1]) : bflo(w4[e >> 1]); }
        ss += __shfl_xor(ss, 1); ss += __shfl_xor(ss, 2); ss += __shfl_xor(ss, 4); bon += __shfl_xor(bon, 1); bon += __shfl_xor(bon, 2); bon += __shfl_xor(bon, 4);
        const float inv = 1.f / fmaxf(sqrtf(ss), 1e-12f);
#pragma unroll
        for (int e = 0; e < 8; ++e) { kkv[e] *= inv; bb[e] *= kkv[e]; }
        if (c8 == 0) ((float*)(F.ws + WS_BON))[row * 16 + h] = bon; }
    if (unext >= 0) rwkv_load_raw(F, unext, tid, raw);
    __syncthreads();
    { constexpr int TE = L / 8; const int j = tid & 63, e8 = tid >> 6; float cs[TE]; float run = 0.f;
#pragma unroll
      for (int q = 0; q < TE; ++q) { run += G[(e8 * TE + q) * 64 + j]; cs[q] = run; }
      PSUM[e8 * 64 + j] = run;
      __syncthreads();
      float off = 0.f, gm = 0.f, gl = 0.f;
#pragma unroll
      for (int q = 0; q < 8; ++q) { const float p = PSUM[q * 64 + j]; if (q < e8) off += p; if (q < 4) gm += p; gl += p; }
#pragma unroll
      for (int q = 0; q < TE; ++q) G[(e8 * TE + q) * 64 + j] = off + cs[q];
      if (e8 == 0) { GMID[j] = gm; GLV[j] = gl; EGM[j] = __expf(gm); if (!SAMPLE) ((float*)(F.ws + WS_REC + ((size_t)h * 256 + c) * REC_B + 16384))[j] = __expf(gl); } }
    __syncthreads();
    if (act) { float fa[8], fr_[8], fb[8], fk[8];
#pragma unroll
        for (int e = 0; e < 8; ++e) { const int j = 8 * c8 + e; const float g = G[t * 64 + j], gp = (t > 0) ? G[(t - 1) * 64 + j] : 0.f, gm = GMID[j], gl = GLV[j];
            const float ed = __expf(gm - g), eu = __expf(g - gm), el = __expf(gl - g);
            fa[e] = -kkv[e] * __expf(gp - gm); fr_[e] = rr[e] * eu; fb[e] = bb[e] * ed; fk[e] = kh[e] * ed;
            if constexpr (!(DRY && (LOCAL_SKIP & 4))) { BHT[j * 72 + t] = (bf16_t)f2bf(bb[e] * el); KHT[j * 72 + t] = (bf16_t)f2bf(kh[e] * el); VT[j * 72 + t] = (bf16_t)f2bf(vv[e]); } }
        u32x4 p;
        p.x = pk2(fa[0], fa[1]); p.y = pk2(fa[2], fa[3]); p.z = pk2(fa[4], fa[5]); p.w = pk2(fa[6], fa[7]); *(LAS u32x4*)(AT + t * 72 + 8 * c8) = p;
        p.x = pk2(fr_[0], fr_[1]); p.y = pk2(fr_[2], fr_[3]); p.z = pk2(fr_[4], fr_[5]); p.w = pk2(fr_[6], fr_[7]); *(LAS u32x4*)(RT + t * 72 + 8 * c8) = p;
        p.x = pk2(fb[0], fb[1]); p.y = pk2(fb[2], fb[3]); p.z = pk2(fb[4], fb[5]); p.w = pk2(fb[6], fb[7]); *(LAS u32x4*)(BT + t * 72 + 8 * c8) = p;
        p.x = pk2(fk[0], fk[1]); p.y = pk2(fk[2], fk[3]); p.z = pk2(fk[4], fk[5]); p.w = pk2(fk[6], fk[7]); *(LAS u32x4*)(KT + t * 72 + 8 * c8) = p; }
    __syncthreads();
    if constexpr (DRY && (LOCAL_SKIP & 2)) return;
    { constexpr int TPW = (NIT * NIT >= 8) ? NIT * NIT / 8 : 1;
      if (w * TPW < NIT * NIT) { const int it = (w * TPW) / NIT, jt0 = (w * TPW) % NIT;
          f32x4 ab[1][TPW], ak[1][TPW], rb[1][TPW], rk[1][TPW];
#pragma unroll
          for (int q = 0; q < TPW; ++q) { ab[0][q] = (f32x4){0.f, 0.f, 0.f, 0.f}; ak[0][q] = ab[0][q]; rb[0][q] = ab[0][q]; rk[0][q] = ab[0][q]; }
          wave_mm_nt<1, TPW>(ab, AT + it * 16 * 72, 72, BT + jt0 * 16 * 72, 72, 64, fr, fq); wave_mm_nt<1, TPW>(ak, AT + it * 16 * 72, 72, KT + jt0 * 16 * 72, 72, 64, fr, fq);
          wave_mm_nt<1, TPW>(rb, RT + it * 16 * 72, 72, BT + jt0 * 16 * 72, 72, 64, fr, fq); wave_mm_nt<1, TPW>(rk, RT + it * 16 * 72, 72, KT + jt0 * 16 * 72, 72, 64, fr, fq);
          const int tt = it * 16 + fr;
#pragma unroll
          for (int q = 0; q < TPW; ++q) { const int s0 = (jt0 + q) * 16 + 4 * fq; f32x4 fab; float fak[4], frb[4], frk[4];
#pragma unroll
              for (int r = 0; r < 4; ++r) { const int sx = s0 + r; fab[r] = (sx < tt) ? ab[0][q][r] : 0.f; fak[r] = (sx < tt) ? ak[0][q][r] : 0.f; frb[r] = (sx <= tt) ? rb[0][q][r] : 0.f; frk[r] = (sx <= tt) ? rk[0][q][r] : 0.f; }
#pragma unroll
              for (int r = 0; r < 4; ++r) AAB[(s0 + r) * 68 + tt] = fab[r];
              u32x2 p; p.x = pk2(fak[0], fak[1]); p.y = pk2(fak[2], fak[3]); *(LAS u32x2*)(AAK + tt * 72 + s0) = p;
              p.x = pk2(frb[0], frb[1]); p.y = pk2(frb[2], frb[3]); *(LAS u32x2*)(ARB + tt * 72 + s0) = p;
              p.x = pk2(frk[0], frk[1]); p.y = pk2(frk[2], frk[3]); *(LAS u32x2*)(ARK + tt * 72 + s0) = p; } } }
    __syncthreads();
    { constexpr int TP3 = NIT / 2; const int it = (w * TP3) / 4, nt0 = (w * TP3) % 4;
      f32x4 ww[1][TP3];
#pragma unroll
      for (int q = 0; q < TP3; ++q) ww[0][q] = (f32x4){0.f, 0.f, 0.f, 0.f};
      wave_mm_nt<1, TP3>(ww, AAK + it * 16 * 72, 72, VT + nt0 * 16 * 72, 72, L, fr, fq);
#pragma unroll
      for (int q = 0; q < TP3; ++q) *(LAS f32x4*)(WW + (it * 16 + fr) * 68 + (nt0 + q) * 16 + 4 * fq) = ww[0][q]; }
    __syncthreads();
    { constexpr int RQ = L / 4, NV4 = RQ / 4; const int col = tid >> 2, qd = tid & 3, cidx = col & 63; const bool isA = col < 64; const float eg = EGM[cidx];
      float x[RQ]; f32x4 aq[3][NV4];
#pragma unroll
      for (int i = 0; i < RQ; ++i) { const int tt = qd * RQ + i; x[i] = isA ? bf2f(AT[tt * 72 + cidx]) * eg : WW[tt * 68 + cidx]; }
      const LAS float* ap = AAB + qd * RQ;
#pragma unroll
      for (int k = 0; k < NV4; ++k) { aq[0][k] = *(const LAS f32x4*)(ap + 4 * k); aq[1][k] = *(const LAS f32x4*)(ap + 68 + 4 * k); }
      if constexpr (!(DRY && (LOCAL_SKIP & 1))) SubstQ<0, L>::run(x, aq, ap);
      LAS bf16_t* dst = (isA ? APT : U0T) + cidx * 72 + qd * RQ;
#pragma unroll
      for (int t8 = 0; t8 < RQ; t8 += 8) { u32x4 p; p.x = pk2(x[t8], x[t8 + 1]); p.y = pk2(x[t8 + 2], x[t8 + 3]); p.z = pk2(x[t8 + 4], x[t8 + 5]); p.w = pk2(x[t8 + 6], x[t8 + 7]); *(LAS u32x4*)(dst + t8) = p; } }
    __syncthreads();
    { const int mt = w >> 1, nt0 = (w & 1) * 2;
      f32x4 pp[1][2], qt[1][2];
#pragma unroll
      for (int q = 0; q < 2; ++q) { pp[0][q] = (f32x4){0.f, 0.f, 0.f, 0.f}; qt[0][q] = pp[0][q]; }
      wave_mm_nt<1, 2>(pp, BHT + mt * 16 * 72, 72, APT + nt0 * 16 * 72, 72, L, fr, fq);
      wave_mm_nt<1, 2>(qt, U0T + mt * 16 * 72, 72, BHT + nt0 * 16 * 72, 72, L, fr, fq); wave_mm_nt<1, 2>(qt, VT + mt * 16 * 72, 72, KHT + nt0 * 16 * 72, 72, L, fr, fq);
      constexpr int TP5 = NIT / 2; const int it = (w * TP5) / 4, rn0 = (w * TP5) % 4;
      f32x4 rp[1][TP5], y0[1][TP5];
#pragma unroll
      for (int q = 0; q < TP5; ++q) { const int j = (rn0 + q) * 16 + 4 * fq; const u32x2 rw = *(const LAS u32x2*)(RT + (it * 16 + fr) * 72 + j); const f32x4 e4 = *(const LAS f32x4*)(EGM + j);
          rp[0][q] = (f32x4){bflo(rw.x) * e4[0], bfhi(rw.x) * e4[1], bflo(rw.y) * e4[2], bfhi(rw.y) * e4[3]}; y0[0][q] = (f32x4){0.f, 0.f, 0.f, 0.f}; }
      wave_mm_nt<1, TP5>(rp, ARB + it * 16 * 72, 72, APT + rn0 * 16 * 72, 72, L, fr, fq);
      wave_mm_nt<1, TP5>(y0, ARB + it * 16 * 72, 72, U0T + rn0 * 16 * 72, 72, L, fr, fq); wave_mm_nt<1, TP5>(y0, ARK + it * 16 * 72, 72, VT + rn0 * 16 * 72, 72, L, fr, fq);
      if constexpr (!SAMPLE) {
          bf16_t* PP = (bf16_t*)(F.ws + WS_REC + ((size_t)h * 256 + c) * REC_B); bf16_t* QQ = PP + 4096;
#pragma unroll
          for (int q = 0; q < 2; ++q) { const int n0 = (nt0 + q) * 16 + 4 * fq; u32x2 p; p.x = pk2(pp[0][q][0], pp[0][q][1]); p.y = pk2(pp[0][q][2], pp[0][q][3]);
              *(u32x2*)(PP + (mt * 16 + fr) * 64 + pperm(n0)) = p;
              p.x = pk2(qt[0][q][0], qt[0][q][1]); p.y = pk2(qt[0][q][2], qt[0][q][3]); *(u32x2*)(QQ + (mt * 16 + fr) * 64 + n0) = p; }
#pragma unroll
          for (int q = 0; q < TP5; ++q) { const size_t row = (size_t)(r0 + it * 16 + fr); const int n0 = (rn0 + q) * 16 + 4 * fq; u32x2 p;
              p.x = pk2(rp[0][q][0], rp[0][q][1]); p.y = pk2(rp[0][q][2], rp[0][q][3]); if constexpr (DRY) asm volatile("" :: "v"(p.x), "v"(p.y)); else *(u32x2*)(RKV + row * 3072 + 1024 + h * 64 + n0) = p;
              p.x = pk2(y0[0][q][0], y0[0][q][1]); p.y = pk2(y0[0][q][2], y0[0][q][3]); if constexpr (DRY) asm volatile("" :: "v"(p.x), "v"(p.y)); else *(u32x2*)(RKV + row * 3072 + h * 64 + n0) = p; }
      } else {
          __syncthreads();
          LAS bf16_t* PL = (LAS bf16_t*)(F.lds + RL_PL); LAS bf16_t* RLs = (LAS bf16_t*)(F.lds + RL_RL); LAS float* Y0L = (LAS float*)(F.lds + RL_Y0L); LAS float* QTL = (LAS float*)(F.lds + RL_QTL); LAS bf16_t* Sl = (LAS bf16_t*)(F.lds + RL_S);
#pragma unroll
          for (int q = 0; q < 2; ++q) { const int n0 = (nt0 + q) * 16 + 4 * fq; u32x2 p; p.x = pk2(pp[0][q][0], pp[0][q][1]); p.y = pk2(pp[0][q][2], pp[0][q][3]);
              *(LAS u32x2*)(PL + (mt * 16 + fr) * 72 + n0) = p; *(LAS f32x4*)(QTL + (mt * 16 + fr) * 68 + n0) = qt[0][q]; }
#pragma unroll
          for (int q = 0; q < TP5; ++q) { const int n0 = (rn0 + q) * 16 + 4 * fq; u32x2 p; p.x = pk2(rp[0][q][0], rp[0][q][1]); p.y = pk2(rp[0][q][2], rp[0][q][3]);
              *(LAS u32x2*)(RLs + (it * 16 + fr) * 72 + n0) = p; *(LAS f32x4*)(Y0L + (it * 16 + fr) * 68 + n0) = y0[0][q]; }
          const int sb = c - 256; const float* sin_ = F.in[I_SWKV] + (((size_t)m * 32 + sb) * 16 + h) * 4096; float* sout = F.out + O_WKVS + (((size_t)m * 32 + sb) * 16 + h) * 4096;
          for (int it2 = tid; it2 < 64 * 16; it2 += NT) { const int i = it2 >> 4, j4 = (it2 & 15) * 4; const f32x4 sv = *(const f32x4*)(sin_ + i * 64 + j4); u32x2 p; p.x = pk2(sv[0], sv[1]); p.y = pk2(sv[2], sv[3]); *(LAS u32x2*)(Sl + i * 72 + j4) = p; }
          __syncthreads();
          if (w < 2) { f32x4 y[1][4];
#pragma unroll
              for (int q = 0; q < 4; ++q) y[0][q] = *(const LAS f32x4*)(Y0L + (w * 16 + fr) * 68 + q * 16 + 4 * fq);
              wave_mm_nt<1, 4>(y, RLs + w * 16 * 72, 72, Sl, 72, 64, fr, fq);
              rwkv_out_epilogue<DRY>(F, m, y[0], (size_t)(r0 + w * 16 + fr), h, fq); }
          else if (w < 6) { const int mi = w - 2; f32x4 tl[1][4];
#pragma unroll
              for (int q = 0; q < 4; ++q) { const int j = q * 16 + 4 * fq; const f32x4 sv = *(const f32x4*)(sin_ + (mi * 16 + fr) * 64 + j), gl4 = *(const LAS f32x4*)(GLV + j), qv = *(const LAS f32x4*)(QTL + (mi * 16 + fr) * 68 + j);
                  tl[0][q] = (f32x4){__expf(gl4[0]) * sv[0] + qv[0], __expf(gl4[1]) * sv[1] + qv[1], __expf(gl4[2]) * sv[2] + qv[2], __expf(gl4[3]) * sv[3] + qv[3]}; }
              wave_mm_nt<1, 4>(tl, Sl + mi * 16 * 72, 72, PL, 72, 64, fr, fq);
#pragma unroll
              for (int q = 0; q < 4; ++q) *(f32x4*)(sout + (mi * 16 + fr) * 64 + q * 16 + 4 * fq) = tl[0][q]; }
      }
    }
}

constexpr int SC_GRP = 4, SC_CH = 8192 + 2048 + 256, SC_LCH = 9216 + 2304 + 256, SC_LBUF = SC_GRP * SC_LCH;
template <int SKIP = 0> __device__ __forceinline__ void rwkv_scan_phase(Frame& F, int layer) {
    const int tid = otid(); const int lane = tid & 63, m = layer >> 1; const int b = blockIdx.x;
    if (b >= 64) {
        if constexpr (SKIP == 0) { const int nb = (int)F.G - 64; RawRegs raw; int u = 256 * 16 + (b - 64); if (u < NCHUNK * 16) rwkv_load_raw(F, u, tid, raw);
            for (; u < NCHUNK * 16; u += nb) { const int un = (u + nb < NCHUNK * 16) ? u + nb : -1; rwkv_local_unit<32>(F, layer, u >> 4, u & 15, raw, un); }
            if (layer == 1) { __syncthreads(); mod_phase(F, 2, 4, b - 64, nb); } }
        return; }
    const int h = 2 * (b & 7) + (b >> 5), sl = (b >> 3) & 3;
    const unsigned char* REC = F.ws + WS_REC;
    constexpr int NG = 256 / SC_GRP, DEPTH = 4;
    static_assert(NG % DEPTH == 0, "scan groups vs prefetch depth");
    if (F.wave != 0) {
        constexpr int NV = SC_GRP * SC_CH / 16, NLT = NT - 64, NPT = (NV + NLT - 1) / NLT;
        struct RegSet { u32x4 v[NPT]; };
        RegSet sets[DEPTH];
        unsigned poff[NPT], pdst[NPT];
#pragma unroll
        for (int q = 0; q < NPT; ++q) { int v = (tid - 64) + q * NLT; v = v < NV ? v : NV - 1; const int cc = v / (SC_CH / 16), o = (v % (SC_CH / 16)) * 16;
            poff[q] = (unsigned)(cc * REC_B + o + (o >= 10240 ? 6144 : (o >= 8192 ? sl * 2048 : 0)));
            const int lo = (o < 8192) ? (o >> 7) * 144 + (o & 127) : (o < 10240) ? 9216 + ((o - 8192) >> 7) * 144 + ((o - 8192) & 127) : 9216 + 2304 + (o - 10240);
            pdst[q] = (unsigned)(cc * SC_LCH + lo); }
        auto issue = [&](int g, RegSet& st) { const unsigned char* gb = REC + ((size_t)h * 256 + g * SC_GRP) * REC_B;
#pragma unroll
            for (int q = 0; q < NPT; ++q) st.v[q] = *(const u32x4*)(gb + poff[q]); };
        auto commit = [&](int buf, const RegSet& st) {
#pragma unroll
            for (int q = 0; q < NPT; ++q) *(LAS u32x4*)(F.lds + buf * SC_LBUF + pdst[q]) = st.v[q]; };
        if (!(SKIP & 2)) {
#pragma unroll
            for (int d = 0; d < DEPTH; ++d) issue(d, sets[d]);
            commit(0, sets[0]); }
        for (int g0 = 0; g0 < NG; g0 += DEPTH) {
#pragma unroll
            for (int dd = 0; dd < DEPTH; ++dd) { const int g = g0 + dd;
                if (!(SKIP & 2)) { if (g > 0 && g + DEPTH - 1 < NG) issue(g + DEPTH - 1, sets[(dd + DEPTH - 1) % DEPTH]); }
                __syncthreads();
                __syncthreads();
                if (!(SKIP & 2)) { if (g + 1 < NG) commit((g + 1) & 1, sets[(dd + 1) % DEPTH]); } }
        }
    } else {
        const int ci = lane & 15, q4 = lane >> 4, i = 16 * sl + ci;
        f32x4 T[4];
#pragma unroll
        for (int mm = 0; mm < 4; ++mm) T[mm] = (f32x4){0.f, 0.f, 0.f, 0.f};
        bf16_t* TST = (bf16_t*)(F.ws + WS_TST);
        const unsigned pfo = (unsigned)(ci * 144 + q4 * 16);
        for (int g = 0; g < NG; ++g) {
            __syncthreads();
            if (!(SKIP & 1)) {
                const LAS unsigned char* base = F.lds + (g & 1) * SC_LBUF;
                bf16x8 pf[4][2];
#pragma unroll
                for (int mm = 0; mm < 4; ++mm)
#pragma unroll
                    for (int s = 0; s < 2; ++s) pf[mm][s] = *(const LAS bf16x8*)(base + pfo + mm * 2304 + s * 64);
#pragma unroll
                for (int cc = 0; cc < SC_GRP; ++cc) { const int c = g * SC_GRP + cc; const LAS unsigned char* cb = base + cc * SC_LCH;
                    bf16_t* tdst = TST + (((size_t)h * 256 + c) * 64 + i) * 64;
                    f32x4 gv[4]; u32x2 qv[4];
#pragma unroll
                    for (int mm = 0; mm < 4; ++mm) { const int j = 16 * mm + 4 * q4; gv[mm] = *(const LAS f32x4*)(cb + 9216 + 2304 + j * 4); qv[mm] = *(const LAS u32x2*)(cb + 9216 + ci * 144 + j * 2); }
                    bf16x8 pn[4][2];
                    if (cc + 1 < SC_GRP) {
#pragma unroll
                        for (int mm = 0; mm < 4; ++mm)
#pragma unroll
                            for (int s = 0; s < 2; ++s) pn[mm][s] = *(const LAS bf16x8*)(cb + SC_LCH + pfo + mm * 2304 + s * 64); }
                    bf16x8 Tf[2];
#pragma unroll
                    for (int mm = 0; mm < 4; ++mm) { u32x2 p; p.x = pk2(T[mm][0], T[mm][1]); p.y = pk2(T[mm][2], T[mm][3]); *(u32x2*)(tdst + 16 * mm + 4 * q4) = p;
                        Tf[mm >> 1][(mm & 1) * 4 + 0] = (short)(p.x & 0xffffu); Tf[mm >> 1][(mm & 1) * 4 + 1] = (short)(p.x >> 16); Tf[mm >> 1][(mm & 1) * 4 + 2] = (short)(p.y & 0xffffu); Tf[mm >> 1][(mm & 1) * 4 + 3] = (short)(p.y >> 16); }
#pragma unroll
                    for (int mm = 0; mm < 4; ++mm) {
                        f32x4 acc = (f32x4){gv[mm][0] * T[mm][0] + bflo(qv[mm].x), gv[mm][1] * T[mm][1] + bfhi(qv[mm].x), gv[mm][2] * T[mm][2] + bflo(qv[mm].y), gv[mm][3] * T[mm][3] + bfhi(qv[mm].y)};
                        acc = __builtin_amdgcn_mfma_f32_16x16x32_bf16(pf[mm][0], Tf[0], acc, 0, 0, 0); acc = __builtin_amdgcn_mfma_f32_16x16x32_bf16(pf[mm][1], Tf[1], acc, 0, 0, 0);
                        T[mm] = acc; }
                    if (cc + 1 < SC_GRP) {
#pragma unroll
                        for (int mm = 0; mm < 4; ++mm) { pf[mm][0] = pn[mm][0]; pf[mm][1] = pn[mm][1]; } }
                }
            }
            __syncthreads();
        }
        float* outp = F.out + O_WKVP + ((size_t)m * 16 + h) * 4096 + (size_t)i * 64;
#pragma unroll
        for (int mm = 0; mm < 4; ++mm) *(f32x4*)(outp + 16 * mm + 4 * q4) = T[mm];
    }
}

struct OutMain { u32x2 y0[4]; bf16x8 xa[2]; bf16x8 yb[2][4]; };
template <bool DRY = false> __device__ __forceinline__ void rwkv_output_phase(Frame& F, int layer) {
    const int tid = otid(); const int lane = tid & 63, fr = lane & 15, fq = lane >> 4, m = layer >> 1;
    const bf16_t* RKV = (const bf16_t*)(F.ws + WS_RKV); const bf16_t* TST = (const bf16_t*)(F.ws + WS_TST);
    const int gw = F.vcu * NWAVES + F.wave, NGW = F.G * NWAVES;
    auto issue = [&](int u, OutMain& mn, OutSide& sd) { const int it = u & 3, h = (u >> 2) & 15, c = u >> 6;
        const size_t row = (size_t)(64 * c + 16 * it + fr); const bf16_t* ts = TST + ((size_t)h * 256 + c) * 4096;
#pragma unroll
        for (int nt = 0; nt < 4; ++nt) mn.y0[nt] = *(const u32x2*)(RKV + row * 3072 + h * 64 + 16 * nt + 4 * fq);
#pragma unroll
        for (int s = 0; s < 2; ++s) { mn.xa[s] = *(const bf16x8*)(RKV + row * 3072 + 1024 + h * 64 + 32 * s + 8 * fq);
#pragma unroll
            for (int nt = 0; nt < 4; ++nt) mn.yb[s][nt] = *(const bf16x8*)(ts + (16 * nt + fr) * 64 + 32 * s + 8 * fq); }
        rwkv_out_side(F, m, row, h, fq, sd); };
    constexpr int NU = 256 * 16 * 4;
    OutMain mA, mB; OutSide sA, sB;
    int u = gw; if (u < NU) issue(u, mA, sA);
    for (; u < NU; u += 2 * NGW) {
        { int un = u + NGW; un = un < NU ? un : NU - 1; issue(un, mB, sB);
          const int it = u & 3, h = (u >> 2) & 15, c = u >> 6; const size_t row = (size_t)(64 * c + 16 * it + fr); f32x4 y[4];
#pragma unroll
          for (int nt = 0; nt < 4; ++nt) y[nt] = (f32x4){bflo(mA.y0[nt].x), bfhi(mA.y0[nt].x), bflo(mA.y0[nt].y), bfhi(mA.y0[nt].y)};
#pragma unroll
          for (int s = 0; s < 2; ++s)
#pragma unroll
              for (int nt = 0; nt < 4; ++nt) y[nt] = __builtin_amdgcn_mfma_f32_16x16x32_bf16(mA.yb[s][nt], mA.xa[s], y[nt], 0, 0, 0);
          rwkv_out_core<DRY>(F, y, row, h, fq, sA); }
        { const int u1 = u + NGW; if (u1 < NU) { int un = u1 + NGW; un = un < NU ? un : NU - 1; issue(un, mA, sA);
          const int it = u1 & 3, h = (u1 >> 2) & 15, c = u1 >> 6; const size_t row = (size_t)(64 * c + 16 * it + fr); f32x4 y[4];
#pragma unroll
          for (int nt = 0; nt < 4; ++nt) y[nt] = (f32x4){bflo(mB.y0[nt].x), bfhi(mB.y0[nt].x), bflo(mB.y0[nt].y), bfhi(mB.y0[nt].y)};
#pragma unroll
          for (int s = 0; s < 2; ++s)
#pragma unroll
              for (int nt = 0; nt < 4; ++nt) y[nt] = __builtin_amdgcn_mfma_f32_16x16x32_bf16(mB.yb[s][nt], mB.xa[s], y[nt], 0, 0, 0);
          rwkv_out_core<DRY>(F, y, row, h, fq, sB); } }
    }
}

#define GRID_BAR() xcd_barrier(bar)
#ifndef PHASE_MASK
#define PHASE_MASK 0xffffffffu
#endif
#ifndef STRETCH_MASK
#define STRETCH_MASK 0u
#endif
struct StretchGuard { unsigned long long t0; bool on; __device__ __forceinline__ StretchGuard(bool o) : t0(o ? __builtin_amdgcn_s_memrealtime() : 0ull), on(o) {}
    __device__ __forceinline__ ~StretchGuard() { if (on) { __syncthreads(); const unsigned long long t1 = __builtin_amdgcn_s_memrealtime(); while (__builtin_amdgcn_s_memrealtime() < t1 + (t1 - t0)) __builtin_amdgcn_s_sleep(2); } } };
#define PH(k) if (StretchGuard sg_(((STRETCH_MASK) >> (k)) & 1u); PHASE_MASK & (1u << (k)))
#ifndef REP_MASK
#define REP_MASK 0u
#endif
#define REP(k) (((REP_MASK) >> (k)) & 1u)
#ifndef LOCAL_SKIP
#define LOCAL_SKIP 0
#endif
#ifndef EXTRA_BARS
#define EXTRA_BARS 0
#endif
template <int layer> __device__ __forceinline__ void layer_body(Frame& F, const XcdBarrier& bar) {
    unsigned char* ws = F.ws; unsigned char* ar = ws + WS_ARENA;
    bf16_t* XN = (bf16_t*)(ws + WS_XN);
    const float* MOD = (const float*)(ws + WS_MOD);
    constexpr int m = layer >> 1; const float* modl = MOD + (size_t)layer * NSEQ * 6144;
    PH(1) for (int rep = 0; rep <= (int)REP(1); ++rep) if (layer > 0) convert_layer_weights(F, layer);
    if constexpr ((layer & 1) == 0) {
        PH(2) for (int rep = 0; rep <= (int)REP(2); ++rep) { if constexpr (layer == 0) norm_pass<0, 0, true>(F, layer, 0, 0, F.in[I_XS], nullptr); else norm_pass<0, 8>(F, layer, layer - 1, 5120, F.out + (size_t)MP * D, (float*)(ws + WS_SXB)); }
        GRID_BAR();
        PH(3) { using GC = pg8::Geo<D, D, D, 30, 0, 1 << 20, 0>; pg8::Gemm<GC> g{XN, (const bf16_t*)(ar + AR_WIN), nullptr}; pg8::StaticOrder S; S.init(M, ABIN, F.G, (int)blockIdx.x);
          pg8::EpiBf16<0> E{(bf16_t*)(ws + WS_Z), ABIN};
          pg8::gemm_phase<pg8::EpiBf16<0>, pg8::StaticOrder, GC, true, true>(F.lds, g, S, E);
          if (REP(3)) { pg8::EpiNull<true> EN; pg8::gemm_phase<pg8::EpiNull<true>, pg8::StaticOrder, GC, true, true>(F.lds, g, S, EN); } }
        GRID_BAR();
        PH(4) for (int rep = 0; rep <= (int)REP(4); ++rep) for (int u = F.vcu; u < NCHUNK * 8; u += F.G) { const int c = u >> 3, hh = (u + u / F.G) & 7;
            if (c < 256) { if (hh < 4) ab_summary_unit<64, false>(F, layer, c, hh); else ab_summary_unit<64, true>(F, layer, c, hh - 4); }
            else { if (hh < 4) ab_summary_unit<32, false>(F, layer, c, hh); else ab_summary_unit<32, true>(F, layer, c, hh - 4); } }
        GRID_BAR();
        PH(5) { if (REP(5)) ab_scan<true>(F, layer); ab_scan<false>(F, layer); }
        GRID_BAR();
        PH(6) for (int rep = 0; rep <= (int)REP(6); ++rep) for (int u = F.vcu; u < NCHUNK * 8; u += F.G) { const int c = u >> 3, hh = (u + u / F.G) & 7;
            if (c < 256) { if (hh < 4) ab_output_unit<64, false>(F, layer, c, hh); else ab_output_unit<64, true>(F, layer, c, hh - 4); }
            else { if (hh < 4) ab_output_unit<32, false>(F, layer, c, hh); else ab_output_unit<32, true>(F, layer, c, hh - 4); } }
        GRID_BAR();
        PH(7) { using GC = pg8::Geo<D, D, D, 30, 0, 1 << 20, 0>; pg8::Gemm<GC> g{XN, (const bf16_t*)(ar + AR_WOUT), nullptr}; pg8::StaticOrder S; S.init(MP, D, F.G, (int)blockIdx.x);
          pg8::EpiRes E{F.out, modl, 2048, (layer == 0) ? F.in[I_XP] : F.out};
          pg8::gemm_phase<pg8::EpiRes, pg8::StaticOrder, GC, true, true>(F.lds, g, S, E);
          if (REP(7)) { pg8::EpiNull<false> EN; pg8::gemm_phase<pg8::EpiNull<false>, pg8::StaticOrder, GC, true, true>(F.lds, g, S, EN); }
          using GC2 = pg8::Geo<D, D, 256, 30, 0, 1 << 20, 0, true>; pg8::Gemm<GC2> g2{XN, (const bf16_t*)(ar + AR_WOUT), nullptr}; pg8::SplitOrder S2{F.vcu, 4};
          pg8::EpiPartial E2{(float*)(ws + WS_PART), 4};
          pg8::gemm_phase<pg8::EpiPartial, pg8::SplitOrder, GC2, true, true>(F.lds, g2, S2, E2); }
        GRID_BAR();
    } else {
        PH(8) for (int rep = 0; rep <= (int)REP(8); ++rep) norm_pass<1, 8>(F, layer, layer - 1, 5120, F.out + (size_t)MP * D, (float*)(ws + WS_SXB));
        GRID_BAR();
        PH(9) { using GCr = pg8::Geo<D, 2048, D, 2, M * D, 1 << 20, 0>; pg8::Gemm<GCr> gr{(const bf16_t*)(ws + WS_XMIX), (const bf16_t*)(ar + AR_WC1), nullptr}; pg8::StaticOrder Sr; Sr.init(M, 3072, F.G, (int)blockIdx.x);
          pg8::EpiRkv E{(bf16_t*)(ws + WS_RKV), (bf16_t*)(ws + WS_LO), (m == 0) ? (bf16_t*)(ws + WS_VFIRST) : nullptr};
          pg8::gemm_phase<pg8::EpiRkv, pg8::StaticOrder, GCr, true, true>(F.lds, gr, Sr, E);
          if (REP(9)) { pg8::EpiNull<true> EN; pg8::gemm_phase<pg8::EpiNull<true>, pg8::StaticOrder, GCr, true, true>(F.lds, gr, Sr, EN); }
          using GC = pg8::Geo<D, 2048, 2048, 30, 0, 16, -4096>; pg8::Gemm<GC> g{XN, (const bf16_t*)(ar + AR_WC1), (const bf16_t*)(ws + WS_PREVS)}; pg8::LoraOrder Sl{(int)blockIdx.x};
          pg8::gemm_phase<pg8::EpiRkv, pg8::LoraOrder, GC, true, true>(F.lds, g, Sl, E); }
        GRID_BAR();
        PH(10) { using GC = pg8::Geo<D, 256, 256, 2, 256, 1 << 20, 0>; pg8::Gemm<GC> g{(const bf16_t*)(ws + WS_LO), (const bf16_t*)(ar + AR_WC2), nullptr}; pg8::SkipVOrder S; S.skip = (m == 0); S.S.init(M, (m == 0) ? 3072 : 4096, F.G, (int)blockIdx.x);
          pg8::EpiLora2 E{(bf16_t*)(ws + WS_WLOG), XN, (bf16_t*)(ws + WS_G), (bf16_t*)(ws + WS_RKV), (m == 1) ? (const bf16_t*)(ws + WS_VFIRST) : nullptr,
                          F.in[I_RW0] + m * D, F.in[I_RA0] + m * D, F.in[I_RV0]};
          pg8::gemm_phase<pg8::EpiLora2, pg8::SkipVOrder, GC, true, true>(F.lds, g, S, E);
           }
        GRID_BAR();
        PH(11) { RawRegs raw; const int tid0 = otid(); int u = F.vcu; if (u < 256 * 16) rwkv_load_raw(F, u, tid0, raw);
          for (; u < 256 * 16; u += F.G) { const int c = u >> 4, hh = u & 15, un = (u + F.G < 256 * 16) ? u + F.G : -1;
              rwkv_local_unit<64>(F, layer, c, hh, raw, un); } }
        GRID_BAR();
        PH(17) { if (REP(17)) rwkv_scan_phase<LOCAL_SKIP>(F, layer); rwkv_scan_phase<0>(F, layer); }
        GRID_BAR();
        PH(18) { if (REP(18)) rwkv_output_phase<true>(F, layer); rwkv_output_phase<false>(F, layer); }
        GRID_BAR();
        PH(12) { using GC = pg8::Geo<3072, D, D, 30, 0, 1 << 20, 0>; pg8::Gemm<GC> g{(const bf16_t*)(ws + WS_RKV), (const bf16_t*)(ar + AR_WO), nullptr}; pg8::StaticOrder S; S.init(MP, D, F.G, (int)blockIdx.x);
          pg8::EpiRes E{F.out, modl, 2048, F.out};
          pg8::gemm_phase<pg8::EpiRes, pg8::StaticOrder, GC, true, true>(F.lds, g, S, E);
          if (REP(12)) { pg8::EpiNull<false> EN; pg8::gemm_phase<pg8::EpiNull<false>, pg8::StaticOrder, GC, true, true>(F.lds, g, S, EN); }
          using GC2 = pg8::Geo<3072, D, 256, 30, 0, 1 << 20, 0, true>; pg8::Gemm<GC2> g2{(const bf16_t*)(ws + WS_RKV), (const bf16_t*)(ar + AR_WO), nullptr}; pg8::SplitOrder S2{F.vcu, 4};
          pg8::EpiPartial E2{(float*)(ws + WS_PART), 4};
          pg8::gemm_phase<pg8::EpiPartial, pg8::SplitOrder, GC2, true, true>(F.lds, g2, S2, E2); }
        GRID_BAR();
    }
    PH(13) for (int rep = 0; rep <= (int)REP(13); ++rep) norm_pass<2, 4>(F, layer, layer, 2048, (layer == 0) ? F.in[I_XS] : (const float*)(ws + WS_SXB), F.out + (size_t)MP * D);
    GRID_BAR();
    PH(14) { using GC = pg8::Geo<D, D, D, 30, 0, 1 << 20, 0>; pg8::Gemm<GC> g{XN, (const bf16_t*)(ar + AR_W1), nullptr}; pg8::StaticOrder S; S.init(M, DFF, F.G, (int)blockIdx.x);
      pg8::EpiBf16<1> E{(bf16_t*)(ws + WS_H), DFF};
      pg8::gemm_phase<pg8::EpiBf16<1>, pg8::StaticOrder, GC, true, true>(F.lds, g, S, E);
          if (REP(14)) { pg8::EpiNull<true> EN; pg8::gemm_phase<pg8::EpiNull<true>, pg8::StaticOrder, GC, true, true>(F.lds, g, S, EN); } }
    GRID_BAR();
    PH(15) { using GC = pg8::Geo<DFF, DFF, DFF, 30, 0, 1 << 20, 0>; pg8::Gemm<GC> g{(const bf16_t*)(ws + WS_H), (const bf16_t*)(ar + AR_W2), nullptr}; pg8::StaticOrder S; S.init(MP, D, F.G, (int)blockIdx.x);
      pg8::EpiRes E{F.out, modl, 5120, F.out};
      for (int xb = 0; xb < EXTRA_BARS; ++xb) GRID_BAR();
      pg8::gemm_phase<pg8::EpiRes, pg8::StaticOrder, GC, true, true>(F.lds, g, S, E);
      if (REP(15)) { pg8::EpiNull<false> EN; pg8::gemm_phase<pg8::EpiNull<false>, pg8::StaticOrder, GC, true, true>(F.lds, g, S, EN); }
      using GC2 = pg8::Geo<DFF, DFF, 512, 30, 0, 1 << 20, 0, true>; pg8::Gemm<GC2> g2{(const bf16_t*)(ws + WS_H), (const bf16_t*)(ar + AR_W2), nullptr}; pg8::SplitOrder S2{F.vcu, 8};
      pg8::EpiPartial E2{(float*)(ws + WS_PART), 8};
      pg8::gemm_phase<pg8::EpiPartial, pg8::SplitOrder, GC2, true, true>(F.lds, g2, S2, E2); }
    GRID_BAR();
}

__global__ void __launch_bounds__(NT, 2) fwd_kernel(Args args) {
    extern __shared__ __attribute__((aligned(16))) unsigned char lds[];
    Frame F;
    F.lds = (LAS unsigned char*)lds; F.MISC = (volatile LAS unsigned*)(F.lds + MISC_OFF);
    F.wave = __builtin_amdgcn_readfirstlane(threadIdx.x >> 6);
    F.G = gridDim.x; { const int bx = blockIdx.x; F.vcu = (F.G % 8 == 0) ? (bx % 8) * (F.G / 8) + bx / 8 : bx; }
    F.in = args.in; F.out = args.out; F.ws = args.ws;
    for (int u = threadIdx.x; u < (LDS_BYTES - LDSCTL_OFF) / 4; u += NT) ((LAS unsigned*)(F.lds + LDSCTL_OFF))[u] = 0u;
    __syncthreads();
    XcdBarrier bar = xcd_barrier_post((unsigned*)(F.ws + WS_CTL) + CW_BAR, F.MISC + 8);
    PH(0) prologue(F);
    GRID_BAR();
    PH(0) mod_phase(F, 0, 2, F.vcu, F.G);
    GRID_BAR();
    layer_body<0>(F, bar); layer_body<1>(F, bar); layer_body<2>(F, bar); layer_body<3>(F, bar);
    PH(16) norm_pass<3, 8>(F, 0, 3, 5120, F.out + (size_t)MP * D, nullptr);
}

extern "C" void kernel_launch(void* const* d_in, const int* in_sizes, int n_in, void* d_out, int out_size, void* d_ws, size_t ws_size, hipStream_t stream) {
    static int grid = 0;
    if (grid == 0) {
        if (n_in != 38 || out_size != 28706816 || ws_size < WS_END) { fprintf(stderr, "kernel_launch: unexpected problem (n_in %d, out %d, ws %zu; need ws >= %zu)\n", n_in, out_size, ws_size, (size_t)WS_END); grid = -1; return; }
        int dev = 0, cus = 0, per_cu = 0;
        if (hipGetDevice(&dev) != hipSuccess || hipDeviceGetAttribute(&cus, hipDeviceAttributeMultiprocessorCount, dev) != hipSuccess) { grid = -1; return; }
        if (hipFuncSetAttribute((const void*)fwd_kernel, hipFuncAttributeMaxDynamicSharedMemorySize, LDS_BYTES) != hipSuccess) { fprintf(stderr, "kernel_launch: hipFuncSetAttribute failed\n"); grid = -1; return; }
        if (hipOccupancyMaxActiveBlocksPerMultiprocessor(&per_cu, (const void*)fwd_kernel, NT, LDS_BYTES) != hipSuccess || per_cu < 1) { fprintf(stderr, "kernel_launch: occupancy query says %d\n", per_cu); per_cu = 1; }
        (void)hipGetLastError();
        grid = cus;
    }
    if (grid < 0) return;
    (void)hipMemsetAsync((char*)d_ws + WS_CTL, 0, ZERO_BYTES, stream);
    Args a{};
    for (int i = 0; i < 38; ++i) a.in[i] = (const float*)d_in[i];
    a.out = (float*)d_out; a.ws = (unsigned char*)d_ws;
    void* kargs[] = {&a};
    hipError_t e = hipLaunchCooperativeKernel((const void*)fwd_kernel, dim3(grid), dim3(NT), kargs, LDS_BYTES, stream);
    if (e != hipSuccess) fprintf(stderr, "kernel_launch: cooperative launch failed: %s (grid %d)\n", hipGetErrorString(e), grid);
}
```

```cpp
#include <hip/hip_runtime.h>
#include <cstdio>
#include <cstdint>

#define LAS __attribute__((address_space(3)))
#define GAS __attribute__((address_space(1)))
typedef unsigned short bf16_t;
typedef short bf16x8 __attribute__((ext_vector_type(8)));
typedef float f32x4 __attribute__((ext_vector_type(4)));
typedef float f32x2 __attribute__((ext_vector_type(2)));
typedef unsigned u32x4 __attribute__((ext_vector_type(4)));
typedef unsigned u32x2 __attribute__((ext_vector_type(2)));

#ifndef LOCAL_SKIP
#define LOCAL_SKIP 0
#endif
constexpr int D = 1024, MP = 16384, MS = 1024, M = MP + MS, NSEQ = 33, DFF = 4096, ABIN = 3584;
constexpr int NCHUNK = 288;
constexpr int SLOT_E = 4 * 8192 + 4 * 16384;
constexpr float NORM_EPS = 1e-6f, RW_LN_EPS = 64e-5f;

constexpr size_t MiB = 1u << 20;
constexpr size_t WS_CTL = 0, WS_MOD = 1 * MiB, ZERO_BYTES = 65536;
constexpr size_t WS_ROPE = 5 * MiB;
constexpr size_t WS_ARENA = 10 * MiB;
constexpr size_t AR_W1 = 0, AR_W2 = 8 * MiB, AR_WIN = 16 * MiB, AR_WOUT = 23 * MiB, AR_WC1 = 16 * MiB, AR_WC2 = 32 * MiB, AR_WO = 34 * MiB;
constexpr size_t WS_VFIRST = 46 * MiB;
constexpr size_t WS_XN0 = 80 * MiB, WS_XN = WS_XN0 + 2048;
constexpr size_t WS_PREVS = 115 * MiB;
constexpr size_t WS_R1 = 118 * MiB;
constexpr size_t WS_Z = WS_R1, WS_STATE = WS_R1 + 120 * MiB, WS_DEC = WS_R1 + 174 * MiB;
constexpr size_t WS_H = WS_R1;
constexpr size_t WS_RKV = WS_R1, WS_LO = WS_R1 + 102 * MiB, WS_WLOG = WS_R1 + 136 * MiB, WS_G = WS_R1 + 170 * MiB;
constexpr size_t WS_TST = WS_R1 + 102 * MiB;
constexpr size_t WS_REC = WS_R1 + 204 * MiB, WS_BON = WS_R1 + 269 * MiB;
constexpr int REC_B = 16640;
constexpr size_t WS_XMIX = WS_R1 + 168 * MiB;
constexpr size_t WS_PART = WS_R1 + 136 * MiB;
constexpr size_t WS_SXB = WS_R1 + 271 * MiB;
constexpr size_t WS_END = WS_R1 + 275 * MiB;

__device__ const double ROPE_REV[32] = {0.15915494309189535, 0.11934937021124886, 0.089499401608891013, 0.067115083005227255, 0.050329212104487035, 0.037741584717419771, 0.028302195830623399, 0.02122365276477766, 0.015915494309189534, 0.011934937021124886, 0.0089499401608891024, 0.0067115083005227253, 0.0050329212104487037, 0.0037741584717419772, 0.0028302195830623399, 0.0021223652764777662, 0.0015915494309189536, 0.0011934937021124885, 0.00089499401608891024, 0.0006711508300522726, 0.00050329212104487033, 0.00037741584717419774, 0.00028302195830623395, 0.00021223652764777661, 0.00015915494309189535, 0.00011934937021124886, 8.9499401608891018e-05, 6.7115083005227254e-05, 5.0329212104487035e-05, 3.7741584717419777e-05, 2.8302195830623396e-05, 2.1223652764777659e-05};

__device__ __forceinline__ unsigned f2bf(float f) { unsigned u = __builtin_bit_cast(unsigned, f); return (u + 0x7fffu + ((u >> 16) & 1u)) >> 16; }
typedef __bf16 bf16x2_t __attribute__((ext_vector_type(2)));
__device__ __forceinline__ unsigned pk2(float lo, float hi) { const f32x2 v = {lo, hi}; const bf16x2_t b = __builtin_convertvector(v, bf16x2_t); return __builtin_bit_cast(unsigned, b); }
__device__ __forceinline__ float bf2f(unsigned short b) { return __builtin_bit_cast(float, (unsigned)b << 16); }
__device__ __forceinline__ float bflo(unsigned w) { return __builtin_bit_cast(float, w << 16); }
__device__ __forceinline__ float bfhi(unsigned w) { return __builtin_bit_cast(float, w & 0xffff0000u); }
__device__ __forceinline__ float sigmoidf_(float x) { return 1.f / (1.f + __expf(-x)); }
__device__ __forceinline__ float siluf_(float x) { return x / (1.f + __expf(-x)); }
__device__ __forceinline__ float wave_sum(float v) {
#pragma unroll
    for (int o = 1; o < 64; o <<= 1) v += __shfl_xor(v, o);
    return v;
}
__device__ __forceinline__ int otid() { int t = threadIdx.x; asm volatile("" : "+v"(t)); return t; }
__device__ __forceinline__ int seq_of_row(int r) { return r < MP ? 0 : 1 + ((r - MP) >> 5); }
#define LDS_WAIT() asm volatile("s_waitcnt lgkmcnt(0)" ::: "memory")
#define VM_WAIT() asm volatile("s_waitcnt vmcnt(0)" ::: "memory")

namespace pg8 {
constexpr int BM = 256, BK = 64, HALF = 128, HTB = HALF * BK * 2, STAGE_BYTES = 8 * HTB, NXCD = 8, WGM = 8;
__host__ __device__ __forceinline__ int lds_byte(int r, int c) { const int st = (r >> 4) * 2 + (c >> 5), rr = r & 15, cc = c & 31, ob = rr * 64 + cc * 2; return st * 1024 + (ob ^ (((ob >> 9) & 1) << 5)); }
__host__ __device__ __forceinline__ void stage_rc(int b, int& R, int& C) { const int st = b / 1024, sb = b % 1024, swz = sb ^ (((sb >> 9) & 1) << 5); R = (st >> 1) * 16 + swz / 64; C = (st & 1) * 32 + (swz % 64) / 2; }
__host__ __device__ __forceinline__ int perm32(int rho) { const int n = rho >> 4, i = rho & 15; return 8 * (i >> 2) + 4 * n + (i & 3); }

struct Unit { int pm, pn, ks; };
template <int LDA_, int LDB_, int K_, int GSHIFT_, int GSTRIDE_, int KSPLIT_, int DELTAP_, bool SPLIT_ = false> struct Geo {
    static constexpr int LDA = LDA_, LDB = LDB_, K = K_, GSHIFT = GSHIFT_, GSTRIDE = GSTRIDE_, KSPLIT = KSPLIT_, DELTAP = DELTAP_; static constexpr bool SPLIT = SPLIT_;
};
template <class GC> struct Gemm {
    const bf16_t* A; const bf16_t* Bt; const bf16_t* A2s;
    __device__ __forceinline__ const char* a_base(const Unit& u) const { return (const char*)(A + (size_t)u.pm * BM * GC::LDA + (size_t)(u.pn >> GC::GSHIFT) * GC::GSTRIDE + (GC::SPLIT ? (size_t)u.ks * GC::K : 0)); }
    __device__ __forceinline__ const char* b_base(const Unit& u) const { return (const char*)(Bt + (size_t)u.pn * BM * GC::LDB + (GC::SPLIT ? (size_t)u.ks * GC::K : 0)); }
    __device__ __forceinline__ long a_delta(const Unit& u) const {
        if constexpr (GC::KSPLIT >= GC::K / BK) return 0;
        else { if (u.pm < 64) return (long)GC::DELTAP;
            return (long)((const char*)(A2s + (size_t)(u.pm - 64) * BM * GC::LDA) - a_base(u)) - (long)GC::KSPLIT * BK * 2; }
    }
};
struct StaticOrder {
    int nM, nN, nwg, G, c;
    __host__ __device__ void init(int M_, int N_, int G_, int c_) { nM = M_ / BM; nN = N_ / BM; nwg = nM * nN; G = G_; c = c_; }
    __host__ __device__ bool next(int i, Unit& u) const {
        const long L = (long)i * G + c; if (L >= nwg) return false;
        int wgid = (int)L; { const int q = nwg / NXCD, r = nwg % NXCD, xcd = wgid % NXCD, off = wgid / NXCD; wgid = (xcd < r ? xcd * (q + 1) : r * (q + 1) + (xcd - r) * q) + off; }
        const int nig = WGM * nN, gid = wgid / nig, fm = gid * WGM, gsz = (nM - fm) < WGM ? (nM - fm) : WGM;
        u.pm = fm + ((wgid % nig) % gsz); u.pn = (wgid % nig) / gsz; u.ks = 0; return true;
    }
};
__device__ __forceinline__ unsigned cvt_pk_bf16(float lo, float hi) { return pk2(lo, hi); }

template <class Epi, class Sched, class GC, bool ALIGN_EPI = false, bool SP2 = false>
__device__ __forceinline__ void gemm_phase(LAS unsigned char* lds, const Gemm<GC> g, const Sched& S, const Epi& E) {
    const int tid = otid(), wid = __builtin_amdgcn_readfirstlane(tid >> 6), lane = tid & 63, wr = wid >> 2, wc = wid & 3, fr = lane & 15, fq = lane >> 4;
    constexpr int K = GC::K, nt = K / BK, ksplit = GC::KSPLIT;
    unsigned voffA[2], voffB[2];
#pragma unroll
    for (int i = 0; i < 2; ++i) { int R, C; stage_rc(tid * 16 + i * 8192, R, C); const int Rb = Epi::PERM ? ((R & ~31) + perm32(R & 31)) : R;
        voffA[i] = (unsigned)(R * GC::LDA + C) * 2u; voffB[i] = (unsigned)(Rb * GC::LDB + C) * 2u; }
    constexpr size_t kstep = (size_t)(BK * 2);
    constexpr size_t hstepA = (size_t)HALF * GC::LDA * 2, hstepB = (size_t)HALF * GC::LDB * 2;
    const unsigned ldsw = (unsigned)wid * 1024u;
    const int aoff = lds_byte(wr * 64 + fr, fq * 8), boff = lds_byte(wc * 32 + fr, fq * 8);
#define PG8_SA(b, h) (((b) * 2 + (h)) * HTB)
#define PG8_SB(b, h) ((4 + (b) * 2 + (h)) * HTB)
#define PG8_STAGE(bufoff, gbase, voff) do { _Pragma("unroll") for (int _i = 0; _i < 2; ++_i) \
        __builtin_amdgcn_global_load_lds((const unsigned*)((const char*)(gbase) + (voff)[_i]), (LAS unsigned*)(lds + (bufoff) + ldsw + _i * 8192), 16, 0, 0); } while (0)
#define PG8_LDA(dst, b, h) do { _Pragma("unroll") for (int m = 0; m < 4; ++m) _Pragma("unroll") for (int k = 0; k < 2; ++k) dst[m][k] = *(const LAS bf16x8*)(lds + PG8_SA(b, h) + aoff + m * 2048 + k * 1024); } while (0)
#define PG8_LDB(dst, b, h) do { _Pragma("unroll") for (int n = 0; n < 2; ++n) _Pragma("unroll") for (int k = 0; k < 2; ++k) dst[n][k] = *(const LAS bf16x8*)(lds + PG8_SB(b, h) + boff + n * 2048 + k * 1024); } while (0)
#define PG8_MMA(ai, bj, At, Bt) do { __builtin_amdgcn_s_setprio(1); _Pragma("unroll") for (int m = 0; m < 4; ++m) _Pragma("unroll") for (int n = 0; n < 2; ++n) _Pragma("unroll") for (int k = 0; k < 2; ++k) \
        acc[ai][bj][m][n] = __builtin_amdgcn_mfma_f32_16x16x32_bf16(Bt[n][k], At[m][k], acc[ai][bj][m][n], 0, 0, 0); __builtin_amdgcn_s_setprio(0); } while (0)
#define PG8_WAIT_V(n) asm volatile("s_waitcnt vmcnt(" #n ")" ::: "memory")
#define PG8_WAIT_L(n) asm volatile("s_waitcnt lgkmcnt(" #n ")" ::: "memory")
#define PG8_BAR __builtin_amdgcn_s_barrier()
#define PG8_SCHED __builtin_amdgcn_sched_barrier(0)
    Unit cur, nxt; int ui = 0;
    if (!S.next(0, cur)) return;
    f32x4 acc[2][2][4][2];
#pragma unroll
    for (int a = 0; a < 2; ++a)
#pragma unroll
        for (int b = 0; b < 2; ++b)
#pragma unroll
            for (int m = 0; m < 4; ++m)
#pragma unroll
                for (int n = 0; n < 2; ++n) acc[a][b][m][n] = (f32x4){0.f, 0.f, 0.f, 0.f};
    bf16x8 At[4][2], B0[2][2], B1[2][2];
    const char* cA = g.a_base(cur); const char* cB = g.b_base(cur); long cD = g.a_delta(cur);
    if constexpr (SP2) {
        PG8_STAGE(PG8_SB(0, 0), cB, voffB); PG8_STAGE(PG8_SB(0, 1), cB + hstepB, voffB); PG8_STAGE(PG8_SA(0, 0), cA, voffA); PG8_STAGE(PG8_SA(0, 1), cA + hstepA, voffA);
        if (wr == 1) PG8_BAR;
        PG8_WAIT_V(2); PG8_BAR;
        PG8_STAGE(PG8_SB(1, 0), cB + kstep, voffB); PG8_STAGE(PG8_SA(1, 0), cA + kstep, voffA); PG8_STAGE(PG8_SB(1, 1), cB + hstepB + kstep, voffB);
        PG8_WAIT_V(6); PG8_BAR;
    } else {
        PG8_STAGE(PG8_SB(0, 0), cB, voffB); PG8_STAGE(PG8_SA(0, 0), cA, voffA); PG8_STAGE(PG8_SB(0, 1), cB + hstepB, voffB); PG8_STAGE(PG8_SA(0, 1), cA + hstepA, voffA);
        if (wr == 1) PG8_BAR;
        PG8_WAIT_V(4); PG8_BAR;
        PG8_STAGE(PG8_SB(1, 0), cB + kstep, voffB); PG8_STAGE(PG8_SA(1, 0), cA + kstep, voffA); PG8_STAGE(PG8_SB(1, 1), cB + hstepB + kstep, voffB);
        PG8_WAIT_V(6); PG8_BAR;
    }
    for (;;) {
        const bool has_next = S.next(ui + 1, nxt);
        const char* nA = has_next ? g.a_base(nxt) : cA; const char* nB = has_next ? g.b_base(nxt) : cB;
        const long nD = has_next ? g.a_delta(nxt) : cD;
#pragma unroll 1
        for (int t = 0; t < nt; t += 2) {
            const bool last = (t == nt - 2);
            const char* a1 = cA + (size_t)(t + 1) * kstep + (t >= ksplit ? cD : 0);
            const char* a2 = last ? nA : cA + (size_t)(t + 2) * kstep + (t + 2 >= ksplit ? cD : 0); const char* b2 = last ? nB : cB + (size_t)(t + 2) * kstep;
            const char* a3 = a2 + kstep; const char* b3 = b2 + kstep;
            if constexpr (SP2) {
            PG8_LDB(B0, 0, 0); PG8_LDB(B1, 0, 1); PG8_SCHED; PG8_LDA(At, 0, 0); PG8_STAGE(PG8_SA(1, 1), a1 + hstepA, voffA);
            PG8_WAIT_V(8); PG8_WAIT_L(0); PG8_BAR; PG8_MMA(0, 0, At, B0); PG8_MMA(0, 1, At, B1); PG8_BAR; PG8_SCHED;
            PG8_LDA(At, 0, 1); PG8_STAGE(PG8_SB(0, 0), b2, voffB); PG8_STAGE(PG8_SB(0, 1), b2 + hstepB, voffB); PG8_STAGE(PG8_SA(0, 0), a2, voffA);
            PG8_WAIT_V(8); PG8_WAIT_L(0); PG8_BAR; PG8_MMA(1, 0, At, B0); PG8_MMA(1, 1, At, B1); PG8_BAR; PG8_SCHED;
            PG8_LDB(B0, 1, 0); PG8_LDB(B1, 1, 1); PG8_SCHED; PG8_LDA(At, 1, 0); PG8_STAGE(PG8_SA(0, 1), a2 + hstepA, voffA);
            PG8_WAIT_V(8); PG8_WAIT_L(0); PG8_BAR; PG8_MMA(0, 0, At, B0); PG8_MMA(0, 1, At, B1); PG8_BAR; PG8_SCHED;
            PG8_LDA(At, 1, 1); PG8_STAGE(PG8_SB(1, 0), b3, voffB); PG8_STAGE(PG8_SB(1, 1), b3 + hstepB, voffB); PG8_STAGE(PG8_SA(1, 0), a3, voffA);
            PG8_WAIT_V(8); PG8_WAIT_L(0); PG8_BAR; PG8_MMA(1, 0, At, B0); PG8_MMA(1, 1, At, B1); PG8_BAR; PG8_SCHED;
            } else {
            PG8_LDB(B0, 0, 0); PG8_SCHED; PG8_LDA(At, 0, 0); PG8_STAGE(PG8_SA(1, 1), a1 + hstepA, voffA);
            PG8_WAIT_L(8); PG8_BAR; PG8_WAIT_L(0); PG8_MMA(0, 0, At, B0); PG8_BAR; PG8_SCHED;
            PG8_LDB(B1, 0, 1); PG8_STAGE(PG8_SB(0, 0), b2, voffB);
            PG8_BAR; PG8_WAIT_L(0); PG8_MMA(0, 1, At, B1); PG8_BAR;
            PG8_LDA(At, 0, 1); PG8_STAGE(PG8_SA(0, 0), a2, voffA);
            PG8_BAR; PG8_WAIT_L(0); PG8_MMA(1, 0, At, B0); PG8_BAR; PG8_SCHED;
            PG8_STAGE(PG8_SB(0, 1), b2 + hstepB, voffB);
            PG8_WAIT_V(6); PG8_BAR; PG8_MMA(1, 1, At, B1); PG8_BAR;
            PG8_LDB(B0, 1, 0); PG8_SCHED; PG8_LDA(At, 1, 0); PG8_STAGE(PG8_SA(0, 1), a2 + hstepA, voffA);
            PG8_WAIT_L(8); PG8_BAR; PG8_WAIT_L(0); PG8_MMA(0, 0, At, B0); PG8_BAR; PG8_SCHED;
            PG8_LDB(B1, 1, 1); PG8_STAGE(PG8_SB(1, 0), b3, voffB);
            PG8_BAR; PG8_WAIT_L(0); PG8_MMA(0, 1, At, B1); PG8_BAR;
            PG8_LDA(At, 1, 1); PG8_STAGE(PG8_SA(1, 0), a3, voffA);
            PG8_BAR; PG8_WAIT_L(0); PG8_MMA(1, 0, At, B0); PG8_BAR; PG8_SCHED;
            PG8_STAGE(PG8_SB(1, 1), b3 + hstepB, voffB);
            PG8_WAIT_V(6); PG8_BAR; PG8_MMA(1, 1, At, B1); PG8_BAR;
            }
        }
        if constexpr (ALIGN_EPI) { if (wr == 0) PG8_BAR; }
        E(acc, cur, wr, wc, fr, fq);
        if (!has_next) break;
#pragma unroll
        for (int a = 0; a < 2; ++a)
#pragma unroll
            for (int b = 0; b < 2; ++b)
#pragma unroll
                for (int m = 0; m < 4; ++m)
#pragma unroll
                    for (int n = 0; n < 2; ++n) acc[a][b][m][n] = (f32x4){0.f, 0.f, 0.f, 0.f};
        cur = nxt; cA = nA; cB = nB; cD = nD; ++ui;
        if constexpr (ALIGN_EPI) { if (wr == 1) PG8_BAR; }
    }
    PG8_WAIT_V(0);
    if constexpr (!ALIGN_EPI) { if (wr == 0) PG8_BAR; }
    PG8_BAR;
#undef PG8_SA
#undef PG8_SB
#undef PG8_STAGE
#undef PG8_LDA
#undef PG8_LDB
#undef PG8_MMA
#undef PG8_WAIT_V
#undef PG8_WAIT_L
#undef PG8_BAR
#undef PG8_SCHED
}

__device__ __forceinline__ float act_apply(float v, int act) {
    if (act == 1) { const float r = v > 0.f ? v : 0.f; return r * r; }
    if (act == 2) { const float e = __expf(-2.f * fabsf(v)); const float t = (1.f - e) / (1.f + e); return v < 0.f ? -t : t; }
    if (act == 3) return 1.f / (1.f + __expf(-v));
    return v;
}
template <int ACT> __device__ __forceinline__ void store_tile_bf16(const f32x4 (&acc)[2][2][4][2], bf16_t* base, int ldc, int row0, int col0, bf16_t* base2, int ldc2, int col2) {
#pragma unroll
    for (int ai = 0; ai < 2; ++ai)
#pragma unroll
        for (int m = 0; m < 4; ++m) { const size_t r = (size_t)(row0 + ai * HALF + m * 16);
#pragma unroll
            for (int bj = 0; bj < 2; ++bj) { f32x4 v0 = acc[ai][bj][m][0], v1 = acc[ai][bj][m][1];
#pragma unroll
                for (int q = 0; q < 4; ++q) { v0[q] = act_apply(v0[q], ACT); v1[q] = act_apply(v1[q], ACT); }
                u32x4 w; w.x = cvt_pk_bf16(v0[0], v0[1]); w.y = cvt_pk_bf16(v0[2], v0[3]); w.z = cvt_pk_bf16(v1[0], v1[1]); w.w = cvt_pk_bf16(v1[2], v1[3]);
                *(u32x4*)(base + r * ldc + col0 + bj * HALF) = w;
                if (base2) *(u32x4*)(base2 + r * ldc2 + col2 + bj * HALF) = w; } }
}
template <int ACT> struct EpiBf16 {
    static constexpr bool PERM = true;
    bf16_t* O; int ldc;
    __device__ __forceinline__ void operator()(const f32x4 (&acc)[2][2][4][2], const Unit& u, int wr, int wc, int fr, int fq) const {
        store_tile_bf16<ACT>(acc, O, ldc, u.pm * BM + wr * 64 + fr, u.pn * BM + wc * 32 + 8 * fq, nullptr, 0, 0);
    }
};
struct EpiRkv {
    static constexpr bool PERM = true;
    bf16_t* RKV; bf16_t* LO; bf16_t* vf;
    __device__ __forceinline__ void operator()(const f32x4 (&acc)[2][2][4][2], const Unit& u, int wr, int wc, int fr, int fq) const {
        const int row0 = u.pm * BM + wr * 64 + fr, cin = wc * 32 + 8 * fq;
        if (u.pn < 12) { bf16_t* b2 = (u.pn >= 8) ? vf : nullptr; store_tile_bf16<0>(acc, RKV, 3072, row0, u.pn * BM + cin, b2, 1024, (u.pn - 8) * BM + cin); }
        else {
#pragma unroll
            for (int bj = 0; bj < 2; ++bj) { const int c = cin + bj * HALF; int dst = -1, act = 0;
                if (u.pn == 12) { if (c < 64) { dst = c; act = 2; } else if (c < 128) dst = 256 + (c - 64); else if (c < 160) dst = 512 + (c - 128); }
                else if (c < 160) { dst = 768 + c; act = 3; }
                if (dst >= 0) {
#pragma unroll
                    for (int ai = 0; ai < 2; ++ai)
#pragma unroll
                        for (int m = 0; m < 4; ++m) { const size_t r = (size_t)(row0 + ai * HALF + m * 16); f32x4 v0 = acc[ai][bj][m][0], v1 = acc[ai][bj][m][1];
#pragma unroll
                            for (int q = 0; q < 4; ++q) { v0[q] = act_apply(v0[q], act); v1[q] = act_apply(v1[q], act); }
                            u32x4 w; w.x = cvt_pk_bf16(v0[0], v0[1]); w.y = cvt_pk_bf16(v0[2], v0[3]); w.z = cvt_pk_bf16(v1[0], v1[1]); w.w = cvt_pk_bf16(v1[2], v1[3]);
                            *(u32x4*)(LO + r * 1024 + dst) = w; } } }
        }
    }
};
struct EpiRes {
    static constexpr bool PERM = false;
    float* X; const float* modl; int goff; const float* Xin;
    __device__ __forceinline__ void operator()(const f32x4 (&acc)[2][2][4][2], const Unit& u, int wr, int wc, int fr, int fq) const {
        const int col0 = u.pn * BM + wc * 32 + 4 * fq;
#pragma unroll
        for (int ai = 0; ai < 2; ++ai)
#pragma unroll
            for (int m = 0; m < 4; ++m) { const int r = u.pm * BM + ai * HALF + wr * 64 + m * 16 + fr; const float* gp = modl + (size_t)seq_of_row(r) * 6144 + goff + col0; float* xp = X + (size_t)r * D + col0; const float* xi = Xin + (size_t)r * D + col0;
#pragma unroll
                for (int bj = 0; bj < 2; ++bj)
#pragma unroll
                    for (int n = 0; n < 2; ++n) { const f32x4 gv = *(const f32x4*)(gp + bj * HALF + n * 16); f32x4 xv = *(const f32x4*)(xi + bj * HALF + n * 16);
                        xv = xv + gv * acc[ai][bj][m][n]; *(f32x4*)(xp + bj * HALF + n * 16) = xv; }
                asm volatile("" ::: "memory"); }
    }
};
struct EpiLora2 {
    static constexpr bool PERM = false;
    bf16_t* WLOG; bf16_t* Aout; bf16_t* G; bf16_t* RKV; const bf16_t* vf; const float* w0; const float* a0; const float* v0;
    template <int GRP> __device__ __forceinline__ void run(const f32x4 (&acc)[2][2][4][2], const Unit& u, int wr, int wc, int fr, int fq) const {
        const int col0 = (u.pn & 3) * BM + wc * 32 + 4 * fq;
#pragma unroll
        for (int ai = 0; ai < 2; ++ai)
#pragma unroll
            for (int m = 0; m < 4; ++m) { const size_t r = (size_t)(u.pm * BM + ai * HALF + wr * 64 + m * 16 + fr);
#pragma unroll
                for (int bj = 0; bj < 2; ++bj)
#pragma unroll
                    for (int n = 0; n < 2; ++n) { const int c = col0 + bj * HALF + n * 16; const f32x4 a = acc[ai][bj][m][n]; f32x4 o;
                        if constexpr (GRP == 0) { const f32x4 b = *(const f32x4*)(w0 + c);
#pragma unroll
                            for (int q = 0; q < 4; ++q) { const float x = -(b[q] + a[q]); const float sp = fmaxf(x, 0.f) + __logf(1.f + __expf(-fabsf(x))); o[q] = -__expf(-sp - 0.5f); }
                            u32x2 w; w.x = cvt_pk_bf16(o[0], o[1]); w.y = cvt_pk_bf16(o[2], o[3]); *(u32x2*)(WLOG + r * D + c) = w; }
                        else if constexpr (GRP == 1) { const f32x4 b = *(const f32x4*)(a0 + c);
#pragma unroll
                            for (int q = 0; q < 4; ++q) o[q] = 1.f / (1.f + __expf(-(b[q] + a[q])));
                            u32x2 w; w.x = cvt_pk_bf16(o[0], o[1]); w.y = cvt_pk_bf16(o[2], o[3]); *(u32x2*)(Aout + r * D + c) = w; }
                        else if constexpr (GRP == 2) { const f32x4 b = *(const f32x4*)(v0 + c); const u32x2 vv = *(const u32x2*)(RKV + r * 3072 + 2048 + c), ff = *(const u32x2*)(vf + r * D + c);
                            f32x4 v4, f4; v4[0] = bflo(vv.x); v4[1] = bfhi(vv.x); v4[2] = bflo(vv.y); v4[3] = bfhi(vv.y); f4[0] = bflo(ff.x); f4[1] = bfhi(ff.x); f4[2] = bflo(ff.y); f4[3] = bfhi(ff.y);
#pragma unroll
                            for (int q = 0; q < 4; ++q) { const float gte = 1.f / (1.f + __expf(-(b[q] + a[q]))); o[q] = v4[q] + (f4[q] - v4[q]) * gte; }
                            u32x2 w; w.x = cvt_pk_bf16(o[0], o[1]); w.y = cvt_pk_bf16(o[2], o[3]); *(u32x2*)(RKV + r * 3072 + 2048 + c) = w; }
                        else { u32x2 w; w.x = cvt_pk_bf16(a[0], a[1]); w.y = cvt_pk_bf16(a[2], a[3]); *(u32x2*)(G + r * D + c) = w; } }
                asm volatile("" ::: "memory"); }
    }
    __device__ __forceinline__ void operator()(const f32x4 (&acc)[2][2][4][2], const Unit& u, int wr, int wc, int fr, int fq) const {
        const int grp = u.pn >> 2;
        if (grp == 0) run<0>(acc, u, wr, wc, fr, fq);
        else if (grp == 1) run<1>(acc, u, wr, wc, fr, fq);
        else if (grp == 2) { if (vf != nullptr) run<2>(acc, u, wr, wc, fr, fq); }
        else run<3>(acc, u, wr, wc, fr, fq);
    }
};
struct SplitOrder {
    int c, splitk;
    __device__ bool next(int i, Unit& u) const { if (i != 0 || c >= 16 * splitk) return false; const int t = c / splitk; u.pm = 64 + (t >> 2); u.pn = t & 3; u.ks = c % splitk; return true; }
};
struct SkipVOrder {
    StaticOrder S; bool skip;
    __device__ bool next(int i, Unit& u) const { if (!S.next(i, u)) return false; if (skip && u.pn >= 8) u.pn += 4; return true; }
};
struct LoraOrder {
    int c;
    __device__ bool next(int i, Unit& u) const { const int idx = c - 48; if (i != 0 || idx < 0 || idx >= 136) return false; u.pm = idx >> 1; u.pn = 12 + (idx & 1); u.ks = 0; return true; }
};
struct EpiPartial {
    static constexpr bool PERM = false;
    float* PART; int splitk;
    __device__ __forceinline__ void operator()(const f32x4 (&acc)[2][2][4][2], const Unit& u, int wr, int wc, int fr, int fq) const {
        float* base = PART + ((size_t)(((u.pm - 64) * 4 + u.pn) * splitk + u.ks) << 16) + wc * 32 + 4 * fq;
#pragma unroll
        for (int ai = 0; ai < 2; ++ai)
#pragma unroll
            for (int m = 0; m < 4; ++m) { float* rp = base + (ai * HALF + wr * 64 + m * 16 + fr) * 256;
#pragma unroll
                for (int bj = 0; bj < 2; ++bj)
#pragma unroll
                    for (int n = 0; n < 2; ++n) *(f32x4*)(rp + bj * HALF + n * 16) = acc[ai][bj][m][n]; }
    }
};
template <bool PERM_> struct EpiNull {
    static constexpr bool PERM = PERM_;
    __device__ __forceinline__ void operator()(const f32x4 (&acc)[2][2][4][2], const Unit&, int, int, int, int) const {
#pragma unroll
        for (int a = 0; a < 2; ++a)
#pragma unroll
            for (int b = 0; b < 2; ++b)
#pragma unroll
                for (int m = 0; m < 4; ++m)
#pragma unroll
                    for (int n = 0; n < 2; ++n) asm volatile("" :: "v"(acc[a][b][m][n]));
    }
};
}

#define RLX_AGENT __ATOMIC_RELAXED, __HIP_MEMORY_SCOPE_AGENT
#define XB_TMO      128
#define XB_XCNT(j)  (256  + 64 * (j))
#define XB_XSUB(j)  (1280 + 64 * (j))
#define XB_XGEN(j)  (2304 + 64 * (j))
#define XB_TOP      3328
#define XB_TOPGEN   3392
#define XCD_BAR_WORDS 3456
#define XB_SPIN_CAP (1u << 24)
__device__ __forceinline__ unsigned xb_ld(unsigned* p)              { return __hip_atomic_load(p, __ATOMIC_RELAXED, __HIP_MEMORY_SCOPE_AGENT); }
__device__ __forceinline__ unsigned xb_add(unsigned* p, unsigned v) { return __hip_atomic_fetch_add(p, v, __ATOMIC_RELAXED, __HIP_MEMORY_SCOPE_AGENT); }
__device__ __forceinline__ unsigned xb_xcc_id() { return (unsigned)__builtin_amdgcn_s_getreg((3 << 11) | 20) & 0xFu; }
#define XB_SPIN(cond, bar) do { unsigned _sp = 0; while (cond) { __builtin_amdgcn_s_sleep(4); \
    if ((++_sp & 255u) == 0u) { if (xb_ld(&(bar)[XB_TMO])) break; if (_sp > XB_SPIN_CAP) { atomicAdd(&(bar)[XB_TMO], 1u); break; } } } } while (0)
struct XcdBarrier { unsigned* bar; unsigned x; volatile LAS unsigned* st; };
__device__ __forceinline__ XcdBarrier xcd_barrier_post(unsigned* bar, volatile LAS unsigned* st) {
    XcdBarrier b; b.bar = bar; b.x = xb_xcc_id(); b.st = st;
    if (threadIdx.x == 0) (void)xb_add(&bar[XB_XCNT(b.x)], 1u);
    return b;
}
__device__ __forceinline__ void xcd_barrier_complete(unsigned* bar, unsigned x, unsigned& nloc, unsigned& nx) {
    const unsigned G = gridDim.x * gridDim.y * gridDim.z;
    unsigned sum, cnt, mine, sp = 0u;
    for (;;) {
        sum = 0u; cnt = 0u; mine = 0u;
#pragma unroll
        for (unsigned j = 0; j < 16; ++j) { const unsigned c = xb_ld(&bar[XB_XCNT(j)]); sum += c; cnt += (c > 0u) ? 1u : 0u; mine = (j == x) ? c : mine; }
        if (sum == G) break;
        __builtin_amdgcn_s_sleep(1);
        if ((++sp & 255u) == 0u) { if (xb_ld(&bar[XB_TMO])) break; if (sp > XB_SPIN_CAP) { atomicAdd(&bar[XB_TMO], 1u); break; } }
    }
    nloc = mine > 0u ? mine : 1u; nx = cnt > 0u ? cnt : 1u;
}
__device__ __forceinline__ void xcd_barrier(const XcdBarrier& b) {
    asm volatile("s_waitcnt vmcnt(0)" ::: "memory");
    __syncthreads();
    if (threadIdx.x == 0) {
        unsigned* bar = b.bar;
        __builtin_amdgcn_s_waitcnt(0);
        unsigned nloc = b.st[0], nx = b.st[1];
        if (nloc == 0u) { xcd_barrier_complete(bar, b.x, nloc, nx); b.st[0] = nloc; b.st[1] = nx; }
        const unsigned gen = b.st[2];
        const unsigned old = xb_add(&bar[XB_XSUB(b.x)], 1u);
        if (old + 1u == (gen + 1u) * nloc) {
            __builtin_amdgcn_fence(__ATOMIC_RELEASE, "agent");
            asm volatile("s_waitcnt vmcnt(0)" ::: "memory");
            const unsigned og = xb_add(&bar[XB_TOP], 1u);
            if (og + 1u == (gen + 1u) * nx) xb_add(&bar[XB_TOPGEN], 1u);
            else XB_SPIN(xb_ld(&bar[XB_TOPGEN]) == gen, bar);
        } else {
            XB_SPIN(xb_ld(&bar[XB_TOPGEN]) == gen, bar);
        }
        __builtin_amdgcn_fence(__ATOMIC_ACQUIRE, "agent");
        asm volatile("s_waitcnt vmcnt(0)" ::: "memory");
        b.st[2] = gen + 1u;
    }
    __syncthreads();
}

constexpr int NWAVES = 8, NT = NWAVES * 64;
constexpr int RING_BYTES = 131072, LDSCTL_OFF = RING_BYTES, MISC_OFF = LDSCTL_OFF + 320, LDS_BYTES = 147456;
constexpr int CW_BAR = 4096;

struct Args { const float* in[38]; float* out; unsigned char* ws; };
struct Frame {
    LAS unsigned char* lds; volatile LAS unsigned* MISC;
    int wave, vcu, G;
    const float* const* in; float* out; unsigned char* ws;
};
enum { I_XP = 0, I_XS, I_SRET, I_SHG, I_SWKV, I_SSHIFT, I_CP, I_CS, I_MODW, I_MODB, I_NMIXG, I_NMLPG, I_FINALG, I_W1, I_W2, I_ABWIN, I_ABWOUT, I_HGLB, I_HGNG,
       I_MU, I_WRKV, I_RW0, I_RW1, I_RW2, I_RA0, I_RA1, I_RA2, I_RV0, I_RV1, I_RV2, I_RG1, I_RG2, I_RKK, I_RKA, I_RRK, I_RLNG, I_RLNB, I_RWOUT };
constexpr size_t O_Y = 0, O_RETP = 17825792, O_RETS = 17891328, O_HGP = 19988480, O_HGS = 20119552, O_WKVP = 24313856, O_WKVS = 24444928, O_SHP = 28639232, O_SHS = 28641280;

__device__ __forceinline__ void transpose_item(const float* W, int N, bf16_t* WT, int ldt, int row_off, int col_off, const float* mu, int mode, LAS float* scr, int item, int lane) {
    const int nblk = N / 32, kb = item / nblk, nb = item % nblk, k0 = 64 * kb, n0 = 32 * nb;
#pragma unroll 8
    for (int i = 0; i < 32; ++i) { const int kk = 2 * i + (lane >> 5); float s = 1.f; if (mode == 1) s = 1.f - mu[k0 + kk]; else if (mode == 2) s = mu[k0 + kk];
        scr[kk * 33 + (lane & 31)] = W[(size_t)(k0 + kk) * N + n0 + (lane & 31)] * s; }
    LDS_WAIT(); asm volatile("" ::: "memory");
    const int c = lane & 7;
#pragma unroll
    for (int j = 0; j < 4; ++j) { const int n = (lane >> 3) + 8 * j; const LAS float* s = scr + (8 * c) * 33 + n;
        u32x4 o; o.x = pk2(s[0 * 33], s[1 * 33]); o.y = pk2(s[2 * 33], s[3 * 33]); o.z = pk2(s[4 * 33], s[5 * 33]); o.w = pk2(s[6 * 33], s[7 * 33]);
        *(u32x4*)(WT + (size_t)(row_off + n0 + n) * ldt + col_off + k0 + 8 * c) = o; }
    LDS_WAIT(); asm volatile("" ::: "memory");
}
__device__ __forceinline__ void convert_layer_weights(Frame& F, int layer) {
    const int tid = otid(); const int lane = tid & 63; (void)lane;
    LAS float* scr = (LAS float*)(F.lds + F.wave * 16384);
    const int gw = F.vcu * NWAVES + F.wave, NGW = F.G * NWAVES;
    unsigned char* ar = F.ws + WS_ARENA;
    const int m = layer >> 1;
    constexpr int I_1 = (D / 64) * (DFF / 32), I_2 = (DFF / 64) * (D / 32);
    const float* w1 = F.in[I_W1] + (size_t)layer * D * DFF; const float* w2 = F.in[I_W2] + (size_t)layer * DFF * D;
    if ((layer & 1) == 0) {
        constexpr int I_IN = (D / 64) * (ABIN / 32), I_OUT = (D / 64) * (D / 32), NI = I_1 + I_2 + I_IN + I_OUT;
        const float* win = F.in[I_ABWIN] + (size_t)m * D * ABIN; const float* wout = F.in[I_ABWOUT] + (size_t)m * D * D;
        for (int it = gw; it < NI; it += NGW) { int r = it;
            if (r < I_1) { transpose_item(w1, DFF, (bf16_t*)(ar + AR_W1), D, 0, 0, nullptr, 0, scr, r, lane); continue; } r -= I_1;
            if (r < I_2) { transpose_item(w2, D, (bf16_t*)(ar + AR_W2), DFF, 0, 0, nullptr, 0, scr, r, lane); continue; } r -= I_2;
            if (r < I_IN) { transpose_item(win, ABIN, (bf16_t*)(ar + AR_WIN), D, 0, 0, nullptr, 0, scr, r, lane); continue; } r -= I_IN;
            transpose_item(wout, D, (bf16_t*)(ar + AR_WOUT), D, 0, 0, nullptr, 0, scr, r, lane); }
    } else {
        constexpr int I_P = (D / 64) * (D / 32), NI = I_1 + I_2 + 4 * I_P;
        const float* mu = F.in[I_MU] + (size_t)m * 6 * D; const float* wrkv = F.in[I_WRKV] + (size_t)m * 3 * D * D; const float* wo = F.in[I_RWOUT] + (size_t)m * D * D;
        bf16_t* wc1 = (bf16_t*)(ar + AR_WC1);
        for (int it = gw; it < NI; it += NGW) { int r = it;
            if (r < I_1) { transpose_item(w1, DFF, (bf16_t*)(ar + AR_W1), D, 0, 0, nullptr, 0, scr, r, lane); continue; } r -= I_1;
            if (r < I_2) { transpose_item(w2, D, (bf16_t*)(ar + AR_W2), DFF, 0, 0, nullptr, 0, scr, r, lane); continue; } r -= I_2;
            if (r < 3 * I_P) { const int p = r / I_P;
                transpose_item(wrkv + (size_t)p * D * D, D, wc1, 2048, p * D, 0, nullptr, 0, scr, r % I_P, lane); continue; } r -= 3 * I_P;
            transpose_item(wo, D, (bf16_t*)(ar + AR_WO), D, 0, 0, nullptr, 0, scr, r, lane); }
        const int gt = F.vcu * NT + tid, NG = F.G * NT;
        const float* lw1 = F.in[I_RW1] + (size_t)m * D * 64; const float* la1 = F.in[I_RA1] + (size_t)m * D * 64; const float* lv1 = F.in[I_RV1]; const float* lg1 = F.in[I_RG1] + (size_t)m * D * 160;
        for (int idx = gt; idx < 512 * 2048; idx += NG) { const int n = idx >> 11, k = idx & 2047, kk = k & 1023, nn = n & 255;
            const float* src = nullptr; int ns = 0, mi = 0, nc = 0;
            if (n < 256) { if (nn < 64) { src = lw1; ns = 64; mi = 1; nc = nn; } else if (nn < 128) { src = la1; ns = 64; mi = 4; nc = nn - 64; } else if (nn < 160 && m == 1) { src = lv1; ns = 32; mi = 3; nc = nn - 128; } }
            else if (nn < 160) { src = lg1; ns = 160; mi = 5; nc = nn; }
            float v = 0.f; if (src) { const float muv = mu[mi * D + kk]; v = src[(size_t)kk * ns + nc] * (k < 1024 ? 1.f - muv : muv); }
            wc1[(size_t)(3072 + n) * 2048 + k] = (bf16_t)f2bf(v); }
        bf16_t* wc2 = (bf16_t*)(ar + AR_WC2);
        const float* lw2 = F.in[I_RW2] + (size_t)m * 64 * D; const float* la2 = F.in[I_RA2] + (size_t)m * 64 * D; const float* lv2 = F.in[I_RV2]; const float* lg2 = F.in[I_RG2] + (size_t)m * 160 * D;
        for (int idx = gt; idx < 4096 * 256; idx += NG) { const int k = idx >> 12, n = idx & 4095, g = n >> 10, nn = n & 1023;
            const float* src = (g == 0) ? lw2 : (g == 1) ? la2 : (g == 2) ? lv2 : lg2; const int ks = (g == 0 || g == 1) ? 64 : (g == 2 ? 32 : 160);
            float v = 0.f; if (k < ks && !(g == 2 && m == 0)) v = src[(size_t)k * D + nn];
            wc2[(size_t)n * 256 + k] = (bf16_t)f2bf(v); }
    }
}

__device__ __forceinline__ void mod_phase(Frame& F, int l_lo, int l_hi, int wb, int nb) {
    const int tid = otid(); const int lane = tid & 63;
    const float* __restrict__ SC = (const float*)(F.ws + WS_MOD + 3584 * 1024);
    float* MOD = (float*)(F.ws + WS_MOD);
    LAS float* red = (LAS float*)F.lds;
    for (int task = l_lo * 96 + wb; task < l_hi * 96; task += nb) { const int l = task / 96, n = (task % 96) * 64 + lane, ks = F.wave;
        const float* w = F.in[I_MODW] + ((size_t)l * D + ks * 128) * 6144 + n;
        float acc[NSEQ];
#pragma unroll
        for (int s = 0; s < NSEQ; ++s) acc[s] = 0.f;
        for (int k = 0; k < 128; k += 4) { const float w0 = w[(size_t)k * 6144], w1 = w[(size_t)(k + 1) * 6144], w2 = w[(size_t)(k + 2) * 6144], w3 = w[(size_t)(k + 3) * 6144];
#pragma unroll
            for (int s = 0; s < NSEQ; ++s) { const f32x4 c4 = *(const f32x4*)(SC + s * D + ks * 128 + k); acc[s] += (c4[0] * w0 + c4[1] * w1) + (c4[2] * w2 + c4[3] * w3); } }
        __syncthreads();
#pragma unroll
        for (int s = 0; s < NSEQ; ++s) red[(F.wave * NSEQ + s) * 64 + lane] = acc[s];
        __syncthreads();
        for (int i = tid; i < NSEQ * 64; i += NT) { const int s = i >> 6, c = i & 63; float t = F.in[I_MODB][l * 6144 + (task % 96) * 64 + c];
#pragma unroll
            for (int q = 0; q < 8; ++q) t += red[(q * NSEQ + s) * 64 + c];
            MOD[((size_t)l * NSEQ + s) * 6144 + (task % 96) * 64 + c] = t; }
    }
    __syncthreads();
}

__device__ __forceinline__ void prologue(Frame& F) {
    const int tid = otid(); const int lane = tid & 63; (void)lane;
    const int gt = F.vcu * NT + tid, NG = F.G * NT;
    { f32x2* tab = (f32x2*)(F.ws + WS_ROPE);
      for (int i = gt; i < 16384 * 32; i += NG) { const int p = i >> 5, d = i & 31; double rev = (double)p * ROPE_REV[d]; rev -= floor(rev); const float fr = (float)rev;
          tab[i] = (f32x2){__builtin_amdgcn_cosf(fr), __builtin_amdgcn_sinf(fr)}; } }
    { unsigned* z = (unsigned*)(F.ws + WS_XN0); for (int i = gt; i < 512; i += NG) z[i] = 0u; }
    { float* SC = (float*)(F.ws + WS_MOD + 3584 * 1024);
      for (int i = gt; i < NSEQ * D; i += NG) { const int s = i >> 10, k = i & 1023; const float c = (s == 0) ? F.in[I_CP][k] : F.in[I_CS][(size_t)(s - 1) * D + k]; SC[i] = siluf_(c); } }
    convert_layer_weights(F, 0);
}

template <int MODE> __device__ __forceinline__ void norm_row(Frame& F, int layer, int r, f32x4 (&v)[4], const float* MOD, const float* gvec, int lane, f32x4 (&ho)[4]) {
    const int m = layer >> 1; const int shoff = (MODE == 2) ? 3072 : 0, scoff = (MODE == 2) ? 4096 : 1024;
    bf16_t* XN = (bf16_t*)(F.ws + WS_XN); bf16_t* PREVS = (bf16_t*)(F.ws + WS_PREVS);
    float* xrow = F.out + (size_t)r * D; float s2 = 0.f;
#pragma unroll
    for (int j = 0; j < 4; ++j) s2 += (v[j].x * v[j].x + v[j].y * v[j].y) + (v[j].z * v[j].z + v[j].w * v[j].w);
    const float rstd = 1.f / sqrtf(wave_sum(s2) * (1.f / D) + NORM_EPS);
    const int seq = seq_of_row(r); const float* mp = MOD + (size_t)seq * 6144;
#pragma unroll
    for (int j = 0; j < 4; ++j) { const int c = 4 * lane + 256 * j; const f32x4 g4 = *(const f32x4*)(gvec + c); f32x4 o = v[j] * rstd * g4;
        if (MODE == 3) { *((f32x4*)xrow + lane + 64 * j) = o; continue; }
        const f32x4 sc = *(const f32x4*)(mp + scoff + c), sh = *(const f32x4*)(mp + shoff + c);
        o = o * (1.f + sc) + sh; ho[j] = o;
        const unsigned long long pk = (unsigned long long)pk2(o.x, o.y) | ((unsigned long long)pk2(o.z, o.w) << 32);
        *(unsigned long long*)(XN + (size_t)r * D + c) = pk;
        if (MODE == 1) {
            if (r >= MP) { const int t = (r - MP) & 31; if (t < 31) *(unsigned long long*)(PREVS + (size_t)(r - MP + 1) * D + c) = pk;
                else *(f32x4*)(F.out + O_SHS + ((size_t)m * 32 + ((r - MP) >> 5)) * D + c) = o;
                if (t == 0) { const f32x4 ss = *(const f32x4*)(F.in[I_SSHIFT] + ((size_t)m * 32 + ((r - MP) >> 5)) * D + c);
                    *(unsigned long long*)(PREVS + (size_t)(r - MP) * D + c) = (unsigned long long)pk2(ss.x, ss.y) | ((unsigned long long)pk2(ss.z, ss.w) << 32); } }
            else if (r == MP - 1) *(f32x4*)(F.out + O_SHP + (size_t)m * D + c) = o;
        } }
}
__device__ __forceinline__ void hmix_calc(const float* mp, const float* gvec, const f32x4 (&v)[4], int lane, f32x4 (&h)[4]) {
    float s2 = 0.f;
#pragma unroll
    for (int j = 0; j < 4; ++j) s2 += (v[j].x * v[j].x + v[j].y * v[j].y) + (v[j].z * v[j].z + v[j].w * v[j].w);
    const float rstd = 1.f / sqrtf(wave_sum(s2) * (1.f / D) + NORM_EPS);
#pragma unroll
    for (int j = 0; j < 4; ++j) { const int c = 4 * lane + 256 * j; const f32x4 g4 = *(const f32x4*)(gvec + c), sc = *(const f32x4*)(mp + 1024 + c), sh = *(const f32x4*)(mp + c); h[j] = v[j] * rstd * g4 * (1.f + sc) + sh; }
}
__device__ __forceinline__ void write_mixes(Frame& F, int m, int r, const f32x4 (&h)[4], const f32x4 (&p)[4], int lane) {
    bf16_t* XM = (bf16_t*)(F.ws + WS_XMIX); const float* mu = F.in[I_MU] + (size_t)m * 6 * D;
#pragma unroll
    for (int j = 0; j < 4; ++j) { const int c = 4 * lane + 256 * j; const f32x4 d = p[j] - h[j];
#pragma unroll
        for (int q = 0; q < 3; ++q) { const f32x4 mv = *(const f32x4*)(mu + (q == 0 ? 0 : (q == 1 ? 2 : 3)) * D + c); const f32x4 x = h[j] + d * mv;
            *(unsigned long long*)(XM + ((size_t)q * M + r) * D + c) = (unsigned long long)pk2(x.x, x.y) | ((unsigned long long)pk2(x.z, x.w) << 32); } }
}
template <int MODE, int PEND = 0, bool FIRSTP = false> __device__ __forceinline__ void norm_pass(Frame& F, int layer, int player, int pgoff, const float* sx_in, float* sx_out) {
    const int tid = otid(); const int lane = tid & 63;
    const int gw = F.vcu * NWAVES + F.wave, NGW = F.G * NWAVES;
    const float* MOD = (const float*)(F.ws + WS_MOD) + (size_t)layer * NSEQ * 6144;
    const float* gvec = (MODE == 3) ? F.in[I_FINALG] : (MODE == 2 ? F.in[I_NMLPG] + layer * D : F.in[I_NMIXG] + layer * D);
    constexpr int HALO = (MODE == 1) ? 1 : 0;
    LAS float* xs = (LAS float*)F.lds;
    const int m = layer >> 1; const int r0s = MP + 4 * F.vcu;
    const float* gmod = (const float*)(F.ws + WS_MOD) + (size_t)player * NSEQ * 6144 + pgoff;
    if constexpr (PEND > 0) {
        __syncthreads();
#pragma unroll
        for (int q = 0; q < (4 + HALO + 1) / 2; ++q) { const int idx = tid + q * NT, rr = idx >> 8, c4 = (idx & 255) * 4; const int r = r0s - HALO + rr;
            if (rr < 4 + HALO && !(HALO && rr == 0 && ((r0s - MP) & 31) == 0)) {
                const int pn = c4 >> 8; const float* pb = (const float*)(F.ws + WS_PART) + ((size_t)((((r >> 8) - 64) * 4 + pn) * PEND) << 16) + (r & 255) * 256 + (c4 & 255);
                f32x4 acc = (f32x4){0.f, 0.f, 0.f, 0.f};
#pragma unroll
                for (int ks = 0; ks < PEND; ++ks) acc += *(const f32x4*)(pb + ((size_t)ks << 16));
                const f32x4 g4 = *(const f32x4*)(gmod + (size_t)seq_of_row(r) * 6144 + c4); f32x4 x4 = *(const f32x4*)(sx_in + (size_t)(r - MP) * D + c4);
                x4 = x4 + g4 * acc; if (sx_out != nullptr && !(HALO && rr == 0)) *(f32x4*)(sx_out + (size_t)(r - MP) * D + c4) = x4; *(LAS f32x4*)(xs + rr * 1024 + c4) = x4; } }
        __syncthreads();
    }
    for (int r = gw; r < MP; r += NGW) {
        const f32x4* xr = (const f32x4*)((FIRSTP ? F.in[I_XP] : F.out) + (size_t)r * D) + lane; f32x4 v[4], ho[4];
#pragma unroll
        for (int j = 0; j < 4; ++j) v[j] = xr[64 * j];
        if constexpr (MODE == 1) { f32x4 pv[4], hp[4];
#pragma unroll
            for (int j = 0; j < 4; ++j) pv[j] = (r > 0) ? *((const f32x4*)(F.out + (size_t)(r - 1) * D) + lane + 64 * j) : (f32x4){0.f, 0.f, 0.f, 0.f};
            norm_row<MODE>(F, layer, r, v, MOD, gvec, lane, ho);
            if (r > 0) hmix_calc(MOD, gvec, pv, lane, hp); else {
#pragma unroll
                for (int j = 0; j < 4; ++j) hp[j] = (f32x4){0.f, 0.f, 0.f, 0.f}; }
            write_mixes(F, m, r, ho, hp, lane);
        } else norm_row<MODE>(F, layer, r, v, MOD, gvec, lane, ho);
    }
    if (F.wave < 4 && 4 * F.vcu + F.wave < MS) { const int r = r0s + F.wave; f32x4 v[4], ho[4];
#pragma unroll
        for (int j = 0; j < 4; ++j) { if constexpr (PEND > 0) v[j] = *(const LAS f32x4*)(xs + (F.wave + HALO) * 1024 + 4 * lane + 256 * j); else v[j] = *((const f32x4*)(sx_in + (size_t)(r - MP) * D) + lane + 64 * j); }
        norm_row<MODE>(F, layer, r, v, MOD, gvec, lane, ho);
        if constexpr (MODE == 1) { f32x4 hp[4]; const int t = (r - MP) & 31, sq = (r - MP) >> 5;
            if (t == 0) {
#pragma unroll
                for (int j = 0; j < 4; ++j) hp[j] = *((const f32x4*)(F.in[I_SSHIFT] + ((size_t)m * 32 + sq) * D) + lane + 64 * j);
            } else { f32x4 pv[4];
#pragma unroll
                for (int j = 0; j < 4; ++j) pv[j] = *(const LAS f32x4*)(xs + (F.wave + HALO - 1) * 1024 + 4 * lane + 256 * j);
                hmix_calc(MOD + (size_t)(1 + sq) * 6144, gvec, pv, lane, hp); }
            write_mixes(F, m, r, ho, hp, lane); } }
}

template <int MT, int NTT> __device__ __forceinline__ void wave_mm_nt(f32x4 (&acc)[MT][NTT], const LAS bf16_t* X, int ldx, const LAS bf16_t* Y, int ldy, int K, int fr, int fq) {
    for (int k0 = 0; k0 < K; k0 += 32) {
        bf16x8 xa[MT], yb[NTT];
#pragma unroll
        for (int i = 0; i < MT; ++i) xa[i] = *(const LAS bf16x8*)(X + (16 * i + fr) * ldx + k0 + 8 * fq);
#pragma unroll
        for (int j = 0; j < NTT; ++j) yb[j] = *(const LAS bf16x8*)(Y + (16 * j + fr) * ldy + k0 + 8 * fq);
#pragma unroll
        for (int i = 0; i < MT; ++i)
#pragma unroll
            for (int j = 0; j < NTT; ++j) acc[i][j] = __builtin_amdgcn_mfma_f32_16x16x32_bf16(yb[j], xa[i], acc[i][j], 0, 0, 0);
    }
}

constexpr int LQS = 0, LKS = 18432, LQG = 36864, LVT = 55296, LST = 73728, LPS = 108544, LRED = 117760, LBS = 118784;
__device__ __forceinline__ void chunk_geom(int c, int& r0, int& pos0) { if (c < 256) { r0 = 64 * c; pos0 = 64 * c; } else { r0 = MP + 32 * (c - 256); pos0 = 2048; } }

template <int L, bool HG, bool SUMMARY> __device__ __forceinline__ void ab_load(Frame& F, int layer, int c, int h) {
    const int tid = otid(); const int lane = tid & 63; (void)lane;
    const int m = layer >> 1; int r0, pos0; chunk_geom(c, r0, pos0);
    const bf16_t* Z = (const bf16_t*)(F.ws + WS_Z);
    LAS bf16_t* QS = (LAS bf16_t*)(F.lds + LQS); LAS bf16_t* KS = (LAS bf16_t*)(F.lds + LKS); LAS bf16_t* QG = (LAS bf16_t*)(F.lds + LQG); LAS bf16_t* VT = (LAS bf16_t*)(F.lds + LVT);
    constexpr int LDT = L + 8;
    if constexpr (HG) {
        constexpr int TQ = L / 4; LAS float* BS = (LAS float*)(F.lds + LBS);
        const int ch = tid & 127, qtr = tid >> 7;
        float lb = 0.f;
        if (m == 1) { const float a0 = F.in[I_HGLB][h * 128 + ch], a1 = F.in[I_HGLB][512 + h * 128 + ch]; lb = 1.f / (1.f + __expf(a0 - a1)); }
        { constexpr int NP = L * 16;
#pragma unroll
          for (int q = 0; q < (NP + NT - 1) / NT; ++q) { const int v = tid + q * NT; if (NP % NT == 0 || v < NP) { const int j = v >> 4, c8 = v & 15; const size_t zr = (size_t)(r0 + j) * ABIN + h * 128 + c8 * 8;
                  const u32x4 zf4 = *(const u32x4*)(Z + zr + 2048), v4 = *(const u32x4*)(Z + zr + 2560);
                  *(LAS u32x4*)(QG + j * 136 + c8 * 8) = zf4; *(LAS u32x4*)(KS + j * 136 + c8 * 8) = v4;
                  if constexpr (!SUMMARY) { const u32x4 q4 = *(const u32x4*)(Z + zr + 1536); *(LAS u32x4*)(QS + j * 136 + c8 * 8) = q4; } } } }
        __syncthreads();
        float zf[TQ], cs[TQ]; float run = 0.f;
#pragma unroll
        for (int jj = 0; jj < TQ; ++jj) { const int j = qtr * TQ + jj; zf[jj] = bf2f(QG[j * 136 + ch]);
            float lf; if (lb == 0.f) lf = fminf(zf[jj], 0.f) - __logf(1.f + __expf(-fabsf(zf[jj]))); else lf = __logf(lb + (1.f - lb) * sigmoidf_(zf[jj]));
            run += lf; cs[jj] = run; }
        BS[qtr * 128 + ch] = run;
        __syncthreads();
        const float b0 = BS[ch], b1 = BS[128 + ch], b2 = BS[256 + ch], b3 = BS[384 + ch];
        const float off = (qtr > 0 ? b0 : 0.f) + (qtr > 1 ? b1 : 0.f) + (qtr > 2 ? b2 : 0.f), bL = (b0 + b1) + (b2 + b3), bmid = b0 + b1;
        if constexpr (SUMMARY) {
#pragma unroll
            for (int j8 = 0; j8 < TQ; j8 += 8) { unsigned vv[8]; float kd[8];
#pragma unroll
                for (int q = 0; q < 8; ++q) { const int jj = j8 + q, j = qtr * TQ + jj; const float b = off + cs[jj]; const float kb = (1.f - lb) * sigmoidf_(-zf[jj]); vv[q] = KS[j * 136 + ch]; kd[q] = kb * __expf(bL - b); }
                u32x4 pv, pk; pv.x = vv[0] | (vv[1] << 16); pv.y = vv[2] | (vv[3] << 16); pv.z = vv[4] | (vv[5] << 16); pv.w = vv[6] | (vv[7] << 16);
                pk.x = pk2(kd[0], kd[1]); pk.y = pk2(kd[2], kd[3]); pk.z = pk2(kd[4], kd[5]); pk.w = pk2(kd[6], kd[7]);
                *(LAS u32x4*)(VT + ch * LDT + qtr * TQ + j8) = pv; *(LAS u32x4*)(QS + ch * LDT + qtr * TQ + j8) = pk; }
            if (qtr == 0) ((float*)(F.ws + WS_DEC))[((size_t)c * 4 + h) * 128 + ch] = __expf(bL);
        } else {
#pragma unroll
            for (int j8 = 0; j8 < TQ; j8 += 8) { unsigned vv[8];
#pragma unroll
                for (int q8 = 0; q8 < 8; ++q8) { const int jj = j8 + q8, j = qtr * TQ + jj; const float b = off + cs[jj]; const float kb = (1.f - lb) * sigmoidf_(-zf[jj]);
                    const float q = siluf_(bf2f(QS[j * 136 + ch])); vv[q8] = KS[j * 136 + ch];
                    QS[j * 136 + ch] = (bf16_t)f2bf(q * __expf(b - bmid)); KS[j * 136 + ch] = (bf16_t)f2bf(kb * __expf(bmid - b)); QG[j * 136 + ch] = (bf16_t)f2bf(q * __expf(b)); }
                u32x4 pv; pv.x = vv[0] | (vv[1] << 16); pv.y = vv[2] | (vv[3] << 16); pv.z = vv[4] | (vv[5] << 16); pv.w = vv[6] | (vv[7] << 16);
                *(LAS u32x4*)(VT + ch * LDT + qtr * TQ + j8) = pv; }
        }
    } else {
        const float logg = log1pf(-exp2f(-5.f - (float)h));
        const f32x2* rope = (const f32x2*)(F.ws + WS_ROPE);
        for (int it = tid; it < L * 4; it += NT) { const int j = it >> 2, d8 = it & 3; const size_t zr = (size_t)(r0 + j) * ABIN;
            const f32x2* rp = rope + (size_t)(pos0 + j) * 32 + d8 * 8;
            const u32x4 k1 = *(const u32x4*)(Z + zr + 256 + h * 64 + d8 * 8), k2 = *(const u32x4*)(Z + zr + 256 + h * 64 + 32 + d8 * 8);
            const float gk = __expf((float)(L - 1 - j) * logg), gq = __expf((float)(j + 1) * logg);
            u32x4 q1 = (u32x4){0, 0, 0, 0}, q2 = q1; if constexpr (!SUMMARY) { q1 = *(const u32x4*)(Z + zr + h * 64 + d8 * 8); q2 = *(const u32x4*)(Z + zr + h * 64 + 32 + d8 * 8); }
#pragma unroll
            for (int e = 0; e < 8; ++e) { const f32x2 cs_ = rp[e]; const unsigned wk1 = k1[e >> 1], wk2 = k2[e >> 1]; const float x1 = (e & 1) ? bfhi(wk1) : bflo(wk1), x2 = (e & 1) ? bfhi(wk2) : bflo(wk2);
                const float o1 = x1 * cs_.x - x2 * cs_.y, o2 = x1 * cs_.y + x2 * cs_.x; const int d = d8 * 8 + e;
                if constexpr (SUMMARY) { QS[d * LDT + j] = (bf16_t)f2bf(o1 * gk); QS[(d + 32) * LDT + j] = (bf16_t)f2bf(o2 * gk); }
                else { KS[j * 72 + d] = (bf16_t)f2bf(o1); KS[j * 72 + d + 32] = (bf16_t)f2bf(o2);
                    const unsigned wq1 = q1[e >> 1], wq2 = q2[e >> 1]; const float y1 = (e & 1) ? bfhi(wq1) : bflo(wq1), y2 = (e & 1) ? bfhi(wq2) : bflo(wq2);
                    const float p1 = (y1 * cs_.x - y2 * cs_.y) * 0.125f, p2 = (y1 * cs_.y + y2 * cs_.x) * 0.125f;
                    QS[j * 72 + d] = (bf16_t)f2bf(p1); QS[j * 72 + d + 32] = (bf16_t)f2bf(p2); QG[j * 72 + d] = (bf16_t)f2bf(p1 * gq); QG[j * 72 + d + 32] = (bf16_t)f2bf(p2 * gq); } } }
        for (int it = tid; it < L * 16; it += NT) { const int j = it >> 4, e8 = it & 15; const u32x4 vv = *(const u32x4*)(Z + (size_t)(r0 + j) * ABIN + 512 + h * 128 + e8 * 8);
#pragma unroll
            for (int e = 0; e < 8; ++e) { const unsigned w = vv[e >> 1]; VT[(e8 * 8 + e) * LDT + j] = (bf16_t)((e & 1) ? (w >> 16) : (w & 0xffffu)); } }
    }
}

template <int L, bool HG> __device__ __forceinline__ void ab_summary_unit(Frame& F, int layer, int c, int h) {
    const int tid = otid(); const int lane = tid & 63; (void)lane;
    constexpr int DK = HG ? 128 : 64, NCT = DK / 16, LDT = L + 8;
    __syncthreads();
    ab_load<L, HG, true>(F, layer, c, h);
    __syncthreads();
    const int fr = lane & 15, fq = lane >> 4;
    const LAS bf16_t* KDT = (const LAS bf16_t*)(F.lds + LQS); const LAS bf16_t* VT = (const LAS bf16_t*)(F.lds + LVT);
    f32x4 acc[1][NCT];
#pragma unroll
    for (int j = 0; j < NCT; ++j) acc[0][j] = (f32x4){0.f, 0.f, 0.f, 0.f};
    wave_mm_nt<1, NCT>(acc, VT + F.wave * 16 * LDT, LDT, KDT, LDT, L, fr, fq);
    bf16_t* ST = (bf16_t*)(F.ws + WS_STATE) + (size_t)c * SLOT_E + (HG ? 32768 + h * 16384 : h * 8192);
    const int e = F.wave * 16 + fr;
#pragma unroll
    for (int j = 0; j < NCT; ++j) { u32x2 w; w.x = pk2(acc[0][j][0], acc[0][j][1]); w.y = pk2(acc[0][j][2], acc[0][j][3]); *(u32x2*)(ST + (size_t)e * DK + 16 * j + 4 * fq) = w; }
}

template <int L, bool HG> __device__ __forceinline__ void ab_output_unit(Frame& F, int layer, int c, int h) {
    const int tid = otid(); const int lane = tid & 63; (void)lane;
    constexpr int DK = HG ? 128 : 64, LDQ = HG ? 136 : 72, LDT = L + 8, NIT = L / 16, WPI = 8 / NIT, ET = 8 / WPI, TPW = (NIT * NIT >= 8) ? NIT * NIT / 8 : 1;
    const int m = layer >> 1; int r0, pos0; chunk_geom(c, r0, pos0);
    __syncthreads();
    ab_load<L, HG, false>(F, layer, c, h);
    LAS bf16_t* QS = (LAS bf16_t*)(F.lds + LQS); LAS bf16_t* KS = (LAS bf16_t*)(F.lds + LKS); LAS bf16_t* QG = (LAS bf16_t*)(F.lds + LQG); LAS bf16_t* VT = (LAS bf16_t*)(F.lds + LVT);
    LAS bf16_t* STl = (LAS bf16_t*)(F.lds + LST); LAS bf16_t* PS = (LAS bf16_t*)(F.lds + LPS); LAS float* RED = (LAS float*)(F.lds + LRED);
    { const bf16_t* ST = (const bf16_t*)(F.ws + WS_STATE) + (size_t)c * SLOT_E + (HG ? 32768 + h * 16384 : h * 8192);
      for (int it = tid; it < 128 * DK / 8; it += NT) { const int e = it / (DK / 8), c8 = it % (DK / 8); *(LAS u32x4*)(STl + e * LDQ + c8 * 8) = *(const u32x4*)(ST + (size_t)e * DK + c8 * 8); } }
    __syncthreads();
    const int fr = lane & 15, fq = lane >> 4, w = F.wave;
    const float logg = HG ? 0.f : log1pf(-exp2f(-5.f - (float)h));
    if (w * TPW < NIT * NIT) {
        const int it = (w * TPW) / NIT, jt0 = (w * TPW) % NIT;
        f32x4 sc[1][TPW];
#pragma unroll
        for (int q = 0; q < TPW; ++q) sc[0][q] = (f32x4){0.f, 0.f, 0.f, 0.f};
        wave_mm_nt<1, TPW>(sc, QS + it * 16 * LDQ, LDQ, KS + jt0 * 16 * LDQ, LDQ, DK, fr, fq);
        const int i = it * 16 + fr;
#pragma unroll
        for (int q = 0; q < TPW; ++q) { float p[4];
#pragma unroll
            for (int r = 0; r < 4; ++r) { const int j = (jt0 + q) * 16 + 4 * fq + r; float v = sc[0][q][r]; if (!HG) v *= __expf((float)(i - j) * logg); p[r] = (j <= i) ? v : 0.f; }
            u32x2 pw; pw.x = pk2(p[0], p[1]); pw.y = pk2(p[2], p[3]); *(LAS u32x2*)(PS + i * LDT + (jt0 + q) * 16 + 4 * fq) = pw; }
    }
    __syncthreads();
    const int it = w % NIT, eg = w / NIT;
    f32x4 o[1][ET];
#pragma unroll
    for (int q = 0; q < ET; ++q) o[0][q] = (f32x4){0.f, 0.f, 0.f, 0.f};
    wave_mm_nt<1, ET>(o, PS + it * 16 * LDT, LDT, VT + eg * ET * 16 * LDT, LDT, L, fr, fq);
    wave_mm_nt<1, ET>(o, QG + it * 16 * LDQ, LDQ, STl + eg * ET * 16 * LDQ, LDQ, DK, fr, fq);
    float ss = 0.f;
#pragma unroll
    for (int q = 0; q < ET; ++q) ss += (o[0][q][0] * o[0][q][0] + o[0][q][1] * o[0][q][1]) + (o[0][q][2] * o[0][q][2] + o[0][q][3] * o[0][q][3]);
    ss += __shfl_xor(ss, 16); ss += __shfl_xor(ss, 32);
    const int i = it * 16 + fr;
    if (fq == 0) RED[i * 4 + eg] = ss;
    __syncthreads();
    float tot = 0.f;
#pragma unroll
    for (int q = 0; q < WPI; ++q) tot += RED[i * 4 + q];
    const float rstd = 1.f / sqrtf(tot * (1.f / 128.f) + NORM_EPS);
    const bf16_t* Z = (const bf16_t*)(F.ws + WS_Z); bf16_t* O = (bf16_t*)(F.ws + WS_XN);
    const size_t row = (size_t)(r0 + i);
#pragma unroll
    for (int q = 0; q < ET; ++q) { const int e = (eg * ET + q) * 16 + 4 * fq; const u32x2 gw = *(const u32x2*)(Z + row * ABIN + (HG ? 3072 : 1024) + h * 128 + e);
        const float g4[4] = {bflo(gw.x), bfhi(gw.x), bflo(gw.y), bfhi(gw.y)}; float ov[4];
#pragma unroll
        for (int r = 0; r < 4; ++r) { if (HG) ov[r] = o[0][q][r] * rstd * F.in[I_HGNG][m * 128 + e + r] * sigmoidf_(g4[r]); else ov[r] = o[0][q][r] * rstd * siluf_(g4[r]); }
        u32x2 ow; ow.x = pk2(ov[0], ov[1]); ow.y = pk2(ov[2], ov[3]); *(u32x2*)(O + row * D + (HG ? 512 : 0) + h * 128 + e) = ow; }
}

template <bool DRY = false> __device__ __forceinline__ void ab_scan(Frame& F, int layer) {
    const int tid = otid(); const int lane = tid & 63; (void)lane;
    const int m = layer >> 1;
    unsigned* ST32 = (unsigned*)(F.ws + WS_STATE); const float* DEC = (const float*)(F.ws + WS_DEC);
    constexpr int NP = SLOT_E / 2;
    const int gt = F.vcu * NT + tid;
    if (gt < NP) {
        const int eo = 2 * gt; const bool hg = eo >= 32768; const int eo2 = hg ? eo - 32768 : eo; const int head = hg ? eo2 >> 14 : eo2 >> 13; const int cch = hg ? (eo2 & 127) : (eo2 & 63); const int e = hg ? ((eo2 & 16383) >> 7) : ((eo2 & 8191) >> 6);
        const float gdec = hg ? 0.f : __expf(64.f * log1pf(-exp2f(-5.f - (float)head)));
        float s0 = 0.f, s1 = 0.f;
        for (int c0 = 0; c0 < 256; c0 += 32) {
            unsigned kv[32]; float d0[32], d1[32];
#pragma unroll
            for (int u = 0; u < 32; ++u) { kv[u] = ST32[(size_t)(c0 + u) * NP + gt]; if (hg) { const f32x2 dd = *(const f32x2*)(DEC + ((size_t)(c0 + u) * 4 + head) * 128 + cch); d0[u] = dd.x; d1[u] = dd.y; } else { d0[u] = gdec; d1[u] = gdec; } }
#pragma unroll
            for (int u = 0; u < 32; ++u) { const unsigned pw = pk2(s0, s1); if constexpr (DRY) asm volatile("" :: "v"(pw)); else ST32[(size_t)(c0 + u) * NP + gt] = pw; s0 = d0[u] * s0 + bflo(kv[u]); s1 = d1[u] * s1 + bfhi(kv[u]); }
        }
        float* outp = hg ? F.out + O_HGP + (size_t)m * 65536 + head * 16384 : F.out + O_RETP + (size_t)m * 32768 + head * 8192;
        outp[(size_t)cch * 128 + e] = s0; outp[(size_t)(cch + 1) * 128 + e] = s1;
    } else {
        const int NG2 = F.G * NT - NP; if (NG2 <= 0) return;
        for (int idx = gt - NP; idx < 32 * NP; idx += NG2) { const int b = idx / NP, pr = idx % NP;
            const int eo = 2 * pr; const bool hg = eo >= 32768; const int eo2 = hg ? eo - 32768 : eo; const int head = hg ? eo2 >> 14 : eo2 >> 13; const int cch = hg ? (eo2 & 127) : (eo2 & 63); const int e = hg ? ((eo2 & 16383) >> 7) : ((eo2 & 8191) >> 6);
            float d0, d1; if (hg) { const f32x2 dd = *(const f32x2*)(DEC + ((size_t)(256 + b) * 4 + head) * 128 + cch); d0 = dd.x; d1 = dd.y; } else { d0 = d1 = __expf(32.f * log1pf(-exp2f(-5.f - (float)head))); }
            const size_t so = hg ? ((size_t)(m * 32 + b) * 4 + head) * 16384 : ((size_t)(m * 32 + b) * 4 + head) * 8192;
            const float* sin_ = (hg ? F.in[I_SHG] : F.in[I_SRET]) + so; float* sout = F.out + (hg ? O_HGS : O_RETS) + so;
            const float i0 = sin_[(size_t)cch * 128 + e], i1 = sin_[(size_t)(cch + 1) * 128 + e];
            const unsigned kv = ST32[(size_t)(256 + b) * NP + pr]; if constexpr (!DRY) ST32[(size_t)(256 + b) * NP + pr] = pk2(i0, i1);
            sout[(size_t)cch * 128 + e] = d0 * i0 + bflo(kv); sout[(size_t)(cch + 1) * 128 + e] = d1 * i1 + bfhi(kv); }
    }
}

constexpr int RL_AT = 0, RL_RT = 9216, RL_BT = 18432, RL_KT = 27648, RL_BHT = 36864, RL_KHT = 46080, RL_VT = 55296, RL_AAB = 64512, RL_AAK = 81920, RL_ARB = 91136, RL_ARK = 100352,
              RL_U0T = 109568, RL_VEC = 118784, RL_PSUM = 119808;
constexpr int RL_G = RL_AAB, RL_WW = RL_BT, RL_APT = RL_AAK;
constexpr int RL_PL = RL_AT, RL_RL = RL_BT, RL_Y0L = RL_BT + 4608, RL_QTL = RL_AAB, RL_S = RL_BHT;
__device__ __forceinline__ int pperm(int k) { return 32 * (k >> 5) + 8 * ((k >> 2) & 3) + 4 * ((k >> 4) & 1) + (k & 3); }

struct OutSide { u32x2 vv[4], gg[4]; f32x4 lg[4], lb[4]; float bon; };
__device__ __forceinline__ void rwkv_out_side(Frame& F, int m, size_t row, int h, int fq, OutSide& o) {
    const bf16_t* RKV = (const bf16_t*)(F.ws + WS_RKV); const bf16_t* GG = (const bf16_t*)(F.ws + WS_G); const float* BON = (const float*)(F.ws + WS_BON);
    o.bon = BON[row * 16 + h];
#pragma unroll
    for (int nt = 0; nt < 4; ++nt) { const int i = h * 64 + 16 * nt + 4 * fq;
        o.lg[nt] = *(const f32x4*)(F.in[I_RLNG] + m * D + i); o.lb[nt] = *(const f32x4*)(F.in[I_RLNB] + m * D + i);
        o.vv[nt] = *(const u32x2*)(RKV + row * 3072 + 2048 + i); o.gg[nt] = *(const u32x2*)(GG + row * D + i); }
}
template <bool DRY = false> __device__ __forceinline__ void rwkv_out_core(Frame& F, const f32x4 (&y)[4], size_t row, int h, int fq, const OutSide& sd) {
    bf16_t* RKV = (bf16_t*)(F.ws + WS_RKV);
    float s1 = 0.f;
#pragma unroll
    for (int nt = 0; nt < 4; ++nt) s1 += (y[nt][0] + y[nt][1]) + (y[nt][2] + y[nt][3]);
    s1 += __shfl_xor(s1, 16); s1 += __shfl_xor(s1, 32);
    const float mean = s1 * (1.f / 64.f); float s2 = 0.f;
#pragma unroll
    for (int nt = 0; nt < 4; ++nt)
#pragma unroll
        for (int r = 0; r < 4; ++r) { const float d = y[nt][r] - mean; s2 += d * d; }
    s2 += __shfl_xor(s2, 16); s2 += __shfl_xor(s2, 32);
    const float rstd = 1.f / sqrtf(s2 * (1.f / 64.f) + RW_LN_EPS), bon = sd.bon;
#pragma unroll
    for (int nt = 0; nt < 4; ++nt) { const int i = h * 64 + 16 * nt + 4 * fq; const f32x4 lg = sd.lg[nt], lb = sd.lb[nt]; const u32x2 vv = sd.vv[nt], gg = sd.gg[nt];
        const float v4[4] = {bflo(vv.x), bfhi(vv.x), bflo(vv.y), bfhi(vv.y)}, g4[4] = {bflo(gg.x), bfhi(gg.x), bflo(gg.y), bfhi(gg.y)}; float o[4];
#pragma unroll
        for (int r = 0; r < 4; ++r) o[r] = ((y[nt][r] - mean) * rstd * lg[r] + lb[r] + bon * v4[r]) * g4[r];
        u32x2 w; w.x = pk2(o[0], o[1]); w.y = pk2(o[2], o[3]); if constexpr (DRY) asm volatile("" :: "v"(w.x), "v"(w.y)); else *(u32x2*)(RKV + row * 3072 + i) = w; }
}
template <bool DRY = false> __device__ __forceinline__ void rwkv_out_epilogue(Frame& F, int m, const f32x4 (&y)[4], size_t row, int h, int fq) {
    OutSide sd; rwkv_out_side(F, m, row, h, fq, sd); rwkv_out_core<DRY>(F, y, row, h, fq, sd);
}

template <int S, int L> struct SubstQ {
    static constexpr int RQ = L / 4, NV4 = RQ / 4;
    static __device__ __forceinline__ void run(float (&x)[RQ], f32x4 (&aq)[3][NV4], const LAS float* ap) {
        if constexpr (S < L - 1) {
            if constexpr (S + 2 < L - 1) {
#pragma unroll
                for (int k = 0; k < NV4; ++k) aq[(S + 2) % 3][k] = *(const LAS f32x4*)(ap + (S + 2) * 68 + 4 * k);
            }
            constexpr int own = S / RQ, ctrl = own * 0x55;
            const float xs = __builtin_bit_cast(float, __builtin_amdgcn_update_dpp(0, __builtin_bit_cast(int, x[S % RQ]), ctrl, 0xf, 0xf, false));
#pragma unroll
            for (int k = 0; k < NV4; ++k) { x[4 * k] += aq[S % 3][k][0] * xs; x[4 * k + 1] += aq[S % 3][k][1] * xs; x[4 * k + 2] += aq[S % 3][k][2] * xs; x[4 * k + 3] += aq[S % 3][k][3] * xs;
                asm volatile("" : "+v"(x[4 * k]), "+v"(x[4 * k + 1]), "+v"(x[4 * k + 2]), "+v"(x[4 * k + 3])); }
            asm volatile("" ::: "memory");
            SubstQ<S + 1, L>::run(x, aq, ap);
        }
    }
};
struct RawRegs { u32x4 r, k, v, w, a; };
__device__ __forceinline__ void rwkv_load_raw(Frame& F, int u, int tid, RawRegs& raw) {
    const int c = u >> 4, h = u & 15; int r0, pos0; chunk_geom(c, r0, pos0); const int L = c < 256 ? 64 : 32; int t = tid >> 3; t = t < L ? t : 0;
    const bf16_t* RKV = (const bf16_t*)(F.ws + WS_RKV); const bf16_t* WLOG = (const bf16_t*)(F.ws + WS_WLOG); const bf16_t* AA = (const bf16_t*)(F.ws + WS_XN);
    const size_t row = (size_t)(r0 + t); const int col = h * 64 + 8 * (tid & 7);
    raw.r = *(const u32x4*)(RKV + row * 3072 + col); raw.k = *(const u32x4*)(RKV + row * 3072 + 1024 + col); raw.v = *(const u32x4*)(RKV + row * 3072 + 2048 + col);
    raw.w = *(const u32x4*)(WLOG + row * D + col); raw.a = *(const u32x4*)(AA + row * D + col);
}
template <int L, bool DRY = false> __device__ __forceinline__ void rwkv_local_unit(Frame& F, int layer, int c, int h, RawRegs& raw, int unext) {
    const int tid = otid(); const int lane = tid & 63, fr = lane & 15, fq = lane >> 4, w = F.wave;
    constexpr int NIT = L / 16; constexpr bool SAMPLE = (L == 32);
    const int m = layer >> 1; int r0, pos0; chunk_geom(c, r0, pos0);
    bf16_t* RKV = (bf16_t*)(F.ws + WS_RKV); const bf16_t* WLOG = (const bf16_t*)(F.ws + WS_WLOG); const bf16_t* AA = (const bf16_t*)(F.ws + WS_XN);
    LAS bf16_t* AT = (LAS bf16_t*)(F.lds + RL_AT); LAS bf16_t* RT = (LAS bf16_t*)(F.lds + RL_RT); LAS bf16_t* BT = (LAS bf16_t*)(F.lds + RL_BT); LAS bf16_t* KT = (LAS bf16_t*)(F.lds + RL_KT);
    LAS bf16_t* BHT = (LAS bf16_t*)(F.lds + RL_BHT); LAS bf16_t* KHT = (LAS bf16_t*)(F.lds + RL_KHT); LAS bf16_t* VT = (LAS bf16_t*)(F.lds + RL_VT);
    LAS float* AAB = (LAS float*)(F.lds + RL_AAB); LAS bf16_t* AAK = (LAS bf16_t*)(F.lds + RL_AAK); LAS bf16_t* ARB = (LAS bf16_t*)(F.lds + RL_ARB); LAS bf16_t* ARK = (LAS bf16_t*)(F.lds + RL_ARK);
    LAS bf16_t* U0T = (LAS bf16_t*)(F.lds + RL_U0T); LAS float* GMID = (LAS float*)(F.lds + RL_VEC); LAS float* GLV = GMID + 64; LAS float* EGM = GMID + 128; LAS float* PSUM = (LAS float*)(F.lds + RL_PSUM);
    LAS float* G = (LAS float*)(F.lds + RL_G); LAS float* WW = (LAS float*)(F.lds + RL_WW); LAS bf16_t* APT = (LAS bf16_t*)(F.lds + RL_APT);
    __syncthreads();
    const int t = tid >> 3, c8 = tid & 7; const bool act = t < L;
    float rr[8], kkv[8], bb[8], kh[8], vv[8];
    if (act) { const size_t row = (size_t)(r0 + t); const int col = h * 64 + 8 * c8;
        const u32x4 r4 = raw.r, k4 = raw.k, v4 = raw.v, w4 = raw.w, a4 = raw.a;
        const float* kkp = F.in[I_RKK] + m * D + col; const float* kap = F.in[I_RKA] + m * D + col; const float* rkp = F.in[I_RRK] + m * D + col;
        float ss = 0.f, bon = 0.f;
#pragma unroll
        for (int e = 0; e < 8; ++e) { const float kx = (e & 1) ? bfhi(k4[e >> 1]) : bflo(k4[e >> 1]), al = (e & 1) ? bfhi(a4[e >> 1]) : bflo(a4[e >> 1]);
            rr[e] = (e & 1) ? bfhi(r4[e >> 1]) : bflo(r4[e >> 1]); vv[e] = (e & 1) ? bfhi(v4[e >> 1]) : bflo(v4[e >> 1]);
            kkv[e] = kx * kkp[e]; ss += kkv[e] * kkv[e]; kh[e] = kx * (1.f + (al - 1.f) * kap[e]); bb[e] = al; bon += rr[e] * kh[e] * rkp[e];
            G[t * 64 + 8 * c8 + e] = (e & 1) ? bfhi(w4[e >> 1]) : bflo(w4[e >> 1]); }
        ss += __shfl_xor(ss, 1); ss += __shfl_xor(ss, 2); ss += __shfl_xor(ss, 4); bon += __shfl_xor(bon, 1); bon += __shfl_xor(bon, 2); bon += __shfl_xor(bon, 4);
        const float inv = 1.f / fmaxf(sqrtf(ss), 1e-12f);
#pragma unroll
        for (int e = 0; e < 8; ++e) { kkv[e] *= inv; bb[e] *= kkv[e]; }
        if (c8 == 0) ((float*)(F.ws + WS_BON))[row * 16 + h] = bon; }
    if (unext >= 0) rwkv_load_raw(F, unext, tid, raw);
    __syncthreads();
    { constexpr int TE = L / 8; const int j = tid & 63, e8 = tid >> 6; float cs[TE]; float run = 0.f;
#pragma unroll
      for (int q = 0; q < TE; ++q) { run += G[(e8 * TE + q) * 64 + j]; cs[q] = run; }
      PSUM[e8 * 64 + j] = run;
      __syncthreads();
      float off = 0.f, gm = 0.f, gl = 0.f;
#pragma unroll
      for (int q = 0; q < 8; ++q) { const float p = PSUM[q * 64 + j]; if (q < e8) off += p; if (q < 4) gm += p; gl += p; }
#pragma unroll
      for (int q = 0; q < TE; ++q) G[(e8 * TE + q) * 64 + j] = off + cs[q];
      if (e8 == 0) { GMID[j] = gm; GLV[j] = gl; EGM[j] = __expf(gm); if (!SAMPLE) ((float*)(F.ws + WS_REC + ((size_t)h * 256 + c) * REC_B + 16384))[j] = __expf(gl); } }
    __syncthreads();
    if (act) { float fa[8], fr_[8], fb[8], fk[8];
#pragma unroll
        for (int e = 0; e < 8; ++e) { const int j = 8 * c8 + e; const float g = G[t * 64 + j], gp = (t > 0) ? G[(t - 1) * 64 + j] : 0.f, gm = GMID[j], gl = GLV[j];
            const float ed = __expf(gm - g), eu = __expf(g - gm), el = __expf(gl - g);
            fa[e] = -kkv[e] * __expf(gp - gm); fr_[e] = rr[e] * eu; fb[e] = bb[e] * ed; fk[e] = kh[e] * ed;
            if constexpr (!(DRY && (LOCAL_SKIP & 4))) { BHT[j * 72 + t] = (bf16_t)f2bf(bb[e] * el); KHT[j * 72 + t] = (bf16_t)f2bf(kh[e] * el); VT[j * 72 + t] = (bf16_t)f2bf(vv[e]); } }
        u32x4 p;
        p.x = pk2(fa[0], fa[1]); p.y = pk2(fa[2], fa[3]); p.z = pk2(fa[4], fa[5]); p.w = pk2(fa[6], fa[7]); *(LAS u32x4*)(AT + t * 72 + 8 * c8) = p;
        p.x = pk2(fr_[0], fr_[1]); p.y = pk2(fr_[2], fr_[3]); p.z = pk2(fr_[4], fr_[5]); p.w = pk2(fr_[6], fr_[7]); *(LAS u32x4*)(RT + t * 72 + 8 * c8) = p;
        p.x = pk2(fb[0], fb[1]); p.y = pk2(fb[2], fb[3]); p.z = pk2(fb[4], fb[5]); p.w = pk2(fb[6], fb[7]); *(LAS u32x4*)(BT + t * 72 + 8 * c8) = p;
        p.x = pk2(fk[0], fk[1]); p.y = pk2(fk[2], fk[3]); p.z = pk2(fk[4], fk[5]); p.w = pk2(fk[6], fk[7]); *(LAS u32x4*)(KT + t * 72 + 8 * c8) = p; }
    __syncthreads();
    if constexpr (DRY && (LOCAL_SKIP & 2)) return;
    { constexpr int TPW = (NIT * NIT >= 8) ? NIT * NIT / 8 : 1;
      if (w * TPW < NIT * NIT) { const int it = (w * TPW) / NIT, jt0 = (w * TPW) % NIT;
          f32x4 ab[1][TPW], ak[1][TPW], rb[1][TPW], rk[1][TPW];
#pragma unroll
          for (int q = 0; q < TPW; ++q) { ab[0][q] = (f32x4){0.f, 0.f, 0.f, 0.f}; ak[0][q] = ab[0][q]; rb[0][q] = ab[0][q]; rk[0][q] = ab[0][q]; }
          wave_mm_nt<1, TPW>(ab, AT + it * 16 * 72, 72, BT + jt0 * 16 * 72, 72, 64, fr, fq); wave_mm_nt<1, TPW>(ak, AT + it * 16 * 72, 72, KT + jt0 * 16 * 72, 72, 64, fr, fq);
          wave_mm_nt<1, TPW>(rb, RT + it * 16 * 72, 72, BT + jt0 * 16 * 72, 72, 64, fr, fq); wave_mm_nt<1, TPW>(rk, RT + it * 16 * 72, 72, KT + jt0 * 16 * 72, 72, 64, fr, fq);
          const int tt = it * 16 + fr;
#pragma unroll
          for (int q = 0; q < TPW; ++q) { const int s0 = (jt0 + q) * 16 + 4 * fq; f32x4 fab; float fak[4], frb[4], frk[4];
#pragma unroll
              for (int r = 0; r < 4; ++r) { const int sx = s0 + r; fab[r] = (sx < tt) ? ab[0][q][r] : 0.f; fak[r] = (sx < tt) ? ak[0][q][r] : 0.f; frb[r] = (sx <= tt) ? rb[0][q][r] : 0.f; frk[r] = (sx <= tt) ? rk[0][q][r] : 0.f; }
#pragma unroll
              for (int r = 0; r < 4; ++r) AAB[(s0 + r) * 68 + tt] = fab[r];
              u32x2 p; p.x = pk2(fak[0], fak[1]); p.y = pk2(fak[2], fak[3]); *(LAS u32x2*)(AAK + tt * 72 + s0) = p;
              p.x = pk2(frb[0], frb[1]); p.y = pk2(frb[2], frb[3]); *(LAS u32x2*)(ARB + tt * 72 + s0) = p;
              p.x = pk2(frk[0], frk[1]); p.y = pk2(frk[2], frk[3]); *(LAS u32x2*)(ARK + tt * 72 + s0) = p; } } }
    __syncthreads();
    { constexpr int TP3 = NIT / 2; const int it = (w * TP3) / 4, nt0 = (w * TP3) % 4;
      f32x4 ww[1][TP3];
#pragma unroll
      for (int q = 0; q < TP3; ++q) ww[0][q] = (f32x4){0.f, 0.f, 0.f, 0.f};
      wave_mm_nt<1, TP3>(ww, AAK + it * 16 * 72, 72, VT + nt0 * 16 * 72, 72, L, fr, fq);
#pragma unroll
      for (int q = 0; q < TP3; ++q) *(LAS f32x4*)(WW + (it * 16 + fr) * 68 + (nt0 + q) * 16 + 4 * fq) = ww[0][q]; }
    __syncthreads();
    { constexpr int RQ = L / 4, NV4 = RQ / 4; const int col = tid >> 2, qd = tid & 3, cidx = col & 63; const bool isA = col < 64; const float eg = EGM[cidx];
      float x[RQ]; f32x4 aq[3][NV4];
#pragma unroll
      for (int i = 0; i < RQ; ++i) { const int tt = qd * RQ + i; x[i] = isA ? bf2f(AT[tt * 72 + cidx]) * eg : WW[tt * 68 + cidx]; }
      const LAS float* ap = AAB + qd * RQ;
#pragma unroll
      for (int k = 0; k < NV4; ++k) { aq[0][k] = *(const LAS f32x4*)(ap + 4 * k); aq[1][k] = *(const LAS f32x4*)(ap + 68 + 4 * k); }
      if constexpr (!(DRY && (LOCAL_SKIP & 1))) SubstQ<0, L>::run(x, aq, ap);
      LAS bf16_t* dst = (isA ? APT : U0T) + cidx * 72 + qd * RQ;
#pragma unroll
      for (int t8 = 0; t8 < RQ; t8 += 8) { u32x4 p; p.x = pk2(x[t8], x[t8 + 1]); p.y = pk2(x[t8 + 2], x[t8 + 3]); p.z = pk2(x[t8 + 4], x[t8 + 5]); p.w = pk2(x[t8 + 6], x[t8 + 7]); *(LAS u32x4*)(dst + t8) = p; } }
    __syncthreads();
    { const int mt = w >> 1, nt0 = (w & 1) * 2;
      f32x4 pp[1][2], qt[1][2];
#pragma unroll
      for (int q = 0; q < 2; ++q) { pp[0][q] = (f32x4){0.f, 0.f, 0.f, 0.f}; qt[0][q] = pp[0][q]; }
      wave_mm_nt<1, 2>(pp, BHT + mt * 16 * 72, 72, APT + nt0 * 16 * 72, 72, L, fr, fq);
      wave_mm_nt<1, 2>(qt, U0T + mt * 16 * 72, 72, BHT + nt0 * 16 * 72, 72, L, fr, fq); wave_mm_nt<1, 2>(qt, VT + mt * 16 * 72, 72, KHT + nt0 * 16 * 72, 72, L, fr, fq);
      constexpr int TP5 = NIT / 2; const int it = (w * TP5) / 4, rn0 = (w * TP5) % 4;
      f32x4 rp[1][TP5], y0[1][TP5];
#pragma unroll
      for (int q = 0; q < TP5; ++q) { const int j = (rn0 + q) * 16 + 4 * fq; const u32x2 rw = *(const LAS u32x2*)(RT + (it * 16 + fr) * 72 + j); const f32x4 e4 = *(const LAS f32x4*)(EGM + j);
          rp[0][q] = (f32x4){bflo(rw.x) * e4[0], bfhi(rw.x) * e4[1], bflo(rw.y) * e4[2], bfhi(rw.y) * e4[3]}; y0[0][q] = (f32x4){0.f, 0.f, 0.f, 0.f}; }
      wave_mm_nt<1, TP5>(rp, ARB + it * 16 * 72, 72, APT + rn0 * 16 * 72, 72, L, fr, fq);
      wave_mm_nt<1, TP5>(y0, ARB + it * 16 * 72, 72, U0T + rn0 * 16 * 72, 72, L, fr, fq); wave_mm_nt<1, TP5>(y0, ARK + it * 16 * 72, 72, VT + rn0 * 16 * 72, 72, L, fr, fq);
      if constexpr (!SAMPLE) {
          bf16_t* PP = (bf16_t*)(F.ws + WS_REC + ((size_t)h * 256 + c) * REC_B); bf16_t* QQ = PP + 4096;
#pragma unroll
          for (int q = 0; q < 2; ++q) { const int n0 = (nt0 + q) * 16 + 4 * fq; u32x2 p; p.x = pk2(pp[0][q][0], pp[0][q][1]); p.y = pk2(pp[0][q][2], pp[0][q][3]);
              *(u32x2*)(PP + (mt * 16 + fr) * 64 + pperm(n0)) = p;
              p.x = pk2(qt[0][q][0], qt[0][q][1]); p.y = pk2(qt[0][q][2], qt[0][q][3]); *(u32x2*)(QQ + (mt * 16 + fr) * 64 + n0) = p; }
#pragma unroll
          for (int q = 0; q < TP5; ++q) { const size_t row = (size_t)(r0 + it * 16 + fr); const int n0 = (rn0 + q) * 16 + 4 * fq; u32x2 p;
              p.x = pk2(rp[0][q][0], rp[0][q][1]); p.y = pk2(rp[0][q][2], rp[0][q][3]); if constexpr (DRY) asm volatile("" :: "v"(p.x), "v"(p.y)); else *(u32x2*)(RKV + row * 3072 + 1024 + h * 64 + n0) = p;
              p.x = pk2(y0[0][q][0], y0[0][q][1]); p.y = pk2(y0[0][q][2], y0[0][q][3]); if constexpr (DRY) asm volatile("" :: "v"(p.x), "v"(p.y)); else *(u32x2*)(RKV + row * 3072 + h * 64 + n0) = p; }
      } else {
          __syncthreads();
          LAS bf16_t* PL = (LAS bf16_t*)(F.lds + RL_PL); LAS bf16_t* RLs = (LAS bf16_t*)(F.lds + RL_RL); LAS float* Y0L = (LAS float*)(F.lds + RL_Y0L); LAS float* QTL = (LAS float*)(F.lds + RL_QTL); LAS bf16_t* Sl = (LAS bf16_t*)(F.lds + RL_S);
#pragma unroll
          for (int q = 0; q < 2; ++q) { const int n0 = (nt0 + q) * 16 + 4 * fq; u32x2 p; p.x = pk2(pp[0][q][0], pp[0][q][1]); p.y = pk2(pp[0][q][2], pp[0][q][3]);
              *(LAS u32x2*)(PL + (mt * 16 + fr) * 72 + n0) = p; *(LAS f32x4*)(QTL + (mt * 16 + fr) * 68 + n0) = qt[0][q]; }
#pragma unroll
          for (int q = 0; q < TP5; ++q) { const int n0 = (rn0 + q) * 16 + 4 * fq; u32x2 p; p.x = pk2(rp[0][q][0], rp[0][q][1]); p.y = pk2(rp[0][q][2], rp[0][q][3]);
              *(LAS u32x2*)(RLs + (it * 16 + fr) * 72 + n0) = p; *(LAS f32x4*)(Y0L + (it * 16 + fr) * 68 + n0) = y0[0][q]; }
          const int sb = c - 256; const float* sin_ = F.in[I_SWKV] + (((size_t)m * 32 + sb) * 16 + h) * 4096; float* sout = F.out + O_WKVS + (((size_t)m * 32 + sb) * 16 + h) * 4096;
          for (int it2 = tid; it2 < 64 * 16; it2 += NT) { const int i = it2 >> 4, j4 = (it2 & 15) * 4; const f32x4 sv = *(const f32x4*)(sin_ + i * 64 + j4); u32x2 p; p.x = pk2(sv[0], sv[1]); p.y = pk2(sv[2], sv[3]); *(LAS u32x2*)(Sl + i * 72 + j4) = p; }
          __syncthreads();
          if (w < 2) { f32x4 y[1][4];
#pragma unroll
              for (int q = 0; q < 4; ++q) y[0][q] = *(const LAS f32x4*)(Y0L + (w * 16 + fr) * 68 + q * 16 + 4 * fq);
              wave_mm_nt<1, 4>(y, RLs + w * 16 * 72, 72, Sl, 72, 64, fr, fq);
              rwkv_out_epilogue<DRY>(F, m, y[0], (size_t)(r0 + w * 16 + fr), h, fq); }
          else if (w < 6) { const int mi = w - 2; f32x4 tl[1][4];
#pragma unroll
              for (int q = 0; q < 4; ++q) { const int j = q * 16 + 4 * fq; const f32x4 sv = *(const f32x4*)(sin_ + (mi * 16 + fr) * 64 + j), gl4 = *(const LAS f32x4*)(GLV + j), qv = *(const LAS f32x4*)(QTL + (mi * 16 + fr) * 68 + j);
                  tl[0][q] = (f32x4){__expf(gl4[0]) * sv[0] + qv[0], __expf(gl4[1]) * sv[1] + qv[1], __expf(gl4[2]) * sv[2] + qv[2], __expf(gl4[3]) * sv[3] + qv[3]}; }
              wave_mm_nt<1, 4>(tl, Sl + mi * 16 * 72, 72, PL, 72, 64, fr, fq);
#pragma unroll
              for (int q = 0; q < 4; ++q) *(f32x4*)(sout + (mi * 16 + fr) * 64 + q * 16 + 4 * fq) = tl[0][q]; }
      }
    }
}

constexpr int SC_GRP = 4, SC_CH = 8192 + 2048 + 256, SC_LCH = 9216 + 2304 + 256, SC_LBUF = SC_GRP * SC_LCH;
template <int SKIP = 0> __device__ __forceinline__ void rwkv_scan_phase(Frame& F, int layer) {
    const int tid = otid(); const int lane = tid & 63, m = layer >> 1; const int b = blockIdx.x;
    if (b >= 64) {
        if constexpr (SKIP == 0) { const int nb = (int)F.G - 64; RawRegs raw; int u = 256 * 16 + (b - 64); if (u < NCHUNK * 16) rwkv_load_raw(F, u, tid, raw);
            for (; u < NCHUNK * 16; u += nb) { const int un = (u + nb < NCHUNK * 16) ? u + nb : -1; rwkv_local_unit<32>(F, layer, u >> 4, u & 15, raw, un); }
            if (layer == 1) { __syncthreads(); mod_phase(F, 2, 4, b - 64, nb); } }
        return; }
    const int h = 2 * (b & 7) + (b >> 5), sl = (b >> 3) & 3;
    const unsigned char* REC = F.ws + WS_REC;
    constexpr int NG = 256 / SC_GRP, DEPTH = 4;
    static_assert(NG % DEPTH == 0, "scan groups vs prefetch depth");
    if (F.wave != 0) {
        constexpr int NV = SC_GRP * SC_CH / 16, NLT = NT - 64, NPT = (NV + NLT - 1) / NLT;
        struct RegSet { u32x4 v[NPT]; };
        RegSet sets[DEPTH];
        unsigned poff[NPT], pdst[NPT];
#pragma unroll
        for (int q = 0; q < NPT; ++q) { int v = (tid - 64) + q * NLT; v = v < NV ? v : NV - 1; const int cc = v / (SC_CH / 16), o = (v % (SC_CH / 16)) * 16;
            poff[q] = (unsigned)(cc * REC_B + o + (o >= 10240 ? 6144 : (o >= 8192 ? sl * 2048 : 0)));
            const int lo = (o < 8192) ? (o >> 7) * 144 + (o & 127) : (o < 10240) ? 9216 + ((o - 8192) >> 7) * 144 + ((o - 8192) & 127) : 9216 + 2304 + (o - 10240);
            pdst[q] = (unsigned)(cc * SC_LCH + lo); }
        auto issue = [&](int g, RegSet& st) { const unsigned char* gb = REC + ((size_t)h * 256 + g * SC_GRP) * REC_B;
#pragma unroll
            for (int q = 0; q < NPT; ++q) st.v[q] = *(const u32x4*)(gb + poff[q]); };
        auto commit = [&](int buf, const RegSet& st) {
#pragma unroll
            for (int q = 0; q < NPT; ++q) *(LAS u32x4*)(F.lds + buf * SC_LBUF + pdst[q]) = st.v[q]; };
        if (!(SKIP & 2)) {
#pragma unroll
            for (int d = 0; d < DEPTH; ++d) issue(d, sets[d]);
            commit(0, sets[0]); }
        for (int g0 = 0; g0 < NG; g0 += DEPTH) {
#pragma unroll
            for (int dd = 0; dd < DEPTH; ++dd) { const int g = g0 + dd;
                if (!(SKIP & 2)) { if (g > 0 && g + DEPTH - 1 < NG) issue(g + DEPTH - 1, sets[(dd + DEPTH - 1) % DEPTH]); }
                __syncthreads();
                __syncthreads();
                if (!(SKIP & 2)) { if (g + 1 < NG) commit((g + 1) & 1, sets[(dd + 1) % DEPTH]); } }
        }
    } else {
        const int ci = lane & 15, q4 = lane >> 4, i = 16 * sl + ci;
        f32x4 T[4];
#pragma unroll
        for (int mm = 0; mm < 4; ++mm) T[mm] = (f32x4){0.f, 0.f, 0.f, 0.f};
        bf16_t* TST = (bf16_t*)(F.ws + WS_TST);
        const unsigned pfo = (unsigned)(ci * 144 + q4 * 16);
        for (int g = 0; g < NG; ++g) {
            __syncthreads();
            if (!(SKIP & 1)) {
                const LAS unsigned char* base = F.lds + (g & 1) * SC_LBUF;
                bf16x8 pf[4][2];
#pragma unroll
                for (int mm = 0; mm < 4; ++mm)
#pragma unroll
                    for (int s = 0; s < 2; ++s) pf[mm][s] = *(const LAS bf16x8*)(base + pfo + mm * 2304 + s * 64);
#pragma unroll
                for (int cc = 0; cc < SC_GRP; ++cc) { const int c = g * SC_GRP + cc; const LAS unsigned char* cb = base + cc * SC_LCH;
                    bf16_t* tdst = TST + (((size_t)h * 256 + c) * 64 + i) * 64;
                    f32x4 gv[4]; u32x2 qv[4];
#pragma unroll
                    for (int mm = 0; mm < 4; ++mm) { const int j = 16 * mm + 4 * q4; gv[mm] = *(const LAS f32x4*)(cb + 9216 + 2304 + j * 4); qv[mm] = *(const LAS u32x2*)(cb + 9216 + ci * 144 + j * 2); }
                    bf16x8 pn[4][2];
                    if (cc + 1 < SC_GRP) {
#pragma unroll
                        for (int mm = 0; mm < 4; ++mm)
#pragma unroll
                            for (int s = 0; s < 2; ++s) pn[mm][s] = *(const LAS bf16x8*)(cb + SC_LCH + pfo + mm * 2304 + s * 64); }
                    bf16x8 Tf[2];
#pragma unroll
                    for (int mm = 0; mm < 4; ++mm) { u32x2 p; p.x = pk2(T[mm][0], T[mm][1]); p.y = pk2(T[mm][2], T[mm][3]); *(u32x2*)(tdst + 16 * mm + 4 * q4) = p;
                        Tf[mm >> 1][(mm & 1) * 4 + 0] = (short)(p.x & 0xffffu); Tf[mm >> 1][(mm & 1) * 4 + 1] = (short)(p.x >> 16); Tf[mm >> 1][(mm & 1) * 4 + 2] = (short)(p.y & 0xffffu); Tf[mm >> 1][(mm & 1) * 4 + 3] = (short)(p.y >> 16); }
#pragma unroll
                    for (int mm = 0; mm < 4; ++mm) {
                        f32x4 acc = (f32x4){gv[mm][0] * T[mm][0] + bflo(qv[mm].x), gv[mm][1] * T[mm][1] + bfhi(qv[mm].x), gv[mm][2] * T[mm][2] + bflo(qv[mm].y), gv[mm][3] * T[mm][3] + bfhi(qv[mm].y)};
                        acc = __builtin_amdgcn_mfma_f32_16x16x32_bf16(pf[mm][0], Tf[0], acc, 0, 0, 0); acc = __builtin_amdgcn_mfma_f32_16x16x32_bf16(pf[mm][1], Tf[1], acc, 0, 0, 0);
                        T[mm] = acc; }
                    if (cc + 1 < SC_GRP) {
#pragma unroll
                        for (int mm = 0; mm < 4; ++mm) { pf[mm][0] = pn[mm][0]; pf[mm][1] = pn[mm][1]; } }
                }
            }
            __syncthreads();
        }
        float* outp = F.out + O_WKVP + ((size_t)m * 16 + h) * 4096 + (size_t)i * 64;
#pragma unroll
        for (int mm = 0; mm < 4; ++mm) *(f32x4*)(outp + 16 * mm + 4 * q4) = T[mm];
    }
}

struct OutMain { u32x2 y0[4]; bf16x8 xa[2]; };
template <bool DRY = false> __device__ __forceinline__ void rwkv_output_phase(Frame& F, int layer) {
    const int tid = otid(); const int lane = tid & 63, fr = lane & 15, fq = lane >> 4, m = layer >> 1;
    const bf16_t* RKV = (const bf16_t*)(F.ws + WS_RKV); const bf16_t* TST = (const bf16_t*)(F.ws + WS_TST);
    const int gw = F.vcu * NWAVES + F.wave, NGW = F.G * NWAVES;
    for (int u = gw; u < 256 * 16; u += NGW) { const int h = u & 15, c = u >> 4; const bf16_t* ts = TST + ((size_t)h * 256 + c) * 4096;
        bf16x8 yb[2][4];
#pragma unroll
        for (int s = 0; s < 2; ++s)
#pragma unroll
            for (int nt = 0; nt < 4; ++nt) yb[s][nt] = *(const bf16x8*)(ts + (16 * nt + fr) * 64 + 32 * s + 8 * fq);
        f32x4 lgu[4], lbu[4];
#pragma unroll
        for (int nt = 0; nt < 4; ++nt) { const int i = h * 64 + 16 * nt + 4 * fq; lgu[nt] = *(const f32x4*)(F.in[I_RLNG] + m * D + i); lbu[nt] = *(const f32x4*)(F.in[I_RLNB] + m * D + i); }
        const bf16_t* GG = (const bf16_t*)(F.ws + WS_G); const float* BON = (const float*)(F.ws + WS_BON);
        auto issue = [&](int it, OutMain& mn, OutSide& sd) { const size_t row = (size_t)(64 * c + 16 * it + fr);
#pragma unroll
            for (int nt = 0; nt < 4; ++nt) mn.y0[nt] = *(const u32x2*)(RKV + row * 3072 + h * 64 + 16 * nt + 4 * fq);
#pragma unroll
            for (int s = 0; s < 2; ++s) mn.xa[s] = *(const bf16x8*)(RKV + row * 3072 + 1024 + h * 64 + 32 * s + 8 * fq);
            sd.bon = BON[row * 16 + h];
#pragma unroll
            for (int nt = 0; nt < 4; ++nt) { const int i = h * 64 + 16 * nt + 4 * fq; sd.vv[nt] = *(const u32x2*)(RKV + row * 3072 + 2048 + i); sd.gg[nt] = *(const u32x2*)(GG + row * D + i); } };
        auto compute = [&](int it, const OutMain& mn, OutSide& sd) { const size_t row = (size_t)(64 * c + 16 * it + fr); f32x4 y[4];
#pragma unroll
            for (int nt = 0; nt < 4; ++nt) y[nt] = (f32x4){bflo(mn.y0[nt].x), bfhi(mn.y0[nt].x), bflo(mn.y0[nt].y), bfhi(mn.y0[nt].y)};
#pragma unroll
            for (int s = 0; s < 2; ++s)
#pragma unroll
                for (int nt = 0; nt < 4; ++nt) y[nt] = __builtin_amdgcn_mfma_f32_16x16x32_bf16(yb[s][nt], mn.xa[s], y[nt], 0, 0, 0);
#pragma unroll
            for (int nt = 0; nt < 4; ++nt) { sd.lg[nt] = lgu[nt]; sd.lb[nt] = lbu[nt]; }
            rwkv_out_core<DRY>(F, y, row, h, fq, sd); };
        OutMain mA, mB; OutSide sA, sB;
        issue(0, mA, sA); asm volatile("" ::: "memory");
        issue(1, mB, sB); asm volatile("" ::: "memory"); compute(0, mA, sA); asm volatile("" ::: "memory");
        issue(2, mA, sA); asm volatile("" ::: "memory"); compute(1, mB, sB); asm volatile("" ::: "memory");
        issue(3, mB, sB); asm volatile("" ::: "memory"); compute(2, mA, sA); asm volatile("" ::: "memory");
        compute(3, mB, sB);
    }
}

#define GRID_BAR() xcd_barrier(bar)
#ifndef PHASE_MASK
#define PHASE_MASK 0xffffffffu
#endif
#ifndef STRETCH_MASK
#define STRETCH_MASK 0u
#endif
struct StretchGuard { unsigned long long t0; bool on; __device__ __forceinline__ StretchGuard(bool o) : t0(o ? __builtin_amdgcn_s_memrealtime() : 0ull), on(o) {}
    __device__ __forceinline__ ~StretchGuard() { if (on) { __syncthreads(); const unsigned long long t1 = __builtin_amdgcn_s_memrealtime(); while (__builtin_amdgcn_s_memrealtime() < t1 + (t1 - t0)) __builtin_amdgcn_s_sleep(2); } } };
#define PH(k) if (StretchGuard sg_(((STRETCH_MASK) >> (k)) & 1u); PHASE_MASK & (1u << (k)))
#ifndef REP_MASK
#define REP_MASK 0u
#endif
#define REP(k) (((REP_MASK) >> (k)) & 1u)
#ifndef LOCAL_SKIP
#define LOCAL_SKIP 0
#endif
#ifndef EXTRA_BARS
#define EXTRA_BARS 0
#endif
template <int layer> __device__ __forceinline__ void layer_body(Frame& F, const XcdBarrier& bar) {
    unsigned char* ws = F.ws; unsigned char* ar = ws + WS_ARENA;
    bf16_t* XN = (bf16_t*)(ws + WS_XN);
    const float* MOD = (const float*)(ws + WS_MOD);
    constexpr int m = layer >> 1; const float* modl = MOD + (size_t)layer * NSEQ * 6144;
    PH(1) for (int rep = 0; rep <= (int)REP(1); ++rep) if (layer > 0) convert_layer_weights(F, layer);
    if constexpr ((layer & 1) == 0) {
        PH(2) for (int rep = 0; rep <= (int)REP(2); ++rep) { if constexpr (layer == 0) norm_pass<0, 0, true>(F, layer, 0, 0, F.in[I_XS], nullptr); else norm_pass<0, 8>(F, layer, layer - 1, 5120, F.out + (size_t)MP * D, (float*)(ws + WS_SXB)); }
        GRID_BAR();
        PH(3) { using GC = pg8::Geo<D, D, D, 30, 0, 1 << 20, 0>; pg8::Gemm<GC> g{XN, (const bf16_t*)(ar + AR_WIN), nullptr}; pg8::StaticOrder S; S.init(M, ABIN, F.G, (int)blockIdx.x);
          pg8::EpiBf16<0> E{(bf16_t*)(ws + WS_Z), ABIN};
          pg8::gemm_phase<pg8::EpiBf16<0>, pg8::StaticOrder, GC, true, true>(F.lds, g, S, E);
          if (REP(3)) { pg8::EpiNull<true> EN; pg8::gemm_phase<pg8::EpiNull<true>, pg8::StaticOrder, GC, true, true>(F.lds, g, S, EN); } }
        GRID_BAR();
        PH(4) for (int rep = 0; rep <= (int)REP(4); ++rep) for (int u = F.vcu; u < NCHUNK * 8; u += F.G) { const int c = u >> 3, hh = (u + u / F.G) & 7;
            if (c < 256) { if (hh < 4) ab_summary_unit<64, false>(F, layer, c, hh); else ab_summary_unit<64, true>(F, layer, c, hh - 4); }
            else { if (hh < 4) ab_summary_unit<32, false>(F, layer, c, hh); else ab_summary_unit<32, true>(F, layer, c, hh - 4); } }
        GRID_BAR();
        PH(5) { if (REP(5)) ab_scan<true>(F, layer); ab_scan<false>(F, layer); }
        GRID_BAR();
        PH(6) for (int rep = 0; rep <= (int)REP(6); ++rep) for (int u = F.vcu; u < NCHUNK * 8; u += F.G) { const int c = u >> 3, hh = (u + u / F.G) & 7;
            if (c < 256) { if (hh < 4) ab_output_unit<64, false>(F, layer, c, hh); else ab_output_unit<64, true>(F, layer, c, hh - 4); }
            else { if (hh < 4) ab_output_unit<32, false>(F, layer, c, hh); else ab_output_unit<32, true>(F, layer, c, hh - 4); } }
        GRID_BAR();
        PH(7) { using GC = pg8::Geo<D, D, D, 30, 0, 1 << 20, 0>; pg8::Gemm<GC> g{XN, (const bf16_t*)(ar + AR_WOUT), nullptr}; pg8::StaticOrder S; S.init(MP, D, F.G, (int)blockIdx.x);
          pg8::EpiRes E{F.out, modl, 2048, (layer == 0) ? F.in[I_XP] : F.out};
          pg8::gemm_phase<pg8::EpiRes, pg8::StaticOrder, GC, true, true>(F.lds, g, S, E);
          if (REP(7)) { pg8::EpiNull<false> EN; pg8::gemm_phase<pg8::EpiNull<false>, pg8::StaticOrder, GC, true, true>(F.lds, g, S, EN); }
          using GC2 = pg8::Geo<D, D, 256, 30, 0, 1 << 20, 0, true>; pg8::Gemm<GC2> g2{XN, (const bf16_t*)(ar + AR_WOUT), nullptr}; pg8::SplitOrder S2{F.vcu, 4};
          pg8::EpiPartial E2{(float*)(ws + WS_PART), 4};
          pg8::gemm_phase<pg8::EpiPartial, pg8::SplitOrder, GC2, true, true>(F.lds, g2, S2, E2); }
        GRID_BAR();
    } else {
        PH(8) for (int rep = 0; rep <= (int)REP(8); ++rep) norm_pass<1, 8>(F, layer, layer - 1, 5120, F.out + (size_t)MP * D, (float*)(ws + WS_SXB));
        GRID_BAR();
        PH(9) { using GCr = pg8::Geo<D, 2048, D, 2, M * D, 1 << 20, 0>; pg8::Gemm<GCr> gr{(const bf16_t*)(ws + WS_XMIX), (const bf16_t*)(ar + AR_WC1), nullptr}; pg8::StaticOrder Sr; Sr.init(M, 3072, F.G, (int)blockIdx.x);
          pg8::EpiRkv E{(bf16_t*)(ws + WS_RKV), (bf16_t*)(ws + WS_LO), (m == 0) ? (bf16_t*)(ws + WS_VFIRST) : nullptr};
          pg8::gemm_phase<pg8::EpiRkv, pg8::StaticOrder, GCr, true, true>(F.lds, gr, Sr, E);
          if (REP(9)) { pg8::EpiNull<true> EN; pg8::gemm_phase<pg8::EpiNull<true>, pg8::StaticOrder, GCr, true, true>(F.lds, gr, Sr, EN); }
          using GC = pg8::Geo<D, 2048, 2048, 30, 0, 16, -4096>; pg8::Gemm<GC> g{XN, (const bf16_t*)(ar + AR_WC1), (const bf16_t*)(ws + WS_PREVS)}; pg8::LoraOrder Sl{(int)blockIdx.x};
          pg8::gemm_phase<pg8::EpiRkv, pg8::LoraOrder, GC, true, true>(F.lds, g, Sl, E); }
        GRID_BAR();
        PH(10) { using GC = pg8::Geo<D, 256, 256, 2, 256, 1 << 20, 0>; pg8::Gemm<GC> g{(const bf16_t*)(ws + WS_LO), (const bf16_t*)(ar + AR_WC2), nullptr}; pg8::SkipVOrder S; S.skip = (m == 0); S.S.init(M, (m == 0) ? 3072 : 4096, F.G, (int)blockIdx.x);
          pg8::EpiLora2 E{(bf16_t*)(ws + WS_WLOG), XN, (bf16_t*)(ws + WS_G), (bf16_t*)(ws + WS_RKV), (m == 1) ? (const bf16_t*)(ws + WS_VFIRST) : nullptr,
                          F.in[I_RW0] + m * D, F.in[I_RA0] + m * D, F.in[I_RV0]};
          pg8::gemm_phase<pg8::EpiLora2, pg8::SkipVOrder, GC, true, true>(F.lds, g, S, E);
           }
        GRID_BAR();
        PH(11) { RawRegs raw; const int tid0 = otid(); int u = F.vcu; if (u < 256 * 16) rwkv_load_raw(F, u, tid0, raw);
          for (; u < 256 * 16; u += F.G) { const int c = u >> 4, hh = u & 15, un = (u + F.G < 256 * 16) ? u + F.G : -1;
              rwkv_local_unit<64>(F, layer, c, hh, raw, un); } }
        GRID_BAR();
        PH(17) { if (REP(17)) rwkv_scan_phase<LOCAL_SKIP>(F, layer); rwkv_scan_phase<0>(F, layer); }
        GRID_BAR();
        PH(18) { if (REP(18)) rwkv_output_phase<true>(F, layer); rwkv_output_phase<false>(F, layer); }
        GRID_BAR();
        PH(12) { using GC = pg8::Geo<3072, D, D, 30, 0, 1 << 20, 0>; pg8::Gemm<GC> g{(const bf16_t*)(ws + WS_RKV), (const bf16_t*)(ar + AR_WO), nullptr}; pg8::StaticOrder S; S.init(MP, D, F.G, (int)blockIdx.x);
          pg8::EpiRes E{F.out, modl, 2048, F.out};
          pg8::gemm_phase<pg8::EpiRes, pg8::StaticOrder, GC, true, true>(F.lds, g, S, E);
          if (REP(12)) { pg8::EpiNull<false> EN; pg8::gemm_phase<pg8::EpiNull<false>, pg8::StaticOrder, GC, true, true>(F.lds, g, S, EN); }
          using GC2 = pg8::Geo<3072, D, 256, 30, 0, 1 << 20, 0, true>; pg8::Gemm<GC2> g2{(const bf16_t*)(ws + WS_RKV), (const bf16_t*)(ar + AR_WO), nullptr}; pg8::SplitOrder S2{F.vcu, 4};
          pg8::EpiPartial E2{(float*)(ws + WS_PART), 4};
          pg8::gemm_phase<pg8::EpiPartial, pg8::SplitOrder, GC2, true, true>(F.lds, g2, S2, E2); }
        GRID_BAR();
    }
    PH(13) for (int rep = 0; rep <= (int)REP(13); ++rep) norm_pass<2, 4>(F, layer, layer, 2048, (layer == 0) ? F.in[I_XS] : (const float*)(ws + WS_SXB), F.out + (size_t)MP * D);
    GRID_BAR();
    PH(14) { using GC = pg8::Geo<D, D, D, 30, 0, 1 << 20, 0>; pg8::Gemm<GC> g{XN, (const bf16_t*)(ar + AR_W1), nullptr}; pg8::StaticOrder S; S.init(M, DFF, F.G, (int)blockIdx.x);
      pg8::EpiBf16<1> E{(bf16_t*)(ws + WS_H), DFF};
      pg8::gemm_phase<pg8::EpiBf16<1>, pg8::StaticOrder, GC, true, true>(F.lds, g, S, E);
          if (REP(14)) { pg8::EpiNull<true> EN; pg8::gemm_phase<pg8::EpiNull<true>, pg8::StaticOrder, GC, true, true>(F.lds, g, S, EN); } }
    GRID_BAR();
    PH(15) { using GC = pg8::Geo<DFF, DFF, DFF, 30, 0, 1 << 20, 0>; pg8::Gemm<GC> g{(const bf16_t*)(ws + WS_H), (const bf16_t*)(ar + AR_W2), nullptr}; pg8::StaticOrder S; S.init(MP, D, F.G, (int)blockIdx.x);
      pg8::EpiRes E{F.out, modl, 5120, F.out};
      for (int xb = 0; xb < EXTRA_BARS; ++xb) GRID_BAR();
      pg8::gemm_phase<pg8::EpiRes, pg8::StaticOrder, GC, true, true>(F.lds, g, S, E);
      if (REP(15)) { pg8::EpiNull<false> EN; pg8::gemm_phase<pg8::EpiNull<false>, pg8::StaticOrder, GC, true, true>(F.lds, g, S, EN); }
      using GC2 = pg8::Geo<DFF, DFF, 512, 30, 0, 1 << 20, 0, true>; pg8::Gemm<GC2> g2{(const bf16_t*)(ws + WS_H), (const bf16_t*)(ar + AR_W2), nullptr}; pg8::SplitOrder S2{F.vcu, 8};
      pg8::EpiPartial E2{(float*)(ws + WS_PART), 8};
      pg8::gemm_phase<pg8::EpiPartial, pg8::SplitOrder, GC2, true, true>(F.lds, g2, S2, E2); }
    GRID_BAR();
}

__global__ void __launch_bounds__(NT, 2) fwd_kernel(Args args) {
    extern __shared__ __attribute__((aligned(16))) unsigned char lds[];
    Frame F;
    F.lds = (LAS unsigned char*)lds; F.MISC = (volatile LAS unsigned*)(F.lds + MISC_OFF);
    F.wave = __builtin_amdgcn_readfirstlane(threadIdx.x >> 6);
    F.G = gridDim.x; { const int bx = blockIdx.x; F.vcu = (F.G % 8 == 0) ? (bx % 8) * (F.G / 8) + bx / 8 : bx; }
    F.in = args.in; F.out = args.out; F.ws = args.ws;
    for (int u = threadIdx.x; u < (LDS_BYTES - LDSCTL_OFF) / 4; u += NT) ((LAS unsigned*)(F.lds + LDSCTL_OFF))[u] = 0u;
    __syncthreads();
    XcdBarrier bar = xcd_barrier_post((unsigned*)(F.ws + WS_CTL) + CW_BAR, F.MISC + 8);
    PH(0) prologue(F);
    GRID_BAR();
    PH(0) mod_phase(F, 0, 2, F.vcu, F.G);
    GRID_BAR();
    layer_body<0>(F, bar); layer_body<1>(F, bar); layer_body<2>(F, bar); layer_body<3>(F, bar);
    PH(16) norm_pass<3, 8>(F, 0, 3, 5120, F.out + (size_t)MP * D, nullptr);
}

extern "C" void kernel_launch(void* const* d_in, const int* in_sizes, int n_in, void* d_out, int out_size, void* d_ws, size_t ws_size, hipStream_t stream) {
    static int grid = 0;
    if (grid == 0) {
        if (n_in != 38 || out_size != 28706816 || ws_size < WS_END) { fprintf(stderr, "kernel_launch: unexpected problem (n_in %d, out %d, ws %zu; need ws >= %zu)\n", n_in, out_size, ws_size, (size_t)WS_END); grid = -1; return; }
        int dev = 0, cus = 0, per_cu = 0;
        if (hipGetDevice(&dev) != hipSuccess || hipDeviceGetAttribute(&cus, hipDeviceAttributeMultiprocessorCount, dev) != hipSuccess) { grid = -1; return; }
        if (hipFuncSetAttribute((const void*)fwd_kernel, hipFuncAttributeMaxDynamicSharedMemorySize, LDS_BYTES) != hipSuccess) { fprintf(stderr, "kernel_launch: hipFuncSetAttribute failed\n"); grid = -1; return; }
        if (hipOccupancyMaxActiveBlocksPerMultiprocessor(&per_cu, (const void*)fwd_kernel, NT, LDS_BYTES) != hipSuccess || per_cu < 1) { fprintf(stderr, "kernel_launch: occupancy query says %d\n", per_cu); per_cu = 1; }
        (void)hipGetLastError();
        grid = cus;
    }
    if (grid < 0) return;
    (void)hipMemsetAsync((char*)d_ws + WS_CTL, 0, ZERO_BYTES, stream);
    Args a{};
    for (int i = 0; i < 38; ++i) a.in[i] = (const float*)d_in[i];
    a.out = (float*)d_out; a.ws = (unsigned char*)d_ws;
    void* kargs[] = {&a};
    hipError_t e = hipLaunchCooperativeKernel((const void*)fwd_kernel, dim3(grid), dim3(NT), kargs, LDS_BYTES, stream);
    if (e != hipSuccess) fprintf(stderr, "kernel_launch: cooperative launch failed: %s (grid %d)\n", hipGetErrorString(e), grid);
}
```

```cpp
#include <hip/hip_runtime.h>
#include <cstdio>
#include <cstdint>

#define LAS __attribute__((address_space(3)))
#define GAS __attribute__((address_space(1)))
typedef unsigned short bf16_t;
typedef short bf16x8 __attribute__((ext_vector_type(8)));
typedef float f32x4 __attribute__((ext_vector_type(4)));
typedef float f32x2 __attribute__((ext_vector_type(2)));
typedef unsigned u32x4 __attribute__((ext_vector_type(4)));
typedef unsigned u32x2 __attribute__((ext_vector_type(2)));

#ifndef LOCAL_SKIP
#define LOCAL_SKIP 0
#endif
constexpr int D = 1024, MP = 16384, MS = 1024, M = MP + MS, NSEQ = 33, DFF = 4096, ABIN = 3584;
constexpr int NCHUNK = 288;
constexpr int SLOT_E = 4 * 8192 + 4 * 16384;
constexpr float NORM_EPS = 1e-6f, RW_LN_EPS = 64e-5f;

constexpr size_t MiB = 1u << 20;
constexpr size_t WS_CTL = 0, WS_MOD = 1 * MiB, ZERO_BYTES = 65536;
constexpr size_t WS_ROPE = 5 * MiB;
constexpr size_t WS_ARENA = 10 * MiB;
constexpr size_t AR_W1 = 0, AR_W2 = 8 * MiB, AR_WIN = 16 * MiB, AR_WOUT = 23 * MiB, AR_WC1 = 16 * MiB, AR_WC2 = 32 * MiB, AR_WO = 34 * MiB;
constexpr size_t WS_VFIRST = 46 * MiB;
constexpr size_t WS_XN0 = 80 * MiB, WS_XN = WS_XN0 + 2048;
constexpr size_t WS_PREVS = 115 * MiB;
constexpr size_t WS_R1 = 118 * MiB;
constexpr size_t WS_Z = WS_R1, WS_STATE = WS_R1 + 120 * MiB, WS_DEC = WS_R1 + 174 * MiB;
constexpr size_t WS_H = WS_R1;
constexpr size_t WS_RKV = WS_R1, WS_LO = WS_R1 + 102 * MiB, WS_WLOG = WS_R1 + 136 * MiB, WS_G = WS_R1 + 170 * MiB;
constexpr size_t WS_TST = WS_R1 + 102 * MiB;
constexpr size_t WS_REC = WS_R1 + 204 * MiB, WS_BON = WS_R1 + 269 * MiB;
constexpr int REC_B = 16640;
constexpr size_t WS_XMIX = WS_R1 + 168 * MiB;
constexpr size_t WS_PART = WS_R1 + 136 * MiB;
constexpr size_t WS_SXB = WS_R1 + 271 * MiB;
constexpr size_t WS_END = WS_R1 + 275 * MiB;

__device__ const double ROPE_REV[32] = {0.15915494309189535, 0.11934937021124886, 0.089499401608891013, 0.067115083005227255, 0.050329212104487035, 0.037741584717419771, 0.028302195830623399, 0.02122365276477766, 0.015915494309189534, 0.011934937021124886, 0.0089499401608891024, 0.0067115083005227253, 0.0050329212104487037, 0.0037741584717419772, 0.0028302195830623399, 0.0021223652764777662, 0.0015915494309189536, 0.0011934937021124885, 0.00089499401608891024, 0.0006711508300522726, 0.00050329212104487033, 0.00037741584717419774, 0.00028302195830623395, 0.00021223652764777661, 0.00015915494309189535, 0.00011934937021124886, 8.9499401608891018e-05, 6.7115083005227254e-05, 5.0329212104487035e-05, 3.7741584717419777e-05, 2.8302195830623396e-05, 2.1223652764777659e-05};

__device__ __forceinline__ unsigned f2bf(float f) { unsigned u = __builtin_bit_cast(unsigned, f); return (u + 0x7fffu + ((u >> 16) & 1u)) >> 16; }
typedef __bf16 bf16x2_t __attribute__((ext_vector_type(2)));
__device__ __forceinline__ unsigned pk2(float lo, float hi) { const f32x2 v = {lo, hi}; const bf16x2_t b = __builtin_convertvector(v, bf16x2_t); return __builtin_bit_cast(unsigned, b); }
__device__ __forceinline__ float bf2f(unsigned short b) { return __builtin_bit_cast(float, (unsigned)b << 16); }
__device__ __forceinline__ float bflo(unsigned w) { return __builtin_bit_cast(float, w << 16); }
__device__ __forceinline__ float bfhi(unsigned w) { return __builtin_bit_cast(float, w & 0xffff0000u); }
__device__ __forceinline__ float sigmoidf_(float x) { return 1.f / (1.f + __expf(-x)); }
__device__ __forceinline__ float siluf_(float x) { return x / (1.f + __expf(-x)); }
__device__ __forceinline__ float wave_sum(float v) {
#pragma unroll
    for (int o = 1; o < 64; o <<= 1) v += __shfl_xor(v, o);
    return v;
}
__device__ __forceinline__ int otid() { int t = threadIdx.x; asm volatile("" : "+v"(t)); return t; }
__device__ __forceinline__ int seq_of_row(int r) { return r < MP ? 0 : 1 + ((r - MP) >> 5); }
#define LDS_WAIT() asm volatile("s_waitcnt lgkmcnt(0)" ::: "memory")
#define VM_WAIT() asm volatile("s_waitcnt vmcnt(0)" ::: "memory")

namespace pg8 {
constexpr int BM = 256, BK = 64, HALF = 128, HTB = HALF * BK * 2, STAGE_BYTES = 8 * HTB, NXCD = 8, WGM = 8;
__host__ __device__ __forceinline__ int lds_byte(int r, int c) { const int st = (r >> 4) * 2 + (c >> 5), rr = r & 15, cc = c & 31, ob = rr * 64 + cc * 2; return st * 1024 + (ob ^ (((ob >> 9) & 1) << 5)); }
__host__ __device__ __forceinline__ void stage_rc(int b, int& R, int& C) { const int st = b / 1024, sb = b % 1024, swz = sb ^ (((sb >> 9) & 1) << 5); R = (st >> 1) * 16 + swz / 64; C = (st & 1) * 32 + (swz % 64) / 2; }
__host__ __device__ __forceinline__ int perm32(int rho) { const int n = rho >> 4, i = rho & 15; return 8 * (i >> 2) + 4 * n + (i & 3); }

struct Unit { int pm, pn, ks; };
template <int LDA_, int LDB_, int K_, int GSHIFT_, int GSTRIDE_, int KSPLIT_, int DELTAP_, bool SPLIT_ = false> struct Geo {
    static constexpr int LDA = LDA_, LDB = LDB_, K = K_, GSHIFT = GSHIFT_, GSTRIDE = GSTRIDE_, KSPLIT = KSPLIT_, DELTAP = DELTAP_; static constexpr bool SPLIT = SPLIT_;
};
template <class GC> struct Gemm {
    const bf16_t* A; const bf16_t* Bt; const bf16_t* A2s;
    __device__ __forceinline__ const char* a_base(const Unit& u) const { return (const char*)(A + (size_t)u.pm * BM * GC::LDA + (size_t)(u.pn >> GC::GSHIFT) * GC::GSTRIDE + (GC::SPLIT ? (size_t)u.ks * GC::K : 0)); }
    __device__ __forceinline__ const char* b_base(const Unit& u) const { return (const char*)(Bt + (size_t)u.pn * BM * GC::LDB + (GC::SPLIT ? (size_t)u.ks * GC::K : 0)); }
    __device__ __forceinline__ long a_delta(const Unit& u) const {
        if constexpr (GC::KSPLIT >= GC::K / BK) return 0;
        else { if (u.pm < 64) return (long)GC::DELTAP;
            return (long)((const char*)(A2s + (size_t)(u.pm - 64) * BM * GC::LDA) - a_base(u)) - (long)GC::KSPLIT * BK * 2; }
    }
};
struct StaticOrder {
    int nM, nN, nwg, G, c;
    __host__ __device__ void init(int M_, int N_, int G_, int c_) { nM = M_ / BM; nN = N_ / BM; nwg = nM * nN; G = G_; c = c_; }
    __host__ __device__ bool next(int i, Unit& u) const {
        const long L = (long)i * G + c; if (L >= nwg) return false;
        int wgid = (int)L; { const int q = nwg / NXCD, r = nwg % NXCD, xcd = wgid % NXCD, off = wgid / NXCD; wgid = (xcd < r ? xcd * (q + 1) : r * (q + 1) + (xcd - r) * q) + off; }
        const int nig = WGM * nN, gid = wgid / nig, fm = gid * WGM, gsz = (nM - fm) < WGM ? (nM - fm) : WGM;
        u.pm = fm + ((wgid % nig) % gsz); u.pn = (wgid % nig) / gsz; u.ks = 0; return true;
    }
};
__device__ __forceinline__ unsigned cvt_pk_bf16(float lo, float hi) { return pk2(lo, hi); }

template <class Epi, class Sched, class GC, bool ALIGN_EPI = false, bool SP2 = false>
__device__ __forceinline__ void gemm_phase(LAS unsigned char* lds, const Gemm<GC> g, const Sched& S, const Epi& E) {
    const int tid = otid(), wid = __builtin_amdgcn_readfirstlane(tid >> 6), lane = tid & 63, wr = wid >> 2, wc = wid & 3, fr = lane & 15, fq = lane >> 4;
    constexpr int K = GC::K, nt = K / BK, ksplit = GC::KSPLIT;
    unsigned voffA[2], voffB[2];
#pragma unroll
    for (int i = 0; i < 2; ++i) { int R, C; stage_rc(tid * 16 + i * 8192, R, C); const int Rb = Epi::PERM ? ((R & ~31) + perm32(R & 31)) : R;
        voffA[i] = (unsigned)(R * GC::LDA + C) * 2u; voffB[i] = (unsigned)(Rb * GC::LDB + C) * 2u; }
    constexpr size_t kstep = (size_t)(BK * 2);
    constexpr size_t hstepA = (size_t)HALF * GC::LDA * 2, hstepB = (size_t)HALF * GC::LDB * 2;
    const unsigned ldsw = (unsigned)wid * 1024u;
    const int aoff = lds_byte(wr * 64 + fr, fq * 8), boff = lds_byte(wc * 32 + fr, fq * 8);
#define PG8_SA(b, h) (((b) * 2 + (h)) * HTB)
#define PG8_SB(b, h) ((4 + (b) * 2 + (h)) * HTB)
#define PG8_STAGE(bufoff, gbase, voff) do { _Pragma("unroll") for (int _i = 0; _i < 2; ++_i) \
        __builtin_amdgcn_global_load_lds((const unsigned*)((const char*)(gbase) + (voff)[_i]), (LAS unsigned*)(lds + (bufoff) + ldsw + _i * 8192), 16, 0, 0); } while (0)
#define PG8_LDA(dst, b, h) do { _Pragma("unroll") for (int m = 0; m < 4; ++m) _Pragma("unroll") for (int k = 0; k < 2; ++k) dst[m][k] = *(const LAS bf16x8*)(lds + PG8_SA(b, h) + aoff + m * 2048 + k * 1024); } while (0)
#define PG8_LDB(dst, b, h) do { _Pragma("unroll") for (int n = 0; n < 2; ++n) _Pragma("unroll") for (int k = 0; k < 2; ++k) dst[n][k] = *(const LAS bf16x8*)(lds + PG8_SB(b, h) + boff + n * 2048 + k * 1024); } while (0)
#define PG8_MMA(ai, bj, At, Bt) do { __builtin_amdgcn_s_setprio(1); _Pragma("unroll") for (int m = 0; m < 4; ++m) _Pragma("unroll") for (int n = 0; n < 2; ++n) _Pragma("unroll") for (int k = 0; k < 2; ++k) \
        acc[ai][bj][m][n] = __builtin_amdgcn_mfma_f32_16x16x32_bf16(Bt[n][k], At[m][k], acc[ai][bj][m][n], 0, 0, 0); __builtin_amdgcn_s_setprio(0); } while (0)
#define PG8_WAIT_V(n) asm volatile("s_waitcnt vmcnt(" #n ")" ::: "memory")
#define PG8_WAIT_L(n) asm volatile("s_waitcnt lgkmcnt(" #n ")" ::: "memory")
#define PG8_BAR __builtin_amdgcn_s_barrier()
#define PG8_SCHED __builtin_amdgcn_sched_barrier(0)
    Unit cur, nxt; int ui = 0;
    if (!S.next(0, cur)) return;
    f32x4 acc[2][2][4][2];
#pragma unroll
    for (int a = 0; a < 2; ++a)
#pragma unroll
        for (int b = 0; b < 2; ++b)
#pragma unroll
            for (int m = 0; m < 4; ++m)
#pragma unroll
                for (int n = 0; n < 2; ++n) acc[a][b][m][n] = (f32x4){0.f, 0.f, 0.f, 0.f};
    bf16x8 At[4][2], B0[2][2], B1[2][2];
    const char* cA = g.a_base(cur); const char* cB = g.b_base(cur); long cD = g.a_delta(cur);
    if constexpr (SP2) {
        PG8_STAGE(PG8_SB(0, 0), cB, voffB); PG8_STAGE(PG8_SB(0, 1), cB + hstepB, voffB); PG8_STAGE(PG8_SA(0, 0), cA, voffA); PG8_STAGE(PG8_SA(0, 1), cA + hstepA, voffA);
        if (wr == 1) PG8_BAR;
        PG8_WAIT_V(2); PG8_BAR;
        PG8_STAGE(PG8_SB(1, 0), cB + kstep, voffB); PG8_STAGE(PG8_SA(1, 0), cA + kstep, voffA); PG8_STAGE(PG8_SB(1, 1), cB + hstepB + kstep, voffB);
        PG8_WAIT_V(6); PG8_BAR;
    } else {
        PG8_STAGE(PG8_SB(0, 0), cB, voffB); PG8_STAGE(PG8_SA(0, 0), cA, voffA); PG8_STAGE(PG8_SB(0, 1), cB + hstepB, voffB); PG8_STAGE(PG8_SA(0, 1), cA + hstepA, voffA);
        if (wr == 1) PG8_BAR;
        PG8_WAIT_V(4); PG8_BAR;
        PG8_STAGE(PG8_SB(1, 0), cB + kstep, voffB); PG8_STAGE(PG8_SA(1, 0), cA + kstep, voffA); PG8_STAGE(PG8_SB(1, 1), cB + hstepB + kstep, voffB);
        PG8_WAIT_V(6); PG8_BAR;
    }
    for (;;) {
        const bool has_next = S.next(ui + 1, nxt);
        const char* nA = has_next ? g.a_base(nxt) : cA; const char* nB = has_next ? g.b_base(nxt) : cB;
        const long nD = has_next ? g.a_delta(nxt) : cD;
#pragma unroll 1
        for (int t = 0; t < nt; t += 2) {
            const bool last = (t == nt - 2);
            const char* a1 = cA + (size_t)(t + 1) * kstep + (t >= ksplit ? cD : 0);
            const char* a2 = last ? nA : cA + (size_t)(t + 2) * kstep + (t + 2 >= ksplit ? cD : 0); const char* b2 = last ? nB : cB + (size_t)(t + 2) * kstep;
            const char* a3 = a2 + kstep; const char* b3 = b2 + kstep;
            if constexpr (SP2) {
            PG8_LDB(B0, 0, 0); PG8_LDB(B1, 0, 1); PG8_SCHED; PG8_LDA(At, 0, 0); PG8_STAGE(PG8_SA(1, 1), a1 + hstepA, voffA);
            PG8_WAIT_V(8); PG8_WAIT_L(0); PG8_BAR; PG8_MMA(0, 0, At, B0); PG8_MMA(0, 1, At, B1); PG8_BAR; PG8_SCHED;
            PG8_LDA(At, 0, 1); PG8_STAGE(PG8_SB(0, 0), b2, voffB); PG8_STAGE(PG8_SB(0, 1), b2 + hstepB, voffB); PG8_STAGE(PG8_SA(0, 0), a2, voffA);
            PG8_WAIT_V(8); PG8_WAIT_L(0); PG8_BAR; PG8_MMA(1, 0, At, B0); PG8_MMA(1, 1, At, B1); PG8_BAR; PG8_SCHED;
            PG8_LDB(B0, 1, 0); PG8_LDB(B1, 1, 1); PG8_SCHED; PG8_LDA(At, 1, 0); PG8_STAGE(PG8_SA(0, 1), a2 + hstepA, voffA);
            PG8_WAIT_V(8); PG8_WAIT_L(0); PG8_BAR; PG8_MMA(0, 0, At, B0); PG8_MMA(0, 1, At, B1); PG8_BAR; PG8_SCHED;
            PG8_LDA(At, 1, 1); PG8_STAGE(PG8_SB(1, 0), b3, voffB); PG8_STAGE(PG8_SB(1, 1), b3 + hstepB, voffB); PG8_STAGE(PG8_SA(1, 0), a3, voffA);
            PG8_WAIT_V(8); PG8_WAIT_L(0); PG8_BAR; PG8_MMA(1, 0, At, B0); PG8_MMA(1, 1, At, B1); PG8_BAR; PG8_SCHED;
            } else {
            PG8_LDB(B0, 0, 0); PG8_SCHED; PG8_LDA(At, 0, 0); PG8_STAGE(PG8_SA(1, 1), a1 + hstepA, voffA);
            PG8_WAIT_L(8); PG8_BAR; PG8_WAIT_L(0); PG8_MMA(0, 0, At, B0); PG8_BAR; PG8_SCHED;
            PG8_LDB(B1, 0, 1); PG8_STAGE(PG8_SB(0, 0), b2, voffB);
            PG8_BAR; PG8_WAIT_L(0); PG8_MMA(0, 1, At, B1); PG8_BAR;
            PG8_LDA(At, 0, 1); PG8_STAGE(PG8_SA(0, 0), a2, voffA);
            PG8_BAR; PG8_WAIT_L(0); PG8_MMA(1, 0, At, B0); PG8_BAR; PG8_SCHED;
            PG8_STAGE(PG8_SB(0, 1), b2 + hstepB, voffB);
            PG8_WAIT_V(6); PG8_BAR; PG8_MMA(1, 1, At, B1); PG8_BAR;
            PG8_LDB(B0, 1, 0); PG8_SCHED; PG8_LDA(At, 1, 0); PG8_STAGE(PG8_SA(0, 1), a2 + hstepA, voffA);
            PG8_WAIT_L(8); PG8_BAR; PG8_WAIT_L(0); PG8_MMA(0, 0, At, B0); PG8_BAR; PG8_SCHED;
            PG8_LDB(B1, 1, 1); PG8_STAGE(PG8_SB(1, 0), b3, voffB);
            PG8_BAR; PG8_WAIT_L(0); PG8_MMA(0, 1, At, B1); PG8_BAR;
            PG8_LDA(At, 1, 1); PG8_STAGE(PG8_SA(1, 0), a3, voffA);
            PG8_BAR; PG8_WAIT_L(0); PG8_MMA(1, 0, At, B0); PG8_BAR; PG8_SCHED;
            PG8_STAGE(PG8_SB(1, 1), b3 + hstepB, voffB);
            PG8_WAIT_V(6); PG8_BAR; PG8_MMA(1, 1, At, B1); PG8_BAR;
            }
        }
        if constexpr (ALIGN_EPI) { if (wr == 0) PG8_BAR; }
        E(acc, cur, wr, wc, fr, fq);
        if (!has_next) break;
#pragma unroll
        for (int a = 0; a < 2; ++a)
#pragma unroll
            for (int b = 0; b < 2; ++b)
#pragma unroll
                for (int m = 0; m < 4; ++m)
#pragma unroll
                    for (int n = 0; n < 2; ++n) acc[a][b][m][n] = (f32x4){0.f, 0.f, 0.f, 0.f};
        cur = nxt; cA = nA; cB = nB; cD = nD; ++ui;
        if constexpr (ALIGN_EPI) { if (wr == 1) PG8_BAR; }
    }
    PG8_WAIT_V(0);
    if constexpr (!ALIGN_EPI) { if (wr == 0) PG8_BAR; }
    PG8_BAR;
#undef PG8_SA
#undef PG8_SB
#undef PG8_STAGE
#undef PG8_LDA
#undef PG8_LDB
#undef PG8_MMA
#undef PG8_WAIT_V
#undef PG8_WAIT_L
#undef PG8_BAR
#undef PG8_SCHED
}

__device__ __forceinline__ float act_apply(float v, int act) {
    if (act == 1) { const float r = v > 0.f ? v : 0.f; return r * r; }
    if (act == 2) { const float e = __expf(-2.f * fabsf(v)); const float t = (1.f - e) / (1.f + e); return v < 0.f ? -t : t; }
    if (act == 3) return 1.f / (1.f + __expf(-v));
    return v;
}
template <int ACT> __device__ __forceinline__ void store_tile_bf16(const f32x4 (&acc)[2][2][4][2], bf16_t* base, int ldc, int row0, int col0, bf16_t* base2, int ldc2, int col2) {
#pragma unroll
    for (int ai = 0; ai < 2; ++ai)
#pragma unroll
        for (int m = 0; m < 4; ++m) { const size_t r = (size_t)(row0 + ai * HALF + m * 16);
#pragma unroll
            for (int bj = 0; bj < 2; ++bj) { f32x4 v0 = acc[ai][bj][m][0], v1 = acc[ai][bj][m][1];
#pragma unroll
                for (int q = 0; q < 4; ++q) { v0[q] = act_apply(v0[q], ACT); v1[q] = act_apply(v1[q], ACT); }
                u32x4 w; w.x = cvt_pk_bf16(v0[0], v0[1]); w.y = cvt_pk_bf16(v0[2], v0[3]); w.z = cvt_pk_bf16(v1[0], v1[1]); w.w = cvt_pk_bf16(v1[2], v1[3]);
                *(u32x4*)(base + r * ldc + col0 + bj * HALF) = w;
                if (base2) *(u32x4*)(base2 + r * ldc2 + col2 + bj * HALF) = w; } }
}
template <int ACT> struct EpiBf16 {
    static constexpr bool PERM = true;
    bf16_t* O; int ldc;
    __device__ __forceinline__ void operator()(const f32x4 (&acc)[2][2][4][2], const Unit& u, int wr, int wc, int fr, int fq) const {
        store_tile_bf16<ACT>(acc, O, ldc, u.pm * BM + wr * 64 + fr, u.pn * BM + wc * 32 + 8 * fq, nullptr, 0, 0);
    }
};
struct EpiRkv {
    static constexpr bool PERM = true;
    bf16_t* RKV; bf16_t* LO; bf16_t* vf;
    __device__ __forceinline__ void operator()(const f32x4 (&acc)[2][2][4][2], const Unit& u, int wr, int wc, int fr, int fq) const {
        const int row0 = u.pm * BM + wr * 64 + fr, cin = wc * 32 + 8 * fq;
        if (u.pn < 12) { bf16_t* b2 = (u.pn >= 8) ? vf : nullptr; store_tile_bf16<0>(acc, RKV, 3072, row0, u.pn * BM + cin, b2, 1024, (u.pn - 8) * BM + cin); }
        else {
#pragma unroll
            for (int bj = 0; bj < 2; ++bj) { const int c = cin + bj * HALF; int dst = -1, act = 0;
                if (u.pn == 12) { if (c < 64) { dst = c; act = 2; } else if (c < 128) dst = 256 + (c - 64); else if (c < 160) dst = 512 + (c - 128); }
                else if (c < 160) { dst = 768 + c; act = 3; }
                if (dst >= 0) {
#pragma unroll
                    for (int ai = 0; ai < 2; ++ai)
#pragma unroll
                        for (int m = 0; m < 4; ++m) { const size_t r = (size_t)(row0 + ai * HALF + m * 16); f32x4 v0 = acc[ai][bj][m][0], v1 = acc[ai][bj][m][1];
#pragma unroll
                            for (int q = 0; q < 4; ++q) { v0[q] = act_apply(v0[q], act); v1[q] = act_apply(v1[q], act); }
                            u32x4 w; w.x = cvt_pk_bf16(v0[0], v0[1]); w.y = cvt_pk_bf16(v0[2], v0[3]); w.z = cvt_pk_bf16(v1[0], v1[1]); w.w = cvt_pk_bf16(v1[2], v1[3]);
                            *(u32x4*)(LO + r * 1024 + dst) = w; } } }
        }
    }
};
struct EpiRes {
    static constexpr bool PERM = false;
    float* X; const float* modl; int goff; const float* Xin;
    __device__ __forceinline__ void operator()(const f32x4 (&acc)[2][2][4][2], const Unit& u, int wr, int wc, int fr, int fq) const {
        const int col0 = u.pn * BM + wc * 32 + 4 * fq;
#pragma unroll
        for (int ai = 0; ai < 2; ++ai)
#pragma unroll
            for (int m = 0; m < 4; ++m) { const int r = u.pm * BM + ai * HALF + wr * 64 + m * 16 + fr; const float* gp = modl + (size_t)seq_of_row(r) * 6144 + goff + col0; float* xp = X + (size_t)r * D + col0; const float* xi = Xin + (size_t)r * D + col0;
#pragma unroll
                for (int bj = 0; bj < 2; ++bj)
#pragma unroll
                    for (int n = 0; n < 2; ++n) { const f32x4 gv = *(const f32x4*)(gp + bj * HALF + n * 16); f32x4 xv = *(const f32x4*)(xi + bj * HALF + n * 16);
                        xv = xv + gv * acc[ai][bj][m][n]; *(f32x4*)(xp + bj * HALF + n * 16) = xv; }
                asm volatile("" ::: "memory"); }
    }
};
struct EpiLora2 {
    static constexpr bool PERM = true, AFTER_DRAIN = false;
    bf16_t* WLOG; bf16_t* Aout; bf16_t* G; bf16_t* RKV; const bf16_t* vf; const float* w0; const float* a0; const float* v0;
    template <int GRP> __device__ __forceinline__ void run(const f32x4 (&acc)[2][2][4][2], const Unit& u, int wr, int wc, int fr, int fq) const {
        const int col0 = (u.pn & 3) * BM + wc * 32 + 8 * fq;
#pragma unroll
        for (int ai = 0; ai < 2; ++ai)
#pragma unroll
            for (int m = 0; m < 4; ++m) { const size_t r = (size_t)(u.pm * BM + ai * HALF + wr * 64 + m * 16 + fr);
#pragma unroll
                for (int bj = 0; bj < 2; ++bj) { const int c = col0 + bj * HALF; float a[8], o[8];
#pragma unroll
                    for (int q = 0; q < 4; ++q) { a[q] = acc[ai][bj][m][0][q]; a[4 + q] = acc[ai][bj][m][1][q]; }
                    if constexpr (GRP == 0) { const f32x4 b0 = *(const f32x4*)(w0 + c), b1 = *(const f32x4*)(w0 + c + 4);
#pragma unroll
                        for (int q = 0; q < 8; ++q) { const float x = -((q < 4 ? b0[q & 3] : b1[q & 3]) + a[q]); const float sp = fmaxf(x, 0.f) + __logf(1.f + __expf(-fabsf(x))); o[q] = -__expf(-sp - 0.5f); }
                        u32x4 w; w.x = cvt_pk_bf16(o[0], o[1]); w.y = cvt_pk_bf16(o[2], o[3]); w.z = cvt_pk_bf16(o[4], o[5]); w.w = cvt_pk_bf16(o[6], o[7]); *(u32x4*)(WLOG + r * D + c) = w; }
                    else if constexpr (GRP == 1) { const f32x4 b0 = *(const f32x4*)(a0 + c), b1 = *(const f32x4*)(a0 + c + 4);
#pragma unroll
                        for (int q = 0; q < 8; ++q) o[q] = 1.f / (1.f + __expf(-((q < 4 ? b0[q & 3] : b1[q & 3]) + a[q])));
                        u32x4 w; w.x = cvt_pk_bf16(o[0], o[1]); w.y = cvt_pk_bf16(o[2], o[3]); w.z = cvt_pk_bf16(o[4], o[5]); w.w = cvt_pk_bf16(o[6], o[7]); *(u32x4*)(Aout + r * D + c) = w; }
                    else if constexpr (GRP == 2) { const f32x4 b0 = *(const f32x4*)(v0 + c), b1 = *(const f32x4*)(v0 + c + 4); const u32x4 vv = *(const u32x4*)(RKV + r * 3072 + 2048 + c), ff = *(const u32x4*)(vf + r * D + c);
#pragma unroll
                        for (int q = 0; q < 8; ++q) { const float vx = (q & 1) ? bfhi(vv[q >> 1]) : bflo(vv[q >> 1]), fx = (q & 1) ? bfhi(ff[q >> 1]) : bflo(ff[q >> 1]);
                            const float gte = 1.f / (1.f + __expf(-((q < 4 ? b0[q & 3] : b1[q & 3]) + a[q]))); o[q] = vx + (fx - vx) * gte; }
                        u32x4 w; w.x = cvt_pk_bf16(o[0], o[1]); w.y = cvt_pk_bf16(o[2], o[3]); w.z = cvt_pk_bf16(o[4], o[5]); w.w = cvt_pk_bf16(o[6], o[7]); *(u32x4*)(RKV + r * 3072 + 2048 + c) = w; }
                    else { u32x4 w; w.x = cvt_pk_bf16(a[0], a[1]); w.y = cvt_pk_bf16(a[2], a[3]); w.z = cvt_pk_bf16(a[4], a[5]); w.w = cvt_pk_bf16(a[6], a[7]); *(u32x4*)(G + r * D + c) = w; } }
                asm volatile("" ::: "memory"); }
    }
    __device__ __forceinline__ void operator()(const f32x4 (&acc)[2][2][4][2], const Unit& u, int wr, int wc, int fr, int fq) const {
        const int grp = u.pn >> 2;
        if (grp == 0) run<0>(acc, u, wr, wc, fr, fq);
        else if (grp == 1) run<1>(acc, u, wr, wc, fr, fq);
        else if (grp == 2) { if (vf != nullptr) run<2>(acc, u, wr, wc, fr, fq); }
        else run<3>(acc, u, wr, wc, fr, fq);
    }
};
struct SplitOrder {
    int c, splitk;
    __device__ bool next(int i, Unit& u) const { if (i != 0 || c >= 16 * splitk) return false; const int t = c / splitk; u.pm = 64 + (t >> 2); u.pn = t & 3; u.ks = c % splitk; return true; }
};
struct SkipVOrder {
    StaticOrder S; bool skip;
    __device__ bool next(int i, Unit& u) const { if (!S.next(i, u)) return false; if (skip && u.pn >= 8) u.pn += 4; return true; }
};
struct LoraOrder {
    int c;
    __device__ bool next(int i, Unit& u) const { const int idx = c - 48; if (i != 0 || idx < 0 || idx >= 136) return false; u.pm = idx >> 1; u.pn = 12 + (idx & 1); u.ks = 0; return true; }
};
struct EpiPartial {
    static constexpr bool PERM = false;
    float* PART; int splitk;
    __device__ __forceinline__ void operator()(const f32x4 (&acc)[2][2][4][2], const Unit& u, int wr, int wc, int fr, int fq) const {
        float* base = PART + ((size_t)(((u.pm - 64) * 4 + u.pn) * splitk + u.ks) << 16) + wc * 32 + 4 * fq;
#pragma unroll
        for (int ai = 0; ai < 2; ++ai)
#pragma unroll
            for (int m = 0; m < 4; ++m) { float* rp = base + (ai * HALF + wr * 64 + m * 16 + fr) * 256;
#pragma unroll
                for (int bj = 0; bj < 2; ++bj)
#pragma unroll
                    for (int n = 0; n < 2; ++n) *(f32x4*)(rp + bj * HALF + n * 16) = acc[ai][bj][m][n]; }
    }
};
template <bool PERM_> struct EpiNull {
    static constexpr bool PERM = PERM_;
    __device__ __forceinline__ void operator()(const f32x4 (&acc)[2][2][4][2], const Unit&, int, int, int, int) const {
#pragma unroll
        for (int a = 0; a < 2; ++a)
#pragma unroll
            for (int b = 0; b < 2; ++b)
#pragma unroll
                for (int m = 0; m < 4; ++m)
#pragma unroll
                    for (int n = 0; n < 2; ++n) asm volatile("" :: "v"(acc[a][b][m][n]));
    }
};
}

#define RLX_AGENT __ATOMIC_RELAXED, __HIP_MEMORY_SCOPE_AGENT
#define XB_TMO      128
#define XB_XCNT(j)  (256  + 64 * (j))
#define XB_XSUB(j)  (1280 + 64 * (j))
#define XB_XGEN(j)  (2304 + 64 * (j))
#define XB_TOP      3328
#define XB_TOPGEN   3392
#define XCD_BAR_WORDS 3456
#define XB_SPIN_CAP (1u << 24)
__device__ __forceinline__ unsigned xb_ld(unsigned* p)              { return __hip_atomic_load(p, __ATOMIC_RELAXED, __HIP_MEMORY_SCOPE_AGENT); }
__device__ __forceinline__ unsigned xb_add(unsigned* p, unsigned v) { return __hip_atomic_fetch_add(p, v, __ATOMIC_RELAXED, __HIP_MEMORY_SCOPE_AGENT); }
__device__ __forceinline__ unsigned xb_xcc_id() { return (unsigned)__builtin_amdgcn_s_getreg((3 << 11) | 20) & 0xFu; }
#define XB_SPIN(cond, bar) do { unsigned _sp = 0; while (cond) { __builtin_amdgcn_s_sleep(4); \
    if ((++_sp & 255u) == 0u) { if (xb_ld(&(bar)[XB_TMO])) break; if (_sp > XB_SPIN_CAP) { atomicAdd(&(bar)[XB_TMO], 1u); break; } } } } while (0)
struct XcdBarrier { unsigned* bar; unsigned x; volatile LAS unsigned* st; };
__device__ __forceinline__ XcdBarrier xcd_barrier_post(unsigned* bar, volatile LAS unsigned* st) {
    XcdBarrier b; b.bar = bar; b.x = xb_xcc_id(); b.st = st;
    if (threadIdx.x == 0) (void)xb_add(&bar[XB_XCNT(b.x)], 1u);
    return b;
}
__device__ __forceinline__ void xcd_barrier_complete(unsigned* bar, unsigned x, unsigned& nloc, unsigned& nx) {
    const unsigned G = gridDim.x * gridDim.y * gridDim.z;
    unsigned sum, cnt, mine, sp = 0u;
    for (;;) {
        sum = 0u; cnt = 0u; mine = 0u;
#pragma unroll
        for (unsigned j = 0; j < 16; ++j) { const unsigned c = xb_ld(&bar[XB_XCNT(j)]); sum += c; cnt += (c > 0u) ? 1u : 0u; mine = (j == x) ? c : mine; }
        if (sum == G) break;
        __builtin_amdgcn_s_sleep(1);
        if ((++sp & 255u) == 0u) { if (xb_ld(&bar[XB_TMO])) break; if (sp > XB_SPIN_CAP) { atomicAdd(&bar[XB_TMO], 1u); break; } }
    }
    nloc = mine > 0u ? mine : 1u; nx = cnt > 0u ? cnt : 1u;
}
__device__ __forceinline__ void xcd_barrier(const XcdBarrier& b) {
    asm volatile("s_waitcnt vmcnt(0)" ::: "memory");
    __syncthreads();
    if (threadIdx.x == 0) {
        unsigned* bar = b.bar;
        __builtin_amdgcn_s_waitcnt(0);
        unsigned nloc = b.st[0], nx = b.st[1];
        if (nloc == 0u) { xcd_barrier_complete(bar, b.x, nloc, nx); b.st[0] = nloc; b.st[1] = nx; }
        const unsigned gen = b.st[2];
        const unsigned old = xb_add(&bar[XB_XSUB(b.x)], 1u);
        if (old + 1u == (gen + 1u) * nloc) {
            __builtin_amdgcn_fence(__ATOMIC_RELEASE, "agent");
            asm volatile("s_waitcnt vmcnt(0)" ::: "memory");
            const unsigned og = xb_add(&bar[XB_TOP], 1u);
            if (og + 1u == (gen + 1u) * nx) xb_add(&bar[XB_TOPGEN], 1u);
            else XB_SPIN(xb_ld(&bar[XB_TOPGEN]) == gen, bar);
        } else {
            XB_SPIN(xb_ld(&bar[XB_TOPGEN]) == gen, bar);
        }
        __builtin_amdgcn_fence(__ATOMIC_ACQUIRE, "agent");
        asm volatile("s_waitcnt vmcnt(0)" ::: "memory");
        b.st[2] = gen + 1u;
    }
    __syncthreads();
}

constexpr int NWAVES = 8, NT = NWAVES * 64;
constexpr int RING_BYTES = 131072, LDSCTL_OFF = RING_BYTES, MISC_OFF = LDSCTL_OFF + 320, LDS_BYTES = 147456;
constexpr int CW_BAR = 4096;

struct Args { const float* in[38]; float* out; unsigned char* ws; };
struct Frame {
    LAS unsigned char* lds; volatile LAS unsigned* MISC;
    int wave, vcu, G;
    const float* const* in; float* out; unsigned char* ws;
};
enum { I_XP = 0, I_XS, I_SRET, I_SHG, I_SWKV, I_SSHIFT, I_CP, I_CS, I_MODW, I_MODB, I_NMIXG, I_NMLPG, I_FINALG, I_W1, I_W2, I_ABWIN, I_ABWOUT, I_HGLB, I_HGNG,
       I_MU, I_WRKV, I_RW0, I_RW1, I_RW2, I_RA0, I_RA1, I_RA2, I_RV0, I_RV1, I_RV2, I_RG1, I_RG2, I_RKK, I_RKA, I_RRK, I_RLNG, I_RLNB, I_RWOUT };
constexpr size_t O_Y = 0, O_RETP = 17825792, O_RETS = 17891328, O_HGP = 19988480, O_HGS = 20119552, O_WKVP = 24313856, O_WKVS = 24444928, O_SHP = 28639232, O_SHS = 28641280;

__device__ __forceinline__ void transpose_item(const float* W, int N, bf16_t* WT, int ldt, int row_off, int col_off, const float* mu, int mode, LAS float* scr, int item, int lane) {
    const int nblk = N / 32, kb = item / nblk, nb = item % nblk, k0 = 64 * kb, n0 = 32 * nb;
#pragma unroll 8
    for (int i = 0; i < 32; ++i) { const int kk = 2 * i + (lane >> 5); float s = 1.f; if (mode == 1) s = 1.f - mu[k0 + kk]; else if (mode == 2) s = mu[k0 + kk];
        scr[kk * 33 + (lane & 31)] = W[(size_t)(k0 + kk) * N + n0 + (lane & 31)] * s; }
    LDS_WAIT(); asm volatile("" ::: "memory");
    const int c = lane & 7;
#pragma unroll
    for (int j = 0; j < 4; ++j) { const int n = (lane >> 3) + 8 * j; const LAS float* s = scr + (8 * c) * 33 + n;
        u32x4 o; o.x = pk2(s[0 * 33], s[1 * 33]); o.y = pk2(s[2 * 33], s[3 * 33]); o.z = pk2(s[4 * 33], s[5 * 33]); o.w = pk2(s[6 * 33], s[7 * 33]);
        *(u32x4*)(WT + (size_t)(row_off + n0 + n) * ldt + col_off + k0 + 8 * c) = o; }
    LDS_WAIT(); asm volatile("" ::: "memory");
}
__device__ __forceinline__ void convert_layer_weights(Frame& F, int layer) {
    const int tid = otid(); const int lane = tid & 63; (void)lane;
    LAS float* scr = (LAS float*)(F.lds + F.wave * 16384);
    const int gw = F.vcu * NWAVES + F.wave, NGW = F.G * NWAVES;
    unsigned char* ar = F.ws + WS_ARENA;
    const int m = layer >> 1;
    constexpr int I_1 = (D / 64) * (DFF / 32), I_2 = (DFF / 64) * (D / 32);
    const float* w1 = F.in[I_W1] + (size_t)layer * D * DFF; const float* w2 = F.in[I_W2] + (size_t)layer * DFF * D;
    if ((layer & 1) == 0) {
        constexpr int I_IN = (D / 64) * (ABIN / 32), I_OUT = (D / 64) * (D / 32), NI = I_1 + I_2 + I_IN + I_OUT;
        const float* win = F.in[I_ABWIN] + (size_t)m * D * ABIN; const float* wout = F.in[I_ABWOUT] + (size_t)m * D * D;
        for (int it = gw; it < NI; it += NGW) { int r = it;
            if (r < I_1) { transpose_item(w1, DFF, (bf16_t*)(ar + AR_W1), D, 0, 0, nullptr, 0, scr, r, lane); continue; } r -= I_1;
            if (r < I_2) { transpose_item(w2, D, (bf16_t*)(ar + AR_W2), DFF, 0, 0, nullptr, 0, scr, r, lane); continue; } r -= I_2;
            if (r < I_IN) { transpose_item(win, ABIN, (bf16_t*)(ar + AR_WIN), D, 0, 0, nullptr, 0, scr, r, lane); continue; } r -= I_IN;
            transpose_item(wout, D, (bf16_t*)(ar + AR_WOUT), D, 0, 0, nullptr, 0, scr, r, lane); }
    } else {
        constexpr int I_P = (D / 64) * (D / 32), NI = I_1 + I_2 + 4 * I_P;
        const float* mu = F.in[I_MU] + (size_t)m * 6 * D; const float* wrkv = F.in[I_WRKV] + (size_t)m * 3 * D * D; const float* wo = F.in[I_RWOUT] + (size_t)m * D * D;
        bf16_t* wc1 = (bf16_t*)(ar + AR_WC1);
        for (int it = gw; it < NI; it += NGW) { int r = it;
            if (r < I_1) { transpose_item(w1, DFF, (bf16_t*)(ar + AR_W1), D, 0, 0, nullptr, 0, scr, r, lane); continue; } r -= I_1;
            if (r < I_2) { transpose_item(w2, D, (bf16_t*)(ar + AR_W2), DFF, 0, 0, nullptr, 0, scr, r, lane); continue; } r -= I_2;
            if (r < 3 * I_P) { const int p = r / I_P;
                transpose_item(wrkv + (size_t)p * D * D, D, wc1, 2048, p * D, 0, nullptr, 0, scr, r % I_P, lane); continue; } r -= 3 * I_P;
            transpose_item(wo, D, (bf16_t*)(ar + AR_WO), D, 0, 0, nullptr, 0, scr, r, lane); }
        const int gt = F.vcu * NT + tid, NG = F.G * NT;
        const float* lw1 = F.in[I_RW1] + (size_t)m * D * 64; const float* la1 = F.in[I_RA1] + (size_t)m * D * 64; const float* lv1 = F.in[I_RV1]; const float* lg1 = F.in[I_RG1] + (size_t)m * D * 160;
        for (int idx = gt; idx < 512 * 2048; idx += NG) { const int n = idx >> 11, k = idx & 2047, kk = k & 1023, nn = n & 255;
            const float* src = nullptr; int ns = 0, mi = 0, nc = 0;
            if (n < 256) { if (nn < 64) { src = lw1; ns = 64; mi = 1; nc = nn; } else if (nn < 128) { src = la1; ns = 64; mi = 4; nc = nn - 64; } else if (nn < 160 && m == 1) { src = lv1; ns = 32; mi = 3; nc = nn - 128; } }
            else if (nn < 160) { src = lg1; ns = 160; mi = 5; nc = nn; }
            float v = 0.f; if (src) { const float muv = mu[mi * D + kk]; v = src[(size_t)kk * ns + nc] * (k < 1024 ? 1.f - muv : muv); }
            wc1[(size_t)(3072 + n) * 2048 + k] = (bf16_t)f2bf(v); }
        bf16_t* wc2 = (bf16_t*)(ar + AR_WC2);
        const float* lw2 = F.in[I_RW2] + (size_t)m * 64 * D; const float* la2 = F.in[I_RA2] + (size_t)m * 64 * D; const float* lv2 = F.in[I_RV2]; const float* lg2 = F.in[I_RG2] + (size_t)m * 160 * D;
        for (int idx = gt; idx < 4096 * 256; idx += NG) { const int k = idx >> 12, n = idx & 4095, g = n >> 10, nn = n & 1023;
            const float* src = (g == 0) ? lw2 : (g == 1) ? la2 : (g == 2) ? lv2 : lg2; const int ks = (g == 0 || g == 1) ? 64 : (g == 2 ? 32 : 160);
            float v = 0.f; if (k < ks && !(g == 2 && m == 0)) v = src[(size_t)k * D + nn];
            wc2[(size_t)n * 256 + k] = (bf16_t)f2bf(v); }
    }
}

__device__ __forceinline__ void mod_phase(Frame& F, int l_lo, int l_hi, int wb, int nb) {
    const int tid = otid(); const int lane = tid & 63;
    const float* __restrict__ SC = (const float*)(F.ws + WS_MOD + 3584 * 1024);
    float* MOD = (float*)(F.ws + WS_MOD);
    LAS float* red = (LAS float*)F.lds;
    for (int task = l_lo * 96 + wb; task < l_hi * 96; task += nb) { const int l = task / 96, n = (task % 96) * 64 + lane, ks = F.wave;
        const float* w = F.in[I_MODW] + ((size_t)l * D + ks * 128) * 6144 + n;
        float acc[NSEQ];
#pragma unroll
        for (int s = 0; s < NSEQ; ++s) acc[s] = 0.f;
        for (int k = 0; k < 128; k += 4) { const float w0 = w[(size_t)k * 6144], w1 = w[(size_t)(k + 1) * 6144], w2 = w[(size_t)(k + 2) * 6144], w3 = w[(size_t)(k + 3) * 6144];
#pragma unroll
            for (int s = 0; s < NSEQ; ++s) { const f32x4 c4 = *(const f32x4*)(SC + s * D + ks * 128 + k); acc[s] += (c4[0] * w0 + c4[1] * w1) + (c4[2] * w2 + c4[3] * w3); } }
        __syncthreads();
#pragma unroll
        for (int s = 0; s < NSEQ; ++s) red[(F.wave * NSEQ + s) * 64 + lane] = acc[s];
        __syncthreads();
        for (int i = tid; i < NSEQ * 64; i += NT) { const int s = i >> 6, c = i & 63; float t = F.in[I_MODB][l * 6144 + (task % 96) * 64 + c];
#pragma unroll
            for (int q = 0; q < 8; ++q) t += red[(q * NSEQ + s) * 64 + c];
            MOD[((size_t)l * NSEQ + s) * 6144 + (task % 96) * 64 + c] = t; }
    }
    __syncthreads();
}

__device__ __forceinline__ void prologue(Frame& F) {
    const int tid = otid(); const int lane = tid & 63; (void)lane;
    const int gt = F.vcu * NT + tid, NG = F.G * NT;
    { f32x2* tab = (f32x2*)(F.ws + WS_ROPE);
      for (int i = gt; i < 16384 * 32; i += NG) { const int p = i >> 5, d = i & 31; double rev = (double)p * ROPE_REV[d]; rev -= floor(rev); const float fr = (float)rev;
          tab[i] = (f32x2){__builtin_amdgcn_cosf(fr), __builtin_amdgcn_sinf(fr)}; } }
    { unsigned* z = (unsigned*)(F.ws + WS_XN0); for (int i = gt; i < 512; i += NG) z[i] = 0u; }
    { float* SC = (float*)(F.ws + WS_MOD + 3584 * 1024);
      for (int i = gt; i < NSEQ * D; i += NG) { const int s = i >> 10, k = i & 1023; const float c = (s == 0) ? F.in[I_CP][k] : F.in[I_CS][(size_t)(s - 1) * D + k]; SC[i] = siluf_(c); } }
    convert_layer_weights(F, 0);
}

template <int MODE> __device__ __forceinline__ void norm_row(Frame& F, int layer, int r, f32x4 (&v)[4], const float* MOD, const float* gvec, int lane, f32x4 (&ho)[4]) {
    const int m = layer >> 1; const int shoff = (MODE == 2) ? 3072 : 0, scoff = (MODE == 2) ? 4096 : 1024;
    bf16_t* XN = (bf16_t*)(F.ws + WS_XN); bf16_t* PREVS = (bf16_t*)(F.ws + WS_PREVS);
    float* xrow = F.out + (size_t)r * D; float s2 = 0.f;
#pragma unroll
    for (int j = 0; j < 4; ++j) s2 += (v[j].x * v[j].x + v[j].y * v[j].y) + (v[j].z * v[j].z + v[j].w * v[j].w);
    const float rstd = 1.f / sqrtf(wave_sum(s2) * (1.f / D) + NORM_EPS);
    const int seq = seq_of_row(r); const float* mp = MOD + (size_t)seq * 6144;
#pragma unroll
    for (int j = 0; j < 4; ++j) { const int c = 4 * lane + 256 * j; const f32x4 g4 = *(const f32x4*)(gvec + c); f32x4 o = v[j] * rstd * g4;
        if (MODE == 3) { *((f32x4*)xrow + lane + 64 * j) = o; continue; }
        const f32x4 sc = *(const f32x4*)(mp + scoff + c), sh = *(const f32x4*)(mp + shoff + c);
        o = o * (1.f + sc) + sh; ho[j] = o;
        const unsigned long long pk = (unsigned long long)pk2(o.x, o.y) | ((unsigned long long)pk2(o.z, o.w) << 32);
        *(unsigned long long*)(XN + (size_t)r * D + c) = pk;
        if (MODE == 1) {
            if (r >= MP) { const int t = (r - MP) & 31; if (t < 31) *(unsigned long long*)(PREVS + (size_t)(r - MP + 1) * D + c) = pk;
                else *(f32x4*)(F.out + O_SHS + ((size_t)m * 32 + ((r - MP) >> 5)) * D + c) = o;
                if (t == 0) { const f32x4 ss = *(const f32x4*)(F.in[I_SSHIFT] + ((size_t)m * 32 + ((r - MP) >> 5)) * D + c);
                    *(unsigned long long*)(PREVS + (size_t)(r - MP) * D + c) = (unsigned long long)pk2(ss.x, ss.y) | ((unsigned long long)pk2(ss.z, ss.w) << 32); } }
            else if (r == MP - 1) *(f32x4*)(F.out + O_SHP + (size_t)m * D + c) = o;
        } }
}
__device__ __forceinline__ void hmix_calc(const float* mp, const float* gvec, const f32x4 (&v)[4], int lane, f32x4 (&h)[4]) {
    float s2 = 0.f;
#pragma unroll
    for (int j = 0; j < 4; ++j) s2 += (v[j].x * v[j].x + v[j].y * v[j].y) + (v[j].z * v[j].z + v[j].w * v[j].w);
    const float rstd = 1.f / sqrtf(wave_sum(s2) * (1.f / D) + NORM_EPS);
#pragma unroll
    for (int j = 0; j < 4; ++j) { const int c = 4 * lane + 256 * j; const f32x4 g4 = *(const f32x4*)(gvec + c), sc = *(const f32x4*)(mp + 1024 + c), sh = *(const f32x4*)(mp + c); h[j] = v[j] * rstd * g4 * (1.f + sc) + sh; }
}
__device__ __forceinline__ void write_mixes(Frame& F, int m, int r, const f32x4 (&h)[4], const f32x4 (&p)[4], int lane) {
    bf16_t* XM = (bf16_t*)(F.ws + WS_XMIX); const float* mu = F.in[I_MU] + (size_t)m * 6 * D;
#pragma unroll
    for (int j = 0; j < 4; ++j) { const int c = 4 * lane + 256 * j; const f32x4 d = p[j] - h[j];
#pragma unroll
        for (int q = 0; q < 3; ++q) { const f32x4 mv = *(const f32x4*)(mu + (q == 0 ? 0 : (q == 1 ? 2 : 3)) * D + c); const f32x4 x = h[j] + d * mv;
            *(unsigned long long*)(XM + ((size_t)q * M + r) * D + c) = (unsigned long long)pk2(x.x, x.y) | ((unsigned long long)pk2(x.z, x.w) << 32); } }
}
template <int MODE, int PEND = 0, bool FIRSTP = false> __device__ __forceinline__ void norm_pass(Frame& F, int layer, int player, int pgoff, const float* sx_in, float* sx_out) {
    const int tid = otid(); const int lane = tid & 63;
    const int gw = F.vcu * NWAVES + F.wave, NGW = F.G * NWAVES;
    const float* MOD = (const float*)(F.ws + WS_MOD) + (size_t)layer * NSEQ * 6144;
    const float* gvec = (MODE == 3) ? F.in[I_FINALG] : (MODE == 2 ? F.in[I_NMLPG] + layer * D : F.in[I_NMIXG] + layer * D);
    constexpr int HALO = (MODE == 1) ? 1 : 0;
    LAS float* xs = (LAS float*)F.lds;
    const int m = layer >> 1; const int r0s = MP + 4 * F.vcu;
    const float* gmod = (const float*)(F.ws + WS_MOD) + (size_t)player * NSEQ * 6144 + pgoff;
    if constexpr (PEND > 0) {
        __syncthreads();
#pragma unroll
        for (int q = 0; q < (4 + HALO + 1) / 2; ++q) { const int idx = tid + q * NT, rr = idx >> 8, c4 = (idx & 255) * 4; const int r = r0s - HALO + rr;
            if (rr < 4 + HALO && !(HALO && rr == 0 && ((r0s - MP) & 31) == 0)) {
                const int pn = c4 >> 8; const float* pb = (const float*)(F.ws + WS_PART) + ((size_t)((((r >> 8) - 64) * 4 + pn) * PEND) << 16) + (r & 255) * 256 + (c4 & 255);
                f32x4 acc = (f32x4){0.f, 0.f, 0.f, 0.f};
#pragma unroll
                for (int ks = 0; ks < PEND; ++ks) acc += *(const f32x4*)(pb + ((size_t)ks << 16));
                const f32x4 g4 = *(const f32x4*)(gmod + (size_t)seq_of_row(r) * 6144 + c4); f32x4 x4 = *(const f32x4*)(sx_in + (size_t)(r - MP) * D + c4);
                x4 = x4 + g4 * acc; if (sx_out != nullptr && !(HALO && rr == 0)) *(f32x4*)(sx_out + (size_t)(r - MP) * D + c4) = x4; *(LAS f32x4*)(xs + rr * 1024 + c4) = x4; } }
        __syncthreads();
    }
    for (int r = gw; r < MP; r += NGW) {
        const f32x4* xr = (const f32x4*)((FIRSTP ? F.in[I_XP] : F.out) + (size_t)r * D) + lane; f32x4 v[4], ho[4];
#pragma unroll
        for (int j = 0; j < 4; ++j) v[j] = xr[64 * j];
        if constexpr (MODE == 1) { f32x4 pv[4], hp[4];
#pragma unroll
            for (int j = 0; j < 4; ++j) pv[j] = (r > 0) ? *((const f32x4*)(F.out + (size_t)(r - 1) * D) + lane + 64 * j) : (f32x4){0.f, 0.f, 0.f, 0.f};
            norm_row<MODE>(F, layer, r, v, MOD, gvec, lane, ho);
            if (r > 0) hmix_calc(MOD, gvec, pv, lane, hp); else {
#pragma unroll
                for (int j = 0; j < 4; ++j) hp[j] = (f32x4){0.f, 0.f, 0.f, 0.f}; }
            write_mixes(F, m, r, ho, hp, lane);
        } else norm_row<MODE>(F, layer, r, v, MOD, gvec, lane, ho);
    }
    if (F.wave < 4 && 4 * F.vcu + F.wave < MS) { const int r = r0s + F.wave; f32x4 v[4], ho[4];
#pragma unroll
        for (int j = 0; j < 4; ++j) { if constexpr (PEND > 0) v[j] = *(const LAS f32x4*)(xs + (F.wave + HALO) * 1024 + 4 * lane + 256 * j); else v[j] = *((const f32x4*)(sx_in + (size_t)(r - MP) * D) + lane + 64 * j); }
        norm_row<MODE>(F, layer, r, v, MOD, gvec, lane, ho);
        if constexpr (MODE == 1) { f32x4 hp[4]; const int t = (r - MP) & 31, sq = (r - MP) >> 5;
            if (t == 0) {
#pragma unroll
                for (int j = 0; j < 4; ++j) hp[j] = *((const f32x4*)(F.in[I_SSHIFT] + ((size_t)m * 32 + sq) * D) + lane + 64 * j);
            } else { f32x4 pv[4];
#pragma unroll
                for (int j = 0; j < 4; ++j) pv[j] = *(const LAS f32x4*)(xs + (F.wave + HALO - 1) * 1024 + 4 * lane + 256 * j);
                hmix_calc(MOD + (size_t)(1 + sq) * 6144, gvec, pv, lane, hp); }
            write_mixes(F, m, r, ho, hp, lane); } }
}

template <int MT, int NTT> __device__ __forceinline__ void wave_mm_nt(f32x4 (&acc)[MT][NTT], const LAS bf16_t* X, int ldx, const LAS bf16_t* Y, int ldy, int K, int fr, int fq) {
    for (int k0 = 0; k0 < K; k0 += 32) {
        bf16x8 xa[MT], yb[NTT];
#pragma unroll
        for (int i = 0; i < MT; ++i) xa[i] = *(const LAS bf16x8*)(X + (16 * i + fr) * ldx + k0 + 8 * fq);
#pragma unroll
        for (int j = 0; j < NTT; ++j) yb[j] = *(const LAS bf16x8*)(Y + (16 * j + fr) * ldy + k0 + 8 * fq);
#pragma unroll
        for (int i = 0; i < MT; ++i)
#pragma unroll
            for (int j = 0; j < NTT; ++j) acc[i][j] = __builtin_amdgcn_mfma_f32_16x16x32_bf16(yb[j], xa[i], acc[i][j], 0, 0, 0);
    }
}

constexpr int LQS = 0, LKS = 18432, LQG = 36864, LVT = 55296, LST = 73728, LPS = 108544, LRED = 117760, LBS = 118784;
__device__ __forceinline__ void chunk_geom(int c, int& r0, int& pos0) { if (c < 256) { r0 = 64 * c; pos0 = 64 * c; } else { r0 = MP + 32 * (c - 256); pos0 = 2048; } }

template <int L, bool HG, bool SUMMARY> __device__ __forceinline__ void ab_load(Frame& F, int layer, int c, int h) {
    const int tid = otid(); const int lane = tid & 63; (void)lane;
    const int m = layer >> 1; int r0, pos0; chunk_geom(c, r0, pos0);
    const bf16_t* Z = (const bf16_t*)(F.ws + WS_Z);
    LAS bf16_t* QS = (LAS bf16_t*)(F.lds + LQS); LAS bf16_t* KS = (LAS bf16_t*)(F.lds + LKS); LAS bf16_t* QG = (LAS bf16_t*)(F.lds + LQG); LAS bf16_t* VT = (LAS bf16_t*)(F.lds + LVT);
    constexpr int LDT = L + 8;
    if constexpr (HG) {
        constexpr int TQ = L / 4; LAS float* BS = (LAS float*)(F.lds + LBS);
        const int ch = tid & 127, qtr = tid >> 7;
        float lb = 0.f;
        if (m == 1) { const float a0 = F.in[I_HGLB][h * 128 + ch], a1 = F.in[I_HGLB][512 + h * 128 + ch]; lb = 1.f / (1.f + __expf(a0 - a1)); }
        { constexpr int NP = L * 16;
#pragma unroll
          for (int q = 0; q < (NP + NT - 1) / NT; ++q) { const int v = tid + q * NT; if (NP % NT == 0 || v < NP) { const int j = v >> 4, c8 = v & 15; const size_t zr = (size_t)(r0 + j) * ABIN + h * 128 + c8 * 8;
                  const u32x4 zf4 = *(const u32x4*)(Z + zr + 2048), v4 = *(const u32x4*)(Z + zr + 2560);
                  *(LAS u32x4*)(QG + j * 136 + c8 * 8) = zf4; *(LAS u32x4*)(KS + j * 136 + c8 * 8) = v4;
                  if constexpr (!SUMMARY) { const u32x4 q4 = *(const u32x4*)(Z + zr + 1536); *(LAS u32x4*)(QS + j * 136 + c8 * 8) = q4; } } } }
        __syncthreads();
        float zf[TQ], cs[TQ]; float run = 0.f;
#pragma unroll
        for (int jj = 0; jj < TQ; ++jj) { const int j = qtr * TQ + jj; zf[jj] = bf2f(QG[j * 136 + ch]);
            float lf; if (lb == 0.f) lf = fminf(zf[jj], 0.f) - __logf(1.f + __expf(-fabsf(zf[jj]))); else lf = __logf(lb + (1.f - lb) * sigmoidf_(zf[jj]));
            run += lf; cs[jj] = run; }
        BS[qtr * 128 + ch] = run;
        __syncthreads();
        const float b0 = BS[ch], b1 = BS[128 + ch], b2 = BS[256 + ch], b3 = BS[384 + ch];
        const float off = (qtr > 0 ? b0 : 0.f) + (qtr > 1 ? b1 : 0.f) + (qtr > 2 ? b2 : 0.f), bL = (b0 + b1) + (b2 + b3), bmid = b0 + b1;
        if constexpr (SUMMARY) {
#pragma unroll
            for (int j8 = 0; j8 < TQ; j8 += 8) { unsigned vv[8]; float kd[8];
#pragma unroll
                for (int q = 0; q < 8; ++q) { const int jj = j8 + q, j = qtr * TQ + jj; const float b = off + cs[jj]; const float kb = (1.f - lb) * sigmoidf_(-zf[jj]); vv[q] = KS[j * 136 + ch]; kd[q] = kb * __expf(bL - b); }
                u32x4 pv, pk; pv.x = vv[0] | (vv[1] << 16); pv.y = vv[2] | (vv[3] << 16); pv.z = vv[4] | (vv[5] << 16); pv.w = vv[6] | (vv[7] << 16);
                pk.x = pk2(kd[0], kd[1]); pk.y = pk2(kd[2], kd[3]); pk.z = pk2(kd[4], kd[5]); pk.w = pk2(kd[6], kd[7]);
                *(LAS u32x4*)(VT + ch * LDT + qtr * TQ + j8) = pv; *(LAS u32x4*)(QS + ch * LDT + qtr * TQ + j8) = pk; }
            if (qtr == 0) ((float*)(F.ws + WS_DEC))[((size_t)c * 4 + h) * 128 + ch] = __expf(bL);
        } else {
#pragma unroll
            for (int j8 = 0; j8 < TQ; j8 += 8) { unsigned vv[8];
#pragma unroll
                for (int q8 = 0; q8 < 8; ++q8) { const int jj = j8 + q8, j = qtr * TQ + jj; const float b = off + cs[jj]; const float kb = (1.f - lb) * sigmoidf_(-zf[jj]);
                    const float q = siluf_(bf2f(QS[j * 136 + ch])); vv[q8] = KS[j * 136 + ch];
                    QS[j * 136 + ch] = (bf16_t)f2bf(q * __expf(b - bmid)); KS[j * 136 + ch] = (bf16_t)f2bf(kb * __expf(bmid - b)); QG[j * 136 + ch] = (bf16_t)f2bf(q * __expf(b)); }
                u32x4 pv; pv.x = vv[0] | (vv[1] << 16); pv.y = vv[2] | (vv[3] << 16); pv.z = vv[4] | (vv[5] << 16); pv.w = vv[6] | (vv[7] << 16);
                *(LAS u32x4*)(VT + ch * LDT + qtr * TQ + j8) = pv; }
        }
    } else {
        const float logg = log1pf(-exp2f(-5.f - (float)h));
        const f32x2* rope = (const f32x2*)(F.ws + WS_ROPE);
        for (int it = tid; it < L * 4; it += NT) { const int j = it >> 2, d8 = it & 3; const size_t zr = (size_t)(r0 + j) * ABIN;
            const f32x2* rp = rope + (size_t)(pos0 + j) * 32 + d8 * 8;
            const u32x4 k1 = *(const u32x4*)(Z + zr + 256 + h * 64 + d8 * 8), k2 = *(const u32x4*)(Z + zr + 256 + h * 64 + 32 + d8 * 8);
            const float gk = __expf((float)(L - 1 - j) * logg), gq = __expf((float)(j + 1) * logg);
            u32x4 q1 = (u32x4){0, 0, 0, 0}, q2 = q1; if constexpr (!SUMMARY) { q1 = *(const u32x4*)(Z + zr + h * 64 + d8 * 8); q2 = *(const u32x4*)(Z + zr + h * 64 + 32 + d8 * 8); }
#pragma unroll
            for (int e = 0; e < 8; ++e) { const f32x2 cs_ = rp[e]; const unsigned wk1 = k1[e >> 1], wk2 = k2[e >> 1]; const float x1 = (e & 1) ? bfhi(wk1) : bflo(wk1), x2 = (e & 1) ? bfhi(wk2) : bflo(wk2);
                const float o1 = x1 * cs_.x - x2 * cs_.y, o2 = x1 * cs_.y + x2 * cs_.x; const int d = d8 * 8 + e;
                if constexpr (SUMMARY) { QS[d * LDT + j] = (bf16_t)f2bf(o1 * gk); QS[(d + 32) * LDT + j] = (bf16_t)f2bf(o2 * gk); }
                else { KS[j * 72 + d] = (bf16_t)f2bf(o1); KS[j * 72 + d + 32] = (bf16_t)f2bf(o2);
                    const unsigned wq1 = q1[e >> 1], wq2 = q2[e >> 1]; const float y1 = (e & 1) ? bfhi(wq1) : bflo(wq1), y2 = (e & 1) ? bfhi(wq2) : bflo(wq2);
                    const float p1 = (y1 * cs_.x - y2 * cs_.y) * 0.125f, p2 = (y1 * cs_.y + y2 * cs_.x) * 0.125f;
                    QS[j * 72 + d] = (bf16_t)f2bf(p1); QS[j * 72 + d + 32] = (bf16_t)f2bf(p2); QG[j * 72 + d] = (bf16_t)f2bf(p1 * gq); QG[j * 72 + d + 32] = (bf16_t)f2bf(p2 * gq); } } }
        for (int it = tid; it < L * 16; it += NT) { const int j = it >> 4, e8 = it & 15; const u32x4 vv = *(const u32x4*)(Z + (size_t)(r0 + j) * ABIN + 512 + h * 128 + e8 * 8);
#pragma unroll
            for (int e = 0; e < 8; ++e) { const unsigned w = vv[e >> 1]; VT[(e8 * 8 + e) * LDT + j] = (bf16_t)((e & 1) ? (w >> 16) : (w & 0xffffu)); } }
    }
}

template <int L, bool HG> __device__ __forceinline__ void ab_summary_unit(Frame& F, int layer, int c, int h) {
    const int tid = otid(); const int lane = tid & 63; (void)lane;
    constexpr int DK = HG ? 128 : 64, NCT = DK / 16, LDT = L + 8;
    __syncthreads();
    ab_load<L, HG, true>(F, layer, c, h);
    __syncthreads();
    const int fr = lane & 15, fq = lane >> 4;
    const LAS bf16_t* KDT = (const LAS bf16_t*)(F.lds + LQS); const LAS bf16_t* VT = (const LAS bf16_t*)(F.lds + LVT);
    f32x4 acc[1][NCT];
#pragma unroll
    for (int j = 0; j < NCT; ++j) acc[0][j] = (f32x4){0.f, 0.f, 0.f, 0.f};
    wave_mm_nt<1, NCT>(acc, VT + F.wave * 16 * LDT, LDT, KDT, LDT, L, fr, fq);
    bf16_t* ST = (bf16_t*)(F.ws + WS_STATE) + (size_t)c * SLOT_E + (HG ? 32768 + h * 16384 : h * 8192);
    const int e = F.wave * 16 + fr;
#pragma unroll
    for (int j = 0; j < NCT; ++j) { u32x2 w; w.x = pk2(acc[0][j][0], acc[0][j][1]); w.y = pk2(acc[0][j][2], acc[0][j][3]); *(u32x2*)(ST + (size_t)e * DK + 16 * j + 4 * fq) = w; }
}

template <int L, bool HG> __device__ __forceinline__ void ab_output_unit(Frame& F, int layer, int c, int h) {
    const int tid = otid(); const int lane = tid & 63; (void)lane;
    constexpr int DK = HG ? 128 : 64, LDQ = HG ? 136 : 72, LDT = L + 8, NIT = L / 16, WPI = 8 / NIT, ET = 8 / WPI, TPW = (NIT * NIT >= 8) ? NIT * NIT / 8 : 1;
    const int m = layer >> 1; int r0, pos0; chunk_geom(c, r0, pos0);
    __syncthreads();
    ab_load<L, HG, false>(F, layer, c, h);
    LAS bf16_t* QS = (LAS bf16_t*)(F.lds + LQS); LAS bf16_t* KS = (LAS bf16_t*)(F.lds + LKS); LAS bf16_t* QG = (LAS bf16_t*)(F.lds + LQG); LAS bf16_t* VT = (LAS bf16_t*)(F.lds + LVT);
    LAS bf16_t* STl = (LAS bf16_t*)(F.lds + LST); LAS bf16_t* PS = (LAS bf16_t*)(F.lds + LPS); LAS float* RED = (LAS float*)(F.lds + LRED);
    { const bf16_t* ST = (const bf16_t*)(F.ws + WS_STATE) + (size_t)c * SLOT_E + (HG ? 32768 + h * 16384 : h * 8192);
      for (int it = tid; it < 128 * DK / 8; it += NT) { const int e = it / (DK / 8), c8 = it % (DK / 8); *(LAS u32x4*)(STl + e * LDQ + c8 * 8) = *(const u32x4*)(ST + (size_t)e * DK + c8 * 8); } }
    __syncthreads();
    const int fr = lane & 15, fq = lane >> 4, w = F.wave;
    const float logg = HG ? 0.f : log1pf(-exp2f(-5.f - (float)h));
    if (w * TPW < NIT * NIT) {
        const int it = (w * TPW) / NIT, jt0 = (w * TPW) % NIT;
        f32x4 sc[1][TPW];
#pragma unroll
        for (int q = 0; q < TPW; ++q) sc[0][q] = (f32x4){0.f, 0.f, 0.f, 0.f};
        wave_mm_nt<1, TPW>(sc, QS + it * 16 * LDQ, LDQ, KS + jt0 * 16 * LDQ, LDQ, DK, fr, fq);
        const int i = it * 16 + fr;
#pragma unroll
        for (int q = 0; q < TPW; ++q) { float p[4];
#pragma unroll
            for (int r = 0; r < 4; ++r) { const int j = (jt0 + q) * 16 + 4 * fq + r; float v = sc[0][q][r]; if (!HG) v *= __expf((float)(i - j) * logg); p[r] = (j <= i) ? v : 0.f; }
            u32x2 pw; pw.x = pk2(p[0], p[1]); pw.y = pk2(p[2], p[3]); *(LAS u32x2*)(PS + i * LDT + (jt0 + q) * 16 + 4 * fq) = pw; }
    }
    __syncthreads();
    const int it = w % NIT, eg = w / NIT;
    f32x4 o[1][ET];
#pragma unroll
    for (int q = 0; q < ET; ++q) o[0][q] = (f32x4){0.f, 0.f, 0.f, 0.f};
    wave_mm_nt<1, ET>(o, PS + it * 16 * LDT, LDT, VT + eg * ET * 16 * LDT, LDT, L, fr, fq);
    wave_mm_nt<1, ET>(o, QG + it * 16 * LDQ, LDQ, STl + eg * ET * 16 * LDQ, LDQ, DK, fr, fq);
    float ss = 0.f;
#pragma unroll
    for (int q = 0; q < ET; ++q) ss += (o[0][q][0] * o[0][q][0] + o[0][q][1] * o[0][q][1]) + (o[0][q][2] * o[0][q][2] + o[0][q][3] * o[0][q][3]);
    ss += __shfl_xor(ss, 16); ss += __shfl_xor(ss, 32);
    const int i = it * 16 + fr;
    if (fq == 0) RED[i * 4 + eg] = ss;
    __syncthreads();
    float tot = 0.f;
#pragma unroll
    for (int q = 0; q < WPI; ++q) tot += RED[i * 4 + q];
    const float rstd = 1.f / sqrtf(tot * (1.f / 128.f) + NORM_EPS);
    const bf16_t* Z = (const bf16_t*)(F.ws + WS_Z); bf16_t* O = (bf16_t*)(F.ws + WS_XN);
    const size_t row = (size_t)(r0 + i);
#pragma unroll
    for (int q = 0; q < ET; ++q) { const int e = (eg * ET + q) * 16 + 4 * fq; const u32x2 gw = *(const u32x2*)(Z + row * ABIN + (HG ? 3072 : 1024) + h * 128 + e);
        const float g4[4] = {bflo(gw.x), bfhi(gw.x), bflo(gw.y), bfhi(gw.y)}; float ov[4];
#pragma unroll
        for (int r = 0; r < 4; ++r) { if (HG) ov[r] = o[0][q][r] * rstd * F.in[I_HGNG][m * 128 + e + r] * sigmoidf_(g4[r]); else ov[r] = o[0][q][r] * rstd * siluf_(g4[r]); }
        u32x2 ow; ow.x = pk2(ov[0], ov[1]); ow.y = pk2(ov[2], ov[3]); *(u32x2*)(O + row * D + (HG ? 512 : 0) + h * 128 + e) = ow; }
}

template <bool DRY = false> __device__ __forceinline__ void ab_scan(Frame& F, int layer) {
    const int tid = otid(); const int lane = tid & 63; (void)lane;
    const int m = layer >> 1;
    unsigned* ST32 = (unsigned*)(F.ws + WS_STATE); const float* DEC = (const float*)(F.ws + WS_DEC);
    constexpr int NP = SLOT_E / 2;
    const int gt = F.vcu * NT + tid;
    if (gt < NP) {
        const int eo = 2 * gt; const bool hg = eo >= 32768; const int eo2 = hg ? eo - 32768 : eo; const int head = hg ? eo2 >> 14 : eo2 >> 13; const int cch = hg ? (eo2 & 127) : (eo2 & 63); const int e = hg ? ((eo2 & 16383) >> 7) : ((eo2 & 8191) >> 6);
        const float gdec = hg ? 0.f : __expf(64.f * log1pf(-exp2f(-5.f - (float)head)));
        float s0 = 0.f, s1 = 0.f;
        for (int c0 = 0; c0 < 256; c0 += 32) {
            unsigned kv[32]; float d0[32], d1[32];
#pragma unroll
            for (int u = 0; u < 32; ++u) { kv[u] = ST32[(size_t)(c0 + u) * NP + gt]; if (hg) { const f32x2 dd = *(const f32x2*)(DEC + ((size_t)(c0 + u) * 4 + head) * 128 + cch); d0[u] = dd.x; d1[u] = dd.y; } else { d0[u] = gdec; d1[u] = gdec; } }
#pragma unroll
            for (int u = 0; u < 32; ++u) { const unsigned pw = pk2(s0, s1); if constexpr (DRY) asm volatile("" :: "v"(pw)); else ST32[(size_t)(c0 + u) * NP + gt] = pw; s0 = d0[u] * s0 + bflo(kv[u]); s1 = d1[u] * s1 + bfhi(kv[u]); }
        }
        float* outp = hg ? F.out + O_HGP + (size_t)m * 65536 + head * 16384 : F.out + O_RETP + (size_t)m * 32768 + head * 8192;
        outp[(size_t)cch * 128 + e] = s0; outp[(size_t)(cch + 1) * 128 + e] = s1;
    } else {
        const int NG2 = F.G * NT - NP; if (NG2 <= 0) return;
        for (int idx = gt - NP; idx < 32 * NP; idx += NG2) { const int b = idx / NP, pr = idx % NP;
            const int eo = 2 * pr; const bool hg = eo >= 32768; const int eo2 = hg ? eo - 32768 : eo; const int head = hg ? eo2 >> 14 : eo2 >> 13; const int cch = hg ? (eo2 & 127) : (eo2 & 63); const int e = hg ? ((eo2 & 16383) >> 7) : ((eo2 & 8191) >> 6);
            float d0, d1; if (hg) { const f32x2 dd = *(const f32x2*)(DEC + ((size_t)(256 + b) * 4 + head) * 128 + cch); d0 = dd.x; d1 = dd.y; } else { d0 = d1 = __expf(32.f * log1pf(-exp2f(-5.f - (float)head))); }
            const size_t so = hg ? ((size_t)(m * 32 + b) * 4 + head) * 16384 : ((size_t)(m * 32 + b) * 4 + head) * 8192;
            const float* sin_ = (hg ? F.in[I_SHG] : F.in[I_SRET]) + so; float* sout = F.out + (hg ? O_HGS : O_RETS) + so;
            const float i0 = sin_[(size_t)cch * 128 + e], i1 = sin_[(size_t)(cch + 1) * 128 + e];
            const unsigned kv = ST32[(size_t)(256 + b) * NP + pr]; if constexpr (!DRY) ST32[(size_t)(256 + b) * NP + pr] = pk2(i0, i1);
            sout[(size_t)cch * 128 + e] = d0 * i0 + bflo(kv); sout[(size_t)(cch + 1) * 128 + e] = d1 * i1 + bfhi(kv); }
    }
}

constexpr int RL_AT = 0, RL_RT = 9216, RL_BT = 18432, RL_KT = 27648, RL_BHT = 36864, RL_KHT = 46080, RL_VT = 55296, RL_AAB = 64512, RL_AAK = 81920, RL_ARB = 91136, RL_ARK = 100352,
              RL_U0T = 109568, RL_VEC = 118784, RL_PSUM = 119808;
constexpr int RL_G = RL_AAB, RL_WW = RL_BT, RL_APT = RL_AAK;
constexpr int RL_PL = RL_AT, RL_RL = RL_BT, RL_Y0L = RL_BT + 4608, RL_QTL = RL_AAB, RL_S = RL_BHT;
__device__ __forceinline__ int pperm(int k) { return 32 * (k >> 5) + 8 * ((k >> 2) & 3) + 4 * ((k >> 4) & 1) + (k & 3); }

struct OutSide { u32x2 vv[4], gg[4]; f32x4 lg[4], lb[4]; float bon; };
__device__ __forceinline__ void rwkv_out_side(Frame& F, int m, size_t row, int h, int fq, OutSide& o) {
    const bf16_t* RKV = (const bf16_t*)(F.ws + WS_RKV); const bf16_t* GG = (const bf16_t*)(F.ws + WS_G); const float* BON = (const float*)(F.ws + WS_BON);
    o.bon = BON[row * 16 + h];
#pragma unroll
    for (int nt = 0; nt < 4; ++nt) { const int i = h * 64 + 16 * nt + 4 * fq;
        o.lg[nt] = *(const f32x4*)(F.in[I_RLNG] + m * D + i); o.lb[nt] = *(const f32x4*)(F.in[I_RLNB] + m * D + i);
        o.vv[nt] = *(const u32x2*)(RKV + row * 3072 + 2048 + i); o.gg[nt] = *(const u32x2*)(GG + row * D + i); }
}
template <bool DRY = false> __device__ __forceinline__ void rwkv_out_core(Frame& F, const f32x4 (&y)[4], size_t row, int h, int fq, const OutSide& sd) {
    bf16_t* RKV = (bf16_t*)(F.ws + WS_RKV);
    float s1 = 0.f;
#pragma unroll
    for (int nt = 0; nt < 4; ++nt) s1 += (y[nt][0] + y[nt][1]) + (y[nt][2] + y[nt][3]);
    s1 += __shfl_xor(s1, 16); s1 += __shfl_xor(s1, 32);
    const float mean = s1 * (1.f / 64.f); float s2 = 0.f;
#pragma unroll
    for (int nt = 0; nt < 4; ++nt)
#pragma unroll
        for (int r = 0; r < 4; ++r) { const float d = y[nt][r] - mean; s2 += d * d; }
    s2 += __shfl_xor(s2, 16); s2 += __shfl_xor(s2, 32);
    const float rstd = 1.f / sqrtf(s2 * (1.f / 64.f) + RW_LN_EPS), bon = sd.bon;
#pragma unroll
    for (int nt = 0; nt < 4; ++nt) { const int i = h * 64 + 16 * nt + 4 * fq; const f32x4 lg = sd.lg[nt], lb = sd.lb[nt]; const u32x2 vv = sd.vv[nt], gg = sd.gg[nt];
        const float v4[4] = {bflo(vv.x), bfhi(vv.x), bflo(vv.y), bfhi(vv.y)}, g4[4] = {bflo(gg.x), bfhi(gg.x), bflo(gg.y), bfhi(gg.y)}; float o[4];
#pragma unroll
        for (int r = 0; r < 4; ++r) o[r] = ((y[nt][r] - mean) * rstd * lg[r] + lb[r] + bon * v4[r]) * g4[r];
        u32x2 w; w.x = pk2(o[0], o[1]); w.y = pk2(o[2], o[3]); if constexpr (DRY) asm volatile("" :: "v"(w.x), "v"(w.y)); else *(u32x2*)(RKV + row * 3072 + i) = w; }
}
template <bool DRY = false> __device__ __forceinline__ void rwkv_out_epilogue(Frame& F, int m, const f32x4 (&y)[4], size_t row, int h, int fq) {
    OutSide sd; rwkv_out_side(F, m, row, h, fq, sd); rwkv_out_core<DRY>(F, y, row, h, fq, sd);
}

template <int S, int L> struct SubstQ {
    static constexpr int RQ = L / 4, NV4 = RQ / 4;
    static __device__ __forceinline__ void run(float (&x)[RQ], f32x4 (&aq)[3][NV4], const LAS float* ap) {
        if constexpr (S < L - 1) {
            if constexpr (S + 2 < L - 1) {
#pragma unroll
                for (int k = 0; k < NV4; ++k) aq[(S + 2) % 3][k] = *(const LAS f32x4*)(ap + (S + 2) * 68 + 4 * k);
            }
            constexpr int own = S / RQ, ctrl = own * 0x55;
            const float xs = __builtin_bit_cast(float, __builtin_amdgcn_update_dpp(0, __builtin_bit_cast(int, x[S % RQ]), ctrl, 0xf, 0xf, false));
#pragma unroll
            for (int k = 0; k < NV4; ++k) { x[4 * k] += aq[S % 3][k][0] * xs; x[4 * k + 1] += aq[S % 3][k][1] * xs; x[4 * k + 2] += aq[S % 3][k][2] * xs; x[4 * k + 3] += aq[S % 3][k][3] * xs;
                asm volatile("" : "+v"(x[4 * k]), "+v"(x[4 * k + 1]), "+v"(x[4 * k + 2]), "+v"(x[4 * k + 3])); }
            asm volatile("" ::: "memory");
            SubstQ<S + 1, L>::run(x, aq, ap);
        }
    }
};
struct RawRegs { u32x4 r, k, v, w, a; };
__device__ __forceinline__ void rwkv_load_raw(Frame& F, int u, int tid, RawRegs& raw) {
    const int c = u >> 4, h = u & 15; int r0, pos0; chunk_geom(c, r0, pos0); const int L = c < 256 ? 64 : 32; int t = tid >> 3; t = t < L ? t : 0;
    const bf16_t* RKV = (const bf16_t*)(F.ws + WS_RKV); const bf16_t* WLOG = (const bf16_t*)(F.ws + WS_WLOG); const bf16_t* AA = (const bf16_t*)(F.ws + WS_XN);
    const size_t row = (size_t)(r0 + t); const int col = h * 64 + 8 * (tid & 7);
    raw.r = *(const u32x4*)(RKV + row * 3072 + col); raw.k = *(const u32x4*)(RKV + row * 3072 + 1024 + col); raw.v = *(const u32x4*)(RKV + row * 3072 + 2048 + col);
    raw.w = *(const u32x4*)(WLOG + row * D + col); raw.a = *(const u32x4*)(AA + row * D + col);
}
template <int L, bool DRY = false> __device__ __forceinline__ void rwkv_local_unit(Frame& F, int layer, int c, int h, RawRegs& raw, int unext) {
    const int tid = otid(); const int lane = tid & 63, fr = lane & 15, fq = lane >> 4, w = F.wave;
    constexpr int NIT = L / 16; constexpr bool SAMPLE = (L == 32);
    const int m = layer >> 1; int r0, pos0; chunk_geom(c, r0, pos0);
    bf16_t* RKV = (bf16_t*)(F.ws + WS_RKV); const bf16_t* WLOG = (const bf16_t*)(F.ws + WS_WLOG); const bf16_t* AA = (const bf16_t*)(F.ws + WS_XN);
    LAS bf16_t* AT = (LAS bf16_t*)(F.lds + RL_AT); LAS bf16_t* RT = (LAS bf16_t*)(F.lds + RL_RT); LAS bf16_t* BT = (LAS bf16_t*)(F.lds + RL_BT); LAS bf16_t* KT = (LAS bf16_t*)(F.lds + RL_KT);
    LAS bf16_t* BHT = (LAS bf16_t*)(F.lds + RL_BHT); LAS bf16_t* KHT = (LAS bf16_t*)(F.lds + RL_KHT); LAS bf16_t* VT = (LAS bf16_t*)(F.lds + RL_VT);
    LAS float* AAB = (LAS float*)(F.lds + RL_AAB); LAS bf16_t* AAK = (LAS bf16_t*)(F.lds + RL_AAK); LAS bf16_t* ARB = (LAS bf16_t*)(F.lds + RL_ARB); LAS bf16_t* ARK = (LAS bf16_t*)(F.lds + RL_ARK);
    LAS bf16_t* U0T = (LAS bf16_t*)(F.lds + RL_U0T); LAS float* GMID = (LAS float*)(F.lds + RL_VEC); LAS float* GLV = GMID + 64; LAS float* EGM = GMID + 128; LAS float* PSUM = (LAS float*)(F.lds + RL_PSUM);
    LAS float* G = (LAS float*)(F.lds + RL_G); LAS float* WW = (LAS float*)(F.lds + RL_WW); LAS bf16_t* APT = (LAS bf16_t*)(F.lds + RL_APT);
    __syncthreads();
    const int t = tid >> 3, c8 = tid & 7; const bool act = t < L;
    float rr[8], kkv[8], bb[8], kh[8], vv[8];
    if (act) { const size_t row = (size_t)(r0 + t); const int col = h * 64 + 8 * c8;
        const u32x4 r4 = raw.r, k4 = raw.k, v4 = raw.v, w4 = raw.w, a4 = raw.a;
        const float* kkp = F.in[I_RKK] + m * D + col; const float* kap = F.in[I_RKA] + m * D + col; const float* rkp = F.in[I_RRK] + m * D + col;
        float ss = 0.f, bon = 0.f;
#pragma unroll
        for (int e = 0; e < 8; ++e) { const float kx = (e & 1) ? bfhi(k4[e >> 1]) : bflo(k4[e >> 1]), al = (e & 1) ? bfhi(a4[e >> 1]) : bflo(a4[e >> 1]);
            rr[e] = (e & 1) ? bfhi(r4[e >> 1]) : bflo(r4[e >> 1]); vv[e] = (e & 1) ? bfhi(v4[e >> 1]) : bflo(v4[e >> 1]);
            kkv[e] = kx * kkp[e]; ss += kkv[e] * kkv[e]; kh[e] = kx * (1.f + (al - 1.f) * kap[e]); bb[e] = al; bon += rr[e] * kh[e] * rkp[e];
            G[t * 64 + 8 * c8 + e] = (e & 1) ? bfhi(w4[e >> 1]) : bflo(w4[e >> 1]); }
        ss += __shfl_xor(ss, 1); ss += __shfl_xor(ss, 2); ss += __shfl_xor(ss, 4); bon += __shfl_xor(bon, 1); bon += __shfl_xor(bon, 2); bon += __shfl_xor(bon, 4);
        const float inv = 1.f / fmaxf(sqrtf(ss), 1e-12f);
#pragma unroll
        for (int e = 0; e < 8; ++e) { kkv[e] *= inv; bb[e] *= kkv[e]; }
        if (c8 == 0) ((float*)(F.ws + WS_BON))[row * 16 + h] = bon; }
    if (unext >= 0) rwkv_load_raw(F, unext, tid, raw);
    __syncthreads();
    { constexpr int TE = L / 8; const int j = tid & 63, e8 = tid >> 6; float cs[TE]; float run = 0.f;
#pragma unroll
      for (int q = 0; q < TE; ++q) { run += G[(e8 * TE + q) * 64 + j]; cs[q] = run; }
      PSUM[e8 * 64 + j] = run;
      __syncthreads();
      float off = 0.f, gm = 0.f, gl = 0.f;
#pragma unroll
      for (int q = 0; q < 8; ++q) { const float p = PSUM[q * 64 + j]; if (q < e8) off += p; if (q < 4) gm += p; gl += p; }
#pragma unroll
      for (int q = 0; q < TE; ++q) G[(e8 * TE + q) * 64 + j] = off + cs[q];
      if (e8 == 0) { GMID[j] = gm; GLV[j] = gl; EGM[j] = __expf(gm); if (!SAMPLE) ((float*)(F.ws + WS_REC + ((size_t)h * 256 + c) * REC_B + 16384))[j] = __expf(gl); } }
    __syncthreads();
    if (act) { float fa[8], fr_[8], fb[8], fk[8];
#pragma unroll
        for (int e = 0; e < 8; ++e) { const int j = 8 * c8 + e; const float g = G[t * 64 + j], gp = (t > 0) ? G[(t - 1) * 64 + j] : 0.f, gm = GMID[j], gl = GLV[j];
            const float ed = __expf(gm - g), eu = __expf(g - gm), el = __expf(gl - g);
            fa[e] = -kkv[e] * __expf(gp - gm); fr_[e] = rr[e] * eu; fb[e] = bb[e] * ed; fk[e] = kh[e] * ed;
            if constexpr (!(DRY && (LOCAL_SKIP & 4))) { BHT[j * 72 + t] = (bf16_t)f2bf(bb[e] * el); KHT[j * 72 + t] = (bf16_t)f2bf(kh[e] * el); VT[j * 72 + t] = (bf16_t)f2bf(vv[e]); } }
        u32x4 p;
        p.x = pk2(fa[0], fa[1]); p.y = pk2(fa[2], fa[3]); p.z = pk2(fa[4], fa[5]); p.w = pk2(fa[6], fa[7]); *(LAS u32x4*)(AT + t * 72 + 8 * c8) = p;
        p.x = pk2(fr_[0], fr_[1]); p.y = pk2(fr_[2], fr_[3]); p.z = pk2(fr_[4], fr_[5]); p.w = pk2(fr_[6], fr_[7]); *(LAS u32x4*)(RT + t * 72 + 8 * c8) = p;
        p.x = pk2(fb[0], fb[1]); p.y = pk2(fb[2], fb[3]); p.z = pk2(fb[4], fb[5]); p.w = pk2(fb[6], fb[7]); *(LAS u32x4*)(BT + t * 72 + 8 * c8) = p;
        p.x = pk2(fk[0], fk[1]); p.y = pk2(fk[2], fk[3]); p.z = pk2(fk[4], fk[5]); p.w = pk2(fk[6], fk[7]); *(LAS u32x4*)(KT + t * 72 + 8 * c8) = p; }
    __syncthreads();
    if constexpr (DRY && (LOCAL_SKIP & 2)) return;
    { constexpr int TPW = (NIT * NIT >= 8) ? NIT * NIT / 8 : 1;
      if (w * TPW < NIT * NIT) { const int it = (w * TPW) / NIT, jt0 = (w * TPW) % NIT;
          f32x4 ab[1][TPW], ak[1][TPW], rb[1][TPW], rk[1][TPW];
#pragma unroll
          for (int q = 0; q < TPW; ++q) { ab[0][q] = (f32x4){0.f, 0.f, 0.f, 0.f}; ak[0][q] = ab[0][q]; rb[0][q] = ab[0][q]; rk[0][q] = ab[0][q]; }
          wave_mm_nt<1, TPW>(ab, AT + it * 16 * 72, 72, BT + jt0 * 16 * 72, 72, 64, fr, fq); wave_mm_nt<1, TPW>(ak, AT + it * 16 * 72, 72, KT + jt0 * 16 * 72, 72, 64, fr, fq);
          wave_mm_nt<1, TPW>(rb, RT + it * 16 * 72, 72, BT + jt0 * 16 * 72, 72, 64, fr, fq); wave_mm_nt<1, TPW>(rk, RT + it * 16 * 72, 72, KT + jt0 * 16 * 72, 72, 64, fr, fq);
          const int tt = it * 16 + fr;
#pragma unroll
          for (int q = 0; q < TPW; ++q) { const int s0 = (jt0 + q) * 16 + 4 * fq; f32x4 fab; float fak[4], frb[4], frk[4];
#pragma unroll
              for (int r = 0; r < 4; ++r) { const int sx = s0 + r; fab[r] = (sx < tt) ? ab[0][q][r] : 0.f; fak[r] = (sx < tt) ? ak[0][q][r] : 0.f; frb[r] = (sx <= tt) ? rb[0][q][r] : 0.f; frk[r] = (sx <= tt) ? rk[0][q][r] : 0.f; }
#pragma unroll
              for (int r = 0; r < 4; ++r) AAB[(s0 + r) * 68 + tt] = fab[r];
              u32x2 p; p.x = pk2(fak[0], fak[1]); p.y = pk2(fak[2], fak[3]); *(LAS u32x2*)(AAK + tt * 72 + s0) = p;
              p.x = pk2(frb[0], frb[1]); p.y = pk2(frb[2], frb[3]); *(LAS u32x2*)(ARB + tt * 72 + s0) = p;
              p.x = pk2(frk[0], frk[1]); p.y = pk2(frk[2], frk[3]); *(LAS u32x2*)(ARK + tt * 72 + s0) = p; } } }
    __syncthreads();
    { constexpr int TP3 = NIT / 2; const int it = (w * TP3) / 4, nt0 = (w * TP3) % 4;
      f32x4 ww[1][TP3];
#pragma unroll
      for (int q = 0; q < TP3; ++q) ww[0][q] = (f32x4){0.f, 0.f, 0.f, 0.f};
      wave_mm_nt<1, TP3>(ww, AAK + it * 16 * 72, 72, VT + nt0 * 16 * 72, 72, L, fr, fq);
#pragma unroll
      for (int q = 0; q < TP3; ++q) *(LAS f32x4*)(WW + (it * 16 + fr) * 68 + (nt0 + q) * 16 + 4 * fq) = ww[0][q]; }
    __syncthreads();
    { constexpr int RQ = L / 4, NV4 = RQ / 4; const int col = tid >> 2, qd = tid & 3, cidx = col & 63; const bool isA = col < 64; const float eg = EGM[cidx];
      float x[RQ]; f32x4 aq[3][NV4];
#pragma unroll
      for (int i = 0; i < RQ; ++i) { const int tt = qd * RQ + i; x[i] = isA ? bf2f(AT[tt * 72 + cidx]) * eg : WW[tt * 68 + cidx]; }
      const LAS float* ap = AAB + qd * RQ;
#pragma unroll
      for (int k = 0; k < NV4; ++k) { aq[0][k] = *(const LAS f32x4*)(ap + 4 * k); aq[1][k] = *(const LAS f32x4*)(ap + 68 + 4 * k); }
      if constexpr (!(DRY && (LOCAL_SKIP & 1))) SubstQ<0, L>::run(x, aq, ap);
      LAS bf16_t* dst = (isA ? APT : U0T) + cidx * 72 + qd * RQ;
#pragma unroll
      for (int t8 = 0; t8 < RQ; t8 += 8) { u32x4 p; p.x = pk2(x[t8], x[t8 + 1]); p.y = pk2(x[t8 + 2], x[t8 + 3]); p.z = pk2(x[t8 + 4], x[t8 + 5]); p.w = pk2(x[t8 + 6], x[t8 + 7]); *(LAS u32x4*)(dst + t8) = p; } }
    __syncthreads();
    { const int mt = w >> 1, nt0 = (w & 1) * 2;
      f32x4 pp[1][2], qt[1][2];
#pragma unroll
      for (int q = 0; q < 2; ++q) { pp[0][q] = (f32x4){0.f, 0.f, 0.f, 0.f}; qt[0][q] = pp[0][q]; }
      wave_mm_nt<1, 2>(pp, BHT + mt * 16 * 72, 72, APT + nt0 * 16 * 72, 72, L, fr, fq);
      wave_mm_nt<1, 2>(qt, U0T + mt * 16 * 72, 72, BHT + nt0 * 16 * 72, 72, L, fr, fq); wave_mm_nt<1, 2>(qt, VT + mt * 16 * 72, 72, KHT + nt0 * 16 * 72, 72, L, fr, fq);
      constexpr int TP5 = NIT / 2; const int it = (w * TP5) / 4, rn0 = (w * TP5) % 4;
      f32x4 rp[1][TP5], y0[1][TP5];
#pragma unroll
      for (int q = 0; q < TP5; ++q) { const int j = (rn0 + q) * 16 + 4 * fq; const u32x2 rw = *(const LAS u32x2*)(RT + (it * 16 + fr) * 72 + j); const f32x4 e4 = *(const LAS f32x4*)(EGM + j);
          rp[0][q] = (f32x4){bflo(rw.x) * e4[0], bfhi(rw.x) * e4[1], bflo(rw.y) * e4[2], bfhi(rw.y) * e4[3]}; y0[0][q] = (f32x4){0.f, 0.f, 0.f, 0.f}; }
      wave_mm_nt<1, TP5>(rp, ARB + it * 16 * 72, 72, APT + rn0 * 16 * 72, 72, L, fr, fq);
      wave_mm_nt<1, TP5>(y0, ARB + it * 16 * 72, 72, U0T + rn0 * 16 * 72, 72, L, fr, fq); wave_mm_nt<1, TP5>(y0, ARK + it * 16 * 72, 72, VT + rn0 * 16 * 72, 72, L, fr, fq);
      if constexpr (!SAMPLE) {
          bf16_t* PP = (bf16_t*)(F.ws + WS_REC + ((size_t)h * 256 + c) * REC_B); bf16_t* QQ = PP + 4096;
#pragma unroll
          for (int q = 0; q < 2; ++q) { const int n0 = (nt0 + q) * 16 + 4 * fq; u32x2 p; p.x = pk2(pp[0][q][0], pp[0][q][1]); p.y = pk2(pp[0][q][2], pp[0][q][3]);
              *(u32x2*)(PP + (mt * 16 + fr) * 64 + pperm(n0)) = p;
              p.x = pk2(qt[0][q][0], qt[0][q][1]); p.y = pk2(qt[0][q][2], qt[0][q][3]); *(u32x2*)(QQ + (mt * 16 + fr) * 64 + n0) = p; }
#pragma unroll
          for (int q = 0; q < TP5; ++q) { const size_t row = (size_t)(r0 + it * 16 + fr); const int n0 = (rn0 + q) * 16 + 4 * fq; u32x2 p;
              p.x = pk2(rp[0][q][0], rp[0][q][1]); p.y = pk2(rp[0][q][2], rp[0][q][3]); if constexpr (DRY) asm volatile("" :: "v"(p.x), "v"(p.y)); else *(u32x2*)(RKV + row * 3072 + 1024 + h * 64 + n0) = p;
              p.x = pk2(y0[0][q][0], y0[0][q][1]); p.y = pk2(y0[0][q][2], y0[0][q][3]); if constexpr (DRY) asm volatile("" :: "v"(p.x), "v"(p.y)); else *(u32x2*)(RKV + row * 3072 + h * 64 + n0) = p; }
      } else {
          __syncthreads();
          LAS bf16_t* PL = (LAS bf16_t*)(F.lds + RL_PL); LAS bf16_t* RLs = (LAS bf16_t*)(F.lds + RL_RL); LAS float* Y0L = (LAS float*)(F.lds + RL_Y0L); LAS float* QTL = (LAS float*)(F.lds + RL_QTL); LAS bf16_t* Sl = (LAS bf16_t*)(F.lds + RL_S);
#pragma unroll
          for (int q = 0; q < 2; ++q) { const int n0 = (nt0 + q) * 16 + 4 * fq; u32x2 p; p.x = pk2(pp[0][q][0], pp[0][q][1]); p.y = pk2(pp[0][q][2], pp[0][q][3]);
              *(LAS u32x2*)(PL + (mt * 16 + fr) * 72 + n0) = p; *(LAS f32x4*)(QTL + (mt * 16 + fr) * 68 + n0) = qt[0][q]; }
#pragma unroll
          for (int q = 0; q < TP5; ++q) { const int n0 = (rn0 + q) * 16 + 4 * fq; u32x2 p; p.x = pk2(rp[0][q][0], rp[0][q][1]); p.y = pk2(rp[0][q][2], rp[0][q][3]);
              *(LAS u32x2*)(RLs + (it * 16 + fr) * 72 + n0) = p; *(LAS f32x4*)(Y0L + (it * 16 + fr) * 68 + n0) = y0[0][q]; }
          const int sb = c - 256; const float* sin_ = F.in[I_SWKV] + (((size_t)m * 32 + sb) * 16 + h) * 4096; float* sout = F.out + O_WKVS + (((size_t)m * 32 + sb) * 16 + h) * 4096;
          for (int it2 = tid; it2 < 64 * 16; it2 += NT) { const int i = it2 >> 4, j4 = (it2 & 15) * 4; const f32x4 sv = *(const f32x4*)(sin_ + i * 64 + j4); u32x2 p; p.x = pk2(sv[0], sv[1]); p.y = pk2(sv[2], sv[3]); *(LAS u32x2*)(Sl + i * 72 + j4) = p; }
          __syncthreads();
          if (w < 2) { f32x4 y[1][4];
#pragma unroll
              for (int q = 0; q < 4; ++q) y[0][q] = *(const LAS f32x4*)(Y0L + (w * 16 + fr) * 68 + q * 16 + 4 * fq);
              wave_mm_nt<1, 4>(y, RLs + w * 16 * 72, 72, Sl, 72, 64, fr, fq);
              rwkv_out_epilogue<DRY>(F, m, y[0], (size_t)(r0 + w * 16 + fr), h, fq); }
          else if (w < 6) { const int mi = w - 2; f32x4 tl[1][4];
#pragma unroll
              for (int q = 0; q < 4; ++q) { const int j = q * 16 + 4 * fq; const f32x4 sv = *(const f32x4*)(sin_ + (mi * 16 + fr) * 64 + j), gl4 = *(const LAS f32x4*)(GLV + j), qv = *(const LAS f32x4*)(QTL + (mi * 16 + fr) * 68 + j);
                  tl[0][q] = (f32x4){__expf(gl4[0]) * sv[0] + qv[0], __expf(gl4[1]) * sv[1] + qv[1], __expf(gl4[2]) * sv[2] + qv[2], __expf(gl4[3]) * sv[3] + qv[3]}; }
              wave_mm_nt<1, 4>(tl, Sl + mi * 16 * 72, 72, PL, 72, 64, fr, fq);
#pragma unroll
              for (int q = 0; q < 4; ++q) *(f32x4*)(sout + (mi * 16 + fr) * 64 + q * 16 + 4 * fq) = tl[0][q]; }
      }
    }
}

constexpr int SC_GRP = 4, SC_CH = 8192 + 2048 + 256, SC_LCH = 9216 + 2304 + 256, SC_LBUF = SC_GRP * SC_LCH;
template <int SKIP = 0> __device__ __forceinline__ void rwkv_scan_phase(Frame& F, int layer) {
    const int tid = otid(); const int lane = tid & 63, m = layer >> 1; const int b = blockIdx.x;
    if (b >= 64) {
        if constexpr (SKIP == 0) { const int nb = (int)F.G - 64; RawRegs raw; int u = 256 * 16 + (b - 64); if (u < NCHUNK * 16) rwkv_load_raw(F, u, tid, raw);
            for (; u < NCHUNK * 16; u += nb) { const int un = (u + nb < NCHUNK * 16) ? u + nb : -1; rwkv_local_unit<32>(F, layer, u >> 4, u & 15, raw, un); }
            if (layer == 1) { __syncthreads(); mod_phase(F, 2, 4, b - 64, nb); } }
        return; }
    const int h = 2 * (b & 7) + (b >> 5), sl = (b >> 3) & 3;
    const unsigned char* REC = F.ws + WS_REC;
    constexpr int NG = 256 / SC_GRP, DEPTH = 4;
    static_assert(NG % DEPTH == 0, "scan groups vs prefetch depth");
    if (F.wave != 0) {
        constexpr int NV = SC_GRP * SC_CH / 16, NLT = NT - 64, NPT = (NV + NLT - 1) / NLT;
        struct RegSet { u32x4 v[NPT]; };
        RegSet sets[DEPTH];
        unsigned poff[NPT], pdst[NPT];
#pragma unroll
        for (int q = 0; q < NPT; ++q) { int v = (tid - 64) + q * NLT; v = v < NV ? v : NV - 1; const int cc = v / (SC_CH / 16), o = (v % (SC_CH / 16)) * 16;
            poff[q] = (unsigned)(cc * REC_B + o + (o >= 10240 ? 6144 : (o >= 8192 ? sl * 2048 : 0)));
            const int lo = (o < 8192) ? (o >> 7) * 144 + (o & 127) : (o < 10240) ? 9216 + ((o - 8192) >> 7) * 144 + ((o - 8192) & 127) : 9216 + 2304 + (o - 10240);
            pdst[q] = (unsigned)(cc * SC_LCH + lo); }
        auto issue = [&](int g, RegSet& st) { const unsigned char* gb = REC + ((size_t)h * 256 + g * SC_GRP) * REC_B;
#pragma unroll
            for (int q = 0; q < NPT; ++q) st.v[q] = *(const u32x4*)(gb + poff[q]); };
        auto commit = [&](int buf, const RegSet& st) {
#pragma unroll
            for (int q = 0; q < NPT; ++q) *(LAS u32x4*)(F.lds + buf * SC_LBUF + pdst[q]) = st.v[q]; };
        if (!(SKIP & 2)) {
#pragma unroll
            for (int d = 0; d < DEPTH; ++d) issue(d, sets[d]);
            commit(0, sets[0]); }
        for (int g0 = 0; g0 < NG; g0 += DEPTH) {
#pragma unroll
            for (int dd = 0; dd < DEPTH; ++dd) { const int g = g0 + dd;
                if (!(SKIP & 2)) { if (g > 0 && g + DEPTH - 1 < NG) issue(g + DEPTH - 1, sets[(dd + DEPTH - 1) % DEPTH]); }
                __syncthreads();
                __syncthreads();
                if (!(SKIP & 2)) { if (g + 1 < NG) commit((g + 1) & 1, sets[(dd + 1) % DEPTH]); } }
        }
    } else {
        const int ci = lane & 15, q4 = lane >> 4, i = 16 * sl + ci;
        f32x4 T[4];
#pragma unroll
        for (int mm = 0; mm < 4; ++mm) T[mm] = (f32x4){0.f, 0.f, 0.f, 0.f};
        bf16_t* TST = (bf16_t*)(F.ws + WS_TST);
        const unsigned pfo = (unsigned)(ci * 144 + q4 * 16);
        for (int g = 0; g < NG; ++g) {
            __syncthreads();
            if (!(SKIP & 1)) {
                const LAS unsigned char* base = F.lds + (g & 1) * SC_LBUF;
                bf16x8 pf[4][2];
#pragma unroll
                for (int mm = 0; mm < 4; ++mm)
#pragma unroll
                    for (int s = 0; s < 2; ++s) pf[mm][s] = *(const LAS bf16x8*)(base + pfo + mm * 2304 + s * 64);
#pragma unroll
                for (int cc = 0; cc < SC_GRP; ++cc) { const int c = g * SC_GRP + cc; const LAS unsigned char* cb = base + cc * SC_LCH;
                    bf16_t* tdst = TST + (((size_t)h * 256 + c) * 64 + i) * 64;
                    f32x4 gv[4]; u32x2 qv[4];
#pragma unroll
                    for (int mm = 0; mm < 4; ++mm) { const int j = 16 * mm + 4 * q4; gv[mm] = *(const LAS f32x4*)(cb + 9216 + 2304 + j * 4); qv[mm] = *(const LAS u32x2*)(cb + 9216 + ci * 144 + j * 2); }
                    bf16x8 pn[4][2];
                    if (cc + 1 < SC_GRP) {
#pragma unroll
                        for (int mm = 0; mm < 4; ++mm)
#pragma unroll
                            for (int s = 0; s < 2; ++s) pn[mm][s] = *(const LAS bf16x8*)(cb + SC_LCH + pfo + mm * 2304 + s * 64); }
                    bf16x8 Tf[2];
#pragma unroll
                    for (int mm = 0; mm < 4; ++mm) { u32x2 p; p.x = pk2(T[mm][0], T[mm][1]); p.y = pk2(T[mm][2], T[mm][3]); *(u32x2*)(tdst + 16 * mm + 4 * q4) = p;
                        Tf[mm >> 1][(mm & 1) * 4 + 0] = (short)(p.x & 0xffffu); Tf[mm >> 1][(mm & 1) * 4 + 1] = (short)(p.x >> 16); Tf[mm >> 1][(mm & 1) * 4 + 2] = (short)(p.y & 0xffffu); Tf[mm >> 1][(mm & 1) * 4 + 3] = (short)(p.y >> 16); }
#pragma unroll
                    for (int mm = 0; mm < 4; ++mm) {
                        f32x4 acc = (f32x4){gv[mm][0] * T[mm][0] + bflo(qv[mm].x), gv[mm][1] * T[mm][1] + bfhi(qv[mm].x), gv[mm][2] * T[mm][2] + bflo(qv[mm].y), gv[mm][3] * T[mm][3] + bfhi(qv[mm].y)};
                        acc = __builtin_amdgcn_mfma_f32_16x16x32_bf16(pf[mm][0], Tf[0], acc, 0, 0, 0); acc = __builtin_amdgcn_mfma_f32_16x16x32_bf16(pf[mm][1], Tf[1], acc, 0, 0, 0);
                        T[mm] = acc; }
                    if (cc + 1 < SC_GRP) {
#pragma unroll
                        for (int mm = 0; mm < 4; ++mm) { pf[mm][0] = pn[mm][0]; pf[mm][1] = pn[mm][1]; } }
                }
            }
            __syncthreads();
        }
        float* outp = F.out + O_WKVP + ((size_t)m * 16 + h) * 4096 + (size_t)i * 64;
#pragma unroll
        for (int mm = 0; mm < 4; ++mm) *(f32x4*)(outp + 16 * mm + 4 * q4) = T[mm];
    }
}

struct OutMain { u32x2 y0[4]; bf16x8 xa[2]; };
template <bool DRY = false> __device__ __forceinline__ void rwkv_output_phase(Frame& F, int layer) {
    const int tid = otid(); const int lane = tid & 63, fr = lane & 15, fq = lane >> 4, m = layer >> 1;
    const bf16_t* RKV = (const bf16_t*)(F.ws + WS_RKV); const bf16_t* TST = (const bf16_t*)(F.ws + WS_TST);
    const int gw = F.vcu * NWAVES + F.wave, NGW = F.G * NWAVES;
    for (int u = gw; u < 256 * 16; u += NGW) { const int h = u & 15, c = u >> 4; const bf16_t* ts = TST + ((size_t)h * 256 + c) * 4096;
        bf16x8 yb[2][4];
#pragma unroll
        for (int s = 0; s < 2; ++s)
#pragma unroll
            for (int nt = 0; nt < 4; ++nt) yb[s][nt] = *(const bf16x8*)(ts + (16 * nt + fr) * 64 + 32 * s + 8 * fq);
        f32x4 lgu[4], lbu[4];
#pragma unroll
        for (int nt = 0; nt < 4; ++nt) { const int i = h * 64 + 16 * nt + 4 * fq; lgu[nt] = *(const f32x4*)(F.in[I_RLNG] + m * D + i); lbu[nt] = *(const f32x4*)(F.in[I_RLNB] + m * D + i); }
        const bf16_t* GG = (const bf16_t*)(F.ws + WS_G); const float* BON = (const float*)(F.ws + WS_BON);
        auto issue = [&](int it, OutMain& mn, OutSide& sd) { const size_t row = (size_t)(64 * c + 16 * it + fr);
#pragma unroll
            for (int nt = 0; nt < 4; ++nt) mn.y0[nt] = *(const u32x2*)(RKV + row * 3072 + h * 64 + 16 * nt + 4 * fq);
#pragma unroll
            for (int s = 0; s < 2; ++s) mn.xa[s] = *(const bf16x8*)(RKV + row * 3072 + 1024 + h * 64 + 32 * s + 8 * fq);
            sd.bon = BON[row * 16 + h];
#pragma unroll
            for (int nt = 0; nt < 4; ++nt) { const int i = h * 64 + 16 * nt + 4 * fq; sd.vv[nt] = *(const u32x2*)(RKV + row * 3072 + 2048 + i); sd.gg[nt] = *(const u32x2*)(GG + row * D + i); } };
        auto compute = [&](int it, const OutMain& mn, OutSide& sd) { const size_t row = (size_t)(64 * c + 16 * it + fr); f32x4 y[4];
#pragma unroll
            for (int nt = 0; nt < 4; ++nt) y[nt] = (f32x4){bflo(mn.y0[nt].x), bfhi(mn.y0[nt].x), bflo(mn.y0[nt].y), bfhi(mn.y0[nt].y)};
#pragma unroll
            for (int s = 0; s < 2; ++s)
#pragma unroll
                for (int nt = 0; nt < 4; ++nt) y[nt] = __builtin_amdgcn_mfma_f32_16x16x32_bf16(yb[s][nt], mn.xa[s], y[nt], 0, 0, 0);
#pragma unroll
            for (int nt = 0; nt < 4; ++nt) { sd.lg[nt] = lgu[nt]; sd.lb[nt] = lbu[nt]; }
            rwkv_out_core<DRY>(F, y, row, h, fq, sd); };
        OutMain mA, mB; OutSide sA, sB;
        issue(0, mA, sA); asm volatile("" ::: "memory");
        issue(1, mB, sB); asm volatile("" ::: "memory"); compute(0, mA, sA); asm volatile("" ::: "memory");
        issue(2, mA, sA); asm volatile("" ::: "memory"); compute(1, mB, sB); asm volatile("" ::: "memory");
        issue(3, mB, sB); asm volatile("" ::: "memory"); compute(2, mA, sA); asm volatile("" ::: "memory");
        compute(3, mB, sB);
    }
}

#define GRID_BAR() xcd_barrier(bar)
#ifndef PHASE_MASK
#define PHASE_MASK 0xffffffffu
#endif
#ifndef STRETCH_MASK
#define STRETCH_MASK 0u
#endif
struct StretchGuard { unsigned long long t0; bool on; __device__ __forceinline__ StretchGuard(bool o) : t0(o ? __builtin_amdgcn_s_memrealtime() : 0ull), on(o) {}
    __device__ __forceinline__ ~StretchGuard() { if (on) { __syncthreads(); const unsigned long long t1 = __builtin_amdgcn_s_memrealtime(); while (__builtin_amdgcn_s_memrealtime() < t1 + (t1 - t0)) __builtin_amdgcn_s_sleep(2); } } };
#define PH(k) if (StretchGuard sg_(((STRETCH_MASK) >> (k)) & 1u); PHASE_MASK & (1u << (k)))
#ifndef REP_MASK
#define REP_MASK 0u
#endif
#define REP(k) (((REP_MASK) >> (k)) & 1u)
#ifndef LOCAL_SKIP
#define LOCAL_SKIP 0
#endif
#ifndef EXTRA_BARS
#define EXTRA_BARS 0
#endif
template <int layer> __device__ __forceinline__ void layer_body(Frame& F, const XcdBarrier& bar) {
    unsigned char* ws = F.ws; unsigned char* ar = ws + WS_ARENA;
    bf16_t* XN = (bf16_t*)(ws + WS_XN);
    const float* MOD = (const float*)(ws + WS_MOD);
    constexpr int m = layer >> 1; const float* modl = MOD + (size_t)layer * NSEQ * 6144;
    PH(1) for (int rep = 0; rep <= (int)REP(1); ++rep) if (layer > 0) convert_layer_weights(F, layer);
    if constexpr ((layer & 1) == 0) {
        PH(2) for (int rep = 0; rep <= (int)REP(2); ++rep) { if constexpr (layer == 0) norm_pass<0, 0, true>(F, layer, 0, 0, F.in[I_XS], nullptr); else norm_pass<0, 8>(F, layer, layer - 1, 5120, F.out + (size_t)MP * D, (float*)(ws + WS_SXB)); }
        GRID_BAR();
        PH(3) { using GC = pg8::Geo<D, D, D, 30, 0, 1 << 20, 0>; pg8::Gemm<GC> g{XN, (const bf16_t*)(ar + AR_WIN), nullptr}; pg8::StaticOrder S; S.init(M, ABIN, F.G, (int)blockIdx.x);
          pg8::EpiBf16<0> E{(bf16_t*)(ws + WS_Z), ABIN};
          pg8::gemm_phase<pg8::EpiBf16<0>, pg8::StaticOrder, GC, true, true>(F.lds, g, S, E);
          if (REP(3)) { pg8::EpiNull<true> EN; pg8::gemm_phase<pg8::EpiNull<true>, pg8::StaticOrder, GC, true, true>(F.lds, g, S, EN); } }
        GRID_BAR();
        PH(4) for (int rep = 0; rep <= (int)REP(4); ++rep) for (int u = F.vcu; u < NCHUNK * 8; u += F.G) { const int c = u >> 3, hh = (u + u / F.G) & 7;
            if (c < 256) { if (hh < 4) ab_summary_unit<64, false>(F, layer, c, hh); else ab_summary_unit<64, true>(F, layer, c, hh - 4); }
            else { if (hh < 4) ab_summary_unit<32, false>(F, layer, c, hh); else ab_summary_unit<32, true>(F, layer, c, hh - 4); } }
        GRID_BAR();
        PH(5) { if (REP(5)) ab_scan<true>(F, layer); ab_scan<false>(F, layer); }
        GRID_BAR();
        PH(6) for (int rep = 0; rep <= (int)REP(6); ++rep) for (int u = F.vcu; u < NCHUNK * 8; u += F.G) { const int c = u >> 3, hh = (u + u / F.G) & 7;
            if (c < 256) { if (hh < 4) ab_output_unit<64, false>(F, layer, c, hh); else ab_output_unit<64, true>(F, layer, c, hh - 4); }
            else { if (hh < 4) ab_output_unit<32, false>(F, layer, c, hh); else ab_output_unit<32, true>(F, layer, c, hh - 4); } }
        GRID_BAR();
        PH(7) { using GC = pg8::Geo<D, D, D, 30, 0, 1 << 20, 0>; pg8::Gemm<GC> g{XN, (const bf16_t*)(ar + AR_WOUT), nullptr}; pg8::StaticOrder S; S.init(MP, D, F.G, (int)blockIdx.x);
          pg8::EpiRes E{F.out, modl, 2048, (layer == 0) ? F.in[I_XP] : F.out};
          pg8::gemm_phase<pg8::EpiRes, pg8::StaticOrder, GC, true, true>(F.lds, g, S, E);
          if (REP(7)) { pg8::EpiNull<false> EN; pg8::gemm_phase<pg8::EpiNull<false>, pg8::StaticOrder, GC, true, true>(F.lds, g, S, EN); }
          using GC2 = pg8::Geo<D, D, 256, 30, 0, 1 << 20, 0, true>; pg8::Gemm<GC2> g2{XN, (const bf16_t*)(ar + AR_WOUT), nullptr}; pg8::SplitOrder S2{F.vcu, 4};
          pg8::EpiPartial E2{(float*)(ws + WS_PART), 4};
          pg8::gemm_phase<pg8::EpiPartial, pg8::SplitOrder, GC2, true, true>(F.lds, g2, S2, E2); }
        GRID_BAR();
    } else {
        PH(8) for (int rep = 0; rep <= (int)REP(8); ++rep) norm_pass<1, 8>(F, layer, layer - 1, 5120, F.out + (size_t)MP * D, (float*)(ws + WS_SXB));
        GRID_BAR();
        PH(9) { using GCr = pg8::Geo<D, 2048, D, 2, M * D, 1 << 20, 0>; pg8::Gemm<GCr> gr{(const bf16_t*)(ws + WS_XMIX), (const bf16_t*)(ar + AR_WC1), nullptr}; pg8::StaticOrder Sr; Sr.init(M, 3072, F.G, (int)blockIdx.x);
          pg8::EpiRkv E{(bf16_t*)(ws + WS_RKV), (bf16_t*)(ws + WS_LO), (m == 0) ? (bf16_t*)(ws + WS_VFIRST) : nullptr};
          pg8::gemm_phase<pg8::EpiRkv, pg8::StaticOrder, GCr, true, true>(F.lds, gr, Sr, E);
          if (REP(9)) { pg8::EpiNull<true> EN; pg8::gemm_phase<pg8::EpiNull<true>, pg8::StaticOrder, GCr, true, true>(F.lds, gr, Sr, EN); }
          using GC = pg8::Geo<D, 2048, 2048, 30, 0, 16, -4096>; pg8::Gemm<GC> g{XN, (const bf16_t*)(ar + AR_WC1), (const bf16_t*)(ws + WS_PREVS)}; pg8::LoraOrder Sl{(int)blockIdx.x};
          pg8::gemm_phase<pg8::EpiRkv, pg8::LoraOrder, GC, true, true>(F.lds, g, Sl, E); }
        GRID_BAR();
        PH(10) { using GC = pg8::Geo<D, 256, 256, 2, 256, 1 << 20, 0>; pg8::Gemm<GC> g{(const bf16_t*)(ws + WS_LO), (const bf16_t*)(ar + AR_WC2), nullptr}; pg8::SkipVOrder S; S.skip = (m == 0); S.S.init(M, (m == 0) ? 3072 : 4096, F.G, (int)blockIdx.x);
          pg8::EpiLora2 E{(bf16_t*)(ws + WS_WLOG), XN, (bf16_t*)(ws + WS_G), (bf16_t*)(ws + WS_RKV), (m == 1) ? (const bf16_t*)(ws + WS_VFIRST) : nullptr,
                          F.in[I_RW0] + m * D, F.in[I_RA0] + m * D, F.in[I_RV0]};
          pg8::gemm_phase<pg8::EpiLora2, pg8::SkipVOrder, GC, true, true>(F.lds, g, S, E);
           }
        GRID_BAR();
        PH(11) { RawRegs raw; const int tid0 = otid(); int u = F.vcu; if (u < 256 * 16) rwkv_load_raw(F, u, tid0, raw);
          for (; u < 256 * 16; u += F.G) { const int c = u >> 4, hh = u & 15, un = (u + F.G < 256 * 16) ? u + F.G : -1;
              rwkv_local_unit<64>(F, layer, c, hh, raw, un); } }
        GRID_BAR();
        PH(17) { if (REP(17)) rwkv_scan_phase<LOCAL_SKIP>(F, layer); rwkv_scan_phase<0>(F, layer); }
        GRID_BAR();
        PH(18) { if (REP(18)) rwkv_output_phase<true>(F, layer); rwkv_output_phase<false>(F, layer); }
        GRID_BAR();
        PH(12) { using GC = pg8::Geo<3072, D, D, 30, 0, 1 << 20, 0>; pg8::Gemm<GC> g{(const bf16_t*)(ws + WS_RKV), (const bf16_t*)(ar + AR_WO), nullptr}; pg8::StaticOrder S; S.init(MP, D, F.G, (int)blockIdx.x);
          pg8::EpiRes E{F.out, modl, 2048, F.out};
          pg8::gemm_phase<pg8::EpiRes, pg8::StaticOrder, GC, true, true>(F.lds, g, S, E);
          if (REP(12)) { pg8::EpiNull<false> EN; pg8::gemm_phase<pg8::EpiNull<false>, pg8::StaticOrder, GC, true, true>(F.lds, g, S, EN); }
          using GC2 = pg8::Geo<3072, D, 256, 30, 0, 1 << 20, 0, true>; pg8::Gemm<GC2> g2{(const bf16_t*)(ws + WS_RKV), (const bf16_t*)(ar + AR_WO), nullptr}; pg8::SplitOrder S2{F.vcu, 4};
          pg8::EpiPartial E2{(float*)(ws + WS_PART), 4};
          pg8::gemm_phase<pg8::EpiPartial, pg8::SplitOrder, GC2, true, true>(F.lds, g2, S2, E2); }
        GRID_BAR();
    }
    PH(13) for (int rep = 0; rep <= (int)REP(13); ++rep) norm_pass<2, 4>(F, layer, layer, 2048, (layer == 0) ? F.in[I_XS] : (const float*)(ws + WS_SXB), F.out + (size_t)MP * D);
    GRID_BAR();
    PH(14) { using GC = pg8::Geo<D, D, D, 30, 0, 1 << 20, 0>; pg8::Gemm<GC> g{XN, (const bf16_t*)(ar + AR_W1), nullptr}; pg8::StaticOrder S; S.init(M, DFF, F.G, (int)blockIdx.x);
      pg8::EpiBf16<1> E{(bf16_t*)(ws + WS_H), DFF};
      pg8::gemm_phase<pg8::EpiBf16<1>, pg8::StaticOrder, GC, true, true>(F.lds, g, S, E);
          if (REP(14)) { pg8::EpiNull<true> EN; pg8::gemm_phase<pg8::EpiNull<true>, pg8::StaticOrder, GC, true, true>(F.lds, g, S, EN); } }
    GRID_BAR();
    PH(15) { using GC = pg8::Geo<DFF, DFF, DFF, 30, 0, 1 << 20, 0>; pg8::Gemm<GC> g{(const bf16_t*)(ws + WS_H), (const bf16_t*)(ar + AR_W2), nullptr}; pg8::StaticOrder S; S.init(MP, D, F.G, (int)blockIdx.x);
      pg8::EpiRes E{F.out, modl, 5120, F.out};
      for (int xb = 0; xb < EXTRA_BARS; ++xb) GRID_BAR();
      pg8::gemm_phase<pg8::EpiRes, pg8::StaticOrder, GC, true, true>(F.lds, g, S, E);
      if (REP(15)) { pg8::EpiNull<false> EN; pg8::gemm_phase<pg8::EpiNull<false>, pg8::StaticOrder, GC, true, true>(F.lds, g, S, EN); }
      using GC2 = pg8::Geo<DFF, DFF, 512, 30, 0, 1 << 20, 0, true>; pg8::Gemm<GC2> g2{(const bf16_t*)(ws + WS_H), (const bf16_t*)(ar + AR_W2), nullptr}; pg8::SplitOrder S2{F.vcu, 8};
      pg8::EpiPartial E2{(float*)(ws + WS_PART), 8};
      pg8::gemm_phase<pg8::EpiPartial, pg8::SplitOrder, GC2, true, true>(F.lds, g2, S2, E2); }
    GRID_BAR();
}

__global__ void __launch_bounds__(NT, 2) fwd_kernel(Args args) {
    extern __shared__ __attribute__((aligned(16))) unsigned char lds[];
    Frame F;
    F.lds = (LAS unsigned char*)lds; F.MISC = (volatile LAS unsigned*)(F.lds + MISC_OFF);
    F.wave = __builtin_amdgcn_readfirstlane(threadIdx.x >> 6);
    F.G = gridDim.x; { const int bx = blockIdx.x; F.vcu = (F.G % 8 == 0) ? (bx % 8) * (F.G / 8) + bx / 8 : bx; }
    F.in = args.in; F.out = args.out; F.ws = args.ws;
    for (int u = threadIdx.x; u < (LDS_BYTES - LDSCTL_OFF) / 4; u += NT) ((LAS unsigned*)(F.lds + LDSCTL_OFF))[u] = 0u;
    __syncthreads();
    XcdBarrier bar = xcd_barrier_post((unsigned*)(F.ws + WS_CTL) + CW_BAR, F.MISC + 8);
    PH(0) prologue(F);
    GRID_BAR();
    PH(0) mod_phase(F, 0, 2, F.vcu, F.G);
    GRID_BAR();
    layer_body<0>(F, bar); layer_body<1>(F, bar); layer_body<2>(F, bar); layer_body<3>(F, bar);
    PH(16) norm_pass<3, 8>(F, 0, 3, 5120, F.out + (size_t)MP * D, nullptr);
}

extern "C" void kernel_launch(void* const* d_in, const int* in_sizes, int n_in, void* d_out, int out_size, void* d_ws, size_t ws_size, hipStream_t stream) {
    static int grid = 0;
    if (grid == 0) {
        if (n_in != 38 || out_size != 28706816 || ws_size < WS_END) { fprintf(stderr, "kernel_launch: unexpected problem (n_in %d, out %d, ws %zu; need ws >= %zu)\n", n_in, out_size, ws_size, (size_t)WS_END); grid = -1; return; }
        int dev = 0, cus = 0, per_cu = 0;
        if (hipGetDevice(&dev) != hipSuccess || hipDeviceGetAttribute(&cus, hipDeviceAttributeMultiprocessorCount, dev) != hipSuccess) { grid = -1; return; }
        if (hipFuncSetAttribute((const void*)fwd_kernel, hipFuncAttributeMaxDynamicSharedMemorySize, LDS_BYTES) != hipSuccess) { fprintf(stderr, "kernel_launch: hipFuncSetAttribute failed\n"); grid = -1; return; }
        if (hipOccupancyMaxActiveBlocksPerMultiprocessor(&per_cu, (const void*)fwd_kernel, NT, LDS_BYTES) != hipSuccess || per_cu < 1) { fprintf(stderr, "kernel_launch: occupancy query says %d\n", per_cu); per_cu = 1; }
        (void)hipGetLastError();
        grid = cus;
    }
    if (grid < 0) return;
    (void)hipMemsetAsync((char*)d_ws + WS_CTL, 0, ZERO_BYTES, stream);
    Args a{};
    for (int i = 0; i < 38; ++i) a.in[i] = (const float*)d_in[i];
    a.out = (float*)d_out; a.ws = (unsigned char*)d_ws;
    void* kargs[] = {&a};
    hipError_t e = hipLaunchCooperativeKernel((const void*)fwd_kernel, dim3(grid), dim3(NT), kargs, LDS_BYTES, stream);
    if (e != hipSuccess) fprintf(stderr, "kernel_launch: cooperative launch failed: %s (grid %d)\n", hipGetErrorString(e), grid);
}
```

```cpp
#include <hip/hip_runtime.h>
#include <cstdio>
#include <cstdint>

#define LAS __attribute__((address_space(3)))
#define GAS __attribute__((address_space(1)))
typedef unsigned short bf16_t;
typedef short bf16x8 __attribute__((ext_vector_type(8)));
typedef float f32x4 __attribute__((ext_vector_type(4)));
typedef float f32x2 __attribute__((ext_vector_type(2)));
typedef unsigned u32x4 __attribute__((ext_vector_type(4)));
typedef unsigned u32x2 __attribute__((ext_vector_type(2)));

#ifndef LOCAL_SKIP
#define LOCAL_SKIP 0
#endif
constexpr int D = 1024, MP = 16384, MS = 1024, M = MP + MS, NSEQ = 33, DFF = 4096, ABIN = 3584;
constexpr int NCHUNK = 288;
constexpr int SLOT_E = 4 * 8192 + 4 * 16384;
constexpr float NORM_EPS = 1e-6f, RW_LN_EPS = 64e-5f;

constexpr size_t MiB = 1u << 20;
constexpr size_t WS_CTL = 0, WS_MOD = 1 * MiB, ZERO_BYTES = 65536;
constexpr size_t WS_ROPE = 5 * MiB;
constexpr size_t WS_ARENA = 10 * MiB;
constexpr size_t AR_W1 = 0, AR_W2 = 8 * MiB, AR_WIN = 16 * MiB, AR_WOUT = 23 * MiB, AR_WC1 = 16 * MiB, AR_WC2 = 32 * MiB, AR_WO = 34 * MiB;
constexpr size_t WS_VFIRST = 46 * MiB;
constexpr size_t WS_XN0 = 80 * MiB, WS_XN = WS_XN0 + 2048;
constexpr size_t WS_PREVS = 115 * MiB;
constexpr size_t WS_R1 = 118 * MiB;
constexpr size_t WS_Z = WS_R1, WS_STATE = WS_R1 + 120 * MiB, WS_DEC = WS_R1 + 174 * MiB;
constexpr size_t WS_H = WS_R1;
constexpr size_t WS_RKV = WS_R1, WS_LO = WS_R1 + 102 * MiB, WS_WLOG = WS_R1 + 136 * MiB, WS_G = WS_R1 + 170 * MiB;
constexpr size_t WS_TST = WS_R1 + 102 * MiB;
constexpr size_t WS_REC = WS_R1 + 204 * MiB, WS_BON = WS_R1 + 269 * MiB;
constexpr int REC_B = 16640;
constexpr size_t WS_XMIX = WS_R1 + 168 * MiB;
constexpr size_t WS_PART = WS_R1 + 136 * MiB;
constexpr size_t WS_SXB = WS_R1 + 271 * MiB;
constexpr size_t WS_END = WS_R1 + 275 * MiB;

__device__ const double ROPE_REV[32] = {0.15915494309189535, 0.11934937021124886, 0.089499401608891013, 0.067115083005227255, 0.050329212104487035, 0.037741584717419771, 0.028302195830623399, 0.02122365276477766, 0.015915494309189534, 0.011934937021124886, 0.0089499401608891024, 0.0067115083005227253, 0.0050329212104487037, 0.0037741584717419772, 0.0028302195830623399, 0.0021223652764777662, 0.0015915494309189536, 0.0011934937021124885, 0.00089499401608891024, 0.0006711508300522726, 0.00050329212104487033, 0.00037741584717419774, 0.00028302195830623395, 0.00021223652764777661, 0.00015915494309189535, 0.00011934937021124886, 8.9499401608891018e-05, 6.7115083005227254e-05, 5.0329212104487035e-05, 3.7741584717419777e-05, 2.8302195830623396e-05, 2.1223652764777659e-05};

__device__ __forceinline__ unsigned f2bf(float f) { unsigned u = __builtin_bit_cast(unsigned, f); return (u + 0x7fffu + ((u >> 16) & 1u)) >> 16; }
typedef __bf16 bf16x2_t __attribute__((ext_vector_type(2)));
__device__ __forceinline__ unsigned pk2(float lo, float hi) { const f32x2 v = {lo, hi}; const bf16x2_t b = __builtin_convertvector(v, bf16x2_t); return __builtin_bit_cast(unsigned, b); }
__device__ __forceinline__ float bf2f(unsigned short b) { return __builtin_bit_cast(float, (unsigned)b << 16); }
__device__ __forceinline__ float bflo(unsigned w) { return __builtin_bit_cast(float, w << 16); }
__device__ __forceinline__ float bfhi(unsigned w) { return __builtin_bit_cast(float, w & 0xffff0000u); }
__device__ __forceinline__ float sigmoidf_(float x) { return 1.f / (1.f + __expf(-x)); }
__device__ __forceinline__ float siluf_(float x) { return x / (1.f + __expf(-x)); }
__device__ __forceinline__ float wave_sum(float v) {
#pragma unroll
    for (int o = 1; o < 64; o <<= 1) v += __shfl_xor(v, o);
    return v;
}
__device__ __forceinline__ int otid() { int t = threadIdx.x; asm volatile("" : "+v"(t)); return t; }
__device__ __forceinline__ int seq_of_row(int r) { return r < MP ? 0 : 1 + ((r - MP) >> 5); }
#define LDS_WAIT() asm volatile("s_waitcnt lgkmcnt(0)" ::: "memory")
#define VM_WAIT() asm volatile("s_waitcnt vmcnt(0)" ::: "memory")

namespace pg8 {
constexpr int BM = 256, BK = 64, HALF = 128, HTB = HALF * BK * 2, STAGE_BYTES = 8 * HTB, NXCD = 8, WGM = 8;
__host__ __device__ __forceinline__ int lds_byte(int r, int c) { const int st = (r >> 4) * 2 + (c >> 5), rr = r & 15, cc = c & 31, ob = rr * 64 + cc * 2; return st * 1024 + (ob ^ (((ob >> 9) & 1) << 5)); }
__host__ __device__ __forceinline__ void stage_rc(int b, int& R, int& C) { const int st = b / 1024, sb = b % 1024, swz = sb ^ (((sb >> 9) & 1) << 5); R = (st >> 1) * 16 + swz / 64; C = (st & 1) * 32 + (swz % 64) / 2; }
__host__ __device__ __forceinline__ int perm32(int rho) { const int n = rho >> 4, i = rho & 15; return 8 * (i >> 2) + 4 * n + (i & 3); }

struct Unit { int pm, pn, ks; };
template <int LDA_, int LDB_, int K_, int GSHIFT_, int GSTRIDE_, int KSPLIT_, int DELTAP_, bool SPLIT_ = false> struct Geo {
    static constexpr int LDA = LDA_, LDB = LDB_, K = K_, GSHIFT = GSHIFT_, GSTRIDE = GSTRIDE_, KSPLIT = KSPLIT_, DELTAP = DELTAP_; static constexpr bool SPLIT = SPLIT_;
};
template <class GC> struct Gemm {
    const bf16_t* A; const bf16_t* Bt; const bf16_t* A2s;
    __device__ __forceinline__ const char* a_base(const Unit& u) const { return (const char*)(A + (size_t)u.pm * BM * GC::LDA + (size_t)(u.pn >> GC::GSHIFT) * GC::GSTRIDE + (GC::SPLIT ? (size_t)u.ks * GC::K : 0)); }
    __device__ __forceinline__ const char* b_base(const Unit& u) const { return (const char*)(Bt + (size_t)u.pn * BM * GC::LDB + (GC::SPLIT ? (size_t)u.ks * GC::K : 0)); }
    __device__ __forceinline__ long a_delta(const Unit& u) const {
        if constexpr (GC::KSPLIT >= GC::K / BK) return 0;
        else { if (u.pm < 64) return (long)GC::DELTAP;
            return (long)((const char*)(A2s + (size_t)(u.pm - 64) * BM * GC::LDA) - a_base(u)) - (long)GC::KSPLIT * BK * 2; }
    }
};
struct StaticOrder {
    int nM, nN, nwg, G, c;
    __host__ __device__ void init(int M_, int N_, int G_, int c_) { nM = M_ / BM; nN = N_ / BM; nwg = nM * nN; G = G_; c = c_; }
    __host__ __device__ bool next(int i, Unit& u) const {
        const long L = (long)i * G + c; if (L >= nwg) return false;
        int wgid = (int)L; { const int q = nwg / NXCD, r = nwg % NXCD, xcd = wgid % NXCD, off = wgid / NXCD; wgid = (xcd < r ? xcd * (q + 1) : r * (q + 1) + (xcd - r) * q) + off; }
        const int nig = WGM * nN, gid = wgid / nig, fm = gid * WGM, gsz = (nM - fm) < WGM ? (nM - fm) : WGM;
        u.pm = fm + ((wgid % nig) % gsz); u.pn = (wgid % nig) / gsz; u.ks = 0; return true;
    }
};
__device__ __forceinline__ unsigned cvt_pk_bf16(float lo, float hi) { return pk2(lo, hi); }

template <class Epi, class Sched, class GC, bool ALIGN_EPI = false, bool SP2 = false>
__device__ __forceinline__ void gemm_phase(LAS unsigned char* lds, const Gemm<GC> g, const Sched& S, const Epi& E) {
    const int tid = otid(), wid = __builtin_amdgcn_readfirstlane(tid >> 6), lane = tid & 63, wr = wid >> 2, wc = wid & 3, fr = lane & 15, fq = lane >> 4;
    constexpr int K = GC::K, nt = K / BK, ksplit = GC::KSPLIT;
    unsigned voffA[2], voffB[2];
#pragma unroll
    for (int i = 0; i < 2; ++i) { int R, C; stage_rc(tid * 16 + i * 8192, R, C); const int Rb = Epi::PERM ? ((R & ~31) + perm32(R & 31)) : R;
        voffA[i] = (unsigned)(R * GC::LDA + C) * 2u; voffB[i] = (unsigned)(Rb * GC::LDB + C) * 2u; }
    constexpr size_t kstep = (size_t)(BK * 2);
    constexpr size_t hstepA = (size_t)HALF * GC::LDA * 2, hstepB = (size_t)HALF * GC::LDB * 2;
    const unsigned ldsw = (unsigned)wid * 1024u;
    const int aoff = lds_byte(wr * 64 + fr, fq * 8), boff = lds_byte(wc * 32 + fr, fq * 8);
#define PG8_SA(b, h) (((b) * 2 + (h)) * HTB)
#define PG8_SB(b, h) ((4 + (b) * 2 + (h)) * HTB)
#define PG8_STAGE(bufoff, gbase, voff) do { _Pragma("unroll") for (int _i = 0; _i < 2; ++_i) \
        __builtin_amdgcn_global_load_lds((const unsigned*)((const char*)(gbase) + (voff)[_i]), (LAS unsigned*)(lds + (bufoff) + ldsw + _i * 8192), 16, 0, 0); } while (0)
#define PG8_LDA(dst, b, h) do { _Pragma("unroll") for (int m = 0; m < 4; ++m) _Pragma("unroll") for (int k = 0; k < 2; ++k) dst[m][k] = *(const LAS bf16x8*)(lds + PG8_SA(b, h) + aoff + m * 2048 + k * 1024); } while (0)
#define PG8_LDB(dst, b, h) do { _Pragma("unroll") for (int n = 0; n < 2; ++n) _Pragma("unroll") for (int k = 0; k < 2; ++k) dst[n][k] = *(const LAS bf16x8*)(lds + PG8_SB(b, h) + boff + n * 2048 + k * 1024); } while (0)
#define PG8_MMA(ai, bj, At, Bt) do { __builtin_amdgcn_s_setprio(1); _Pragma("unroll") for (int m = 0; m < 4; ++m) _Pragma("unroll") for (int n = 0; n < 2; ++n) _Pragma("unroll") for (int k = 0; k < 2; ++k) \
        acc[ai][bj][m][n] = __builtin_amdgcn_mfma_f32_16x16x32_bf16(Bt[n][k], At[m][k], acc[ai][bj][m][n], 0, 0, 0); __builtin_amdgcn_s_setprio(0); } while (0)
#define PG8_WAIT_V(n) asm volatile("s_waitcnt vmcnt(" #n ")" ::: "memory")
#define PG8_WAIT_L(n) asm volatile("s_waitcnt lgkmcnt(" #n ")" ::: "memory")
#define PG8_BAR __builtin_amdgcn_s_barrier()
#define PG8_SCHED __builtin_amdgcn_sched_barrier(0)
    Unit cur, nxt; int ui = 0;
    if (!S.next(0, cur)) return;
    f32x4 acc[2][2][4][2];
#pragma unroll
    for (int a = 0; a < 2; ++a)
#pragma unroll
        for (int b = 0; b < 2; ++b)
#pragma unroll
            for (int m = 0; m < 4; ++m)
#pragma unroll
                for (int n = 0; n < 2; ++n) acc[a][b][m][n] = (f32x4){0.f, 0.f, 0.f, 0.f};
    bf16x8 At[4][2], B0[2][2], B1[2][2];
    const char* cA = g.a_base(cur); const char* cB = g.b_base(cur); long cD = g.a_delta(cur);
    if constexpr (SP2) {
        PG8_STAGE(PG8_SB(0, 0), cB, voffB); PG8_STAGE(PG8_SB(0, 1), cB + hstepB, voffB); PG8_STAGE(PG8_SA(0, 0), cA, voffA); PG8_STAGE(PG8_SA(0, 1), cA + hstepA, voffA);
        if (wr == 1) PG8_BAR;
        PG8_WAIT_V(2); PG8_BAR;
        PG8_STAGE(PG8_SB(1, 0), cB + kstep, voffB); PG8_STAGE(PG8_SA(1, 0), cA + kstep, voffA); PG8_STAGE(PG8_SB(1, 1), cB + hstepB + kstep, voffB);
        PG8_WAIT_V(6); PG8_BAR;
    } else {
        PG8_STAGE(PG8_SB(0, 0), cB, voffB); PG8_STAGE(PG8_SA(0, 0), cA, voffA); PG8_STAGE(PG8_SB(0, 1), cB + hstepB, voffB); PG8_STAGE(PG8_SA(0, 1), cA + hstepA, voffA);
        if (wr == 1) PG8_BAR;
        PG8_WAIT_V(4); PG8_BAR;
        PG8_STAGE(PG8_SB(1, 0), cB + kstep, voffB); PG8_STAGE(PG8_SA(1, 0), cA + kstep, voffA); PG8_STAGE(PG8_SB(1, 1), cB + hstepB + kstep, voffB);
        PG8_WAIT_V(6); PG8_BAR;
    }
    for (;;) {
        const bool has_next = S.next(ui + 1, nxt);
        const char* nA = has_next ? g.a_base(nxt) : cA; const char* nB = has_next ? g.b_base(nxt) : cB;
        const long nD = has_next ? g.a_delta(nxt) : cD;
#pragma unroll 1
        for (int t = 0; t < nt; t += 2) {
            const bool last = (t == nt - 2);
            const char* a1 = cA + (size_t)(t + 1) * kstep + (t >= ksplit ? cD : 0);
            const char* a2 = last ? nA : cA + (size_t)(t + 2) * kstep + (t + 2 >= ksplit ? cD : 0); const char* b2 = last ? nB : cB + (size_t)(t + 2) * kstep;
            const char* a3 = a2 + kstep; const char* b3 = b2 + kstep;
            if constexpr (SP2) {
            PG8_LDB(B0, 0, 0); PG8_LDB(B1, 0, 1); PG8_SCHED; PG8_LDA(At, 0, 0); PG8_STAGE(PG8_SA(1, 1), a1 + hstepA, voffA);
            PG8_WAIT_V(8); PG8_WAIT_L(0); PG8_BAR; PG8_MMA(0, 0, At, B0); PG8_MMA(0, 1, At, B1); PG8_BAR; PG8_SCHED;
            PG8_LDA(At, 0, 1); PG8_STAGE(PG8_SB(0, 0), b2, voffB); PG8_STAGE(PG8_SB(0, 1), b2 + hstepB, voffB); PG8_STAGE(PG8_SA(0, 0), a2, voffA);
            PG8_WAIT_V(8); PG8_WAIT_L(0); PG8_BAR; PG8_MMA(1, 0, At, B0); PG8_MMA(1, 1, At, B1); PG8_BAR; PG8_SCHED;
            PG8_LDB(B0, 1, 0); PG8_LDB(B1, 1, 1); PG8_SCHED; PG8_LDA(At, 1, 0); PG8_STAGE(PG8_SA(0, 1), a2 + hstepA, voffA);
            PG8_WAIT_V(8); PG8_WAIT_L(0); PG8_BAR; PG8_MMA(0, 0, At, B0); PG8_MMA(0, 1, At, B1); PG8_BAR; PG8_SCHED;
            PG8_LDA(At, 1, 1); PG8_STAGE(PG8_SB(1, 0), b3, voffB); PG8_STAGE(PG8_SB(1, 1), b3 + hstepB, voffB); PG8_STAGE(PG8_SA(1, 0), a3, voffA);
            PG8_WAIT_V(8); PG8_WAIT_L(0); PG8_BAR; PG8_MMA(1, 0, At, B0); PG8_MMA(1, 1, At, B1); PG8_BAR; PG8_SCHED;
            } else {
            PG8_LDB(B0, 0, 0); PG8_SCHED; PG8_LDA(At, 0, 0); PG8_STAGE(PG8_SA(1, 1), a1 + hstepA, voffA);
            PG8_WAIT_L(8); PG8_BAR; PG8_WAIT_L(0); PG8_MMA(0, 0, At, B0); PG8_BAR; PG8_SCHED;
            PG8_LDB(B1, 0, 1); PG8_STAGE(PG8_SB(0, 0), b2, voffB);
            PG8_BAR; PG8_WAIT_L(0); PG8_MMA(0, 1, At, B1); PG8_BAR;
            PG8_LDA(At, 0, 1); PG8_STAGE(PG8_SA(0, 0), a2, voffA);
            PG8_BAR; PG8_WAIT_L(0); PG8_MMA(1, 0, At, B0); PG8_BAR; PG8_SCHED;
            PG8_STAGE(PG8_SB(0, 1), b2 + hstepB, voffB);
            PG8_WAIT_V(6); PG8_BAR; PG8_MMA(1, 1, At, B1); PG8_BAR;
            PG8_LDB(B0, 1, 0); PG8_SCHED; PG8_LDA(At, 1, 0); PG8_STAGE(PG8_SA(0, 1), a2 + hstepA, voffA);
            PG8_WAIT_L(8); PG8_BAR; PG8_WAIT_L(0); PG8_MMA(0, 0, At, B0); PG8_BAR; PG8_SCHED;
            PG8_LDB(B1, 1, 1); PG8_STAGE(PG8_SB(1, 0), b3, voffB);
            PG8_BAR; PG8_WAIT_L(0); PG8_MMA(0, 1, At, B1); PG8_BAR;
            PG8_LDA(At, 1, 1); PG8_STAGE(PG8_SA(1, 0), a3, voffA);
            PG8_BAR; PG8_WAIT_L(0); PG8_MMA(1, 0, At, B0); PG8_BAR; PG8_SCHED;
            PG8_STAGE(PG8_SB(1, 1), b3 + hstepB, voffB);
            PG8_WAIT_V(6); PG8_BAR; PG8_MMA(1, 1, At, B1); PG8_BAR;
            }
        }
        if constexpr (ALIGN_EPI) { if (wr == 0) PG8_BAR; }
        E(acc, cur, wr, wc, fr, fq);
        if (!has_next) break;
#pragma unroll
        for (int a = 0; a < 2; ++a)
#pragma unroll
            for (int b = 0; b < 2; ++b)
#pragma unroll
                for (int m = 0; m < 4; ++m)
#pragma unroll
                    for (int n = 0; n < 2; ++n) acc[a][b][m][n] = (f32x4){0.f, 0.f, 0.f, 0.f};
        cur = nxt; cA = nA; cB = nB; cD = nD; ++ui;
        if constexpr (ALIGN_EPI) { if (wr == 1) PG8_BAR; }
    }
    PG8_WAIT_V(0);
    if constexpr (!ALIGN_EPI) { if (wr == 0) PG8_BAR; }
    PG8_BAR;
#undef PG8_SA
#undef PG8_SB
#undef PG8_STAGE
#undef PG8_LDA
#undef PG8_LDB
#undef PG8_MMA
#undef PG8_WAIT_V
#undef PG8_WAIT_L
#undef PG8_BAR
#undef PG8_SCHED
}

__device__ __forceinline__ float act_apply(float v, int act) {
    if (act == 1) { const float r = v > 0.f ? v : 0.f; return r * r; }
    if (act == 2) { const float e = __expf(-2.f * fabsf(v)); const float t = (1.f - e) / (1.f + e); return v < 0.f ? -t : t; }
    if (act == 3) return 1.f / (1.f + __expf(-v));
    return v;
}
template <int ACT> __device__ __forceinline__ void store_tile_bf16(const f32x4 (&acc)[2][2][4][2], bf16_t* base, int ldc, int row0, int col0, bf16_t* base2, int ldc2, int col2) {
#pragma unroll
    for (int ai = 0; ai < 2; ++ai)
#pragma unroll
        for (int m = 0; m < 4; ++m) { const size_t r = (size_t)(row0 + ai * HALF + m * 16);
#pragma unroll
            for (int bj = 0; bj < 2; ++bj) { f32x4 v0 = acc[ai][bj][m][0], v1 = acc[ai][bj][m][1];
#pragma unroll
                for (int q = 0; q < 4; ++q) { v0[q] = act_apply(v0[q], ACT); v1[q] = act_apply(v1[q], ACT); }
                u32x4 w; w.x = cvt_pk_bf16(v0[0], v0[1]); w.y = cvt_pk_bf16(v0[2], v0[3]); w.z = cvt_pk_bf16(v1[0], v1[1]); w.w = cvt_pk_bf16(v1[2], v1[3]);
                *(u32x4*)(base + r * ldc + col0 + bj * HALF) = w;
                if (base2) *(u32x4*)(base2 + r * ldc2 + col2 + bj * HALF) = w; } }
}
template <int ACT> struct EpiBf16 {
    static constexpr bool PERM = true;
    bf16_t* O; int ldc;
    __device__ __forceinline__ void operator()(const f32x4 (&acc)[2][2][4][2], const Unit& u, int wr, int wc, int fr, int fq) const {
        store_tile_bf16<ACT>(acc, O, ldc, u.pm * BM + wr * 64 + fr, u.pn * BM + wc * 32 + 8 * fq, nullptr, 0, 0);
    }
};
struct EpiRkv {
    static constexpr bool PERM = true;
    bf16_t* RKV; bf16_t* LO; bf16_t* vf;
    __device__ __forceinline__ void operator()(const f32x4 (&acc)[2][2][4][2], const Unit& u, int wr, int wc, int fr, int fq) const {
        const int row0 = u.pm * BM + wr * 64 + fr, cin = wc * 32 + 8 * fq;
        if (u.pn < 12) { bf16_t* b2 = (u.pn >= 8) ? vf : nullptr; store_tile_bf16<0>(acc, RKV, 3072, row0, u.pn * BM + cin, b2, 1024, (u.pn - 8) * BM + cin); }
        else {
#pragma unroll
            for (int bj = 0; bj < 2; ++bj) { const int c = cin + bj * HALF; int dst = -1, act = 0;
                if (u.pn == 12) { if (c < 64) { dst = c; act = 2; } else if (c < 128) dst = 256 + (c - 64); else if (c < 160) dst = 512 + (c - 128); }
                else if (c < 160) { dst = 768 + c; act = 3; }
                if (dst >= 0) {
#pragma unroll
                    for (int ai = 0; ai < 2; ++ai)
#pragma unroll
                        for (int m = 0; m < 4; ++m) { const size_t r = (size_t)(row0 + ai * HALF + m * 16); f32x4 v0 = acc[ai][bj][m][0], v1 = acc[ai][bj][m][1];
#pragma unroll
                            for (int q = 0; q < 4; ++q) { v0[q] = act_apply(v0[q], act); v1[q] = act_apply(v1[q], act); }
                            u32x4 w; w.x = cvt_pk_bf16(v0[0], v0[1]); w.y = cvt_pk_bf16(v0[2], v0[3]); w.z = cvt_pk_bf16(v1[0], v1[1]); w.w = cvt_pk_bf16(v1[2], v1[3]);
                            *(u32x4*)(LO + r * 1024 + dst) = w; } } }
        }
    }
};
struct EpiRes {
    static constexpr bool PERM = false;
    float* X; const float* modl; int goff; const float* Xin;
    __device__ __forceinline__ void operator()(const f32x4 (&acc)[2][2][4][2], const Unit& u, int wr, int wc, int fr, int fq) const {
        const int col0 = u.pn * BM + wc * 32 + 4 * fq;
#pragma unroll
        for (int ai = 0; ai < 2; ++ai)
#pragma unroll
            for (int m = 0; m < 4; ++m) { const int r = u.pm * BM + ai * HALF + wr * 64 + m * 16 + fr; const float* gp = modl + (size_t)seq_of_row(r) * 6144 + goff + col0; float* xp = X + (size_t)r * D + col0; const float* xi = Xin + (size_t)r * D + col0;
#pragma unroll
                for (int bj = 0; bj < 2; ++bj)
#pragma unroll
                    for (int n = 0; n < 2; ++n) { const f32x4 gv = *(const f32x4*)(gp + bj * HALF + n * 16); f32x4 xv = *(const f32x4*)(xi + bj * HALF + n * 16);
                        xv = xv + gv * acc[ai][bj][m][n]; *(f32x4*)(xp + bj * HALF + n * 16) = xv; }
                asm volatile("" ::: "memory"); }
    }
};
struct EpiLora2 {
    static constexpr bool PERM = true, AFTER_DRAIN = false;
    bf16_t* WLOG; bf16_t* Aout; bf16_t* G; bf16_t* RKV; const bf16_t* vf; const float* w0; const float* a0; const float* v0;
    template <int GRP> __device__ __forceinline__ void run(const f32x4 (&acc)[2][2][4][2], const Unit& u, int wr, int wc, int fr, int fq) const {
        const int col0 = (u.pn & 3) * BM + wc * 32 + 8 * fq;
#pragma unroll
        for (int ai = 0; ai < 2; ++ai)
#pragma unroll
            for (int m = 0; m < 4; ++m) { const size_t r = (size_t)(u.pm * BM + ai * HALF + wr * 64 + m * 16 + fr);
#pragma unroll
                for (int bj = 0; bj < 2; ++bj) { const int c = col0 + bj * HALF; float a[8], o[8];
#pragma unroll
                    for (int q = 0; q < 4; ++q) { a[q] = acc[ai][bj][m][0][q]; a[4 + q] = acc[ai][bj][m][1][q]; }
                    if constexpr (GRP == 0) { const f32x4 b0 = *(const f32x4*)(w0 + c), b1 = *(const f32x4*)(w0 + c + 4);
#pragma unroll
                        for (int q = 0; q < 8; ++q) { const float x = -((q < 4 ? b0[q & 3] : b1[q & 3]) + a[q]); const float sp = fmaxf(x, 0.f) + __logf(1.f + __expf(-fabsf(x))); o[q] = -__expf(-sp - 0.5f); }
                        u32x4 w; w.x = cvt_pk_bf16(o[0], o[1]); w.y = cvt_pk_bf16(o[2], o[3]); w.z = cvt_pk_bf16(o[4], o[5]); w.w = cvt_pk_bf16(o[6], o[7]); *(u32x4*)(WLOG + r * D + c) = w; }
                    else if constexpr (GRP == 1) { const f32x4 b0 = *(const f32x4*)(a0 + c), b1 = *(const f32x4*)(a0 + c + 4);
#pragma unroll
                        for (int q = 0; q < 8; ++q) o[q] = 1.f / (1.f + __expf(-((q < 4 ? b0[q & 3] : b1[q & 3]) + a[q])));
                        u32x4 w; w.x = cvt_pk_bf16(o[0], o[1]); w.y = cvt_pk_bf16(o[2], o[3]); w.z = cvt_pk_bf16(o[4], o[5]); w.w = cvt_pk_bf16(o[6], o[7]); *(u32x4*)(Aout + r * D + c) = w; }
                    else if constexpr (GRP == 2) { const f32x4 b0 = *(const f32x4*)(v0 + c), b1 = *(const f32x4*)(v0 + c + 4); const u32x4 vv = *(const u32x4*)(RKV + r * 3072 + 2048 + c), ff = *(const u32x4*)(vf + r * D + c);
#pragma unroll
                        for (int q = 0; q < 8; ++q) { const float vx = (q & 1) ? bfhi(vv[q >> 1]) : bflo(vv[q >> 1]), fx = (q & 1) ? bfhi(ff[q >> 1]) : bflo(ff[q >> 1]);
                            const float gte = 1.f / (1.f + __expf(-((q < 4 ? b0[q & 3] : b1[q & 3]) + a[q]))); o[q] = vx + (fx - vx) * gte; }
                        u32x4 w; w.x = cvt_pk_bf16(o[0], o[1]); w.y = cvt_pk_bf16(o[2], o[3]); w.z = cvt_pk_bf16(o[4], o[5]); w.w = cvt_pk_bf16(o[6], o[7]); *(u32x4*)(RKV + r * 3072 + 2048 + c) = w; }
                    else { u32x4 w; w.x = cvt_pk_bf16(a[0], a[1]); w.y = cvt_pk_bf16(a[2], a[3]); w.z = cvt_pk_bf16(a[4], a[5]); w.w = cvt_pk_bf16(a[6], a[7]); *(u32x4*)(G + r * D + c) = w; } }
                asm volatile("" ::: "memory"); }
    }
    __device__ __forceinline__ void operator()(const f32x4 (&acc)[2][2][4][2], const Unit& u, int wr, int wc, int fr, int fq) const {
        const int grp = u.pn >> 2;
        if (grp == 0) run<0>(acc, u, wr, wc, fr, fq);
        else if (grp == 1) run<1>(acc, u, wr, wc, fr, fq);
        else if (grp == 2) { if (vf != nullptr) run<2>(acc, u, wr, wc, fr, fq); }
        else run<3>(acc, u, wr, wc, fr, fq);
    }
};
struct SplitOrder {
    int c, splitk;
    __device__ bool next(int i, Unit& u) const { if (i != 0 || c >= 16 * splitk) return false; const int t = c / splitk; u.pm = 64 + (t >> 2); u.pn = t & 3; u.ks = c % splitk; return true; }
};
struct SkipVOrder {
    StaticOrder S; bool skip;
    __device__ bool next(int i, Unit& u) const { if (!S.next(i, u)) return false; if (skip && u.pn >= 8) u.pn += 4; return true; }
};
struct LoraOrder {
    int c;
    __device__ bool next(int i, Unit& u) const { const int idx = c - 48; if (i != 0 || idx < 0 || idx >= 136) return false; u.pm = idx >> 1; u.pn = 12 + (idx & 1); u.ks = 0; return true; }
};
struct EpiPartial {
    static constexpr bool PERM = false;
    float* PART; int splitk;
    __device__ __forceinline__ void operator()(const f32x4 (&acc)[2][2][4][2], const Unit& u, int wr, int wc, int fr, int fq) const {
        float* base = PART + ((size_t)(((u.pm - 64) * 4 + u.pn) * splitk + u.ks) << 16) + wc * 32 + 4 * fq;
#pragma unroll
        for (int ai = 0; ai < 2; ++ai)
#pragma unroll
            for (int m = 0; m < 4; ++m) { float* rp = base + (ai * HALF + wr * 64 + m * 16 + fr) * 256;
#pragma unroll
                for (int bj = 0; bj < 2; ++bj)
#pragma unroll
                    for (int n = 0; n < 2; ++n) *(f32x4*)(rp + bj * HALF + n * 16) = acc[ai][bj][m][n]; }
    }
};
template <bool PERM_> struct EpiNull {
    static constexpr bool PERM = PERM_;
    __device__ __forceinline__ void operator()(const f32x4 (&acc)[2][2][4][2], const Unit&, int, int, int, int) const {
#pragma unroll
        for (int a = 0; a < 2; ++a)
#pragma unroll
            for (int b = 0; b < 2; ++b)
#pragma unroll
                for (int m = 0; m < 4; ++m)
#pragma unroll
                    for (int n = 0; n < 2; ++n) asm volatile("" :: "v"(acc[a][b][m][n]));
    }
};
}

#define RLX_AGENT __ATOMIC_RELAXED, __HIP_MEMORY_SCOPE_AGENT
#define XB_TMO      128
#define XB_XCNT(j)  (256  + 64 * (j))
#define XB_XSUB(j)  (1280 + 64 * (j))
#define XB_XGEN(j)  (2304 + 64 * (j))
#define XB_TOP      3328
#define XB_TOPGEN   3392
#define XCD_BAR_WORDS 3456
#define XB_SPIN_CAP (1u << 24)
__device__ __forceinline__ unsigned xb_ld(unsigned* p)              { return __hip_atomic_load(p, __ATOMIC_RELAXED, __HIP_MEMORY_SCOPE_AGENT); }
__device__ __forceinline__ unsigned xb_add(unsigned* p, unsigned v) { return __hip_atomic_fetch_add(p, v, __ATOMIC_RELAXED, __HIP_MEMORY_SCOPE_AGENT); }
__device__ __forceinline__ unsigned xb_xcc_id() { return (unsigned)__builtin_amdgcn_s_getreg((3 << 11) | 20) & 0xFu; }
#define XB_SPIN(cond, bar) do { unsigned _sp = 0; while (cond) { __builtin_amdgcn_s_sleep(4); \
    if ((++_sp & 255u) == 0u) { if (xb_ld(&(bar)[XB_TMO])) break; if (_sp > XB_SPIN_CAP) { atomicAdd(&(bar)[XB_TMO], 1u); break; } } } } while (0)
struct XcdBarrier { unsigned* bar; unsigned x; volatile LAS unsigned* st; };
__device__ __forceinline__ XcdBarrier xcd_barrier_post(unsigned* bar, volatile LAS unsigned* st) {
    XcdBarrier b; b.bar = bar; b.x = xb_xcc_id(); b.st = st;
    if (threadIdx.x == 0) (void)xb_add(&bar[XB_XCNT(b.x)], 1u);
    return b;
}
__device__ __forceinline__ void xcd_barrier_complete(unsigned* bar, unsigned x, unsigned& nloc, unsigned& nx) {
    const unsigned G = gridDim.x * gridDim.y * gridDim.z;
    unsigned sum, cnt, mine, sp = 0u;
    for (;;) {
        sum = 0u; cnt = 0u; mine = 0u;
#pragma unroll
        for (unsigned j = 0; j < 16; ++j) { const unsigned c = xb_ld(&bar[XB_XCNT(j)]); sum += c; cnt += (c > 0u) ? 1u : 0u; mine = (j == x) ? c : mine; }
        if (sum == G) break;
        __builtin_amdgcn_s_sleep(1);
        if ((++sp & 255u) == 0u) { if (xb_ld(&bar[XB_TMO])) break; if (sp > XB_SPIN_CAP) { atomicAdd(&bar[XB_TMO], 1u); break; } }
    }
    nloc = mine > 0u ? mine : 1u; nx = cnt > 0u ? cnt : 1u;
}
__device__ __forceinline__ void xcd_barrier(const XcdBarrier& b) {
    asm volatile("s_waitcnt vmcnt(0)" ::: "memory");
    __syncthreads();
    if (threadIdx.x == 0) {
        unsigned* bar = b.bar;
        __builtin_amdgcn_s_waitcnt(0);
        unsigned nloc = b.st[0], nx = b.st[1];
        if (nloc == 0u) { xcd_barrier_complete(bar, b.x, nloc, nx); b.st[0] = nloc; b.st[1] = nx; }
        const unsigned gen = b.st[2];
        const unsigned old = xb_add(&bar[XB_XSUB(b.x)], 1u);
        if (old + 1u == (gen + 1u) * nloc) {
            __builtin_amdgcn_fence(__ATOMIC_RELEASE, "agent");
            asm volatile("s_waitcnt vmcnt(0)" ::: "memory");
            const unsigned og = xb_add(&bar[XB_TOP], 1u);
            if (og + 1u == (gen + 1u) * nx) xb_add(&bar[XB_TOPGEN], 1u);
            else XB_SPIN(xb_ld(&bar[XB_TOPGEN]) == gen, bar);
        } else {
            XB_SPIN(xb_ld(&bar[XB_TOPGEN]) == gen, bar);
        }
        __builtin_amdgcn_fence(__ATOMIC_ACQUIRE, "agent");
        asm volatile("s_waitcnt vmcnt(0)" ::: "memory");
        b.st[2] = gen + 1u;
    }
    __syncthreads();
}

constexpr int NWAVES = 8, NT = NWAVES * 64;
constexpr int RING_BYTES = 131072, LDSCTL_OFF = RING_BYTES, MISC_OFF = LDSCTL_OFF + 320, LDS_BYTES = 147456;
constexpr int CW_BAR = 4096;

struct Args { const float* in[38]; float* out; unsigned char* ws; };
struct Frame {
    LAS unsigned char* lds; volatile LAS unsigned* MISC;
    int wave, vcu, G;
    const float* const* in; float* out; unsigned char* ws;
};
enum { I_XP = 0, I_XS, I_SRET, I_SHG, I_SWKV, I_SSHIFT, I_CP, I_CS, I_MODW, I_MODB, I_NMIXG, I_NMLPG, I_FINALG, I_W1, I_W2, I_ABWIN, I_ABWOUT, I_HGLB, I_HGNG,
       I_MU, I_WRKV, I_RW0, I_RW1, I_RW2, I_RA0, I_RA1, I_RA2, I_RV0, I_RV1, I_RV2, I_RG1, I_RG2, I_RKK, I_RKA, I_RRK, I_RLNG, I_RLNB, I_RWOUT };
constexpr size_t O_Y = 0, O_RETP = 17825792, O_RETS = 17891328, O_HGP = 19988480, O_HGS = 20119552, O_WKVP = 24313856, O_WKVS = 24444928, O_SHP = 28639232, O_SHS = 28641280;

__device__ __forceinline__ void transpose_item(const float* W, int N, bf16_t* WT, int ldt, int row_off, int col_off, const float* mu, int mode, LAS float* scr, int item, int lane) {
    const int nblk = N / 32, kb = item / nblk, nb = item % nblk, k0 = 64 * kb, n0 = 32 * nb;
#pragma unroll 8
    for (int i = 0; i < 32; ++i) { const int kk = 2 * i + (lane >> 5); float s = 1.f; if (mode == 1) s = 1.f - mu[k0 + kk]; else if (mode == 2) s = mu[k0 + kk];
        scr[kk * 33 + (lane & 31)] = W[(size_t)(k0 + kk) * N + n0 + (lane & 31)] * s; }
    LDS_WAIT(); asm volatile("" ::: "memory");
    const int c = lane & 7;
#pragma unroll
    for (int j = 0; j < 4; ++j) { const int n = (lane >> 3) + 8 * j; const LAS float* s = scr + (8 * c) * 33 + n;
        u32x4 o; o.x = pk2(s[0 * 33], s[1 * 33]); o.y = pk2(s[2 * 33], s[3 * 33]); o.z = pk2(s[4 * 33], s[5 * 33]); o.w = pk2(s[6 * 33], s[7 * 33]);
        *(u32x4*)(WT + (size_t)(row_off + n0 + n) * ldt + col_off + k0 + 8 * c) = o; }
    LDS_WAIT(); asm volatile("" ::: "memory");
}
__device__ __forceinline__ void convert_layer_weights(Frame& F, int layer) {
    const int tid = otid(); const int lane = tid & 63; (void)lane;
    LAS float* scr = (LAS float*)(F.lds + F.wave * 16384);
    const int gw = F.vcu * NWAVES + F.wave, NGW = F.G * NWAVES;
    unsigned char* ar = F.ws + WS_ARENA;
    const int m = layer >> 1;
    constexpr int I_1 = (D / 64) * (DFF / 32), I_2 = (DFF / 64) * (D / 32);
    const float* w1 = F.in[I_W1] + (size_t)layer * D * DFF; const float* w2 = F.in[I_W2] + (size_t)layer * DFF * D;
    if ((layer & 1) == 0) {
        constexpr int I_IN = (D / 64) * (ABIN / 32), I_OUT = (D / 64) * (D / 32), NI = I_1 + I_2 + I_IN + I_OUT;
        const float* win = F.in[I_ABWIN] + (size_t)m * D * ABIN; const float* wout = F.in[I_ABWOUT] + (size_t)m * D * D;
        for (int it = gw; it < NI; it += NGW) { int r = it;
            if (r < I_1) { transpose_item(w1, DFF, (bf16_t*)(ar + AR_W1), D, 0, 0, nullptr, 0, scr, r, lane); continue; } r -= I_1;
            if (r < I_2) { transpose_item(w2, D, (bf16_t*)(ar + AR_W2), DFF, 0, 0, nullptr, 0, scr, r, lane); continue; } r -= I_2;
            if (r < I_IN) { transpose_item(win, ABIN, (bf16_t*)(ar + AR_WIN), D, 0, 0, nullptr, 0, scr, r, lane); continue; } r -= I_IN;
            transpose_item(wout, D, (bf16_t*)(ar + AR_WOUT), D, 0, 0, nullptr, 0, scr, r, lane); }
    } else {
        constexpr int I_P = (D / 64) * (D / 32), NI = I_1 + I_2 + 4 * I_P;
        const float* mu = F.in[I_MU] + (size_t)m * 6 * D; const float* wrkv = F.in[I_WRKV] + (size_t)m * 3 * D * D; const float* wo = F.in[I_RWOUT] + (size_t)m * D * D;
        bf16_t* wc1 = (bf16_t*)(ar + AR_WC1);
        for (int it = gw; it < NI; it += NGW) { int r = it;
            if (r < I_1) { transpose_item(w1, DFF, (bf16_t*)(ar + AR_W1), D, 0, 0, nullptr, 0, scr, r, lane); continue; } r -= I_1;
            if (r < I_2) { transpose_item(w2, D, (bf16_t*)(ar + AR_W2), DFF, 0, 0, nullptr, 0, scr, r, lane); continue; } r -= I_2;
            if (r < 3 * I_P) { const int p = r / I_P;
                transpose_item(wrkv + (size_t)p * D * D, D, wc1, 2048, p * D, 0, nullptr, 0, scr, r % I_P, lane); continue; } r -= 3 * I_P;
            transpose_item(wo, D, (bf16_t*)(ar + AR_WO), D, 0, 0, nullptr, 0, scr, r, lane); }
        const int gt = F.vcu * NT + tid, NG = F.G * NT;
        const float* lw1 = F.in[I_RW1] + (size_t)m * D * 64; const float* la1 = F.in[I_RA1] + (size_t)m * D * 64; const float* lv1 = F.in[I_RV1]; const float* lg1 = F.in[I_RG1] + (size_t)m * D * 160;
        for (int idx = gt; idx < 512 * 2048; idx += NG) { const int n = idx >> 11, k = idx & 2047, kk = k & 1023, nn = n & 255;
            const float* src = nullptr; int ns = 0, mi = 0, nc = 0;
            if (n < 256) { if (nn < 64) { src = lw1; ns = 64; mi = 1; nc = nn; } else if (nn < 128) { src = la1; ns = 64; mi = 4; nc = nn - 64; } else if (nn < 160 && m == 1) { src = lv1; ns = 32; mi = 3; nc = nn - 128; } }
            else if (nn < 160) { src = lg1; ns = 160; mi = 5; nc = nn; }
            float v = 0.f; if (src) { const float muv = mu[mi * D + kk]; v = src[(size_t)kk * ns + nc] * (k < 1024 ? 1.f - muv : muv); }
            wc1[(size_t)(3072 + n) * 2048 + k] = (bf16_t)f2bf(v); }
        bf16_t* wc2 = (bf16_t*)(ar + AR_WC2);
        const float* lw2 = F.in[I_RW2] + (size_t)m * 64 * D; const float* la2 = F.in[I_RA2] + (size_t)m * 64 * D; const float* lv2 = F.in[I_RV2]; const float* lg2 = F.in[I_RG2] + (size_t)m * 160 * D;
        for (int idx = gt; idx < 4096 * 256; idx += NG) { const int k = idx >> 12, n = idx & 4095, g = n >> 10, nn = n & 1023;
            const float* src = (g == 0) ? lw2 : (g == 1) ? la2 : (g == 2) ? lv2 : lg2; const int ks = (g == 0 || g == 1) ? 64 : (g == 2 ? 32 : 160);
            float v = 0.f; if (k < ks && !(g == 2 && m == 0)) v = src[(size_t)k * D + nn];
            wc2[(size_t)n * 256 + k] = (bf16_t)f2bf(v); }
    }
}

__device__ __forceinline__ void mod_phase(Frame& F, int l_lo, int l_hi, int wb, int nb) {
    const int tid = otid(); const int lane = tid & 63;
    const float* __restrict__ SC = (const float*)(F.ws + WS_MOD + 3584 * 1024);
    float* MOD = (float*)(F.ws + WS_MOD);
    LAS float* red = (LAS float*)F.lds;
    for (int task = l_lo * 96 + wb; task < l_hi * 96; task += nb) { const int l = task / 96, n = (task % 96) * 64 + lane, ks = F.wave;
        const float* w = F.in[I_MODW] + ((size_t)l * D + ks * 128) * 6144 + n;
        float acc[NSEQ];
#pragma unroll
        for (int s = 0; s < NSEQ; ++s) acc[s] = 0.f;
        for (int k = 0; k < 128; k += 4) { const float w0 = w[(size_t)k * 6144], w1 = w[(size_t)(k + 1) * 6144], w2 = w[(size_t)(k + 2) * 6144], w3 = w[(size_t)(k + 3) * 6144];
#pragma unroll
            for (int s = 0; s < NSEQ; ++s) { const f32x4 c4 = *(const f32x4*)(SC + s * D + ks * 128 + k); acc[s] += (c4[0] * w0 + c4[1] * w1) + (c4[2] * w2 + c4[3] * w3); } }
        __syncthreads();
#pragma unroll
        for (int s = 0; s < NSEQ; ++s) red[(F.wave * NSEQ + s) * 64 + lane] = acc[s];
        __syncthreads();
        for (int i = tid; i < NSEQ * 64; i += NT) { const int s = i >> 6, c = i & 63; float t = F.in[I_MODB][l * 6144 + (task % 96) * 64 + c];
#pragma unroll
            for (int q = 0; q < 8; ++q) t += red[(q * NSEQ + s) * 64 + c];
            MOD[((size_t)l * NSEQ + s) * 6144 + (task % 96) * 64 + c] = t; }
    }
    __syncthreads();
}

__device__ __forceinline__ void prologue(Frame& F) {
    const int tid = otid(); const int lane = tid & 63; (void)lane;
    const int gt = F.vcu * NT + tid, NG = F.G * NT;
    { f32x2* tab = (f32x2*)(F.ws + WS_ROPE);
      for (int i = gt; i < 16384 * 32; i += NG) { const int p = i >> 5, d = i & 31; double rev = (double)p * ROPE_REV[d]; rev -= floor(rev); const float fr = (float)rev;
          tab[i] = (f32x2){__builtin_amdgcn_cosf(fr), __builtin_amdgcn_sinf(fr)}; } }
    { unsigned* z = (unsigned*)(F.ws + WS_XN0); for (int i = gt; i < 512; i += NG) z[i] = 0u; }
    { float* SC = (float*)(F.ws + WS_MOD + 3584 * 1024);
      for (int i = gt; i < NSEQ * D; i += NG) { const int s = i >> 10, k = i & 1023; const float c = (s == 0) ? F.in[I_CP][k] : F.in[I_CS][(size_t)(s - 1) * D + k]; SC[i] = siluf_(c); } }
    convert_layer_weights(F, 0);
}

template <int MODE> __device__ __forceinline__ void norm_row(Frame& F, int layer, int r, f32x4 (&v)[4], const float* MOD, const float* gvec, int lane, f32x4 (&ho)[4]) {
    const int m = layer >> 1; const int shoff = (MODE == 2) ? 3072 : 0, scoff = (MODE == 2) ? 4096 : 1024;
    bf16_t* XN = (bf16_t*)(F.ws + WS_XN); bf16_t* PREVS = (bf16_t*)(F.ws + WS_PREVS);
    float* xrow = F.out + (size_t)r * D; float s2 = 0.f;
#pragma unroll
    for (int j = 0; j < 4; ++j) s2 += (v[j].x * v[j].x + v[j].y * v[j].y) + (v[j].z * v[j].z + v[j].w * v[j].w);
    const float rstd = 1.f / sqrtf(wave_sum(s2) * (1.f / D) + NORM_EPS);
    const int seq = seq_of_row(r); const float* mp = MOD + (size_t)seq * 6144;
#pragma unroll
    for (int j = 0; j < 4; ++j) { const int c = 4 * lane + 256 * j; const f32x4 g4 = *(const f32x4*)(gvec + c); f32x4 o = v[j] * rstd * g4;
        if (MODE == 3) { *((f32x4*)xrow + lane + 64 * j) = o; continue; }
        const f32x4 sc = *(const f32x4*)(mp + scoff + c), sh = *(const f32x4*)(mp + shoff + c);
        o = o * (1.f + sc) + sh; ho[j] = o;
        const unsigned long long pk = (unsigned long long)pk2(o.x, o.y) | ((unsigned long long)pk2(o.z, o.w) << 32);
        *(unsigned long long*)(XN + (size_t)r * D + c) = pk;
        if (MODE == 1) {
            if (r >= MP) { const int t = (r - MP) & 31; if (t < 31) *(unsigned long long*)(PREVS + (size_t)(r - MP + 1) * D + c) = pk;
                else *(f32x4*)(F.out + O_SHS + ((size_t)m * 32 + ((r - MP) >> 5)) * D + c) = o;
                if (t == 0) { const f32x4 ss = *(const f32x4*)(F.in[I_SSHIFT] + ((size_t)m * 32 + ((r - MP) >> 5)) * D + c);
                    *(unsigned long long*)(PREVS + (size_t)(r - MP) * D + c) = (unsigned long long)pk2(ss.x, ss.y) | ((unsigned long long)pk2(ss.z, ss.w) << 32); } }
            else if (r == MP - 1) *(f32x4*)(F.out + O_SHP + (size_t)m * D + c) = o;
        } }
}
__device__ __forceinline__ void hmix_calc(const float* mp, const float* gvec, const f32x4 (&v)[4], int lane, f32x4 (&h)[4]) {
    float s2 = 0.f;
#pragma unroll
    for (int j = 0; j < 4; ++j) s2 += (v[j].x * v[j].x + v[j].y * v[j].y) + (v[j].z * v[j].z + v[j].w * v[j].w);
    const float rstd = 1.f / sqrtf(wave_sum(s2) * (1.f / D) + NORM_EPS);
#pragma unroll
    for (int j = 0; j < 4; ++j) { const int c = 4 * lane + 256 * j; const f32x4 g4 = *(const f32x4*)(gvec + c), sc = *(const f32x4*)(mp + 1024 + c), sh = *(const f32x4*)(mp + c); h[j] = v[j] * rstd * g4 * (1.f + sc) + sh; }
}
__device__ __forceinline__ void write_mixes(Frame& F, int m, int r, const f32x4 (&h)[4], const f32x4 (&p)[4], int lane) {
    bf16_t* XM = (bf16_t*)(F.ws + WS_XMIX); const float* mu = F.in[I_MU] + (size_t)m * 6 * D;
#pragma unroll
    for (int j = 0; j < 4; ++j) { const int c = 4 * lane + 256 * j; const f32x4 d = p[j] - h[j];
#pragma unroll
        for (int q = 0; q < 3; ++q) { const f32x4 mv = *(const f32x4*)(mu + (q == 0 ? 0 : (q == 1 ? 2 : 3)) * D + c); const f32x4 x = h[j] + d * mv;
            *(unsigned long long*)(XM + ((size_t)q * M + r) * D + c) = (unsigned long long)pk2(x.x, x.y) | ((unsigned long long)pk2(x.z, x.w) << 32); } }
}
template <int MODE, int PEND = 0, bool FIRSTP = false> __device__ __forceinline__ void norm_pass(Frame& F, int layer, int player, int pgoff, const float* sx_in, float* sx_out) {
    const int tid = otid(); const int lane = tid & 63;
    const int gw = F.vcu * NWAVES + F.wave, NGW = F.G * NWAVES;
    const float* MOD = (const float*)(F.ws + WS_MOD) + (size_t)layer * NSEQ * 6144;
    const float* gvec = (MODE == 3) ? F.in[I_FINALG] : (MODE == 2 ? F.in[I_NMLPG] + layer * D : F.in[I_NMIXG] + layer * D);
    constexpr int HALO = (MODE == 1) ? 1 : 0;
    LAS float* xs = (LAS float*)F.lds;
    const int m = layer >> 1; const int r0s = MP + 4 * F.vcu;
    const float* gmod = (const float*)(F.ws + WS_MOD) + (size_t)player * NSEQ * 6144 + pgoff;
    if constexpr (PEND > 0) {
        __syncthreads();
#pragma unroll
        for (int q = 0; q < (4 + HALO + 1) / 2; ++q) { const int idx = tid + q * NT, rr = idx >> 8, c4 = (idx & 255) * 4; const int r = r0s - HALO + rr;
            if (rr < 4 + HALO && !(HALO && rr == 0 && ((r0s - MP) & 31) == 0)) {
                const int pn = c4 >> 8; const float* pb = (const float*)(F.ws + WS_PART) + ((size_t)((((r >> 8) - 64) * 4 + pn) * PEND) << 16) + (r & 255) * 256 + (c4 & 255);
                f32x4 acc = (f32x4){0.f, 0.f, 0.f, 0.f};
#pragma unroll
                for (int ks = 0; ks < PEND; ++ks) acc += *(const f32x4*)(pb + ((size_t)ks << 16));
                const f32x4 g4 = *(const f32x4*)(gmod + (size_t)seq_of_row(r) * 6144 + c4); f32x4 x4 = *(const f32x4*)(sx_in + (size_t)(r - MP) * D + c4);
                x4 = x4 + g4 * acc; if (sx_out != nullptr && !(HALO && rr == 0)) *(f32x4*)(sx_out + (size_t)(r - MP) * D + c4) = x4; *(LAS f32x4*)(xs + rr * 1024 + c4) = x4; } }
        __syncthreads();
    }
    for (int r = gw; r < MP; r += NGW) {
        const f32x4* xr = (const f32x4*)((FIRSTP ? F.in[I_XP] : F.out) + (size_t)r * D) + lane; f32x4 v[4], ho[4];
#pragma unroll
        for (int j = 0; j < 4; ++j) v[j] = xr[64 * j];
        if constexpr (MODE == 1) { f32x4 pv[4], hp[4];
#pragma unroll
            for (int j = 0; j < 4; ++j) pv[j] = (r > 0) ? *((const f32x4*)(F.out + (size_t)(r - 1) * D) + lane + 64 * j) : (f32x4){0.f, 0.f, 0.f, 0.f};
            norm_row<MODE>(F, layer, r, v, MOD, gvec, lane, ho);
            if (r > 0) hmix_calc(MOD, gvec, pv, lane, hp); else {
#pragma unroll
                for (int j = 0; j < 4; ++j) hp[j] = (f32x4){0.f, 0.f, 0.f, 0.f}; }
            write_mixes(F, m, r, ho, hp, lane);
        } else norm_row<MODE>(F, layer, r, v, MOD, gvec, lane, ho);
    }
    if (F.wave < 4 && 4 * F.vcu + F.wave < MS) { const int r = r0s + F.wave; f32x4 v[4], ho[4];
#pragma unroll
        for (int j = 0; j < 4; ++j) { if constexpr (PEND > 0) v[j] = *(const LAS f32x4*)(xs + (F.wave + HALO) * 1024 + 4 * lane + 256 * j); else v[j] = *((const f32x4*)(sx_in + (size_t)(r - MP) * D) + lane + 64 * j); }
        norm_row<MODE>(F, layer, r, v, MOD, gvec, lane, ho);
        if constexpr (MODE == 1) { f32x4 hp[4]; const int t = (r - MP) & 31, sq = (r - MP) >> 5;
            if (t == 0) {
#pragma unroll
                for (int j = 0; j < 4; ++j) hp[j] = *((const f32x4*)(F.in[I_SSHIFT] + ((size_t)m * 32 + sq) * D) + lane + 64 * j);
            } else { f32x4 pv[4];
#pragma unroll
                for (int j = 0; j < 4; ++j) pv[j] = *(const LAS f32x4*)(xs + (F.wave + HALO - 1) * 1024 + 4 * lane + 256 * j);
                hmix_calc(MOD + (size_t)(1 + sq) * 6144, gvec, pv, lane, hp); }
            write_mixes(F, m, r, ho, hp, lane); } }
}

template <int MT, int NTT> __device__ __forceinline__ void wave_mm_nt(f32x4 (&acc)[MT][NTT], const LAS bf16_t* X, int ldx, const LAS bf16_t* Y, int ldy, int K, int fr, int fq) {
    for (int k0 = 0; k0 < K; k0 += 32) {
        bf16x8 xa[MT], yb[NTT];
#pragma unroll
        for (int i = 0; i < MT; ++i) xa[i] = *(const LAS bf16x8*)(X + (16 * i + fr) * ldx + k0 + 8 * fq);
#pragma unroll
        for (int j = 0; j < NTT; ++j) yb[j] = *(const LAS bf16x8*)(Y + (16 * j + fr) * ldy + k0 + 8 * fq);
#pragma unroll
        for (int i = 0; i < MT; ++i)
#pragma unroll
            for (int j = 0; j < NTT; ++j) acc[i][j] = __builtin_amdgcn_mfma_f32_16x16x32_bf16(yb[j], xa[i], acc[i][j], 0, 0, 0);
    }
}

constexpr int LQS = 0, LKS = 18432, LQG = 36864, LVT = 55296, LST = 73728, LPS = 108544, LRED = 117760, LBS = 118784;
__device__ __forceinline__ void chunk_geom(int c, int& r0, int& pos0) { if (c < 256) { r0 = 64 * c; pos0 = 64 * c; } else { r0 = MP + 32 * (c - 256); pos0 = 2048; } }

template <int L, bool HG, bool SUMMARY> __device__ __forceinline__ void ab_load(Frame& F, int layer, int c, int h) {
    const int tid = otid(); const int lane = tid & 63; (void)lane;
    const int m = layer >> 1; int r0, pos0; chunk_geom(c, r0, pos0);
    const bf16_t* Z = (const bf16_t*)(F.ws + WS_Z);
    LAS bf16_t* QS = (LAS bf16_t*)(F.lds + LQS); LAS bf16_t* KS = (LAS bf16_t*)(F.lds + LKS); LAS bf16_t* QG = (LAS bf16_t*)(F.lds + LQG); LAS bf16_t* VT = (LAS bf16_t*)(F.lds + LVT);
    constexpr int LDT = L + 8;
    if constexpr (HG) {
        constexpr int TQ = L / 4; LAS float* BS = (LAS float*)(F.lds + LBS);
        const int ch = tid & 127, qtr = tid >> 7;
        float lb = 0.f;
        if (m == 1) { const float a0 = F.in[I_HGLB][h * 128 + ch], a1 = F.in[I_HGLB][512 + h * 128 + ch]; lb = 1.f / (1.f + __expf(a0 - a1)); }
        { constexpr int NP = L * 16;
#pragma unroll
          for (int q = 0; q < (NP + NT - 1) / NT; ++q) { const int v = tid + q * NT; if (NP % NT == 0 || v < NP) { const int j = v >> 4, c8 = v & 15; const size_t zr = (size_t)(r0 + j) * ABIN + h * 128 + c8 * 8;
                  const u32x4 zf4 = *(const u32x4*)(Z + zr + 2048), v4 = *(const u32x4*)(Z + zr + 2560);
                  *(LAS u32x4*)(QG + j * 136 + c8 * 8) = zf4; *(LAS u32x4*)(KS + j * 136 + c8 * 8) = v4;
                  if constexpr (!SUMMARY) { const u32x4 q4 = *(const u32x4*)(Z + zr + 1536); *(LAS u32x4*)(QS + j * 136 + c8 * 8) = q4; } } } }
        __syncthreads();
        float zf[TQ], cs[TQ]; float run = 0.f;
#pragma unroll
        for (int jj = 0; jj < TQ; ++jj) { const int j = qtr * TQ + jj; zf[jj] = bf2f(QG[j * 136 + ch]);
            float lf; if (lb == 0.f) lf = fminf(zf[jj], 0.f) - __logf(1.f + __expf(-fabsf(zf[jj]))); else lf = __logf(lb + (1.f - lb) * sigmoidf_(zf[jj]));
            run += lf; cs[jj] = run; }
        BS[qtr * 128 + ch] = run;
        __syncthreads();
        const float b0 = BS[ch], b1 = BS[128 + ch], b2 = BS[256 + ch], b3 = BS[384 + ch];
        const float off = (qtr > 0 ? b0 : 0.f) + (qtr > 1 ? b1 : 0.f) + (qtr > 2 ? b2 : 0.f), bL = (b0 + b1) + (b2 + b3), bmid = b0 + b1;
        if constexpr (SUMMARY) {
#pragma unroll
            for (int j8 = 0; j8 < TQ; j8 += 8) { unsigned vv[8]; float kd[8];
#pragma unroll
                for (int q = 0; q < 8; ++q) { const int jj = j8 + q, j = qtr * TQ + jj; const float b = off + cs[jj]; const float kb = (1.f - lb) * sigmoidf_(-zf[jj]); vv[q] = KS[j * 136 + ch]; kd[q] = kb * __expf(bL - b); }
                u32x4 pv, pk; pv.x = vv[0] | (vv[1] << 16); pv.y = vv[2] | (vv[3] << 16); pv.z = vv[4] | (vv[5] << 16); pv.w = vv[6] | (vv[7] << 16);
                pk.x = pk2(kd[0], kd[1]); pk.y = pk2(kd[2], kd[3]); pk.z = pk2(kd[4], kd[5]); pk.w = pk2(kd[6], kd[7]);
                *(LAS u32x4*)(VT + ch * LDT + qtr * TQ + j8) = pv; *(LAS u32x4*)(QS + ch * LDT + qtr * TQ + j8) = pk; }
            if (qtr == 0) ((float*)(F.ws + WS_DEC))[((size_t)c * 4 + h) * 128 + ch] = __expf(bL);
        } else {
#pragma unroll
            for (int j8 = 0; j8 < TQ; j8 += 8) { unsigned vv[8];
#pragma unroll
                for (int q8 = 0; q8 < 8; ++q8) { const int jj = j8 + q8, j = qtr * TQ + jj; const float b = off + cs[jj]; const float kb = (1.f - lb) * sigmoidf_(-zf[jj]);
                    const float q = siluf_(bf2f(QS[j * 136 + ch])); vv[q8] = KS[j * 136 + ch];
                    QS[j * 136 + ch] = (bf16_t)f2bf(q * __expf(b - bmid)); KS[j * 136 + ch] = (bf16_t)f2bf(kb * __expf(bmid - b)); QG[j * 136 + ch] = (bf16_t)f2bf(q * __expf(b)); }
                u32x4 pv; pv.x = vv[0] | (vv[1] << 16); pv.y = vv[2] | (vv[3] << 16); pv.z = vv[4] | (vv[5] << 16); pv.w = vv[6] | (vv[7] << 16);
                *(LAS u32x4*)(VT + ch * LDT + qtr * TQ + j8) = pv; }
        }
    } else {
        const float logg = log1pf(-exp2f(-5.f - (float)h));
        const f32x2* rope = (const f32x2*)(F.ws + WS_ROPE);
        for (int it = tid; it < L * 4; it += NT) { const int j = it >> 2, d8 = it & 3; const size_t zr = (size_t)(r0 + j) * ABIN;
            const f32x2* rp = rope + (size_t)(pos0 + j) * 32 + d8 * 8;
            const u32x4 k1 = *(const u32x4*)(Z + zr + 256 + h * 64 + d8 * 8), k2 = *(const u32x4*)(Z + zr + 256 + h * 64 + 32 + d8 * 8);
            const float gk = __expf((float)(L - 1 - j) * logg), gq = __expf((float)(j + 1) * logg);
            u32x4 q1 = (u32x4){0, 0, 0, 0}, q2 = q1; if constexpr (!SUMMARY) { q1 = *(const u32x4*)(Z + zr + h * 64 + d8 * 8); q2 = *(const u32x4*)(Z + zr + h * 64 + 32 + d8 * 8); }
#pragma unroll
            for (int e = 0; e < 8; ++e) { const f32x2 cs_ = rp[e]; const unsigned wk1 = k1[e >> 1], wk2 = k2[e >> 1]; const float x1 = (e & 1) ? bfhi(wk1) : bflo(wk1), x2 = (e & 1) ? bfhi(wk2) : bflo(wk2);
                const float o1 = x1 * cs_.x - x2 * cs_.y, o2 = x1 * cs_.y + x2 * cs_.x; const int d = d8 * 8 + e;
                if constexpr (SUMMARY) { QS[d * LDT + j] = (bf16_t)f2bf(o1 * gk); QS[(d + 32) * LDT + j] = (bf16_t)f2bf(o2 * gk); }
                else { KS[j * 72 + d] = (bf16_t)f2bf(o1); KS[j * 72 + d + 32] = (bf16_t)f2bf(o2);
                    const unsigned wq1 = q1[e >> 1], wq2 = q2[e >> 1]; const float y1 = (e & 1) ? bfhi(wq1) : bflo(wq1), y2 = (e & 1) ? bfhi(wq2) : bflo(wq2);
                    const float p1 = (y1 * cs_.x - y2 * cs_.y) * 0.125f, p2 = (y1 * cs_.y + y2 * cs_.x) * 0.125f;
                    QS[j * 72 + d] = (bf16_t)f2bf(p1); QS[j * 72 + d + 32] = (bf16_t)f2bf(p2); QG[j * 72 + d] = (bf16_t)f2bf(p1 * gq); QG[j * 72 + d + 32] = (bf16_t)f2bf(p2 * gq); } } }
        for (int it = tid; it < L * 16; it += NT) { const int j = it >> 4, e8 = it & 15; const u32x4 vv = *(const u32x4*)(Z + (size_t)(r0 + j) * ABIN + 512 + h * 128 + e8 * 8);
#pragma unroll
            for (int e = 0; e < 8; ++e) { const unsigned w = vv[e >> 1]; VT[(e8 * 8 + e) * LDT + j] = (bf16_t)((e & 1) ? (w >> 16) : (w & 0xffffu)); } }
    }
}

template <int L, bool HG> __device__ __forceinline__ void ab_summary_unit(Frame& F, int layer, int c, int h) {
    const int tid = otid(); const int lane = tid & 63; (void)lane;
    constexpr int DK = HG ? 128 : 64, NCT = DK / 16, LDT = L + 8;
    __syncthreads();
    ab_load<L, HG, true>(F, layer, c, h);
    __syncthreads();
    const int fr = lane & 15, fq = lane >> 4;
    const LAS bf16_t* KDT = (const LAS bf16_t*)(F.lds + LQS); const LAS bf16_t* VT = (const LAS bf16_t*)(F.lds + LVT);
    f32x4 acc[1][NCT];
#pragma unroll
    for (int j = 0; j < NCT; ++j) acc[0][j] = (f32x4){0.f, 0.f, 0.f, 0.f};
    wave_mm_nt<1, NCT>(acc, VT + F.wave * 16 * LDT, LDT, KDT, LDT, L, fr, fq);
    bf16_t* ST = (bf16_t*)(F.ws + WS_STATE) + (size_t)c * SLOT_E + (HG ? 32768 + h * 16384 : h * 8192);
    const int e = F.wave * 16 + fr;
#pragma unroll
    for (int j = 0; j < NCT; ++j) { u32x2 w; w.x = pk2(acc[0][j][0], acc[0][j][1]); w.y = pk2(acc[0][j][2], acc[0][j][3]); *(u32x2*)(ST + (size_t)e * DK + 16 * j + 4 * fq) = w; }
}

template <int L, bool HG> __device__ __forceinline__ void ab_output_unit(Frame& F, int layer, int c, int h) {
    const int tid = otid(); const int lane = tid & 63; (void)lane;
    constexpr int DK = HG ? 128 : 64, LDQ = HG ? 136 : 72, LDT = L + 8, NIT = L / 16, WPI = 8 / NIT, ET = 8 / WPI, TPW = (NIT * NIT >= 8) ? NIT * NIT / 8 : 1;
    const int m = layer >> 1; int r0, pos0; chunk_geom(c, r0, pos0);
    __syncthreads();
    ab_load<L, HG, false>(F, layer, c, h);
    LAS bf16_t* QS = (LAS bf16_t*)(F.lds + LQS); LAS bf16_t* KS = (LAS bf16_t*)(F.lds + LKS); LAS bf16_t* QG = (LAS bf16_t*)(F.lds + LQG); LAS bf16_t* VT = (LAS bf16_t*)(F.lds + LVT);
    LAS bf16_t* STl = (LAS bf16_t*)(F.lds + LST); LAS bf16_t* PS = (LAS bf16_t*)(F.lds + LPS); LAS float* RED = (LAS float*)(F.lds + LRED);
    { const bf16_t* ST = (const bf16_t*)(F.ws + WS_STATE) + (size_t)c * SLOT_E + (HG ? 32768 + h * 16384 : h * 8192);
      for (int it = tid; it < 128 * DK / 8; it += NT) { const int e = it / (DK / 8), c8 = it % (DK / 8); *(LAS u32x4*)(STl + e * LDQ + c8 * 8) = *(const u32x4*)(ST + (size_t)e * DK + c8 * 8); } }
    __syncthreads();
    const int fr = lane & 15, fq = lane >> 4, w = F.wave;
    const float logg = HG ? 0.f : log1pf(-exp2f(-5.f - (float)h));
    if (w * TPW < NIT * NIT) {
        const int it = (w * TPW) / NIT, jt0 = (w * TPW) % NIT;
        f32x4 sc[1][TPW];
#pragma unroll
        for (int q = 0; q < TPW; ++q) sc[0][q] = (f32x4){0.f, 0.f, 0.f, 0.f};
        wave_mm_nt<1, TPW>(sc, QS + it * 16 * LDQ, LDQ, KS + jt0 * 16 * LDQ, LDQ, DK, fr, fq);
        const int i = it * 16 + fr;
#pragma unroll
        for (int q = 0; q < TPW; ++q) { float p[4];
#pragma unroll
            for (int r = 0; r < 4; ++r) { const int j = (jt0 + q) * 16 + 4 * fq + r; float v = sc[0][q][r]; if (!HG) v *= __expf((float)(i - j) * logg); p[r] = (j <= i) ? v : 0.f; }
            u32x2 pw; pw.x = pk2(p[0], p[1]); pw.y = pk2(p[2], p[3]); *(LAS u32x2*)(PS + i * LDT + (jt0 + q) * 16 + 4 * fq) = pw; }
    }
    __syncthreads();
    const int it = w % NIT, eg = w / NIT;
    f32x4 o[1][ET];
#pragma unroll
    for (int q = 0; q < ET; ++q) o[0][q] = (f32x4){0.f, 0.f, 0.f, 0.f};
    wave_mm_nt<1, ET>(o, PS + it * 16 * LDT, LDT, VT + eg * ET * 16 * LDT, LDT, L, fr, fq);
    wave_mm_nt<1, ET>(o, QG + it * 16 * LDQ, LDQ, STl + eg * ET * 16 * LDQ, LDQ, DK, fr, fq);
    float ss = 0.f;
#pragma unroll
    for (int q = 0; q < ET; ++q) ss += (o[0][q][0] * o[0][q][0] + o[0][q][1] * o[0][q][1]) + (o[0][q][2] * o[0][q][2] + o[0][q][3] * o[0][q][3]);
    ss += __shfl_xor(ss, 16); ss += __shfl_xor(ss, 32);
    const int i = it * 16 + fr;
    if (fq == 0) RED[i * 4 + eg] = ss;
    __syncthreads();
    float tot = 0.f;
#pragma unroll
    for (int q = 0; q < WPI; ++q) tot += RED[i * 4 + q];
    const float rstd = 1.f / sqrtf(tot * (1.f / 128.f) + NORM_EPS);
    const bf16_t* Z = (const bf16_t*)(F.ws + WS_Z); bf16_t* O = (bf16_t*)(F.ws + WS_XN);
    const size_t row = (size_t)(r0 + i);
#pragma unroll
    for (int q = 0; q < ET; ++q) { const int e = (eg * ET + q) * 16 + 4 * fq; const u32x2 gw = *(const u32x2*)(Z + row * ABIN + (HG ? 3072 : 1024) + h * 128 + e);
        const float g4[4] = {bflo(gw.x), bfhi(gw.x), bflo(gw.y), bfhi(gw.y)}; float ov[4];
#pragma unroll
        for (int r = 0; r < 4; ++r) { if (HG) ov[r] = o[0][q][r] * rstd * F.in[I_HGNG][m * 128 + e + r] * sigmoidf_(g4[r]); else ov[r] = o[0][q][r] * rstd * siluf_(g4[r]); }
        u32x2 ow; ow.x = pk2(ov[0], ov[1]); ow.y = pk2(ov[2], ov[3]); *(u32x2*)(O + row * D + (HG ? 512 : 0) + h * 128 + e) = ow; }
}

template <bool DRY = false> __device__ __forceinline__ void ab_scan(Frame& F, int layer) {
    const int tid = otid(); const int lane = tid & 63; (void)lane;
    const int m = layer >> 1;
    unsigned* ST32 = (unsigned*)(F.ws + WS_STATE); const float* DEC = (const float*)(F.ws + WS_DEC);
    constexpr int NP = SLOT_E / 2;
    const int gt = F.vcu * NT + tid;
    if (gt < NP) {
        const int eo = 2 * gt; const bool hg = eo >= 32768; const int eo2 = hg ? eo - 32768 : eo; const int head = hg ? eo2 >> 14 : eo2 >> 13; const int cch = hg ? (eo2 & 127) : (eo2 & 63); const int e = hg ? ((eo2 & 16383) >> 7) : ((eo2 & 8191) >> 6);
        const float gdec = hg ? 0.f : __expf(64.f * log1pf(-exp2f(-5.f - (float)head)));
        float s0 = 0.f, s1 = 0.f;
        for (int c0 = 0; c0 < 256; c0 += 32) {
            unsigned kv[32]; float d0[32], d1[32];
#pragma unroll
            for (int u = 0; u < 32; ++u) { kv[u] = ST32[(size_t)(c0 + u) * NP + gt]; if (hg) { const f32x2 dd = *(const f32x2*)(DEC + ((size_t)(c0 + u) * 4 + head) * 128 + cch); d0[u] = dd.x; d1[u] = dd.y; } else { d0[u] = gdec; d1[u] = gdec; } }
#pragma unroll
            for (int u = 0; u < 32; ++u) { const unsigned pw = pk2(s0, s1); if constexpr (DRY) asm volatile("" :: "v"(pw)); else ST32[(size_t)(c0 + u) * NP + gt] = pw; s0 = d0[u] * s0 + bflo(kv[u]); s1 = d1[u] * s1 + bfhi(kv[u]); }
        }
        float* outp = hg ? F.out + O_HGP + (size_t)m * 65536 + head * 16384 : F.out + O_RETP + (size_t)m * 32768 + head * 8192;
        outp[(size_t)cch * 128 + e] = s0; outp[(size_t)(cch + 1) * 128 + e] = s1;
    } else {
        const int NG2 = F.G * NT - NP; if (NG2 <= 0) return;
        for (int idx = gt - NP; idx < 32 * NP; idx += NG2) { const int b = idx / NP, pr = idx % NP;
            const int eo = 2 * pr; const bool hg = eo >= 32768; const int eo2 = hg ? eo - 32768 : eo; const int head = hg ? eo2 >> 14 : eo2 >> 13; const int cch = hg ? (eo2 & 127) : (eo2 & 63); const int e = hg ? ((eo2 & 16383) >> 7) : ((eo2 & 8191) >> 6);
            float d0, d1; if (hg) { const f32x2 dd = *(const f32x2*)(DEC + ((size_t)(256 + b) * 4 + head) * 128 + cch); d0 = dd.x; d1 = dd.y; } else { d0 = d1 = __expf(32.f * log1pf(-exp2f(-5.f - (float)head))); }
            const size_t so = hg ? ((size_t)(m * 32 + b) * 4 + head) * 16384 : ((size_t)(m * 32 + b) * 4 + head) * 8192;
            const float* sin_ = (hg ? F.in[I_SHG] : F.in[I_SRET]) + so; float* sout = F.out + (hg ? O_HGS : O_RETS) + so;
            const float i0 = sin_[(size_t)cch * 128 + e], i1 = sin_[(size_t)(cch + 1) * 128 + e];
            const unsigned kv = ST32[(size_t)(256 + b) * NP + pr]; if constexpr (!DRY) ST32[(size_t)(256 + b) * NP + pr] = pk2(i0, i1);
            sout[(size_t)cch * 128 + e] = d0 * i0 + bflo(kv); sout[(size_t)(cch + 1) * 128 + e] = d1 * i1 + bfhi(kv); }
    }
}

constexpr int RL_AT = 0, RL_RT = 9216, RL_BT = 18432, RL_KT = 27648, RL_BHT = 36864, RL_KHT = 46080, RL_VT = 55296, RL_AAB = 64512, RL_AAK = 81920, RL_ARB = 91136, RL_ARK = 100352,
              RL_U0T = 109568, RL_VEC = 118784, RL_PSUM = 119808;
constexpr int RL_G = RL_AAB, RL_WW = RL_BT, RL_APT = RL_AAK;
constexpr int RL_PL = RL_AT, RL_RL = RL_BT, RL_Y0L = RL_BT + 4608, RL_QTL = RL_AAB, RL_S = RL_BHT;
__device__ __forceinline__ int pperm(int k) { return 32 * (k >> 5) + 8 * ((k >> 2) & 3) + 4 * ((k >> 4) & 1) + (k & 3); }

struct OutSide { u32x2 vv[4], gg[4]; f32x4 lg[4], lb[4]; float bon; };
__device__ __forceinline__ void rwkv_out_side(Frame& F, int m, size_t row, int h, int fq, OutSide& o) {
    const bf16_t* RKV = (const bf16_t*)(F.ws + WS_RKV); const bf16_t* GG = (const bf16_t*)(F.ws + WS_G); const float* BON = (const float*)(F.ws + WS_BON);
    o.bon = BON[row * 16 + h];
#pragma unroll
    for (int nt = 0; nt < 4; ++nt) { const int i = h * 64 + 16 * nt + 4 * fq;
        o.lg[nt] = *(const f32x4*)(F.in[I_RLNG] + m * D + i); o.lb[nt] = *(const f32x4*)(F.in[I_RLNB] + m * D + i);
        o.vv[nt] = *(const u32x2*)(RKV + row * 3072 + 2048 + i); o.gg[nt] = *(const u32x2*)(GG + row * D + i); }
}
template <bool DRY = false> __device__ __forceinline__ void rwkv_out_core(Frame& F, const f32x4 (&y)[4], size_t row, int h, int fq, const OutSide& sd) {
    bf16_t* RKV = (bf16_t*)(F.ws + WS_RKV);
    float s1 = 0.f;
#pragma unroll
    for (int nt = 0; nt < 4; ++nt) s1 += (y[nt][0] + y[nt][1]) + (y[nt][2] + y[nt][3]);
    s1 += __shfl_xor(s1, 16); s1 += __shfl_xor(s1, 32);
    const float mean = s1 * (1.f / 64.f); float s2 = 0.f;
#pragma unroll
    for (int nt = 0; nt < 4; ++nt)
#pragma unroll
        for (int r = 0; r < 4; ++r) { const float d = y[nt][r] - mean; s2 += d * d; }
    s2 += __shfl_xor(s2, 16); s2 += __shfl_xor(s2, 32);
    const float rstd = 1.f / sqrtf(s2 * (1.f / 64.f) + RW_LN_EPS), bon = sd.bon;
#pragma unroll
    for (int nt = 0; nt < 4; ++nt) { const int i = h * 64 + 16 * nt + 4 * fq; const f32x4 lg = sd.lg[nt], lb = sd.lb[nt]; const u32x2 vv = sd.vv[nt], gg = sd.gg[nt];
        const float v4[4] = {bflo(vv.x), bfhi(vv.x), bflo(vv.y), bfhi(vv.y)}, g4[4] = {bflo(gg.x), bfhi(gg.x), bflo(gg.y), bfhi(gg.y)}; float o[4];
#pragma unroll
        for (int r = 0; r < 4; ++r) o[r] = ((y[nt][r] - mean) * rstd * lg[r] + lb[r] + bon * v4[r]) * g4[r];
        u32x2 w; w.x = pk2(o[0], o[1]); w.y = pk2(o[2], o[3]); if constexpr (DRY) asm volatile("" :: "v"(w.x), "v"(w.y)); else *(u32x2*)(RKV + row * 3072 + i) = w; }
}
template <bool DRY = false> __device__ __forceinline__ void rwkv_out_epilogue(Frame& F, int m, const f32x4 (&y)[4], size_t row, int h, int fq) {
    OutSide sd; rwkv_out_side(F, m, row, h, fq, sd); rwkv_out_core<DRY>(F, y, row, h, fq, sd);
}

typedef short s16x4 __attribute__((ext_vector_type(4)));
__device__ __forceinline__ s16x4 pack4(const f32x4& v) { u32x2 p; p.x = pk2(v[0], v[1]); p.y = pk2(v[2], v[3]); return __builtin_bit_cast(s16x4, p); }
template <int S> struct TinvStep {
    static __device__ __forceinline__ void run(float (&y)[16], f32x4 (&nq)[3][4], const LAS float* dp) {
        if constexpr (S >= 1) {
            if constexpr (S - 2 >= 1) {
#pragma unroll
                for (int k = 0; k < (S - 2 + 3) / 4; ++k) nq[(S - 2) % 3][k] = *(const LAS f32x4*)(dp + (S - 2) * 20 + 4 * k);
            }
            const float ys = y[S];
#pragma unroll
            for (int q = 0; q < S; ++q) { y[q] += nq[S % 3][q >> 2][q & 3] * ys; asm volatile("" : "+v"(y[q])); }
            asm volatile("" ::: "memory");
            TinvStep<S - 1>::run(y, nq, dp);
        }
    }
};
struct RawRegs { u32x4 r, k, v, w, a; };
__device__ __forceinline__ void rwkv_load_raw(Frame& F, int u, int tid, RawRegs& raw) {
    const int c = u >> 4, h = u & 15; int r0, pos0; chunk_geom(c, r0, pos0); const int L = c < 256 ? 64 : 32; int t = tid >> 3; t = t < L ? t : 0;
    const bf16_t* RKV = (const bf16_t*)(F.ws + WS_RKV); const bf16_t* WLOG = (const bf16_t*)(F.ws + WS_WLOG); const bf16_t* AA = (const bf16_t*)(F.ws + WS_XN);
    const size_t row = (size_t)(r0 + t); const int col = h * 64 + 8 * (tid & 7);
    raw.r = *(const u32x4*)(RKV + row * 3072 + col); raw.k = *(const u32x4*)(RKV + row * 3072 + 1024 + col); raw.v = *(const u32x4*)(RKV + row * 3072 + 2048 + col);
    raw.w = *(const u32x4*)(WLOG + row * D + col); raw.a = *(const u32x4*)(AA + row * D + col);
}
template <int L, bool DRY = false> __device__ __forceinline__ void rwkv_local_unit(Frame& F, int layer, int c, int h, RawRegs& raw, int unext) {
    const int tid = otid(); const int lane = tid & 63, fr = lane & 15, fq = lane >> 4, w = F.wave;
    constexpr int NIT = L / 16; constexpr bool SAMPLE = (L == 32);
    const int m = layer >> 1; int r0, pos0; chunk_geom(c, r0, pos0);
    bf16_t* RKV = (bf16_t*)(F.ws + WS_RKV); const bf16_t* WLOG = (const bf16_t*)(F.ws + WS_WLOG); const bf16_t* AA = (const bf16_t*)(F.ws + WS_XN);
    LAS bf16_t* AT = (LAS bf16_t*)(F.lds + RL_AT); LAS bf16_t* RT = (LAS bf16_t*)(F.lds + RL_RT); LAS bf16_t* BT = (LAS bf16_t*)(F.lds + RL_BT); LAS bf16_t* KT = (LAS bf16_t*)(F.lds + RL_KT);
    LAS bf16_t* BHT = (LAS bf16_t*)(F.lds + RL_BHT); LAS bf16_t* KHT = (LAS bf16_t*)(F.lds + RL_KHT); LAS bf16_t* VT = (LAS bf16_t*)(F.lds + RL_VT);
    LAS bf16_t* AABH = (LAS bf16_t*)(F.lds + RL_AAB); LAS float* DIAG = (LAS float*)(F.lds + RL_AAB + 9216); LAS bf16_t* TINV = (LAS bf16_t*)(F.lds + RL_AAB + 14336); LAS bf16_t* AAK = (LAS bf16_t*)(F.lds + RL_AAK); LAS bf16_t* ARB = (LAS bf16_t*)(F.lds + RL_ARB); LAS bf16_t* ARK = (LAS bf16_t*)(F.lds + RL_ARK);
    LAS bf16_t* U0T = (LAS bf16_t*)(F.lds + RL_U0T); LAS float* GMID = (LAS float*)(F.lds + RL_VEC); LAS float* GLV = GMID + 64; LAS float* EGM = GMID + 128; LAS float* PSUM = (LAS float*)(F.lds + RL_PSUM);
    LAS float* G = (LAS float*)(F.lds + RL_G); LAS float* WW = (LAS float*)(F.lds + RL_WW); LAS bf16_t* APT = (LAS bf16_t*)(F.lds + RL_APT);
    __syncthreads();
    const int t = tid >> 3, c8 = tid & 7; const bool act = t < L;
    float rr[8], kkv[8], bb[8], kh[8], vv[8];
    if (act) { const size_t row = (size_t)(r0 + t); const int col = h * 64 + 8 * c8;
        const u32x4 r4 = raw.r, k4 = raw.k, v4 = raw.v, w4 = raw.w, a4 = raw.a;
        const float* kkp = F.in[I_RKK] + m * D + col; const float* kap = F.in[I_RKA] + m * D + col; const float* rkp = F.in[I_RRK] + m * D + col;
        float ss = 0.f, bon = 0.f;
#pragma unroll
        for (int e = 0; e < 8; ++e) { const float kx = (e & 1) ? bfhi(k4[e >> 1]) : bflo(k4[e >> 1]), al = (e & 1) ? bfhi(a4[e >> 1]) : bflo(a4[e >> 1]);
            rr[e] = (e & 1) ? bfhi(r4[e >> 1]) : bflo(r4[e >> 1]); vv[e] = (e & 1) ? bfhi(v4[e >> 1]) : bflo(v4[e >> 1]);
            kkv[e] = kx * kkp[e]; ss += kkv[e] * kkv[e]; kh[e] = kx * (1.f + (al - 1.f) * kap[e]); bb[e] = al; bon += rr[e] * kh[e] * rkp[e];
            G[t * 64 + 8 * c8 + e] = (e & 1) ? bfhi(w4[e >> 1]) : bflo(w4[e >> 1]); }
        ss += __shfl_xor(ss, 1); ss += __shfl_xor(ss, 2); ss += __shfl_xor(ss, 4); bon += __shfl_xor(bon, 1); bon += __shfl_xor(bon, 2); bon += __shfl_xor(bon, 4);
        const float inv = 1.f / fmaxf(sqrtf(ss), 1e-12f);
#pragma unroll
        for (int e = 0; e < 8; ++e) { kkv[e] *= inv; bb[e] *= kkv[e]; }
        if (c8 == 0) ((float*)(F.ws + WS_BON))[row * 16 + h] = bon; }
    if (unext >= 0) rwkv_load_raw(F, unext, tid, raw);
    __syncthreads();
    { constexpr int TE = L / 8; const int j = tid & 63, e8 = tid >> 6; float cs[TE]; float run = 0.f;
#pragma unroll
      for (int q = 0; q < TE; ++q) { run += G[(e8 * TE + q) * 64 + j]; cs[q] = run; }
      PSUM[e8 * 64 + j] = run;
      __syncthreads();
      float off = 0.f, gm = 0.f, gl = 0.f;
#pragma unroll
      for (int q = 0; q < 8; ++q) { const float p = PSUM[q * 64 + j]; if (q < e8) off += p; if (q < 4) gm += p; gl += p; }
#pragma unroll
      for (int q = 0; q < TE; ++q) G[(e8 * TE + q) * 64 + j] = off + cs[q];
      if (e8 == 0) { GMID[j] = gm; GLV[j] = gl; EGM[j] = __expf(gm); if (!SAMPLE) ((float*)(F.ws + WS_REC + ((size_t)h * 256 + c) * REC_B + 16384))[j] = __expf(gl); } }
    __syncthreads();
    if (act) { float fa[8], fr_[8], fb[8], fk[8];
#pragma unroll
        for (int e = 0; e < 8; ++e) { const int j = 8 * c8 + e; const float g = G[t * 64 + j], gp = (t > 0) ? G[(t - 1) * 64 + j] : 0.f, gm = GMID[j], gl = GLV[j];
            const float ed = __expf(gm - g), eu = __expf(g - gm), el = __expf(gl - g);
            fa[e] = -kkv[e] * __expf(gp - gm); fr_[e] = rr[e] * eu; fb[e] = bb[e] * ed; fk[e] = kh[e] * ed;
            if constexpr (!(DRY && (LOCAL_SKIP & 4))) { BHT[j * 72 + t] = (bf16_t)f2bf(bb[e] * el); KHT[j * 72 + t] = (bf16_t)f2bf(kh[e] * el); VT[j * 72 + t] = (bf16_t)f2bf(vv[e]); } }
        u32x4 p;
        p.x = pk2(fa[0], fa[1]); p.y = pk2(fa[2], fa[3]); p.z = pk2(fa[4], fa[5]); p.w = pk2(fa[6], fa[7]); *(LAS u32x4*)(AT + t * 72 + 8 * c8) = p;
        p.x = pk2(fr_[0], fr_[1]); p.y = pk2(fr_[2], fr_[3]); p.z = pk2(fr_[4], fr_[5]); p.w = pk2(fr_[6], fr_[7]); *(LAS u32x4*)(RT + t * 72 + 8 * c8) = p;
        p.x = pk2(fb[0], fb[1]); p.y = pk2(fb[2], fb[3]); p.z = pk2(fb[4], fb[5]); p.w = pk2(fb[6], fb[7]); *(LAS u32x4*)(BT + t * 72 + 8 * c8) = p;
        p.x = pk2(fk[0], fk[1]); p.y = pk2(fk[2], fk[3]); p.z = pk2(fk[4], fk[5]); p.w = pk2(fk[6], fk[7]); *(LAS u32x4*)(KT + t * 72 + 8 * c8) = p; }
    __syncthreads();
    if constexpr (DRY && (LOCAL_SKIP & 2)) return;
    { constexpr int TPW = (NIT * NIT >= 8) ? NIT * NIT / 8 : 1;
      if (w * TPW < NIT * NIT) { const int it = (w * TPW) / NIT, jt0 = (w * TPW) % NIT;
          f32x4 ab[1][TPW], ak[1][TPW], rb[1][TPW], rk[1][TPW];
#pragma unroll
          for (int q = 0; q < TPW; ++q) { ab[0][q] = (f32x4){0.f, 0.f, 0.f, 0.f}; ak[0][q] = ab[0][q]; rb[0][q] = ab[0][q]; rk[0][q] = ab[0][q]; }
          wave_mm_nt<1, TPW>(ab, AT + it * 16 * 72, 72, BT + jt0 * 16 * 72, 72, 64, fr, fq); wave_mm_nt<1, TPW>(ak, AT + it * 16 * 72, 72, KT + jt0 * 16 * 72, 72, 64, fr, fq);
          wave_mm_nt<1, TPW>(rb, RT + it * 16 * 72, 72, BT + jt0 * 16 * 72, 72, 64, fr, fq); wave_mm_nt<1, TPW>(rk, RT + it * 16 * 72, 72, KT + jt0 * 16 * 72, 72, 64, fr, fq);
          const int tt = it * 16 + fr;
#pragma unroll
          for (int q = 0; q < TPW; ++q) { const int s0 = (jt0 + q) * 16 + 4 * fq; f32x4 fab; float fak[4], frb[4], frk[4];
#pragma unroll
              for (int r = 0; r < 4; ++r) { const int sx = s0 + r; fab[r] = (sx < tt) ? ab[0][q][r] : 0.f; fak[r] = (sx < tt) ? ak[0][q][r] : 0.f; frb[r] = (sx <= tt) ? rb[0][q][r] : 0.f; frk[r] = (sx <= tt) ? rk[0][q][r] : 0.f; }
              u32x2 p; p.x = pk2(fab[0], fab[1]); p.y = pk2(fab[2], fab[3]); *(LAS u32x2*)(AABH + tt * 72 + s0) = p;
              if (jt0 + q == it) *(LAS f32x4*)(DIAG + tt * 20 + 4 * fq) = fab;
              p.x = pk2(fak[0], fak[1]); p.y = pk2(fak[2], fak[3]); *(LAS u32x2*)(AAK + tt * 72 + s0) = p;
              p.x = pk2(frb[0], frb[1]); p.y = pk2(frb[2], frb[3]); *(LAS u32x2*)(ARB + tt * 72 + s0) = p;
              p.x = pk2(frk[0], frk[1]); p.y = pk2(frk[2], frk[3]); *(LAS u32x2*)(ARK + tt * 72 + s0) = p; } } }
    __syncthreads();
    constexpr int NB = L / 16;
    f32x4 rhs[1][NB];
    if (w >= 4) {
#pragma unroll
        for (int b = 0; b < NB; ++b) rhs[0][b] = (f32x4){0.f, 0.f, 0.f, 0.f};
        wave_mm_nt<1, NB>(rhs, VT + (w - 4) * 16 * 72, 72, AAK, 72, L, fr, fq);
    } else { const int cc = w * 16 + fr; const float eg = EGM[cc];
#pragma unroll
        for (int b = 0; b < NB; ++b)
#pragma unroll
            for (int r = 0; r < 4; ++r) rhs[0][b][r] = bf2f(AT[(16 * b + 4 * fq + r) * 72 + cc]) * eg; }
    if (w == 0) {
        float y[16]; f32x4 nq[3][4]; const LAS float* dp = DIAG + 16 * fq * 20;
#pragma unroll
        for (int q = 0; q < 16; ++q) y[q] = (q == fr) ? 1.f : 0.f;
#pragma unroll
        for (int k = 0; k < 4; ++k) { nq[15 % 3][k] = *(const LAS f32x4*)(dp + 15 * 20 + 4 * k); nq[14 % 3][k] = *(const LAS f32x4*)(dp + 14 * 20 + 4 * k); }
        TinvStep<15>::run(y, nq, dp);
        if (fq < NB) { u32x4 p; LAS bf16_t* tp = TINV + (16 * fq + fr) * 24;
            p.x = pk2(y[0], y[1]); p.y = pk2(y[2], y[3]); p.z = pk2(y[4], y[5]); p.w = pk2(y[6], y[7]); *(LAS u32x4*)tp = p;
            p.x = pk2(y[8], y[9]); p.y = pk2(y[10], y[11]); p.z = pk2(y[12], y[13]); p.w = pk2(y[14], y[15]); *(LAS u32x4*)(tp + 8) = p; } }
    __syncthreads();
    { s16x4 xb[NB]; LAS bf16_t* dst = ((w < 4) ? APT : U0T) + ((w & 3) * 16 + fr) * 72 + 4 * fq;
#pragma unroll
      for (int bi = 0; bi < NB; ++bi) { f32x4 acc = rhs[0][bi];
#pragma unroll
          for (int bj = 0; bj < bi; ++bj) { const s16x4 pa = *(const LAS s16x4*)(AABH + (16 * bi + fr) * 72 + 16 * bj + 4 * fq); acc = __builtin_amdgcn_mfma_f32_16x16x16bf16_1k(pa, xb[bj], acc, 0, 0, 0); }
          const s16x4 ti = *(const LAS s16x4*)(TINV + (16 * bi + fr) * 24 + 4 * fq);
          const f32x4 xa = __builtin_amdgcn_mfma_f32_16x16x16bf16_1k(ti, pack4(acc), (f32x4){0.f, 0.f, 0.f, 0.f}, 0, 0, 0);
          xb[bi] = pack4(xa);
          *(LAS s16x4*)(dst + 16 * bi) = xb[bi]; } }
    __syncthreads();
    { const int mt = w >> 1, nt0 = (w & 1) * 2;
      f32x4 pp[1][2], qt[1][2];
#pragma unroll
      for (int q = 0; q < 2; ++q) { pp[0][q] = (f32x4){0.f, 0.f, 0.f, 0.f}; qt[0][q] = pp[0][q]; }
      wave_mm_nt<1, 2>(pp, BHT + mt * 16 * 72, 72, APT + nt0 * 16 * 72, 72, L, fr, fq);
      wave_mm_nt<1, 2>(qt, U0T + mt * 16 * 72, 72, BHT + nt0 * 16 * 72, 72, L, fr, fq); wave_mm_nt<1, 2>(qt, VT + mt * 16 * 72, 72, KHT + nt0 * 16 * 72, 72, L, fr, fq);
      constexpr int TP5 = NIT / 2; const int it = (w * TP5) / 4, rn0 = (w * TP5) % 4;
      f32x4 rp[1][TP5], y0[1][TP5];
#pragma unroll
      for (int q = 0; q < TP5; ++q) { const int j = (rn0 + q) * 16 + 4 * fq; const u32x2 rw = *(const LAS u32x2*)(RT + (it * 16 + fr) * 72 + j); const f32x4 e4 = *(const LAS f32x4*)(EGM + j);
          rp[0][q] = (f32x4){bflo(rw.x) * e4[0], bfhi(rw.x) * e4[1], bflo(rw.y) * e4[2], bfhi(rw.y) * e4[3]}; y0[0][q] = (f32x4){0.f, 0.f, 0.f, 0.f}; }
      wave_mm_nt<1, TP5>(rp, ARB + it * 16 * 72, 72, APT + rn0 * 16 * 72, 72, L, fr, fq);
      wave_mm_nt<1, TP5>(y0, ARB + it * 16 * 72, 72, U0T + rn0 * 16 * 72, 72, L, fr, fq); wave_mm_nt<1, TP5>(y0, ARK + it * 16 * 72, 72, VT + rn0 * 16 * 72, 72, L, fr, fq);
      if constexpr (!SAMPLE) {
          bf16_t* PP = (bf16_t*)(F.ws + WS_REC + ((size_t)h * 256 + c) * REC_B); bf16_t* QQ = PP + 4096;
#pragma unroll
          for (int q = 0; q < 2; ++q) { const int n0 = (nt0 + q) * 16 + 4 * fq; u32x2 p; p.x = pk2(pp[0][q][0], pp[0][q][1]); p.y = pk2(pp[0][q][2], pp[0][q][3]);
              *(u32x2*)(PP + (mt * 16 + fr) * 64 + pperm(n0)) = p;
              p.x = pk2(qt[0][q][0], qt[0][q][1]); p.y = pk2(qt[0][q][2], qt[0][q][3]); *(u32x2*)(QQ + (mt * 16 + fr) * 64 + n0) = p; }
#pragma unroll
          for (int q = 0; q < TP5; ++q) { const size_t row = (size_t)(r0 + it * 16 + fr); const int n0 = (rn0 + q) * 16 + 4 * fq; u32x2 p;
              p.x = pk2(rp[0][q][0], rp[0][q][1]); p.y = pk2(rp[0][q][2], rp[0][q][3]); if constexpr (DRY) asm volatile("" :: "v"(p.x), "v"(p.y)); else *(u32x2*)(RKV + row * 3072 + 1024 + h * 64 + n0) = p;
              p.x = pk2(y0[0][q][0], y0[0][q][1]); p.y = pk2(y0[0][q][2], y0[0][q][3]); if constexpr (DRY) asm volatile("" :: "v"(p.x), "v"(p.y)); else *(u32x2*)(RKV + row * 3072 + h * 64 + n0) = p; }
      } else {
          __syncthreads();
          LAS bf16_t* PL = (LAS bf16_t*)(F.lds + RL_PL); LAS bf16_t* RLs = (LAS bf16_t*)(F.lds + RL_RL); LAS float* Y0L = (LAS float*)(F.lds + RL_Y0L); LAS float* QTL = (LAS float*)(F.lds + RL_QTL); LAS bf16_t* Sl = (LAS bf16_t*)(F.lds + RL_S);
#pragma unroll
          for (int q = 0; q < 2; ++q) { const int n0 = (nt0 + q) * 16 + 4 * fq; u32x2 p; p.x = pk2(pp[0][q][0], pp[0][q][1]); p.y = pk2(pp[0][q][2], pp[0][q][3]);
              *(LAS u32x2*)(PL + (mt * 16 + fr) * 72 + n0) = p; *(LAS f32x4*)(QTL + (mt * 16 + fr) * 68 + n0) = qt[0][q]; }
#pragma unroll
          for (int q = 0; q < TP5; ++q) { const int n0 = (rn0 + q) * 16 + 4 * fq; u32x2 p; p.x = pk2(rp[0][q][0], rp[0][q][1]); p.y = pk2(rp[0][q][2], rp[0][q][3]);
              *(LAS u32x2*)(RLs + (it * 16 + fr) * 72 + n0) = p; *(LAS f32x4*)(Y0L + (it * 16 + fr) * 68 + n0) = y0[0][q]; }
          const int sb = c - 256; const float* sin_ = F.in[I_SWKV] + (((size_t)m * 32 + sb) * 16 + h) * 4096; float* sout = F.out + O_WKVS + (((size_t)m * 32 + sb) * 16 + h) * 4096;
          for (int it2 = tid; it2 < 64 * 16; it2 += NT) { const int i = it2 >> 4, j4 = (it2 & 15) * 4; const f32x4 sv = *(const f32x4*)(sin_ + i * 64 + j4); u32x2 p; p.x = pk2(sv[0], sv[1]); p.y = pk2(sv[2], sv[3]); *(LAS u32x2*)(Sl + i * 72 + j4) = p; }
          __syncthreads();
          if (w < 2) { f32x4 y[1][4];
#pragma unroll
              for (int q = 0; q < 4; ++q) y[0][q] = *(const LAS f32x4*)(Y0L + (w * 16 + fr) * 68 + q * 16 + 4 * fq);
              wave_mm_nt<1, 4>(y, RLs + w * 16 * 72, 72, Sl, 72, 64, fr, fq);
              rwkv_out_epilogue<DRY>(F, m, y[0], (size_t)(r0 + w * 16 + fr), h, fq); }
          else if (w < 6) { const int mi = w - 2; f32x4 tl[1][4];
#pragma unroll
              for (int q = 0; q < 4; ++q) { const int j = q * 16 + 4 * fq; const f32x4 sv = *(const f32x4*)(sin_ + (mi * 16 + fr) * 64 + j), gl4 = *(const LAS f32x4*)(GLV + j), qv = *(const LAS f32x4*)(QTL + (mi * 16 + fr) * 68 + j);
                  tl[0][q] = (f32x4){__expf(gl4[0]) * sv[0] + qv[0], __expf(gl4[1]) * sv[1] + qv[1], __expf(gl4[2]) * sv[2] + qv[2], __expf(gl4[3]) * sv[3] + qv[3]}; }
              wave_mm_nt<1, 4>(tl, Sl + mi * 16 * 72, 72, PL, 72, 64, fr, fq);
#pragma unroll
              for (int q = 0; q < 4; ++q) *(f32x4*)(sout + (mi * 16 + fr) * 64 + q * 16 + 4 * fq) = tl[0][q]; }
      }
    }
}

constexpr int SC_GRP = 4, SC_CH = 8192 + 2048 + 256, SC_LCH = 9216 + 2304 + 256, SC_LBUF = SC_GRP * SC_LCH;
template <int SKIP = 0> __device__ __forceinline__ void rwkv_scan_phase(Frame& F, int layer) {
    const int tid = otid(); const int lane = tid & 63, m = layer >> 1; const int b = blockIdx.x;
    if (b >= 64) {
        if constexpr (SKIP == 0) { const int nb = (int)F.G - 64; RawRegs raw; int u = 256 * 16 + (b - 64); if (u < NCHUNK * 16) rwkv_load_raw(F, u, tid, raw);
            for (; u < NCHUNK * 16; u += nb) { const int un = (u + nb < NCHUNK * 16) ? u + nb : -1; rwkv_local_unit<32>(F, layer, u >> 4, u & 15, raw, un); }
            if (layer == 1) { __syncthreads(); mod_phase(F, 2, 4, b - 64, nb); } }
        return; }
    const int h = 2 * (b & 7) + (b >> 5), sl = (b >> 3) & 3;
    const unsigned char* REC = F.ws + WS_REC;
    constexpr int NG = 256 / SC_GRP, DEPTH = 4;
    static_assert(NG % DEPTH == 0, "scan groups vs prefetch depth");
    if (F.wave != 0) {
        constexpr int NV = SC_GRP * SC_CH / 16, NLT = NT - 64, NPT = (NV + NLT - 1) / NLT;
        struct RegSet { u32x4 v[NPT]; };
        RegSet sets[DEPTH];
        unsigned poff[NPT], pdst[NPT];
#pragma unroll
        for (int q = 0; q < NPT; ++q) { int v = (tid - 64) + q * NLT; v = v < NV ? v : NV - 1; const int cc = v / (SC_CH / 16), o = (v % (SC_CH / 16)) * 16;
            poff[q] = (unsigned)(cc * REC_B + o + (o >= 10240 ? 6144 : (o >= 8192 ? sl * 2048 : 0)));
            const int lo = (o < 8192) ? (o >> 7) * 144 + (o & 127) : (o < 10240) ? 9216 + ((o - 8192) >> 7) * 144 + ((o - 8192) & 127) : 9216 + 2304 + (o - 10240);
            pdst[q] = (unsigned)(cc * SC_LCH + lo); }
        auto issue = [&](int g, RegSet& st) { const unsigned char* gb = REC + ((size_t)h * 256 + g * SC_GRP) * REC_B;
#pragma unroll
            for (int q = 0; q < NPT; ++q) st.v[q] = *(const u32x4*)(gb + poff[q]); };
        auto commit = [&](int buf, const RegSet& st) {
#pragma unroll
            for (int q = 0; q < NPT; ++q) *(LAS u32x4*)(F.lds + buf * SC_LBUF + pdst[q]) = st.v[q]; };
        if (!(SKIP & 2)) {
#pragma unroll
            for (int d = 0; d < DEPTH; ++d) issue(d, sets[d]);
            commit(0, sets[0]); }
        for (int g0 = 0; g0 < NG; g0 += DEPTH) {
#pragma unroll
            for (int dd = 0; dd < DEPTH; ++dd) { const int g = g0 + dd;
                if (!(SKIP & 2)) { if (g > 0 && g + DEPTH - 1 < NG) issue(g + DEPTH - 1, sets[(dd + DEPTH - 1) % DEPTH]); }
                __syncthreads();
                __syncthreads();
                if (!(SKIP & 2)) { if (g + 1 < NG) commit((g + 1) & 1, sets[(dd + 1) % DEPTH]); } }
        }
    } else {
        const int ci = lane & 15, q4 = lane >> 4, i = 16 * sl + ci;
        f32x4 T[4];
#pragma unroll
        for (int mm = 0; mm < 4; ++mm) T[mm] = (f32x4){0.f, 0.f, 0.f, 0.f};
        bf16_t* TST = (bf16_t*)(F.ws + WS_TST);
        const unsigned pfo = (unsigned)(ci * 144 + q4 * 16);
        for (int g = 0; g < NG; ++g) {
            __syncthreads();
            if (!(SKIP & 1)) {
                const LAS unsigned char* base = F.lds + (g & 1) * SC_LBUF;
                bf16x8 pf[4][2];
#pragma unroll
                for (int mm = 0; mm < 4; ++mm)
#pragma unroll
                    for (int s = 0; s < 2; ++s) pf[mm][s] = *(const LAS bf16x8*)(base + pfo + mm * 2304 + s * 64);
#pragma unroll
                for (int cc = 0; cc < SC_GRP; ++cc) { const int c = g * SC_GRP + cc; const LAS unsigned char* cb = base + cc * SC_LCH;
                    bf16_t* tdst = TST + (((size_t)h * 256 + c) * 64 + i) * 64;
                    f32x4 gv[4]; u32x2 qv[4];
#pragma unroll
                    for (int mm = 0; mm < 4; ++mm) { const int j = 16 * mm + 4 * q4; gv[mm] = *(const LAS f32x4*)(cb + 9216 + 2304 + j * 4); qv[mm] = *(const LAS u32x2*)(cb + 9216 + ci * 144 + j * 2); }
                    bf16x8 pn[4][2];
                    if (cc + 1 < SC_GRP) {
#pragma unroll
                        for (int mm = 0; mm < 4; ++mm)
#pragma unroll
                            for (int s = 0; s < 2; ++s) pn[mm][s] = *(const LAS bf16x8*)(cb + SC_LCH + pfo + mm * 2304 + s * 64); }
                    bf16x8 Tf[2];
#pragma unroll
                    for (int mm = 0; mm < 4; ++mm) { u32x2 p; p.x = pk2(T[mm][0], T[mm][1]); p.y = pk2(T[mm][2], T[mm][3]); *(u32x2*)(tdst + 16 * mm + 4 * q4) = p;
                        Tf[mm >> 1][(mm & 1) * 4 + 0] = (short)(p.x & 0xffffu); Tf[mm >> 1][(mm & 1) * 4 + 1] = (short)(p.x >> 16); Tf[mm >> 1][(mm & 1) * 4 + 2] = (short)(p.y & 0xffffu); Tf[mm >> 1][(mm & 1) * 4 + 3] = (short)(p.y >> 16); }
#pragma unroll
                    for (int mm = 0; mm < 4; ++mm) {
                        f32x4 acc = (f32x4){gv[mm][0] * T[mm][0] + bflo(qv[mm].x), gv[mm][1] * T[mm][1] + bfhi(qv[mm].x), gv[mm][2] * T[mm][2] + bflo(qv[mm].y), gv[mm][3] * T[mm][3] + bfhi(qv[mm].y)};
                        acc = __builtin_amdgcn_mfma_f32_16x16x32_bf16(pf[mm][0], Tf[0], acc, 0, 0, 0); acc = __builtin_amdgcn_mfma_f32_16x16x32_bf16(pf[mm][1], Tf[1], acc, 0, 0, 0);
                        T[mm] = acc; }
                    if (cc + 1 < SC_GRP) {
#pragma unroll
                        for (int mm = 0; mm < 4; ++mm) { pf[mm][0] = pn[mm][0]; pf[mm][1] = pn[mm][1]; } }
                }
            }
            __syncthreads();
        }
        float* outp = F.out + O_WKVP + ((size_t)m * 16 + h) * 4096 + (size_t)i * 64;
#pragma unroll
        for (int mm = 0; mm < 4; ++mm) *(f32x4*)(outp + 16 * mm + 4 * q4) = T[mm];
    }
}

struct OutMain { u32x2 y0[4]; bf16x8 xa[2]; };
template <bool DRY = false> __device__ __forceinline__ void rwkv_output_phase(Frame& F, int layer) {
    const int tid = otid(); const int lane = tid & 63, fr = lane & 15, fq = lane >> 4, m = layer >> 1;
    const bf16_t* RKV = (const bf16_t*)(F.ws + WS_RKV); const bf16_t* TST = (const bf16_t*)(F.ws + WS_TST);
    const int gw = F.vcu * NWAVES + F.wave, NGW = F.G * NWAVES;
    for (int u = gw; u < 256 * 16; u += NGW) { const int h = u & 15, c = u >> 4; const bf16_t* ts = TST + ((size_t)h * 256 + c) * 4096;
        bf16x8 yb[2][4];
#pragma unroll
        for (int s = 0; s < 2; ++s)
#pragma unroll
            for (int nt = 0; nt < 4; ++nt) yb[s][nt] = *(const bf16x8*)(ts + (16 * nt + fr) * 64 + 32 * s + 8 * fq);
        f32x4 lgu[4], lbu[4];
#pragma unroll
        for (int nt = 0; nt < 4; ++nt) { const int i = h * 64 + 16 * nt + 4 * fq; lgu[nt] = *(const f32x4*)(F.in[I_RLNG] + m * D + i); lbu[nt] = *(const f32x4*)(F.in[I_RLNB] + m * D + i); }
        const bf16_t* GG = (const bf16_t*)(F.ws + WS_G); const float* BON = (const float*)(F.ws + WS_BON);
        auto issue = [&](int it, OutMain& mn, OutSide& sd) { const size_t row = (size_t)(64 * c + 16 * it + fr);
#pragma unroll
            for (int nt = 0; nt < 4; ++nt) mn.y0[nt] = *(const u32x2*)(RKV + row * 3072 + h * 64 + 16 * nt + 4 * fq);
#pragma unroll
            for (int s = 0; s < 2; ++s) mn.xa[s] = *(const bf16x8*)(RKV + row * 3072 + 1024 + h * 64 + 32 * s + 8 * fq);
            sd.bon = BON[row * 16 + h];
#pragma unroll
            for (int nt = 0; nt < 4; ++nt) { const int i = h * 64 + 16 * nt + 4 * fq; sd.vv[nt] = *(const u32x2*)(RKV + row * 3072 + 2048 + i); sd.gg[nt] = *(const u32x2*)(GG + row * D + i); } };
        auto compute = [&](int it, const OutMain& mn, OutSide& sd) { const size_t row = (size_t)(64 * c + 16 * it + fr); f32x4 y[4];
#pragma unroll
            for (int nt = 0; nt < 4; ++nt) y[nt] = (f32x4){bflo(mn.y0[nt].x), bfhi(mn.y0[nt].x), bflo(mn.y0[nt].y), bfhi(mn.y0[nt].y)};
#pragma unroll
            for (int s = 0; s < 2; ++s)
#pragma unroll
                for (int nt = 0; nt < 4; ++nt) y[nt] = __builtin_amdgcn_mfma_f32_16x16x32_bf16(yb[s][nt], mn.xa[s], y[nt], 0, 0, 0);
#pragma unroll
            for (int nt = 0; nt < 4; ++nt) { sd.lg[nt] = lgu[nt]; sd.lb[nt] = lbu[nt]; }
            rwkv_out_core<DRY>(F, y, row, h, fq, sd); };
        OutMain mA, mB; OutSide sA, sB;
        issue(0, mA, sA); asm volatile("" ::: "memory");
        issue(1, mB, sB); asm volatile("" ::: "memory"); compute(0, mA, sA); asm volatile("" ::: "memory");
        issue(2, mA, sA); asm volatile("" ::: "memory"); compute(1, mB, sB); asm volatile("" ::: "memory");
        issue(3, mB, sB); asm volatile("" ::: "memory"); compute(2, mA, sA); asm volatile("" ::: "memory");
        compute(3, mB, sB);
    }
}

#define GRID_BAR() xcd_barrier(bar)
#ifndef PHASE_MASK
#define PHASE_MASK 0xffffffffu
#endif
#ifndef STRETCH_MASK
#define STRETCH_MASK 0u
#endif
struct StretchGuard { unsigned long long t0; bool on; __device__ __forceinline__ StretchGuard(bool o) : t0(o ? __builtin_amdgcn_s_memrealtime() : 0ull), on(o) {}
    __device__ __forceinline__ ~StretchGuard() { if (on) { __syncthreads(); const unsigned long long t1 = __builtin_amdgcn_s_memrealtime(); while (__builtin_amdgcn_s_memrealtime() < t1 + (t1 - t0)) __builtin_amdgcn_s_sleep(2); } } };
#define PH(k) if (StretchGuard sg_(((STRETCH_MASK) >> (k)) & 1u); PHASE_MASK & (1u << (k)))
#ifndef REP_MASK
#define REP_MASK 0u
#endif
#define REP(k) (((REP_MASK) >> (k)) & 1u)
#ifndef LOCAL_SKIP
#define LOCAL_SKIP 0
#endif
#ifndef EXTRA_BARS
#define EXTRA_BARS 0
#endif
template <int layer> __device__ __forceinline__ void layer_body(Frame& F, const XcdBarrier& bar) {
    unsigned char* ws = F.ws; unsigned char* ar = ws + WS_ARENA;
    bf16_t* XN = (bf16_t*)(ws + WS_XN);
    const float* MOD = (const float*)(ws + WS_MOD);
    constexpr int m = layer >> 1; const float* modl = MOD + (size_t)layer * NSEQ * 6144;
    PH(1) for (int rep = 0; rep <= (int)REP(1); ++rep) if (layer > 0) convert_layer_weights(F, layer);
    if constexpr ((layer & 1) == 0) {
        PH(2) for (int rep = 0; rep <= (int)REP(2); ++rep) { if constexpr (layer == 0) norm_pass<0, 0, true>(F, layer, 0, 0, F.in[I_XS], nullptr); else norm_pass<0, 8>(F, layer, layer - 1, 5120, F.out + (size_t)MP * D, (float*)(ws + WS_SXB)); }
        GRID_BAR();
        PH(3) { using GC = pg8::Geo<D, D, D, 30, 0, 1 << 20, 0>; pg8::Gemm<GC> g{XN, (const bf16_t*)(ar + AR_WIN), nullptr}; pg8::StaticOrder S; S.init(M, ABIN, F.G, (int)blockIdx.x);
          pg8::EpiBf16<0> E{(bf16_t*)(ws + WS_Z), ABIN};
          pg8::gemm_phase<pg8::EpiBf16<0>, pg8::StaticOrder, GC, true, true>(F.lds, g, S, E);
          if (REP(3)) { pg8::EpiNull<true> EN; pg8::gemm_phase<pg8::EpiNull<true>, pg8::StaticOrder, GC, true, true>(F.lds, g, S, EN); } }
        GRID_BAR();
        PH(4) for (int rep = 0; rep <= (int)REP(4); ++rep) for (int u = F.vcu; u < NCHUNK * 8; u += F.G) { const int c = u >> 3, hh = (u + u / F.G) & 7;
            if (c < 256) { if (hh < 4) ab_summary_unit<64, false>(F, layer, c, hh); else ab_summary_unit<64, true>(F, layer, c, hh - 4); }
            else { if (hh < 4) ab_summary_unit<32, false>(F, layer, c, hh); else ab_summary_unit<32, true>(F, layer, c, hh - 4); } }
        GRID_BAR();
        PH(5) { if (REP(5)) ab_scan<true>(F, layer); ab_scan<false>(F, layer); }
        GRID_BAR();
        PH(6) for (int rep = 0; rep <= (int)REP(6); ++rep) for (int u = F.vcu; u < NCHUNK * 8; u += F.G) { const int c = u >> 3, hh = (u + u / F.G) & 7;
            if (c < 256) { if (hh < 4) ab_output_unit<64, false>(F, layer, c, hh); else ab_output_unit<64, true>(F, layer, c, hh - 4); }
            else { if (hh < 4) ab_output_unit<32, false>(F, layer, c, hh); else ab_output_unit<32, true>(F, layer, c, hh - 4); } }
        GRID_BAR();
        PH(7) { using GC = pg8::Geo<D, D, D, 30, 0, 1 << 20, 0>; pg8::Gemm<GC> g{XN, (const bf16_t*)(ar + AR_WOUT), nullptr}; pg8::StaticOrder S; S.init(MP, D, F.G, (int)blockIdx.x);
          pg8::EpiRes E{F.out, modl, 2048, (layer == 0) ? F.in[I_XP] : F.out};
          pg8::gemm_phase<pg8::EpiRes, pg8::StaticOrder, GC, true, true>(F.lds, g, S, E);
          if (REP(7)) { pg8::EpiNull<false> EN; pg8::gemm_phase<pg8::EpiNull<false>, pg8::StaticOrder, GC, true, true>(F.lds, g, S, EN); }
          using GC2 = pg8::Geo<D, D, 256, 30, 0, 1 << 20, 0, true>; pg8::Gemm<GC2> g2{XN, (const bf16_t*)(ar + AR_WOUT), nullptr}; pg8::SplitOrder S2{F.vcu, 4};
          pg8::EpiPartial E2{(float*)(ws + WS_PART), 4};
          pg8::gemm_phase<pg8::EpiPartial, pg8::SplitOrder, GC2, true, true>(F.lds, g2, S2, E2); }
        GRID_BAR();
    } else {
        PH(8) for (int rep = 0; rep <= (int)REP(8); ++rep) norm_pass<1, 8>(F, layer, layer - 1, 5120, F.out + (size_t)MP * D, (float*)(ws + WS_SXB));
        GRID_BAR();
        PH(9) { using GCr = pg8::Geo<D, 2048, D, 2, M * D, 1 << 20, 0>; pg8::Gemm<GCr> gr{(const bf16_t*)(ws + WS_XMIX), (const bf16_t*)(ar + AR_WC1), nullptr}; pg8::StaticOrder Sr; Sr.init(M, 3072, F.G, (int)blockIdx.x);
          pg8::EpiRkv E{(bf16_t*)(ws + WS_RKV), (bf16_t*)(ws + WS_LO), (m == 0) ? (bf16_t*)(ws + WS_VFIRST) : nullptr};
          pg8::gemm_phase<pg8::EpiRkv, pg8::StaticOrder, GCr, true, true>(F.lds, gr, Sr, E);
          if (REP(9)) { pg8::EpiNull<true> EN; pg8::gemm_phase<pg8::EpiNull<true>, pg8::StaticOrder, GCr, true, true>(F.lds, gr, Sr, EN); }
          using GC = pg8::Geo<D, 2048, 2048, 30, 0, 16, -4096>; pg8::Gemm<GC> g{XN, (const bf16_t*)(ar + AR_WC1), (const bf16_t*)(ws + WS_PREVS)}; pg8::LoraOrder Sl{(int)blockIdx.x};
          pg8::gemm_phase<pg8::EpiRkv, pg8::LoraOrder, GC, true, true>(F.lds, g, Sl, E); }
        GRID_BAR();
        PH(10) { using GC = pg8::Geo<D, 256, 256, 2, 256, 1 << 20, 0>; pg8::Gemm<GC> g{(const bf16_t*)(ws + WS_LO), (const bf16_t*)(ar + AR_WC2), nullptr}; pg8::SkipVOrder S; S.skip = (m == 0); S.S.init(M, (m == 0) ? 3072 : 4096, F.G, (int)blockIdx.x);
          pg8::EpiLora2 E{(bf16_t*)(ws + WS_WLOG), XN, (bf16_t*)(ws + WS_G), (bf16_t*)(ws + WS_RKV), (m == 1) ? (const bf16_t*)(ws + WS_VFIRST) : nullptr,
                          F.in[I_RW0] + m * D, F.in[I_RA0] + m * D, F.in[I_RV0]};
          pg8::gemm_phase<pg8::EpiLora2, pg8::SkipVOrder, GC, true, true>(F.lds, g, S, E);
           }
        GRID_BAR();
        PH(11) { RawRegs raw; const int tid0 = otid(); int u = F.vcu; if (u < 256 * 16) rwkv_load_raw(F, u, tid0, raw);
          for (; u < 256 * 16; u += F.G) { const int c = u >> 4, hh = u & 15, un = (u + F.G < 256 * 16) ? u + F.G : -1;
              rwkv_local_unit<64>(F, layer, c, hh, raw, un); } }
        GRID_BAR();
        PH(17) { if (REP(17)) rwkv_scan_phase<LOCAL_SKIP>(F, layer); rwkv_scan_phase<0>(F, layer); }
        GRID_BAR();
        PH(18) { if (REP(18)) rwkv_output_phase<true>(F, layer); rwkv_output_phase<false>(F, layer); }
        GRID_BAR();
        PH(12) { using GC = pg8::Geo<3072, D, D, 30, 0, 1 << 20, 0>; pg8::Gemm<GC> g{(const bf16_t*)(ws + WS_RKV), (const bf16_t*)(ar + AR_WO), nullptr}; pg8::StaticOrder S; S.init(MP, D, F.G, (int)blockIdx.x);
          pg8::EpiRes E{F.out, modl, 2048, F.out};
          pg8::gemm_phase<pg8::EpiRes, pg8::StaticOrder, GC, true, true>(F.lds, g, S, E);
          if (REP(12)) { pg8::EpiNull<false> EN; pg8::gemm_phase<pg8::EpiNull<false>, pg8::StaticOrder, GC, true, true>(F.lds, g, S, EN); }
          using GC2 = pg8::Geo<3072, D, 256, 30, 0, 1 << 20, 0, true>; pg8::Gemm<GC2> g2{(const bf16_t*)(ws + WS_RKV), (const bf16_t*)(ar + AR_WO), nullptr}; pg8::SplitOrder S2{F.vcu, 4};
          pg8::EpiPartial E2{(float*)(ws + WS_PART), 4};
          pg8::gemm_phase<pg8::EpiPartial, pg8::SplitOrder, GC2, true, true>(F.lds, g2, S2, E2); }
        GRID_BAR();
    }
    PH(13) for (int rep = 0; rep <= (int)REP(13); ++rep) norm_pass<2, 4>(F, layer, layer, 2048, (layer == 0) ? F.in[I_XS] : (const float*)(ws + WS_SXB), F.out + (size_t)MP * D);
    GRID_BAR();
    PH(14) { using GC = pg8::Geo<D, D, D, 30, 0, 1 << 20, 0>; pg8::Gemm<GC> g{XN, (const bf16_t*)(ar + AR_W1), nullptr}; pg8::StaticOrder S; S.init(M, DFF, F.G, (int)blockIdx.x);
      pg8::EpiBf16<1> E{(bf16_t*)(ws + WS_H), DFF};
      pg8::gemm_phase<pg8::EpiBf16<1>, pg8::StaticOrder, GC, true, true>(F.lds, g, S, E);
          if (REP(14)) { pg8::EpiNull<true> EN; pg8::gemm_phase<pg8::EpiNull<true>, pg8::StaticOrder, GC, true, true>(F.lds, g, S, EN); } }
    GRID_BAR();
    PH(15) { using GC = pg8::Geo<DFF, DFF, DFF, 30, 0, 1 << 20, 0>; pg8::Gemm<GC> g{(const bf16_t*)(ws + WS_H), (const bf16_t*)(ar + AR_W2), nullptr}; pg8::StaticOrder S; S.init(MP, D, F.G, (int)blockIdx.x);
      pg8::EpiRes E{F.out, modl, 5120, F.out};
      for (int xb = 0; xb < EXTRA_BARS; ++xb) GRID_BAR();
      pg8::gemm_phase<pg8::EpiRes, pg8::StaticOrder, GC, true, true>(F.lds, g, S, E);
      if (REP(15)) { pg8::EpiNull<false> EN; pg8::gemm_phase<pg8::EpiNull<false>, pg8::StaticOrder, GC, true, true>(F.lds, g, S, EN); }
      using GC2 = pg8::Geo<DFF, DFF, 512, 30, 0, 1 << 20, 0, true>; pg8::Gemm<GC2> g2{(const bf16_t*)(ws + WS_H), (const bf16_t*)(ar + AR_W2), nullptr}; pg8::SplitOrder S2{F.vcu, 8};
      pg8::EpiPartial E2{(float*)(ws + WS_PART), 8};
      pg8::gemm_phase<pg8::EpiPartial, pg8::SplitOrder, GC2, true, true>(F.lds, g2, S2, E2); }
    GRID_BAR();
}

__global__ void __launch_bounds__(NT, 2) fwd_kernel(Args args) {
    extern __shared__ __attribute__((aligned(16))) unsigned char lds[];
    Frame F;
    F.lds = (LAS unsigned char*)lds; F.MISC = (volatile LAS unsigned*)(F.lds + MISC_OFF);
    F.wave = __builtin_amdgcn_readfirstlane(threadIdx.x >> 6);
    F.G = gridDim.x; { const int bx = blockIdx.x; F.vcu = (F.G % 8 == 0) ? (bx % 8) * (F.G / 8) + bx / 8 : bx; }
    F.in = args.in; F.out = args.out; F.ws = args.ws;
    for (int u = threadIdx.x; u < (LDS_BYTES - LDSCTL_OFF) / 4; u += NT) ((LAS unsigned*)(F.lds + LDSCTL_OFF))[u] = 0u;
    __syncthreads();
    XcdBarrier bar = xcd_barrier_post((unsigned*)(F.ws + WS_CTL) + CW_BAR, F.MISC + 8);
    PH(0) prologue(F);
    GRID_BAR();
    PH(0) mod_phase(F, 0, 2, F.vcu, F.G);
    GRID_BAR();
    layer_body<0>(F, bar); layer_body<1>(F, bar); layer_body<2>(F, bar); layer_body<3>(F, bar);
    PH(16) norm_pass<3, 8>(F, 0, 3, 5120, F.out + (size_t)MP * D, nullptr);
}

extern "C" void kernel_launch(void* const* d_in, const int* in_sizes, int n_in, void* d_out, int out_size, void* d_ws, size_t ws_size, hipStream_t stream) {
    static int grid = 0;
    if (grid == 0) {
        if (n_in != 38 || out_size != 28706816 || ws_size < WS_END) { fprintf(stderr, "kernel_launch: unexpected problem (n_in %d, out %d, ws %zu; need ws >= %zu)\n", n_in, out_size, ws_size, (size_t)WS_END); grid = -1; return; }
        int dev = 0, cus = 0, per_cu = 0;
        if (hipGetDevice(&dev) != hipSuccess || hipDeviceGetAttribute(&cus, hipDeviceAttributeMultiprocessorCount, dev) != hipSuccess) { grid = -1; return; }
        if (hipFuncSetAttribute((const void*)fwd_kernel, hipFuncAttributeMaxDynamicSharedMemorySize, LDS_BYTES) != hipSuccess) { fprintf(stderr, "kernel_launch: hipFuncSetAttribute failed\n"); grid = -1; return; }
        if (hipOccupancyMaxActiveBlocksPerMultiprocessor(&per_cu, (const void*)fwd_kernel, NT, LDS_BYTES) != hipSuccess || per_cu < 1) { fprintf(stderr, "kernel_launch: occupancy query says %d\n", per_cu); per_cu = 1; }
        (void)hipGetLastError();
        grid = cus;
    }
    if (grid < 0) return;
    (void)hipMemsetAsync((char*)d_ws + WS_CTL, 0, ZERO_BYTES, stream);
    Args a{};
    for (int i = 0; i < 38; ++i) a.in[i] = (const float*)d_in[i];
    a.out = (float*)d_out; a.ws = (unsigned char*)d_ws;
    void* kargs[] = {&a};
    hipError_t e = hipLaunchCooperativeKernel((const void*)fwd_kernel, dim3(grid), dim3(NT), kargs, LDS_BYTES, stream);
    if (e != hipSuccess) fprintf(stderr, "kernel_launch: cooperative launch failed: %s (grid %d)\n", hipGetErrorString(e), grid);
}
```

```cpp
#include <hip/hip_runtime.h>
#include <cstdio>
#include <cstdint>

#define LAS __attribute__((address_space(3)))
#define GAS __attribute__((address_space(1)))
typedef unsigned short bf16_t;
typedef short bf16x8 __attribute__((ext_vector_type(8)));
typedef float f32x4 __attribute__((ext_vector_type(4)));
typedef float f32x2 __attribute__((ext_vector_type(2)));
typedef unsigned u32x4 __attribute__((ext_vector_type(4)));
typedef unsigned u32x2 __attribute__((ext_vector_type(2)));

#ifndef LOCAL_SKIP
#define LOCAL_SKIP 0
#endif
constexpr int D = 1024, MP = 16384, MS = 1024, M = MP + MS, NSEQ = 33, DFF = 4096, ABIN = 3584;
constexpr int NCHUNK = 288;
constexpr int SLOT_E = 4 * 8192 + 4 * 16384;
constexpr float NORM_EPS = 1e-6f, RW_LN_EPS = 64e-5f;

constexpr size_t MiB = 1u << 20;
constexpr size_t WS_CTL = 0, WS_MOD = 1 * MiB, ZERO_BYTES = 65536;
constexpr size_t WS_ROPE = 5 * MiB;
constexpr size_t WS_ARENA = 10 * MiB;
constexpr size_t AR_W1 = 0, AR_W2 = 8 * MiB, AR_WIN = 16 * MiB, AR_WOUT = 23 * MiB, AR_WC1 = 16 * MiB, AR_WC2 = 32 * MiB, AR_WO = 34 * MiB;
constexpr size_t WS_VFIRST = 46 * MiB;
constexpr size_t WS_XN0 = 80 * MiB, WS_XN = WS_XN0 + 2048;
constexpr size_t WS_PREVS = 115 * MiB;
constexpr size_t WS_R1 = 118 * MiB;
constexpr size_t WS_Z = WS_R1, WS_STATE = WS_R1 + 120 * MiB, WS_DEC = WS_R1 + 174 * MiB;
constexpr size_t WS_H = WS_R1;
constexpr size_t WS_RKV = WS_R1, WS_LO = WS_R1 + 102 * MiB, WS_WLOG = WS_R1 + 136 * MiB, WS_G = WS_R1 + 170 * MiB;
constexpr size_t WS_TST = WS_R1 + 102 * MiB;
constexpr size_t WS_REC = WS_R1 + 204 * MiB, WS_BON = WS_R1 + 269 * MiB;
constexpr int REC_B = 16640;
constexpr size_t WS_XMIX = WS_R1 + 168 * MiB;
constexpr size_t WS_PART = WS_R1 + 136 * MiB;
constexpr size_t WS_SXB = WS_R1 + 271 * MiB;
constexpr size_t WS_END = WS_R1 + 275 * MiB;

__device__ const double ROPE_REV[32] = {0.15915494309189535, 0.11934937021124886, 0.089499401608891013, 0.067115083005227255, 0.050329212104487035, 0.037741584717419771, 0.028302195830623399, 0.02122365276477766, 0.015915494309189534, 0.011934937021124886, 0.0089499401608891024, 0.0067115083005227253, 0.0050329212104487037, 0.0037741584717419772, 0.0028302195830623399, 0.0021223652764777662, 0.0015915494309189536, 0.0011934937021124885, 0.00089499401608891024, 0.0006711508300522726, 0.00050329212104487033, 0.00037741584717419774, 0.00028302195830623395, 0.00021223652764777661, 0.00015915494309189535, 0.00011934937021124886, 8.9499401608891018e-05, 6.7115083005227254e-05, 5.0329212104487035e-05, 3.7741584717419777e-05, 2.8302195830623396e-05, 2.1223652764777659e-05};

__device__ __forceinline__ unsigned f2bf(float f) { unsigned u = __builtin_bit_cast(unsigned, f); return (u + 0x7fffu + ((u >> 16) & 1u)) >> 16; }
typedef __bf16 bf16x2_t __attribute__((ext_vector_type(2)));
__device__ __forceinline__ unsigned pk2(float lo, float hi) { const f32x2 v = {lo, hi}; const bf16x2_t b = __builtin_convertvector(v, bf16x2_t); return __builtin_bit_cast(unsigned, b); }
__device__ __forceinline__ float bf2f(unsigned short b) { return __builtin_bit_cast(float, (unsigned)b << 16); }
__device__ __forceinline__ float bflo(unsigned w) { return __builtin_bit_cast(float, w << 16); }
__device__ __forceinline__ float bfhi(unsigned w) { return __builtin_bit_cast(float, w & 0xffff0000u); }
__device__ __forceinline__ float sigmoidf_(float x) { return 1.f / (1.f + __expf(-x)); }
__device__ __forceinline__ float siluf_(float x) { return x / (1.f + __expf(-x)); }
__device__ __forceinline__ float wave_sum(float v) {
#pragma unroll
    for (int o = 1; o < 64; o <<= 1) v += __shfl_xor(v, o);
    return v;
}
__device__ __forceinline__ int otid() { int t = threadIdx.x; asm volatile("" : "+v"(t)); return t; }
__device__ __forceinline__ int seq_of_row(int r) { return r < MP ? 0 : 1 + ((r - MP) >> 5); }
#define LDS_WAIT() asm volatile("s_waitcnt lgkmcnt(0)" ::: "memory")
#define VM_WAIT() asm volatile("s_waitcnt vmcnt(0)" ::: "memory")

namespace pg8 {
constexpr int BM = 256, BK = 64, HALF = 128, HTB = HALF * BK * 2, STAGE_BYTES = 8 * HTB, NXCD = 8, WGM = 8;
__host__ __device__ __forceinline__ int lds_byte(int r, int c) { const int st = (r >> 4) * 2 + (c >> 5), rr = r & 15, cc = c & 31, ob = rr * 64 + cc * 2; return st * 1024 + (ob ^ (((ob >> 9) & 1) << 5)); }
__host__ __device__ __forceinline__ void stage_rc(int b, int& R, int& C) { const int st = b / 1024, sb = b % 1024, swz = sb ^ (((sb >> 9) & 1) << 5); R = (st >> 1) * 16 + swz / 64; C = (st & 1) * 32 + (swz % 64) / 2; }
__host__ __device__ __forceinline__ int perm32(int rho) { const int n = rho >> 4, i = rho & 15; return 8 * (i >> 2) + 4 * n + (i & 3); }

struct Unit { int pm, pn, ks; };
template <int LDA_, int LDB_, int K_, int GSHIFT_, int GSTRIDE_, int KSPLIT_, int DELTAP_, bool SPLIT_ = false> struct Geo {
    static constexpr int LDA = LDA_, LDB = LDB_, K = K_, GSHIFT = GSHIFT_, GSTRIDE = GSTRIDE_, KSPLIT = KSPLIT_, DELTAP = DELTAP_; static constexpr bool SPLIT = SPLIT_;
};
template <class GC> struct Gemm {
    const bf16_t* A; const bf16_t* Bt; const bf16_t* A2s;
    __device__ __forceinline__ const char* a_base(const Unit& u) const { return (const char*)(A + (size_t)u.pm * BM * GC::LDA + (size_t)(u.pn >> GC::GSHIFT) * GC::GSTRIDE + (GC::SPLIT ? (size_t)u.ks * GC::K : 0)); }
    __device__ __forceinline__ const char* b_base(const Unit& u) const { return (const char*)(Bt + (size_t)u.pn * BM * GC::LDB + (GC::SPLIT ? (size_t)u.ks * GC::K : 0)); }
    __device__ __forceinline__ long a_delta(const Unit& u) const {
        if constexpr (GC::KSPLIT >= GC::K / BK) return 0;
        else { if (u.pm < 64) return (long)GC::DELTAP;
            return (long)((const char*)(A2s + (size_t)(u.pm - 64) * BM * GC::LDA) - a_base(u)) - (long)GC::KSPLIT * BK * 2; }
    }
};
struct StaticOrder {
    int nM, nN, nwg, G, c;
    __host__ __device__ void init(int M_, int N_, int G_, int c_) { nM = M_ / BM; nN = N_ / BM; nwg = nM * nN; G = G_; c = c_; }
    __host__ __device__ bool next(int i, Unit& u) const {
        const long L = (long)i * G + c; if (L >= nwg) return false;
        int wgid = (int)L; { const int q = nwg / NXCD, r = nwg % NXCD, xcd = wgid % NXCD, off = wgid / NXCD; wgid = (xcd < r ? xcd * (q + 1) : r * (q + 1) + (xcd - r) * q) + off; }
        const int nig = WGM * nN, gid = wgid / nig, fm = gid * WGM, gsz = (nM - fm) < WGM ? (nM - fm) : WGM;
        u.pm = fm + ((wgid % nig) % gsz); u.pn = (wgid % nig) / gsz; u.ks = 0; return true;
    }
};
__device__ __forceinline__ unsigned cvt_pk_bf16(float lo, float hi) { return pk2(lo, hi); }

template <class Epi, class Sched, class GC, bool ALIGN_EPI = false, bool SP2 = false>
__device__ __forceinline__ void gemm_phase(LAS unsigned char* lds, const Gemm<GC> g, const Sched& S, const Epi& E) {
    const int tid = otid(), wid = __builtin_amdgcn_readfirstlane(tid >> 6), lane = tid & 63, wr = wid >> 2, wc = wid & 3, fr = lane & 15, fq = lane >> 4;
    constexpr int K = GC::K, nt = K / BK, ksplit = GC::KSPLIT;
    unsigned voffA[2], voffB[2];
#pragma unroll
    for (int i = 0; i < 2; ++i) { int R, C; stage_rc(tid * 16 + i * 8192, R, C); const int Rb = Epi::PERM ? ((R & ~31) + perm32(R & 31)) : R;
        voffA[i] = (unsigned)(R * GC::LDA + C) * 2u; voffB[i] = (unsigned)(Rb * GC::LDB + C) * 2u; }
    constexpr size_t kstep = (size_t)(BK * 2);
    constexpr size_t hstepA = (size_t)HALF * GC::LDA * 2, hstepB = (size_t)HALF * GC::LDB * 2;
    const unsigned ldsw = (unsigned)wid * 1024u;
    const int aoff = lds_byte(wr * 64 + fr, fq * 8), boff = lds_byte(wc * 32 + fr, fq * 8);
#define PG8_SA(b, h) (((b) * 2 + (h)) * HTB)
#define PG8_SB(b, h) ((4 + (b) * 2 + (h)) * HTB)
#define PG8_STAGE(bufoff, gbase, voff) do { _Pragma("unroll") for (int _i = 0; _i < 2; ++_i) \
        __builtin_amdgcn_global_load_lds((const unsigned*)((const char*)(gbase) + (voff)[_i]), (LAS unsigned*)(lds + (bufoff) + ldsw + _i * 8192), 16, 0, 0); } while (0)
#define PG8_LDA(dst, b, h) do { _Pragma("unroll") for (int m = 0; m < 4; ++m) _Pragma("unroll") for (int k = 0; k < 2; ++k) dst[m][k] = *(const LAS bf16x8*)(lds + PG8_SA(b, h) + aoff + m * 2048 + k * 1024); } while (0)
#define PG8_LDB(dst, b, h) do { _Pragma("unroll") for (int n = 0; n < 2; ++n) _Pragma("unroll") for (int k = 0; k < 2; ++k) dst[n][k] = *(const LAS bf16x8*)(lds + PG8_SB(b, h) + boff + n * 2048 + k * 1024); } while (0)
#define PG8_MMA(ai, bj, At, Bt) do { __builtin_amdgcn_s_setprio(1); _Pragma("unroll") for (int m = 0; m < 4; ++m) _Pragma("unroll") for (int n = 0; n < 2; ++n) _Pragma("unroll") for (int k = 0; k < 2; ++k) \
        acc[ai][bj][m][n] = __builtin_amdgcn_mfma_f32_16x16x32_bf16(Bt[n][k], At[m][k], acc[ai][bj][m][n], 0, 0, 0); __builtin_amdgcn_s_setprio(0); } while (0)
#define PG8_WAIT_V(n) asm volatile("s_waitcnt vmcnt(" #n ")" ::: "memory")
#define PG8_WAIT_L(n) asm volatile("s_waitcnt lgkmcnt(" #n ")" ::: "memory")
#define PG8_BAR __builtin_amdgcn_s_barrier()
#define PG8_SCHED __builtin_amdgcn_sched_barrier(0)
    Unit cur, nxt; int ui = 0;
    if (!S.next(0, cur)) return;
    f32x4 acc[2][2][4][2];
#pragma unroll
    for (int a = 0; a < 2; ++a)
#pragma unroll
        for (int b = 0; b < 2; ++b)
#pragma unroll
            for (int m = 0; m < 4; ++m)
#pragma unroll
                for (int n = 0; n < 2; ++n) acc[a][b][m][n] = (f32x4){0.f, 0.f, 0.f, 0.f};
    bf16x8 At[4][2], B0[2][2], B1[2][2];
    const char* cA = g.a_base(cur); const char* cB = g.b_base(cur); long cD = g.a_delta(cur);
    if constexpr (SP2) {
        PG8_STAGE(PG8_SB(0, 0), cB, voffB); PG8_STAGE(PG8_SB(0, 1), cB + hstepB, voffB); PG8_STAGE(PG8_SA(0, 0), cA, voffA); PG8_STAGE(PG8_SA(0, 1), cA + hstepA, voffA);
        if (wr == 1) PG8_BAR;
        PG8_WAIT_V(2); PG8_BAR;
        PG8_STAGE(PG8_SB(1, 0), cB + kstep, voffB); PG8_STAGE(PG8_SA(1, 0), cA + kstep, voffA); PG8_STAGE(PG8_SB(1, 1), cB + hstepB + kstep, voffB);
        PG8_WAIT_V(6); PG8_BAR;
    } else {
        PG8_STAGE(PG8_SB(0, 0), cB, voffB); PG8_STAGE(PG8_SA(0, 0), cA, voffA); PG8_STAGE(PG8_SB(0, 1), cB + hstepB, voffB); PG8_STAGE(PG8_SA(0, 1), cA + hstepA, voffA);
        if (wr == 1) PG8_BAR;
        PG8_WAIT_V(4); PG8_BAR;
        PG8_STAGE(PG8_SB(1, 0), cB + kstep, voffB); PG8_STAGE(PG8_SA(1, 0), cA + kstep, voffA); PG8_STAGE(PG8_SB(1, 1), cB + hstepB + kstep, voffB);
        PG8_WAIT_V(6); PG8_BAR;
    }
    for (;;) {
        const bool has_next = S.next(ui + 1, nxt);
        const char* nA = has_next ? g.a_base(nxt) : cA; const char* nB = has_next ? g.b_base(nxt) : cB;
        const long nD = has_next ? g.a_delta(nxt) : cD;
#pragma unroll 1
        for (int t = 0; t < nt; t += 2) {
            const bool last = (t == nt - 2);
            const char* a1 = cA + (size_t)(t + 1) * kstep + (t >= ksplit ? cD : 0);
            const char* a2 = last ? nA : cA + (size_t)(t + 2) * kstep + (t + 2 >= ksplit ? cD : 0); const char* b2 = last ? nB : cB + (size_t)(t + 2) * kstep;
            const char* a3 = a2 + kstep; const char* b3 = b2 + kstep;
            if constexpr (SP2) {
            PG8_LDB(B0, 0, 0); PG8_LDB(B1, 0, 1); PG8_SCHED; PG8_LDA(At, 0, 0); PG8_STAGE(PG8_SA(1, 1), a1 + hstepA, voffA);
            PG8_WAIT_V(8); PG8_WAIT_L(0); PG8_BAR; PG8_MMA(0, 0, At, B0); PG8_MMA(0, 1, At, B1); PG8_BAR; PG8_SCHED;
            PG8_LDA(At, 0, 1); PG8_STAGE(PG8_SB(0, 0), b2, voffB); PG8_STAGE(PG8_SB(0, 1), b2 + hstepB, voffB); PG8_STAGE(PG8_SA(0, 0), a2, voffA);
            PG8_WAIT_V(8); PG8_WAIT_L(0); PG8_BAR; PG8_MMA(1, 0, At, B0); PG8_MMA(1, 1, At, B1); PG8_BAR; PG8_SCHED;
            PG8_LDB(B0, 1, 0); PG8_LDB(B1, 1, 1); PG8_SCHED; PG8_LDA(At, 1, 0); PG8_STAGE(PG8_SA(0, 1), a2 + hstepA, voffA);
            PG8_WAIT_V(8); PG8_WAIT_L(0); PG8_BAR; PG8_MMA(0, 0, At, B0); PG8_MMA(0, 1, At, B1); PG8_BAR; PG8_SCHED;
            PG8_LDA(At, 1, 1); PG8_STAGE(PG8_SB(1, 0), b3, voffB); PG8_STAGE(PG8_SB(1, 1), b3 + hstepB, voffB); PG8_STAGE(PG8_SA(1, 0), a3, voffA);
            PG8_WAIT_V(8); PG8_WAIT_L(0); PG8_BAR; PG8_MMA(1, 0, At, B0); PG8_MMA(1, 1, At, B1); PG8_BAR; PG8_SCHED;
            } else {
            PG8_LDB(B0, 0, 0); PG8_SCHED; PG8_LDA(At, 0, 0); PG8_STAGE(PG8_SA(1, 1), a1 + hstepA, voffA);
            PG8_WAIT_L(8); PG8_BAR; PG8_WAIT_L(0); PG8_MMA(0, 0, At, B0); PG8_BAR; PG8_SCHED;
            PG8_LDB(B1, 0, 1); PG8_STAGE(PG8_SB(0, 0), b2, voffB);
            PG8_BAR; PG8_WAIT_L(0); PG8_MMA(0, 1, At, B1); PG8_BAR;
            PG8_LDA(At, 0, 1); PG8_STAGE(PG8_SA(0, 0), a2, voffA);
            PG8_BAR; PG8_WAIT_L(0); PG8_MMA(1, 0, At, B0); PG8_BAR; PG8_SCHED;
            PG8_STAGE(PG8_SB(0, 1), b2 + hstepB, voffB);
            PG8_WAIT_V(6); PG8_BAR; PG8_MMA(1, 1, At, B1); PG8_BAR;
            PG8_LDB(B0, 1, 0); PG8_SCHED; PG8_LDA(At, 1, 0); PG8_STAGE(PG8_SA(0, 1), a2 + hstepA, voffA);
            PG8_WAIT_L(8); PG8_BAR; PG8_WAIT_L(0); PG8_MMA(0, 0, At, B0); PG8_BAR; PG8_SCHED;
            PG8_LDB(B1, 1, 1); PG8_STAGE(PG8_SB(1, 0), b3, voffB);
            PG8_BAR; PG8_WAIT_L(0); PG8_MMA(0, 1, At, B1); PG8_BAR;
            PG8_LDA(At, 1, 1); PG8_STAGE(PG8_SA(1, 0), a3, voffA);
            PG8_BAR; PG8_WAIT_L(0); PG8_MMA(1, 0, At, B0); PG8_BAR; PG8_SCHED;
            PG8_STAGE(PG8_SB(1, 1), b3 + hstepB, voffB);
            PG8_WAIT_V(6); PG8_BAR; PG8_MMA(1, 1, At, B1); PG8_BAR;
            }
        }
        if constexpr (ALIGN_EPI) { if (wr == 0) PG8_BAR; }
        E(acc, cur, wr, wc, fr, fq);
        if (!has_next) break;
#pragma unroll
        for (int a = 0; a < 2; ++a)
#pragma unroll
            for (int b = 0; b < 2; ++b)
#pragma unroll
                for (int m = 0; m < 4; ++m)
#pragma unroll
                    for (int n = 0; n < 2; ++n) acc[a][b][m][n] = (f32x4){0.f, 0.f, 0.f, 0.f};
        cur = nxt; cA = nA; cB = nB; cD = nD; ++ui;
        if constexpr (ALIGN_EPI) { if (wr == 1) PG8_BAR; }
    }
    PG8_WAIT_V(0);
    if constexpr (!ALIGN_EPI) { if (wr == 0) PG8_BAR; }
    PG8_BAR;
#undef PG8_SA
#undef PG8_SB
#undef PG8_STAGE
#undef PG8_LDA
#undef PG8_LDB
#undef PG8_MMA
#undef PG8_WAIT_V
#undef PG8_WAIT_L
#undef PG8_BAR
#undef PG8_SCHED
}

__device__ __forceinline__ float act_apply(float v, int act) {
    if (act == 1) { const float r = v > 0.f ? v : 0.f; return r * r; }
    if (act == 2) { const float e = __expf(-2.f * fabsf(v)); const float t = (1.f - e) / (1.f + e); return v < 0.f ? -t : t; }
    if (act == 3) return 1.f / (1.f + __expf(-v));
    return v;
}
template <int ACT> __device__ __forceinline__ void store_tile_bf16(const f32x4 (&acc)[2][2][4][2], bf16_t* base, int ldc, int row0, int col0, bf16_t* base2, int ldc2, int col2) {
#pragma unroll
    for (int ai = 0; ai < 2; ++ai)
#pragma unroll
        for (int m = 0; m < 4; ++m) { const size_t r = (size_t)(row0 + ai * HALF + m * 16);
#pragma unroll
            for (int bj = 0; bj < 2; ++bj) { f32x4 v0 = acc[ai][bj][m][0], v1 = acc[ai][bj][m][1];
#pragma unroll
                for (int q = 0; q < 4; ++q) { v0[q] = act_apply(v0[q], ACT); v1[q] = act_apply(v1[q], ACT); }
                u32x4 w; w.x = cvt_pk_bf16(v0[0], v0[1]); w.y = cvt_pk_bf16(v0[2], v0[3]); w.z = cvt_pk_bf16(v1[0], v1[1]); w.w = cvt_pk_bf16(v1[2], v1[3]);
                *(u32x4*)(base + r * ldc + col0 + bj * HALF) = w;
                if (base2) *(u32x4*)(base2 + r * ldc2 + col2 + bj * HALF) = w; } }
}
template <int ACT> struct EpiBf16 {
    static constexpr bool PERM = true;
    bf16_t* O; int ldc;
    __device__ __forceinline__ void operator()(const f32x4 (&acc)[2][2][4][2], const Unit& u, int wr, int wc, int fr, int fq) const {
        store_tile_bf16<ACT>(acc, O, ldc, u.pm * BM + wr * 64 + fr, u.pn * BM + wc * 32 + 8 * fq, nullptr, 0, 0);
    }
};
struct EpiRkv {
    static constexpr bool PERM = true;
    bf16_t* RKV; bf16_t* LO; bf16_t* vf;
    __device__ __forceinline__ void operator()(const f32x4 (&acc)[2][2][4][2], const Unit& u, int wr, int wc, int fr, int fq) const {
        const int row0 = u.pm * BM + wr * 64 + fr, cin = wc * 32 + 8 * fq;
        if (u.pn < 12) { bf16_t* b2 = (u.pn >= 8) ? vf : nullptr; store_tile_bf16<0>(acc, RKV, 3072, row0, u.pn * BM + cin, b2, 1024, (u.pn - 8) * BM + cin); }
        else {
#pragma unroll
            for (int bj = 0; bj < 2; ++bj) { const int c = cin + bj * HALF; int dst = -1, act = 0;
                if (u.pn == 12) { if (c < 64) { dst = c; act = 2; } else if (c < 128) dst = 256 + (c - 64); else if (c < 160) dst = 512 + (c - 128); }
                else if (c < 160) { dst = 768 + c; act = 3; }
                if (dst >= 0) {
#pragma unroll
                    for (int ai = 0; ai < 2; ++ai)
#pragma unroll
                        for (int m = 0; m < 4; ++m) { const size_t r = (size_t)(row0 + ai * HALF + m * 16); f32x4 v0 = acc[ai][bj][m][0], v1 = acc[ai][bj][m][1];
#pragma unroll
                            for (int q = 0; q < 4; ++q) { v0[q] = act_apply(v0[q], act); v1[q] = act_apply(v1[q], act); }
                            u32x4 w; w.x = cvt_pk_bf16(v0[0], v0[1]); w.y = cvt_pk_bf16(v0[2], v0[3]); w.z = cvt_pk_bf16(v1[0], v1[1]); w.w = cvt_pk_bf16(v1[2], v1[3]);
                            *(u32x4*)(LO + r * 1024 + dst) = w; } } }
        }
    }
};
struct EpiRes {
    static constexpr bool PERM = false;
    float* X; const float* modl; int goff; const float* Xin;
    __device__ __forceinline__ void operator()(const f32x4 (&acc)[2][2][4][2], const Unit& u, int wr, int wc, int fr, int fq) const {
        const int col0 = u.pn * BM + wc * 32 + 4 * fq;
#pragma unroll
        for (int ai = 0; ai < 2; ++ai)
#pragma unroll
            for (int m = 0; m < 4; ++m) { const int r = u.pm * BM + ai * HALF + wr * 64 + m * 16 + fr; const float* gp = modl + (size_t)seq_of_row(r) * 6144 + goff + col0; float* xp = X + (size_t)r * D + col0; const float* xi = Xin + (size_t)r * D + col0;
#pragma unroll
                for (int bj = 0; bj < 2; ++bj)
#pragma unroll
                    for (int n = 0; n < 2; ++n) { const f32x4 gv = *(const f32x4*)(gp + bj * HALF + n * 16); f32x4 xv = *(const f32x4*)(xi + bj * HALF + n * 16);
                        xv = xv + gv * acc[ai][bj][m][n]; *(f32x4*)(xp + bj * HALF + n * 16) = xv; }
                asm volatile("" ::: "memory"); }
    }
};
struct EpiLora2 {
    static constexpr bool PERM = true, AFTER_DRAIN = false;
    bf16_t* WLOG; bf16_t* Aout; bf16_t* G; bf16_t* RKV; const bf16_t* vf; const float* w0; const float* a0; const float* v0;
    template <int GRP> __device__ __forceinline__ void run(const f32x4 (&acc)[2][2][4][2], const Unit& u, int wr, int wc, int fr, int fq) const {
        const int col0 = (u.pn & 3) * BM + wc * 32 + 8 * fq;
#pragma unroll
        for (int ai = 0; ai < 2; ++ai)
#pragma unroll
            for (int m = 0; m < 4; ++m) { const size_t r = (size_t)(u.pm * BM + ai * HALF + wr * 64 + m * 16 + fr);
#pragma unroll
                for (int bj = 0; bj < 2; ++bj) { const int c = col0 + bj * HALF; float a[8], o[8];
#pragma unroll
                    for (int q = 0; q < 4; ++q) { a[q] = acc[ai][bj][m][0][q]; a[4 + q] = acc[ai][bj][m][1][q]; }
                    if constexpr (GRP == 0) { const f32x4 b0 = *(const f32x4*)(w0 + c), b1 = *(const f32x4*)(w0 + c + 4);
#pragma unroll
                        for (int q = 0; q < 8; ++q) { const float x = -((q < 4 ? b0[q & 3] : b1[q & 3]) + a[q]); const float sp = fmaxf(x, 0.f) + __logf(1.f + __expf(-fabsf(x))); o[q] = -__expf(-sp - 0.5f); }
                        u32x4 w; w.x = cvt_pk_bf16(o[0], o[1]); w.y = cvt_pk_bf16(o[2], o[3]); w.z = cvt_pk_bf16(o[4], o[5]); w.w = cvt_pk_bf16(o[6], o[7]); *(u32x4*)(WLOG + r * D + c) = w; }
                    else if constexpr (GRP == 1) { const f32x4 b0 = *(const f32x4*)(a0 + c), b1 = *(const f32x4*)(a0 + c + 4);
#pragma unroll
                        for (int q = 0; q < 8; ++q) o[q] = 1.f / (1.f + __expf(-((q < 4 ? b0[q & 3] : b1[q & 3]) + a[q])));
                        u32x4 w; w.x = cvt_pk_bf16(o[0], o[1]); w.y = cvt_pk_bf16(o[2], o[3]); w.z = cvt_pk_bf16(o[4], o[5]); w.w = cvt_pk_bf16(o[6], o[7]); *(u32x4*)(Aout + r * D + c) = w; }
                    else if constexpr (GRP == 2) { const f32x4 b0 = *(const f32x4*)(v0 + c), b1 = *(const f32x4*)(v0 + c + 4); const u32x4 vv = *(const u32x4*)(RKV + r * 3072 + 2048 + c), ff = *(const u32x4*)(vf + r * D + c);
#pragma unroll
                        for (int q = 0; q < 8; ++q) { const float vx = (q & 1) ? bfhi(vv[q >> 1]) : bflo(vv[q >> 1]), fx = (q & 1) ? bfhi(ff[q >> 1]) : bflo(ff[q >> 1]);
                            const float gte = 1.f / (1.f + __expf(-((q < 4 ? b0[q & 3] : b1[q & 3]) + a[q]))); o[q] = vx + (fx - vx) * gte; }
                        u32x4 w; w.x = cvt_pk_bf16(o[0], o[1]); w.y = cvt_pk_bf16(o[2], o[3]); w.z = cvt_pk_bf16(o[4], o[5]); w.w = cvt_pk_bf16(o[6], o[7]); *(u32x4*)(RKV + r * 3072 + 2048 + c) = w; }
                    else { u32x4 w; w.x = cvt_pk_bf16(a[0], a[1]); w.y = cvt_pk_bf16(a[2], a[3]); w.z = cvt_pk_bf16(a[4], a[5]); w.w = cvt_pk_bf16(a[6], a[7]); *(u32x4*)(G + r * D + c) = w; } }
                asm volatile("" ::: "memory"); }
    }
    __device__ __forceinline__ void operator()(const f32x4 (&acc)[2][2][4][2], const Unit& u, int wr, int wc, int fr, int fq) const {
        const int grp = u.pn >> 2;
        if (grp == 0) run<0>(acc, u, wr, wc, fr, fq);
        else if (grp == 1) run<1>(acc, u, wr, wc, fr, fq);
        else if (grp == 2) { if (vf != nullptr) run<2>(acc, u, wr, wc, fr, fq); }
        else run<3>(acc, u, wr, wc, fr, fq);
    }
};
struct SplitOrder {
    int c, splitk;
    __device__ bool next(int i, Unit& u) const { if (i != 0 || c >= 16 * splitk) return false; const int t = c / splitk; u.pm = 64 + (t >> 2); u.pn = t & 3; u.ks = c % splitk; return true; }
};
struct SkipVOrder {
    StaticOrder S; bool skip;
    __device__ bool next(int i, Unit& u) const { if (!S.next(i, u)) return false; if (skip && u.pn >= 8) u.pn += 4; return true; }
};
struct LoraOrder {
    int c;
    __device__ bool next(int i, Unit& u) const { const int idx = c - 48; if (i != 0 || idx < 0 || idx >= 136) return false; u.pm = idx >> 1; u.pn = 12 + (idx & 1); u.ks = 0; return true; }
};
struct EpiPartial {
    static constexpr bool PERM = false;
    float* PART; int splitk;
    __device__ __forceinline__ void operator()(const f32x4 (&acc)[2][2][4][2], const Unit& u, int wr, int wc, int fr, int fq) const {
        float* base = PART + ((size_t)(((u.pm - 64) * 4 + u.pn) * splitk + u.ks) << 16) + wc * 32 + 4 * fq;
#pragma unroll
        for (int ai = 0; ai < 2; ++ai)
#pragma unroll
            for (int m = 0; m < 4; ++m) { float* rp = base + (ai * HALF + wr * 64 + m * 16 + fr) * 256;
#pragma unroll
                for (int bj = 0; bj < 2; ++bj)
#pragma unroll
                    for (int n = 0; n < 2; ++n) *(f32x4*)(rp + bj * HALF + n * 16) = acc[ai][bj][m][n]; }
    }
};
template <bool PERM_> struct EpiNull {
    static constexpr bool PERM = PERM_;
    __device__ __forceinline__ void operator()(const f32x4 (&acc)[2][2][4][2], const Unit&, int, int, int, int) const {
#pragma unroll
        for (int a = 0; a < 2; ++a)
#pragma unroll
            for (int b = 0; b < 2; ++b)
#pragma unroll
                for (int m = 0; m < 4; ++m)
#pragma unroll
                    for (int n = 0; n < 2; ++n) asm volatile("" :: "v"(acc[a][b][m][n]));
    }
};
}

#define RLX_AGENT __ATOMIC_RELAXED, __HIP_MEMORY_SCOPE_AGENT
#define XB_TMO      128
#define XB_XCNT(j)  (256  + 64 * (j))
#define XB_XSUB(j)  (1280 + 64 * (j))
#define XB_XGEN(j)  (2304 + 64 * (j))
#define XB_TOP      3328
#define XB_TOPGEN   3392
#define XCD_BAR_WORDS 3456
#define XB_SPIN_CAP (1u << 24)
__device__ __forceinline__ unsigned xb_ld(unsigned* p)              { return __hip_atomic_load(p, __ATOMIC_RELAXED, __HIP_MEMORY_SCOPE_AGENT); }
__device__ __forceinline__ unsigned xb_add(unsigned* p, unsigned v) { return __hip_atomic_fetch_add(p, v, __ATOMIC_RELAXED, __HIP_MEMORY_SCOPE_AGENT); }
__device__ __forceinline__ unsigned xb_xcc_id() { return (unsigned)__builtin_amdgcn_s_getreg((3 << 11) | 20) & 0xFu; }
#define XB_SPIN(cond, bar) do { unsigned _sp = 0; while (cond) { __builtin_amdgcn_s_sleep(4); \
    if ((++_sp & 255u) == 0u) { if (xb_ld(&(bar)[XB_TMO])) break; if (_sp > XB_SPIN_CAP) { atomicAdd(&(bar)[XB_TMO], 1u); break; } } } } while (0)
struct XcdBarrier { unsigned* bar; unsigned x; volatile LAS unsigned* st; };
__device__ __forceinline__ XcdBarrier xcd_barrier_post(unsigned* bar, volatile LAS unsigned* st) {
    XcdBarrier b; b.bar = bar; b.x = xb_xcc_id(); b.st = st;
    if (threadIdx.x == 0) (void)xb_add(&bar[XB_XCNT(b.x)], 1u);
    return b;
}
__device__ __forceinline__ void xcd_barrier_complete(unsigned* bar, unsigned x, unsigned& nloc, unsigned& nx) {
    const unsigned G = gridDim.x * gridDim.y * gridDim.z;
    unsigned sum, cnt, mine, sp = 0u;
    for (;;) {
        sum = 0u; cnt = 0u; mine = 0u;
#pragma unroll
        for (unsigned j = 0; j < 16; ++j) { const unsigned c = xb_ld(&bar[XB_XCNT(j)]); sum += c; cnt += (c > 0u) ? 1u : 0u; mine = (j == x) ? c : mine; }
        if (sum == G) break;
        __builtin_amdgcn_s_sleep(1);
        if ((++sp & 255u) == 0u) { if (xb_ld(&bar[XB_TMO])) break; if (sp > XB_SPIN_CAP) { atomicAdd(&bar[XB_TMO], 1u); break; } }
    }
    nloc = mine > 0u ? mine : 1u; nx = cnt > 0u ? cnt : 1u;
}
__device__ __forceinline__ void xcd_barrier(const XcdBarrier& b) {
    asm volatile("s_waitcnt vmcnt(0)" ::: "memory");
    __syncthreads();
    if (threadIdx.x == 0) {
        unsigned* bar = b.bar;
        __builtin_amdgcn_s_waitcnt(0);
        unsigned nloc = b.st[0], nx = b.st[1];
        if (nloc == 0u) { xcd_barrier_complete(bar, b.x, nloc, nx); b.st[0] = nloc; b.st[1] = nx; }
        const unsigned gen = b.st[2];
        const unsigned old = xb_add(&bar[XB_XSUB(b.x)], 1u);
        if (old + 1u == (gen + 1u) * nloc) {
            __builtin_amdgcn_fence(__ATOMIC_RELEASE, "agent");
            asm volatile("s_waitcnt vmcnt(0)" ::: "memory");
            const unsigned og = xb_add(&bar[XB_TOP], 1u);
            if (og + 1u == (gen + 1u) * nx) xb_add(&bar[XB_TOPGEN], 1u);
            else XB_SPIN(xb_ld(&bar[XB_TOPGEN]) == gen, bar);
        } else {
            XB_SPIN(xb_ld(&bar[XB_TOPGEN]) == gen, bar);
        }
        __builtin_amdgcn_fence(__ATOMIC_ACQUIRE, "agent");
        asm volatile("s_waitcnt vmcnt(0)" ::: "memory");
        b.st[2] = gen + 1u;
    }
    __syncthreads();
}

constexpr int NWAVES = 8, NT = NWAVES * 64;
constexpr int RING_BYTES = 131072, LDSCTL_OFF = RING_BYTES, MISC_OFF = LDSCTL_OFF + 320, LDS_BYTES = 147456;
constexpr int CW_BAR = 4096;

struct Args { const float* in[38]; float* out; unsigned char* ws; };
struct Frame {
    LAS unsigned char* lds; volatile LAS unsigned* MISC;
    int wave, vcu, G;
    const float* const* in; float* out; unsigned char* ws;
};
enum { I_XP = 0, I_XS, I_SRET, I_SHG, I_SWKV, I_SSHIFT, I_CP, I_CS, I_MODW, I_MODB, I_NMIXG, I_NMLPG, I_FINALG, I_W1, I_W2, I_ABWIN, I_ABWOUT, I_HGLB, I_HGNG,
       I_MU, I_WRKV, I_RW0, I_RW1, I_RW2, I_RA0, I_RA1, I_RA2, I_RV0, I_RV1, I_RV2, I_RG1, I_RG2, I_RKK, I_RKA, I_RRK, I_RLNG, I_RLNB, I_RWOUT };
constexpr size_t O_Y = 0, O_RETP = 17825792, O_RETS = 17891328, O_HGP = 19988480, O_HGS = 20119552, O_WKVP = 24313856, O_WKVS = 24444928, O_SHP = 28639232, O_SHS = 28641280;

__device__ __forceinline__ void transpose_item(const float* W, int N, bf16_t* WT, int ldt, int row_off, int col_off, const float* mu, int mode, LAS float* scr, int item, int lane) {
    const int nblk = N / 32, kb = item / nblk, nb = item % nblk, k0 = 64 * kb, n0 = 32 * nb;
#pragma unroll 8
    for (int i = 0; i < 32; ++i) { const int kk = 2 * i + (lane >> 5); float s = 1.f; if (mode == 1) s = 1.f - mu[k0 + kk]; else if (mode == 2) s = mu[k0 + kk];
        scr[kk * 33 + (lane & 31)] = W[(size_t)(k0 + kk) * N + n0 + (lane & 31)] * s; }
    LDS_WAIT(); asm volatile("" ::: "memory");
    const int c = lane & 7;
#pragma unroll
    for (int j = 0; j < 4; ++j) { const int n = (lane >> 3) + 8 * j; const LAS float* s = scr + (8 * c) * 33 + n;
        u32x4 o; o.x = pk2(s[0 * 33], s[1 * 33]); o.y = pk2(s[2 * 33], s[3 * 33]); o.z = pk2(s[4 * 33], s[5 * 33]); o.w = pk2(s[6 * 33], s[7 * 33]);
        *(u32x4*)(WT + (size_t)(row_off + n0 + n) * ldt + col_off + k0 + 8 * c) = o; }
    LDS_WAIT(); asm volatile("" ::: "memory");
}
__device__ __forceinline__ void convert_layer_weights(Frame& F, int layer) {
    const int tid = otid(); const int lane = tid & 63; (void)lane;
    LAS float* scr = (LAS float*)(F.lds + F.wave * 16384);
    const int gw = F.vcu * NWAVES + F.wave, NGW = F.G * NWAVES;
    unsigned char* ar = F.ws + WS_ARENA;
    const int m = layer >> 1;
    constexpr int I_1 = (D / 64) * (DFF / 32), I_2 = (DFF / 64) * (D / 32);
    const float* w1 = F.in[I_W1] + (size_t)layer * D * DFF; const float* w2 = F.in[I_W2] + (size_t)layer * DFF * D;
    if ((layer & 1) == 0) {
        constexpr int I_IN = (D / 64) * (ABIN / 32), I_OUT = (D / 64) * (D / 32), NI = I_1 + I_2 + I_IN + I_OUT;
        const float* win = F.in[I_ABWIN] + (size_t)m * D * ABIN; const float* wout = F.in[I_ABWOUT] + (size_t)m * D * D;
        for (int it = gw; it < NI; it += NGW) { int r = it;
            if (r < I_1) { transpose_item(w1, DFF, (bf16_t*)(ar + AR_W1), D, 0, 0, nullptr, 0, scr, r, lane); continue; } r -= I_1;
            if (r < I_2) { transpose_item(w2, D, (bf16_t*)(ar + AR_W2), DFF, 0, 0, nullptr, 0, scr, r, lane); continue; } r -= I_2;
            if (r < I_IN) { transpose_item(win, ABIN, (bf16_t*)(ar + AR_WIN), D, 0, 0, nullptr, 0, scr, r, lane); continue; } r -= I_IN;
            transpose_item(wout, D, (bf16_t*)(ar + AR_WOUT), D, 0, 0, nullptr, 0, scr, r, lane); }
    } else {
        constexpr int I_P = (D / 64) * (D / 32), NI = I_1 + I_2 + 4 * I_P;
        const float* mu = F.in[I_MU] + (size_t)m * 6 * D; const float* wrkv = F.in[I_WRKV] + (size_t)m * 3 * D * D; const float* wo = F.in[I_RWOUT] + (size_t)m * D * D;
        bf16_t* wc1 = (bf16_t*)(ar + AR_WC1);
        for (int it = gw; it < NI; it += NGW) { int r = it;
            if (r < I_1) { transpose_item(w1, DFF, (bf16_t*)(ar + AR_W1), D, 0, 0, nullptr, 0, scr, r, lane); continue; } r -= I_1;
            if (r < I_2) { transpose_item(w2, D, (bf16_t*)(ar + AR_W2), DFF, 0, 0, nullptr, 0, scr, r, lane); continue; } r -= I_2;
            if (r < 3 * I_P) { const int p = r / I_P;
                transpose_item(wrkv + (size_t)p * D * D, D, wc1, 2048, p * D, 0, nullptr, 0, scr, r % I_P, lane); continue; } r -= 3 * I_P;
            transpose_item(wo, D, (bf16_t*)(ar + AR_WO), D, 0, 0, nullptr, 0, scr, r, lane); }
        const int gt = F.vcu * NT + tid, NG = F.G * NT;
        const float* lw1 = F.in[I_RW1] + (size_t)m * D * 64; const float* la1 = F.in[I_RA1] + (size_t)m * D * 64; const float* lv1 = F.in[I_RV1]; const float* lg1 = F.in[I_RG1] + (size_t)m * D * 160;
        for (int idx = gt; idx < 512 * 2048; idx += NG) { const int n = idx >> 11, k = idx & 2047, kk = k & 1023, nn = n & 255;
            const float* src = nullptr; int ns = 0, mi = 0, nc = 0;
            if (n < 256) { if (nn < 64) { src = lw1; ns = 64; mi = 1; nc = nn; } else if (nn < 128) { src = la1; ns = 64; mi = 4; nc = nn - 64; } else if (nn < 160 && m == 1) { src = lv1; ns = 32; mi = 3; nc = nn - 128; } }
            else if (nn < 160) { src = lg1; ns = 160; mi = 5; nc = nn; }
            float v = 0.f; if (src) { const float muv = mu[mi * D + kk]; v = src[(size_t)kk * ns + nc] * (k < 1024 ? 1.f - muv : muv); }
            wc1[(size_t)(3072 + n) * 2048 + k] = (bf16_t)f2bf(v); }
        bf16_t* wc2 = (bf16_t*)(ar + AR_WC2);
        const float* lw2 = F.in[I_RW2] + (size_t)m * 64 * D; const float* la2 = F.in[I_RA2] + (size_t)m * 64 * D; const float* lv2 = F.in[I_RV2]; const float* lg2 = F.in[I_RG2] + (size_t)m * 160 * D;
        for (int idx = gt; idx < 4096 * 256; idx += NG) { const int k = idx >> 12, n = idx & 4095, g = n >> 10, nn = n & 1023;
            const float* src = (g == 0) ? lw2 : (g == 1) ? la2 : (g == 2) ? lv2 : lg2; const int ks = (g == 0 || g == 1) ? 64 : (g == 2 ? 32 : 160);
            float v = 0.f; if (k < ks && !(g == 2 && m == 0)) v = src[(size_t)k * D + nn];
            wc2[(size_t)n * 256 + k] = (bf16_t)f2bf(v); }
    }
}

__device__ __forceinline__ void mod_phase(Frame& F, int l_lo, int l_hi, int wb, int nb) {
    const int tid = otid(); const int lane = tid & 63;
    const float* __restrict__ SC = (const float*)(F.ws + WS_MOD + 3584 * 1024);
    float* MOD = (float*)(F.ws + WS_MOD);
    LAS float* red = (LAS float*)F.lds;
    for (int task = l_lo * 96 + wb; task < l_hi * 96; task += nb) { const int l = task / 96, n = (task % 96) * 64 + lane, ks = F.wave;
        const float* w = F.in[I_MODW] + ((size_t)l * D + ks * 128) * 6144 + n;
        float acc[NSEQ];
#pragma unroll
        for (int s = 0; s < NSEQ; ++s) acc[s] = 0.f;
        for (int k = 0; k < 128; k += 4) { const float w0 = w[(size_t)k * 6144], w1 = w[(size_t)(k + 1) * 6144], w2 = w[(size_t)(k + 2) * 6144], w3 = w[(size_t)(k + 3) * 6144];
#pragma unroll
            for (int s = 0; s < NSEQ; ++s) { const f32x4 c4 = *(const f32x4*)(SC + s * D + ks * 128 + k); acc[s] += (c4[0] * w0 + c4[1] * w1) + (c4[2] * w2 + c4[3] * w3); } }
        __syncthreads();
#pragma unroll
        for (int s = 0; s < NSEQ; ++s) red[(F.wave * NSEQ + s) * 64 + lane] = acc[s];
        __syncthreads();
        for (int i = tid; i < NSEQ * 64; i += NT) { const int s = i >> 6, c = i & 63; float t = F.in[I_MODB][l * 6144 + (task % 96) * 64 + c];
#pragma unroll
            for (int q = 0; q < 8; ++q) t += red[(q * NSEQ + s) * 64 + c];
            MOD[((size_t)l * NSEQ + s) * 6144 + (task % 96) * 64 + c] = t; }
    }
    __syncthreads();
}

__device__ __forceinline__ void prologue(Frame& F) {
    const int tid = otid(); const int lane = tid & 63; (void)lane;
    const int gt = F.vcu * NT + tid, NG = F.G * NT;
    { f32x2* tab = (f32x2*)(F.ws + WS_ROPE);
      for (int i = gt; i < 16384 * 32; i += NG) { const int p = i >> 5, d = i & 31; double rev = (double)p * ROPE_REV[d]; rev -= floor(rev); const float fr = (float)rev;
          tab[i] = (f32x2){__builtin_amdgcn_cosf(fr), __builtin_amdgcn_sinf(fr)}; } }
    { unsigned* z = (unsigned*)(F.ws + WS_XN0); for (int i = gt; i < 512; i += NG) z[i] = 0u; }
    { float* SC = (float*)(F.ws + WS_MOD + 3584 * 1024);
      for (int i = gt; i < NSEQ * D; i += NG) { const int s = i >> 10, k = i & 1023; const float c = (s == 0) ? F.in[I_CP][k] : F.in[I_CS][(size_t)(s - 1) * D + k]; SC[i] = siluf_(c); } }
    convert_layer_weights(F, 0);
}

template <int MODE> __device__ __forceinline__ void norm_row(Frame& F, int layer, int r, f32x4 (&v)[4], const float* MOD, const float* gvec, int lane, f32x4 (&ho)[4]) {
    const int m = layer >> 1; const int shoff = (MODE == 2) ? 3072 : 0, scoff = (MODE == 2) ? 4096 : 1024;
    bf16_t* XN = (bf16_t*)(F.ws + WS_XN); bf16_t* PREVS = (bf16_t*)(F.ws + WS_PREVS);
    float* xrow = F.out + (size_t)r * D; float s2 = 0.f;
#pragma unroll
    for (int j = 0; j < 4; ++j) s2 += (v[j].x * v[j].x + v[j].y * v[j].y) + (v[j].z * v[j].z + v[j].w * v[j].w);
    const float rstd = 1.f / sqrtf(wave_sum(s2) * (1.f / D) + NORM_EPS);
    const int seq = seq_of_row(r); const float* mp = MOD + (size_t)seq * 6144;
#pragma unroll
    for (int j = 0; j < 4; ++j) { const int c = 4 * lane + 256 * j; const f32x4 g4 = *(const f32x4*)(gvec + c); f32x4 o = v[j] * rstd * g4;
        if (MODE == 3) { *((f32x4*)xrow + lane + 64 * j) = o; continue; }
        const f32x4 sc = *(const f32x4*)(mp + scoff + c), sh = *(const f32x4*)(mp + shoff + c);
        o = o * (1.f + sc) + sh; ho[j] = o;
        const unsigned long long pk = (unsigned long long)pk2(o.x, o.y) | ((unsigned long long)pk2(o.z, o.w) << 32);
        *(unsigned long long*)(XN + (size_t)r * D + c) = pk;
        if (MODE == 1) {
            if (r >= MP) { const int t = (r - MP) & 31; if (t < 31) *(unsigned long long*)(PREVS + (size_t)(r - MP + 1) * D + c) = pk;
                else *(f32x4*)(F.out + O_SHS + ((size_t)m * 32 + ((r - MP) >> 5)) * D + c) = o;
                if (t == 0) { const f32x4 ss = *(const f32x4*)(F.in[I_SSHIFT] + ((size_t)m * 32 + ((r - MP) >> 5)) * D + c);
                    *(unsigned long long*)(PREVS + (size_t)(r - MP) * D + c) = (unsigned long long)pk2(ss.x, ss.y) | ((unsigned long long)pk2(ss.z, ss.w) << 32); } }
            else if (r == MP - 1) *(f32x4*)(F.out + O_SHP + (size_t)m * D + c) = o;
        } }
}
__device__ __forceinline__ void hmix_calc(const float* mp, const float* gvec, const f32x4 (&v)[4], int lane, f32x4 (&h)[4]) {
    float s2 = 0.f;
#pragma unroll
    for (int j = 0; j < 4; ++j) s2 += (v[j].x * v[j].x + v[j].y * v[j].y) + (v[j].z * v[j].z + v[j].w * v[j].w);
    const float rstd = 1.f / sqrtf(wave_sum(s2) * (1.f / D) + NORM_EPS);
#pragma unroll
    for (int j = 0; j < 4; ++j) { const int c = 4 * lane + 256 * j; const f32x4 g4 = *(const f32x4*)(gvec + c), sc = *(const f32x4*)(mp + 1024 + c), sh = *(const f32x4*)(mp + c); h[j] = v[j] * rstd * g4 * (1.f + sc) + sh; }
}
__device__ __forceinline__ void write_mixes(Frame& F, int m, int r, const f32x4 (&h)[4], const f32x4 (&p)[4], int lane) {
    bf16_t* XM = (bf16_t*)(F.ws + WS_XMIX); const float* mu = F.in[I_MU] + (size_t)m * 6 * D;
#pragma unroll
    for (int j = 0; j < 4; ++j) { const int c = 4 * lane + 256 * j; const f32x4 d = p[j] - h[j];
#pragma unroll
        for (int q = 0; q < 3; ++q) { const f32x4 mv = *(const f32x4*)(mu + (q == 0 ? 0 : (q == 1 ? 2 : 3)) * D + c); const f32x4 x = h[j] + d * mv;
            *(unsigned long long*)(XM + ((size_t)q * M + r) * D + c) = (unsigned long long)pk2(x.x, x.y) | ((unsigned long long)pk2(x.z, x.w) << 32); } }
}
template <int MODE, int PEND = 0, bool FIRSTP = false> __device__ __forceinline__ void norm_pass(Frame& F, int layer, int player, int pgoff, const float* sx_in, float* sx_out) {
    const int tid = otid(); const int lane = tid & 63;
    const int gw = F.vcu * NWAVES + F.wave, NGW = F.G * NWAVES;
    const float* MOD = (const float*)(F.ws + WS_MOD) + (size_t)layer * NSEQ * 6144;
    const float* gvec = (MODE == 3) ? F.in[I_FINALG] : (MODE == 2 ? F.in[I_NMLPG] + layer * D : F.in[I_NMIXG] + layer * D);
    constexpr int HALO = (MODE == 1) ? 1 : 0;
    LAS float* xs = (LAS float*)F.lds;
    const int m = layer >> 1; const int r0s = MP + 4 * F.vcu;
    const float* gmod = (const float*)(F.ws + WS_MOD) + (size_t)player * NSEQ * 6144 + pgoff;
    if constexpr (PEND > 0) {
        __syncthreads();
#pragma unroll
        for (int q = 0; q < (4 + HALO + 1) / 2; ++q) { const int idx = tid + q * NT, rr = idx >> 8, c4 = (idx & 255) * 4; const int r = r0s - HALO + rr;
            if (rr < 4 + HALO && !(HALO && rr == 0 && ((r0s - MP) & 31) == 0)) {
                const int pn = c4 >> 8; const float* pb = (const float*)(F.ws + WS_PART) + ((size_t)((((r >> 8) - 64) * 4 + pn) * PEND) << 16) + (r & 255) * 256 + (c4 & 255);
                f32x4 acc = (f32x4){0.f, 0.f, 0.f, 0.f};
#pragma unroll
                for (int ks = 0; ks < PEND; ++ks) acc += *(const f32x4*)(pb + ((size_t)ks << 16));
                const f32x4 g4 = *(const f32x4*)(gmod + (size_t)seq_of_row(r) * 6144 + c4); f32x4 x4 = *(const f32x4*)(sx_in + (size_t)(r - MP) * D + c4);
                x4 = x4 + g4 * acc; if (sx_out != nullptr && !(HALO && rr == 0)) *(f32x4*)(sx_out + (size_t)(r - MP) * D + c4) = x4; *(LAS f32x4*)(xs + rr * 1024 + c4) = x4; } }
        __syncthreads();
    }
    for (int r = gw; r < MP; r += NGW) {
        const f32x4* xr = (const f32x4*)((FIRSTP ? F.in[I_XP] : F.out) + (size_t)r * D) + lane; f32x4 v[4], ho[4];
#pragma unroll
        for (int j = 0; j < 4; ++j) v[j] = xr[64 * j];
        if constexpr (MODE == 1) { f32x4 pv[4], hp[4];
#pragma unroll
            for (int j = 0; j < 4; ++j) pv[j] = (r > 0) ? *((const f32x4*)(F.out + (size_t)(r - 1) * D) + lane + 64 * j) : (f32x4){0.f, 0.f, 0.f, 0.f};
            norm_row<MODE>(F, layer, r, v, MOD, gvec, lane, ho);
            if (r > 0) hmix_calc(MOD, gvec, pv, lane, hp); else {
#pragma unroll
                for (int j = 0; j < 4; ++j) hp[j] = (f32x4){0.f, 0.f, 0.f, 0.f}; }
            write_mixes(F, m, r, ho, hp, lane);
        } else norm_row<MODE>(F, layer, r, v, MOD, gvec, lane, ho);
    }
    if (F.wave < 4 && 4 * F.vcu + F.wave < MS) { const int r = r0s + F.wave; f32x4 v[4], ho[4];
#pragma unroll
        for (int j = 0; j < 4; ++j) { if constexpr (PEND > 0) v[j] = *(const LAS f32x4*)(xs + (F.wave + HALO) * 1024 + 4 * lane + 256 * j); else v[j] = *((const f32x4*)(sx_in + (size_t)(r - MP) * D) + lane + 64 * j); }
        norm_row<MODE>(F, layer, r, v, MOD, gvec, lane, ho);
        if constexpr (MODE == 1) { f32x4 hp[4]; const int t = (r - MP) & 31, sq = (r - MP) >> 5;
            if (t == 0) {
#pragma unroll
                for (int j = 0; j < 4; ++j) hp[j] = *((const f32x4*)(F.in[I_SSHIFT] + ((size_t)m * 32 + sq) * D) + lane + 64 * j);
            } else { f32x4 pv[4];
#pragma unroll
                for (int j = 0; j < 4; ++j) pv[j] = *(const LAS f32x4*)(xs + (F.wave + HALO - 1) * 1024 + 4 * lane + 256 * j);
                hmix_calc(MOD + (size_t)(1 + sq) * 6144, gvec, pv, lane, hp); }
            write_mixes(F, m, r, ho, hp, lane); } }
}

template <int MT, int NTT> __device__ __forceinline__ void wave_mm_nt(f32x4 (&acc)[MT][NTT], const LAS bf16_t* X, int ldx, const LAS bf16_t* Y, int ldy, int K, int fr, int fq) {
    for (int k0 = 0; k0 < K; k0 += 32) {
        bf16x8 xa[MT], yb[NTT];
#pragma unroll
        for (int i = 0; i < MT; ++i) xa[i] = *(const LAS bf16x8*)(X + (16 * i + fr) * ldx + k0 + 8 * fq);
#pragma unroll
        for (int j = 0; j < NTT; ++j) yb[j] = *(const LAS bf16x8*)(Y + (16 * j + fr) * ldy + k0 + 8 * fq);
#pragma unroll
        for (int i = 0; i < MT; ++i)
#pragma unroll
            for (int j = 0; j < NTT; ++j) acc[i][j] = __builtin_amdgcn_mfma_f32_16x16x32_bf16(yb[j], xa[i], acc[i][j], 0, 0, 0);
    }
}

constexpr int LQS = 0, LKS = 18432, LQG = 36864, LVT = 55296, LST = 73728, LPS = 108544, LRED = 117760, LBS = 118784;
__device__ __forceinline__ void chunk_geom(int c, int& r0, int& pos0) { if (c < 256) { r0 = 64 * c; pos0 = 64 * c; } else { r0 = MP + 32 * (c - 256); pos0 = 2048; } }

template <int L, bool HG, bool SUMMARY> __device__ __forceinline__ void ab_load(Frame& F, int layer, int c, int h) {
    const int tid = otid(); const int lane = tid & 63; (void)lane;
    const int m = layer >> 1; int r0, pos0; chunk_geom(c, r0, pos0);
    const bf16_t* Z = (const bf16_t*)(F.ws + WS_Z);
    LAS bf16_t* QS = (LAS bf16_t*)(F.lds + LQS); LAS bf16_t* KS = (LAS bf16_t*)(F.lds + LKS); LAS bf16_t* QG = (LAS bf16_t*)(F.lds + LQG); LAS bf16_t* VT = (LAS bf16_t*)(F.lds + LVT);
    constexpr int LDT = L + 8;
    if constexpr (HG) {
        constexpr int TQ = L / 4; LAS float* BS = (LAS float*)(F.lds + LBS);
        const int ch = tid & 127, qtr = tid >> 7;
        float lb = 0.f;
        if (m == 1) { const float a0 = F.in[I_HGLB][h * 128 + ch], a1 = F.in[I_HGLB][512 + h * 128 + ch]; lb = 1.f / (1.f + __expf(a0 - a1)); }
        { constexpr int NP = L * 16;
#pragma unroll
          for (int q = 0; q < (NP + NT - 1) / NT; ++q) { const int v = tid + q * NT; if (NP % NT == 0 || v < NP) { const int j = v >> 4, c8 = v & 15; const size_t zr = (size_t)(r0 + j) * ABIN + h * 128 + c8 * 8;
                  const u32x4 zf4 = *(const u32x4*)(Z + zr + 2048), v4 = *(const u32x4*)(Z + zr + 2560);
                  *(LAS u32x4*)(QG + j * 136 + c8 * 8) = zf4; *(LAS u32x4*)(KS + j * 136 + c8 * 8) = v4;
                  if constexpr (!SUMMARY) { const u32x4 q4 = *(const u32x4*)(Z + zr + 1536); *(LAS u32x4*)(QS + j * 136 + c8 * 8) = q4; } } } }
        __syncthreads();
        float zf[TQ], cs[TQ]; float run = 0.f;
#pragma unroll
        for (int jj = 0; jj < TQ; ++jj) { const int j = qtr * TQ + jj; zf[jj] = bf2f(QG[j * 136 + ch]);
            float lf; if (lb == 0.f) lf = fminf(zf[jj], 0.f) - __logf(1.f + __expf(-fabsf(zf[jj]))); else lf = __logf(lb + (1.f - lb) * sigmoidf_(zf[jj]));
            run += lf; cs[jj] = run; }
        BS[qtr * 128 + ch] = run;
        __syncthreads();
        const float b0 = BS[ch], b1 = BS[128 + ch], b2 = BS[256 + ch], b3 = BS[384 + ch];
        const float off = (qtr > 0 ? b0 : 0.f) + (qtr > 1 ? b1 : 0.f) + (qtr > 2 ? b2 : 0.f), bL = (b0 + b1) + (b2 + b3), bmid = b0 + b1;
        if constexpr (SUMMARY) {
#pragma unroll
            for (int j8 = 0; j8 < TQ; j8 += 8) { unsigned vv[8]; float kd[8];
#pragma unroll
                for (int q = 0; q < 8; ++q) { const int jj = j8 + q, j = qtr * TQ + jj; const float b = off + cs[jj]; const float kb = (1.f - lb) * sigmoidf_(-zf[jj]); vv[q] = KS[j * 136 + ch]; kd[q] = kb * __expf(bL - b); }
                u32x4 pv, pk; pv.x = vv[0] | (vv[1] << 16); pv.y = vv[2] | (vv[3] << 16); pv.z = vv[4] | (vv[5] << 16); pv.w = vv[6] | (vv[7] << 16);
                pk.x = pk2(kd[0], kd[1]); pk.y = pk2(kd[2], kd[3]); pk.z = pk2(kd[4], kd[5]); pk.w = pk2(kd[6], kd[7]);
                *(LAS u32x4*)(VT + ch * LDT + qtr * TQ + j8) = pv; *(LAS u32x4*)(QS + ch * LDT + qtr * TQ + j8) = pk; }
            if (qtr == 0) ((float*)(F.ws + WS_DEC))[((size_t)c * 4 + h) * 128 + ch] = __expf(bL);
        } else {
#pragma unroll
            for (int j8 = 0; j8 < TQ; j8 += 8) { unsigned vv[8];
#pragma unroll
                for (int q8 = 0; q8 < 8; ++q8) { const int jj = j8 + q8, j = qtr * TQ + jj; const float b = off + cs[jj]; const float kb = (1.f - lb) * sigmoidf_(-zf[jj]);
                    const float q = siluf_(bf2f(QS[j * 136 + ch])); vv[q8] = KS[j * 136 + ch];
                    QS[j * 136 + ch] = (bf16_t)f2bf(q * __expf(b - bmid)); KS[j * 136 + ch] = (bf16_t)f2bf(kb * __expf(bmid - b)); QG[j * 136 + ch] = (bf16_t)f2bf(q * __expf(b)); }
                u32x4 pv; pv.x = vv[0] | (vv[1] << 16); pv.y = vv[2] | (vv[3] << 16); pv.z = vv[4] | (vv[5] << 16); pv.w = vv[6] | (vv[7] << 16);
                *(LAS u32x4*)(VT + ch * LDT + qtr * TQ + j8) = pv; }
        }
    } else {
        const float logg = log1pf(-exp2f(-5.f - (float)h));
        const f32x2* rope = (const f32x2*)(F.ws + WS_ROPE);
        for (int it = tid; it < L * 4; it += NT) { const int j = it >> 2, d8 = it & 3; const size_t zr = (size_t)(r0 + j) * ABIN;
            const f32x2* rp = rope + (size_t)(pos0 + j) * 32 + d8 * 8;
            const u32x4 k1 = *(const u32x4*)(Z + zr + 256 + h * 64 + d8 * 8), k2 = *(const u32x4*)(Z + zr + 256 + h * 64 + 32 + d8 * 8);
            const float gk = __expf((float)(L - 1 - j) * logg), gq = __expf((float)(j + 1) * logg);
            u32x4 q1 = (u32x4){0, 0, 0, 0}, q2 = q1; if constexpr (!SUMMARY) { q1 = *(const u32x4*)(Z + zr + h * 64 + d8 * 8); q2 = *(const u32x4*)(Z + zr + h * 64 + 32 + d8 * 8); }
#pragma unroll
            for (int e = 0; e < 8; ++e) { const f32x2 cs_ = rp[e]; const unsigned wk1 = k1[e >> 1], wk2 = k2[e >> 1]; const float x1 = (e & 1) ? bfhi(wk1) : bflo(wk1), x2 = (e & 1) ? bfhi(wk2) : bflo(wk2);
                const float o1 = x1 * cs_.x - x2 * cs_.y, o2 = x1 * cs_.y + x2 * cs_.x; const int d = d8 * 8 + e;
                if constexpr (SUMMARY) { QS[d * LDT + j] = (bf16_t)f2bf(o1 * gk); QS[(d + 32) * LDT + j] = (bf16_t)f2bf(o2 * gk); }
                else { KS[j * 72 + d] = (bf16_t)f2bf(o1); KS[j * 72 + d + 32] = (bf16_t)f2bf(o2);
                    const unsigned wq1 = q1[e >> 1], wq2 = q2[e >> 1]; const float y1 = (e & 1) ? bfhi(wq1) : bflo(wq1), y2 = (e & 1) ? bfhi(wq2) : bflo(wq2);
                    const float p1 = (y1 * cs_.x - y2 * cs_.y) * 0.125f, p2 = (y1 * cs_.y + y2 * cs_.x) * 0.125f;
                    QS[j * 72 + d] = (bf16_t)f2bf(p1); QS[j * 72 + d + 32] = (bf16_t)f2bf(p2); QG[j * 72 + d] = (bf16_t)f2bf(p1 * gq); QG[j * 72 + d + 32] = (bf16_t)f2bf(p2 * gq); } } }
        for (int it = tid; it < L * 16; it += NT) { const int j = it >> 4, e8 = it & 15; const u32x4 vv = *(const u32x4*)(Z + (size_t)(r0 + j) * ABIN + 512 + h * 128 + e8 * 8);
#pragma unroll
            for (int e = 0; e < 8; ++e) { const unsigned w = vv[e >> 1]; VT[(e8 * 8 + e) * LDT + j] = (bf16_t)((e & 1) ? (w >> 16) : (w & 0xffffu)); } }
    }
}

template <int L, bool HG> __device__ __forceinline__ void ab_summary_unit(Frame& F, int layer, int c, int h) {
    const int tid = otid(); const int lane = tid & 63; (void)lane;
    constexpr int DK = HG ? 128 : 64, NCT = DK / 16, LDT = L + 8;
    __syncthreads();
    ab_load<L, HG, true>(F, layer, c, h);
    __syncthreads();
    const int fr = lane & 15, fq = lane >> 4;
    const LAS bf16_t* KDT = (const LAS bf16_t*)(F.lds + LQS); const LAS bf16_t* VT = (const LAS bf16_t*)(F.lds + LVT);
    f32x4 acc[1][NCT];
#pragma unroll
    for (int j = 0; j < NCT; ++j) acc[0][j] = (f32x4){0.f, 0.f, 0.f, 0.f};
    wave_mm_nt<1, NCT>(acc, VT + F.wave * 16 * LDT, LDT, KDT, LDT, L, fr, fq);
    bf16_t* ST = (bf16_t*)(F.ws + WS_STATE) + (size_t)c * SLOT_E + (HG ? 32768 + h * 16384 : h * 8192);
    const int e = F.wave * 16 + fr;
#pragma unroll
    for (int j = 0; j < NCT; ++j) { u32x2 w; w.x = pk2(acc[0][j][0], acc[0][j][1]); w.y = pk2(acc[0][j][2], acc[0][j][3]); *(u32x2*)(ST + (size_t)e * DK + 16 * j + 4 * fq) = w; }
}

template <int L, bool HG> __device__ __forceinline__ void ab_output_unit(Frame& F, int layer, int c, int h) {
    const int tid = otid(); const int lane = tid & 63; (void)lane;
    constexpr int DK = HG ? 128 : 64, LDQ = HG ? 136 : 72, LDT = L + 8, NIT = L / 16, WPI = 8 / NIT, ET = 8 / WPI, TPW = (NIT * NIT >= 8) ? NIT * NIT / 8 : 1;
    const int m = layer >> 1; int r0, pos0; chunk_geom(c, r0, pos0);
    __syncthreads();
    ab_load<L, HG, false>(F, layer, c, h);
    LAS bf16_t* QS = (LAS bf16_t*)(F.lds + LQS); LAS bf16_t* KS = (LAS bf16_t*)(F.lds + LKS); LAS bf16_t* QG = (LAS bf16_t*)(F.lds + LQG); LAS bf16_t* VT = (LAS bf16_t*)(F.lds + LVT);
    LAS bf16_t* STl = (LAS bf16_t*)(F.lds + LST); LAS bf16_t* PS = (LAS bf16_t*)(F.lds + LPS); LAS float* RED = (LAS float*)(F.lds + LRED);
    { const bf16_t* ST = (const bf16_t*)(F.ws + WS_STATE) + (size_t)c * SLOT_E + (HG ? 32768 + h * 16384 : h * 8192);
      for (int it = tid; it < 128 * DK / 8; it += NT) { const int e = it / (DK / 8), c8 = it % (DK / 8); *(LAS u32x4*)(STl + e * LDQ + c8 * 8) = *(const u32x4*)(ST + (size_t)e * DK + c8 * 8); } }
    __syncthreads();
    const int fr = lane & 15, fq = lane >> 4, w = F.wave;
    const float logg = HG ? 0.f : log1pf(-exp2f(-5.f - (float)h));
    if (w * TPW < NIT * NIT) {
        const int it = (w * TPW) / NIT, jt0 = (w * TPW) % NIT;
        f32x4 sc[1][TPW];
#pragma unroll
        for (int q = 0; q < TPW; ++q) sc[0][q] = (f32x4){0.f, 0.f, 0.f, 0.f};
        wave_mm_nt<1, TPW>(sc, QS + it * 16 * LDQ, LDQ, KS + jt0 * 16 * LDQ, LDQ, DK, fr, fq);
        const int i = it * 16 + fr;
#pragma unroll
        for (int q = 0; q < TPW; ++q) { float p[4];
#pragma unroll
            for (int r = 0; r < 4; ++r) { const int j = (jt0 + q) * 16 + 4 * fq + r; float v = sc[0][q][r]; if (!HG) v *= __expf((float)(i - j) * logg); p[r] = (j <= i) ? v : 0.f; }
            u32x2 pw; pw.x = pk2(p[0], p[1]); pw.y = pk2(p[2], p[3]); *(LAS u32x2*)(PS + i * LDT + (jt0 + q) * 16 + 4 * fq) = pw; }
    }
    __syncthreads();
    const int it = w % NIT, eg = w / NIT;
    f32x4 o[1][ET];
#pragma unroll
    for (int q = 0; q < ET; ++q) o[0][q] = (f32x4){0.f, 0.f, 0.f, 0.f};
    wave_mm_nt<1, ET>(o, PS + it * 16 * LDT, LDT, VT + eg * ET * 16 * LDT, LDT, L, fr, fq);
    wave_mm_nt<1, ET>(o, QG + it * 16 * LDQ, LDQ, STl + eg * ET * 16 * LDQ, LDQ, DK, fr, fq);
    float ss = 0.f;
#pragma unroll
    for (int q = 0; q < ET; ++q) ss += (o[0][q][0] * o[0][q][0] + o[0][q][1] * o[0][q][1]) + (o[0][q][2] * o[0][q][2] + o[0][q][3] * o[0][q][3]);
    ss += __shfl_xor(ss, 16); ss += __shfl_xor(ss, 32);
    const int i = it * 16 + fr;
    if (fq == 0) RED[i * 4 + eg] = ss;
    __syncthreads();
    float tot = 0.f;
#pragma unroll
    for (int q = 0; q < WPI; ++q) tot += RED[i * 4 + q];
    const float rstd = 1.f / sqrtf(tot * (1.f / 128.f) + NORM_EPS);
    const bf16_t* Z = (const bf16_t*)(F.ws + WS_Z); bf16_t* O = (bf16_t*)(F.ws + WS_XN);
    const size_t row = (size_t)(r0 + i);
#pragma unroll
    for (int q = 0; q < ET; ++q) { const int e = (eg * ET + q) * 16 + 4 * fq; const u32x2 gw = *(const u32x2*)(Z + row * ABIN + (HG ? 3072 : 1024) + h * 128 + e);
        const float g4[4] = {bflo(gw.x), bfhi(gw.x), bflo(gw.y), bfhi(gw.y)}; float ov[4];
#pragma unroll
        for (int r = 0; r < 4; ++r) { if (HG) ov[r] = o[0][q][r] * rstd * F.in[I_HGNG][m * 128 + e + r] * sigmoidf_(g4[r]); else ov[r] = o[0][q][r] * rstd * siluf_(g4[r]); }
        u32x2 ow; ow.x = pk2(ov[0], ov[1]); ow.y = pk2(ov[2], ov[3]); *(u32x2*)(O + row * D + (HG ? 512 : 0) + h * 128 + e) = ow; }
}

template <bool DRY = false> __device__ __forceinline__ void ab_scan(Frame& F, int layer) {
    const int tid = otid(); const int lane = tid & 63; (void)lane;
    const int m = layer >> 1;
    unsigned* ST32 = (unsigned*)(F.ws + WS_STATE); const float* DEC = (const float*)(F.ws + WS_DEC);
    constexpr int NP = SLOT_E / 2;
    const int gt = F.vcu * NT + tid;
    if (gt < NP) {
        const int eo = 2 * gt; const bool hg = eo >= 32768; const int eo2 = hg ? eo - 32768 : eo; const int head = hg ? eo2 >> 14 : eo2 >> 13; const int cch = hg ? (eo2 & 127) : (eo2 & 63); const int e = hg ? ((eo2 & 16383) >> 7) : ((eo2 & 8191) >> 6);
        const float gdec = hg ? 0.f : __expf(64.f * log1pf(-exp2f(-5.f - (float)head)));
        float s0 = 0.f, s1 = 0.f;
        for (int c0 = 0; c0 < 256; c0 += 32) {
            unsigned kv[32]; float d0[32], d1[32];
#pragma unroll
            for (int u = 0; u < 32; ++u) { kv[u] = ST32[(size_t)(c0 + u) * NP + gt]; if (hg) { const f32x2 dd = *(const f32x2*)(DEC + ((size_t)(c0 + u) * 4 + head) * 128 + cch); d0[u] = dd.x; d1[u] = dd.y; } else { d0[u] = gdec; d1[u] = gdec; } }
#pragma unroll
            for (int u = 0; u < 32; ++u) { const unsigned pw = pk2(s0, s1); if constexpr (DRY) asm volatile("" :: "v"(pw)); else ST32[(size_t)(c0 + u) * NP + gt] = pw; s0 = d0[u] * s0 + bflo(kv[u]); s1 = d1[u] * s1 + bfhi(kv[u]); }
        }
        float* outp = hg ? F.out + O_HGP + (size_t)m * 65536 + head * 16384 : F.out + O_RETP + (size_t)m * 32768 + head * 8192;
        outp[(size_t)cch * 128 + e] = s0; outp[(size_t)(cch + 1) * 128 + e] = s1;
    } else {
        const int NG2 = F.G * NT - NP; if (NG2 <= 0) return;
        for (int idx = gt - NP; idx < 32 * NP; idx += NG2) { const int b = idx / NP, pr = idx % NP;
            const int eo = 2 * pr; const bool hg = eo >= 32768; const int eo2 = hg ? eo - 32768 : eo; const int head = hg ? eo2 >> 14 : eo2 >> 13; const int cch = hg ? (eo2 & 127) : (eo2 & 63); const int e = hg ? ((eo2 & 16383) >> 7) : ((eo2 & 8191) >> 6);
            float d0, d1; if (hg) { const f32x2 dd = *(const f32x2*)(DEC + ((size_t)(256 + b) * 4 + head) * 128 + cch); d0 = dd.x; d1 = dd.y; } else { d0 = d1 = __expf(32.f * log1pf(-exp2f(-5.f - (float)head))); }
            const size_t so = hg ? ((size_t)(m * 32 + b) * 4 + head) * 16384 : ((size_t)(m * 32 + b) * 4 + head) * 8192;
            const float* sin_ = (hg ? F.in[I_SHG] : F.in[I_SRET]) + so; float* sout = F.out + (hg ? O_HGS : O_RETS) + so;
            const float i0 = sin_[(size_t)cch * 128 + e], i1 = sin_[(size_t)(cch + 1) * 128 + e];
            const unsigned kv = ST32[(size_t)(256 + b) * NP + pr]; if constexpr (!DRY) ST32[(size_t)(256 + b) * NP + pr] = pk2(i0, i1);
            sout[(size_t)cch * 128 + e] = d0 * i0 + bflo(kv); sout[(size_t)(cch + 1) * 128 + e] = d1 * i1 + bfhi(kv); }
    }
}

constexpr int RL_AT = 0, RL_RT = 9216, RL_BT = 18432, RL_KT = 27648, RL_BHT = 36864, RL_KHT = 46080, RL_VT = 55296, RL_AAB = 64512, RL_AAK = 81920, RL_ARB = 91136, RL_ARK = 100352,
              RL_U0T = 109568, RL_VEC = 118784, RL_PSUM = 119808;
constexpr int RL_G = RL_AAB, RL_WW = RL_BT, RL_APT = RL_AAK;
constexpr int RL_PL = RL_AT, RL_RL = RL_BT, RL_Y0L = RL_BT + 4608, RL_QTL = RL_AAB, RL_S = RL_BHT;
__device__ __forceinline__ int pperm(int k) { return 32 * (k >> 5) + 8 * ((k >> 2) & 3) + 4 * ((k >> 4) & 1) + (k & 3); }

struct OutSide { u32x2 vv[4], gg[4]; f32x4 lg[4], lb[4]; float bon; };
__device__ __forceinline__ void rwkv_out_side(Frame& F, int m, size_t row, int h, int fq, OutSide& o) {
    const bf16_t* RKV = (const bf16_t*)(F.ws + WS_RKV); const bf16_t* GG = (const bf16_t*)(F.ws + WS_G); const float* BON = (const float*)(F.ws + WS_BON);
    o.bon = BON[row * 16 + h];
#pragma unroll
    for (int nt = 0; nt < 4; ++nt) { const int i = h * 64 + 16 * nt + 4 * fq;
        o.lg[nt] = *(const f32x4*)(F.in[I_RLNG] + m * D + i); o.lb[nt] = *(const f32x4*)(F.in[I_RLNB] + m * D + i);
        o.vv[nt] = *(const u32x2*)(RKV + row * 3072 + 2048 + i); o.gg[nt] = *(const u32x2*)(GG + row * D + i); }
}
template <bool DRY = false> __device__ __forceinline__ void rwkv_out_core(Frame& F, const f32x4 (&y)[4], size_t row, int h, int fq, const OutSide& sd) {
    bf16_t* RKV = (bf16_t*)(F.ws + WS_RKV);
    float s1 = 0.f;
#pragma unroll
    for (int nt = 0; nt < 4; ++nt) s1 += (y[nt][0] + y[nt][1]) + (y[nt][2] + y[nt][3]);
    s1 += __shfl_xor(s1, 16); s1 += __shfl_xor(s1, 32);
    const float mean = s1 * (1.f / 64.f); float s2 = 0.f;
#pragma unroll
    for (int nt = 0; nt < 4; ++nt)
#pragma unroll
        for (int r = 0; r < 4; ++r) { const float d = y[nt][r] - mean; s2 += d * d; }
    s2 += __shfl_xor(s2, 16); s2 += __shfl_xor(s2, 32);
    const float rstd = 1.f / sqrtf(s2 * (1.f / 64.f) + RW_LN_EPS), bon = sd.bon;
#pragma unroll
    for (int nt = 0; nt < 4; ++nt) { const int i = h * 64 + 16 * nt + 4 * fq; const f32x4 lg = sd.lg[nt], lb = sd.lb[nt]; const u32x2 vv = sd.vv[nt], gg = sd.gg[nt];
        const float v4[4] = {bflo(vv.x), bfhi(vv.x), bflo(vv.y), bfhi(vv.y)}, g4[4] = {bflo(gg.x), bfhi(gg.x), bflo(gg.y), bfhi(gg.y)}; float o[4];
#pragma unroll
        for (int r = 0; r < 4; ++r) o[r] = ((y[nt][r] - mean) * rstd * lg[r] + lb[r] + bon * v4[r]) * g4[r];
        u32x2 w; w.x = pk2(o[0], o[1]); w.y = pk2(o[2], o[3]); if constexpr (DRY) asm volatile("" :: "v"(w.x), "v"(w.y)); else *(u32x2*)(RKV + row * 3072 + i) = w; }
}
template <bool DRY = false> __device__ __forceinline__ void rwkv_out_epilogue(Frame& F, int m, const f32x4 (&y)[4], size_t row, int h, int fq) {
    OutSide sd; rwkv_out_side(F, m, row, h, fq, sd); rwkv_out_core<DRY>(F, y, row, h, fq, sd);
}

template <int MT, int NTT, bool XS, bool YS> __device__ __forceinline__ void wave_mm_nt72(f32x4 (&acc)[MT][NTT], const LAS bf16_t* X, int xr0, const LAS bf16_t* Y, int yr0, int K, int fr, int fq) {
    for (int k0 = 0; k0 < K; k0 += 32) { const int ch = (k0 >> 3) + fq;
        bf16x8 xa[MT], yb[NTT];
#pragma unroll
        for (int i = 0; i < MT; ++i) { const int row = xr0 + 16 * i + fr; xa[i] = *(const LAS bf16x8*)(X + row * 72 + 8 * (XS ? (ch ^ ((row >> 3) & 7)) : ch)); }
#pragma unroll
        for (int j = 0; j < NTT; ++j) { const int row = yr0 + 16 * j + fr; yb[j] = *(const LAS bf16x8*)(Y + row * 72 + 8 * (YS ? (ch ^ ((row >> 3) & 7)) : ch)); }
#pragma unroll
        for (int i = 0; i < MT; ++i)
#pragma unroll
            for (int j = 0; j < NTT; ++j) acc[i][j] = __builtin_amdgcn_mfma_f32_16x16x32_bf16(yb[j], xa[i], acc[i][j], 0, 0, 0);
    }
}
typedef short s16x4 __attribute__((ext_vector_type(4)));
__device__ __forceinline__ s16x4 pack4(const f32x4& v) { u32x2 p; p.x = pk2(v[0], v[1]); p.y = pk2(v[2], v[3]); return __builtin_bit_cast(s16x4, p); }
template <int S> struct TinvStep {
    static __device__ __forceinline__ void run(float (&y)[16], f32x4 (&nq)[3][4], const LAS float* dp) {
        if constexpr (S >= 1) {
            if constexpr (S - 2 >= 1) {
#pragma unroll
                for (int k = 0; k < (S - 2 + 3) / 4; ++k) nq[(S - 2) % 3][k] = *(const LAS f32x4*)(dp + (S - 2) * 20 + 4 * k);
            }
            const float ys = y[S];
#pragma unroll
            for (int q = S - 1; q >= 0; --q) { y[q] += nq[S % 3][q >> 2][q & 3] * ys; asm volatile("" : "+v"(y[q])); }
            asm volatile("" ::: "memory");
            TinvStep<S - 1>::run(y, nq, dp);
        }
    }
};
struct RawRegs { u32x4 r, k, v, w, a; f32x4 kk[2], ka[2], rk[2]; };
__device__ __forceinline__ void rwkv_load_raw(Frame& F, int m, int u, int tid, RawRegs& raw) {
    const int c = u >> 4, h = u & 15; int r0, pos0; chunk_geom(c, r0, pos0); const int L = c < 256 ? 64 : 32; int t = tid >> 3; t = t < L ? t : 0;
    const bf16_t* RKV = (const bf16_t*)(F.ws + WS_RKV); const bf16_t* WLOG = (const bf16_t*)(F.ws + WS_WLOG); const bf16_t* AA = (const bf16_t*)(F.ws + WS_XN);
    const size_t row = (size_t)(r0 + t); const int col = h * 64 + 8 * (tid & 7);
    raw.r = *(const u32x4*)(RKV + row * 3072 + col); raw.k = *(const u32x4*)(RKV + row * 3072 + 1024 + col); raw.v = *(const u32x4*)(RKV + row * 3072 + 2048 + col);
    raw.w = *(const u32x4*)(WLOG + row * D + col); raw.a = *(const u32x4*)(AA + row * D + col);
    const float* kkp = F.in[I_RKK] + m * D + col; const float* kap = F.in[I_RKA] + m * D + col; const float* rkp = F.in[I_RRK] + m * D + col;
    raw.kk[0] = *(const f32x4*)kkp; raw.kk[1] = *(const f32x4*)(kkp + 4); raw.ka[0] = *(const f32x4*)kap; raw.ka[1] = *(const f32x4*)(kap + 4); raw.rk[0] = *(const f32x4*)rkp; raw.rk[1] = *(const f32x4*)(rkp + 4);
}
template <int L, bool DRY = false> __device__ __forceinline__ void rwkv_local_unit(Frame& F, int layer, int c, int h, RawRegs& raw, int unext) {
    const int tid = otid(); const int lane = tid & 63, fr = lane & 15, fq = lane >> 4, w = F.wave;
    constexpr int NIT = L / 16; constexpr bool SAMPLE = (L == 32);
    const int m = layer >> 1; int r0, pos0; chunk_geom(c, r0, pos0);
    bf16_t* RKV = (bf16_t*)(F.ws + WS_RKV); const bf16_t* WLOG = (const bf16_t*)(F.ws + WS_WLOG); const bf16_t* AA = (const bf16_t*)(F.ws + WS_XN);
    LAS bf16_t* AT = (LAS bf16_t*)(F.lds + RL_AT); LAS bf16_t* RT = (LAS bf16_t*)(F.lds + RL_RT); LAS bf16_t* BT = (LAS bf16_t*)(F.lds + RL_BT); LAS bf16_t* KT = (LAS bf16_t*)(F.lds + RL_KT);
    LAS bf16_t* BHT = (LAS bf16_t*)(F.lds + RL_BHT); LAS bf16_t* KHT = (LAS bf16_t*)(F.lds + RL_KHT); LAS bf16_t* VT = (LAS bf16_t*)(F.lds + RL_VT);
    LAS bf16_t* AABH = (LAS bf16_t*)(F.lds + RL_AAB); LAS float* DIAG = (LAS float*)(F.lds + RL_AAB + 9216); LAS bf16_t* TINV = (LAS bf16_t*)(F.lds + RL_AAB + 14336); LAS bf16_t* AAK = (LAS bf16_t*)(F.lds + RL_AAK); LAS bf16_t* ARB = (LAS bf16_t*)(F.lds + RL_ARB); LAS bf16_t* ARK = (LAS bf16_t*)(F.lds + RL_ARK);
    LAS bf16_t* U0T = (LAS bf16_t*)(F.lds + RL_U0T); LAS float* GMID = (LAS float*)(F.lds + RL_VEC); LAS float* GLV = GMID + 64; LAS float* EGM = GMID + 128; LAS float* PSUM = (LAS float*)(F.lds + RL_PSUM);
    LAS float* G = (LAS float*)(F.lds + RL_G); LAS float* WW = (LAS float*)(F.lds + RL_WW); LAS bf16_t* APT = (LAS bf16_t*)(F.lds + RL_APT);
    __syncthreads();
    const int t = tid >> 3, c8 = tid & 7; const bool act = t < L;
    float rr[8], kkv[8], bb[8], kh[8], vv[8];
    if (act) { const size_t row = (size_t)(r0 + t); const int col = h * 64 + 8 * c8;
        const u32x4 r4 = raw.r, k4 = raw.k, v4 = raw.v, w4 = raw.w, a4 = raw.a;
        const f32x4 kkq[2] = {raw.kk[0], raw.kk[1]}, kaq[2] = {raw.ka[0], raw.ka[1]}, rkq[2] = {raw.rk[0], raw.rk[1]};
        float ss = 0.f, bon = 0.f;
#pragma unroll
        for (int e = 0; e < 8; ++e) { const float kx = (e & 1) ? bfhi(k4[e >> 1]) : bflo(k4[e >> 1]), al = (e & 1) ? bfhi(a4[e >> 1]) : bflo(a4[e >> 1]);
            rr[e] = (e & 1) ? bfhi(r4[e >> 1]) : bflo(r4[e >> 1]); vv[e] = (e & 1) ? bfhi(v4[e >> 1]) : bflo(v4[e >> 1]);
            kkv[e] = kx * kkq[e >> 2][e & 3]; ss += kkv[e] * kkv[e]; kh[e] = kx * (1.f + (al - 1.f) * kaq[e >> 2][e & 3]); bb[e] = al; bon += rr[e] * kh[e] * rkq[e >> 2][e & 3];
            G[t * 64 + 8 * c8 + e] = (e & 1) ? bfhi(w4[e >> 1]) : bflo(w4[e >> 1]); }
        ss += __shfl_xor(ss, 1); ss += __shfl_xor(ss, 2); ss += __shfl_xor(ss, 4); bon += __shfl_xor(bon, 1); bon += __shfl_xor(bon, 2); bon += __shfl_xor(bon, 4);
        const float inv = 1.f / fmaxf(sqrtf(ss), 1e-12f);
#pragma unroll
        for (int e = 0; e < 8; ++e) { kkv[e] *= inv; bb[e] *= kkv[e]; }
        if (c8 == 0) ((float*)(F.ws + WS_BON))[row * 16 + h] = bon; }
    if (unext >= 0) rwkv_load_raw(F, m, unext, tid, raw);
    __syncthreads();
    { constexpr int TE = L / 8; const int j = tid & 63, e8 = tid >> 6; float cs[TE]; float run = 0.f;
#pragma unroll
      for (int q = 0; q < TE; ++q) { run += G[(e8 * TE + q) * 64 + j]; cs[q] = run; }
      PSUM[e8 * 64 + j] = run;
      __syncthreads();
      float off = 0.f, gm = 0.f, gl = 0.f;
#pragma unroll
      for (int q = 0; q < 8; ++q) { const float p = PSUM[q * 64 + j]; if (q < e8) off += p; if (q < 4) gm += p; gl += p; }
#pragma unroll
      for (int q = 0; q < TE; ++q) G[(e8 * TE + q) * 64 + j] = off + cs[q];
      if (e8 == 0) { GMID[j] = gm; GLV[j] = gl; EGM[j] = __expf(gm); if (!SAMPLE) ((float*)(F.ws + WS_REC + ((size_t)h * 256 + c) * REC_B + 16384))[j] = __expf(gl); } }
    __syncthreads();
    if (act) { float fa[8], fr_[8], fb[8], fk[8]; const int tsw = 8 * ((t >> 3) ^ c8) + (t & 7);
#pragma unroll
        for (int e = 0; e < 8; ++e) { const int j = 8 * c8 + e; const float g = G[t * 64 + j], gp = (t > 0) ? G[(t - 1) * 64 + j] : 0.f, gm = GMID[j], gl = GLV[j];
            const float ed = __expf(gm - g), eu = __expf(g - gm), el = __expf(gl - g);
            fa[e] = -kkv[e] * __expf(gp - gm); fr_[e] = rr[e] * eu; fb[e] = bb[e] * ed; fk[e] = kh[e] * ed;
            if constexpr (!(DRY && (LOCAL_SKIP & 4))) { BHT[j * 72 + tsw] = (bf16_t)f2bf(bb[e] * el); KHT[j * 72 + tsw] = (bf16_t)f2bf(kh[e] * el); VT[j * 72 + tsw] = (bf16_t)f2bf(vv[e]); } }
        u32x4 p;
        p.x = pk2(fa[0], fa[1]); p.y = pk2(fa[2], fa[3]); p.z = pk2(fa[4], fa[5]); p.w = pk2(fa[6], fa[7]); *(LAS u32x4*)(AT + t * 72 + 8 * c8) = p;
        p.x = pk2(fr_[0], fr_[1]); p.y = pk2(fr_[2], fr_[3]); p.z = pk2(fr_[4], fr_[5]); p.w = pk2(fr_[6], fr_[7]); *(LAS u32x4*)(RT + t * 72 + 8 * c8) = p;
        p.x = pk2(fb[0], fb[1]); p.y = pk2(fb[2], fb[3]); p.z = pk2(fb[4], fb[5]); p.w = pk2(fb[6], fb[7]); *(LAS u32x4*)(BT + t * 72 + 8 * c8) = p;
        p.x = pk2(fk[0], fk[1]); p.y = pk2(fk[2], fk[3]); p.z = pk2(fk[4], fk[5]); p.w = pk2(fk[6], fk[7]); *(LAS u32x4*)(KT + t * 72 + 8 * c8) = p; }
    __syncthreads();
    if constexpr (DRY && (LOCAL_SKIP & 2)) return;
    { constexpr int TPW = (NIT * NIT >= 8) ? NIT * NIT / 8 : 1;
      if (w * TPW < NIT * NIT) { const int it = (w * TPW) / NIT, jt0 = (w * TPW) % NIT;
          f32x4 ab[1][TPW], ak[1][TPW], rb[1][TPW], rk[1][TPW];
#pragma unroll
          for (int q = 0; q < TPW; ++q) { ab[0][q] = (f32x4){0.f, 0.f, 0.f, 0.f}; ak[0][q] = ab[0][q]; rb[0][q] = ab[0][q]; rk[0][q] = ab[0][q]; }
          wave_mm_nt<1, TPW>(ab, AT + it * 16 * 72, 72, BT + jt0 * 16 * 72, 72, 64, fr, fq); wave_mm_nt<1, TPW>(ak, AT + it * 16 * 72, 72, KT + jt0 * 16 * 72, 72, 64, fr, fq);
          wave_mm_nt<1, TPW>(rb, RT + it * 16 * 72, 72, BT + jt0 * 16 * 72, 72, 64, fr, fq); wave_mm_nt<1, TPW>(rk, RT + it * 16 * 72, 72, KT + jt0 * 16 * 72, 72, 64, fr, fq);
          const int tt = it * 16 + fr;
#pragma unroll
          for (int q = 0; q < TPW; ++q) { const int s0 = (jt0 + q) * 16 + 4 * fq; f32x4 fab; float fak[4], frb[4], frk[4];
#pragma unroll
              for (int r = 0; r < 4; ++r) { const int sx = s0 + r; fab[r] = (sx < tt) ? ab[0][q][r] : 0.f; fak[r] = (sx < tt) ? ak[0][q][r] : 0.f; frb[r] = (sx <= tt) ? rb[0][q][r] : 0.f; frk[r] = (sx <= tt) ? rk[0][q][r] : 0.f; }
              u32x2 p; p.x = pk2(fab[0], fab[1]); p.y = pk2(fab[2], fab[3]); *(LAS u32x2*)(AABH + tt * 72 + s0) = p;
              if (jt0 + q == it) *(LAS f32x4*)(DIAG + tt * 20 + 4 * fq) = fab;
              p.x = pk2(fak[0], fak[1]); p.y = pk2(fak[2], fak[3]); *(LAS u32x2*)(AAK + tt * 72 + s0) = p;
              p.x = pk2(frb[0], frb[1]); p.y = pk2(frb[2], frb[3]); *(LAS u32x2*)(ARB + tt * 72 + s0) = p;
              p.x = pk2(frk[0], frk[1]); p.y = pk2(frk[2], frk[3]); *(LAS u32x2*)(ARK + tt * 72 + s0) = p; } } }
    __syncthreads();
    constexpr int NB = L / 16;
    f32x4 rhs[1][NB];
    if (w >= 4) {
#pragma unroll
        for (int b = 0; b < NB; ++b) rhs[0][b] = (f32x4){0.f, 0.f, 0.f, 0.f};
        wave_mm_nt72<1, NB, true, false>(rhs, VT, (w - 4) * 16, AAK, 0, L, fr, fq);
    } else { const int cc = w * 16 + fr; const float eg = EGM[cc];
#pragma unroll
        for (int b = 0; b < NB; ++b)
#pragma unroll
            for (int r = 0; r < 4; ++r) rhs[0][b][r] = bf2f(AT[(16 * b + 4 * fq + r) * 72 + cc]) * eg; }
    if (w == 0) {
        float y[16]; f32x4 nq[3][4]; const LAS float* dp = DIAG + 16 * fq * 20;
#pragma unroll
        for (int q = 0; q < 16; ++q) y[q] = (q == fr) ? 1.f : 0.f;
#pragma unroll
        for (int k = 0; k < 4; ++k) { nq[15 % 3][k] = *(const LAS f32x4*)(dp + 15 * 20 + 4 * k); nq[14 % 3][k] = *(const LAS f32x4*)(dp + 14 * 20 + 4 * k); }
        TinvStep<15>::run(y, nq, dp);
        if (fq < NB) { u32x4 p; LAS bf16_t* tp = TINV + (16 * fq + fr) * 24;
            p.x = pk2(y[0], y[1]); p.y = pk2(y[2], y[3]); p.z = pk2(y[4], y[5]); p.w = pk2(y[6], y[7]); *(LAS u32x4*)tp = p;
            p.x = pk2(y[8], y[9]); p.y = pk2(y[10], y[11]); p.z = pk2(y[12], y[13]); p.w = pk2(y[14], y[15]); *(LAS u32x4*)(tp + 8) = p; } }
    __syncthreads();
    { s16x4 xb[NB], ti[NB], pa[NB][NB]; LAS bf16_t* dst = ((w < 4) ? APT : U0T) + ((w & 3) * 16 + fr) * 72 + 4 * fq;
#pragma unroll
      for (int bi = 0; bi < NB; ++bi) { ti[bi] = *(const LAS s16x4*)(TINV + (16 * bi + fr) * 24 + 4 * fq);
#pragma unroll
          for (int bj = 0; bj < bi; ++bj) pa[bi][bj] = *(const LAS s16x4*)(AABH + (16 * bi + fr) * 72 + 16 * bj + 4 * fq); }
#pragma unroll
      for (int bi = 0; bi < NB; ++bi) { f32x4 acc = rhs[0][bi];
#pragma unroll
          for (int bj = 0; bj < bi; ++bj) acc = __builtin_amdgcn_mfma_f32_16x16x16bf16_1k(pa[bi][bj], xb[bj], acc, 0, 0, 0);
          const f32x4 xa = __builtin_amdgcn_mfma_f32_16x16x16bf16_1k(ti[bi], pack4(acc), (f32x4){0.f, 0.f, 0.f, 0.f}, 0, 0, 0);
          xb[bi] = pack4(xa); }
#pragma unroll
      for (int bi = 0; bi < NB; ++bi) *(LAS s16x4*)(dst + 16 * bi) = xb[bi]; }
    __syncthreads();
    { const int mt = w >> 1, nt0 = (w & 1) * 2;
      f32x4 pp[1][2], qt[1][2];
#pragma unroll
      for (int q = 0; q < 2; ++q) { pp[0][q] = (f32x4){0.f, 0.f, 0.f, 0.f}; qt[0][q] = pp[0][q]; }
      wave_mm_nt72<1, 2, true, false>(pp, BHT, mt * 16, APT, nt0 * 16, L, fr, fq);
      wave_mm_nt72<1, 2, false, true>(qt, U0T, mt * 16, BHT, nt0 * 16, L, fr, fq); wave_mm_nt72<1, 2, true, true>(qt, VT, mt * 16, KHT, nt0 * 16, L, fr, fq);
      constexpr int TP5 = NIT / 2; const int it = (w * TP5) / 4, rn0 = (w * TP5) % 4;
      f32x4 rp[1][TP5], y0[1][TP5];
#pragma unroll
      for (int q = 0; q < TP5; ++q) { const int j = (rn0 + q) * 16 + 4 * fq; const u32x2 rw = *(const LAS u32x2*)(RT + (it * 16 + fr) * 72 + j); const f32x4 e4 = *(const LAS f32x4*)(EGM + j);
          rp[0][q] = (f32x4){bflo(rw.x) * e4[0], bfhi(rw.x) * e4[1], bflo(rw.y) * e4[2], bfhi(rw.y) * e4[3]}; y0[0][q] = (f32x4){0.f, 0.f, 0.f, 0.f}; }
      wave_mm_nt<1, TP5>(rp, ARB + it * 16 * 72, 72, APT + rn0 * 16 * 72, 72, L, fr, fq);
      wave_mm_nt<1, TP5>(y0, ARB + it * 16 * 72, 72, U0T + rn0 * 16 * 72, 72, L, fr, fq); wave_mm_nt72<1, TP5, false, true>(y0, ARK, it * 16, VT, rn0 * 16, L, fr, fq);
      if constexpr (!SAMPLE) {
          bf16_t* PP = (bf16_t*)(F.ws + WS_REC + ((size_t)h * 256 + c) * REC_B); bf16_t* QQ = PP + 4096;
#pragma unroll
          for (int q = 0; q < 2; ++q) { const int n0 = (nt0 + q) * 16 + 4 * fq; u32x2 p; p.x = pk2(pp[0][q][0], pp[0][q][1]); p.y = pk2(pp[0][q][2], pp[0][q][3]);
              *(u32x2*)(PP + (mt * 16 + fr) * 64 + pperm(n0)) = p;
              p.x = pk2(qt[0][q][0], qt[0][q][1]); p.y = pk2(qt[0][q][2], qt[0][q][3]); *(u32x2*)(QQ + (mt * 16 + fr) * 64 + n0) = p; }
#pragma unroll
          for (int q = 0; q < TP5; ++q) { const size_t row = (size_t)(r0 + it * 16 + fr); const int n0 = (rn0 + q) * 16 + 4 * fq; u32x2 p;
              p.x = pk2(rp[0][q][0], rp[0][q][1]); p.y = pk2(rp[0][q][2], rp[0][q][3]); if constexpr (DRY) asm volatile("" :: "v"(p.x), "v"(p.y)); else *(u32x2*)(RKV + row * 3072 + 1024 + h * 64 + n0) = p;
              p.x = pk2(y0[0][q][0], y0[0][q][1]); p.y = pk2(y0[0][q][2], y0[0][q][3]); if constexpr (DRY) asm volatile("" :: "v"(p.x), "v"(p.y)); else *(u32x2*)(RKV + row * 3072 + h * 64 + n0) = p; }
      } else {
          __syncthreads();
          LAS bf16_t* PL = (LAS bf16_t*)(F.lds + RL_PL); LAS bf16_t* RLs = (LAS bf16_t*)(F.lds + RL_RL); LAS float* Y0L = (LAS float*)(F.lds + RL_Y0L); LAS float* QTL = (LAS float*)(F.lds + RL_QTL); LAS bf16_t* Sl = (LAS bf16_t*)(F.lds + RL_S);
#pragma unroll
          for (int q = 0; q < 2; ++q) { const int n0 = (nt0 + q) * 16 + 4 * fq; u32x2 p; p.x = pk2(pp[0][q][0], pp[0][q][1]); p.y = pk2(pp[0][q][2], pp[0][q][3]);
              *(LAS u32x2*)(PL + (mt * 16 + fr) * 72 + n0) = p; *(LAS f32x4*)(QTL + (mt * 16 + fr) * 68 + n0) = qt[0][q]; }
#pragma unroll
          for (int q = 0; q < TP5; ++q) { const int n0 = (rn0 + q) * 16 + 4 * fq; u32x2 p; p.x = pk2(rp[0][q][0], rp[0][q][1]); p.y = pk2(rp[0][q][2], rp[0][q][3]);
              *(LAS u32x2*)(RLs + (it * 16 + fr) * 72 + n0) = p; *(LAS f32x4*)(Y0L + (it * 16 + fr) * 68 + n0) = y0[0][q]; }
          const int sb = c - 256; const float* sin_ = F.in[I_SWKV] + (((size_t)m * 32 + sb) * 16 + h) * 4096; float* sout = F.out + O_WKVS + (((size_t)m * 32 + sb) * 16 + h) * 4096;
          for (int it2 = tid; it2 < 64 * 16; it2 += NT) { const int i = it2 >> 4, j4 = (it2 & 15) * 4; const f32x4 sv = *(const f32x4*)(sin_ + i * 64 + j4); u32x2 p; p.x = pk2(sv[0], sv[1]); p.y = pk2(sv[2], sv[3]); *(LAS u32x2*)(Sl + i * 72 + j4) = p; }
          __syncthreads();
          if (w < 2) { f32x4 y[1][4];
#pragma unroll
              for (int q = 0; q < 4; ++q) y[0][q] = *(const LAS f32x4*)(Y0L + (w * 16 + fr) * 68 + q * 16 + 4 * fq);
              wave_mm_nt<1, 4>(y, RLs + w * 16 * 72, 72, Sl, 72, 64, fr, fq);
              rwkv_out_epilogue<DRY>(F, m, y[0], (size_t)(r0 + w * 16 + fr), h, fq); }
          else if (w < 6) { const int mi = w - 2; f32x4 tl[1][4];
#pragma unroll
              for (int q = 0; q < 4; ++q) { const int j = q * 16 + 4 * fq; const f32x4 sv = *(const f32x4*)(sin_ + (mi * 16 + fr) * 64 + j), gl4 = *(const LAS f32x4*)(GLV + j), qv = *(const LAS f32x4*)(QTL + (mi * 16 + fr) * 68 + j);
                  tl[0][q] = (f32x4){__expf(gl4[0]) * sv[0] + qv[0], __expf(gl4[1]) * sv[1] + qv[1], __expf(gl4[2]) * sv[2] + qv[2], __expf(gl4[3]) * sv[3] + qv[3]}; }
              wave_mm_nt<1, 4>(tl, Sl + mi * 16 * 72, 72, PL, 72, 64, fr, fq);
#pragma unroll
              for (int q = 0; q < 4; ++q) *(f32x4*)(sout + (mi * 16 + fr) * 64 + q * 16 + 4 * fq) = tl[0][q]; }
      }
    }
}

constexpr int SC_GRP = 4, SC_CH = 8192 + 2048 + 256, SC_LCH = 9216 + 2304 + 256, SC_LBUF = SC_GRP * SC_LCH;
template <int SKIP = 0> __device__ __forceinline__ void rwkv_scan_phase(Frame& F, int layer) {
    const int tid = otid(); const int lane = tid & 63, m = layer >> 1; const int b = blockIdx.x;
    if (b >= 64) {
        if constexpr (SKIP == 0) { const int nb = (int)F.G - 64; RawRegs raw; int u = 256 * 16 + (b - 64); if (u < NCHUNK * 16) rwkv_load_raw(F, layer >> 1, u, tid, raw);
            for (; u < NCHUNK * 16; u += nb) { const int un = (u + nb < NCHUNK * 16) ? u + nb : -1; rwkv_local_unit<32>(F, layer, u >> 4, u & 15, raw, un); }
            if (layer == 1) { __syncthreads(); mod_phase(F, 2, 4, b - 64, nb); } }
        return; }
    const int h = 2 * (b & 7) + (b >> 5), sl = (b >> 3) & 3;
    const unsigned char* REC = F.ws + WS_REC;
    constexpr int NG = 256 / SC_GRP, DEPTH = 4;
    static_assert(NG % DEPTH == 0, "scan groups vs prefetch depth");
    if (F.wave != 0) {
        constexpr int NV = SC_GRP * SC_CH / 16, NLT = NT - 64, NPT = (NV + NLT - 1) / NLT;
        struct RegSet { u32x4 v[NPT]; };
        RegSet sets[DEPTH];
        unsigned poff[NPT], pdst[NPT];
#pragma unroll
        for (int q = 0; q < NPT; ++q) { int v = (tid - 64) + q * NLT; v = v < NV ? v : NV - 1; const int cc = v / (SC_CH / 16), o = (v % (SC_CH / 16)) * 16;
            poff[q] = (unsigned)(cc * REC_B + o + (o >= 10240 ? 6144 : (o >= 8192 ? sl * 2048 : 0)));
            const int lo = (o < 8192) ? (o >> 7) * 144 + (o & 127) : (o < 10240) ? 9216 + ((o - 8192) >> 7) * 144 + ((o - 8192) & 127) : 9216 + 2304 + (o - 10240);
            pdst[q] = (unsigned)(cc * SC_LCH + lo); }
        auto issue = [&](int g, RegSet& st) { const unsigned char* gb = REC + ((size_t)h * 256 + g * SC_GRP) * REC_B;
#pragma unroll
            for (int q = 0; q < NPT; ++q) st.v[q] = *(const u32x4*)(gb + poff[q]); };
        auto commit = [&](int buf, const RegSet& st) {
#pragma unroll
            for (int q = 0; q < NPT; ++q) *(LAS u32x4*)(F.lds + buf * SC_LBUF + pdst[q]) = st.v[q]; };
        if (!(SKIP & 2)) {
#pragma unroll
            for (int d = 0; d < DEPTH; ++d) issue(d, sets[d]);
            commit(0, sets[0]); }
        for (int g0 = 0; g0 < NG; g0 += DEPTH) {
#pragma unroll
            for (int dd = 0; dd < DEPTH; ++dd) { const int g = g0 + dd;
                if (!(SKIP & 2)) { if (g > 0 && g + DEPTH - 1 < NG) issue(g + DEPTH - 1, sets[(dd + DEPTH - 1) % DEPTH]); }
                __syncthreads();
                __syncthreads();
                if (!(SKIP & 2)) { if (g + 1 < NG) commit((g + 1) & 1, sets[(dd + 1) % DEPTH]); } }
        }
    } else {
        const int ci = lane & 15, q4 = lane >> 4, i = 16 * sl + ci;
        f32x4 T[4];
#pragma unroll
        for (int mm = 0; mm < 4; ++mm) T[mm] = (f32x4){0.f, 0.f, 0.f, 0.f};
        bf16_t* TST = (bf16_t*)(F.ws + WS_TST);
        const unsigned pfo = (unsigned)(ci * 144 + q4 * 16);
        for (int g = 0; g < NG; ++g) {
            __syncthreads();
            if (!(SKIP & 1)) {
                const LAS unsigned char* base = F.lds + (g & 1) * SC_LBUF;
                bf16x8 pf[4][2];
#pragma unroll
                for (int mm = 0; mm < 4; ++mm)
#pragma unroll
                    for (int s = 0; s < 2; ++s) pf[mm][s] = *(const LAS bf16x8*)(base + pfo + mm * 2304 + s * 64);
#pragma unroll
                for (int cc = 0; cc < SC_GRP; ++cc) { const int c = g * SC_GRP + cc; const LAS unsigned char* cb = base + cc * SC_LCH;
                    bf16_t* tdst = TST + (((size_t)h * 256 + c) * 64 + i) * 64;
                    f32x4 gv[4]; u32x2 qv[4];
#pragma unroll
                    for (int mm = 0; mm < 4; ++mm) { const int j = 16 * mm + 4 * q4; gv[mm] = *(const LAS f32x4*)(cb + 9216 + 2304 + j * 4); qv[mm] = *(const LAS u32x2*)(cb + 9216 + ci * 144 + j * 2); }
                    bf16x8 pn[4][2];
                    if (cc + 1 < SC_GRP) {
#pragma unroll
                        for (int mm = 0; mm < 4; ++mm)
#pragma unroll
                            for (int s = 0; s < 2; ++s) pn[mm][s] = *(const LAS bf16x8*)(cb + SC_LCH + pfo + mm * 2304 + s * 64); }
                    bf16x8 Tf[2];
#pragma unroll
                    for (int mm = 0; mm < 4; ++mm) { u32x2 p; p.x = pk2(T[mm][0], T[mm][1]); p.y = pk2(T[mm][2], T[mm][3]); *(u32x2*)(tdst + 16 * mm + 4 * q4) = p;
                        Tf[mm >> 1][(mm & 1) * 4 + 0] = (short)(p.x & 0xffffu); Tf[mm >> 1][(mm & 1) * 4 + 1] = (short)(p.x >> 16); Tf[mm >> 1][(mm & 1) * 4 + 2] = (short)(p.y & 0xffffu); Tf[mm >> 1][(mm & 1) * 4 + 3] = (short)(p.y >> 16); }
#pragma unroll
                    for (int mm = 0; mm < 4; ++mm) {
                        f32x4 acc = (f32x4){gv[mm][0] * T[mm][0] + bflo(qv[mm].x), gv[mm][1] * T[mm][1] + bfhi(qv[mm].x), gv[mm][2] * T[mm][2] + bflo(qv[mm].y), gv[mm][3] * T[mm][3] + bfhi(qv[mm].y)};
                        acc = __builtin_amdgcn_mfma_f32_16x16x32_bf16(pf[mm][0], Tf[0], acc, 0, 0, 0); acc = __builtin_amdgcn_mfma_f32_16x16x32_bf16(pf[mm][1], Tf[1], acc, 0, 0, 0);
                        T[mm] = acc; }
                    if (cc + 1 < SC_GRP) {
#pragma unroll
                        for (int mm = 0; mm < 4; ++mm) { pf[mm][0] = pn[mm][0]; pf[mm][1] = pn[mm][1]; } }
                }
            }
            __syncthreads();
        }
        float* outp = F.out + O_WKVP + ((size_t)m * 16 + h) * 4096 + (size_t)i * 64;
#pragma unroll
        for (int mm = 0; mm < 4; ++mm) *(f32x4*)(outp + 16 * mm + 4 * q4) = T[mm];
    }
}

struct OutMain { u32x2 y0[4]; bf16x8 xa[2]; };
template <bool DRY = false> __device__ __forceinline__ void rwkv_output_phase(Frame& F, int layer) {
    const int tid = otid(); const int lane = tid & 63, fr = lane & 15, fq = lane >> 4, m = layer >> 1;
    const bf16_t* RKV = (const bf16_t*)(F.ws + WS_RKV); const bf16_t* TST = (const bf16_t*)(F.ws + WS_TST);
    const int gw = F.vcu * NWAVES + F.wave, NGW = F.G * NWAVES;
    for (int u = gw; u < 256 * 16; u += NGW) { const int h = u & 15, c = u >> 4; const bf16_t* ts = TST + ((size_t)h * 256 + c) * 4096;
        bf16x8 yb[2][4];
#pragma unroll
        for (int s = 0; s < 2; ++s)
#pragma unroll
            for (int nt = 0; nt < 4; ++nt) yb[s][nt] = *(const bf16x8*)(ts + (16 * nt + fr) * 64 + 32 * s + 8 * fq);
        f32x4 lgu[4], lbu[4];
#pragma unroll
        for (int nt = 0; nt < 4; ++nt) { const int i = h * 64 + 16 * nt + 4 * fq; lgu[nt] = *(const f32x4*)(F.in[I_RLNG] + m * D + i); lbu[nt] = *(const f32x4*)(F.in[I_RLNB] + m * D + i); }
        const bf16_t* GG = (const bf16_t*)(F.ws + WS_G); const float* BON = (const float*)(F.ws + WS_BON);
        auto issue = [&](int it, OutMain& mn, OutSide& sd) { const size_t row = (size_t)(64 * c + 16 * it + fr);
#pragma unroll
            for (int nt = 0; nt < 4; ++nt) mn.y0[nt] = *(const u32x2*)(RKV + row * 3072 + h * 64 + 16 * nt + 4 * fq);
#pragma unroll
            for (int s = 0; s < 2; ++s) mn.xa[s] = *(const bf16x8*)(RKV + row * 3072 + 1024 + h * 64 + 32 * s + 8 * fq);
            sd.bon = BON[row * 16 + h];
#pragma unroll
            for (int nt = 0; nt < 4; ++nt) { const int i = h * 64 + 16 * nt + 4 * fq; sd.vv[nt] = *(const u32x2*)(RKV + row * 3072 + 2048 + i); sd.gg[nt] = *(const u32x2*)(GG + row * D + i); } };
        auto compute = [&](int it, const OutMain& mn, OutSide& sd) { const size_t row = (size_t)(64 * c + 16 * it + fr); f32x4 y[4];
#pragma unroll
            for (int nt = 0; nt < 4; ++nt) y[nt] = (f32x4){bflo(mn.y0[nt].x), bfhi(mn.y0[nt].x), bflo(mn.y0[nt].y), bfhi(mn.y0[nt].y)};
#pragma unroll
            for (int s = 0; s < 2; ++s)
#pragma unroll
                for (int nt = 0; nt < 4; ++nt) y[nt] = __builtin_amdgcn_mfma_f32_16x16x32_bf16(yb[s][nt], mn.xa[s], y[nt], 0, 0, 0);
#pragma unroll
            for (int nt = 0; nt < 4; ++nt) { sd.lg[nt] = lgu[nt]; sd.lb[nt] = lbu[nt]; }
            rwkv_out_core<DRY>(F, y, row, h, fq, sd); };
        OutMain mA, mB; OutSide sA, sB;
        issue(0, mA, sA); asm volatile("" ::: "memory");
        issue(1, mB, sB); asm volatile("" ::: "memory"); compute(0, mA, sA); asm volatile("" ::: "memory");
        issue(2, mA, sA); asm volatile("" ::: "memory"); compute(1, mB, sB); asm volatile("" ::: "memory");
        issue(3, mB, sB); asm volatile("" ::: "memory"); compute(2, mA, sA); asm volatile("" ::: "memory");
        compute(3, mB, sB);
    }
}

#define GRID_BAR() xcd_barrier(bar)
#ifndef PHASE_MASK
#define PHASE_MASK 0xffffffffu
#endif
#ifndef STRETCH_MASK
#define STRETCH_MASK 0u
#endif
struct StretchGuard { unsigned long long t0; bool on; __device__ __forceinline__ StretchGuard(bool o) : t0(o ? __builtin_amdgcn_s_memrealtime() : 0ull), on(o) {}
    __device__ __forceinline__ ~StretchGuard() { if (on) { __syncthreads(); const unsigned long long t1 = __builtin_amdgcn_s_memrealtime(); while (__builtin_amdgcn_s_memrealtime() < t1 + (t1 - t0)) __builtin_amdgcn_s_sleep(2); } } };
#define PH(k) if (StretchGuard sg_(((STRETCH_MASK) >> (k)) & 1u); PHASE_MASK & (1u << (k)))
#ifndef REP_MASK
#define REP_MASK 0u
#endif
#define REP(k) (((REP_MASK) >> (k)) & 1u)
#ifndef LOCAL_SKIP
#define LOCAL_SKIP 0
#endif
#ifndef EXTRA_BARS
#define EXTRA_BARS 0
#endif
template <int layer> __device__ __forceinline__ void layer_body(Frame& F, const XcdBarrier& bar) {
    unsigned char* ws = F.ws; unsigned char* ar = ws + WS_ARENA;
    bf16_t* XN = (bf16_t*)(ws + WS_XN);
    const float* MOD = (const float*)(ws + WS_MOD);
    constexpr int m = layer >> 1; const float* modl = MOD + (size_t)layer * NSEQ * 6144;
    PH(1) for (int rep = 0; rep <= (int)REP(1); ++rep) if (layer > 0) convert_layer_weights(F, layer);
    if constexpr ((layer & 1) == 0) {
        PH(2) for (int rep = 0; rep <= (int)REP(2); ++rep) { if constexpr (layer == 0) norm_pass<0, 0, true>(F, layer, 0, 0, F.in[I_XS], nullptr); else norm_pass<0, 8>(F, layer, layer - 1, 5120, F.out + (size_t)MP * D, (float*)(ws + WS_SXB)); }
        GRID_BAR();
        PH(3) { using GC = pg8::Geo<D, D, D, 30, 0, 1 << 20, 0>; pg8::Gemm<GC> g{XN, (const bf16_t*)(ar + AR_WIN), nullptr}; pg8::StaticOrder S; S.init(M, ABIN, F.G, (int)blockIdx.x);
          pg8::EpiBf16<0> E{(bf16_t*)(ws + WS_Z), ABIN};
          pg8::gemm_phase<pg8::EpiBf16<0>, pg8::StaticOrder, GC, true, true>(F.lds, g, S, E);
          if (REP(3)) { pg8::EpiNull<true> EN; pg8::gemm_phase<pg8::EpiNull<true>, pg8::StaticOrder, GC, true, true>(F.lds, g, S, EN); } }
        GRID_BAR();
        PH(4) for (int rep = 0; rep <= (int)REP(4); ++rep) for (int u = F.vcu; u < NCHUNK * 8; u += F.G) { const int c = u >> 3, hh = (u + u / F.G) & 7;
            if (c < 256) { if (hh < 4) ab_summary_unit<64, false>(F, layer, c, hh); else ab_summary_unit<64, true>(F, layer, c, hh - 4); }
            else { if (hh < 4) ab_summary_unit<32, false>(F, layer, c, hh); else ab_summary_unit<32, true>(F, layer, c, hh - 4); } }
        GRID_BAR();
        PH(5) { if (REP(5)) ab_scan<true>(F, layer); ab_scan<false>(F, layer); }
        GRID_BAR();
        PH(6) for (int rep = 0; rep <= (int)REP(6); ++rep) for (int u = F.vcu; u < NCHUNK * 8; u += F.G) { const int c = u >> 3, hh = (u + u / F.G) & 7;
            if (c < 256) { if (hh < 4) ab_output_unit<64, false>(F, layer, c, hh); else ab_output_unit<64, true>(F, layer, c, hh - 4); }
            else { if (hh < 4) ab_output_unit<32, false>(F, layer, c, hh); else ab_output_unit<32, true>(F, layer, c, hh - 4); } }
        GRID_BAR();
        PH(7) { using GC = pg8::Geo<D, D, D, 30, 0, 1 << 20, 0>; pg8::Gemm<GC> g{XN, (const bf16_t*)(ar + AR_WOUT), nullptr}; pg8::StaticOrder S; S.init(MP, D, F.G, (int)blockIdx.x);
          pg8::EpiRes E{F.out, modl, 2048, (layer == 0) ? F.in[I_XP] : F.out};
          pg8::gemm_phase<pg8::EpiRes, pg8::StaticOrder, GC, true, true>(F.lds, g, S, E);
          if (REP(7)) { pg8::EpiNull<false> EN; pg8::gemm_phase<pg8::EpiNull<false>, pg8::StaticOrder, GC, true, true>(F.lds, g, S, EN); }
          using GC2 = pg8::Geo<D, D, 256, 30, 0, 1 << 20, 0, true>; pg8::Gemm<GC2> g2{XN, (const bf16_t*)(ar + AR_WOUT), nullptr}; pg8::SplitOrder S2{F.vcu, 4};
          pg8::EpiPartial E2{(float*)(ws + WS_PART), 4};
          pg8::gemm_phase<pg8::EpiPartial, pg8::SplitOrder, GC2, true, true>(F.lds, g2, S2, E2); }
        GRID_BAR();
    } else {
        PH(8) for (int rep = 0; rep <= (int)REP(8); ++rep) norm_pass<1, 8>(F, layer, layer - 1, 5120, F.out + (size_t)MP * D, (float*)(ws + WS_SXB));
        GRID_BAR();
        PH(9) { using GCr = pg8::Geo<D, 2048, D, 2, M * D, 1 << 20, 0>; pg8::Gemm<GCr> gr{(const bf16_t*)(ws + WS_XMIX), (const bf16_t*)(ar + AR_WC1), nullptr}; pg8::StaticOrder Sr; Sr.init(M, 3072, F.G, (int)blockIdx.x);
          pg8::EpiRkv E{(bf16_t*)(ws + WS_RKV), (bf16_t*)(ws + WS_LO), (m == 0) ? (bf16_t*)(ws + WS_VFIRST) : nullptr};
          pg8::gemm_phase<pg8::EpiRkv, pg8::StaticOrder, GCr, true, true>(F.lds, gr, Sr, E);
          if (REP(9)) { pg8::EpiNull<true> EN; pg8::gemm_phase<pg8::EpiNull<true>, pg8::StaticOrder, GCr, true, true>(F.lds, gr, Sr, EN); }
          using GC = pg8::Geo<D, 2048, 2048, 30, 0, 16, -4096>; pg8::Gemm<GC> g{XN, (const bf16_t*)(ar + AR_WC1), (const bf16_t*)(ws + WS_PREVS)}; pg8::LoraOrder Sl{(int)blockIdx.x};
          pg8::gemm_phase<pg8::EpiRkv, pg8::LoraOrder, GC, true, true>(F.lds, g, Sl, E); }
        GRID_BAR();
        PH(10) { using GC = pg8::Geo<D, 256, 256, 2, 256, 1 << 20, 0>; pg8::Gemm<GC> g{(const bf16_t*)(ws + WS_LO), (const bf16_t*)(ar + AR_WC2), nullptr}; pg8::SkipVOrder S; S.skip = (m == 0); S.S.init(M, (m == 0) ? 3072 : 4096, F.G, (int)blockIdx.x);
          pg8::EpiLora2 E{(bf16_t*)(ws + WS_WLOG), XN, (bf16_t*)(ws + WS_G), (bf16_t*)(ws + WS_RKV), (m == 1) ? (const bf16_t*)(ws + WS_VFIRST) : nullptr,
                          F.in[I_RW0] + m * D, F.in[I_RA0] + m * D, F.in[I_RV0]};
          pg8::gemm_phase<pg8::EpiLora2, pg8::SkipVOrder, GC, true, true>(F.lds, g, S, E);
           }
        GRID_BAR();
        PH(11) { RawRegs raw; const int tid0 = otid(); int u = F.vcu; if (u < 256 * 16) rwkv_load_raw(F, layer >> 1, u, tid0, raw);
          for (; u < 256 * 16; u += F.G) { const int c = u >> 4, hh = u & 15, un = (u + F.G < 256 * 16) ? u + F.G : -1;
              rwkv_local_unit<64>(F, layer, c, hh, raw, un); } }
        GRID_BAR();
        PH(17) { if (REP(17)) rwkv_scan_phase<LOCAL_SKIP>(F, layer); rwkv_scan_phase<0>(F, layer); }
        GRID_BAR();
        PH(18) { if (REP(18)) rwkv_output_phase<true>(F, layer); rwkv_output_phase<false>(F, layer); }
        GRID_BAR();
        PH(12) { using GC = pg8::Geo<3072, D, D, 30, 0, 1 << 20, 0>; pg8::Gemm<GC> g{(const bf16_t*)(ws + WS_RKV), (const bf16_t*)(ar + AR_WO), nullptr}; pg8::StaticOrder S; S.init(MP, D, F.G, (int)blockIdx.x);
          pg8::EpiRes E{F.out, modl, 2048, F.out};
          pg8::gemm_phase<pg8::EpiRes, pg8::StaticOrder, GC, true, true>(F.lds, g, S, E);
          if (REP(12)) { pg8::EpiNull<false> EN; pg8::gemm_phase<pg8::EpiNull<false>, pg8::StaticOrder, GC, true, true>(F.lds, g, S, EN); }
          using GC2 = pg8::Geo<3072, D, 256, 30, 0, 1 << 20, 0, true>; pg8::Gemm<GC2> g2{(const bf16_t*)(ws + WS_RKV), (const bf16_t*)(ar + AR_WO), nullptr}; pg8::SplitOrder S2{F.vcu, 4};
          pg8::EpiPartial E2{(float*)(ws + WS_PART), 4};
          pg8::gemm_phase<pg8::EpiPartial, pg8::SplitOrder, GC2, true, true>(F.lds, g2, S2, E2); }
        GRID_BAR();
    }
    PH(13) for (int rep = 0; rep <= (int)REP(13); ++rep) norm_pass<2, 4>(F, layer, layer, 2048, (layer == 0) ? F.in[I_XS] : (const float*)(ws + WS_SXB), F.out + (size_t)MP * D);
    GRID_BAR();
    PH(14) { using GC = pg8::Geo<D, D, D, 30, 0, 1 << 20, 0>; pg8::Gemm<GC> g{XN, (const bf16_t*)(ar + AR_W1), nullptr}; pg8::StaticOrder S; S.init(M, DFF, F.G, (int)blockIdx.x);
      pg8::EpiBf16<1> E{(bf16_t*)(ws + WS_H), DFF};
      pg8::gemm_phase<pg8::EpiBf16<1>, pg8::StaticOrder, GC, true, true>(F.lds, g, S, E);
          if (REP(14)) { pg8::EpiNull<true> EN; pg8::gemm_phase<pg8::EpiNull<true>, pg8::StaticOrder, GC, true, true>(F.lds, g, S, EN); } }
    GRID_BAR();
    PH(15) { using GC = pg8::Geo<DFF, DFF, DFF, 30, 0, 1 << 20, 0>; pg8::Gemm<GC> g{(const bf16_t*)(ws + WS_H), (const bf16_t*)(ar + AR_W2), nullptr}; pg8::StaticOrder S; S.init(MP, D, F.G, (int)blockIdx.x);
      pg8::EpiRes E{F.out, modl, 5120, F.out};
      for (int xb = 0; xb < EXTRA_BARS; ++xb) GRID_BAR();
      pg8::gemm_phase<pg8::EpiRes, pg8::StaticOrder, GC, true, true>(F.lds, g, S, E);
      if (REP(15)) { pg8::EpiNull<false> EN; pg8::gemm_phase<pg8::EpiNull<false>, pg8::StaticOrder, GC, true, true>(F.lds, g, S, EN); }
      using GC2 = pg8::Geo<DFF, DFF, 512, 30, 0, 1 << 20, 0, true>; pg8::Gemm<GC2> g2{(const bf16_t*)(ws + WS_H), (const bf16_t*)(ar + AR_W2), nullptr}; pg8::SplitOrder S2{F.vcu, 8};
      pg8::EpiPartial E2{(float*)(ws + WS_PART), 8};
      pg8::gemm_phase<pg8::EpiPartial, pg8::SplitOrder, GC2, true, true>(F.lds, g2, S2, E2); }
    GRID_BAR();
}

__global__ void __launch_bounds__(NT, 2) fwd_kernel(Args args) {
    extern __shared__ __attribute__((aligned(16))) unsigned char lds[];
    Frame F;
    F.lds = (LAS unsigned char*)lds; F.MISC = (volatile LAS unsigned*)(F.lds + MISC_OFF);
    F.wave = __builtin_amdgcn_readfirstlane(threadIdx.x >> 6);
    F.G = gridDim.x; { const int bx = blockIdx.x; F.vcu = (F.G % 8 == 0) ? (bx % 8) * (F.G / 8) + bx / 8 : bx; }
    F.in = args.in; F.out = args.out; F.ws = args.ws;
    for (int u = threadIdx.x; u < (LDS_BYTES - LDSCTL_OFF) / 4; u += NT) ((LAS unsigned*)(F.lds + LDSCTL_OFF))[u] = 0u;
    __syncthreads();
    XcdBarrier bar = xcd_barrier_post((unsigned*)(F.ws + WS_CTL) + CW_BAR, F.MISC + 8);
    PH(0) prologue(F);
    GRID_BAR();
    PH(0) mod_phase(F, 0, 2, F.vcu, F.G);
    GRID_BAR();
    layer_body<0>(F, bar); layer_body<1>(F, bar); layer_body<2>(F, bar); layer_body<3>(F, bar);
    PH(16) norm_pass<3, 8>(F, 0, 3, 5120, F.out + (size_t)MP * D, nullptr);
}

extern "C" void kernel_launch(void* const* d_in, const int* in_sizes, int n_in, void* d_out, int out_size, void* d_ws, size_t ws_size, hipStream_t stream) {
    static int grid = 0;
    if (grid == 0) {
        if (n_in != 38 || out_size != 28706816 || ws_size < WS_END) { fprintf(stderr, "kernel_launch: unexpected problem (n_in %d, out %d, ws %zu; need ws >= %zu)\n", n_in, out_size, ws_size, (size_t)WS_END); grid = -1; return; }
        int dev = 0, cus = 0, per_cu = 0;
        if (hipGetDevice(&dev) != hipSuccess || hipDeviceGetAttribute(&cus, hipDeviceAttributeMultiprocessorCount, dev) != hipSuccess) { grid = -1; return; }
        if (hipFuncSetAttribute((const void*)fwd_kernel, hipFuncAttributeMaxDynamicSharedMemorySize, LDS_BYTES) != hipSuccess) { fprintf(stderr, "kernel_launch: hipFuncSetAttribute failed\n"); grid = -1; return; }
        if (hipOccupancyMaxActiveBlocksPerMultiprocessor(&per_cu, (const void*)fwd_kernel, NT, LDS_BYTES) != hipSuccess || per_cu < 1) { fprintf(stderr, "kernel_launch: occupancy query says %d\n", per_cu); per_cu = 1; }
        (void)hipGetLastError();
        grid = cus;
    }
    if (grid < 0) return;
    (void)hipMemsetAsync((char*)d_ws + WS_CTL, 0, ZERO_BYTES, stream);
    Args a{};
    for (int i = 0; i < 38; ++i) a.in[i] = (const float*)d_in[i];
    a.out = (float*)d_out; a.ws = (unsigned char*)d_ws;
    void* kargs[] = {&a};
    hipError_t e = hipLaunchCooperativeKernel((const void*)fwd_kernel, dim3(grid), dim3(NT), kargs, LDS_BYTES, stream);
    if (e != hipSuccess) fprintf(stderr, "kernel_launch: cooperative launch failed: %s (grid %d)\n", hipGetErrorString(e), grid);
}
```

```cpp
#include <hip/hip_runtime.h>
#include <cstdio>
#include <cstdint>

#define LAS __attribute__((address_space(3)))
#define GAS __attribute__((address_space(1)))
typedef unsigned short bf16_t;
typedef short bf16x8 __attribute__((ext_vector_type(8)));
typedef float f32x4 __attribute__((ext_vector_type(4)));
typedef float f32x2 __attribute__((ext_vector_type(2)));
typedef unsigned u32x4 __attribute__((ext_vector_type(4)));
typedef unsigned u32x2 __attribute__((ext_vector_type(2)));

#ifndef LOCAL_SKIP
#define LOCAL_SKIP 0
#endif
constexpr int D = 1024, MP = 16384, MS = 1024, M = MP + MS, NSEQ = 33, DFF = 4096, ABIN = 3584;
constexpr int NCHUNK = 288;
constexpr int SLOT_E = 4 * 8192 + 4 * 16384;
constexpr float NORM_EPS = 1e-6f, RW_LN_EPS = 64e-5f;

constexpr size_t MiB = 1u << 20;
constexpr size_t WS_CTL = 0, WS_MOD = 1 * MiB, ZERO_BYTES = 65536;
constexpr size_t WS_ROPE = 5 * MiB;
constexpr size_t WS_ARENA = 10 * MiB;
constexpr size_t AR_W1 = 0, AR_W2 = 8 * MiB, AR_WIN = 16 * MiB, AR_WOUT = 23 * MiB, AR_WC1 = 16 * MiB, AR_WC2 = 32 * MiB, AR_WO = 34 * MiB;
constexpr size_t WS_VFIRST = 46 * MiB;
constexpr size_t WS_XN0 = 80 * MiB, WS_XN = WS_XN0 + 2048;
constexpr size_t WS_PREVS = 115 * MiB;
constexpr size_t WS_R1 = 118 * MiB;
constexpr size_t WS_Z = WS_R1, WS_STATE = WS_R1 + 120 * MiB, WS_DEC = WS_R1 + 174 * MiB;
constexpr size_t WS_H = WS_R1;
constexpr size_t WS_RKV = WS_R1, WS_LO = WS_R1 + 102 * MiB, WS_WLOG = WS_R1 + 136 * MiB, WS_G = WS_R1 + 170 * MiB;
constexpr size_t WS_TST = WS_R1 + 102 * MiB;
constexpr size_t WS_REC = WS_R1 + 204 * MiB, WS_BON = WS_R1 + 269 * MiB;
constexpr int REC_B = 16640;
constexpr size_t WS_XMIX = WS_R1 + 168 * MiB;
constexpr size_t WS_PART = WS_R1 + 136 * MiB;
constexpr size_t WS_SXB = WS_R1 + 271 * MiB;
constexpr size_t WS_END = WS_R1 + 275 * MiB;

__device__ const double ROPE_REV[32] = {0.15915494309189535, 0.11934937021124886, 0.089499401608891013, 0.067115083005227255, 0.050329212104487035, 0.037741584717419771, 0.028302195830623399, 0.02122365276477766, 0.015915494309189534, 0.011934937021124886, 0.0089499401608891024, 0.0067115083005227253, 0.0050329212104487037, 0.0037741584717419772, 0.0028302195830623399, 0.0021223652764777662, 0.0015915494309189536, 0.0011934937021124885, 0.00089499401608891024, 0.0006711508300522726, 0.00050329212104487033, 0.00037741584717419774, 0.00028302195830623395, 0.00021223652764777661, 0.00015915494309189535, 0.00011934937021124886, 8.9499401608891018e-05, 6.7115083005227254e-05, 5.0329212104487035e-05, 3.7741584717419777e-05, 2.8302195830623396e-05, 2.1223652764777659e-05};

__device__ __forceinline__ unsigned f2bf(float f) { unsigned u = __builtin_bit_cast(unsigned, f); return (u + 0x7fffu + ((u >> 16) & 1u)) >> 16; }
typedef __bf16 bf16x2_t __attribute__((ext_vector_type(2)));
__device__ __forceinline__ unsigned pk2(float lo, float hi) { const f32x2 v = {lo, hi}; const bf16x2_t b = __builtin_convertvector(v, bf16x2_t); return __builtin_bit_cast(unsigned, b); }
__device__ __forceinline__ float bf2f(unsigned short b) { return __builtin_bit_cast(float, (unsigned)b << 16); }
__device__ __forceinline__ float bflo(unsigned w) { return __builtin_bit_cast(float, w << 16); }
__device__ __forceinline__ float bfhi(unsigned w) { return __builtin_bit_cast(float, w & 0xffff0000u); }
__device__ __forceinline__ float sigmoidf_(float x) { return 1.f / (1.f + __expf(-x)); }
__device__ __forceinline__ float siluf_(float x) { return x / (1.f + __expf(-x)); }
__device__ __forceinline__ float wave_sum(float v) {
#pragma unroll
    for (int o = 1; o < 64; o <<= 1) v += __shfl_xor(v, o);
    return v;
}
__device__ __forceinline__ int otid() { int t = threadIdx.x; asm volatile("" : "+v"(t)); return t; }
__device__ __forceinline__ int seq_of_row(int r) { return r < MP ? 0 : 1 + ((r - MP) >> 5); }
#define LDS_WAIT() asm volatile("s_waitcnt lgkmcnt(0)" ::: "memory")
#define VM_WAIT() asm volatile("s_waitcnt vmcnt(0)" ::: "memory")

namespace pg8 {
constexpr int BM = 256, BK = 64, HALF = 128, HTB = HALF * BK * 2, STAGE_BYTES = 8 * HTB, NXCD = 8, WGM = 8;
__host__ __device__ __forceinline__ int lds_byte(int r, int c) { const int st = (r >> 4) * 2 + (c >> 5), rr = r & 15, cc = c & 31, ob = rr * 64 + cc * 2; return st * 1024 + (ob ^ (((ob >> 9) & 1) << 5)); }
__host__ __device__ __forceinline__ void stage_rc(int b, int& R, int& C) { const int st = b / 1024, sb = b % 1024, swz = sb ^ (((sb >> 9) & 1) << 5); R = (st >> 1) * 16 + swz / 64; C = (st & 1) * 32 + (swz % 64) / 2; }
__host__ __device__ __forceinline__ int perm32(int rho) { const int n = rho >> 4, i = rho & 15; return 8 * (i >> 2) + 4 * n + (i & 3); }

struct Unit { int pm, pn, ks; };
template <int LDA_, int LDB_, int K_, int GSHIFT_, int GSTRIDE_, int KSPLIT_, int DELTAP_, bool SPLIT_ = false> struct Geo {
    static constexpr int LDA = LDA_, LDB = LDB_, K = K_, GSHIFT = GSHIFT_, GSTRIDE = GSTRIDE_, KSPLIT = KSPLIT_, DELTAP = DELTAP_; static constexpr bool SPLIT = SPLIT_;
};
template <class GC> struct Gemm {
    const bf16_t* A; const bf16_t* Bt; const bf16_t* A2s;
    __device__ __forceinline__ const char* a_base(const Unit& u) const { return (const char*)(A + (size_t)u.pm * BM * GC::LDA + (size_t)(u.pn >> GC::GSHIFT) * GC::GSTRIDE + (GC::SPLIT ? (size_t)u.ks * GC::K : 0)); }
    __device__ __forceinline__ const char* b_base(const Unit& u) const { return (const char*)(Bt + (size_t)u.pn * BM * GC::LDB + (GC::SPLIT ? (size_t)u.ks * GC::K : 0)); }
    __device__ __forceinline__ long a_delta(const Unit& u) const {
        if constexpr (GC::KSPLIT >= GC::K / BK) return 0;
        else { if (u.pm < 64) return (long)GC::DELTAP;
            return (long)((const char*)(A2s + (size_t)(u.pm - 64) * BM * GC::LDA) - a_base(u)) - (long)GC::KSPLIT * BK * 2; }
    }
};
struct StaticOrder {
    int nM, nN, nwg, G, c;
    __host__ __device__ void init(int M_, int N_, int G_, int c_) { nM = M_ / BM; nN = N_ / BM; nwg = nM * nN; G = G_; c = c_; }
    __host__ __device__ bool next(int i, Unit& u) const {
        const long L = (long)i * G + c; if (L >= nwg) return false;
        int wgid = (int)L; { const int q = nwg / NXCD, r = nwg % NXCD, xcd = wgid % NXCD, off = wgid / NXCD; wgid = (xcd < r ? xcd * (q + 1) : r * (q + 1) + (xcd - r) * q) + off; }
        const int nig = WGM * nN, gid = wgid / nig, fm = gid * WGM, gsz = (nM - fm) < WGM ? (nM - fm) : WGM;
        u.pm = fm + ((wgid % nig) % gsz); u.pn = (wgid % nig) / gsz; u.ks = 0; return true;
    }
};
__device__ __forceinline__ unsigned cvt_pk_bf16(float lo, float hi) { return pk2(lo, hi); }

template <class Epi, class Sched, class GC, bool ALIGN_EPI = false, bool SP2 = false>
__device__ __forceinline__ void gemm_phase(LAS unsigned char* lds, const Gemm<GC> g, const Sched& S, const Epi& E) {
    const int tid = otid(), wid = __builtin_amdgcn_readfirstlane(tid >> 6), lane = tid & 63, wr = wid >> 2, wc = wid & 3, fr = lane & 15, fq = lane >> 4;
    constexpr int K = GC::K, nt = K / BK, ksplit = GC::KSPLIT;
    unsigned voffA[2], voffB[2];
#pragma unroll
    for (int i = 0; i < 2; ++i) { int R, C; stage_rc(tid * 16 + i * 8192, R, C); const int Rb = Epi::PERM ? ((R & ~31) + perm32(R & 31)) : R;
        voffA[i] = (unsigned)(R * GC::LDA + C) * 2u; voffB[i] = (unsigned)(Rb * GC::LDB + C) * 2u; }
    constexpr size_t kstep = (size_t)(BK * 2);
    constexpr size_t hstepA = (size_t)HALF * GC::LDA * 2, hstepB = (size_t)HALF * GC::LDB * 2;
    const unsigned ldsw = (unsigned)wid * 1024u;
    const int aoff = lds_byte(wr * 64 + fr, fq * 8), boff = lds_byte(wc * 32 + fr, fq * 8);
#define PG8_SA(b, h) (((b) * 2 + (h)) * HTB)
#define PG8_SB(b, h) ((4 + (b) * 2 + (h)) * HTB)
#define PG8_STAGE(bufoff, gbase, voff) do { _Pragma("unroll") for (int _i = 0; _i < 2; ++_i) \
        __builtin_amdgcn_global_load_lds((const unsigned*)((const char*)(gbase) + (voff)[_i]), (LAS unsigned*)(lds + (bufoff) + ldsw + _i * 8192), 16, 0, 0); } while (0)
#define PG8_LDA(dst, b, h) do { _Pragma("unroll") for (int m = 0; m < 4; ++m) _Pragma("unroll") for (int k = 0; k < 2; ++k) dst[m][k] = *(const LAS bf16x8*)(lds + PG8_SA(b, h) + aoff + m * 2048 + k * 1024); } while (0)
#define PG8_LDB(dst, b, h) do { _Pragma("unroll") for (int n = 0; n < 2; ++n) _Pragma("unroll") for (int k = 0; k < 2; ++k) dst[n][k] = *(const LAS bf16x8*)(lds + PG8_SB(b, h) + boff + n * 2048 + k * 1024); } while (0)
#define PG8_MMA(ai, bj, At, Bt) do { __builtin_amdgcn_s_setprio(1); _Pragma("unroll") for (int m = 0; m < 4; ++m) _Pragma("unroll") for (int n = 0; n < 2; ++n) _Pragma("unroll") for (int k = 0; k < 2; ++k) \
        acc[ai][bj][m][n] = __builtin_amdgcn_mfma_f32_16x16x32_bf16(Bt[n][k], At[m][k], acc[ai][bj][m][n], 0, 0, 0); __builtin_amdgcn_s_setprio(0); } while (0)
#define PG8_WAIT_V(n) asm volatile("s_waitcnt vmcnt(" #n ")" ::: "memory")
#define PG8_WAIT_L(n) asm volatile("s_waitcnt lgkmcnt(" #n ")" ::: "memory")
#define PG8_BAR __builtin_amdgcn_s_barrier()
#define PG8_SCHED __builtin_amdgcn_sched_barrier(0)
    Unit cur, nxt; int ui = 0;
    if (!S.next(0, cur)) return;
    f32x4 acc[2][2][4][2];
#pragma unroll
    for (int a = 0; a < 2; ++a)
#pragma unroll
        for (int b = 0; b < 2; ++b)
#pragma unroll
            for (int m = 0; m < 4; ++m)
#pragma unroll
                for (int n = 0; n < 2; ++n) acc[a][b][m][n] = (f32x4){0.f, 0.f, 0.f, 0.f};
    bf16x8 At[4][2], B0[2][2], B1[2][2];
    const char* cA = g.a_base(cur); const char* cB = g.b_base(cur); long cD = g.a_delta(cur);
    if constexpr (SP2) {
        PG8_STAGE(PG8_SB(0, 0), cB, voffB); PG8_STAGE(PG8_SB(0, 1), cB + hstepB, voffB); PG8_STAGE(PG8_SA(0, 0), cA, voffA); PG8_STAGE(PG8_SA(0, 1), cA + hstepA, voffA);
        if (wr == 1) PG8_BAR;
        PG8_WAIT_V(2); PG8_BAR;
        PG8_STAGE(PG8_SB(1, 0), cB + kstep, voffB); PG8_STAGE(PG8_SA(1, 0), cA + kstep, voffA); PG8_STAGE(PG8_SB(1, 1), cB + hstepB + kstep, voffB);
        PG8_WAIT_V(6); PG8_BAR;
    } else {
        PG8_STAGE(PG8_SB(0, 0), cB, voffB); PG8_STAGE(PG8_SA(0, 0), cA, voffA); PG8_STAGE(PG8_SB(0, 1), cB + hstepB, voffB); PG8_STAGE(PG8_SA(0, 1), cA + hstepA, voffA);
        if (wr == 1) PG8_BAR;
        PG8_WAIT_V(4); PG8_BAR;
        PG8_STAGE(PG8_SB(1, 0), cB + kstep, voffB); PG8_STAGE(PG8_SA(1, 0), cA + kstep, voffA); PG8_STAGE(PG8_SB(1, 1), cB + hstepB + kstep, voffB);
        PG8_WAIT_V(6); PG8_BAR;
    }
    for (;;) {
        const bool has_next = S.next(ui + 1, nxt);
        const char* nA = has_next ? g.a_base(nxt) : cA; const char* nB = has_next ? g.b_base(nxt) : cB;
        const long nD = has_next ? g.a_delta(nxt) : cD;
#pragma unroll 1
        for (int t = 0; t < nt; t += 2) {
            const bool last = (t == nt - 2);
            const char* a1 = cA + (size_t)(t + 1) * kstep + (t >= ksplit ? cD : 0);
            const char* a2 = last ? nA : cA + (size_t)(t + 2) * kstep + (t + 2 >= ksplit ? cD : 0); const char* b2 = last ? nB : cB + (size_t)(t + 2) * kstep;
            const char* a3 = a2 + kstep; const char* b3 = b2 + kstep;
            if constexpr (SP2) {
            PG8_LDB(B0, 0, 0); PG8_LDB(B1, 0, 1); PG8_SCHED; PG8_LDA(At, 0, 0); PG8_STAGE(PG8_SA(1, 1), a1 + hstepA, voffA);
            PG8_WAIT_V(8); PG8_WAIT_L(0); PG8_BAR; PG8_MMA(0, 0, At, B0); PG8_MMA(0, 1, At, B1); PG8_BAR; PG8_SCHED;
            PG8_LDA(At, 0, 1); PG8_STAGE(PG8_SB(0, 0), b2, voffB); PG8_STAGE(PG8_SB(0, 1), b2 + hstepB, voffB); PG8_STAGE(PG8_SA(0, 0), a2, voffA);
            PG8_WAIT_V(8); PG8_WAIT_L(0); PG8_BAR; PG8_MMA(1, 0, At, B0); PG8_MMA(1, 1, At, B1); PG8_BAR; PG8_SCHED;
            PG8_LDB(B0, 1, 0); PG8_LDB(B1, 1, 1); PG8_SCHED; PG8_LDA(At, 1, 0); PG8_STAGE(PG8_SA(0, 1), a2 + hstepA, voffA);
            PG8_WAIT_V(8); PG8_WAIT_L(0); PG8_BAR; PG8_MMA(0, 0, At, B0); PG8_MMA(0, 1, At, B1); PG8_BAR; PG8_SCHED;
            PG8_LDA(At, 1, 1); PG8_STAGE(PG8_SB(1, 0), b3, voffB); PG8_STAGE(PG8_SB(1, 1), b3 + hstepB, voffB); PG8_STAGE(PG8_SA(1, 0), a3, voffA);
            PG8_WAIT_V(8); PG8_WAIT_L(0); PG8_BAR; PG8_MMA(1, 0, At, B0); PG8_MMA(1, 1, At, B1); PG8_BAR; PG8_SCHED;
            } else {
            PG8_LDB(B0, 0, 0); PG8_SCHED; PG8_LDA(At, 0, 0); PG8_STAGE(PG8_SA(1, 1), a1 + hstepA, voffA);
            PG8_WAIT_L(8); PG8_BAR; PG8_WAIT_L(0); PG8_MMA(0, 0, At, B0); PG8_BAR; PG8_SCHED;
            PG8_LDB(B1, 0, 1); PG8_STAGE(PG8_SB(0, 0), b2, voffB);
            PG8_BAR; PG8_WAIT_L(0); PG8_MMA(0, 1, At, B1); PG8_BAR;
            PG8_LDA(At, 0, 1); PG8_STAGE(PG8_SA(0, 0), a2, voffA);
            PG8_BAR; PG8_WAIT_L(0); PG8_MMA(1, 0, At, B0); PG8_BAR; PG8_SCHED;
            PG8_STAGE(PG8_SB(0, 1), b2 + hstepB, voffB);
            PG8_WAIT_V(6); PG8_BAR; PG8_MMA(1, 1, At, B1); PG8_BAR;
            PG8_LDB(B0, 1, 0); PG8_SCHED; PG8_LDA(At, 1, 0); PG8_STAGE(PG8_SA(0, 1), a2 + hstepA, voffA);
            PG8_WAIT_L(8); PG8_BAR; PG8_WAIT_L(0); PG8_MMA(0, 0, At, B0); PG8_BAR; PG8_SCHED;
            PG8_LDB(B1, 1, 1); PG8_STAGE(PG8_SB(1, 0), b3, voffB);
            PG8_BAR; PG8_WAIT_L(0); PG8_MMA(0, 1, At, B1); PG8_BAR;
            PG8_LDA(At, 1, 1); PG8_STAGE(PG8_SA(1, 0), a3, voffA);
            PG8_BAR; PG8_WAIT_L(0); PG8_MMA(1, 0, At, B0); PG8_BAR; PG8_SCHED;
            PG8_STAGE(PG8_SB(1, 1), b3 + hstepB, voffB);
            PG8_WAIT_V(6); PG8_BAR; PG8_MMA(1, 1, At, B1); PG8_BAR;
            }
        }
        if constexpr (ALIGN_EPI) { if (wr == 0) PG8_BAR; }
        E(acc, cur, wr, wc, fr, fq);
        if (!has_next) break;
#pragma unroll
        for (int a = 0; a < 2; ++a)
#pragma unroll
            for (int b = 0; b < 2; ++b)
#pragma unroll
                for (int m = 0; m < 4; ++m)
#pragma unroll
                    for (int n = 0; n < 2; ++n) acc[a][b][m][n] = (f32x4){0.f, 0.f, 0.f, 0.f};
        cur = nxt; cA = nA; cB = nB; cD = nD; ++ui;
        if constexpr (ALIGN_EPI) { if (wr == 1) PG8_BAR; }
    }
    PG8_WAIT_V(0);
    if constexpr (!ALIGN_EPI) { if (wr == 0) PG8_BAR; }
    PG8_BAR;
#undef PG8_SA
#undef PG8_SB
#undef PG8_STAGE
#undef PG8_LDA
#undef PG8_LDB
#undef PG8_MMA
#undef PG8_WAIT_V
#undef PG8_WAIT_L
#undef PG8_BAR
#undef PG8_SCHED
}

__device__ __forceinline__ float act_apply(float v, int act) {
    if (act == 1) { const float r = v > 0.f ? v : 0.f; return r * r; }
    if (act == 2) { const float e = __expf(-2.f * fabsf(v)); const float t = (1.f - e) / (1.f + e); return v < 0.f ? -t : t; }
    if (act == 3) return 1.f / (1.f + __expf(-v));
    return v;
}
template <int ACT> __device__ __forceinline__ void store_tile_bf16(const f32x4 (&acc)[2][2][4][2], bf16_t* base, int ldc, int row0, int col0, bf16_t* base2, int ldc2, int col2) {
#pragma unroll
    for (int ai = 0; ai < 2; ++ai)
#pragma unroll
        for (int m = 0; m < 4; ++m) { const size_t r = (size_t)(row0 + ai * HALF + m * 16);
#pragma unroll
            for (int bj = 0; bj < 2; ++bj) { f32x4 v0 = acc[ai][bj][m][0], v1 = acc[ai][bj][m][1];
#pragma unroll
                for (int q = 0; q < 4; ++q) { v0[q] = act_apply(v0[q], ACT); v1[q] = act_apply(v1[q], ACT); }
                u32x4 w; w.x = cvt_pk_bf16(v0[0], v0[1]); w.y = cvt_pk_bf16(v0[2], v0[3]); w.z = cvt_pk_bf16(v1[0], v1[1]); w.w = cvt_pk_bf16(v1[2], v1[3]);
                *(u32x4*)(base + r * ldc + col0 + bj * HALF) = w;
                if (base2) *(u32x4*)(base2 + r * ldc2 + col2 + bj * HALF) = w; } }
}
template <int ACT> struct EpiBf16 {
    static constexpr bool PERM = true;
    bf16_t* O; int ldc;
    __device__ __forceinline__ void operator()(const f32x4 (&acc)[2][2][4][2], const Unit& u, int wr, int wc, int fr, int fq) const {
        store_tile_bf16<ACT>(acc, O, ldc, u.pm * BM + wr * 64 + fr, u.pn * BM + wc * 32 + 8 * fq, nullptr, 0, 0);
    }
};
struct EpiRkv {
    static constexpr bool PERM = true;
    bf16_t* RKV; bf16_t* LO; bf16_t* vf;
    __device__ __forceinline__ void operator()(const f32x4 (&acc)[2][2][4][2], const Unit& u, int wr, int wc, int fr, int fq) const {
        const int row0 = u.pm * BM + wr * 64 + fr, cin = wc * 32 + 8 * fq;
        if (u.pn < 12) { bf16_t* b2 = (u.pn >= 8) ? vf : nullptr; store_tile_bf16<0>(acc, RKV, 3072, row0, u.pn * BM + cin, b2, 1024, (u.pn - 8) * BM + cin); }
        else {
#pragma unroll
            for (int bj = 0; bj < 2; ++bj) { const int c = cin + bj * HALF; int dst = -1, act = 0;
                if (u.pn == 12) { if (c < 64) { dst = c; act = 2; } else if (c < 128) dst = 256 + (c - 64); else if (c < 160) dst = 512 + (c - 128); }
                else if (c < 160) { dst = 768 + c; act = 3; }
                if (dst >= 0) {
#pragma unroll
                    for (int ai = 0; ai < 2; ++ai)
#pragma unroll
                        for (int m = 0; m < 4; ++m) { const size_t r = (size_t)(row0 + ai * HALF + m * 16); f32x4 v0 = acc[ai][bj][m][0], v1 = acc[ai][bj][m][1];
#pragma unroll
                            for (int q = 0; q < 4; ++q) { v0[q] = act_apply(v0[q], act); v1[q] = act_apply(v1[q], act); }
                            u32x4 w; w.x = cvt_pk_bf16(v0[0], v0[1]); w.y = cvt_pk_bf16(v0[2], v0[3]); w.z = cvt_pk_bf16(v1[0], v1[1]); w.w = cvt_pk_bf16(v1[2], v1[3]);
                            *(u32x4*)(LO + r * 1024 + dst) = w; } } }
        }
    }
};
struct EpiRes {
    static constexpr bool PERM = false;
    float* X; const float* modl; int goff; const float* Xin;
    __device__ __forceinline__ void operator()(const f32x4 (&acc)[2][2][4][2], const Unit& u, int wr, int wc, int fr, int fq) const {
        const int col0 = u.pn * BM + wc * 32 + 4 * fq;
#pragma unroll
        for (int ai = 0; ai < 2; ++ai)
#pragma unroll
            for (int m = 0; m < 4; ++m) { const int r = u.pm * BM + ai * HALF + wr * 64 + m * 16 + fr; const float* gp = modl + (size_t)seq_of_row(r) * 6144 + goff + col0; float* xp = X + (size_t)r * D + col0; const float* xi = Xin + (size_t)r * D + col0;
#pragma unroll
                for (int bj = 0; bj < 2; ++bj)
#pragma unroll
                    for (int n = 0; n < 2; ++n) { const f32x4 gv = *(const f32x4*)(gp + bj * HALF + n * 16); f32x4 xv = *(const f32x4*)(xi + bj * HALF + n * 16);
                        xv = xv + gv * acc[ai][bj][m][n]; *(f32x4*)(xp + bj * HALF + n * 16) = xv; }
                asm volatile("" ::: "memory"); }
    }
};
struct EpiLora2 {
    static constexpr bool PERM = true, AFTER_DRAIN = false;
    bf16_t* WLOG; bf16_t* Aout; bf16_t* G; bf16_t* RKV; const bf16_t* vf; const float* w0; const float* a0; const float* v0;
    template <int GRP> __device__ __forceinline__ void run(const f32x4 (&acc)[2][2][4][2], const Unit& u, int wr, int wc, int fr, int fq) const {
        const int col0 = (u.pn & 3) * BM + wc * 32 + 8 * fq;
#pragma unroll
        for (int ai = 0; ai < 2; ++ai)
#pragma unroll
            for (int m = 0; m < 4; ++m) { const size_t r = (size_t)(u.pm * BM + ai * HALF + wr * 64 + m * 16 + fr);
#pragma unroll
                for (int bj = 0; bj < 2; ++bj) { const int c = col0 + bj * HALF; float a[8], o[8];
#pragma unroll
                    for (int q = 0; q < 4; ++q) { a[q] = acc[ai][bj][m][0][q]; a[4 + q] = acc[ai][bj][m][1][q]; }
                    if constexpr (GRP == 0) { const f32x4 b0 = *(const f32x4*)(w0 + c), b1 = *(const f32x4*)(w0 + c + 4);
#pragma unroll
                        for (int q = 0; q < 8; ++q) { const float x = -((q < 4 ? b0[q & 3] : b1[q & 3]) + a[q]); const float sp = fmaxf(x, 0.f) + __logf(1.f + __expf(-fabsf(x))); o[q] = -__expf(-sp - 0.5f); }
                        u32x4 w; w.x = cvt_pk_bf16(o[0], o[1]); w.y = cvt_pk_bf16(o[2], o[3]); w.z = cvt_pk_bf16(o[4], o[5]); w.w = cvt_pk_bf16(o[6], o[7]); *(u32x4*)(WLOG + r * D + c) = w; }
                    else if constexpr (GRP == 1) { const f32x4 b0 = *(const f32x4*)(a0 + c), b1 = *(const f32x4*)(a0 + c + 4);
#pragma unroll
                        for (int q = 0; q < 8; ++q) o[q] = 1.f / (1.f + __expf(-((q < 4 ? b0[q & 3] : b1[q & 3]) + a[q])));
                        u32x4 w; w.x = cvt_pk_bf16(o[0], o[1]); w.y = cvt_pk_bf16(o[2], o[3]); w.z = cvt_pk_bf16(o[4], o[5]); w.w = cvt_pk_bf16(o[6], o[7]); *(u32x4*)(Aout + r * D + c) = w; }
                    else if constexpr (GRP == 2) { const f32x4 b0 = *(const f32x4*)(v0 + c), b1 = *(const f32x4*)(v0 + c + 4); const u32x4 vv = *(const u32x4*)(RKV + r * 3072 + 2048 + c), ff = *(const u32x4*)(vf + r * D + c);
#pragma unroll
                        for (int q = 0; q < 8; ++q) { const float vx = (q & 1) ? bfhi(vv[q >> 1]) : bflo(vv[q >> 1]), fx = (q & 1) ? bfhi(ff[q >> 1]) : bflo(ff[q >> 1]);
                            const float gte = 1.f / (1.f + __expf(-((q < 4 ? b0[q & 3] : b1[q & 3]) + a[q]))); o[q] = vx + (fx - vx) * gte; }
                        u32x4 w; w.x = cvt_pk_bf16(o[0], o[1]); w.y = cvt_pk_bf16(o[2], o[3]); w.z = cvt_pk_bf16(o[4], o[5]); w.w = cvt_pk_bf16(o[6], o[7]); *(u32x4*)(RKV + r * 3072 + 2048 + c) = w; }
                    else { u32x4 w; w.x = cvt_pk_bf16(a[0], a[1]); w.y = cvt_pk_bf16(a[2], a[3]); w.z = cvt_pk_bf16(a[4], a[5]); w.w = cvt_pk_bf16(a[6], a[7]); *(u32x4*)(G + r * D + c) = w; } }
                asm volatile("" ::: "memory"); }
    }
    __device__ __forceinline__ void operator()(const f32x4 (&acc)[2][2][4][2], const Unit& u, int wr, int wc, int fr, int fq) const {
        const int grp = u.pn >> 2;
        if (grp == 0) run<0>(acc, u, wr, wc, fr, fq);
        else if (grp == 1) run<1>(acc, u, wr, wc, fr, fq);
        else if (grp == 2) { if (vf != nullptr) run<2>(acc, u, wr, wc, fr, fq); }
        else run<3>(acc, u, wr, wc, fr, fq);
    }
};
struct SplitOrder {
    int c, splitk;
    __device__ bool next(int i, Unit& u) const { if (i != 0 || c >= 16 * splitk) return false; const int t = c / splitk; u.pm = 64 + (t >> 2); u.pn = t & 3; u.ks = c % splitk; return true; }
};
struct SkipVOrder {
    StaticOrder S; bool skip;
    __device__ bool next(int i, Unit& u) const { if (!S.next(i, u)) return false; if (skip && u.pn >= 8) u.pn += 4; return true; }
};
struct LoraOrder {
    int c;
    __device__ bool next(int i, Unit& u) const { const int idx = c - 48; if (i != 0 || idx < 0 || idx >= 136) return false; u.pm = idx >> 1; u.pn = 12 + (idx & 1); u.ks = 0; return true; }
};
struct EpiPartial {
    static constexpr bool PERM = false;
    float* PART; int splitk;
    __device__ __forceinline__ void operator()(const f32x4 (&acc)[2][2][4][2], const Unit& u, int wr, int wc, int fr, int fq) const {
        float* base = PART + ((size_t)(((u.pm - 64) * 4 + u.pn) * splitk + u.ks) << 16) + wc * 32 + 4 * fq;
#pragma unroll
        for (int ai = 0; ai < 2; ++ai)
#pragma unroll
            for (int m = 0; m < 4; ++m) { float* rp = base + (ai * HALF + wr * 64 + m * 16 + fr) * 256;
#pragma unroll
                for (int bj = 0; bj < 2; ++bj)
#pragma unroll
                    for (int n = 0; n < 2; ++n) *(f32x4*)(rp + bj * HALF + n * 16) = acc[ai][bj][m][n]; }
    }
};
template <bool PERM_> struct EpiNull {
    static constexpr bool PERM = PERM_;
    __device__ __forceinline__ void operator()(const f32x4 (&acc)[2][2][4][2], const Unit&, int, int, int, int) const {
#pragma unroll
        for (int a = 0; a < 2; ++a)
#pragma unroll
            for (int b = 0; b < 2; ++b)
#pragma unroll
                for (int m = 0; m < 4; ++m)
#pragma unroll
                    for (int n = 0; n < 2; ++n) asm volatile("" :: "v"(acc[a][b][m][n]));
    }
};
}

#define RLX_AGENT __ATOMIC_RELAXED, __HIP_MEMORY_SCOPE_AGENT
#define XB_TMO      128
#define XB_XCNT(j)  (256  + 64 * (j))
#define XB_XSUB(j)  (1280 + 64 * (j))
#define XB_XGEN(j)  (2304 + 64 * (j))
#define XB_TOP      3328
#define XB_TOPGEN   3392
#define XCD_BAR_WORDS 3456
#define XB_SPIN_CAP (1u << 24)
__device__ __forceinline__ unsigned xb_ld(unsigned* p)              { return __hip_atomic_load(p, __ATOMIC_RELAXED, __HIP_MEMORY_SCOPE_AGENT); }
__device__ __forceinline__ unsigned xb_add(unsigned* p, unsigned v) { return __hip_atomic_fetch_add(p, v, __ATOMIC_RELAXED, __HIP_MEMORY_SCOPE_AGENT); }
__device__ __forceinline__ unsigned xb_xcc_id() { return (unsigned)__builtin_amdgcn_s_getreg((3 << 11) | 20) & 0xFu; }
#define XB_SPIN(cond, bar) do { unsigned _sp = 0; while (cond) { __builtin_amdgcn_s_sleep(4); \
    if ((++_sp & 255u) == 0u) { if (xb_ld(&(bar)[XB_TMO])) break; if (_sp > XB_SPIN_CAP) { atomicAdd(&(bar)[XB_TMO], 1u); break; } } } } while (0)
struct XcdBarrier { unsigned* bar; unsigned x; volatile LAS unsigned* st; };
__device__ __forceinline__ XcdBarrier xcd_barrier_post(unsigned* bar, volatile LAS unsigned* st) {
    XcdBarrier b; b.bar = bar; b.x = xb_xcc_id(); b.st = st;
    if (threadIdx.x == 0) (void)xb_add(&bar[XB_XCNT(b.x)], 1u);
    return b;
}
__device__ __forceinline__ void xcd_barrier_complete(unsigned* bar, unsigned x, unsigned& nloc, unsigned& nx) {
    const unsigned G = gridDim.x * gridDim.y * gridDim.z;
    unsigned sum, cnt, mine, sp = 0u;
    for (;;) {
        sum = 0u; cnt = 0u; mine = 0u;
#pragma unroll
        for (unsigned j = 0; j < 16; ++j) { const unsigned c = xb_ld(&bar[XB_XCNT(j)]); sum += c; cnt += (c > 0u) ? 1u : 0u; mine = (j == x) ? c : mine; }
        if (sum == G) break;
        __builtin_amdgcn_s_sleep(1);
        if ((++sp & 255u) == 0u) { if (xb_ld(&bar[XB_TMO])) break; if (sp > XB_SPIN_CAP) { atomicAdd(&bar[XB_TMO], 1u); break; } }
    }
    nloc = mine > 0u ? mine : 1u; nx = cnt > 0u ? cnt : 1u;
}
__device__ __forceinline__ void xcd_barrier(const XcdBarrier& b) {
    asm volatile("s_waitcnt vmcnt(0)" ::: "memory");
    __syncthreads();
    if (threadIdx.x == 0) {
        unsigned* bar = b.bar;
        __builtin_amdgcn_s_waitcnt(0);
        unsigned nloc = b.st[0], nx = b.st[1];
        if (nloc == 0u) { xcd_barrier_complete(bar, b.x, nloc, nx); b.st[0] = nloc; b.st[1] = nx; }
        const unsigned gen = b.st[2];
        const unsigned old = xb_add(&bar[XB_XSUB(b.x)], 1u);
        if (old + 1u == (gen + 1u) * nloc) {
            __builtin_amdgcn_fence(__ATOMIC_RELEASE, "agent");
            asm volatile("s_waitcnt vmcnt(0)" ::: "memory");
            const unsigned og = xb_add(&bar[XB_TOP], 1u);
            if (og + 1u == (gen + 1u) * nx) xb_add(&bar[XB_TOPGEN], 1u);
            else XB_SPIN(xb_ld(&bar[XB_TOPGEN]) == gen, bar);
        } else {
            XB_SPIN(xb_ld(&bar[XB_TOPGEN]) == gen, bar);
        }
        __builtin_amdgcn_fence(__ATOMIC_ACQUIRE, "agent");
        asm volatile("s_waitcnt vmcnt(0)" ::: "memory");
        b.st[2] = gen + 1u;
    }
    __syncthreads();
}

constexpr int NWAVES = 8, NT = NWAVES * 64;
constexpr int RING_BYTES = 131072, LDSCTL_OFF = RING_BYTES, MISC_OFF = LDSCTL_OFF + 320, LDS_BYTES = 147456;
constexpr int CW_BAR = 4096;

struct Args { const float* in[38]; float* out; unsigned char* ws; };
struct Frame {
    LAS unsigned char* lds; volatile LAS unsigned* MISC;
    int wave, vcu, G;
    const float* const* in; float* out; unsigned char* ws;
};
enum { I_XP = 0, I_XS, I_SRET, I_SHG, I_SWKV, I_SSHIFT, I_CP, I_CS, I_MODW, I_MODB, I_NMIXG, I_NMLPG, I_FINALG, I_W1, I_W2, I_ABWIN, I_ABWOUT, I_HGLB, I_HGNG,
       I_MU, I_WRKV, I_RW0, I_RW1, I_RW2, I_RA0, I_RA1, I_RA2, I_RV0, I_RV1, I_RV2, I_RG1, I_RG2, I_RKK, I_RKA, I_RRK, I_RLNG, I_RLNB, I_RWOUT };
constexpr size_t O_Y = 0, O_RETP = 17825792, O_RETS = 17891328, O_HGP = 19988480, O_HGS = 20119552, O_WKVP = 24313856, O_WKVS = 24444928, O_SHP = 28639232, O_SHS = 28641280;

__device__ __forceinline__ void transpose_item(const float* W, int N, bf16_t* WT, int ldt, int row_off, int col_off, const float* mu, int mode, LAS float* scr, int item, int lane) {
    const int nblk = N / 32, kb = item / nblk, nb = item % nblk, k0 = 64 * kb, n0 = 32 * nb;
#pragma unroll 8
    for (int i = 0; i < 32; ++i) { const int kk = 2 * i + (lane >> 5); float s = 1.f; if (mode == 1) s = 1.f - mu[k0 + kk]; else if (mode == 2) s = mu[k0 + kk];
        scr[kk * 33 + (lane & 31)] = W[(size_t)(k0 + kk) * N + n0 + (lane & 31)] * s; }
    LDS_WAIT(); asm volatile("" ::: "memory");
    const int c = lane & 7;
#pragma unroll
    for (int j = 0; j < 4; ++j) { const int n = (lane >> 3) + 8 * j; const LAS float* s = scr + (8 * c) * 33 + n;
        u32x4 o; o.x = pk2(s[0 * 33], s[1 * 33]); o.y = pk2(s[2 * 33], s[3 * 33]); o.z = pk2(s[4 * 33], s[5 * 33]); o.w = pk2(s[6 * 33], s[7 * 33]);
        *(u32x4*)(WT + (size_t)(row_off + n0 + n) * ldt + col_off + k0 + 8 * c) = o; }
    LDS_WAIT(); asm volatile("" ::: "memory");
}
__device__ __forceinline__ void convert_layer_weights(Frame& F, int layer) {
    const int tid = otid(); const int lane = tid & 63; (void)lane;
    LAS float* scr = (LAS float*)(F.lds + F.wave * 16384);
    const int gw = F.vcu * NWAVES + F.wave, NGW = F.G * NWAVES;
    unsigned char* ar = F.ws + WS_ARENA;
    const int m = layer >> 1;
    constexpr int I_1 = (D / 64) * (DFF / 32), I_2 = (DFF / 64) * (D / 32);
    const float* w1 = F.in[I_W1] + (size_t)layer * D * DFF; const float* w2 = F.in[I_W2] + (size_t)layer * DFF * D;
    if ((layer & 1) == 0) {
        constexpr int I_IN = (D / 64) * (ABIN / 32), I_OUT = (D / 64) * (D / 32), NI = I_1 + I_2 + I_IN + I_OUT;
        const float* win = F.in[I_ABWIN] + (size_t)m * D * ABIN; const float* wout = F.in[I_ABWOUT] + (size_t)m * D * D;
        for (int it = gw; it < NI; it += NGW) { int r = it;
            if (r < I_1) { transpose_item(w1, DFF, (bf16_t*)(ar + AR_W1), D, 0, 0, nullptr, 0, scr, r, lane); continue; } r -= I_1;
            if (r < I_2) { transpose_item(w2, D, (bf16_t*)(ar + AR_W2), DFF, 0, 0, nullptr, 0, scr, r, lane); continue; } r -= I_2;
            if (r < I_IN) { transpose_item(win, ABIN, (bf16_t*)(ar + AR_WIN), D, 0, 0, nullptr, 0, scr, r, lane); continue; } r -= I_IN;
            transpose_item(wout, D, (bf16_t*)(ar + AR_WOUT), D, 0, 0, nullptr, 0, scr, r, lane); }
    } else {
        constexpr int I_P = (D / 64) * (D / 32), NI = I_1 + I_2 + 4 * I_P;
        const float* mu = F.in[I_MU] + (size_t)m * 6 * D; const float* wrkv = F.in[I_WRKV] + (size_t)m * 3 * D * D; const float* wo = F.in[I_RWOUT] + (size_t)m * D * D;
        bf16_t* wc1 = (bf16_t*)(ar + AR_WC1);
        for (int it = gw; it < NI; it += NGW) { int r = it;
            if (r < I_1) { transpose_item(w1, DFF, (bf16_t*)(ar + AR_W1), D, 0, 0, nullptr, 0, scr, r, lane); continue; } r -= I_1;
            if (r < I_2) { transpose_item(w2, D, (bf16_t*)(ar + AR_W2), DFF, 0, 0, nullptr, 0, scr, r, lane); continue; } r -= I_2;
            if (r < 3 * I_P) { const int p = r / I_P;
                transpose_item(wrkv + (size_t)p * D * D, D, wc1, 2048, p * D, 0, nullptr, 0, scr, r % I_P, lane); continue; } r -= 3 * I_P;
            transpose_item(wo, D, (bf16_t*)(ar + AR_WO), D, 0, 0, nullptr, 0, scr, r, lane); }
        const int gt = F.vcu * NT + tid, NG = F.G * NT;
        const float* lw1 = F.in[I_RW1] + (size_t)m * D * 64; const float* la1 = F.in[I_RA1] + (size_t)m * D * 64; const float* lv1 = F.in[I_RV1]; const float* lg1 = F.in[I_RG1] + (size_t)m * D * 160;
        for (int idx = gt; idx < 512 * 2048; idx += NG) { const int n = idx >> 11, k = idx & 2047, kk = k & 1023, nn = n & 255;
            const float* src = nullptr; int ns = 0, mi = 0, nc = 0;
            if (n < 256) { if (nn < 64) { src = lw1; ns = 64; mi = 1; nc = nn; } else if (nn < 128) { src = la1; ns = 64; mi = 4; nc = nn - 64; } else if (nn < 160 && m == 1) { src = lv1; ns = 32; mi = 3; nc = nn - 128; } }
            else if (nn < 160) { src = lg1; ns = 160; mi = 5; nc = nn; }
            float v = 0.f; if (src) { const float muv = mu[mi * D + kk]; v = src[(size_t)kk * ns + nc] * (k < 1024 ? 1.f - muv : muv); }
            wc1[(size_t)(3072 + n) * 2048 + k] = (bf16_t)f2bf(v); }
        bf16_t* wc2 = (bf16_t*)(ar + AR_WC2);
        const float* lw2 = F.in[I_RW2] + (size_t)m * 64 * D; const float* la2 = F.in[I_RA2] + (size_t)m * 64 * D; const float* lv2 = F.in[I_RV2]; const float* lg2 = F.in[I_RG2] + (size_t)m * 160 * D;
        for (int idx = gt; idx < 4096 * 256; idx += NG) { const int k = idx >> 12, n = idx & 4095, g = n >> 10, nn = n & 1023;
            const float* src = (g == 0) ? lw2 : (g == 1) ? la2 : (g == 2) ? lv2 : lg2; const int ks = (g == 0 || g == 1) ? 64 : (g == 2 ? 32 : 160);
            float v = 0.f; if (k < ks && !(g == 2 && m == 0)) v = src[(size_t)k * D + nn];
            wc2[(size_t)n * 256 + k] = (bf16_t)f2bf(v); }
    }
}

__device__ __forceinline__ void mod_phase(Frame& F, int l_lo, int l_hi, int wb, int nb) {
    const int tid = otid(); const int lane = tid & 63;
    const float* __restrict__ SC = (const float*)(F.ws + WS_MOD + 3584 * 1024);
    float* MOD = (float*)(F.ws + WS_MOD);
    LAS float* red = (LAS float*)F.lds;
    for (int task = l_lo * 96 + wb; task < l_hi * 96; task += nb) { const int l = task / 96, n = (task % 96) * 64 + lane, ks = F.wave;
        const float* w = F.in[I_MODW] + ((size_t)l * D + ks * 128) * 6144 + n;
        float acc[NSEQ];
#pragma unroll
        for (int s = 0; s < NSEQ; ++s) acc[s] = 0.f;
        for (int k = 0; k < 128; k += 4) { const float w0 = w[(size_t)k * 6144], w1 = w[(size_t)(k + 1) * 6144], w2 = w[(size_t)(k + 2) * 6144], w3 = w[(size_t)(k + 3) * 6144];
#pragma unroll
            for (int s = 0; s < NSEQ; ++s) { const f32x4 c4 = *(const f32x4*)(SC + s * D + ks * 128 + k); acc[s] += (c4[0] * w0 + c4[1] * w1) + (c4[2] * w2 + c4[3] * w3); } }
        __syncthreads();
#pragma unroll
        for (int s = 0; s < NSEQ; ++s) red[(F.wave * NSEQ + s) * 64 + lane] = acc[s];
        __syncthreads();
        for (int i = tid; i < NSEQ * 64; i += NT) { const int s = i >> 6, c = i & 63; float t = F.in[I_MODB][l * 6144 + (task % 96) * 64 + c];
#pragma unroll
            for (int q = 0; q < 8; ++q) t += red[(q * NSEQ + s) * 64 + c];
            MOD[((size_t)l * NSEQ + s) * 6144 + (task % 96) * 64 + c] = t; }
    }
    __syncthreads();
}

__device__ __forceinline__ void prologue(Frame& F) {
    const int tid = otid(); const int lane = tid & 63; (void)lane;
    const int gt = F.vcu * NT + tid, NG = F.G * NT;
    { f32x2* tab = (f32x2*)(F.ws + WS_ROPE);
      for (int i = gt; i < 16384 * 32; i += NG) { const int p = i >> 5, d = i & 31; double rev = (double)p * ROPE_REV[d]; rev -= floor(rev); const float fr = (float)rev;
          tab[i] = (f32x2){__builtin_amdgcn_cosf(fr), __builtin_amdgcn_sinf(fr)}; } }
    { unsigned* z = (unsigned*)(F.ws + WS_XN0); for (int i = gt; i < 512; i += NG) z[i] = 0u; }
    { float* SC = (float*)(F.ws + WS_MOD + 3584 * 1024);
      for (int i = gt; i < NSEQ * D; i += NG) { const int s = i >> 10, k = i & 1023; const float c = (s == 0) ? F.in[I_CP][k] : F.in[I_CS][(size_t)(s - 1) * D + k]; SC[i] = siluf_(c); } }
    convert_layer_weights(F, 0);
}

template <int MODE> __device__ __forceinline__ void norm_row(Frame& F, int layer, int r, f32x4 (&v)[4], const float* MOD, const float* gvec, int lane, f32x4 (&ho)[4]) {
    const int m = layer >> 1; const int shoff = (MODE == 2) ? 3072 : 0, scoff = (MODE == 2) ? 4096 : 1024;
    bf16_t* XN = (bf16_t*)(F.ws + WS_XN); bf16_t* PREVS = (bf16_t*)(F.ws + WS_PREVS);
    float* xrow = F.out + (size_t)r * D; float s2 = 0.f;
#pragma unroll
    for (int j = 0; j < 4; ++j) s2 += (v[j].x * v[j].x + v[j].y * v[j].y) + (v[j].z * v[j].z + v[j].w * v[j].w);
    const float rstd = 1.f / sqrtf(wave_sum(s2) * (1.f / D) + NORM_EPS);
    const int seq = seq_of_row(r); const float* mp = MOD + (size_t)seq * 6144;
#pragma unroll
    for (int j = 0; j < 4; ++j) { const int c = 4 * lane + 256 * j; const f32x4 g4 = *(const f32x4*)(gvec + c); f32x4 o = v[j] * rstd * g4;
        if (MODE == 3) { *((f32x4*)xrow + lane + 64 * j) = o; continue; }
        const f32x4 sc = *(const f32x4*)(mp + scoff + c), sh = *(const f32x4*)(mp + shoff + c);
        o = o * (1.f + sc) + sh; ho[j] = o;
        const unsigned long long pk = (unsigned long long)pk2(o.x, o.y) | ((unsigned long long)pk2(o.z, o.w) << 32);
        *(unsigned long long*)(XN + (size_t)r * D + c) = pk;
        if (MODE == 1) {
            if (r >= MP) { const int t = (r - MP) & 31; if (t < 31) *(unsigned long long*)(PREVS + (size_t)(r - MP + 1) * D + c) = pk;
                else *(f32x4*)(F.out + O_SHS + ((size_t)m * 32 + ((r - MP) >> 5)) * D + c) = o;
                if (t == 0) { const f32x4 ss = *(const f32x4*)(F.in[I_SSHIFT] + ((size_t)m * 32 + ((r - MP) >> 5)) * D + c);
                    *(unsigned long long*)(PREVS + (size_t)(r - MP) * D + c) = (unsigned long long)pk2(ss.x, ss.y) | ((unsigned long long)pk2(ss.z, ss.w) << 32); } }
            else if (r == MP - 1) *(f32x4*)(F.out + O_SHP + (size_t)m * D + c) = o;
        } }
}
__device__ __forceinline__ void hmix_calc(const float* mp, const float* gvec, const f32x4 (&v)[4], int lane, f32x4 (&h)[4]) {
    float s2 = 0.f;
#pragma unroll
    for (int j = 0; j < 4; ++j) s2 += (v[j].x * v[j].x + v[j].y * v[j].y) + (v[j].z * v[j].z + v[j].w * v[j].w);
    const float rstd = 1.f / sqrtf(wave_sum(s2) * (1.f / D) + NORM_EPS);
#pragma unroll
    for (int j = 0; j < 4; ++j) { const int c = 4 * lane + 256 * j; const f32x4 g4 = *(const f32x4*)(gvec + c), sc = *(const f32x4*)(mp + 1024 + c), sh = *(const f32x4*)(mp + c); h[j] = v[j] * rstd * g4 * (1.f + sc) + sh; }
}
__device__ __forceinline__ void write_mixes(Frame& F, int m, int r, const f32x4 (&h)[4], const f32x4 (&p)[4], int lane) {
    bf16_t* XM = (bf16_t*)(F.ws + WS_XMIX); const float* mu = F.in[I_MU] + (size_t)m * 6 * D;
#pragma unroll
    for (int j = 0; j < 4; ++j) { const int c = 4 * lane + 256 * j; const f32x4 d = p[j] - h[j];
#pragma unroll
        for (int q = 0; q < 3; ++q) { const f32x4 mv = *(const f32x4*)(mu + (q == 0 ? 0 : (q == 1 ? 2 : 3)) * D + c); const f32x4 x = h[j] + d * mv;
            *(unsigned long long*)(XM + ((size_t)q * M + r) * D + c) = (unsigned long long)pk2(x.x, x.y) | ((unsigned long long)pk2(x.z, x.w) << 32); } }
}
template <int MODE, int PEND = 0, bool FIRSTP = false> __device__ __forceinline__ void norm_pass(Frame& F, int layer, int player, int pgoff, const float* sx_in, float* sx_out) {
    const int tid = otid(); const int lane = tid & 63;
    const int gw = F.vcu * NWAVES + F.wave, NGW = F.G * NWAVES;
    const float* MOD = (const float*)(F.ws + WS_MOD) + (size_t)layer * NSEQ * 6144;
    const float* gvec = (MODE == 3) ? F.in[I_FINALG] : (MODE == 2 ? F.in[I_NMLPG] + layer * D : F.in[I_NMIXG] + layer * D);
    constexpr int HALO = (MODE == 1) ? 1 : 0;
    LAS float* xs = (LAS float*)F.lds;
    const int m = layer >> 1; const int r0s = MP + 4 * F.vcu;
    const float* gmod = (const float*)(F.ws + WS_MOD) + (size_t)player * NSEQ * 6144 + pgoff;
    if constexpr (PEND > 0) {
        __syncthreads();
#pragma unroll
        for (int q = 0; q < (4 + HALO + 1) / 2; ++q) { const int idx = tid + q * NT, rr = idx >> 8, c4 = (idx & 255) * 4; const int r = r0s - HALO + rr;
            if (rr < 4 + HALO && !(HALO && rr == 0 && ((r0s - MP) & 31) == 0)) {
                const int pn = c4 >> 8; const float* pb = (const float*)(F.ws + WS_PART) + ((size_t)((((r >> 8) - 64) * 4 + pn) * PEND) << 16) + (r & 255) * 256 + (c4 & 255);
                f32x4 acc = (f32x4){0.f, 0.f, 0.f, 0.f};
#pragma unroll
                for (int ks = 0; ks < PEND; ++ks) acc += *(const f32x4*)(pb + ((size_t)ks << 16));
                const f32x4 g4 = *(const f32x4*)(gmod + (size_t)seq_of_row(r) * 6144 + c4); f32x4 x4 = *(const f32x4*)(sx_in + (size_t)(r - MP) * D + c4);
                x4 = x4 + g4 * acc; if (sx_out != nullptr && !(HALO && rr == 0)) *(f32x4*)(sx_out + (size_t)(r - MP) * D + c4) = x4; *(LAS f32x4*)(xs + rr * 1024 + c4) = x4; } }
        __syncthreads();
    }
    for (int r = gw; r < MP; r += NGW) {
        const f32x4* xr = (const f32x4*)((FIRSTP ? F.in[I_XP] : F.out) + (size_t)r * D) + lane; f32x4 v[4], ho[4];
#pragma unroll
        for (int j = 0; j < 4; ++j) v[j] = xr[64 * j];
        if constexpr (MODE == 1) { f32x4 pv[4], hp[4];
#pragma unroll
            for (int j = 0; j < 4; ++j) pv[j] = (r > 0) ? *((const f32x4*)(F.out + (size_t)(r - 1) * D) + lane + 64 * j) : (f32x4){0.f, 0.f, 0.f, 0.f};
            norm_row<MODE>(F, layer, r, v, MOD, gvec, lane, ho);
            if (r > 0) hmix_calc(MOD, gvec, pv, lane, hp); else {
#pragma unroll
                for (int j = 0; j < 4; ++j) hp[j] = (f32x4){0.f, 0.f, 0.f, 0.f}; }
            write_mixes(F, m, r, ho, hp, lane);
        } else norm_row<MODE>(F, layer, r, v, MOD, gvec, lane, ho);
    }
    if (F.wave < 4 && 4 * F.vcu + F.wave < MS) { const int r = r0s + F.wave; f32x4 v[4], ho[4];
#pragma unroll
        for (int j = 0; j < 4; ++j) { if constexpr (PEND > 0) v[j] = *(const LAS f32x4*)(xs + (F.wave + HALO) * 1024 + 4 * lane + 256 * j); else v[j] = *((const f32x4*)(sx_in + (size_t)(r - MP) * D) + lane + 64 * j); }
        norm_row<MODE>(F, layer, r, v, MOD, gvec, lane, ho);
        if constexpr (MODE == 1) { f32x4 hp[4]; const int t = (r - MP) & 31, sq = (r - MP) >> 5;
            if (t == 0) {
#pragma unroll
                for (int j = 0; j < 4; ++j) hp[j] = *((const f32x4*)(F.in[I_SSHIFT] + ((size_t)m * 32 + sq) * D) + lane + 64 * j);
            } else { f32x4 pv[4];
#pragma unroll
                for (int j = 0; j < 4; ++j) pv[j] = *(const LAS f32x4*)(xs + (F.wave + HALO - 1) * 1024 + 4 * lane + 256 * j);
                hmix_calc(MOD + (size_t)(1 + sq) * 6144, gvec, pv, lane, hp); }
            write_mixes(F, m, r, ho, hp, lane); } }
}

template <int MT, int NTT> __device__ __forceinline__ void wave_mm_nt(f32x4 (&acc)[MT][NTT], const LAS bf16_t* X, int ldx, const LAS bf16_t* Y, int ldy, int K, int fr, int fq) {
    for (int k0 = 0; k0 < K; k0 += 32) {
        bf16x8 xa[MT], yb[NTT];
#pragma unroll
        for (int i = 0; i < MT; ++i) xa[i] = *(const LAS bf16x8*)(X + (16 * i + fr) * ldx + k0 + 8 * fq);
#pragma unroll
        for (int j = 0; j < NTT; ++j) yb[j] = *(const LAS bf16x8*)(Y + (16 * j + fr) * ldy + k0 + 8 * fq);
#pragma unroll
        for (int i = 0; i < MT; ++i)
#pragma unroll
            for (int j = 0; j < NTT; ++j) acc[i][j] = __builtin_amdgcn_mfma_f32_16x16x32_bf16(yb[j], xa[i], acc[i][j], 0, 0, 0);
    }
}

constexpr int LQS = 0, LKS = 18432, LQG = 36864, LVT = 55296, LST = 73728, LPS = 108544, LRED = 117760, LBS = 118784;
__device__ __forceinline__ void chunk_geom(int c, int& r0, int& pos0) { if (c < 256) { r0 = 64 * c; pos0 = 64 * c; } else { r0 = MP + 32 * (c - 256); pos0 = 2048; } }

template <int L, bool HG, bool SUMMARY> __device__ __forceinline__ void ab_load(Frame& F, int layer, int c, int h) {
    const int tid = otid(); const int lane = tid & 63; (void)lane;
    const int m = layer >> 1; int r0, pos0; chunk_geom(c, r0, pos0);
    const bf16_t* Z = (const bf16_t*)(F.ws + WS_Z);
    LAS bf16_t* QS = (LAS bf16_t*)(F.lds + LQS); LAS bf16_t* KS = (LAS bf16_t*)(F.lds + LKS); LAS bf16_t* QG = (LAS bf16_t*)(F.lds + LQG); LAS bf16_t* VT = (LAS bf16_t*)(F.lds + LVT);
    constexpr int LDT = L + 8;
    if constexpr (HG) {
        constexpr int TQ = L / 4; LAS float* BS = (LAS float*)(F.lds + LBS);
        const int ch = tid & 127, qtr = tid >> 7;
        float lb = 0.f;
        if (m == 1) { const float a0 = F.in[I_HGLB][h * 128 + ch], a1 = F.in[I_HGLB][512 + h * 128 + ch]; lb = 1.f / (1.f + __expf(a0 - a1)); }
        { constexpr int NP = L * 16;
#pragma unroll
          for (int q = 0; q < (NP + NT - 1) / NT; ++q) { const int v = tid + q * NT; if (NP % NT == 0 || v < NP) { const int j = v >> 4, c8 = v & 15; const size_t zr = (size_t)(r0 + j) * ABIN + h * 128 + c8 * 8;
                  const u32x4 zf4 = *(const u32x4*)(Z + zr + 2048), v4 = *(const u32x4*)(Z + zr + 2560);
                  *(LAS u32x4*)(QG + j * 136 + c8 * 8) = zf4; *(LAS u32x4*)(KS + j * 136 + c8 * 8) = v4;
                  if constexpr (!SUMMARY) { const u32x4 q4 = *(const u32x4*)(Z + zr + 1536); *(LAS u32x4*)(QS + j * 136 + c8 * 8) = q4; } } } }
        __syncthreads();
        float zf[TQ], cs[TQ]; float run = 0.f;
#pragma unroll
        for (int jj = 0; jj < TQ; ++jj) { const int j = qtr * TQ + jj; zf[jj] = bf2f(QG[j * 136 + ch]);
            float lf; if (lb == 0.f) lf = fminf(zf[jj], 0.f) - __logf(1.f + __expf(-fabsf(zf[jj]))); else lf = __logf(lb + (1.f - lb) * sigmoidf_(zf[jj]));
            run += lf; cs[jj] = run; }
        BS[qtr * 128 + ch] = run;
        __syncthreads();
        const float b0 = BS[ch], b1 = BS[128 + ch], b2 = BS[256 + ch], b3 = BS[384 + ch];
        const float off = (qtr > 0 ? b0 : 0.f) + (qtr > 1 ? b1 : 0.f) + (qtr > 2 ? b2 : 0.f), bL = (b0 + b1) + (b2 + b3), bmid = b0 + b1;
        if constexpr (SUMMARY) {
#pragma unroll
            for (int j8 = 0; j8 < TQ; j8 += 8) { unsigned vv[8]; float kd[8];
#pragma unroll
                for (int q = 0; q < 8; ++q) { const int jj = j8 + q, j = qtr * TQ + jj; const float b = off + cs[jj]; const float kb = (1.f - lb) * sigmoidf_(-zf[jj]); vv[q] = KS[j * 136 + ch]; kd[q] = kb * __expf(bL - b); }
                u32x4 pv, pk; pv.x = vv[0] | (vv[1] << 16); pv.y = vv[2] | (vv[3] << 16); pv.z = vv[4] | (vv[5] << 16); pv.w = vv[6] | (vv[7] << 16);
                pk.x = pk2(kd[0], kd[1]); pk.y = pk2(kd[2], kd[3]); pk.z = pk2(kd[4], kd[5]); pk.w = pk2(kd[6], kd[7]);
                *(LAS u32x4*)(VT + ch * LDT + qtr * TQ + j8) = pv; *(LAS u32x4*)(QS + ch * LDT + qtr * TQ + j8) = pk; }
            if (qtr == 0) ((float*)(F.ws + WS_DEC))[((size_t)c * 4 + h) * 128 + ch] = __expf(bL);
        } else {
#pragma unroll
            for (int j8 = 0; j8 < TQ; j8 += 8) { unsigned vv[8];
#pragma unroll
                for (int q8 = 0; q8 < 8; ++q8) { const int jj = j8 + q8, j = qtr * TQ + jj; const float b = off + cs[jj]; const float kb = (1.f - lb) * sigmoidf_(-zf[jj]);
                    const float q = siluf_(bf2f(QS[j * 136 + ch])); vv[q8] = KS[j * 136 + ch];
                    QS[j * 136 + ch] = (bf16_t)f2bf(q * __expf(b - bmid)); KS[j * 136 + ch] = (bf16_t)f2bf(kb * __expf(bmid - b)); QG[j * 136 + ch] = (bf16_t)f2bf(q * __expf(b)); }
                u32x4 pv; pv.x = vv[0] | (vv[1] << 16); pv.y = vv[2] | (vv[3] << 16); pv.z = vv[4] | (vv[5] << 16); pv.w = vv[6] | (vv[7] << 16);
                *(LAS u32x4*)(VT + ch * LDT + qtr * TQ + j8) = pv; }
        }
    } else {
        const float logg = log1pf(-exp2f(-5.f - (float)h));
        const f32x2* rope = (const f32x2*)(F.ws + WS_ROPE);
        for (int it = tid; it < L * 4; it += NT) { const int j = it >> 2, d8 = it & 3; const size_t zr = (size_t)(r0 + j) * ABIN;
            const f32x2* rp = rope + (size_t)(pos0 + j) * 32 + d8 * 8;
            const u32x4 k1 = *(const u32x4*)(Z + zr + 256 + h * 64 + d8 * 8), k2 = *(const u32x4*)(Z + zr + 256 + h * 64 + 32 + d8 * 8);
            const float gk = __expf((float)(L - 1 - j) * logg), gq = __expf((float)(j + 1) * logg);
            u32x4 q1 = (u32x4){0, 0, 0, 0}, q2 = q1; if constexpr (!SUMMARY) { q1 = *(const u32x4*)(Z + zr + h * 64 + d8 * 8); q2 = *(const u32x4*)(Z + zr + h * 64 + 32 + d8 * 8); }
#pragma unroll
            for (int e = 0; e < 8; ++e) { const f32x2 cs_ = rp[e]; const unsigned wk1 = k1[e >> 1], wk2 = k2[e >> 1]; const float x1 = (e & 1) ? bfhi(wk1) : bflo(wk1), x2 = (e & 1) ? bfhi(wk2) : bflo(wk2);
                const float o1 = x1 * cs_.x - x2 * cs_.y, o2 = x1 * cs_.y + x2 * cs_.x; const int d = d8 * 8 + e;
                if constexpr (SUMMARY) { QS[d * LDT + j] = (bf16_t)f2bf(o1 * gk); QS[(d + 32) * LDT + j] = (bf16_t)f2bf(o2 * gk); }
                else { KS[j * 72 + d] = (bf16_t)f2bf(o1); KS[j * 72 + d + 32] = (bf16_t)f2bf(o2);
                    const unsigned wq1 = q1[e >> 1], wq2 = q2[e >> 1]; const float y1 = (e & 1) ? bfhi(wq1) : bflo(wq1), y2 = (e & 1) ? bfhi(wq2) : bflo(wq2);
                    const float p1 = (y1 * cs_.x - y2 * cs_.y) * 0.125f, p2 = (y1 * cs_.y + y2 * cs_.x) * 0.125f;
                    QS[j * 72 + d] = (bf16_t)f2bf(p1); QS[j * 72 + d + 32] = (bf16_t)f2bf(p2); QG[j * 72 + d] = (bf16_t)f2bf(p1 * gq); QG[j * 72 + d + 32] = (bf16_t)f2bf(p2 * gq); } } }
        for (int it = tid; it < L * 16; it += NT) { const int j = it >> 4, e8 = it & 15; const u32x4 vv = *(const u32x4*)(Z + (size_t)(r0 + j) * ABIN + 512 + h * 128 + e8 * 8);
#pragma unroll
            for (int e = 0; e < 8; ++e) { const unsigned w = vv[e >> 1]; VT[(e8 * 8 + e) * LDT + j] = (bf16_t)((e & 1) ? (w >> 16) : (w & 0xffffu)); } }
    }
}

template <int L, bool HG> __device__ __forceinline__ void ab_summary_unit(Frame& F, int layer, int c, int h) {
    const int tid = otid(); const int lane = tid & 63; (void)lane;
    constexpr int DK = HG ? 128 : 64, NCT = DK / 16, LDT = L + 8;
    __syncthreads();
    ab_load<L, HG, true>(F, layer, c, h);
    __syncthreads();
    const int fr = lane & 15, fq = lane >> 4;
    const LAS bf16_t* KDT = (const LAS bf16_t*)(F.lds + LQS); const LAS bf16_t* VT = (const LAS bf16_t*)(F.lds + LVT);
    f32x4 acc[1][NCT];
#pragma unroll
    for (int j = 0; j < NCT; ++j) acc[0][j] = (f32x4){0.f, 0.f, 0.f, 0.f};
    wave_mm_nt<1, NCT>(acc, VT + F.wave * 16 * LDT, LDT, KDT, LDT, L, fr, fq);
    bf16_t* ST = (bf16_t*)(F.ws + WS_STATE) + (size_t)c * SLOT_E + (HG ? 32768 + h * 16384 : h * 8192);
    const int e = F.wave * 16 + fr;
#pragma unroll
    for (int j = 0; j < NCT; ++j) { u32x2 w; w.x = pk2(acc[0][j][0], acc[0][j][1]); w.y = pk2(acc[0][j][2], acc[0][j][3]); *(u32x2*)(ST + (size_t)e * DK + 16 * j + 4 * fq) = w; }
}

template <int L, bool HG> __device__ __forceinline__ void ab_output_unit(Frame& F, int layer, int c, int h) {
    const int tid = otid(); const int lane = tid & 63; (void)lane;
    constexpr int DK = HG ? 128 : 64, LDQ = HG ? 136 : 72, LDT = L + 8, NIT = L / 16, WPI = 8 / NIT, ET = 8 / WPI, TPW = (NIT * NIT >= 8) ? NIT * NIT / 8 : 1;
    const int m = layer >> 1; int r0, pos0; chunk_geom(c, r0, pos0);
    __syncthreads();
    ab_load<L, HG, false>(F, layer, c, h);
    LAS bf16_t* QS = (LAS bf16_t*)(F.lds + LQS); LAS bf16_t* KS = (LAS bf16_t*)(F.lds + LKS); LAS bf16_t* QG = (LAS bf16_t*)(F.lds + LQG); LAS bf16_t* VT = (LAS bf16_t*)(F.lds + LVT);
    LAS bf16_t* STl = (LAS bf16_t*)(F.lds + LST); LAS bf16_t* PS = (LAS bf16_t*)(F.lds + LPS); LAS float* RED = (LAS float*)(F.lds + LRED);
    { const bf16_t* ST = (const bf16_t*)(F.ws + WS_STATE) + (size_t)c * SLOT_E + (HG ? 32768 + h * 16384 : h * 8192);
      for (int it = tid; it < 128 * DK / 8; it += NT) { const int e = it / (DK / 8), c8 = it % (DK / 8); *(LAS u32x4*)(STl + e * LDQ + c8 * 8) = *(const u32x4*)(ST + (size_t)e * DK + c8 * 8); } }
    __syncthreads();
    const int fr = lane & 15, fq = lane >> 4, w = F.wave;
    const float logg = HG ? 0.f : log1pf(-exp2f(-5.f - (float)h));
    if (w * TPW < NIT * NIT) {
        const int it = (w * TPW) / NIT, jt0 = (w * TPW) % NIT;
        f32x4 sc[1][TPW];
#pragma unroll
        for (int q = 0; q < TPW; ++q) sc[0][q] = (f32x4){0.f, 0.f, 0.f, 0.f};
        wave_mm_nt<1, TPW>(sc, QS + it * 16 * LDQ, LDQ, KS + jt0 * 16 * LDQ, LDQ, DK, fr, fq);
        const int i = it * 16 + fr;
#pragma unroll
        for (int q = 0; q < TPW; ++q) { float p[4];
#pragma unroll
            for (int r = 0; r < 4; ++r) { const int j = (jt0 + q) * 16 + 4 * fq + r; float v = sc[0][q][r]; if (!HG) v *= __expf((float)(i - j) * logg); p[r] = (j <= i) ? v : 0.f; }
            u32x2 pw; pw.x = pk2(p[0], p[1]); pw.y = pk2(p[2], p[3]); *(LAS u32x2*)(PS + i * LDT + (jt0 + q) * 16 + 4 * fq) = pw; }
    }
    __syncthreads();
    const int it = w % NIT, eg = w / NIT;
    f32x4 o[1][ET];
#pragma unroll
    for (int q = 0; q < ET; ++q) o[0][q] = (f32x4){0.f, 0.f, 0.f, 0.f};
    wave_mm_nt<1, ET>(o, PS + it * 16 * LDT, LDT, VT + eg * ET * 16 * LDT, LDT, L, fr, fq);
    wave_mm_nt<1, ET>(o, QG + it * 16 * LDQ, LDQ, STl + eg * ET * 16 * LDQ, LDQ, DK, fr, fq);
    float ss = 0.f;
#pragma unroll
    for (int q = 0; q < ET; ++q) ss += (o[0][q][0] * o[0][q][0] + o[0][q][1] * o[0][q][1]) + (o[0][q][2] * o[0][q][2] + o[0][q][3] * o[0][q][3]);
    ss += __shfl_xor(ss, 16); ss += __shfl_xor(ss, 32);
    const int i = it * 16 + fr;
    if (fq == 0) RED[i * 4 + eg] = ss;
    __syncthreads();
    float tot = 0.f;
#pragma unroll
    for (int q = 0; q < WPI; ++q) tot += RED[i * 4 + q];
    const float rstd = 1.f / sqrtf(tot * (1.f / 128.f) + NORM_EPS);
    const bf16_t* Z = (const bf16_t*)(F.ws + WS_Z); bf16_t* O = (bf16_t*)(F.ws + WS_XN);
    const size_t row = (size_t)(r0 + i);
#pragma unroll
    for (int q = 0; q < ET; ++q) { const int e = (eg * ET + q) * 16 + 4 * fq; const u32x2 gw = *(const u32x2*)(Z + row * ABIN + (HG ? 3072 : 1024) + h * 128 + e);
        const float g4[4] = {bflo(gw.x), bfhi(gw.x), bflo(gw.y), bfhi(gw.y)}; float ov[4];
#pragma unroll
        for (int r = 0; r < 4; ++r) { if (HG) ov[r] = o[0][q][r] * rstd * F.in[I_HGNG][m * 128 + e + r] * sigmoidf_(g4[r]); else ov[r] = o[0][q][r] * rstd * siluf_(g4[r]); }
        u32x2 ow; ow.x = pk2(ov[0], ov[1]); ow.y = pk2(ov[2], ov[3]); *(u32x2*)(O + row * D + (HG ? 512 : 0) + h * 128 + e) = ow; }
}

template <bool DRY = false> __device__ __forceinline__ void ab_scan(Frame& F, int layer) {
    const int tid = otid(); const int lane = tid & 63; (void)lane;
    const int m = layer >> 1;
    unsigned* ST32 = (unsigned*)(F.ws + WS_STATE); const float* DEC = (const float*)(F.ws + WS_DEC);
    constexpr int NP = SLOT_E / 2;
    const int gt = F.vcu * NT + tid;
    if (gt < NP) {
        const int eo = 2 * gt; const bool hg = eo >= 32768; const int eo2 = hg ? eo - 32768 : eo; const int head = hg ? eo2 >> 14 : eo2 >> 13; const int cch = hg ? (eo2 & 127) : (eo2 & 63); const int e = hg ? ((eo2 & 16383) >> 7) : ((eo2 & 8191) >> 6);
        const float gdec = hg ? 0.f : __expf(64.f * log1pf(-exp2f(-5.f - (float)head)));
        float s0 = 0.f, s1 = 0.f;
        for (int c0 = 0; c0 < 256; c0 += 32) {
            unsigned kv[32]; float d0[32], d1[32];
#pragma unroll
            for (int u = 0; u < 32; ++u) { kv[u] = ST32[(size_t)(c0 + u) * NP + gt]; if (hg) { const f32x2 dd = *(const f32x2*)(DEC + ((size_t)(c0 + u) * 4 + head) * 128 + cch); d0[u] = dd.x; d1[u] = dd.y; } else { d0[u] = gdec; d1[u] = gdec; } }
#pragma unroll
            for (int u = 0; u < 32; ++u) { const unsigned pw = pk2(s0, s1); if constexpr (DRY) asm volatile("" :: "v"(pw)); else ST32[(size_t)(c0 + u) * NP + gt] = pw; s0 = d0[u] * s0 + bflo(kv[u]); s1 = d1[u] * s1 + bfhi(kv[u]); }
        }
        float* outp = hg ? F.out + O_HGP + (size_t)m * 65536 + head * 16384 : F.out + O_RETP + (size_t)m * 32768 + head * 8192;
        outp[(size_t)cch * 128 + e] = s0; outp[(size_t)(cch + 1) * 128 + e] = s1;
    } else {
        const int NG2 = F.G * NT - NP; if (NG2 <= 0) return;
        for (int idx = gt - NP; idx < 32 * NP; idx += NG2) { const int b = idx / NP, pr = idx % NP;
            const int eo = 2 * pr; const bool hg = eo >= 32768; const int eo2 = hg ? eo - 32768 : eo; const int head = hg ? eo2 >> 14 : eo2 >> 13; const int cch = hg ? (eo2 & 127) : (eo2 & 63); const int e = hg ? ((eo2 & 16383) >> 7) : ((eo2 & 8191) >> 6);
            float d0, d1; if (hg) { const f32x2 dd = *(const f32x2*)(DEC + ((size_t)(256 + b) * 4 + head) * 128 + cch); d0 = dd.x; d1 = dd.y; } else { d0 = d1 = __expf(32.f * log1pf(-exp2f(-5.f - (float)head))); }
            const size_t so = hg ? ((size_t)(m * 32 + b) * 4 + head) * 16384 : ((size_t)(m * 32 + b) * 4 + head) * 8192;
            const float* sin_ = (hg ? F.in[I_SHG] : F.in[I_SRET]) + so; float* sout = F.out + (hg ? O_HGS : O_RETS) + so;
            const float i0 = sin_[(size_t)cch * 128 + e], i1 = sin_[(size_t)(cch + 1) * 128 + e];
            const unsigned kv = ST32[(size_t)(256 + b) * NP + pr]; if constexpr (!DRY) ST32[(size_t)(256 + b) * NP + pr] = pk2(i0, i1);
            sout[(size_t)cch * 128 + e] = d0 * i0 + bflo(kv); sout[(size_t)(cch + 1) * 128 + e] = d1 * i1 + bfhi(kv); }
    }
}

constexpr int RL_AT = 0, RL_RT = 9216, RL_BT = 18432, RL_KT = 27648, RL_BHT = 36864, RL_KHT = 46080, RL_VT = 55296, RL_AAB = 64512, RL_AAK = 81920, RL_ARB = 91136, RL_ARK = 100352,
              RL_U0T = 109568, RL_VEC = 118784, RL_PSUM = 119808;
constexpr int RL_G = RL_AAB, RL_WW = RL_BT, RL_APT = RL_AAK;
constexpr int RL_PL = RL_AT, RL_RL = RL_BT, RL_Y0L = RL_BT + 4608, RL_QTL = RL_AAB, RL_S = RL_BHT;
__device__ __forceinline__ int pperm(int k) { return 32 * (k >> 5) + 8 * ((k >> 2) & 3) + 4 * ((k >> 4) & 1) + (k & 3); }

struct OutSide { u32x2 vv[4], gg[4]; f32x4 lg[4], lb[4]; float bon; };
__device__ __forceinline__ void rwkv_out_side(Frame& F, int m, size_t row, int h, int fq, OutSide& o) {
    const bf16_t* RKV = (const bf16_t*)(F.ws + WS_RKV); const bf16_t* GG = (const bf16_t*)(F.ws + WS_G); const float* BON = (const float*)(F.ws + WS_BON);
    o.bon = BON[row * 16 + h];
#pragma unroll
    for (int nt = 0; nt < 4; ++nt) { const int i = h * 64 + 16 * nt + 4 * fq;
        o.lg[nt] = *(const f32x4*)(F.in[I_RLNG] + m * D + i); o.lb[nt] = *(const f32x4*)(F.in[I_RLNB] + m * D + i);
        o.vv[nt] = *(const u32x2*)(RKV + row * 3072 + 2048 + i); o.gg[nt] = *(const u32x2*)(GG + row * D + i); }
}
template <bool DRY = false> __device__ __forceinline__ void rwkv_out_core(Frame& F, const f32x4 (&y)[4], size_t row, int h, int fq, const OutSide& sd) {
    bf16_t* RKV = (bf16_t*)(F.ws + WS_RKV);
    float s1 = 0.f;
#pragma unroll
    for (int nt = 0; nt < 4; ++nt) s1 += (y[nt][0] + y[nt][1]) + (y[nt][2] + y[nt][3]);
    s1 += __shfl_xor(s1, 16); s1 += __shfl_xor(s1, 32);
    const float mean = s1 * (1.f / 64.f); float s2 = 0.f;
#pragma unroll
    for (int nt = 0; nt < 4; ++nt)
#pragma unroll
        for (int r = 0; r < 4; ++r) { const float d = y[nt][r] - mean; s2 += d * d; }
    s2 += __shfl_xor(s2, 16); s2 += __shfl_xor(s2, 32);
    const float rstd = 1.f / sqrtf(s2 * (1.f / 64.f) + RW_LN_EPS), bon = sd.bon;
#pragma unroll
    for (int nt = 0; nt < 4; ++nt) { const int i = h * 64 + 16 * nt + 4 * fq; const f32x4 lg = sd.lg[nt], lb = sd.lb[nt]; const u32x2 vv = sd.vv[nt], gg = sd.gg[nt];
        const float v4[4] = {bflo(vv.x), bfhi(vv.x), bflo(vv.y), bfhi(vv.y)}, g4[4] = {bflo(gg.x), bfhi(gg.x), bflo(gg.y), bfhi(gg.y)}; float o[4];
#pragma unroll
        for (int r = 0; r < 4; ++r) o[r] = ((y[nt][r] - mean) * rstd * lg[r] + lb[r] + bon * v4[r]) * g4[r];
        u32x2 w; w.x = pk2(o[0], o[1]); w.y = pk2(o[2], o[3]); if constexpr (DRY) asm volatile("" :: "v"(w.x), "v"(w.y)); else *(u32x2*)(RKV + row * 3072 + i) = w; }
}
template <bool DRY = false> __device__ __forceinline__ void rwkv_out_epilogue(Frame& F, int m, const f32x4 (&y)[4], size_t row, int h, int fq) {
    OutSide sd; rwkv_out_side(F, m, row, h, fq, sd); rwkv_out_core<DRY>(F, y, row, h, fq, sd);
}

template <int MT, int NTT, bool XS, bool YS> __device__ __forceinline__ void wave_mm_nt72(f32x4 (&acc)[MT][NTT], const LAS bf16_t* X, int xr0, const LAS bf16_t* Y, int yr0, int K, int fr, int fq) {
    for (int k0 = 0; k0 < K; k0 += 32) { const int ch = (k0 >> 3) + fq;
        bf16x8 xa[MT], yb[NTT];
#pragma unroll
        for (int i = 0; i < MT; ++i) { const int row = xr0 + 16 * i + fr; xa[i] = *(const LAS bf16x8*)(X + row * 72 + 8 * (XS ? (ch ^ ((row >> 3) & 7)) : ch)); }
#pragma unroll
        for (int j = 0; j < NTT; ++j) { const int row = yr0 + 16 * j + fr; yb[j] = *(const LAS bf16x8*)(Y + row * 72 + 8 * (YS ? (ch ^ ((row >> 3) & 7)) : ch)); }
#pragma unroll
        for (int i = 0; i < MT; ++i)
#pragma unroll
            for (int j = 0; j < NTT; ++j) acc[i][j] = __builtin_amdgcn_mfma_f32_16x16x32_bf16(yb[j], xa[i], acc[i][j], 0, 0, 0);
    }
}
typedef short s16x4 __attribute__((ext_vector_type(4)));
__device__ __forceinline__ s16x4 pack4(const f32x4& v) { u32x2 p; p.x = pk2(v[0], v[1]); p.y = pk2(v[2], v[3]); return __builtin_bit_cast(s16x4, p); }
template <int S> struct TinvStep {
    static __device__ __forceinline__ void run(float (&y)[16], f32x4 (&nq)[3][4], const LAS float* dp) {
        if constexpr (S >= 1) {
            if constexpr (S - 2 >= 1) {
#pragma unroll
                for (int k = 0; k < (S - 2 + 3) / 4; ++k) nq[(S - 2) % 3][k] = *(const LAS f32x4*)(dp + (S - 2) * 20 + 4 * k);
            }
            const float ys = y[S];
#pragma unroll
            for (int q = S - 1; q >= 0; --q) { y[q] += nq[S % 3][q >> 2][q & 3] * ys; asm volatile("" : "+v"(y[q])); }
            asm volatile("" ::: "memory");
            TinvStep<S - 1>::run(y, nq, dp);
        }
    }
};
#define RAW_CONSUME(q) asm volatile("" :: "v"((q).r), "v"((q).k), "v"((q).v), "v"((q).w), "v"((q).a), "v"((q).kk[0]), "v"((q).kk[1]), "v"((q).ka[0]), "v"((q).ka[1]), "v"((q).rk[0]), "v"((q).rk[1]) : "memory")
struct RawRegs { u32x4 r, k, v, w, a; f32x4 kk[2], ka[2], rk[2]; };
__device__ __forceinline__ void rwkv_load_raw(Frame& F, int m, int u, int tid, RawRegs& raw) {
    const int c = u >> 4, h = u & 15; int r0, pos0; chunk_geom(c, r0, pos0); const int L = c < 256 ? 64 : 32; int t = tid >> 3; t = t < L ? t : 0;
    const bf16_t* RKV = (const bf16_t*)(F.ws + WS_RKV); const bf16_t* WLOG = (const bf16_t*)(F.ws + WS_WLOG); const bf16_t* AA = (const bf16_t*)(F.ws + WS_XN);
    const size_t row = (size_t)(r0 + t); const int col = h * 64 + 8 * (tid & 7);
    raw.r = *(const u32x4*)(RKV + row * 3072 + col); raw.k = *(const u32x4*)(RKV + row * 3072 + 1024 + col); raw.v = *(const u32x4*)(RKV + row * 3072 + 2048 + col);
    raw.w = *(const u32x4*)(WLOG + row * D + col); raw.a = *(const u32x4*)(AA + row * D + col);
    const float* kkp = F.in[I_RKK] + m * D + col; const float* kap = F.in[I_RKA] + m * D + col; const float* rkp = F.in[I_RRK] + m * D + col;
    raw.kk[0] = *(const f32x4*)kkp; raw.kk[1] = *(const f32x4*)(kkp + 4); raw.ka[0] = *(const f32x4*)kap; raw.ka[1] = *(const f32x4*)(kap + 4); raw.rk[0] = *(const f32x4*)rkp; raw.rk[1] = *(const f32x4*)(rkp + 4);
}
template <int L, bool DRY = false> __device__ __forceinline__ void rwkv_local_unit(Frame& F, int layer, int c, int h, RawRegs& raw, int unext) {
    const int tid = otid(); const int lane = tid & 63, fr = lane & 15, fq = lane >> 4, w = F.wave;
    constexpr int NIT = L / 16; constexpr bool SAMPLE = (L == 32);
    const int m = layer >> 1; int r0, pos0; chunk_geom(c, r0, pos0);
    bf16_t* RKV = (bf16_t*)(F.ws + WS_RKV); const bf16_t* WLOG = (const bf16_t*)(F.ws + WS_WLOG); const bf16_t* AA = (const bf16_t*)(F.ws + WS_XN);
    LAS bf16_t* AT = (LAS bf16_t*)(F.lds + RL_AT); LAS bf16_t* RT = (LAS bf16_t*)(F.lds + RL_RT); LAS bf16_t* BT = (LAS bf16_t*)(F.lds + RL_BT); LAS bf16_t* KT = (LAS bf16_t*)(F.lds + RL_KT);
    LAS bf16_t* BHT = (LAS bf16_t*)(F.lds + RL_BHT); LAS bf16_t* KHT = (LAS bf16_t*)(F.lds + RL_KHT); LAS bf16_t* VT = (LAS bf16_t*)(F.lds + RL_VT);
    LAS bf16_t* AABH = (LAS bf16_t*)(F.lds + RL_AAB); LAS float* DIAG = (LAS float*)(F.lds + RL_AAB + 9216); LAS bf16_t* TINV = (LAS bf16_t*)(F.lds + RL_AAB + 14336); LAS bf16_t* AAK = (LAS bf16_t*)(F.lds + RL_AAK); LAS bf16_t* ARB = (LAS bf16_t*)(F.lds + RL_ARB); LAS bf16_t* ARK = (LAS bf16_t*)(F.lds + RL_ARK);
    LAS bf16_t* U0T = (LAS bf16_t*)(F.lds + RL_U0T); LAS float* GMID = (LAS float*)(F.lds + RL_VEC); LAS float* GLV = GMID + 64; LAS float* EGM = GMID + 128; LAS float* EGL = GMID + 192; LAS float* PSUM = (LAS float*)(F.lds + RL_PSUM);
    LAS float* G = (LAS float*)(F.lds + RL_G); LAS float* WW = (LAS float*)(F.lds + RL_WW); LAS bf16_t* APT = (LAS bf16_t*)(F.lds + RL_APT);
    __syncthreads();
    const int t = tid >> 3, c8 = tid & 7; const bool act = t < L;
    float rr[8], kkv[8], bb[8], kh[8]; u32x4 vraw = {0u, 0u, 0u, 0u};
    if (act) { const size_t row = (size_t)(r0 + t); const int col = h * 64 + 8 * c8;
        const u32x4 r4 = raw.r, k4 = raw.k, v4 = raw.v, w4 = raw.w, a4 = raw.a;
        const f32x4 kkq[2] = {raw.kk[0], raw.kk[1]}, kaq[2] = {raw.ka[0], raw.ka[1]}, rkq[2] = {raw.rk[0], raw.rk[1]};
        float ss = 0.f, bon = 0.f;
#pragma unroll
        for (int e = 0; e < 8; ++e) { const float kx = (e & 1) ? bfhi(k4[e >> 1]) : bflo(k4[e >> 1]), al = (e & 1) ? bfhi(a4[e >> 1]) : bflo(a4[e >> 1]);
            rr[e] = (e & 1) ? bfhi(r4[e >> 1]) : bflo(r4[e >> 1]);
            kkv[e] = kx * kkq[e >> 2][e & 3]; ss += kkv[e] * kkv[e]; kh[e] = kx * (1.f + (al - 1.f) * kaq[e >> 2][e & 3]); bb[e] = al; bon += rr[e] * kh[e] * rkq[e >> 2][e & 3];
        }
        vraw = v4;
        *(LAS f32x4*)(G + t * 64 + 8 * c8) = (f32x4){bflo(w4.x), bfhi(w4.x), bflo(w4.y), bfhi(w4.y)}; *(LAS f32x4*)(G + t * 64 + 8 * c8 + 4) = (f32x4){bflo(w4.z), bfhi(w4.z), bflo(w4.w), bfhi(w4.w)};
        ss += __shfl_xor(ss, 1); ss += __shfl_xor(ss, 2); ss += __shfl_xor(ss, 4); bon += __shfl_xor(bon, 1); bon += __shfl_xor(bon, 2); bon += __shfl_xor(bon, 4);
        const float inv = 1.f / fmaxf(sqrtf(ss), 1e-12f);
#pragma unroll
        for (int e = 0; e < 8; ++e) { kkv[e] *= inv; bb[e] *= kkv[e]; }
        if (c8 == 0) ((float*)(F.ws + WS_BON))[row * 16 + h] = bon; }
    if (unext >= 0) rwkv_load_raw(F, m, unext, tid, raw);
    __syncthreads();
    { constexpr int TE = L / 8; const int j = tid & 63, e8 = tid >> 6; float cs[TE]; float run = 0.f;
#pragma unroll
      for (int q = 0; q < TE; ++q) { run += G[(e8 * TE + q) * 64 + j]; cs[q] = run; }
      PSUM[e8 * 64 + j] = run;
      __syncthreads();
      float off = 0.f, gm = 0.f, gl = 0.f;
#pragma unroll
      for (int q = 0; q < 8; ++q) { const float p = PSUM[q * 64 + j]; if (q < e8) off += p; if (q < 4) gm += p; gl += p; }
#pragma unroll
      for (int q = 0; q < TE; ++q) G[(e8 * TE + q) * 64 + j] = off + cs[q];
      if (e8 == 0) { GMID[j] = gm; GLV[j] = gl; EGM[j] = __expf(gm); EGL[j] = __expf(gl - gm); if (!SAMPLE) ((float*)(F.ws + WS_REC + ((size_t)h * 256 + c) * REC_B + 16384))[j] = __expf(gl); } }
    __syncthreads();
    if (act) { float fa[8], fr_[8], fb[8], fk[8]; const int tsw = 8 * ((t >> 3) ^ c8) + (t & 7);
        const int tp = t > 0 ? t - 1 : 0; f32x4 g4[2], p4[2], m4[2], l4[2];
#pragma unroll
        for (int hf = 0; hf < 2; ++hf) { g4[hf] = *(const LAS f32x4*)(G + t * 64 + 8 * c8 + 4 * hf); p4[hf] = *(const LAS f32x4*)(G + tp * 64 + 8 * c8 + 4 * hf);
            m4[hf] = *(const LAS f32x4*)(GMID + 8 * c8 + 4 * hf); l4[hf] = *(const LAS f32x4*)(EGL + 8 * c8 + 4 * hf); }
#pragma unroll
        for (int e = 0; e < 8; ++e) { const int j = 8 * c8 + e; const float g = g4[e >> 2][e & 3], gp = (t > 0) ? p4[e >> 2][e & 3] : 0.f, gm = m4[e >> 2][e & 3];
            const float ed = __expf(gm - g), eu = __expf(g - gm), el = ed * l4[e >> 2][e & 3];
            fa[e] = -kkv[e] * __expf(gp - gm); fr_[e] = rr[e] * eu; fb[e] = bb[e] * ed; fk[e] = kh[e] * ed;
            const unsigned bk = pk2(bb[e] * el, kh[e] * el), vb = vraw[e >> 1];
            BHT[j * 72 + tsw] = (bf16_t)(bk & 0xffffu); KHT[j * 72 + tsw] = (bf16_t)(bk >> 16); VT[j * 72 + tsw] = (bf16_t)((e & 1) ? (vb >> 16) : (vb & 0xffffu)); }
        u32x4 p;
        p.x = pk2(fa[0], fa[1]); p.y = pk2(fa[2], fa[3]); p.z = pk2(fa[4], fa[5]); p.w = pk2(fa[6], fa[7]); *(LAS u32x4*)(AT + t * 72 + 8 * c8) = p;
        p.x = pk2(fr_[0], fr_[1]); p.y = pk2(fr_[2], fr_[3]); p.z = pk2(fr_[4], fr_[5]); p.w = pk2(fr_[6], fr_[7]); *(LAS u32x4*)(RT + t * 72 + 8 * c8) = p;
        p.x = pk2(fb[0], fb[1]); p.y = pk2(fb[2], fb[3]); p.z = pk2(fb[4], fb[5]); p.w = pk2(fb[6], fb[7]); *(LAS u32x4*)(BT + t * 72 + 8 * c8) = p;
        p.x = pk2(fk[0], fk[1]); p.y = pk2(fk[2], fk[3]); p.z = pk2(fk[4], fk[5]); p.w = pk2(fk[6], fk[7]); *(LAS u32x4*)(KT + t * 72 + 8 * c8) = p; }
    __syncthreads();
    if constexpr (DRY && (LOCAL_SKIP & 2)) return;
    { constexpr int TPW = (NIT * NIT >= 8) ? NIT * NIT / 8 : 1;
      if (w * TPW < NIT * NIT) { const int it = (w * TPW) / NIT, jt0 = (w * TPW) % NIT;
          f32x4 ab[1][TPW], ak[1][TPW], rb[1][TPW], rk[1][TPW];
#pragma unroll
          for (int q = 0; q < TPW; ++q) { ab[0][q] = (f32x4){0.f, 0.f, 0.f, 0.f}; ak[0][q] = ab[0][q]; rb[0][q] = ab[0][q]; rk[0][q] = ab[0][q]; }
          wave_mm_nt<1, TPW>(ab, AT + it * 16 * 72, 72, BT + jt0 * 16 * 72, 72, 64, fr, fq); wave_mm_nt<1, TPW>(ak, AT + it * 16 * 72, 72, KT + jt0 * 16 * 72, 72, 64, fr, fq);
          wave_mm_nt<1, TPW>(rb, RT + it * 16 * 72, 72, BT + jt0 * 16 * 72, 72, 64, fr, fq); wave_mm_nt<1, TPW>(rk, RT + it * 16 * 72, 72, KT + jt0 * 16 * 72, 72, 64, fr, fq);
          const int tt = it * 16 + fr;
#pragma unroll
          for (int q = 0; q < TPW; ++q) { const int s0 = (jt0 + q) * 16 + 4 * fq; f32x4 fab; float fak[4], frb[4], frk[4];
#pragma unroll
              for (int r = 0; r < 4; ++r) { const int sx = s0 + r; fab[r] = (sx < tt) ? ab[0][q][r] : 0.f; fak[r] = (sx < tt) ? ak[0][q][r] : 0.f; frb[r] = (sx <= tt) ? rb[0][q][r] : 0.f; frk[r] = (sx <= tt) ? rk[0][q][r] : 0.f; }
              u32x2 p; p.x = pk2(fab[0], fab[1]); p.y = pk2(fab[2], fab[3]); *(LAS u32x2*)(AABH + tt * 72 + s0) = p;
              if (jt0 + q == it) *(LAS f32x4*)(DIAG + tt * 20 + 4 * fq) = fab;
              p.x = pk2(fak[0], fak[1]); p.y = pk2(fak[2], fak[3]); *(LAS u32x2*)(AAK + tt * 72 + s0) = p;
              p.x = pk2(frb[0], frb[1]); p.y = pk2(frb[2], frb[3]); *(LAS u32x2*)(ARB + tt * 72 + s0) = p;
              p.x = pk2(frk[0], frk[1]); p.y = pk2(frk[2], frk[3]); *(LAS u32x2*)(ARK + tt * 72 + s0) = p; } } }
    __syncthreads();
    constexpr int NB = L / 16;
    f32x4 rhs[1][NB];
    if (w >= 4) {
#pragma unroll
        for (int b = 0; b < NB; ++b) rhs[0][b] = (f32x4){0.f, 0.f, 0.f, 0.f};
        wave_mm_nt72<1, NB, true, false>(rhs, VT, (w - 4) * 16, AAK, 0, L, fr, fq);
    } else { const int cc = w * 16 + fr; const float eg = EGM[cc];
#pragma unroll
        for (int b = 0; b < NB; ++b)
#pragma unroll
            for (int r = 0; r < 4; ++r) rhs[0][b][r] = bf2f(AT[(16 * b + 4 * fq + r) * 72 + cc]) * eg; }
    if (w == 0) {
        float y[16]; f32x4 nq[3][4]; const LAS float* dp = DIAG + 16 * fq * 20;
#pragma unroll
        for (int q = 0; q < 16; ++q) y[q] = (q == fr) ? 1.f : 0.f;
#pragma unroll
        for (int k = 0; k < 4; ++k) { nq[15 % 3][k] = *(const LAS f32x4*)(dp + 15 * 20 + 4 * k); nq[14 % 3][k] = *(const LAS f32x4*)(dp + 14 * 20 + 4 * k); }
        TinvStep<15>::run(y, nq, dp);
        if (fq < NB) { u32x4 p; LAS bf16_t* tp = TINV + (16 * fq + fr) * 24;
            p.x = pk2(y[0], y[1]); p.y = pk2(y[2], y[3]); p.z = pk2(y[4], y[5]); p.w = pk2(y[6], y[7]); *(LAS u32x4*)tp = p;
            p.x = pk2(y[8], y[9]); p.y = pk2(y[10], y[11]); p.z = pk2(y[12], y[13]); p.w = pk2(y[14], y[15]); *(LAS u32x4*)(tp + 8) = p; } }
    __syncthreads();
    { s16x4 xb[NB], ti[NB], pa[NB][NB]; LAS bf16_t* dst = ((w < 4) ? APT : U0T) + ((w & 3) * 16 + fr) * 72 + 4 * fq;
#pragma unroll
      for (int bi = 0; bi < NB; ++bi) { ti[bi] = *(const LAS s16x4*)(TINV + (16 * bi + fr) * 24 + 4 * fq);
#pragma unroll
          for (int bj = 0; bj < bi; ++bj) pa[bi][bj] = *(const LAS s16x4*)(AABH + (16 * bi + fr) * 72 + 16 * bj + 4 * fq); }
#pragma unroll
      for (int bi = 0; bi < NB; ++bi) { f32x4 acc = rhs[0][bi];
#pragma unroll
          for (int bj = 0; bj < bi; ++bj) acc = __builtin_amdgcn_mfma_f32_16x16x16bf16_1k(pa[bi][bj], xb[bj], acc, 0, 0, 0);
          const f32x4 xa = __builtin_amdgcn_mfma_f32_16x16x16bf16_1k(ti[bi], pack4(acc), (f32x4){0.f, 0.f, 0.f, 0.f}, 0, 0, 0);
          xb[bi] = pack4(xa); }
#pragma unroll
      for (int bi = 0; bi < NB; ++bi) *(LAS s16x4*)(dst + 16 * bi) = xb[bi]; }
    __syncthreads();
    RAW_CONSUME(raw);
    { const int mt = w >> 1, nt0 = (w & 1) * 2;
      f32x4 pp[1][2], qt[1][2];
#pragma unroll
      for (int q = 0; q < 2; ++q) { pp[0][q] = (f32x4){0.f, 0.f, 0.f, 0.f}; qt[0][q] = pp[0][q]; }
      wave_mm_nt72<1, 2, true, false>(pp, BHT, mt * 16, APT, nt0 * 16, L, fr, fq);
      wave_mm_nt72<1, 2, false, true>(qt, U0T, mt * 16, BHT, nt0 * 16, L, fr, fq); wave_mm_nt72<1, 2, true, true>(qt, VT, mt * 16, KHT, nt0 * 16, L, fr, fq);
      constexpr int TP5 = NIT / 2; const int it = (w * TP5) / 4, rn0 = (w * TP5) % 4;
      f32x4 rp[1][TP5], y0[1][TP5];
#pragma unroll
      for (int q = 0; q < TP5; ++q) { const int j = (rn0 + q) * 16 + 4 * fq; const u32x2 rw = *(const LAS u32x2*)(RT + (it * 16 + fr) * 72 + j); const f32x4 e4 = *(const LAS f32x4*)(EGM + j);
          rp[0][q] = (f32x4){bflo(rw.x) * e4[0], bfhi(rw.x) * e4[1], bflo(rw.y) * e4[2], bfhi(rw.y) * e4[3]}; y0[0][q] = (f32x4){0.f, 0.f, 0.f, 0.f}; }
      wave_mm_nt<1, TP5>(rp, ARB + it * 16 * 72, 72, APT + rn0 * 16 * 72, 72, L, fr, fq);
      wave_mm_nt<1, TP5>(y0, ARB + it * 16 * 72, 72, U0T + rn0 * 16 * 72, 72, L, fr, fq); wave_mm_nt72<1, TP5, false, true>(y0, ARK, it * 16, VT, rn0 * 16, L, fr, fq);
      if constexpr (!SAMPLE) {
          bf16_t* PP = (bf16_t*)(F.ws + WS_REC + ((size_t)h * 256 + c) * REC_B); bf16_t* QQ = PP + 4096;
#pragma unroll
          for (int q = 0; q < 2; ++q) { const int n0 = (nt0 + q) * 16 + 4 * fq; u32x2 p; p.x = pk2(pp[0][q][0], pp[0][q][1]); p.y = pk2(pp[0][q][2], pp[0][q][3]);
              *(u32x2*)(PP + (mt * 16 + fr) * 64 + pperm(n0)) = p;
              p.x = pk2(qt[0][q][0], qt[0][q][1]); p.y = pk2(qt[0][q][2], qt[0][q][3]); *(u32x2*)(QQ + (mt * 16 + fr) * 64 + n0) = p; }
#pragma unroll
          for (int q = 0; q < TP5; ++q) { const size_t row = (size_t)(r0 + it * 16 + fr); const int n0 = (rn0 + q) * 16 + 4 * fq; u32x2 p;
              p.x = pk2(rp[0][q][0], rp[0][q][1]); p.y = pk2(rp[0][q][2], rp[0][q][3]); if constexpr (DRY) asm volatile("" :: "v"(p.x), "v"(p.y)); else *(u32x2*)(RKV + row * 3072 + 1024 + h * 64 + n0) = p;
              p.x = pk2(y0[0][q][0], y0[0][q][1]); p.y = pk2(y0[0][q][2], y0[0][q][3]); if constexpr (DRY) asm volatile("" :: "v"(p.x), "v"(p.y)); else *(u32x2*)(RKV + row * 3072 + h * 64 + n0) = p; }
      } else {
          __syncthreads();
          LAS bf16_t* PL = (LAS bf16_t*)(F.lds + RL_PL); LAS bf16_t* RLs = (LAS bf16_t*)(F.lds + RL_RL); LAS float* Y0L = (LAS float*)(F.lds + RL_Y0L); LAS float* QTL = (LAS float*)(F.lds + RL_QTL); LAS bf16_t* Sl = (LAS bf16_t*)(F.lds + RL_S);
#pragma unroll
          for (int q = 0; q < 2; ++q) { const int n0 = (nt0 + q) * 16 + 4 * fq; u32x2 p; p.x = pk2(pp[0][q][0], pp[0][q][1]); p.y = pk2(pp[0][q][2], pp[0][q][3]);
              *(LAS u32x2*)(PL + (mt * 16 + fr) * 72 + n0) = p; *(LAS f32x4*)(QTL + (mt * 16 + fr) * 68 + n0) = qt[0][q]; }
#pragma unroll
          for (int q = 0; q < TP5; ++q) { const int n0 = (rn0 + q) * 16 + 4 * fq; u32x2 p; p.x = pk2(rp[0][q][0], rp[0][q][1]); p.y = pk2(rp[0][q][2], rp[0][q][3]);
              *(LAS u32x2*)(RLs + (it * 16 + fr) * 72 + n0) = p; *(LAS f32x4*)(Y0L + (it * 16 + fr) * 68 + n0) = y0[0][q]; }
          const int sb = c - 256; const float* sin_ = F.in[I_SWKV] + (((size_t)m * 32 + sb) * 16 + h) * 4096; float* sout = F.out + O_WKVS + (((size_t)m * 32 + sb) * 16 + h) * 4096;
          for (int it2 = tid; it2 < 64 * 16; it2 += NT) { const int i = it2 >> 4, j4 = (it2 & 15) * 4; const f32x4 sv = *(const f32x4*)(sin_ + i * 64 + j4); u32x2 p; p.x = pk2(sv[0], sv[1]); p.y = pk2(sv[2], sv[3]); *(LAS u32x2*)(Sl + i * 72 + j4) = p; }
          __syncthreads();
          if (w < 2) { f32x4 y[1][4];
#pragma unroll
              for (int q = 0; q < 4; ++q) y[0][q] = *(const LAS f32x4*)(Y0L + (w * 16 + fr) * 68 + q * 16 + 4 * fq);
              wave_mm_nt<1, 4>(y, RLs + w * 16 * 72, 72, Sl, 72, 64, fr, fq);
              rwkv_out_epilogue<DRY>(F, m, y[0], (size_t)(r0 + w * 16 + fr), h, fq); }
          else if (w < 6) { const int mi = w - 2; f32x4 tl[1][4];
#pragma unroll
              for (int q = 0; q < 4; ++q) { const int j = q * 16 + 4 * fq; const f32x4 sv = *(const f32x4*)(sin_ + (mi * 16 + fr) * 64 + j), gl4 = *(const LAS f32x4*)(GLV + j), qv = *(const LAS f32x4*)(QTL + (mi * 16 + fr) * 68 + j);
                  tl[0][q] = (f32x4){__expf(gl4[0]) * sv[0] + qv[0], __expf(gl4[1]) * sv[1] + qv[1], __expf(gl4[2]) * sv[2] + qv[2], __expf(gl4[3]) * sv[3] + qv[3]}; }
              wave_mm_nt<1, 4>(tl, Sl + mi * 16 * 72, 72, PL, 72, 64, fr, fq);
#pragma unroll
              for (int q = 0; q < 4; ++q) *(f32x4*)(sout + (mi * 16 + fr) * 64 + q * 16 + 4 * fq) = tl[0][q]; }
      }
    }
}

constexpr int SC_GRP = 4, SC_CH = 8192 + 2048 + 256, SC_LCH = 9216 + 2304 + 256, SC_LBUF = SC_GRP * SC_LCH;
template <int SKIP = 0> __device__ __forceinline__ void rwkv_scan_phase(Frame& F, int layer) {
    const int tid = otid(); const int lane = tid & 63, m = layer >> 1; const int b = blockIdx.x;
    if (b >= 64) {
        if constexpr (SKIP == 0) { const int nb = (int)F.G - 64; RawRegs raw; int u = 256 * 16 + (b - 64); if (u < NCHUNK * 16) { rwkv_load_raw(F, layer >> 1, u, tid, raw); RAW_CONSUME(raw); }
            for (; u < NCHUNK * 16; u += nb) { const int un = (u + nb < NCHUNK * 16) ? u + nb : -1; rwkv_local_unit<32>(F, layer, u >> 4, u & 15, raw, un); }
            if (layer == 1) { __syncthreads(); mod_phase(F, 2, 4, b - 64, nb); } }
        return; }
    const int h = 2 * (b & 7) + (b >> 5), sl = (b >> 3) & 3;
    const unsigned char* REC = F.ws + WS_REC;
    constexpr int NG = 256 / SC_GRP, DEPTH = 4;
    static_assert(NG % DEPTH == 0, "scan groups vs prefetch depth");
    if (F.wave != 0) {
        constexpr int NV = SC_GRP * SC_CH / 16, NLT = NT - 64, NPT = (NV + NLT - 1) / NLT;
        struct RegSet { u32x4 v[NPT]; };
        RegSet sets[DEPTH];
        unsigned poff[NPT], pdst[NPT];
#pragma unroll
        for (int q = 0; q < NPT; ++q) { int v = (tid - 64) + q * NLT; v = v < NV ? v : NV - 1; const int cc = v / (SC_CH / 16), o = (v % (SC_CH / 16)) * 16;
            poff[q] = (unsigned)(cc * REC_B + o + (o >= 10240 ? 6144 : (o >= 8192 ? sl * 2048 : 0)));
            const int lo = (o < 8192) ? (o >> 7) * 144 + (o & 127) : (o < 10240) ? 9216 + ((o - 8192) >> 7) * 144 + ((o - 8192) & 127) : 9216 + 2304 + (o - 10240);
            pdst[q] = (unsigned)(cc * SC_LCH + lo); }
        auto issue = [&](int g, RegSet& st) { const unsigned char* gb = REC + ((size_t)h * 256 + g * SC_GRP) * REC_B;
#pragma unroll
            for (int q = 0; q < NPT; ++q) st.v[q] = *(const u32x4*)(gb + poff[q]); };
        auto commit = [&](int buf, const RegSet& st) {
#pragma unroll
            for (int q = 0; q < NPT; ++q) *(LAS u32x4*)(F.lds + buf * SC_LBUF + pdst[q]) = st.v[q]; };
        if (!(SKIP & 2)) {
#pragma unroll
            for (int d = 0; d < DEPTH; ++d) issue(d, sets[d]);
            commit(0, sets[0]); }
        for (int g0 = 0; g0 < NG; g0 += DEPTH) {
#pragma unroll
            for (int dd = 0; dd < DEPTH; ++dd) { const int g = g0 + dd;
                if (!(SKIP & 2)) { if (g > 0 && g + DEPTH - 1 < NG) issue(g + DEPTH - 1, sets[(dd + DEPTH - 1) % DEPTH]); }
                __syncthreads();
                __syncthreads();
                if (!(SKIP & 2)) { if (g + 1 < NG) commit((g + 1) & 1, sets[(dd + 1) % DEPTH]); } }
        }
    } else {
        const int ci = lane & 15, q4 = lane >> 4, i = 16 * sl + ci;
        f32x4 T[4];
#pragma unroll
        for (int mm = 0; mm < 4; ++mm) T[mm] = (f32x4){0.f, 0.f, 0.f, 0.f};
        bf16_t* TST = (bf16_t*)(F.ws + WS_TST);
        const unsigned pfo = (unsigned)(ci * 144 + q4 * 16);
        for (int g = 0; g < NG; ++g) {
            __syncthreads();
            if (!(SKIP & 1)) {
                const LAS unsigned char* base = F.lds + (g & 1) * SC_LBUF;
                bf16x8 pf[4][2];
#pragma unroll
                for (int mm = 0; mm < 4; ++mm)
#pragma unroll
                    for (int s = 0; s < 2; ++s) pf[mm][s] = *(const LAS bf16x8*)(base + pfo + mm * 2304 + s * 64);
#pragma unroll
                for (int cc = 0; cc < SC_GRP; ++cc) { const int c = g * SC_GRP + cc; const LAS unsigned char* cb = base + cc * SC_LCH;
                    bf16_t* tdst = TST + (((size_t)h * 256 + c) * 64 + i) * 64;
                    f32x4 gv[4]; u32x2 qv[4];
#pragma unroll
                    for (int mm = 0; mm < 4; ++mm) { const int j = 16 * mm + 4 * q4; gv[mm] = *(const LAS f32x4*)(cb + 9216 + 2304 + j * 4); qv[mm] = *(const LAS u32x2*)(cb + 9216 + ci * 144 + j * 2); }
                    bf16x8 pn[4][2];
                    if (cc + 1 < SC_GRP) {
#pragma unroll
                        for (int mm = 0; mm < 4; ++mm)
#pragma unroll
                            for (int s = 0; s < 2; ++s) pn[mm][s] = *(const LAS bf16x8*)(cb + SC_LCH + pfo + mm * 2304 + s * 64); }
                    bf16x8 Tf[2];
#pragma unroll
                    for (int mm = 0; mm < 4; ++mm) { u32x2 p; p.x = pk2(T[mm][0], T[mm][1]); p.y = pk2(T[mm][2], T[mm][3]); *(u32x2*)(tdst + 16 * mm + 4 * q4) = p;
                        Tf[mm >> 1][(mm & 1) * 4 + 0] = (short)(p.x & 0xffffu); Tf[mm >> 1][(mm & 1) * 4 + 1] = (short)(p.x >> 16); Tf[mm >> 1][(mm & 1) * 4 + 2] = (short)(p.y & 0xffffu); Tf[mm >> 1][(mm & 1) * 4 + 3] = (short)(p.y >> 16); }
#pragma unroll
                    for (int mm = 0; mm < 4; ++mm) {
                        f32x4 acc = (f32x4){gv[mm][0] * T[mm][0] + bflo(qv[mm].x), gv[mm][1] * T[mm][1] + bfhi(qv[mm].x), gv[mm][2] * T[mm][2] + bflo(qv[mm].y), gv[mm][3] * T[mm][3] + bfhi(qv[mm].y)};
                        acc = __builtin_amdgcn_mfma_f32_16x16x32_bf16(pf[mm][0], Tf[0], acc, 0, 0, 0); acc = __builtin_amdgcn_mfma_f32_16x16x32_bf16(pf[mm][1], Tf[1], acc, 0, 0, 0);
                        T[mm] = acc; }
                    if (cc + 1 < SC_GRP) {
#pragma unroll
                        for (int mm = 0; mm < 4; ++mm) { pf[mm][0] = pn[mm][0]; pf[mm][1] = pn[mm][1]; } }
                }
            }
            __syncthreads();
        }
        float* outp = F.out + O_WKVP + ((size_t)m * 16 + h) * 4096 + (size_t)i * 64;
#pragma unroll
        for (int mm = 0; mm < 4; ++mm) *(f32x4*)(outp + 16 * mm + 4 * q4) = T[mm];
    }
}

struct OutMain { u32x2 y0[4]; bf16x8 xa[2]; };
template <bool DRY = false> __device__ __forceinline__ void rwkv_output_phase(Frame& F, int layer) {
    const int tid = otid(); const int lane = tid & 63, fr = lane & 15, fq = lane >> 4, m = layer >> 1;
    const bf16_t* RKV = (const bf16_t*)(F.ws + WS_RKV); const bf16_t* TST = (const bf16_t*)(F.ws + WS_TST);
    const int gw = F.vcu * NWAVES + F.wave, NGW = F.G * NWAVES;
    for (int u = gw; u < 256 * 16; u += NGW) { const int h = u & 15, c = u >> 4; const bf16_t* ts = TST + ((size_t)h * 256 + c) * 4096;
        bf16x8 yb[2][4];
#pragma unroll
        for (int s = 0; s < 2; ++s)
#pragma unroll
            for (int nt = 0; nt < 4; ++nt) yb[s][nt] = *(const bf16x8*)(ts + (16 * nt + fr) * 64 + 32 * s + 8 * fq);
        f32x4 lgu[4], lbu[4];
#pragma unroll
        for (int nt = 0; nt < 4; ++nt) { const int i = h * 64 + 16 * nt + 4 * fq; lgu[nt] = *(const f32x4*)(F.in[I_RLNG] + m * D + i); lbu[nt] = *(const f32x4*)(F.in[I_RLNB] + m * D + i); }
        const bf16_t* GG = (const bf16_t*)(F.ws + WS_G); const float* BON = (const float*)(F.ws + WS_BON);
        auto issue = [&](int it, OutMain& mn, OutSide& sd) { const size_t row = (size_t)(64 * c + 16 * it + fr);
#pragma unroll
            for (int nt = 0; nt < 4; ++nt) mn.y0[nt] = *(const u32x2*)(RKV + row * 3072 + h * 64 + 16 * nt + 4 * fq);
#pragma unroll
            for (int s = 0; s < 2; ++s) mn.xa[s] = *(const bf16x8*)(RKV + row * 3072 + 1024 + h * 64 + 32 * s + 8 * fq);
            sd.bon = BON[row * 16 + h];
#pragma unroll
            for (int nt = 0; nt < 4; ++nt) { const int i = h * 64 + 16 * nt + 4 * fq; sd.vv[nt] = *(const u32x2*)(RKV + row * 3072 + 2048 + i); sd.gg[nt] = *(const u32x2*)(GG + row * D + i); } };
        auto compute = [&](int it, const OutMain& mn, OutSide& sd) { const size_t row = (size_t)(64 * c + 16 * it + fr); f32x4 y[4];
#pragma unroll
            for (int nt = 0; nt < 4; ++nt) y[nt] = (f32x4){bflo(mn.y0[nt].x), bfhi(mn.y0[nt].x), bflo(mn.y0[nt].y), bfhi(mn.y0[nt].y)};
#pragma unroll
            for (int s = 0; s < 2; ++s)
#pragma unroll
                for (int nt = 0; nt < 4; ++nt) y[nt] = __builtin_amdgcn_mfma_f32_16x16x32_bf16(yb[s][nt], mn.xa[s], y[nt], 0, 0, 0);
#pragma unroll
            for (int nt = 0; nt < 4; ++nt) { sd.lg[nt] = lgu[nt]; sd.lb[nt] = lbu[nt]; }
            rwkv_out_core<DRY>(F, y, row, h, fq, sd); };
        OutMain mA, mB; OutSide sA, sB;
        issue(0, mA, sA); asm volatile("" ::: "memory");
        issue(1, mB, sB); asm volatile("" ::: "memory"); compute(0, mA, sA); asm volatile("" ::: "memory");
        issue(2, mA, sA); asm volatile("" ::: "memory"); compute(1, mB, sB); asm volatile("" ::: "memory");
        issue(3, mB, sB); asm volatile("" ::: "memory"); compute(2, mA, sA); asm volatile("" ::: "memory");
        compute(3, mB, sB);
    }
}

#define GRID_BAR() xcd_barrier(bar)
#ifndef PHASE_MASK
#define PHASE_MASK 0xffffffffu
#endif
#ifndef STRETCH_MASK
#define STRETCH_MASK 0u
#endif
struct StretchGuard { unsigned long long t0; bool on; __device__ __forceinline__ StretchGuard(bool o) : t0(o ? __builtin_amdgcn_s_memrealtime() : 0ull), on(o) {}
    __device__ __forceinline__ ~StretchGuard() { if (on) { __syncthreads(); const unsigned long long t1 = __builtin_amdgcn_s_memrealtime(); while (__builtin_amdgcn_s_memrealtime() < t1 + (t1 - t0)) __builtin_amdgcn_s_sleep(2); } } };
#define PH(k) if (StretchGuard sg_(((STRETCH_MASK) >> (k)) & 1u); PHASE_MASK & (1u << (k)))
#ifndef REP_MASK
#define REP_MASK 0u
#endif
#define REP(k) (((REP_MASK) >> (k)) & 1u)
#ifndef LOCAL_SKIP
#define LOCAL_SKIP 0
#endif
#ifndef EXTRA_BARS
#define EXTRA_BARS 0
#endif
template <int layer> __device__ __forceinline__ void layer_body(Frame& F, const XcdBarrier& bar) {
    unsigned char* ws = F.ws; unsigned char* ar = ws + WS_ARENA;
    bf16_t* XN = (bf16_t*)(ws + WS_XN);
    const float* MOD = (const float*)(ws + WS_MOD);
    constexpr int m = layer >> 1; const float* modl = MOD + (size_t)layer * NSEQ * 6144;
    PH(1) for (int rep = 0; rep <= (int)REP(1); ++rep) if (layer > 0) convert_layer_weights(F, layer);
    if constexpr ((layer & 1) == 0) {
        PH(2) for (int rep = 0; rep <= (int)REP(2); ++rep) { if constexpr (layer == 0) norm_pass<0, 0, true>(F, layer, 0, 0, F.in[I_XS], nullptr); else norm_pass<0, 8>(F, layer, layer - 1, 5120, F.out + (size_t)MP * D, (float*)(ws + WS_SXB)); }
        GRID_BAR();
        PH(3) { using GC = pg8::Geo<D, D, D, 30, 0, 1 << 20, 0>; pg8::Gemm<GC> g{XN, (const bf16_t*)(ar + AR_WIN), nullptr}; pg8::StaticOrder S; S.init(M, ABIN, F.G, (int)blockIdx.x);
          pg8::EpiBf16<0> E{(bf16_t*)(ws + WS_Z), ABIN};
          pg8::gemm_phase<pg8::EpiBf16<0>, pg8::StaticOrder, GC, true, true>(F.lds, g, S, E);
          if (REP(3)) { pg8::EpiNull<true> EN; pg8::gemm_phase<pg8::EpiNull<true>, pg8::StaticOrder, GC, true, true>(F.lds, g, S, EN); } }
        GRID_BAR();
        PH(4) for (int rep = 0; rep <= (int)REP(4); ++rep) for (int u = F.vcu; u < NCHUNK * 8; u += F.G) { const int c = u >> 3, hh = (u + u / F.G) & 7;
            if (c < 256) { if (hh < 4) ab_summary_unit<64, false>(F, layer, c, hh); else ab_summary_unit<64, true>(F, layer, c, hh - 4); }
            else { if (hh < 4) ab_summary_unit<32, false>(F, layer, c, hh); else ab_summary_unit<32, true>(F, layer, c, hh - 4); } }
        GRID_BAR();
        PH(5) { if (REP(5)) ab_scan<true>(F, layer); ab_scan<false>(F, layer); }
        GRID_BAR();
        PH(6) for (int rep = 0; rep <= (int)REP(6); ++rep) for (int u = F.vcu; u < NCHUNK * 8; u += F.G) { const int c = u >> 3, hh = (u + u / F.G) & 7;
            if (c < 256) { if (hh < 4) ab_output_unit<64, false>(F, layer, c, hh); else ab_output_unit<64, true>(F, layer, c, hh - 4); }
            else { if (hh < 4) ab_output_unit<32, false>(F, layer, c, hh); else ab_output_unit<32, true>(F, layer, c, hh - 4); } }
        GRID_BAR();
        PH(7) { using GC = pg8::Geo<D, D, D, 30, 0, 1 << 20, 0>; pg8::Gemm<GC> g{XN, (const bf16_t*)(ar + AR_WOUT), nullptr}; pg8::StaticOrder S; S.init(MP, D, F.G, (int)blockIdx.x);
          pg8::EpiRes E{F.out, modl, 2048, (layer == 0) ? F.in[I_XP] : F.out};
          pg8::gemm_phase<pg8::EpiRes, pg8::StaticOrder, GC, true, true>(F.lds, g, S, E);
          if (REP(7)) { pg8::EpiNull<false> EN; pg8::gemm_phase<pg8::EpiNull<false>, pg8::StaticOrder, GC, true, true>(F.lds, g, S, EN); }
          using GC2 = pg8::Geo<D, D, 256, 30, 0, 1 << 20, 0, true>; pg8::Gemm<GC2> g2{XN, (const bf16_t*)(ar + AR_WOUT), nullptr}; pg8::SplitOrder S2{F.vcu, 4};
          pg8::EpiPartial E2{(float*)(ws + WS_PART), 4};
          pg8::gemm_phase<pg8::EpiPartial, pg8::SplitOrder, GC2, true, true>(F.lds, g2, S2, E2); }
        GRID_BAR();
    } else {
        PH(8) for (int rep = 0; rep <= (int)REP(8); ++rep) norm_pass<1, 8>(F, layer, layer - 1, 5120, F.out + (size_t)MP * D, (float*)(ws + WS_SXB));
        GRID_BAR();
        PH(9) { using GCr = pg8::Geo<D, 2048, D, 2, M * D, 1 << 20, 0>; pg8::Gemm<GCr> gr{(const bf16_t*)(ws + WS_XMIX), (const bf16_t*)(ar + AR_WC1), nullptr}; pg8::StaticOrder Sr; Sr.init(M, 3072, F.G, (int)blockIdx.x);
          pg8::EpiRkv E{(bf16_t*)(ws + WS_RKV), (bf16_t*)(ws + WS_LO), (m == 0) ? (bf16_t*)(ws + WS_VFIRST) : nullptr};
          pg8::gemm_phase<pg8::EpiRkv, pg8::StaticOrder, GCr, true, true>(F.lds, gr, Sr, E);
          if (REP(9)) { pg8::EpiNull<true> EN; pg8::gemm_phase<pg8::EpiNull<true>, pg8::StaticOrder, GCr, true, true>(F.lds, gr, Sr, EN); }
          using GC = pg8::Geo<D, 2048, 2048, 30, 0, 16, -4096>; pg8::Gemm<GC> g{XN, (const bf16_t*)(ar + AR_WC1), (const bf16_t*)(ws + WS_PREVS)}; pg8::LoraOrder Sl{(int)blockIdx.x};
          pg8::gemm_phase<pg8::EpiRkv, pg8::LoraOrder, GC, true, true>(F.lds, g, Sl, E); }
        GRID_BAR();
        PH(10) { using GC = pg8::Geo<D, 256, 256, 2, 256, 1 << 20, 0>; pg8::Gemm<GC> g{(const bf16_t*)(ws + WS_LO), (const bf16_t*)(ar + AR_WC2), nullptr}; pg8::SkipVOrder S; S.skip = (m == 0); S.S.init(M, (m == 0) ? 3072 : 4096, F.G, (int)blockIdx.x);
          pg8::EpiLora2 E{(bf16_t*)(ws + WS_WLOG), XN, (bf16_t*)(ws + WS_G), (bf16_t*)(ws + WS_RKV), (m == 1) ? (const bf16_t*)(ws + WS_VFIRST) : nullptr,
                          F.in[I_RW0] + m * D, F.in[I_RA0] + m * D, F.in[I_RV0]};
          pg8::gemm_phase<pg8::EpiLora2, pg8::SkipVOrder, GC, true, true>(F.lds, g, S, E);
           }
        GRID_BAR();
        PH(11) { RawRegs raw; const int tid0 = otid(); int u = F.vcu; if (u < 256 * 16) { rwkv_load_raw(F, layer >> 1, u, tid0, raw); RAW_CONSUME(raw); }
          for (; u < 256 * 16; u += F.G) { const int c = u >> 4, hh = u & 15, un = (u + F.G < 256 * 16) ? u + F.G : -1;
              rwkv_local_unit<64>(F, layer, c, hh, raw, un); } }
        GRID_BAR();
        PH(17) { if (REP(17)) rwkv_scan_phase<LOCAL_SKIP>(F, layer); rwkv_scan_phase<0>(F, layer); }
        GRID_BAR();
        PH(18) { if (REP(18)) rwkv_output_phase<true>(F, layer); rwkv_output_phase<false>(F, layer); }
        GRID_BAR();
        PH(12) { using GC = pg8::Geo<3072, D, D, 30, 0, 1 << 20, 0>; pg8::Gemm<GC> g{(const bf16_t*)(ws + WS_RKV), (const bf16_t*)(ar + AR_WO), nullptr}; pg8::StaticOrder S; S.init(MP, D, F.G, (int)blockIdx.x);
          pg8::EpiRes E{F.out, modl, 2048, F.out};
          pg8::gemm_phase<pg8::EpiRes, pg8::StaticOrder, GC, true, true>(F.lds, g, S, E);
          if (REP(12)) { pg8::EpiNull<false> EN; pg8::gemm_phase<pg8::EpiNull<false>, pg8::StaticOrder, GC, true, true>(F.lds, g, S, EN); }
          using GC2 = pg8::Geo<3072, D, 256, 30, 0, 1 << 20, 0, true>; pg8::Gemm<GC2> g2{(const bf16_t*)(ws + WS_RKV), (const bf16_t*)(ar + AR_WO), nullptr}; pg8::SplitOrder S2{F.vcu, 4};
          pg8::EpiPartial E2{(float*)(ws + WS_PART), 4};
          pg8::gemm_phase<pg8::EpiPartial, pg8::SplitOrder, GC2, true, true>(F.lds, g2, S2, E2); }
        GRID_BAR();
    }
    PH(13) for (int rep = 0; rep <= (int)REP(13); ++rep) norm_pass<2, 4>(F, layer, layer, 2048, (layer == 0) ? F.in[I_XS] : (const float*)(ws + WS_SXB), F.out + (size_t)MP * D);
    GRID_BAR();
    PH(14) { using GC = pg8::Geo<D, D, D, 30, 0, 1 << 20, 0>; pg8::Gemm<GC> g{XN, (const bf16_t*)(ar + AR_W1), nullptr}; pg8::StaticOrder S; S.init(M, DFF, F.G, (int)blockIdx.x);
      pg8::EpiBf16<1> E{(bf16_t*)(ws + WS_H), DFF};
      pg8::gemm_phase<pg8::EpiBf16<1>, pg8::StaticOrder, GC, true, true>(F.lds, g, S, E);
          if (REP(14)) { pg8::EpiNull<true> EN; pg8::gemm_phase<pg8::EpiNull<true>, pg8::StaticOrder, GC, true, true>(F.lds, g, S, EN); } }
    GRID_BAR();
    PH(15) { using GC = pg8::Geo<DFF, DFF, DFF, 30, 0, 1 << 20, 0>; pg8::Gemm<GC> g{(const bf16_t*)(ws + WS_H), (const bf16_t*)(ar + AR_W2), nullptr}; pg8::StaticOrder S; S.init(MP, D, F.G, (int)blockIdx.x);
      pg8::EpiRes E{F.out, modl, 5120, F.out};
      for (int xb = 0; xb < EXTRA_BARS; ++xb) GRID_BAR();
      pg8::gemm_phase<pg8::EpiRes, pg8::StaticOrder, GC, true, true>(F.lds, g, S, E);
      if (REP(15)) { pg8::EpiNull<false> EN; pg8::gemm_phase<pg8::EpiNull<false>, pg8::StaticOrder, GC, true, true>(F.lds, g, S, EN); }
      using GC2 = pg8::Geo<DFF, DFF, 512, 30, 0, 1 << 20, 0, true>; pg8::Gemm<GC2> g2{(const bf16_t*)(ws + WS_H), (const bf16_t*)(ar + AR_W2), nullptr}; pg8::SplitOrder S2{F.vcu, 8};
      pg8::EpiPartial E2{(float*)(ws + WS_PART), 8};
      pg8::gemm_phase<pg8::EpiPartial, pg8::SplitOrder, GC2, true, true>(F.lds, g2, S2, E2); }
    GRID_BAR();
}

__global__ void __launch_bounds__(NT, 2) fwd_kernel(Args args) {
    extern __shared__ __attribute__((aligned(16))) unsigned char lds[];
    Frame F;
    F.lds = (LAS unsigned char*)lds; F.MISC = (volatile LAS unsigned*)(F.lds + MISC_OFF);
    F.wave = __builtin_amdgcn_readfirstlane(threadIdx.x >> 6);
    F.G = gridDim.x; { const int bx = blockIdx.x; F.vcu = (F.G % 8 == 0) ? (bx % 8) * (F.G / 8) + bx / 8 : bx; }
    F.in = args.in; F.out = args.out; F.ws = args.ws;
    for (int u = threadIdx.x; u < (LDS_BYTES - LDSCTL_OFF) / 4; u += NT) ((LAS unsigned*)(F.lds + LDSCTL_OFF))[u] = 0u;
    __syncthreads();
    XcdBarrier bar = xcd_barrier_post((unsigned*)(F.ws + WS_CTL) + CW_BAR, F.MISC + 8);
    PH(0) prologue(F);
    GRID_BAR();
    PH(0) mod_phase(F, 0, 2, F.vcu, F.G);
    GRID_BAR();
    layer_body<0>(F, bar); layer_body<1>(F, bar); layer_body<2>(F, bar); layer_body<3>(F, bar);
    PH(16) norm_pass<3, 8>(F, 0, 3, 5120, F.out + (size_t)MP * D, nullptr);
}

extern "C" void kernel_launch(void* const* d_in, const int* in_sizes, int n_in, void* d_out, int out_size, void* d_ws, size_t ws_size, hipStream_t stream) {
    static int grid = 0;
    if (grid == 0) {
        if (n_in != 38 || out_size != 28706816 || ws_size < WS_END) { fprintf(stderr, "kernel_launch: unexpected problem (n_in %d, out %d, ws %zu; need ws >= %zu)\n", n_in, out_size, ws_size, (size_t)WS_END); grid = -1; return; }
        int dev = 0, cus = 0, per_cu = 0;
        if (hipGetDevice(&dev) != hipSuccess || hipDeviceGetAttribute(&cus, hipDeviceAttributeMultiprocessorCount, dev) != hipSuccess) { grid = -1; return; }
        if (hipFuncSetAttribute((const void*)fwd_kernel, hipFuncAttributeMaxDynamicSharedMemorySize, LDS_BYTES) != hipSuccess) { fprintf(stderr, "kernel_launch: hipFuncSetAttribute failed\n"); grid = -1; return; }
        if (hipOccupancyMaxActiveBlocksPerMultiprocessor(&per_cu, (const void*)fwd_kernel, NT, LDS_BYTES) != hipSuccess || per_cu < 1) { fprintf(stderr, "kernel_launch: occupancy query says %d\n", per_cu); per_cu = 1; }
        (void)hipGetLastError();
        grid = cus;
    }
    if (grid < 0) return;
    (void)hipMemsetAsync((char*)d_ws + WS_CTL, 0, ZERO_BYTES, stream);
    Args a{};
    for (int i = 0; i < 38; ++i) a.in[i] = (const float*)d_in[i];
    a.out = (float*)d_out; a.ws = (unsigned char*)d_ws;
    void* kargs[] = {&a};
    hipError_t e = hipLaunchCooperativeKernel((const void*)fwd_kernel, dim3(grid), dim3(NT), kargs, LDS_BYTES, stream);
    if (e != hipSuccess) fprintf(stderr, "kernel_launch: cooperative launch failed: %s (grid %d)\n", hipGetErrorString(e), grid);
}
```
